# Optimizing an MI355X kernel written in HIP

```python
import jax, jax.numpy as jnp
from jax import lax
import numpy as np

D_MODEL = 1024
BATCH = 8
SEQ = 4096
DEPTH = 1

HEAD_DIM = 64
ROPE_THETA = 10000.0
BLOCK = 128
RMS_EPS = 1e-6
DIL_GROUPS = ((128, 1), (512, 4), (2048, 16))
N_DIL_GROUPS = len(DIL_GROUPS)
A_HEADS = D_MODEL // (2 * HEAD_DIM)
A_GROUP_WIDTH = A_HEADS * HEAD_DIM
A_QKV_WIDTH = 3 * N_DIL_GROUPS * A_GROUP_WIDTH
B_Q_HEADS = D_MODEL // HEAD_DIM
B_KV_HEADS = max(1, B_Q_HEADS // 8)
B_GROUP = B_Q_HEADS // B_KV_HEADS
B_WINDOW = 128
B_Q_WIDTH = B_Q_HEADS * HEAD_DIM
B_KV_WIDTH = B_KV_HEADS * HEAD_DIM
B_QKV_WIDTH = B_Q_WIDTH + 2 * B_KV_WIDTH
N_BRANCHES = 2
GATE_WIDTH = N_BRANCHES * D_MODEL
IN_WIDTH = A_QKV_WIDTH + B_QKV_WIDTH + GATE_WIDTH
N_EXPERT_GROUPS = 4
EXPERTS_PER_GROUP = 8
N_EXPERTS = N_EXPERT_GROUPS * EXPERTS_PER_GROUP
TOP_K_IN_GROUP = 2
D_EXPERT = D_MODEL // 4

kernel_name = "hybrid_dilated_swa_sink_hmoe"


def rmsnorm(x, g):
    xf = x.astype(jnp.float32)
    y = xf * lax.rsqrt(jnp.mean(xf * xf, axis=-1, keepdims=True) + RMS_EPS)
    return (y * g.astype(jnp.float32)).astype(x.dtype)


def rope(t, cos, sin):
    half = t.shape[-1] // 2
    tf = t.astype(jnp.float32)
    t1, t2 = tf[..., :half], tf[..., half:]
    c, s = cos[:, None, :], sin[:, None, :]
    return jnp.concatenate([t1 * c - t2 * s, t2 * c + t1 * s], axis=-1).astype(t.dtype)


def banded_attention(q, k, v, max_dist, sink=None):
    n, hk, g, L, hd = q.shape
    nb = -(-L // BLOCK)
    lp = nb * BLOCK
    qb = jnp.pad(q, ((0, 0), (0, 0), (0, 0), (0, lp - L), (0, 0))).reshape(n, hk, g, nb, BLOCK, hd)
    kv_pad = ((0, 0), (0, 0), (BLOCK, lp - L), (0, 0))
    kp = jnp.pad(k, kv_pad).reshape(n, hk, nb + 1, BLOCK, hd)
    vp = jnp.pad(v, kv_pad).reshape(n, hk, nb + 1, BLOCK, hd)
    kb = jnp.concatenate([kp[:, :, :-1], kp[:, :, 1:]], axis=3)
    vb = jnp.concatenate([vp[:, :, :-1], vp[:, :, 1:]], axis=3)
    s = jnp.einsum('nhgiqd,nhikd->nhgiqk', qb, kb).astype(jnp.float32) * (hd ** -0.5)
    r = jnp.arange(BLOCK)[:, None]
    c = jnp.arange(2 * BLOCK)[None, :]
    dist = r - c + BLOCK
    kpos = jnp.arange(nb)[:, None, None] * BLOCK - BLOCK + c[None]
    mask = (dist >= 0)[None] & (dist <= max_dist)[None] & (kpos >= 0)
    s = jnp.where(mask, s, -jnp.inf)
    m = jnp.max(s, axis=-1)
    if sink is not None:
        sink_b = sink.astype(jnp.float32)[None, :, :, None, None]
        m = jnp.maximum(m, sink_b)
    p = jnp.exp(s - m[..., None])
    denom = jnp.sum(p, axis=-1)
    if sink is not None:
        denom = denom + jnp.exp(sink_b - m)
    o = jnp.einsum('nhgiqk,nhikd->nhgiqd', p.astype(v.dtype), vb).astype(jnp.float32) / denom[..., None]
    lse = m + jnp.log(denom)
    o = o.astype(q.dtype).reshape(n, hk, g, lp, hd)[:, :, :, :L]
    lse = lse.reshape(n, hk, g, lp)[:, :, :, :L]
    return o, lse


def dilated_group(q, k, v, window, dilation):
    b, s, h, hd = q.shape
    ls = s // dilation

    def to_sub(t):
        return t.reshape(b, ls, dilation, h, hd).transpose(0, 2, 3, 1, 4).reshape(b * dilation, h, ls, hd)

    o, lse = banded_attention(to_sub(q)[:, :, None], to_sub(k), to_sub(v), window // dilation)
    o = o[:, :, 0].reshape(b, dilation, h, ls, hd).transpose(0, 3, 1, 2, 4).reshape(b, s, h, hd)
    lse = lse[:, :, 0].reshape(b, dilation, h, ls).transpose(0, 3, 1, 2).reshape(b, s, h)
    return o, lse


def hier_moe(t, w_rg, b_rg, w_re, b_re, w_eg, w_eu, w_ed):
    n_tok = t.shape[0]
    lg = (t @ w_rg).astype(jnp.float32) + b_rg.astype(jnp.float32)
    pg = jax.nn.softmax(lg, axis=-1)
    gsel = jnp.argmax(lg, axis=-1)
    pg_sel = jnp.take_along_axis(pg, gsel[:, None], axis=-1)[:, 0]
    le = ((t @ w_re).astype(jnp.float32) + b_re.astype(jnp.float32)).reshape(n_tok, N_EXPERT_GROUPS, EXPERTS_PER_GROUP)
    le_sel = jnp.take_along_axis(le, gsel[:, None, None], axis=1)[:, 0]
    pe = jax.nn.softmax(le_sel, axis=-1)
    top_p, top_i = lax.top_k(pe, TOP_K_IN_GROUP)
    wts = pg_sel[:, None] * top_p / jnp.sum(top_p, axis=-1, keepdims=True)
    eidx = gsel[:, None] * EXPERTS_PER_GROUP + top_i
    combine = jnp.sum(jax.nn.one_hot(eidx, N_EXPERTS, dtype=jnp.float32) * wts[..., None], axis=1)
    y = jnp.zeros((n_tok, t.shape[1]), jnp.float32)
    for gi in range(N_EXPERT_GROUPS):
        sl = slice(gi * EXPERTS_PER_GROUP, (gi + 1) * EXPERTS_PER_GROUP)
        hg = jnp.einsum('td,edf->etf', t, w_eg[sl])
        hu = jnp.einsum('td,edf->etf', t, w_eu[sl])
        a = jax.nn.silu(hg) * hu * combine[:, sl].T[:, :, None].astype(t.dtype)
        y = y + jnp.einsum('etf,efd->td', a, w_ed[sl]).astype(jnp.float32)
    return y.astype(t.dtype)


def hybrid_layer(x, cos, sin, w_in, b_in, sinks, w_proj_a, w_proj_b, w_out, g_mix, g_ffn,
                 w_rg, b_rg, w_re, b_re, w_eg, w_eu, w_ed):
    b, s, d = x.shape
    h = rmsnorm(x, g_mix)
    z = h @ w_in + b_in
    za = z[..., :A_QKV_WIDTH]
    zb = z[..., A_QKV_WIDTH:A_QKV_WIDTH + B_QKV_WIDTH]
    zg = z[..., A_QKV_WIDTH + B_QKV_WIDTH:]

    za = za.reshape(b, s, 3, N_DIL_GROUPS, A_HEADS, HEAD_DIM)
    outs, lses = [], []
    for gi, (window, dil) in enumerate(DIL_GROUPS):
        qa = rope(za[:, :, 0, gi], cos, sin)
        ka = rope(za[:, :, 1, gi], cos, sin)
        o, l = dilated_group(qa, ka, za[:, :, 2, gi], window, dil)
        outs.append(o)
        lses.append(l)
    wgt = jax.nn.softmax(jnp.stack(lses), axis=0)
    ya = jnp.einsum('gbsh,gbshd->bshd', wgt.astype(x.dtype), jnp.stack(outs)).reshape(b, s, A_GROUP_WIDTH)

    qb = rope(zb[..., :B_Q_WIDTH].reshape(b, s, B_Q_HEADS, HEAD_DIM), cos, sin)
    kb = rope(zb[..., B_Q_WIDTH:B_Q_WIDTH + B_KV_WIDTH].reshape(b, s, B_KV_HEADS, HEAD_DIM), cos, sin)
    vb = zb[..., B_Q_WIDTH + B_KV_WIDTH:].reshape(b, s, B_KV_HEADS, HEAD_DIM)
    qb = qb.reshape(b, s, B_KV_HEADS, B_GROUP, HEAD_DIM).transpose(0, 2, 3, 1, 4)
    ob, _ = banded_attention(qb, kb.transpose(0, 2, 1, 3), vb.transpose(0, 2, 1, 3),
                             B_WINDOW - 1, sinks.reshape(B_KV_HEADS, B_GROUP))
    yb = ob.transpose(0, 3, 1, 2, 4).reshape(b, s, B_Q_WIDTH)

    gates = jax.nn.sigmoid(zg.reshape(b, s, N_BRANCHES, d))
    merged = gates[:, :, 0] * (ya @ w_proj_a) + gates[:, :, 1] * (yb @ w_proj_b)
    x = x + merged @ w_out

    h2 = rmsnorm(x, g_ffn)
    x = x + hier_moe(h2.reshape(b * s, d), w_rg, b_rg, w_re, b_re, w_eg, w_eu, w_ed).reshape(b, s, d)
    return x


def setup_inputs(seed: int = 0) -> dict:
    key = jax.random.key(seed)
    ks = jax.random.split(key, 18)
    f32 = jnp.float32
    nrm = lambda k, shape, scale: jax.random.normal(k, shape, f32) * scale
    return {
        "x": nrm(ks[0], (BATCH, SEQ, D_MODEL), 1.0),
        "w_in": nrm(ks[1], (DEPTH, D_MODEL, IN_WIDTH), D_MODEL ** -0.5),
        "b_in": nrm(ks[2], (DEPTH, IN_WIDTH), 0.02),
        "sinks": nrm(ks[3], (DEPTH, B_Q_HEADS), 0.5),
        "w_proj_a": nrm(ks[4], (DEPTH, A_GROUP_WIDTH, D_MODEL), A_GROUP_WIDTH ** -0.5),
        "w_proj_b": nrm(ks[5], (DEPTH, B_Q_WIDTH, D_MODEL), B_Q_WIDTH ** -0.5),
        "w_out": nrm(ks[6], (DEPTH, D_MODEL, D_MODEL), D_MODEL ** -0.5),
        "g_mix": 1.0 + nrm(ks[7], (DEPTH, D_MODEL), 0.05),
        "g_ffn": 1.0 + nrm(ks[8], (DEPTH, D_MODEL), 0.05),
        "w_router_group": nrm(ks[9], (DEPTH, D_MODEL, N_EXPERT_GROUPS), D_MODEL ** -0.5),
        "b_router_group": nrm(ks[10], (DEPTH, N_EXPERT_GROUPS), 0.01),
        "w_router_expert": nrm(ks[11], (DEPTH, D_MODEL, N_EXPERTS), D_MODEL ** -0.5),
        "b_router_expert": nrm(ks[12], (DEPTH, N_EXPERTS), 0.01),
        "w_exp_gate": nrm(ks[13], (DEPTH, N_EXPERTS, D_MODEL, D_EXPERT), D_MODEL ** -0.5),
        "w_exp_up": nrm(ks[14], (DEPTH, N_EXPERTS, D_MODEL, D_EXPERT), D_MODEL ** -0.5),
        "w_exp_down": nrm(ks[15], (DEPTH, N_EXPERTS, D_EXPERT, D_MODEL), D_EXPERT ** -0.5),
        "g_final": 1.0 + nrm(ks[16], (D_MODEL,), 0.05),
    }


def reference(x, w_in, b_in, sinks, w_proj_a, w_proj_b, w_out, g_mix, g_ffn,
              w_router_group, b_router_group, w_router_expert, b_router_expert,
              w_exp_gate, w_exp_up, w_exp_down, g_final):
    s = x.shape[1]
    pos = jnp.arange(s, dtype=jnp.float32)
    inv_freq = ROPE_THETA ** (-jnp.arange(0, HEAD_DIM, 2, dtype=jnp.float32) / HEAD_DIM)
    ang = pos[:, None] * inv_freq[None, :]
    cos, sin = jnp.cos(ang), jnp.sin(ang)
    for layer in range(DEPTH):
        x = hybrid_layer(x, cos, sin, w_in[layer], b_in[layer], sinks[layer], w_proj_a[layer],
                         w_proj_b[layer], w_out[layer], g_mix[layer], g_ffn[layer],
                         w_router_group[layer], b_router_group[layer], w_router_expert[layer],
                         b_router_expert[layer], w_exp_gate[layer], w_exp_up[layer], w_exp_down[layer])
    return rmsnorm(x, g_final)
```

```cpp
#include <hip/hip_runtime.h>
#include <cstdint>
#include <cstdio>

#define GAS __attribute__((address_space(1)))
#define LAS __attribute__((address_space(3)))
typedef unsigned short bf16;
typedef short bf16x8 __attribute__((ext_vector_type(8)));
typedef float f32x4 __attribute__((ext_vector_type(4)));
typedef unsigned v4u __attribute__((ext_vector_type(4)));
typedef unsigned v2u __attribute__((ext_vector_type(2)));
typedef GAS unsigned gu32;

constexpr int T = 32768, D = 1024, SEQ = 4096, NIN = 7936;
constexpr int A_W = 4608, B_W = 1280, G_W = 2048, Y_W = 1536;
constexpr int NE = 32, DE = 256;
constexpr int NCH = 4, TC = T / NCH;
constexpr float QSCALE = 0.125f * 1.4426950408889634f;
constexpr float LOG2E = 1.4426950408889634f;
constexpr float RMS_EPS = 1e-6f;
constexpr int NWAVES = 8, NTHR = 512;

constexpr size_t MiB = 1u << 20;
constexpr size_t WS_CTL = 0, CTL_BYTES = 1 * MiB;
constexpr size_t WS_ROPE = 1 * MiB;
constexpr size_t WS_WRT = 2 * MiB;
constexpr size_t WS_TOKOF = 3 * MiB;
constexpr size_t WS_WTOF = 7 * MiB;
constexpr size_t WS_TPOS = 11 * MiB;
constexpr size_t WS_WIN = 12 * MiB;
constexpr size_t WS_WAB = 28 * MiB;
constexpr size_t WS_WO = 31 * MiB;
constexpr size_t WS_WGU = 33 * MiB;
constexpr size_t WS_WD = 65 * MiB;
constexpr size_t WS_HN = 82 * MiB;
constexpr size_t WS_G = 146 * MiB;
constexpr size_t WS_Y = 274 * MiB;
constexpr size_t WS_ZA = 370 * MiB;
constexpr size_t WS_ZB = 442 * MiB;
constexpr size_t WS_MG = 370 * MiB;
constexpr size_t WS_HACT = 146 * MiB;
constexpr size_t WS_YS = 182 * MiB;
constexpr size_t WS_END = 462 * MiB;
constexpr int MAXSLOT = 2 * T + NE * 256;
static_assert(WS_ZA + (size_t)TC * A_W * 2 <= WS_ZB && WS_ZB + (size_t)TC * B_W * 2 <= WS_END, "ws map");
static_assert(WS_MG + (size_t)T * D * 2 <= WS_END && WS_HACT + (size_t)MAXSLOT * DE * 2 <= WS_YS && WS_YS + (size_t)MAXSLOT * D * 2 <= WS_ZA, "ws map");
constexpr int CW_CNT = 1024;
constexpr int CW_BAR = 4096;
constexpr int LDS_BYTES = 147456;
constexpr int LDS_MISC = 131072;

__device__ __forceinline__ unsigned f2bf(float f) { unsigned u = __builtin_bit_cast(unsigned, f); return (u + 0x7fffu + ((u >> 16) & 1u)) >> 16; }
__device__ __forceinline__ unsigned pk2(float lo, float hi) { return f2bf(lo) | (f2bf(hi) << 16); }
__device__ __forceinline__ float bf2f(unsigned b) { return __builtin_bit_cast(float, b << 16); }
__device__ __forceinline__ float bflo(unsigned u) { return __builtin_bit_cast(float, u << 16); }
__device__ __forceinline__ float bfhi(unsigned u) { return __builtin_bit_cast(float, u & 0xffff0000u); }
__device__ __forceinline__ float wave_sum(float v) {
#pragma unroll
    for (int o = 1; o < 64; o <<= 1) v += __shfl_xor(v, o);
    return v;
}
__device__ __forceinline__ float wave_max(float v) {
#pragma unroll
    for (int o = 1; o < 64; o <<= 1) v = fmaxf(v, __shfl_xor(v, o));
    return v;
}
#define LDS_WAIT() asm volatile("s_waitcnt lgkmcnt(0)" ::: "memory")
#define VM_WAIT() asm volatile("s_waitcnt vmcnt(0)" ::: "memory")

#define XB_TMO      128
#define XB_XCNT(j)  (256  + 64 * (j))
#define XB_XSUB(j)  (1280 + 64 * (j))
#define XB_XGEN(j)  (2304 + 64 * (j))
#define XB_TOP      3328
#define XB_TOPGEN   3392
#define XCD_BAR_WORDS 3456
#define XB_SPIN_CAP (1u << 18)
__device__ __forceinline__ unsigned xb_ld(unsigned* p)              { return __hip_atomic_load(p, __ATOMIC_RELAXED, __HIP_MEMORY_SCOPE_AGENT); }
__device__ __forceinline__ unsigned xb_add(unsigned* p, unsigned v) { return __hip_atomic_fetch_add(p, v, __ATOMIC_RELAXED, __HIP_MEMORY_SCOPE_AGENT); }
__device__ __forceinline__ unsigned xb_xcc_id() { return (unsigned)__builtin_amdgcn_s_getreg((3 << 11) | 20) & 0xFu; }
#define XB_SPIN(cond, bar) do { unsigned _sp = 0; while (cond) { __builtin_amdgcn_s_sleep(1); \
    if ((++_sp & 255u) == 0u) { if (xb_ld(&(bar)[XB_TMO])) break; if (_sp > XB_SPIN_CAP) { atomicAdd(&(bar)[XB_TMO], 1u); break; } } } } while (0)
struct XcdBarrier { unsigned* bar; unsigned x; volatile LAS unsigned* st; };
__device__ __forceinline__ XcdBarrier xcd_barrier_post(unsigned* bar, volatile LAS unsigned* st) {
    XcdBarrier b; b.bar = bar; b.x = xb_xcc_id(); b.st = st;
    if (threadIdx.x == 0) (void)xb_add(&bar[XB_XCNT(b.x)], 1u);
    return b;
}
__device__ __forceinline__ void xcd_barrier_complete(unsigned* bar, unsigned x, unsigned& nloc, unsigned& nx) {
    const unsigned G = gridDim.x * gridDim.y * gridDim.z;
    unsigned sum, cnt, mine, sp = 0u;
    for (;;) {
        sum = 0u; cnt = 0u; mine = 0u;
#pragma unroll
        for (unsigned j = 0; j < 16; ++j) { const unsigned c = xb_ld(&bar[XB_XCNT(j)]); sum += c; cnt += (c > 0u) ? 1u : 0u; mine = (j == x) ? c : mine; }
        if (sum == G) break;
        __builtin_amdgcn_s_sleep(1);
        if ((++sp & 255u) == 0u) { if (xb_ld(&bar[XB_TMO])) break; if (sp > XB_SPIN_CAP) { atomicAdd(&bar[XB_TMO], 1u); break; } }
    }
    nloc = mine > 0u ? mine : 1u; nx = cnt > 0u ? cnt : 1u;
}
__device__ __forceinline__ void xcd_barrier(const XcdBarrier& b) {
    asm volatile("s_waitcnt vmcnt(0)" ::: "memory");
    __syncthreads();
    if (threadIdx.x == 0) {
        unsigned* bar = b.bar;
        __builtin_amdgcn_s_waitcnt(0);
        unsigned nloc = b.st[0], nx = b.st[1];
        if (nloc == 0u) { xcd_barrier_complete(bar, b.x, nloc, nx); b.st[0] = nloc; b.st[1] = nx; }
        const unsigned old = xb_add(&bar[XB_XSUB(b.x)], 1u);
        const unsigned gen = old / nloc;
        if (old + 1u == (gen + 1u) * nloc) {
            __builtin_amdgcn_fence(__ATOMIC_RELEASE, "agent");
            asm volatile("s_waitcnt vmcnt(0)" ::: "memory");
            const unsigned og = xb_add(&bar[XB_TOP], 1u);
            const unsigned tg = og / nx;
            if (og + 1u == (tg + 1u) * nx) xb_add(&bar[XB_TOPGEN], 1u);
            else XB_SPIN(xb_ld(&bar[XB_TOPGEN]) == tg, bar);
            __builtin_amdgcn_fence(__ATOMIC_ACQUIRE, "agent");
            xb_add(&bar[XB_XGEN(b.x)], 1u);
            asm volatile("s_waitcnt vmcnt(0)" ::: "memory");
        } else {
            XB_SPIN(xb_ld(&bar[XB_XGEN(b.x)]) == gen, bar);
            __builtin_amdgcn_fence(__ATOMIC_ACQUIRE, "agent");
            asm volatile("s_waitcnt vmcnt(0)" ::: "memory");
        }
    }
    __syncthreads();
}

struct KArgs { const float* in[17]; float* out; unsigned char* ws; int ph_lo, ph_hi, li, pad; };
struct Frame {
    LAS unsigned char* lds;
    int tid, lane, wave, vcu, G;
    const float* in[17]; float* out; unsigned char* ws;
};
enum { I_X = 0, I_WIN, I_BIN, I_SINK, I_WPA, I_WPB, I_WOUT, I_GMIX, I_GFFN, I_WRG, I_BRG, I_WRE, I_BRE, I_WEG, I_WEU, I_WED, I_GFIN };

__device__ __forceinline__ void p0_tr_item(const float* W, int N, bf16* WT, int ldo, int rowbase, int koff, int k0, int n0, LAS float* scr, int lane) {
#pragma unroll 8
    for (int i = 0; i < 32; ++i) { const int kk = 2 * i + (lane >> 5); scr[kk * 33 + (lane & 31)] = W[(size_t)(k0 + kk) * N + n0 + (lane & 31)]; }
    LDS_WAIT(); asm volatile("" ::: "memory");
    const int c = lane & 7;
#pragma unroll
    for (int j = 0; j < 4; ++j) { const int n = (lane >> 3) + 8 * j; const LAS float* s = scr + (8 * c) * 33 + n;
        v4u o; o.x = pk2(s[0 * 33], s[1 * 33]); o.y = pk2(s[2 * 33], s[3 * 33]); o.z = pk2(s[4 * 33], s[5 * 33]); o.w = pk2(s[6 * 33], s[7 * 33]);
        *(GAS v4u*)(WT + (size_t)(rowbase + n) * ldo + koff + k0 + 8 * c) = o; }
    LDS_WAIT(); asm volatile("" ::: "memory");
}
__device__ __forceinline__ void rms_row_to_bf16(const float* xrow, const float* g, bf16* orow, int lane) {
    const GAS f32x4* xr = (const GAS f32x4*)xrow + lane; const GAS f32x4* gr = (const GAS f32x4*)g + lane;
    f32x4 v[4]; float s = 0.f;
#pragma unroll
    for (int j = 0; j < 4; ++j) { v[j] = xr[64 * j]; s += (v[j].x * v[j].x + v[j].y * v[j].y) + (v[j].z * v[j].z + v[j].w * v[j].w); }
    const float rstd = 1.0f / sqrtf(wave_sum(s) * (1.f / D) + RMS_EPS);
    GAS v2u* o8 = (GAS v2u*)orow + lane;
#pragma unroll
    for (int j = 0; j < 4; ++j) { const f32x4 gg = gr[64 * j]; v2u w; w.x = pk2(v[j].x * rstd * gg.x, v[j].y * rstd * gg.y); w.y = pk2(v[j].z * rstd * gg.z, v[j].w * rstd * gg.w); o8[64 * j] = w; }
}
__device__ __forceinline__ void p0_prologue(Frame& F) {
    LAS float* scr = (LAS float*)(F.lds + F.wave * 16384);
    const int gw = F.vcu * NWAVES + F.wave, NGW = F.G * NWAVES;
    unsigned char* ws = F.ws;
    constexpr int I_IN = 16 * 248, I_PA = 8 * 32, I_PB = 16 * 32, I_WO = 16 * 32, I_EG = 32 * 16 * 8, I_ED = 32 * 4 * 32;
    constexpr int NITEMS = I_IN + I_PA + I_PB + I_WO + 2 * I_EG + I_ED;
    for (int it = gw; it < NITEMS; it += NGW) {
        int r = it;
        if (r < I_IN) { const int kb = r / 248, nb = r % 248; p0_tr_item(F.in[I_WIN], NIN, (bf16*)(ws + WS_WIN), 1024, 32 * nb, 0, 64 * kb, 32 * nb, scr, F.lane); continue; } r -= I_IN;
        if (r < I_PA) { const int kb = r / 32, nb = r % 32; p0_tr_item(F.in[I_WPA], 1024, (bf16*)(ws + WS_WAB), 1536, 32 * nb, 0, 64 * kb, 32 * nb, scr, F.lane); continue; } r -= I_PA;
        if (r < I_PB) { const int kb = r / 32, nb = r % 32; p0_tr_item(F.in[I_WPB], 1024, (bf16*)(ws + WS_WAB), 1536, 32 * nb, 512, 64 * kb, 32 * nb, scr, F.lane); continue; } r -= I_PB;
        if (r < I_WO) { const int kb = r / 32, nb = r % 32; p0_tr_item(F.in[I_WOUT], 1024, (bf16*)(ws + WS_WO), 1024, 32 * nb, 0, 64 * kb, 32 * nb, scr, F.lane); continue; } r -= I_WO;
        if (r < 2 * I_EG) { const int up = r >= I_EG; if (up) r -= I_EG; const int e = r / 128, q = r % 128, kb = q / 8, nb = q % 8;
            p0_tr_item(F.in[up ? I_WEU : I_WEG] + (size_t)e * 1024 * 256, 256, (bf16*)(ws + WS_WGU) + (size_t)e * 512 * 1024, 1024, 64 * nb + (up ? 32 : 0), 0, 64 * kb, 32 * nb, scr, F.lane); continue; } r -= 2 * I_EG;
        { const int e = r / 128, q = r % 128, kb = q / 32, nb = q % 32;
            p0_tr_item(F.in[I_WED] + (size_t)e * 256 * 1024, 1024, (bf16*)(ws + WS_WD) + (size_t)e * 1024 * 256, 256, 32 * nb, 0, 64 * kb, 32 * nb, scr, F.lane); }
    }
    for (int m = gw; m < T; m += NGW) rms_row_to_bf16(F.in[I_X] + (size_t)m * D, F.in[I_GMIX], (bf16*)(ws + WS_HN) + (size_t)m * D, F.lane);
    const int gt = F.vcu * NTHR + F.tid, NGT = F.G * NTHR;
    for (int i = gt; i < SEQ * 32; i += NGT) {
        const int pos = i >> 5, fi = i & 31;
        const float inv = (float)exp2(-(double)fi * (13.287712379549449 / 32.0));
        const float ang = (float)pos * inv; float s, c; sincosf(ang, &s, &c);
        ((float2*)(ws + WS_ROPE))[i] = make_float2(c, s);
    }
    for (int i = gt; i < 36 * 1024; i += NGT) {
        const int o = i >> 10, k = i & 1023;
        ((float*)(ws + WS_WRT))[i] = o < 4 ? F.in[I_WRG][k * 4 + o] : F.in[I_WRE][k * 32 + (o - 4)];
    }
}

constexpr int SG_BUF = 24576;
__device__ __forceinline__ void sg_kloop(LAS unsigned char* lds, f32x4 (&acc)[4][4], const bf16* a0, const bf16* a1, const bf16* b0, int nt, int wid, int lane) {
    const int wr = wid >> 1, wc = wid & 1, fr = lane & 15, fq = lane >> 4;
    const unsigned wbase = (unsigned)wid * 1024u;
#define SG_STAGE(buf, kt) do { \
        __builtin_amdgcn_global_load_lds((const unsigned*)(a0 + (kt) * 32), (LAS unsigned*)(lds + (buf) * SG_BUF + wbase), 16, 0, 0); \
        __builtin_amdgcn_global_load_lds((const unsigned*)(a1 + (kt) * 32), (LAS unsigned*)(lds + (buf) * SG_BUF + 8192 + wbase), 16, 0, 0); \
        __builtin_amdgcn_global_load_lds((const unsigned*)(b0 + (kt) * 32), (LAS unsigned*)(lds + (buf) * SG_BUF + 16384 + wbase), 16, 0, 0); } while (0)
    SG_STAGE(0, 0);
    VM_WAIT(); __syncthreads();
    int cur = 0;
    for (int t = 0; t < nt; ++t) {
        if (t + 1 < nt) SG_STAGE(cur ^ 1, t + 1);
        const LAS unsigned char* sa = lds + cur * SG_BUF + (wr * 64 + fr) * 64 + fq * 16;
        const LAS unsigned char* sb = lds + cur * SG_BUF + 16384 + (wc * 64 + fr) * 64 + fq * 16;
        bf16x8 At[4], Bt[4];
#pragma unroll
        for (int m = 0; m < 4; ++m) At[m] = *(const LAS bf16x8*)(sa + m * 1024);
#pragma unroll
        for (int n = 0; n < 4; ++n) Bt[n] = *(const LAS bf16x8*)(sb + n * 1024);
#pragma unroll
        for (int m = 0; m < 4; ++m)
#pragma unroll
            for (int n = 0; n < 4; ++n) acc[m][n] = __builtin_amdgcn_mfma_f32_16x16x32_bf16(At[m], Bt[n], acc[m][n], 0, 0, 0);
        VM_WAIT(); __syncthreads();
        cur ^= 1;
    }
#undef SG_STAGE
}
__device__ __forceinline__ void zero_acc(f32x4 (&acc)[4][4]) {
#pragma unroll
    for (int m = 0; m < 4; ++m)
#pragma unroll
        for (int n = 0; n < 4; ++n) acc[m][n] = (f32x4){0.f, 0.f, 0.f, 0.f};
}

__device__ __forceinline__ void p1_inproj(Frame& F, int ch) {
    unsigned char* ws = F.ws;
    const bf16* A = (const bf16*)(ws + WS_HN) + (size_t)ch * TC * D;
    const bf16* Bt = (const bf16*)(ws + WS_WIN);
    bf16* ZA = (bf16*)(ws + WS_ZA); bf16* ZB = (bf16*)(ws + WS_ZB); bf16* Gt = (bf16*)(ws + WS_G) + (size_t)ch * TC * G_W;
    const float2* rope = (const float2*)(ws + WS_ROPE);
    const float* bias = F.in[I_BIN];
    const int wid = F.wave, lane = F.lane, wr = wid >> 1, wc = wid & 1, fr = lane & 15, fq = lane >> 4;
    constexpr int NCT = NIN / 128, NU = (TC / 256) * NCT;
    for (int u = F.vcu; u < NU; u += F.G) {
        const int pm = u / NCT, pn = u % NCT;
        f32x4 acc[4][4]; zero_acc(acc);
        const int ar = F.tid >> 2, ac = (F.tid & 3) * 8;
        const bf16* a0 = A + (size_t)(pm * 256 + ar) * D + ac; const bf16* a1 = a0 + (size_t)128 * D;
        const bf16* b0 = Bt + (size_t)(pn * 128 + ar) * D + ac;
        sg_kloop(F.lds, acc, a0, a1, b0, D / 32, wid, lane);
        const int colbase = pn * 128 + wc * 64;
        float bv[4];
#pragma unroll
        for (int n = 0; n < 4; ++n) bv[n] = bias[colbase + n * 16 + fr];
        int kind;
        bf16* dst; int ldd, dcol;
        if (colbase < A_W) { const int seg = colbase / 1536; kind = seg; dst = ZA; ldd = A_W; dcol = colbase; }
        else if (colbase < A_W + B_W) { const int cb = colbase - A_W; kind = cb < 1024 ? 0 : (cb < 1152 ? 1 : 2); dst = ZB; ldd = B_W; dcol = cb; }
        else { kind = 3; dst = Gt; ldd = G_W; dcol = colbase - A_W - B_W; }
#pragma unroll
        for (int m = 0; m < 4; ++m)
#pragma unroll
            for (int j = 0; j < 4; ++j) {
                const int row = pm * 256 + wr * 64 + m * 16 + fq * 4 + j;
                float v[4];
#pragma unroll
                for (int n = 0; n < 4; ++n) v[n] = acc[m][n][j] + bv[n];
                if (kind < 2) {
                    const int pos = row & (SEQ - 1);
#pragma unroll
                    for (int n = 0; n < 2; ++n) { const float2 cs = rope[pos * 32 + n * 16 + fr]; const float t1 = v[n], t2 = v[n + 2];
                        v[n] = t1 * cs.x - t2 * cs.y; v[n + 2] = t2 * cs.x + t1 * cs.y; }
                    if (kind == 0) {
#pragma unroll
                        for (int n = 0; n < 4; ++n) v[n] *= QSCALE;
                    }
                } else if (kind == 3) {
#pragma unroll
                    for (int n = 0; n < 4; ++n) v[n] = 1.0f / (1.0f + __expf(-v[n]));
                }
                bf16* drow = dst + (size_t)row * ldd + dcol + fr;
#pragma unroll
                for (int n = 0; n < 4; ++n) drow[n * 16] = (bf16)f2bf(v[n]);
            }
    }
}

__device__ __forceinline__ float dot64(const LAS float* qs, const bf16* kp) {
    float s = 0.f;
#pragma unroll
    for (int c = 0; c < 8; ++c) {
        const v4u kk = *(const GAS v4u*)(kp + 8 * c);
        const f32x4 q0 = *(const LAS f32x4*)(qs + 8 * c), q1 = *(const LAS f32x4*)(qs + 8 * c + 4);
        s += q0.x * bflo(kk.x) + q0.y * bfhi(kk.x) + q0.z * bflo(kk.y) + q0.w * bfhi(kk.y);
        s += q1.x * bflo(kk.z) + q1.y * bfhi(kk.z) + q1.z * bflo(kk.w) + q1.w * bfhi(kk.w);
    }
    return s;
}
__device__ __forceinline__ void p2_attn_naive(Frame& F, int ch) {
    unsigned char* ws = F.ws;
    const bf16* ZA = (const bf16*)(ws + WS_ZA); const bf16* ZB = (const bf16*)(ws + WS_ZB);
    bf16* Y = (bf16*)(ws + WS_Y) + (size_t)ch * TC * Y_W;
    LAS float* qs = (LAS float*)(F.lds + F.wave * 1024);
    const int lane = F.lane;
    const int gw = F.vcu * NWAVES + F.wave, NGW = F.G * NWAVES;
    const float NEG = -INFINITY;
    for (int item = gw; item < TC * 24; item += NGW) {
        if (item < TC * 8) {
            const int t = item >> 3, h = item & 7, pos = t & (SEQ - 1), rb = t - pos;
            float sc[3][3];
#pragma unroll
            for (int g = 0; g < 3; ++g) qs[g * 64 + lane] = bf2f(ZA[(size_t)t * A_W + g * 512 + h * 64 + lane]);
            LDS_WAIT(); asm volatile("" ::: "memory");
#pragma unroll
            for (int g = 0; g < 3; ++g) {
                const int dil = g == 0 ? 1 : (g == 1 ? 4 : 16);
#pragma unroll
                for (int i = 0; i < 3; ++i) {
                    const int m = lane + 64 * i; const int kp = pos - m * dil;
                    float s = NEG;
                    if (m <= 128 && kp >= 0) s = dot64(qs + g * 64, ZA + (size_t)(rb + kp) * A_W + 1536 + g * 512 + h * 64);
                    sc[g][i] = s;
                }
            }
            float mx = NEG;
#pragma unroll
            for (int g = 0; g < 3; ++g)
#pragma unroll
                for (int i = 0; i < 3; ++i) mx = fmaxf(mx, sc[g][i]);
            mx = wave_max(mx);
            float ls = 0.f;
#pragma unroll
            for (int g = 0; g < 3; ++g)
#pragma unroll
                for (int i = 0; i < 3; ++i) { sc[g][i] = __builtin_amdgcn_exp2f(sc[g][i] - mx); ls += sc[g][i]; }
            ls = wave_sum(ls);
            float o = 0.f;
#pragma unroll
            for (int g = 0; g < 3; ++g) {
                const int dil = g == 0 ? 1 : (g == 1 ? 4 : 16);
                const bf16* vb = ZA + (size_t)rb * A_W + 3072 + g * 512 + h * 64 + lane;
#pragma unroll
                for (int i = 0; i < 3; ++i) {
                    const int mend = i < 2 ? 64 : 1;
                    for (int ml = 0; ml < mend; ++ml) {
                        const int kp = pos - (64 * i + ml) * dil;
                        if (kp < 0) break;
                        const float pv = __shfl(sc[g][i], ml);
                        o += pv * bf2f(vb[(size_t)kp * A_W]);
                    }
                }
            }
            Y[(size_t)t * Y_W + h * 64 + lane] = (bf16)f2bf(o / ls);
            LDS_WAIT(); asm volatile("" ::: "memory");
        } else {
            const int it = item - TC * 8; const int t = it >> 4, qh = it & 15, kvh = qh >> 3, pos = t & (SEQ - 1), rb = t - pos;
            qs[lane] = bf2f(ZB[(size_t)t * B_W + qh * 64 + lane]);
            LDS_WAIT(); asm volatile("" ::: "memory");
            float sc[2];
#pragma unroll
            for (int i = 0; i < 2; ++i) {
                const int m = lane + 64 * i; const int kp = pos - m;
                float s = NEG;
                if (kp >= 0) s = dot64(qs, ZB + (size_t)(rb + kp) * B_W + 1024 + kvh * 64);
                sc[i] = s;
            }
            const float sink2 = F.in[I_SINK][qh] * LOG2E;
            float mx = fmaxf(wave_max(fmaxf(sc[0], sc[1])), sink2);
            float ls = 0.f;
#pragma unroll
            for (int i = 0; i < 2; ++i) { sc[i] = __builtin_amdgcn_exp2f(sc[i] - mx); ls += sc[i]; }
            ls = wave_sum(ls) + __builtin_amdgcn_exp2f(sink2 - mx);
            float o = 0.f;
            const bf16* vb = ZB + (size_t)rb * B_W + 1152 + kvh * 64 + lane;
#pragma unroll
            for (int i = 0; i < 2; ++i) {
                for (int ml = 0; ml < 64; ++ml) {
                    const int kp = pos - (64 * i + ml);
                    if (kp < 0) break;
                    const float pv = __shfl(sc[i], ml);
                    o += pv * bf2f(vb[(size_t)kp * B_W]);
                }
            }
            Y[(size_t)t * Y_W + 512 + qh * 64 + lane] = (bf16)f2bf(o / ls);
            LDS_WAIT(); asm volatile("" ::: "memory");
        }
    }
}

__device__ __forceinline__ void p3_merge(Frame& F) {
    unsigned char* ws = F.ws;
    const bf16* Y = (const bf16*)(ws + WS_Y); const bf16* Wab = (const bf16*)(ws + WS_WAB); const bf16* Gt = (const bf16*)(ws + WS_G);
    bf16* MG = (bf16*)(ws + WS_MG);
    const int wid = F.wave, lane = F.lane, wr = wid >> 1, wc = wid & 1, fr = lane & 15, fq = lane >> 4;
    constexpr int NCT = D / 128, NU = (T / 256) * NCT;
    for (int u = F.vcu; u < NU; u += F.G) {
        const int pm = u / NCT, pn = u % NCT;
        const int ar = F.tid >> 2, ac = (F.tid & 3) * 8;
        const bf16* a0 = Y + (size_t)(pm * 256 + ar) * Y_W + ac; const bf16* a1 = a0 + (size_t)128 * Y_W;
        const bf16* b0 = Wab + (size_t)(pn * 128 + ar) * Y_W + ac;
        f32x4 acc[4][4]; zero_acc(acc);
        sg_kloop(F.lds, acc, a0, a1, b0, 512 / 32, wid, lane);
        const int col0 = pn * 128 + wc * 64 + fr;
#pragma unroll
        for (int m = 0; m < 4; ++m)
#pragma unroll
            for (int j = 0; j < 4; ++j) { const int row = pm * 256 + wr * 64 + m * 16 + fq * 4 + j; const bf16* gr = Gt + (size_t)row * G_W + col0; bf16* orow = MG + (size_t)row * D + col0;
#pragma unroll
                for (int n = 0; n < 4; ++n) orow[n * 16] = (bf16)f2bf(acc[m][n][j] * bf2f(gr[n * 16]));
                asm volatile("" ::: "memory"); }
        zero_acc(acc);
        sg_kloop(F.lds, acc, a0 + 512, a1 + 512, b0 + 512, 1024 / 32, wid, lane);
#pragma unroll
        for (int m = 0; m < 4; ++m)
#pragma unroll
            for (int j = 0; j < 4; ++j) { const int row = pm * 256 + wr * 64 + m * 16 + fq * 4 + j; const bf16* gr = Gt + (size_t)row * G_W + 1024 + col0; bf16* orow = MG + (size_t)row * D + col0;
#pragma unroll
                for (int n = 0; n < 4; ++n) orow[n * 16] = (bf16)f2bf(bf2f(orow[n * 16]) + acc[m][n][j] * bf2f(gr[n * 16]));
                asm volatile("" ::: "memory"); }
    }
}

__device__ __forceinline__ void p4_outproj(Frame& F) {
    unsigned char* ws = F.ws;
    const bf16* MG = (const bf16*)(ws + WS_MG); const bf16* Wo = (const bf16*)(ws + WS_WO);
    const float* X = F.in[I_X]; float* X1 = F.out;
    const int wid = F.wave, lane = F.lane, wr = wid >> 1, wc = wid & 1, fr = lane & 15, fq = lane >> 4;
    constexpr int NCT = D / 128, NU = (T / 256) * NCT;
    for (int u = F.vcu; u < NU; u += F.G) {
        const int pm = u / NCT, pn = u % NCT;
        const int ar = F.tid >> 2, ac = (F.tid & 3) * 8;
        const bf16* a0 = MG + (size_t)(pm * 256 + ar) * D + ac; const bf16* a1 = a0 + (size_t)128 * D;
        const bf16* b0 = Wo + (size_t)(pn * 128 + ar) * D + ac;
        f32x4 acc[4][4]; zero_acc(acc);
        sg_kloop(F.lds, acc, a0, a1, b0, D / 32, wid, lane);
        const int col0 = pn * 128 + wc * 64 + fr;
#pragma unroll
        for (int m = 0; m < 4; ++m)
#pragma unroll
            for (int j = 0; j < 4; ++j) { const size_t off = (size_t)(pm * 256 + wr * 64 + m * 16 + fq * 4 + j) * D + col0;
#pragma unroll
                for (int n = 0; n < 4; ++n) X1[off + n * 16] = X[off + n * 16] + acc[m][n][j]; }
    }
}

__device__ __forceinline__ void p5_route(Frame& F) {
    unsigned char* ws = F.ws;
    const float* X1 = F.out; bf16* H2 = (bf16*)(ws + WS_HN);
    const float* WRT = (const float*)(ws + WS_WRT);
    unsigned* cnt = (unsigned*)(ws + WS_CTL) + CW_CNT;
    int* tokof = (int*)(ws + WS_TOKOF); float* wtof = (float*)(ws + WS_WTOF); int4* tpos = (int4*)(ws + WS_TPOS);
    const int lane = F.lane;
    const int gw = F.vcu * NWAVES + F.wave, NGW = F.G * NWAVES;
    const GAS f32x4* gr = (const GAS f32x4*)F.in[I_GFFN] + lane;
    for (int row = gw; row < T; row += NGW) {
        const GAS f32x4* xr = (const GAS f32x4*)(X1 + (size_t)row * D) + lane;
        f32x4 v[4]; float s = 0.f;
#pragma unroll
        for (int j = 0; j < 4; ++j) { v[j] = xr[64 * j]; s += (v[j].x * v[j].x + v[j].y * v[j].y) + (v[j].z * v[j].z + v[j].w * v[j].w); }
        const float rstd = 1.0f / sqrtf(wave_sum(s) * (1.f / D) + RMS_EPS);
        GAS v2u* o8 = (GAS v2u*)(H2 + (size_t)row * D) + lane;
#pragma unroll
        for (int j = 0; j < 4; ++j) { const f32x4 gg = gr[64 * j]; v[j].x *= rstd * gg.x; v[j].y *= rstd * gg.y; v[j].z *= rstd * gg.z; v[j].w *= rstd * gg.w;
            v2u w; w.x = pk2(v[j].x, v[j].y); w.y = pk2(v[j].z, v[j].w); o8[64 * j] = w; }
        float lg[36];
#pragma unroll
        for (int o = 0; o < 36; ++o) {
            const GAS f32x4* wr_ = (const GAS f32x4*)(WRT + o * 1024) + lane; float p = 0.f;
#pragma unroll
            for (int j = 0; j < 4; ++j) { const f32x4 w = wr_[64 * j]; p += (v[j].x * w.x + v[j].y * w.y) + (v[j].z * w.z + v[j].w * w.w); }
            lg[o] = wave_sum(p) + (o < 4 ? F.in[I_BRG][o] : F.in[I_BRE][o - 4]);
            asm volatile("" ::: "memory");
        }
        int gsel = 0; float gmax = lg[0];
#pragma unroll
        for (int i = 1; i < 4; ++i) if (lg[i] > gmax) { gmax = lg[i]; gsel = i; }
        float gden = 0.f;
#pragma unroll
        for (int i = 0; i < 4; ++i) gden += __expf(lg[i] - gmax);
        const float pg = 1.0f / gden;
        float le[8];
#pragma unroll
        for (int j = 0; j < 8; ++j) { le[j] = lg[4 + j];
#pragma unroll
            for (int gi = 1; gi < 4; ++gi) le[j] = (gsel == gi) ? lg[4 + gi * 8 + j] : le[j]; }
        int i1 = 0; float m1 = le[0];
#pragma unroll
        for (int j = 1; j < 8; ++j) if (le[j] > m1) { m1 = le[j]; i1 = j; }
        int i2 = -1; float m2 = -INFINITY;
#pragma unroll
        for (int j = 0; j < 8; ++j) if (j != i1 && le[j] > m2) { m2 = le[j]; i2 = j; }
        const float e2 = __expf(m2 - m1);
        const float w1 = pg / (1.0f + e2), w2 = pg * e2 / (1.0f + e2);
        if (lane == 0) {
            const int e0 = gsel * 8 + i1, e1 = gsel * 8 + i2;
            const int p0 = (int)atomicAdd(&cnt[e0], 1u), p1 = (int)atomicAdd(&cnt[e1], 1u);
            tokof[(size_t)e0 * T + p0] = row; wtof[(size_t)e0 * T + p0] = w1;
            tokof[(size_t)e1 * T + p1] = row; wtof[(size_t)e1 * T + p1] = w2;
            tpos[row] = make_int4(e0, p0, e1, p1);
        }
    }
}

__device__ __forceinline__ void expert_tiles(Frame& F, LAS int* tb, LAS int* cn) {
    if (F.tid == 0) {
        const unsigned* cnt = (const unsigned*)(F.ws + WS_CTL) + CW_CNT;
        int acc = 0;
        for (int e = 0; e < NE; ++e) { const int c = (int)__hip_atomic_load(cnt + e, __ATOMIC_RELAXED, __HIP_MEMORY_SCOPE_AGENT); cn[e] = c; tb[e] = acc; acc += (c + 255) >> 8; }
        tb[NE] = acc;
    }
    __syncthreads();
}

__device__ __forceinline__ void p6a_gateup(Frame& F) {
    unsigned char* ws = F.ws;
    LAS int* tb = (LAS int*)(F.lds + LDS_MISC + 1024); LAS int* cn = tb + 64;
    expert_tiles(F, tb, cn);
    const bf16* H2 = (const bf16*)(ws + WS_HN); const bf16* Wgu = (const bf16*)(ws + WS_WGU); bf16* HACT = (bf16*)(ws + WS_HACT);
    const int* tokof = (const int*)(ws + WS_TOKOF); const float* wtof = (const float*)(ws + WS_WTOF);
    const int wid = F.wave, lane = F.lane, wr = wid >> 1, wc = wid & 1, fr = lane & 15, fq = lane >> 4;
    const int NU = tb[NE] * 4;
    for (int u = F.vcu; u < NU; u += F.G) {
        const int rt = u >> 2, ct = u & 3;
        int e = 0;
        for (int i = 1; i < NE; ++i) if (tb[i] <= rt) e = i;
        const int ce = cn[e], p0 = (rt - tb[e]) * 256;
        const int ar = F.tid >> 2, ac = (F.tid & 3) * 8;
        const int pa0 = p0 + ar, pa1 = p0 + ar + 128;
        const int tk0 = tokof[(size_t)e * T + (pa0 < ce ? pa0 : 0)], tk1 = tokof[(size_t)e * T + (pa1 < ce ? pa1 : 0)];
        const bf16* a0 = H2 + (size_t)tk0 * D + ac; const bf16* a1 = H2 + (size_t)tk1 * D + ac;
        const bf16* b0 = Wgu + ((size_t)e * 512 + ct * 128 + ar) * D + ac;
        f32x4 acc[4][4]; zero_acc(acc);
        sg_kloop(F.lds, acc, a0, a1, b0, D / 32, wid, lane);
#pragma unroll
        for (int m = 0; m < 4; ++m)
#pragma unroll
            for (int j = 0; j < 4; ++j) {
                const int r = wr * 64 + m * 16 + fq * 4 + j, p = p0 + r;
                const float w = p < ce ? wtof[(size_t)e * T + p] : 0.f;
                bf16* orow = HACT + (size_t)(rt * 256 + r) * DE + ct * 64 + wc * 32 + fr;
#pragma unroll
                for (int n = 0; n < 2; ++n) { const float g = acc[m][n][j], uu = acc[m][n + 2][j]; const float hv = g / (1.0f + __expf(-g)) * uu * w; orow[n * 16] = (bf16)f2bf(hv); }
            }
    }
}
__device__ __forceinline__ void p6b_down(Frame& F) {
    unsigned char* ws = F.ws;
    LAS int* tb = (LAS int*)(F.lds + LDS_MISC + 1024); LAS int* cn = tb + 64;
    expert_tiles(F, tb, cn);
    const bf16* HACT = (const bf16*)(ws + WS_HACT); const bf16* Wd = (const bf16*)(ws + WS_WD); bf16* YS = (bf16*)(ws + WS_YS);
    const int wid = F.wave, lane = F.lane, wr = wid >> 1, wc = wid & 1, fr = lane & 15, fq = lane >> 4;
    const int NU = tb[NE] * 8;
    for (int u = F.vcu; u < NU; u += F.G) {
        const int rt = u >> 3, ct = u & 7;
        int e = 0;
        for (int i = 1; i < NE; ++i) if (tb[i] <= rt) e = i;
        const int ar = F.tid >> 2, ac = (F.tid & 3) * 8;
        const bf16* a0 = HACT + (size_t)(rt * 256 + ar) * DE + ac; const bf16* a1 = a0 + (size_t)128 * DE;
        const bf16* b0 = Wd + ((size_t)e * 1024 + ct * 128 + ar) * DE + ac;
        f32x4 acc[4][4]; zero_acc(acc);
        sg_kloop(F.lds, acc, a0, a1, b0, DE / 32, wid, lane);
#pragma unroll
        for (int m = 0; m < 4; ++m)
#pragma unroll
            for (int j = 0; j < 4; ++j) { bf16* orow = YS + (size_t)(rt * 256 + wr * 64 + m * 16 + fq * 4 + j) * D + ct * 128 + wc * 64 + fr;
#pragma unroll
                for (int n = 0; n < 4; ++n) orow[n * 16] = (bf16)f2bf(acc[m][n][j]); }
    }
}
__device__ __forceinline__ void p7_final(Frame& F) {
    unsigned char* ws = F.ws;
    LAS int* tb = (LAS int*)(F.lds + LDS_MISC + 1024); LAS int* cn = tb + 64;
    expert_tiles(F, tb, cn);
    const bf16* YS = (const bf16*)(ws + WS_YS); const int4* tpos = (const int4*)(ws + WS_TPOS);
    float* X1 = F.out;
    const int lane = F.lane;
    const int gw = F.vcu * NWAVES + F.wave, NGW = F.G * NWAVES;
    const GAS f32x4* gr = (const GAS f32x4*)F.in[I_GFIN] + lane;
    for (int row = gw; row < T; row += NGW) {
        const int4 tp = tpos[row];
        const size_t s0 = (size_t)tb[tp.x] * 256 + tp.y, s1 = (size_t)tb[tp.z] * 256 + tp.w;
        GAS f32x4* xr = (GAS f32x4*)(X1 + (size_t)row * D) + lane;
        const GAS v2u* y0 = (const GAS v2u*)(YS + s0 * D) + lane; const GAS v2u* y1 = (const GAS v2u*)(YS + s1 * D) + lane;
        f32x4 v[4]; float s = 0.f;
#pragma unroll
        for (int j = 0; j < 4; ++j) { v[j] = xr[64 * j]; const v2u a = y0[64 * j], b = y1[64 * j];
            v[j].x += bflo(a.x) + bflo(b.x); v[j].y += bfhi(a.x) + bfhi(b.x); v[j].z += bflo(a.y) + bflo(b.y); v[j].w += bfhi(a.y) + bfhi(b.y);
            s += (v[j].x * v[j].x + v[j].y * v[j].y) + (v[j].z * v[j].z + v[j].w * v[j].w); }
        const float rstd = 1.0f / sqrtf(wave_sum(s) * (1.f / D) + RMS_EPS);
#pragma unroll
        for (int j = 0; j < 4; ++j) { const f32x4 gg = gr[64 * j]; f32x4 o; o.x = v[j].x * rstd * gg.x; o.y = v[j].y * rstd * gg.y; o.z = v[j].z * rstd * gg.z; o.w = v[j].w * rstd * gg.w; xr[64 * j] = o; }
    }
}

constexpr int NPHASE = 1 + 2 * NCH + 6;
__global__ void __launch_bounds__(NTHR, 2) fwd_kernel(KArgs args) {
    extern __shared__ __attribute__((aligned(16))) unsigned char lds_raw[];
    Frame F;
    F.lds = (LAS unsigned char*)lds_raw;
    F.tid = threadIdx.x; F.lane = F.tid & 63; F.wave = __builtin_amdgcn_readfirstlane(F.tid >> 6);
    F.G = gridDim.x; { const int bx = blockIdx.x; F.vcu = (F.G % 8 == 0) ? (bx % 8) * (F.G / 8) + bx / 8 : bx; }
#pragma unroll
    for (int i = 0; i < 17; ++i) F.in[i] = args.in[i];
    F.out = args.out; F.ws = args.ws;
    volatile LAS unsigned* MISC = (volatile LAS unsigned*)(F.lds + LDS_MISC);
    if (F.tid < 64) MISC[F.tid] = 0u;
    __syncthreads();
    XcdBarrier bar = xcd_barrier_post((unsigned*)(F.ws + WS_CTL) + CW_BAR + args.li * XCD_BAR_WORDS, MISC + 8);
#define IN(k) (args.ph_lo <= (k) && (k) < args.ph_hi)
#define SEAM(k) do { if (IN(k) && IN((k) + 1)) xcd_barrier(bar); } while (0)
    if (IN(0)) p0_prologue(F);
    SEAM(0);
#pragma unroll 1
    for (int ch = 0; ch < NCH; ++ch) {
        if (IN(1 + 2 * ch)) p1_inproj(F, ch);
        SEAM(1 + 2 * ch);
        if (IN(2 + 2 * ch)) p2_attn_naive(F, ch);
        SEAM(2 + 2 * ch);
    }
    if (IN(2 * NCH + 1)) p3_merge(F);
    SEAM(2 * NCH + 1);
    if (IN(2 * NCH + 2)) p4_outproj(F);
    SEAM(2 * NCH + 2);
    if (IN(2 * NCH + 3)) p5_route(F);
    SEAM(2 * NCH + 3);
    if (IN(2 * NCH + 4)) p6a_gateup(F);
    SEAM(2 * NCH + 4);
    if (IN(2 * NCH + 5)) p6b_down(F);
    SEAM(2 * NCH + 5);
    if (IN(2 * NCH + 6)) p7_final(F);
#undef IN
#undef SEAM
}

#ifndef N_LAUNCHES
#define N_LAUNCHES NPHASE
#endif
extern "C" void kernel_launch(void* const* d_in, const int* in_sizes, int n_in, void* d_out, int out_size, void* d_ws, size_t ws_size, hipStream_t stream) {
    static int grid = 0;
    if (grid == 0) {
        if (n_in != 17 || in_sizes[0] != T * D || out_size != T * D || ws_size < WS_END) { fprintf(stderr, "kernel_launch: unexpected shapes / workspace (%d inputs, ws %zu)\n", n_in, ws_size); grid = -1; return; }
        int dev = 0, cus = 0;
        if (hipGetDevice(&dev) != hipSuccess || hipDeviceGetAttribute(&cus, hipDeviceAttributeMultiprocessorCount, dev) != hipSuccess) { grid = -1; return; }
        if (hipFuncSetAttribute((const void*)fwd_kernel, hipFuncAttributeMaxDynamicSharedMemorySize, LDS_BYTES) != hipSuccess) { fprintf(stderr, "kernel_launch: hipFuncSetAttribute failed\n"); grid = -1; return; }
        int per_cu = 0;
        if (hipOccupancyMaxActiveBlocksPerMultiprocessor(&per_cu, (const void*)fwd_kernel, NTHR, LDS_BYTES) != hipSuccess || per_cu < 1) fprintf(stderr, "kernel_launch: occupancy query says %d\n", per_cu);
        (void)hipGetLastError();
        grid = cus;
    }
    if (grid < 0) return;
    (void)hipMemsetAsync((char*)d_ws + WS_CTL, 0, CTL_BYTES, stream);
    KArgs a{};
    for (int i = 0; i < 17; ++i) a.in[i] = (const float*)d_in[i];
    a.out = (float*)d_out; a.ws = (unsigned char*)d_ws;
    for (int li = 0; li < N_LAUNCHES; ++li) {
        a.ph_lo = (int)((long)NPHASE * li / N_LAUNCHES); a.ph_hi = (int)((long)NPHASE * (li + 1) / N_LAUNCHES); a.li = li;
        hipLaunchKernelGGL(fwd_kernel, dim3(grid), dim3(NTHR), LDS_BYTES, stream, a);
    }
}
```

```cpp
#include <hip/hip_runtime.h>
#include <cstdint>
#include <cstdio>

#define GAS __attribute__((address_space(1)))
#define LAS __attribute__((address_space(3)))
typedef unsigned short bf16;
typedef short bf16x8 __attribute__((ext_vector_type(8)));
typedef float f32x4 __attribute__((ext_vector_type(4)));
typedef unsigned v4u __attribute__((ext_vector_type(4)));
typedef unsigned v2u __attribute__((ext_vector_type(2)));
typedef GAS unsigned gu32;

constexpr int T = 32768, D = 1024, SEQ = 4096, NIN = 7936;
constexpr int A_W = 4608, B_W = 1280, G_W = 2048, Y_W = 1536;
constexpr int NE = 32, DE = 256;
constexpr int NCH = 4, TC = T / NCH;
constexpr float QSCALE = 0.125f * 1.4426950408889634f;
constexpr float LOG2E = 1.4426950408889634f;
constexpr float RMS_EPS = 1e-6f;
constexpr int NWAVES = 8, NTHR = 512;

constexpr size_t MiB = 1u << 20;
constexpr size_t WS_CTL = 0, CTL_BYTES = 1 * MiB;
constexpr size_t WS_ROPE = 1 * MiB;
constexpr size_t WS_WRT = 2 * MiB;
constexpr size_t WS_TOKOF = 3 * MiB;
constexpr size_t WS_WTOF = 7 * MiB;
constexpr size_t WS_TPOS = 11 * MiB;
constexpr size_t WS_WIN = 12 * MiB;
constexpr size_t WS_WAB = 28 * MiB;
constexpr size_t WS_WO = 31 * MiB;
constexpr size_t WS_WGU = 33 * MiB;
constexpr size_t WS_WD = 65 * MiB;
constexpr size_t WS_HN = 82 * MiB;
constexpr size_t WS_G = 146 * MiB;
constexpr size_t WS_Y = 274 * MiB;
constexpr size_t WS_ZA = 370 * MiB;
constexpr size_t WS_ZB = 442 * MiB;
constexpr size_t WS_MG = 370 * MiB;
constexpr size_t WS_HACT = 146 * MiB;
constexpr size_t WS_YS = 182 * MiB;
constexpr size_t WS_END = 462 * MiB;
constexpr int MAXSLOT = 2 * T + NE * 256;
static_assert(WS_ZA + (size_t)TC * A_W * 2 <= WS_ZB && WS_ZB + (size_t)TC * B_W * 2 <= WS_END, "ws map");
static_assert(WS_MG + (size_t)T * D * 2 <= WS_END && WS_HACT + (size_t)MAXSLOT * DE * 2 <= WS_YS && WS_YS + (size_t)MAXSLOT * D * 2 <= WS_ZA, "ws map");
constexpr int CW_CNT = 1024;
constexpr int CW_BAR = 4096;
constexpr int LDS_BYTES = 147456;
constexpr int LDS_MISC = 131072;

__device__ __forceinline__ unsigned f2bf(float f) { unsigned u = __builtin_bit_cast(unsigned, f); return (u + 0x7fffu + ((u >> 16) & 1u)) >> 16; }
__device__ __forceinline__ unsigned pk2(float lo, float hi) { return f2bf(lo) | (f2bf(hi) << 16); }
__device__ __forceinline__ float bf2f(unsigned b) { return __builtin_bit_cast(float, b << 16); }
__device__ __forceinline__ float bflo(unsigned u) { return __builtin_bit_cast(float, u << 16); }
__device__ __forceinline__ float bfhi(unsigned u) { return __builtin_bit_cast(float, u & 0xffff0000u); }
__device__ __forceinline__ float wave_sum(float v) {
#pragma unroll
    for (int o = 1; o < 64; o <<= 1) v += __shfl_xor(v, o);
    return v;
}
__device__ __forceinline__ float wave_max(float v) {
#pragma unroll
    for (int o = 1; o < 64; o <<= 1) v = fmaxf(v, __shfl_xor(v, o));
    return v;
}
#define LDS_WAIT() asm volatile("s_waitcnt lgkmcnt(0)" ::: "memory")
#define VM_WAIT() asm volatile("s_waitcnt vmcnt(0)" ::: "memory")

#define XB_TMO      128
#define XB_XCNT(j)  (256  + 64 * (j))
#define XB_XSUB(j)  (1280 + 64 * (j))
#define XB_XGEN(j)  (2304 + 64 * (j))
#define XB_TOP      3328
#define XB_TOPGEN   3392
#define XCD_BAR_WORDS 3456
#define XB_SPIN_CAP (1u << 18)
__device__ __forceinline__ unsigned xb_ld(unsigned* p)              { return __hip_atomic_load(p, __ATOMIC_RELAXED, __HIP_MEMORY_SCOPE_AGENT); }
__device__ __forceinline__ unsigned xb_add(unsigned* p, unsigned v) { return __hip_atomic_fetch_add(p, v, __ATOMIC_RELAXED, __HIP_MEMORY_SCOPE_AGENT); }
__device__ __forceinline__ unsigned xb_xcc_id() { return (unsigned)__builtin_amdgcn_s_getreg((3 << 11) | 20) & 0xFu; }
#define XB_SPIN(cond, bar) do { unsigned _sp = 0; while (cond) { __builtin_amdgcn_s_sleep(1); \
    if ((++_sp & 255u) == 0u) { if (xb_ld(&(bar)[XB_TMO])) break; if (_sp > XB_SPIN_CAP) { atomicAdd(&(bar)[XB_TMO], 1u); break; } } } } while (0)
struct XcdBarrier { unsigned* bar; unsigned x; volatile LAS unsigned* st; };
__device__ __forceinline__ XcdBarrier xcd_barrier_post(unsigned* bar, volatile LAS unsigned* st) {
    XcdBarrier b; b.bar = bar; b.x = xb_xcc_id(); b.st = st;
    if (threadIdx.x == 0) (void)xb_add(&bar[XB_XCNT(b.x)], 1u);
    return b;
}
__device__ __forceinline__ void xcd_barrier_complete(unsigned* bar, unsigned x, unsigned& nloc, unsigned& nx) {
    const unsigned G = gridDim.x * gridDim.y * gridDim.z;
    unsigned sum, cnt, mine, sp = 0u;
    for (;;) {
        sum = 0u; cnt = 0u; mine = 0u;
#pragma unroll
        for (unsigned j = 0; j < 16; ++j) { const unsigned c = xb_ld(&bar[XB_XCNT(j)]); sum += c; cnt += (c > 0u) ? 1u : 0u; mine = (j == x) ? c : mine; }
        if (sum == G) break;
        __builtin_amdgcn_s_sleep(1);
        if ((++sp & 255u) == 0u) { if (xb_ld(&bar[XB_TMO])) break; if (sp > XB_SPIN_CAP) { atomicAdd(&bar[XB_TMO], 1u); break; } }
    }
    nloc = mine > 0u ? mine : 1u; nx = cnt > 0u ? cnt : 1u;
}
__device__ __forceinline__ void xcd_barrier(const XcdBarrier& b) {
    asm volatile("s_waitcnt vmcnt(0)" ::: "memory");
    __syncthreads();
    if (threadIdx.x == 0) {
        unsigned* bar = b.bar;
        __builtin_amdgcn_s_waitcnt(0);
        unsigned nloc = b.st[0], nx = b.st[1];
        if (nloc == 0u) { xcd_barrier_complete(bar, b.x, nloc, nx); b.st[0] = nloc; b.st[1] = nx; }
        const unsigned old = xb_add(&bar[XB_XSUB(b.x)], 1u);
        const unsigned gen = old / nloc;
        if (old + 1u == (gen + 1u) * nloc) {
            __builtin_amdgcn_fence(__ATOMIC_RELEASE, "agent");
            asm volatile("s_waitcnt vmcnt(0)" ::: "memory");
            const unsigned og = xb_add(&bar[XB_TOP], 1u);
            const unsigned tg = og / nx;
            if (og + 1u == (tg + 1u) * nx) xb_add(&bar[XB_TOPGEN], 1u);
            else XB_SPIN(xb_ld(&bar[XB_TOPGEN]) == tg, bar);
            __builtin_amdgcn_fence(__ATOMIC_ACQUIRE, "agent");
            xb_add(&bar[XB_XGEN(b.x)], 1u);
            asm volatile("s_waitcnt vmcnt(0)" ::: "memory");
        } else {
            XB_SPIN(xb_ld(&bar[XB_XGEN(b.x)]) == gen, bar);
            __builtin_amdgcn_fence(__ATOMIC_ACQUIRE, "agent");
            asm volatile("s_waitcnt vmcnt(0)" ::: "memory");
        }
    }
    __syncthreads();
}

struct KArgs { const float* in[17]; float* out; unsigned char* ws; int ph_lo, ph_hi, li, pad; };
struct Frame {
    LAS unsigned char* lds;
    int tid, lane, wave, vcu, G;
    const float* in[17]; float* out; unsigned char* ws;
};
enum { I_X = 0, I_WIN, I_BIN, I_SINK, I_WPA, I_WPB, I_WOUT, I_GMIX, I_GFFN, I_WRG, I_BRG, I_WRE, I_BRE, I_WEG, I_WEU, I_WED, I_GFIN };

__device__ __forceinline__ void p0_tr_item(const float* W, int N, bf16* WT, int ldo, int rowbase, int koff, int k0, int n0, LAS float* scr, int lane) {
#pragma unroll 8
    for (int i = 0; i < 32; ++i) { const int kk = 2 * i + (lane >> 5); scr[kk * 33 + (lane & 31)] = W[(size_t)(k0 + kk) * N + n0 + (lane & 31)]; }
    LDS_WAIT(); asm volatile("" ::: "memory");
    const int c = lane & 7;
#pragma unroll
    for (int j = 0; j < 4; ++j) { const int n = (lane >> 3) + 8 * j; const LAS float* s = scr + (8 * c) * 33 + n;
        v4u o; o.x = pk2(s[0 * 33], s[1 * 33]); o.y = pk2(s[2 * 33], s[3 * 33]); o.z = pk2(s[4 * 33], s[5 * 33]); o.w = pk2(s[6 * 33], s[7 * 33]);
        *(GAS v4u*)(WT + (size_t)(rowbase + n) * ldo + koff + k0 + 8 * c) = o; }
    LDS_WAIT(); asm volatile("" ::: "memory");
}
__device__ __forceinline__ void rms_row_to_bf16(const float* xrow, const float* g, bf16* orow, int lane) {
    const GAS f32x4* xr = (const GAS f32x4*)xrow + lane; const GAS f32x4* gr = (const GAS f32x4*)g + lane;
    f32x4 v[4]; float s = 0.f;
#pragma unroll
    for (int j = 0; j < 4; ++j) { v[j] = xr[64 * j]; s += (v[j].x * v[j].x + v[j].y * v[j].y) + (v[j].z * v[j].z + v[j].w * v[j].w); }
    const float rstd = 1.0f / sqrtf(wave_sum(s) * (1.f / D) + RMS_EPS);
    GAS v2u* o8 = (GAS v2u*)orow + lane;
#pragma unroll
    for (int j = 0; j < 4; ++j) { const f32x4 gg = gr[64 * j]; v2u w; w.x = pk2(v[j].x * rstd * gg.x, v[j].y * rstd * gg.y); w.y = pk2(v[j].z * rstd * gg.z, v[j].w * rstd * gg.w); o8[64 * j] = w; }
}
__device__ __forceinline__ void p0_prologue(Frame& F) {
    LAS float* scr = (LAS float*)(F.lds + F.wave * 16384);
    const int gw = F.vcu * NWAVES + F.wave, NGW = F.G * NWAVES;
    unsigned char* ws = F.ws;
    constexpr int I_IN = 16 * 248, I_PA = 8 * 32, I_PB = 16 * 32, I_WO = 16 * 32, I_EG = 32 * 16 * 8, I_ED = 32 * 4 * 32;
    constexpr int NITEMS = I_IN + I_PA + I_PB + I_WO + 2 * I_EG + I_ED;
    for (int it = gw; it < NITEMS; it += NGW) {
        int r = it;
        if (r < I_IN) { const int kb = r / 248, nb = r % 248; p0_tr_item(F.in[I_WIN], NIN, (bf16*)(ws + WS_WIN), 1024, 32 * nb, 0, 64 * kb, 32 * nb, scr, F.lane); continue; } r -= I_IN;
        if (r < I_PA) { const int kb = r / 32, nb = r % 32; p0_tr_item(F.in[I_WPA], 1024, (bf16*)(ws + WS_WAB), 1536, 32 * nb, 0, 64 * kb, 32 * nb, scr, F.lane); continue; } r -= I_PA;
        if (r < I_PB) { const int kb = r / 32, nb = r % 32; p0_tr_item(F.in[I_WPB], 1024, (bf16*)(ws + WS_WAB), 1536, 32 * nb, 512, 64 * kb, 32 * nb, scr, F.lane); continue; } r -= I_PB;
        if (r < I_WO) { const int kb = r / 32, nb = r % 32; p0_tr_item(F.in[I_WOUT], 1024, (bf16*)(ws + WS_WO), 1024, 32 * nb, 0, 64 * kb, 32 * nb, scr, F.lane); continue; } r -= I_WO;
        if (r < 2 * I_EG) { const int up = r >= I_EG; if (up) r -= I_EG; const int e = r / 128, q = r % 128, kb = q / 8, nb = q % 8;
            p0_tr_item(F.in[up ? I_WEU : I_WEG] + (size_t)e * 1024 * 256, 256, (bf16*)(ws + WS_WGU) + (size_t)e * 512 * 1024, 1024, 64 * nb + (up ? 32 : 0), 0, 64 * kb, 32 * nb, scr, F.lane); continue; } r -= 2 * I_EG;
        { const int e = r / 128, q = r % 128, kb = q / 32, nb = q % 32;
            p0_tr_item(F.in[I_WED] + (size_t)e * 256 * 1024, 1024, (bf16*)(ws + WS_WD) + (size_t)e * 1024 * 256, 256, 32 * nb, 0, 64 * kb, 32 * nb, scr, F.lane); }
    }
    for (int m = gw; m < T; m += NGW) rms_row_to_bf16(F.in[I_X] + (size_t)m * D, F.in[I_GMIX], (bf16*)(ws + WS_HN) + (size_t)m * D, F.lane);
    const int gt = F.vcu * NTHR + F.tid, NGT = F.G * NTHR;
    for (int i = gt; i < SEQ * 32; i += NGT) {
        const int pos = i >> 5, fi = i & 31;
        const float inv = (float)exp2(-(double)fi * (13.287712379549449 / 32.0));
        const float ang = (float)pos * inv; float s, c; sincosf(ang, &s, &c);
        ((float2*)(ws + WS_ROPE))[i] = make_float2(c, s);
    }
    for (int i = gt; i < 36 * 1024; i += NGT) {
        const int o = i >> 10, k = i & 1023;
        ((float*)(ws + WS_WRT))[i] = o < 4 ? F.in[I_WRG][k * 4 + o] : F.in[I_WRE][k * 32 + (o - 4)];
    }
}

constexpr int SG_BUF = 24576;
__device__ __forceinline__ void sg_kloop(LAS unsigned char* lds, f32x4 (&acc)[4][4], const bf16* a0, const bf16* a1, const bf16* b0, int nt, int wid, int lane) {
    const int wr = wid >> 1, wc = wid & 1, fr = lane & 15, fq = lane >> 4;
    const unsigned wbase = (unsigned)wid * 1024u;
#define SG_STAGE(buf, kt) do { \
        __builtin_amdgcn_global_load_lds((const unsigned*)(a0 + (kt) * 32), (LAS unsigned*)(lds + (buf) * SG_BUF + wbase), 16, 0, 0); \
        __builtin_amdgcn_global_load_lds((const unsigned*)(a1 + (kt) * 32), (LAS unsigned*)(lds + (buf) * SG_BUF + 8192 + wbase), 16, 0, 0); \
        __builtin_amdgcn_global_load_lds((const unsigned*)(b0 + (kt) * 32), (LAS unsigned*)(lds + (buf) * SG_BUF + 16384 + wbase), 16, 0, 0); } while (0)
    SG_STAGE(0, 0);
    VM_WAIT(); __syncthreads();
    int cur = 0;
    for (int t = 0; t < nt; ++t) {
        if (t + 1 < nt) SG_STAGE(cur ^ 1, t + 1);
        const LAS unsigned char* sa = lds + cur * SG_BUF + (wr * 64 + fr) * 64 + fq * 16;
        const LAS unsigned char* sb = lds + cur * SG_BUF + 16384 + (wc * 64 + fr) * 64 + fq * 16;
        bf16x8 At[4], Bt[4];
#pragma unroll
        for (int m = 0; m < 4; ++m) At[m] = *(const LAS bf16x8*)(sa + m * 1024);
#pragma unroll
        for (int n = 0; n < 4; ++n) Bt[n] = *(const LAS bf16x8*)(sb + n * 1024);
#pragma unroll
        for (int m = 0; m < 4; ++m)
#pragma unroll
            for (int n = 0; n < 4; ++n) acc[m][n] = __builtin_amdgcn_mfma_f32_16x16x32_bf16(At[m], Bt[n], acc[m][n], 0, 0, 0);
        VM_WAIT(); __syncthreads();
        cur ^= 1;
    }
#undef SG_STAGE
}
__device__ __forceinline__ void zero_acc(f32x4 (&acc)[4][4]) {
#pragma unroll
    for (int m = 0; m < 4; ++m)
#pragma unroll
        for (int n = 0; n < 4; ++n) acc[m][n] = (f32x4){0.f, 0.f, 0.f, 0.f};
}

__device__ __forceinline__ void p1_inproj(Frame& F, int ch) {
    unsigned char* ws = F.ws;
    const bf16* A = (const bf16*)(ws + WS_HN) + (size_t)ch * TC * D;
    const bf16* Bt = (const bf16*)(ws + WS_WIN);
    bf16* ZA = (bf16*)(ws + WS_ZA); bf16* ZB = (bf16*)(ws + WS_ZB); bf16* Gt = (bf16*)(ws + WS_G) + (size_t)ch * TC * G_W;
    const float2* rope = (const float2*)(ws + WS_ROPE);
    const float* bias = F.in[I_BIN];
    const int wid = F.wave, lane = F.lane, wr = wid >> 1, wc = wid & 1, fr = lane & 15, fq = lane >> 4;
    constexpr int NCT = NIN / 128, NU = (TC / 256) * NCT;
    for (int u = F.vcu; u < NU; u += F.G) {
        const int pm = u / NCT, pn = u % NCT;
        f32x4 acc[4][4]; zero_acc(acc);
        const int ar = F.tid >> 2, ac = (F.tid & 3) * 8;
        const bf16* a0 = A + (size_t)(pm * 256 + ar) * D + ac; const bf16* a1 = a0 + (size_t)128 * D;
        const bf16* b0 = Bt + (size_t)(pn * 128 + ar) * D + ac;
        sg_kloop(F.lds, acc, a0, a1, b0, D / 32, wid, lane);
        const int colbase = pn * 128 + wc * 64;
        float bv[4];
#pragma unroll
        for (int n = 0; n < 4; ++n) bv[n] = bias[colbase + n * 16 + fr];
        int kind;
        bf16* dst; int ldd, dcol;
        if (colbase < A_W) { const int seg = colbase / 1536; kind = seg; dst = ZA; ldd = A_W; dcol = colbase; }
        else if (colbase < A_W + B_W) { const int cb = colbase - A_W; kind = cb < 1024 ? 0 : (cb < 1152 ? 1 : 2); dst = ZB; ldd = B_W; dcol = cb; }
        else { kind = 3; dst = Gt; ldd = G_W; dcol = colbase - A_W - B_W; }
#pragma unroll
        for (int m = 0; m < 4; ++m)
#pragma unroll
            for (int j = 0; j < 4; ++j) {
                const int row = pm * 256 + wr * 64 + m * 16 + fq * 4 + j;
                float v[4];
#pragma unroll
                for (int n = 0; n < 4; ++n) v[n] = acc[m][n][j] + bv[n];
                if (kind < 2) {
                    const int pos = row & (SEQ - 1);
#pragma unroll
                    for (int n = 0; n < 2; ++n) { const float2 cs = rope[pos * 32 + n * 16 + fr]; const float t1 = v[n], t2 = v[n + 2];
                        v[n] = t1 * cs.x - t2 * cs.y; v[n + 2] = t2 * cs.x + t1 * cs.y; }
                    if (kind == 0) {
#pragma unroll
                        for (int n = 0; n < 4; ++n) v[n] *= QSCALE;
                    }
                } else if (kind == 3) {
#pragma unroll
                    for (int n = 0; n < 4; ++n) v[n] = 1.0f / (1.0f + __expf(-v[n]));
                }
                bf16* drow = dst + (size_t)row * ldd + dcol + fr;
#pragma unroll
                for (int n = 0; n < 4; ++n) drow[n * 16] = (bf16)f2bf(v[n]);
            }
    }
}

__device__ __forceinline__ float dot64(const LAS float* qs, const bf16* kp) {
    float s = 0.f;
#pragma unroll
    for (int c = 0; c < 8; ++c) {
        const v4u kk = *(const GAS v4u*)(kp + 8 * c);
        const f32x4 q0 = *(const LAS f32x4*)(qs + 8 * c), q1 = *(const LAS f32x4*)(qs + 8 * c + 4);
        s += q0.x * bflo(kk.x) + q0.y * bfhi(kk.x) + q0.z * bflo(kk.y) + q0.w * bfhi(kk.y);
        s += q1.x * bflo(kk.z) + q1.y * bfhi(kk.z) + q1.z * bflo(kk.w) + q1.w * bfhi(kk.w);
    }
    return s;
}
__device__ __forceinline__ void p2_attn_naive(Frame& F, int ch) {
    unsigned char* ws = F.ws;
    const bf16* ZA = (const bf16*)(ws + WS_ZA); const bf16* ZB = (const bf16*)(ws + WS_ZB);
    bf16* Y = (bf16*)(ws + WS_Y) + (size_t)ch * TC * Y_W;
    LAS float* qs = (LAS float*)(F.lds + F.wave * 1024);
    const int lane = F.lane;
    const int gw = F.vcu * NWAVES + F.wave, NGW = F.G * NWAVES;
    const float NEG = -INFINITY;
    for (int item = gw; item < TC * 24; item += NGW) {
        if (item < TC * 8) {
            const int t = item >> 3, h = item & 7, pos = t & (SEQ - 1), rb = t - pos;
            float sc[3][3];
#pragma unroll
            for (int g = 0; g < 3; ++g) qs[g * 64 + lane] = bf2f(ZA[(size_t)t * A_W + g * 512 + h * 64 + lane]);
            LDS_WAIT(); asm volatile("" ::: "memory");
#pragma unroll
            for (int g = 0; g < 3; ++g) {
                const int dil = g == 0 ? 1 : (g == 1 ? 4 : 16);
#pragma unroll
                for (int i = 0; i < 3; ++i) {
                    const int m = lane + 64 * i; const int kp = pos - m * dil;
                    float s = NEG;
                    if (m <= 128 && kp >= 0) s = dot64(qs + g * 64, ZA + (size_t)(rb + kp) * A_W + 1536 + g * 512 + h * 64);
                    sc[g][i] = s;
                }
            }
            float mx = NEG;
#pragma unroll
            for (int g = 0; g < 3; ++g)
#pragma unroll
                for (int i = 0; i < 3; ++i) mx = fmaxf(mx, sc[g][i]);
            mx = wave_max(mx);
            float ls = 0.f;
#pragma unroll
            for (int g = 0; g < 3; ++g)
#pragma unroll
                for (int i = 0; i < 3; ++i) { sc[g][i] = __builtin_amdgcn_exp2f(sc[g][i] - mx); ls += sc[g][i]; }
            ls = wave_sum(ls);
            float o = 0.f;
#pragma unroll
            for (int g = 0; g < 3; ++g) {
                const int dil = g == 0 ? 1 : (g == 1 ? 4 : 16);
                const bf16* vb = ZA + (size_t)rb * A_W + 3072 + g * 512 + h * 64 + lane;
#pragma unroll
                for (int i = 0; i < 3; ++i) {
                    const int mend = i < 2 ? 64 : 1;
                    for (int ml = 0; ml < mend; ++ml) {
                        const int kp = pos - (64 * i + ml) * dil;
                        if (kp < 0) break;
                        const float pv = __shfl(sc[g][i], ml);
                        o += pv * bf2f(vb[(size_t)kp * A_W]);
                    }
                }
            }
            Y[(size_t)t * Y_W + h * 64 + lane] = (bf16)f2bf(o / ls);
            LDS_WAIT(); asm volatile("" ::: "memory");
        } else {
            const int it = item - TC * 8; const int t = it >> 4, qh = it & 15, kvh = qh >> 3, pos = t & (SEQ - 1), rb = t - pos;
            qs[lane] = bf2f(ZB[(size_t)t * B_W + qh * 64 + lane]);
            LDS_WAIT(); asm volatile("" ::: "memory");
            float sc[2];
#pragma unroll
            for (int i = 0; i < 2; ++i) {
                const int m = lane + 64 * i; const int kp = pos - m;
                float s = NEG;
                if (kp >= 0) s = dot64(qs, ZB + (size_t)(rb + kp) * B_W + 1024 + kvh * 64);
                sc[i] = s;
            }
            const float sink2 = F.in[I_SINK][qh] * LOG2E;
            float mx = fmaxf(wave_max(fmaxf(sc[0], sc[1])), sink2);
            float ls = 0.f;
#pragma unroll
            for (int i = 0; i < 2; ++i) { sc[i] = __builtin_amdgcn_exp2f(sc[i] - mx); ls += sc[i]; }
            ls = wave_sum(ls) + __builtin_amdgcn_exp2f(sink2 - mx);
            float o = 0.f;
            const bf16* vb = ZB + (size_t)rb * B_W + 1152 + kvh * 64 + lane;
#pragma unroll
            for (int i = 0; i < 2; ++i) {
                for (int ml = 0; ml < 64; ++ml) {
                    const int kp = pos - (64 * i + ml);
                    if (kp < 0) break;
                    const float pv = __shfl(sc[i], ml);
                    o += pv * bf2f(vb[(size_t)kp * B_W]);
                }
            }
            Y[(size_t)t * Y_W + 512 + qh * 64 + lane] = (bf16)f2bf(o / ls);
            LDS_WAIT(); asm volatile("" ::: "memory");
        }
    }
}

__device__ __forceinline__ void p3_merge(Frame& F) {
    unsigned char* ws = F.ws;
    const bf16* Y = (const bf16*)(ws + WS_Y); const bf16* Wab = (const bf16*)(ws + WS_WAB); const bf16* Gt = (const bf16*)(ws + WS_G);
    bf16* MG = (bf16*)(ws + WS_MG);
    const int wid = F.wave, lane = F.lane, wr = wid >> 1, wc = wid & 1, fr = lane & 15, fq = lane >> 4;
    constexpr int NCT = D / 128, NU = (T / 256) * NCT;
    for (int u = F.vcu; u < NU; u += F.G) {
        const int pm = u / NCT, pn = u % NCT;
        const int ar = F.tid >> 2, ac = (F.tid & 3) * 8;
        const bf16* a0 = Y + (size_t)(pm * 256 + ar) * Y_W + ac; const bf16* a1 = a0 + (size_t)128 * Y_W;
        const bf16* b0 = Wab + (size_t)(pn * 128 + ar) * Y_W + ac;
        f32x4 acc[4][4]; zero_acc(acc);
        sg_kloop(F.lds, acc, a0, a1, b0, 512 / 32, wid, lane);
        const int col0 = pn * 128 + wc * 64 + fr;
#pragma unroll
        for (int m = 0; m < 4; ++m)
#pragma unroll
            for (int j = 0; j < 4; ++j) { const int row = pm * 256 + wr * 64 + m * 16 + fq * 4 + j; const bf16* gr = Gt + (size_t)row * G_W + col0; bf16* orow = MG + (size_t)row * D + col0;
#pragma unroll
                for (int n = 0; n < 4; ++n) orow[n * 16] = (bf16)f2bf(acc[m][n][j] * bf2f(gr[n * 16]));
                asm volatile("" ::: "memory"); }
        zero_acc(acc);
        sg_kloop(F.lds, acc, a0 + 512, a1 + 512, b0 + 512, 1024 / 32, wid, lane);
#pragma unroll
        for (int m = 0; m < 4; ++m)
#pragma unroll
            for (int j = 0; j < 4; ++j) { const int row = pm * 256 + wr * 64 + m * 16 + fq * 4 + j; const bf16* gr = Gt + (size_t)row * G_W + 1024 + col0; bf16* orow = MG + (size_t)row * D + col0;
#pragma unroll
                for (int n = 0; n < 4; ++n) orow[n * 16] = (bf16)f2bf(bf2f(orow[n * 16]) + acc[m][n][j] * bf2f(gr[n * 16]));
                asm volatile("" ::: "memory"); }
    }
}

__device__ __forceinline__ void p4_outproj(Frame& F) {
    unsigned char* ws = F.ws;
    const bf16* MG = (const bf16*)(ws + WS_MG); const bf16* Wo = (const bf16*)(ws + WS_WO);
    const float* X = F.in[I_X]; float* X1 = F.out;
    const int wid = F.wave, lane = F.lane, wr = wid >> 1, wc = wid & 1, fr = lane & 15, fq = lane >> 4;
    constexpr int NCT = D / 128, NU = (T / 256) * NCT;
    for (int u = F.vcu; u < NU; u += F.G) {
        const int pm = u / NCT, pn = u % NCT;
        const int ar = F.tid >> 2, ac = (F.tid & 3) * 8;
        const bf16* a0 = MG + (size_t)(pm * 256 + ar) * D + ac; const bf16* a1 = a0 + (size_t)128 * D;
        const bf16* b0 = Wo + (size_t)(pn * 128 + ar) * D + ac;
        f32x4 acc[4][4]; zero_acc(acc);
        sg_kloop(F.lds, acc, a0, a1, b0, D / 32, wid, lane);
        const int col0 = pn * 128 + wc * 64 + fr;
#pragma unroll
        for (int m = 0; m < 4; ++m)
#pragma unroll
            for (int j = 0; j < 4; ++j) { const size_t off = (size_t)(pm * 256 + wr * 64 + m * 16 + fq * 4 + j) * D + col0;
#pragma unroll
                for (int n = 0; n < 4; ++n) X1[off + n * 16] = X[off + n * 16] + acc[m][n][j]; }
    }
}

__device__ __forceinline__ void p5_route(Frame& F) {
    unsigned char* ws = F.ws;
    const float* X1 = F.out; bf16* H2 = (bf16*)(ws + WS_HN);
    const float* WRT = (const float*)(ws + WS_WRT);
    unsigned* cnt = (unsigned*)(ws + WS_CTL) + CW_CNT;
    int* tokof = (int*)(ws + WS_TOKOF); float* wtof = (float*)(ws + WS_WTOF); int4* tpos = (int4*)(ws + WS_TPOS);
    const int lane = F.lane;
    const int gw = F.vcu * NWAVES + F.wave, NGW = F.G * NWAVES;
    const GAS f32x4* gr = (const GAS f32x4*)F.in[I_GFFN] + lane;
    for (int row = gw; row < T; row += NGW) {
        const GAS f32x4* xr = (const GAS f32x4*)(X1 + (size_t)row * D) + lane;
        f32x4 v[4]; float s = 0.f;
#pragma unroll
        for (int j = 0; j < 4; ++j) { v[j] = xr[64 * j]; s += (v[j].x * v[j].x + v[j].y * v[j].y) + (v[j].z * v[j].z + v[j].w * v[j].w); }
        const float rstd = 1.0f / sqrtf(wave_sum(s) * (1.f / D) + RMS_EPS);
        GAS v2u* o8 = (GAS v2u*)(H2 + (size_t)row * D) + lane;
#pragma unroll
        for (int j = 0; j < 4; ++j) { const f32x4 gg = gr[64 * j]; v[j].x *= rstd * gg.x; v[j].y *= rstd * gg.y; v[j].z *= rstd * gg.z; v[j].w *= rstd * gg.w;
            v2u w; w.x = pk2(v[j].x, v[j].y); w.y = pk2(v[j].z, v[j].w); o8[64 * j] = w; }
        float lg[36];
#pragma unroll
        for (int o = 0; o < 36; ++o) {
            const GAS f32x4* wr_ = (const GAS f32x4*)(WRT + o * 1024) + lane; float p = 0.f;
#pragma unroll
            for (int j = 0; j < 4; ++j) { const f32x4 w = wr_[64 * j]; p += (v[j].x * w.x + v[j].y * w.y) + (v[j].z * w.z + v[j].w * w.w); }
            lg[o] = wave_sum(p) + (o < 4 ? F.in[I_BRG][o] : F.in[I_BRE][o - 4]);
            asm volatile("" ::: "memory");
        }
        int gsel = 0; float gmax = lg[0];
#pragma unroll
        for (int i = 1; i < 4; ++i) if (lg[i] > gmax) { gmax = lg[i]; gsel = i; }
        float gden = 0.f;
#pragma unroll
        for (int i = 0; i < 4; ++i) gden += __expf(lg[i] - gmax);
        const float pg = 1.0f / gden;
        float le[8];
#pragma unroll
        for (int j = 0; j < 8; ++j) { le[j] = lg[4 + j];
#pragma unroll
            for (int gi = 1; gi < 4; ++gi) le[j] = (gsel == gi) ? lg[4 + gi * 8 + j] : le[j]; }
        int i1 = 0; float m1 = le[0];
#pragma unroll
        for (int j = 1; j < 8; ++j) if (le[j] > m1) { m1 = le[j]; i1 = j; }
        int i2 = -1; float m2 = -INFINITY;
#pragma unroll
        for (int j = 0; j < 8; ++j) if (j != i1 && le[j] > m2) { m2 = le[j]; i2 = j; }
        const float e2 = __expf(m2 - m1);
        const float w1 = pg / (1.0f + e2), w2 = pg * e2 / (1.0f + e2);
        if (lane == 0) {
            const int e0 = gsel * 8 + i1, e1 = gsel * 8 + i2;
            const int p0 = (int)atomicAdd(&cnt[e0], 1u), p1 = (int)atomicAdd(&cnt[e1], 1u);
            tokof[(size_t)e0 * T + p0] = row; wtof[(size_t)e0 * T + p0] = w1;
            tokof[(size_t)e1 * T + p1] = row; wtof[(size_t)e1 * T + p1] = w2;
            tpos[row] = make_int4(e0, p0, e1, p1);
        }
    }
}

__device__ __forceinline__ void expert_tiles(Frame& F, LAS int* tb, LAS int* cn) {
    if (F.tid == 0) {
        const unsigned* cnt = (const unsigned*)(F.ws + WS_CTL) + CW_CNT;
        int acc = 0;
        for (int e = 0; e < NE; ++e) { const int c = (int)__hip_atomic_load(cnt + e, __ATOMIC_RELAXED, __HIP_MEMORY_SCOPE_AGENT); cn[e] = c; tb[e] = acc; acc += (c + 255) >> 8; }
        tb[NE] = acc;
    }
    __syncthreads();
}

__device__ __forceinline__ void p6a_gateup(Frame& F) {
    unsigned char* ws = F.ws;
    LAS int* tb = (LAS int*)(F.lds + LDS_MISC + 1024); LAS int* cn = tb + 64;
    expert_tiles(F, tb, cn);
    const bf16* H2 = (const bf16*)(ws + WS_HN); const bf16* Wgu = (const bf16*)(ws + WS_WGU); bf16* HACT = (bf16*)(ws + WS_HACT);
    const int* tokof = (const int*)(ws + WS_TOKOF); const float* wtof = (const float*)(ws + WS_WTOF);
    const int wid = F.wave, lane = F.lane, wr = wid >> 1, wc = wid & 1, fr = lane & 15, fq = lane >> 4;
    const int NU = tb[NE] * 4;
    for (int u = F.vcu; u < NU; u += F.G) {
        const int rt = u >> 2, ct = u & 3;
        int e = 0;
        for (int i = 1; i < NE; ++i) if (tb[i] <= rt) e = i;
        const int ce = cn[e], p0 = (rt - tb[e]) * 256;
        const int ar = F.tid >> 2, ac = (F.tid & 3) * 8;
        const int pa0 = p0 + ar, pa1 = p0 + ar + 128;
        const int tk0 = tokof[(size_t)e * T + (pa0 < ce ? pa0 : 0)], tk1 = tokof[(size_t)e * T + (pa1 < ce ? pa1 : 0)];
        const bf16* a0 = H2 + (size_t)tk0 * D + ac; const bf16* a1 = H2 + (size_t)tk1 * D + ac;
        const bf16* b0 = Wgu + ((size_t)e * 512 + ct * 128 + ar) * D + ac;
        f32x4 acc[4][4]; zero_acc(acc);
        sg_kloop(F.lds, acc, a0, a1, b0, D / 32, wid, lane);
#pragma unroll
        for (int m = 0; m < 4; ++m)
#pragma unroll
            for (int j = 0; j < 4; ++j) {
                const int r = wr * 64 + m * 16 + fq * 4 + j, p = p0 + r;
                const float w = p < ce ? wtof[(size_t)e * T + p] : 0.f;
                bf16* orow = HACT + (size_t)(rt * 256 + r) * DE + ct * 64 + wc * 32 + fr;
#pragma unroll
                for (int n = 0; n < 2; ++n) { const float g = acc[m][n][j], uu = acc[m][n + 2][j]; const float hv = g / (1.0f + __expf(-g)) * uu * w; orow[n * 16] = (bf16)f2bf(hv); }
            }
    }
}
__device__ __forceinline__ void p6b_down(Frame& F) {
    unsigned char* ws = F.ws;
    LAS int* tb = (LAS int*)(F.lds + LDS_MISC + 1024); LAS int* cn = tb + 64;
    expert_tiles(F, tb, cn);
    const bf16* HACT = (const bf16*)(ws + WS_HACT); const bf16* Wd = (const bf16*)(ws + WS_WD); bf16* YS = (bf16*)(ws + WS_YS);
    const int wid = F.wave, lane = F.lane, wr = wid >> 1, wc = wid & 1, fr = lane & 15, fq = lane >> 4;
    const int NU = tb[NE] * 8;
    for (int u = F.vcu; u < NU; u += F.G) {
        const int rt = u >> 3, ct = u & 7;
        int e = 0;
        for (int i = 1; i < NE; ++i) if (tb[i] <= rt) e = i;
        const int ar = F.tid >> 2, ac = (F.tid & 3) * 8;
        const bf16* a0 = HACT + (size_t)(rt * 256 + ar) * DE + ac; const bf16* a1 = a0 + (size_t)128 * DE;
        const bf16* b0 = Wd + ((size_t)e * 1024 + ct * 128 + ar) * DE + ac;
        f32x4 acc[4][4]; zero_acc(acc);
        sg_kloop(F.lds, acc, a0, a1, b0, DE / 32, wid, lane);
#pragma unroll
        for (int m = 0; m < 4; ++m)
#pragma unroll
            for (int j = 0; j < 4; ++j) { bf16* orow = YS + (size_t)(rt * 256 + wr * 64 + m * 16 + fq * 4 + j) * D + ct * 128 + wc * 64 + fr;
#pragma unroll
                for (int n = 0; n < 4; ++n) orow[n * 16] = (bf16)f2bf(acc[m][n][j]); }
    }
}
__device__ __forceinline__ void p7_final(Frame& F) {
    unsigned char* ws = F.ws;
    LAS int* tb = (LAS int*)(F.lds + LDS_MISC + 1024); LAS int* cn = tb + 64;
    expert_tiles(F, tb, cn);
    const bf16* YS = (const bf16*)(ws + WS_YS); const int4* tpos = (const int4*)(ws + WS_TPOS);
    float* X1 = F.out;
    const int lane = F.lane;
    const int gw = F.vcu * NWAVES + F.wave, NGW = F.G * NWAVES;
    const GAS f32x4* gr = (const GAS f32x4*)F.in[I_GFIN] + lane;
    for (int row = gw; row < T; row += NGW) {
        const int4 tp = tpos[row];
        const size_t s0 = (size_t)tb[tp.x] * 256 + tp.y, s1 = (size_t)tb[tp.z] * 256 + tp.w;
        GAS f32x4* xr = (GAS f32x4*)(X1 + (size_t)row * D) + lane;
        const GAS v2u* y0 = (const GAS v2u*)(YS + s0 * D) + lane; const GAS v2u* y1 = (const GAS v2u*)(YS + s1 * D) + lane;
        f32x4 v[4]; float s = 0.f;
#pragma unroll
        for (int j = 0; j < 4; ++j) { v[j] = xr[64 * j]; const v2u a = y0[64 * j], b = y1[64 * j];
            v[j].x += bflo(a.x) + bflo(b.x); v[j].y += bfhi(a.x) + bfhi(b.x); v[j].z += bflo(a.y) + bflo(b.y); v[j].w += bfhi(a.y) + bfhi(b.y);
            s += (v[j].x * v[j].x + v[j].y * v[j].y) + (v[j].z * v[j].z + v[j].w * v[j].w); }
        const float rstd = 1.0f / sqrtf(wave_sum(s) * (1.f / D) + RMS_EPS);
#pragma unroll
        for (int j = 0; j < 4; ++j) { const f32x4 gg = gr[64 * j]; f32x4 o; o.x = v[j].x * rstd * gg.x; o.y = v[j].y * rstd * gg.y; o.z = v[j].z * rstd * gg.z; o.w = v[j].w * rstd * gg.w; xr[64 * j] = o; }
    }
}

constexpr int NPHASE = 1 + 2 * NCH + 6;
__global__ void __launch_bounds__(NTHR, 2) fwd_kernel(KArgs args) {
    extern __shared__ __attribute__((aligned(16))) unsigned char lds_raw[];
    Frame F;
    F.lds = (LAS unsigned char*)lds_raw;
    F.tid = threadIdx.x; F.lane = F.tid & 63; F.wave = __builtin_amdgcn_readfirstlane(F.tid >> 6);
    F.G = gridDim.x; { const int bx = blockIdx.x; F.vcu = (F.G % 8 == 0) ? (bx % 8) * (F.G / 8) + bx / 8 : bx; }
#pragma unroll
    for (int i = 0; i < 17; ++i) F.in[i] = args.in[i];
    F.out = args.out; F.ws = args.ws;
    volatile LAS unsigned* MISC = (volatile LAS unsigned*)(F.lds + LDS_MISC);
    if (F.tid < 64) MISC[F.tid] = 0u;
    __syncthreads();
    XcdBarrier bar = xcd_barrier_post((unsigned*)(F.ws + WS_CTL) + CW_BAR + args.li * XCD_BAR_WORDS, MISC + 8);
#define IN(k) (args.ph_lo <= (k) && (k) < args.ph_hi)
#define SEAM(k) do { if (IN(k) && IN((k) + 1)) xcd_barrier(bar); } while (0)
    if (IN(0)) p0_prologue(F);
    SEAM(0);
#pragma unroll 1
    for (int ch = 0; ch < NCH; ++ch) {
        if (IN(1 + 2 * ch)) p1_inproj(F, ch);
        SEAM(1 + 2 * ch);
        if (IN(2 + 2 * ch)) p2_attn_naive(F, ch);
        SEAM(2 + 2 * ch);
    }
    if (IN(2 * NCH + 1)) p3_merge(F);
    SEAM(2 * NCH + 1);
    if (IN(2 * NCH + 2)) p4_outproj(F);
    SEAM(2 * NCH + 2);
    if (IN(2 * NCH + 3)) p5_route(F);
    SEAM(2 * NCH + 3);
    if (IN(2 * NCH + 4)) p6a_gateup(F);
    SEAM(2 * NCH + 4);
    if (IN(2 * NCH + 5)) p6b_down(F);
    SEAM(2 * NCH + 5);
    if (IN(2 * NCH + 6)) p7_final(F);
#undef IN
#undef SEAM
}

#ifndef N_LAUNCHES
#define N_LAUNCHES 1
#endif
extern "C" void kernel_launch(void* const* d_in, const int* in_sizes, int n_in, void* d_out, int out_size, void* d_ws, size_t ws_size, hipStream_t stream) {
    static int grid = 0;
    if (grid == 0) {
        if (n_in != 17 || in_sizes[0] != T * D || out_size != T * D || ws_size < WS_END) { fprintf(stderr, "kernel_launch: unexpected shapes / workspace (%d inputs, ws %zu)\n", n_in, ws_size); grid = -1; return; }
        int dev = 0, cus = 0;
        if (hipGetDevice(&dev) != hipSuccess || hipDeviceGetAttribute(&cus, hipDeviceAttributeMultiprocessorCount, dev) != hipSuccess) { grid = -1; return; }
        if (hipFuncSetAttribute((const void*)fwd_kernel, hipFuncAttributeMaxDynamicSharedMemorySize, LDS_BYTES) != hipSuccess) { fprintf(stderr, "kernel_launch: hipFuncSetAttribute failed\n"); grid = -1; return; }
        int per_cu = 0;
        if (hipOccupancyMaxActiveBlocksPerMultiprocessor(&per_cu, (const void*)fwd_kernel, NTHR, LDS_BYTES) != hipSuccess || per_cu < 1) fprintf(stderr, "kernel_launch: occupancy query says %d\n", per_cu);
        (void)hipGetLastError();
        grid = cus;
    }
    if (grid < 0) return;
    (void)hipMemsetAsync((char*)d_ws + WS_CTL, 0, CTL_BYTES, stream);
    KArgs a{};
    for (int i = 0; i < 17; ++i) a.in[i] = (const float*)d_in[i];
    a.out = (float*)d_out; a.ws = (unsigned char*)d_ws;
    for (int li = 0; li < N_LAUNCHES; ++li) {
        a.ph_lo = (int)((long)NPHASE * li / N_LAUNCHES); a.ph_hi = (int)((long)NPHASE * (li + 1) / N_LAUNCHES); a.li = li;
        hipLaunchKernelGGL(fwd_kernel, dim3(grid), dim3(NTHR), LDS_BYTES, stream, a);
    }
}
```

```cpp
#include <hip/hip_runtime.h>
#include <cstdint>
#include <cstdio>

#define GAS __attribute__((address_space(1)))
#define LAS __attribute__((address_space(3)))
typedef unsigned short bf16;
typedef short bf16x8 __attribute__((ext_vector_type(8)));
typedef float f32x4 __attribute__((ext_vector_type(4)));
typedef unsigned v4u __attribute__((ext_vector_type(4)));
typedef unsigned v2u __attribute__((ext_vector_type(2)));
typedef GAS unsigned gu32;

constexpr int T = 32768, D = 1024, SEQ = 4096, NIN = 7936;
constexpr int A_W = 4608, B_W = 1280, G_W = 2048, Y_W = 1536;
constexpr int NE = 32, DE = 256;
constexpr int NCH = 4, TC = T / NCH;
constexpr float QSCALE = 0.125f * 1.4426950408889634f;
constexpr float LOG2E = 1.4426950408889634f;
constexpr float RMS_EPS = 1e-6f;
constexpr int NWAVES = 8, NTHR = 512;

constexpr size_t MiB = 1u << 20;
constexpr size_t WS_CTL = 0, CTL_BYTES = 1 * MiB;
constexpr size_t WS_ROPE = 1 * MiB;
constexpr size_t WS_WRT = 2 * MiB;
constexpr size_t WS_TOKOF = 3 * MiB;
constexpr size_t WS_WTOF = 7 * MiB;
constexpr size_t WS_TPOS = 11 * MiB;
constexpr size_t WS_WIN = 12 * MiB;
constexpr size_t WS_WAB = 28 * MiB;
constexpr size_t WS_WO = 31 * MiB;
constexpr size_t WS_WGU = 33 * MiB;
constexpr size_t WS_WD = 65 * MiB;
constexpr size_t WS_HN = 82 * MiB;
constexpr size_t WS_G = 146 * MiB;
constexpr size_t WS_Y = 274 * MiB;
constexpr size_t WS_ZA = 370 * MiB;
constexpr size_t WS_ZB = 442 * MiB;
constexpr size_t WS_MG = 370 * MiB;
constexpr size_t WS_HACT = 146 * MiB;
constexpr size_t WS_YS = 182 * MiB;
constexpr size_t WS_OG = 462 * MiB;
constexpr size_t WS_LSE = 486 * MiB;
constexpr size_t WS_END = 487 * MiB;
constexpr int MAXSLOT = 2 * T + NE * 256;
static_assert(WS_ZA + (size_t)TC * A_W * 2 <= WS_ZB && WS_ZB + (size_t)TC * B_W * 2 <= WS_OG && WS_OG + (size_t)3 * TC * 512 * 2 <= WS_LSE && WS_LSE + (size_t)3 * TC * 8 * 4 <= WS_END, "ws map");
static_assert(WS_MG + (size_t)T * D * 2 <= WS_END && WS_HACT + (size_t)MAXSLOT * DE * 2 <= WS_YS && WS_YS + (size_t)MAXSLOT * D * 2 <= WS_ZA, "ws map");
constexpr int CW_CNT = 1024;
constexpr int CW_BAR = 4096;
constexpr int LDS_BYTES = 147456;
constexpr int LDS_MISC = 131072;

__device__ __forceinline__ unsigned f2bf(float f) { unsigned u = __builtin_bit_cast(unsigned, f); return (u + 0x7fffu + ((u >> 16) & 1u)) >> 16; }
__device__ __forceinline__ unsigned pk2(float lo, float hi) { return f2bf(lo) | (f2bf(hi) << 16); }
__device__ __forceinline__ float bf2f(unsigned b) { return __builtin_bit_cast(float, b << 16); }
__device__ __forceinline__ float bflo(unsigned u) { return __builtin_bit_cast(float, u << 16); }
__device__ __forceinline__ float bfhi(unsigned u) { return __builtin_bit_cast(float, u & 0xffff0000u); }
__device__ __forceinline__ float wave_sum(float v) {
#pragma unroll
    for (int o = 1; o < 64; o <<= 1) v += __shfl_xor(v, o);
    return v;
}
__device__ __forceinline__ float wave_max(float v) {
#pragma unroll
    for (int o = 1; o < 64; o <<= 1) v = fmaxf(v, __shfl_xor(v, o));
    return v;
}
#define LDS_WAIT() asm volatile("s_waitcnt lgkmcnt(0)" ::: "memory")
#define VM_WAIT() asm volatile("s_waitcnt vmcnt(0)" ::: "memory")

#define XB_TMO      128
#define XB_XCNT(j)  (256  + 64 * (j))
#define XB_XSUB(j)  (1280 + 64 * (j))
#define XB_XGEN(j)  (2304 + 64 * (j))
#define XB_TOP      3328
#define XB_TOPGEN   3392
#define XCD_BAR_WORDS 3456
#define XB_SPIN_CAP (1u << 18)
__device__ __forceinline__ unsigned xb_ld(unsigned* p)              { return __hip_atomic_load(p, __ATOMIC_RELAXED, __HIP_MEMORY_SCOPE_AGENT); }
__device__ __forceinline__ unsigned xb_add(unsigned* p, unsigned v) { return __hip_atomic_fetch_add(p, v, __ATOMIC_RELAXED, __HIP_MEMORY_SCOPE_AGENT); }
__device__ __forceinline__ unsigned xb_xcc_id() { return (unsigned)__builtin_amdgcn_s_getreg((3 << 11) | 20) & 0xFu; }
#define XB_SPIN(cond, bar) do { unsigned _sp = 0; while (cond) { __builtin_amdgcn_s_sleep(1); \
    if ((++_sp & 255u) == 0u) { if (xb_ld(&(bar)[XB_TMO])) break; if (_sp > XB_SPIN_CAP) { atomicAdd(&(bar)[XB_TMO], 1u); break; } } } } while (0)
struct XcdBarrier { unsigned* bar; unsigned x; volatile LAS unsigned* st; };
__device__ __forceinline__ XcdBarrier xcd_barrier_post(unsigned* bar, volatile LAS unsigned* st) {
    XcdBarrier b; b.bar = bar; b.x = xb_xcc_id(); b.st = st;
    if (threadIdx.x == 0) (void)xb_add(&bar[XB_XCNT(b.x)], 1u);
    return b;
}
__device__ __forceinline__ void xcd_barrier_complete(unsigned* bar, unsigned x, unsigned& nloc, unsigned& nx) {
    const unsigned G = gridDim.x * gridDim.y * gridDim.z;
    unsigned sum, cnt, mine, sp = 0u;
    for (;;) {
        sum = 0u; cnt = 0u; mine = 0u;
#pragma unroll
        for (unsigned j = 0; j < 16; ++j) { const unsigned c = xb_ld(&bar[XB_XCNT(j)]); sum += c; cnt += (c > 0u) ? 1u : 0u; mine = (j == x) ? c : mine; }
        if (sum == G) break;
        __builtin_amdgcn_s_sleep(1);
        if ((++sp & 255u) == 0u) { if (xb_ld(&bar[XB_TMO])) break; if (sp > XB_SPIN_CAP) { atomicAdd(&bar[XB_TMO], 1u); break; } }
    }
    nloc = mine > 0u ? mine : 1u; nx = cnt > 0u ? cnt : 1u;
}
__device__ __forceinline__ void xcd_barrier(const XcdBarrier& b) {
    asm volatile("s_waitcnt vmcnt(0)" ::: "memory");
    __syncthreads();
    if (threadIdx.x == 0) {
        unsigned* bar = b.bar;
        __builtin_amdgcn_s_waitcnt(0);
        unsigned nloc = b.st[0], nx = b.st[1];
        if (nloc == 0u) { xcd_barrier_complete(bar, b.x, nloc, nx); b.st[0] = nloc; b.st[1] = nx; }
        const unsigned old = xb_add(&bar[XB_XSUB(b.x)], 1u);
        const unsigned gen = old / nloc;
        if (old + 1u == (gen + 1u) * nloc) {
            __builtin_amdgcn_fence(__ATOMIC_RELEASE, "agent");
            asm volatile("s_waitcnt vmcnt(0)" ::: "memory");
            const unsigned og = xb_add(&bar[XB_TOP], 1u);
            const unsigned tg = og / nx;
            if (og + 1u == (tg + 1u) * nx) xb_add(&bar[XB_TOPGEN], 1u);
            else XB_SPIN(xb_ld(&bar[XB_TOPGEN]) == tg, bar);
            __builtin_amdgcn_fence(__ATOMIC_ACQUIRE, "agent");
            xb_add(&bar[XB_XGEN(b.x)], 1u);
            asm volatile("s_waitcnt vmcnt(0)" ::: "memory");
        } else {
            XB_SPIN(xb_ld(&bar[XB_XGEN(b.x)]) == gen, bar);
            __builtin_amdgcn_fence(__ATOMIC_ACQUIRE, "agent");
            asm volatile("s_waitcnt vmcnt(0)" ::: "memory");
        }
    }
    __syncthreads();
}

struct KArgs { const float* in[17]; float* out; unsigned char* ws; int ph_lo, ph_hi, li, pad; };
struct Frame {
    LAS unsigned char* lds;
    int tid, lane, wave, vcu, G;
    const float* in[17]; float* out; unsigned char* ws;
};
enum { I_X = 0, I_WIN, I_BIN, I_SINK, I_WPA, I_WPB, I_WOUT, I_GMIX, I_GFFN, I_WRG, I_BRG, I_WRE, I_BRE, I_WEG, I_WEU, I_WED, I_GFIN };

__device__ __forceinline__ void p0_tr_item(const float* W, int N, bf16* WT, int ldo, int rowbase, int koff, int k0, int n0, LAS float* scr, int lane) {
#pragma unroll 8
    for (int i = 0; i < 32; ++i) { const int kk = 2 * i + (lane >> 5); scr[kk * 33 + (lane & 31)] = W[(size_t)(k0 + kk) * N + n0 + (lane & 31)]; }
    LDS_WAIT(); asm volatile("" ::: "memory");
    const int c = lane & 7;
#pragma unroll
    for (int j = 0; j < 4; ++j) { const int n = (lane >> 3) + 8 * j; const LAS float* s = scr + (8 * c) * 33 + n;
        v4u o; o.x = pk2(s[0 * 33], s[1 * 33]); o.y = pk2(s[2 * 33], s[3 * 33]); o.z = pk2(s[4 * 33], s[5 * 33]); o.w = pk2(s[6 * 33], s[7 * 33]);
        *(GAS v4u*)(WT + (size_t)(rowbase + n) * ldo + koff + k0 + 8 * c) = o; }
    LDS_WAIT(); asm volatile("" ::: "memory");
}
__device__ __forceinline__ void rms_row_to_bf16(const float* xrow, const float* g, bf16* orow, int lane) {
    const GAS f32x4* xr = (const GAS f32x4*)xrow + lane; const GAS f32x4* gr = (const GAS f32x4*)g + lane;
    f32x4 v[4]; float s = 0.f;
#pragma unroll
    for (int j = 0; j < 4; ++j) { v[j] = xr[64 * j]; s += (v[j].x * v[j].x + v[j].y * v[j].y) + (v[j].z * v[j].z + v[j].w * v[j].w); }
    const float rstd = 1.0f / sqrtf(wave_sum(s) * (1.f / D) + RMS_EPS);
    GAS v2u* o8 = (GAS v2u*)orow + lane;
#pragma unroll
    for (int j = 0; j < 4; ++j) { const f32x4 gg = gr[64 * j]; v2u w; w.x = pk2(v[j].x * rstd * gg.x, v[j].y * rstd * gg.y); w.y = pk2(v[j].z * rstd * gg.z, v[j].w * rstd * gg.w); o8[64 * j] = w; }
}
__device__ __forceinline__ void p0_prologue(Frame& F) {
    LAS float* scr = (LAS float*)(F.lds + F.wave * 16384);
    const int gw = F.vcu * NWAVES + F.wave, NGW = F.G * NWAVES;
    unsigned char* ws = F.ws;
    constexpr int I_IN = 16 * 248, I_PA = 8 * 32, I_PB = 16 * 32, I_WO = 16 * 32, I_EG = 32 * 16 * 8, I_ED = 32 * 4 * 32;
    constexpr int NITEMS = I_IN + I_PA + I_PB + I_WO + 2 * I_EG + I_ED;
    for (int it = gw; it < NITEMS; it += NGW) {
        int r = it;
        if (r < I_IN) { const int kb = r / 248, nb = r % 248; p0_tr_item(F.in[I_WIN], NIN, (bf16*)(ws + WS_WIN), 1024, 32 * nb, 0, 64 * kb, 32 * nb, scr, F.lane); continue; } r -= I_IN;
        if (r < I_PA) { const int kb = r / 32, nb = r % 32; p0_tr_item(F.in[I_WPA], 1024, (bf16*)(ws + WS_WAB), 1536, 32 * nb, 0, 64 * kb, 32 * nb, scr, F.lane); continue; } r -= I_PA;
        if (r < I_PB) { const int kb = r / 32, nb = r % 32; p0_tr_item(F.in[I_WPB], 1024, (bf16*)(ws + WS_WAB), 1536, 32 * nb, 512, 64 * kb, 32 * nb, scr, F.lane); continue; } r -= I_PB;
        if (r < I_WO) { const int kb = r / 32, nb = r % 32; p0_tr_item(F.in[I_WOUT], 1024, (bf16*)(ws + WS_WO), 1024, 32 * nb, 0, 64 * kb, 32 * nb, scr, F.lane); continue; } r -= I_WO;
        if (r < 2 * I_EG) { const int up = r >= I_EG; if (up) r -= I_EG; const int e = r / 128, q = r % 128, kb = q / 8, nb = q % 8;
            p0_tr_item(F.in[up ? I_WEU : I_WEG] + (size_t)e * 1024 * 256, 256, (bf16*)(ws + WS_WGU) + (size_t)e * 512 * 1024, 1024, 64 * nb + (up ? 32 : 0), 0, 64 * kb, 32 * nb, scr, F.lane); continue; } r -= 2 * I_EG;
        { const int e = r / 128, q = r % 128, kb = q / 32, nb = q % 32;
            p0_tr_item(F.in[I_WED] + (size_t)e * 256 * 1024, 1024, (bf16*)(ws + WS_WD) + (size_t)e * 1024 * 256, 256, 32 * nb, 0, 64 * kb, 32 * nb, scr, F.lane); }
    }
    for (int m = gw; m < T; m += NGW) rms_row_to_bf16(F.in[I_X] + (size_t)m * D, F.in[I_GMIX], (bf16*)(ws + WS_HN) + (size_t)m * D, F.lane);
    const int gt = F.vcu * NTHR + F.tid, NGT = F.G * NTHR;
    for (int i = gt; i < SEQ * 32; i += NGT) {
        const int pos = i >> 5, fi = i & 31;
        const float inv = (float)exp2(-(double)fi * (13.287712379549449 / 32.0));
        const float ang = (float)pos * inv; float s, c; sincosf(ang, &s, &c);
        ((float2*)(ws + WS_ROPE))[i] = make_float2(c, s);
    }
    for (int i = gt; i < 36 * 1024; i += NGT) {
        const int o = i >> 10, k = i & 1023;
        ((float*)(ws + WS_WRT))[i] = o < 4 ? F.in[I_WRG][k * 4 + o] : F.in[I_WRE][k * 32 + (o - 4)];
    }
}

constexpr int SG_BUF = 24576;
__device__ __forceinline__ void sg_kloop(LAS unsigned char* lds, f32x4 (&acc)[4][4], const bf16* a0, const bf16* a1, const bf16* b0, int nt, int wid, int lane) {
    const int wr = wid >> 1, wc = wid & 1, fr = lane & 15, fq = lane >> 4;
    const unsigned wbase = (unsigned)wid * 1024u;
#define SG_STAGE(buf, kt) do { \
        __builtin_amdgcn_global_load_lds((const unsigned*)(a0 + (kt) * 32), (LAS unsigned*)(lds + (buf) * SG_BUF + wbase), 16, 0, 0); \
        __builtin_amdgcn_global_load_lds((const unsigned*)(a1 + (kt) * 32), (LAS unsigned*)(lds + (buf) * SG_BUF + 8192 + wbase), 16, 0, 0); \
        __builtin_amdgcn_global_load_lds((const unsigned*)(b0 + (kt) * 32), (LAS unsigned*)(lds + (buf) * SG_BUF + 16384 + wbase), 16, 0, 0); } while (0)
    SG_STAGE(0, 0);
    VM_WAIT(); __syncthreads();
    int cur = 0;
    for (int t = 0; t < nt; ++t) {
        if (t + 1 < nt) SG_STAGE(cur ^ 1, t + 1);
        const LAS unsigned char* sa = lds + cur * SG_BUF + (wr * 64 + fr) * 64 + fq * 16;
        const LAS unsigned char* sb = lds + cur * SG_BUF + 16384 + (wc * 64 + fr) * 64 + fq * 16;
        bf16x8 At[4], Bt[4];
#pragma unroll
        for (int m = 0; m < 4; ++m) At[m] = *(const LAS bf16x8*)(sa + m * 1024);
#pragma unroll
        for (int n = 0; n < 4; ++n) Bt[n] = *(const LAS bf16x8*)(sb + n * 1024);
#pragma unroll
        for (int m = 0; m < 4; ++m)
#pragma unroll
            for (int n = 0; n < 4; ++n) acc[m][n] = __builtin_amdgcn_mfma_f32_16x16x32_bf16(At[m], Bt[n], acc[m][n], 0, 0, 0);
        VM_WAIT(); __syncthreads();
        cur ^= 1;
    }
#undef SG_STAGE
}
__device__ __forceinline__ void zero_acc(f32x4 (&acc)[4][4]) {
#pragma unroll
    for (int m = 0; m < 4; ++m)
#pragma unroll
        for (int n = 0; n < 4; ++n) acc[m][n] = (f32x4){0.f, 0.f, 0.f, 0.f};
}

__device__ __forceinline__ void p1_inproj(Frame& F, int ch) {
    unsigned char* ws = F.ws;
    const bf16* A = (const bf16*)(ws + WS_HN) + (size_t)ch * TC * D;
    const bf16* Bt = (const bf16*)(ws + WS_WIN);
    bf16* ZA = (bf16*)(ws + WS_ZA); bf16* ZB = (bf16*)(ws + WS_ZB); bf16* Gt = (bf16*)(ws + WS_G) + (size_t)ch * TC * G_W;
    const float2* rope = (const float2*)(ws + WS_ROPE);
    const float* bias = F.in[I_BIN];
    const int wid = F.wave, lane = F.lane, wr = wid >> 1, wc = wid & 1, fr = lane & 15, fq = lane >> 4;
    constexpr int NCT = NIN / 128, NU = (TC / 256) * NCT;
    for (int u = F.vcu; u < NU; u += F.G) {
        const int pm = u / NCT, pn = u % NCT;
        f32x4 acc[4][4]; zero_acc(acc);
        const int ar = F.tid >> 2, ac = (F.tid & 3) * 8;
        const bf16* a0 = A + (size_t)(pm * 256 + ar) * D + ac; const bf16* a1 = a0 + (size_t)128 * D;
        const bf16* b0 = Bt + (size_t)(pn * 128 + ar) * D + ac;
        sg_kloop(F.lds, acc, a0, a1, b0, D / 32, wid, lane);
        const int colbase = pn * 128 + wc * 64;
        float bv[4];
#pragma unroll
        for (int n = 0; n < 4; ++n) bv[n] = bias[colbase + n * 16 + fr];
        int kind;
        bf16* dst; int ldd, dcol;
        if (colbase < A_W) { const int seg = colbase / 1536; kind = seg; dst = ZA; ldd = A_W; dcol = colbase; }
        else if (colbase < A_W + B_W) { const int cb = colbase - A_W; kind = cb < 1024 ? 0 : (cb < 1152 ? 1 : 2); dst = ZB; ldd = B_W; dcol = cb; }
        else { kind = 3; dst = Gt; ldd = G_W; dcol = colbase - A_W - B_W; }
#pragma unroll
        for (int m = 0; m < 4; ++m)
#pragma unroll
            for (int j = 0; j < 4; ++j) {
                const int row = pm * 256 + wr * 64 + m * 16 + fq * 4 + j;
                float v[4];
#pragma unroll
                for (int n = 0; n < 4; ++n) v[n] = acc[m][n][j] + bv[n];
                if (kind < 2) {
                    const int pos = row & (SEQ - 1);
#pragma unroll
                    for (int n = 0; n < 2; ++n) { const float2 cs = rope[pos * 32 + n * 16 + fr]; const float t1 = v[n], t2 = v[n + 2];
                        v[n] = t1 * cs.x - t2 * cs.y; v[n + 2] = t2 * cs.x + t1 * cs.y; }
                    if (kind == 0) {
#pragma unroll
                        for (int n = 0; n < 4; ++n) v[n] *= QSCALE;
                    }
                } else if (kind == 3) {
#pragma unroll
                    for (int n = 0; n < 4; ++n) v[n] = 1.0f / (1.0f + __expf(-v[n]));
                }
                bf16* drow = dst + (size_t)row * ldd + dcol + fr;
#pragma unroll
                for (int n = 0; n < 4; ++n) drow[n * 16] = (bf16)f2bf(v[n]);
            }
    }
}

__device__ __forceinline__ float dot64(const LAS float* qs, const bf16* kp) {
    float s = 0.f;
#pragma unroll
    for (int c = 0; c < 8; ++c) {
        const v4u kk = *(const GAS v4u*)(kp + 8 * c);
        const f32x4 q0 = *(const LAS f32x4*)(qs + 8 * c), q1 = *(const LAS f32x4*)(qs + 8 * c + 4);
        s += q0.x * bflo(kk.x) + q0.y * bfhi(kk.x) + q0.z * bflo(kk.y) + q0.w * bfhi(kk.y);
        s += q1.x * bflo(kk.z) + q1.y * bfhi(kk.z) + q1.z * bflo(kk.w) + q1.w * bfhi(kk.w);
    }
    return s;
}
__device__ __forceinline__ void p2_attn_naive(Frame& F, int ch) {
    unsigned char* ws = F.ws;
    const bf16* ZA = (const bf16*)(ws + WS_ZA); const bf16* ZB = (const bf16*)(ws + WS_ZB);
    bf16* Y = (bf16*)(ws + WS_Y) + (size_t)ch * TC * Y_W;
    LAS float* qs = (LAS float*)(F.lds + F.wave * 1024);
    const int lane = F.lane;
    const int gw = F.vcu * NWAVES + F.wave, NGW = F.G * NWAVES;
    const float NEG = -INFINITY;
    for (int item = gw; item < TC * 24; item += NGW) {
        if (item < TC * 8) {
            const int t = item >> 3, h = item & 7, pos = t & (SEQ - 1), rb = t - pos;
            float sc[3][3];
#pragma unroll
            for (int g = 0; g < 3; ++g) qs[g * 64 + lane] = bf2f(ZA[(size_t)t * A_W + g * 512 + h * 64 + lane]);
            LDS_WAIT(); asm volatile("" ::: "memory");
#pragma unroll
            for (int g = 0; g < 3; ++g) {
                const int dil = g == 0 ? 1 : (g == 1 ? 4 : 16);
#pragma unroll
                for (int i = 0; i < 3; ++i) {
                    const int m = lane + 64 * i; const int kp = pos - m * dil;
                    float s = NEG;
                    if (m <= 128 && kp >= 0) s = dot64(qs + g * 64, ZA + (size_t)(rb + kp) * A_W + 1536 + g * 512 + h * 64);
                    sc[g][i] = s;
                }
            }
            float mx = NEG;
#pragma unroll
            for (int g = 0; g < 3; ++g)
#pragma unroll
                for (int i = 0; i < 3; ++i) mx = fmaxf(mx, sc[g][i]);
            mx = wave_max(mx);
            float ls = 0.f;
#pragma unroll
            for (int g = 0; g < 3; ++g)
#pragma unroll
                for (int i = 0; i < 3; ++i) { sc[g][i] = __builtin_amdgcn_exp2f(sc[g][i] - mx); ls += sc[g][i]; }
            ls = wave_sum(ls);
            float o = 0.f;
#pragma unroll
            for (int g = 0; g < 3; ++g) {
                const int dil = g == 0 ? 1 : (g == 1 ? 4 : 16);
                const bf16* vb = ZA + (size_t)rb * A_W + 3072 + g * 512 + h * 64 + lane;
#pragma unroll
                for (int i = 0; i < 3; ++i) {
                    const int mend = i < 2 ? 64 : 1;
                    for (int ml = 0; ml < mend; ++ml) {
                        const int kp = pos - (64 * i + ml) * dil;
                        if (kp < 0) break;
                        const float pv = __shfl(sc[g][i], ml);
                        o += pv * bf2f(vb[(size_t)kp * A_W]);
                    }
                }
            }
            Y[(size_t)t * Y_W + h * 64 + lane] = (bf16)f2bf(o / ls);
            LDS_WAIT(); asm volatile("" ::: "memory");
        } else {
            const int it = item - TC * 8; const int t = it >> 4, qh = it & 15, kvh = qh >> 3, pos = t & (SEQ - 1), rb = t - pos;
            qs[lane] = bf2f(ZB[(size_t)t * B_W + qh * 64 + lane]);
            LDS_WAIT(); asm volatile("" ::: "memory");
            float sc[2];
#pragma unroll
            for (int i = 0; i < 2; ++i) {
                const int m = lane + 64 * i; const int kp = pos - m;
                float s = NEG;
                if (kp >= 0) s = dot64(qs, ZB + (size_t)(rb + kp) * B_W + 1024 + kvh * 64);
                sc[i] = s;
            }
            const float sink2 = F.in[I_SINK][qh] * LOG2E;
            float mx = fmaxf(wave_max(fmaxf(sc[0], sc[1])), sink2);
            float ls = 0.f;
#pragma unroll
            for (int i = 0; i < 2; ++i) { sc[i] = __builtin_amdgcn_exp2f(sc[i] - mx); ls += sc[i]; }
            ls = wave_sum(ls) + __builtin_amdgcn_exp2f(sink2 - mx);
            float o = 0.f;
            const bf16* vb = ZB + (size_t)rb * B_W + 1152 + kvh * 64 + lane;
#pragma unroll
            for (int i = 0; i < 2; ++i) {
                for (int ml = 0; ml < 64; ++ml) {
                    const int kp = pos - (64 * i + ml);
                    if (kp < 0) break;
                    const float pv = __shfl(sc[i], ml);
                    o += pv * bf2f(vb[(size_t)kp * B_W]);
                }
            }
            Y[(size_t)t * Y_W + 512 + qh * 64 + lane] = (bf16)f2bf(o / ls);
            LDS_WAIT(); asm volatile("" ::: "memory");
        }
    }
}


typedef float f32x16 __attribute__((ext_vector_type(16)));
typedef short v4i16_t __attribute__((ext_vector_type(4)));
typedef float f32x2_t __attribute__((ext_vector_type(2)));
typedef __bf16 bf16x2_t __attribute__((ext_vector_type(2)));
__device__ __forceinline__ unsigned cvtpk(float lo, float hi) { f32x2_t v = {lo, hi}; bf16x2_t b = __builtin_convertvector(v, bf16x2_t); return __builtin_bit_cast(unsigned, b); }
__device__ __forceinline__ float half_max(float v) { auto rr = __builtin_amdgcn_permlane32_swap(__float_as_uint(v), __float_as_uint(v), false, false); return fmaxf(__uint_as_float(rr[0]), __uint_as_float(rr[1])); }
__device__ __forceinline__ float half_sum(float v) { auto rr = __builtin_amdgcn_permlane32_swap(__float_as_uint(v), __float_as_uint(v), false, false); return __uint_as_float(rr[0]) + __uint_as_float(rr[1]); }
constexpr int ATT_VOFF = 49152;

template <int KIND>
__device__ __forceinline__ void attn_unit(Frame& F, int ch, int u) {
    unsigned char* ws = F.ws;
    const int tid = F.tid, lane = F.lane, w = F.wave, c = lane & 31, h = lane >> 5;
    LAS unsigned char* KL = F.lds; LAS unsigned char* VL = F.lds + ATT_VOFF;
    constexpr int NP = KIND == 0 ? 6 : 3;
    constexpr int NKEYS = KIND == 0 ? 384 : 160;
    const bf16 *Kw, *Vw, *Qp; size_t pitch; int kk_lo, kb0, kstart; float m, l;
    bf16* Op; float* Lp = nullptr;
    if (KIND == 0) {
        const bf16* ZA = (const bf16*)(ws + WS_ZA);
        const int rt = u & 15, hh = (u >> 4) & 7, gb = u >> 7, g = gb % 3, bl = gb / 3;
        const int dsh = 2 * g, d = 1 << dsh;
        const int tsh = 4 - dsh;
        const int r = rt >> tsh, tile = rt & ((1 << tsh) - 1), i0 = tile * 256;
        const int rowb = bl * SEQ + r;
        const int col = g * 512 + hh * 64;
        pitch = (size_t)d * A_W;
        Kw = ZA + ((long)rowb + (long)d * (i0 - 128)) * A_W + 1536 + col;
        Vw = Kw + 1536;
        const long qrow = (long)rowb + (long)d * (i0 + 32 * w + c);
        Qp = ZA + qrow * A_W + col;
        kk_lo = (i0 == 0) ? 128 : 0;
        kb0 = w; kstart = (i0 == 0) ? (w < 4 ? 4 - w : 0) : 0;
        m = -1e30f; l = 0.f;
        Op = (bf16*)(ws + WS_OG) + ((size_t)g * TC + qrow) * 512 + hh * 64;
        Lp = (float*)(ws + WS_LSE) + ((size_t)g * TC + qrow) * 8 + hh;
    } else {
        const bf16* ZB = (const bf16*)(ws + WS_ZB);
        const int blk = u & 127, kvh = (u >> 7) & 1, bl = u >> 8;
        const int t0 = blk * 32, rowb = bl * SEQ;
        pitch = B_W;
        Kw = ZB + ((long)rowb + t0 - 128) * B_W + 1024 + kvh * 64;
        Vw = Kw + 128;
        const int qh = kvh * 8 + w;
        const long qrow = (long)rowb + t0 + c;
        Qp = ZB + qrow * B_W + qh * 64;
        kk_lo = t0 < 128 ? 128 - t0 : 0;
        kb0 = 0; kstart = kk_lo >> 5;
        m = F.in[I_SINK][qh] * LOG2E; l = h == 0 ? 1.f : 0.f;
        Op = (bf16*)(ws + WS_Y) + ((size_t)ch * TC + qrow) * Y_W + 512 + qh * 64;
    }
    {
        const int skey = tid >> 3, sch = tid & 7;
        v4u kreg[NP], vreg[NP];
#pragma unroll
        for (int p = 0; p < NP; ++p) { const int kk = 64 * p + skey;
            if (kk >= kk_lo && kk < NKEYS) { kreg[p] = *(const GAS v4u*)(Kw + (size_t)kk * pitch + 8 * sch); vreg[p] = *(const GAS v4u*)(Vw + (size_t)kk * pitch + 8 * sch); } }
#pragma unroll
        for (int p = 0; p < NP; ++p) { const int kk = 64 * p + skey;
            if (kk >= kk_lo && kk < NKEYS) {
                *(LAS v4u*)(KL + kk * 128 + ((sch ^ ((kk >> 1) & 7)) << 4)) = kreg[p];
                *(LAS v4u*)(VL + kk * 128 + ((sch * 16) ^ (((kk >> 1) & 1) << 6))) = vreg[p]; } }
    }
    bf16x8 qf[4];
#pragma unroll
    for (int s4 = 0; s4 < 4; ++s4) qf[s4] = *(const GAS bf16x8*)(Qp + 16 * s4 + 8 * h);
    __syncthreads();
    int koff[4];
    { const int kswz = (c >> 1) & 7;
#pragma unroll
      for (int s4 = 0; s4 < 4; ++s4) koff[s4] = c * 128 + (((2 * s4 + h) ^ kswz) << 4); }
    const int vrow = 4 * h + ((lane & 15) >> 2), vsw = (lane >> 3) & 1;
    const int voff0 = vrow * 128 + ((32 * ((lane >> 4) & 1) + 8 * (lane & 3)) ^ (vsw << 6)), voff1 = voff0 ^ 64;
    const float NEG = -INFINITY;
    f32x16 o0, o1;
#pragma unroll
    for (int i = 0; i < 16; ++i) { o0[i] = 0.f; o1[i] = 0.f; }
    const LAS unsigned char* kbp = KL + kb0 * 4096; const LAS unsigned char* vbp = VL + kb0 * 4096;
#pragma unroll
    for (int kbi = 0; kbi < 5; ++kbi) {
        if (kbi >= kstart) {
            f32x16 p;
#pragma unroll
            for (int i = 0; i < 16; ++i) p[i] = 0.f;
#pragma unroll
            for (int s4 = 0; s4 < 4; ++s4) { const bf16x8 kf = *(const LAS bf16x8*)(kbp + kbi * 4096 + koff[s4]); p = __builtin_amdgcn_mfma_f32_32x32x16_bf16(kf, qf[s4], p, 0, 0, 0); }
            if (kbi == 0) {
#pragma unroll
                for (int i = 0; i < 16; ++i) { const int x = (i & 3) + 8 * (i >> 2) + 4 * h; if (x < c + (KIND == 0 ? 0 : 1)) p[i] = NEG; }
            }
            if (kbi == 4) {
#pragma unroll
                for (int i = 0; i < 16; ++i) { const int x = (i & 3) + 8 * (i >> 2) + 4 * h; if (x > c) p[i] = NEG; }
            }
            float mt = p[0];
#pragma unroll
            for (int i = 1; i < 16; ++i) mt = fmaxf(mt, p[i]);
            mt = half_max(mt);
            const float mn = fmaxf(m, mt), alpha = __builtin_amdgcn_exp2f(m - mn);
            m = mn;
            float ps = 0.f;
#pragma unroll
            for (int i = 0; i < 16; ++i) { p[i] = __builtin_amdgcn_exp2f(p[i] - mn); ps += p[i]; }
            l = l * alpha + ps;
#pragma unroll
            for (int i = 0; i < 16; ++i) { o0[i] *= alpha; o1[i] *= alpha; }
            bf16x8 pb[2];
#pragma unroll
            for (int s2 = 0; s2 < 2; ++s2) { v4u t; t.x = cvtpk(p[8 * s2 + 0], p[8 * s2 + 1]); t.y = cvtpk(p[8 * s2 + 2], p[8 * s2 + 3]); t.z = cvtpk(p[8 * s2 + 4], p[8 * s2 + 5]); t.w = cvtpk(p[8 * s2 + 6], p[8 * s2 + 7]); pb[s2] = __builtin_bit_cast(bf16x8, t); }
#pragma unroll
            for (int s2 = 0; s2 < 2; ++s2) {
#pragma unroll
                for (int db = 0; db < 2; ++db) {
                    const LAS unsigned char* vp = vbp + kbi * 4096 + s2 * 2048 + (db ? voff1 : voff0);
                    const v4i16_t lo = __builtin_amdgcn_ds_read_tr16_b64_v4i16((LAS v4i16_t*)vp);
                    const v4i16_t hi = __builtin_amdgcn_ds_read_tr16_b64_v4i16((LAS v4i16_t*)(vp + 1024));
                    const bf16x8 vf = {lo[0], lo[1], lo[2], lo[3], hi[0], hi[1], hi[2], hi[3]};
                    if (db == 0) o0 = __builtin_amdgcn_mfma_f32_32x32x16_bf16(vf, pb[s2], o0, 0, 0, 0);
                    else o1 = __builtin_amdgcn_mfma_f32_32x32x16_bf16(vf, pb[s2], o1, 0, 0, 0);
                }
            }
        }
    }
    const float lt = half_sum(l), inv = 1.0f / lt;
#pragma unroll
    for (int g4 = 0; g4 < 4; ++g4) {
        v2u a, b;
        a.x = cvtpk(o0[4 * g4 + 0] * inv, o0[4 * g4 + 1] * inv); a.y = cvtpk(o0[4 * g4 + 2] * inv, o0[4 * g4 + 3] * inv);
        b.x = cvtpk(o1[4 * g4 + 0] * inv, o1[4 * g4 + 1] * inv); b.y = cvtpk(o1[4 * g4 + 2] * inv, o1[4 * g4 + 3] * inv);
        *(GAS v2u*)(Op + 8 * g4 + 4 * h) = a;
        *(GAS v2u*)(Op + 32 + 8 * g4 + 4 * h) = b;
    }
    if (KIND == 0) { if (h == 0) *Lp = m + __builtin_amdgcn_logf(lt); }
    __syncthreads();
}
__device__ __forceinline__ void p2_attn(Frame& F, int ch) {
    constexpr int NUA = (TC / SEQ) * 3 * 8 * 16, NUB = (TC / SEQ) * 2 * 128;
    for (int u = F.vcu; u < NUA + NUB; u += F.G) {
        if (u < NUA) attn_unit<0>(F, ch, u); else attn_unit<1>(F, ch, u - NUA);
    }
}
__device__ __forceinline__ void p2_combine(Frame& F, int ch) {
    unsigned char* ws = F.ws;
    const bf16* OG = (const bf16*)(ws + WS_OG); const float* LSE = (const float*)(ws + WS_LSE);
    bf16* Y = (bf16*)(ws + WS_Y) + (size_t)ch * TC * Y_W;
    const int lane = F.lane, hd = lane >> 3;
    const int gw = F.vcu * NWAVES + F.wave, NGW = F.G * NWAVES;
    for (int row = gw; row < TC; row += NGW) {
        float lg[3]; v4u og[3];
#pragma unroll
        for (int g = 0; g < 3; ++g) { lg[g] = LSE[((size_t)g * TC + row) * 8 + hd]; og[g] = *(const GAS v4u*)(OG + ((size_t)g * TC + row) * 512 + lane * 8); }
        const float mx = fmaxf(fmaxf(lg[0], lg[1]), lg[2]);
        float e[3]; e[0] = __builtin_amdgcn_exp2f(lg[0] - mx); e[1] = __builtin_amdgcn_exp2f(lg[1] - mx); e[2] = __builtin_amdgcn_exp2f(lg[2] - mx);
        const float inv = 1.0f / (e[0] + e[1] + e[2]);
        float acc[8];
#pragma unroll
        for (int i = 0; i < 8; ++i) acc[i] = 0.f;
#pragma unroll
        for (int g = 0; g < 3; ++g) { const float wg = e[g] * inv;
            acc[0] += wg * bflo(og[g].x); acc[1] += wg * bfhi(og[g].x); acc[2] += wg * bflo(og[g].y); acc[3] += wg * bfhi(og[g].y);
            acc[4] += wg * bflo(og[g].z); acc[5] += wg * bfhi(og[g].z); acc[6] += wg * bflo(og[g].w); acc[7] += wg * bfhi(og[g].w); }
        v4u o; o.x = cvtpk(acc[0], acc[1]); o.y = cvtpk(acc[2], acc[3]); o.z = cvtpk(acc[4], acc[5]); o.w = cvtpk(acc[6], acc[7]);
        *(GAS v4u*)(Y + (size_t)row * Y_W + lane * 8) = o;
    }
}

__device__ __forceinline__ void p3_merge(Frame& F) {
    unsigned char* ws = F.ws;
    const bf16* Y = (const bf16*)(ws + WS_Y); const bf16* Wab = (const bf16*)(ws + WS_WAB); const bf16* Gt = (const bf16*)(ws + WS_G);
    bf16* MG = (bf16*)(ws + WS_MG);
    const int wid = F.wave, lane = F.lane, wr = wid >> 1, wc = wid & 1, fr = lane & 15, fq = lane >> 4;
    constexpr int NCT = D / 128, NU = (T / 256) * NCT;
    for (int u = F.vcu; u < NU; u += F.G) {
        const int pm = u / NCT, pn = u % NCT;
        const int ar = F.tid >> 2, ac = (F.tid & 3) * 8;
        const bf16* a0 = Y + (size_t)(pm * 256 + ar) * Y_W + ac; const bf16* a1 = a0 + (size_t)128 * Y_W;
        const bf16* b0 = Wab + (size_t)(pn * 128 + ar) * Y_W + ac;
        f32x4 acc[4][4]; zero_acc(acc);
        sg_kloop(F.lds, acc, a0, a1, b0, 512 / 32, wid, lane);
        const int col0 = pn * 128 + wc * 64 + fr;
#pragma unroll
        for (int m = 0; m < 4; ++m)
#pragma unroll
            for (int j = 0; j < 4; ++j) { const int row = pm * 256 + wr * 64 + m * 16 + fq * 4 + j; const bf16* gr = Gt + (size_t)row * G_W + col0; bf16* orow = MG + (size_t)row * D + col0;
#pragma unroll
                for (int n = 0; n < 4; ++n) orow[n * 16] = (bf16)f2bf(acc[m][n][j] * bf2f(gr[n * 16]));
                asm volatile("" ::: "memory"); }
        zero_acc(acc);
        sg_kloop(F.lds, acc, a0 + 512, a1 + 512, b0 + 512, 1024 / 32, wid, lane);
#pragma unroll
        for (int m = 0; m < 4; ++m)
#pragma unroll
            for (int j = 0; j < 4; ++j) { const int row = pm * 256 + wr * 64 + m * 16 + fq * 4 + j; const bf16* gr = Gt + (size_t)row * G_W + 1024 + col0; bf16* orow = MG + (size_t)row * D + col0;
#pragma unroll
                for (int n = 0; n < 4; ++n) orow[n * 16] = (bf16)f2bf(bf2f(orow[n * 16]) + acc[m][n][j] * bf2f(gr[n * 16]));
                asm volatile("" ::: "memory"); }
    }
}

__device__ __forceinline__ void p4_outproj(Frame& F) {
    unsigned char* ws = F.ws;
    const bf16* MG = (const bf16*)(ws + WS_MG); const bf16* Wo = (const bf16*)(ws + WS_WO);
    const float* X = F.in[I_X]; float* X1 = F.out;
    const int wid = F.wave, lane = F.lane, wr = wid >> 1, wc = wid & 1, fr = lane & 15, fq = lane >> 4;
    constexpr int NCT = D / 128, NU = (T / 256) * NCT;
    for (int u = F.vcu; u < NU; u += F.G) {
        const int pm = u / NCT, pn = u % NCT;
        const int ar = F.tid >> 2, ac = (F.tid & 3) * 8;
        const bf16* a0 = MG + (size_t)(pm * 256 + ar) * D + ac; const bf16* a1 = a0 + (size_t)128 * D;
        const bf16* b0 = Wo + (size_t)(pn * 128 + ar) * D + ac;
        f32x4 acc[4][4]; zero_acc(acc);
        sg_kloop(F.lds, acc, a0, a1, b0, D / 32, wid, lane);
        const int col0 = pn * 128 + wc * 64 + fr;
#pragma unroll
        for (int m = 0; m < 4; ++m)
#pragma unroll
            for (int j = 0; j < 4; ++j) { const size_t off = (size_t)(pm * 256 + wr * 64 + m * 16 + fq * 4 + j) * D + col0;
#pragma unroll
                for (int n = 0; n < 4; ++n) X1[off + n * 16] = X[off + n * 16] + acc[m][n][j]; }
    }
}

__device__ __forceinline__ void p5_route(Frame& F) {
    unsigned char* ws = F.ws;
    const float* X1 = F.out; bf16* H2 = (bf16*)(ws + WS_HN);
    const float* WRT = (const float*)(ws + WS_WRT);
    unsigned* cnt = (unsigned*)(ws + WS_CTL) + CW_CNT;
    int* tokof = (int*)(ws + WS_TOKOF); float* wtof = (float*)(ws + WS_WTOF); int4* tpos = (int4*)(ws + WS_TPOS);
    const int lane = F.lane;
    const int gw = F.vcu * NWAVES + F.wave, NGW = F.G * NWAVES;
    const GAS f32x4* gr = (const GAS f32x4*)F.in[I_GFFN] + lane;
    for (int row = gw; row < T; row += NGW) {
        const GAS f32x4* xr = (const GAS f32x4*)(X1 + (size_t)row * D) + lane;
        f32x4 v[4]; float s = 0.f;
#pragma unroll
        for (int j = 0; j < 4; ++j) { v[j] = xr[64 * j]; s += (v[j].x * v[j].x + v[j].y * v[j].y) + (v[j].z * v[j].z + v[j].w * v[j].w); }
        const float rstd = 1.0f / sqrtf(wave_sum(s) * (1.f / D) + RMS_EPS);
        GAS v2u* o8 = (GAS v2u*)(H2 + (size_t)row * D) + lane;
#pragma unroll
        for (int j = 0; j < 4; ++j) { const f32x4 gg = gr[64 * j]; v[j].x *= rstd * gg.x; v[j].y *= rstd * gg.y; v[j].z *= rstd * gg.z; v[j].w *= rstd * gg.w;
            v2u w; w.x = pk2(v[j].x, v[j].y); w.y = pk2(v[j].z, v[j].w); o8[64 * j] = w; }
        float lg[36];
#pragma unroll
        for (int o = 0; o < 36; ++o) {
            const GAS f32x4* wr_ = (const GAS f32x4*)(WRT + o * 1024) + lane; float p = 0.f;
#pragma unroll
            for (int j = 0; j < 4; ++j) { const f32x4 w = wr_[64 * j]; p += (v[j].x * w.x + v[j].y * w.y) + (v[j].z * w.z + v[j].w * w.w); }
            lg[o] = wave_sum(p) + (o < 4 ? F.in[I_BRG][o] : F.in[I_BRE][o - 4]);
            asm volatile("" ::: "memory");
        }
        int gsel = 0; float gmax = lg[0];
#pragma unroll
        for (int i = 1; i < 4; ++i) if (lg[i] > gmax) { gmax = lg[i]; gsel = i; }
        float gden = 0.f;
#pragma unroll
        for (int i = 0; i < 4; ++i) gden += __expf(lg[i] - gmax);
        const float pg = 1.0f / gden;
        float le[8];
#pragma unroll
        for (int j = 0; j < 8; ++j) { le[j] = lg[4 + j];
#pragma unroll
            for (int gi = 1; gi < 4; ++gi) le[j] = (gsel == gi) ? lg[4 + gi * 8 + j] : le[j]; }
        int i1 = 0; float m1 = le[0];
#pragma unroll
        for (int j = 1; j < 8; ++j) if (le[j] > m1) { m1 = le[j]; i1 = j; }
        int i2 = -1; float m2 = -INFINITY;
#pragma unroll
        for (int j = 0; j < 8; ++j) if (j != i1 && le[j] > m2) { m2 = le[j]; i2 = j; }
        const float e2 = __expf(m2 - m1);
        const float w1 = pg / (1.0f + e2), w2 = pg * e2 / (1.0f + e2);
        if (lane == 0) {
            const int e0 = gsel * 8 + i1, e1 = gsel * 8 + i2;
            const int p0 = (int)atomicAdd(&cnt[e0], 1u), p1 = (int)atomicAdd(&cnt[e1], 1u);
            tokof[(size_t)e0 * T + p0] = row; wtof[(size_t)e0 * T + p0] = w1;
            tokof[(size_t)e1 * T + p1] = row; wtof[(size_t)e1 * T + p1] = w2;
            tpos[row] = make_int4(e0, p0, e1, p1);
        }
    }
}

__device__ __forceinline__ void expert_tiles(Frame& F, LAS int* tb, LAS int* cn) {
    if (F.tid == 0) {
        const unsigned* cnt = (const unsigned*)(F.ws + WS_CTL) + CW_CNT;
        int acc = 0;
        for (int e = 0; e < NE; ++e) { const int c = (int)__hip_atomic_load(cnt + e, __ATOMIC_RELAXED, __HIP_MEMORY_SCOPE_AGENT); cn[e] = c; tb[e] = acc; acc += (c + 255) >> 8; }
        tb[NE] = acc;
    }
    __syncthreads();
}

__device__ __forceinline__ void p6a_gateup(Frame& F) {
    unsigned char* ws = F.ws;
    LAS int* tb = (LAS int*)(F.lds + LDS_MISC + 1024); LAS int* cn = tb + 64;
    expert_tiles(F, tb, cn);
    const bf16* H2 = (const bf16*)(ws + WS_HN); const bf16* Wgu = (const bf16*)(ws + WS_WGU); bf16* HACT = (bf16*)(ws + WS_HACT);
    const int* tokof = (const int*)(ws + WS_TOKOF); const float* wtof = (const float*)(ws + WS_WTOF);
    const int wid = F.wave, lane = F.lane, wr = wid >> 1, wc = wid & 1, fr = lane & 15, fq = lane >> 4;
    const int NU = tb[NE] * 4;
    for (int u = F.vcu; u < NU; u += F.G) {
        const int rt = u >> 2, ct = u & 3;
        int e = 0;
        for (int i = 1; i < NE; ++i) if (tb[i] <= rt) e = i;
        const int ce = cn[e], p0 = (rt - tb[e]) * 256;
        const int ar = F.tid >> 2, ac = (F.tid & 3) * 8;
        const int pa0 = p0 + ar, pa1 = p0 + ar + 128;
        const int tk0 = tokof[(size_t)e * T + (pa0 < ce ? pa0 : 0)], tk1 = tokof[(size_t)e * T + (pa1 < ce ? pa1 : 0)];
        const bf16* a0 = H2 + (size_t)tk0 * D + ac; const bf16* a1 = H2 + (size_t)tk1 * D + ac;
        const bf16* b0 = Wgu + ((size_t)e * 512 + ct * 128 + ar) * D + ac;
        f32x4 acc[4][4]; zero_acc(acc);
        sg_kloop(F.lds, acc, a0, a1, b0, D / 32, wid, lane);
#pragma unroll
        for (int m = 0; m < 4; ++m)
#pragma unroll
            for (int j = 0; j < 4; ++j) {
                const int r = wr * 64 + m * 16 + fq * 4 + j, p = p0 + r;
                const float w = p < ce ? wtof[(size_t)e * T + p] : 0.f;
                bf16* orow = HACT + (size_t)(rt * 256 + r) * DE + ct * 64 + wc * 32 + fr;
#pragma unroll
                for (int n = 0; n < 2; ++n) { const float g = acc[m][n][j], uu = acc[m][n + 2][j]; const float hv = g / (1.0f + __expf(-g)) * uu * w; orow[n * 16] = (bf16)f2bf(hv); }
            }
    }
}
__device__ __forceinline__ void p6b_down(Frame& F) {
    unsigned char* ws = F.ws;
    LAS int* tb = (LAS int*)(F.lds + LDS_MISC + 1024); LAS int* cn = tb + 64;
    expert_tiles(F, tb, cn);
    const bf16* HACT = (const bf16*)(ws + WS_HACT); const bf16* Wd = (const bf16*)(ws + WS_WD); bf16* YS = (bf16*)(ws + WS_YS);
    const int wid = F.wave, lane = F.lane, wr = wid >> 1, wc = wid & 1, fr = lane & 15, fq = lane >> 4;
    const int NU = tb[NE] * 8;
    for (int u = F.vcu; u < NU; u += F.G) {
        const int rt = u >> 3, ct = u & 7;
        int e = 0;
        for (int i = 1; i < NE; ++i) if (tb[i] <= rt) e = i;
        const int ar = F.tid >> 2, ac = (F.tid & 3) * 8;
        const bf16* a0 = HACT + (size_t)(rt * 256 + ar) * DE + ac; const bf16* a1 = a0 + (size_t)128 * DE;
        const bf16* b0 = Wd + ((size_t)e * 1024 + ct * 128 + ar) * DE + ac;
        f32x4 acc[4][4]; zero_acc(acc);
        sg_kloop(F.lds, acc, a0, a1, b0, DE / 32, wid, lane);
#pragma unroll
        for (int m = 0; m < 4; ++m)
#pragma unroll
            for (int j = 0; j < 4; ++j) { bf16* orow = YS + (size_t)(rt * 256 + wr * 64 + m * 16 + fq * 4 + j) * D + ct * 128 + wc * 64 + fr;
#pragma unroll
                for (int n = 0; n < 4; ++n) orow[n * 16] = (bf16)f2bf(acc[m][n][j]); }
    }
}
__device__ __forceinline__ void p7_final(Frame& F) {
    unsigned char* ws = F.ws;
    LAS int* tb = (LAS int*)(F.lds + LDS_MISC + 1024); LAS int* cn = tb + 64;
    expert_tiles(F, tb, cn);
    const bf16* YS = (const bf16*)(ws + WS_YS); const int4* tpos = (const int4*)(ws + WS_TPOS);
    float* X1 = F.out;
    const int lane = F.lane;
    const int gw = F.vcu * NWAVES + F.wave, NGW = F.G * NWAVES;
    const GAS f32x4* gr = (const GAS f32x4*)F.in[I_GFIN] + lane;
    for (int row = gw; row < T; row += NGW) {
        const int4 tp = tpos[row];
        const size_t s0 = (size_t)tb[tp.x] * 256 + tp.y, s1 = (size_t)tb[tp.z] * 256 + tp.w;
        GAS f32x4* xr = (GAS f32x4*)(X1 + (size_t)row * D) + lane;
        const GAS v2u* y0 = (const GAS v2u*)(YS + s0 * D) + lane; const GAS v2u* y1 = (const GAS v2u*)(YS + s1 * D) + lane;
        f32x4 v[4]; float s = 0.f;
#pragma unroll
        for (int j = 0; j < 4; ++j) { v[j] = xr[64 * j]; const v2u a = y0[64 * j], b = y1[64 * j];
            v[j].x += bflo(a.x) + bflo(b.x); v[j].y += bfhi(a.x) + bfhi(b.x); v[j].z += bflo(a.y) + bflo(b.y); v[j].w += bfhi(a.y) + bfhi(b.y);
            s += (v[j].x * v[j].x + v[j].y * v[j].y) + (v[j].z * v[j].z + v[j].w * v[j].w); }
        const float rstd = 1.0f / sqrtf(wave_sum(s) * (1.f / D) + RMS_EPS);
#pragma unroll
        for (int j = 0; j < 4; ++j) { const f32x4 gg = gr[64 * j]; f32x4 o; o.x = v[j].x * rstd * gg.x; o.y = v[j].y * rstd * gg.y; o.z = v[j].z * rstd * gg.z; o.w = v[j].w * rstd * gg.w; xr[64 * j] = o; }
    }
}

constexpr int NPHASE = 1 + 3 * NCH + 6;
__global__ void __launch_bounds__(NTHR, 2) fwd_kernel(KArgs args) {
    extern __shared__ __attribute__((aligned(16))) unsigned char lds_raw[];
    Frame F;
    F.lds = (LAS unsigned char*)lds_raw;
    F.tid = threadIdx.x; F.lane = F.tid & 63; F.wave = __builtin_amdgcn_readfirstlane(F.tid >> 6);
    F.G = gridDim.x; { const int bx = blockIdx.x; F.vcu = (F.G % 8 == 0) ? (bx % 8) * (F.G / 8) + bx / 8 : bx; }
#pragma unroll
    for (int i = 0; i < 17; ++i) F.in[i] = args.in[i];
    F.out = args.out; F.ws = args.ws;
    volatile LAS unsigned* MISC = (volatile LAS unsigned*)(F.lds + LDS_MISC);
    if (F.tid < 64) MISC[F.tid] = 0u;
    __syncthreads();
    XcdBarrier bar = xcd_barrier_post((unsigned*)(F.ws + WS_CTL) + CW_BAR + args.li * XCD_BAR_WORDS, MISC + 8);
#define IN(k) (args.ph_lo <= (k) && (k) < args.ph_hi)
#define SEAM(k) do { if (IN(k) && IN((k) + 1)) xcd_barrier(bar); } while (0)
    if (IN(0)) p0_prologue(F);
    SEAM(0);
#pragma unroll 1
    for (int ch = 0; ch < NCH; ++ch) {
        if (IN(1 + 3 * ch)) p1_inproj(F, ch);
        SEAM(1 + 3 * ch);
        if (IN(2 + 3 * ch)) p2_attn(F, ch);
        SEAM(2 + 3 * ch);
        if (IN(3 + 3 * ch)) p2_combine(F, ch);
        SEAM(3 + 3 * ch);
    }
    if (IN(3 * NCH + 1)) p3_merge(F);
    SEAM(3 * NCH + 1);
    if (IN(3 * NCH + 2)) p4_outproj(F);
    SEAM(3 * NCH + 2);
    if (IN(3 * NCH + 3)) p5_route(F);
    SEAM(3 * NCH + 3);
    if (IN(3 * NCH + 4)) p6a_gateup(F);
    SEAM(3 * NCH + 4);
    if (IN(3 * NCH + 5)) p6b_down(F);
    SEAM(3 * NCH + 5);
    if (IN(3 * NCH + 6)) p7_final(F);
#undef IN
#undef SEAM
}

#ifndef N_LAUNCHES
#define N_LAUNCHES 1
#endif
extern "C" void kernel_launch(void* const* d_in, const int* in_sizes, int n_in, void* d_out, int out_size, void* d_ws, size_t ws_size, hipStream_t stream) {
    static int grid = 0;
    if (grid == 0) {
        if (n_in != 17 || in_sizes[0] != T * D || out_size != T * D || ws_size < WS_END) { fprintf(stderr, "kernel_launch: unexpected shapes / workspace (%d inputs, ws %zu)\n", n_in, ws_size); grid = -1; return; }
        int dev = 0, cus = 0;
        if (hipGetDevice(&dev) != hipSuccess || hipDeviceGetAttribute(&cus, hipDeviceAttributeMultiprocessorCount, dev) != hipSuccess) { grid = -1; return; }
        if (hipFuncSetAttribute((const void*)fwd_kernel, hipFuncAttributeMaxDynamicSharedMemorySize, LDS_BYTES) != hipSuccess) { fprintf(stderr, "kernel_launch: hipFuncSetAttribute failed\n"); grid = -1; return; }
        int per_cu = 0;
        if (hipOccupancyMaxActiveBlocksPerMultiprocessor(&per_cu, (const void*)fwd_kernel, NTHR, LDS_BYTES) != hipSuccess || per_cu < 1) fprintf(stderr, "kernel_launch: occupancy query says %d\n", per_cu);
        (void)hipGetLastError();
        grid = cus;
    }
    if (grid < 0) return;
    (void)hipMemsetAsync((char*)d_ws + WS_CTL, 0, CTL_BYTES, stream);
    KArgs a{};
    for (int i = 0; i < 17; ++i) a.in[i] = (const float*)d_in[i];
    a.out = (float*)d_out; a.ws = (unsigned char*)d_ws;
    for (int li = 0; li < N_LAUNCHES; ++li) {
        a.ph_lo = (int)((long)NPHASE * li / N_LAUNCHES); a.ph_hi = (int)((long)NPHASE * (li + 1) / N_LAUNCHES); a.li = li;
        hipLaunchKernelGGL(fwd_kernel, dim3(grid), dim3(NTHR), LDS_BYTES, stream, a);
    }
}
```

```cpp
#include <hip/hip_runtime.h>
#include <cstdint>
#include <cstdio>

#define GAS __attribute__((address_space(1)))
#define LAS __attribute__((address_space(3)))
typedef unsigned short bf16;
typedef short bf16x8 __attribute__((ext_vector_type(8)));
typedef float f32x4 __attribute__((ext_vector_type(4)));
typedef unsigned v4u __attribute__((ext_vector_type(4)));
typedef unsigned v2u __attribute__((ext_vector_type(2)));
typedef GAS unsigned gu32;

constexpr int T = 32768, D = 1024, SEQ = 4096, NIN = 7936;
constexpr int A_W = 4608, B_W = 1280, G_W = 2048, Y_W = 1536;
constexpr int NE = 32, DE = 256;
constexpr int NCH = 4, TC = T / NCH;
constexpr float QSCALE = 0.125f * 1.4426950408889634f;
constexpr float LOG2E = 1.4426950408889634f;
constexpr float RMS_EPS = 1e-6f;
constexpr int NWAVES = 8, NTHR = 512;

constexpr size_t MiB = 1u << 20;
constexpr size_t WS_CTL = 0, CTL_BYTES = 1 * MiB;
constexpr size_t WS_ROPE = 1 * MiB;
constexpr size_t WS_WRT = 2 * MiB;
constexpr size_t WS_TOKOF = 3 * MiB;
constexpr size_t WS_WTOF = 7 * MiB;
constexpr size_t WS_TPOS = 11 * MiB;
constexpr size_t WS_WIN = 12 * MiB;
constexpr size_t WS_WAB = 28 * MiB;
constexpr size_t WS_WO = 31 * MiB;
constexpr size_t WS_WGU = 33 * MiB;
constexpr size_t WS_WD = 65 * MiB;
constexpr size_t WS_HN = 82 * MiB;
constexpr size_t WS_G = 146 * MiB;
constexpr size_t WS_Y = 274 * MiB;
constexpr size_t WS_ZA = 370 * MiB;
constexpr size_t WS_ZB = 442 * MiB;
constexpr size_t WS_MG = 370 * MiB;
constexpr size_t WS_HACT = 146 * MiB;
constexpr size_t WS_YS = 182 * MiB;
constexpr size_t WS_OG = 462 * MiB;
constexpr size_t WS_LSE = 486 * MiB;
constexpr size_t WS_END = 487 * MiB;
constexpr int MAXSLOT = 2 * T + NE * 256;
static_assert(WS_ZA + (size_t)TC * A_W * 2 <= WS_ZB && WS_ZB + (size_t)TC * B_W * 2 <= WS_OG && WS_OG + (size_t)3 * TC * 512 * 2 <= WS_LSE && WS_LSE + (size_t)3 * TC * 8 * 4 <= WS_END, "ws map");
static_assert(WS_MG + (size_t)T * D * 2 <= WS_END && WS_HACT + (size_t)MAXSLOT * DE * 2 <= WS_YS && WS_YS + (size_t)MAXSLOT * D * 2 <= WS_ZA, "ws map");
constexpr int CW_CNT = 1024;
constexpr int CW_BAR = 4096;
constexpr int LDS_BYTES = 147456;
constexpr int LDS_MISC = 131072;

__device__ __forceinline__ unsigned f2bf(float f) { unsigned u = __builtin_bit_cast(unsigned, f); return (u + 0x7fffu + ((u >> 16) & 1u)) >> 16; }
__device__ __forceinline__ unsigned pk2(float lo, float hi) { return f2bf(lo) | (f2bf(hi) << 16); }
__device__ __forceinline__ float bf2f(unsigned b) { return __builtin_bit_cast(float, b << 16); }
__device__ __forceinline__ float bflo(unsigned u) { return __builtin_bit_cast(float, u << 16); }
__device__ __forceinline__ float bfhi(unsigned u) { return __builtin_bit_cast(float, u & 0xffff0000u); }
__device__ __forceinline__ float wave_sum(float v) {
#pragma unroll
    for (int o = 1; o < 64; o <<= 1) v += __shfl_xor(v, o);
    return v;
}
__device__ __forceinline__ float wave_max(float v) {
#pragma unroll
    for (int o = 1; o < 64; o <<= 1) v = fmaxf(v, __shfl_xor(v, o));
    return v;
}
typedef float f32x2_t __attribute__((ext_vector_type(2)));
typedef __bf16 bf16x2_t __attribute__((ext_vector_type(2)));
__device__ __forceinline__ unsigned cvtpk(float lo, float hi) { f32x2_t v = {lo, hi}; bf16x2_t b = __builtin_convertvector(v, bf16x2_t); return __builtin_bit_cast(unsigned, b); }
#define LDS_WAIT() asm volatile("s_waitcnt lgkmcnt(0)" ::: "memory")
#define VM_WAIT() asm volatile("s_waitcnt vmcnt(0)" ::: "memory")

#define XB_TMO      128
#define XB_XCNT(j)  (256  + 64 * (j))
#define XB_XSUB(j)  (1280 + 64 * (j))
#define XB_XGEN(j)  (2304 + 64 * (j))
#define XB_TOP      3328
#define XB_TOPGEN   3392
#define XCD_BAR_WORDS 3456
#define XB_SPIN_CAP (1u << 18)
__device__ __forceinline__ unsigned xb_ld(unsigned* p)              { return __hip_atomic_load(p, __ATOMIC_RELAXED, __HIP_MEMORY_SCOPE_AGENT); }
__device__ __forceinline__ unsigned xb_add(unsigned* p, unsigned v) { return __hip_atomic_fetch_add(p, v, __ATOMIC_RELAXED, __HIP_MEMORY_SCOPE_AGENT); }
__device__ __forceinline__ unsigned xb_xcc_id() { return (unsigned)__builtin_amdgcn_s_getreg((3 << 11) | 20) & 0xFu; }
#define XB_SPIN(cond, bar) do { unsigned _sp = 0; while (cond) { __builtin_amdgcn_s_sleep(1); \
    if ((++_sp & 255u) == 0u) { if (xb_ld(&(bar)[XB_TMO])) break; if (_sp > XB_SPIN_CAP) { atomicAdd(&(bar)[XB_TMO], 1u); break; } } } } while (0)
struct XcdBarrier { unsigned* bar; unsigned x; volatile LAS unsigned* st; };
__device__ __forceinline__ XcdBarrier xcd_barrier_post(unsigned* bar, volatile LAS unsigned* st) {
    XcdBarrier b; b.bar = bar; b.x = xb_xcc_id(); b.st = st;
    if (threadIdx.x == 0) (void)xb_add(&bar[XB_XCNT(b.x)], 1u);
    return b;
}
__device__ __forceinline__ void xcd_barrier_complete(unsigned* bar, unsigned x, unsigned& nloc, unsigned& nx) {
    const unsigned G = gridDim.x * gridDim.y * gridDim.z;
    unsigned sum, cnt, mine, sp = 0u;
    for (;;) {
        sum = 0u; cnt = 0u; mine = 0u;
#pragma unroll
        for (unsigned j = 0; j < 16; ++j) { const unsigned c = xb_ld(&bar[XB_XCNT(j)]); sum += c; cnt += (c > 0u) ? 1u : 0u; mine = (j == x) ? c : mine; }
        if (sum == G) break;
        __builtin_amdgcn_s_sleep(1);
        if ((++sp & 255u) == 0u) { if (xb_ld(&bar[XB_TMO])) break; if (sp > XB_SPIN_CAP) { atomicAdd(&bar[XB_TMO], 1u); break; } }
    }
    nloc = mine > 0u ? mine : 1u; nx = cnt > 0u ? cnt : 1u;
}
__device__ __forceinline__ void xcd_barrier(const XcdBarrier& b) {
    asm volatile("s_waitcnt vmcnt(0)" ::: "memory");
    __syncthreads();
    if (threadIdx.x == 0) {
        unsigned* bar = b.bar;
        __builtin_amdgcn_s_waitcnt(0);
        unsigned nloc = b.st[0], nx = b.st[1];
        if (nloc == 0u) { xcd_barrier_complete(bar, b.x, nloc, nx); b.st[0] = nloc; b.st[1] = nx; }
        const unsigned old = xb_add(&bar[XB_XSUB(b.x)], 1u);
        const unsigned gen = old / nloc;
        if (old + 1u == (gen + 1u) * nloc) {
            __builtin_amdgcn_fence(__ATOMIC_RELEASE, "agent");
            asm volatile("s_waitcnt vmcnt(0)" ::: "memory");
            const unsigned og = xb_add(&bar[XB_TOP], 1u);
            const unsigned tg = og / nx;
            if (og + 1u == (tg + 1u) * nx) xb_add(&bar[XB_TOPGEN], 1u);
            else XB_SPIN(xb_ld(&bar[XB_TOPGEN]) == tg, bar);
            __builtin_amdgcn_fence(__ATOMIC_ACQUIRE, "agent");
            xb_add(&bar[XB_XGEN(b.x)], 1u);
            asm volatile("s_waitcnt vmcnt(0)" ::: "memory");
        } else {
            XB_SPIN(xb_ld(&bar[XB_XGEN(b.x)]) == gen, bar);
            __builtin_amdgcn_fence(__ATOMIC_ACQUIRE, "agent");
            asm volatile("s_waitcnt vmcnt(0)" ::: "memory");
        }
    }
    __syncthreads();
}

struct KArgs { const float* in[17]; float* out; unsigned char* ws; int ph_lo, ph_hi, li, pad; };
struct Frame {
    LAS unsigned char* lds;
    int tid, lane, wave, vcu, G;
    const float* in[17]; float* out; unsigned char* ws;
};
enum { I_X = 0, I_WIN, I_BIN, I_SINK, I_WPA, I_WPB, I_WOUT, I_GMIX, I_GFFN, I_WRG, I_BRG, I_WRE, I_BRE, I_WEG, I_WEU, I_WED, I_GFIN };

__device__ __forceinline__ void p0_tr_item(const float* W, int N, bf16* WT, int ldo, int rowbase, int koff, int k0, int n0, LAS float* scr, int lane, bool perm = false) {
#pragma unroll 8
    for (int i = 0; i < 32; ++i) { const int kk = 2 * i + (lane >> 5); scr[kk * 33 + (lane & 31)] = W[(size_t)(k0 + kk) * N + n0 + (lane & 31)]; }
    LDS_WAIT(); asm volatile("" ::: "memory");
    const int c = lane & 7;
#pragma unroll
    for (int j = 0; j < 4; ++j) { const int n = (lane >> 3) + 8 * j; const LAS float* s = scr + (8 * c) * 33 + n;
        v4u o; o.x = pk2(s[0 * 33], s[1 * 33]); o.y = pk2(s[2 * 33], s[3 * 33]); o.z = pk2(s[4 * 33], s[5 * 33]); o.w = pk2(s[6 * 33], s[7 * 33]);
        const int rr = perm ? 8 * (n >> 2) + (n & 3) : n;
        *(GAS v4u*)(WT + (size_t)(rowbase + rr) * ldo + koff + k0 + 8 * c) = o; }
    LDS_WAIT(); asm volatile("" ::: "memory");
}
__device__ __forceinline__ void rms_row_to_bf16(const float* xrow, const float* g, bf16* orow, int lane) {
    const GAS f32x4* xr = (const GAS f32x4*)xrow + lane; const GAS f32x4* gr = (const GAS f32x4*)g + lane;
    f32x4 v[4]; float s = 0.f;
#pragma unroll
    for (int j = 0; j < 4; ++j) { v[j] = xr[64 * j]; s += (v[j].x * v[j].x + v[j].y * v[j].y) + (v[j].z * v[j].z + v[j].w * v[j].w); }
    const float rstd = 1.0f / sqrtf(wave_sum(s) * (1.f / D) + RMS_EPS);
    GAS v2u* o8 = (GAS v2u*)orow + lane;
#pragma unroll
    for (int j = 0; j < 4; ++j) { const f32x4 gg = gr[64 * j]; v2u w; w.x = pk2(v[j].x * rstd * gg.x, v[j].y * rstd * gg.y); w.y = pk2(v[j].z * rstd * gg.z, v[j].w * rstd * gg.w); o8[64 * j] = w; }
}
__device__ __forceinline__ void p0_prologue(Frame& F) {
    int tid_ = threadIdx.x; asm volatile("" : "+v"(tid_)); const int lane_ = tid_ & 63;
    LAS float* scr = (LAS float*)(F.lds + F.wave * 16384);
    const int gw = F.vcu * NWAVES + F.wave, NGW = F.G * NWAVES;
    unsigned char* ws = F.ws;
    constexpr int I_IN = 16 * 248, I_PA = 8 * 32, I_PB = 16 * 32, I_WO = 16 * 32, I_EG = 32 * 16 * 8, I_ED = 32 * 4 * 32;
    constexpr int NITEMS = I_IN + I_PA + I_PB + I_WO + 2 * I_EG + I_ED;
    for (int it = gw; it < NITEMS; it += NGW) {
        int r = it;
        if (r < I_IN) { const int kb = r / 248, nb = r % 248, n0 = 32 * nb; const bool qk = (n0 < 3072) || (n0 >= A_W && n0 < A_W + 1152);
            p0_tr_item(F.in[I_WIN], NIN, (bf16*)(ws + WS_WIN), 1024, qk ? (n0 & ~63) + ((n0 >> 5) & 1) * 4 : n0, 0, 64 * kb, n0, scr, lane_, qk); continue; } r -= I_IN;
        if (r < I_PA) { const int kb = r / 32, nb = r % 32; p0_tr_item(F.in[I_WPA], 1024, (bf16*)(ws + WS_WAB), 1536, 32 * nb, 0, 64 * kb, 32 * nb, scr, lane_); continue; } r -= I_PA;
        if (r < I_PB) { const int kb = r / 32, nb = r % 32; p0_tr_item(F.in[I_WPB], 1024, (bf16*)(ws + WS_WAB), 1536, 32 * nb, 512, 64 * kb, 32 * nb, scr, lane_); continue; } r -= I_PB;
        if (r < I_WO) { const int kb = r / 32, nb = r % 32; p0_tr_item(F.in[I_WOUT], 1024, (bf16*)(ws + WS_WO), 1024, 32 * nb, 0, 64 * kb, 32 * nb, scr, lane_); continue; } r -= I_WO;
        if (r < 2 * I_EG) { const int up = r >= I_EG; if (up) r -= I_EG; const int e = r / 128, q = r % 128, kb = q / 8, nb = q % 8;
            p0_tr_item(F.in[up ? I_WEU : I_WEG] + (size_t)e * 1024 * 256, 256, (bf16*)(ws + WS_WGU) + (size_t)e * 512 * 1024, 1024, 64 * nb + (up ? 32 : 0), 0, 64 * kb, 32 * nb, scr, lane_); continue; } r -= 2 * I_EG;
        { const int e = r / 128, q = r % 128, kb = q / 32, nb = q % 32;
            p0_tr_item(F.in[I_WED] + (size_t)e * 256 * 1024, 1024, (bf16*)(ws + WS_WD) + (size_t)e * 1024 * 256, 256, 32 * nb, 0, 64 * kb, 32 * nb, scr, lane_); }
    }
    for (int m = gw; m < T; m += NGW) rms_row_to_bf16(F.in[I_X] + (size_t)m * D, F.in[I_GMIX], (bf16*)(ws + WS_HN) + (size_t)m * D, lane_);
    const int gt = F.vcu * NTHR + tid_, NGT = F.G * NTHR;
    for (int i = gt; i < SEQ * 32; i += NGT) {
        const int pos = i >> 5, fi = i & 31;
        const float inv = (float)exp2(-(double)fi * (13.287712379549449 / 32.0));
        const float ang = (float)pos * inv; float s, c; sincosf(ang, &s, &c);
        ((float2*)(ws + WS_ROPE))[i] = make_float2(c, s);
    }
    for (int i = gt; i < 36 * 1024; i += NGT) {
        const int o = i >> 10, k = i & 1023;
        ((float*)(ws + WS_WRT))[i] = o < 4 ? F.in[I_WRG][k * 4 + o] : F.in[I_WRE][k * 32 + (o - 4)];
    }
}

constexpr int SG_BUF = 24576;
__device__ __forceinline__ void sg_kloop(LAS unsigned char* lds, f32x4 (&acc)[4][4], const bf16* a0, const bf16* a1, const bf16* b0, int nt, int wid, int lane) {
    const int wr = wid >> 1, wc = wid & 1, fr = lane & 15, fq = lane >> 4;
    const unsigned wbase = (unsigned)wid * 1024u;
#define SG_STAGE(buf, kt) do { \
        __builtin_amdgcn_global_load_lds((const unsigned*)(a0 + (kt) * 32), (LAS unsigned*)(lds + (buf) * SG_BUF + wbase), 16, 0, 0); \
        __builtin_amdgcn_global_load_lds((const unsigned*)(a1 + (kt) * 32), (LAS unsigned*)(lds + (buf) * SG_BUF + 8192 + wbase), 16, 0, 0); \
        __builtin_amdgcn_global_load_lds((const unsigned*)(b0 + (kt) * 32), (LAS unsigned*)(lds + (buf) * SG_BUF + 16384 + wbase), 16, 0, 0); } while (0)
    SG_STAGE(0, 0);
    VM_WAIT(); __syncthreads();
    int cur = 0;
    for (int t = 0; t < nt; ++t) {
        if (t + 1 < nt) SG_STAGE(cur ^ 1, t + 1);
        const LAS unsigned char* sa = lds + cur * SG_BUF + (wr * 64 + fr) * 64 + fq * 16;
        const LAS unsigned char* sb = lds + cur * SG_BUF + 16384 + (wc * 64 + fr) * 64 + fq * 16;
        bf16x8 At[4], Bt[4];
#pragma unroll
        for (int m = 0; m < 4; ++m) At[m] = *(const LAS bf16x8*)(sa + m * 1024);
#pragma unroll
        for (int n = 0; n < 4; ++n) Bt[n] = *(const LAS bf16x8*)(sb + n * 1024);
#pragma unroll
        for (int m = 0; m < 4; ++m)
#pragma unroll
            for (int n = 0; n < 4; ++n) acc[m][n] = __builtin_amdgcn_mfma_f32_16x16x32_bf16(At[m], Bt[n], acc[m][n], 0, 0, 0);
        VM_WAIT(); __syncthreads();
        cur ^= 1;
    }
#undef SG_STAGE
}
__device__ __forceinline__ void zero_acc(f32x4 (&acc)[4][4]) {
#pragma unroll
    for (int m = 0; m < 4; ++m)
#pragma unroll
        for (int n = 0; n < 4; ++n) acc[m][n] = (f32x4){0.f, 0.f, 0.f, 0.f};
}

namespace pg8 {
#define PG8_LAS __attribute__((address_space(3)))
typedef unsigned short bf16_t;
typedef short bf16x8 __attribute__((ext_vector_type(8)));
typedef float f32x4 __attribute__((ext_vector_type(4)));
typedef unsigned u32x4 __attribute__((ext_vector_type(4)));
constexpr int BM = 256, BK = 64, HALF = 128, HTB = HALF * BK * 2  , STAGE_BYTES = 8 * HTB, NXCD = 8, WGM = 8;

__host__ __device__ __forceinline__ int lds_byte(int r, int c) { const int st = (r >> 4) * 2 + (c >> 5), rr = r & 15, cc = c & 31, ob = rr * 64 + cc * 2; return st * 1024 + (ob ^ (((ob >> 9) & 1) << 5)); }
__host__ __device__ __forceinline__ void stage_rc(int b, int& R, int& C) { const int st = b / 1024, sb = b % 1024, swz = sb ^ (((sb >> 9) & 1) << 5); R = (st >> 1) * 16 + swz / 64; C = (st & 1) * 32 + (swz % 64) / 2; }
__host__ __device__ __forceinline__ int perm32(int rho) { const int n = rho >> 4, i = rho & 15; return 8 * (i >> 2) + 4 * n + (i & 3); }

struct Unit { int pm, pn; };
struct Gemm { const bf16_t* A; const bf16_t* Bt; int M, N, K; };

struct StaticOrder {
    int nM, nN, nwg, G, c;
    __host__ __device__ void init(int M, int N, int G_, int c_) { nM = M / BM; nN = N / BM; nwg = nM * nN; G = G_; c = c_; }
    __host__ __device__ bool next(int i, Unit& u) const {
        const long L = (long)i * G + c; if (L >= nwg) return false;
        int wgid = (int)L; { const int q = nwg / NXCD, r = nwg % NXCD, xcd = wgid % NXCD, off = wgid / NXCD; wgid = (xcd < r ? xcd * (q + 1) : r * (q + 1) + (xcd - r) * q) + off; }
        const int nig = WGM * nN, gid = wgid / nig, fm = gid * WGM, gsz = (nM - fm) < WGM ? (nM - fm) : WGM;
        u.pm = fm + ((wgid % nig) % gsz); u.pn = (wgid % nig) / gsz; return true;
    }
    __device__ __forceinline__ void a_ready(const Unit&) const {}
    __device__ __forceinline__ void done(const Unit&) const {}
};
template <class Epi, class Sched, bool ALIGN_EPI = false, bool SP2 = false>
__device__ __forceinline__ void gemm_phase(PG8_LAS unsigned char* lds, const Gemm g, const Sched& S, const Epi& E) {
    const int tid = threadIdx.x, wid = __builtin_amdgcn_readfirstlane(tid >> 6), lane = tid & 63, wr = wid >> 2, wc = wid & 3, fr = lane & 15, fq = lane >> 4;
    const int K = g.K, nt = K / BK;
    unsigned voffA[2], voffB[2];
#pragma unroll
    for (int i = 0; i < 2; ++i) { int R, C; stage_rc(tid * 16 + i * 8192, R, C); const int Rb = Epi::PERM ? ((R & ~31) + perm32(R & 31)) : R;
        voffA[i] = (unsigned)(R * K + C) * 2u; voffB[i] = (unsigned)(Rb * K + C) * 2u; }
    const size_t kstep = (size_t)(BK * 2);
    const size_t hstep = (size_t)HALF * K * 2;
    const size_t tstep = 2 * hstep;
    const unsigned ldsw = (unsigned)wid * 1024u;
    const int aoff = lds_byte(wr * 64 + fr, fq * 8), boff = lds_byte(wc * 32 + fr, fq * 8);
#define PG8_SA(b, h) (((b) * 2 + (h)) * HTB)
#define PG8_SB(b, h) ((4 + (b) * 2 + (h)) * HTB)
#define PG8_STAGE(bufoff, gbase, voff) do { _Pragma("unroll") for (int _i = 0; _i < 2; ++_i) \
        __builtin_amdgcn_global_load_lds((const unsigned*)((const char*)(gbase) + (voff)[_i]), (PG8_LAS unsigned*)(lds + (bufoff) + ldsw + _i * 8192), 16, 0, 0); } while (0)
#define PG8_LDA(dst, b, h) do { _Pragma("unroll") for (int m = 0; m < 4; ++m) _Pragma("unroll") for (int k = 0; k < 2; ++k) dst[m][k] = *(const PG8_LAS bf16x8*)(lds + PG8_SA(b, h) + aoff + m * 2048 + k * 1024); } while (0)
#define PG8_LDB(dst, b, h) do { _Pragma("unroll") for (int n = 0; n < 2; ++n) _Pragma("unroll") for (int k = 0; k < 2; ++k) dst[n][k] = *(const PG8_LAS bf16x8*)(lds + PG8_SB(b, h) + boff + n * 2048 + k * 1024); } while (0)
#define PG8_MMA(ai, bj, At, Bt) do { __builtin_amdgcn_s_setprio(1); _Pragma("unroll") for (int m = 0; m < 4; ++m) _Pragma("unroll") for (int n = 0; n < 2; ++n) _Pragma("unroll") for (int k = 0; k < 2; ++k) \
        acc[ai][bj][m][n] = __builtin_amdgcn_mfma_f32_16x16x32_bf16(Bt[n][k], At[m][k], acc[ai][bj][m][n], 0, 0, 0); __builtin_amdgcn_s_setprio(0); } while (0)
#define PG8_WAIT_V(n) asm volatile("s_waitcnt vmcnt(" #n ")" ::: "memory")
#define PG8_WAIT_L(n) asm volatile("s_waitcnt lgkmcnt(" #n ")" ::: "memory")
#define PG8_BAR __builtin_amdgcn_s_barrier()
#define PG8_SCHED __builtin_amdgcn_sched_barrier(0)
    Unit cur, nxt; int ui = 0;
    if (!S.next(0, cur)) return;
    f32x4 acc[2][2][4][2];
#pragma unroll
    for (int a = 0; a < 2; ++a)
#pragma unroll
        for (int b = 0; b < 2; ++b)
#pragma unroll
            for (int m = 0; m < 4; ++m)
#pragma unroll
                for (int n = 0; n < 2; ++n) acc[a][b][m][n] = (f32x4){0.f, 0.f, 0.f, 0.f};
    bf16x8 At[4][2], B0[2][2], B1[2][2];
    const char* cA = (const char*)g.A + (size_t)cur.pm * tstep; const char* cB = (const char*)g.Bt + (size_t)cur.pn * tstep;
    S.a_ready(cur);
    if constexpr (SP2) {
        PG8_STAGE(PG8_SB(0, 0), cB, voffB); PG8_STAGE(PG8_SB(0, 1), cB + hstep, voffB); PG8_STAGE(PG8_SA(0, 0), cA, voffA); PG8_STAGE(PG8_SA(0, 1), cA + hstep, voffA);
        if (wr == 1) PG8_BAR;
        PG8_WAIT_V(2); PG8_BAR;
        PG8_STAGE(PG8_SB(1, 0), cB + kstep, voffB); PG8_STAGE(PG8_SA(1, 0), cA + kstep, voffA); PG8_STAGE(PG8_SB(1, 1), cB + hstep + kstep, voffB);
        PG8_WAIT_V(6); PG8_BAR;
    } else {
        PG8_STAGE(PG8_SB(0, 0), cB, voffB); PG8_STAGE(PG8_SA(0, 0), cA, voffA); PG8_STAGE(PG8_SB(0, 1), cB + hstep, voffB); PG8_STAGE(PG8_SA(0, 1), cA + hstep, voffA);
        if (wr == 1) PG8_BAR;
        PG8_WAIT_V(4); PG8_BAR;
        PG8_STAGE(PG8_SB(1, 0), cB + kstep, voffB); PG8_STAGE(PG8_SA(1, 0), cA + kstep, voffA); PG8_STAGE(PG8_SB(1, 1), cB + hstep + kstep, voffB);
        PG8_WAIT_V(6); PG8_BAR;
    }
    for (;;) {
        const bool has_next = S.next(ui + 1, nxt);
        const char* nA = has_next ? (const char*)g.A + (size_t)nxt.pm * tstep : cA; const char* nB = has_next ? (const char*)g.Bt + (size_t)nxt.pn * tstep : cB;
        for (int t = 0; t < nt; t += 2) {
            const bool last = (t == nt - 2);
            const char* a1 = cA + (size_t)(t + 1) * kstep;
            const char* a2 = last ? nA : cA + (size_t)(t + 2) * kstep; const char* b2 = last ? nB : cB + (size_t)(t + 2) * kstep;
            const char* a3 = a2 + kstep; const char* b3 = b2 + kstep;
            if (last && has_next) S.a_ready(nxt);
            if constexpr (SP2) {
            PG8_LDB(B0, 0, 0); PG8_LDB(B1, 0, 1); PG8_SCHED; PG8_LDA(At, 0, 0); PG8_STAGE(PG8_SA(1, 1), a1 + hstep, voffA);
            PG8_WAIT_V(8); PG8_WAIT_L(0); PG8_BAR; PG8_MMA(0, 0, At, B0); PG8_MMA(0, 1, At, B1); PG8_BAR; PG8_SCHED;
            PG8_LDA(At, 0, 1); PG8_STAGE(PG8_SB(0, 0), b2, voffB); PG8_STAGE(PG8_SB(0, 1), b2 + hstep, voffB); PG8_STAGE(PG8_SA(0, 0), a2, voffA);
            PG8_WAIT_V(8); PG8_WAIT_L(0); PG8_BAR; PG8_MMA(1, 0, At, B0); PG8_MMA(1, 1, At, B1); PG8_BAR; PG8_SCHED;
            PG8_LDB(B0, 1, 0); PG8_LDB(B1, 1, 1); PG8_SCHED; PG8_LDA(At, 1, 0); PG8_STAGE(PG8_SA(0, 1), a2 + hstep, voffA);
            PG8_WAIT_V(8); PG8_WAIT_L(0); PG8_BAR; PG8_MMA(0, 0, At, B0); PG8_MMA(0, 1, At, B1); PG8_BAR; PG8_SCHED;
            PG8_LDA(At, 1, 1); PG8_STAGE(PG8_SB(1, 0), b3, voffB); PG8_STAGE(PG8_SB(1, 1), b3 + hstep, voffB); PG8_STAGE(PG8_SA(1, 0), a3, voffA);
            PG8_WAIT_V(8); PG8_WAIT_L(0); PG8_BAR; PG8_MMA(1, 0, At, B0); PG8_MMA(1, 1, At, B1); PG8_BAR; PG8_SCHED;
            } else {
            PG8_LDB(B0, 0, 0); PG8_SCHED; PG8_LDA(At, 0, 0); PG8_STAGE(PG8_SA(1, 1), a1 + hstep, voffA);
            PG8_WAIT_L(8); PG8_BAR; PG8_WAIT_L(0); PG8_MMA(0, 0, At, B0); PG8_BAR; PG8_SCHED;
            PG8_LDB(B1, 0, 1); PG8_STAGE(PG8_SB(0, 0), b2, voffB);
            PG8_BAR; PG8_WAIT_L(0); PG8_MMA(0, 1, At, B1); PG8_BAR;
            PG8_LDA(At, 0, 1); PG8_STAGE(PG8_SA(0, 0), a2, voffA);
            PG8_BAR; PG8_WAIT_L(0); PG8_MMA(1, 0, At, B0); PG8_BAR; PG8_SCHED;
            PG8_STAGE(PG8_SB(0, 1), b2 + hstep, voffB);
            PG8_WAIT_V(6); PG8_BAR; PG8_MMA(1, 1, At, B1); PG8_BAR;
            PG8_LDB(B0, 1, 0); PG8_SCHED; PG8_LDA(At, 1, 0); PG8_STAGE(PG8_SA(0, 1), a2 + hstep, voffA);
            PG8_WAIT_L(8); PG8_BAR; PG8_WAIT_L(0); PG8_MMA(0, 0, At, B0); PG8_BAR; PG8_SCHED;
            PG8_LDB(B1, 1, 1); PG8_STAGE(PG8_SB(1, 0), b3, voffB);
            PG8_BAR; PG8_WAIT_L(0); PG8_MMA(0, 1, At, B1); PG8_BAR;
            PG8_LDA(At, 1, 1); PG8_STAGE(PG8_SA(1, 0), a3, voffA);
            PG8_BAR; PG8_WAIT_L(0); PG8_MMA(1, 0, At, B0); PG8_BAR; PG8_SCHED;
            PG8_STAGE(PG8_SB(1, 1), b3 + hstep, voffB);
            PG8_WAIT_V(6); PG8_BAR; PG8_MMA(1, 1, At, B1); PG8_BAR;
            }
        }
        if constexpr (ALIGN_EPI) { if (wr == 0) PG8_BAR; }
        if constexpr (!Epi::AFTER_DRAIN) { E(acc, cur, wr, wc, fr, fq); S.done(cur); }
        if (!has_next) break;
#pragma unroll
        for (int a = 0; a < 2; ++a)
#pragma unroll
            for (int b = 0; b < 2; ++b)
#pragma unroll
                for (int m = 0; m < 4; ++m)
#pragma unroll
                    for (int n = 0; n < 2; ++n) acc[a][b][m][n] = (f32x4){0.f, 0.f, 0.f, 0.f};
        cur = nxt; cA = nA; cB = nB; ++ui;
        if constexpr (ALIGN_EPI) { if (wr == 1) PG8_BAR; }
    }
    PG8_WAIT_V(0);
    if constexpr (!ALIGN_EPI) { if (wr == 0) PG8_BAR; }
    PG8_BAR;
    if constexpr (Epi::AFTER_DRAIN) { E.fused(acc, cur, wr, wc, fr, fq, lds, wid, lane); S.done(cur); }
#undef PG8_SA
#undef PG8_SB
#undef PG8_STAGE
#undef PG8_LDA
#undef PG8_LDB
#undef PG8_MMA
#undef PG8_WAIT_V
#undef PG8_WAIT_L
#undef PG8_BAR
#undef PG8_SCHED
}
}


struct EpiInproj {
    static constexpr bool PERM = true, AFTER_DRAIN = false;
    bf16* ZA; bf16* ZB; bf16* Gt; const float* bias; const float* rope;
    __device__ __forceinline__ void operator()(const f32x4 (&acc)[2][2][4][2], const pg8::Unit& u, int wr, int wc, int fr, int fq) const {
        const int row0 = u.pm * 256 + wr * 64 + fr;
        const int q = 4 * (wc & 1) + fq;
#pragma unroll
        for (int bj = 0; bj < 2; ++bj) {
            const int colpos = u.pn * 256 + bj * 128 + wc * 32 + 8 * fq, hb = colpos & ~63;
            int kind; bf16* dst; int ldd;
            if (hb < A_W) { kind = hb / 1536; dst = ZA + colpos; ldd = A_W; }
            else if (hb < A_W + B_W) { const int cb = hb - A_W; kind = cb < 1024 ? 0 : (cb < 1152 ? 1 : 2); dst = ZB + (colpos - A_W); ldd = B_W; }
            else { kind = 3; dst = Gt + (colpos - A_W - B_W); ldd = G_W; }
            const f32x4 b0 = *(const f32x4*)(bias + (kind < 2 ? hb + 4 * q : colpos));
            const f32x4 b1 = *(const f32x4*)(bias + (kind < 2 ? hb + 32 + 4 * q : colpos + 4));
#pragma unroll
            for (int ai = 0; ai < 2; ++ai)
#pragma unroll
                for (int m = 0; m < 4; ++m) {
                    const int row = row0 + ai * 128 + m * 16;
                    f32x4 v0 = acc[ai][bj][m][0] + b0, v1 = acc[ai][bj][m][1] + b1;
                    if (kind < 2) {
                        const float* rp = rope + ((size_t)(row & (SEQ - 1)) * 32 + 4 * q) * 2;
                        const f32x4 r0 = *(const f32x4*)rp, r1 = *(const f32x4*)(rp + 4);
                        const f32x4 cc = {r0[0], r0[2], r1[0], r1[2]}, ss = {r0[1], r0[3], r1[1], r1[3]};
                        const f32x4 t0 = v0 * cc - v1 * ss, t1 = v1 * cc + v0 * ss;
                        v0 = t0; v1 = t1;
                        if (kind == 0) { v0 = v0 * QSCALE; v1 = v1 * QSCALE; }
                    } else if (kind == 3) {
#pragma unroll
                        for (int e = 0; e < 4; ++e) { v0[e] = 1.0f / (1.0f + __expf(-v0[e])); v1[e] = 1.0f / (1.0f + __expf(-v1[e])); }
                    }
                    v4u w; w.x = cvtpk(v0[0], v0[1]); w.y = cvtpk(v0[2], v0[3]); w.z = cvtpk(v1[0], v1[1]); w.w = cvtpk(v1[2], v1[3]);
                    *(GAS v4u*)(dst + (size_t)row * ldd) = w;
                }
        }
    }
};
__device__ __forceinline__ void p1_inproj(Frame& F, int ch) {
    unsigned char* ws = F.ws;
    pg8::Gemm g{(const bf16*)(ws + WS_HN) + (size_t)ch * TC * D, (const bf16*)(ws + WS_WIN), TC, NIN, D};
    pg8::StaticOrder S; S.init(TC, NIN, F.G, (int)blockIdx.x);
    EpiInproj E{(bf16*)(ws + WS_ZA), (bf16*)(ws + WS_ZB), (bf16*)(ws + WS_G) + (size_t)ch * TC * G_W, F.in[I_BIN], (const float*)(ws + WS_ROPE)};
    pg8::gemm_phase<EpiInproj, pg8::StaticOrder, true, true>(F.lds, g, S, E);
}

typedef float f32x16 __attribute__((ext_vector_type(16)));
typedef short v4i16_t __attribute__((ext_vector_type(4)));
__device__ __forceinline__ float half_max(float v) { auto rr = __builtin_amdgcn_permlane32_swap(__float_as_uint(v), __float_as_uint(v), false, false); return fmaxf(__uint_as_float(rr[0]), __uint_as_float(rr[1])); }
__device__ __forceinline__ float half_sum(float v) { auto rr = __builtin_amdgcn_permlane32_swap(__float_as_uint(v), __float_as_uint(v), false, false); return __uint_as_float(rr[0]) + __uint_as_float(rr[1]); }
constexpr int ATT_VOFF = 49152;

template <int KIND>
__device__ __forceinline__ void attn_unit(Frame& F, int ch, int u) {
    unsigned char* ws = F.ws;
    int tid_ = threadIdx.x; asm volatile("" : "+v"(tid_));
    const int tid = tid_, lane = tid & 63, w = F.wave, c = lane & 31, h = (lane >> 5) & 1;
    LAS unsigned char* KL = F.lds; LAS unsigned char* VL = F.lds + ATT_VOFF;
    constexpr int NP = KIND == 0 ? 6 : 3;
    constexpr int NKEYS = KIND == 0 ? 384 : 160;
    const bf16 *Kw, *Vw, *Qp; size_t pitch; int kk_lo, kb0, kstart; float m, l;
    bf16* Op; float* Lp = nullptr;
    if (KIND == 0) {
        const bf16* ZA = (const bf16*)(ws + WS_ZA);
        const int rt = u & 15, hh = (u >> 4) & 7, gb = u >> 7, g = gb % 3, bl = gb / 3;
        const int dsh = 2 * g, d = 1 << dsh;
        const int tsh = 4 - dsh;
        const int r = rt >> tsh, tile = rt & ((1 << tsh) - 1), i0 = tile * 256;
        const int rowb = bl * SEQ + r;
        const int col = g * 512 + hh * 64;
        pitch = (size_t)d * A_W;
        Kw = ZA + ((long)rowb + (long)d * (i0 - 128)) * A_W + 1536 + col;
        Vw = Kw + 1536;
        const long qrow = (long)rowb + (long)d * (i0 + 32 * w + c);
        Qp = ZA + qrow * A_W + col;
        kk_lo = (i0 == 0) ? 128 : 0;
        kb0 = w; kstart = (i0 == 0) ? (w < 4 ? 4 - w : 0) : 0;
        m = -1e30f; l = 0.f;
        Op = (bf16*)(ws + WS_OG) + ((size_t)g * TC + qrow) * 512 + hh * 64;
        Lp = (float*)(ws + WS_LSE) + ((size_t)g * TC + qrow) * 8 + hh;
    } else {
        const bf16* ZB = (const bf16*)(ws + WS_ZB);
        const int blk = u & 127, kvh = (u >> 7) & 1, bl = u >> 8;
        const int t0 = blk * 32, rowb = bl * SEQ;
        pitch = B_W;
        Kw = ZB + ((long)rowb + t0 - 128) * B_W + 1024 + kvh * 64;
        Vw = Kw + 128;
        const int qh = kvh * 8 + w;
        const long qrow = (long)rowb + t0 + c;
        Qp = ZB + qrow * B_W + qh * 64;
        kk_lo = t0 < 128 ? 128 - t0 : 0;
        kb0 = 0; kstart = kk_lo >> 5;
        m = F.in[I_SINK][qh] * LOG2E; l = h == 0 ? 1.f : 0.f;
        Op = (bf16*)(ws + WS_Y) + ((size_t)ch * TC + qrow) * Y_W + 512 + qh * 64;
    }
    {
        const int skey = tid >> 3, sch = tid & 7;
        v4u kreg[NP], vreg[NP];
#pragma unroll
        for (int p = 0; p < NP; ++p) { const int kk = 64 * p + skey;
            if (kk >= kk_lo && kk < NKEYS) { kreg[p] = *(const GAS v4u*)(Kw + (size_t)kk * pitch + 8 * sch); vreg[p] = *(const GAS v4u*)(Vw + (size_t)kk * pitch + 8 * sch); } }
#pragma unroll
        for (int p = 0; p < NP; ++p) { const int kk = 64 * p + skey;
            if (kk >= kk_lo && kk < NKEYS) {
                *(LAS v4u*)(KL + kk * 128 + ((sch ^ ((kk >> 1) & 7)) << 4)) = kreg[p];
                *(LAS v4u*)(VL + kk * 128 + ((sch * 16) ^ (((kk >> 1) & 1) << 6))) = vreg[p]; } }
    }
    bf16x8 qf[4];
#pragma unroll
    for (int s4 = 0; s4 < 4; ++s4) qf[s4] = *(const GAS bf16x8*)(Qp + 16 * s4 + 8 * h);
    __syncthreads();
    int koff[4];
    { const int kswz = (c >> 1) & 7;
#pragma unroll
      for (int s4 = 0; s4 < 4; ++s4) koff[s4] = c * 128 + (((2 * s4 + h) ^ kswz) << 4); }
    const int vrow = 4 * h + ((lane & 15) >> 2), vsw = (lane >> 3) & 1;
    const int voff0 = vrow * 128 + ((32 * ((lane >> 4) & 1) + 8 * (lane & 3)) ^ (vsw << 6)), voff1 = voff0 ^ 64;
    const float NEG = -INFINITY;
    f32x16 o0, o1;
#pragma unroll
    for (int i = 0; i < 16; ++i) { o0[i] = 0.f; o1[i] = 0.f; }
    const LAS unsigned char* kbp = KL + kb0 * 4096; const LAS unsigned char* vbp = VL + kb0 * 4096;
#pragma unroll
    for (int kbi = 0; kbi < 5; ++kbi) {
        if (kbi >= kstart) {
            f32x16 p;
#pragma unroll
            for (int i = 0; i < 16; ++i) p[i] = 0.f;
#pragma unroll
            for (int s4 = 0; s4 < 4; ++s4) { const bf16x8 kf = *(const LAS bf16x8*)(kbp + kbi * 4096 + koff[s4]); p = __builtin_amdgcn_mfma_f32_32x32x16_bf16(kf, qf[s4], p, 0, 0, 0); }
            if (kbi == 0) {
#pragma unroll
                for (int i = 0; i < 16; ++i) { const int x = (i & 3) + 8 * (i >> 2) + 4 * h; if (x < c + (KIND == 0 ? 0 : 1)) p[i] = NEG; }
            }
            if (kbi == 4) {
#pragma unroll
                for (int i = 0; i < 16; ++i) { const int x = (i & 3) + 8 * (i >> 2) + 4 * h; if (x > c) p[i] = NEG; }
            }
            float mt = p[0];
#pragma unroll
            for (int i = 1; i < 16; ++i) mt = fmaxf(mt, p[i]);
            mt = half_max(mt);
            const float mn = fmaxf(m, mt), alpha = __builtin_amdgcn_exp2f(m - mn);
            m = mn;
            float ps = 0.f;
#pragma unroll
            for (int i = 0; i < 16; ++i) { p[i] = __builtin_amdgcn_exp2f(p[i] - mn); ps += p[i]; }
            l = l * alpha + ps;
#pragma unroll
            for (int i = 0; i < 16; ++i) { o0[i] *= alpha; o1[i] *= alpha; }
            bf16x8 pb[2];
#pragma unroll
            for (int s2 = 0; s2 < 2; ++s2) { v4u t; t.x = cvtpk(p[8 * s2 + 0], p[8 * s2 + 1]); t.y = cvtpk(p[8 * s2 + 2], p[8 * s2 + 3]); t.z = cvtpk(p[8 * s2 + 4], p[8 * s2 + 5]); t.w = cvtpk(p[8 * s2 + 6], p[8 * s2 + 7]); pb[s2] = __builtin_bit_cast(bf16x8, t); }
#pragma unroll
            for (int s2 = 0; s2 < 2; ++s2) {
#pragma unroll
                for (int db = 0; db < 2; ++db) {
                    const LAS unsigned char* vp = vbp + kbi * 4096 + s2 * 2048 + (db ? voff1 : voff0);
                    const v4i16_t lo = __builtin_amdgcn_ds_read_tr16_b64_v4i16((LAS v4i16_t*)vp);
                    const v4i16_t hi = __builtin_amdgcn_ds_read_tr16_b64_v4i16((LAS v4i16_t*)(vp + 1024));
                    const bf16x8 vf = {lo[0], lo[1], lo[2], lo[3], hi[0], hi[1], hi[2], hi[3]};
                    if (db == 0) o0 = __builtin_amdgcn_mfma_f32_32x32x16_bf16(vf, pb[s2], o0, 0, 0, 0);
                    else o1 = __builtin_amdgcn_mfma_f32_32x32x16_bf16(vf, pb[s2], o1, 0, 0, 0);
                }
            }
        }
    }
    const float lt = half_sum(l), inv = 1.0f / lt;
#pragma unroll
    for (int g4 = 0; g4 < 4; ++g4) {
        v2u a, b;
        a.x = cvtpk(o0[4 * g4 + 0] * inv, o0[4 * g4 + 1] * inv); a.y = cvtpk(o0[4 * g4 + 2] * inv, o0[4 * g4 + 3] * inv);
        b.x = cvtpk(o1[4 * g4 + 0] * inv, o1[4 * g4 + 1] * inv); b.y = cvtpk(o1[4 * g4 + 2] * inv, o1[4 * g4 + 3] * inv);
        *(GAS v2u*)(Op + 8 * g4 + 4 * h) = a;
        *(GAS v2u*)(Op + 32 + 8 * g4 + 4 * h) = b;
    }
    if (KIND == 0) { if (h == 0) *Lp = m + __builtin_amdgcn_logf(lt); }
    __syncthreads();
}
__device__ __forceinline__ void p2_attn(Frame& F, int ch) {
    constexpr int NUA = (TC / SEQ) * 3 * 8 * 16, NUB = (TC / SEQ) * 2 * 128;
    for (int u = F.vcu; u < NUA + NUB; u += F.G) {
        if (u < NUA) attn_unit<0>(F, ch, u); else attn_unit<1>(F, ch, u - NUA);
    }
}
__device__ __forceinline__ void p2_combine(Frame& F, int ch) {
    int tid_ = threadIdx.x; asm volatile("" : "+v"(tid_)); const int lane_ = tid_ & 63;
    unsigned char* ws = F.ws;
    const bf16* OG = (const bf16*)(ws + WS_OG); const float* LSE = (const float*)(ws + WS_LSE);
    bf16* Y = (bf16*)(ws + WS_Y) + (size_t)ch * TC * Y_W;
    const int lane = lane_, hd = lane >> 3;
    const int gw = F.vcu * NWAVES + F.wave, NGW = F.G * NWAVES;
    for (int row = gw; row < TC; row += NGW) {
        float lg[3]; v4u og[3];
#pragma unroll
        for (int g = 0; g < 3; ++g) { lg[g] = LSE[((size_t)g * TC + row) * 8 + hd]; og[g] = *(const GAS v4u*)(OG + ((size_t)g * TC + row) * 512 + lane * 8); }
        const float mx = fmaxf(fmaxf(lg[0], lg[1]), lg[2]);
        float e[3]; e[0] = __builtin_amdgcn_exp2f(lg[0] - mx); e[1] = __builtin_amdgcn_exp2f(lg[1] - mx); e[2] = __builtin_amdgcn_exp2f(lg[2] - mx);
        const float inv = 1.0f / (e[0] + e[1] + e[2]);
        float acc[8];
#pragma unroll
        for (int i = 0; i < 8; ++i) acc[i] = 0.f;
#pragma unroll
        for (int g = 0; g < 3; ++g) { const float wg = e[g] * inv;
            acc[0] += wg * bflo(og[g].x); acc[1] += wg * bfhi(og[g].x); acc[2] += wg * bflo(og[g].y); acc[3] += wg * bfhi(og[g].y);
            acc[4] += wg * bflo(og[g].z); acc[5] += wg * bfhi(og[g].z); acc[6] += wg * bflo(og[g].w); acc[7] += wg * bfhi(og[g].w); }
        v4u o; o.x = cvtpk(acc[0], acc[1]); o.y = cvtpk(acc[2], acc[3]); o.z = cvtpk(acc[4], acc[5]); o.w = cvtpk(acc[6], acc[7]);
        *(GAS v4u*)(Y + (size_t)row * Y_W + lane * 8) = o;
    }
}


namespace pg9 {
using pg8::BM; using pg8::BK; using pg8::HALF; using pg8::HTB; using pg8::lds_byte; using pg8::stage_rc; using pg8::perm32;
struct Unit { int pm, pn, e; };
template <class Epi, class Sched, class AOff, class BBase>
__device__ __forceinline__ void gemm_phase(LAS unsigned char* lds, const char* Abase, int K, const Sched& S, const Epi& E, const AOff& aoffn, const BBase& bbase) {
    int tid_ = threadIdx.x; asm volatile("" : "+v"(tid_));
    const int tid = tid_, wid = __builtin_amdgcn_readfirstlane(tid >> 6), lane = tid & 63, wr = wid >> 2, wc = wid & 3, fr = lane & 15, fq = lane >> 4;
    const int nt = K / BK;
    int Rr[2], Cc[2]; unsigned voffB[2];
#pragma unroll
    for (int i = 0; i < 2; ++i) { int R, C; stage_rc(tid * 16 + i * 8192, R, C); const int Rb = Epi::PERM ? ((R & ~31) + perm32(R & 31)) : R; Rr[i] = R; Cc[i] = C; voffB[i] = (unsigned)(Rb * K + C) * 2u; }
    const size_t kstep = (size_t)(BK * 2);
    const size_t hstep = (size_t)HALF * K * 2;
    const unsigned ldsw = (unsigned)wid * 1024u;
    const int aoff = lds_byte(wr * 64 + fr, fq * 8), boff = lds_byte(wc * 32 + fr, fq * 8);
#define PG9_SA(b, h) (((b) * 2 + (h)) * HTB)
#define PG9_SB(b, h) ((4 + (b) * 2 + (h)) * HTB)
#define PG9_STAGE(bufoff, gbase, voff) do { _Pragma("unroll") for (int _i = 0; _i < 2; ++_i) \
        __builtin_amdgcn_global_load_lds((const unsigned*)((const char*)(gbase) + (voff)[_i]), (LAS unsigned*)(lds + (bufoff) + ldsw + _i * 8192), 16, 0, 0); } while (0)
#define PG9_LDA(dst, b, h) do { _Pragma("unroll") for (int m = 0; m < 4; ++m) _Pragma("unroll") for (int k = 0; k < 2; ++k) dst[m][k] = *(const LAS bf16x8*)(lds + PG9_SA(b, h) + aoff + m * 2048 + k * 1024); } while (0)
#define PG9_LDB(dst, b, h) do { _Pragma("unroll") for (int n = 0; n < 2; ++n) _Pragma("unroll") for (int k = 0; k < 2; ++k) dst[n][k] = *(const LAS bf16x8*)(lds + PG9_SB(b, h) + boff + n * 2048 + k * 1024); } while (0)
#define PG9_MMA(ai, bj, At, Bt) do { __builtin_amdgcn_s_setprio(1); _Pragma("unroll") for (int m = 0; m < 4; ++m) _Pragma("unroll") for (int n = 0; n < 2; ++n) _Pragma("unroll") for (int k = 0; k < 2; ++k) \
        acc[ai][bj][m][n] = __builtin_amdgcn_mfma_f32_16x16x32_bf16(Bt[n][k], At[m][k], acc[ai][bj][m][n], 0, 0, 0); __builtin_amdgcn_s_setprio(0); } while (0)
#define PG9_WAIT_V(n) asm volatile("s_waitcnt vmcnt(" #n ")" ::: "memory")
#define PG9_WAIT_L(n) asm volatile("s_waitcnt lgkmcnt(" #n ")" ::: "memory")
#define PG9_BAR __builtin_amdgcn_s_barrier()
#define PG9_SCHED __builtin_amdgcn_sched_barrier(0)
#define PG9_VA(dst, u) do { _Pragma("unroll") for (int _h = 0; _h < 2; ++_h) _Pragma("unroll") for (int _i = 0; _i < 2; ++_i) dst[_h][_i] = aoffn((u), _h * HALF + Rr[_i]) + (unsigned)(Cc[_i] * 2); } while (0)
    Unit cur, nxt; int ui = 0;
    if (!S.next(0, cur)) return;
    f32x4 acc[2][2][4][2];
#pragma unroll
    for (int a = 0; a < 2; ++a)
#pragma unroll
        for (int b = 0; b < 2; ++b)
#pragma unroll
            for (int m = 0; m < 4; ++m)
#pragma unroll
                for (int n = 0; n < 2; ++n) acc[a][b][m][n] = (f32x4){0.f, 0.f, 0.f, 0.f};
    bf16x8 At[4][2], B0[2][2], B1[2][2];
    unsigned cvA[2][2], nvA[2][2];
    PG9_VA(cvA, cur);
    const char* cB = bbase(cur);
    PG9_STAGE(PG9_SB(0, 0), cB, voffB); PG9_STAGE(PG9_SB(0, 1), cB + hstep, voffB); PG9_STAGE(PG9_SA(0, 0), Abase, cvA[0]); PG9_STAGE(PG9_SA(0, 1), Abase, cvA[1]);
    if (wr == 1) PG9_BAR;
    PG9_WAIT_V(2); PG9_BAR;
    PG9_STAGE(PG9_SB(1, 0), cB + kstep, voffB); PG9_STAGE(PG9_SA(1, 0), Abase + kstep, cvA[0]); PG9_STAGE(PG9_SB(1, 1), cB + hstep + kstep, voffB);
    PG9_WAIT_V(6); PG9_BAR;
    for (;;) {
        const bool has_next = S.next(ui + 1, nxt);
        if (has_next) { PG9_VA(nvA, nxt); } else {
#pragma unroll
            for (int _h = 0; _h < 2; ++_h)
#pragma unroll
                for (int _i = 0; _i < 2; ++_i) nvA[_h][_i] = cvA[_h][_i]; }
        const char* nB = has_next ? bbase(nxt) : cB;
        for (int t = 0; t < nt; t += 2) {
            const bool last = (t == nt - 2);
            if (Epi::HOOK_T >= 0) { if (t == Epi::HOOK_T) E.hook(acc, cur, wr, wc, fr, fq); }
            const char* a1 = Abase + (size_t)(t + 1) * kstep;
            const char* a2 = last ? Abase : Abase + (size_t)(t + 2) * kstep; const char* b2 = last ? nB : cB + (size_t)(t + 2) * kstep;
            const char* a3 = a2 + kstep; const char* b3 = b2 + kstep;
            unsigned v2[2][2];
#pragma unroll
            for (int _h = 0; _h < 2; ++_h)
#pragma unroll
                for (int _i = 0; _i < 2; ++_i) v2[_h][_i] = last ? nvA[_h][_i] : cvA[_h][_i];
            PG9_LDB(B0, 0, 0); PG9_LDB(B1, 0, 1); PG9_SCHED; PG9_LDA(At, 0, 0); PG9_STAGE(PG9_SA(1, 1), a1, cvA[1]);
            PG9_WAIT_V(8); PG9_WAIT_L(0); PG9_BAR; PG9_MMA(0, 0, At, B0); PG9_MMA(0, 1, At, B1); PG9_BAR; PG9_SCHED;
            PG9_LDA(At, 0, 1); PG9_STAGE(PG9_SB(0, 0), b2, voffB); PG9_STAGE(PG9_SB(0, 1), b2 + hstep, voffB); PG9_STAGE(PG9_SA(0, 0), a2, v2[0]);
            PG9_WAIT_V(8); PG9_WAIT_L(0); PG9_BAR; PG9_MMA(1, 0, At, B0); PG9_MMA(1, 1, At, B1); PG9_BAR; PG9_SCHED;
            PG9_LDB(B0, 1, 0); PG9_LDB(B1, 1, 1); PG9_SCHED; PG9_LDA(At, 1, 0); PG9_STAGE(PG9_SA(0, 1), a2, v2[1]);
            PG9_WAIT_V(8); PG9_WAIT_L(0); PG9_BAR; PG9_MMA(0, 0, At, B0); PG9_MMA(0, 1, At, B1); PG9_BAR; PG9_SCHED;
            PG9_LDA(At, 1, 1); PG9_STAGE(PG9_SB(1, 0), b3, voffB); PG9_STAGE(PG9_SB(1, 1), b3 + hstep, voffB); PG9_STAGE(PG9_SA(1, 0), a3, v2[0]);
            PG9_WAIT_V(8); PG9_WAIT_L(0); PG9_BAR; PG9_MMA(1, 0, At, B0); PG9_MMA(1, 1, At, B1); PG9_BAR; PG9_SCHED;
        }
        if (wr == 0) PG9_BAR;
        E(acc, cur, wr, wc, fr, fq);
        if (!has_next) break;
#pragma unroll
        for (int a = 0; a < 2; ++a)
#pragma unroll
            for (int b = 0; b < 2; ++b)
#pragma unroll
                for (int m = 0; m < 4; ++m)
#pragma unroll
                    for (int n = 0; n < 2; ++n) acc[a][b][m][n] = (f32x4){0.f, 0.f, 0.f, 0.f};
        cur = nxt; cB = nB; ++ui;
#pragma unroll
        for (int _h = 0; _h < 2; ++_h)
#pragma unroll
            for (int _i = 0; _i < 2; ++_i) cvA[_h][_i] = nvA[_h][_i];
        if (wr == 1) PG9_BAR;
    }
    PG9_WAIT_V(0);
    PG9_BAR;
#undef PG9_SA
#undef PG9_SB
#undef PG9_STAGE
#undef PG9_LDA
#undef PG9_LDB
#undef PG9_MMA
#undef PG9_WAIT_V
#undef PG9_WAIT_L
#undef PG9_BAR
#undef PG9_SCHED
#undef PG9_VA
}
struct DenseOrder { pg8::StaticOrder so;
    __device__ void init(int M, int N, int G, int c) { so.init(M, N, G, c); }
    __device__ bool next(int i, Unit& u) const { pg8::Unit v; if (!so.next(i, v)) return false; u.pm = v.pm; u.pn = v.pn; u.e = 0; return true; } };
struct DenseA { unsigned rowbytes; __device__ __forceinline__ unsigned operator()(const Unit& u, int row) const { return (unsigned)(u.pm * 256 + row) * rowbytes; } };
struct DenseB { const char* Bt; size_t tilebytes; __device__ __forceinline__ const char* operator()(const Unit& u) const { return Bt + (size_t)u.pn * tilebytes; } };
}

struct EpiMerge {
    static constexpr bool PERM = true; static constexpr int HOOK_T = 8;
    const bf16* Gt; bf16* MG;
    __device__ __forceinline__ void hook(f32x4 (&acc)[2][2][4][2], const pg9::Unit& u, int wr, int wc, int fr, int fq) const {
        const bf16* gr = Gt + (size_t)(u.pm * 256 + wr * 64 + fr) * G_W + u.pn * 256 + wc * 32 + 8 * fq;
#pragma unroll
        for (int ai = 0; ai < 2; ++ai)
#pragma unroll
            for (int m = 0; m < 4; ++m) {
                asm volatile("" : "+v"(gr));
#pragma unroll
                for (int bj = 0; bj < 2; ++bj) { const v4u a = *(const GAS v4u*)(gr + bj * 128), b = *(const GAS v4u*)(gr + 1024 + bj * 128);
                    f32x4 r0, r1;
                    r0[0] = bflo(a.x) / bflo(b.x); r0[1] = bfhi(a.x) / bfhi(b.x); r0[2] = bflo(a.y) / bflo(b.y); r0[3] = bfhi(a.y) / bfhi(b.y);
                    r1[0] = bflo(a.z) / bflo(b.z); r1[1] = bfhi(a.z) / bfhi(b.z); r1[2] = bflo(a.w) / bflo(b.w); r1[3] = bfhi(a.w) / bfhi(b.w);
                    acc[ai][bj][m][0] = acc[ai][bj][m][0] * r0; acc[ai][bj][m][1] = acc[ai][bj][m][1] * r1; }
                gr += (m == 3 ? (128 - 48) : 16) * G_W; }
    }
    __device__ __forceinline__ void operator()(const f32x4 (&acc)[2][2][4][2], const pg9::Unit& u, int wr, int wc, int fr, int fq) const {
        const bf16* gr = Gt + (size_t)(u.pm * 256 + wr * 64 + fr) * G_W + 1024 + u.pn * 256 + wc * 32 + 8 * fq;
        bf16* mr = MG + (size_t)(u.pm * 256 + wr * 64 + fr) * D + u.pn * 256 + wc * 32 + 8 * fq;
#pragma unroll
        for (int ai = 0; ai < 2; ++ai)
#pragma unroll
            for (int m = 0; m < 4; ++m) {
                asm volatile("" : "+v"(gr), "+v"(mr));
#pragma unroll
                for (int bj = 0; bj < 2; ++bj) { const v4u b = *(const GAS v4u*)(gr + bj * 128);
                    const f32x4 v0 = acc[ai][bj][m][0], v1 = acc[ai][bj][m][1];
                    v4u w; w.x = cvtpk(v0[0] * bflo(b.x), v0[1] * bfhi(b.x)); w.y = cvtpk(v0[2] * bflo(b.y), v0[3] * bfhi(b.y));
                    w.z = cvtpk(v1[0] * bflo(b.z), v1[1] * bfhi(b.z)); w.w = cvtpk(v1[2] * bflo(b.w), v1[3] * bfhi(b.w));
                    *(GAS v4u*)(mr + bj * 128) = w; }
                gr += (m == 3 ? (128 - 48) : 16) * G_W; mr += (m == 3 ? (128 - 48) : 16) * D; }
    }
};
__device__ __forceinline__ void p3_merge(Frame& F) {
    unsigned char* ws = F.ws;
    pg9::DenseOrder S; S.init(T, D, F.G, (int)blockIdx.x);
    EpiMerge E{(const bf16*)(ws + WS_G), (bf16*)(ws + WS_MG)};
    pg9::DenseA ao{(unsigned)(Y_W * 2)}; pg9::DenseB bb{(const char*)(ws + WS_WAB), (size_t)256 * Y_W * 2};
    pg9::gemm_phase(F.lds, (const char*)(ws + WS_Y), Y_W, S, E, ao, bb);
}
struct EpiOut {
    static constexpr bool PERM = false; static constexpr int HOOK_T = -1;
    const float* X; float* X1;
    __device__ __forceinline__ void hook(f32x4 (&)[2][2][4][2], const pg9::Unit&, int, int, int, int) const {}
    __device__ __forceinline__ void operator()(const f32x4 (&acc)[2][2][4][2], const pg9::Unit& u, int wr, int wc, int fr, int fq) const {
        const int row0 = u.pm * 256 + wr * 64 + fr, col0 = u.pn * 256 + wc * 32 + 4 * fq;
#pragma unroll
        for (int ai = 0; ai < 2; ++ai)
#pragma unroll
            for (int m = 0; m < 4; ++m) { const size_t off = (size_t)(row0 + ai * 128 + m * 16) * D + col0;
#pragma unroll
                for (int bj = 0; bj < 2; ++bj)
#pragma unroll
                    for (int n = 0; n < 2; ++n) { const f32x4 xv = *(const GAS f32x4*)(X + off + bj * 128 + n * 16); *(GAS f32x4*)(X1 + off + bj * 128 + n * 16) = xv + acc[ai][bj][m][n]; }
                asm volatile("" ::: "memory"); }
    }
};
__device__ __forceinline__ void p4_outproj(Frame& F) {
    unsigned char* ws = F.ws;
    pg9::DenseOrder S; S.init(T, D, F.G, (int)blockIdx.x);
    EpiOut E{F.in[I_X], F.out};
    pg9::DenseA ao{(unsigned)(D * 2)}; pg9::DenseB bb{(const char*)(ws + WS_WO), (size_t)256 * D * 2};
    pg9::gemm_phase(F.lds, (const char*)(ws + WS_MG), D, S, E, ao, bb);
}

__device__ __forceinline__ void p5_route(Frame& F) {
    int tid_ = threadIdx.x; asm volatile("" : "+v"(tid_)); const int lane_ = tid_ & 63;
    unsigned char* ws = F.ws;
    const float* X1 = F.out; bf16* H2 = (bf16*)(ws + WS_HN);
    const float* WRT = (const float*)(ws + WS_WRT);
    unsigned* cnt = (unsigned*)(ws + WS_CTL) + CW_CNT;
    int* tokof = (int*)(ws + WS_TOKOF); float* wtof = (float*)(ws + WS_WTOF); int4* tpos = (int4*)(ws + WS_TPOS);
    const int lane = lane_;
    const int gw = F.vcu * NWAVES + F.wave, NGW = F.G * NWAVES;
    const GAS f32x4* gr = (const GAS f32x4*)F.in[I_GFFN] + lane;
    for (int row = gw; row < T; row += NGW) {
        const GAS f32x4* xr = (const GAS f32x4*)(X1 + (size_t)row * D) + lane;
        f32x4 v[4]; float s = 0.f;
#pragma unroll
        for (int j = 0; j < 4; ++j) { v[j] = xr[64 * j]; s += (v[j].x * v[j].x + v[j].y * v[j].y) + (v[j].z * v[j].z + v[j].w * v[j].w); }
        const float rstd = 1.0f / sqrtf(wave_sum(s) * (1.f / D) + RMS_EPS);
        GAS v2u* o8 = (GAS v2u*)(H2 + (size_t)row * D) + lane;
#pragma unroll
        for (int j = 0; j < 4; ++j) { const f32x4 gg = gr[64 * j]; v[j].x *= rstd * gg.x; v[j].y *= rstd * gg.y; v[j].z *= rstd * gg.z; v[j].w *= rstd * gg.w;
            v2u w; w.x = pk2(v[j].x, v[j].y); w.y = pk2(v[j].z, v[j].w); o8[64 * j] = w; }
        float lg[36];
#pragma unroll
        for (int o = 0; o < 36; ++o) {
            const GAS f32x4* wr_ = (const GAS f32x4*)(WRT + o * 1024) + lane; float p = 0.f;
#pragma unroll
            for (int j = 0; j < 4; ++j) { const f32x4 w = wr_[64 * j]; p += (v[j].x * w.x + v[j].y * w.y) + (v[j].z * w.z + v[j].w * w.w); }
            lg[o] = wave_sum(p) + (o < 4 ? F.in[I_BRG][o] : F.in[I_BRE][o - 4]);
            asm volatile("" ::: "memory");
        }
        int gsel = 0; float gmax = lg[0];
#pragma unroll
        for (int i = 1; i < 4; ++i) if (lg[i] > gmax) { gmax = lg[i]; gsel = i; }
        float gden = 0.f;
#pragma unroll
        for (int i = 0; i < 4; ++i) gden += __expf(lg[i] - gmax);
        const float pg = 1.0f / gden;
        float le[8];
#pragma unroll
        for (int j = 0; j < 8; ++j) { le[j] = lg[4 + j];
#pragma unroll
            for (int gi = 1; gi < 4; ++gi) le[j] = (gsel == gi) ? lg[4 + gi * 8 + j] : le[j]; }
        int i1 = 0; float m1 = le[0];
#pragma unroll
        for (int j = 1; j < 8; ++j) if (le[j] > m1) { m1 = le[j]; i1 = j; }
        int i2 = -1; float m2 = -INFINITY;
#pragma unroll
        for (int j = 0; j < 8; ++j) if (j != i1 && le[j] > m2) { m2 = le[j]; i2 = j; }
        const float e2 = __expf(m2 - m1);
        const float w1 = pg / (1.0f + e2), w2 = pg * e2 / (1.0f + e2);
        if (lane == 0) {
            const int e0 = gsel * 8 + i1, e1 = gsel * 8 + i2;
            const int p0 = (int)atomicAdd(&cnt[e0], 1u), p1 = (int)atomicAdd(&cnt[e1], 1u);
            tokof[(size_t)e0 * T + p0] = row; wtof[(size_t)e0 * T + p0] = w1;
            tokof[(size_t)e1 * T + p1] = row; wtof[(size_t)e1 * T + p1] = w2;
            tpos[row] = make_int4(e0, p0, e1, p1);
        }
    }
}

__device__ __forceinline__ void expert_tiles(Frame& F, LAS int* tb, LAS int* cn) {
    int tid_ = threadIdx.x; asm volatile("" : "+v"(tid_)); const int lane_ = tid_ & 63;
    if (tid_ == 0) {
        const unsigned* cnt = (const unsigned*)(F.ws + WS_CTL) + CW_CNT;
        int acc = 0;
        for (int e = 0; e < NE; ++e) { const int c = (int)__hip_atomic_load(cnt + e, __ATOMIC_RELAXED, __HIP_MEMORY_SCOPE_AGENT); cn[e] = c; tb[e] = acc; acc += (c + 255) >> 8; }
        tb[NE] = acc;
    }
    __syncthreads();
}

__device__ __forceinline__ void p6a_gateup(Frame& F) {
    int tid_ = threadIdx.x; asm volatile("" : "+v"(tid_)); const int lane_ = tid_ & 63;
    unsigned char* ws = F.ws;
    LAS int* tb = (LAS int*)(F.lds + LDS_MISC + 1024); LAS int* cn = tb + 64;
    expert_tiles(F, tb, cn);
    const bf16* H2 = (const bf16*)(ws + WS_HN); const bf16* Wgu = (const bf16*)(ws + WS_WGU); bf16* HACT = (bf16*)(ws + WS_HACT);
    const int* tokof = (const int*)(ws + WS_TOKOF); const float* wtof = (const float*)(ws + WS_WTOF);
    const int wid = F.wave, lane = lane_, wr = wid >> 1, wc = wid & 1, fr = lane & 15, fq = lane >> 4;
    const int NU = tb[NE] * 4;
    for (int u = F.vcu; u < NU; u += F.G) {
        const int rt = u >> 2, ct = u & 3;
        int e = 0;
        for (int i = 1; i < NE; ++i) if (tb[i] <= rt) e = i;
        const int ce = cn[e], p0 = (rt - tb[e]) * 256;
        const int ar = tid_ >> 2, ac = (tid_ & 3) * 8;
        const int pa0 = p0 + ar, pa1 = p0 + ar + 128;
        const int tk0 = tokof[(size_t)e * T + (pa0 < ce ? pa0 : 0)], tk1 = tokof[(size_t)e * T + (pa1 < ce ? pa1 : 0)];
        const bf16* a0 = H2 + (size_t)tk0 * D + ac; const bf16* a1 = H2 + (size_t)tk1 * D + ac;
        const bf16* b0 = Wgu + ((size_t)e * 512 + ct * 128 + ar) * D + ac;
        f32x4 acc[4][4]; zero_acc(acc);
        sg_kloop(F.lds, acc, a0, a1, b0, D / 32, wid, lane);
#pragma unroll
        for (int m = 0; m < 4; ++m)
#pragma unroll
            for (int j = 0; j < 4; ++j) {
                const int r = wr * 64 + m * 16 + fq * 4 + j, p = p0 + r;
                const float w = p < ce ? wtof[(size_t)e * T + p] : 0.f;
                bf16* orow = HACT + (size_t)(rt * 256 + r) * DE + ct * 64 + wc * 32 + fr;
#pragma unroll
                for (int n = 0; n < 2; ++n) { const float g = acc[m][n][j], uu = acc[m][n + 2][j]; const float hv = g / (1.0f + __expf(-g)) * uu * w; orow[n * 16] = (bf16)f2bf(hv); }
            }
    }
}
__device__ __forceinline__ void p6b_down(Frame& F) {
    int tid_ = threadIdx.x; asm volatile("" : "+v"(tid_)); const int lane_ = tid_ & 63;
    unsigned char* ws = F.ws;
    LAS int* tb = (LAS int*)(F.lds + LDS_MISC + 1024); LAS int* cn = tb + 64;
    expert_tiles(F, tb, cn);
    const bf16* HACT = (const bf16*)(ws + WS_HACT); const bf16* Wd = (const bf16*)(ws + WS_WD); bf16* YS = (bf16*)(ws + WS_YS);
    const int wid = F.wave, lane = lane_, wr = wid >> 1, wc = wid & 1, fr = lane & 15, fq = lane >> 4;
    const int NU = tb[NE] * 8;
    for (int u = F.vcu; u < NU; u += F.G) {
        const int rt = u >> 3, ct = u & 7;
        int e = 0;
        for (int i = 1; i < NE; ++i) if (tb[i] <= rt) e = i;
        const int ar = tid_ >> 2, ac = (tid_ & 3) * 8;
        const bf16* a0 = HACT + (size_t)(rt * 256 + ar) * DE + ac; const bf16* a1 = a0 + (size_t)128 * DE;
        const bf16* b0 = Wd + ((size_t)e * 1024 + ct * 128 + ar) * DE + ac;
        f32x4 acc[4][4]; zero_acc(acc);
        sg_kloop(F.lds, acc, a0, a1, b0, DE / 32, wid, lane);
#pragma unroll
        for (int m = 0; m < 4; ++m)
#pragma unroll
            for (int j = 0; j < 4; ++j) { bf16* orow = YS + (size_t)(rt * 256 + wr * 64 + m * 16 + fq * 4 + j) * D + ct * 128 + wc * 64 + fr;
#pragma unroll
                for (int n = 0; n < 4; ++n) orow[n * 16] = (bf16)f2bf(acc[m][n][j]); }
    }
}
__device__ __forceinline__ void p7_final(Frame& F) {
    int tid_ = threadIdx.x; asm volatile("" : "+v"(tid_)); const int lane_ = tid_ & 63;
    unsigned char* ws = F.ws;
    LAS int* tb = (LAS int*)(F.lds + LDS_MISC + 1024); LAS int* cn = tb + 64;
    expert_tiles(F, tb, cn);
    const bf16* YS = (const bf16*)(ws + WS_YS); const int4* tpos = (const int4*)(ws + WS_TPOS);
    float* X1 = F.out;
    const int lane = lane_;
    const int gw = F.vcu * NWAVES + F.wave, NGW = F.G * NWAVES;
    const GAS f32x4* gr = (const GAS f32x4*)F.in[I_GFIN] + lane;
    for (int row = gw; row < T; row += NGW) {
        const int4 tp = tpos[row];
        const size_t s0 = (size_t)tb[tp.x] * 256 + tp.y, s1 = (size_t)tb[tp.z] * 256 + tp.w;
        GAS f32x4* xr = (GAS f32x4*)(X1 + (size_t)row * D) + lane;
        const GAS v2u* y0 = (const GAS v2u*)(YS + s0 * D) + lane; const GAS v2u* y1 = (const GAS v2u*)(YS + s1 * D) + lane;
        f32x4 v[4]; float s = 0.f;
#pragma unroll
        for (int j = 0; j < 4; ++j) { v[j] = xr[64 * j]; const v2u a = y0[64 * j], b = y1[64 * j];
            v[j].x += bflo(a.x) + bflo(b.x); v[j].y += bfhi(a.x) + bfhi(b.x); v[j].z += bflo(a.y) + bflo(b.y); v[j].w += bfhi(a.y) + bfhi(b.y);
            s += (v[j].x * v[j].x + v[j].y * v[j].y) + (v[j].z * v[j].z + v[j].w * v[j].w); }
        const float rstd = 1.0f / sqrtf(wave_sum(s) * (1.f / D) + RMS_EPS);
#pragma unroll
        for (int j = 0; j < 4; ++j) { const f32x4 gg = gr[64 * j]; f32x4 o; o.x = v[j].x * rstd * gg.x; o.y = v[j].y * rstd * gg.y; o.z = v[j].z * rstd * gg.z; o.w = v[j].w * rstd * gg.w; xr[64 * j] = o; }
    }
}

constexpr int NPHASE = 1 + 3 * NCH + 6;
__global__ void __launch_bounds__(NTHR, 2) fwd_kernel(KArgs args) {
    extern __shared__ __attribute__((aligned(16))) unsigned char lds_raw[];
    Frame F;
    F.lds = (LAS unsigned char*)lds_raw;
    F.tid = threadIdx.x; F.lane = F.tid & 63; F.wave = __builtin_amdgcn_readfirstlane(F.tid >> 6);
    F.G = gridDim.x; { const int bx = blockIdx.x; F.vcu = (F.G % 8 == 0) ? (bx % 8) * (F.G / 8) + bx / 8 : bx; }
#pragma unroll
    for (int i = 0; i < 17; ++i) F.in[i] = args.in[i];
    F.out = args.out; F.ws = args.ws;
    volatile LAS unsigned* MISC = (volatile LAS unsigned*)(F.lds + LDS_MISC);
    if (F.tid < 64) MISC[F.tid] = 0u;
    __syncthreads();
    XcdBarrier bar = xcd_barrier_post((unsigned*)(F.ws + WS_CTL) + CW_BAR + args.li * XCD_BAR_WORDS, MISC + 8);
#define IN(k) (args.ph_lo <= (k) && (k) < args.ph_hi)
#define SEAM(k) do { if (IN(k) && IN((k) + 1)) xcd_barrier(bar); } while (0)
    if (IN(0)) p0_prologue(F);
    SEAM(0);
#pragma unroll 1
    for (int ch = 0; ch < NCH; ++ch) {
        if (IN(1 + 3 * ch)) p1_inproj(F, ch);
        SEAM(1 + 3 * ch);
        if (IN(2 + 3 * ch)) p2_attn(F, ch);
        SEAM(2 + 3 * ch);
        if (IN(3 + 3 * ch)) p2_combine(F, ch);
        SEAM(3 + 3 * ch);
    }
    if (IN(3 * NCH + 1)) p3_merge(F);
    SEAM(3 * NCH + 1);
    if (IN(3 * NCH + 2)) p4_outproj(F);
    SEAM(3 * NCH + 2);
    if (IN(3 * NCH + 3)) p5_route(F);
    SEAM(3 * NCH + 3);
    if (IN(3 * NCH + 4)) p6a_gateup(F);
    SEAM(3 * NCH + 4);
    if (IN(3 * NCH + 5)) p6b_down(F);
    SEAM(3 * NCH + 5);
    if (IN(3 * NCH + 6)) p7_final(F);
#undef IN
#undef SEAM
}

#ifndef N_LAUNCHES
#define N_LAUNCHES 1
#endif
extern "C" void kernel_launch(void* const* d_in, const int* in_sizes, int n_in, void* d_out, int out_size, void* d_ws, size_t ws_size, hipStream_t stream) {
    static int grid = 0;
    if (grid == 0) {
        if (n_in != 17 || in_sizes[0] != T * D || out_size != T * D || ws_size < WS_END) { fprintf(stderr, "kernel_launch: unexpected shapes / workspace (%d inputs, ws %zu)\n", n_in, ws_size); grid = -1; return; }
        int dev = 0, cus = 0;
        if (hipGetDevice(&dev) != hipSuccess || hipDeviceGetAttribute(&cus, hipDeviceAttributeMultiprocessorCount, dev) != hipSuccess) { grid = -1; return; }
        if (hipFuncSetAttribute((const void*)fwd_kernel, hipFuncAttributeMaxDynamicSharedMemorySize, LDS_BYTES) != hipSuccess) { fprintf(stderr, "kernel_launch: hipFuncSetAttribute failed\n"); grid = -1; return; }
        int per_cu = 0;
        if (hipOccupancyMaxActiveBlocksPerMultiprocessor(&per_cu, (const void*)fwd_kernel, NTHR, LDS_BYTES) != hipSuccess || per_cu < 1) fprintf(stderr, "kernel_launch: occupancy query says %d\n", per_cu);
        (void)hipGetLastError();
        grid = cus;
    }
    if (grid < 0) return;
    (void)hipMemsetAsync((char*)d_ws + WS_CTL, 0, CTL_BYTES, stream);
    KArgs a{};
    for (int i = 0; i < 17; ++i) a.in[i] = (const float*)d_in[i];
    a.out = (float*)d_out; a.ws = (unsigned char*)d_ws;
    for (int li = 0; li < N_LAUNCHES; ++li) {
        a.ph_lo = (int)((long)NPHASE * li / N_LAUNCHES); a.ph_hi = (int)((long)NPHASE * (li + 1) / N_LAUNCHES); a.li = li;
        hipLaunchKernelGGL(fwd_kernel, dim3(grid), dim3(NTHR), LDS_BYTES, stream, a);
    }
}
```

```cpp
#include <hip/hip_runtime.h>
#include <cstdint>
#include <cstdio>

#define GAS __attribute__((address_space(1)))
#define LAS __attribute__((address_space(3)))
typedef unsigned short bf16;
typedef short bf16x8 __attribute__((ext_vector_type(8)));
typedef float f32x4 __attribute__((ext_vector_type(4)));
typedef unsigned v4u __attribute__((ext_vector_type(4)));
typedef unsigned v2u __attribute__((ext_vector_type(2)));
typedef GAS unsigned gu32;

constexpr int T = 32768, D = 1024, SEQ = 4096, NIN = 7936;
constexpr int A_W = 4608, B_W = 1280, G_W = 2048, Y_W = 1536;
constexpr int NE = 32, DE = 256;
constexpr int NCH = 4, TC = T / NCH;
constexpr float QSCALE = 0.125f * 1.4426950408889634f;
constexpr float LOG2E = 1.4426950408889634f;
constexpr float RMS_EPS = 1e-6f;
constexpr int NWAVES = 8, NTHR = 512;

constexpr size_t MiB = 1u << 20;
constexpr size_t WS_CTL = 0, CTL_BYTES = 1 * MiB;
constexpr size_t WS_ROPE = 1 * MiB;
constexpr size_t WS_WRF = 2 * MiB;
constexpr size_t WS_TOKOF = 3 * MiB;
constexpr size_t WS_WTOF = 7 * MiB;
constexpr size_t WS_TPOS = 15 * MiB;
constexpr size_t WS_WIN = 16 * MiB;
constexpr size_t WS_WAB = 32 * MiB;
constexpr size_t WS_WO = 35 * MiB;
constexpr size_t WS_WGU = 37 * MiB;
constexpr size_t WS_WD = 69 * MiB;
constexpr size_t WS_HN = 86 * MiB;
constexpr size_t WS_G = 150 * MiB;
constexpr size_t WS_Y = 278 * MiB;
constexpr size_t WS_ZA = 374 * MiB;
constexpr size_t WS_ZB = 446 * MiB;
constexpr size_t WS_MG = 374 * MiB;
constexpr size_t WS_HACT = 150 * MiB;
constexpr size_t WS_YS = 186 * MiB;
constexpr size_t WS_OG = 466 * MiB;
constexpr size_t WS_LSE = 490 * MiB;
constexpr size_t WS_END = 491 * MiB;
constexpr int MAXSLOT = 2 * T + NE * 256;
static_assert(WS_ZA + (size_t)TC * A_W * 2 <= WS_ZB && WS_ZB + (size_t)TC * B_W * 2 <= WS_OG && WS_OG + (size_t)3 * TC * 512 * 2 <= WS_LSE && WS_LSE + (size_t)3 * TC * 8 * 4 <= WS_END, "ws map");
static_assert(WS_MG + (size_t)T * D * 2 <= WS_END && WS_HACT + (size_t)MAXSLOT * DE * 2 <= WS_YS && WS_YS + (size_t)MAXSLOT * D * 2 <= WS_ZA, "ws map");
constexpr int CW_CNT = 1024;
constexpr int CW_BAR = 4096;
constexpr int LDS_BYTES = 147456;
constexpr int LDS_MISC = 131072;

__device__ __forceinline__ unsigned f2bf(float f) { unsigned u = __builtin_bit_cast(unsigned, f); return (u + 0x7fffu + ((u >> 16) & 1u)) >> 16; }
__device__ __forceinline__ unsigned pk2(float lo, float hi) { return f2bf(lo) | (f2bf(hi) << 16); }
__device__ __forceinline__ float bf2f(unsigned b) { return __builtin_bit_cast(float, b << 16); }
__device__ __forceinline__ float bflo(unsigned u) { return __builtin_bit_cast(float, u << 16); }
__device__ __forceinline__ float bfhi(unsigned u) { return __builtin_bit_cast(float, u & 0xffff0000u); }
__device__ __forceinline__ float wave_sum(float v) {
#pragma unroll
    for (int o = 1; o < 64; o <<= 1) v += __shfl_xor(v, o);
    return v;
}
__device__ __forceinline__ float wave_max(float v) {
#pragma unroll
    for (int o = 1; o < 64; o <<= 1) v = fmaxf(v, __shfl_xor(v, o));
    return v;
}
typedef float f32x2_t __attribute__((ext_vector_type(2)));
typedef __bf16 bf16x2_t __attribute__((ext_vector_type(2)));
__device__ __forceinline__ unsigned cvtpk(float lo, float hi) { f32x2_t v = {lo, hi}; bf16x2_t b = __builtin_convertvector(v, bf16x2_t); return __builtin_bit_cast(unsigned, b); }
#define LDS_WAIT() asm volatile("s_waitcnt lgkmcnt(0)" ::: "memory")
#define VM_WAIT() asm volatile("s_waitcnt vmcnt(0)" ::: "memory")

#define XB_TMO      128
#define XB_XCNT(j)  (256  + 64 * (j))
#define XB_XSUB(j)  (1280 + 64 * (j))
#define XB_XGEN(j)  (2304 + 64 * (j))
#define XB_TOP      3328
#define XB_TOPGEN   3392
#define XCD_BAR_WORDS 3456
#define XB_SPIN_CAP (1u << 18)
__device__ __forceinline__ unsigned xb_ld(unsigned* p)              { return __hip_atomic_load(p, __ATOMIC_RELAXED, __HIP_MEMORY_SCOPE_AGENT); }
__device__ __forceinline__ unsigned xb_add(unsigned* p, unsigned v) { return __hip_atomic_fetch_add(p, v, __ATOMIC_RELAXED, __HIP_MEMORY_SCOPE_AGENT); }
__device__ __forceinline__ unsigned xb_xcc_id() { return (unsigned)__builtin_amdgcn_s_getreg((3 << 11) | 20) & 0xFu; }
#define XB_SPIN(cond, bar) do { unsigned _sp = 0; while (cond) { __builtin_amdgcn_s_sleep(1); \
    if ((++_sp & 255u) == 0u) { if (xb_ld(&(bar)[XB_TMO])) break; if (_sp > XB_SPIN_CAP) { atomicAdd(&(bar)[XB_TMO], 1u); break; } } } } while (0)
struct XcdBarrier { unsigned* bar; unsigned x; volatile LAS unsigned* st; };
__device__ __forceinline__ XcdBarrier xcd_barrier_post(unsigned* bar, volatile LAS unsigned* st) {
    XcdBarrier b; b.bar = bar; b.x = xb_xcc_id(); b.st = st;
    if (threadIdx.x == 0) (void)xb_add(&bar[XB_XCNT(b.x)], 1u);
    return b;
}
__device__ __forceinline__ void xcd_barrier_complete(unsigned* bar, unsigned x, unsigned& nloc, unsigned& nx) {
    const unsigned G = gridDim.x * gridDim.y * gridDim.z;
    unsigned sum, cnt, mine, sp = 0u;
    for (;;) {
        sum = 0u; cnt = 0u; mine = 0u;
#pragma unroll
        for (unsigned j = 0; j < 16; ++j) { const unsigned c = xb_ld(&bar[XB_XCNT(j)]); sum += c; cnt += (c > 0u) ? 1u : 0u; mine = (j == x) ? c : mine; }
        if (sum == G) break;
        __builtin_amdgcn_s_sleep(1);
        if ((++sp & 255u) == 0u) { if (xb_ld(&bar[XB_TMO])) break; if (sp > XB_SPIN_CAP) { atomicAdd(&bar[XB_TMO], 1u); break; } }
    }
    nloc = mine > 0u ? mine : 1u; nx = cnt > 0u ? cnt : 1u;
}
__device__ __forceinline__ void xcd_barrier(const XcdBarrier& b) {
    asm volatile("s_waitcnt vmcnt(0)" ::: "memory");
    __syncthreads();
    if (threadIdx.x == 0) {
        unsigned* bar = b.bar;
        __builtin_amdgcn_s_waitcnt(0);
        unsigned nloc = b.st[0], nx = b.st[1];
        if (nloc == 0u) { xcd_barrier_complete(bar, b.x, nloc, nx); b.st[0] = nloc; b.st[1] = nx; }
        const unsigned old = xb_add(&bar[XB_XSUB(b.x)], 1u);
        const unsigned gen = old / nloc;
        if (old + 1u == (gen + 1u) * nloc) {
            __builtin_amdgcn_fence(__ATOMIC_RELEASE, "agent");
            asm volatile("s_waitcnt vmcnt(0)" ::: "memory");
            const unsigned og = xb_add(&bar[XB_TOP], 1u);
            const unsigned tg = og / nx;
            if (og + 1u == (tg + 1u) * nx) xb_add(&bar[XB_TOPGEN], 1u);
            else XB_SPIN(xb_ld(&bar[XB_TOPGEN]) == tg, bar);
            __builtin_amdgcn_fence(__ATOMIC_ACQUIRE, "agent");
            xb_add(&bar[XB_XGEN(b.x)], 1u);
            asm volatile("s_waitcnt vmcnt(0)" ::: "memory");
        } else {
            XB_SPIN(xb_ld(&bar[XB_XGEN(b.x)]) == gen, bar);
            __builtin_amdgcn_fence(__ATOMIC_ACQUIRE, "agent");
            asm volatile("s_waitcnt vmcnt(0)" ::: "memory");
        }
    }
    __syncthreads();
}

struct KArgs { const float* in[17]; float* out; unsigned char* ws; int ph_lo, ph_hi, li, pad; };
struct Frame {
    LAS unsigned char* lds;
    int tid, lane, wave, vcu, G;
    const float* in[17]; float* out; unsigned char* ws;
};
enum { I_X = 0, I_WIN, I_BIN, I_SINK, I_WPA, I_WPB, I_WOUT, I_GMIX, I_GFFN, I_WRG, I_BRG, I_WRE, I_BRE, I_WEG, I_WEU, I_WED, I_GFIN };

__device__ __forceinline__ void p0_tr_item(const float* W, int N, bf16* WT, int ldo, int rowbase, int koff, int k0, int n0, LAS float* scr, int lane, bool perm = false, const float* kscale = nullptr) {
#pragma unroll 8
    for (int i = 0; i < 32; ++i) { const int kk = 2 * i + (lane >> 5); float v = W[(size_t)(k0 + kk) * N + n0 + (lane & 31)]; if (kscale) v *= kscale[k0 + kk]; scr[kk * 33 + (lane & 31)] = v; }
    LDS_WAIT(); asm volatile("" ::: "memory");
    const int c = lane & 7;
#pragma unroll
    for (int j = 0; j < 4; ++j) { const int n = (lane >> 3) + 8 * j; const LAS float* s = scr + (8 * c) * 33 + n;
        v4u o; o.x = pk2(s[0 * 33], s[1 * 33]); o.y = pk2(s[2 * 33], s[3 * 33]); o.z = pk2(s[4 * 33], s[5 * 33]); o.w = pk2(s[6 * 33], s[7 * 33]);
        const int rr = perm ? 8 * (n >> 2) + (n & 3) : n;
        *(GAS v4u*)(WT + (size_t)(rowbase + rr) * ldo + koff + k0 + 8 * c) = o; }
    LDS_WAIT(); asm volatile("" ::: "memory");
}
__device__ __forceinline__ void rms_row_to_bf16(const float* xrow, const float* g, bf16* orow, int lane) {
    const GAS f32x4* xr = (const GAS f32x4*)xrow + lane; const GAS f32x4* gr = (const GAS f32x4*)g + lane;
    f32x4 v[4]; float s = 0.f;
#pragma unroll
    for (int j = 0; j < 4; ++j) { v[j] = xr[64 * j]; s += (v[j].x * v[j].x + v[j].y * v[j].y) + (v[j].z * v[j].z + v[j].w * v[j].w); }
    const float rstd = 1.0f / sqrtf(wave_sum(s) * (1.f / D) + RMS_EPS);
    GAS v2u* o8 = (GAS v2u*)orow + lane;
#pragma unroll
    for (int j = 0; j < 4; ++j) { const f32x4 gg = gr[64 * j]; v2u w; w.x = pk2(v[j].x * rstd * gg.x, v[j].y * rstd * gg.y); w.y = pk2(v[j].z * rstd * gg.z, v[j].w * rstd * gg.w); o8[64 * j] = w; }
}
__device__ __forceinline__ void p0_prologue(Frame& F) {
    int tid_ = threadIdx.x; asm volatile("" : "+v"(tid_)); const int lane_ = tid_ & 63;
    LAS float* scr = (LAS float*)(F.lds + F.wave * 16384);
    const int gw = F.vcu * NWAVES + F.wave, NGW = F.G * NWAVES;
    unsigned char* ws = F.ws;
    constexpr int I_IN = 16 * 248, I_PA = 8 * 32, I_PB = 16 * 32, I_WO = 16 * 32, I_EG = 32 * 16 * 8, I_ED = 32 * 4 * 32;
    constexpr int NITEMS = I_IN + I_PA + I_PB + I_WO + 2 * I_EG + I_ED;
    for (int it = gw; it < NITEMS; it += NGW) {
        int r = it;
        if (r < I_IN) { const int kb = r / 248, nb = r % 248, n0 = 32 * nb; const bool qk = (n0 < 3072) || (n0 >= A_W && n0 < A_W + 1152);
            p0_tr_item(F.in[I_WIN], NIN, (bf16*)(ws + WS_WIN), 1024, qk ? (n0 & ~63) + ((n0 >> 5) & 1) * 4 : n0, 0, 64 * kb, n0, scr, lane_, qk); continue; } r -= I_IN;
        if (r < I_PA) { const int kb = r / 32, nb = r % 32; p0_tr_item(F.in[I_WPA], 1024, (bf16*)(ws + WS_WAB), 1536, 32 * nb, 0, 64 * kb, 32 * nb, scr, lane_); continue; } r -= I_PA;
        if (r < I_PB) { const int kb = r / 32, nb = r % 32; p0_tr_item(F.in[I_WPB], 1024, (bf16*)(ws + WS_WAB), 1536, 32 * nb, 512, 64 * kb, 32 * nb, scr, lane_); continue; } r -= I_PB;
        if (r < I_WO) { const int kb = r / 32, nb = r % 32; p0_tr_item(F.in[I_WOUT], 1024, (bf16*)(ws + WS_WO), 1024, 32 * nb, 0, 64 * kb, 32 * nb, scr, lane_); continue; } r -= I_WO;
        if (r < 2 * I_EG) { const int up = r >= I_EG; if (up) r -= I_EG; const int e = r / 128, q = r % 128, kb = q / 8, nb = q % 8;
            p0_tr_item(F.in[up ? I_WEU : I_WEG] + (size_t)e * 1024 * 256, 256, (bf16*)(ws + WS_WGU) + (size_t)e * 512 * 1024, 1024, 64 * nb + (up ? 4 : 0), 0, 64 * kb, 32 * nb, scr, lane_, true, F.in[I_GFFN]); continue; } r -= 2 * I_EG;
        { const int e = r / 128, q = r % 128, kb = q / 32, nb = q % 32;
            p0_tr_item(F.in[I_WED] + (size_t)e * 256 * 1024, 1024, (bf16*)(ws + WS_WD) + (size_t)e * 1024 * 256, 256, 32 * nb, 0, 64 * kb, 32 * nb, scr, lane_); }
    }
    for (int m = gw; m < T; m += NGW) rms_row_to_bf16(F.in[I_X] + (size_t)m * D, F.in[I_GMIX], (bf16*)(ws + WS_HN) + (size_t)m * D, lane_);
    const int gt = F.vcu * NTHR + tid_, NGT = F.G * NTHR;
    for (int i = gt; i < SEQ * 32; i += NGT) {
        const int pos = i >> 5, fi = i & 31;
        const float inv = (float)exp2(-(double)fi * (13.287712379549449 / 32.0));
        const float ang = (float)pos * inv; float s, c; sincosf(ang, &s, &c);
        ((float2*)(ws + WS_ROPE))[i] = make_float2(c, s);
    }
    for (int i = gt; i < 64 * 3 * 64 * 4; i += NGT) {
        const int c = i & 3, ln = (i >> 2) & 63, nb = (i >> 8) % 3, s = i / 768;
        const int k = 16 * s + 4 * (ln >> 4) + c, n = 16 * nb + (ln & 15);
        float v = 0.f;
        if (n < 4) v = F.in[I_WRG][k * 4 + n]; else if (n < 36) v = F.in[I_WRE][k * 32 + (n - 4)];
        ((float*)(ws + WS_WRF))[i] = v * F.in[I_GFFN][k];
    }
}

constexpr int SG_BUF = 24576;
__device__ __forceinline__ void sg_kloop(LAS unsigned char* lds, f32x4 (&acc)[4][4], const bf16* a0, const bf16* a1, const bf16* b0, int nt, int wid, int lane) {
    const int wr = wid >> 1, wc = wid & 1, fr = lane & 15, fq = lane >> 4;
    const unsigned wbase = (unsigned)wid * 1024u;
#define SG_STAGE(buf, kt) do { \
        __builtin_amdgcn_global_load_lds((const unsigned*)(a0 + (kt) * 32), (LAS unsigned*)(lds + (buf) * SG_BUF + wbase), 16, 0, 0); \
        __builtin_amdgcn_global_load_lds((const unsigned*)(a1 + (kt) * 32), (LAS unsigned*)(lds + (buf) * SG_BUF + 8192 + wbase), 16, 0, 0); \
        __builtin_amdgcn_global_load_lds((const unsigned*)(b0 + (kt) * 32), (LAS unsigned*)(lds + (buf) * SG_BUF + 16384 + wbase), 16, 0, 0); } while (0)
    SG_STAGE(0, 0);
    VM_WAIT(); __syncthreads();
    int cur = 0;
    for (int t = 0; t < nt; ++t) {
        if (t + 1 < nt) SG_STAGE(cur ^ 1, t + 1);
        const LAS unsigned char* sa = lds + cur * SG_BUF + (wr * 64 + fr) * 64 + fq * 16;
        const LAS unsigned char* sb = lds + cur * SG_BUF + 16384 + (wc * 64 + fr) * 64 + fq * 16;
        bf16x8 At[4], Bt[4];
#pragma unroll
        for (int m = 0; m < 4; ++m) At[m] = *(const LAS bf16x8*)(sa + m * 1024);
#pragma unroll
        for (int n = 0; n < 4; ++n) Bt[n] = *(const LAS bf16x8*)(sb + n * 1024);
#pragma unroll
        for (int m = 0; m < 4; ++m)
#pragma unroll
            for (int n = 0; n < 4; ++n) acc[m][n] = __builtin_amdgcn_mfma_f32_16x16x32_bf16(At[m], Bt[n], acc[m][n], 0, 0, 0);
        VM_WAIT(); __syncthreads();
        cur ^= 1;
    }
#undef SG_STAGE
}
__device__ __forceinline__ void zero_acc(f32x4 (&acc)[4][4]) {
#pragma unroll
    for (int m = 0; m < 4; ++m)
#pragma unroll
        for (int n = 0; n < 4; ++n) acc[m][n] = (f32x4){0.f, 0.f, 0.f, 0.f};
}

namespace pg8 {
#define PG8_LAS __attribute__((address_space(3)))
typedef unsigned short bf16_t;
typedef short bf16x8 __attribute__((ext_vector_type(8)));
typedef float f32x4 __attribute__((ext_vector_type(4)));
typedef unsigned u32x4 __attribute__((ext_vector_type(4)));
constexpr int BM = 256, BK = 64, HALF = 128, HTB = HALF * BK * 2  , STAGE_BYTES = 8 * HTB, NXCD = 8, WGM = 8;

__host__ __device__ __forceinline__ int lds_byte(int r, int c) { const int st = (r >> 4) * 2 + (c >> 5), rr = r & 15, cc = c & 31, ob = rr * 64 + cc * 2; return st * 1024 + (ob ^ (((ob >> 9) & 1) << 5)); }
__host__ __device__ __forceinline__ void stage_rc(int b, int& R, int& C) { const int st = b / 1024, sb = b % 1024, swz = sb ^ (((sb >> 9) & 1) << 5); R = (st >> 1) * 16 + swz / 64; C = (st & 1) * 32 + (swz % 64) / 2; }
__host__ __device__ __forceinline__ int perm32(int rho) { const int n = rho >> 4, i = rho & 15; return 8 * (i >> 2) + 4 * n + (i & 3); }

struct Unit { int pm, pn; };
struct Gemm { const bf16_t* A; const bf16_t* Bt; int M, N, K; };

struct StaticOrder {
    int nM, nN, nwg, G, c;
    __host__ __device__ void init(int M, int N, int G_, int c_) { nM = M / BM; nN = N / BM; nwg = nM * nN; G = G_; c = c_; }
    __host__ __device__ bool next(int i, Unit& u) const {
        const long L = (long)i * G + c; if (L >= nwg) return false;
        int wgid = (int)L; { const int q = nwg / NXCD, r = nwg % NXCD, xcd = wgid % NXCD, off = wgid / NXCD; wgid = (xcd < r ? xcd * (q + 1) : r * (q + 1) + (xcd - r) * q) + off; }
        const int nig = WGM * nN, gid = wgid / nig, fm = gid * WGM, gsz = (nM - fm) < WGM ? (nM - fm) : WGM;
        u.pm = fm + ((wgid % nig) % gsz); u.pn = (wgid % nig) / gsz; return true;
    }
    __device__ __forceinline__ void a_ready(const Unit&) const {}
    __device__ __forceinline__ void done(const Unit&) const {}
};
template <class Epi, class Sched, bool ALIGN_EPI = false, bool SP2 = false>
__device__ __forceinline__ void gemm_phase(PG8_LAS unsigned char* lds, const Gemm g, const Sched& S, const Epi& E) {
    const int tid = threadIdx.x, wid = __builtin_amdgcn_readfirstlane(tid >> 6), lane = tid & 63, wr = wid >> 2, wc = wid & 3, fr = lane & 15, fq = lane >> 4;
    const int K = g.K, nt = K / BK;
    unsigned voffA[2], voffB[2];
#pragma unroll
    for (int i = 0; i < 2; ++i) { int R, C; stage_rc(tid * 16 + i * 8192, R, C); const int Rb = Epi::PERM ? ((R & ~31) + perm32(R & 31)) : R;
        voffA[i] = (unsigned)(R * K + C) * 2u; voffB[i] = (unsigned)(Rb * K + C) * 2u; }
    const size_t kstep = (size_t)(BK * 2);
    const size_t hstep = (size_t)HALF * K * 2;
    const size_t tstep = 2 * hstep;
    const unsigned ldsw = (unsigned)wid * 1024u;
    const int aoff = lds_byte(wr * 64 + fr, fq * 8), boff = lds_byte(wc * 32 + fr, fq * 8);
#define PG8_SA(b, h) (((b) * 2 + (h)) * HTB)
#define PG8_SB(b, h) ((4 + (b) * 2 + (h)) * HTB)
#define PG8_STAGE(bufoff, gbase, voff) do { _Pragma("unroll") for (int _i = 0; _i < 2; ++_i) \
        __builtin_amdgcn_global_load_lds((const unsigned*)((const char*)(gbase) + (voff)[_i]), (PG8_LAS unsigned*)(lds + (bufoff) + ldsw + _i * 8192), 16, 0, 0); } while (0)
#define PG8_LDA(dst, b, h) do { _Pragma("unroll") for (int m = 0; m < 4; ++m) _Pragma("unroll") for (int k = 0; k < 2; ++k) dst[m][k] = *(const PG8_LAS bf16x8*)(lds + PG8_SA(b, h) + aoff + m * 2048 + k * 1024); } while (0)
#define PG8_LDB(dst, b, h) do { _Pragma("unroll") for (int n = 0; n < 2; ++n) _Pragma("unroll") for (int k = 0; k < 2; ++k) dst[n][k] = *(const PG8_LAS bf16x8*)(lds + PG8_SB(b, h) + boff + n * 2048 + k * 1024); } while (0)
#define PG8_MMA(ai, bj, At, Bt) do { __builtin_amdgcn_s_setprio(1); _Pragma("unroll") for (int m = 0; m < 4; ++m) _Pragma("unroll") for (int n = 0; n < 2; ++n) _Pragma("unroll") for (int k = 0; k < 2; ++k) \
        acc[ai][bj][m][n] = __builtin_amdgcn_mfma_f32_16x16x32_bf16(Bt[n][k], At[m][k], acc[ai][bj][m][n], 0, 0, 0); __builtin_amdgcn_s_setprio(0); } while (0)
#define PG8_WAIT_V(n) asm volatile("s_waitcnt vmcnt(" #n ")" ::: "memory")
#define PG8_WAIT_L(n) asm volatile("s_waitcnt lgkmcnt(" #n ")" ::: "memory")
#define PG8_BAR __builtin_amdgcn_s_barrier()
#define PG8_SCHED __builtin_amdgcn_sched_barrier(0)
    Unit cur, nxt; int ui = 0;
    if (!S.next(0, cur)) return;
    f32x4 acc[2][2][4][2];
#pragma unroll
    for (int a = 0; a < 2; ++a)
#pragma unroll
        for (int b = 0; b < 2; ++b)
#pragma unroll
            for (int m = 0; m < 4; ++m)
#pragma unroll
                for (int n = 0; n < 2; ++n) acc[a][b][m][n] = (f32x4){0.f, 0.f, 0.f, 0.f};
    bf16x8 At[4][2], B0[2][2], B1[2][2];
    const char* cA = (const char*)g.A + (size_t)cur.pm * tstep; const char* cB = (const char*)g.Bt + (size_t)cur.pn * tstep;
    S.a_ready(cur);
    if constexpr (SP2) {
        PG8_STAGE(PG8_SB(0, 0), cB, voffB); PG8_STAGE(PG8_SB(0, 1), cB + hstep, voffB); PG8_STAGE(PG8_SA(0, 0), cA, voffA); PG8_STAGE(PG8_SA(0, 1), cA + hstep, voffA);
        if (wr == 1) PG8_BAR;
        PG8_WAIT_V(2); PG8_BAR;
        PG8_STAGE(PG8_SB(1, 0), cB + kstep, voffB); PG8_STAGE(PG8_SA(1, 0), cA + kstep, voffA); PG8_STAGE(PG8_SB(1, 1), cB + hstep + kstep, voffB);
        PG8_WAIT_V(6); PG8_BAR;
    } else {
        PG8_STAGE(PG8_SB(0, 0), cB, voffB); PG8_STAGE(PG8_SA(0, 0), cA, voffA); PG8_STAGE(PG8_SB(0, 1), cB + hstep, voffB); PG8_STAGE(PG8_SA(0, 1), cA + hstep, voffA);
        if (wr == 1) PG8_BAR;
        PG8_WAIT_V(4); PG8_BAR;
        PG8_STAGE(PG8_SB(1, 0), cB + kstep, voffB); PG8_STAGE(PG8_SA(1, 0), cA + kstep, voffA); PG8_STAGE(PG8_SB(1, 1), cB + hstep + kstep, voffB);
        PG8_WAIT_V(6); PG8_BAR;
    }
    for (;;) {
        const bool has_next = S.next(ui + 1, nxt);
        const char* nA = has_next ? (const char*)g.A + (size_t)nxt.pm * tstep : cA; const char* nB = has_next ? (const char*)g.Bt + (size_t)nxt.pn * tstep : cB;
        for (int t = 0; t < nt; t += 2) {
            const bool last = (t == nt - 2);
            const char* a1 = cA + (size_t)(t + 1) * kstep;
            const char* a2 = last ? nA : cA + (size_t)(t + 2) * kstep; const char* b2 = last ? nB : cB + (size_t)(t + 2) * kstep;
            const char* a3 = a2 + kstep; const char* b3 = b2 + kstep;
            if (last && has_next) S.a_ready(nxt);
            if constexpr (SP2) {
            PG8_LDB(B0, 0, 0); PG8_LDB(B1, 0, 1); PG8_SCHED; PG8_LDA(At, 0, 0); PG8_STAGE(PG8_SA(1, 1), a1 + hstep, voffA);
            PG8_WAIT_V(8); PG8_WAIT_L(0); PG8_BAR; PG8_MMA(0, 0, At, B0); PG8_MMA(0, 1, At, B1); PG8_BAR; PG8_SCHED;
            PG8_LDA(At, 0, 1); PG8_STAGE(PG8_SB(0, 0), b2, voffB); PG8_STAGE(PG8_SB(0, 1), b2 + hstep, voffB); PG8_STAGE(PG8_SA(0, 0), a2, voffA);
            PG8_WAIT_V(8); PG8_WAIT_L(0); PG8_BAR; PG8_MMA(1, 0, At, B0); PG8_MMA(1, 1, At, B1); PG8_BAR; PG8_SCHED;
            PG8_LDB(B0, 1, 0); PG8_LDB(B1, 1, 1); PG8_SCHED; PG8_LDA(At, 1, 0); PG8_STAGE(PG8_SA(0, 1), a2 + hstep, voffA);
            PG8_WAIT_V(8); PG8_WAIT_L(0); PG8_BAR; PG8_MMA(0, 0, At, B0); PG8_MMA(0, 1, At, B1); PG8_BAR; PG8_SCHED;
            PG8_LDA(At, 1, 1); PG8_STAGE(PG8_SB(1, 0), b3, voffB); PG8_STAGE(PG8_SB(1, 1), b3 + hstep, voffB); PG8_STAGE(PG8_SA(1, 0), a3, voffA);
            PG8_WAIT_V(8); PG8_WAIT_L(0); PG8_BAR; PG8_MMA(1, 0, At, B0); PG8_MMA(1, 1, At, B1); PG8_BAR; PG8_SCHED;
            } else {
            PG8_LDB(B0, 0, 0); PG8_SCHED; PG8_LDA(At, 0, 0); PG8_STAGE(PG8_SA(1, 1), a1 + hstep, voffA);
            PG8_WAIT_L(8); PG8_BAR; PG8_WAIT_L(0); PG8_MMA(0, 0, At, B0); PG8_BAR; PG8_SCHED;
            PG8_LDB(B1, 0, 1); PG8_STAGE(PG8_SB(0, 0), b2, voffB);
            PG8_BAR; PG8_WAIT_L(0); PG8_MMA(0, 1, At, B1); PG8_BAR;
            PG8_LDA(At, 0, 1); PG8_STAGE(PG8_SA(0, 0), a2, voffA);
            PG8_BAR; PG8_WAIT_L(0); PG8_MMA(1, 0, At, B0); PG8_BAR; PG8_SCHED;
            PG8_STAGE(PG8_SB(0, 1), b2 + hstep, voffB);
            PG8_WAIT_V(6); PG8_BAR; PG8_MMA(1, 1, At, B1); PG8_BAR;
            PG8_LDB(B0, 1, 0); PG8_SCHED; PG8_LDA(At, 1, 0); PG8_STAGE(PG8_SA(0, 1), a2 + hstep, voffA);
            PG8_WAIT_L(8); PG8_BAR; PG8_WAIT_L(0); PG8_MMA(0, 0, At, B0); PG8_BAR; PG8_SCHED;
            PG8_LDB(B1, 1, 1); PG8_STAGE(PG8_SB(1, 0), b3, voffB);
            PG8_BAR; PG8_WAIT_L(0); PG8_MMA(0, 1, At, B1); PG8_BAR;
            PG8_LDA(At, 1, 1); PG8_STAGE(PG8_SA(1, 0), a3, voffA);
            PG8_BAR; PG8_WAIT_L(0); PG8_MMA(1, 0, At, B0); PG8_BAR; PG8_SCHED;
            PG8_STAGE(PG8_SB(1, 1), b3 + hstep, voffB);
            PG8_WAIT_V(6); PG8_BAR; PG8_MMA(1, 1, At, B1); PG8_BAR;
            }
        }
        if constexpr (ALIGN_EPI) { if (wr == 0) PG8_BAR; }
        if constexpr (!Epi::AFTER_DRAIN) { E(acc, cur, wr, wc, fr, fq); S.done(cur); }
        if (!has_next) break;
#pragma unroll
        for (int a = 0; a < 2; ++a)
#pragma unroll
            for (int b = 0; b < 2; ++b)
#pragma unroll
                for (int m = 0; m < 4; ++m)
#pragma unroll
                    for (int n = 0; n < 2; ++n) acc[a][b][m][n] = (f32x4){0.f, 0.f, 0.f, 0.f};
        cur = nxt; cA = nA; cB = nB; ++ui;
        if constexpr (ALIGN_EPI) { if (wr == 1) PG8_BAR; }
    }
    PG8_WAIT_V(0);
    if constexpr (!ALIGN_EPI) { if (wr == 0) PG8_BAR; }
    PG8_BAR;
    if constexpr (Epi::AFTER_DRAIN) { E.fused(acc, cur, wr, wc, fr, fq, lds, wid, lane); S.done(cur); }
#undef PG8_SA
#undef PG8_SB
#undef PG8_STAGE
#undef PG8_LDA
#undef PG8_LDB
#undef PG8_MMA
#undef PG8_WAIT_V
#undef PG8_WAIT_L
#undef PG8_BAR
#undef PG8_SCHED
}
}


struct EpiInproj {
    static constexpr bool PERM = true, AFTER_DRAIN = false;
    bf16* ZA; bf16* ZB; bf16* Gt; const float* bias; const float* rope;
    __device__ __forceinline__ void operator()(const f32x4 (&acc)[2][2][4][2], const pg8::Unit& u, int wr, int wc, int fr, int fq) const {
        const int row0 = u.pm * 256 + wr * 64 + fr;
        const int q = 4 * (wc & 1) + fq;
#pragma unroll
        for (int bj = 0; bj < 2; ++bj) {
            const int colpos = u.pn * 256 + bj * 128 + wc * 32 + 8 * fq, hb = colpos & ~63;
            int kind; bf16* dst; int ldd;
            if (hb < A_W) { kind = hb / 1536; dst = ZA + colpos; ldd = A_W; }
            else if (hb < A_W + B_W) { const int cb = hb - A_W; kind = cb < 1024 ? 0 : (cb < 1152 ? 1 : 2); dst = ZB + (colpos - A_W); ldd = B_W; }
            else { kind = 3; dst = Gt + (colpos - A_W - B_W); ldd = G_W; }
            const f32x4 b0 = *(const f32x4*)(bias + (kind < 2 ? hb + 4 * q : colpos));
            const f32x4 b1 = *(const f32x4*)(bias + (kind < 2 ? hb + 32 + 4 * q : colpos + 4));
#pragma unroll
            for (int ai = 0; ai < 2; ++ai)
#pragma unroll
                for (int m = 0; m < 4; ++m) {
                    const int row = row0 + ai * 128 + m * 16;
                    f32x4 v0 = acc[ai][bj][m][0] + b0, v1 = acc[ai][bj][m][1] + b1;
                    if (kind < 2) {
                        const float* rp = rope + ((size_t)(row & (SEQ - 1)) * 32 + 4 * q) * 2;
                        const f32x4 r0 = *(const f32x4*)rp, r1 = *(const f32x4*)(rp + 4);
                        const f32x4 cc = {r0[0], r0[2], r1[0], r1[2]}, ss = {r0[1], r0[3], r1[1], r1[3]};
                        const f32x4 t0 = v0 * cc - v1 * ss, t1 = v1 * cc + v0 * ss;
                        v0 = t0; v1 = t1;
                        if (kind == 0) { v0 = v0 * QSCALE; v1 = v1 * QSCALE; }
                    } else if (kind == 3) {
#pragma unroll
                        for (int e = 0; e < 4; ++e) { v0[e] = 1.0f / (1.0f + __expf(-v0[e])); v1[e] = 1.0f / (1.0f + __expf(-v1[e])); }
                    }
                    v4u w; w.x = cvtpk(v0[0], v0[1]); w.y = cvtpk(v0[2], v0[3]); w.z = cvtpk(v1[0], v1[1]); w.w = cvtpk(v1[2], v1[3]);
                    *(GAS v4u*)(dst + (size_t)row * ldd) = w;
                }
        }
    }
};
__device__ __forceinline__ void p1_inproj(Frame& F, int ch) {
    unsigned char* ws = F.ws;
    pg8::Gemm g{(const bf16*)(ws + WS_HN) + (size_t)ch * TC * D, (const bf16*)(ws + WS_WIN), TC, NIN, D};
    pg8::StaticOrder S; S.init(TC, NIN, F.G, (int)blockIdx.x);
    EpiInproj E{(bf16*)(ws + WS_ZA), (bf16*)(ws + WS_ZB), (bf16*)(ws + WS_G) + (size_t)ch * TC * G_W, F.in[I_BIN], (const float*)(ws + WS_ROPE)};
    pg8::gemm_phase<EpiInproj, pg8::StaticOrder, true, true>(F.lds, g, S, E);
}

typedef float f32x16 __attribute__((ext_vector_type(16)));
typedef short v4i16_t __attribute__((ext_vector_type(4)));
__device__ __forceinline__ float half_max(float v) { auto rr = __builtin_amdgcn_permlane32_swap(__float_as_uint(v), __float_as_uint(v), false, false); return fmaxf(__uint_as_float(rr[0]), __uint_as_float(rr[1])); }
__device__ __forceinline__ float half_sum(float v) { auto rr = __builtin_amdgcn_permlane32_swap(__float_as_uint(v), __float_as_uint(v), false, false); return __uint_as_float(rr[0]) + __uint_as_float(rr[1]); }
constexpr int ATT_VOFF = 49152;

template <int KIND>
__device__ __forceinline__ void attn_unit(Frame& F, int ch, int u) {
    unsigned char* ws = F.ws;
    int tid_ = threadIdx.x; asm volatile("" : "+v"(tid_));
    const int tid = tid_, lane = tid & 63, w = F.wave, c = lane & 31, h = (lane >> 5) & 1;
    LAS unsigned char* KL = F.lds; LAS unsigned char* VL = F.lds + ATT_VOFF;
    constexpr int NP = KIND == 0 ? 6 : 3;
    constexpr int NKEYS = KIND == 0 ? 384 : 160;
    const bf16 *Kw, *Vw, *Qp; size_t pitch; int kk_lo, kb0, kstart; float m, l;
    bf16* Op; float* Lp = nullptr;
    if (KIND == 0) {
        const bf16* ZA = (const bf16*)(ws + WS_ZA);
        const int rt = u & 15, hh = (u >> 4) & 7, gb = u >> 7, g = gb % 3, bl = gb / 3;
        const int dsh = 2 * g, d = 1 << dsh;
        const int tsh = 4 - dsh;
        const int r = rt >> tsh, tile = rt & ((1 << tsh) - 1), i0 = tile * 256;
        const int rowb = bl * SEQ + r;
        const int col = g * 512 + hh * 64;
        pitch = (size_t)d * A_W;
        Kw = ZA + ((long)rowb + (long)d * (i0 - 128)) * A_W + 1536 + col;
        Vw = Kw + 1536;
        const long qrow = (long)rowb + (long)d * (i0 + 32 * w + c);
        Qp = ZA + qrow * A_W + col;
        kk_lo = (i0 == 0) ? 128 : 0;
        kb0 = w; kstart = (i0 == 0) ? (w < 4 ? 4 - w : 0) : 0;
        m = -1e30f; l = 0.f;
        Op = (bf16*)(ws + WS_OG) + ((size_t)g * TC + qrow) * 512 + hh * 64;
        Lp = (float*)(ws + WS_LSE) + ((size_t)g * TC + qrow) * 8 + hh;
    } else {
        const bf16* ZB = (const bf16*)(ws + WS_ZB);
        const int blk = u & 127, kvh = (u >> 7) & 1, bl = u >> 8;
        const int t0 = blk * 32, rowb = bl * SEQ;
        pitch = B_W;
        Kw = ZB + ((long)rowb + t0 - 128) * B_W + 1024 + kvh * 64;
        Vw = Kw + 128;
        const int qh = kvh * 8 + w;
        const long qrow = (long)rowb + t0 + c;
        Qp = ZB + qrow * B_W + qh * 64;
        kk_lo = t0 < 128 ? 128 - t0 : 0;
        kb0 = 0; kstart = kk_lo >> 5;
        m = F.in[I_SINK][qh] * LOG2E; l = h == 0 ? 1.f : 0.f;
        Op = (bf16*)(ws + WS_Y) + ((size_t)ch * TC + qrow) * Y_W + 512 + qh * 64;
    }
    {
        const int skey = tid >> 3, sch = tid & 7;
        v4u kreg[NP], vreg[NP];
#pragma unroll
        for (int p = 0; p < NP; ++p) { const int kk = 64 * p + skey;
            if (kk >= kk_lo && kk < NKEYS) { kreg[p] = *(const GAS v4u*)(Kw + (size_t)kk * pitch + 8 * sch); vreg[p] = *(const GAS v4u*)(Vw + (size_t)kk * pitch + 8 * sch); } }
#pragma unroll
        for (int p = 0; p < NP; ++p) { const int kk = 64 * p + skey;
            if (kk >= kk_lo && kk < NKEYS) {
                *(LAS v4u*)(KL + kk * 128 + ((sch ^ ((kk >> 1) & 7)) << 4)) = kreg[p];
                *(LAS v4u*)(VL + kk * 128 + ((sch * 16) ^ (((kk >> 1) & 1) << 6))) = vreg[p]; } }
    }
    bf16x8 qf[4];
#pragma unroll
    for (int s4 = 0; s4 < 4; ++s4) qf[s4] = *(const GAS bf16x8*)(Qp + 16 * s4 + 8 * h);
    __syncthreads();
    int koff[4];
    { const int kswz = (c >> 1) & 7;
#pragma unroll
      for (int s4 = 0; s4 < 4; ++s4) koff[s4] = c * 128 + (((2 * s4 + h) ^ kswz) << 4); }
    const int vrow = 4 * h + ((lane & 15) >> 2), vsw = (lane >> 3) & 1;
    const int voff0 = vrow * 128 + ((32 * ((lane >> 4) & 1) + 8 * (lane & 3)) ^ (vsw << 6)), voff1 = voff0 ^ 64;
    const float NEG = -INFINITY;
    f32x16 o0, o1;
#pragma unroll
    for (int i = 0; i < 16; ++i) { o0[i] = 0.f; o1[i] = 0.f; }
    const LAS unsigned char* kbp = KL + kb0 * 4096; const LAS unsigned char* vbp = VL + kb0 * 4096;
#pragma unroll
    for (int kbi = 0; kbi < 5; ++kbi) {
        if (kbi >= kstart) {
            f32x16 p;
#pragma unroll
            for (int i = 0; i < 16; ++i) p[i] = 0.f;
#pragma unroll
            for (int s4 = 0; s4 < 4; ++s4) { const bf16x8 kf = *(const LAS bf16x8*)(kbp + kbi * 4096 + koff[s4]); p = __builtin_amdgcn_mfma_f32_32x32x16_bf16(kf, qf[s4], p, 0, 0, 0); }
            if (kbi == 0) {
#pragma unroll
                for (int i = 0; i < 16; ++i) { const int x = (i & 3) + 8 * (i >> 2) + 4 * h; if (x < c + (KIND == 0 ? 0 : 1)) p[i] = NEG; }
            }
            if (kbi == 4) {
#pragma unroll
                for (int i = 0; i < 16; ++i) { const int x = (i & 3) + 8 * (i >> 2) + 4 * h; if (x > c) p[i] = NEG; }
            }
            float mt = p[0];
#pragma unroll
            for (int i = 1; i < 16; ++i) mt = fmaxf(mt, p[i]);
            mt = half_max(mt);
            const float mn = fmaxf(m, mt), alpha = __builtin_amdgcn_exp2f(m - mn);
            m = mn;
            float ps = 0.f;
#pragma unroll
            for (int i = 0; i < 16; ++i) { p[i] = __builtin_amdgcn_exp2f(p[i] - mn); ps += p[i]; }
            l = l * alpha + ps;
#pragma unroll
            for (int i = 0; i < 16; ++i) { o0[i] *= alpha; o1[i] *= alpha; }
            bf16x8 pb[2];
#pragma unroll
            for (int s2 = 0; s2 < 2; ++s2) { v4u t; t.x = cvtpk(p[8 * s2 + 0], p[8 * s2 + 1]); t.y = cvtpk(p[8 * s2 + 2], p[8 * s2 + 3]); t.z = cvtpk(p[8 * s2 + 4], p[8 * s2 + 5]); t.w = cvtpk(p[8 * s2 + 6], p[8 * s2 + 7]); pb[s2] = __builtin_bit_cast(bf16x8, t); }
#pragma unroll
            for (int s2 = 0; s2 < 2; ++s2) {
#pragma unroll
                for (int db = 0; db < 2; ++db) {
                    const LAS unsigned char* vp = vbp + kbi * 4096 + s2 * 2048 + (db ? voff1 : voff0);
                    const v4i16_t lo = __builtin_amdgcn_ds_read_tr16_b64_v4i16((LAS v4i16_t*)vp);
                    const v4i16_t hi = __builtin_amdgcn_ds_read_tr16_b64_v4i16((LAS v4i16_t*)(vp + 1024));
                    const bf16x8 vf = {lo[0], lo[1], lo[2], lo[3], hi[0], hi[1], hi[2], hi[3]};
                    if (db == 0) o0 = __builtin_amdgcn_mfma_f32_32x32x16_bf16(vf, pb[s2], o0, 0, 0, 0);
                    else o1 = __builtin_amdgcn_mfma_f32_32x32x16_bf16(vf, pb[s2], o1, 0, 0, 0);
                }
            }
        }
    }
    const float lt = half_sum(l), inv = 1.0f / lt;
#pragma unroll
    for (int g4 = 0; g4 < 4; ++g4) {
        v2u a, b;
        a.x = cvtpk(o0[4 * g4 + 0] * inv, o0[4 * g4 + 1] * inv); a.y = cvtpk(o0[4 * g4 + 2] * inv, o0[4 * g4 + 3] * inv);
        b.x = cvtpk(o1[4 * g4 + 0] * inv, o1[4 * g4 + 1] * inv); b.y = cvtpk(o1[4 * g4 + 2] * inv, o1[4 * g4 + 3] * inv);
        *(GAS v2u*)(Op + 8 * g4 + 4 * h) = a;
        *(GAS v2u*)(Op + 32 + 8 * g4 + 4 * h) = b;
    }
    if (KIND == 0) { if (h == 0) *Lp = m + __builtin_amdgcn_logf(lt); }
    __syncthreads();
}
__device__ __forceinline__ void p2_attn(Frame& F, int ch) {
    constexpr int NUA = (TC / SEQ) * 3 * 8 * 16, NUB = (TC / SEQ) * 2 * 128;
    for (int u = F.vcu; u < NUA + NUB; u += F.G) {
        if (u < NUA) attn_unit<0>(F, ch, u); else attn_unit<1>(F, ch, u - NUA);
    }
}
__device__ __forceinline__ void p2_combine(Frame& F, int ch) {
    int tid_ = threadIdx.x; asm volatile("" : "+v"(tid_)); const int lane_ = tid_ & 63;
    unsigned char* ws = F.ws;
    const bf16* OG = (const bf16*)(ws + WS_OG); const float* LSE = (const float*)(ws + WS_LSE);
    bf16* Y = (bf16*)(ws + WS_Y) + (size_t)ch * TC * Y_W;
    const int lane = lane_, hd = lane >> 3;
    const int gw = F.vcu * NWAVES + F.wave, NGW = F.G * NWAVES;
    for (int row = gw; row < TC; row += NGW) {
        float lg[3]; v4u og[3];
#pragma unroll
        for (int g = 0; g < 3; ++g) { lg[g] = LSE[((size_t)g * TC + row) * 8 + hd]; og[g] = *(const GAS v4u*)(OG + ((size_t)g * TC + row) * 512 + lane * 8); }
        const float mx = fmaxf(fmaxf(lg[0], lg[1]), lg[2]);
        float e[3]; e[0] = __builtin_amdgcn_exp2f(lg[0] - mx); e[1] = __builtin_amdgcn_exp2f(lg[1] - mx); e[2] = __builtin_amdgcn_exp2f(lg[2] - mx);
        const float inv = 1.0f / (e[0] + e[1] + e[2]);
        float acc[8];
#pragma unroll
        for (int i = 0; i < 8; ++i) acc[i] = 0.f;
#pragma unroll
        for (int g = 0; g < 3; ++g) { const float wg = e[g] * inv;
            acc[0] += wg * bflo(og[g].x); acc[1] += wg * bfhi(og[g].x); acc[2] += wg * bflo(og[g].y); acc[3] += wg * bfhi(og[g].y);
            acc[4] += wg * bflo(og[g].z); acc[5] += wg * bfhi(og[g].z); acc[6] += wg * bflo(og[g].w); acc[7] += wg * bfhi(og[g].w); }
        v4u o; o.x = cvtpk(acc[0], acc[1]); o.y = cvtpk(acc[2], acc[3]); o.z = cvtpk(acc[4], acc[5]); o.w = cvtpk(acc[6], acc[7]);
        *(GAS v4u*)(Y + (size_t)row * Y_W + lane * 8) = o;
    }
}


namespace pg9 {
using pg8::BM; using pg8::BK; using pg8::HALF; using pg8::HTB; using pg8::lds_byte; using pg8::stage_rc; using pg8::perm32;
struct Unit { int pm, pn, e; };
template <class Epi, class Sched, class AOff, class BBase>
__device__ __forceinline__ void gemm_phase(LAS unsigned char* lds, const char* Abase, int K, const Sched& S, const Epi& E, const AOff& aoffn, const BBase& bbase) {
    int tid_ = threadIdx.x; asm volatile("" : "+v"(tid_));
    const int tid = tid_, wid = __builtin_amdgcn_readfirstlane(tid >> 6), lane = tid & 63, wr = wid >> 2, wc = wid & 3, fr = lane & 15, fq = lane >> 4;
    const int nt = K / BK;
    int Rr[2], Cc[2]; unsigned voffB[2];
#pragma unroll
    for (int i = 0; i < 2; ++i) { int R, C; stage_rc(tid * 16 + i * 8192, R, C); const int Rb = Epi::PERM ? ((R & ~31) + perm32(R & 31)) : R; Rr[i] = R; Cc[i] = C; voffB[i] = (unsigned)(Rb * K + C) * 2u; }
    const size_t kstep = (size_t)(BK * 2);
    const size_t hstep = (size_t)HALF * K * 2;
    const unsigned ldsw = (unsigned)wid * 1024u;
    const int aoff = lds_byte(wr * 64 + fr, fq * 8), boff = lds_byte(wc * 32 + fr, fq * 8);
#define PG9_SA(b, h) (((b) * 2 + (h)) * HTB)
#define PG9_SB(b, h) ((4 + (b) * 2 + (h)) * HTB)
#define PG9_STAGE(bufoff, gbase, voff) do { _Pragma("unroll") for (int _i = 0; _i < 2; ++_i) \
        __builtin_amdgcn_global_load_lds((const unsigned*)((const char*)(gbase) + (voff)[_i]), (LAS unsigned*)(lds + (bufoff) + ldsw + _i * 8192), 16, 0, 0); } while (0)
#define PG9_LDA(dst, b, h) do { _Pragma("unroll") for (int m = 0; m < 4; ++m) _Pragma("unroll") for (int k = 0; k < 2; ++k) dst[m][k] = *(const LAS bf16x8*)(lds + PG9_SA(b, h) + aoff + m * 2048 + k * 1024); } while (0)
#define PG9_LDB(dst, b, h) do { _Pragma("unroll") for (int n = 0; n < 2; ++n) _Pragma("unroll") for (int k = 0; k < 2; ++k) dst[n][k] = *(const LAS bf16x8*)(lds + PG9_SB(b, h) + boff + n * 2048 + k * 1024); } while (0)
#define PG9_MMA(ai, bj, At, Bt) do { __builtin_amdgcn_s_setprio(1); _Pragma("unroll") for (int m = 0; m < 4; ++m) _Pragma("unroll") for (int n = 0; n < 2; ++n) _Pragma("unroll") for (int k = 0; k < 2; ++k) \
        acc[ai][bj][m][n] = __builtin_amdgcn_mfma_f32_16x16x32_bf16(Bt[n][k], At[m][k], acc[ai][bj][m][n], 0, 0, 0); __builtin_amdgcn_s_setprio(0); } while (0)
#define PG9_WAIT_V(n) asm volatile("s_waitcnt vmcnt(" #n ")" ::: "memory")
#define PG9_WAIT_L(n) asm volatile("s_waitcnt lgkmcnt(" #n ")" ::: "memory")
#define PG9_BAR __builtin_amdgcn_s_barrier()
#define PG9_SCHED __builtin_amdgcn_sched_barrier(0)
#define PG9_VA(dst, u) do { _Pragma("unroll") for (int _h = 0; _h < 2; ++_h) _Pragma("unroll") for (int _i = 0; _i < 2; ++_i) dst[_h][_i] = aoffn((u), _h * HALF + Rr[_i]) + (unsigned)(Cc[_i] * 2); } while (0)
    Unit cur, nxt; int ui = 0;
    if (!S.next(0, cur)) return;
    f32x4 acc[2][2][4][2];
#pragma unroll
    for (int a = 0; a < 2; ++a)
#pragma unroll
        for (int b = 0; b < 2; ++b)
#pragma unroll
            for (int m = 0; m < 4; ++m)
#pragma unroll
                for (int n = 0; n < 2; ++n) acc[a][b][m][n] = (f32x4){0.f, 0.f, 0.f, 0.f};
    bf16x8 At[4][2], B0[2][2], B1[2][2];
    unsigned cvA[2][2], nvA[2][2];
    PG9_VA(cvA, cur);
    const char* cB = bbase(cur);
    PG9_STAGE(PG9_SB(0, 0), cB, voffB); PG9_STAGE(PG9_SB(0, 1), cB + hstep, voffB); PG9_STAGE(PG9_SA(0, 0), Abase, cvA[0]); PG9_STAGE(PG9_SA(0, 1), Abase, cvA[1]);
    if (wr == 1) PG9_BAR;
    PG9_WAIT_V(2); PG9_BAR;
    PG9_STAGE(PG9_SB(1, 0), cB + kstep, voffB); PG9_STAGE(PG9_SA(1, 0), Abase + kstep, cvA[0]); PG9_STAGE(PG9_SB(1, 1), cB + hstep + kstep, voffB);
    PG9_WAIT_V(6); PG9_BAR;
    for (;;) {
        const bool has_next = S.next(ui + 1, nxt);
        if (has_next) { PG9_VA(nvA, nxt); } else {
#pragma unroll
            for (int _h = 0; _h < 2; ++_h)
#pragma unroll
                for (int _i = 0; _i < 2; ++_i) nvA[_h][_i] = cvA[_h][_i]; }
        const char* nB = has_next ? bbase(nxt) : cB;
#pragma unroll 1
        for (int t = 0; t < nt; t += 2) {
            const bool last = (t == nt - 2);
            if (Epi::HOOK_T >= 0) { if (t == Epi::HOOK_T) E.hook(acc, cur, wr, wc, fr, fq); }
            const char* a1 = Abase + (size_t)(t + 1) * kstep;
            const char* a2 = last ? Abase : Abase + (size_t)(t + 2) * kstep; const char* b2 = last ? nB : cB + (size_t)(t + 2) * kstep;
            const char* a3 = a2 + kstep; const char* b3 = b2 + kstep;
            unsigned v2[2][2];
#pragma unroll
            for (int _h = 0; _h < 2; ++_h)
#pragma unroll
                for (int _i = 0; _i < 2; ++_i) v2[_h][_i] = last ? nvA[_h][_i] : cvA[_h][_i];
            PG9_LDB(B0, 0, 0); PG9_LDB(B1, 0, 1); PG9_SCHED; PG9_LDA(At, 0, 0); PG9_STAGE(PG9_SA(1, 1), a1, cvA[1]);
            PG9_WAIT_V(8); PG9_WAIT_L(0); PG9_BAR; PG9_MMA(0, 0, At, B0); PG9_MMA(0, 1, At, B1); PG9_BAR; PG9_SCHED;
            PG9_LDA(At, 0, 1); PG9_STAGE(PG9_SB(0, 0), b2, voffB); PG9_STAGE(PG9_SB(0, 1), b2 + hstep, voffB); PG9_STAGE(PG9_SA(0, 0), a2, v2[0]);
            PG9_WAIT_V(8); PG9_WAIT_L(0); PG9_BAR; PG9_MMA(1, 0, At, B0); PG9_MMA(1, 1, At, B1); PG9_BAR; PG9_SCHED;
            PG9_LDB(B0, 1, 0); PG9_LDB(B1, 1, 1); PG9_SCHED; PG9_LDA(At, 1, 0); PG9_STAGE(PG9_SA(0, 1), a2, v2[1]);
            PG9_WAIT_V(8); PG9_WAIT_L(0); PG9_BAR; PG9_MMA(0, 0, At, B0); PG9_MMA(0, 1, At, B1); PG9_BAR; PG9_SCHED;
            PG9_LDA(At, 1, 1); PG9_STAGE(PG9_SB(1, 0), b3, voffB); PG9_STAGE(PG9_SB(1, 1), b3 + hstep, voffB); PG9_STAGE(PG9_SA(1, 0), a3, v2[0]);
            PG9_WAIT_V(8); PG9_WAIT_L(0); PG9_BAR; PG9_MMA(1, 0, At, B0); PG9_MMA(1, 1, At, B1); PG9_BAR; PG9_SCHED;
        }
        if (wr == 0) PG9_BAR;
        E(acc, cur, wr, wc, fr, fq);
        if (!has_next) break;
#pragma unroll
        for (int a = 0; a < 2; ++a)
#pragma unroll
            for (int b = 0; b < 2; ++b)
#pragma unroll
                for (int m = 0; m < 4; ++m)
#pragma unroll
                    for (int n = 0; n < 2; ++n) acc[a][b][m][n] = (f32x4){0.f, 0.f, 0.f, 0.f};
        cur = nxt; cB = nB; ++ui;
#pragma unroll
        for (int _h = 0; _h < 2; ++_h)
#pragma unroll
            for (int _i = 0; _i < 2; ++_i) cvA[_h][_i] = nvA[_h][_i];
        if (wr == 1) PG9_BAR;
    }
    PG9_WAIT_V(0);
    PG9_BAR;
#undef PG9_SA
#undef PG9_SB
#undef PG9_STAGE
#undef PG9_LDA
#undef PG9_LDB
#undef PG9_MMA
#undef PG9_WAIT_V
#undef PG9_WAIT_L
#undef PG9_BAR
#undef PG9_SCHED
#undef PG9_VA
}
struct DenseOrder { pg8::StaticOrder so;
    __device__ void init(int M, int N, int G, int c) { so.init(M, N, G, c); }
    __device__ bool next(int i, Unit& u) const { pg8::Unit v; if (!so.next(i, v)) return false; u.pm = v.pm; u.pn = v.pn; u.e = 0; return true; } };
struct DenseA { unsigned rowbytes; __device__ __forceinline__ unsigned operator()(const Unit& u, int row) const { return (unsigned)(u.pm * 256 + row) * rowbytes; } };
struct DenseB { const char* Bt; size_t tilebytes; __device__ __forceinline__ const char* operator()(const Unit& u) const { return Bt + (size_t)u.pn * tilebytes; } };
}

struct EpiMerge {
    static constexpr bool PERM = true; static constexpr int HOOK_T = 8;
    const bf16* Gt; bf16* MG;
    __device__ __forceinline__ void hook(f32x4 (&acc)[2][2][4][2], const pg9::Unit& u, int wr, int wc, int fr, int fq) const {
        const bf16* gr = Gt + (size_t)(u.pm * 256 + wr * 64 + fr) * G_W + u.pn * 256 + wc * 32 + 8 * fq;
#pragma unroll
        for (int ai = 0; ai < 2; ++ai)
#pragma unroll
            for (int m = 0; m < 4; ++m) {
                asm volatile("" : "+v"(gr));
#pragma unroll
                for (int bj = 0; bj < 2; ++bj) { const v4u a = *(const GAS v4u*)(gr + bj * 128), b = *(const GAS v4u*)(gr + 1024 + bj * 128);
                    f32x4 r0, r1;
                    r0[0] = bflo(a.x) / bflo(b.x); r0[1] = bfhi(a.x) / bfhi(b.x); r0[2] = bflo(a.y) / bflo(b.y); r0[3] = bfhi(a.y) / bfhi(b.y);
                    r1[0] = bflo(a.z) / bflo(b.z); r1[1] = bfhi(a.z) / bfhi(b.z); r1[2] = bflo(a.w) / bflo(b.w); r1[3] = bfhi(a.w) / bfhi(b.w);
                    acc[ai][bj][m][0] = acc[ai][bj][m][0] * r0; acc[ai][bj][m][1] = acc[ai][bj][m][1] * r1; }
                gr += (m == 3 ? (128 - 48) : 16) * G_W; }
    }
    __device__ __forceinline__ void operator()(const f32x4 (&acc)[2][2][4][2], const pg9::Unit& u, int wr, int wc, int fr, int fq) const {
        const bf16* gr = Gt + (size_t)(u.pm * 256 + wr * 64 + fr) * G_W + 1024 + u.pn * 256 + wc * 32 + 8 * fq;
        bf16* mr = MG + (size_t)(u.pm * 256 + wr * 64 + fr) * D + u.pn * 256 + wc * 32 + 8 * fq;
#pragma unroll
        for (int ai = 0; ai < 2; ++ai)
#pragma unroll
            for (int m = 0; m < 4; ++m) {
                asm volatile("" : "+v"(gr), "+v"(mr));
#pragma unroll
                for (int bj = 0; bj < 2; ++bj) { const v4u b = *(const GAS v4u*)(gr + bj * 128);
                    const f32x4 v0 = acc[ai][bj][m][0], v1 = acc[ai][bj][m][1];
                    v4u w; w.x = cvtpk(v0[0] * bflo(b.x), v0[1] * bfhi(b.x)); w.y = cvtpk(v0[2] * bflo(b.y), v0[3] * bfhi(b.y));
                    w.z = cvtpk(v1[0] * bflo(b.z), v1[1] * bfhi(b.z)); w.w = cvtpk(v1[2] * bflo(b.w), v1[3] * bfhi(b.w));
                    *(GAS v4u*)(mr + bj * 128) = w; }
                gr += (m == 3 ? (128 - 48) : 16) * G_W; mr += (m == 3 ? (128 - 48) : 16) * D; }
    }
};
__device__ __forceinline__ void p3_merge(Frame& F) {
    unsigned char* ws = F.ws;
    pg9::DenseOrder S; S.init(T, D, F.G, (int)blockIdx.x);
    EpiMerge E{(const bf16*)(ws + WS_G), (bf16*)(ws + WS_MG)};
    pg9::DenseA ao{(unsigned)(Y_W * 2)}; pg9::DenseB bb{(const char*)(ws + WS_WAB), (size_t)256 * Y_W * 2};
    pg9::gemm_phase(F.lds, (const char*)(ws + WS_Y), Y_W, S, E, ao, bb);
}
struct EpiOut {
    static constexpr bool PERM = false; static constexpr int HOOK_T = -1;
    const float* X; float* X1; bf16* X1B;
    __device__ __forceinline__ void hook(f32x4 (&)[2][2][4][2], const pg9::Unit&, int, int, int, int) const {}
    __device__ __forceinline__ void operator()(const f32x4 (&acc)[2][2][4][2], const pg9::Unit& u, int wr, int wc, int fr, int fq) const {
        const int row0 = u.pm * 256 + wr * 64 + fr, col0 = u.pn * 256 + wc * 32 + 4 * fq;
#pragma unroll
        for (int ai = 0; ai < 2; ++ai)
#pragma unroll
            for (int m = 0; m < 4; ++m) { const size_t off = (size_t)(row0 + ai * 128 + m * 16) * D + col0;
#pragma unroll
                for (int bj = 0; bj < 2; ++bj)
#pragma unroll
                    for (int n = 0; n < 2; ++n) { const f32x4 xv = *(const GAS f32x4*)(X + off + bj * 128 + n * 16) + acc[ai][bj][m][n]; *(GAS f32x4*)(X1 + off + bj * 128 + n * 16) = xv;
                        v2u w; w.x = cvtpk(xv[0], xv[1]); w.y = cvtpk(xv[2], xv[3]); *(GAS v2u*)(X1B + off + bj * 128 + n * 16) = w; }
                asm volatile("" ::: "memory"); }
    }
};
__device__ __forceinline__ void p4_outproj(Frame& F) {
    unsigned char* ws = F.ws;
    pg9::DenseOrder S; S.init(T, D, F.G, (int)blockIdx.x);
    EpiOut E{F.in[I_X], F.out, (bf16*)(ws + WS_HN)};
    pg9::DenseA ao{(unsigned)(D * 2)}; pg9::DenseB bb{(const char*)(ws + WS_WO), (size_t)256 * D * 2};
    pg9::gemm_phase(F.lds, (const char*)(ws + WS_MG), D, S, E, ao, bb);
}

__device__ __forceinline__ void p5_route(Frame& F) {
    int tid_ = threadIdx.x; asm volatile("" : "+v"(tid_)); const int lane = tid_ & 63;
    unsigned char* ws = F.ws;
    const float* X1 = F.out; const f32x4* WRF = (const f32x4*)(ws + WS_WRF);
    unsigned* cnt = (unsigned*)(ws + WS_CTL) + CW_CNT;
    int* tokof = (int*)(ws + WS_TOKOF); float2* wtof = (float2*)(ws + WS_WTOF); int4* tpos = (int4*)(ws + WS_TPOS);
    LAS float* sl = (LAS float*)(F.lds + F.wave * 4096);
    const int i = lane & 15, q = lane >> 4;
    for (int tile = F.vcu * NWAVES + F.wave; tile < T / 16; tile += F.G * NWAVES) {
        const float* xr = X1 + (size_t)(tile * 16 + i) * D + 4 * q;
        f32x4 a0 = {0.f, 0.f, 0.f, 0.f}, a1 = a0, a2 = a0; float ss = 0.f;
#pragma unroll 2
        for (int s = 0; s < 64; ++s) {
            const f32x4 v = *(const GAS f32x4*)(xr + 16 * s);
            const f32x4 w0 = WRF[(s * 3 + 0) * 64 + lane], w1 = WRF[(s * 3 + 1) * 64 + lane], w2 = WRF[(s * 3 + 2) * 64 + lane];
            ss += (v[0] * v[0] + v[1] * v[1]) + (v[2] * v[2] + v[3] * v[3]);
#pragma unroll
            for (int c = 0; c < 4; ++c) { a0 = __builtin_amdgcn_mfma_f32_16x16x4f32(v[c], w0[c], a0, 0, 0, 0); a1 = __builtin_amdgcn_mfma_f32_16x16x4f32(v[c], w1[c], a1, 0, 0, 0); a2 = __builtin_amdgcn_mfma_f32_16x16x4f32(v[c], w2[c], a2, 0, 0, 0); }
        }
        ss += __shfl_xor(ss, 16); ss += __shfl_xor(ss, 32);
#pragma unroll
        for (int r = 0; r < 4; ++r) { sl[(4 * q + r) * 48 + i] = a0[r]; sl[(4 * q + r) * 48 + 16 + i] = a1[r]; sl[(4 * q + r) * 48 + 32 + i] = a2[r]; }
        LDS_WAIT(); asm volatile("" ::: "memory");
        if (lane < 16) {
            const int row = tile * 16 + lane;
            const float rstd = 1.0f / sqrtf(ss * (1.f / D) + RMS_EPS);
            float lg[36];
#pragma unroll
            for (int o = 0; o < 36; ++o) lg[o] = sl[lane * 48 + o] * rstd + (o < 4 ? F.in[I_BRG][o] : F.in[I_BRE][o - 4]);
            int gsel = 0; float gmax = lg[0];
#pragma unroll
            for (int k = 1; k < 4; ++k) if (lg[k] > gmax) { gmax = lg[k]; gsel = k; }
            float gden = 0.f;
#pragma unroll
            for (int k = 0; k < 4; ++k) gden += __expf(lg[k] - gmax);
            const float pg = 1.0f / gden;
            float le[8];
#pragma unroll
            for (int j = 0; j < 8; ++j) { le[j] = lg[4 + j];
#pragma unroll
                for (int gi = 1; gi < 4; ++gi) le[j] = (gsel == gi) ? lg[4 + gi * 8 + j] : le[j]; }
            int i1 = 0; float m1 = le[0];
#pragma unroll
            for (int j = 1; j < 8; ++j) if (le[j] > m1) { m1 = le[j]; i1 = j; }
            int i2 = -1; float m2 = -INFINITY;
#pragma unroll
            for (int j = 0; j < 8; ++j) if (j != i1 && le[j] > m2) { m2 = le[j]; i2 = j; }
            const float e2 = __expf(m2 - m1);
            const float w1 = pg / (1.0f + e2), w2 = pg * e2 / (1.0f + e2);
            const int e0 = gsel * 8 + i1, e1 = gsel * 8 + i2;
            const int p0 = (int)atomicAdd(&cnt[e0], 1u), p1 = (int)atomicAdd(&cnt[e1], 1u);
            tokof[(size_t)e0 * T + p0] = row; wtof[(size_t)e0 * T + p0] = make_float2(w1, rstd);
            tokof[(size_t)e1 * T + p1] = row; wtof[(size_t)e1 * T + p1] = make_float2(w2, rstd);
            tpos[row] = make_int4(e0, p0, e1, p1);
        }
        LDS_WAIT(); asm volatile("" ::: "memory");
    }
}

__device__ __forceinline__ void expert_tiles(Frame& F, LAS int* tb, LAS int* cn) {
    int tid_ = threadIdx.x; asm volatile("" : "+v"(tid_)); const int lane_ = tid_ & 63;
    if (tid_ == 0) {
        const unsigned* cnt = (const unsigned*)(F.ws + WS_CTL) + CW_CNT;
        int acc = 0;
        for (int e = 0; e < NE; ++e) { const int c = (int)__hip_atomic_load(cnt + e, __ATOMIC_RELAXED, __HIP_MEMORY_SCOPE_AGENT); cn[e] = c; tb[e] = acc; acc += (c + 255) >> 8; }
        tb[NE] = acc;
    }
    __syncthreads();
}

struct MoeOrder { const LAS int* tb; int ncol, G, c;
    __device__ bool next(int i, pg9::Unit& u) const {
        const int L = i * G + c; if (L >= tb[NE] * ncol) return false;
        const int rt = L / ncol; int e = 0;
        for (int k = 1; k < NE; ++k) if (tb[k] <= rt) e = k;
        u.pm = rt; u.pn = L % ncol; u.e = e; return true; } };
struct GatherA { const int* tokof; const LAS int* tb; const LAS int* cn;
    __device__ __forceinline__ unsigned operator()(const pg9::Unit& u, int row) const {
        const int p = (u.pm - tb[u.e]) * 256 + row; const int tok = tokof[(size_t)u.e * T + (p < cn[u.e] ? p : 0)]; return (unsigned)tok * (unsigned)(D * 2); } };
struct ExpertB { const char* W; size_t ebytes, tilebytes; __device__ __forceinline__ const char* operator()(const pg9::Unit& u) const { return W + (size_t)u.e * ebytes + (size_t)u.pn * tilebytes; } };
struct EpiGateUp {
    static constexpr bool PERM = true; static constexpr int HOOK_T = -1;
    const float2* wtof; bf16* HACT; const LAS int* tb; const LAS int* cn;
    __device__ __forceinline__ void hook(f32x4 (&)[2][2][4][2], const pg9::Unit&, int, int, int, int) const {}
    __device__ __forceinline__ void operator()(const f32x4 (&acc)[2][2][4][2], const pg9::Unit& u, int wr, int wc, int fr, int fq) const {
        const int r0 = wr * 64 + fr, p0 = (u.pm - tb[u.e]) * 256, ce = cn[u.e];
        const float2* wp = wtof + (size_t)u.e * T;
#pragma unroll
        for (int ai = 0; ai < 2; ++ai)
#pragma unroll
            for (int m = 0; m < 4; ++m) { const int r = r0 + ai * 128 + m * 16, p = p0 + r;
                const float2 wr2 = p < ce ? wp[p] : make_float2(0.f, 0.f); const float w = wr2.x, rs = wr2.y;
                bf16* orow = HACT + (size_t)(u.pm * 256 + r) * DE + u.pn * 128 + wc * 16 + 4 * fq;
#pragma unroll
                for (int bj = 0; bj < 2; ++bj) { const f32x4 g = acc[ai][bj][m][0], uu = acc[ai][bj][m][1]; f32x4 hv;
#pragma unroll
                    for (int e = 0; e < 4; ++e) { const float gg = g[e] * rs; hv[e] = gg / (1.0f + __expf(-gg)) * (uu[e] * rs) * w; }
                    v2u o; o.x = cvtpk(hv[0], hv[1]); o.y = cvtpk(hv[2], hv[3]); *(GAS v2u*)(orow + bj * 64) = o; }
                asm volatile("" ::: "memory"); }
    }
};
__device__ __forceinline__ void p6a_gateup(Frame& F) {
    unsigned char* ws = F.ws;
    LAS int* tb = (LAS int*)(F.lds + LDS_MISC + 1024); LAS int* cn = tb + 64;
    expert_tiles(F, tb, cn);
    MoeOrder S{tb, 2, F.G, F.vcu};
    GatherA ao{(const int*)(ws + WS_TOKOF), tb, cn}; ExpertB bb{(const char*)(ws + WS_WGU), (size_t)512 * D * 2, (size_t)256 * D * 2};
    EpiGateUp E{(const float2*)(ws + WS_WTOF), (bf16*)(ws + WS_HACT), tb, cn};
    pg9::gemm_phase(F.lds, (const char*)(ws + WS_HN), D, S, E, ao, bb);
}
struct EpiDown {
    static constexpr bool PERM = true; static constexpr int HOOK_T = -1;
    bf16* YS;
    __device__ __forceinline__ void hook(f32x4 (&)[2][2][4][2], const pg9::Unit&, int, int, int, int) const {}
    __device__ __forceinline__ void operator()(const f32x4 (&acc)[2][2][4][2], const pg9::Unit& u, int wr, int wc, int fr, int fq) const {
#pragma unroll
        for (int ai = 0; ai < 2; ++ai)
#pragma unroll
            for (int m = 0; m < 4; ++m) { bf16* orow = YS + (size_t)(u.pm * 256 + wr * 64 + fr + ai * 128 + m * 16) * D + u.pn * 256 + wc * 32 + 8 * fq;
#pragma unroll
                for (int bj = 0; bj < 2; ++bj) { const f32x4 v0 = acc[ai][bj][m][0], v1 = acc[ai][bj][m][1];
                    v4u w; w.x = cvtpk(v0[0], v0[1]); w.y = cvtpk(v0[2], v0[3]); w.z = cvtpk(v1[0], v1[1]); w.w = cvtpk(v1[2], v1[3]); *(GAS v4u*)(orow + bj * 128) = w; }
                asm volatile("" ::: "memory"); }
    }
};
__device__ __forceinline__ void p6b_down(Frame& F) {
    unsigned char* ws = F.ws;
    LAS int* tb = (LAS int*)(F.lds + LDS_MISC + 1024); LAS int* cn = tb + 64;
    expert_tiles(F, tb, cn);
    MoeOrder S{tb, 4, F.G, F.vcu};
    pg9::DenseA ao{(unsigned)(DE * 2)}; ExpertB bb{(const char*)(ws + WS_WD), (size_t)D * DE * 2, (size_t)256 * DE * 2};
    EpiDown E{(bf16*)(ws + WS_YS)};
    pg9::gemm_phase(F.lds, (const char*)(ws + WS_HACT), DE, S, E, ao, bb);
}
__device__ __forceinline__ void p7_final(Frame& F) {
    int tid_ = threadIdx.x; asm volatile("" : "+v"(tid_)); const int lane_ = tid_ & 63;
    unsigned char* ws = F.ws;
    LAS int* tb = (LAS int*)(F.lds + LDS_MISC + 1024); LAS int* cn = tb + 64;
    expert_tiles(F, tb, cn);
    const bf16* YS = (const bf16*)(ws + WS_YS); const int4* tpos = (const int4*)(ws + WS_TPOS);
    float* X1 = F.out;
    const int lane = lane_;
    const int gw = F.vcu * NWAVES + F.wave, NGW = F.G * NWAVES;
    const GAS f32x4* gr = (const GAS f32x4*)F.in[I_GFIN] + lane;
    for (int row = gw; row < T; row += NGW) {
        const int4 tp = tpos[row];
        const size_t s0 = (size_t)tb[tp.x] * 256 + tp.y, s1 = (size_t)tb[tp.z] * 256 + tp.w;
        GAS f32x4* xr = (GAS f32x4*)(X1 + (size_t)row * D) + lane;
        const GAS v2u* y0 = (const GAS v2u*)(YS + s0 * D) + lane; const GAS v2u* y1 = (const GAS v2u*)(YS + s1 * D) + lane;
        f32x4 v[4]; float s = 0.f;
#pragma unroll
        for (int j = 0; j < 4; ++j) { v[j] = xr[64 * j]; const v2u a = y0[64 * j], b = y1[64 * j];
            v[j].x += bflo(a.x) + bflo(b.x); v[j].y += bfhi(a.x) + bfhi(b.x); v[j].z += bflo(a.y) + bflo(b.y); v[j].w += bfhi(a.y) + bfhi(b.y);
            s += (v[j].x * v[j].x + v[j].y * v[j].y) + (v[j].z * v[j].z + v[j].w * v[j].w); }
        const float rstd = 1.0f / sqrtf(wave_sum(s) * (1.f / D) + RMS_EPS);
#pragma unroll
        for (int j = 0; j < 4; ++j) { const f32x4 gg = gr[64 * j]; f32x4 o; o.x = v[j].x * rstd * gg.x; o.y = v[j].y * rstd * gg.y; o.z = v[j].z * rstd * gg.z; o.w = v[j].w * rstd * gg.w; xr[64 * j] = o; }
    }
}

constexpr int NPHASE = 1 + 3 * NCH + 6;
__global__ void __launch_bounds__(NTHR, 2) fwd_kernel(KArgs args) {
    extern __shared__ __attribute__((aligned(16))) unsigned char lds_raw[];
    Frame F;
    F.lds = (LAS unsigned char*)lds_raw;
    F.tid = threadIdx.x; F.lane = F.tid & 63; F.wave = __builtin_amdgcn_readfirstlane(F.tid >> 6);
    F.G = gridDim.x; { const int bx = blockIdx.x; F.vcu = (F.G % 8 == 0) ? (bx % 8) * (F.G / 8) + bx / 8 : bx; }
#pragma unroll
    for (int i = 0; i < 17; ++i) F.in[i] = args.in[i];
    F.out = args.out; F.ws = args.ws;
    volatile LAS unsigned* MISC = (volatile LAS unsigned*)(F.lds + LDS_MISC);
    if (F.tid < 64) MISC[F.tid] = 0u;
    __syncthreads();
    XcdBarrier bar = xcd_barrier_post((unsigned*)(F.ws + WS_CTL) + CW_BAR + args.li * XCD_BAR_WORDS, MISC + 8);
#define IN(k) (args.ph_lo <= (k) && (k) < args.ph_hi)
#define SEAM(k) do { if (IN(k) && IN((k) + 1)) xcd_barrier(bar); } while (0)
    if (IN(0)) p0_prologue(F);
    SEAM(0);
#pragma unroll 1
    for (int ch = 0; ch < NCH; ++ch) {
        if (IN(1 + 3 * ch)) p1_inproj(F, ch);
        SEAM(1 + 3 * ch);
        if (IN(2 + 3 * ch)) p2_attn(F, ch);
        SEAM(2 + 3 * ch);
        if (IN(3 + 3 * ch)) p2_combine(F, ch);
        SEAM(3 + 3 * ch);
    }
    if (IN(3 * NCH + 1)) p3_merge(F);
    SEAM(3 * NCH + 1);
    if (IN(3 * NCH + 2)) p4_outproj(F);
    SEAM(3 * NCH + 2);
    if (IN(3 * NCH + 3)) p5_route(F);
    SEAM(3 * NCH + 3);
    if (IN(3 * NCH + 4)) p6a_gateup(F);
    SEAM(3 * NCH + 4);
    if (IN(3 * NCH + 5)) p6b_down(F);
    SEAM(3 * NCH + 5);
    if (IN(3 * NCH + 6)) p7_final(F);
#undef IN
#undef SEAM
}

#ifndef N_LAUNCHES
#define N_LAUNCHES 1
#endif
extern "C" void kernel_launch(void* const* d_in, const int* in_sizes, int n_in, void* d_out, int out_size, void* d_ws, size_t ws_size, hipStream_t stream) {
    static int grid = 0;
    if (grid == 0) {
        if (n_in != 17 || in_sizes[0] != T * D || out_size != T * D || ws_size < WS_END) { fprintf(stderr, "kernel_launch: unexpected shapes / workspace (%d inputs, ws %zu)\n", n_in, ws_size); grid = -1; return; }
        int dev = 0, cus = 0;
        if (hipGetDevice(&dev) != hipSuccess || hipDeviceGetAttribute(&cus, hipDeviceAttributeMultiprocessorCount, dev) != hipSuccess) { grid = -1; return; }
        if (hipFuncSetAttribute((const void*)fwd_kernel, hipFuncAttributeMaxDynamicSharedMemorySize, LDS_BYTES) != hipSuccess) { fprintf(stderr, "kernel_launch: hipFuncSetAttribute failed\n"); grid = -1; return; }
        int per_cu = 0;
        if (hipOccupancyMaxActiveBlocksPerMultiprocessor(&per_cu, (const void*)fwd_kernel, NTHR, LDS_BYTES) != hipSuccess || per_cu < 1) fprintf(stderr, "kernel_launch: occupancy query says %d\n", per_cu);
        (void)hipGetLastError();
        grid = cus;
    }
    if (grid < 0) return;
    (void)hipMemsetAsync((char*)d_ws + WS_CTL, 0, CTL_BYTES, stream);
    KArgs a{};
    for (int i = 0; i < 17; ++i) a.in[i] = (const float*)d_in[i];
    a.out = (float*)d_out; a.ws = (unsigned char*)d_ws;
    for (int li = 0; li < N_LAUNCHES; ++li) {
        a.ph_lo = (int)((long)NPHASE * li / N_LAUNCHES); a.ph_hi = (int)((long)NPHASE * (li + 1) / N_LAUNCHES); a.li = li;
        hipLaunchKernelGGL(fwd_kernel, dim3(grid), dim3(NTHR), LDS_BYTES, stream, a);
    }
}
```

```cpp
#include <hip/hip_runtime.h>
#include <cstdint>
#include <cstdio>

#define GAS __attribute__((address_space(1)))
#define LAS __attribute__((address_space(3)))
typedef unsigned short bf16;
typedef short bf16x8 __attribute__((ext_vector_type(8)));
typedef float f32x4 __attribute__((ext_vector_type(4)));
typedef unsigned v4u __attribute__((ext_vector_type(4)));
typedef unsigned v2u __attribute__((ext_vector_type(2)));
typedef GAS unsigned gu32;

constexpr int T = 32768, D = 1024, SEQ = 4096, NIN = 7936;
constexpr int A_W = 4608, B_W = 1280, G_W = 2048, Y_W = 1536;
constexpr int NE = 32, DE = 256;
constexpr int NCH = 4, TC = T / NCH;
constexpr float QSCALE = 0.125f * 1.4426950408889634f;
constexpr float LOG2E = 1.4426950408889634f;
constexpr float RMS_EPS = 1e-6f;
#ifndef P1_FP8
#define P1_FP8 0
#endif
constexpr float W8_SCALE = P1_FP8 ? 64.0f : 0.0f, W8_INV = P1_FP8 ? 1.0f / 64.0f : 1.0f;
#ifndef P6_FP8
#define P6_FP8 0
#endif
constexpr float WG8_SCALE = P6_FP8 ? 64.0f : 0.0f, WD8_SCALE = P6_FP8 ? 32.0f : 0.0f, H8_SCALE = 32.0f;
constexpr int NWAVES = 8, NTHR = 512;

constexpr size_t MiB = 1u << 20;
constexpr size_t WS_CTL = 0, CTL_BYTES = 1 * MiB;
constexpr size_t WS_INVF = 1 * MiB;
constexpr size_t WS_WRF = 2 * MiB;
constexpr size_t WS_TOKOF = 3 * MiB;
constexpr size_t WS_WTOF = 7 * MiB;
constexpr size_t WS_TPOS = 15 * MiB;
constexpr size_t WS_WIN = 16 * MiB;
constexpr size_t WS_WAB = 32 * MiB;
constexpr size_t WS_WO = 35 * MiB;
constexpr size_t WS_WGU = 37 * MiB;
constexpr size_t WS_WD = 69 * MiB;
constexpr size_t WS_G = 86 * MiB;
constexpr size_t WS_Y = 214 * MiB;
constexpr size_t WS_ZA = 310 * MiB;
constexpr size_t WS_ZB = 454 * MiB;
constexpr size_t WS_END = 494 * MiB;
constexpr size_t WS_MG = WS_ZA;
constexpr size_t WS_X1B = WS_ZA + 64 * MiB;
constexpr size_t WS_X1F8 = WS_Y + 64 * MiB;
constexpr size_t WS_HACT = WS_G;
constexpr size_t WS_YS = WS_G + 36 * MiB;
constexpr size_t DO_DELTA = 0;
constexpr size_t DO_HN = 0;
constexpr size_t DO_OG = 64 * MiB;
constexpr size_t DO_LSE = 112 * MiB;
constexpr int MAXSLOT = 2 * T + NE * 256;
static_assert(WS_ZA + (size_t)TC * A_W * 2 <= WS_ZB && WS_ZB + (size_t)TC * B_W * 2 <= WS_END && WS_Y + (size_t)T * Y_W * 2 <= WS_ZA && WS_G + (size_t)T * G_W * 2 <= WS_Y, "ws map");
static_assert(WS_MG + (size_t)T * D * 2 <= WS_END && WS_HACT + (size_t)MAXSLOT * DE * 2 <= WS_YS && WS_YS + (size_t)MAXSLOT * D * 2 <= WS_ZA && WS_X1B >= WS_MG + (size_t)T * D * 2 && WS_X1B + (size_t)T * D * 2 <= WS_ZB, "ws map");
static_assert(DO_OG + (size_t)3 * TC * 512 * 2 <= DO_LSE && DO_LSE + (size_t)3 * TC * 8 * 4 <= (size_t)T * D * 4 && DO_HN + (size_t)T * D * 2 <= DO_OG, "d_out scratch map");
constexpr int CW_CNT = 1024;
constexpr int CW_BAR = 4096;
constexpr int LDS_BYTES = 147456;
constexpr int LDS_MISC = 131072;

__device__ __forceinline__ unsigned f2bf(float f) { unsigned u = __builtin_bit_cast(unsigned, f); return (u + 0x7fffu + ((u >> 16) & 1u)) >> 16; }
__device__ __forceinline__ unsigned pk4_fp8(float a, float b, float c, float d) {
    a = __builtin_amdgcn_fmed3f(a, -448.f, 448.f); b = __builtin_amdgcn_fmed3f(b, -448.f, 448.f); c = __builtin_amdgcn_fmed3f(c, -448.f, 448.f); d = __builtin_amdgcn_fmed3f(d, -448.f, 448.f);
    int w = 0; w = __builtin_amdgcn_cvt_pk_fp8_f32(a, b, w, false); w = __builtin_amdgcn_cvt_pk_fp8_f32(c, d, w, true); return (unsigned)w; }
__device__ __forceinline__ unsigned pk2(float lo, float hi) { return f2bf(lo) | (f2bf(hi) << 16); }
__device__ __forceinline__ float bf2f(unsigned b) { return __builtin_bit_cast(float, b << 16); }
__device__ __forceinline__ float bflo(unsigned u) { return __builtin_bit_cast(float, u << 16); }
__device__ __forceinline__ float bfhi(unsigned u) { return __builtin_bit_cast(float, u & 0xffff0000u); }
__device__ __forceinline__ float wave_sum(float v) {
#pragma unroll
    for (int o = 1; o < 64; o <<= 1) v += __shfl_xor(v, o);
    return v;
}
__device__ __forceinline__ float wave_max(float v) {
#pragma unroll
    for (int o = 1; o < 64; o <<= 1) v = fmaxf(v, __shfl_xor(v, o));
    return v;
}
typedef float f32x2_t __attribute__((ext_vector_type(2)));
typedef __bf16 bf16x2_t __attribute__((ext_vector_type(2)));
__device__ __forceinline__ unsigned cvtpk(float lo, float hi) { f32x2_t v = {lo, hi}; bf16x2_t b = __builtin_convertvector(v, bf16x2_t); return __builtin_bit_cast(unsigned, b); }
#ifndef WT_STORES
#define WT_STORES 0
#endif
__device__ __forceinline__ __amdgpu_buffer_rsrc_t wt_rsrc(unsigned char* base) { return __builtin_amdgcn_make_buffer_rsrc(base, 0, 0x7ffffffc, 0x00020000); }
__device__ __forceinline__ void st16(__amdgpu_buffer_rsrc_t r, unsigned char* base, void* p, v4u v) { if (WT_STORES) __builtin_amdgcn_raw_buffer_store_b128(v, r, (unsigned)((unsigned char*)p - base), 0, 16); else *(GAS v4u*)p = v; }
__device__ __forceinline__ void st8(__amdgpu_buffer_rsrc_t r, unsigned char* base, void* p, v2u v) { if (WT_STORES) __builtin_amdgcn_raw_buffer_store_b64(v, r, (unsigned)((unsigned char*)p - base), 0, 16); else *(GAS v2u*)p = v; }
#define LDS_WAIT() asm volatile("s_waitcnt lgkmcnt(0)" ::: "memory")
#define VM_WAIT() asm volatile("s_waitcnt vmcnt(0)" ::: "memory")

#define XB_TMO      128
#define XB_XCNT(j)  (256  + 64 * (j))
#define XB_XSUB(j)  (1280 + 64 * (j))
#define XB_XGEN(j)  (2304 + 64 * (j))
#define XB_TOP      3328
#define XB_TOPGEN   3392
#define XCD_BAR_WORDS 3456
#define XB_SPIN_CAP (1u << 18)
__device__ __forceinline__ unsigned xb_ld(unsigned* p)              { return __hip_atomic_load(p, __ATOMIC_RELAXED, __HIP_MEMORY_SCOPE_AGENT); }
__device__ __forceinline__ unsigned xb_add(unsigned* p, unsigned v) { return __hip_atomic_fetch_add(p, v, __ATOMIC_RELAXED, __HIP_MEMORY_SCOPE_AGENT); }
__device__ __forceinline__ unsigned xb_xcc_id() { return (unsigned)__builtin_amdgcn_s_getreg((3 << 11) | 20) & 0xFu; }
#define XB_SPIN(cond, bar) do { unsigned _sp = 0; while (cond) { __builtin_amdgcn_s_sleep(1); \
    if ((++_sp & 255u) == 0u) { if (xb_ld(&(bar)[XB_TMO])) break; if (_sp > XB_SPIN_CAP) { atomicAdd(&(bar)[XB_TMO], 1u); break; } } } } while (0)
struct XcdBarrier { unsigned* bar; unsigned x; volatile LAS unsigned* st; };
__device__ __forceinline__ XcdBarrier xcd_barrier_post(unsigned* bar, volatile LAS unsigned* st) {
    XcdBarrier b; b.bar = bar; b.x = xb_xcc_id(); b.st = st;
    if (threadIdx.x == 0) (void)xb_add(&bar[XB_XCNT(b.x)], 1u);
    return b;
}
__device__ __forceinline__ void xcd_barrier_complete(unsigned* bar, unsigned x, unsigned& nloc, unsigned& nx) {
    const unsigned G = gridDim.x * gridDim.y * gridDim.z;
    unsigned sum, cnt, mine, sp = 0u;
    for (;;) {
        sum = 0u; cnt = 0u; mine = 0u;
#pragma unroll
        for (unsigned j = 0; j < 16; ++j) { const unsigned c = xb_ld(&bar[XB_XCNT(j)]); sum += c; cnt += (c > 0u) ? 1u : 0u; mine = (j == x) ? c : mine; }
        if (sum == G) break;
        __builtin_amdgcn_s_sleep(1);
        if ((++sp & 255u) == 0u) { if (xb_ld(&bar[XB_TMO])) break; if (sp > XB_SPIN_CAP) { atomicAdd(&bar[XB_TMO], 1u); break; } }
    }
    nloc = mine > 0u ? mine : 1u; nx = cnt > 0u ? cnt : 1u;
}
__device__ __forceinline__ void xcd_barrier(const XcdBarrier& b) {
    asm volatile("s_waitcnt vmcnt(0)" ::: "memory");
    __syncthreads();
    if (threadIdx.x == 0) {
        unsigned* bar = b.bar;
        __builtin_amdgcn_s_waitcnt(0);
        unsigned nloc = b.st[0], nx = b.st[1];
        if (nloc == 0u) { xcd_barrier_complete(bar, b.x, nloc, nx); b.st[0] = nloc; b.st[1] = nx; }
        const unsigned old = xb_add(&bar[XB_XSUB(b.x)], 1u);
        const unsigned gen = old / nloc;
        if (old + 1u == (gen + 1u) * nloc) {
            __builtin_amdgcn_fence(__ATOMIC_RELEASE, "agent");
            asm volatile("s_waitcnt vmcnt(0)" ::: "memory");
            const unsigned og = xb_add(&bar[XB_TOP], 1u);
            const unsigned tg = og / nx;
            if (og + 1u == (tg + 1u) * nx) xb_add(&bar[XB_TOPGEN], 1u);
            else XB_SPIN(xb_ld(&bar[XB_TOPGEN]) == tg, bar);
            __builtin_amdgcn_fence(__ATOMIC_ACQUIRE, "agent");
            xb_add(&bar[XB_XGEN(b.x)], 1u);
            asm volatile("s_waitcnt vmcnt(0)" ::: "memory");
        } else {
            XB_SPIN(xb_ld(&bar[XB_XGEN(b.x)]) == gen, bar);
            __builtin_amdgcn_fence(__ATOMIC_ACQUIRE, "agent");
            asm volatile("s_waitcnt vmcnt(0)" ::: "memory");
        }
    }
    __syncthreads();
}

struct KArgs { const float* in[17]; float* out; unsigned char* ws; int ph_lo, ph_hi, li, pad; };
struct Frame {
    LAS unsigned char* lds;
    int tid, lane, wave, vcu, G;
    const float* in[17]; float* out; unsigned char* ws;
};
enum { I_X = 0, I_WIN, I_BIN, I_SINK, I_WPA, I_WPB, I_WOUT, I_GMIX, I_GFFN, I_WRG, I_BRG, I_WRE, I_BRE, I_WEG, I_WEU, I_WED, I_GFIN };

struct TrDesc { const float* W; int N; bf16* WT; int ldo, rowbase, koff, k0, n0; bool perm; const float* kscale; float f8scale; };
__device__ __forceinline__ void tr_load(const TrDesc& d, int lane, f32x4 (&tv)[8], float (&ks)[8]) {
    const float* src = d.W + (size_t)(d.k0 + (lane >> 3)) * d.N + d.n0 + 4 * (lane & 7);
#pragma unroll
    for (int i = 0; i < 8; ++i) tv[i] = *(const GAS f32x4*)(src + (size_t)(8 * i) * d.N);
#pragma unroll
    for (int i = 0; i < 8; ++i) ks[i] = d.kscale ? d.kscale[d.k0 + 8 * i + (lane >> 3)] : 1.0f;
}
__device__ __forceinline__ void tr_finish(const TrDesc& d, LAS float* scr, int lane, const f32x4 (&tv)[8], const float (&ks)[8]) {
#pragma unroll
    for (int i = 0; i < 8; ++i) { const int kk = 8 * i + (lane >> 3); LAS float* w = scr + kk * 33 + 4 * (lane & 7);
        w[0] = tv[i][0] * ks[i]; w[1] = tv[i][1] * ks[i]; w[2] = tv[i][2] * ks[i]; w[3] = tv[i][3] * ks[i]; }
    LDS_WAIT(); asm volatile("" ::: "memory");
    const int c = lane & 7;
#pragma unroll
    for (int j = 0; j < 4; ++j) { const int n = (lane >> 3) + 8 * j; const LAS float* s = scr + (8 * c) * 33 + n;
        const int rr = d.perm ? 8 * (n >> 2) + (n & 3) : n;
        if (d.f8scale != 0.f) { const float f = d.f8scale; v2u o8; o8.x = pk4_fp8(s[0 * 33] * f, s[1 * 33] * f, s[2 * 33] * f, s[3 * 33] * f); o8.y = pk4_fp8(s[4 * 33] * f, s[5 * 33] * f, s[6 * 33] * f, s[7 * 33] * f);
            *(GAS v2u*)((unsigned char*)d.WT + (size_t)(d.rowbase + rr) * d.ldo + d.koff + d.k0 + 8 * c) = o8; }
        else { v4u o; o.x = pk2(s[0 * 33], s[1 * 33]); o.y = pk2(s[2 * 33], s[3 * 33]); o.z = pk2(s[4 * 33], s[5 * 33]); o.w = pk2(s[6 * 33], s[7 * 33]);
            *(GAS v4u*)(d.WT + (size_t)(d.rowbase + rr) * d.ldo + d.koff + d.k0 + 8 * c) = o; } }
    LDS_WAIT(); asm volatile("" ::: "memory");
}
__device__ __forceinline__ void rms_row_to_bf16(const float* xrow, const float* g, bf16* orow, int lane) {
    const GAS f32x4* xr = (const GAS f32x4*)xrow + lane; const GAS f32x4* gr = (const GAS f32x4*)g + lane;
    f32x4 v[4]; float s = 0.f;
#pragma unroll
    for (int j = 0; j < 4; ++j) { v[j] = xr[64 * j]; s += (v[j].x * v[j].x + v[j].y * v[j].y) + (v[j].z * v[j].z + v[j].w * v[j].w); }
    const float rstd = 1.0f / sqrtf(wave_sum(s) * (1.f / D) + RMS_EPS);
    GAS v2u* o8 = (GAS v2u*)orow + lane;
#pragma unroll
    for (int j = 0; j < 4; ++j) { const f32x4 gg = gr[64 * j]; v2u w; w.x = pk2(v[j].x * rstd * gg.x, v[j].y * rstd * gg.y); w.y = pk2(v[j].z * rstd * gg.z, v[j].w * rstd * gg.w); o8[64 * j] = w; }
}
__device__ __forceinline__ void p0_prologue(Frame& F) {
    int tid_ = threadIdx.x; asm volatile("" : "+v"(tid_)); const int lane_ = tid_ & 63;
    LAS float* scr = (LAS float*)(F.lds + F.wave * 16384);
    const int gw = F.vcu * NWAVES + F.wave, NGW = F.G * NWAVES;
    unsigned char* ws = F.ws;
    constexpr int I_IN = 16 * 248, I_PA = 8 * 32, I_PB = 16 * 32, I_WO = 16 * 32, I_EG = 32 * 16 * 8, I_ED = 32 * 4 * 32;
    constexpr int NITEMS = I_IN + I_PA + I_PB + I_WO + 2 * I_EG + I_ED;
    auto decode = [&](int it, TrDesc& d) {
        int r = it; d.perm = false; d.kscale = nullptr; d.f8scale = 0.f; d.koff = 0;
        if (r < I_IN) { const int kb = r / 248, nb = r % 248, n0 = 32 * nb; const bool qk = (n0 < 3072) || (n0 >= A_W && n0 < A_W + 1152);
            const bool gt_ = n0 >= A_W + B_W; const int gc = n0 - (A_W + B_W);
            d.W = F.in[I_WIN]; d.N = NIN; d.WT = (bf16*)(ws + WS_WIN); d.ldo = 1024; d.rowbase = qk ? (n0 & ~63) + ((n0 >> 5) & 1) * 4 : (gt_ ? A_W + B_W + 2 * (gc % 1024) + 4 * (gc / 1024) : n0); d.k0 = 64 * kb; d.n0 = n0; d.perm = qk || gt_; d.f8scale = W8_SCALE; return; } r -= I_IN;
        if (r < I_PA) { const int kb = r / 32, nb = r % 32; d.W = F.in[I_WPA]; d.N = 1024; d.WT = (bf16*)(ws + WS_WAB); d.ldo = 1536; d.rowbase = 32 * nb; d.k0 = 64 * kb; d.n0 = 32 * nb; return; } r -= I_PA;
        if (r < I_PB) { const int kb = r / 32, nb = r % 32; d.W = F.in[I_WPB]; d.N = 1024; d.WT = (bf16*)(ws + WS_WAB); d.ldo = 1536; d.rowbase = 32 * nb; d.koff = 512; d.k0 = 64 * kb; d.n0 = 32 * nb; return; } r -= I_PB;
        if (r < I_WO) { const int kb = r / 32, nb = r % 32; d.W = F.in[I_WOUT]; d.N = 1024; d.WT = (bf16*)(ws + WS_WO); d.ldo = 1024; d.rowbase = 32 * nb; d.k0 = 64 * kb; d.n0 = 32 * nb; return; } r -= I_WO;
        if (r < 2 * I_EG) { const int up = r >= I_EG; if (up) r -= I_EG; const int e = r / 128, q = r % 128, kb = q / 8, nb = q % 8;
            d.W = F.in[up ? I_WEU : I_WEG] + (size_t)e * 1024 * 256; d.N = 256; d.WT = (bf16*)(ws + WS_WGU) + (size_t)e * 512 * 1024; d.ldo = 1024; d.rowbase = 64 * nb + (up ? 4 : 0); d.k0 = 64 * kb; d.n0 = 32 * nb; d.perm = true; d.kscale = F.in[I_GFFN]; d.f8scale = WG8_SCALE; if (P6_FP8) d.WT = (bf16*)((unsigned char*)(ws + WS_WGU) + (size_t)e * 512 * 1024); return; } r -= 2 * I_EG;
        { const int e = r / 128, q = r % 128, kb = q / 32, nb = q % 32;
            d.W = F.in[I_WED] + (size_t)e * 256 * 1024; d.N = 1024; d.WT = (bf16*)(ws + WS_WD) + (size_t)e * 1024 * 256; d.ldo = 256; d.rowbase = 32 * nb; d.k0 = 64 * kb; d.n0 = 32 * nb; d.f8scale = WD8_SCALE; if (P6_FP8) d.WT = (bf16*)((unsigned char*)(ws + WS_WD) + (size_t)e * 1024 * 256); }
    };
    {
        int it = gw; TrDesc dc, dn; f32x4 tc[8], tn[8]; float kc[8], kn[8];
        bool hc = it < NITEMS; if (hc) { decode(it, dc); tr_load(dc, lane_, tc, kc); }
        while (hc) {
            it += NGW; const bool hn = it < NITEMS;
            if (hn) { decode(it, dn); tr_load(dn, lane_, tn, kn); }
            tr_finish(dc, scr, lane_, tc, kc);
            hc = hn; dc = dn;
#pragma unroll
            for (int i = 0; i < 8; ++i) { tc[i] = tn[i]; kc[i] = kn[i]; }
        }
    }
    for (int m = gw; m < T; m += 4 * NGW) {
        const GAS f32x4* gr = (const GAS f32x4*)F.in[I_GMIX] + lane_;
        f32x4 v[4][4]; float ss[4];
#pragma unroll
        for (int r = 0; r < 4; ++r) { const int mr = (m + r * NGW < T) ? m + r * NGW : m; const GAS f32x4* xr = (const GAS f32x4*)(F.in[I_X] + (size_t)mr * D) + lane_;
#pragma unroll
            for (int j = 0; j < 4; ++j) v[r][j] = xr[64 * j]; }
#pragma unroll
        for (int r = 0; r < 4; ++r) { float a = 0.f;
#pragma unroll
            for (int j = 0; j < 4; ++j) a += (v[r][j].x * v[r][j].x + v[r][j].y * v[r][j].y) + (v[r][j].z * v[r][j].z + v[r][j].w * v[r][j].w);
            ss[r] = 1.0f / sqrtf(wave_sum(a) * (1.f / D) + RMS_EPS); }
#pragma unroll
        for (int r = 0; r < 4; ++r) { if (m + r * NGW >= T) continue; GAS unsigned* o4 = (GAS unsigned*)((unsigned char*)F.out + DO_HN + (size_t)(m + r * NGW) * D) + lane_;
#pragma unroll
            for (int j = 0; j < 4; ++j) { const f32x4 gg = gr[64 * j];
                if (P1_FP8) o4[64 * j] = pk4_fp8(v[r][j].x * ss[r] * gg.x, v[r][j].y * ss[r] * gg.y, v[r][j].z * ss[r] * gg.z, v[r][j].w * ss[r] * gg.w);
                else { v2u w; w.x = cvtpk(v[r][j].x * ss[r] * gg.x, v[r][j].y * ss[r] * gg.y); w.y = cvtpk(v[r][j].z * ss[r] * gg.z, v[r][j].w * ss[r] * gg.w); ((GAS v2u*)((unsigned char*)F.out + DO_HN + (size_t)(m + r * NGW) * D * 2) + lane_)[64 * j] = w; } } }
    }
    const int gt = F.vcu * NTHR + tid_, NGT = F.G * NTHR;
    if (gt < 32) ((float*)(ws + WS_INVF))[gt] = (float)exp2(-(double)gt * (13.287712379549449 / 32.0));
    for (int i = gt; i < 32 * 3 * 64; i += NGT) {
        const int ln = i & 63, nb = (i >> 6) % 3, ks = i / 192;
        const int n = 16 * nb + (ln & 15);
        float hi[8], lo[8];
#pragma unroll
        for (int e = 0; e < 8; ++e) { const int k = 32 * ks + 8 * (ln >> 4) + e; float v = 0.f;
            if (n < 4) v = F.in[I_WRG][k * 4 + n]; else if (n < 36) v = F.in[I_WRE][k * 32 + (n - 4)];
            v *= F.in[I_GFFN][k]; hi[e] = bf2f(f2bf(v)); lo[e] = v - hi[e]; }
        v4u h, l; h.x = pk2(hi[0], hi[1]); h.y = pk2(hi[2], hi[3]); h.z = pk2(hi[4], hi[5]); h.w = pk2(hi[6], hi[7]);
        l.x = pk2(lo[0], lo[1]); l.y = pk2(lo[2], lo[3]); l.z = pk2(lo[4], lo[5]); l.w = pk2(lo[6], lo[7]);
        ((v4u*)(ws + WS_WRF))[((ks * 3 + nb) * 2 + 0) * 64 + ln] = h; ((v4u*)(ws + WS_WRF))[((ks * 3 + nb) * 2 + 1) * 64 + ln] = l;
    }
}

namespace pg8 {
#define PG8_LAS __attribute__((address_space(3)))
typedef unsigned short bf16_t;
typedef short bf16x8 __attribute__((ext_vector_type(8)));
typedef float f32x4 __attribute__((ext_vector_type(4)));
typedef unsigned u32x4 __attribute__((ext_vector_type(4)));
constexpr int BM = 256, BK = 64, HALF = 128, HTB = HALF * BK * 2  , STAGE_BYTES = 8 * HTB, NXCD = 8, WGM = 8;

__host__ __device__ __forceinline__ int lds_byte(int r, int c) { const int st = (r >> 4) * 2 + (c >> 5), rr = r & 15, cc = c & 31, ob = rr * 64 + cc * 2; return st * 1024 + (ob ^ (((ob >> 9) & 1) << 5)); }
__host__ __device__ __forceinline__ void stage_rc(int b, int& R, int& C) { const int st = b / 1024, sb = b % 1024, swz = sb ^ (((sb >> 9) & 1) << 5); R = (st >> 1) * 16 + swz / 64; C = (st & 1) * 32 + (swz % 64) / 2; }
__host__ __device__ __forceinline__ int perm32(int rho) { const int n = rho >> 4, i = rho & 15; return 8 * (i >> 2) + 4 * n + (i & 3); }

struct Unit { int pm, pn; };
struct Gemm { const bf16_t* A; const bf16_t* Bt; int M, N, K; };

struct StaticOrder {
    int nM, nN, nwg, G, c;
    __host__ __device__ void init(int M, int N, int G_, int c_) { nM = M / BM; nN = N / BM; nwg = nM * nN; G = G_; c = c_; }
    __host__ __device__ bool next(int i, Unit& u) const {
        const long L = (long)i * G + c; if (L >= nwg) return false;
        int wgid = (int)L; { const int q = nwg / NXCD, r = nwg % NXCD, xcd = wgid % NXCD, off = wgid / NXCD; wgid = (xcd < r ? xcd * (q + 1) : r * (q + 1) + (xcd - r) * q) + off; }
        const int nig = WGM * nN, gid = wgid / nig, fm = gid * WGM, gsz = (nM - fm) < WGM ? (nM - fm) : WGM;
        u.pm = fm + ((wgid % nig) % gsz); u.pn = (wgid % nig) / gsz; return true;
    }
    __device__ __forceinline__ void a_ready(const Unit&) const {}
    __device__ __forceinline__ void done(const Unit&) const {}
};
}


namespace pg9 {
using pg8::BM; using pg8::BK; using pg8::HALF; using pg8::HTB; using pg8::lds_byte; using pg8::stage_rc; using pg8::perm32;
struct Unit { int pm, pn, e; };
typedef int v8i_t __attribute__((ext_vector_type(8)));
typedef int v4i_t __attribute__((ext_vector_type(4)));
template <int ESZ, class Epi, class Sched, class AOff, class BBase>
__device__ __forceinline__ void gemm_phase(LAS unsigned char* lds, const char* Abase, int K, const Sched& S, const Epi& E, const AOff& aoffn, const BBase& bbase) {
    int tid_ = threadIdx.x; asm volatile("" : "+v"(tid_));
    const int tid = tid_, wid = __builtin_amdgcn_readfirstlane(tid >> 6), lane = tid & 63, wr = wid >> 2, wc = wid & 3, fr = lane & 15, fq = lane >> 4;
    const int nt = K * ESZ / (BK * 2);
    int Rr[2], Cc[2]; unsigned voffB[2];
#pragma unroll
    for (int i = 0; i < 2; ++i) { int R, C; stage_rc(tid * 16 + i * 8192, R, C); const int Rb = Epi::PERM ? ((R & ~31) + perm32(R & 31)) : R; Rr[i] = R; Cc[i] = C; voffB[i] = (unsigned)(Rb * K * ESZ + C * 2); }
    const size_t kstep = (size_t)(BK * 2);
    const size_t hstep = (size_t)HALF * K * ESZ;
    const unsigned ldsw = (unsigned)wid * 1024u;
    const int aoff = lds_byte(wr * 64 + fr, fq * 8), boff = lds_byte(wc * 32 + fr, fq * 8);
#define PG9_SA(b, h) (((b) * 2 + (h)) * HTB)
#define PG9_SB(b, h) ((4 + (b) * 2 + (h)) * HTB)
#define PG9_STAGE(bufoff, gbase, voff) do { _Pragma("unroll") for (int _i = 0; _i < 2; ++_i) \
        __builtin_amdgcn_global_load_lds((const unsigned*)((const char*)(gbase) + (voff)[_i]), (LAS unsigned*)(lds + (bufoff) + ldsw + _i * 8192), 16, 0, 0); } while (0)
#define PG9_LDA(dst, b, h) do { _Pragma("unroll") for (int m = 0; m < 4; ++m) { dst[m].lo = *(const LAS v4i_t*)(lds + PG9_SA(b, h) + aoff + m * 2048); dst[m].hi = *(const LAS v4i_t*)(lds + PG9_SA(b, h) + aoff + m * 2048 + 1024); } } while (0)
#define PG9_LDB(dst, b, h) do { _Pragma("unroll") for (int n = 0; n < 2; ++n) { dst[n].lo = *(const LAS v4i_t*)(lds + PG9_SB(b, h) + boff + n * 2048); dst[n].hi = *(const LAS v4i_t*)(lds + PG9_SB(b, h) + boff + n * 2048 + 1024); } } while (0)
#define PG9_HALF(v, o) __builtin_bit_cast(bf16x8, __builtin_shufflevector((v), (v), (o), (o) + 1, (o) + 2, (o) + 3))
#define PG9_MMA(ai, bj, At, Bt) do { __builtin_amdgcn_s_setprio(1); _Pragma("unroll") for (int m = 0; m < 4; ++m) _Pragma("unroll") for (int n = 0; n < 2; ++n) { \
        if (ESZ == 2) { acc[ai][bj][m][n] = __builtin_amdgcn_mfma_f32_16x16x32_bf16(PG9_HALF(Bt[n], 0), PG9_HALF(At[m], 0), acc[ai][bj][m][n], 0, 0, 0); \
                        acc[ai][bj][m][n] = __builtin_amdgcn_mfma_f32_16x16x32_bf16(PG9_HALF(Bt[n], 4), PG9_HALF(At[m], 4), acc[ai][bj][m][n], 0, 0, 0); } \
        else { asm volatile("v_mfma_scale_f32_16x16x128_f8f6f4 %0, %1, %2, %0, %3, %3 op_sel_hi:[0,0,0]" : "+v"(acc[ai][bj][m][n]) : "v"(Bt[n]), "v"(At[m]), "v"(one8)); } } \
        __builtin_amdgcn_s_setprio(0); } while (0)
#define PG9_WAIT_V(n) asm volatile("s_waitcnt vmcnt(" #n ")" ::: "memory")
#define PG9_WAIT_L(n) asm volatile("s_waitcnt lgkmcnt(" #n ")" ::: "memory")
#define PG9_BAR __builtin_amdgcn_s_barrier()
#define PG9_SCHED __builtin_amdgcn_sched_barrier(0)
#define PG9_VA(dst, u) do { _Pragma("unroll") for (int _h = 0; _h < 2; ++_h) _Pragma("unroll") for (int _i = 0; _i < 2; ++_i) dst[_h][_i] = aoffn((u), _h * HALF + Rr[_i]) + (unsigned)(Cc[_i] * 2); } while (0)
    constexpr bool GATHER = AOff::GATHER;
    const size_t hstepA = (size_t)HALF * aoffn.rowbytes;
    unsigned voffA[2];
#pragma unroll
    for (int i = 0; i < 2; ++i) voffA[i] = (unsigned)Rr[i] * aoffn.rowbytes + (unsigned)(Cc[i] * 2);
#define PG9_STAGE_A(bufoff, h, koff, nx) do { if (GATHER) { PG9_STAGE(bufoff, Abase + (koff), ((nx) ? nvA[h] : cvA[h])); } else { PG9_STAGE(bufoff, ((nx) ? nAu : cAu) + (h) * hstepA + (koff), voffA); } } while (0)
    Unit cur, nxt; int ui = 0;
    if (!S.next(0, cur)) return;
    f32x4 acc[2][2][4][2];
#pragma unroll
    for (int a = 0; a < 2; ++a)
#pragma unroll
        for (int b = 0; b < 2; ++b)
#pragma unroll
            for (int m = 0; m < 4; ++m)
#pragma unroll
                for (int n = 0; n < 2; ++n) acc[a][b][m][n] = (f32x4){0.f, 0.f, 0.f, 0.f};
    int one8 = 0x7f7f7f7f; asm volatile("" : "+v"(one8));
    v8i_t At[4], B0[2], B1[2];
    unsigned cvA[2][2], nvA[2][2];
    if (GATHER) { PG9_VA(cvA, cur); }
    const char* cAu = GATHER ? Abase : Abase + (size_t)aoffn(cur, 0); const char* nAu = cAu;
    const char* cB = bbase(cur);
    PG9_STAGE(PG9_SB(0, 0), cB, voffB); PG9_STAGE(PG9_SB(0, 1), cB + hstep, voffB); PG9_STAGE_A(PG9_SA(0, 0), 0, 0, false); PG9_STAGE_A(PG9_SA(0, 1), 1, 0, false);
    if (wr == 1) PG9_BAR;
    PG9_WAIT_V(2); PG9_BAR;
    PG9_STAGE(PG9_SB(1, 0), cB + kstep, voffB); PG9_STAGE_A(PG9_SA(1, 0), 0, kstep, false); PG9_STAGE(PG9_SB(1, 1), cB + hstep + kstep, voffB);
    PG9_WAIT_V(6); PG9_BAR;
    for (;;) {
        const bool has_next = S.next(ui + 1, nxt);
        if (GATHER) {
            if (has_next) { PG9_VA(nvA, nxt); } else {
#pragma unroll
                for (int _h = 0; _h < 2; ++_h)
#pragma unroll
                    for (int _i = 0; _i < 2; ++_i) nvA[_h][_i] = cvA[_h][_i]; }
        } else nAu = has_next ? Abase + (size_t)aoffn(nxt, 0) : cAu;
        const char* nB = has_next ? bbase(nxt) : cB;
#pragma unroll 1
        for (int t = 0; t < nt; t += 2) {
            const bool last = (t == nt - 2);
            if (Epi::HOOK_T >= 0) { if (t == Epi::HOOK_T) E.hook(acc, cur, wr, wc, fr, fq); }
            const size_t k1 = (size_t)(t + 1) * kstep, k2 = last ? 0 : (size_t)(t + 2) * kstep, k3 = k2 + kstep;
            const char* b2 = last ? nB : cB + (size_t)(t + 2) * kstep; const char* b3 = b2 + kstep;
            PG9_LDB(B0, 0, 0); PG9_LDB(B1, 0, 1); PG9_SCHED; PG9_LDA(At, 0, 0); PG9_STAGE_A(PG9_SA(1, 1), 1, k1, false);
            PG9_WAIT_V(8); PG9_WAIT_L(0); PG9_BAR; PG9_MMA(0, 0, At, B0); PG9_MMA(0, 1, At, B1); PG9_BAR; PG9_SCHED;
            PG9_LDA(At, 0, 1); PG9_STAGE(PG9_SB(0, 0), b2, voffB); PG9_STAGE(PG9_SB(0, 1), b2 + hstep, voffB); PG9_STAGE_A(PG9_SA(0, 0), 0, k2, last);
            PG9_WAIT_V(8); PG9_WAIT_L(0); PG9_BAR; PG9_MMA(1, 0, At, B0); PG9_MMA(1, 1, At, B1); PG9_BAR; PG9_SCHED;
            PG9_LDB(B0, 1, 0); PG9_LDB(B1, 1, 1); PG9_SCHED; PG9_LDA(At, 1, 0); PG9_STAGE_A(PG9_SA(0, 1), 1, k2, last);
            PG9_WAIT_V(8); PG9_WAIT_L(0); PG9_BAR; PG9_MMA(0, 0, At, B0); PG9_MMA(0, 1, At, B1); PG9_BAR; PG9_SCHED;
            PG9_LDA(At, 1, 1); PG9_STAGE(PG9_SB(1, 0), b3, voffB); PG9_STAGE(PG9_SB(1, 1), b3 + hstep, voffB); PG9_STAGE_A(PG9_SA(1, 0), 0, k3, last);
            PG9_WAIT_V(8); PG9_WAIT_L(0); PG9_BAR; PG9_MMA(1, 0, At, B0); PG9_MMA(1, 1, At, B1); PG9_BAR; PG9_SCHED;
        }
        if (wr == 0) PG9_BAR;
        if (ESZ == 1) asm volatile("s_nop 15\n\ts_nop 15" ::: "memory");
        E(acc, cur, wr, wc, fr, fq);
        if (!has_next) break;
#pragma unroll
        for (int a = 0; a < 2; ++a)
#pragma unroll
            for (int b = 0; b < 2; ++b)
#pragma unroll
                for (int m = 0; m < 4; ++m)
#pragma unroll
                    for (int n = 0; n < 2; ++n) acc[a][b][m][n] = (f32x4){0.f, 0.f, 0.f, 0.f};
        cur = nxt; cB = nB; cAu = nAu; ++ui;
        if (GATHER) {
#pragma unroll
            for (int _h = 0; _h < 2; ++_h)
#pragma unroll
                for (int _i = 0; _i < 2; ++_i) cvA[_h][_i] = nvA[_h][_i]; }
        if (wr == 1) PG9_BAR;
    }
    PG9_WAIT_V(0);
    PG9_BAR;
#undef PG9_SA
#undef PG9_SB
#undef PG9_STAGE
#undef PG9_LDA
#undef PG9_LDB
#undef PG9_MMA
#undef PG9_HALF
#undef PG9_WAIT_V
#undef PG9_WAIT_L
#undef PG9_BAR
#undef PG9_SCHED
#undef PG9_VA
#undef PG9_STAGE_A
}
struct DenseOrder { pg8::StaticOrder so;
    __device__ void init(int M, int N, int G, int c) { so.init(M, N, G, c); }
    __device__ bool next(int i, Unit& u) const { pg8::Unit v; if (!so.next(i, v)) return false; u.pm = v.pm; u.pn = v.pn; u.e = 0; return true; } };
struct DenseA { static constexpr bool GATHER = false; unsigned rowbytes; __device__ __forceinline__ unsigned operator()(const Unit& u, int row) const { return (unsigned)(u.pm * 256 + row) * rowbytes; } };
struct DenseB { const char* Bt; size_t tilebytes; __device__ __forceinline__ const char* operator()(const Unit& u) const { return Bt + (size_t)u.pn * tilebytes; } };
}

struct EpiInproj {
    static constexpr bool PERM = true; static constexpr int HOOK_T = -1;
    bf16* ZA; bf16* ZB; bf16* Gt; const float* bias; const float* invf; unsigned char* wsb;
    __device__ __forceinline__ void hook(f32x4 (&)[2][2][4][2], const pg9::Unit&, int, int, int, int) const {}
    __device__ __forceinline__ void operator()(const f32x4 (&acc)[2][2][4][2], const pg9::Unit& u, int wr, int wc, int fr, int fq) const {
        asm volatile("" : "+v"(fr), "+v"(fq));
        const int row0 = u.pm * 256 + wr * 64 + fr;
        const int q = 4 * (wc & 1) + fq;
        const __amdgpu_buffer_rsrc_t wr_ = wt_rsrc(wsb);
        int kind[2]; bf16* dst[2]; int ldd[2]; f32x4 b0[2], b1[2];
#pragma unroll
        for (int bj = 0; bj < 2; ++bj) {
            const int colpos = u.pn * 256 + bj * 128 + wc * 32 + 8 * fq, hb = u.pn * 256 + bj * 128 + (wc >> 1) * 64;
            if (hb < A_W) { kind[bj] = hb / 1536; dst[bj] = ZA + colpos; ldd[bj] = A_W; }
            else if (hb < A_W + B_W) { const int cb = hb - A_W; kind[bj] = cb < 1024 ? 0 : (cb < 1152 ? 1 : 2); dst[bj] = ZB + (colpos - A_W); ldd[bj] = B_W; }
            else { kind[bj] = 3; dst[bj] = Gt + ((colpos - A_W - B_W) >> 1); ldd[bj] = G_W; }
            b0[bj] = *(const f32x4*)(bias + (kind[bj] < 2 ? hb + 4 * q : (kind[bj] == 3 ? A_W + B_W + ((colpos - A_W - B_W) >> 1) : colpos)));
            b1[bj] = *(const f32x4*)(bias + (kind[bj] < 2 ? hb + 32 + 4 * q : (kind[bj] == 3 ? A_W + B_W + 1024 + ((colpos - A_W - B_W) >> 1) : colpos + 4)));
        }
        const bool need_rope = kind[0] < 2 || kind[1] < 2;
        const f32x4 fv = *(const f32x4*)(invf + 4 * q);
#pragma unroll
        for (int ai = 0; ai < 2; ++ai) {
            f32x4 rc[4], rs[4];
#pragma unroll
            for (int m = 0; m < 4; ++m) { rc[m] = (f32x4){1.f, 1.f, 1.f, 1.f}; rs[m] = (f32x4){0.f, 0.f, 0.f, 0.f}; }
            if (need_rope) {
#pragma unroll
                for (int m = 0; m < 4; ++m) { const float posf = (float)((row0 + ai * 128 + m * 16) & (SEQ - 1));
#pragma unroll
                    for (int e = 0; e < 4; ++e) { const float ang = posf * fv[e]; const float pr = ang * 0.15915494f; const float er = __builtin_fmaf(ang, 0.15915494f, -pr) + ang * 6.4206382e-9f;
                        const float fr = __builtin_amdgcn_fractf(pr) + er; rc[m][e] = __builtin_amdgcn_cosf(fr); rs[m][e] = __builtin_amdgcn_sinf(fr); } }
            }
#pragma unroll
            for (int bj = 0; bj < 2; ++bj) {
#pragma unroll
                for (int m = 0; m < 4; ++m) {
                    const int row = row0 + ai * 128 + m * 16;
                    f32x4 v0 = acc[ai][bj][m][0] * W8_INV + b0[bj], v1 = acc[ai][bj][m][1] * W8_INV + b1[bj];
                    if (kind[bj] < 2) {
                        const f32x4 cc = rc[m], ss = rs[m];
                        const f32x4 t0 = v0 * cc - v1 * ss, t1 = v1 * cc + v0 * ss;
                        v0 = t0; v1 = t1;
                        if (kind[bj] == 0) { v0 = v0 * QSCALE; v1 = v1 * QSCALE; }
                    }
                    if (kind[bj] == 3) {
#pragma unroll
                        for (int e = 0; e < 4; ++e) { const float d0 = 1.0f + __expf(-v0[e]), d1 = 1.0f + __expf(-v1[e]); v0[e] = d1 * __builtin_amdgcn_rcpf(d0); v1[e] = __builtin_amdgcn_rcpf(d1); }
                        v2u w0, w1; w0.x = cvtpk(v0[0], v0[1]); w0.y = cvtpk(v0[2], v0[3]); w1.x = cvtpk(v1[0], v1[1]); w1.y = cvtpk(v1[2], v1[3]);
                        st8(wr_, wsb, dst[bj] + (size_t)row * ldd[bj], w0); st8(wr_, wsb, dst[bj] + (size_t)row * ldd[bj] + 1024, w1);
                    } else {
                    v4u w; w.x = cvtpk(v0[0], v0[1]); w.y = cvtpk(v0[2], v0[3]); w.z = cvtpk(v1[0], v1[1]); w.w = cvtpk(v1[2], v1[3]);
                    st16(wr_, wsb, dst[bj] + (size_t)row * ldd[bj], w); }
                }
            }
        }
    }
};
__device__ __forceinline__ void p1_inproj(Frame& F, int ch) {
    unsigned char* ws = F.ws;
    pg9::DenseOrder S; S.init(TC, NIN, F.G, (int)blockIdx.x);
    EpiInproj E{(bf16*)(ws + WS_ZA), (bf16*)(ws + WS_ZB), (bf16*)(ws + WS_G) + (size_t)ch * TC * G_W, F.in[I_BIN], (const float*)(ws + WS_INVF), ws};
    constexpr int ES = P1_FP8 ? 1 : 2;
    pg9::DenseA ao{(unsigned)(D * ES)}; pg9::DenseB bb{(const char*)(ws + WS_WIN), (size_t)256 * D * ES};
    pg9::gemm_phase<ES>(F.lds, (const char*)F.out + DO_HN + (size_t)ch * TC * D * ES, D, S, E, ao, bb);
}

typedef float f32x16 __attribute__((ext_vector_type(16)));
typedef short v4i16_t __attribute__((ext_vector_type(4)));
__device__ __forceinline__ float half_max(float v) { auto rr = __builtin_amdgcn_permlane32_swap(__float_as_uint(v), __float_as_uint(v), false, false); return fmaxf(__uint_as_float(rr[0]), __uint_as_float(rr[1])); }
__device__ __forceinline__ float half_sum(float v) { auto rr = __builtin_amdgcn_permlane32_swap(__float_as_uint(v), __float_as_uint(v), false, false); return __uint_as_float(rr[0]) + __uint_as_float(rr[1]); }
__device__ __forceinline__ float max3f(float a, float b, float c) { float r; asm("v_max3_f32 %0, %1, %2, %3" : "=v"(r) : "v"(a), "v"(b), "v"(c)); return r; }
constexpr int ATT_VOFF = 49152;

struct AUnit { const bf16 *Kw, *Vw, *Qp; size_t pitch; int kk_lo, nkeys, kb0, kstart, lo; float m0, l0; bf16* Op; float* Lp; };
__device__ __forceinline__ void attn_decode(Frame& F, int ch, int u, int NUA, int lane, AUnit& d) {
    unsigned char* ws = F.ws;
    const int w = F.wave, c = lane & 31, h = (lane >> 5) & 1;
    if (u < NUA) {
        const bf16* ZA = (const bf16*)(ws + WS_ZA);
        const int rt = u & 15, hh = (u >> 4) & 7, gb = u >> 7, g = gb % 3, bl = gb / 3;
        const int dsh = 2 * g, dd = 1 << dsh, tsh = 4 - dsh;
        const int r = rt >> tsh, tile = rt & ((1 << tsh) - 1), i0 = tile * 256;
        const int rowb = bl * SEQ + r, col = g * 512 + hh * 64;
        d.pitch = (size_t)dd * A_W;
        d.Kw = ZA + ((long)rowb + (long)dd * (i0 - 128)) * A_W + 1536 + col; d.Vw = d.Kw + 1536;
        const long qrow = (long)rowb + (long)dd * (i0 + 32 * w + c);
        d.Qp = ZA + qrow * A_W + col;
        d.kk_lo = (i0 == 0) ? 128 : 0; d.nkeys = 384; d.kb0 = w; d.kstart = (i0 == 0) ? (w < 4 ? 4 - w : 0) : 0; d.lo = 0;
        d.m0 = -1e30f; d.l0 = 0.f;
        d.Op = (bf16*)((unsigned char*)F.out + DO_OG) + ((size_t)g * TC + qrow) * 512 + hh * 64;
        d.Lp = (float*)((unsigned char*)F.out + DO_LSE) + ((size_t)g * TC + qrow) * 8 + hh;
    } else {
        const int u2 = u - NUA;
        const bf16* ZB = (const bf16*)(ws + WS_ZB);
        const int blk = u2 & 127, kvh = (u2 >> 7) & 1, bl = u2 >> 8;
        const int t0 = blk * 32, rowb = bl * SEQ;
        d.pitch = B_W;
        d.Kw = ZB + ((long)rowb + t0 - 128) * B_W + 1024 + kvh * 64; d.Vw = d.Kw + 128;
        const int qh = kvh * 8 + w;
        const long qrow = (long)rowb + t0 + c;
        d.Qp = ZB + qrow * B_W + qh * 64;
        d.kk_lo = t0 < 128 ? 128 - t0 : 0; d.nkeys = 160; d.kb0 = 0; d.kstart = d.kk_lo >> 5; d.lo = 1;
        d.m0 = F.in[I_SINK][qh] * LOG2E; d.l0 = h == 0 ? 1.f : 0.f;
        d.Op = (bf16*)(ws + WS_Y) + ((size_t)ch * TC + qrow) * Y_W + 512 + qh * 64;
        d.Lp = nullptr;
    }
}
__device__ __forceinline__ void attn_load(const AUnit& d, int tid, int lane, v4u (&kreg)[6], v4u (&vreg)[6], bf16x8 (&qf)[4]) {
    const int skey = tid >> 3, sch = tid & 7, h = (lane >> 5) & 1;
#pragma unroll
    for (int s4 = 0; s4 < 4; ++s4) qf[s4] = *(const GAS bf16x8*)(d.Qp + 16 * s4 + 8 * h);
#pragma unroll
    for (int p = 0; p < 6; ++p) { const int kk = 64 * p + skey;
        if (kk >= d.kk_lo && kk < d.nkeys) { kreg[p] = *(const GAS v4u*)(d.Kw + (size_t)kk * d.pitch + 8 * sch); vreg[p] = *(const GAS v4u*)(d.Vw + (size_t)kk * d.pitch + 8 * sch); } }
}
__device__ __forceinline__ void attn_write(const AUnit& d, LAS unsigned char* KL, LAS unsigned char* VL, int tid, const v4u (&kreg)[6], const v4u (&vreg)[6]) {
    const int skey = tid >> 3, sch = tid & 7;
#pragma unroll
    for (int p = 0; p < 6; ++p) { const int kk = 64 * p + skey;
        if (kk >= d.kk_lo && kk < d.nkeys) {
            *(LAS v4u*)(KL + kk * 128 + ((sch ^ ((kk >> 1) & 7)) << 4)) = kreg[p];
            *(LAS v4u*)(VL + kk * 128 + ((sch * 16) ^ (((kk >> 1) & 1) << 6))) = vreg[p]; } }
}
__device__ __forceinline__ void attn_compute_edge(const AUnit& d, const LAS unsigned char* KL, const LAS unsigned char* VL, int lane, const bf16x8 (&qf)[4]) {
    const int c = lane & 31, h = (lane >> 5) & 1;
    int koff[4];
    { const int kswz = (c >> 1) & 7;
#pragma unroll
      for (int s4 = 0; s4 < 4; ++s4) koff[s4] = c * 128 + (((2 * s4 + h) ^ kswz) << 4); }
    const int vrow = 4 * h + ((lane & 15) >> 2), vsw = (lane >> 3) & 1;
    const int voff0 = vrow * 128 + ((32 * ((lane >> 4) & 1) + 8 * (lane & 3)) ^ (vsw << 6)), voff1 = voff0 ^ 64;
    const float NEG = -INFINITY;
    float m = d.m0, l = d.l0;
    f32x16 o0, o1;
#pragma unroll
    for (int i = 0; i < 16; ++i) { o0[i] = 0.f; o1[i] = 0.f; }
    const LAS unsigned char* kbp = KL + d.kb0 * 4096; const LAS unsigned char* vbp = VL + d.kb0 * 4096;
    const int clo = c + d.lo;
#pragma unroll
    for (int kbi = 0; kbi < 5; ++kbi) {
        if (kbi >= d.kstart) {
            f32x16 p;
#pragma unroll
            for (int i = 0; i < 16; ++i) p[i] = 0.f;
#pragma unroll
            for (int s4 = 0; s4 < 4; ++s4) { const bf16x8 kf = *(const LAS bf16x8*)(kbp + kbi * 4096 + koff[s4]); p = __builtin_amdgcn_mfma_f32_32x32x16_bf16(kf, qf[s4], p, 0, 0, 0); }
            if (kbi == 0) {
#pragma unroll
                for (int i = 0; i < 16; ++i) { const int x = (i & 3) + 8 * (i >> 2) + 4 * h; if (x < clo) p[i] = NEG; }
            }
            if (kbi == 4) {
#pragma unroll
                for (int i = 0; i < 16; ++i) { const int x = (i & 3) + 8 * (i >> 2) + 4 * h; if (x > c) p[i] = NEG; }
            }
            float mt = p[0];
#pragma unroll
            for (int i = 1; i < 16; ++i) mt = fmaxf(mt, p[i]);
            mt = half_max(mt);
            const float mn = fmaxf(m, mt), alpha = __builtin_amdgcn_exp2f(m - mn);
            m = mn;
            float ps = 0.f;
#pragma unroll
            for (int i = 0; i < 16; ++i) { p[i] = __builtin_amdgcn_exp2f(p[i] - mn); ps += p[i]; }
            l = l * alpha + ps;
#pragma unroll
            for (int i = 0; i < 16; ++i) { o0[i] *= alpha; o1[i] *= alpha; }
            bf16x8 pb[2];
#pragma unroll
            for (int s2 = 0; s2 < 2; ++s2) { v4u t; t.x = cvtpk(p[8 * s2 + 0], p[8 * s2 + 1]); t.y = cvtpk(p[8 * s2 + 2], p[8 * s2 + 3]); t.z = cvtpk(p[8 * s2 + 4], p[8 * s2 + 5]); t.w = cvtpk(p[8 * s2 + 6], p[8 * s2 + 7]); pb[s2] = __builtin_bit_cast(bf16x8, t); }
#pragma unroll
            for (int s2 = 0; s2 < 2; ++s2) {
#pragma unroll
                for (int db = 0; db < 2; ++db) {
                    const LAS unsigned char* vp = vbp + kbi * 4096 + s2 * 2048 + (db ? voff1 : voff0);
                    const v4i16_t lo = __builtin_amdgcn_ds_read_tr16_b64_v4i16((LAS v4i16_t*)vp);
                    const v4i16_t hi = __builtin_amdgcn_ds_read_tr16_b64_v4i16((LAS v4i16_t*)(vp + 1024));
                    const bf16x8 vf = {lo[0], lo[1], lo[2], lo[3], hi[0], hi[1], hi[2], hi[3]};
                    if (db == 0) o0 = __builtin_amdgcn_mfma_f32_32x32x16_bf16(vf, pb[s2], o0, 0, 0, 0);
                    else o1 = __builtin_amdgcn_mfma_f32_32x32x16_bf16(vf, pb[s2], o1, 0, 0, 0);
                }
            }
        }
    }
    const float lt = half_sum(l), inv = 1.0f / lt;
#pragma unroll
    for (int g4 = 0; g4 < 4; ++g4) {
        v2u a, b;
        a.x = cvtpk(o0[4 * g4 + 0] * inv, o0[4 * g4 + 1] * inv); a.y = cvtpk(o0[4 * g4 + 2] * inv, o0[4 * g4 + 3] * inv);
        b.x = cvtpk(o1[4 * g4 + 0] * inv, o1[4 * g4 + 1] * inv); b.y = cvtpk(o1[4 * g4 + 2] * inv, o1[4 * g4 + 3] * inv);
        *(GAS v2u*)(d.Op + 8 * g4 + 4 * h) = a;
        *(GAS v2u*)(d.Op + 32 + 8 * g4 + 4 * h) = b;
    }
    if (d.Lp) { if (h == 0) *d.Lp = m + __builtin_amdgcn_logf(lt); }
}
__device__ __forceinline__ void attn_compute(const AUnit& d, const LAS unsigned char* KL, const LAS unsigned char* VL, int lane, const bf16x8 (&qf)[4]) {
    const int c = lane & 31, h = (lane >> 5) & 1;
    int koff[4];
    { const int kswz = (c >> 1) & 7;
#pragma unroll
      for (int s4 = 0; s4 < 4; ++s4) koff[s4] = c * 128 + (((2 * s4 + h) ^ kswz) << 4); }
    const int vrow = 4 * h + ((lane & 15) >> 2), vsw = (lane >> 3) & 1;
    const int voff0 = vrow * 128 + ((32 * ((lane >> 4) & 1) + 8 * (lane & 3)) ^ (vsw << 6)), voff1 = voff0 ^ 64;
    const float NEG = -INFINITY;
    float m = d.m0;
    f32x16 o0, o1, L;
#pragma unroll
    for (int i = 0; i < 16; ++i) { o0[i] = 0.f; o1[i] = 0.f; L[i] = 0.f; }
    v4u onesu = {0x3F803F80u, 0x3F803F80u, 0x3F803F80u, 0x3F803F80u}; asm volatile("" : "+v"(onesu));
    const bf16x8 ones = __builtin_bit_cast(bf16x8, onesu);
    const LAS unsigned char* kbp = KL + d.kb0 * 4096; const LAS unsigned char* vbp = VL + d.kb0 * 4096;
    const int clo = c + d.lo;
#pragma unroll
    for (int kbi = 0; kbi < 5; ++kbi) {
        {
            constexpr bool first_dummy = false; (void)first_dummy;
            const bool first = (kbi == 0);
            const float cinit = first ? 0.f : -m;
            f32x16 p;
#pragma unroll
            for (int i = 0; i < 16; ++i) p[i] = cinit;
#pragma unroll
            for (int s4 = 0; s4 < 4; ++s4) { const bf16x8 kf = *(const LAS bf16x8*)(kbp + kbi * 4096 + koff[s4]); p = __builtin_amdgcn_mfma_f32_32x32x16_bf16(kf, qf[s4], p, 0, 0, 0); }
            if (kbi == 0) {
#pragma unroll
                for (int i = 0; i < 16; ++i) { const int x = (i & 3) + 8 * (i >> 2) + 4 * h; p[i] = x < clo ? NEG : p[i]; }
            }
            if (kbi == 4) {
#pragma unroll
                for (int i = 0; i < 16; ++i) { const int x = (i & 3) + 8 * (i >> 2) + 4 * h; p[i] = x > c ? NEG : p[i]; }
            }
            float t0 = max3f(p[0], p[4], p[8]), t1 = max3f(p[1], p[5], p[9]), t2 = max3f(p[2], p[6], p[10]), t3 = max3f(p[3], p[7], p[11]);
            t0 = max3f(t0, p[12], p[13]); t1 = max3f(t1, p[14], p[15]);
            const float mt = half_max(max3f(max3f(t0, t1, t2), t3, t3));
            if (first) {
                const float mn = fmaxf(m, mt), l0 = d.m0 > -1e29f ? __builtin_amdgcn_exp2f(m - mn) : 0.f;
                m = mn;
#pragma unroll
                for (int i = 0; i < 16; ++i) { p[i] -= mn; L[i] = l0; }
            } else if (__any(mt > 8.0f)) {
                const float dl = fmaxf(mt, 0.f), al = __builtin_amdgcn_exp2f(-dl);
                m += dl;
#pragma unroll
                for (int i = 0; i < 16; ++i) { o0[i] *= al; o1[i] *= al; L[i] *= al; p[i] -= dl; }
            }
#pragma unroll
            for (int i = 0; i < 16; ++i) p[i] = __builtin_amdgcn_exp2f(p[i]);
            bf16x8 pb[2];
#pragma unroll
            for (int s2 = 0; s2 < 2; ++s2) { v4u t; t.x = cvtpk(p[8 * s2 + 0], p[8 * s2 + 1]); t.y = cvtpk(p[8 * s2 + 2], p[8 * s2 + 3]); t.z = cvtpk(p[8 * s2 + 4], p[8 * s2 + 5]); t.w = cvtpk(p[8 * s2 + 6], p[8 * s2 + 7]); pb[s2] = __builtin_bit_cast(bf16x8, t); }
#pragma unroll
            for (int s2 = 0; s2 < 2; ++s2) {
                L = __builtin_amdgcn_mfma_f32_32x32x16_bf16(ones, pb[s2], L, 0, 0, 0);
#pragma unroll
                for (int db = 0; db < 2; ++db) {
                    const LAS unsigned char* vp = vbp + kbi * 4096 + s2 * 2048 + (db ? voff1 : voff0);
                    const v4i16_t lo = __builtin_amdgcn_ds_read_tr16_b64_v4i16((LAS v4i16_t*)vp);
                    const v4i16_t hi = __builtin_amdgcn_ds_read_tr16_b64_v4i16((LAS v4i16_t*)(vp + 1024));
                    const bf16x8 vf = {lo[0], lo[1], lo[2], lo[3], hi[0], hi[1], hi[2], hi[3]};
                    if (db == 0) o0 = __builtin_amdgcn_mfma_f32_32x32x16_bf16(vf, pb[s2], o0, 0, 0, 0);
                    else o1 = __builtin_amdgcn_mfma_f32_32x32x16_bf16(vf, pb[s2], o1, 0, 0, 0);
                }
            }
        }
    }
    const float lt = L[0], inv = 1.0f / lt;
#pragma unroll
    for (int g4 = 0; g4 < 4; ++g4) {
        v2u a, b;
        a.x = cvtpk(o0[4 * g4 + 0] * inv, o0[4 * g4 + 1] * inv); a.y = cvtpk(o0[4 * g4 + 2] * inv, o0[4 * g4 + 3] * inv);
        b.x = cvtpk(o1[4 * g4 + 0] * inv, o1[4 * g4 + 1] * inv); b.y = cvtpk(o1[4 * g4 + 2] * inv, o1[4 * g4 + 3] * inv);
        *(GAS v2u*)(d.Op + 8 * g4 + 4 * h) = a;
        *(GAS v2u*)(d.Op + 32 + 8 * g4 + 4 * h) = b;
    }
    if (d.Lp) { if (h == 0) *d.Lp = m + __builtin_amdgcn_logf(lt); }
}
__device__ __forceinline__ void p2_attn(Frame& F, int ch) {
    int tid_ = threadIdx.x; asm volatile("" : "+v"(tid_));
    const int tid = tid_, lane = tid & 63;
    LAS unsigned char* KL = F.lds; LAS unsigned char* VL = F.lds + ATT_VOFF;
    constexpr int NUA = (TC / SEQ) * 3 * 8 * 16, NUB = (TC / SEQ) * 2 * 128, NU = NUA + NUB;
    int u = F.vcu;
    if (u >= NU) return;
    AUnit cur, nxt;
    v4u kreg[6], vreg[6]; bf16x8 qn[4];
    attn_decode(F, ch, u, NUA, lane, cur);
    attn_load(cur, tid, lane, kreg, vreg, qn);
    for (;;) {
        attn_write(cur, KL, VL, tid, kreg, vreg);
        bf16x8 qf[4];
#pragma unroll
        for (int s4 = 0; s4 < 4; ++s4) qf[s4] = qn[s4];
        __syncthreads();
        const int un = u + F.G; const bool has_next = un < NU;
        if (has_next) { attn_decode(F, ch, un, NUA, lane, nxt); attn_load(nxt, tid, lane, kreg, vreg, qn); }
        if (cur.kk_lo == 0) attn_compute(cur, KL, VL, lane, qf); else attn_compute_edge(cur, KL, VL, lane, qf);
        __syncthreads();
        if (!has_next) break;
        cur = nxt; u = un;
    }
}
__device__ __forceinline__ void p2_combine(Frame& F, int ch) {
    int tid_ = threadIdx.x; asm volatile("" : "+v"(tid_)); const int lane_ = tid_ & 63;
    unsigned char* ws = F.ws;
    const bf16* OG = (const bf16*)((const unsigned char*)F.out + DO_OG); const float* LSE = (const float*)((const unsigned char*)F.out + DO_LSE);
    bf16* Y = (bf16*)(ws + WS_Y) + (size_t)ch * TC * Y_W;
    const int lane = lane_, hd = lane >> 3;
    const int gw = F.vcu * NWAVES + F.wave, NGW = F.G * NWAVES;
    for (int row = gw; row < TC; row += NGW) {
        float lg[3]; v4u og[3];
#pragma unroll
        for (int g = 0; g < 3; ++g) { lg[g] = LSE[((size_t)g * TC + row) * 8 + hd]; og[g] = *(const GAS v4u*)(OG + ((size_t)g * TC + row) * 512 + lane * 8); }
        const float mx = fmaxf(fmaxf(lg[0], lg[1]), lg[2]);
        float e[3]; e[0] = __builtin_amdgcn_exp2f(lg[0] - mx); e[1] = __builtin_amdgcn_exp2f(lg[1] - mx); e[2] = __builtin_amdgcn_exp2f(lg[2] - mx);
        const float inv = 1.0f / (e[0] + e[1] + e[2]);
        float acc[8];
#pragma unroll
        for (int i = 0; i < 8; ++i) acc[i] = 0.f;
#pragma unroll
        for (int g = 0; g < 3; ++g) { const float wg = e[g] * inv;
            acc[0] += wg * bflo(og[g].x); acc[1] += wg * bfhi(og[g].x); acc[2] += wg * bflo(og[g].y); acc[3] += wg * bfhi(og[g].y);
            acc[4] += wg * bflo(og[g].z); acc[5] += wg * bfhi(og[g].z); acc[6] += wg * bflo(og[g].w); acc[7] += wg * bfhi(og[g].w); }
        v4u o; o.x = cvtpk(acc[0], acc[1]); o.y = cvtpk(acc[2], acc[3]); o.z = cvtpk(acc[4], acc[5]); o.w = cvtpk(acc[6], acc[7]);
        *(GAS v4u*)(Y + (size_t)row * Y_W + lane * 8) = o;
    }
}


struct EpiMerge {
    static constexpr bool PERM = true; static constexpr int HOOK_T = 8;
    const bf16* Gt; bf16* MG;
    __device__ __forceinline__ void hook(f32x4 (&acc)[2][2][4][2], const pg9::Unit& u, int wr, int wc, int fr, int fq) const {
        asm volatile("" : "+v"(fr), "+v"(fq));
        const bf16* gr = Gt + (size_t)(u.pm * 256 + wr * 64 + fr) * G_W + u.pn * 256 + wc * 32 + 8 * fq;
        v4u rv[8][2];
#pragma unroll
        for (int rg = 0; rg < 8; ++rg)
#pragma unroll
            for (int bj = 0; bj < 2; ++bj) rv[rg][bj] = *(const GAS v4u*)(gr + (size_t)((rg >> 2) * 128 + (rg & 3) * 16) * G_W + bj * 128);
#pragma unroll
        for (int rg = 0; rg < 8; ++rg)
#pragma unroll
            for (int bj = 0; bj < 2; ++bj) { const v4u a = rv[rg][bj];
                const f32x4 r0 = {bflo(a.x), bfhi(a.x), bflo(a.y), bfhi(a.y)}, r1 = {bflo(a.z), bfhi(a.z), bflo(a.w), bfhi(a.w)};
                acc[rg >> 2][bj][rg & 3][0] = acc[rg >> 2][bj][rg & 3][0] * r0; acc[rg >> 2][bj][rg & 3][1] = acc[rg >> 2][bj][rg & 3][1] * r1; }
    }
    __device__ __forceinline__ void operator()(const f32x4 (&acc)[2][2][4][2], const pg9::Unit& u, int wr, int wc, int fr, int fq) const {
        asm volatile("" : "+v"(fr), "+v"(fq));
        const bf16* gr = Gt + (size_t)(u.pm * 256 + wr * 64 + fr) * G_W + 1024 + u.pn * 256 + wc * 32 + 8 * fq;
        bf16* mr = MG + (size_t)(u.pm * 256 + wr * 64 + fr) * D + u.pn * 256 + wc * 32 + 8 * fq;
        v4u gb[8][2];
#pragma unroll
        for (int rg = 0; rg < 8; ++rg)
#pragma unroll
            for (int bj = 0; bj < 2; ++bj) gb[rg][bj] = *(const GAS v4u*)(gr + (size_t)((rg >> 2) * 128 + (rg & 3) * 16) * G_W + bj * 128);
#pragma unroll
        for (int rg = 0; rg < 8; ++rg)
#pragma unroll
            for (int bj = 0; bj < 2; ++bj) { const v4u b = gb[rg][bj];
                const f32x4 v0 = acc[rg >> 2][bj][rg & 3][0], v1 = acc[rg >> 2][bj][rg & 3][1];
                v4u w; w.x = cvtpk(v0[0] * bflo(b.x), v0[1] * bfhi(b.x)); w.y = cvtpk(v0[2] * bflo(b.y), v0[3] * bfhi(b.y));
                w.z = cvtpk(v1[0] * bflo(b.z), v1[1] * bfhi(b.z)); w.w = cvtpk(v1[2] * bflo(b.w), v1[3] * bfhi(b.w));
                *(GAS v4u*)(mr + (size_t)((rg >> 2) * 128 + (rg & 3) * 16) * D + bj * 128) = w; }
    }
};
__device__ __forceinline__ void p3_merge(Frame& F) {
    unsigned char* ws = F.ws;
    pg9::DenseOrder S; S.init(T, D, F.G, (int)blockIdx.x);
    EpiMerge E{(const bf16*)(ws + WS_G), (bf16*)(ws + WS_MG)};
    pg9::DenseA ao{(unsigned)(Y_W * 2)}; pg9::DenseB bb{(const char*)(ws + WS_WAB), (size_t)256 * Y_W * 2};
    pg9::gemm_phase<2>(F.lds, (const char*)(ws + WS_Y), Y_W, S, E, ao, bb);
}
struct EpiOut {
    static constexpr bool PERM = true; static constexpr int HOOK_T = -1;
    bf16* DELTA;
    __device__ __forceinline__ void hook(f32x4 (&)[2][2][4][2], const pg9::Unit&, int, int, int, int) const {}
    __device__ __forceinline__ void operator()(const f32x4 (&acc)[2][2][4][2], const pg9::Unit& u, int wr, int wc, int fr, int fq) const {
        asm volatile("" : "+v"(fr), "+v"(fq));
        bf16* orow = DELTA + (size_t)(u.pm * 256 + wr * 64 + fr) * D + u.pn * 256 + wc * 32 + 8 * fq;
#pragma unroll
        for (int ai = 0; ai < 2; ++ai)
#pragma unroll
            for (int m = 0; m < 4; ++m)
#pragma unroll
                for (int bj = 0; bj < 2; ++bj) { const f32x4 o0 = acc[ai][bj][m][0], o1 = acc[ai][bj][m][1];
                    v4u w; w.x = cvtpk(o0[0], o0[1]); w.y = cvtpk(o0[2], o0[3]); w.z = cvtpk(o1[0], o1[1]); w.w = cvtpk(o1[2], o1[3]); *(GAS v4u*)(orow + (size_t)(ai * 128 + m * 16) * D + bj * 128) = w; }
    }
};
__device__ __forceinline__ void p4_outproj(Frame& F) {
    unsigned char* ws = F.ws;
    pg9::DenseOrder S; S.init(T, D, F.G, (int)blockIdx.x);
    EpiOut E{(bf16*)((unsigned char*)F.out + DO_DELTA)};
    pg9::DenseA ao{(unsigned)(D * 2)}; pg9::DenseB bb{(const char*)(ws + WS_WO), (size_t)256 * D * 2};
    pg9::gemm_phase<2>(F.lds, (const char*)(ws + WS_MG), D, S, E, ao, bb);
}

__device__ __forceinline__ void p5_route(Frame& F) {
    int tid_ = threadIdx.x; asm volatile("" : "+v"(tid_)); const int lane = tid_ & 63;
    unsigned char* ws = F.ws;
    const float* X = F.in[I_X]; const bf16* DELTA = (const bf16*)((const unsigned char*)F.out + DO_DELTA);
    bf16* X1B = (bf16*)(ws + WS_X1B); unsigned char* X1F8 = ws + WS_X1F8;
    unsigned* cnt = (unsigned*)(ws + WS_CTL) + CW_CNT;
    int* tokof = (int*)(ws + WS_TOKOF); float2* wtof = (float2*)(ws + WS_WTOF); int4* tpos = (int4*)(ws + WS_TPOS);
    const v4u* WRF = (const v4u*)(ws + WS_WRF);
    LAS v4u* wl = (LAS v4u*)F.lds;
    LAS float* sl = (LAS float*)(F.lds + 98304 + F.wave * 4096);
    const int i = lane & 15, q = lane >> 4;
    LAS unsigned* hist = (LAS unsigned*)(F.lds + LDS_MISC + 2048);
    for (int wt = F.vcu; wt < T / 128; wt += F.G) {
        const int tile = wt * NWAVES + F.wave;
        if (tid_ < 32) hist[tid_] = 0u;
        const size_t roff = (size_t)(tile * 16 + i) * D + 8 * q;
        const float* xr = X + roff; const bf16* dr = DELTA + roff;
        f32x4 a0 = {0.f, 0.f, 0.f, 0.f}, a1 = a0, a2 = a0; float ss = 0.f;
        f32x4 va[8][2]; v4u vd[8];
#pragma unroll
        for (int j = 0; j < 8; ++j) { va[j][0] = *(const GAS f32x4*)(xr + 32 * j); va[j][1] = *(const GAS f32x4*)(xr + 32 * j + 4); vd[j] = *(const GAS v4u*)(dr + 32 * j); }
#pragma unroll 1
        for (int half = 0; half < 2; ++half) {
            __syncthreads();
            { v4u t[12];
#pragma unroll
              for (int k = 0; k < 12; ++k) t[k] = WRF[half * 6144 + k * 512 + tid_];
#pragma unroll
              for (int k = 0; k < 12; ++k) wl[k * 512 + tid_] = t[k]; }
            __syncthreads();
#pragma unroll 1
            for (int sb = 0; sb < 2; ++sb) {
#pragma unroll
                for (int j = 0; j < 8; ++j) {
                    const int ksl = sb * 8 + j, ks = half * 16 + ksl;
                    const v4u dd = vd[j];
                    const f32x4 v0 = va[j][0] + (f32x4){bflo(dd.x), bfhi(dd.x), bflo(dd.y), bfhi(dd.y)}, v1 = va[j][1] + (f32x4){bflo(dd.z), bfhi(dd.z), bflo(dd.w), bfhi(dd.w)};
                    if (ks + 8 < 32) { va[j][0] = *(const GAS f32x4*)(xr + 32 * (ks + 8)); va[j][1] = *(const GAS f32x4*)(xr + 32 * (ks + 8) + 4); vd[j] = *(const GAS v4u*)(dr + 32 * (ks + 8)); }
                    ss += ((v0[0] * v0[0] + v0[1] * v0[1]) + (v0[2] * v0[2] + v0[3] * v0[3])) + ((v1[0] * v1[0] + v1[1] * v1[1]) + (v1[2] * v1[2] + v1[3] * v1[3]));
                    v4u hu; hu.x = cvtpk(v0[0], v0[1]); hu.y = cvtpk(v0[2], v0[3]); hu.z = cvtpk(v1[0], v1[1]); hu.w = cvtpk(v1[2], v1[3]);
                    v4u lu; lu.x = cvtpk(v0[0] - bflo(hu.x), v0[1] - bfhi(hu.x)); lu.y = cvtpk(v0[2] - bflo(hu.y), v0[3] - bfhi(hu.y)); lu.z = cvtpk(v1[0] - bflo(hu.z), v1[1] - bfhi(hu.z)); lu.w = cvtpk(v1[2] - bflo(hu.w), v1[3] - bfhi(hu.w));
                    *(GAS v4u*)(X1B + roff + 32 * ks) = hu;
                    if (P6_FP8) { v2u w8; w8.x = pk4_fp8(v0[0], v0[1], v0[2], v0[3]); w8.y = pk4_fp8(v1[0], v1[1], v1[2], v1[3]); *(GAS v2u*)(X1F8 + roff + 32 * ks) = w8; }
                    const bf16x8 ah = __builtin_bit_cast(bf16x8, hu), al = __builtin_bit_cast(bf16x8, lu);
#pragma unroll
                    for (int nb = 0; nb < 3; ++nb) {
                        const bf16x8 bh = __builtin_bit_cast(bf16x8, wl[((ksl * 3 + nb) * 2 + 0) * 64 + lane]), bl = __builtin_bit_cast(bf16x8, wl[((ksl * 3 + nb) * 2 + 1) * 64 + lane]);
                        f32x4 acc = nb == 0 ? a0 : (nb == 1 ? a1 : a2);
                        acc = __builtin_amdgcn_mfma_f32_16x16x32_bf16(ah, bh, acc, 0, 0, 0); acc = __builtin_amdgcn_mfma_f32_16x16x32_bf16(ah, bl, acc, 0, 0, 0); acc = __builtin_amdgcn_mfma_f32_16x16x32_bf16(al, bh, acc, 0, 0, 0);
                        if (nb == 0) a0 = acc; else if (nb == 1) a1 = acc; else a2 = acc;
                    }
                }
            }
        }
        ss += __shfl_xor(ss, 16); ss += __shfl_xor(ss, 32);
#pragma unroll
        for (int r = 0; r < 4; ++r) { sl[(4 * q + r) * 48 + i] = a0[r]; sl[(4 * q + r) * 48 + 16 + i] = a1[r]; sl[(4 * q + r) * 48 + 32 + i] = a2[r]; }
        LDS_WAIT(); asm volatile("" ::: "memory");
        int e0 = 0, e1 = 0, lp0 = 0, lp1 = 0; float w1 = 0.f, w2 = 0.f, rstd = 0.f;
        __syncthreads();
        if (lane < 16) {
            rstd = 1.0f / sqrtf(ss * (1.f / D) + RMS_EPS);
            float lg[36];
#pragma unroll
            for (int o = 0; o < 36; ++o) lg[o] = sl[lane * 48 + o] * rstd + (o < 4 ? F.in[I_BRG][o] : F.in[I_BRE][o - 4]);
            int gsel = 0; float gmax = lg[0];
#pragma unroll
            for (int k = 1; k < 4; ++k) if (lg[k] > gmax) { gmax = lg[k]; gsel = k; }
            float gden = 0.f;
#pragma unroll
            for (int k = 0; k < 4; ++k) gden += __expf(lg[k] - gmax);
            const float pg = 1.0f / gden;
            float le[8];
#pragma unroll
            for (int j = 0; j < 8; ++j) { le[j] = lg[4 + j];
#pragma unroll
                for (int gi = 1; gi < 4; ++gi) le[j] = (gsel == gi) ? lg[4 + gi * 8 + j] : le[j]; }
            int i1 = 0; float m1 = le[0];
#pragma unroll
            for (int j = 1; j < 8; ++j) if (le[j] > m1) { m1 = le[j]; i1 = j; }
            int i2 = -1; float m2 = -INFINITY;
#pragma unroll
            for (int j = 0; j < 8; ++j) if (j != i1 && le[j] > m2) { m2 = le[j]; i2 = j; }
            const float e2 = __expf(m2 - m1);
            w1 = pg / (1.0f + e2); w2 = pg * e2 / (1.0f + e2);
            e0 = gsel * 8 + i1; e1 = gsel * 8 + i2;
            lp0 = (int)__hip_atomic_fetch_add(&hist[e0], 1u, __ATOMIC_RELAXED, __HIP_MEMORY_SCOPE_WORKGROUP);
            lp1 = (int)__hip_atomic_fetch_add(&hist[e1], 1u, __ATOMIC_RELAXED, __HIP_MEMORY_SCOPE_WORKGROUP);
        }
        __syncthreads();
        if (tid_ < 32) { const unsigned n = hist[tid_]; hist[32 + tid_] = n ? atomicAdd(&cnt[64 * tid_], n) : 0u; }
        __syncthreads();
        if (lane < 16) {
            const int row = tile * 16 + lane;
            const int p0 = (int)hist[32 + e0] + lp0, p1 = (int)hist[32 + e1] + lp1;
            tokof[(size_t)e0 * T + p0] = row; wtof[(size_t)e0 * T + p0] = make_float2(w1, rstd);
            tokof[(size_t)e1 * T + p1] = row; wtof[(size_t)e1 * T + p1] = make_float2(w2, rstd);
            tpos[row] = make_int4(e0, p0, e1, p1);
        }
        __syncthreads();
    }
}

__device__ __forceinline__ void expert_tiles(Frame& F, LAS int* tb, LAS int* cn) {
    int tid_ = threadIdx.x; asm volatile("" : "+v"(tid_)); const int lane_ = tid_ & 63;
    if (tid_ == 0) {
        const unsigned* cnt = (const unsigned*)(F.ws + WS_CTL) + CW_CNT;
        int acc = 0;
        for (int e = 0; e < NE; ++e) { const int c = (int)__hip_atomic_load(cnt + 64 * e, __ATOMIC_RELAXED, __HIP_MEMORY_SCOPE_AGENT); cn[e] = c; tb[e] = acc; acc += (c + 255) >> 8; }
        tb[NE] = acc;
    }
    __syncthreads();
}

struct MoeOrder { const LAS int* tb; int ncol, G, c;
    __device__ bool next(int i, pg9::Unit& u) const {
        const int L = i * G + c; if (L >= tb[NE] * ncol) return false;
        const int rt = L / ncol; int e = 0;
        for (int k = 1; k < NE; ++k) if (tb[k] <= rt) e = k;
        u.pm = rt; u.pn = L % ncol; u.e = e; return true; } };
struct GatherA { static constexpr bool GATHER = true; unsigned rowbytes; const int* tokof; const LAS int* tb; const LAS int* cn;
    __device__ __forceinline__ unsigned operator()(const pg9::Unit& u, int row) const {
        const int p = (u.pm - tb[u.e]) * 256 + row; const int tok = tokof[(size_t)u.e * T + (p < cn[u.e] ? p : 0)]; return (unsigned)tok * rowbytes; } };
struct ExpertB { const char* W; size_t ebytes, tilebytes; __device__ __forceinline__ const char* operator()(const pg9::Unit& u) const { return W + (size_t)u.e * ebytes + (size_t)u.pn * tilebytes; } };
struct EpiGateUp {
    static constexpr bool PERM = true; static constexpr int HOOK_T = -1;
    const float2* wtof; bf16* HACT; const LAS int* tb; const LAS int* cn; float ascale;
    __device__ __forceinline__ void hook(f32x4 (&)[2][2][4][2], const pg9::Unit&, int, int, int, int) const {}
    __device__ __forceinline__ void operator()(const f32x4 (&acc)[2][2][4][2], const pg9::Unit& u, int wr, int wc, int fr, int fq) const {
        asm volatile("" : "+v"(fr), "+v"(fq));
        const int r0 = wr * 64 + fr, p0 = (u.pm - tb[u.e]) * 256, ce = cn[u.e];
        const float2* wp = wtof + (size_t)u.e * T;
#pragma unroll
        for (int ai = 0; ai < 2; ++ai) {
            float2 wv[4];
#pragma unroll
            for (int m = 0; m < 4; ++m) { const int p = p0 + r0 + ai * 128 + m * 16; wv[m] = p < ce ? wp[p] : make_float2(0.f, 0.f); }
#pragma unroll
            for (int m = 0; m < 4; ++m) { const int r = r0 + ai * 128 + m * 16;
                const float w = wv[m].x, rs = wv[m].y * ascale;
                bf16* orow = HACT + (size_t)(u.pm * 256 + r) * DE + u.pn * 128 + wc * 16 + 4 * fq; unsigned char* orow8 = (unsigned char*)HACT + (size_t)(u.pm * 256 + r) * DE + u.pn * 128 + wc * 16 + 4 * fq;
#pragma unroll
                for (int bj = 0; bj < 2; ++bj) { const f32x4 g = acc[ai][bj][m][0], uu = acc[ai][bj][m][1]; f32x4 hv;
#pragma unroll
                    for (int e = 0; e < 4; ++e) { const float gg = g[e] * rs; hv[e] = gg / (1.0f + __expf(-gg)) * (uu[e] * rs) * w; }
                    if (P6_FP8) *(GAS unsigned*)(orow8 + bj * 64) = pk4_fp8(hv[0] * H8_SCALE, hv[1] * H8_SCALE, hv[2] * H8_SCALE, hv[3] * H8_SCALE);
                    else { v2u o; o.x = cvtpk(hv[0], hv[1]); o.y = cvtpk(hv[2], hv[3]); *(GAS v2u*)(orow + bj * 64) = o; } } }
        }
    }
};
__device__ __forceinline__ void p6a_gateup(Frame& F) {
    unsigned char* ws = F.ws;
    LAS int* tb = (LAS int*)(F.lds + LDS_MISC + 1024); LAS int* cn = tb + 64;
    expert_tiles(F, tb, cn);
    MoeOrder S{tb, 2, F.G, F.vcu};
    constexpr int ES = P6_FP8 ? 1 : 2;
    GatherA ao{(unsigned)(D * ES), (const int*)(ws + WS_TOKOF), tb, cn}; ExpertB bb{(const char*)(ws + WS_WGU), (size_t)512 * D * ES, (size_t)256 * D * ES};
    EpiGateUp E{(const float2*)(ws + WS_WTOF), (bf16*)(ws + WS_HACT), tb, cn, P6_FP8 ? 1.0f / WG8_SCALE : 1.0f};
    pg9::gemm_phase<ES>(F.lds, (const char*)(ws + (P6_FP8 ? WS_X1F8 : WS_X1B)), D, S, E, ao, bb);
}
struct EpiDown {
    static constexpr bool PERM = true; static constexpr int HOOK_T = -1;
    bf16* YS; float ascale;
    __device__ __forceinline__ void hook(f32x4 (&)[2][2][4][2], const pg9::Unit&, int, int, int, int) const {}
    __device__ __forceinline__ void operator()(const f32x4 (&acc)[2][2][4][2], const pg9::Unit& u, int wr, int wc, int fr, int fq) const {
        asm volatile("" : "+v"(fr), "+v"(fq));
#pragma unroll
        for (int ai = 0; ai < 2; ++ai)
#pragma unroll
            for (int m = 0; m < 4; ++m) { bf16* orow = YS + (size_t)(u.pm * 256 + wr * 64 + fr + ai * 128 + m * 16) * D + u.pn * 256 + wc * 32 + 8 * fq;
#pragma unroll
                for (int bj = 0; bj < 2; ++bj) { const f32x4 v0 = acc[ai][bj][m][0] * ascale, v1 = acc[ai][bj][m][1] * ascale;
                    v4u w; w.x = cvtpk(v0[0], v0[1]); w.y = cvtpk(v0[2], v0[3]); w.z = cvtpk(v1[0], v1[1]); w.w = cvtpk(v1[2], v1[3]); *(GAS v4u*)(orow + bj * 128) = w; } }
    }
};
__device__ __forceinline__ void p6b_down(Frame& F) {
    unsigned char* ws = F.ws;
    LAS int* tb = (LAS int*)(F.lds + LDS_MISC + 1024); LAS int* cn = tb + 64;
    expert_tiles(F, tb, cn);
    MoeOrder S{tb, 4, F.G, F.vcu};
    constexpr int ES = P6_FP8 ? 1 : 2;
    pg9::DenseA ao{(unsigned)(DE * ES)}; ExpertB bb{(const char*)(ws + WS_WD), (size_t)D * DE * ES, (size_t)256 * DE * ES};
    EpiDown E{(bf16*)(ws + WS_YS), P6_FP8 ? 1.0f / (WD8_SCALE * H8_SCALE) : 1.0f};
    pg9::gemm_phase<ES>(F.lds, (const char*)(ws + WS_HACT), DE, S, E, ao, bb);
}
__device__ __forceinline__ void p7_final(Frame& F) {
    int tid_ = threadIdx.x; asm volatile("" : "+v"(tid_)); const int lane_ = tid_ & 63;
    unsigned char* ws = F.ws;
    LAS int* tb = (LAS int*)(F.lds + LDS_MISC + 1024); LAS int* cn = tb + 64;
    expert_tiles(F, tb, cn);
    const bf16* YS = (const bf16*)(ws + WS_YS); const int4* tpos = (const int4*)(ws + WS_TPOS);
    float* X1 = F.out; const bf16* X1B = (const bf16*)(ws + WS_X1B);
    const int lane = lane_;
    const int gw = F.vcu * NWAVES + F.wave, NGW = F.G * NWAVES;
    const GAS f32x4* gr = (const GAS f32x4*)F.in[I_GFIN] + lane;
    for (int row = gw; row < T; row += NGW) {
        const int4 tp = tpos[row];
        const size_t s0 = (size_t)tb[tp.x] * 256 + tp.y, s1 = (size_t)tb[tp.z] * 256 + tp.w;
        GAS f32x4* xr = (GAS f32x4*)(X1 + (size_t)row * D) + lane; const GAS v2u* xb = (const GAS v2u*)(X1B + (size_t)row * D) + lane;
        const GAS v2u* y0 = (const GAS v2u*)(YS + s0 * D) + lane; const GAS v2u* y1 = (const GAS v2u*)(YS + s1 * D) + lane;
        f32x4 v[4]; float s = 0.f;
#pragma unroll
        for (int j = 0; j < 4; ++j) { const v2u xx = xb[64 * j]; v[j] = (f32x4){bflo(xx.x), bfhi(xx.x), bflo(xx.y), bfhi(xx.y)}; const v2u a = y0[64 * j], b = y1[64 * j];
            v[j].x += bflo(a.x) + bflo(b.x); v[j].y += bfhi(a.x) + bfhi(b.x); v[j].z += bflo(a.y) + bflo(b.y); v[j].w += bfhi(a.y) + bfhi(b.y);
            s += (v[j].x * v[j].x + v[j].y * v[j].y) + (v[j].z * v[j].z + v[j].w * v[j].w); }
        const float rstd = 1.0f / sqrtf(wave_sum(s) * (1.f / D) + RMS_EPS);
#pragma unroll
        for (int j = 0; j < 4; ++j) { const f32x4 gg = gr[64 * j]; f32x4 o; o.x = v[j].x * rstd * gg.x; o.y = v[j].y * rstd * gg.y; o.z = v[j].z * rstd * gg.z; o.w = v[j].w * rstd * gg.w; xr[64 * j] = o; }
    }
}

constexpr int NPHASE = 2 * NCH + 8;
__global__ void __launch_bounds__(NTHR, 2) fwd_kernel(KArgs args) {
    extern __shared__ __attribute__((aligned(16))) unsigned char lds_raw[];
    Frame F;
    F.lds = (LAS unsigned char*)lds_raw;
    F.tid = threadIdx.x; F.lane = F.tid & 63; F.wave = __builtin_amdgcn_readfirstlane(F.tid >> 6);
    F.G = gridDim.x; { const int bx = blockIdx.x; F.vcu = (F.G % 8 == 0) ? (bx % 8) * (F.G / 8) + bx / 8 : bx; }
#pragma unroll
    for (int i = 0; i < 17; ++i) F.in[i] = args.in[i];
    F.out = args.out; F.ws = args.ws;
    volatile LAS unsigned* MISC = (volatile LAS unsigned*)(F.lds + LDS_MISC);
    if (F.tid < 64) MISC[F.tid] = 0u;
    __syncthreads();
    XcdBarrier bar = xcd_barrier_post((unsigned*)(F.ws + WS_CTL) + CW_BAR + args.li * XCD_BAR_WORDS, MISC + 8);
#define IN(k) (args.ph_lo <= (k) && (k) < args.ph_hi)
#ifdef PROBE_MASK
    unsigned long long pr_acc = 0, pr_t0 = 0; const bool pr_me = (blockIdx.x == 0 && threadIdx.x == 0);
#define PR_BEGIN(k) do { if (pr_me && ((PROBE_MASK >> (k)) & 1ull)) pr_t0 = __builtin_amdgcn_s_memrealtime(); } while (0)
#define PR_END(k) do { if (pr_me && ((PROBE_MASK >> (k)) & 1ull)) pr_acc += __builtin_amdgcn_s_memrealtime() - pr_t0; } while (0)
#else
#define PR_BEGIN(k) do {} while (0)
#define PR_END(k) do {} while (0)
#endif
#define SEAM(k) do { if (IN(k) && IN((k) + 1)) xcd_barrier(bar); PR_END(k); } while (0)
    PR_BEGIN(0); if (IN(0)) p0_prologue(F);
    SEAM(0);
#pragma unroll 1
    for (int ch = 0; ch < NCH; ++ch) {
        PR_BEGIN(1 + 2 * ch); if (IN(1 + 2 * ch)) { if (ch > 0) p2_combine(F, ch - 1); p1_inproj(F, ch); }
        SEAM(1 + 2 * ch);
        PR_BEGIN(2 + 2 * ch); if (IN(2 + 2 * ch)) p2_attn(F, ch);
        SEAM(2 + 2 * ch);
    }
    PR_BEGIN(2 * NCH + 1); if (IN(2 * NCH + 1)) p2_combine(F, NCH - 1);
    SEAM(2 * NCH + 1);
    PR_BEGIN(2 * NCH + 2); if (IN(2 * NCH + 2)) p3_merge(F);
    SEAM(2 * NCH + 2);
    PR_BEGIN(2 * NCH + 3); if (IN(2 * NCH + 3)) p4_outproj(F);
    SEAM(2 * NCH + 3);
    PR_BEGIN(2 * NCH + 4); if (IN(2 * NCH + 4)) p5_route(F);
    SEAM(2 * NCH + 4);
    PR_BEGIN(2 * NCH + 5); if (IN(2 * NCH + 5)) p6a_gateup(F);
    SEAM(2 * NCH + 5);
    PR_BEGIN(2 * NCH + 6); if (IN(2 * NCH + 6)) p6b_down(F);
    SEAM(2 * NCH + 6);
    PR_BEGIN(2 * NCH + 7); if (IN(2 * NCH + 7)) p7_final(F);
    PR_END(2 * NCH + 7);
#ifdef PROBE_MASK
    if (pr_me) { const unsigned long long t1 = __builtin_amdgcn_s_memrealtime(); while (__builtin_amdgcn_s_memrealtime() - t1 < pr_acc) __builtin_amdgcn_s_sleep(4); }
#endif
#undef IN
#undef SEAM
}

#ifndef N_LAUNCHES
#define N_LAUNCHES 1
#endif
extern "C" void kernel_launch(void* const* d_in, const int* in_sizes, int n_in, void* d_out, int out_size, void* d_ws, size_t ws_size, hipStream_t stream) {
    static int grid = 0;
    if (grid == 0) {
        if (n_in != 17 || in_sizes[0] != T * D || out_size != T * D || ws_size < WS_END) { fprintf(stderr, "kernel_launch: unexpected shapes / workspace (%d inputs, ws %zu)\n", n_in, ws_size); grid = -1; return; }
        int dev = 0, cus = 0;
        if (hipGetDevice(&dev) != hipSuccess || hipDeviceGetAttribute(&cus, hipDeviceAttributeMultiprocessorCount, dev) != hipSuccess) { grid = -1; return; }
        if (hipFuncSetAttribute((const void*)fwd_kernel, hipFuncAttributeMaxDynamicSharedMemorySize, LDS_BYTES) != hipSuccess) { fprintf(stderr, "kernel_launch: hipFuncSetAttribute failed\n"); grid = -1; return; }
        int per_cu = 0;
        if (hipOccupancyMaxActiveBlocksPerMultiprocessor(&per_cu, (const void*)fwd_kernel, NTHR, LDS_BYTES) != hipSuccess || per_cu < 1) fprintf(stderr, "kernel_launch: occupancy query says %d\n", per_cu);
        (void)hipGetLastError();
        grid = cus;
    }
    if (grid < 0) return;
    (void)hipMemsetAsync((char*)d_ws + WS_CTL, 0, N_LAUNCHES == 1 ? (size_t)(CW_BAR + XCD_BAR_WORDS) * 4 : CTL_BYTES, stream);
    KArgs a{};
    for (int i = 0; i < 17; ++i) a.in[i] = (const float*)d_in[i];
    a.out = (float*)d_out; a.ws = (unsigned char*)d_ws;
    for (int li = 0; li < N_LAUNCHES; ++li) {
        a.ph_lo = (int)((long)NPHASE * li / N_LAUNCHES); a.ph_hi = (int)((long)NPHASE * (li + 1) / N_LAUNCHES); a.li = li;
        hipLaunchKernelGGL(fwd_kernel, dim3(grid), dim3(NTHR), LDS_BYTES, stream, a);
    }
}
```

```cpp
#include <hip/hip_runtime.h>
#include <cstdint>
#include <cstdio>

#define GAS __attribute__((address_space(1)))
#define LAS __attribute__((address_space(3)))
typedef unsigned short bf16;
typedef short bf16x8 __attribute__((ext_vector_type(8)));
typedef float f32x4 __attribute__((ext_vector_type(4)));
typedef unsigned v4u __attribute__((ext_vector_type(4)));
typedef unsigned v2u __attribute__((ext_vector_type(2)));
typedef GAS unsigned gu32;

constexpr int T = 32768, D = 1024, SEQ = 4096, NIN = 7936;
constexpr int A_W = 4608, B_W = 1280, G_W = 2048, Y_W = 1536;
constexpr int NE = 32, DE = 256;
constexpr int NCH = 4, TC = T / NCH;
constexpr float QSCALE = 0.125f * 1.4426950408889634f;
constexpr float LOG2E = 1.4426950408889634f;
constexpr float RMS_EPS = 1e-6f;
#ifndef P1_FP8
#define P1_FP8 1
#endif
constexpr float W8_SCALE = P1_FP8 ? 64.0f : 0.0f, W8_INV = P1_FP8 ? 1.0f / 64.0f : 1.0f;
#ifndef P6_FP8
#define P6_FP8 1
#endif
constexpr float WG8_SCALE = P6_FP8 ? 64.0f : 0.0f, WD8_SCALE = P6_FP8 ? 32.0f : 0.0f, H8_SCALE = 32.0f;
constexpr int NWAVES = 8, NTHR = 512;

constexpr size_t MiB = 1u << 20;
constexpr size_t WS_CTL = 0, CTL_BYTES = 1 * MiB;
constexpr size_t WS_INVF = 1 * MiB;
constexpr size_t WS_WRF = 2 * MiB;
constexpr size_t WS_TOKOF = 3 * MiB;
constexpr size_t WS_WTOF = 7 * MiB;
constexpr size_t WS_TPOS = 15 * MiB;
constexpr size_t WS_WIN = 16 * MiB;
constexpr size_t WS_WAB = 32 * MiB;
constexpr size_t WS_WO = 35 * MiB;
constexpr size_t WS_WGU = 37 * MiB;
constexpr size_t WS_WD = 69 * MiB;
constexpr size_t WS_G = 86 * MiB;
constexpr size_t WS_Y = 214 * MiB;
constexpr size_t WS_ZA = 310 * MiB;
constexpr size_t WS_ZB = 454 * MiB;
constexpr size_t WS_END = 494 * MiB;
constexpr size_t WS_MG = WS_ZA;
constexpr size_t WS_X1B = WS_ZA + 64 * MiB;
constexpr size_t WS_X1F8 = WS_Y + 64 * MiB;
constexpr size_t WS_HACT = WS_G;
constexpr size_t WS_YS = WS_G + 36 * MiB;
constexpr size_t DO_DELTA = 0;
constexpr size_t DO_HN = 0;
constexpr size_t DO_OG = 64 * MiB;
constexpr size_t DO_LSE = 112 * MiB;
constexpr int MAXSLOT = 2 * T + NE * 256;
static_assert(WS_ZA + (size_t)TC * A_W * 2 <= WS_ZB && WS_ZB + (size_t)TC * B_W * 2 <= WS_END && WS_Y + (size_t)T * Y_W * 2 <= WS_ZA && WS_G + (size_t)T * G_W * 2 <= WS_Y, "ws map");
static_assert(WS_MG + (size_t)T * D * 2 <= WS_END && WS_HACT + (size_t)MAXSLOT * DE * 2 <= WS_YS && WS_YS + (size_t)MAXSLOT * D * 2 <= WS_ZA && WS_X1B >= WS_MG + (size_t)T * D * 2 && WS_X1B + (size_t)T * D * 2 <= WS_ZB, "ws map");
static_assert(DO_OG + (size_t)3 * TC * 512 * 2 <= DO_LSE && DO_LSE + (size_t)3 * TC * 8 * 4 <= (size_t)T * D * 4 && DO_HN + (size_t)T * D * 2 <= DO_OG, "d_out scratch map");
constexpr int CW_CNT = 1024;
constexpr int CW_BAR = 4096;
constexpr int LDS_BYTES = 147456;
constexpr int LDS_MISC = 131072;

__device__ __forceinline__ unsigned f2bf(float f) { unsigned u = __builtin_bit_cast(unsigned, f); return (u + 0x7fffu + ((u >> 16) & 1u)) >> 16; }
__device__ __forceinline__ unsigned pk4_fp8(float a, float b, float c, float d) {
    a = __builtin_amdgcn_fmed3f(a, -448.f, 448.f); b = __builtin_amdgcn_fmed3f(b, -448.f, 448.f); c = __builtin_amdgcn_fmed3f(c, -448.f, 448.f); d = __builtin_amdgcn_fmed3f(d, -448.f, 448.f);
    int w = 0; w = __builtin_amdgcn_cvt_pk_fp8_f32(a, b, w, false); w = __builtin_amdgcn_cvt_pk_fp8_f32(c, d, w, true); return (unsigned)w; }
__device__ __forceinline__ unsigned pk2(float lo, float hi) { return f2bf(lo) | (f2bf(hi) << 16); }
__device__ __forceinline__ float bf2f(unsigned b) { return __builtin_bit_cast(float, b << 16); }
__device__ __forceinline__ float bflo(unsigned u) { return __builtin_bit_cast(float, u << 16); }
__device__ __forceinline__ float bfhi(unsigned u) { return __builtin_bit_cast(float, u & 0xffff0000u); }
__device__ __forceinline__ float wave_sum(float v) {
#pragma unroll
    for (int o = 1; o < 64; o <<= 1) v += __shfl_xor(v, o);
    return v;
}
__device__ __forceinline__ float wave_max(float v) {
#pragma unroll
    for (int o = 1; o < 64; o <<= 1) v = fmaxf(v, __shfl_xor(v, o));
    return v;
}
typedef float f32x2_t __attribute__((ext_vector_type(2)));
typedef __bf16 bf16x2_t __attribute__((ext_vector_type(2)));
__device__ __forceinline__ unsigned cvtpk(float lo, float hi) { f32x2_t v = {lo, hi}; bf16x2_t b = __builtin_convertvector(v, bf16x2_t); return __builtin_bit_cast(unsigned, b); }
#ifndef WT_STORES
#define WT_STORES 0
#endif
__device__ __forceinline__ __amdgpu_buffer_rsrc_t wt_rsrc(unsigned char* base) { return __builtin_amdgcn_make_buffer_rsrc(base, 0, 0x7ffffffc, 0x00020000); }
__device__ __forceinline__ void st16(__amdgpu_buffer_rsrc_t r, unsigned char* base, void* p, v4u v) { if (WT_STORES) __builtin_amdgcn_raw_buffer_store_b128(v, r, (unsigned)((unsigned char*)p - base), 0, 16); else *(GAS v4u*)p = v; }
__device__ __forceinline__ void st8(__amdgpu_buffer_rsrc_t r, unsigned char* base, void* p, v2u v) { if (WT_STORES) __builtin_amdgcn_raw_buffer_store_b64(v, r, (unsigned)((unsigned char*)p - base), 0, 16); else *(GAS v2u*)p = v; }
#define LDS_WAIT() asm volatile("s_waitcnt lgkmcnt(0)" ::: "memory")
#define VM_WAIT() asm volatile("s_waitcnt vmcnt(0)" ::: "memory")

#define XB_TMO      128
#define XB_XCNT(j)  (256  + 64 * (j))
#define XB_XSUB(j)  (1280 + 64 * (j))
#define XB_XGEN(j)  (2304 + 64 * (j))
#define XB_TOP      3328
#define XB_TOPGEN   3392
#define XCD_BAR_WORDS 3456
#define XB_SPIN_CAP (1u << 18)
__device__ __forceinline__ unsigned xb_ld(unsigned* p)              { return __hip_atomic_load(p, __ATOMIC_RELAXED, __HIP_MEMORY_SCOPE_AGENT); }
__device__ __forceinline__ unsigned xb_add(unsigned* p, unsigned v) { return __hip_atomic_fetch_add(p, v, __ATOMIC_RELAXED, __HIP_MEMORY_SCOPE_AGENT); }
__device__ __forceinline__ unsigned xb_xcc_id() { return (unsigned)__builtin_amdgcn_s_getreg((3 << 11) | 20) & 0xFu; }
#define XB_SPIN(cond, bar) do { unsigned _sp = 0; while (cond) { __builtin_amdgcn_s_sleep(1); \
    if ((++_sp & 255u) == 0u) { if (xb_ld(&(bar)[XB_TMO])) break; if (_sp > XB_SPIN_CAP) { atomicAdd(&(bar)[XB_TMO], 1u); break; } } } } while (0)
struct XcdBarrier { unsigned* bar; unsigned x; volatile LAS unsigned* st; };
__device__ __forceinline__ XcdBarrier xcd_barrier_post(unsigned* bar, volatile LAS unsigned* st) {
    XcdBarrier b; b.bar = bar; b.x = xb_xcc_id(); b.st = st;
    if (threadIdx.x == 0) (void)xb_add(&bar[XB_XCNT(b.x)], 1u);
    return b;
}
__device__ __forceinline__ void xcd_barrier_complete(unsigned* bar, unsigned x, unsigned& nloc, unsigned& nx) {
    const unsigned G = gridDim.x * gridDim.y * gridDim.z;
    unsigned sum, cnt, mine, sp = 0u;
    for (;;) {
        sum = 0u; cnt = 0u; mine = 0u;
#pragma unroll
        for (unsigned j = 0; j < 16; ++j) { const unsigned c = xb_ld(&bar[XB_XCNT(j)]); sum += c; cnt += (c > 0u) ? 1u : 0u; mine = (j == x) ? c : mine; }
        if (sum == G) break;
        __builtin_amdgcn_s_sleep(1);
        if ((++sp & 255u) == 0u) { if (xb_ld(&bar[XB_TMO])) break; if (sp > XB_SPIN_CAP) { atomicAdd(&bar[XB_TMO], 1u); break; } }
    }
    nloc = mine > 0u ? mine : 1u; nx = cnt > 0u ? cnt : 1u;
}
__device__ __forceinline__ void xcd_barrier(const XcdBarrier& b) {
    asm volatile("s_waitcnt vmcnt(0)" ::: "memory");
    __syncthreads();
    if (threadIdx.x == 0) {
        unsigned* bar = b.bar;
        __builtin_amdgcn_s_waitcnt(0);
        unsigned nloc = b.st[0], nx = b.st[1];
        if (nloc == 0u) { xcd_barrier_complete(bar, b.x, nloc, nx); b.st[0] = nloc; b.st[1] = nx; }
        const unsigned old = xb_add(&bar[XB_XSUB(b.x)], 1u);
        const unsigned gen = old / nloc;
        if (old + 1u == (gen + 1u) * nloc) {
            __builtin_amdgcn_fence(__ATOMIC_RELEASE, "agent");
            asm volatile("s_waitcnt vmcnt(0)" ::: "memory");
            const unsigned og = xb_add(&bar[XB_TOP], 1u);
            const unsigned tg = og / nx;
            if (og + 1u == (tg + 1u) * nx) xb_add(&bar[XB_TOPGEN], 1u);
            else XB_SPIN(xb_ld(&bar[XB_TOPGEN]) == tg, bar);
            __builtin_amdgcn_fence(__ATOMIC_ACQUIRE, "agent");
            xb_add(&bar[XB_XGEN(b.x)], 1u);
            asm volatile("s_waitcnt vmcnt(0)" ::: "memory");
        } else {
            XB_SPIN(xb_ld(&bar[XB_XGEN(b.x)]) == gen, bar);
            __builtin_amdgcn_fence(__ATOMIC_ACQUIRE, "agent");
            asm volatile("s_waitcnt vmcnt(0)" ::: "memory");
        }
    }
    __syncthreads();
}

struct KArgs { const float* in[17]; float* out; unsigned char* ws; int ph_lo, ph_hi, li, pad; };
struct Frame {
    LAS unsigned char* lds;
    int tid, lane, wave, vcu, G;
    const float* in[17]; float* out; unsigned char* ws;
};
enum { I_X = 0, I_WIN, I_BIN, I_SINK, I_WPA, I_WPB, I_WOUT, I_GMIX, I_GFFN, I_WRG, I_BRG, I_WRE, I_BRE, I_WEG, I_WEU, I_WED, I_GFIN };

struct TrDesc { const float* W; int N; bf16* WT; int ldo, rowbase, koff, k0, n0; bool perm; const float* kscale; float f8scale; };
__device__ __forceinline__ void tr_load(const TrDesc& d, int lane, f32x4 (&tv)[8], float (&ks)[8]) {
    const float* src = d.W + (size_t)(d.k0 + (lane >> 3)) * d.N + d.n0 + 4 * (lane & 7);
#pragma unroll
    for (int i = 0; i < 8; ++i) tv[i] = *(const GAS f32x4*)(src + (size_t)(8 * i) * d.N);
#pragma unroll
    for (int i = 0; i < 8; ++i) ks[i] = d.kscale ? d.kscale[d.k0 + 8 * i + (lane >> 3)] : 1.0f;
}
__device__ __forceinline__ void tr_finish(const TrDesc& d, LAS float* scr, int lane, const f32x4 (&tv)[8], const float (&ks)[8]) {
#pragma unroll
    for (int i = 0; i < 8; ++i) { const int kk = 8 * i + (lane >> 3); LAS float* w = scr + kk * 33 + 4 * (lane & 7);
        w[0] = tv[i][0] * ks[i]; w[1] = tv[i][1] * ks[i]; w[2] = tv[i][2] * ks[i]; w[3] = tv[i][3] * ks[i]; }
    LDS_WAIT(); asm volatile("" ::: "memory");
    const int c = lane & 7;
#pragma unroll
    for (int j = 0; j < 4; ++j) { const int n = (lane >> 3) + 8 * j; const LAS float* s = scr + (8 * c) * 33 + n;
        const int rr = d.perm ? 8 * (n >> 2) + (n & 3) : n;
        if (d.f8scale != 0.f) { const float f = d.f8scale; v2u o8; o8.x = pk4_fp8(s[0 * 33] * f, s[1 * 33] * f, s[2 * 33] * f, s[3 * 33] * f); o8.y = pk4_fp8(s[4 * 33] * f, s[5 * 33] * f, s[6 * 33] * f, s[7 * 33] * f);
            *(GAS v2u*)((unsigned char*)d.WT + (size_t)(d.rowbase + rr) * d.ldo + d.koff + d.k0 + 8 * c) = o8; }
        else { v4u o; o.x = pk2(s[0 * 33], s[1 * 33]); o.y = pk2(s[2 * 33], s[3 * 33]); o.z = pk2(s[4 * 33], s[5 * 33]); o.w = pk2(s[6 * 33], s[7 * 33]);
            *(GAS v4u*)(d.WT + (size_t)(d.rowbase + rr) * d.ldo + d.koff + d.k0 + 8 * c) = o; } }
    LDS_WAIT(); asm volatile("" ::: "memory");
}
__device__ __forceinline__ void rms_row_to_bf16(const float* xrow, const float* g, bf16* orow, int lane) {
    const GAS f32x4* xr = (const GAS f32x4*)xrow + lane; const GAS f32x4* gr = (const GAS f32x4*)g + lane;
    f32x4 v[4]; float s = 0.f;
#pragma unroll
    for (int j = 0; j < 4; ++j) { v[j] = xr[64 * j]; s += (v[j].x * v[j].x + v[j].y * v[j].y) + (v[j].z * v[j].z + v[j].w * v[j].w); }
    const float rstd = 1.0f / sqrtf(wave_sum(s) * (1.f / D) + RMS_EPS);
    GAS v2u* o8 = (GAS v2u*)orow + lane;
#pragma unroll
    for (int j = 0; j < 4; ++j) { const f32x4 gg = gr[64 * j]; v2u w; w.x = pk2(v[j].x * rstd * gg.x, v[j].y * rstd * gg.y); w.y = pk2(v[j].z * rstd * gg.z, v[j].w * rstd * gg.w); o8[64 * j] = w; }
}
__device__ __forceinline__ void p0_prologue(Frame& F) {
    int tid_ = threadIdx.x; asm volatile("" : "+v"(tid_)); const int lane_ = tid_ & 63;
    LAS float* scr = (LAS float*)(F.lds + F.wave * 16384);
    const int gw = F.vcu * NWAVES + F.wave, NGW = F.G * NWAVES;
    unsigned char* ws = F.ws;
    constexpr int I_IN = 16 * 248, I_PA = 8 * 32, I_PB = 16 * 32, I_WO = 16 * 32, I_EG = 32 * 16 * 8, I_ED = 32 * 4 * 32;
    constexpr int NITEMS = I_IN + I_PA + I_PB + I_WO + 2 * I_EG + I_ED;
    auto decode = [&](int it, TrDesc& d) {
        int r = it; d.perm = false; d.kscale = nullptr; d.f8scale = 0.f; d.koff = 0;
        if (r < I_IN) { const int kb = r / 248, nb = r % 248, n0 = 32 * nb; const bool qk = (n0 < 3072) || (n0 >= A_W && n0 < A_W + 1152);
            const bool gt_ = n0 >= A_W + B_W; const int gc = n0 - (A_W + B_W);
            d.W = F.in[I_WIN]; d.N = NIN; d.WT = (bf16*)(ws + WS_WIN); d.ldo = 1024; d.rowbase = qk ? (n0 & ~63) + ((n0 >> 5) & 1) * 4 : (gt_ ? A_W + B_W + 2 * (gc % 1024) + 4 * (gc / 1024) : n0); d.k0 = 64 * kb; d.n0 = n0; d.perm = qk || gt_; d.f8scale = W8_SCALE; return; } r -= I_IN;
        if (r < I_PA) { const int kb = r / 32, nb = r % 32; d.W = F.in[I_WPA]; d.N = 1024; d.WT = (bf16*)(ws + WS_WAB); d.ldo = 1536; d.rowbase = 32 * nb; d.k0 = 64 * kb; d.n0 = 32 * nb; return; } r -= I_PA;
        if (r < I_PB) { const int kb = r / 32, nb = r % 32; d.W = F.in[I_WPB]; d.N = 1024; d.WT = (bf16*)(ws + WS_WAB); d.ldo = 1536; d.rowbase = 32 * nb; d.koff = 512; d.k0 = 64 * kb; d.n0 = 32 * nb; return; } r -= I_PB;
        if (r < I_WO) { const int kb = r / 32, nb = r % 32; d.W = F.in[I_WOUT]; d.N = 1024; d.WT = (bf16*)(ws + WS_WO); d.ldo = 1024; d.rowbase = 32 * nb; d.k0 = 64 * kb; d.n0 = 32 * nb; return; } r -= I_WO;
        if (r < 2 * I_EG) { const int up = r >= I_EG; if (up) r -= I_EG; const int e = r / 128, q = r % 128, kb = q / 8, nb = q % 8;
            d.W = F.in[up ? I_WEU : I_WEG] + (size_t)e * 1024 * 256; d.N = 256; d.WT = (bf16*)(ws + WS_WGU) + (size_t)e * 512 * 1024; d.ldo = 1024; d.rowbase = 64 * nb + (up ? 4 : 0); d.k0 = 64 * kb; d.n0 = 32 * nb; d.perm = true; d.kscale = F.in[I_GFFN]; d.f8scale = WG8_SCALE; if (P6_FP8) d.WT = (bf16*)((unsigned char*)(ws + WS_WGU) + (size_t)e * 512 * 1024); return; } r -= 2 * I_EG;
        { const int e = r / 128, q = r % 128, kb = q / 32, nb = q % 32;
            d.W = F.in[I_WED] + (size_t)e * 256 * 1024; d.N = 1024; d.WT = (bf16*)(ws + WS_WD) + (size_t)e * 1024 * 256; d.ldo = 256; d.rowbase = 32 * nb; d.k0 = 64 * kb; d.n0 = 32 * nb; d.f8scale = WD8_SCALE; if (P6_FP8) d.WT = (bf16*)((unsigned char*)(ws + WS_WD) + (size_t)e * 1024 * 256); }
    };
    {
        int it = gw; TrDesc dc, dn; f32x4 tc[8], tn[8]; float kc[8], kn[8];
        bool hc = it < NITEMS; if (hc) { decode(it, dc); tr_load(dc, lane_, tc, kc); }
        while (hc) {
            it += NGW; const bool hn = it < NITEMS;
            if (hn) { decode(it, dn); tr_load(dn, lane_, tn, kn); }
            tr_finish(dc, scr, lane_, tc, kc);
            hc = hn; dc = dn;
#pragma unroll
            for (int i = 0; i < 8; ++i) { tc[i] = tn[i]; kc[i] = kn[i]; }
        }
    }
    for (int m = gw; m < T; m += 4 * NGW) {
        const GAS f32x4* gr = (const GAS f32x4*)F.in[I_GMIX] + lane_;
        f32x4 v[4][4]; float ss[4];
#pragma unroll
        for (int r = 0; r < 4; ++r) { const int mr = (m + r * NGW < T) ? m + r * NGW : m; const GAS f32x4* xr = (const GAS f32x4*)(F.in[I_X] + (size_t)mr * D) + lane_;
#pragma unroll
            for (int j = 0; j < 4; ++j) v[r][j] = xr[64 * j]; }
#pragma unroll
        for (int r = 0; r < 4; ++r) { float a = 0.f;
#pragma unroll
            for (int j = 0; j < 4; ++j) a += (v[r][j].x * v[r][j].x + v[r][j].y * v[r][j].y) + (v[r][j].z * v[r][j].z + v[r][j].w * v[r][j].w);
            ss[r] = 1.0f / sqrtf(wave_sum(a) * (1.f / D) + RMS_EPS); }
#pragma unroll
        for (int r = 0; r < 4; ++r) { if (m + r * NGW >= T) continue; GAS unsigned* o4 = (GAS unsigned*)((unsigned char*)F.out + DO_HN + (size_t)(m + r * NGW) * D) + lane_;
#pragma unroll
            for (int j = 0; j < 4; ++j) { const f32x4 gg = gr[64 * j];
                if (P1_FP8) o4[64 * j] = pk4_fp8(v[r][j].x * ss[r] * gg.x, v[r][j].y * ss[r] * gg.y, v[r][j].z * ss[r] * gg.z, v[r][j].w * ss[r] * gg.w);
                else { v2u w; w.x = cvtpk(v[r][j].x * ss[r] * gg.x, v[r][j].y * ss[r] * gg.y); w.y = cvtpk(v[r][j].z * ss[r] * gg.z, v[r][j].w * ss[r] * gg.w); ((GAS v2u*)((unsigned char*)F.out + DO_HN + (size_t)(m + r * NGW) * D * 2) + lane_)[64 * j] = w; } } }
    }
    const int gt = F.vcu * NTHR + tid_, NGT = F.G * NTHR;
    if (gt < 32) ((float*)(ws + WS_INVF))[gt] = (float)exp2(-(double)gt * (13.287712379549449 / 32.0));
    for (int i = gt; i < 32 * 3 * 64; i += NGT) {
        const int ln = i & 63, nb = (i >> 6) % 3, ks = i / 192;
        const int n = 16 * nb + (ln & 15);
        float hi[8], lo[8];
#pragma unroll
        for (int e = 0; e < 8; ++e) { const int k = 32 * ks + 8 * (ln >> 4) + e; float v = 0.f;
            if (n < 4) v = F.in[I_WRG][k * 4 + n]; else if (n < 36) v = F.in[I_WRE][k * 32 + (n - 4)];
            v *= F.in[I_GFFN][k]; hi[e] = bf2f(f2bf(v)); lo[e] = v - hi[e]; }
        v4u h, l; h.x = pk2(hi[0], hi[1]); h.y = pk2(hi[2], hi[3]); h.z = pk2(hi[4], hi[5]); h.w = pk2(hi[6], hi[7]);
        l.x = pk2(lo[0], lo[1]); l.y = pk2(lo[2], lo[3]); l.z = pk2(lo[4], lo[5]); l.w = pk2(lo[6], lo[7]);
        ((v4u*)(ws + WS_WRF))[((ks * 3 + nb) * 2 + 0) * 64 + ln] = h; ((v4u*)(ws + WS_WRF))[((ks * 3 + nb) * 2 + 1) * 64 + ln] = l;
    }
}

namespace pg8 {
#define PG8_LAS __attribute__((address_space(3)))
typedef unsigned short bf16_t;
typedef short bf16x8 __attribute__((ext_vector_type(8)));
typedef float f32x4 __attribute__((ext_vector_type(4)));
typedef unsigned u32x4 __attribute__((ext_vector_type(4)));
constexpr int BM = 256, BK = 64, HALF = 128, HTB = HALF * BK * 2  , STAGE_BYTES = 8 * HTB, NXCD = 8, WGM = 8;

__host__ __device__ __forceinline__ int lds_byte(int r, int c) { const int st = (r >> 4) * 2 + (c >> 5), rr = r & 15, cc = c & 31, ob = rr * 64 + cc * 2; return st * 1024 + (ob ^ (((ob >> 9) & 1) << 5)); }
__host__ __device__ __forceinline__ void stage_rc(int b, int& R, int& C) { const int st = b / 1024, sb = b % 1024, swz = sb ^ (((sb >> 9) & 1) << 5); R = (st >> 1) * 16 + swz / 64; C = (st & 1) * 32 + (swz % 64) / 2; }
__host__ __device__ __forceinline__ int perm32(int rho) { const int n = rho >> 4, i = rho & 15; return 8 * (i >> 2) + 4 * n + (i & 3); }

struct Unit { int pm, pn; };
struct Gemm { const bf16_t* A; const bf16_t* Bt; int M, N, K; };

struct StaticOrder {
    int nM, nN, nwg, G, c;
    __host__ __device__ void init(int M, int N, int G_, int c_) { nM = M / BM; nN = N / BM; nwg = nM * nN; G = G_; c = c_; }
    __host__ __device__ bool next(int i, Unit& u) const {
        const long L = (long)i * G + c; if (L >= nwg) return false;
        int wgid = (int)L; { const int q = nwg / NXCD, r = nwg % NXCD, xcd = wgid % NXCD, off = wgid / NXCD; wgid = (xcd < r ? xcd * (q + 1) : r * (q + 1) + (xcd - r) * q) + off; }
        const int nig = WGM * nN, gid = wgid / nig, fm = gid * WGM, gsz = (nM - fm) < WGM ? (nM - fm) : WGM;
        u.pm = fm + ((wgid % nig) % gsz); u.pn = (wgid % nig) / gsz; return true;
    }
    __device__ __forceinline__ void a_ready(const Unit&) const {}
    __device__ __forceinline__ void done(const Unit&) const {}
};
}


namespace pg9 {
using pg8::BM; using pg8::BK; using pg8::HALF; using pg8::HTB; using pg8::lds_byte; using pg8::stage_rc; using pg8::perm32;
struct Unit { int pm, pn, e; };
typedef int v8i_t __attribute__((ext_vector_type(8)));
typedef int v4i_t __attribute__((ext_vector_type(4)));
template <int ESZ, class Epi, class Sched, class AOff, class BBase>
__device__ __forceinline__ void gemm_phase(LAS unsigned char* lds, const char* Abase, int K, const Sched& S, const Epi& E, const AOff& aoffn, const BBase& bbase) {
    int tid_ = threadIdx.x; asm volatile("" : "+v"(tid_));
    const int tid = tid_, wid = __builtin_amdgcn_readfirstlane(tid >> 6), lane = tid & 63, wr = wid >> 2, wc = wid & 3, fr = lane & 15, fq = lane >> 4;
    const int nt = K * ESZ / (BK * 2);
    int Rr[2], Cc[2]; unsigned voffB[2];
#pragma unroll
    for (int i = 0; i < 2; ++i) { int R, C; stage_rc(tid * 16 + i * 8192, R, C); const int Rb = Epi::PERM ? ((R & ~31) + perm32(R & 31)) : R; Rr[i] = R; Cc[i] = C; voffB[i] = (unsigned)(Rb * K * ESZ + C * 2); }
    const size_t kstep = (size_t)(BK * 2);
    const size_t hstep = (size_t)HALF * K * ESZ;
    const unsigned ldsw = (unsigned)wid * 1024u;
    const int aoff = lds_byte(wr * 64 + fr, fq * 8), boff = lds_byte(wc * 32 + fr, fq * 8);
#define PG9_SA(b, h) (((b) * 2 + (h)) * HTB)
#define PG9_SB(b, h) ((4 + (b) * 2 + (h)) * HTB)
#define PG9_STAGE(bufoff, gbase, voff) do { _Pragma("unroll") for (int _i = 0; _i < 2; ++_i) \
        __builtin_amdgcn_global_load_lds((const unsigned*)((const char*)(gbase) + (voff)[_i]), (LAS unsigned*)(lds + (bufoff) + ldsw + _i * 8192), 16, 0, 0); } while (0)
#define PG9_LDA(dst, b, h) do { _Pragma("unroll") for (int m = 0; m < 4; ++m) { dst[m].lo = *(const LAS v4i_t*)(lds + PG9_SA(b, h) + aoff + m * 2048); dst[m].hi = *(const LAS v4i_t*)(lds + PG9_SA(b, h) + aoff + m * 2048 + 1024); } } while (0)
#define PG9_LDB(dst, b, h) do { _Pragma("unroll") for (int n = 0; n < 2; ++n) { dst[n].lo = *(const LAS v4i_t*)(lds + PG9_SB(b, h) + boff + n * 2048); dst[n].hi = *(const LAS v4i_t*)(lds + PG9_SB(b, h) + boff + n * 2048 + 1024); } } while (0)
#define PG9_HALF(v, o) __builtin_bit_cast(bf16x8, __builtin_shufflevector((v), (v), (o), (o) + 1, (o) + 2, (o) + 3))
#define PG9_MMA(ai, bj, At, Bt) do { __builtin_amdgcn_s_setprio(1); _Pragma("unroll") for (int m = 0; m < 4; ++m) _Pragma("unroll") for (int n = 0; n < 2; ++n) { \
        if (ESZ == 2) { acc[ai][bj][m][n] = __builtin_amdgcn_mfma_f32_16x16x32_bf16(PG9_HALF(Bt[n], 0), PG9_HALF(At[m], 0), acc[ai][bj][m][n], 0, 0, 0); \
                        acc[ai][bj][m][n] = __builtin_amdgcn_mfma_f32_16x16x32_bf16(PG9_HALF(Bt[n], 4), PG9_HALF(At[m], 4), acc[ai][bj][m][n], 0, 0, 0); } \
        else { asm volatile("v_mfma_scale_f32_16x16x128_f8f6f4 %0, %1, %2, %0, %3, %3 op_sel_hi:[0,0,0]" : "+v"(acc[ai][bj][m][n]) : "v"(Bt[n]), "v"(At[m]), "v"(one8)); } } \
        __builtin_amdgcn_s_setprio(0); } while (0)
#define PG9_WAIT_V(n) asm volatile("s_waitcnt vmcnt(" #n ")" ::: "memory")
#define PG9_WAIT_L(n) asm volatile("s_waitcnt lgkmcnt(" #n ")" ::: "memory")
#define PG9_BAR __builtin_amdgcn_s_barrier()
#define PG9_SCHED __builtin_amdgcn_sched_barrier(0)
#define PG9_VA(dst, u) do { _Pragma("unroll") for (int _h = 0; _h < 2; ++_h) _Pragma("unroll") for (int _i = 0; _i < 2; ++_i) dst[_h][_i] = aoffn((u), _h * HALF + Rr[_i]) + (unsigned)(Cc[_i] * 2); } while (0)
    constexpr bool GATHER = AOff::GATHER;
    const size_t hstepA = (size_t)HALF * aoffn.rowbytes;
    unsigned voffA[2];
#pragma unroll
    for (int i = 0; i < 2; ++i) voffA[i] = (unsigned)Rr[i] * aoffn.rowbytes + (unsigned)(Cc[i] * 2);
#define PG9_STAGE_A(bufoff, h, koff, nx) do { if (GATHER) { PG9_STAGE(bufoff, Abase + (koff), ((nx) ? nvA[h] : cvA[h])); } else { PG9_STAGE(bufoff, ((nx) ? nAu : cAu) + (h) * hstepA + (koff), voffA); } } while (0)
    Unit cur, nxt; int ui = 0;
    if (!S.next(0, cur)) return;
    f32x4 acc[2][2][4][2];
#pragma unroll
    for (int a = 0; a < 2; ++a)
#pragma unroll
        for (int b = 0; b < 2; ++b)
#pragma unroll
            for (int m = 0; m < 4; ++m)
#pragma unroll
                for (int n = 0; n < 2; ++n) acc[a][b][m][n] = (f32x4){0.f, 0.f, 0.f, 0.f};
    int one8 = 0x7f7f7f7f; asm volatile("" : "+v"(one8));
    v8i_t At[4], B0[2], B1[2];
    unsigned cvA[2][2], nvA[2][2];
    if (GATHER) { PG9_VA(cvA, cur); }
    const char* cAu = GATHER ? Abase : Abase + (size_t)aoffn(cur, 0); const char* nAu = cAu;
    const char* cB = bbase(cur);
    PG9_STAGE(PG9_SB(0, 0), cB, voffB); PG9_STAGE(PG9_SB(0, 1), cB + hstep, voffB); PG9_STAGE_A(PG9_SA(0, 0), 0, 0, false); PG9_STAGE_A(PG9_SA(0, 1), 1, 0, false);
    if (wr == 1) PG9_BAR;
    PG9_WAIT_V(2); PG9_BAR;
    PG9_STAGE(PG9_SB(1, 0), cB + kstep, voffB); PG9_STAGE_A(PG9_SA(1, 0), 0, kstep, false); PG9_STAGE(PG9_SB(1, 1), cB + hstep + kstep, voffB);
    PG9_WAIT_V(6); PG9_BAR;
    for (;;) {
        const bool has_next = S.next(ui + 1, nxt);
        if (GATHER) {
            if (has_next) { PG9_VA(nvA, nxt); } else {
#pragma unroll
                for (int _h = 0; _h < 2; ++_h)
#pragma unroll
                    for (int _i = 0; _i < 2; ++_i) nvA[_h][_i] = cvA[_h][_i]; }
        } else nAu = has_next ? Abase + (size_t)aoffn(nxt, 0) : cAu;
        const char* nB = has_next ? bbase(nxt) : cB;
#pragma unroll 1
        for (int t = 0; t < nt; t += 2) {
            const bool last = (t == nt - 2);
            if (Epi::HOOK_T >= 0) { if (t == Epi::HOOK_T) E.hook(acc, cur, wr, wc, fr, fq); }
            const size_t k1 = (size_t)(t + 1) * kstep, k2 = last ? 0 : (size_t)(t + 2) * kstep, k3 = k2 + kstep;
            const char* b2 = last ? nB : cB + (size_t)(t + 2) * kstep; const char* b3 = b2 + kstep;
            PG9_LDB(B0, 0, 0); PG9_LDB(B1, 0, 1); PG9_SCHED; PG9_LDA(At, 0, 0); PG9_STAGE_A(PG9_SA(1, 1), 1, k1, false);
            PG9_WAIT_V(8); PG9_WAIT_L(0); PG9_BAR; PG9_MMA(0, 0, At, B0); PG9_MMA(0, 1, At, B1); PG9_BAR; PG9_SCHED;
            PG9_LDA(At, 0, 1); PG9_STAGE(PG9_SB(0, 0), b2, voffB); PG9_STAGE(PG9_SB(0, 1), b2 + hstep, voffB); PG9_STAGE_A(PG9_SA(0, 0), 0, k2, last);
            PG9_WAIT_V(8); PG9_WAIT_L(0); PG9_BAR; PG9_MMA(1, 0, At, B0); PG9_MMA(1, 1, At, B1); PG9_BAR; PG9_SCHED;
            PG9_LDB(B0, 1, 0); PG9_LDB(B1, 1, 1); PG9_SCHED; PG9_LDA(At, 1, 0); PG9_STAGE_A(PG9_SA(0, 1), 1, k2, last);
            PG9_WAIT_V(8); PG9_WAIT_L(0); PG9_BAR; PG9_MMA(0, 0, At, B0); PG9_MMA(0, 1, At, B1); PG9_BAR; PG9_SCHED;
            PG9_LDA(At, 1, 1); PG9_STAGE(PG9_SB(1, 0), b3, voffB); PG9_STAGE(PG9_SB(1, 1), b3 + hstep, voffB); PG9_STAGE_A(PG9_SA(1, 0), 0, k3, last);
            PG9_WAIT_V(8); PG9_WAIT_L(0); PG9_BAR; PG9_MMA(1, 0, At, B0); PG9_MMA(1, 1, At, B1); PG9_BAR; PG9_SCHED;
        }
        if (wr == 0) PG9_BAR;
        if (ESZ == 1) asm volatile("s_nop 15\n\ts_nop 15" ::: "memory");
        E(acc, cur, wr, wc, fr, fq);
        if (!has_next) break;
#pragma unroll
        for (int a = 0; a < 2; ++a)
#pragma unroll
            for (int b = 0; b < 2; ++b)
#pragma unroll
                for (int m = 0; m < 4; ++m)
#pragma unroll
                    for (int n = 0; n < 2; ++n) acc[a][b][m][n] = (f32x4){0.f, 0.f, 0.f, 0.f};
        cur = nxt; cB = nB; cAu = nAu; ++ui;
        if (GATHER) {
#pragma unroll
            for (int _h = 0; _h < 2; ++_h)
#pragma unroll
                for (int _i = 0; _i < 2; ++_i) cvA[_h][_i] = nvA[_h][_i]; }
        if (wr == 1) PG9_BAR;
    }
    PG9_WAIT_V(0);
    PG9_BAR;
#undef PG9_SA
#undef PG9_SB
#undef PG9_STAGE
#undef PG9_LDA
#undef PG9_LDB
#undef PG9_MMA
#undef PG9_HALF
#undef PG9_WAIT_V
#undef PG9_WAIT_L
#undef PG9_BAR
#undef PG9_SCHED
#undef PG9_VA
#undef PG9_STAGE_A
}
struct DenseOrder { pg8::StaticOrder so;
    __device__ void init(int M, int N, int G, int c) { so.init(M, N, G, c); }
    __device__ bool next(int i, Unit& u) const { pg8::Unit v; if (!so.next(i, v)) return false; u.pm = v.pm; u.pn = v.pn; u.e = 0; return true; } };
struct DenseA { static constexpr bool GATHER = false; unsigned rowbytes; __device__ __forceinline__ unsigned operator()(const Unit& u, int row) const { return (unsigned)(u.pm * 256 + row) * rowbytes; } };
struct DenseB { const char* Bt; size_t tilebytes; __device__ __forceinline__ const char* operator()(const Unit& u) const { return Bt + (size_t)u.pn * tilebytes; } };
}

struct EpiInproj {
    static constexpr bool PERM = true; static constexpr int HOOK_T = -1;
    bf16* ZA; bf16* ZB; bf16* Gt; const float* bias; const float* invf; unsigned char* wsb;
    __device__ __forceinline__ void hook(f32x4 (&)[2][2][4][2], const pg9::Unit&, int, int, int, int) const {}
    __device__ __forceinline__ void operator()(const f32x4 (&acc)[2][2][4][2], const pg9::Unit& u, int wr, int wc, int fr, int fq) const {
        asm volatile("" : "+v"(fr), "+v"(fq));
        const int row0 = u.pm * 256 + wr * 64 + fr;
        const int q = 4 * (wc & 1) + fq;
        const __amdgpu_buffer_rsrc_t wr_ = wt_rsrc(wsb);
        int kind[2]; bf16* dst[2]; int ldd[2]; f32x4 b0[2], b1[2];
#pragma unroll
        for (int bj = 0; bj < 2; ++bj) {
            const int colpos = u.pn * 256 + bj * 128 + wc * 32 + 8 * fq, hb = u.pn * 256 + bj * 128 + (wc >> 1) * 64;
            if (hb < A_W) { kind[bj] = hb / 1536; dst[bj] = ZA + colpos; ldd[bj] = A_W; }
            else if (hb < A_W + B_W) { const int cb = hb - A_W; kind[bj] = cb < 1024 ? 0 : (cb < 1152 ? 1 : 2); dst[bj] = ZB + (colpos - A_W); ldd[bj] = B_W; }
            else { kind[bj] = 3; dst[bj] = Gt + ((colpos - A_W - B_W) >> 1); ldd[bj] = G_W; }
            b0[bj] = *(const f32x4*)(bias + (kind[bj] < 2 ? hb + 4 * q : (kind[bj] == 3 ? A_W + B_W + ((colpos - A_W - B_W) >> 1) : colpos)));
            b1[bj] = *(const f32x4*)(bias + (kind[bj] < 2 ? hb + 32 + 4 * q : (kind[bj] == 3 ? A_W + B_W + 1024 + ((colpos - A_W - B_W) >> 1) : colpos + 4)));
        }
        const bool need_rope = kind[0] < 2 || kind[1] < 2;
        const f32x4 fv = *(const f32x4*)(invf + 4 * q);
#pragma unroll
        for (int ai = 0; ai < 2; ++ai) {
            f32x4 rc[4], rs[4];
#pragma unroll
            for (int m = 0; m < 4; ++m) { rc[m] = (f32x4){1.f, 1.f, 1.f, 1.f}; rs[m] = (f32x4){0.f, 0.f, 0.f, 0.f}; }
            if (need_rope) {
#pragma unroll
                for (int m = 0; m < 4; ++m) { const float posf = (float)((row0 + ai * 128 + m * 16) & (SEQ - 1));
#pragma unroll
                    for (int e = 0; e < 4; ++e) { const float ang = posf * fv[e]; const float pr = ang * 0.15915494f; const float er = __builtin_fmaf(ang, 0.15915494f, -pr) + ang * 6.4206382e-9f;
                        const float fr = __builtin_amdgcn_fractf(pr) + er; rc[m][e] = __builtin_amdgcn_cosf(fr); rs[m][e] = __builtin_amdgcn_sinf(fr); } }
            }
#pragma unroll
            for (int bj = 0; bj < 2; ++bj) {
#pragma unroll
                for (int m = 0; m < 4; ++m) {
                    const int row = row0 + ai * 128 + m * 16;
                    f32x4 v0 = acc[ai][bj][m][0] * W8_INV + b0[bj], v1 = acc[ai][bj][m][1] * W8_INV + b1[bj];
                    if (kind[bj] < 2) {
                        const f32x4 cc = rc[m], ss = rs[m];
                        const f32x4 t0 = v0 * cc - v1 * ss, t1 = v1 * cc + v0 * ss;
                        v0 = t0; v1 = t1;
                        if (kind[bj] == 0) { v0 = v0 * QSCALE; v1 = v1 * QSCALE; }
                    }
                    if (kind[bj] == 3) {
#pragma unroll
                        for (int e = 0; e < 4; ++e) { const float d0 = 1.0f + __expf(-v0[e]), d1 = 1.0f + __expf(-v1[e]); v0[e] = d1 * __builtin_amdgcn_rcpf(d0); v1[e] = __builtin_amdgcn_rcpf(d1); }
                        v2u w0, w1; w0.x = cvtpk(v0[0], v0[1]); w0.y = cvtpk(v0[2], v0[3]); w1.x = cvtpk(v1[0], v1[1]); w1.y = cvtpk(v1[2], v1[3]);
                        st8(wr_, wsb, dst[bj] + (size_t)row * ldd[bj], w0); st8(wr_, wsb, dst[bj] + (size_t)row * ldd[bj] + 1024, w1);
                    } else {
                    v4u w; w.x = cvtpk(v0[0], v0[1]); w.y = cvtpk(v0[2], v0[3]); w.z = cvtpk(v1[0], v1[1]); w.w = cvtpk(v1[2], v1[3]);
                    st16(wr_, wsb, dst[bj] + (size_t)row * ldd[bj], w); }
                }
            }
        }
    }
};
__device__ __forceinline__ void p1_inproj(Frame& F, int ch) {
    unsigned char* ws = F.ws;
    pg9::DenseOrder S; S.init(TC, NIN, F.G, (int)blockIdx.x);
    EpiInproj E{(bf16*)(ws + WS_ZA), (bf16*)(ws + WS_ZB), (bf16*)(ws + WS_G) + (size_t)ch * TC * G_W, F.in[I_BIN], (const float*)(ws + WS_INVF), ws};
    constexpr int ES = P1_FP8 ? 1 : 2;
    pg9::DenseA ao{(unsigned)(D * ES)}; pg9::DenseB bb{(const char*)(ws + WS_WIN), (size_t)256 * D * ES};
    pg9::gemm_phase<ES>(F.lds, (const char*)F.out + DO_HN + (size_t)ch * TC * D * ES, D, S, E, ao, bb);
}

typedef float f32x16 __attribute__((ext_vector_type(16)));
typedef short v4i16_t __attribute__((ext_vector_type(4)));
__device__ __forceinline__ float half_max(float v) { auto rr = __builtin_amdgcn_permlane32_swap(__float_as_uint(v), __float_as_uint(v), false, false); return fmaxf(__uint_as_float(rr[0]), __uint_as_float(rr[1])); }
__device__ __forceinline__ float half_sum(float v) { auto rr = __builtin_amdgcn_permlane32_swap(__float_as_uint(v), __float_as_uint(v), false, false); return __uint_as_float(rr[0]) + __uint_as_float(rr[1]); }
__device__ __forceinline__ float max3f(float a, float b, float c) { float r; asm("v_max3_f32 %0, %1, %2, %3" : "=v"(r) : "v"(a), "v"(b), "v"(c)); return r; }
constexpr int ATT_VOFF = 49152;

struct AUnit { const bf16 *Kw, *Vw, *Qp; size_t pitch; int kk_lo, nkeys, kb0, kstart, lo; float m0, l0; bf16* Op; float* Lp; };
__device__ __forceinline__ void attn_decode(Frame& F, int ch, int u, int NUA, int lane, AUnit& d) {
    unsigned char* ws = F.ws;
    const int w = F.wave, c = lane & 31, h = (lane >> 5) & 1;
    if (u < NUA) {
        const bf16* ZA = (const bf16*)(ws + WS_ZA);
        const int rt = u & 15, hh = (u >> 4) & 7, gb = u >> 7, g = gb % 3, bl = gb / 3;
        const int dsh = 2 * g, dd = 1 << dsh, tsh = 4 - dsh;
        const int r = rt >> tsh, tile = rt & ((1 << tsh) - 1), i0 = tile * 256;
        const int rowb = bl * SEQ + r, col = g * 512 + hh * 64;
        d.pitch = (size_t)dd * A_W;
        d.Kw = ZA + ((long)rowb + (long)dd * (i0 - 128)) * A_W + 1536 + col; d.Vw = d.Kw + 1536;
        const long qrow = (long)rowb + (long)dd * (i0 + 32 * w + c);
        d.Qp = ZA + qrow * A_W + col;
        d.kk_lo = (i0 == 0) ? 128 : 0; d.nkeys = 384; d.kb0 = w; d.kstart = (i0 == 0) ? (w < 4 ? 4 - w : 0) : 0; d.lo = 0;
        d.m0 = -1e30f; d.l0 = 0.f;
        d.Op = (bf16*)((unsigned char*)F.out + DO_OG) + ((size_t)g * TC + qrow) * 512 + hh * 64;
        d.Lp = (float*)((unsigned char*)F.out + DO_LSE) + ((size_t)g * TC + qrow) * 8 + hh;
    } else {
        const int u2 = u - NUA;
        const bf16* ZB = (const bf16*)(ws + WS_ZB);
        const int blk = u2 & 127, kvh = (u2 >> 7) & 1, bl = u2 >> 8;
        const int t0 = blk * 32, rowb = bl * SEQ;
        d.pitch = B_W;
        d.Kw = ZB + ((long)rowb + t0 - 128) * B_W + 1024 + kvh * 64; d.Vw = d.Kw + 128;
        const int qh = kvh * 8 + w;
        const long qrow = (long)rowb + t0 + c;
        d.Qp = ZB + qrow * B_W + qh * 64;
        d.kk_lo = t0 < 128 ? 128 - t0 : 0; d.nkeys = 160; d.kb0 = 0; d.kstart = d.kk_lo >> 5; d.lo = 1;
        d.m0 = F.in[I_SINK][qh] * LOG2E; d.l0 = h == 0 ? 1.f : 0.f;
        d.Op = (bf16*)(ws + WS_Y) + ((size_t)ch * TC + qrow) * Y_W + 512 + qh * 64;
        d.Lp = nullptr;
    }
}
__device__ __forceinline__ void attn_load(const AUnit& d, int tid, int lane, v4u (&kreg)[6], v4u (&vreg)[6], bf16x8 (&qf)[4]) {
    const int skey = tid >> 3, sch = tid & 7, h = (lane >> 5) & 1;
#pragma unroll
    for (int s4 = 0; s4 < 4; ++s4) qf[s4] = *(const GAS bf16x8*)(d.Qp + 16 * s4 + 8 * h);
#pragma unroll
    for (int p = 0; p < 6; ++p) { const int kk = 64 * p + skey;
        if (kk >= d.kk_lo && kk < d.nkeys) { kreg[p] = *(const GAS v4u*)(d.Kw + (size_t)kk * d.pitch + 8 * sch); vreg[p] = *(const GAS v4u*)(d.Vw + (size_t)kk * d.pitch + 8 * sch); } }
}
__device__ __forceinline__ void attn_write(const AUnit& d, LAS unsigned char* KL, LAS unsigned char* VL, int tid, const v4u (&kreg)[6], const v4u (&vreg)[6]) {
    const int skey = tid >> 3, sch = tid & 7;
#pragma unroll
    for (int p = 0; p < 6; ++p) { const int kk = 64 * p + skey;
        if (kk >= d.kk_lo && kk < d.nkeys) {
            *(LAS v4u*)(KL + kk * 128 + ((sch ^ ((kk >> 1) & 7)) << 4)) = kreg[p];
            *(LAS v4u*)(VL + kk * 128 + ((sch * 16) ^ (((kk >> 1) & 1) << 6))) = vreg[p]; } }
}
__device__ __forceinline__ void attn_compute_edge(const AUnit& d, const LAS unsigned char* KL, const LAS unsigned char* VL, int lane, const bf16x8 (&qf)[4]) {
    const int c = lane & 31, h = (lane >> 5) & 1;
    int koff[4];
    { const int kswz = (c >> 1) & 7;
#pragma unroll
      for (int s4 = 0; s4 < 4; ++s4) koff[s4] = c * 128 + (((2 * s4 + h) ^ kswz) << 4); }
    const int vrow = 4 * h + ((lane & 15) >> 2), vsw = (lane >> 3) & 1;
    const int voff0 = vrow * 128 + ((32 * ((lane >> 4) & 1) + 8 * (lane & 3)) ^ (vsw << 6)), voff1 = voff0 ^ 64;
    const float NEG = -INFINITY;
    float m = d.m0, l = d.l0;
    f32x16 o0, o1;
#pragma unroll
    for (int i = 0; i < 16; ++i) { o0[i] = 0.f; o1[i] = 0.f; }
    const LAS unsigned char* kbp = KL + d.kb0 * 4096; const LAS unsigned char* vbp = VL + d.kb0 * 4096;
    const int clo = c + d.lo;
#pragma unroll
    for (int kbi = 0; kbi < 5; ++kbi) {
        if (kbi >= d.kstart) {
            f32x16 p;
#pragma unroll
            for (int i = 0; i < 16; ++i) p[i] = 0.f;
#pragma unroll
            for (int s4 = 0; s4 < 4; ++s4) { const bf16x8 kf = *(const LAS bf16x8*)(kbp + kbi * 4096 + koff[s4]); p = __builtin_amdgcn_mfma_f32_32x32x16_bf16(kf, qf[s4], p, 0, 0, 0); }
            if (kbi == 0) {
#pragma unroll
                for (int i = 0; i < 16; ++i) { const int x = (i & 3) + 8 * (i >> 2) + 4 * h; if (x < clo) p[i] = NEG; }
            }
            if (kbi == 4) {
#pragma unroll
                for (int i = 0; i < 16; ++i) { const int x = (i & 3) + 8 * (i >> 2) + 4 * h; if (x > c) p[i] = NEG; }
            }
            float mt = p[0];
#pragma unroll
            for (int i = 1; i < 16; ++i) mt = fmaxf(mt, p[i]);
            mt = half_max(mt);
            const float mn = fmaxf(m, mt), alpha = __builtin_amdgcn_exp2f(m - mn);
            m = mn;
            float ps = 0.f;
#pragma unroll
            for (int i = 0; i < 16; ++i) { p[i] = __builtin_amdgcn_exp2f(p[i] - mn); ps += p[i]; }
            l = l * alpha + ps;
#pragma unroll
            for (int i = 0; i < 16; ++i) { o0[i] *= alpha; o1[i] *= alpha; }
            bf16x8 pb[2];
#pragma unroll
            for (int s2 = 0; s2 < 2; ++s2) { v4u t; t.x = cvtpk(p[8 * s2 + 0], p[8 * s2 + 1]); t.y = cvtpk(p[8 * s2 + 2], p[8 * s2 + 3]); t.z = cvtpk(p[8 * s2 + 4], p[8 * s2 + 5]); t.w = cvtpk(p[8 * s2 + 6], p[8 * s2 + 7]); pb[s2] = __builtin_bit_cast(bf16x8, t); }
#pragma unroll
            for (int s2 = 0; s2 < 2; ++s2) {
#pragma unroll
                for (int db = 0; db < 2; ++db) {
                    const LAS unsigned char* vp = vbp + kbi * 4096 + s2 * 2048 + (db ? voff1 : voff0);
                    const v4i16_t lo = __builtin_amdgcn_ds_read_tr16_b64_v4i16((LAS v4i16_t*)vp);
                    const v4i16_t hi = __builtin_amdgcn_ds_read_tr16_b64_v4i16((LAS v4i16_t*)(vp + 1024));
                    const bf16x8 vf = {lo[0], lo[1], lo[2], lo[3], hi[0], hi[1], hi[2], hi[3]};
                    if (db == 0) o0 = __builtin_amdgcn_mfma_f32_32x32x16_bf16(vf, pb[s2], o0, 0, 0, 0);
                    else o1 = __builtin_amdgcn_mfma_f32_32x32x16_bf16(vf, pb[s2], o1, 0, 0, 0);
                }
            }
        }
    }
    const float lt = half_sum(l), inv = 1.0f / lt;
#pragma unroll
    for (int g4 = 0; g4 < 4; ++g4) {
        v2u a, b;
        a.x = cvtpk(o0[4 * g4 + 0] * inv, o0[4 * g4 + 1] * inv); a.y = cvtpk(o0[4 * g4 + 2] * inv, o0[4 * g4 + 3] * inv);
        b.x = cvtpk(o1[4 * g4 + 0] * inv, o1[4 * g4 + 1] * inv); b.y = cvtpk(o1[4 * g4 + 2] * inv, o1[4 * g4 + 3] * inv);
        *(GAS v2u*)(d.Op + 8 * g4 + 4 * h) = a;
        *(GAS v2u*)(d.Op + 32 + 8 * g4 + 4 * h) = b;
    }
    if (d.Lp) { if (h == 0) *d.Lp = m + __builtin_amdgcn_logf(lt); }
}
__device__ __forceinline__ void attn_compute(const AUnit& d, const LAS unsigned char* KL, const LAS unsigned char* VL, int lane, const bf16x8 (&qf)[4]) {
    const int c = lane & 31, h = (lane >> 5) & 1;
    int koff[4];
    { const int kswz = (c >> 1) & 7;
#pragma unroll
      for (int s4 = 0; s4 < 4; ++s4) koff[s4] = c * 128 + (((2 * s4 + h) ^ kswz) << 4); }
    const int vrow = 4 * h + ((lane & 15) >> 2), vsw = (lane >> 3) & 1;
    const int voff0 = vrow * 128 + ((32 * ((lane >> 4) & 1) + 8 * (lane & 3)) ^ (vsw << 6)), voff1 = voff0 ^ 64;
    const float NEG = -INFINITY;
    float m = d.m0;
    f32x16 o0, o1, L;
#pragma unroll
    for (int i = 0; i < 16; ++i) { o0[i] = 0.f; o1[i] = 0.f; L[i] = 0.f; }
    v4u onesu = {0x3F803F80u, 0x3F803F80u, 0x3F803F80u, 0x3F803F80u}; asm volatile("" : "+v"(onesu));
    const bf16x8 ones = __builtin_bit_cast(bf16x8, onesu);
    const LAS unsigned char* kbp = KL + d.kb0 * 4096; const LAS unsigned char* vbp = VL + d.kb0 * 4096;
    const int clo = c + d.lo;
#pragma unroll
    for (int kbi = 0; kbi < 5; ++kbi) {
        {
            constexpr bool first_dummy = false; (void)first_dummy;
            const bool first = (kbi == 0);
            const float cinit = first ? 0.f : -m;
            f32x16 p;
#pragma unroll
            for (int i = 0; i < 16; ++i) p[i] = cinit;
#pragma unroll
            for (int s4 = 0; s4 < 4; ++s4) { const bf16x8 kf = *(const LAS bf16x8*)(kbp + kbi * 4096 + koff[s4]); p = __builtin_amdgcn_mfma_f32_32x32x16_bf16(kf, qf[s4], p, 0, 0, 0); }
            if (kbi == 0) {
#pragma unroll
                for (int i = 0; i < 16; ++i) { const int x = (i & 3) + 8 * (i >> 2) + 4 * h; p[i] = x < clo ? NEG : p[i]; }
            }
            if (kbi == 4) {
#pragma unroll
                for (int i = 0; i < 16; ++i) { const int x = (i & 3) + 8 * (i >> 2) + 4 * h; p[i] = x > c ? NEG : p[i]; }
            }
            float t0 = max3f(p[0], p[4], p[8]), t1 = max3f(p[1], p[5], p[9]), t2 = max3f(p[2], p[6], p[10]), t3 = max3f(p[3], p[7], p[11]);
            t0 = max3f(t0, p[12], p[13]); t1 = max3f(t1, p[14], p[15]);
            const float mt = half_max(max3f(max3f(t0, t1, t2), t3, t3));
            if (first) {
                const float mn = fmaxf(m, mt), l0 = d.m0 > -1e29f ? __builtin_amdgcn_exp2f(m - mn) : 0.f;
                m = mn;
#pragma unroll
                for (int i = 0; i < 16; ++i) { p[i] -= mn; L[i] = l0; }
            } else if (__any(mt > 8.0f)) {
                const float dl = fmaxf(mt, 0.f), al = __builtin_amdgcn_exp2f(-dl);
                m += dl;
#pragma unroll
                for (int i = 0; i < 16; ++i) { o0[i] *= al; o1[i] *= al; L[i] *= al; p[i] -= dl; }
            }
#pragma unroll
            for (int i = 0; i < 16; ++i) p[i] = __builtin_amdgcn_exp2f(p[i]);
            bf16x8 pb[2];
#pragma unroll
            for (int s2 = 0; s2 < 2; ++s2) { v4u t; t.x = cvtpk(p[8 * s2 + 0], p[8 * s2 + 1]); t.y = cvtpk(p[8 * s2 + 2], p[8 * s2 + 3]); t.z = cvtpk(p[8 * s2 + 4], p[8 * s2 + 5]); t.w = cvtpk(p[8 * s2 + 6], p[8 * s2 + 7]); pb[s2] = __builtin_bit_cast(bf16x8, t); }
#pragma unroll
            for (int s2 = 0; s2 < 2; ++s2) {
                L = __builtin_amdgcn_mfma_f32_32x32x16_bf16(ones, pb[s2], L, 0, 0, 0);
#pragma unroll
                for (int db = 0; db < 2; ++db) {
                    const LAS unsigned char* vp = vbp + kbi * 4096 + s2 * 2048 + (db ? voff1 : voff0);
                    const v4i16_t lo = __builtin_amdgcn_ds_read_tr16_b64_v4i16((LAS v4i16_t*)vp);
                    const v4i16_t hi = __builtin_amdgcn_ds_read_tr16_b64_v4i16((LAS v4i16_t*)(vp + 1024));
                    const bf16x8 vf = {lo[0], lo[1], lo[2], lo[3], hi[0], hi[1], hi[2], hi[3]};
                    if (db == 0) o0 = __builtin_amdgcn_mfma_f32_32x32x16_bf16(vf, pb[s2], o0, 0, 0, 0);
                    else o1 = __builtin_amdgcn_mfma_f32_32x32x16_bf16(vf, pb[s2], o1, 0, 0, 0);
                }
            }
        }
    }
    const float lt = L[0], inv = 1.0f / lt;
#pragma unroll
    for (int g4 = 0; g4 < 4; ++g4) {
        v2u a, b;
        a.x = cvtpk(o0[4 * g4 + 0] * inv, o0[4 * g4 + 1] * inv); a.y = cvtpk(o0[4 * g4 + 2] * inv, o0[4 * g4 + 3] * inv);
        b.x = cvtpk(o1[4 * g4 + 0] * inv, o1[4 * g4 + 1] * inv); b.y = cvtpk(o1[4 * g4 + 2] * inv, o1[4 * g4 + 3] * inv);
        *(GAS v2u*)(d.Op + 8 * g4 + 4 * h) = a;
        *(GAS v2u*)(d.Op + 32 + 8 * g4 + 4 * h) = b;
    }
    if (d.Lp) { if (h == 0) *d.Lp = m + __builtin_amdgcn_logf(lt); }
}
__device__ __forceinline__ void p2_attn(Frame& F, int ch) {
    int tid_ = threadIdx.x; asm volatile("" : "+v"(tid_));
    const int tid = tid_, lane = tid & 63;
    LAS unsigned char* KL = F.lds; LAS unsigned char* VL = F.lds + ATT_VOFF;
    constexpr int NUA = (TC / SEQ) * 3 * 8 * 16, NUB = (TC / SEQ) * 2 * 128, NU = NUA + NUB;
    int u = F.vcu;
    if (u >= NU) return;
    AUnit cur, nxt;
    v4u kreg[6], vreg[6]; bf16x8 qn[4];
    attn_decode(F, ch, u, NUA, lane, cur);
    attn_load(cur, tid, lane, kreg, vreg, qn);
    for (;;) {
        attn_write(cur, KL, VL, tid, kreg, vreg);
        bf16x8 qf[4];
#pragma unroll
        for (int s4 = 0; s4 < 4; ++s4) qf[s4] = qn[s4];
        __syncthreads();
        const int un = u + F.G; const bool has_next = un < NU;
        if (has_next) { attn_decode(F, ch, un, NUA, lane, nxt); attn_load(nxt, tid, lane, kreg, vreg, qn); }
        if (cur.kk_lo == 0) attn_compute(cur, KL, VL, lane, qf); else attn_compute_edge(cur, KL, VL, lane, qf);
        __syncthreads();
        if (!has_next) break;
        cur = nxt; u = un;
    }
}
__device__ __forceinline__ void p2_combine(Frame& F, int ch, int cu, int ncu) {
    int tid_ = threadIdx.x; asm volatile("" : "+v"(tid_)); const int lane_ = tid_ & 63;
    unsigned char* ws = F.ws;
    const bf16* OG = (const bf16*)((const unsigned char*)F.out + DO_OG); const float* LSE = (const float*)((const unsigned char*)F.out + DO_LSE);
    bf16* Y = (bf16*)(ws + WS_Y) + (size_t)ch * TC * Y_W;
    const int lane = lane_, hd = lane >> 3;
    const int gw = cu * NWAVES + F.wave, NGW = ncu * NWAVES;
    for (int row0 = gw; row0 < TC; row0 += 4 * NGW) {
        float lg[4][3]; v4u og[4][3];
#pragma unroll
        for (int r = 0; r < 4; ++r) { const int row = row0 + r * NGW < TC ? row0 + r * NGW : row0;
#pragma unroll
            for (int g = 0; g < 3; ++g) { lg[r][g] = LSE[((size_t)g * TC + row) * 8 + hd]; og[r][g] = *(const GAS v4u*)(OG + ((size_t)g * TC + row) * 512 + lane * 8); } }
#pragma unroll
        for (int r = 0; r < 4; ++r) { const int row = row0 + r * NGW; if (row >= TC) continue;
            const float mx = fmaxf(fmaxf(lg[r][0], lg[r][1]), lg[r][2]);
            float e[3]; e[0] = __builtin_amdgcn_exp2f(lg[r][0] - mx); e[1] = __builtin_amdgcn_exp2f(lg[r][1] - mx); e[2] = __builtin_amdgcn_exp2f(lg[r][2] - mx);
            const float inv = 1.0f / (e[0] + e[1] + e[2]);
            float acc[8];
#pragma unroll
            for (int i = 0; i < 8; ++i) acc[i] = 0.f;
#pragma unroll
            for (int g = 0; g < 3; ++g) { const float wg = e[g] * inv; const v4u o_ = og[r][g];
                acc[0] += wg * bflo(o_.x); acc[1] += wg * bfhi(o_.x); acc[2] += wg * bflo(o_.y); acc[3] += wg * bfhi(o_.y);
                acc[4] += wg * bflo(o_.z); acc[5] += wg * bfhi(o_.z); acc[6] += wg * bflo(o_.w); acc[7] += wg * bfhi(o_.w); }
            v4u o; o.x = cvtpk(acc[0], acc[1]); o.y = cvtpk(acc[2], acc[3]); o.z = cvtpk(acc[4], acc[5]); o.w = cvtpk(acc[6], acc[7]);
            *(GAS v4u*)(Y + (size_t)row * Y_W + lane * 8) = o; }
    }
}


struct EpiMerge {
    static constexpr bool PERM = true; static constexpr int HOOK_T = 8;
    const bf16* Gt; bf16* MG;
    __device__ __forceinline__ void hook(f32x4 (&acc)[2][2][4][2], const pg9::Unit& u, int wr, int wc, int fr, int fq) const {
        asm volatile("" : "+v"(fr), "+v"(fq));
        const bf16* gr = Gt + (size_t)(u.pm * 256 + wr * 64 + fr) * G_W + u.pn * 256 + wc * 32 + 8 * fq;
        v4u rv[8][2];
#pragma unroll
        for (int rg = 0; rg < 8; ++rg)
#pragma unroll
            for (int bj = 0; bj < 2; ++bj) rv[rg][bj] = *(const GAS v4u*)(gr + (size_t)((rg >> 2) * 128 + (rg & 3) * 16) * G_W + bj * 128);
#pragma unroll
        for (int rg = 0; rg < 8; ++rg)
#pragma unroll
            for (int bj = 0; bj < 2; ++bj) { const v4u a = rv[rg][bj];
                const f32x4 r0 = {bflo(a.x), bfhi(a.x), bflo(a.y), bfhi(a.y)}, r1 = {bflo(a.z), bfhi(a.z), bflo(a.w), bfhi(a.w)};
                acc[rg >> 2][bj][rg & 3][0] = acc[rg >> 2][bj][rg & 3][0] * r0; acc[rg >> 2][bj][rg & 3][1] = acc[rg >> 2][bj][rg & 3][1] * r1; }
    }
    __device__ __forceinline__ void operator()(const f32x4 (&acc)[2][2][4][2], const pg9::Unit& u, int wr, int wc, int fr, int fq) const {
        asm volatile("" : "+v"(fr), "+v"(fq));
        const bf16* gr = Gt + (size_t)(u.pm * 256 + wr * 64 + fr) * G_W + 1024 + u.pn * 256 + wc * 32 + 8 * fq;
        bf16* mr = MG + (size_t)(u.pm * 256 + wr * 64 + fr) * D + u.pn * 256 + wc * 32 + 8 * fq;
        v4u gb[8][2];
#pragma unroll
        for (int rg = 0; rg < 8; ++rg)
#pragma unroll
            for (int bj = 0; bj < 2; ++bj) gb[rg][bj] = *(const GAS v4u*)(gr + (size_t)((rg >> 2) * 128 + (rg & 3) * 16) * G_W + bj * 128);
#pragma unroll
        for (int rg = 0; rg < 8; ++rg)
#pragma unroll
            for (int bj = 0; bj < 2; ++bj) { const v4u b = gb[rg][bj];
                const f32x4 v0 = acc[rg >> 2][bj][rg & 3][0], v1 = acc[rg >> 2][bj][rg & 3][1];
                v4u w; w.x = cvtpk(v0[0] * bflo(b.x), v0[1] * bfhi(b.x)); w.y = cvtpk(v0[2] * bflo(b.y), v0[3] * bfhi(b.y));
                w.z = cvtpk(v1[0] * bflo(b.z), v1[1] * bfhi(b.z)); w.w = cvtpk(v1[2] * bflo(b.w), v1[3] * bfhi(b.w));
                *(GAS v4u*)(mr + (size_t)((rg >> 2) * 128 + (rg & 3) * 16) * D + bj * 128) = w; }
    }
};
__device__ __forceinline__ void p3_merge(Frame& F) {
    unsigned char* ws = F.ws;
    pg9::DenseOrder S; S.init(T, D, F.G, (int)blockIdx.x);
    EpiMerge E{(const bf16*)(ws + WS_G), (bf16*)(ws + WS_MG)};
    pg9::DenseA ao{(unsigned)(Y_W * 2)}; pg9::DenseB bb{(const char*)(ws + WS_WAB), (size_t)256 * Y_W * 2};
    pg9::gemm_phase<2>(F.lds, (const char*)(ws + WS_Y), Y_W, S, E, ao, bb);
}
struct EpiOut {
    static constexpr bool PERM = true; static constexpr int HOOK_T = -1;
    bf16* DELTA;
    __device__ __forceinline__ void hook(f32x4 (&)[2][2][4][2], const pg9::Unit&, int, int, int, int) const {}
    __device__ __forceinline__ void operator()(const f32x4 (&acc)[2][2][4][2], const pg9::Unit& u, int wr, int wc, int fr, int fq) const {
        asm volatile("" : "+v"(fr), "+v"(fq));
        bf16* orow = DELTA + (size_t)(u.pm * 256 + wr * 64 + fr) * D + u.pn * 256 + wc * 32 + 8 * fq;
#pragma unroll
        for (int ai = 0; ai < 2; ++ai)
#pragma unroll
            for (int m = 0; m < 4; ++m)
#pragma unroll
                for (int bj = 0; bj < 2; ++bj) { const f32x4 o0 = acc[ai][bj][m][0], o1 = acc[ai][bj][m][1];
                    v4u w; w.x = cvtpk(o0[0], o0[1]); w.y = cvtpk(o0[2], o0[3]); w.z = cvtpk(o1[0], o1[1]); w.w = cvtpk(o1[2], o1[3]); *(GAS v4u*)(orow + (size_t)(ai * 128 + m * 16) * D + bj * 128) = w; }
    }
};
__device__ __forceinline__ void p4_outproj(Frame& F) {
    unsigned char* ws = F.ws;
    pg9::DenseOrder S; S.init(T, D, F.G, (int)blockIdx.x);
    EpiOut E{(bf16*)((unsigned char*)F.out + DO_DELTA)};
    pg9::DenseA ao{(unsigned)(D * 2)}; pg9::DenseB bb{(const char*)(ws + WS_WO), (size_t)256 * D * 2};
    pg9::gemm_phase<2>(F.lds, (const char*)(ws + WS_MG), D, S, E, ao, bb);
}

__device__ __forceinline__ void p5_route(Frame& F) {
    int tid_ = threadIdx.x; asm volatile("" : "+v"(tid_)); const int lane = tid_ & 63;
    unsigned char* ws = F.ws;
    const float* X = F.in[I_X]; const bf16* DELTA = (const bf16*)((const unsigned char*)F.out + DO_DELTA);
    bf16* X1B = (bf16*)(ws + WS_X1B); unsigned char* X1F8 = ws + WS_X1F8;
    unsigned* cnt = (unsigned*)(ws + WS_CTL) + CW_CNT;
    int* tokof = (int*)(ws + WS_TOKOF); float2* wtof = (float2*)(ws + WS_WTOF); int4* tpos = (int4*)(ws + WS_TPOS);
    const v4u* WRF = (const v4u*)(ws + WS_WRF);
    LAS v4u* wl = (LAS v4u*)F.lds;
    LAS float* sl = (LAS float*)(F.lds + 98304 + F.wave * 4096);
    const int i = lane & 15, q = lane >> 4;
    LAS unsigned* hist = (LAS unsigned*)(F.lds + LDS_MISC + 2048);
    for (int wt = F.vcu; wt < T / 128; wt += F.G) {
        const int tile = wt * NWAVES + F.wave;
        if (tid_ < 32) hist[tid_] = 0u;
        const size_t roff = (size_t)(tile * 16 + i) * D + 8 * q;
        const float* xr = X + roff; const bf16* dr = DELTA + roff;
        f32x4 a0 = {0.f, 0.f, 0.f, 0.f}, a1 = a0, a2 = a0; float ss = 0.f;
        f32x4 va[8][2]; v4u vd[8];
#pragma unroll
        for (int j = 0; j < 8; ++j) { va[j][0] = *(const GAS f32x4*)(xr + 32 * j); va[j][1] = *(const GAS f32x4*)(xr + 32 * j + 4); vd[j] = *(const GAS v4u*)(dr + 32 * j); }
#pragma unroll 1
        for (int half = 0; half < 2; ++half) {
            __syncthreads();
            { v4u t[12];
#pragma unroll
              for (int k = 0; k < 12; ++k) t[k] = WRF[half * 6144 + k * 512 + tid_];
#pragma unroll
              for (int k = 0; k < 12; ++k) wl[k * 512 + tid_] = t[k]; }
            __syncthreads();
#pragma unroll 1
            for (int sb = 0; sb < 2; ++sb) {
#pragma unroll
                for (int j = 0; j < 8; ++j) {
                    const int ksl = sb * 8 + j, ks = half * 16 + ksl;
                    const v4u dd = vd[j];
                    const f32x4 v0 = va[j][0] + (f32x4){bflo(dd.x), bfhi(dd.x), bflo(dd.y), bfhi(dd.y)}, v1 = va[j][1] + (f32x4){bflo(dd.z), bfhi(dd.z), bflo(dd.w), bfhi(dd.w)};
                    if (ks + 8 < 32) { va[j][0] = *(const GAS f32x4*)(xr + 32 * (ks + 8)); va[j][1] = *(const GAS f32x4*)(xr + 32 * (ks + 8) + 4); vd[j] = *(const GAS v4u*)(dr + 32 * (ks + 8)); }
                    ss += ((v0[0] * v0[0] + v0[1] * v0[1]) + (v0[2] * v0[2] + v0[3] * v0[3])) + ((v1[0] * v1[0] + v1[1] * v1[1]) + (v1[2] * v1[2] + v1[3] * v1[3]));
                    v4u hu; hu.x = cvtpk(v0[0], v0[1]); hu.y = cvtpk(v0[2], v0[3]); hu.z = cvtpk(v1[0], v1[1]); hu.w = cvtpk(v1[2], v1[3]);
                    v4u lu; lu.x = cvtpk(v0[0] - bflo(hu.x), v0[1] - bfhi(hu.x)); lu.y = cvtpk(v0[2] - bflo(hu.y), v0[3] - bfhi(hu.y)); lu.z = cvtpk(v1[0] - bflo(hu.z), v1[1] - bfhi(hu.z)); lu.w = cvtpk(v1[2] - bflo(hu.w), v1[3] - bfhi(hu.w));
                    *(GAS v4u*)(X1B + roff + 32 * ks) = hu;
                    if (P6_FP8) { v2u w8; w8.x = pk4_fp8(v0[0], v0[1], v0[2], v0[3]); w8.y = pk4_fp8(v1[0], v1[1], v1[2], v1[3]); *(GAS v2u*)(X1F8 + roff + 32 * ks) = w8; }
                    const bf16x8 ah = __builtin_bit_cast(bf16x8, hu), al = __builtin_bit_cast(bf16x8, lu);
#pragma unroll
                    for (int nb = 0; nb < 3; ++nb) {
                        const bf16x8 bh = __builtin_bit_cast(bf16x8, wl[((ksl * 3 + nb) * 2 + 0) * 64 + lane]), bl = __builtin_bit_cast(bf16x8, wl[((ksl * 3 + nb) * 2 + 1) * 64 + lane]);
                        f32x4 acc = nb == 0 ? a0 : (nb == 1 ? a1 : a2);
                        acc = __builtin_amdgcn_mfma_f32_16x16x32_bf16(ah, bh, acc, 0, 0, 0); acc = __builtin_amdgcn_mfma_f32_16x16x32_bf16(ah, bl, acc, 0, 0, 0); acc = __builtin_amdgcn_mfma_f32_16x16x32_bf16(al, bh, acc, 0, 0, 0);
                        if (nb == 0) a0 = acc; else if (nb == 1) a1 = acc; else a2 = acc;
                    }
                }
            }
        }
        ss += __shfl_xor(ss, 16); ss += __shfl_xor(ss, 32);
#pragma unroll
        for (int r = 0; r < 4; ++r) { sl[(4 * q + r) * 48 + i] = a0[r]; sl[(4 * q + r) * 48 + 16 + i] = a1[r]; sl[(4 * q + r) * 48 + 32 + i] = a2[r]; }
        LDS_WAIT(); asm volatile("" ::: "memory");
        int e0 = 0, e1 = 0, lp0 = 0, lp1 = 0; float w1 = 0.f, w2 = 0.f, rstd = 0.f;
        __syncthreads();
        if (lane < 16) {
            rstd = 1.0f / sqrtf(ss * (1.f / D) + RMS_EPS);
            float lg[36];
#pragma unroll
            for (int o = 0; o < 36; ++o) lg[o] = sl[lane * 48 + o] * rstd + (o < 4 ? F.in[I_BRG][o] : F.in[I_BRE][o - 4]);
            int gsel = 0; float gmax = lg[0];
#pragma unroll
            for (int k = 1; k < 4; ++k) if (lg[k] > gmax) { gmax = lg[k]; gsel = k; }
            float gden = 0.f;
#pragma unroll
            for (int k = 0; k < 4; ++k) gden += __expf(lg[k] - gmax);
            const float pg = 1.0f / gden;
            float le[8];
#pragma unroll
            for (int j = 0; j < 8; ++j) { le[j] = lg[4 + j];
#pragma unroll
                for (int gi = 1; gi < 4; ++gi) le[j] = (gsel == gi) ? lg[4 + gi * 8 + j] : le[j]; }
            int i1 = 0; float m1 = le[0];
#pragma unroll
            for (int j = 1; j < 8; ++j) if (le[j] > m1) { m1 = le[j]; i1 = j; }
            int i2 = -1; float m2 = -INFINITY;
#pragma unroll
            for (int j = 0; j < 8; ++j) if (j != i1 && le[j] > m2) { m2 = le[j]; i2 = j; }
            const float e2 = __expf(m2 - m1);
            w1 = pg / (1.0f + e2); w2 = pg * e2 / (1.0f + e2);
            e0 = gsel * 8 + i1; e1 = gsel * 8 + i2;
            lp0 = (int)__hip_atomic_fetch_add(&hist[e0], 1u, __ATOMIC_RELAXED, __HIP_MEMORY_SCOPE_WORKGROUP);
            lp1 = (int)__hip_atomic_fetch_add(&hist[e1], 1u, __ATOMIC_RELAXED, __HIP_MEMORY_SCOPE_WORKGROUP);
        }
        __syncthreads();
        if (tid_ < 32) { const unsigned n = hist[tid_]; hist[32 + tid_] = n ? atomicAdd(&cnt[64 * tid_], n) : 0u; }
        __syncthreads();
        if (lane < 16) {
            const int row = tile * 16 + lane;
            const int p0 = (int)hist[32 + e0] + lp0, p1 = (int)hist[32 + e1] + lp1;
            tokof[(size_t)e0 * T + p0] = row; wtof[(size_t)e0 * T + p0] = make_float2(w1, rstd);
            tokof[(size_t)e1 * T + p1] = row; wtof[(size_t)e1 * T + p1] = make_float2(w2, rstd);
            tpos[row] = make_int4(e0, p0, e1, p1);
        }
        __syncthreads();
    }
}

__device__ __forceinline__ void expert_tiles(Frame& F, LAS int* tb, LAS int* cn) {
    int tid_ = threadIdx.x; asm volatile("" : "+v"(tid_)); const int lane_ = tid_ & 63;
    if (tid_ == 0) {
        const unsigned* cnt = (const unsigned*)(F.ws + WS_CTL) + CW_CNT;
        int acc = 0;
        for (int e = 0; e < NE; ++e) { const int c = (int)__hip_atomic_load(cnt + 64 * e, __ATOMIC_RELAXED, __HIP_MEMORY_SCOPE_AGENT); cn[e] = c; tb[e] = acc; acc += (c + 255) >> 8; }
        tb[NE] = acc;
    }
    __syncthreads();
}

struct MoeOrder { const LAS int* tb; int ncol, G, c;
    __device__ bool next(int i, pg9::Unit& u) const {
        const int L = i * G + c; if (L >= tb[NE] * ncol) return false;
        const int rt = L / ncol; int e = 0;
        for (int k = 1; k < NE; ++k) if (tb[k] <= rt) e = k;
        u.pm = rt; u.pn = L % ncol; u.e = e; return true; } };
struct GatherA { static constexpr bool GATHER = true; unsigned rowbytes; const int* tokof; const LAS int* tb; const LAS int* cn;
    __device__ __forceinline__ unsigned operator()(const pg9::Unit& u, int row) const {
        const int p = (u.pm - tb[u.e]) * 256 + row; const int tok = tokof[(size_t)u.e * T + (p < cn[u.e] ? p : 0)]; return (unsigned)tok * rowbytes; } };
struct ExpertB { const char* W; size_t ebytes, tilebytes; __device__ __forceinline__ const char* operator()(const pg9::Unit& u) const { return W + (size_t)u.e * ebytes + (size_t)u.pn * tilebytes; } };
struct EpiGateUp {
    static constexpr bool PERM = true; static constexpr int HOOK_T = -1;
    const float2* wtof; bf16* HACT; const LAS int* tb; const LAS int* cn; float ascale;
    __device__ __forceinline__ void hook(f32x4 (&)[2][2][4][2], const pg9::Unit&, int, int, int, int) const {}
    __device__ __forceinline__ void operator()(const f32x4 (&acc)[2][2][4][2], const pg9::Unit& u, int wr, int wc, int fr, int fq) const {
        asm volatile("" : "+v"(fr), "+v"(fq));
        const int r0 = wr * 64 + fr, p0 = (u.pm - tb[u.e]) * 256, ce = cn[u.e];
        const float2* wp = wtof + (size_t)u.e * T;
#pragma unroll
        for (int ai = 0; ai < 2; ++ai) {
            float2 wv[4];
#pragma unroll
            for (int m = 0; m < 4; ++m) { const int p = p0 + r0 + ai * 128 + m * 16; wv[m] = p < ce ? wp[p] : make_float2(0.f, 0.f); }
#pragma unroll
            for (int m = 0; m < 4; ++m) { const int r = r0 + ai * 128 + m * 16;
                const float w = wv[m].x, rs = wv[m].y * ascale;
                bf16* orow = HACT + (size_t)(u.pm * 256 + r) * DE + u.pn * 128 + wc * 16 + 4 * fq; unsigned char* orow8 = (unsigned char*)HACT + (size_t)(u.pm * 256 + r) * DE + u.pn * 128 + wc * 16 + 4 * fq;
#pragma unroll
                for (int bj = 0; bj < 2; ++bj) { const f32x4 g = acc[ai][bj][m][0], uu = acc[ai][bj][m][1]; f32x4 hv;
#pragma unroll
                    for (int e = 0; e < 4; ++e) { const float gg = g[e] * rs; hv[e] = gg / (1.0f + __expf(-gg)) * (uu[e] * rs) * w; }
                    if (P6_FP8) *(GAS unsigned*)(orow8 + bj * 64) = pk4_fp8(hv[0] * H8_SCALE, hv[1] * H8_SCALE, hv[2] * H8_SCALE, hv[3] * H8_SCALE);
                    else { v2u o; o.x = cvtpk(hv[0], hv[1]); o.y = cvtpk(hv[2], hv[3]); *(GAS v2u*)(orow + bj * 64) = o; } } }
        }
    }
};
__device__ __forceinline__ void p6a_gateup(Frame& F) {
    unsigned char* ws = F.ws;
    LAS int* tb = (LAS int*)(F.lds + LDS_MISC + 1024); LAS int* cn = tb + 64;
    expert_tiles(F, tb, cn);
    MoeOrder S{tb, 2, F.G, F.vcu};
    constexpr int ES = P6_FP8 ? 1 : 2;
    GatherA ao{(unsigned)(D * ES), (const int*)(ws + WS_TOKOF), tb, cn}; ExpertB bb{(const char*)(ws + WS_WGU), (size_t)512 * D * ES, (size_t)256 * D * ES};
    EpiGateUp E{(const float2*)(ws + WS_WTOF), (bf16*)(ws + WS_HACT), tb, cn, P6_FP8 ? 1.0f / WG8_SCALE : 1.0f};
    pg9::gemm_phase<ES>(F.lds, (const char*)(ws + (P6_FP8 ? WS_X1F8 : WS_X1B)), D, S, E, ao, bb);
}
struct EpiDown {
    static constexpr bool PERM = true; static constexpr int HOOK_T = -1;
    bf16* YS; float ascale;
    __device__ __forceinline__ void hook(f32x4 (&)[2][2][4][2], const pg9::Unit&, int, int, int, int) const {}
    __device__ __forceinline__ void operator()(const f32x4 (&acc)[2][2][4][2], const pg9::Unit& u, int wr, int wc, int fr, int fq) const {
        asm volatile("" : "+v"(fr), "+v"(fq));
#pragma unroll
        for (int ai = 0; ai < 2; ++ai)
#pragma unroll
            for (int m = 0; m < 4; ++m) { bf16* orow = YS + (size_t)(u.pm * 256 + wr * 64 + fr + ai * 128 + m * 16) * D + u.pn * 256 + wc * 32 + 8 * fq;
#pragma unroll
                for (int bj = 0; bj < 2; ++bj) { const f32x4 v0 = acc[ai][bj][m][0] * ascale, v1 = acc[ai][bj][m][1] * ascale;
                    v4u w; w.x = cvtpk(v0[0], v0[1]); w.y = cvtpk(v0[2], v0[3]); w.z = cvtpk(v1[0], v1[1]); w.w = cvtpk(v1[2], v1[3]); *(GAS v4u*)(orow + bj * 128) = w; } }
    }
};
__device__ __forceinline__ void p6b_down(Frame& F) {
    unsigned char* ws = F.ws;
    LAS int* tb = (LAS int*)(F.lds + LDS_MISC + 1024); LAS int* cn = tb + 64;
    expert_tiles(F, tb, cn);
    MoeOrder S{tb, 4, F.G, F.vcu};
    constexpr int ES = P6_FP8 ? 1 : 2;
    pg9::DenseA ao{(unsigned)(DE * ES)}; ExpertB bb{(const char*)(ws + WS_WD), (size_t)D * DE * ES, (size_t)256 * DE * ES};
    EpiDown E{(bf16*)(ws + WS_YS), P6_FP8 ? 1.0f / (WD8_SCALE * H8_SCALE) : 1.0f};
    pg9::gemm_phase<ES>(F.lds, (const char*)(ws + WS_HACT), DE, S, E, ao, bb);
}
__device__ __forceinline__ void p7_final(Frame& F) {
    int tid_ = threadIdx.x; asm volatile("" : "+v"(tid_)); const int lane_ = tid_ & 63;
    unsigned char* ws = F.ws;
    LAS int* tb = (LAS int*)(F.lds + LDS_MISC + 1024); LAS int* cn = tb + 64;
    expert_tiles(F, tb, cn);
    const bf16* YS = (const bf16*)(ws + WS_YS); const int4* tpos = (const int4*)(ws + WS_TPOS);
    float* X1 = F.out; const bf16* X1B = (const bf16*)(ws + WS_X1B);
    const int lane = lane_;
    const int gw = F.vcu * NWAVES + F.wave, NGW = F.G * NWAVES;
    const GAS f32x4* gr = (const GAS f32x4*)F.in[I_GFIN] + lane;
    for (int row = gw; row < T; row += NGW) {
        const int4 tp = tpos[row];
        const size_t s0 = (size_t)tb[tp.x] * 256 + tp.y, s1 = (size_t)tb[tp.z] * 256 + tp.w;
        GAS f32x4* xr = (GAS f32x4*)(X1 + (size_t)row * D) + lane; const GAS v2u* xb = (const GAS v2u*)(X1B + (size_t)row * D) + lane;
        const GAS v2u* y0 = (const GAS v2u*)(YS + s0 * D) + lane; const GAS v2u* y1 = (const GAS v2u*)(YS + s1 * D) + lane;
        f32x4 v[4]; float s = 0.f;
#pragma unroll
        for (int j = 0; j < 4; ++j) { const v2u xx = xb[64 * j]; v[j] = (f32x4){bflo(xx.x), bfhi(xx.x), bflo(xx.y), bfhi(xx.y)}; const v2u a = y0[64 * j], b = y1[64 * j];
            v[j].x += bflo(a.x) + bflo(b.x); v[j].y += bfhi(a.x) + bfhi(b.x); v[j].z += bflo(a.y) + bflo(b.y); v[j].w += bfhi(a.y) + bfhi(b.y);
            s += (v[j].x * v[j].x + v[j].y * v[j].y) + (v[j].z * v[j].z + v[j].w * v[j].w); }
        const float rstd = 1.0f / sqrtf(wave_sum(s) * (1.f / D) + RMS_EPS);
#pragma unroll
        for (int j = 0; j < 4; ++j) { const f32x4 gg = gr[64 * j]; f32x4 o; o.x = v[j].x * rstd * gg.x; o.y = v[j].y * rstd * gg.y; o.z = v[j].z * rstd * gg.z; o.w = v[j].w * rstd * gg.w; xr[64 * j] = o; }
    }
}

constexpr int NPHASE = 2 * NCH + 8;
__global__ void __launch_bounds__(NTHR, 2) fwd_kernel(KArgs args) {
    extern __shared__ __attribute__((aligned(16))) unsigned char lds_raw[];
    Frame F;
    F.lds = (LAS unsigned char*)lds_raw;
    F.tid = threadIdx.x; F.lane = F.tid & 63; F.wave = __builtin_amdgcn_readfirstlane(F.tid >> 6);
    F.G = gridDim.x; { const int bx = blockIdx.x; F.vcu = (F.G % 8 == 0) ? (bx % 8) * (F.G / 8) + bx / 8 : bx; }
#pragma unroll
    for (int i = 0; i < 17; ++i) F.in[i] = args.in[i];
    F.out = args.out; F.ws = args.ws;
    volatile LAS unsigned* MISC = (volatile LAS unsigned*)(F.lds + LDS_MISC);
    if (F.tid < 64) MISC[F.tid] = 0u;
    __syncthreads();
    XcdBarrier bar = xcd_barrier_post((unsigned*)(F.ws + WS_CTL) + CW_BAR + args.li * XCD_BAR_WORDS, MISC + 8);
#define IN(k) (args.ph_lo <= (k) && (k) < args.ph_hi)
#ifdef PROBE_MASK
    unsigned long long pr_acc = 0, pr_t0 = 0; const bool pr_me = (blockIdx.x == 0 && threadIdx.x == 0);
#define PR_BEGIN(k) do { if (pr_me && ((PROBE_MASK >> (k)) & 1ull)) pr_t0 = __builtin_amdgcn_s_memrealtime(); } while (0)
#define PR_END(k) do { if (pr_me && ((PROBE_MASK >> (k)) & 1ull)) pr_acc += __builtin_amdgcn_s_memrealtime() - pr_t0; } while (0)
#else
#define PR_BEGIN(k) do {} while (0)
#define PR_END(k) do {} while (0)
#endif
#define SEAM(k) do { if (IN(k) && IN((k) + 1)) xcd_barrier(bar); PR_END(k); } while (0)
    PR_BEGIN(0); if (IN(0)) p0_prologue(F);
    SEAM(0);
#pragma unroll 1
    for (int ch = 0; ch < NCH; ++ch) {
        PR_BEGIN(1 + 2 * ch);
        if (IN(1 + 2 * ch)) {
            constexpr int NWG1 = (TC / 256) * (NIN / 256);
            const int nfull = NWG1 % F.G, bx = (int)blockIdx.x;
            if (ch > 0 && nfull == 0) p2_combine(F, ch - 1, F.vcu, F.G);
            p1_inproj(F, ch);
            if (ch > 0 && nfull != 0 && bx >= nfull) p2_combine(F, ch - 1, bx - nfull, F.G - nfull);
        }
        SEAM(1 + 2 * ch);
        PR_BEGIN(2 + 2 * ch); if (IN(2 + 2 * ch)) p2_attn(F, ch);
        SEAM(2 + 2 * ch);
    }
    PR_BEGIN(2 * NCH + 1); if (IN(2 * NCH + 1)) p2_combine(F, NCH - 1, F.vcu, F.G);
    SEAM(2 * NCH + 1);
    PR_BEGIN(2 * NCH + 2); if (IN(2 * NCH + 2)) p3_merge(F);
    SEAM(2 * NCH + 2);
    PR_BEGIN(2 * NCH + 3); if (IN(2 * NCH + 3)) p4_outproj(F);
    SEAM(2 * NCH + 3);
    PR_BEGIN(2 * NCH + 4); if (IN(2 * NCH + 4)) p5_route(F);
    SEAM(2 * NCH + 4);
    PR_BEGIN(2 * NCH + 5); if (IN(2 * NCH + 5)) p6a_gateup(F);
    SEAM(2 * NCH + 5);
    PR_BEGIN(2 * NCH + 6); if (IN(2 * NCH + 6)) p6b_down(F);
    SEAM(2 * NCH + 6);
    PR_BEGIN(2 * NCH + 7); if (IN(2 * NCH + 7)) p7_final(F);
    PR_END(2 * NCH + 7);
#ifdef PROBE_MASK
    if (pr_me) { const unsigned long long t1 = __builtin_amdgcn_s_memrealtime(); while (__builtin_amdgcn_s_memrealtime() - t1 < pr_acc) __builtin_amdgcn_s_sleep(4); }
#endif
#undef IN
#undef SEAM
}

#ifndef N_LAUNCHES
#define N_LAUNCHES 1
#endif
extern "C" void kernel_launch(void* const* d_in, const int* in_sizes, int n_in, void* d_out, int out_size, void* d_ws, size_t ws_size, hipStream_t stream) {
    static int grid = 0;
    if (grid == 0) {
        if (n_in != 17 || in_sizes[0] != T * D || out_size != T * D || ws_size < WS_END) { fprintf(stderr, "kernel_launch: unexpected shapes / workspace (%d inputs, ws %zu)\n", n_in, ws_size); grid = -1; return; }
        int dev = 0, cus = 0;
        if (hipGetDevice(&dev) != hipSuccess || hipDeviceGetAttribute(&cus, hipDeviceAttributeMultiprocessorCount, dev) != hipSuccess) { grid = -1; return; }
        if (hipFuncSetAttribute((const void*)fwd_kernel, hipFuncAttributeMaxDynamicSharedMemorySize, LDS_BYTES) != hipSuccess) { fprintf(stderr, "kernel_launch: hipFuncSetAttribute failed\n"); grid = -1; return; }
        int per_cu = 0;
        if (hipOccupancyMaxActiveBlocksPerMultiprocessor(&per_cu, (const void*)fwd_kernel, NTHR, LDS_BYTES) != hipSuccess || per_cu < 1) fprintf(stderr, "kernel_launch: occupancy query says %d\n", per_cu);
        (void)hipGetLastError();
        grid = cus;
    }
    if (grid < 0) return;
    (void)hipMemsetAsync((char*)d_ws + WS_CTL, 0, N_LAUNCHES == 1 ? (size_t)(CW_BAR + XCD_BAR_WORDS) * 4 : CTL_BYTES, stream);
    KArgs a{};
    for (int i = 0; i < 17; ++i) a.in[i] = (const float*)d_in[i];
    a.out = (float*)d_out; a.ws = (unsigned char*)d_ws;
    for (int li = 0; li < N_LAUNCHES; ++li) {
        a.ph_lo = (int)((long)NPHASE * li / N_LAUNCHES); a.ph_hi = (int)((long)NPHASE * (li + 1) / N_LAUNCHES); a.li = li;
        hipLaunchKernelGGL(fwd_kernel, dim3(grid), dim3(NTHR), LDS_BYTES, stream, a);
    }
}
```

```cpp
#include <hip/hip_runtime.h>
#include <cstdint>
#include <cstdio>

#define GAS __attribute__((address_space(1)))
#define LAS __attribute__((address_space(3)))
typedef unsigned short bf16;
typedef short bf16x8 __attribute__((ext_vector_type(8)));
typedef float f32x4 __attribute__((ext_vector_type(4)));
typedef unsigned v4u __attribute__((ext_vector_type(4)));
typedef unsigned v2u __attribute__((ext_vector_type(2)));
typedef GAS unsigned gu32;

constexpr int T = 32768, D = 1024, SEQ = 4096, NIN = 7936;
constexpr int A_W = 4608, B_W = 1280, G_W = 2048, Y_W = 1536;
constexpr int NE = 32, DE = 256;
constexpr int NCH = 4, TC = T / NCH;
constexpr float QSCALE = 0.125f * 1.4426950408889634f;
constexpr float LOG2E = 1.4426950408889634f;
constexpr float RMS_EPS = 1e-6f;
#ifndef P1_FP8
#define P1_FP8 1
#endif
constexpr float W8_SCALE = P1_FP8 ? 64.0f : 0.0f, W8_INV = P1_FP8 ? 1.0f / 64.0f : 1.0f;
#ifndef P6_FP8
#define P6_FP8 1
#endif
#ifndef P34_FP8
#define P34_FP8 1
#endif
constexpr float Y8_SCALE = 16.0f, W34_SCALE = 64.0f, MG8_SCALE = 32.0f;
constexpr float WG8_SCALE = P6_FP8 ? 64.0f : 0.0f, WD8_SCALE = P6_FP8 ? 32.0f : 0.0f, H8_SCALE = 32.0f;
constexpr int NWAVES = 8, NTHR = 512;

constexpr size_t MiB = 1u << 20;
constexpr size_t WS_CTL = 0, CTL_BYTES = 1 * MiB;
constexpr size_t WS_INVF = 1 * MiB;
constexpr size_t WS_WRF = 2 * MiB;
constexpr size_t WS_TOKOF = 3 * MiB;
constexpr size_t WS_WTOF = 7 * MiB;
constexpr size_t WS_TPOS = 15 * MiB;
constexpr size_t WS_WIN = 16 * MiB;
constexpr size_t WS_WAB = 32 * MiB;
constexpr size_t WS_WO = 35 * MiB;
constexpr size_t WS_WGU = 37 * MiB;
constexpr size_t WS_WD = 69 * MiB;
constexpr size_t WS_G = 86 * MiB;
constexpr size_t WS_Y = 214 * MiB;
constexpr size_t WS_ZA = 310 * MiB;
constexpr size_t WS_ZB = 454 * MiB;
constexpr size_t WS_END = 494 * MiB;
constexpr size_t WS_MG = WS_ZA;
constexpr size_t WS_X1B = WS_ZA + 64 * MiB;
constexpr size_t WS_X1F8 = WS_Y + 64 * MiB;
constexpr size_t WS_HACT = WS_G;
constexpr size_t WS_YS = WS_G + 36 * MiB;
constexpr size_t DO_DELTA = 0;
constexpr size_t DO_HN = 0;
constexpr size_t DO_OG = 64 * MiB;
constexpr size_t DO_LSE = 112 * MiB;
constexpr int MAXSLOT = 2 * T + NE * 256;
static_assert(WS_ZA + (size_t)TC * A_W * 2 <= WS_ZB && WS_ZB + (size_t)TC * B_W * 2 <= WS_END && WS_Y + (size_t)T * Y_W * 2 <= WS_ZA && WS_G + (size_t)T * G_W * 2 <= WS_Y, "ws map");
static_assert(WS_MG + (size_t)T * D * 2 <= WS_END && WS_HACT + (size_t)MAXSLOT * DE * 2 <= WS_YS && WS_YS + (size_t)MAXSLOT * D * 2 <= WS_ZA && WS_X1B >= WS_MG + (size_t)T * D * 2 && WS_X1B + (size_t)T * D * 2 <= WS_ZB, "ws map");
static_assert(DO_OG + (size_t)3 * TC * 512 * 2 <= DO_LSE && DO_LSE + (size_t)3 * TC * 8 * 4 <= (size_t)T * D * 4 && DO_HN + (size_t)T * D * 2 <= DO_OG, "d_out scratch map");
constexpr int CW_CNT = 1024;
constexpr int CW_BAR = 4096;
constexpr int LDS_BYTES = 147456;
constexpr int LDS_MISC = 131072;

__device__ __forceinline__ unsigned f2bf(float f) { unsigned u = __builtin_bit_cast(unsigned, f); return (u + 0x7fffu + ((u >> 16) & 1u)) >> 16; }
__device__ __forceinline__ unsigned pk4_fp8(float a, float b, float c, float d) {
    a = __builtin_amdgcn_fmed3f(a, -448.f, 448.f); b = __builtin_amdgcn_fmed3f(b, -448.f, 448.f); c = __builtin_amdgcn_fmed3f(c, -448.f, 448.f); d = __builtin_amdgcn_fmed3f(d, -448.f, 448.f);
    int w = 0; w = __builtin_amdgcn_cvt_pk_fp8_f32(a, b, w, false); w = __builtin_amdgcn_cvt_pk_fp8_f32(c, d, w, true); return (unsigned)w; }
__device__ __forceinline__ unsigned pk2(float lo, float hi) { return f2bf(lo) | (f2bf(hi) << 16); }
__device__ __forceinline__ float bf2f(unsigned b) { return __builtin_bit_cast(float, b << 16); }
__device__ __forceinline__ float bflo(unsigned u) { return __builtin_bit_cast(float, u << 16); }
__device__ __forceinline__ float bfhi(unsigned u) { return __builtin_bit_cast(float, u & 0xffff0000u); }
__device__ __forceinline__ float wave_sum(float v) {
#pragma unroll
    for (int o = 1; o < 64; o <<= 1) v += __shfl_xor(v, o);
    return v;
}
__device__ __forceinline__ float wave_max(float v) {
#pragma unroll
    for (int o = 1; o < 64; o <<= 1) v = fmaxf(v, __shfl_xor(v, o));
    return v;
}
typedef float f32x2_t __attribute__((ext_vector_type(2)));
typedef __bf16 bf16x2_t __attribute__((ext_vector_type(2)));
__device__ __forceinline__ unsigned cvtpk(float lo, float hi) { f32x2_t v = {lo, hi}; bf16x2_t b = __builtin_convertvector(v, bf16x2_t); return __builtin_bit_cast(unsigned, b); }
#ifndef WT_STORES
#define WT_STORES 0
#endif
__device__ __forceinline__ __amdgpu_buffer_rsrc_t wt_rsrc(unsigned char* base) { return __builtin_amdgcn_make_buffer_rsrc(base, 0, 0x7ffffffc, 0x00020000); }
__device__ __forceinline__ void st16(__amdgpu_buffer_rsrc_t r, unsigned char* base, void* p, v4u v) { if (WT_STORES) __builtin_amdgcn_raw_buffer_store_b128(v, r, (unsigned)((unsigned char*)p - base), 0, 16); else *(GAS v4u*)p = v; }
__device__ __forceinline__ void st8(__amdgpu_buffer_rsrc_t r, unsigned char* base, void* p, v2u v) { if (WT_STORES) __builtin_amdgcn_raw_buffer_store_b64(v, r, (unsigned)((unsigned char*)p - base), 0, 16); else *(GAS v2u*)p = v; }
#define LDS_WAIT() asm volatile("s_waitcnt lgkmcnt(0)" ::: "memory")
#define VM_WAIT() asm volatile("s_waitcnt vmcnt(0)" ::: "memory")

#define XB_TMO      128
#define XB_XCNT(j)  (256  + 64 * (j))
#define XB_XSUB(j)  (1280 + 64 * (j))
#define XB_XGEN(j)  (2304 + 64 * (j))
#define XB_TOP      3328
#define XB_TOPGEN   3392
#define XCD_BAR_WORDS 3456
#define XB_SPIN_CAP (1u << 18)
__device__ __forceinline__ unsigned xb_ld(unsigned* p)              { return __hip_atomic_load(p, __ATOMIC_RELAXED, __HIP_MEMORY_SCOPE_AGENT); }
__device__ __forceinline__ unsigned xb_add(unsigned* p, unsigned v) { return __hip_atomic_fetch_add(p, v, __ATOMIC_RELAXED, __HIP_MEMORY_SCOPE_AGENT); }
__device__ __forceinline__ unsigned xb_xcc_id() { return (unsigned)__builtin_amdgcn_s_getreg((3 << 11) | 20) & 0xFu; }
#define XB_SPIN(cond, bar) do { unsigned _sp = 0; while (cond) { __builtin_amdgcn_s_sleep(1); \
    if ((++_sp & 255u) == 0u) { if (xb_ld(&(bar)[XB_TMO])) break; if (_sp > XB_SPIN_CAP) { atomicAdd(&(bar)[XB_TMO], 1u); break; } } } } while (0)
struct XcdBarrier { unsigned* bar; unsigned x; volatile LAS unsigned* st; };
__device__ __forceinline__ XcdBarrier xcd_barrier_post(unsigned* bar, volatile LAS unsigned* st) {
    XcdBarrier b; b.bar = bar; b.x = xb_xcc_id(); b.st = st;
    if (threadIdx.x == 0) (void)xb_add(&bar[XB_XCNT(b.x)], 1u);
    return b;
}
__device__ __forceinline__ void xcd_barrier_complete(unsigned* bar, unsigned x, unsigned& nloc, unsigned& nx) {
    const unsigned G = gridDim.x * gridDim.y * gridDim.z;
    unsigned sum, cnt, mine, sp = 0u;
    for (;;) {
        sum = 0u; cnt = 0u; mine = 0u;
#pragma unroll
        for (unsigned j = 0; j < 16; ++j) { const unsigned c = xb_ld(&bar[XB_XCNT(j)]); sum += c; cnt += (c > 0u) ? 1u : 0u; mine = (j == x) ? c : mine; }
        if (sum == G) break;
        __builtin_amdgcn_s_sleep(1);
        if ((++sp & 255u) == 0u) { if (xb_ld(&bar[XB_TMO])) break; if (sp > XB_SPIN_CAP) { atomicAdd(&bar[XB_TMO], 1u); break; } }
    }
    nloc = mine > 0u ? mine : 1u; nx = cnt > 0u ? cnt : 1u;
}
__device__ __forceinline__ void xcd_barrier(const XcdBarrier& b) {
    asm volatile("s_waitcnt vmcnt(0)" ::: "memory");
    __syncthreads();
    if (threadIdx.x == 0) {
        unsigned* bar = b.bar;
        __builtin_amdgcn_s_waitcnt(0);
        unsigned nloc = b.st[0], nx = b.st[1];
        if (nloc == 0u) { xcd_barrier_complete(bar, b.x, nloc, nx); b.st[0] = nloc; b.st[1] = nx; }
        const unsigned old = xb_add(&bar[XB_XSUB(b.x)], 1u);
        const unsigned gen = old / nloc;
        if (old + 1u == (gen + 1u) * nloc) {
            __builtin_amdgcn_fence(__ATOMIC_RELEASE, "agent");
            asm volatile("s_waitcnt vmcnt(0)" ::: "memory");
            const unsigned og = xb_add(&bar[XB_TOP], 1u);
            const unsigned tg = og / nx;
            if (og + 1u == (tg + 1u) * nx) xb_add(&bar[XB_TOPGEN], 1u);
            else XB_SPIN(xb_ld(&bar[XB_TOPGEN]) == tg, bar);
            __builtin_amdgcn_fence(__ATOMIC_ACQUIRE, "agent");
            xb_add(&bar[XB_XGEN(b.x)], 1u);
            asm volatile("s_waitcnt vmcnt(0)" ::: "memory");
        } else {
            XB_SPIN(xb_ld(&bar[XB_XGEN(b.x)]) == gen, bar);
            __builtin_amdgcn_fence(__ATOMIC_ACQUIRE, "agent");
            asm volatile("s_waitcnt vmcnt(0)" ::: "memory");
        }
    }
    __syncthreads();
}

struct KArgs { const float* in[17]; float* out; unsigned char* ws; int ph_lo, ph_hi, li, pad; };
struct Frame {
    LAS unsigned char* lds;
    int tid, lane, wave, vcu, G;
    const float* in[17]; float* out; unsigned char* ws;
};
enum { I_X = 0, I_WIN, I_BIN, I_SINK, I_WPA, I_WPB, I_WOUT, I_GMIX, I_GFFN, I_WRG, I_BRG, I_WRE, I_BRE, I_WEG, I_WEU, I_WED, I_GFIN };

struct TrDesc { const float* W; int N; bf16* WT; int ldo, rowbase, koff, k0, n0; bool perm; const float* kscale; float f8scale; };
__device__ __forceinline__ void tr_load(const TrDesc& d, int lane, f32x4 (&tv)[8], float (&ks)[8]) {
    const float* src = d.W + (size_t)(d.k0 + (lane >> 3)) * d.N + d.n0 + 4 * (lane & 7);
#pragma unroll
    for (int i = 0; i < 8; ++i) tv[i] = *(const GAS f32x4*)(src + (size_t)(8 * i) * d.N);
#pragma unroll
    for (int i = 0; i < 8; ++i) ks[i] = d.kscale ? d.kscale[d.k0 + 8 * i + (lane >> 3)] : 1.0f;
}
__device__ __forceinline__ void tr_finish(const TrDesc& d, LAS float* scr, int lane, const f32x4 (&tv)[8], const float (&ks)[8]) {
#pragma unroll
    for (int i = 0; i < 8; ++i) { const int kk = 8 * i + (lane >> 3); LAS float* w = scr + kk * 33 + 4 * (lane & 7);
        w[0] = tv[i][0] * ks[i]; w[1] = tv[i][1] * ks[i]; w[2] = tv[i][2] * ks[i]; w[3] = tv[i][3] * ks[i]; }
    LDS_WAIT(); asm volatile("" ::: "memory");
    const int c = lane & 7;
#pragma unroll
    for (int j = 0; j < 4; ++j) { const int n = (lane >> 3) + 8 * j; const LAS float* s = scr + (8 * c) * 33 + n;
        const int rr = d.perm ? 8 * (n >> 2) + (n & 3) : n;
        if (d.f8scale != 0.f) { const float f = d.f8scale; v2u o8; o8.x = pk4_fp8(s[0 * 33] * f, s[1 * 33] * f, s[2 * 33] * f, s[3 * 33] * f); o8.y = pk4_fp8(s[4 * 33] * f, s[5 * 33] * f, s[6 * 33] * f, s[7 * 33] * f);
            *(GAS v2u*)((unsigned char*)d.WT + (size_t)(d.rowbase + rr) * d.ldo + d.koff + d.k0 + 8 * c) = o8; }
        else { v4u o; o.x = pk2(s[0 * 33], s[1 * 33]); o.y = pk2(s[2 * 33], s[3 * 33]); o.z = pk2(s[4 * 33], s[5 * 33]); o.w = pk2(s[6 * 33], s[7 * 33]);
            *(GAS v4u*)(d.WT + (size_t)(d.rowbase + rr) * d.ldo + d.koff + d.k0 + 8 * c) = o; } }
    LDS_WAIT(); asm volatile("" ::: "memory");
}
__device__ __forceinline__ void rms_row_to_bf16(const float* xrow, const float* g, bf16* orow, int lane) {
    const GAS f32x4* xr = (const GAS f32x4*)xrow + lane; const GAS f32x4* gr = (const GAS f32x4*)g + lane;
    f32x4 v[4]; float s = 0.f;
#pragma unroll
    for (int j = 0; j < 4; ++j) { v[j] = xr[64 * j]; s += (v[j].x * v[j].x + v[j].y * v[j].y) + (v[j].z * v[j].z + v[j].w * v[j].w); }
    const float rstd = 1.0f / sqrtf(wave_sum(s) * (1.f / D) + RMS_EPS);
    GAS v2u* o8 = (GAS v2u*)orow + lane;
#pragma unroll
    for (int j = 0; j < 4; ++j) { const f32x4 gg = gr[64 * j]; v2u w; w.x = pk2(v[j].x * rstd * gg.x, v[j].y * rstd * gg.y); w.y = pk2(v[j].z * rstd * gg.z, v[j].w * rstd * gg.w); o8[64 * j] = w; }
}
__device__ __forceinline__ void p0_prologue(Frame& F) {
    int tid_ = threadIdx.x; asm volatile("" : "+v"(tid_)); const int lane_ = tid_ & 63;
    LAS float* scr = (LAS float*)(F.lds + F.wave * 16384);
    const int gw = F.vcu * NWAVES + F.wave, NGW = F.G * NWAVES;
    unsigned char* ws = F.ws;
    constexpr int I_IN = 16 * 248, I_PA = 8 * 32, I_PB = 16 * 32, I_WO = 16 * 32, I_EG = 32 * 16 * 8, I_ED = 32 * 4 * 32;
    constexpr int NITEMS = I_IN + I_PA + I_PB + I_WO + 2 * I_EG + I_ED;
    auto decode = [&](int it, TrDesc& d) {
        int r = it; d.perm = false; d.kscale = nullptr; d.f8scale = 0.f; d.koff = 0;
        if (r < I_IN) { const int kb = r / 248, nb = r % 248, n0 = 32 * nb; const bool qk = (n0 < 3072) || (n0 >= A_W && n0 < A_W + 1152);
            const bool gt_ = n0 >= A_W + B_W; const int gc = n0 - (A_W + B_W);
            d.W = F.in[I_WIN]; d.N = NIN; d.WT = (bf16*)(ws + WS_WIN); d.ldo = 1024; d.rowbase = qk ? (n0 & ~63) + ((n0 >> 5) & 1) * 4 : (gt_ ? A_W + B_W + 2 * (gc % 1024) + 4 * (gc / 1024) : n0); d.k0 = 64 * kb; d.n0 = n0; d.perm = qk || gt_; d.f8scale = W8_SCALE; return; } r -= I_IN;
        if (r < I_PA) { const int kb = r / 32, nb = r % 32; d.W = F.in[I_WPA]; d.N = 1024; d.WT = (bf16*)(ws + WS_WAB); d.ldo = 1536; d.rowbase = 32 * nb; d.k0 = 64 * kb; d.n0 = 32 * nb; if (P34_FP8) d.f8scale = W34_SCALE; return; } r -= I_PA;
        if (r < I_PB) { const int kb = r / 32, nb = r % 32; d.W = F.in[I_WPB]; d.N = 1024; d.WT = (bf16*)(ws + WS_WAB); d.ldo = 1536; d.rowbase = 32 * nb; d.koff = 512; d.k0 = 64 * kb; d.n0 = 32 * nb; if (P34_FP8) d.f8scale = W34_SCALE; return; } r -= I_PB;
        if (r < I_WO) { const int kb = r / 32, nb = r % 32; d.W = F.in[I_WOUT]; d.N = 1024; d.WT = (bf16*)(ws + WS_WO); d.ldo = 1024; d.rowbase = 32 * nb; d.k0 = 64 * kb; d.n0 = 32 * nb; if (P34_FP8) d.f8scale = W34_SCALE; return; } r -= I_WO;
        if (r < 2 * I_EG) { const int up = r >= I_EG; if (up) r -= I_EG; const int e = r / 128, q = r % 128, kb = q / 8, nb = q % 8;
            d.W = F.in[up ? I_WEU : I_WEG] + (size_t)e * 1024 * 256; d.N = 256; d.WT = (bf16*)(ws + WS_WGU) + (size_t)e * 512 * 1024; d.ldo = 1024; d.rowbase = 64 * nb + (up ? 4 : 0); d.k0 = 64 * kb; d.n0 = 32 * nb; d.perm = true; d.kscale = F.in[I_GFFN]; d.f8scale = WG8_SCALE; if (P6_FP8) d.WT = (bf16*)((unsigned char*)(ws + WS_WGU) + (size_t)e * 512 * 1024); return; } r -= 2 * I_EG;
        { const int e = r / 128, q = r % 128, kb = q / 32, nb = q % 32;
            d.W = F.in[I_WED] + (size_t)e * 256 * 1024; d.N = 1024; d.WT = (bf16*)(ws + WS_WD) + (size_t)e * 1024 * 256; d.ldo = 256; d.rowbase = 32 * nb; d.k0 = 64 * kb; d.n0 = 32 * nb; d.f8scale = WD8_SCALE; if (P6_FP8) d.WT = (bf16*)((unsigned char*)(ws + WS_WD) + (size_t)e * 1024 * 256); }
    };
    {
        int it = gw; TrDesc dc, dn; f32x4 tc[8], tn[8]; float kc[8], kn[8];
        bool hc = it < NITEMS; if (hc) { decode(it, dc); tr_load(dc, lane_, tc, kc); }
        while (hc) {
            it += NGW; const bool hn = it < NITEMS;
            if (hn) { decode(it, dn); tr_load(dn, lane_, tn, kn); }
            tr_finish(dc, scr, lane_, tc, kc);
            hc = hn; dc = dn;
#pragma unroll
            for (int i = 0; i < 8; ++i) { tc[i] = tn[i]; kc[i] = kn[i]; }
        }
    }
    for (int m = gw; m < T; m += 4 * NGW) {
        const GAS f32x4* gr = (const GAS f32x4*)F.in[I_GMIX] + lane_;
        f32x4 v[4][4]; float ss[4];
#pragma unroll
        for (int r = 0; r < 4; ++r) { const int mr = (m + r * NGW < T) ? m + r * NGW : m; const GAS f32x4* xr = (const GAS f32x4*)(F.in[I_X] + (size_t)mr * D) + lane_;
#pragma unroll
            for (int j = 0; j < 4; ++j) v[r][j] = xr[64 * j]; }
#pragma unroll
        for (int r = 0; r < 4; ++r) { float a = 0.f;
#pragma unroll
            for (int j = 0; j < 4; ++j) a += (v[r][j].x * v[r][j].x + v[r][j].y * v[r][j].y) + (v[r][j].z * v[r][j].z + v[r][j].w * v[r][j].w);
            ss[r] = 1.0f / sqrtf(wave_sum(a) * (1.f / D) + RMS_EPS); }
#pragma unroll
        for (int r = 0; r < 4; ++r) { if (m + r * NGW >= T) continue; GAS unsigned* o4 = (GAS unsigned*)((unsigned char*)F.out + DO_HN + (size_t)(m + r * NGW) * D) + lane_;
#pragma unroll
            for (int j = 0; j < 4; ++j) { const f32x4 gg = gr[64 * j];
                if (P1_FP8) o4[64 * j] = pk4_fp8(v[r][j].x * ss[r] * gg.x, v[r][j].y * ss[r] * gg.y, v[r][j].z * ss[r] * gg.z, v[r][j].w * ss[r] * gg.w);
                else { v2u w; w.x = cvtpk(v[r][j].x * ss[r] * gg.x, v[r][j].y * ss[r] * gg.y); w.y = cvtpk(v[r][j].z * ss[r] * gg.z, v[r][j].w * ss[r] * gg.w); ((GAS v2u*)((unsigned char*)F.out + DO_HN + (size_t)(m + r * NGW) * D * 2) + lane_)[64 * j] = w; } } }
    }
    const int gt = F.vcu * NTHR + tid_, NGT = F.G * NTHR;
    if (gt < 32) ((float*)(ws + WS_INVF))[gt] = (float)exp2(-(double)gt * (13.287712379549449 / 32.0));
    for (int i = gt; i < 32 * 3 * 64; i += NGT) {
        const int ln = i & 63, nb = (i >> 6) % 3, ks = i / 192;
        const int n = 16 * nb + (ln & 15);
        float hi[8], lo[8];
#pragma unroll
        for (int e = 0; e < 8; ++e) { const int k = 32 * ks + 8 * (ln >> 4) + e; float v = 0.f;
            if (n < 4) v = F.in[I_WRG][k * 4 + n]; else if (n < 36) v = F.in[I_WRE][k * 32 + (n - 4)];
            v *= F.in[I_GFFN][k]; hi[e] = bf2f(f2bf(v)); lo[e] = v - hi[e]; }
        v4u h, l; h.x = pk2(hi[0], hi[1]); h.y = pk2(hi[2], hi[3]); h.z = pk2(hi[4], hi[5]); h.w = pk2(hi[6], hi[7]);
        l.x = pk2(lo[0], lo[1]); l.y = pk2(lo[2], lo[3]); l.z = pk2(lo[4], lo[5]); l.w = pk2(lo[6], lo[7]);
        ((v4u*)(ws + WS_WRF))[((ks * 3 + nb) * 2 + 0) * 64 + ln] = h; ((v4u*)(ws + WS_WRF))[((ks * 3 + nb) * 2 + 1) * 64 + ln] = l;
    }
}

namespace pg8 {
#define PG8_LAS __attribute__((address_space(3)))
typedef unsigned short bf16_t;
typedef short bf16x8 __attribute__((ext_vector_type(8)));
typedef float f32x4 __attribute__((ext_vector_type(4)));
typedef unsigned u32x4 __attribute__((ext_vector_type(4)));
constexpr int BM = 256, BK = 64, HALF = 128, HTB = HALF * BK * 2  , STAGE_BYTES = 8 * HTB, NXCD = 8, WGM = 8;

__host__ __device__ __forceinline__ int lds_byte(int r, int c) { const int st = (r >> 4) * 2 + (c >> 5), rr = r & 15, cc = c & 31, ob = rr * 64 + cc * 2; return st * 1024 + (ob ^ (((ob >> 9) & 1) << 5)); }
__host__ __device__ __forceinline__ void stage_rc(int b, int& R, int& C) { const int st = b / 1024, sb = b % 1024, swz = sb ^ (((sb >> 9) & 1) << 5); R = (st >> 1) * 16 + swz / 64; C = (st & 1) * 32 + (swz % 64) / 2; }
__host__ __device__ __forceinline__ int perm32(int rho) { const int n = rho >> 4, i = rho & 15; return 8 * (i >> 2) + 4 * n + (i & 3); }

struct Unit { int pm, pn; };
struct Gemm { const bf16_t* A; const bf16_t* Bt; int M, N, K; };

struct StaticOrder {
    int nM, nN, nwg, G, c;
    __host__ __device__ void init(int M, int N, int G_, int c_) { nM = M / BM; nN = N / BM; nwg = nM * nN; G = G_; c = c_; }
    __host__ __device__ bool next(int i, Unit& u) const {
        const long L = (long)i * G + c; if (L >= nwg) return false;
        int wgid = (int)L; { const int q = nwg / NXCD, r = nwg % NXCD, xcd = wgid % NXCD, off = wgid / NXCD; wgid = (xcd < r ? xcd * (q + 1) : r * (q + 1) + (xcd - r) * q) + off; }
        const int nig = WGM * nN, gid = wgid / nig, fm = gid * WGM, gsz = (nM - fm) < WGM ? (nM - fm) : WGM;
        u.pm = fm + ((wgid % nig) % gsz); u.pn = (wgid % nig) / gsz; return true;
    }
    __device__ __forceinline__ void a_ready(const Unit&) const {}
    __device__ __forceinline__ void done(const Unit&) const {}
};
}


namespace pg9 {
using pg8::BM; using pg8::BK; using pg8::HALF; using pg8::HTB; using pg8::lds_byte; using pg8::stage_rc; using pg8::perm32;
struct Unit { int pm, pn, e; };
typedef int v8i_t __attribute__((ext_vector_type(8)));
typedef int v4i_t __attribute__((ext_vector_type(4)));
template <int ESZ, class Epi, class Sched, class AOff, class BBase>
__device__ __forceinline__ void gemm_phase(LAS unsigned char* lds, const char* Abase, int K, const Sched& S, const Epi& E, const AOff& aoffn, const BBase& bbase) {
    int tid_ = threadIdx.x; asm volatile("" : "+v"(tid_));
    const int tid = tid_, wid = __builtin_amdgcn_readfirstlane(tid >> 6), lane = tid & 63, wr = wid >> 2, wc = wid & 3, fr = lane & 15, fq = lane >> 4;
    const int nt = K * ESZ / (BK * 2);
    int Rr[2], Cc[2]; unsigned voffB[2];
#pragma unroll
    for (int i = 0; i < 2; ++i) { int R, C; stage_rc(tid * 16 + i * 8192, R, C); const int Rb = Epi::PERM ? ((R & ~31) + perm32(R & 31)) : R; Rr[i] = R; Cc[i] = C; voffB[i] = (unsigned)(Rb * K * ESZ + C * 2); }
    const size_t kstep = (size_t)(BK * 2);
    const size_t hstep = (size_t)HALF * K * ESZ;
    const unsigned ldsw = (unsigned)wid * 1024u;
    const int aoff = lds_byte(wr * 64 + fr, fq * 8), boff = lds_byte(wc * 32 + fr, fq * 8);
#define PG9_SA(b, h) (((b) * 2 + (h)) * HTB)
#define PG9_SB(b, h) ((4 + (b) * 2 + (h)) * HTB)
#define PG9_STAGE(bufoff, gbase, voff) do { _Pragma("unroll") for (int _i = 0; _i < 2; ++_i) \
        __builtin_amdgcn_global_load_lds((const unsigned*)((const char*)(gbase) + (voff)[_i]), (LAS unsigned*)(lds + (bufoff) + ldsw + _i * 8192), 16, 0, 0); } while (0)
#define PG9_LDA(dst, b, h) do { _Pragma("unroll") for (int m = 0; m < 4; ++m) { dst[m].lo = *(const LAS v4i_t*)(lds + PG9_SA(b, h) + aoff + m * 2048); dst[m].hi = *(const LAS v4i_t*)(lds + PG9_SA(b, h) + aoff + m * 2048 + 1024); } } while (0)
#define PG9_LDB(dst, b, h) do { _Pragma("unroll") for (int n = 0; n < 2; ++n) { dst[n].lo = *(const LAS v4i_t*)(lds + PG9_SB(b, h) + boff + n * 2048); dst[n].hi = *(const LAS v4i_t*)(lds + PG9_SB(b, h) + boff + n * 2048 + 1024); } } while (0)
#define PG9_HALF(v, o) __builtin_bit_cast(bf16x8, __builtin_shufflevector((v), (v), (o), (o) + 1, (o) + 2, (o) + 3))
#define PG9_MMA(ai, bj, At, Bt) do { __builtin_amdgcn_s_setprio(1); _Pragma("unroll") for (int m = 0; m < 4; ++m) _Pragma("unroll") for (int n = 0; n < 2; ++n) { \
        if (ESZ == 2) { acc[ai][bj][m][n] = __builtin_amdgcn_mfma_f32_16x16x32_bf16(PG9_HALF(Bt[n], 0), PG9_HALF(At[m], 0), acc[ai][bj][m][n], 0, 0, 0); \
                        acc[ai][bj][m][n] = __builtin_amdgcn_mfma_f32_16x16x32_bf16(PG9_HALF(Bt[n], 4), PG9_HALF(At[m], 4), acc[ai][bj][m][n], 0, 0, 0); } \
        else { asm volatile("v_mfma_scale_f32_16x16x128_f8f6f4 %0, %1, %2, %0, %3, %3 op_sel_hi:[0,0,0]" : "+v"(acc[ai][bj][m][n]) : "v"(Bt[n]), "v"(At[m]), "v"(one8)); } } \
        __builtin_amdgcn_s_setprio(0); } while (0)
#define PG9_WAIT_V(n) asm volatile("s_waitcnt vmcnt(" #n ")" ::: "memory")
#define PG9_WAIT_L(n) asm volatile("s_waitcnt lgkmcnt(" #n ")" ::: "memory")
#define PG9_BAR __builtin_amdgcn_s_barrier()
#define PG9_SCHED __builtin_amdgcn_sched_barrier(0)
#define PG9_VA(dst, u) do { _Pragma("unroll") for (int _h = 0; _h < 2; ++_h) _Pragma("unroll") for (int _i = 0; _i < 2; ++_i) dst[_h][_i] = aoffn((u), _h * HALF + Rr[_i]) + (unsigned)(Cc[_i] * 2); } while (0)
    constexpr bool GATHER = AOff::GATHER;
    const size_t hstepA = (size_t)HALF * aoffn.rowbytes;
    unsigned voffA[2];
#pragma unroll
    for (int i = 0; i < 2; ++i) voffA[i] = (unsigned)Rr[i] * aoffn.rowbytes + (unsigned)(Cc[i] * 2);
#define PG9_STAGE_A(bufoff, h, koff, nx) do { if (GATHER) { PG9_STAGE(bufoff, Abase + (koff), ((nx) ? nvA[h] : cvA[h])); } else { PG9_STAGE(bufoff, ((nx) ? nAu : cAu) + (h) * hstepA + (koff), voffA); } } while (0)
    Unit cur, nxt; int ui = 0;
    if (!S.next(0, cur)) return;
    f32x4 acc[2][2][4][2];
#pragma unroll
    for (int a = 0; a < 2; ++a)
#pragma unroll
        for (int b = 0; b < 2; ++b)
#pragma unroll
            for (int m = 0; m < 4; ++m)
#pragma unroll
                for (int n = 0; n < 2; ++n) acc[a][b][m][n] = (f32x4){0.f, 0.f, 0.f, 0.f};
    int one8 = 0x7f7f7f7f; asm volatile("" : "+v"(one8));
    v8i_t At[4], B0[2], B1[2];
    unsigned cvA[2][2], nvA[2][2];
    if (GATHER) { PG9_VA(cvA, cur); }
    const char* cAu = GATHER ? Abase : Abase + (size_t)aoffn(cur, 0); const char* nAu = cAu;
    const char* cB = bbase(cur);
    PG9_STAGE(PG9_SB(0, 0), cB, voffB); PG9_STAGE(PG9_SB(0, 1), cB + hstep, voffB); PG9_STAGE_A(PG9_SA(0, 0), 0, 0, false); PG9_STAGE_A(PG9_SA(0, 1), 1, 0, false);
    if (wr == 1) PG9_BAR;
    PG9_WAIT_V(2); PG9_BAR;
    PG9_STAGE(PG9_SB(1, 0), cB + kstep, voffB); PG9_STAGE_A(PG9_SA(1, 0), 0, kstep, false); PG9_STAGE(PG9_SB(1, 1), cB + hstep + kstep, voffB);
    PG9_WAIT_V(6); PG9_BAR;
    for (;;) {
        const bool has_next = S.next(ui + 1, nxt);
        if (GATHER) {
            if (has_next) { PG9_VA(nvA, nxt); } else {
#pragma unroll
                for (int _h = 0; _h < 2; ++_h)
#pragma unroll
                    for (int _i = 0; _i < 2; ++_i) nvA[_h][_i] = cvA[_h][_i]; }
        } else nAu = has_next ? Abase + (size_t)aoffn(nxt, 0) : cAu;
        const char* nB = has_next ? bbase(nxt) : cB;
#pragma unroll 1
        for (int t = 0; t < nt; t += 2) {
            const bool last = (t == nt - 2);
            if (Epi::HOOK_T >= 0) { if (t == Epi::HOOK_T) E.hook(acc, cur, wr, wc, fr, fq); }
            const size_t k1 = (size_t)(t + 1) * kstep, k2 = last ? 0 : (size_t)(t + 2) * kstep, k3 = k2 + kstep;
            const char* b2 = last ? nB : cB + (size_t)(t + 2) * kstep; const char* b3 = b2 + kstep;
            PG9_LDB(B0, 0, 0); PG9_LDB(B1, 0, 1); PG9_SCHED; PG9_LDA(At, 0, 0); PG9_STAGE_A(PG9_SA(1, 1), 1, k1, false);
            PG9_WAIT_V(8); PG9_WAIT_L(0); PG9_BAR; PG9_MMA(0, 0, At, B0); PG9_MMA(0, 1, At, B1); PG9_BAR; PG9_SCHED;
            PG9_LDA(At, 0, 1); PG9_STAGE(PG9_SB(0, 0), b2, voffB); PG9_STAGE(PG9_SB(0, 1), b2 + hstep, voffB); PG9_STAGE_A(PG9_SA(0, 0), 0, k2, last);
            PG9_WAIT_V(8); PG9_WAIT_L(0); PG9_BAR; PG9_MMA(1, 0, At, B0); PG9_MMA(1, 1, At, B1); PG9_BAR; PG9_SCHED;
            PG9_LDB(B0, 1, 0); PG9_LDB(B1, 1, 1); PG9_SCHED; PG9_LDA(At, 1, 0); PG9_STAGE_A(PG9_SA(0, 1), 1, k2, last);
            PG9_WAIT_V(8); PG9_WAIT_L(0); PG9_BAR; PG9_MMA(0, 0, At, B0); PG9_MMA(0, 1, At, B1); PG9_BAR; PG9_SCHED;
            PG9_LDA(At, 1, 1); PG9_STAGE(PG9_SB(1, 0), b3, voffB); PG9_STAGE(PG9_SB(1, 1), b3 + hstep, voffB); PG9_STAGE_A(PG9_SA(1, 0), 0, k3, last);
            PG9_WAIT_V(8); PG9_WAIT_L(0); PG9_BAR; PG9_MMA(1, 0, At, B0); PG9_MMA(1, 1, At, B1); PG9_BAR; PG9_SCHED;
        }
        if (wr == 0) PG9_BAR;
        if (ESZ == 1) asm volatile("s_nop 15\n\ts_nop 15" ::: "memory");
        E(acc, cur, wr, wc, fr, fq);
        if (!has_next) break;
#pragma unroll
        for (int a = 0; a < 2; ++a)
#pragma unroll
            for (int b = 0; b < 2; ++b)
#pragma unroll
                for (int m = 0; m < 4; ++m)
#pragma unroll
                    for (int n = 0; n < 2; ++n) acc[a][b][m][n] = (f32x4){0.f, 0.f, 0.f, 0.f};
        cur = nxt; cB = nB; cAu = nAu; ++ui;
        if (GATHER) {
#pragma unroll
            for (int _h = 0; _h < 2; ++_h)
#pragma unroll
                for (int _i = 0; _i < 2; ++_i) cvA[_h][_i] = nvA[_h][_i]; }
        if (wr == 1) PG9_BAR;
    }
    PG9_WAIT_V(0);
    PG9_BAR;
#undef PG9_SA
#undef PG9_SB
#undef PG9_STAGE
#undef PG9_LDA
#undef PG9_LDB
#undef PG9_MMA
#undef PG9_HALF
#undef PG9_WAIT_V
#undef PG9_WAIT_L
#undef PG9_BAR
#undef PG9_SCHED
#undef PG9_VA
#undef PG9_STAGE_A
}
struct DenseOrder { pg8::StaticOrder so;
    __device__ void init(int M, int N, int G, int c) { so.init(M, N, G, c); }
    __device__ bool next(int i, Unit& u) const { pg8::Unit v; if (!so.next(i, v)) return false; u.pm = v.pm; u.pn = v.pn; u.e = 0; return true; } };
struct DenseA { static constexpr bool GATHER = false; unsigned rowbytes; __device__ __forceinline__ unsigned operator()(const Unit& u, int row) const { return (unsigned)(u.pm * 256 + row) * rowbytes; } };
struct DenseB { const char* Bt; size_t tilebytes; __device__ __forceinline__ const char* operator()(const Unit& u) const { return Bt + (size_t)u.pn * tilebytes; } };
}

struct EpiInproj {
    static constexpr bool PERM = true; static constexpr int HOOK_T = -1;
    bf16* ZA; bf16* ZB; bf16* Gt; const float* bias; const float* invf; unsigned char* wsb;
    __device__ __forceinline__ void hook(f32x4 (&)[2][2][4][2], const pg9::Unit&, int, int, int, int) const {}
    __device__ __forceinline__ void operator()(const f32x4 (&acc)[2][2][4][2], const pg9::Unit& u, int wr, int wc, int fr, int fq) const {
        asm volatile("" : "+v"(fr), "+v"(fq));
        const int row0 = u.pm * 256 + wr * 64 + fr;
        const int q = 4 * (wc & 1) + fq;
        const __amdgpu_buffer_rsrc_t wr_ = wt_rsrc(wsb);
        int kind[2]; bf16* dst[2]; int ldd[2]; f32x4 b0[2], b1[2];
#pragma unroll
        for (int bj = 0; bj < 2; ++bj) {
            const int colpos = u.pn * 256 + bj * 128 + wc * 32 + 8 * fq, hb = u.pn * 256 + bj * 128 + (wc >> 1) * 64;
            if (hb < A_W) { kind[bj] = hb / 1536; dst[bj] = ZA + colpos; ldd[bj] = A_W; }
            else if (hb < A_W + B_W) { const int cb = hb - A_W; kind[bj] = cb < 1024 ? 0 : (cb < 1152 ? 1 : 2); dst[bj] = ZB + (colpos - A_W); ldd[bj] = B_W; }
            else { kind[bj] = 3; dst[bj] = Gt + ((colpos - A_W - B_W) >> 1); ldd[bj] = G_W; }
            b0[bj] = *(const f32x4*)(bias + (kind[bj] < 2 ? hb + 4 * q : (kind[bj] == 3 ? A_W + B_W + ((colpos - A_W - B_W) >> 1) : colpos)));
            b1[bj] = *(const f32x4*)(bias + (kind[bj] < 2 ? hb + 32 + 4 * q : (kind[bj] == 3 ? A_W + B_W + 1024 + ((colpos - A_W - B_W) >> 1) : colpos + 4)));
        }
        const bool need_rope = kind[0] < 2 || kind[1] < 2;
        const f32x4 fv = *(const f32x4*)(invf + 4 * q);
#pragma unroll
        for (int ai = 0; ai < 2; ++ai) {
            f32x4 rc[4], rs[4];
#pragma unroll
            for (int m = 0; m < 4; ++m) { rc[m] = (f32x4){1.f, 1.f, 1.f, 1.f}; rs[m] = (f32x4){0.f, 0.f, 0.f, 0.f}; }
            if (need_rope) {
#pragma unroll
                for (int m = 0; m < 4; ++m) { const float posf = (float)((row0 + ai * 128 + m * 16) & (SEQ - 1));
#pragma unroll
                    for (int e = 0; e < 4; ++e) { const float ang = posf * fv[e]; const float pr = ang * 0.15915494f; const float er = __builtin_fmaf(ang, 0.15915494f, -pr) + ang * 6.4206382e-9f;
                        const float fr = __builtin_amdgcn_fractf(pr) + er; rc[m][e] = __builtin_amdgcn_cosf(fr); rs[m][e] = __builtin_amdgcn_sinf(fr); } }
            }
#pragma unroll
            for (int bj = 0; bj < 2; ++bj) {
#pragma unroll
                for (int m = 0; m < 4; ++m) {
                    const int row = row0 + ai * 128 + m * 16;
                    f32x4 v0 = acc[ai][bj][m][0] * W8_INV + b0[bj], v1 = acc[ai][bj][m][1] * W8_INV + b1[bj];
                    if (kind[bj] < 2) {
                        const f32x4 cc = rc[m], ss = rs[m];
                        const f32x4 t0 = v0 * cc - v1 * ss, t1 = v1 * cc + v0 * ss;
                        v0 = t0; v1 = t1;
                        if (kind[bj] == 0) { v0 = v0 * QSCALE; v1 = v1 * QSCALE; }
                    }
                    if (kind[bj] == 3) {
#pragma unroll
                        for (int e = 0; e < 4; ++e) { const float d0 = 1.0f + __expf(-v0[e]), d1 = 1.0f + __expf(-v1[e]); v0[e] = d1 * __builtin_amdgcn_rcpf(d0); v1[e] = __builtin_amdgcn_rcpf(d1); }
                        v2u w0, w1; w0.x = cvtpk(v0[0], v0[1]); w0.y = cvtpk(v0[2], v0[3]); w1.x = cvtpk(v1[0], v1[1]); w1.y = cvtpk(v1[2], v1[3]);
                        st8(wr_, wsb, dst[bj] + (size_t)row * ldd[bj], w0); st8(wr_, wsb, dst[bj] + (size_t)row * ldd[bj] + 1024, w1);
                    } else {
                    v4u w; w.x = cvtpk(v0[0], v0[1]); w.y = cvtpk(v0[2], v0[3]); w.z = cvtpk(v1[0], v1[1]); w.w = cvtpk(v1[2], v1[3]);
                    st16(wr_, wsb, dst[bj] + (size_t)row * ldd[bj], w); }
                }
            }
        }
    }
};
__device__ __forceinline__ void p1_inproj(Frame& F, int ch) {
    unsigned char* ws = F.ws;
    pg9::DenseOrder S; S.init(TC, NIN, F.G, (int)blockIdx.x);
    EpiInproj E{(bf16*)(ws + WS_ZA), (bf16*)(ws + WS_ZB), (bf16*)(ws + WS_G) + (size_t)ch * TC * G_W, F.in[I_BIN], (const float*)(ws + WS_INVF), ws};
    constexpr int ES = P1_FP8 ? 1 : 2;
    pg9::DenseA ao{(unsigned)(D * ES)}; pg9::DenseB bb{(const char*)(ws + WS_WIN), (size_t)256 * D * ES};
    pg9::gemm_phase<ES>(F.lds, (const char*)F.out + DO_HN + (size_t)ch * TC * D * ES, D, S, E, ao, bb);
}

typedef float f32x16 __attribute__((ext_vector_type(16)));
typedef short v4i16_t __attribute__((ext_vector_type(4)));
__device__ __forceinline__ float half_max(float v) { auto rr = __builtin_amdgcn_permlane32_swap(__float_as_uint(v), __float_as_uint(v), false, false); return fmaxf(__uint_as_float(rr[0]), __uint_as_float(rr[1])); }
__device__ __forceinline__ float half_sum(float v) { auto rr = __builtin_amdgcn_permlane32_swap(__float_as_uint(v), __float_as_uint(v), false, false); return __uint_as_float(rr[0]) + __uint_as_float(rr[1]); }
__device__ __forceinline__ float max3f(float a, float b, float c) { float r; asm("v_max3_f32 %0, %1, %2, %3" : "=v"(r) : "v"(a), "v"(b), "v"(c)); return r; }
constexpr int ATT_VOFF = 49152;

struct AUnit { const bf16 *Kw, *Vw, *Qp; size_t pitch; int kk_lo, nkeys, kb0, kstart, lo; float m0, l0; bf16* Op; float* Lp; int o8; };
__device__ __forceinline__ void attn_decode(Frame& F, int ch, int u, int NUA, int lane, AUnit& d) {
    unsigned char* ws = F.ws;
    const int w = F.wave, c = lane & 31, h = (lane >> 5) & 1;
    if (u < NUA) {
        const bf16* ZA = (const bf16*)(ws + WS_ZA);
        const int rt = u & 15, hh = (u >> 4) & 7, gb = u >> 7, g = gb % 3, bl = gb / 3;
        const int dsh = 2 * g, dd = 1 << dsh, tsh = 4 - dsh;
        const int r = rt >> tsh, tile = rt & ((1 << tsh) - 1), i0 = tile * 256;
        const int rowb = bl * SEQ + r, col = g * 512 + hh * 64;
        d.pitch = (size_t)dd * A_W;
        d.Kw = ZA + ((long)rowb + (long)dd * (i0 - 128)) * A_W + 1536 + col; d.Vw = d.Kw + 1536;
        const long qrow = (long)rowb + (long)dd * (i0 + 32 * w + c);
        d.Qp = ZA + qrow * A_W + col;
        d.kk_lo = (i0 == 0) ? 128 : 0; d.nkeys = 384; d.kb0 = w; d.kstart = (i0 == 0) ? (w < 4 ? 4 - w : 0) : 0; d.lo = 0;
        d.m0 = -1e30f; d.l0 = 0.f;
        d.Op = (bf16*)((unsigned char*)F.out + DO_OG) + ((size_t)g * TC + qrow) * 512 + hh * 64;
        d.Lp = (float*)((unsigned char*)F.out + DO_LSE) + ((size_t)g * TC + qrow) * 8 + hh;
        d.o8 = 0;
    } else {
        const int u2 = u - NUA;
        const bf16* ZB = (const bf16*)(ws + WS_ZB);
        const int blk = u2 & 127, kvh = (u2 >> 7) & 1, bl = u2 >> 8;
        const int t0 = blk * 32, rowb = bl * SEQ;
        d.pitch = B_W;
        d.Kw = ZB + ((long)rowb + t0 - 128) * B_W + 1024 + kvh * 64; d.Vw = d.Kw + 128;
        const int qh = kvh * 8 + w;
        const long qrow = (long)rowb + t0 + c;
        d.Qp = ZB + qrow * B_W + qh * 64;
        d.kk_lo = t0 < 128 ? 128 - t0 : 0; d.nkeys = 160; d.kb0 = 0; d.kstart = d.kk_lo >> 5; d.lo = 1;
        d.m0 = F.in[I_SINK][qh] * LOG2E; d.l0 = h == 0 ? 1.f : 0.f;
        d.o8 = P34_FP8;
        d.Op = P34_FP8 ? (bf16*)(ws + WS_Y + ((size_t)ch * TC + qrow) * Y_W + 512 + qh * 64) : (bf16*)(ws + WS_Y) + ((size_t)ch * TC + qrow) * Y_W + 512 + qh * 64;
        d.Lp = nullptr;
    }
}
__device__ __forceinline__ void attn_load(const AUnit& d, int tid, int lane, v4u (&kreg)[6], v4u (&vreg)[6], bf16x8 (&qf)[4]) {
    const int skey = tid >> 3, sch = tid & 7, h = (lane >> 5) & 1;
#pragma unroll
    for (int s4 = 0; s4 < 4; ++s4) qf[s4] = *(const GAS bf16x8*)(d.Qp + 16 * s4 + 8 * h);
#pragma unroll
    for (int p = 0; p < 6; ++p) { const int kk = 64 * p + skey;
        if (kk >= d.kk_lo && kk < d.nkeys) { kreg[p] = *(const GAS v4u*)(d.Kw + (size_t)kk * d.pitch + 8 * sch); vreg[p] = *(const GAS v4u*)(d.Vw + (size_t)kk * d.pitch + 8 * sch); } }
}
__device__ __forceinline__ void attn_write(const AUnit& d, LAS unsigned char* KL, LAS unsigned char* VL, int tid, const v4u (&kreg)[6], const v4u (&vreg)[6]) {
    const int skey = tid >> 3, sch = tid & 7;
#pragma unroll
    for (int p = 0; p < 6; ++p) { const int kk = 64 * p + skey;
        if (kk >= d.kk_lo && kk < d.nkeys) {
            *(LAS v4u*)(KL + kk * 128 + ((sch ^ ((kk >> 1) & 7)) << 4)) = kreg[p];
            *(LAS v4u*)(VL + kk * 128 + ((sch * 16) ^ (((kk >> 1) & 1) << 6))) = vreg[p]; } }
}
__device__ __forceinline__ void attn_compute_edge(const AUnit& d, const LAS unsigned char* KL, const LAS unsigned char* VL, int lane, const bf16x8 (&qf)[4]) {
    const int c = lane & 31, h = (lane >> 5) & 1;
    int koff[4];
    { const int kswz = (c >> 1) & 7;
#pragma unroll
      for (int s4 = 0; s4 < 4; ++s4) koff[s4] = c * 128 + (((2 * s4 + h) ^ kswz) << 4); }
    const int vrow = 4 * h + ((lane & 15) >> 2), vsw = (lane >> 3) & 1;
    const int voff0 = vrow * 128 + ((32 * ((lane >> 4) & 1) + 8 * (lane & 3)) ^ (vsw << 6)), voff1 = voff0 ^ 64;
    const float NEG = -INFINITY;
    float m = d.m0, l = d.l0;
    f32x16 o0, o1;
#pragma unroll
    for (int i = 0; i < 16; ++i) { o0[i] = 0.f; o1[i] = 0.f; }
    const LAS unsigned char* kbp = KL + d.kb0 * 4096; const LAS unsigned char* vbp = VL + d.kb0 * 4096;
    const int clo = c + d.lo;
#pragma unroll
    for (int kbi = 0; kbi < 5; ++kbi) {
        if (kbi >= d.kstart) {
            f32x16 p;
#pragma unroll
            for (int i = 0; i < 16; ++i) p[i] = 0.f;
#pragma unroll
            for (int s4 = 0; s4 < 4; ++s4) { const bf16x8 kf = *(const LAS bf16x8*)(kbp + kbi * 4096 + koff[s4]); p = __builtin_amdgcn_mfma_f32_32x32x16_bf16(kf, qf[s4], p, 0, 0, 0); }
            if (kbi == 0) {
#pragma unroll
                for (int i = 0; i < 16; ++i) { const int x = (i & 3) + 8 * (i >> 2) + 4 * h; if (x < clo) p[i] = NEG; }
            }
            if (kbi == 4) {
#pragma unroll
                for (int i = 0; i < 16; ++i) { const int x = (i & 3) + 8 * (i >> 2) + 4 * h; if (x > c) p[i] = NEG; }
            }
            float mt = p[0];
#pragma unroll
            for (int i = 1; i < 16; ++i) mt = fmaxf(mt, p[i]);
            mt = half_max(mt);
            const float mn = fmaxf(m, mt), alpha = __builtin_amdgcn_exp2f(m - mn);
            m = mn;
            float ps = 0.f;
#pragma unroll
            for (int i = 0; i < 16; ++i) { p[i] = __builtin_amdgcn_exp2f(p[i] - mn); ps += p[i]; }
            l = l * alpha + ps;
#pragma unroll
            for (int i = 0; i < 16; ++i) { o0[i] *= alpha; o1[i] *= alpha; }
            bf16x8 pb[2];
#pragma unroll
            for (int s2 = 0; s2 < 2; ++s2) { v4u t; t.x = cvtpk(p[8 * s2 + 0], p[8 * s2 + 1]); t.y = cvtpk(p[8 * s2 + 2], p[8 * s2 + 3]); t.z = cvtpk(p[8 * s2 + 4], p[8 * s2 + 5]); t.w = cvtpk(p[8 * s2 + 6], p[8 * s2 + 7]); pb[s2] = __builtin_bit_cast(bf16x8, t); }
#pragma unroll
            for (int s2 = 0; s2 < 2; ++s2) {
#pragma unroll
                for (int db = 0; db < 2; ++db) {
                    const LAS unsigned char* vp = vbp + kbi * 4096 + s2 * 2048 + (db ? voff1 : voff0);
                    const v4i16_t lo = __builtin_amdgcn_ds_read_tr16_b64_v4i16((LAS v4i16_t*)vp);
                    const v4i16_t hi = __builtin_amdgcn_ds_read_tr16_b64_v4i16((LAS v4i16_t*)(vp + 1024));
                    const bf16x8 vf = {lo[0], lo[1], lo[2], lo[3], hi[0], hi[1], hi[2], hi[3]};
                    if (db == 0) o0 = __builtin_amdgcn_mfma_f32_32x32x16_bf16(vf, pb[s2], o0, 0, 0, 0);
                    else o1 = __builtin_amdgcn_mfma_f32_32x32x16_bf16(vf, pb[s2], o1, 0, 0, 0);
                }
            }
        }
    }
    const float lt = half_sum(l), inv = 1.0f / lt;
#pragma unroll
    for (int g4 = 0; g4 < 4; ++g4) {
        v2u a, b;
        a.x = cvtpk(o0[4 * g4 + 0] * inv, o0[4 * g4 + 1] * inv); a.y = cvtpk(o0[4 * g4 + 2] * inv, o0[4 * g4 + 3] * inv);
        b.x = cvtpk(o1[4 * g4 + 0] * inv, o1[4 * g4 + 1] * inv); b.y = cvtpk(o1[4 * g4 + 2] * inv, o1[4 * g4 + 3] * inv);
        if (d.o8) { unsigned char* o8p = (unsigned char*)d.Op; const float sc = inv * Y8_SCALE;
            *(GAS unsigned*)(o8p + 8 * g4 + 4 * h) = pk4_fp8(o0[4 * g4 + 0] * sc, o0[4 * g4 + 1] * sc, o0[4 * g4 + 2] * sc, o0[4 * g4 + 3] * sc);
            *(GAS unsigned*)(o8p + 32 + 8 * g4 + 4 * h) = pk4_fp8(o1[4 * g4 + 0] * sc, o1[4 * g4 + 1] * sc, o1[4 * g4 + 2] * sc, o1[4 * g4 + 3] * sc); }
        else {
        *(GAS v2u*)(d.Op + 8 * g4 + 4 * h) = a;
        *(GAS v2u*)(d.Op + 32 + 8 * g4 + 4 * h) = b; }
    }
    if (d.Lp) { if (h == 0) *d.Lp = m + __builtin_amdgcn_logf(lt); }
}
__device__ __forceinline__ void attn_compute(const AUnit& d, const LAS unsigned char* KL, const LAS unsigned char* VL, int lane, const bf16x8 (&qf)[4]) {
    const int c = lane & 31, h = (lane >> 5) & 1;
    int koff[4];
    { const int kswz = (c >> 1) & 7;
#pragma unroll
      for (int s4 = 0; s4 < 4; ++s4) koff[s4] = c * 128 + (((2 * s4 + h) ^ kswz) << 4); }
    const int vrow = 4 * h + ((lane & 15) >> 2), vsw = (lane >> 3) & 1;
    const int voff0 = vrow * 128 + ((32 * ((lane >> 4) & 1) + 8 * (lane & 3)) ^ (vsw << 6)), voff1 = voff0 ^ 64;
    const float NEG = -INFINITY;
    float m = d.m0;
    f32x16 o0, o1, L;
#pragma unroll
    for (int i = 0; i < 16; ++i) { o0[i] = 0.f; o1[i] = 0.f; L[i] = 0.f; }
    v4u onesu = {0x3F803F80u, 0x3F803F80u, 0x3F803F80u, 0x3F803F80u}; asm volatile("" : "+v"(onesu));
    const bf16x8 ones = __builtin_bit_cast(bf16x8, onesu);
    const LAS unsigned char* kbp = KL + d.kb0 * 4096; const LAS unsigned char* vbp = VL + d.kb0 * 4096;
    const int clo = c + d.lo;
#pragma unroll
    for (int kbi = 0; kbi < 5; ++kbi) {
        {
            constexpr bool first_dummy = false; (void)first_dummy;
            const bool first = (kbi == 0);
            const float cinit = first ? 0.f : -m;
            f32x16 p;
#pragma unroll
            for (int i = 0; i < 16; ++i) p[i] = cinit;
#pragma unroll
            for (int s4 = 0; s4 < 4; ++s4) { const bf16x8 kf = *(const LAS bf16x8*)(kbp + kbi * 4096 + koff[s4]); p = __builtin_amdgcn_mfma_f32_32x32x16_bf16(kf, qf[s4], p, 0, 0, 0); }
            if (kbi == 0) {
#pragma unroll
                for (int i = 0; i < 16; ++i) { const int x = (i & 3) + 8 * (i >> 2) + 4 * h; p[i] = x < clo ? NEG : p[i]; }
            }
            if (kbi == 4) {
#pragma unroll
                for (int i = 0; i < 16; ++i) { const int x = (i & 3) + 8 * (i >> 2) + 4 * h; p[i] = x > c ? NEG : p[i]; }
            }
            float t0 = max3f(p[0], p[4], p[8]), t1 = max3f(p[1], p[5], p[9]), t2 = max3f(p[2], p[6], p[10]), t3 = max3f(p[3], p[7], p[11]);
            t0 = max3f(t0, p[12], p[13]); t1 = max3f(t1, p[14], p[15]);
            const float mt = half_max(max3f(max3f(t0, t1, t2), t3, t3));
            if (first) {
                const float mn = fmaxf(m, mt), l0 = d.m0 > -1e29f ? __builtin_amdgcn_exp2f(m - mn) : 0.f;
                m = mn;
#pragma unroll
                for (int i = 0; i < 16; ++i) { p[i] -= mn; L[i] = l0; }
            } else if (__any(mt > 8.0f)) {
                const float dl = fmaxf(mt, 0.f), al = __builtin_amdgcn_exp2f(-dl);
                m += dl;
#pragma unroll
                for (int i = 0; i < 16; ++i) { o0[i] *= al; o1[i] *= al; L[i] *= al; p[i] -= dl; }
            }
#pragma unroll
            for (int i = 0; i < 16; ++i) p[i] = __builtin_amdgcn_exp2f(p[i]);
            bf16x8 pb[2];
#pragma unroll
            for (int s2 = 0; s2 < 2; ++s2) { v4u t; t.x = cvtpk(p[8 * s2 + 0], p[8 * s2 + 1]); t.y = cvtpk(p[8 * s2 + 2], p[8 * s2 + 3]); t.z = cvtpk(p[8 * s2 + 4], p[8 * s2 + 5]); t.w = cvtpk(p[8 * s2 + 6], p[8 * s2 + 7]); pb[s2] = __builtin_bit_cast(bf16x8, t); }
#pragma unroll
            for (int s2 = 0; s2 < 2; ++s2) {
                L = __builtin_amdgcn_mfma_f32_32x32x16_bf16(ones, pb[s2], L, 0, 0, 0);
#pragma unroll
                for (int db = 0; db < 2; ++db) {
                    const LAS unsigned char* vp = vbp + kbi * 4096 + s2 * 2048 + (db ? voff1 : voff0);
                    const v4i16_t lo = __builtin_amdgcn_ds_read_tr16_b64_v4i16((LAS v4i16_t*)vp);
                    const v4i16_t hi = __builtin_amdgcn_ds_read_tr16_b64_v4i16((LAS v4i16_t*)(vp + 1024));
                    const bf16x8 vf = {lo[0], lo[1], lo[2], lo[3], hi[0], hi[1], hi[2], hi[3]};
                    if (db == 0) o0 = __builtin_amdgcn_mfma_f32_32x32x16_bf16(vf, pb[s2], o0, 0, 0, 0);
                    else o1 = __builtin_amdgcn_mfma_f32_32x32x16_bf16(vf, pb[s2], o1, 0, 0, 0);
                }
            }
        }
    }
    const float lt = L[0], inv = 1.0f / lt;
#pragma unroll
    for (int g4 = 0; g4 < 4; ++g4) {
        v2u a, b;
        a.x = cvtpk(o0[4 * g4 + 0] * inv, o0[4 * g4 + 1] * inv); a.y = cvtpk(o0[4 * g4 + 2] * inv, o0[4 * g4 + 3] * inv);
        b.x = cvtpk(o1[4 * g4 + 0] * inv, o1[4 * g4 + 1] * inv); b.y = cvtpk(o1[4 * g4 + 2] * inv, o1[4 * g4 + 3] * inv);
        if (d.o8) { unsigned char* o8p = (unsigned char*)d.Op; const float sc = inv * Y8_SCALE;
            *(GAS unsigned*)(o8p + 8 * g4 + 4 * h) = pk4_fp8(o0[4 * g4 + 0] * sc, o0[4 * g4 + 1] * sc, o0[4 * g4 + 2] * sc, o0[4 * g4 + 3] * sc);
            *(GAS unsigned*)(o8p + 32 + 8 * g4 + 4 * h) = pk4_fp8(o1[4 * g4 + 0] * sc, o1[4 * g4 + 1] * sc, o1[4 * g4 + 2] * sc, o1[4 * g4 + 3] * sc); }
        else {
        *(GAS v2u*)(d.Op + 8 * g4 + 4 * h) = a;
        *(GAS v2u*)(d.Op + 32 + 8 * g4 + 4 * h) = b; }
    }
    if (d.Lp) { if (h == 0) *d.Lp = m + __builtin_amdgcn_logf(lt); }
}
__device__ __forceinline__ void p2_attn(Frame& F, int ch) {
    int tid_ = threadIdx.x; asm volatile("" : "+v"(tid_));
    const int tid = tid_, lane = tid & 63;
    LAS unsigned char* KL = F.lds; LAS unsigned char* VL = F.lds + ATT_VOFF;
    constexpr int NUA = (TC / SEQ) * 3 * 8 * 16, NUB = (TC / SEQ) * 2 * 128, NU = NUA + NUB;
    int u = F.vcu;
    if (u >= NU) return;
    AUnit cur, nxt;
    v4u kreg[6], vreg[6]; bf16x8 qn[4];
    attn_decode(F, ch, u, NUA, lane, cur);
    attn_load(cur, tid, lane, kreg, vreg, qn);
    for (;;) {
        attn_write(cur, KL, VL, tid, kreg, vreg);
        bf16x8 qf[4];
#pragma unroll
        for (int s4 = 0; s4 < 4; ++s4) qf[s4] = qn[s4];
        __syncthreads();
        const int un = u + F.G; const bool has_next = un < NU;
        if (has_next) { attn_decode(F, ch, un, NUA, lane, nxt); attn_load(nxt, tid, lane, kreg, vreg, qn); }
        if (cur.kk_lo == 0) attn_compute(cur, KL, VL, lane, qf); else attn_compute_edge(cur, KL, VL, lane, qf);
        __syncthreads();
        if (!has_next) break;
        cur = nxt; u = un;
    }
}
__device__ __forceinline__ void p2_combine(Frame& F, int ch, int cu, int ncu) {
    int tid_ = threadIdx.x; asm volatile("" : "+v"(tid_)); const int lane_ = tid_ & 63;
    unsigned char* ws = F.ws;
    const bf16* OG = (const bf16*)((const unsigned char*)F.out + DO_OG); const float* LSE = (const float*)((const unsigned char*)F.out + DO_LSE);
    bf16* Y = (bf16*)(ws + WS_Y) + (size_t)ch * TC * Y_W; unsigned char* Y8 = ws + WS_Y + (size_t)ch * TC * Y_W;
    const int lane = lane_, hd = lane >> 3;
    const int gw = cu * NWAVES + F.wave, NGW = ncu * NWAVES;
    for (int row0 = gw; row0 < TC; row0 += 4 * NGW) {
        float lg[4][3]; v4u og[4][3];
#pragma unroll
        for (int r = 0; r < 4; ++r) { const int row = row0 + r * NGW < TC ? row0 + r * NGW : row0;
#pragma unroll
            for (int g = 0; g < 3; ++g) { lg[r][g] = LSE[((size_t)g * TC + row) * 8 + hd]; og[r][g] = *(const GAS v4u*)(OG + ((size_t)g * TC + row) * 512 + lane * 8); } }
#pragma unroll
        for (int r = 0; r < 4; ++r) { const int row = row0 + r * NGW; if (row >= TC) continue;
            const float mx = fmaxf(fmaxf(lg[r][0], lg[r][1]), lg[r][2]);
            float e[3]; e[0] = __builtin_amdgcn_exp2f(lg[r][0] - mx); e[1] = __builtin_amdgcn_exp2f(lg[r][1] - mx); e[2] = __builtin_amdgcn_exp2f(lg[r][2] - mx);
            const float inv = 1.0f / (e[0] + e[1] + e[2]);
            float acc[8];
#pragma unroll
            for (int i = 0; i < 8; ++i) acc[i] = 0.f;
#pragma unroll
            for (int g = 0; g < 3; ++g) { const float wg = e[g] * inv; const v4u o_ = og[r][g];
                acc[0] += wg * bflo(o_.x); acc[1] += wg * bfhi(o_.x); acc[2] += wg * bflo(o_.y); acc[3] += wg * bfhi(o_.y);
                acc[4] += wg * bflo(o_.z); acc[5] += wg * bfhi(o_.z); acc[6] += wg * bflo(o_.w); acc[7] += wg * bfhi(o_.w); }
            v4u o; o.x = cvtpk(acc[0], acc[1]); o.y = cvtpk(acc[2], acc[3]); o.z = cvtpk(acc[4], acc[5]); o.w = cvtpk(acc[6], acc[7]);
            if (P34_FP8) { v2u o8; o8.x = pk4_fp8(acc[0] * Y8_SCALE, acc[1] * Y8_SCALE, acc[2] * Y8_SCALE, acc[3] * Y8_SCALE); o8.y = pk4_fp8(acc[4] * Y8_SCALE, acc[5] * Y8_SCALE, acc[6] * Y8_SCALE, acc[7] * Y8_SCALE); *(GAS v2u*)(Y8 + (size_t)row * Y_W + lane * 8) = o8; }
            else *(GAS v4u*)(Y + (size_t)row * Y_W + lane * 8) = o; }
    }
}


struct EpiMerge {
    static constexpr bool PERM = true; static constexpr int HOOK_T = P34_FP8 ? 4 : 8;
    const bf16* Gt; bf16* MG;
    __device__ __forceinline__ void hook(f32x4 (&acc)[2][2][4][2], const pg9::Unit& u, int wr, int wc, int fr, int fq) const {
        asm volatile("" : "+v"(fr), "+v"(fq));
        const bf16* gr = Gt + (size_t)(u.pm * 256 + wr * 64 + fr) * G_W + u.pn * 256 + wc * 32 + 8 * fq;
        v4u rv[8][2];
#pragma unroll
        for (int rg = 0; rg < 8; ++rg)
#pragma unroll
            for (int bj = 0; bj < 2; ++bj) rv[rg][bj] = *(const GAS v4u*)(gr + (size_t)((rg >> 2) * 128 + (rg & 3) * 16) * G_W + bj * 128);
#pragma unroll
        for (int rg = 0; rg < 8; ++rg)
#pragma unroll
            for (int bj = 0; bj < 2; ++bj) { const v4u a = rv[rg][bj];
                const f32x4 r0 = {bflo(a.x), bfhi(a.x), bflo(a.y), bfhi(a.y)}, r1 = {bflo(a.z), bfhi(a.z), bflo(a.w), bfhi(a.w)};
                acc[rg >> 2][bj][rg & 3][0] = acc[rg >> 2][bj][rg & 3][0] * r0; acc[rg >> 2][bj][rg & 3][1] = acc[rg >> 2][bj][rg & 3][1] * r1; }
    }
    __device__ __forceinline__ void operator()(const f32x4 (&acc)[2][2][4][2], const pg9::Unit& u, int wr, int wc, int fr, int fq) const {
        asm volatile("" : "+v"(fr), "+v"(fq));
        const bf16* gr = Gt + (size_t)(u.pm * 256 + wr * 64 + fr) * G_W + 1024 + u.pn * 256 + wc * 32 + 8 * fq;
        bf16* mr = MG + (size_t)(u.pm * 256 + wr * 64 + fr) * D + u.pn * 256 + wc * 32 + 8 * fq;
        v4u gb[8][2];
#pragma unroll
        for (int rg = 0; rg < 8; ++rg)
#pragma unroll
            for (int bj = 0; bj < 2; ++bj) gb[rg][bj] = *(const GAS v4u*)(gr + (size_t)((rg >> 2) * 128 + (rg & 3) * 16) * G_W + bj * 128);
#pragma unroll
        for (int rg = 0; rg < 8; ++rg)
#pragma unroll
            for (int bj = 0; bj < 2; ++bj) { const v4u b = gb[rg][bj];
                const f32x4 v0 = acc[rg >> 2][bj][rg & 3][0], v1 = acc[rg >> 2][bj][rg & 3][1];
                if (P34_FP8) { constexpr float f = MG8_SCALE / (W34_SCALE * Y8_SCALE); unsigned char* m8 = (unsigned char*)MG + (size_t)(u.pm * 256 + wr * 64 + fr) * D + u.pn * 256 + wc * 32 + 8 * fq;
                    v2u w8; w8.x = pk4_fp8(v0[0] * bflo(b.x) * f, v0[1] * bfhi(b.x) * f, v0[2] * bflo(b.y) * f, v0[3] * bfhi(b.y) * f); w8.y = pk4_fp8(v1[0] * bflo(b.z) * f, v1[1] * bfhi(b.z) * f, v1[2] * bflo(b.w) * f, v1[3] * bfhi(b.w) * f);
                    *(GAS v2u*)(m8 + (size_t)((rg >> 2) * 128 + (rg & 3) * 16) * D + bj * 128) = w8; }
                else {
                v4u w; w.x = cvtpk(v0[0] * bflo(b.x), v0[1] * bfhi(b.x)); w.y = cvtpk(v0[2] * bflo(b.y), v0[3] * bfhi(b.y));
                w.z = cvtpk(v1[0] * bflo(b.z), v1[1] * bfhi(b.z)); w.w = cvtpk(v1[2] * bflo(b.w), v1[3] * bfhi(b.w));
                *(GAS v4u*)(mr + (size_t)((rg >> 2) * 128 + (rg & 3) * 16) * D + bj * 128) = w; } }
    }
};
__device__ __forceinline__ void p3_merge(Frame& F) {
    unsigned char* ws = F.ws;
    pg9::DenseOrder S; S.init(T, D, F.G, (int)blockIdx.x);
    EpiMerge E{(const bf16*)(ws + WS_G), (bf16*)(ws + WS_MG)};
    constexpr int ES = P34_FP8 ? 1 : 2;
    pg9::DenseA ao{(unsigned)(Y_W * ES)}; pg9::DenseB bb{(const char*)(ws + WS_WAB), (size_t)256 * Y_W * ES};
    pg9::gemm_phase<ES>(F.lds, (const char*)(ws + WS_Y), Y_W, S, E, ao, bb);
}
struct EpiOut {
    static constexpr bool PERM = true; static constexpr int HOOK_T = -1;
    bf16* DELTA;
    __device__ __forceinline__ void hook(f32x4 (&)[2][2][4][2], const pg9::Unit&, int, int, int, int) const {}
    __device__ __forceinline__ void operator()(const f32x4 (&acc)[2][2][4][2], const pg9::Unit& u, int wr, int wc, int fr, int fq) const {
        asm volatile("" : "+v"(fr), "+v"(fq));
        bf16* orow = DELTA + (size_t)(u.pm * 256 + wr * 64 + fr) * D + u.pn * 256 + wc * 32 + 8 * fq;
#pragma unroll
        for (int ai = 0; ai < 2; ++ai)
#pragma unroll
            for (int m = 0; m < 4; ++m)
#pragma unroll
                for (int bj = 0; bj < 2; ++bj) { constexpr float f = P34_FP8 ? 1.0f / (W34_SCALE * MG8_SCALE) : 1.0f; const f32x4 o0 = acc[ai][bj][m][0] * f, o1 = acc[ai][bj][m][1] * f;
                    v4u w; w.x = cvtpk(o0[0], o0[1]); w.y = cvtpk(o0[2], o0[3]); w.z = cvtpk(o1[0], o1[1]); w.w = cvtpk(o1[2], o1[3]); *(GAS v4u*)(orow + (size_t)(ai * 128 + m * 16) * D + bj * 128) = w; }
    }
};
__device__ __forceinline__ void p4_outproj(Frame& F) {
    unsigned char* ws = F.ws;
    pg9::DenseOrder S; S.init(T, D, F.G, (int)blockIdx.x);
    EpiOut E{(bf16*)((unsigned char*)F.out + DO_DELTA)};
    constexpr int ES = P34_FP8 ? 1 : 2;
    pg9::DenseA ao{(unsigned)(D * ES)}; pg9::DenseB bb{(const char*)(ws + WS_WO), (size_t)256 * D * ES};
    pg9::gemm_phase<ES>(F.lds, (const char*)(ws + WS_MG), D, S, E, ao, bb);
}

__device__ __forceinline__ void p5_route(Frame& F) {
    int tid_ = threadIdx.x; asm volatile("" : "+v"(tid_)); const int lane = tid_ & 63;
    unsigned char* ws = F.ws;
    const float* X = F.in[I_X]; const bf16* DELTA = (const bf16*)((const unsigned char*)F.out + DO_DELTA);
    bf16* X1B = (bf16*)(ws + WS_X1B); unsigned char* X1F8 = ws + WS_X1F8;
    unsigned* cnt = (unsigned*)(ws + WS_CTL) + CW_CNT;
    int* tokof = (int*)(ws + WS_TOKOF); float2* wtof = (float2*)(ws + WS_WTOF); int4* tpos = (int4*)(ws + WS_TPOS);
    const v4u* WRF = (const v4u*)(ws + WS_WRF);
    LAS v4u* wl = (LAS v4u*)F.lds;
    LAS float* sl = (LAS float*)(F.lds + 98304 + F.wave * 4096);
    const int i = lane & 15, q = lane >> 4;
    LAS unsigned* hist = (LAS unsigned*)(F.lds + LDS_MISC + 2048);
    for (int wt = F.vcu; wt < T / 128; wt += F.G) {
        const int tile = wt * NWAVES + F.wave;
        if (tid_ < 32) hist[tid_] = 0u;
        const size_t roff = (size_t)(tile * 16 + i) * D + 8 * q;
        const float* xr = X + roff; const bf16* dr = DELTA + roff;
        f32x4 a0 = {0.f, 0.f, 0.f, 0.f}, a1 = a0, a2 = a0; float ss = 0.f;
        f32x4 va[8][2]; v4u vd[8];
#pragma unroll
        for (int j = 0; j < 8; ++j) { va[j][0] = *(const GAS f32x4*)(xr + 32 * j); va[j][1] = *(const GAS f32x4*)(xr + 32 * j + 4); vd[j] = *(const GAS v4u*)(dr + 32 * j); }
#pragma unroll 1
        for (int half = 0; half < 2; ++half) {
            __syncthreads();
            { v4u t[12];
#pragma unroll
              for (int k = 0; k < 12; ++k) t[k] = WRF[half * 6144 + k * 512 + tid_];
#pragma unroll
              for (int k = 0; k < 12; ++k) wl[k * 512 + tid_] = t[k]; }
            __syncthreads();
#pragma unroll 1
            for (int sb = 0; sb < 2; ++sb) {
#pragma unroll
                for (int j = 0; j < 8; ++j) {
                    const int ksl = sb * 8 + j, ks = half * 16 + ksl;
                    const v4u dd = vd[j];
                    const f32x4 v0 = va[j][0] + (f32x4){bflo(dd.x), bfhi(dd.x), bflo(dd.y), bfhi(dd.y)}, v1 = va[j][1] + (f32x4){bflo(dd.z), bfhi(dd.z), bflo(dd.w), bfhi(dd.w)};
                    if (ks + 8 < 32) { va[j][0] = *(const GAS f32x4*)(xr + 32 * (ks + 8)); va[j][1] = *(const GAS f32x4*)(xr + 32 * (ks + 8) + 4); vd[j] = *(const GAS v4u*)(dr + 32 * (ks + 8)); }
                    ss += ((v0[0] * v0[0] + v0[1] * v0[1]) + (v0[2] * v0[2] + v0[3] * v0[3])) + ((v1[0] * v1[0] + v1[1] * v1[1]) + (v1[2] * v1[2] + v1[3] * v1[3]));
                    v4u hu; hu.x = cvtpk(v0[0], v0[1]); hu.y = cvtpk(v0[2], v0[3]); hu.z = cvtpk(v1[0], v1[1]); hu.w = cvtpk(v1[2], v1[3]);
                    v4u lu; lu.x = cvtpk(v0[0] - bflo(hu.x), v0[1] - bfhi(hu.x)); lu.y = cvtpk(v0[2] - bflo(hu.y), v0[3] - bfhi(hu.y)); lu.z = cvtpk(v1[0] - bflo(hu.z), v1[1] - bfhi(hu.z)); lu.w = cvtpk(v1[2] - bflo(hu.w), v1[3] - bfhi(hu.w));
                    *(GAS v4u*)(X1B + roff + 32 * ks) = hu;
                    if (P6_FP8) { v2u w8; w8.x = pk4_fp8(v0[0], v0[1], v0[2], v0[3]); w8.y = pk4_fp8(v1[0], v1[1], v1[2], v1[3]); *(GAS v2u*)(X1F8 + roff + 32 * ks) = w8; }
                    const bf16x8 ah = __builtin_bit_cast(bf16x8, hu), al = __builtin_bit_cast(bf16x8, lu);
#pragma unroll
                    for (int nb = 0; nb < 3; ++nb) {
                        const bf16x8 bh = __builtin_bit_cast(bf16x8, wl[((ksl * 3 + nb) * 2 + 0) * 64 + lane]), bl = __builtin_bit_cast(bf16x8, wl[((ksl * 3 + nb) * 2 + 1) * 64 + lane]);
                        f32x4 acc = nb == 0 ? a0 : (nb == 1 ? a1 : a2);
                        acc = __builtin_amdgcn_mfma_f32_16x16x32_bf16(ah, bh, acc, 0, 0, 0); acc = __builtin_amdgcn_mfma_f32_16x16x32_bf16(ah, bl, acc, 0, 0, 0); acc = __builtin_amdgcn_mfma_f32_16x16x32_bf16(al, bh, acc, 0, 0, 0);
                        if (nb == 0) a0 = acc; else if (nb == 1) a1 = acc; else a2 = acc;
                    }
                }
            }
        }
        ss += __shfl_xor(ss, 16); ss += __shfl_xor(ss, 32);
#pragma unroll
        for (int r = 0; r < 4; ++r) { sl[(4 * q + r) * 48 + i] = a0[r]; sl[(4 * q + r) * 48 + 16 + i] = a1[r]; sl[(4 * q + r) * 48 + 32 + i] = a2[r]; }
        LDS_WAIT(); asm volatile("" ::: "memory");
        int e0 = 0, e1 = 0, lp0 = 0, lp1 = 0; float w1 = 0.f, w2 = 0.f, rstd = 0.f;
        __syncthreads();
        if (lane < 16) {
            rstd = 1.0f / sqrtf(ss * (1.f / D) + RMS_EPS);
            float lg[36];
#pragma unroll
            for (int o = 0; o < 36; ++o) lg[o] = sl[lane * 48 + o] * rstd + (o < 4 ? F.in[I_BRG][o] : F.in[I_BRE][o - 4]);
            int gsel = 0; float gmax = lg[0];
#pragma unroll
            for (int k = 1; k < 4; ++k) if (lg[k] > gmax) { gmax = lg[k]; gsel = k; }
            float gden = 0.f;
#pragma unroll
            for (int k = 0; k < 4; ++k) gden += __expf(lg[k] - gmax);
            const float pg = 1.0f / gden;
            float le[8];
#pragma unroll
            for (int j = 0; j < 8; ++j) { le[j] = lg[4 + j];
#pragma unroll
                for (int gi = 1; gi < 4; ++gi) le[j] = (gsel == gi) ? lg[4 + gi * 8 + j] : le[j]; }
            int i1 = 0; float m1 = le[0];
#pragma unroll
            for (int j = 1; j < 8; ++j) if (le[j] > m1) { m1 = le[j]; i1 = j; }
            int i2 = -1; float m2 = -INFINITY;
#pragma unroll
            for (int j = 0; j < 8; ++j) if (j != i1 && le[j] > m2) { m2 = le[j]; i2 = j; }
            const float e2 = __expf(m2 - m1);
            w1 = pg / (1.0f + e2); w2 = pg * e2 / (1.0f + e2);
            e0 = gsel * 8 + i1; e1 = gsel * 8 + i2;
            lp0 = (int)__hip_atomic_fetch_add(&hist[e0], 1u, __ATOMIC_RELAXED, __HIP_MEMORY_SCOPE_WORKGROUP);
            lp1 = (int)__hip_atomic_fetch_add(&hist[e1], 1u, __ATOMIC_RELAXED, __HIP_MEMORY_SCOPE_WORKGROUP);
        }
        __syncthreads();
        if (tid_ < 32) { const unsigned n = hist[tid_]; hist[32 + tid_] = n ? atomicAdd(&cnt[64 * tid_], n) : 0u; }
        __syncthreads();
        if (lane < 16) {
            const int row = tile * 16 + lane;
            const int p0 = (int)hist[32 + e0] + lp0, p1 = (int)hist[32 + e1] + lp1;
            tokof[(size_t)e0 * T + p0] = row; wtof[(size_t)e0 * T + p0] = make_float2(w1, rstd);
            tokof[(size_t)e1 * T + p1] = row; wtof[(size_t)e1 * T + p1] = make_float2(w2, rstd);
            tpos[row] = make_int4(e0, p0, e1, p1);
        }
        __syncthreads();
    }
}

__device__ __forceinline__ void expert_tiles(Frame& F, LAS int* tb, LAS int* cn) {
    int tid_ = threadIdx.x; asm volatile("" : "+v"(tid_)); const int lane_ = tid_ & 63;
    if (tid_ == 0) {
        const unsigned* cnt = (const unsigned*)(F.ws + WS_CTL) + CW_CNT;
        int acc = 0;
        for (int e = 0; e < NE; ++e) { const int c = (int)__hip_atomic_load(cnt + 64 * e, __ATOMIC_RELAXED, __HIP_MEMORY_SCOPE_AGENT); cn[e] = c; tb[e] = acc; acc += (c + 255) >> 8; }
        tb[NE] = acc;
    }
    __syncthreads();
}

struct MoeOrder { const LAS int* tb; int ncol, G, c;
    __device__ bool next(int i, pg9::Unit& u) const {
        const int L = i * G + c; if (L >= tb[NE] * ncol) return false;
        const int rt = L / ncol; int e = 0;
        for (int k = 1; k < NE; ++k) if (tb[k] <= rt) e = k;
        u.pm = rt; u.pn = L % ncol; u.e = e; return true; } };
struct GatherA { static constexpr bool GATHER = true; unsigned rowbytes; const int* tokof; const LAS int* tb; const LAS int* cn;
    __device__ __forceinline__ unsigned operator()(const pg9::Unit& u, int row) const {
        const int p = (u.pm - tb[u.e]) * 256 + row; const int tok = tokof[(size_t)u.e * T + (p < cn[u.e] ? p : 0)]; return (unsigned)tok * rowbytes; } };
struct ExpertB { const char* W; size_t ebytes, tilebytes; __device__ __forceinline__ const char* operator()(const pg9::Unit& u) const { return W + (size_t)u.e * ebytes + (size_t)u.pn * tilebytes; } };
struct EpiGateUp {
    static constexpr bool PERM = true; static constexpr int HOOK_T = -1;
    const float2* wtof; bf16* HACT; const LAS int* tb; const LAS int* cn; float ascale;
    __device__ __forceinline__ void hook(f32x4 (&)[2][2][4][2], const pg9::Unit&, int, int, int, int) const {}
    __device__ __forceinline__ void operator()(const f32x4 (&acc)[2][2][4][2], const pg9::Unit& u, int wr, int wc, int fr, int fq) const {
        asm volatile("" : "+v"(fr), "+v"(fq));
        const int r0 = wr * 64 + fr, p0 = (u.pm - tb[u.e]) * 256, ce = cn[u.e];
        const float2* wp = wtof + (size_t)u.e * T;
#pragma unroll
        for (int ai = 0; ai < 2; ++ai) {
            float2 wv[4];
#pragma unroll
            for (int m = 0; m < 4; ++m) { const int p = p0 + r0 + ai * 128 + m * 16; wv[m] = p < ce ? wp[p] : make_float2(0.f, 0.f); }
#pragma unroll
            for (int m = 0; m < 4; ++m) { const int r = r0 + ai * 128 + m * 16;
                const float w = wv[m].x, rs = wv[m].y * ascale;
                bf16* orow = HACT + (size_t)(u.pm * 256 + r) * DE + u.pn * 128 + wc * 16 + 4 * fq; unsigned char* orow8 = (unsigned char*)HACT + (size_t)(u.pm * 256 + r) * DE + u.pn * 128 + wc * 16 + 4 * fq;
#pragma unroll
                for (int bj = 0; bj < 2; ++bj) { const f32x4 g = acc[ai][bj][m][0], uu = acc[ai][bj][m][1]; f32x4 hv;
#pragma unroll
                    for (int e = 0; e < 4; ++e) { const float gg = g[e] * rs; hv[e] = gg / (1.0f + __expf(-gg)) * (uu[e] * rs) * w; }
                    if (P6_FP8) *(GAS unsigned*)(orow8 + bj * 64) = pk4_fp8(hv[0] * H8_SCALE, hv[1] * H8_SCALE, hv[2] * H8_SCALE, hv[3] * H8_SCALE);
                    else { v2u o; o.x = cvtpk(hv[0], hv[1]); o.y = cvtpk(hv[2], hv[3]); *(GAS v2u*)(orow + bj * 64) = o; } } }
        }
    }
};
__device__ __forceinline__ void p6a_gateup(Frame& F) {
    unsigned char* ws = F.ws;
    LAS int* tb = (LAS int*)(F.lds + LDS_MISC + 1024); LAS int* cn = tb + 64;
    expert_tiles(F, tb, cn);
    MoeOrder S{tb, 2, F.G, F.vcu};
    constexpr int ES = P6_FP8 ? 1 : 2;
    GatherA ao{(unsigned)(D * ES), (const int*)(ws + WS_TOKOF), tb, cn}; ExpertB bb{(const char*)(ws + WS_WGU), (size_t)512 * D * ES, (size_t)256 * D * ES};
    EpiGateUp E{(const float2*)(ws + WS_WTOF), (bf16*)(ws + WS_HACT), tb, cn, P6_FP8 ? 1.0f / WG8_SCALE : 1.0f};
    pg9::gemm_phase<ES>(F.lds, (const char*)(ws + (P6_FP8 ? WS_X1F8 : WS_X1B)), D, S, E, ao, bb);
}
struct EpiDown {
    static constexpr bool PERM = true; static constexpr int HOOK_T = -1;
    bf16* YS; float ascale;
    __device__ __forceinline__ void hook(f32x4 (&)[2][2][4][2], const pg9::Unit&, int, int, int, int) const {}
    __device__ __forceinline__ void operator()(const f32x4 (&acc)[2][2][4][2], const pg9::Unit& u, int wr, int wc, int fr, int fq) const {
        asm volatile("" : "+v"(fr), "+v"(fq));
#pragma unroll
        for (int ai = 0; ai < 2; ++ai)
#pragma unroll
            for (int m = 0; m < 4; ++m) { bf16* orow = YS + (size_t)(u.pm * 256 + wr * 64 + fr + ai * 128 + m * 16) * D + u.pn * 256 + wc * 32 + 8 * fq;
#pragma unroll
                for (int bj = 0; bj < 2; ++bj) { const f32x4 v0 = acc[ai][bj][m][0] * ascale, v1 = acc[ai][bj][m][1] * ascale;
                    v4u w; w.x = cvtpk(v0[0], v0[1]); w.y = cvtpk(v0[2], v0[3]); w.z = cvtpk(v1[0], v1[1]); w.w = cvtpk(v1[2], v1[3]); *(GAS v4u*)(orow + bj * 128) = w; } }
    }
};
__device__ __forceinline__ void p6b_down(Frame& F) {
    unsigned char* ws = F.ws;
    LAS int* tb = (LAS int*)(F.lds + LDS_MISC + 1024); LAS int* cn = tb + 64;
    expert_tiles(F, tb, cn);
    MoeOrder S{tb, 4, F.G, F.vcu};
    constexpr int ES = P6_FP8 ? 1 : 2;
    pg9::DenseA ao{(unsigned)(DE * ES)}; ExpertB bb{(const char*)(ws + WS_WD), (size_t)D * DE * ES, (size_t)256 * DE * ES};
    EpiDown E{(bf16*)(ws + WS_YS), P6_FP8 ? 1.0f / (WD8_SCALE * H8_SCALE) : 1.0f};
    pg9::gemm_phase<ES>(F.lds, (const char*)(ws + WS_HACT), DE, S, E, ao, bb);
}
__device__ __forceinline__ void p7_final(Frame& F) {
    int tid_ = threadIdx.x; asm volatile("" : "+v"(tid_)); const int lane_ = tid_ & 63;
    unsigned char* ws = F.ws;
    LAS int* tb = (LAS int*)(F.lds + LDS_MISC + 1024); LAS int* cn = tb + 64;
    expert_tiles(F, tb, cn);
    const bf16* YS = (const bf16*)(ws + WS_YS); const int4* tpos = (const int4*)(ws + WS_TPOS);
    float* X1 = F.out; const bf16* X1B = (const bf16*)(ws + WS_X1B);
    const int lane = lane_;
    const int gw = F.vcu * NWAVES + F.wave, NGW = F.G * NWAVES;
    const GAS f32x4* gr = (const GAS f32x4*)F.in[I_GFIN] + lane;
    for (int row = gw; row < T; row += NGW) {
        const int4 tp = tpos[row];
        const size_t s0 = (size_t)tb[tp.x] * 256 + tp.y, s1 = (size_t)tb[tp.z] * 256 + tp.w;
        GAS f32x4* xr = (GAS f32x4*)(X1 + (size_t)row * D) + lane; const GAS v2u* xb = (const GAS v2u*)(X1B + (size_t)row * D) + lane;
        const GAS v2u* y0 = (const GAS v2u*)(YS + s0 * D) + lane; const GAS v2u* y1 = (const GAS v2u*)(YS + s1 * D) + lane;
        f32x4 v[4]; float s = 0.f;
#pragma unroll
        for (int j = 0; j < 4; ++j) { const v2u xx = xb[64 * j]; v[j] = (f32x4){bflo(xx.x), bfhi(xx.x), bflo(xx.y), bfhi(xx.y)}; const v2u a = y0[64 * j], b = y1[64 * j];
            v[j].x += bflo(a.x) + bflo(b.x); v[j].y += bfhi(a.x) + bfhi(b.x); v[j].z += bflo(a.y) + bflo(b.y); v[j].w += bfhi(a.y) + bfhi(b.y);
            s += (v[j].x * v[j].x + v[j].y * v[j].y) + (v[j].z * v[j].z + v[j].w * v[j].w); }
        const float rstd = 1.0f / sqrtf(wave_sum(s) * (1.f / D) + RMS_EPS);
#pragma unroll
        for (int j = 0; j < 4; ++j) { const f32x4 gg = gr[64 * j]; f32x4 o; o.x = v[j].x * rstd * gg.x; o.y = v[j].y * rstd * gg.y; o.z = v[j].z * rstd * gg.z; o.w = v[j].w * rstd * gg.w; xr[64 * j] = o; }
    }
}

constexpr int NPHASE = 2 * NCH + 8;
__global__ void __launch_bounds__(NTHR, 2) fwd_kernel(KArgs args) {
    extern __shared__ __attribute__((aligned(16))) unsigned char lds_raw[];
    Frame F;
    F.lds = (LAS unsigned char*)lds_raw;
    F.tid = threadIdx.x; F.lane = F.tid & 63; F.wave = __builtin_amdgcn_readfirstlane(F.tid >> 6);
    F.G = gridDim.x; { const int bx = blockIdx.x; F.vcu = (F.G % 8 == 0) ? (bx % 8) * (F.G / 8) + bx / 8 : bx; }
#pragma unroll
    for (int i = 0; i < 17; ++i) F.in[i] = args.in[i];
    F.out = args.out; F.ws = args.ws;
    volatile LAS unsigned* MISC = (volatile LAS unsigned*)(F.lds + LDS_MISC);
    if (F.tid < 64) MISC[F.tid] = 0u;
    __syncthreads();
    XcdBarrier bar = xcd_barrier_post((unsigned*)(F.ws + WS_CTL) + CW_BAR + args.li * XCD_BAR_WORDS, MISC + 8);
#define IN(k) (args.ph_lo <= (k) && (k) < args.ph_hi)
#ifdef PROBE_MASK
    unsigned long long pr_acc = 0, pr_t0 = 0; const bool pr_me = (blockIdx.x == 0 && threadIdx.x == 0);
#define PR_BEGIN(k) do { if (pr_me && ((PROBE_MASK >> (k)) & 1ull)) pr_t0 = __builtin_amdgcn_s_memrealtime(); } while (0)
#define PR_END(k) do { if (pr_me && ((PROBE_MASK >> (k)) & 1ull)) pr_acc += __builtin_amdgcn_s_memrealtime() - pr_t0; } while (0)
#else
#define PR_BEGIN(k) do {} while (0)
#define PR_END(k) do {} while (0)
#endif
#define SEAM(k) do { if (IN(k) && IN((k) + 1)) xcd_barrier(bar); PR_END(k); } while (0)
    PR_BEGIN(0); if (IN(0)) p0_prologue(F);
    SEAM(0);
#pragma unroll 1
    for (int ch = 0; ch < NCH; ++ch) {
        PR_BEGIN(1 + 2 * ch);
        if (IN(1 + 2 * ch)) {
            constexpr int NWG1 = (TC / 256) * (NIN / 256);
            const int nfull = NWG1 % F.G, bx = (int)blockIdx.x;
            if (ch > 0 && nfull == 0) p2_combine(F, ch - 1, F.vcu, F.G);
            p1_inproj(F, ch);
            if (ch > 0 && nfull != 0 && bx >= nfull) p2_combine(F, ch - 1, bx - nfull, F.G - nfull);
        }
        SEAM(1 + 2 * ch);
        PR_BEGIN(2 + 2 * ch); if (IN(2 + 2 * ch)) p2_attn(F, ch);
        SEAM(2 + 2 * ch);
    }
    PR_BEGIN(2 * NCH + 1); if (IN(2 * NCH + 1)) p2_combine(F, NCH - 1, F.vcu, F.G);
    SEAM(2 * NCH + 1);
    PR_BEGIN(2 * NCH + 2); if (IN(2 * NCH + 2)) p3_merge(F);
    SEAM(2 * NCH + 2);
    PR_BEGIN(2 * NCH + 3); if (IN(2 * NCH + 3)) p4_outproj(F);
    SEAM(2 * NCH + 3);
    PR_BEGIN(2 * NCH + 4); if (IN(2 * NCH + 4)) p5_route(F);
    SEAM(2 * NCH + 4);
    PR_BEGIN(2 * NCH + 5); if (IN(2 * NCH + 5)) p6a_gateup(F);
    SEAM(2 * NCH + 5);
    PR_BEGIN(2 * NCH + 6); if (IN(2 * NCH + 6)) p6b_down(F);
    SEAM(2 * NCH + 6);
    PR_BEGIN(2 * NCH + 7); if (IN(2 * NCH + 7)) p7_final(F);
    PR_END(2 * NCH + 7);
#ifdef PROBE_MASK
    if (pr_me) { const unsigned long long t1 = __builtin_amdgcn_s_memrealtime(); while (__builtin_amdgcn_s_memrealtime() - t1 < pr_acc) __builtin_amdgcn_s_sleep(4); }
#endif
#undef IN
#undef SEAM
}

#ifndef N_LAUNCHES
#define N_LAUNCHES 1
#endif
extern "C" void kernel_launch(void* const* d_in, const int* in_sizes, int n_in, void* d_out, int out_size, void* d_ws, size_t ws_size, hipStream_t stream) {
    static int grid = 0;
    if (grid == 0) {
        if (n_in != 17 || in_sizes[0] != T * D || out_size != T * D || ws_size < WS_END) { fprintf(stderr, "kernel_launch: unexpected shapes / workspace (%d inputs, ws %zu)\n", n_in, ws_size); grid = -1; return; }
        int dev = 0, cus = 0;
        if (hipGetDevice(&dev) != hipSuccess || hipDeviceGetAttribute(&cus, hipDeviceAttributeMultiprocessorCount, dev) != hipSuccess) { grid = -1; return; }
        if (hipFuncSetAttribute((const void*)fwd_kernel, hipFuncAttributeMaxDynamicSharedMemorySize, LDS_BYTES) != hipSuccess) { fprintf(stderr, "kernel_launch: hipFuncSetAttribute failed\n"); grid = -1; return; }
        int per_cu = 0;
        if (hipOccupancyMaxActiveBlocksPerMultiprocessor(&per_cu, (const void*)fwd_kernel, NTHR, LDS_BYTES) != hipSuccess || per_cu < 1) fprintf(stderr, "kernel_launch: occupancy query says %d\n", per_cu);
        (void)hipGetLastError();
        grid = cus;
    }
    if (grid < 0) return;
    (void)hipMemsetAsync((char*)d_ws + WS_CTL, 0, N_LAUNCHES == 1 ? (size_t)(CW_BAR + XCD_BAR_WORDS) * 4 : CTL_BYTES, stream);
    KArgs a{};
    for (int i = 0; i < 17; ++i) a.in[i] = (const float*)d_in[i];
    a.out = (float*)d_out; a.ws = (unsigned char*)d_ws;
    for (int li = 0; li < N_LAUNCHES; ++li) {
        a.ph_lo = (int)((long)NPHASE * li / N_LAUNCHES); a.ph_hi = (int)((long)NPHASE * (li + 1) / N_LAUNCHES); a.li = li;
        hipLaunchKernelGGL(fwd_kernel, dim3(grid), dim3(NTHR), LDS_BYTES, stream, a);
    }
}
```

```cpp
#include <hip/hip_runtime.h>
#include <cstdint>
#include <cstdio>

#define GAS __attribute__((address_space(1)))
#define LAS __attribute__((address_space(3)))
typedef unsigned short bf16;
typedef short bf16x8 __attribute__((ext_vector_type(8)));
typedef float f32x4 __attribute__((ext_vector_type(4)));
typedef unsigned v4u __attribute__((ext_vector_type(4)));
typedef unsigned v2u __attribute__((ext_vector_type(2)));
typedef GAS unsigned gu32;

constexpr int T = 32768, D = 1024, SEQ = 4096, NIN = 7936;
constexpr int A_W = 4608, B_W = 1280, G_W = 2048, Y_W = 1536;
constexpr int NE = 32, DE = 256;
constexpr int NCH = 4, TC = T / NCH;
constexpr float QSCALE = 0.125f * 1.4426950408889634f;
constexpr float LOG2E = 1.4426950408889634f;
constexpr float RMS_EPS = 1e-6f;
#ifndef P1_FP8
#define P1_FP8 1
#endif
constexpr float W8_SCALE = P1_FP8 ? 64.0f : 0.0f, W8_INV = P1_FP8 ? 1.0f / 64.0f : 1.0f;
#ifndef P6_FP8
#define P6_FP8 1
#endif
#ifndef P34_FP8
#define P34_FP8 1
#endif
constexpr float Y8_SCALE = 16.0f, W34_SCALE = 64.0f, MG8_SCALE = 32.0f;
#ifndef YS_FP8
#define YS_FP8 1
#endif
constexpr float YS8_SCALE = 16.0f;
constexpr float WG8_SCALE = P6_FP8 ? 64.0f : 0.0f, WD8_SCALE = P6_FP8 ? 32.0f : 0.0f, H8_SCALE = 32.0f;
constexpr int NWAVES = 8, NTHR = 512;

constexpr size_t MiB = 1u << 20;
constexpr size_t WS_CTL = 0, CTL_BYTES = 1 * MiB;
constexpr size_t WS_INVF = 1 * MiB;
constexpr size_t WS_WRF = 2 * MiB;
constexpr size_t WS_TOKOF = 3 * MiB;
constexpr size_t WS_WTOF = 7 * MiB;
constexpr size_t WS_TPOS = 15 * MiB;
constexpr size_t WS_WIN = 16 * MiB;
constexpr size_t WS_WAB = 32 * MiB;
constexpr size_t WS_WO = 35 * MiB;
constexpr size_t WS_WGU = 37 * MiB;
constexpr size_t WS_WD = 69 * MiB;
constexpr size_t WS_G = 86 * MiB;
constexpr size_t WS_Y = 214 * MiB;
constexpr size_t WS_ZA = 310 * MiB;
constexpr size_t WS_ZB = 454 * MiB;
constexpr size_t WS_END = 494 * MiB;
constexpr size_t WS_MG = WS_ZA;
constexpr size_t WS_X1B = WS_ZA + 64 * MiB;
constexpr size_t WS_X1F8 = WS_Y + 64 * MiB;
constexpr size_t WS_HACT = WS_G;
constexpr size_t WS_YS = WS_G + 36 * MiB;
constexpr size_t DO_DELTA = 0;
constexpr size_t DO_HN = 0;
constexpr size_t DO_OG = 64 * MiB;
constexpr size_t DO_LSE = 112 * MiB;
constexpr int MAXSLOT = 2 * T + NE * 256;
static_assert(WS_ZA + (size_t)TC * A_W * 2 <= WS_ZB && WS_ZB + (size_t)TC * B_W * 2 <= WS_END && WS_Y + (size_t)T * Y_W * 2 <= WS_ZA && WS_G + (size_t)T * G_W * 2 <= WS_Y, "ws map");
static_assert(WS_MG + (size_t)T * D * 2 <= WS_END && WS_HACT + (size_t)MAXSLOT * DE * 2 <= WS_YS && WS_YS + (size_t)MAXSLOT * D * 2 <= WS_ZA && WS_X1B >= WS_MG + (size_t)T * D * 2 && WS_X1B + (size_t)T * D * 2 <= WS_ZB, "ws map");
static_assert(DO_OG + (size_t)3 * TC * 512 * 2 <= DO_LSE && DO_LSE + (size_t)3 * TC * 8 * 4 <= (size_t)T * D * 4 && DO_HN + (size_t)T * D * 2 <= DO_OG, "d_out scratch map");
constexpr int CW_CNT = 1024;
constexpr int CW_BAR = 4096;
constexpr int LDS_BYTES = 147456;
constexpr int LDS_MISC = 131072;

__device__ __forceinline__ unsigned f2bf(float f) { unsigned u = __builtin_bit_cast(unsigned, f); return (u + 0x7fffu + ((u >> 16) & 1u)) >> 16; }
__device__ __forceinline__ unsigned pk4_fp8(float a, float b, float c, float d) {
    a = __builtin_amdgcn_fmed3f(a, -448.f, 448.f); b = __builtin_amdgcn_fmed3f(b, -448.f, 448.f); c = __builtin_amdgcn_fmed3f(c, -448.f, 448.f); d = __builtin_amdgcn_fmed3f(d, -448.f, 448.f);
    int w = 0; w = __builtin_amdgcn_cvt_pk_fp8_f32(a, b, w, false); w = __builtin_amdgcn_cvt_pk_fp8_f32(c, d, w, true); return (unsigned)w; }
__device__ __forceinline__ unsigned pk2(float lo, float hi) { return f2bf(lo) | (f2bf(hi) << 16); }
__device__ __forceinline__ float bf2f(unsigned b) { return __builtin_bit_cast(float, b << 16); }
__device__ __forceinline__ float bflo(unsigned u) { return __builtin_bit_cast(float, u << 16); }
__device__ __forceinline__ float bfhi(unsigned u) { return __builtin_bit_cast(float, u & 0xffff0000u); }
__device__ __forceinline__ float wave_sum(float v) {
#pragma unroll
    for (int o = 1; o < 64; o <<= 1) v += __shfl_xor(v, o);
    return v;
}
__device__ __forceinline__ float wave_max(float v) {
#pragma unroll
    for (int o = 1; o < 64; o <<= 1) v = fmaxf(v, __shfl_xor(v, o));
    return v;
}
typedef float f32x2_t __attribute__((ext_vector_type(2)));
typedef __bf16 bf16x2_t __attribute__((ext_vector_type(2)));
__device__ __forceinline__ unsigned cvtpk(float lo, float hi) { f32x2_t v = {lo, hi}; bf16x2_t b = __builtin_convertvector(v, bf16x2_t); return __builtin_bit_cast(unsigned, b); }
#ifndef WT_STORES
#define WT_STORES 0
#endif
__device__ __forceinline__ __amdgpu_buffer_rsrc_t wt_rsrc(unsigned char* base) { return __builtin_amdgcn_make_buffer_rsrc(base, 0, 0x7ffffffc, 0x00020000); }
__device__ __forceinline__ void st16(__amdgpu_buffer_rsrc_t r, unsigned char* base, void* p, v4u v) { if (WT_STORES) __builtin_amdgcn_raw_buffer_store_b128(v, r, (unsigned)((unsigned char*)p - base), 0, 16); else *(GAS v4u*)p = v; }
__device__ __forceinline__ void st8(__amdgpu_buffer_rsrc_t r, unsigned char* base, void* p, v2u v) { if (WT_STORES) __builtin_amdgcn_raw_buffer_store_b64(v, r, (unsigned)((unsigned char*)p - base), 0, 16); else *(GAS v2u*)p = v; }
#define LDS_WAIT() asm volatile("s_waitcnt lgkmcnt(0)" ::: "memory")
#define VM_WAIT() asm volatile("s_waitcnt vmcnt(0)" ::: "memory")

#define XB_TMO      128
#define XB_XCNT(j)  (256  + 64 * (j))
#define XB_XSUB(j)  (1280 + 64 * (j))
#define XB_XGEN(j)  (2304 + 64 * (j))
#define XB_TOP      3328
#define XB_TOPGEN   3392
#define XCD_BAR_WORDS 3456
#define XB_SPIN_CAP (1u << 18)
__device__ __forceinline__ unsigned xb_ld(unsigned* p)              { return __hip_atomic_load(p, __ATOMIC_RELAXED, __HIP_MEMORY_SCOPE_AGENT); }
__device__ __forceinline__ unsigned xb_add(unsigned* p, unsigned v) { return __hip_atomic_fetch_add(p, v, __ATOMIC_RELAXED, __HIP_MEMORY_SCOPE_AGENT); }
__device__ __forceinline__ unsigned xb_xcc_id() { return (unsigned)__builtin_amdgcn_s_getreg((3 << 11) | 20) & 0xFu; }
#define XB_SPIN(cond, bar) do { unsigned _sp = 0; while (cond) { __builtin_amdgcn_s_sleep(1); \
    if ((++_sp & 255u) == 0u) { if (xb_ld(&(bar)[XB_TMO])) break; if (_sp > XB_SPIN_CAP) { atomicAdd(&(bar)[XB_TMO], 1u); break; } } } } while (0)
struct XcdBarrier { unsigned* bar; unsigned x; volatile LAS unsigned* st; };
__device__ __forceinline__ XcdBarrier xcd_barrier_post(unsigned* bar, volatile LAS unsigned* st) {
    XcdBarrier b; b.bar = bar; b.x = xb_xcc_id(); b.st = st;
    if (threadIdx.x == 0) (void)xb_add(&bar[XB_XCNT(b.x)], 1u);
    return b;
}
__device__ __forceinline__ void xcd_barrier_complete(unsigned* bar, unsigned x, unsigned& nloc, unsigned& nx) {
    const unsigned G = gridDim.x * gridDim.y * gridDim.z;
    unsigned sum, cnt, mine, sp = 0u;
    for (;;) {
        sum = 0u; cnt = 0u; mine = 0u;
#pragma unroll
        for (unsigned j = 0; j < 16; ++j) { const unsigned c = xb_ld(&bar[XB_XCNT(j)]); sum += c; cnt += (c > 0u) ? 1u : 0u; mine = (j == x) ? c : mine; }
        if (sum == G) break;
        __builtin_amdgcn_s_sleep(1);
        if ((++sp & 255u) == 0u) { if (xb_ld(&bar[XB_TMO])) break; if (sp > XB_SPIN_CAP) { atomicAdd(&bar[XB_TMO], 1u); break; } }
    }
    nloc = mine > 0u ? mine : 1u; nx = cnt > 0u ? cnt : 1u;
}
__device__ __forceinline__ void xcd_barrier(const XcdBarrier& b) {
    asm volatile("s_waitcnt vmcnt(0)" ::: "memory");
    __syncthreads();
    if (threadIdx.x == 0) {
        unsigned* bar = b.bar;
        __builtin_amdgcn_s_waitcnt(0);
        unsigned nloc = b.st[0], nx = b.st[1];
        if (nloc == 0u) { xcd_barrier_complete(bar, b.x, nloc, nx); b.st[0] = nloc; b.st[1] = nx; }
        const unsigned old = xb_add(&bar[XB_XSUB(b.x)], 1u);
        const unsigned gen = old / nloc;
        if (old + 1u == (gen + 1u) * nloc) {
            __builtin_amdgcn_fence(__ATOMIC_RELEASE, "agent");
            asm volatile("s_waitcnt vmcnt(0)" ::: "memory");
            const unsigned og = xb_add(&bar[XB_TOP], 1u);
            const unsigned tg = og / nx;
            if (og + 1u == (tg + 1u) * nx) xb_add(&bar[XB_TOPGEN], 1u);
            else XB_SPIN(xb_ld(&bar[XB_TOPGEN]) == tg, bar);
            __builtin_amdgcn_fence(__ATOMIC_ACQUIRE, "agent");
            xb_add(&bar[XB_XGEN(b.x)], 1u);
            asm volatile("s_waitcnt vmcnt(0)" ::: "memory");
        } else {
            XB_SPIN(xb_ld(&bar[XB_XGEN(b.x)]) == gen, bar);
            __builtin_amdgcn_fence(__ATOMIC_ACQUIRE, "agent");
            asm volatile("s_waitcnt vmcnt(0)" ::: "memory");
        }
    }
    __syncthreads();
}

struct KArgs { const float* in[17]; float* out; unsigned char* ws; int ph_lo, ph_hi, li, pad; };
struct Frame {
    LAS unsigned char* lds;
    int tid, lane, wave, vcu, G;
    const float* in[17]; float* out; unsigned char* ws;
};
enum { I_X = 0, I_WIN, I_BIN, I_SINK, I_WPA, I_WPB, I_WOUT, I_GMIX, I_GFFN, I_WRG, I_BRG, I_WRE, I_BRE, I_WEG, I_WEU, I_WED, I_GFIN };

struct TrDesc { const float* W; int N; bf16* WT; int ldo, rowbase, koff, k0, n0; bool perm; const float* kscale; float f8scale; };
__device__ __forceinline__ void tr_load(const TrDesc& d, int lane, f32x4 (&tv)[8], float (&ks)[8]) {
    const float* src = d.W + (size_t)(d.k0 + (lane >> 3)) * d.N + d.n0 + 4 * (lane & 7);
#pragma unroll
    for (int i = 0; i < 8; ++i) tv[i] = *(const GAS f32x4*)(src + (size_t)(8 * i) * d.N);
#pragma unroll
    for (int i = 0; i < 8; ++i) ks[i] = d.kscale ? d.kscale[d.k0 + 8 * i + (lane >> 3)] : 1.0f;
}
__device__ __forceinline__ void tr_finish(const TrDesc& d, LAS float* scr, int lane, const f32x4 (&tv)[8], const float (&ks)[8]) {
#pragma unroll
    for (int i = 0; i < 8; ++i) { const int kk = 8 * i + (lane >> 3); LAS float* w = scr + kk * 33 + 4 * (lane & 7);
        w[0] = tv[i][0] * ks[i]; w[1] = tv[i][1] * ks[i]; w[2] = tv[i][2] * ks[i]; w[3] = tv[i][3] * ks[i]; }
    LDS_WAIT(); asm volatile("" ::: "memory");
    const int c = lane & 7;
#pragma unroll
    for (int j = 0; j < 4; ++j) { const int n = (lane >> 3) + 8 * j; const LAS float* s = scr + (8 * c) * 33 + n;
        const int rr = d.perm ? 8 * (n >> 2) + (n & 3) : n;
        if (d.f8scale != 0.f) { const float f = d.f8scale; v2u o8; o8.x = pk4_fp8(s[0 * 33] * f, s[1 * 33] * f, s[2 * 33] * f, s[3 * 33] * f); o8.y = pk4_fp8(s[4 * 33] * f, s[5 * 33] * f, s[6 * 33] * f, s[7 * 33] * f);
            *(GAS v2u*)((unsigned char*)d.WT + (size_t)(d.rowbase + rr) * d.ldo + d.koff + d.k0 + 8 * c) = o8; }
        else { v4u o; o.x = pk2(s[0 * 33], s[1 * 33]); o.y = pk2(s[2 * 33], s[3 * 33]); o.z = pk2(s[4 * 33], s[5 * 33]); o.w = pk2(s[6 * 33], s[7 * 33]);
            *(GAS v4u*)(d.WT + (size_t)(d.rowbase + rr) * d.ldo + d.koff + d.k0 + 8 * c) = o; } }
    LDS_WAIT(); asm volatile("" ::: "memory");
}
__device__ __forceinline__ void rms_row_to_bf16(const float* xrow, const float* g, bf16* orow, int lane) {
    const GAS f32x4* xr = (const GAS f32x4*)xrow + lane; const GAS f32x4* gr = (const GAS f32x4*)g + lane;
    f32x4 v[4]; float s = 0.f;
#pragma unroll
    for (int j = 0; j < 4; ++j) { v[j] = xr[64 * j]; s += (v[j].x * v[j].x + v[j].y * v[j].y) + (v[j].z * v[j].z + v[j].w * v[j].w); }
    const float rstd = 1.0f / sqrtf(wave_sum(s) * (1.f / D) + RMS_EPS);
    GAS v2u* o8 = (GAS v2u*)orow + lane;
#pragma unroll
    for (int j = 0; j < 4; ++j) { const f32x4 gg = gr[64 * j]; v2u w; w.x = pk2(v[j].x * rstd * gg.x, v[j].y * rstd * gg.y); w.y = pk2(v[j].z * rstd * gg.z, v[j].w * rstd * gg.w); o8[64 * j] = w; }
}
__device__ __forceinline__ void p0_prologue(Frame& F) {
    int tid_ = threadIdx.x; asm volatile("" : "+v"(tid_)); const int lane_ = tid_ & 63;
    LAS float* scr = (LAS float*)(F.lds + F.wave * 16384);
    const int gw = F.vcu * NWAVES + F.wave, NGW = F.G * NWAVES;
    unsigned char* ws = F.ws;
    constexpr int I_IN = 16 * 248, I_PA = 8 * 32, I_PB = 16 * 32, I_WO = 16 * 32, I_EG = 32 * 16 * 8, I_ED = 32 * 4 * 32;
    constexpr int NITEMS = I_IN + I_PA + I_PB + I_WO + 2 * I_EG + I_ED;
    auto decode = [&](int it, TrDesc& d) {
        int r = it; d.perm = false; d.kscale = nullptr; d.f8scale = 0.f; d.koff = 0;
        if (r < I_IN) { const int kb = r / 248, nb = r % 248, n0 = 32 * nb; const bool qk = (n0 < 3072) || (n0 >= A_W && n0 < A_W + 1152);
            const bool gt_ = n0 >= A_W + B_W; const int gc = n0 - (A_W + B_W);
            d.W = F.in[I_WIN]; d.N = NIN; d.WT = (bf16*)(ws + WS_WIN); d.ldo = 1024; d.rowbase = qk ? (n0 & ~63) + ((n0 >> 5) & 1) * 4 : (gt_ ? A_W + B_W + 2 * (gc % 1024) + 4 * (gc / 1024) : n0); d.k0 = 64 * kb; d.n0 = n0; d.perm = qk || gt_; d.f8scale = W8_SCALE; return; } r -= I_IN;
        if (r < I_PA) { const int kb = r / 32, nb = r % 32; d.W = F.in[I_WPA]; d.N = 1024; d.WT = (bf16*)(ws + WS_WAB); d.ldo = 1536; d.rowbase = 32 * nb; d.k0 = 64 * kb; d.n0 = 32 * nb; if (P34_FP8) d.f8scale = W34_SCALE; return; } r -= I_PA;
        if (r < I_PB) { const int kb = r / 32, nb = r % 32; d.W = F.in[I_WPB]; d.N = 1024; d.WT = (bf16*)(ws + WS_WAB); d.ldo = 1536; d.rowbase = 32 * nb; d.koff = 512; d.k0 = 64 * kb; d.n0 = 32 * nb; if (P34_FP8) d.f8scale = W34_SCALE; return; } r -= I_PB;
        if (r < I_WO) { const int kb = r / 32, nb = r % 32; d.W = F.in[I_WOUT]; d.N = 1024; d.WT = (bf16*)(ws + WS_WO); d.ldo = 1024; d.rowbase = 32 * nb; d.k0 = 64 * kb; d.n0 = 32 * nb; if (P34_FP8) d.f8scale = W34_SCALE; return; } r -= I_WO;
        if (r < 2 * I_EG) { const int up = r >= I_EG; if (up) r -= I_EG; const int e = r / 128, q = r % 128, kb = q / 8, nb = q % 8;
            d.W = F.in[up ? I_WEU : I_WEG] + (size_t)e * 1024 * 256; d.N = 256; d.WT = (bf16*)(ws + WS_WGU) + (size_t)e * 512 * 1024; d.ldo = 1024; d.rowbase = 64 * nb + (up ? 4 : 0); d.k0 = 64 * kb; d.n0 = 32 * nb; d.perm = true; d.kscale = F.in[I_GFFN]; d.f8scale = WG8_SCALE; if (P6_FP8) d.WT = (bf16*)((unsigned char*)(ws + WS_WGU) + (size_t)e * 512 * 1024); return; } r -= 2 * I_EG;
        { const int e = r / 128, q = r % 128, kb = q / 32, nb = q % 32;
            d.W = F.in[I_WED] + (size_t)e * 256 * 1024; d.N = 1024; d.WT = (bf16*)(ws + WS_WD) + (size_t)e * 1024 * 256; d.ldo = 256; d.rowbase = 32 * nb; d.k0 = 64 * kb; d.n0 = 32 * nb; d.f8scale = WD8_SCALE; if (P6_FP8) d.WT = (bf16*)((unsigned char*)(ws + WS_WD) + (size_t)e * 1024 * 256); }
    };
    {
        int it = gw; TrDesc dc, dn; f32x4 tc[8], tn[8]; float kc[8], kn[8];
        bool hc = it < NITEMS; if (hc) { decode(it, dc); tr_load(dc, lane_, tc, kc); }
        while (hc) {
            it += NGW; const bool hn = it < NITEMS;
            if (hn) { decode(it, dn); tr_load(dn, lane_, tn, kn); }
            tr_finish(dc, scr, lane_, tc, kc);
            hc = hn; dc = dn;
#pragma unroll
            for (int i = 0; i < 8; ++i) { tc[i] = tn[i]; kc[i] = kn[i]; }
        }
    }
    for (int m = gw; m < T; m += 4 * NGW) {
        const GAS f32x4* gr = (const GAS f32x4*)F.in[I_GMIX] + lane_;
        f32x4 v[4][4]; float ss[4];
#pragma unroll
        for (int r = 0; r < 4; ++r) { const int mr = (m + r * NGW < T) ? m + r * NGW : m; const GAS f32x4* xr = (const GAS f32x4*)(F.in[I_X] + (size_t)mr * D) + lane_;
#pragma unroll
            for (int j = 0; j < 4; ++j) v[r][j] = xr[64 * j]; }
#pragma unroll
        for (int r = 0; r < 4; ++r) { float a = 0.f;
#pragma unroll
            for (int j = 0; j < 4; ++j) a += (v[r][j].x * v[r][j].x + v[r][j].y * v[r][j].y) + (v[r][j].z * v[r][j].z + v[r][j].w * v[r][j].w);
            ss[r] = 1.0f / sqrtf(wave_sum(a) * (1.f / D) + RMS_EPS); }
#pragma unroll
        for (int r = 0; r < 4; ++r) { if (m + r * NGW >= T) continue; GAS unsigned* o4 = (GAS unsigned*)((unsigned char*)F.out + DO_HN + (size_t)(m + r * NGW) * D) + lane_;
#pragma unroll
            for (int j = 0; j < 4; ++j) { const f32x4 gg = gr[64 * j];
                if (P1_FP8) o4[64 * j] = pk4_fp8(v[r][j].x * ss[r] * gg.x, v[r][j].y * ss[r] * gg.y, v[r][j].z * ss[r] * gg.z, v[r][j].w * ss[r] * gg.w);
                else { v2u w; w.x = cvtpk(v[r][j].x * ss[r] * gg.x, v[r][j].y * ss[r] * gg.y); w.y = cvtpk(v[r][j].z * ss[r] * gg.z, v[r][j].w * ss[r] * gg.w); ((GAS v2u*)((unsigned char*)F.out + DO_HN + (size_t)(m + r * NGW) * D * 2) + lane_)[64 * j] = w; } } }
    }
    const int gt = F.vcu * NTHR + tid_, NGT = F.G * NTHR;
    if (gt < 32) ((float*)(ws + WS_INVF))[gt] = (float)exp2(-(double)gt * (13.287712379549449 / 32.0));
    for (int i = gt; i < 32 * 3 * 64; i += NGT) {
        const int ln = i & 63, nb = (i >> 6) % 3, ks = i / 192;
        const int n = 16 * nb + (ln & 15);
        float hi[8], lo[8];
#pragma unroll
        for (int e = 0; e < 8; ++e) { const int k = 32 * ks + 8 * (ln >> 4) + e; float v = 0.f;
            if (n < 4) v = F.in[I_WRG][k * 4 + n]; else if (n < 36) v = F.in[I_WRE][k * 32 + (n - 4)];
            v *= F.in[I_GFFN][k]; hi[e] = bf2f(f2bf(v)); lo[e] = v - hi[e]; }
        v4u h, l; h.x = pk2(hi[0], hi[1]); h.y = pk2(hi[2], hi[3]); h.z = pk2(hi[4], hi[5]); h.w = pk2(hi[6], hi[7]);
        l.x = pk2(lo[0], lo[1]); l.y = pk2(lo[2], lo[3]); l.z = pk2(lo[4], lo[5]); l.w = pk2(lo[6], lo[7]);
        ((v4u*)(ws + WS_WRF))[((ks * 3 + nb) * 2 + 0) * 64 + ln] = h; ((v4u*)(ws + WS_WRF))[((ks * 3 + nb) * 2 + 1) * 64 + ln] = l;
    }
}

namespace pg8 {
#define PG8_LAS __attribute__((address_space(3)))
typedef unsigned short bf16_t;
typedef short bf16x8 __attribute__((ext_vector_type(8)));
typedef float f32x4 __attribute__((ext_vector_type(4)));
typedef unsigned u32x4 __attribute__((ext_vector_type(4)));
constexpr int BM = 256, BK = 64, HALF = 128, HTB = HALF * BK * 2  , STAGE_BYTES = 8 * HTB, NXCD = 8, WGM = 8;

__host__ __device__ __forceinline__ int lds_byte(int r, int c) { const int st = (r >> 4) * 2 + (c >> 5), rr = r & 15, cc = c & 31, ob = rr * 64 + cc * 2; return st * 1024 + (ob ^ (((ob >> 9) & 1) << 5)); }
__host__ __device__ __forceinline__ void stage_rc(int b, int& R, int& C) { const int st = b / 1024, sb = b % 1024, swz = sb ^ (((sb >> 9) & 1) << 5); R = (st >> 1) * 16 + swz / 64; C = (st & 1) * 32 + (swz % 64) / 2; }
__host__ __device__ __forceinline__ int perm32(int rho) { const int n = rho >> 4, i = rho & 15; return 8 * (i >> 2) + 4 * n + (i & 3); }

struct Unit { int pm, pn; };
struct Gemm { const bf16_t* A; const bf16_t* Bt; int M, N, K; };

struct StaticOrder {
    int nM, nN, nwg, G, c;
    __host__ __device__ void init(int M, int N, int G_, int c_) { nM = M / BM; nN = N / BM; nwg = nM * nN; G = G_; c = c_; }
    __host__ __device__ bool next(int i, Unit& u) const {
        const long L = (long)i * G + c; if (L >= nwg) return false;
        int wgid = (int)L; { const int q = nwg / NXCD, r = nwg % NXCD, xcd = wgid % NXCD, off = wgid / NXCD; wgid = (xcd < r ? xcd * (q + 1) : r * (q + 1) + (xcd - r) * q) + off; }
        const int nig = WGM * nN, gid = wgid / nig, fm = gid * WGM, gsz = (nM - fm) < WGM ? (nM - fm) : WGM;
        u.pm = fm + ((wgid % nig) % gsz); u.pn = (wgid % nig) / gsz; return true;
    }
    __device__ __forceinline__ void a_ready(const Unit&) const {}
    __device__ __forceinline__ void done(const Unit&) const {}
};
}


namespace pg9 {
using pg8::BM; using pg8::BK; using pg8::HALF; using pg8::HTB; using pg8::lds_byte; using pg8::stage_rc; using pg8::perm32;
struct Unit { int pm, pn, e; };
typedef int v8i_t __attribute__((ext_vector_type(8)));
typedef int v4i_t __attribute__((ext_vector_type(4)));
template <int ESZ, class Epi, class Sched, class AOff, class BBase>
__device__ __forceinline__ void gemm_phase(LAS unsigned char* lds, const char* Abase, int K, const Sched& S, const Epi& E, const AOff& aoffn, const BBase& bbase) {
    int tid_ = threadIdx.x; asm volatile("" : "+v"(tid_));
    const int tid = tid_, wid = __builtin_amdgcn_readfirstlane(tid >> 6), lane = tid & 63, wr = wid >> 2, wc = wid & 3, fr = lane & 15, fq = lane >> 4;
    const int nt = K * ESZ / (BK * 2);
    int Rr[2], Cc[2]; unsigned voffB[2];
#pragma unroll
    for (int i = 0; i < 2; ++i) { int R, C; stage_rc(tid * 16 + i * 8192, R, C); const int Rb = Epi::PERM ? ((R & ~31) + perm32(R & 31)) : R; Rr[i] = R; Cc[i] = C; voffB[i] = (unsigned)(Rb * K * ESZ + C * 2); }
    const size_t kstep = (size_t)(BK * 2);
    const size_t hstep = (size_t)HALF * K * ESZ;
    const unsigned ldsw = (unsigned)wid * 1024u;
    const int aoff = lds_byte(wr * 64 + fr, fq * 8), boff = lds_byte(wc * 32 + fr, fq * 8);
#define PG9_SA(b, h) (((b) * 2 + (h)) * HTB)
#define PG9_SB(b, h) ((4 + (b) * 2 + (h)) * HTB)
#define PG9_STAGE(bufoff, gbase, voff) do { _Pragma("unroll") for (int _i = 0; _i < 2; ++_i) \
        __builtin_amdgcn_global_load_lds((const unsigned*)((const char*)(gbase) + (voff)[_i]), (LAS unsigned*)(lds + (bufoff) + ldsw + _i * 8192), 16, 0, 0); } while (0)
#define PG9_LDA(dst, b, h) do { _Pragma("unroll") for (int m = 0; m < 4; ++m) { dst[m].lo = *(const LAS v4i_t*)(lds + PG9_SA(b, h) + aoff + m * 2048); dst[m].hi = *(const LAS v4i_t*)(lds + PG9_SA(b, h) + aoff + m * 2048 + 1024); } } while (0)
#define PG9_LDB(dst, b, h) do { _Pragma("unroll") for (int n = 0; n < 2; ++n) { dst[n].lo = *(const LAS v4i_t*)(lds + PG9_SB(b, h) + boff + n * 2048); dst[n].hi = *(const LAS v4i_t*)(lds + PG9_SB(b, h) + boff + n * 2048 + 1024); } } while (0)
#define PG9_HALF(v, o) __builtin_bit_cast(bf16x8, __builtin_shufflevector((v), (v), (o), (o) + 1, (o) + 2, (o) + 3))
#define PG9_MMA(ai, bj, At, Bt) do { __builtin_amdgcn_s_setprio(1); _Pragma("unroll") for (int m = 0; m < 4; ++m) _Pragma("unroll") for (int n = 0; n < 2; ++n) { \
        if (ESZ == 2) { acc[ai][bj][m][n] = __builtin_amdgcn_mfma_f32_16x16x32_bf16(PG9_HALF(Bt[n], 0), PG9_HALF(At[m], 0), acc[ai][bj][m][n], 0, 0, 0); \
                        acc[ai][bj][m][n] = __builtin_amdgcn_mfma_f32_16x16x32_bf16(PG9_HALF(Bt[n], 4), PG9_HALF(At[m], 4), acc[ai][bj][m][n], 0, 0, 0); } \
        else { asm volatile("v_mfma_scale_f32_16x16x128_f8f6f4 %0, %1, %2, %0, %3, %3 op_sel_hi:[0,0,0]" : "+v"(acc[ai][bj][m][n]) : "v"(Bt[n]), "v"(At[m]), "v"(one8)); } } \
        __builtin_amdgcn_s_setprio(0); } while (0)
#define PG9_WAIT_V(n) asm volatile("s_waitcnt vmcnt(" #n ")" ::: "memory")
#define PG9_WAIT_L(n) asm volatile("s_waitcnt lgkmcnt(" #n ")" ::: "memory")
#define PG9_BAR __builtin_amdgcn_s_barrier()
#define PG9_SCHED __builtin_amdgcn_sched_barrier(0)
#define PG9_VA(dst, u) do { _Pragma("unroll") for (int _h = 0; _h < 2; ++_h) _Pragma("unroll") for (int _i = 0; _i < 2; ++_i) dst[_h][_i] = aoffn((u), _h * HALF + Rr[_i]) + (unsigned)(Cc[_i] * 2); } while (0)
    constexpr bool GATHER = AOff::GATHER;
    const size_t hstepA = (size_t)HALF * aoffn.rowbytes;
    unsigned voffA[2];
#pragma unroll
    for (int i = 0; i < 2; ++i) voffA[i] = (unsigned)Rr[i] * aoffn.rowbytes + (unsigned)(Cc[i] * 2);
#define PG9_STAGE_A(bufoff, h, koff, nx) do { if (GATHER) { PG9_STAGE(bufoff, Abase + (koff), ((nx) ? nvA[h] : cvA[h])); } else { PG9_STAGE(bufoff, ((nx) ? nAu : cAu) + (h) * hstepA + (koff), voffA); } } while (0)
    Unit cur, nxt; int ui = 0;
    if (!S.next(0, cur)) return;
    f32x4 acc[2][2][4][2];
#pragma unroll
    for (int a = 0; a < 2; ++a)
#pragma unroll
        for (int b = 0; b < 2; ++b)
#pragma unroll
            for (int m = 0; m < 4; ++m)
#pragma unroll
                for (int n = 0; n < 2; ++n) acc[a][b][m][n] = (f32x4){0.f, 0.f, 0.f, 0.f};
    int one8 = 0x7f7f7f7f; asm volatile("" : "+v"(one8));
    v8i_t At[4], B0[2], B1[2];
    unsigned cvA[2][2], nvA[2][2];
    if (GATHER) { PG9_VA(cvA, cur); }
    const char* cAu = GATHER ? Abase : Abase + (size_t)aoffn(cur, 0); const char* nAu = cAu;
    const char* cB = bbase(cur);
    PG9_STAGE(PG9_SB(0, 0), cB, voffB); PG9_STAGE(PG9_SB(0, 1), cB + hstep, voffB); PG9_STAGE_A(PG9_SA(0, 0), 0, 0, false); PG9_STAGE_A(PG9_SA(0, 1), 1, 0, false);
    if (wr == 1) PG9_BAR;
    PG9_WAIT_V(2); PG9_BAR;
    PG9_STAGE(PG9_SB(1, 0), cB + kstep, voffB); PG9_STAGE_A(PG9_SA(1, 0), 0, kstep, false); PG9_STAGE(PG9_SB(1, 1), cB + hstep + kstep, voffB);
    PG9_WAIT_V(6); PG9_BAR;
    for (;;) {
        const bool has_next = S.next(ui + 1, nxt);
        if (GATHER) {
            if (has_next) { PG9_VA(nvA, nxt); } else {
#pragma unroll
                for (int _h = 0; _h < 2; ++_h)
#pragma unroll
                    for (int _i = 0; _i < 2; ++_i) nvA[_h][_i] = cvA[_h][_i]; }
        } else nAu = has_next ? Abase + (size_t)aoffn(nxt, 0) : cAu;
        const char* nB = has_next ? bbase(nxt) : cB;
#pragma unroll 1
        for (int t = 0; t < nt; t += 2) {
            const bool last = (t == nt - 2);
            if (Epi::HOOK_T >= 0) { if (t == Epi::HOOK_T) E.hook(acc, cur, wr, wc, fr, fq); }
            const size_t k1 = (size_t)(t + 1) * kstep, k2 = last ? 0 : (size_t)(t + 2) * kstep, k3 = k2 + kstep;
            const char* b2 = last ? nB : cB + (size_t)(t + 2) * kstep; const char* b3 = b2 + kstep;
            PG9_LDB(B0, 0, 0); PG9_LDB(B1, 0, 1); PG9_SCHED; PG9_LDA(At, 0, 0); PG9_STAGE_A(PG9_SA(1, 1), 1, k1, false);
            PG9_WAIT_V(8); PG9_WAIT_L(0); PG9_BAR; PG9_MMA(0, 0, At, B0); PG9_MMA(0, 1, At, B1); PG9_BAR; PG9_SCHED;
            PG9_LDA(At, 0, 1); PG9_STAGE(PG9_SB(0, 0), b2, voffB); PG9_STAGE(PG9_SB(0, 1), b2 + hstep, voffB); PG9_STAGE_A(PG9_SA(0, 0), 0, k2, last);
            PG9_WAIT_V(8); PG9_WAIT_L(0); PG9_BAR; PG9_MMA(1, 0, At, B0); PG9_MMA(1, 1, At, B1); PG9_BAR; PG9_SCHED;
            PG9_LDB(B0, 1, 0); PG9_LDB(B1, 1, 1); PG9_SCHED; PG9_LDA(At, 1, 0); PG9_STAGE_A(PG9_SA(0, 1), 1, k2, last);
            PG9_WAIT_V(8); PG9_WAIT_L(0); PG9_BAR; PG9_MMA(0, 0, At, B0); PG9_MMA(0, 1, At, B1); PG9_BAR; PG9_SCHED;
            PG9_LDA(At, 1, 1); PG9_STAGE(PG9_SB(1, 0), b3, voffB); PG9_STAGE(PG9_SB(1, 1), b3 + hstep, voffB); PG9_STAGE_A(PG9_SA(1, 0), 0, k3, last);
            PG9_WAIT_V(8); PG9_WAIT_L(0); PG9_BAR; PG9_MMA(1, 0, At, B0); PG9_MMA(1, 1, At, B1); PG9_BAR; PG9_SCHED;
        }
        if (wr == 0) PG9_BAR;
        if (ESZ == 1) asm volatile("s_nop 15\n\ts_nop 15" ::: "memory");
        E(acc, cur, wr, wc, fr, fq);
        if (!has_next) break;
#pragma unroll
        for (int a = 0; a < 2; ++a)
#pragma unroll
            for (int b = 0; b < 2; ++b)
#pragma unroll
                for (int m = 0; m < 4; ++m)
#pragma unroll
                    for (int n = 0; n < 2; ++n) acc[a][b][m][n] = (f32x4){0.f, 0.f, 0.f, 0.f};
        cur = nxt; cB = nB; cAu = nAu; ++ui;
        if (GATHER) {
#pragma unroll
            for (int _h = 0; _h < 2; ++_h)
#pragma unroll
                for (int _i = 0; _i < 2; ++_i) cvA[_h][_i] = nvA[_h][_i]; }
        if (wr == 1) PG9_BAR;
    }
    PG9_WAIT_V(0);
    PG9_BAR;
#undef PG9_SA
#undef PG9_SB
#undef PG9_STAGE
#undef PG9_LDA
#undef PG9_LDB
#undef PG9_MMA
#undef PG9_HALF
#undef PG9_WAIT_V
#undef PG9_WAIT_L
#undef PG9_BAR
#undef PG9_SCHED
#undef PG9_VA
#undef PG9_STAGE_A
}
struct DenseOrder { pg8::StaticOrder so;
    __device__ void init(int M, int N, int G, int c) { so.init(M, N, G, c); }
    __device__ bool next(int i, Unit& u) const { pg8::Unit v; if (!so.next(i, v)) return false; u.pm = v.pm; u.pn = v.pn; u.e = 0; return true; } };
struct DenseA { static constexpr bool GATHER = false; unsigned rowbytes; __device__ __forceinline__ unsigned operator()(const Unit& u, int row) const { return (unsigned)(u.pm * 256 + row) * rowbytes; } };
struct DenseB { const char* Bt; size_t tilebytes; __device__ __forceinline__ const char* operator()(const Unit& u) const { return Bt + (size_t)u.pn * tilebytes; } };
}

struct EpiInproj {
    static constexpr bool PERM = true; static constexpr int HOOK_T = -1;
    bf16* ZA; bf16* ZB; bf16* Gt; const float* bias; const float* invf; unsigned char* wsb;
    __device__ __forceinline__ void hook(f32x4 (&)[2][2][4][2], const pg9::Unit&, int, int, int, int) const {}
    __device__ __forceinline__ void operator()(const f32x4 (&acc)[2][2][4][2], const pg9::Unit& u, int wr, int wc, int fr, int fq) const {
        asm volatile("" : "+v"(fr), "+v"(fq));
        const int row0 = u.pm * 256 + wr * 64 + fr;
        const int q = 4 * (wc & 1) + fq;
        const __amdgpu_buffer_rsrc_t wr_ = wt_rsrc(wsb);
        int kind[2]; bf16* dst[2]; int ldd[2]; f32x4 b0[2], b1[2];
#pragma unroll
        for (int bj = 0; bj < 2; ++bj) {
            const int colpos = u.pn * 256 + bj * 128 + wc * 32 + 8 * fq, hb = u.pn * 256 + bj * 128 + (wc >> 1) * 64;
            if (hb < A_W) { kind[bj] = hb / 1536; dst[bj] = ZA + colpos; ldd[bj] = A_W; }
            else if (hb < A_W + B_W) { const int cb = hb - A_W; kind[bj] = cb < 1024 ? 0 : (cb < 1152 ? 1 : 2); dst[bj] = ZB + (colpos - A_W); ldd[bj] = B_W; }
            else { kind[bj] = 3; dst[bj] = Gt + ((colpos - A_W - B_W) >> 1); ldd[bj] = G_W; }
            b0[bj] = *(const f32x4*)(bias + (kind[bj] < 2 ? hb + 4 * q : (kind[bj] == 3 ? A_W + B_W + ((colpos - A_W - B_W) >> 1) : colpos)));
            b1[bj] = *(const f32x4*)(bias + (kind[bj] < 2 ? hb + 32 + 4 * q : (kind[bj] == 3 ? A_W + B_W + 1024 + ((colpos - A_W - B_W) >> 1) : colpos + 4)));
        }
        const bool need_rope = kind[0] < 2 || kind[1] < 2;
        const f32x4 fv = *(const f32x4*)(invf + 4 * q);
#pragma unroll
        for (int ai = 0; ai < 2; ++ai) {
            f32x4 rc[4], rs[4];
#pragma unroll
            for (int m = 0; m < 4; ++m) { rc[m] = (f32x4){1.f, 1.f, 1.f, 1.f}; rs[m] = (f32x4){0.f, 0.f, 0.f, 0.f}; }
            if (need_rope) {
#pragma unroll
                for (int m = 0; m < 4; ++m) { const float posf = (float)((row0 + ai * 128 + m * 16) & (SEQ - 1));
#pragma unroll
                    for (int e = 0; e < 4; ++e) { const float ang = posf * fv[e]; const float pr = ang * 0.15915494f; const float er = __builtin_fmaf(ang, 0.15915494f, -pr) + ang * 6.4206382e-9f;
                        const float fr = __builtin_amdgcn_fractf(pr) + er; rc[m][e] = __builtin_amdgcn_cosf(fr); rs[m][e] = __builtin_amdgcn_sinf(fr); } }
            }
#pragma unroll
            for (int bj = 0; bj < 2; ++bj) {
#pragma unroll
                for (int m = 0; m < 4; ++m) {
                    const int row = row0 + ai * 128 + m * 16;
                    f32x4 v0 = acc[ai][bj][m][0] * W8_INV + b0[bj], v1 = acc[ai][bj][m][1] * W8_INV + b1[bj];
                    if (kind[bj] < 2) {
                        const f32x4 cc = rc[m], ss = rs[m];
                        const f32x4 t0 = v0 * cc - v1 * ss, t1 = v1 * cc + v0 * ss;
                        v0 = t0; v1 = t1;
                        if (kind[bj] == 0) { v0 = v0 * QSCALE; v1 = v1 * QSCALE; }
                    }
                    if (kind[bj] == 3) {
#pragma unroll
                        for (int e = 0; e < 4; ++e) { const float d0 = 1.0f + __expf(-v0[e]), d1 = 1.0f + __expf(-v1[e]); v0[e] = d1 * __builtin_amdgcn_rcpf(d0); v1[e] = __builtin_amdgcn_rcpf(d1); }
                        v2u w0, w1; w0.x = cvtpk(v0[0], v0[1]); w0.y = cvtpk(v0[2], v0[3]); w1.x = cvtpk(v1[0], v1[1]); w1.y = cvtpk(v1[2], v1[3]);
                        st8(wr_, wsb, dst[bj] + (size_t)row * ldd[bj], w0); st8(wr_, wsb, dst[bj] + (size_t)row * ldd[bj] + 1024, w1);
                    } else {
                    v4u w; w.x = cvtpk(v0[0], v0[1]); w.y = cvtpk(v0[2], v0[3]); w.z = cvtpk(v1[0], v1[1]); w.w = cvtpk(v1[2], v1[3]);
                    st16(wr_, wsb, dst[bj] + (size_t)row * ldd[bj], w); }
                }
            }
        }
    }
};
__device__ __forceinline__ void p1_inproj(Frame& F, int ch) {
    unsigned char* ws = F.ws;
    pg9::DenseOrder S; S.init(TC, NIN, F.G, (int)blockIdx.x);
    EpiInproj E{(bf16*)(ws + WS_ZA), (bf16*)(ws + WS_ZB), (bf16*)(ws + WS_G) + (size_t)ch * TC * G_W, F.in[I_BIN], (const float*)(ws + WS_INVF), ws};
    constexpr int ES = P1_FP8 ? 1 : 2;
    pg9::DenseA ao{(unsigned)(D * ES)}; pg9::DenseB bb{(const char*)(ws + WS_WIN), (size_t)256 * D * ES};
    pg9::gemm_phase<ES>(F.lds, (const char*)F.out + DO_HN + (size_t)ch * TC * D * ES, D, S, E, ao, bb);
}

typedef float f32x16 __attribute__((ext_vector_type(16)));
typedef short v4i16_t __attribute__((ext_vector_type(4)));
__device__ __forceinline__ float half_max(float v) { auto rr = __builtin_amdgcn_permlane32_swap(__float_as_uint(v), __float_as_uint(v), false, false); return fmaxf(__uint_as_float(rr[0]), __uint_as_float(rr[1])); }
__device__ __forceinline__ float half_sum(float v) { auto rr = __builtin_amdgcn_permlane32_swap(__float_as_uint(v), __float_as_uint(v), false, false); return __uint_as_float(rr[0]) + __uint_as_float(rr[1]); }
__device__ __forceinline__ float max3f(float a, float b, float c) { float r; asm("v_max3_f32 %0, %1, %2, %3" : "=v"(r) : "v"(a), "v"(b), "v"(c)); return r; }
constexpr int ATT_VOFF = 49152;

struct AUnit { const bf16 *Kw, *Vw, *Qp; size_t pitch; int kk_lo, nkeys, kb0, kstart, lo; float m0, l0; bf16* Op; float* Lp; int o8; };
__device__ __forceinline__ void attn_decode(Frame& F, int ch, int u, int NUA, int lane, AUnit& d) {
    unsigned char* ws = F.ws;
    const int w = F.wave, c = lane & 31, h = (lane >> 5) & 1;
    if (u < NUA) {
        const bf16* ZA = (const bf16*)(ws + WS_ZA);
        const int rt = u & 15, hh = (u >> 4) & 7, gb = u >> 7, g = gb % 3, bl = gb / 3;
        const int dsh = 2 * g, dd = 1 << dsh, tsh = 4 - dsh;
        const int r = rt >> tsh, tile = rt & ((1 << tsh) - 1), i0 = tile * 256;
        const int rowb = bl * SEQ + r, col = g * 512 + hh * 64;
        d.pitch = (size_t)dd * A_W;
        d.Kw = ZA + ((long)rowb + (long)dd * (i0 - 128)) * A_W + 1536 + col; d.Vw = d.Kw + 1536;
        const long qrow = (long)rowb + (long)dd * (i0 + 32 * w + c);
        d.Qp = ZA + qrow * A_W + col;
        d.kk_lo = (i0 == 0) ? 128 : 0; d.nkeys = 384; d.kb0 = w; d.kstart = (i0 == 0) ? (w < 4 ? 4 - w : 0) : 0; d.lo = 0;
        d.m0 = -1e30f; d.l0 = 0.f;
        d.Op = (bf16*)((unsigned char*)F.out + DO_OG) + ((size_t)g * TC + qrow) * 512 + hh * 64;
        d.Lp = (float*)((unsigned char*)F.out + DO_LSE) + ((size_t)g * TC + qrow) * 8 + hh;
        d.o8 = 0;
    } else {
        const int u2 = u - NUA;
        const bf16* ZB = (const bf16*)(ws + WS_ZB);
        const int blk = u2 & 127, kvh = (u2 >> 7) & 1, bl = u2 >> 8;
        const int t0 = blk * 32, rowb = bl * SEQ;
        d.pitch = B_W;
        d.Kw = ZB + ((long)rowb + t0 - 128) * B_W + 1024 + kvh * 64; d.Vw = d.Kw + 128;
        const int qh = kvh * 8 + w;
        const long qrow = (long)rowb + t0 + c;
        d.Qp = ZB + qrow * B_W + qh * 64;
        d.kk_lo = t0 < 128 ? 128 - t0 : 0; d.nkeys = 160; d.kb0 = 0; d.kstart = d.kk_lo >> 5; d.lo = 1;
        d.m0 = F.in[I_SINK][qh] * LOG2E; d.l0 = h == 0 ? 1.f : 0.f;
        d.o8 = P34_FP8;
        d.Op = P34_FP8 ? (bf16*)(ws + WS_Y + ((size_t)ch * TC + qrow) * Y_W + 512 + qh * 64) : (bf16*)(ws + WS_Y) + ((size_t)ch * TC + qrow) * Y_W + 512 + qh * 64;
        d.Lp = nullptr;
    }
}
__device__ __forceinline__ void attn_load(const AUnit& d, int tid, int lane, v4u (&kreg)[6], v4u (&vreg)[6], bf16x8 (&qf)[4]) {
    const int skey = tid >> 3, sch = tid & 7, h = (lane >> 5) & 1;
#pragma unroll
    for (int s4 = 0; s4 < 4; ++s4) qf[s4] = *(const GAS bf16x8*)(d.Qp + 16 * s4 + 8 * h);
#pragma unroll
    for (int p = 0; p < 6; ++p) { const int kk = 64 * p + skey;
        if (kk >= d.kk_lo && kk < d.nkeys) { kreg[p] = *(const GAS v4u*)(d.Kw + (size_t)kk * d.pitch + 8 * sch); vreg[p] = *(const GAS v4u*)(d.Vw + (size_t)kk * d.pitch + 8 * sch); } }
}
__device__ __forceinline__ void attn_write(const AUnit& d, LAS unsigned char* KL, LAS unsigned char* VL, int tid, const v4u (&kreg)[6], const v4u (&vreg)[6]) {
    const int skey = tid >> 3, sch = tid & 7;
#pragma unroll
    for (int p = 0; p < 6; ++p) { const int kk = 64 * p + skey;
        if (kk >= d.kk_lo && kk < d.nkeys) {
            *(LAS v4u*)(KL + kk * 128 + ((sch ^ ((kk >> 1) & 7)) << 4)) = kreg[p];
            *(LAS v4u*)(VL + kk * 128 + ((sch * 16) ^ (((kk >> 1) & 1) << 6))) = vreg[p]; } }
}
__device__ __forceinline__ void attn_compute_edge(const AUnit& d, const LAS unsigned char* KL, const LAS unsigned char* VL, int lane, const bf16x8 (&qf)[4]) {
    const int c = lane & 31, h = (lane >> 5) & 1;
    int koff[4];
    { const int kswz = (c >> 1) & 7;
#pragma unroll
      for (int s4 = 0; s4 < 4; ++s4) koff[s4] = c * 128 + (((2 * s4 + h) ^ kswz) << 4); }
    const int vrow = 4 * h + ((lane & 15) >> 2), vsw = (lane >> 3) & 1;
    const int voff0 = vrow * 128 + ((32 * ((lane >> 4) & 1) + 8 * (lane & 3)) ^ (vsw << 6)), voff1 = voff0 ^ 64;
    const float NEG = -INFINITY;
    float m = d.m0, l = d.l0;
    f32x16 o0, o1;
#pragma unroll
    for (int i = 0; i < 16; ++i) { o0[i] = 0.f; o1[i] = 0.f; }
    const LAS unsigned char* kbp = KL + d.kb0 * 4096; const LAS unsigned char* vbp = VL + d.kb0 * 4096;
    const int clo = c + d.lo;
#pragma unroll
    for (int kbi = 0; kbi < 5; ++kbi) {
        if (kbi >= d.kstart) {
            f32x16 p;
#pragma unroll
            for (int i = 0; i < 16; ++i) p[i] = 0.f;
#pragma unroll
            for (int s4 = 0; s4 < 4; ++s4) { const bf16x8 kf = *(const LAS bf16x8*)(kbp + kbi * 4096 + koff[s4]); p = __builtin_amdgcn_mfma_f32_32x32x16_bf16(kf, qf[s4], p, 0, 0, 0); }
            if (kbi == 0) {
#pragma unroll
                for (int i = 0; i < 16; ++i) { const int x = (i & 3) + 8 * (i >> 2) + 4 * h; if (x < clo) p[i] = NEG; }
            }
            if (kbi == 4) {
#pragma unroll
                for (int i = 0; i < 16; ++i) { const int x = (i & 3) + 8 * (i >> 2) + 4 * h; if (x > c) p[i] = NEG; }
            }
            float mt = p[0];
#pragma unroll
            for (int i = 1; i < 16; ++i) mt = fmaxf(mt, p[i]);
            mt = half_max(mt);
            const float mn = fmaxf(m, mt), alpha = __builtin_amdgcn_exp2f(m - mn);
            m = mn;
            float ps = 0.f;
#pragma unroll
            for (int i = 0; i < 16; ++i) { p[i] = __builtin_amdgcn_exp2f(p[i] - mn); ps += p[i]; }
            l = l * alpha + ps;
#pragma unroll
            for (int i = 0; i < 16; ++i) { o0[i] *= alpha; o1[i] *= alpha; }
            bf16x8 pb[2];
#pragma unroll
            for (int s2 = 0; s2 < 2; ++s2) { v4u t; t.x = cvtpk(p[8 * s2 + 0], p[8 * s2 + 1]); t.y = cvtpk(p[8 * s2 + 2], p[8 * s2 + 3]); t.z = cvtpk(p[8 * s2 + 4], p[8 * s2 + 5]); t.w = cvtpk(p[8 * s2 + 6], p[8 * s2 + 7]); pb[s2] = __builtin_bit_cast(bf16x8, t); }
#pragma unroll
            for (int s2 = 0; s2 < 2; ++s2) {
#pragma unroll
                for (int db = 0; db < 2; ++db) {
                    const LAS unsigned char* vp = vbp + kbi * 4096 + s2 * 2048 + (db ? voff1 : voff0);
                    const v4i16_t lo = __builtin_amdgcn_ds_read_tr16_b64_v4i16((LAS v4i16_t*)vp);
                    const v4i16_t hi = __builtin_amdgcn_ds_read_tr16_b64_v4i16((LAS v4i16_t*)(vp + 1024));
                    const bf16x8 vf = {lo[0], lo[1], lo[2], lo[3], hi[0], hi[1], hi[2], hi[3]};
                    if (db == 0) o0 = __builtin_amdgcn_mfma_f32_32x32x16_bf16(vf, pb[s2], o0, 0, 0, 0);
                    else o1 = __builtin_amdgcn_mfma_f32_32x32x16_bf16(vf, pb[s2], o1, 0, 0, 0);
                }
            }
        }
    }
    const float lt = half_sum(l), inv = 1.0f / lt;
#pragma unroll
    for (int g4 = 0; g4 < 4; ++g4) {
        v2u a, b;
        a.x = cvtpk(o0[4 * g4 + 0] * inv, o0[4 * g4 + 1] * inv); a.y = cvtpk(o0[4 * g4 + 2] * inv, o0[4 * g4 + 3] * inv);
        b.x = cvtpk(o1[4 * g4 + 0] * inv, o1[4 * g4 + 1] * inv); b.y = cvtpk(o1[4 * g4 + 2] * inv, o1[4 * g4 + 3] * inv);
        if (d.o8) { unsigned char* o8p = (unsigned char*)d.Op; const float sc = inv * Y8_SCALE;
            *(GAS unsigned*)(o8p + 8 * g4 + 4 * h) = pk4_fp8(o0[4 * g4 + 0] * sc, o0[4 * g4 + 1] * sc, o0[4 * g4 + 2] * sc, o0[4 * g4 + 3] * sc);
            *(GAS unsigned*)(o8p + 32 + 8 * g4 + 4 * h) = pk4_fp8(o1[4 * g4 + 0] * sc, o1[4 * g4 + 1] * sc, o1[4 * g4 + 2] * sc, o1[4 * g4 + 3] * sc); }
        else {
        *(GAS v2u*)(d.Op + 8 * g4 + 4 * h) = a;
        *(GAS v2u*)(d.Op + 32 + 8 * g4 + 4 * h) = b; }
    }
    if (d.Lp) { if (h == 0) *d.Lp = m + __builtin_amdgcn_logf(lt); }
}
__device__ __forceinline__ void attn_compute(const AUnit& d, const LAS unsigned char* KL, const LAS unsigned char* VL, int lane, const bf16x8 (&qf)[4]) {
    const int c = lane & 31, h = (lane >> 5) & 1;
    int koff[4];
    { const int kswz = (c >> 1) & 7;
#pragma unroll
      for (int s4 = 0; s4 < 4; ++s4) koff[s4] = c * 128 + (((2 * s4 + h) ^ kswz) << 4); }
    const int vrow = 4 * h + ((lane & 15) >> 2), vsw = (lane >> 3) & 1;
    const int voff0 = vrow * 128 + ((32 * ((lane >> 4) & 1) + 8 * (lane & 3)) ^ (vsw << 6)), voff1 = voff0 ^ 64;
    const float NEG = -INFINITY;
    float m = d.m0;
    f32x16 o0, o1, L;
#pragma unroll
    for (int i = 0; i < 16; ++i) { o0[i] = 0.f; o1[i] = 0.f; L[i] = 0.f; }
    v4u onesu = {0x3F803F80u, 0x3F803F80u, 0x3F803F80u, 0x3F803F80u}; asm volatile("" : "+v"(onesu));
    const bf16x8 ones = __builtin_bit_cast(bf16x8, onesu);
    const LAS unsigned char* kbp = KL + d.kb0 * 4096; const LAS unsigned char* vbp = VL + d.kb0 * 4096;
    const int clo = c + d.lo;
#pragma unroll
    for (int kbi = 0; kbi < 5; ++kbi) {
        {
            constexpr bool first_dummy = false; (void)first_dummy;
            const bool first = (kbi == 0);
            const float cinit = first ? 0.f : -m;
            f32x16 p;
#pragma unroll
            for (int i = 0; i < 16; ++i) p[i] = cinit;
#pragma unroll
            for (int s4 = 0; s4 < 4; ++s4) { const bf16x8 kf = *(const LAS bf16x8*)(kbp + kbi * 4096 + koff[s4]); p = __builtin_amdgcn_mfma_f32_32x32x16_bf16(kf, qf[s4], p, 0, 0, 0); }
            if (kbi == 0) {
#pragma unroll
                for (int i = 0; i < 16; ++i) { const int x = (i & 3) + 8 * (i >> 2) + 4 * h; p[i] = x < clo ? NEG : p[i]; }
            }
            if (kbi == 4) {
#pragma unroll
                for (int i = 0; i < 16; ++i) { const int x = (i & 3) + 8 * (i >> 2) + 4 * h; p[i] = x > c ? NEG : p[i]; }
            }
            float t0 = max3f(p[0], p[4], p[8]), t1 = max3f(p[1], p[5], p[9]), t2 = max3f(p[2], p[6], p[10]), t3 = max3f(p[3], p[7], p[11]);
            t0 = max3f(t0, p[12], p[13]); t1 = max3f(t1, p[14], p[15]);
            const float mt = half_max(max3f(max3f(t0, t1, t2), t3, t3));
            if (first) {
                const float mn = fmaxf(m, mt), l0 = d.m0 > -1e29f ? __builtin_amdgcn_exp2f(m - mn) : 0.f;
                m = mn;
#pragma unroll
                for (int i = 0; i < 16; ++i) { p[i] -= mn; L[i] = l0; }
            } else if (__any(mt > 8.0f)) {
                const float dl = fmaxf(mt, 0.f), al = __builtin_amdgcn_exp2f(-dl);
                m += dl;
#pragma unroll
                for (int i = 0; i < 16; ++i) { o0[i] *= al; o1[i] *= al; L[i] *= al; p[i] -= dl; }
            }
#pragma unroll
            for (int i = 0; i < 16; ++i) p[i] = __builtin_amdgcn_exp2f(p[i]);
            bf16x8 pb[2];
#pragma unroll
            for (int s2 = 0; s2 < 2; ++s2) { v4u t; t.x = cvtpk(p[8 * s2 + 0], p[8 * s2 + 1]); t.y = cvtpk(p[8 * s2 + 2], p[8 * s2 + 3]); t.z = cvtpk(p[8 * s2 + 4], p[8 * s2 + 5]); t.w = cvtpk(p[8 * s2 + 6], p[8 * s2 + 7]); pb[s2] = __builtin_bit_cast(bf16x8, t); }
#pragma unroll
            for (int s2 = 0; s2 < 2; ++s2) {
                L = __builtin_amdgcn_mfma_f32_32x32x16_bf16(ones, pb[s2], L, 0, 0, 0);
#pragma unroll
                for (int db = 0; db < 2; ++db) {
                    const LAS unsigned char* vp = vbp + kbi * 4096 + s2 * 2048 + (db ? voff1 : voff0);
                    const v4i16_t lo = __builtin_amdgcn_ds_read_tr16_b64_v4i16((LAS v4i16_t*)vp);
                    const v4i16_t hi = __builtin_amdgcn_ds_read_tr16_b64_v4i16((LAS v4i16_t*)(vp + 1024));
                    const bf16x8 vf = {lo[0], lo[1], lo[2], lo[3], hi[0], hi[1], hi[2], hi[3]};
                    if (db == 0) o0 = __builtin_amdgcn_mfma_f32_32x32x16_bf16(vf, pb[s2], o0, 0, 0, 0);
                    else o1 = __builtin_amdgcn_mfma_f32_32x32x16_bf16(vf, pb[s2], o1, 0, 0, 0);
                }
            }
        }
    }
    const float lt = L[0], inv = 1.0f / lt;
#pragma unroll
    for (int g4 = 0; g4 < 4; ++g4) {
        v2u a, b;
        a.x = cvtpk(o0[4 * g4 + 0] * inv, o0[4 * g4 + 1] * inv); a.y = cvtpk(o0[4 * g4 + 2] * inv, o0[4 * g4 + 3] * inv);
        b.x = cvtpk(o1[4 * g4 + 0] * inv, o1[4 * g4 + 1] * inv); b.y = cvtpk(o1[4 * g4 + 2] * inv, o1[4 * g4 + 3] * inv);
        if (d.o8) { unsigned char* o8p = (unsigned char*)d.Op; const float sc = inv * Y8_SCALE;
            *(GAS unsigned*)(o8p + 8 * g4 + 4 * h) = pk4_fp8(o0[4 * g4 + 0] * sc, o0[4 * g4 + 1] * sc, o0[4 * g4 + 2] * sc, o0[4 * g4 + 3] * sc);
            *(GAS unsigned*)(o8p + 32 + 8 * g4 + 4 * h) = pk4_fp8(o1[4 * g4 + 0] * sc, o1[4 * g4 + 1] * sc, o1[4 * g4 + 2] * sc, o1[4 * g4 + 3] * sc); }
        else {
        *(GAS v2u*)(d.Op + 8 * g4 + 4 * h) = a;
        *(GAS v2u*)(d.Op + 32 + 8 * g4 + 4 * h) = b; }
    }
    if (d.Lp) { if (h == 0) *d.Lp = m + __builtin_amdgcn_logf(lt); }
}
__device__ __forceinline__ void p2_attn(Frame& F, int ch) {
    int tid_ = threadIdx.x; asm volatile("" : "+v"(tid_));
    const int tid = tid_, lane = tid & 63;
    LAS unsigned char* KL = F.lds; LAS unsigned char* VL = F.lds + ATT_VOFF;
    constexpr int NUA = (TC / SEQ) * 3 * 8 * 16, NUB = (TC / SEQ) * 2 * 128, NU = NUA + NUB;
    int u = F.vcu;
    if (u >= NU) return;
    AUnit cur, nxt;
    v4u kreg[6], vreg[6]; bf16x8 qn[4];
    attn_decode(F, ch, u, NUA, lane, cur);
    attn_load(cur, tid, lane, kreg, vreg, qn);
    for (;;) {
        attn_write(cur, KL, VL, tid, kreg, vreg);
        bf16x8 qf[4];
#pragma unroll
        for (int s4 = 0; s4 < 4; ++s4) qf[s4] = qn[s4];
        __syncthreads();
        const int un = u + F.G; const bool has_next = un < NU;
        if (has_next) { attn_decode(F, ch, un, NUA, lane, nxt); attn_load(nxt, tid, lane, kreg, vreg, qn); }
        if (cur.kk_lo == 0) attn_compute(cur, KL, VL, lane, qf); else attn_compute_edge(cur, KL, VL, lane, qf);
        __syncthreads();
        if (!has_next) break;
        cur = nxt; u = un;
    }
}
__device__ __forceinline__ void p2_combine(Frame& F, int ch, int cu, int ncu) {
    int tid_ = threadIdx.x; asm volatile("" : "+v"(tid_)); const int lane_ = tid_ & 63;
    unsigned char* ws = F.ws;
    const bf16* OG = (const bf16*)((const unsigned char*)F.out + DO_OG); const float* LSE = (const float*)((const unsigned char*)F.out + DO_LSE);
    bf16* Y = (bf16*)(ws + WS_Y) + (size_t)ch * TC * Y_W; unsigned char* Y8 = ws + WS_Y + (size_t)ch * TC * Y_W;
    const int lane = lane_, hd = lane >> 3;
    const int gw = cu * NWAVES + F.wave, NGW = ncu * NWAVES;
    for (int row0 = gw; row0 < TC; row0 += 4 * NGW) {
        float lg[4][3]; v4u og[4][3];
#pragma unroll
        for (int r = 0; r < 4; ++r) { const int row = row0 + r * NGW < TC ? row0 + r * NGW : row0;
#pragma unroll
            for (int g = 0; g < 3; ++g) { lg[r][g] = LSE[((size_t)g * TC + row) * 8 + hd]; og[r][g] = *(const GAS v4u*)(OG + ((size_t)g * TC + row) * 512 + lane * 8); } }
#pragma unroll
        for (int r = 0; r < 4; ++r) { const int row = row0 + r * NGW; if (row >= TC) continue;
            const float mx = fmaxf(fmaxf(lg[r][0], lg[r][1]), lg[r][2]);
            float e[3]; e[0] = __builtin_amdgcn_exp2f(lg[r][0] - mx); e[1] = __builtin_amdgcn_exp2f(lg[r][1] - mx); e[2] = __builtin_amdgcn_exp2f(lg[r][2] - mx);
            const float inv = 1.0f / (e[0] + e[1] + e[2]);
            float acc[8];
#pragma unroll
            for (int i = 0; i < 8; ++i) acc[i] = 0.f;
#pragma unroll
            for (int g = 0; g < 3; ++g) { const float wg = e[g] * inv; const v4u o_ = og[r][g];
                acc[0] += wg * bflo(o_.x); acc[1] += wg * bfhi(o_.x); acc[2] += wg * bflo(o_.y); acc[3] += wg * bfhi(o_.y);
                acc[4] += wg * bflo(o_.z); acc[5] += wg * bfhi(o_.z); acc[6] += wg * bflo(o_.w); acc[7] += wg * bfhi(o_.w); }
            v4u o; o.x = cvtpk(acc[0], acc[1]); o.y = cvtpk(acc[2], acc[3]); o.z = cvtpk(acc[4], acc[5]); o.w = cvtpk(acc[6], acc[7]);
            if (P34_FP8) { v2u o8; o8.x = pk4_fp8(acc[0] * Y8_SCALE, acc[1] * Y8_SCALE, acc[2] * Y8_SCALE, acc[3] * Y8_SCALE); o8.y = pk4_fp8(acc[4] * Y8_SCALE, acc[5] * Y8_SCALE, acc[6] * Y8_SCALE, acc[7] * Y8_SCALE); *(GAS v2u*)(Y8 + (size_t)row * Y_W + lane * 8) = o8; }
            else *(GAS v4u*)(Y + (size_t)row * Y_W + lane * 8) = o; }
    }
}


struct EpiMerge {
    static constexpr bool PERM = true; static constexpr int HOOK_T = P34_FP8 ? 4 : 8;
    const bf16* Gt; bf16* MG;
    __device__ __forceinline__ void hook(f32x4 (&acc)[2][2][4][2], const pg9::Unit& u, int wr, int wc, int fr, int fq) const {
        asm volatile("" : "+v"(fr), "+v"(fq));
        const bf16* gr = Gt + (size_t)(u.pm * 256 + wr * 64 + fr) * G_W + u.pn * 256 + wc * 32 + 8 * fq;
        v4u rv[8][2];
#pragma unroll
        for (int rg = 0; rg < 8; ++rg)
#pragma unroll
            for (int bj = 0; bj < 2; ++bj) rv[rg][bj] = *(const GAS v4u*)(gr + (size_t)((rg >> 2) * 128 + (rg & 3) * 16) * G_W + bj * 128);
#pragma unroll
        for (int rg = 0; rg < 8; ++rg)
#pragma unroll
            for (int bj = 0; bj < 2; ++bj) { const v4u a = rv[rg][bj];
                const f32x4 r0 = {bflo(a.x), bfhi(a.x), bflo(a.y), bfhi(a.y)}, r1 = {bflo(a.z), bfhi(a.z), bflo(a.w), bfhi(a.w)};
                acc[rg >> 2][bj][rg & 3][0] = acc[rg >> 2][bj][rg & 3][0] * r0; acc[rg >> 2][bj][rg & 3][1] = acc[rg >> 2][bj][rg & 3][1] * r1; }
    }
    __device__ __forceinline__ void operator()(const f32x4 (&acc)[2][2][4][2], const pg9::Unit& u, int wr, int wc, int fr, int fq) const {
        asm volatile("" : "+v"(fr), "+v"(fq));
        const bf16* gr = Gt + (size_t)(u.pm * 256 + wr * 64 + fr) * G_W + 1024 + u.pn * 256 + wc * 32 + 8 * fq;
        bf16* mr = MG + (size_t)(u.pm * 256 + wr * 64 + fr) * D + u.pn * 256 + wc * 32 + 8 * fq;
        v4u gb[8][2];
#pragma unroll
        for (int rg = 0; rg < 8; ++rg)
#pragma unroll
            for (int bj = 0; bj < 2; ++bj) gb[rg][bj] = *(const GAS v4u*)(gr + (size_t)((rg >> 2) * 128 + (rg & 3) * 16) * G_W + bj * 128);
#pragma unroll
        for (int rg = 0; rg < 8; ++rg)
#pragma unroll
            for (int bj = 0; bj < 2; ++bj) { const v4u b = gb[rg][bj];
                const f32x4 v0 = acc[rg >> 2][bj][rg & 3][0], v1 = acc[rg >> 2][bj][rg & 3][1];
                if (P34_FP8) { constexpr float f = MG8_SCALE / (W34_SCALE * Y8_SCALE); unsigned char* m8 = (unsigned char*)MG + (size_t)(u.pm * 256 + wr * 64 + fr) * D + u.pn * 256 + wc * 32 + 8 * fq;
                    v2u w8; w8.x = pk4_fp8(v0[0] * bflo(b.x) * f, v0[1] * bfhi(b.x) * f, v0[2] * bflo(b.y) * f, v0[3] * bfhi(b.y) * f); w8.y = pk4_fp8(v1[0] * bflo(b.z) * f, v1[1] * bfhi(b.z) * f, v1[2] * bflo(b.w) * f, v1[3] * bfhi(b.w) * f);
                    *(GAS v2u*)(m8 + (size_t)((rg >> 2) * 128 + (rg & 3) * 16) * D + bj * 128) = w8; }
                else {
                v4u w; w.x = cvtpk(v0[0] * bflo(b.x), v0[1] * bfhi(b.x)); w.y = cvtpk(v0[2] * bflo(b.y), v0[3] * bfhi(b.y));
                w.z = cvtpk(v1[0] * bflo(b.z), v1[1] * bfhi(b.z)); w.w = cvtpk(v1[2] * bflo(b.w), v1[3] * bfhi(b.w));
                *(GAS v4u*)(mr + (size_t)((rg >> 2) * 128 + (rg & 3) * 16) * D + bj * 128) = w; } }
    }
};
__device__ __forceinline__ void p3_merge(Frame& F) {
    unsigned char* ws = F.ws;
    pg9::DenseOrder S; S.init(T, D, F.G, (int)blockIdx.x);
    EpiMerge E{(const bf16*)(ws + WS_G), (bf16*)(ws + WS_MG)};
    constexpr int ES = P34_FP8 ? 1 : 2;
    pg9::DenseA ao{(unsigned)(Y_W * ES)}; pg9::DenseB bb{(const char*)(ws + WS_WAB), (size_t)256 * Y_W * ES};
    pg9::gemm_phase<ES>(F.lds, (const char*)(ws + WS_Y), Y_W, S, E, ao, bb);
}
struct EpiOut {
    static constexpr bool PERM = true; static constexpr int HOOK_T = -1;
    bf16* DELTA;
    __device__ __forceinline__ void hook(f32x4 (&)[2][2][4][2], const pg9::Unit&, int, int, int, int) const {}
    __device__ __forceinline__ void operator()(const f32x4 (&acc)[2][2][4][2], const pg9::Unit& u, int wr, int wc, int fr, int fq) const {
        asm volatile("" : "+v"(fr), "+v"(fq));
        bf16* orow = DELTA + (size_t)(u.pm * 256 + wr * 64 + fr) * D + u.pn * 256 + wc * 32 + 8 * fq;
#pragma unroll
        for (int ai = 0; ai < 2; ++ai)
#pragma unroll
            for (int m = 0; m < 4; ++m)
#pragma unroll
                for (int bj = 0; bj < 2; ++bj) { constexpr float f = P34_FP8 ? 1.0f / (W34_SCALE * MG8_SCALE) : 1.0f; const f32x4 o0 = acc[ai][bj][m][0] * f, o1 = acc[ai][bj][m][1] * f;
                    v4u w; w.x = cvtpk(o0[0], o0[1]); w.y = cvtpk(o0[2], o0[3]); w.z = cvtpk(o1[0], o1[1]); w.w = cvtpk(o1[2], o1[3]); *(GAS v4u*)(orow + (size_t)(ai * 128 + m * 16) * D + bj * 128) = w; }
    }
};
__device__ __forceinline__ void p4_outproj(Frame& F) {
    unsigned char* ws = F.ws;
    pg9::DenseOrder S; S.init(T, D, F.G, (int)blockIdx.x);
    EpiOut E{(bf16*)((unsigned char*)F.out + DO_DELTA)};
    constexpr int ES = P34_FP8 ? 1 : 2;
    pg9::DenseA ao{(unsigned)(D * ES)}; pg9::DenseB bb{(const char*)(ws + WS_WO), (size_t)256 * D * ES};
    pg9::gemm_phase<ES>(F.lds, (const char*)(ws + WS_MG), D, S, E, ao, bb);
}

__device__ __forceinline__ void p5_route(Frame& F) {
    int tid_ = threadIdx.x; asm volatile("" : "+v"(tid_)); const int lane = tid_ & 63;
    unsigned char* ws = F.ws;
    const float* X = F.in[I_X]; const bf16* DELTA = (const bf16*)((const unsigned char*)F.out + DO_DELTA);
    bf16* X1B = (bf16*)(ws + WS_X1B); unsigned char* X1F8 = ws + WS_X1F8;
    unsigned* cnt = (unsigned*)(ws + WS_CTL) + CW_CNT;
    int* tokof = (int*)(ws + WS_TOKOF); float2* wtof = (float2*)(ws + WS_WTOF); int4* tpos = (int4*)(ws + WS_TPOS);
    const v4u* WRF = (const v4u*)(ws + WS_WRF);
    LAS v4u* wl = (LAS v4u*)F.lds;
    LAS float* sl = (LAS float*)(F.lds + 98304 + F.wave * 4096);
    const int i = lane & 15, q = lane >> 4;
    LAS unsigned* hist = (LAS unsigned*)(F.lds + LDS_MISC + 2048);
    for (int wt = F.vcu; wt < T / 128; wt += F.G) {
        const int tile = wt * NWAVES + F.wave;
        if (tid_ < 32) hist[tid_] = 0u;
        const size_t roff = (size_t)(tile * 16 + i) * D + 8 * q;
        const float* xr = X + roff; const bf16* dr = DELTA + roff;
        f32x4 a0 = {0.f, 0.f, 0.f, 0.f}, a1 = a0, a2 = a0; float ss = 0.f;
        f32x4 va[8][2]; v4u vd[8];
#pragma unroll
        for (int j = 0; j < 8; ++j) { va[j][0] = *(const GAS f32x4*)(xr + 32 * j); va[j][1] = *(const GAS f32x4*)(xr + 32 * j + 4); vd[j] = *(const GAS v4u*)(dr + 32 * j); }
#pragma unroll 1
        for (int half = 0; half < 2; ++half) {
            __syncthreads();
            { v4u t[12];
#pragma unroll
              for (int k = 0; k < 12; ++k) t[k] = WRF[half * 6144 + k * 512 + tid_];
#pragma unroll
              for (int k = 0; k < 12; ++k) wl[k * 512 + tid_] = t[k]; }
            __syncthreads();
#pragma unroll 1
            for (int sb = 0; sb < 2; ++sb) {
#pragma unroll
                for (int j = 0; j < 8; ++j) {
                    const int ksl = sb * 8 + j, ks = half * 16 + ksl;
                    const v4u dd = vd[j];
                    const f32x4 v0 = va[j][0] + (f32x4){bflo(dd.x), bfhi(dd.x), bflo(dd.y), bfhi(dd.y)}, v1 = va[j][1] + (f32x4){bflo(dd.z), bfhi(dd.z), bflo(dd.w), bfhi(dd.w)};
                    if (ks + 8 < 32) { va[j][0] = *(const GAS f32x4*)(xr + 32 * (ks + 8)); va[j][1] = *(const GAS f32x4*)(xr + 32 * (ks + 8) + 4); vd[j] = *(const GAS v4u*)(dr + 32 * (ks + 8)); }
                    ss += ((v0[0] * v0[0] + v0[1] * v0[1]) + (v0[2] * v0[2] + v0[3] * v0[3])) + ((v1[0] * v1[0] + v1[1] * v1[1]) + (v1[2] * v1[2] + v1[3] * v1[3]));
                    v4u hu; hu.x = cvtpk(v0[0], v0[1]); hu.y = cvtpk(v0[2], v0[3]); hu.z = cvtpk(v1[0], v1[1]); hu.w = cvtpk(v1[2], v1[3]);
                    v4u lu; lu.x = cvtpk(v0[0] - bflo(hu.x), v0[1] - bfhi(hu.x)); lu.y = cvtpk(v0[2] - bflo(hu.y), v0[3] - bfhi(hu.y)); lu.z = cvtpk(v1[0] - bflo(hu.z), v1[1] - bfhi(hu.z)); lu.w = cvtpk(v1[2] - bflo(hu.w), v1[3] - bfhi(hu.w));
                    *(GAS v4u*)(X1B + roff + 32 * ks) = hu;
                    if (P6_FP8) { v2u w8; w8.x = pk4_fp8(v0[0], v0[1], v0[2], v0[3]); w8.y = pk4_fp8(v1[0], v1[1], v1[2], v1[3]); *(GAS v2u*)(X1F8 + roff + 32 * ks) = w8; }
                    const bf16x8 ah = __builtin_bit_cast(bf16x8, hu), al = __builtin_bit_cast(bf16x8, lu);
#pragma unroll
                    for (int nb = 0; nb < 3; ++nb) {
                        const bf16x8 bh = __builtin_bit_cast(bf16x8, wl[((ksl * 3 + nb) * 2 + 0) * 64 + lane]), bl = __builtin_bit_cast(bf16x8, wl[((ksl * 3 + nb) * 2 + 1) * 64 + lane]);
                        f32x4 acc = nb == 0 ? a0 : (nb == 1 ? a1 : a2);
                        acc = __builtin_amdgcn_mfma_f32_16x16x32_bf16(ah, bh, acc, 0, 0, 0); acc = __builtin_amdgcn_mfma_f32_16x16x32_bf16(ah, bl, acc, 0, 0, 0); acc = __builtin_amdgcn_mfma_f32_16x16x32_bf16(al, bh, acc, 0, 0, 0);
                        if (nb == 0) a0 = acc; else if (nb == 1) a1 = acc; else a2 = acc;
                    }
                }
            }
        }
        ss += __shfl_xor(ss, 16); ss += __shfl_xor(ss, 32);
#pragma unroll
        for (int r = 0; r < 4; ++r) { sl[(4 * q + r) * 48 + i] = a0[r]; sl[(4 * q + r) * 48 + 16 + i] = a1[r]; sl[(4 * q + r) * 48 + 32 + i] = a2[r]; }
        LDS_WAIT(); asm volatile("" ::: "memory");
        int e0 = 0, e1 = 0, lp0 = 0, lp1 = 0; float w1 = 0.f, w2 = 0.f, rstd = 0.f;
        __syncthreads();
        if (lane < 16) {
            rstd = 1.0f / sqrtf(ss * (1.f / D) + RMS_EPS);
            float lg[36];
#pragma unroll
            for (int o = 0; o < 36; ++o) lg[o] = sl[lane * 48 + o] * rstd + (o < 4 ? F.in[I_BRG][o] : F.in[I_BRE][o - 4]);
            int gsel = 0; float gmax = lg[0];
#pragma unroll
            for (int k = 1; k < 4; ++k) if (lg[k] > gmax) { gmax = lg[k]; gsel = k; }
            float gden = 0.f;
#pragma unroll
            for (int k = 0; k < 4; ++k) gden += __expf(lg[k] - gmax);
            const float pg = 1.0f / gden;
            float le[8];
#pragma unroll
            for (int j = 0; j < 8; ++j) { le[j] = lg[4 + j];
#pragma unroll
                for (int gi = 1; gi < 4; ++gi) le[j] = (gsel == gi) ? lg[4 + gi * 8 + j] : le[j]; }
            int i1 = 0; float m1 = le[0];
#pragma unroll
            for (int j = 1; j < 8; ++j) if (le[j] > m1) { m1 = le[j]; i1 = j; }
            int i2 = -1; float m2 = -INFINITY;
#pragma unroll
            for (int j = 0; j < 8; ++j) if (j != i1 && le[j] > m2) { m2 = le[j]; i2 = j; }
            const float e2 = __expf(m2 - m1);
            w1 = pg / (1.0f + e2); w2 = pg * e2 / (1.0f + e2);
            e0 = gsel * 8 + i1; e1 = gsel * 8 + i2;
            lp0 = (int)__hip_atomic_fetch_add(&hist[e0], 1u, __ATOMIC_RELAXED, __HIP_MEMORY_SCOPE_WORKGROUP);
            lp1 = (int)__hip_atomic_fetch_add(&hist[e1], 1u, __ATOMIC_RELAXED, __HIP_MEMORY_SCOPE_WORKGROUP);
        }
        __syncthreads();
        if (tid_ < 32) { const unsigned n = hist[tid_]; hist[32 + tid_] = n ? atomicAdd(&cnt[64 * tid_], n) : 0u; }
        __syncthreads();
        if (lane < 16) {
            const int row = tile * 16 + lane;
            const int p0 = (int)hist[32 + e0] + lp0, p1 = (int)hist[32 + e1] + lp1;
            tokof[(size_t)e0 * T + p0] = row; wtof[(size_t)e0 * T + p0] = make_float2(w1, rstd);
            tokof[(size_t)e1 * T + p1] = row; wtof[(size_t)e1 * T + p1] = make_float2(w2, rstd);
            tpos[row] = make_int4(e0, p0, e1, p1);
        }
        __syncthreads();
    }
}

__device__ __forceinline__ void expert_tiles(Frame& F, LAS int* tb, LAS int* cn) {
    int tid_ = threadIdx.x; asm volatile("" : "+v"(tid_)); const int lane_ = tid_ & 63;
    if (tid_ == 0) {
        const unsigned* cnt = (const unsigned*)(F.ws + WS_CTL) + CW_CNT;
        int acc = 0;
        for (int e = 0; e < NE; ++e) { const int c = (int)__hip_atomic_load(cnt + 64 * e, __ATOMIC_RELAXED, __HIP_MEMORY_SCOPE_AGENT); cn[e] = c; tb[e] = acc; acc += (c + 255) >> 8; }
        tb[NE] = acc;
    }
    __syncthreads();
}

struct MoeOrder { const LAS int* tb; int ncol, G, c;
    __device__ bool next(int i, pg9::Unit& u) const {
        const int L = i * G + c; if (L >= tb[NE] * ncol) return false;
        const int rt = L / ncol; int e = 0;
        for (int k = 1; k < NE; ++k) if (tb[k] <= rt) e = k;
        u.pm = rt; u.pn = L % ncol; u.e = e; return true; } };
struct GatherA { static constexpr bool GATHER = true; unsigned rowbytes; const int* tokof; const LAS int* tb; const LAS int* cn;
    __device__ __forceinline__ unsigned operator()(const pg9::Unit& u, int row) const {
        const int p = (u.pm - tb[u.e]) * 256 + row; const int tok = tokof[(size_t)u.e * T + (p < cn[u.e] ? p : 0)]; return (unsigned)tok * rowbytes; } };
struct ExpertB { const char* W; size_t ebytes, tilebytes; __device__ __forceinline__ const char* operator()(const pg9::Unit& u) const { return W + (size_t)u.e * ebytes + (size_t)u.pn * tilebytes; } };
struct EpiGateUp {
    static constexpr bool PERM = true; static constexpr int HOOK_T = -1;
    const float2* wtof; bf16* HACT; const LAS int* tb; const LAS int* cn; float ascale;
    __device__ __forceinline__ void hook(f32x4 (&)[2][2][4][2], const pg9::Unit&, int, int, int, int) const {}
    __device__ __forceinline__ void operator()(const f32x4 (&acc)[2][2][4][2], const pg9::Unit& u, int wr, int wc, int fr, int fq) const {
        asm volatile("" : "+v"(fr), "+v"(fq));
        const int r0 = wr * 64 + fr, p0 = (u.pm - tb[u.e]) * 256, ce = cn[u.e];
        const float2* wp = wtof + (size_t)u.e * T;
#pragma unroll
        for (int ai = 0; ai < 2; ++ai) {
            float2 wv[4];
#pragma unroll
            for (int m = 0; m < 4; ++m) { const int p = p0 + r0 + ai * 128 + m * 16; wv[m] = p < ce ? wp[p] : make_float2(0.f, 0.f); }
#pragma unroll
            for (int m = 0; m < 4; ++m) { const int r = r0 + ai * 128 + m * 16;
                const float w = wv[m].x, rs = wv[m].y * ascale;
                bf16* orow = HACT + (size_t)(u.pm * 256 + r) * DE + u.pn * 128 + wc * 16 + 4 * fq; unsigned char* orow8 = (unsigned char*)HACT + (size_t)(u.pm * 256 + r) * DE + u.pn * 128 + wc * 16 + 4 * fq;
#pragma unroll
                for (int bj = 0; bj < 2; ++bj) { const f32x4 g = acc[ai][bj][m][0], uu = acc[ai][bj][m][1]; f32x4 hv;
#pragma unroll
                    for (int e = 0; e < 4; ++e) { const float gg = g[e] * rs; hv[e] = gg / (1.0f + __expf(-gg)) * (uu[e] * rs) * w; }
                    if (P6_FP8) *(GAS unsigned*)(orow8 + bj * 64) = pk4_fp8(hv[0] * H8_SCALE, hv[1] * H8_SCALE, hv[2] * H8_SCALE, hv[3] * H8_SCALE);
                    else { v2u o; o.x = cvtpk(hv[0], hv[1]); o.y = cvtpk(hv[2], hv[3]); *(GAS v2u*)(orow + bj * 64) = o; } } }
        }
    }
};
__device__ __forceinline__ void p6a_gateup(Frame& F) {
    unsigned char* ws = F.ws;
    LAS int* tb = (LAS int*)(F.lds + LDS_MISC + 1024); LAS int* cn = tb + 64;
    expert_tiles(F, tb, cn);
    MoeOrder S{tb, 2, F.G, F.vcu};
    constexpr int ES = P6_FP8 ? 1 : 2;
    GatherA ao{(unsigned)(D * ES), (const int*)(ws + WS_TOKOF), tb, cn}; ExpertB bb{(const char*)(ws + WS_WGU), (size_t)512 * D * ES, (size_t)256 * D * ES};
    EpiGateUp E{(const float2*)(ws + WS_WTOF), (bf16*)(ws + WS_HACT), tb, cn, P6_FP8 ? 1.0f / WG8_SCALE : 1.0f};
    pg9::gemm_phase<ES>(F.lds, (const char*)(ws + (P6_FP8 ? WS_X1F8 : WS_X1B)), D, S, E, ao, bb);
}
struct EpiDown {
    static constexpr bool PERM = true; static constexpr int HOOK_T = -1;
    bf16* YS; float ascale;
    __device__ __forceinline__ void hook(f32x4 (&)[2][2][4][2], const pg9::Unit&, int, int, int, int) const {}
    __device__ __forceinline__ void operator()(const f32x4 (&acc)[2][2][4][2], const pg9::Unit& u, int wr, int wc, int fr, int fq) const {
        asm volatile("" : "+v"(fr), "+v"(fq));
#pragma unroll
        for (int ai = 0; ai < 2; ++ai)
#pragma unroll
            for (int m = 0; m < 4; ++m) { bf16* orow = YS + (size_t)(u.pm * 256 + wr * 64 + fr + ai * 128 + m * 16) * D + u.pn * 256 + wc * 32 + 8 * fq;
#pragma unroll
                for (int bj = 0; bj < 2; ++bj) { const f32x4 v0 = acc[ai][bj][m][0] * ascale, v1 = acc[ai][bj][m][1] * ascale;
                    if (YS_FP8) { unsigned char* o8 = (unsigned char*)YS + (size_t)(u.pm * 256 + wr * 64 + fr + ai * 128 + m * 16) * D + u.pn * 256 + wc * 32 + 8 * fq + bj * 128;
                        v2u w8; w8.x = pk4_fp8(v0[0] * YS8_SCALE, v0[1] * YS8_SCALE, v0[2] * YS8_SCALE, v0[3] * YS8_SCALE); w8.y = pk4_fp8(v1[0] * YS8_SCALE, v1[1] * YS8_SCALE, v1[2] * YS8_SCALE, v1[3] * YS8_SCALE); *(GAS v2u*)o8 = w8; }
                    else { v4u w; w.x = cvtpk(v0[0], v0[1]); w.y = cvtpk(v0[2], v0[3]); w.z = cvtpk(v1[0], v1[1]); w.w = cvtpk(v1[2], v1[3]); *(GAS v4u*)(orow + bj * 128) = w; } } }
    }
};
__device__ __forceinline__ void p6b_down(Frame& F) {
    unsigned char* ws = F.ws;
    LAS int* tb = (LAS int*)(F.lds + LDS_MISC + 1024); LAS int* cn = tb + 64;
    expert_tiles(F, tb, cn);
    MoeOrder S{tb, 4, F.G, F.vcu};
    constexpr int ES = P6_FP8 ? 1 : 2;
    pg9::DenseA ao{(unsigned)(DE * ES)}; ExpertB bb{(const char*)(ws + WS_WD), (size_t)D * DE * ES, (size_t)256 * DE * ES};
    EpiDown E{(bf16*)(ws + WS_YS), P6_FP8 ? 1.0f / (WD8_SCALE * H8_SCALE) : 1.0f};
    pg9::gemm_phase<ES>(F.lds, (const char*)(ws + WS_HACT), DE, S, E, ao, bb);
}
__device__ __forceinline__ void p7_final(Frame& F) {
    int tid_ = threadIdx.x; asm volatile("" : "+v"(tid_)); const int lane_ = tid_ & 63;
    unsigned char* ws = F.ws;
    LAS int* tb = (LAS int*)(F.lds + LDS_MISC + 1024); LAS int* cn = tb + 64;
    expert_tiles(F, tb, cn);
    const bf16* YS = (const bf16*)(ws + WS_YS); const int4* tpos = (const int4*)(ws + WS_TPOS);
    float* X1 = F.out; const bf16* X1B = (const bf16*)(ws + WS_X1B);
    const int lane = lane_;
    const int gw = F.vcu * NWAVES + F.wave, NGW = F.G * NWAVES;
    const GAS f32x4* gr = (const GAS f32x4*)F.in[I_GFIN] + lane;
    for (int row = gw; row < T; row += NGW) {
        const int4 tp = tpos[row];
        const size_t s0 = (size_t)tb[tp.x] * 256 + tp.y, s1 = (size_t)tb[tp.z] * 256 + tp.w;
        GAS f32x4* xr = (GAS f32x4*)(X1 + (size_t)row * D) + lane; const GAS v2u* xb = (const GAS v2u*)(X1B + (size_t)row * D) + lane;
        const GAS v2u* y0 = (const GAS v2u*)(YS + s0 * D) + lane; const GAS v2u* y1 = (const GAS v2u*)(YS + s1 * D) + lane;
        const GAS unsigned* z0 = (const GAS unsigned*)((const unsigned char*)YS + s0 * D) + lane; const GAS unsigned* z1 = (const GAS unsigned*)((const unsigned char*)YS + s1 * D) + lane;
        f32x4 v[4]; float s = 0.f;
#pragma unroll
        for (int j = 0; j < 4; ++j) { const v2u xx = xb[64 * j]; v[j] = (f32x4){bflo(xx.x), bfhi(xx.x), bflo(xx.y), bfhi(xx.y)};
            if (YS_FP8) { const int a = (int)z0[64 * j], b = (int)z1[64 * j]; typedef float f2_ __attribute__((ext_vector_type(2)));
                const f2_ a0 = __builtin_amdgcn_cvt_pk_f32_fp8(a, false), a1 = __builtin_amdgcn_cvt_pk_f32_fp8(a, true), b0 = __builtin_amdgcn_cvt_pk_f32_fp8(b, false), b1 = __builtin_amdgcn_cvt_pk_f32_fp8(b, true);
                constexpr float f = 1.0f / YS8_SCALE; v[j].x += (a0[0] + b0[0]) * f; v[j].y += (a0[1] + b0[1]) * f; v[j].z += (a1[0] + b1[0]) * f; v[j].w += (a1[1] + b1[1]) * f; }
            else { const v2u a = y0[64 * j], b = y1[64 * j];
            v[j].x += bflo(a.x) + bflo(b.x); v[j].y += bfhi(a.x) + bfhi(b.x); v[j].z += bflo(a.y) + bflo(b.y); v[j].w += bfhi(a.y) + bfhi(b.y); }
            s += (v[j].x * v[j].x + v[j].y * v[j].y) + (v[j].z * v[j].z + v[j].w * v[j].w); }
        const float rstd = 1.0f / sqrtf(wave_sum(s) * (1.f / D) + RMS_EPS);
#pragma unroll
        for (int j = 0; j < 4; ++j) { const f32x4 gg = gr[64 * j]; f32x4 o; o.x = v[j].x * rstd * gg.x; o.y = v[j].y * rstd * gg.y; o.z = v[j].z * rstd * gg.z; o.w = v[j].w * rstd * gg.w; xr[64 * j] = o; }
    }
}

constexpr int NPHASE = 2 * NCH + 8;
__global__ void __launch_bounds__(NTHR, 2) fwd_kernel(KArgs args) {
    extern __shared__ __attribute__((aligned(16))) unsigned char lds_raw[];
    Frame F;
    F.lds = (LAS unsigned char*)lds_raw;
    F.tid = threadIdx.x; F.lane = F.tid & 63; F.wave = __builtin_amdgcn_readfirstlane(F.tid >> 6);
    F.G = gridDim.x; { const int bx = blockIdx.x; F.vcu = (F.G % 8 == 0) ? (bx % 8) * (F.G / 8) + bx / 8 : bx; }
#pragma unroll
    for (int i = 0; i < 17; ++i) F.in[i] = args.in[i];
    F.out = args.out; F.ws = args.ws;
    volatile LAS unsigned* MISC = (volatile LAS unsigned*)(F.lds + LDS_MISC);
    if (F.tid < 64) MISC[F.tid] = 0u;
    __syncthreads();
    XcdBarrier bar = xcd_barrier_post((unsigned*)(F.ws + WS_CTL) + CW_BAR + args.li * XCD_BAR_WORDS, MISC + 8);
#define IN(k) (args.ph_lo <= (k) && (k) < args.ph_hi)
#ifdef PROBE_MASK
    unsigned long long pr_acc = 0, pr_t0 = 0; const bool pr_me = (blockIdx.x == 0 && threadIdx.x == 0);
#define PR_BEGIN(k) do { if (pr_me && ((PROBE_MASK >> (k)) & 1ull)) pr_t0 = __builtin_amdgcn_s_memrealtime(); } while (0)
#define PR_END(k) do { if (pr_me && ((PROBE_MASK >> (k)) & 1ull)) pr_acc += __builtin_amdgcn_s_memrealtime() - pr_t0; } while (0)
#else
#define PR_BEGIN(k) do {} while (0)
#define PR_END(k) do {} while (0)
#endif
#define SEAM(k) do { if (IN(k) && IN((k) + 1)) xcd_barrier(bar); PR_END(k); } while (0)
    PR_BEGIN(0); if (IN(0)) p0_prologue(F);
    SEAM(0);
#pragma unroll 1
    for (int ch = 0; ch < NCH; ++ch) {
        PR_BEGIN(1 + 2 * ch);
        if (IN(1 + 2 * ch)) {
            constexpr int NWG1 = (TC / 256) * (NIN / 256);
            const int nfull = NWG1 % F.G, bx = (int)blockIdx.x;
            if (ch > 0 && nfull == 0) p2_combine(F, ch - 1, F.vcu, F.G);
            p1_inproj(F, ch);
            if (ch > 0 && nfull != 0 && bx >= nfull) p2_combine(F, ch - 1, bx - nfull, F.G - nfull);
        }
        SEAM(1 + 2 * ch);
        PR_BEGIN(2 + 2 * ch); if (IN(2 + 2 * ch)) p2_attn(F, ch);
        SEAM(2 + 2 * ch);
    }
    PR_BEGIN(2 * NCH + 1); if (IN(2 * NCH + 1)) p2_combine(F, NCH - 1, F.vcu, F.G);
    SEAM(2 * NCH + 1);
    PR_BEGIN(2 * NCH + 2); if (IN(2 * NCH + 2)) p3_merge(F);
    SEAM(2 * NCH + 2);
    PR_BEGIN(2 * NCH + 3); if (IN(2 * NCH + 3)) p4_outproj(F);
    SEAM(2 * NCH + 3);
    PR_BEGIN(2 * NCH + 4); if (IN(2 * NCH + 4)) p5_route(F);
    SEAM(2 * NCH + 4);
    PR_BEGIN(2 * NCH + 5); if (IN(2 * NCH + 5)) p6a_gateup(F);
    SEAM(2 * NCH + 5);
    PR_BEGIN(2 * NCH + 6); if (IN(2 * NCH + 6)) p6b_down(F);
    SEAM(2 * NCH + 6);
    PR_BEGIN(2 * NCH + 7); if (IN(2 * NCH + 7)) p7_final(F);
    PR_END(2 * NCH + 7);
#ifdef PROBE_MASK
    if (pr_me) { const unsigned long long t1 = __builtin_amdgcn_s_memrealtime(); while (__builtin_amdgcn_s_memrealtime() - t1 < pr_acc) __builtin_amdgcn_s_sleep(4); }
#endif
#undef IN
#undef SEAM
}

#ifndef N_LAUNCHES
#define N_LAUNCHES 1
#endif
extern "C" void kernel_launch(void* const* d_in, const int* in_sizes, int n_in, void* d_out, int out_size, void* d_ws, size_t ws_size, hipStream_t stream) {
    static int grid = 0;
    if (grid == 0) {
        if (n_in != 17 || in_sizes[0] != T * D || out_size != T * D || ws_size < WS_END) { fprintf(stderr, "kernel_launch: unexpected shapes / workspace (%d inputs, ws %zu)\n", n_in, ws_size); grid = -1; return; }
        int dev = 0, cus = 0;
        if (hipGetDevice(&dev) != hipSuccess || hipDeviceGetAttribute(&cus, hipDeviceAttributeMultiprocessorCount, dev) != hipSuccess) { grid = -1; return; }
        if (hipFuncSetAttribute((const void*)fwd_kernel, hipFuncAttributeMaxDynamicSharedMemorySize, LDS_BYTES) != hipSuccess) { fprintf(stderr, "kernel_launch: hipFuncSetAttribute failed\n"); grid = -1; return; }
        int per_cu = 0;
        if (hipOccupancyMaxActiveBlocksPerMultiprocessor(&per_cu, (const void*)fwd_kernel, NTHR, LDS_BYTES) != hipSuccess || per_cu < 1) fprintf(stderr, "kernel_launch: occupancy query says %d\n", per_cu);
        (void)hipGetLastError();
        grid = cus;
    }
    if (grid < 0) return;
    (void)hipMemsetAsync((char*)d_ws + WS_CTL, 0, N_LAUNCHES == 1 ? (size_t)(CW_BAR + XCD_BAR_WORDS) * 4 : CTL_BYTES, stream);
    KArgs a{};
    for (int i = 0; i < 17; ++i) a.in[i] = (const float*)d_in[i];
    a.out = (float*)d_out; a.ws = (unsigned char*)d_ws;
    for (int li = 0; li < N_LAUNCHES; ++li) {
        a.ph_lo = (int)((long)NPHASE * li / N_LAUNCHES); a.ph_hi = (int)((long)NPHASE * (li + 1) / N_LAUNCHES); a.li = li;
        hipLaunchKernelGGL(fwd_kernel, dim3(grid), dim3(NTHR), LDS_BYTES, stream, a);
    }
}
```

```cpp
#include <hip/hip_runtime.h>
#include <cstdint>
#include <cstdio>

#define GAS __attribute__((address_space(1)))
#define LAS __attribute__((address_space(3)))
typedef unsigned short bf16;
typedef short bf16x8 __attribute__((ext_vector_type(8)));
typedef float f32x4 __attribute__((ext_vector_type(4)));
typedef unsigned v4u __attribute__((ext_vector_type(4)));
typedef unsigned v2u __attribute__((ext_vector_type(2)));
typedef GAS unsigned gu32;

constexpr int T = 32768, D = 1024, SEQ = 4096, NIN = 7936;
constexpr int A_W = 4608, B_W = 1280, G_W = 2048, Y_W = 1536;
constexpr int NE = 32, DE = 256;
constexpr int NCH = 4, TC = T / NCH;
constexpr float QSCALE = 0.125f * 1.4426950408889634f;
constexpr float LOG2E = 1.4426950408889634f;
constexpr float RMS_EPS = 1e-6f;
#ifndef P1_FP8
#define P1_FP8 1
#endif
constexpr float W8_SCALE = P1_FP8 ? 64.0f : 0.0f, W8_INV = P1_FP8 ? 1.0f / 64.0f : 1.0f;
#ifndef P6_FP8
#define P6_FP8 1
#endif
#ifndef P34_FP8
#define P34_FP8 1
#endif
constexpr float Y8_SCALE = 16.0f, W34_SCALE = 64.0f, MG8_SCALE = 32.0f;
#ifndef YS_FP8
#define YS_FP8 1
#endif
constexpr float YS8_SCALE = 16.0f;
constexpr float WG8_SCALE = P6_FP8 ? 64.0f : 0.0f, WD8_SCALE = P6_FP8 ? 32.0f : 0.0f, H8_SCALE = 32.0f;
constexpr int NWAVES = 8, NTHR = 512;

constexpr size_t MiB = 1u << 20;
constexpr size_t WS_CTL = 0, CTL_BYTES = 1 * MiB;
constexpr size_t WS_INVF = 1 * MiB;
constexpr size_t WS_WRF = 2 * MiB;
constexpr size_t WS_TOKOF = 3 * MiB;
constexpr size_t WS_WTOF = 7 * MiB;
constexpr size_t WS_TPOS = 15 * MiB;
constexpr size_t WS_WIN = 16 * MiB;
constexpr size_t WS_WAB = 32 * MiB;
constexpr size_t WS_WO = 35 * MiB;
constexpr size_t WS_WGU = 37 * MiB;
constexpr size_t WS_WD = 69 * MiB;
constexpr size_t WS_G = 86 * MiB;
constexpr size_t WS_Y = 214 * MiB;
constexpr size_t WS_ZA = 310 * MiB;
constexpr size_t WS_ZB = 454 * MiB;
constexpr size_t WS_END = 494 * MiB;
constexpr size_t WS_MG = WS_ZA;
constexpr size_t WS_X1B = WS_ZA + 64 * MiB;
constexpr size_t WS_X1F8 = WS_Y + 64 * MiB;
constexpr size_t WS_HACT = WS_G;
constexpr size_t WS_YS = WS_G + 36 * MiB;
constexpr size_t DO_DELTA = 0;
constexpr size_t DO_HN = 0;
constexpr size_t DO_OG = 64 * MiB;
constexpr size_t DO_LSE = 112 * MiB;
constexpr int MAXSLOT = 2 * T + NE * 256;
static_assert(WS_ZA + (size_t)TC * A_W * 2 <= WS_ZB && WS_ZB + (size_t)TC * B_W * 2 <= WS_END && WS_Y + (size_t)T * Y_W * 2 <= WS_ZA && WS_G + (size_t)T * G_W * 2 <= WS_Y, "ws map");
static_assert(WS_MG + (size_t)T * D * 2 <= WS_END && WS_HACT + (size_t)MAXSLOT * DE * 2 <= WS_YS && WS_YS + (size_t)MAXSLOT * D * 2 <= WS_ZA && WS_X1B >= WS_MG + (size_t)T * D * 2 && WS_X1B + (size_t)T * D * 2 <= WS_ZB, "ws map");
static_assert(DO_OG + (size_t)3 * TC * 512 * 2 <= DO_LSE && DO_LSE + (size_t)3 * TC * 8 * 4 <= (size_t)T * D * 4 && DO_HN + (size_t)T * D * 2 <= DO_OG, "d_out scratch map");
constexpr int CW_CNT = 1024;
constexpr int CW_BAR = 4096;
constexpr int LDS_BYTES = 147456;
constexpr int LDS_MISC = 131072;

__device__ __forceinline__ unsigned f2bf(float f) { unsigned u = __builtin_bit_cast(unsigned, f); return (u + 0x7fffu + ((u >> 16) & 1u)) >> 16; }
__device__ __forceinline__ unsigned pk4_fp8(float a, float b, float c, float d) {
    a = __builtin_amdgcn_fmed3f(a, -448.f, 448.f); b = __builtin_amdgcn_fmed3f(b, -448.f, 448.f); c = __builtin_amdgcn_fmed3f(c, -448.f, 448.f); d = __builtin_amdgcn_fmed3f(d, -448.f, 448.f);
    int w = 0; w = __builtin_amdgcn_cvt_pk_fp8_f32(a, b, w, false); w = __builtin_amdgcn_cvt_pk_fp8_f32(c, d, w, true); return (unsigned)w; }
__device__ __forceinline__ unsigned pk2(float lo, float hi) { return f2bf(lo) | (f2bf(hi) << 16); }
__device__ __forceinline__ float bf2f(unsigned b) { return __builtin_bit_cast(float, b << 16); }
__device__ __forceinline__ float bflo(unsigned u) { return __builtin_bit_cast(float, u << 16); }
__device__ __forceinline__ float bfhi(unsigned u) { return __builtin_bit_cast(float, u & 0xffff0000u); }
__device__ __forceinline__ float wave_sum(float v) {
#pragma unroll
    for (int o = 1; o < 64; o <<= 1) v += __shfl_xor(v, o);
    return v;
}
__device__ __forceinline__ float wave_max(float v) {
#pragma unroll
    for (int o = 1; o < 64; o <<= 1) v = fmaxf(v, __shfl_xor(v, o));
    return v;
}
typedef float f32x2_t __attribute__((ext_vector_type(2)));
typedef __bf16 bf16x2_t __attribute__((ext_vector_type(2)));
__device__ __forceinline__ unsigned cvtpk(float lo, float hi) { f32x2_t v = {lo, hi}; bf16x2_t b = __builtin_convertvector(v, bf16x2_t); return __builtin_bit_cast(unsigned, b); }
#ifndef WT_STORES
#define WT_STORES 0
#endif
__device__ __forceinline__ __amdgpu_buffer_rsrc_t wt_rsrc(unsigned char* base) { return __builtin_amdgcn_make_buffer_rsrc(base, 0, 0x7ffffffc, 0x00020000); }
__device__ __forceinline__ void st16(__amdgpu_buffer_rsrc_t r, unsigned char* base, void* p, v4u v) { if (WT_STORES) __builtin_amdgcn_raw_buffer_store_b128(v, r, (unsigned)((unsigned char*)p - base), 0, 16); else *(GAS v4u*)p = v; }
__device__ __forceinline__ void st8(__amdgpu_buffer_rsrc_t r, unsigned char* base, void* p, v2u v) { if (WT_STORES) __builtin_amdgcn_raw_buffer_store_b64(v, r, (unsigned)((unsigned char*)p - base), 0, 16); else *(GAS v2u*)p = v; }
#define LDS_WAIT() asm volatile("s_waitcnt lgkmcnt(0)" ::: "memory")
#define VM_WAIT() asm volatile("s_waitcnt vmcnt(0)" ::: "memory")

#define XB_TMO      128
#define XB_XCNT(j)  (256  + 64 * (j))
#define XB_XSUB(j)  (1280 + 64 * (j))
#define XB_XGEN(j)  (2304 + 64 * (j))
#define XB_TOP      3328
#define XB_TOPGEN   3392
#define XCD_BAR_WORDS 3456
#define XB_SPIN_CAP (1u << 18)
__device__ __forceinline__ unsigned xb_ld(unsigned* p)              { return __hip_atomic_load(p, __ATOMIC_RELAXED, __HIP_MEMORY_SCOPE_AGENT); }
__device__ __forceinline__ unsigned xb_add(unsigned* p, unsigned v) { return __hip_atomic_fetch_add(p, v, __ATOMIC_RELAXED, __HIP_MEMORY_SCOPE_AGENT); }
__device__ __forceinline__ unsigned xb_xcc_id() { return (unsigned)__builtin_amdgcn_s_getreg((3 << 11) | 20) & 0xFu; }
#define XB_SPIN(cond, bar) do { unsigned _sp = 0; while (cond) { __builtin_amdgcn_s_sleep(1); \
    if ((++_sp & 255u) == 0u) { if (xb_ld(&(bar)[XB_TMO])) break; if (_sp > XB_SPIN_CAP) { atomicAdd(&(bar)[XB_TMO], 1u); break; } } } } while (0)
struct XcdBarrier { unsigned* bar; unsigned x; volatile LAS unsigned* st; };
__device__ __forceinline__ XcdBarrier xcd_barrier_post(unsigned* bar, volatile LAS unsigned* st) {
    XcdBarrier b; b.bar = bar; b.x = xb_xcc_id(); b.st = st;
    if (threadIdx.x == 0) (void)xb_add(&bar[XB_XCNT(b.x)], 1u);
    return b;
}
__device__ __forceinline__ void xcd_barrier_complete(unsigned* bar, unsigned x, unsigned& nloc, unsigned& nx) {
    const unsigned G = gridDim.x * gridDim.y * gridDim.z;
    unsigned sum, cnt, mine, sp = 0u;
    for (;;) {
        sum = 0u; cnt = 0u; mine = 0u;
#pragma unroll
        for (unsigned j = 0; j < 16; ++j) { const unsigned c = xb_ld(&bar[XB_XCNT(j)]); sum += c; cnt += (c > 0u) ? 1u : 0u; mine = (j == x) ? c : mine; }
        if (sum == G) break;
        __builtin_amdgcn_s_sleep(1);
        if ((++sp & 255u) == 0u) { if (xb_ld(&bar[XB_TMO])) break; if (sp > XB_SPIN_CAP) { atomicAdd(&bar[XB_TMO], 1u); break; } }
    }
    nloc = mine > 0u ? mine : 1u; nx = cnt > 0u ? cnt : 1u;
}
__device__ __forceinline__ void xcd_barrier(const XcdBarrier& b) {
    asm volatile("s_waitcnt vmcnt(0)" ::: "memory");
    __syncthreads();
    if (threadIdx.x == 0) {
        unsigned* bar = b.bar;
        __builtin_amdgcn_s_waitcnt(0);
        unsigned nloc = b.st[0], nx = b.st[1];
        if (nloc == 0u) { xcd_barrier_complete(bar, b.x, nloc, nx); b.st[0] = nloc; b.st[1] = nx; }
        const unsigned old = xb_add(&bar[XB_XSUB(b.x)], 1u);
        const unsigned gen = old / nloc;
        if (old + 1u == (gen + 1u) * nloc) {
            __builtin_amdgcn_fence(__ATOMIC_RELEASE, "agent");
            asm volatile("s_waitcnt vmcnt(0)" ::: "memory");
            const unsigned og = xb_add(&bar[XB_TOP], 1u);
            const unsigned tg = og / nx;
            if (og + 1u == (tg + 1u) * nx) xb_add(&bar[XB_TOPGEN], 1u);
            else XB_SPIN(xb_ld(&bar[XB_TOPGEN]) == tg, bar);
            __builtin_amdgcn_fence(__ATOMIC_ACQUIRE, "agent");
            xb_add(&bar[XB_XGEN(b.x)], 1u);
            asm volatile("s_waitcnt vmcnt(0)" ::: "memory");
        } else {
            XB_SPIN(xb_ld(&bar[XB_XGEN(b.x)]) == gen, bar);
            __builtin_amdgcn_fence(__ATOMIC_ACQUIRE, "agent");
            asm volatile("s_waitcnt vmcnt(0)" ::: "memory");
        }
    }
    __syncthreads();
}

struct KArgs { const float* in[17]; float* out; unsigned char* ws; int ph_lo, ph_hi, li, pad; };
struct Frame {
    LAS unsigned char* lds;
    int tid, lane, wave, vcu, G;
    const float* in[17]; float* out; unsigned char* ws;
};
enum { I_X = 0, I_WIN, I_BIN, I_SINK, I_WPA, I_WPB, I_WOUT, I_GMIX, I_GFFN, I_WRG, I_BRG, I_WRE, I_BRE, I_WEG, I_WEU, I_WED, I_GFIN };

struct TrDesc { const float* W; int N; bf16* WT; int ldo, rowbase, koff, k0, n0; bool perm; const float* kscale; float f8scale; };
__device__ __forceinline__ void tr_load(const TrDesc& d, int lane, f32x4 (&tv)[8], float (&ks)[8]) {
    const float* src = d.W + (size_t)(d.k0 + (lane >> 3)) * d.N + d.n0 + 4 * (lane & 7);
#pragma unroll
    for (int i = 0; i < 8; ++i) tv[i] = *(const GAS f32x4*)(src + (size_t)(8 * i) * d.N);
#pragma unroll
    for (int i = 0; i < 8; ++i) ks[i] = d.kscale ? d.kscale[d.k0 + 8 * i + (lane >> 3)] : 1.0f;
}
__device__ __forceinline__ void tr_finish(const TrDesc& d, LAS float* scr, int lane, const f32x4 (&tv)[8], const float (&ks)[8]) {
#pragma unroll
    for (int i = 0; i < 8; ++i) { const int kk = 8 * i + (lane >> 3); LAS float* w = scr + kk * 33 + 4 * (lane & 7);
        w[0] = tv[i][0] * ks[i]; w[1] = tv[i][1] * ks[i]; w[2] = tv[i][2] * ks[i]; w[3] = tv[i][3] * ks[i]; }
    LDS_WAIT(); asm volatile("" ::: "memory");
    const int c = lane & 7;
#pragma unroll
    for (int j = 0; j < 4; ++j) { const int n = (lane >> 3) + 8 * j; const LAS float* s = scr + (8 * c) * 33 + n;
        const int rr = d.perm ? 8 * (n >> 2) + (n & 3) : n;
        if (d.f8scale != 0.f) { const float f = d.f8scale; v2u o8; o8.x = pk4_fp8(s[0 * 33] * f, s[1 * 33] * f, s[2 * 33] * f, s[3 * 33] * f); o8.y = pk4_fp8(s[4 * 33] * f, s[5 * 33] * f, s[6 * 33] * f, s[7 * 33] * f);
            *(GAS v2u*)((unsigned char*)d.WT + (size_t)(d.rowbase + rr) * d.ldo + d.koff + d.k0 + 8 * c) = o8; }
        else { v4u o; o.x = pk2(s[0 * 33], s[1 * 33]); o.y = pk2(s[2 * 33], s[3 * 33]); o.z = pk2(s[4 * 33], s[5 * 33]); o.w = pk2(s[6 * 33], s[7 * 33]);
            *(GAS v4u*)(d.WT + (size_t)(d.rowbase + rr) * d.ldo + d.koff + d.k0 + 8 * c) = o; } }
    LDS_WAIT(); asm volatile("" ::: "memory");
}
__device__ __forceinline__ void rms_row_to_bf16(const float* xrow, const float* g, bf16* orow, int lane) {
    const GAS f32x4* xr = (const GAS f32x4*)xrow + lane; const GAS f32x4* gr = (const GAS f32x4*)g + lane;
    f32x4 v[4]; float s = 0.f;
#pragma unroll
    for (int j = 0; j < 4; ++j) { v[j] = xr[64 * j]; s += (v[j].x * v[j].x + v[j].y * v[j].y) + (v[j].z * v[j].z + v[j].w * v[j].w); }
    const float rstd = 1.0f / sqrtf(wave_sum(s) * (1.f / D) + RMS_EPS);
    GAS v2u* o8 = (GAS v2u*)orow + lane;
#pragma unroll
    for (int j = 0; j < 4; ++j) { const f32x4 gg = gr[64 * j]; v2u w; w.x = pk2(v[j].x * rstd * gg.x, v[j].y * rstd * gg.y); w.y = pk2(v[j].z * rstd * gg.z, v[j].w * rstd * gg.w); o8[64 * j] = w; }
}
__device__ __forceinline__ void p0_prologue(Frame& F) {
    int tid_ = threadIdx.x; asm volatile("" : "+v"(tid_)); const int lane_ = tid_ & 63;
    LAS float* scr = (LAS float*)(F.lds + F.wave * 16384);
    const int gw = F.vcu * NWAVES + F.wave, NGW = F.G * NWAVES;
    unsigned char* ws = F.ws;
    constexpr int I_IN = 16 * 248, I_PA = 8 * 32, I_PB = 16 * 32, I_WO = 16 * 32, I_EG = 32 * 16 * 8, I_ED = 32 * 4 * 32;
    constexpr int NITEMS = I_IN + I_PA + I_PB + I_WO + 2 * I_EG + I_ED;
    auto decode = [&](int it, TrDesc& d) {
        int r = it; d.perm = false; d.kscale = nullptr; d.f8scale = 0.f; d.koff = 0;
        if (r < I_IN) { const int kb = r / 248, nb = r % 248, n0 = 32 * nb; const bool qk = (n0 < 3072) || (n0 >= A_W && n0 < A_W + 1152);
            const bool gt_ = n0 >= A_W + B_W; const int gc = n0 - (A_W + B_W);
            d.W = F.in[I_WIN]; d.N = NIN; d.WT = (bf16*)(ws + WS_WIN); d.ldo = 1024; d.rowbase = qk ? (n0 & ~63) + ((n0 >> 5) & 1) * 4 : (gt_ ? A_W + B_W + 2 * (gc % 1024) + 4 * (gc / 1024) : n0); d.k0 = 64 * kb; d.n0 = n0; d.perm = qk || gt_; d.f8scale = W8_SCALE; return; } r -= I_IN;
        if (r < I_PA) { const int kb = r / 32, nb = r % 32; d.W = F.in[I_WPA]; d.N = 1024; d.WT = (bf16*)(ws + WS_WAB); d.ldo = 1536; d.rowbase = 32 * nb; d.k0 = 64 * kb; d.n0 = 32 * nb; if (P34_FP8) d.f8scale = W34_SCALE; return; } r -= I_PA;
        if (r < I_PB) { const int kb = r / 32, nb = r % 32; d.W = F.in[I_WPB]; d.N = 1024; d.WT = (bf16*)(ws + WS_WAB); d.ldo = 1536; d.rowbase = 32 * nb; d.koff = 512; d.k0 = 64 * kb; d.n0 = 32 * nb; if (P34_FP8) d.f8scale = W34_SCALE; return; } r -= I_PB;
        if (r < I_WO) { const int kb = r / 32, nb = r % 32; d.W = F.in[I_WOUT]; d.N = 1024; d.WT = (bf16*)(ws + WS_WO); d.ldo = 1024; d.rowbase = 32 * nb; d.k0 = 64 * kb; d.n0 = 32 * nb; if (P34_FP8) d.f8scale = W34_SCALE; return; } r -= I_WO;
        if (r < 2 * I_EG) { const int up = r >= I_EG; if (up) r -= I_EG; const int e = r / 128, q = r % 128, kb = q / 8, nb = q % 8;
            d.W = F.in[up ? I_WEU : I_WEG] + (size_t)e * 1024 * 256; d.N = 256; d.WT = (bf16*)(ws + WS_WGU) + (size_t)e * 512 * 1024; d.ldo = 1024; d.rowbase = 64 * nb + (up ? 4 : 0); d.k0 = 64 * kb; d.n0 = 32 * nb; d.perm = true; d.kscale = F.in[I_GFFN]; d.f8scale = WG8_SCALE; if (P6_FP8) d.WT = (bf16*)((unsigned char*)(ws + WS_WGU) + (size_t)e * 512 * 1024); return; } r -= 2 * I_EG;
        { const int e = r / 128, q = r % 128, kb = q / 32, nb = q % 32;
            d.W = F.in[I_WED] + (size_t)e * 256 * 1024; d.N = 1024; d.WT = (bf16*)(ws + WS_WD) + (size_t)e * 1024 * 256; d.ldo = 256; d.rowbase = 32 * nb; d.k0 = 64 * kb; d.n0 = 32 * nb; d.f8scale = WD8_SCALE; if (P6_FP8) d.WT = (bf16*)((unsigned char*)(ws + WS_WD) + (size_t)e * 1024 * 256); }
    };
    {
        int it = gw; TrDesc dc, dn; f32x4 tc[8], tn[8]; float kc[8], kn[8];
        bool hc = it < NITEMS; if (hc) { decode(it, dc); tr_load(dc, lane_, tc, kc); }
        while (hc) {
            it += NGW; const bool hn = it < NITEMS;
            if (hn) { decode(it, dn); tr_load(dn, lane_, tn, kn); }
            tr_finish(dc, scr, lane_, tc, kc);
            hc = hn; dc = dn;
#pragma unroll
            for (int i = 0; i < 8; ++i) { tc[i] = tn[i]; kc[i] = kn[i]; }
        }
    }
    for (int m = gw; m < T; m += 4 * NGW) {
        const GAS f32x4* gr = (const GAS f32x4*)F.in[I_GMIX] + lane_;
        f32x4 v[4][4]; float ss[4];
#pragma unroll
        for (int r = 0; r < 4; ++r) { const int mr = (m + r * NGW < T) ? m + r * NGW : m; const GAS f32x4* xr = (const GAS f32x4*)(F.in[I_X] + (size_t)mr * D) + lane_;
#pragma unroll
            for (int j = 0; j < 4; ++j) v[r][j] = xr[64 * j]; }
#pragma unroll
        for (int r = 0; r < 4; ++r) { float a = 0.f;
#pragma unroll
            for (int j = 0; j < 4; ++j) a += (v[r][j].x * v[r][j].x + v[r][j].y * v[r][j].y) + (v[r][j].z * v[r][j].z + v[r][j].w * v[r][j].w);
            ss[r] = 1.0f / sqrtf(wave_sum(a) * (1.f / D) + RMS_EPS); }
#pragma unroll
        for (int r = 0; r < 4; ++r) { if (m + r * NGW >= T) continue; GAS unsigned* o4 = (GAS unsigned*)((unsigned char*)F.out + DO_HN + (size_t)(m + r * NGW) * D) + lane_;
#pragma unroll
            for (int j = 0; j < 4; ++j) { const f32x4 gg = gr[64 * j];
                if (P1_FP8) o4[64 * j] = pk4_fp8(v[r][j].x * ss[r] * gg.x, v[r][j].y * ss[r] * gg.y, v[r][j].z * ss[r] * gg.z, v[r][j].w * ss[r] * gg.w);
                else { v2u w; w.x = cvtpk(v[r][j].x * ss[r] * gg.x, v[r][j].y * ss[r] * gg.y); w.y = cvtpk(v[r][j].z * ss[r] * gg.z, v[r][j].w * ss[r] * gg.w); ((GAS v2u*)((unsigned char*)F.out + DO_HN + (size_t)(m + r * NGW) * D * 2) + lane_)[64 * j] = w; } } }
    }
    const int gt = F.vcu * NTHR + tid_, NGT = F.G * NTHR;
    if (gt < 32) ((float*)(ws + WS_INVF))[gt] = (float)exp2(-(double)gt * (13.287712379549449 / 32.0));
    for (int i = gt; i < 32 * 3 * 64; i += NGT) {
        const int ln = i & 63, nb = (i >> 6) % 3, ks = i / 192;
        const int n = 16 * nb + (ln & 15);
        float hi[8], lo[8];
#pragma unroll
        for (int e = 0; e < 8; ++e) { const int k = 32 * ks + 8 * (ln >> 4) + e; float v = 0.f;
            if (n < 4) v = F.in[I_WRG][k * 4 + n]; else if (n < 36) v = F.in[I_WRE][k * 32 + (n - 4)];
            v *= F.in[I_GFFN][k]; hi[e] = bf2f(f2bf(v)); lo[e] = v - hi[e]; }
        v4u h, l; h.x = pk2(hi[0], hi[1]); h.y = pk2(hi[2], hi[3]); h.z = pk2(hi[4], hi[5]); h.w = pk2(hi[6], hi[7]);
        l.x = pk2(lo[0], lo[1]); l.y = pk2(lo[2], lo[3]); l.z = pk2(lo[4], lo[5]); l.w = pk2(lo[6], lo[7]);
        ((v4u*)(ws + WS_WRF))[((ks * 3 + nb) * 2 + 0) * 64 + ln] = h; ((v4u*)(ws + WS_WRF))[((ks * 3 + nb) * 2 + 1) * 64 + ln] = l;
    }
}

namespace pg8 {
#define PG8_LAS __attribute__((address_space(3)))
typedef unsigned short bf16_t;
typedef short bf16x8 __attribute__((ext_vector_type(8)));
typedef float f32x4 __attribute__((ext_vector_type(4)));
typedef unsigned u32x4 __attribute__((ext_vector_type(4)));
constexpr int BM = 256, BK = 64, HALF = 128, HTB = HALF * BK * 2  , STAGE_BYTES = 8 * HTB, NXCD = 8, WGM = 8;

__host__ __device__ __forceinline__ int lds_byte(int r, int c) { const int st = (r >> 4) * 2 + (c >> 5), rr = r & 15, cc = c & 31, ob = rr * 64 + cc * 2; return st * 1024 + (ob ^ (((ob >> 9) & 1) << 5)); }
__host__ __device__ __forceinline__ void stage_rc(int b, int& R, int& C) { const int st = b / 1024, sb = b % 1024, swz = sb ^ (((sb >> 9) & 1) << 5); R = (st >> 1) * 16 + swz / 64; C = (st & 1) * 32 + (swz % 64) / 2; }
__host__ __device__ __forceinline__ int perm32(int rho) { const int n = rho >> 4, i = rho & 15; return 8 * (i >> 2) + 4 * n + (i & 3); }

struct Unit { int pm, pn; };
struct Gemm { const bf16_t* A; const bf16_t* Bt; int M, N, K; };

struct StaticOrder {
    int nM, nN, nwg, G, c;
    __host__ __device__ void init(int M, int N, int G_, int c_) { nM = M / BM; nN = N / BM; nwg = nM * nN; G = G_; c = c_; }
    __host__ __device__ bool next(int i, Unit& u) const {
        const long L = (long)i * G + c; if (L >= nwg) return false;
        int wgid = (int)L; { const int q = nwg / NXCD, r = nwg % NXCD, xcd = wgid % NXCD, off = wgid / NXCD; wgid = (xcd < r ? xcd * (q + 1) : r * (q + 1) + (xcd - r) * q) + off; }
        const int nig = WGM * nN, gid = wgid / nig, fm = gid * WGM, gsz = (nM - fm) < WGM ? (nM - fm) : WGM;
        u.pm = fm + ((wgid % nig) % gsz); u.pn = (wgid % nig) / gsz; return true;
    }
    __device__ __forceinline__ void a_ready(const Unit&) const {}
    __device__ __forceinline__ void done(const Unit&) const {}
};
}


namespace pg9 {
using pg8::BM; using pg8::BK; using pg8::HALF; using pg8::HTB; using pg8::lds_byte; using pg8::stage_rc; using pg8::perm32;
struct Unit { int pm, pn, e; };
typedef int v8i_t __attribute__((ext_vector_type(8)));
typedef int v4i_t __attribute__((ext_vector_type(4)));
template <int ESZ, class Epi, class Sched, class AOff, class BBase>
__device__ __forceinline__ void gemm_phase(LAS unsigned char* lds, const char* Abase, int K, const Sched& S, const Epi& E, const AOff& aoffn, const BBase& bbase) {
    int tid_ = threadIdx.x; asm volatile("" : "+v"(tid_));
    const int tid = tid_, wid = __builtin_amdgcn_readfirstlane(tid >> 6), lane = tid & 63, wr = wid >> 2, wc = wid & 3, fr = lane & 15, fq = lane >> 4;
    const int nt = K * ESZ / (BK * 2);
    int Rr[2], Cc[2]; unsigned voffB[2];
#pragma unroll
    for (int i = 0; i < 2; ++i) { int R, C; stage_rc(tid * 16 + i * 8192, R, C); const int Rb = Epi::PERM ? ((R & ~31) + perm32(R & 31)) : R; Rr[i] = R; Cc[i] = C; voffB[i] = (unsigned)(Rb * K * ESZ + C * 2); }
    const size_t kstep = (size_t)(BK * 2);
    const size_t hstep = (size_t)HALF * K * ESZ;
    const unsigned ldsw = (unsigned)wid * 1024u;
    const int aoff = lds_byte(wr * 64 + fr, fq * 8), boff = lds_byte(wc * 32 + fr, fq * 8);
#define PG9_SA(b, h) (((b) * 2 + (h)) * HTB)
#define PG9_SB(b, h) ((4 + (b) * 2 + (h)) * HTB)
#define PG9_STAGE(bufoff, gbase, voff) do { _Pragma("unroll") for (int _i = 0; _i < 2; ++_i) \
        __builtin_amdgcn_global_load_lds((const unsigned*)((const char*)(gbase) + (voff)[_i]), (LAS unsigned*)(lds + (bufoff) + ldsw + _i * 8192), 16, 0, 0); } while (0)
#define PG9_LDA(dst, b, h) do { _Pragma("unroll") for (int m = 0; m < 4; ++m) { dst[m].lo = *(const LAS v4i_t*)(lds + PG9_SA(b, h) + aoff + m * 2048); dst[m].hi = *(const LAS v4i_t*)(lds + PG9_SA(b, h) + aoff + m * 2048 + 1024); } } while (0)
#define PG9_LDB(dst, b, h) do { _Pragma("unroll") for (int n = 0; n < 2; ++n) { dst[n].lo = *(const LAS v4i_t*)(lds + PG9_SB(b, h) + boff + n * 2048); dst[n].hi = *(const LAS v4i_t*)(lds + PG9_SB(b, h) + boff + n * 2048 + 1024); } } while (0)
#define PG9_HALF(v, o) __builtin_bit_cast(bf16x8, __builtin_shufflevector((v), (v), (o), (o) + 1, (o) + 2, (o) + 3))
#define PG9_MMA(ai, bj, At, Bt) do { __builtin_amdgcn_s_setprio(1); _Pragma("unroll") for (int m = 0; m < 4; ++m) _Pragma("unroll") for (int n = 0; n < 2; ++n) { \
        if (ESZ == 2) { acc[ai][bj][m][n] = __builtin_amdgcn_mfma_f32_16x16x32_bf16(PG9_HALF(Bt[n], 0), PG9_HALF(At[m], 0), acc[ai][bj][m][n], 0, 0, 0); \
                        acc[ai][bj][m][n] = __builtin_amdgcn_mfma_f32_16x16x32_bf16(PG9_HALF(Bt[n], 4), PG9_HALF(At[m], 4), acc[ai][bj][m][n], 0, 0, 0); } \
        else { asm volatile("v_mfma_scale_f32_16x16x128_f8f6f4 %0, %1, %2, %0, %3, %3 op_sel_hi:[0,0,0]" : "+v"(acc[ai][bj][m][n]) : "v"(Bt[n]), "v"(At[m]), "v"(one8)); } } \
        __builtin_amdgcn_s_setprio(0); } while (0)
#define PG9_WAIT_V(n) asm volatile("s_waitcnt vmcnt(" #n ")" ::: "memory")
#define PG9_WAIT_L(n) asm volatile("s_waitcnt lgkmcnt(" #n ")" ::: "memory")
#define PG9_BAR __builtin_amdgcn_s_barrier()
#define PG9_SCHED __builtin_amdgcn_sched_barrier(0)
#define PG9_VA(dst, u) do { _Pragma("unroll") for (int _h = 0; _h < 2; ++_h) _Pragma("unroll") for (int _i = 0; _i < 2; ++_i) dst[_h][_i] = aoffn((u), _h * HALF + Rr[_i]) + (unsigned)(Cc[_i] * 2); } while (0)
    constexpr bool GATHER = AOff::GATHER;
    const size_t hstepA = (size_t)HALF * aoffn.rowbytes;
    unsigned voffA[2];
#pragma unroll
    for (int i = 0; i < 2; ++i) voffA[i] = (unsigned)Rr[i] * aoffn.rowbytes + (unsigned)(Cc[i] * 2);
#define PG9_STAGE_A(bufoff, h, koff, nx) do { if (GATHER) { PG9_STAGE(bufoff, Abase + (koff), ((nx) ? nvA[h] : cvA[h])); } else { PG9_STAGE(bufoff, ((nx) ? nAu : cAu) + (h) * hstepA + (koff), voffA); } } while (0)
    Unit cur, nxt; int ui = 0;
    if (!S.next(0, cur)) return;
    f32x4 acc[2][2][4][2];
#pragma unroll
    for (int a = 0; a < 2; ++a)
#pragma unroll
        for (int b = 0; b < 2; ++b)
#pragma unroll
            for (int m = 0; m < 4; ++m)
#pragma unroll
                for (int n = 0; n < 2; ++n) acc[a][b][m][n] = (f32x4){0.f, 0.f, 0.f, 0.f};
    int one8 = 0x7f7f7f7f; asm volatile("" : "+v"(one8));
    v8i_t At[4], B0[2], B1[2];
    unsigned cvA[2][2], nvA[2][2];
    if (GATHER) { PG9_VA(cvA, cur); }
    const char* cAu = GATHER ? Abase : Abase + (size_t)aoffn(cur, 0); const char* nAu = cAu;
    const char* cB = bbase(cur);
    PG9_STAGE(PG9_SB(0, 0), cB, voffB); PG9_STAGE(PG9_SB(0, 1), cB + hstep, voffB); PG9_STAGE_A(PG9_SA(0, 0), 0, 0, false); PG9_STAGE_A(PG9_SA(0, 1), 1, 0, false);
    if (wr == 1) PG9_BAR;
    PG9_WAIT_V(2); PG9_BAR;
    PG9_STAGE(PG9_SB(1, 0), cB + kstep, voffB); PG9_STAGE_A(PG9_SA(1, 0), 0, kstep, false); PG9_STAGE(PG9_SB(1, 1), cB + hstep + kstep, voffB);
    PG9_WAIT_V(6); PG9_BAR;
    for (;;) {
        const bool has_next = S.next(ui + 1, nxt);
        if (GATHER) {
            if (has_next) { PG9_VA(nvA, nxt); } else {
#pragma unroll
                for (int _h = 0; _h < 2; ++_h)
#pragma unroll
                    for (int _i = 0; _i < 2; ++_i) nvA[_h][_i] = cvA[_h][_i]; }
        } else nAu = has_next ? Abase + (size_t)aoffn(nxt, 0) : cAu;
        const char* nB = has_next ? bbase(nxt) : cB;
#pragma unroll 1
        for (int t = 0; t < nt; t += 2) {
            const bool last = (t == nt - 2);
            if (Epi::HOOK_T >= 0) { if (t == Epi::HOOK_T) E.hook(acc, cur, wr, wc, fr, fq); }
            const size_t k1 = (size_t)(t + 1) * kstep, k2 = last ? 0 : (size_t)(t + 2) * kstep, k3 = k2 + kstep;
            const char* b2 = last ? nB : cB + (size_t)(t + 2) * kstep; const char* b3 = b2 + kstep;
            PG9_LDB(B0, 0, 0); PG9_LDB(B1, 0, 1); PG9_SCHED; PG9_LDA(At, 0, 0); PG9_STAGE_A(PG9_SA(1, 1), 1, k1, false);
            PG9_WAIT_V(8); PG9_WAIT_L(0); PG9_BAR; PG9_MMA(0, 0, At, B0); PG9_MMA(0, 1, At, B1); PG9_BAR; PG9_SCHED;
            PG9_LDA(At, 0, 1); PG9_STAGE(PG9_SB(0, 0), b2, voffB); PG9_STAGE(PG9_SB(0, 1), b2 + hstep, voffB); PG9_STAGE_A(PG9_SA(0, 0), 0, k2, last);
            PG9_WAIT_V(8); PG9_WAIT_L(0); PG9_BAR; PG9_MMA(1, 0, At, B0); PG9_MMA(1, 1, At, B1); PG9_BAR; PG9_SCHED;
            PG9_LDB(B0, 1, 0); PG9_LDB(B1, 1, 1); PG9_SCHED; PG9_LDA(At, 1, 0); PG9_STAGE_A(PG9_SA(0, 1), 1, k2, last);
            PG9_WAIT_V(8); PG9_WAIT_L(0); PG9_BAR; PG9_MMA(0, 0, At, B0); PG9_MMA(0, 1, At, B1); PG9_BAR; PG9_SCHED;
            PG9_LDA(At, 1, 1); PG9_STAGE(PG9_SB(1, 0), b3, voffB); PG9_STAGE(PG9_SB(1, 1), b3 + hstep, voffB); PG9_STAGE_A(PG9_SA(1, 0), 0, k3, last);
            PG9_WAIT_V(8); PG9_WAIT_L(0); PG9_BAR; PG9_MMA(1, 0, At, B0); PG9_MMA(1, 1, At, B1); PG9_BAR; PG9_SCHED;
        }
        if (wr == 0) PG9_BAR;
        if (ESZ == 1) asm volatile("s_nop 15\n\ts_nop 15" ::: "memory");
        E(acc, cur, wr, wc, fr, fq);
        if (!has_next) break;
#pragma unroll
        for (int a = 0; a < 2; ++a)
#pragma unroll
            for (int b = 0; b < 2; ++b)
#pragma unroll
                for (int m = 0; m < 4; ++m)
#pragma unroll
                    for (int n = 0; n < 2; ++n) acc[a][b][m][n] = (f32x4){0.f, 0.f, 0.f, 0.f};
        cur = nxt; cB = nB; cAu = nAu; ++ui;
        if (GATHER) {
#pragma unroll
            for (int _h = 0; _h < 2; ++_h)
#pragma unroll
                for (int _i = 0; _i < 2; ++_i) cvA[_h][_i] = nvA[_h][_i]; }
        if (wr == 1) PG9_BAR;
    }
    PG9_WAIT_V(0);
    PG9_BAR;
#undef PG9_SA
#undef PG9_SB
#undef PG9_STAGE
#undef PG9_LDA
#undef PG9_LDB
#undef PG9_MMA
#undef PG9_HALF
#undef PG9_WAIT_V
#undef PG9_WAIT_L
#undef PG9_BAR
#undef PG9_SCHED
#undef PG9_VA
#undef PG9_STAGE_A
}
struct DenseOrder { pg8::StaticOrder so;
    __device__ void init(int M, int N, int G, int c) { so.init(M, N, G, c); }
    __device__ bool next(int i, Unit& u) const { pg8::Unit v; if (!so.next(i, v)) return false; u.pm = v.pm; u.pn = v.pn; u.e = 0; return true; } };
struct DenseA { static constexpr bool GATHER = false; unsigned rowbytes; __device__ __forceinline__ unsigned operator()(const Unit& u, int row) const { return (unsigned)(u.pm * 256 + row) * rowbytes; } };
struct DenseB { const char* Bt; size_t tilebytes; __device__ __forceinline__ const char* operator()(const Unit& u) const { return Bt + (size_t)u.pn * tilebytes; } };
}

struct EpiInproj {
    static constexpr bool PERM = true; static constexpr int HOOK_T = -1;
    bf16* ZA; bf16* ZB; bf16* Gt; const float* bias; const float* invf; unsigned char* wsb;
    __device__ __forceinline__ void hook(f32x4 (&)[2][2][4][2], const pg9::Unit&, int, int, int, int) const {}
    __device__ __forceinline__ void operator()(const f32x4 (&acc)[2][2][4][2], const pg9::Unit& u, int wr, int wc, int fr, int fq) const {
        asm volatile("" : "+v"(fr), "+v"(fq));
        const int row0 = u.pm * 256 + wr * 64 + fr;
        const int q = 4 * (wc & 1) + fq;
        const int fr2 = (fr >> 2) + 4 * fq, fq2 = fr & 3, paddr = 4 * (16 * (fr & 3) + 4 * fq + (fr >> 2));
        const int row0s = u.pm * 256 + wr * 64 + fr2;
        const __amdgpu_buffer_rsrc_t wr_ = wt_rsrc(wsb);
        int kind[2]; bf16* dst[2]; int ldd[2]; f32x4 b0[2], b1[2];
#pragma unroll
        for (int bj = 0; bj < 2; ++bj) {
            const int colpos = u.pn * 256 + bj * 128 + wc * 32 + 8 * fq, colposs = u.pn * 256 + bj * 128 + wc * 32 + 8 * fq2, hb = u.pn * 256 + bj * 128 + (wc >> 1) * 64;
            if (hb < A_W) { kind[bj] = hb / 1536; dst[bj] = ZA + colposs; ldd[bj] = A_W; }
            else if (hb < A_W + B_W) { const int cb = hb - A_W; kind[bj] = cb < 1024 ? 0 : (cb < 1152 ? 1 : 2); dst[bj] = ZB + (colposs - A_W); ldd[bj] = B_W; }
            else { kind[bj] = 3; dst[bj] = Gt + ((colposs - A_W - B_W) >> 1); ldd[bj] = G_W; }
            b0[bj] = *(const f32x4*)(bias + (kind[bj] < 2 ? hb + 4 * q : (kind[bj] == 3 ? A_W + B_W + ((colpos - A_W - B_W) >> 1) : colpos)));
            b1[bj] = *(const f32x4*)(bias + (kind[bj] < 2 ? hb + 32 + 4 * q : (kind[bj] == 3 ? A_W + B_W + 1024 + ((colpos - A_W - B_W) >> 1) : colpos + 4)));
        }
        const bool need_rope = kind[0] < 2 || kind[1] < 2;
        const f32x4 fv = *(const f32x4*)(invf + 4 * q);
#pragma unroll
        for (int ai = 0; ai < 2; ++ai) {
            f32x4 rc[4], rs[4];
#pragma unroll
            for (int m = 0; m < 4; ++m) { rc[m] = (f32x4){1.f, 1.f, 1.f, 1.f}; rs[m] = (f32x4){0.f, 0.f, 0.f, 0.f}; }
            if (need_rope) {
#pragma unroll
                for (int m = 0; m < 4; ++m) { const float posf = (float)((row0 + ai * 128 + m * 16) & (SEQ - 1));
#pragma unroll
                    for (int e = 0; e < 4; ++e) { const float ang = posf * fv[e]; const float pr = ang * 0.15915494f; const float er = __builtin_fmaf(ang, 0.15915494f, -pr) + ang * 6.4206382e-9f;
                        const float fr = __builtin_amdgcn_fractf(pr) + er; rc[m][e] = __builtin_amdgcn_cosf(fr); rs[m][e] = __builtin_amdgcn_sinf(fr); } }
            }
#pragma unroll
            for (int bj = 0; bj < 2; ++bj) {
#pragma unroll
                for (int m = 0; m < 4; ++m) {
                    const int row = row0s + ai * 128 + m * 16;
                    f32x4 v0 = acc[ai][bj][m][0] * W8_INV + b0[bj], v1 = acc[ai][bj][m][1] * W8_INV + b1[bj];
                    if (kind[bj] < 2) {
                        const f32x4 cc = rc[m], ss = rs[m];
                        const f32x4 t0 = v0 * cc - v1 * ss, t1 = v1 * cc + v0 * ss;
                        v0 = t0; v1 = t1;
                        if (kind[bj] == 0) { v0 = v0 * QSCALE; v1 = v1 * QSCALE; }
                    }
                    if (kind[bj] == 3) {
#pragma unroll
                        for (int e = 0; e < 4; ++e) { const float d0 = 1.0f + __expf(-v0[e]), d1 = 1.0f + __expf(-v1[e]); v0[e] = d1 * __builtin_amdgcn_rcpf(d0); v1[e] = __builtin_amdgcn_rcpf(d1); }
                        v2u w0, w1; w0.x = cvtpk(v0[0], v0[1]); w0.y = cvtpk(v0[2], v0[3]); w1.x = cvtpk(v1[0], v1[1]); w1.y = cvtpk(v1[2], v1[3]);
                        w0.x = (unsigned)__builtin_amdgcn_ds_bpermute(paddr, (int)w0.x); w0.y = (unsigned)__builtin_amdgcn_ds_bpermute(paddr, (int)w0.y); w1.x = (unsigned)__builtin_amdgcn_ds_bpermute(paddr, (int)w1.x); w1.y = (unsigned)__builtin_amdgcn_ds_bpermute(paddr, (int)w1.y);
                        st8(wr_, wsb, dst[bj] + (size_t)row * ldd[bj], w0); st8(wr_, wsb, dst[bj] + (size_t)row * ldd[bj] + 1024, w1);
                    } else {
                    v4u w; w.x = cvtpk(v0[0], v0[1]); w.y = cvtpk(v0[2], v0[3]); w.z = cvtpk(v1[0], v1[1]); w.w = cvtpk(v1[2], v1[3]);
                    w.x = (unsigned)__builtin_amdgcn_ds_bpermute(paddr, (int)w.x); w.y = (unsigned)__builtin_amdgcn_ds_bpermute(paddr, (int)w.y); w.z = (unsigned)__builtin_amdgcn_ds_bpermute(paddr, (int)w.z); w.w = (unsigned)__builtin_amdgcn_ds_bpermute(paddr, (int)w.w);
                    st16(wr_, wsb, dst[bj] + (size_t)row * ldd[bj], w); }
                }
            }
        }
    }
};
__device__ __forceinline__ void p1_inproj(Frame& F, int ch) {
    unsigned char* ws = F.ws;
    pg9::DenseOrder S; S.init(TC, NIN, F.G, (int)blockIdx.x);
    EpiInproj E{(bf16*)(ws + WS_ZA), (bf16*)(ws + WS_ZB), (bf16*)(ws + WS_G) + (size_t)ch * TC * G_W, F.in[I_BIN], (const float*)(ws + WS_INVF), ws};
    constexpr int ES = P1_FP8 ? 1 : 2;
    pg9::DenseA ao{(unsigned)(D * ES)}; pg9::DenseB bb{(const char*)(ws + WS_WIN), (size_t)256 * D * ES};
    pg9::gemm_phase<ES>(F.lds, (const char*)F.out + DO_HN + (size_t)ch * TC * D * ES, D, S, E, ao, bb);
}

typedef float f32x16 __attribute__((ext_vector_type(16)));
typedef short v4i16_t __attribute__((ext_vector_type(4)));
__device__ __forceinline__ float half_max(float v) { auto rr = __builtin_amdgcn_permlane32_swap(__float_as_uint(v), __float_as_uint(v), false, false); return fmaxf(__uint_as_float(rr[0]), __uint_as_float(rr[1])); }
__device__ __forceinline__ float half_sum(float v) { auto rr = __builtin_amdgcn_permlane32_swap(__float_as_uint(v), __float_as_uint(v), false, false); return __uint_as_float(rr[0]) + __uint_as_float(rr[1]); }
__device__ __forceinline__ float max3f(float a, float b, float c) { float r; asm("v_max3_f32 %0, %1, %2, %3" : "=v"(r) : "v"(a), "v"(b), "v"(c)); return r; }
constexpr int ATT_VOFF = 49152;

struct AUnit { const bf16 *Kw, *Vw, *Qp; size_t pitch; int kk_lo, nkeys, kb0, kstart, lo; float m0, l0; bf16* Op; float* Lp; int o8; };
__device__ __forceinline__ void attn_decode(Frame& F, int ch, int u, int NUA, int lane, AUnit& d) {
    unsigned char* ws = F.ws;
    const int w = F.wave, c = lane & 31, h = (lane >> 5) & 1;
    if (u < NUA) {
        const bf16* ZA = (const bf16*)(ws + WS_ZA);
        const int rt = u & 15, hh = (u >> 4) & 7, gb = u >> 7, g = gb % 3, bl = gb / 3;
        const int dsh = 2 * g, dd = 1 << dsh, tsh = 4 - dsh;
        const int r = rt >> tsh, tile = rt & ((1 << tsh) - 1), i0 = tile * 256;
        const int rowb = bl * SEQ + r, col = g * 512 + hh * 64;
        d.pitch = (size_t)dd * A_W;
        d.Kw = ZA + ((long)rowb + (long)dd * (i0 - 128)) * A_W + 1536 + col; d.Vw = d.Kw + 1536;
        const long qrow = (long)rowb + (long)dd * (i0 + 32 * w + c);
        d.Qp = ZA + qrow * A_W + col;
        d.kk_lo = (i0 == 0) ? 128 : 0; d.nkeys = 384; d.kb0 = w; d.kstart = (i0 == 0) ? (w < 4 ? 4 - w : 0) : 0; d.lo = 0;
        d.m0 = -1e30f; d.l0 = 0.f;
        d.Op = (bf16*)((unsigned char*)F.out + DO_OG) + ((size_t)g * TC + qrow) * 512 + hh * 64;
        d.Lp = (float*)((unsigned char*)F.out + DO_LSE) + ((size_t)g * TC + qrow) * 8 + hh;
        d.o8 = 0;
    } else {
        const int u2 = u - NUA;
        const bf16* ZB = (const bf16*)(ws + WS_ZB);
        const int blk = u2 & 127, kvh = (u2 >> 7) & 1, bl = u2 >> 8;
        const int t0 = blk * 32, rowb = bl * SEQ;
        d.pitch = B_W;
        d.Kw = ZB + ((long)rowb + t0 - 128) * B_W + 1024 + kvh * 64; d.Vw = d.Kw + 128;
        const int qh = kvh * 8 + w;
        const long qrow = (long)rowb + t0 + c;
        d.Qp = ZB + qrow * B_W + qh * 64;
        d.kk_lo = t0 < 128 ? 128 - t0 : 0; d.nkeys = 160; d.kb0 = 0; d.kstart = d.kk_lo >> 5; d.lo = 1;
        d.m0 = F.in[I_SINK][qh] * LOG2E; d.l0 = h == 0 ? 1.f : 0.f;
        d.o8 = P34_FP8;
        d.Op = P34_FP8 ? (bf16*)(ws + WS_Y + ((size_t)ch * TC + qrow) * Y_W + 512 + qh * 64) : (bf16*)(ws + WS_Y) + ((size_t)ch * TC + qrow) * Y_W + 512 + qh * 64;
        d.Lp = nullptr;
    }
}
__device__ __forceinline__ void attn_load(const AUnit& d, int tid, int lane, v4u (&kreg)[6], v4u (&vreg)[6], bf16x8 (&qf)[4]) {
    const int skey = tid >> 3, sch = tid & 7, h = (lane >> 5) & 1;
#pragma unroll
    for (int s4 = 0; s4 < 4; ++s4) qf[s4] = *(const GAS bf16x8*)(d.Qp + 16 * s4 + 8 * h);
#pragma unroll
    for (int p = 0; p < 6; ++p) { const int kk = 64 * p + skey;
        if (kk >= d.kk_lo && kk < d.nkeys) { kreg[p] = *(const GAS v4u*)(d.Kw + (size_t)kk * d.pitch + 8 * sch); vreg[p] = *(const GAS v4u*)(d.Vw + (size_t)kk * d.pitch + 8 * sch); } }
}
__device__ __forceinline__ void attn_write(const AUnit& d, LAS unsigned char* KL, LAS unsigned char* VL, int tid, const v4u (&kreg)[6], const v4u (&vreg)[6]) {
    const int skey = tid >> 3, sch = tid & 7;
#pragma unroll
    for (int p = 0; p < 6; ++p) { const int kk = 64 * p + skey;
        if (kk >= d.kk_lo && kk < d.nkeys) {
            *(LAS v4u*)(KL + kk * 128 + ((sch ^ ((kk >> 1) & 7)) << 4)) = kreg[p];
            *(LAS v4u*)(VL + kk * 128 + ((sch * 16) ^ (((kk >> 1) & 1) << 6))) = vreg[p]; } }
}
__device__ __forceinline__ void attn_compute_edge(const AUnit& d, const LAS unsigned char* KL, const LAS unsigned char* VL, int lane, const bf16x8 (&qf)[4]) {
    const int c = lane & 31, h = (lane >> 5) & 1;
    int koff[4];
    { const int kswz = (c >> 1) & 7;
#pragma unroll
      for (int s4 = 0; s4 < 4; ++s4) koff[s4] = c * 128 + (((2 * s4 + h) ^ kswz) << 4); }
    const int vrow = 4 * h + ((lane & 15) >> 2), vsw = (lane >> 3) & 1;
    const int voff0 = vrow * 128 + ((32 * ((lane >> 4) & 1) + 8 * (lane & 3)) ^ (vsw << 6)), voff1 = voff0 ^ 64;
    const float NEG = -INFINITY;
    float m = d.m0, l = d.l0;
    f32x16 o0, o1;
#pragma unroll
    for (int i = 0; i < 16; ++i) { o0[i] = 0.f; o1[i] = 0.f; }
    const LAS unsigned char* kbp = KL + d.kb0 * 4096; const LAS unsigned char* vbp = VL + d.kb0 * 4096;
    const int clo = c + d.lo;
#pragma unroll
    for (int kbi = 0; kbi < 5; ++kbi) {
        if (kbi >= d.kstart) {
            f32x16 p;
#pragma unroll
            for (int i = 0; i < 16; ++i) p[i] = 0.f;
#pragma unroll
            for (int s4 = 0; s4 < 4; ++s4) { const bf16x8 kf = *(const LAS bf16x8*)(kbp + kbi * 4096 + koff[s4]); p = __builtin_amdgcn_mfma_f32_32x32x16_bf16(kf, qf[s4], p, 0, 0, 0); }
            if (kbi == 0) {
#pragma unroll
                for (int i = 0; i < 16; ++i) { const int x = (i & 3) + 8 * (i >> 2) + 4 * h; if (x < clo) p[i] = NEG; }
            }
            if (kbi == 4) {
#pragma unroll
                for (int i = 0; i < 16; ++i) { const int x = (i & 3) + 8 * (i >> 2) + 4 * h; if (x > c) p[i] = NEG; }
            }
            float mt = p[0];
#pragma unroll
            for (int i = 1; i < 16; ++i) mt = fmaxf(mt, p[i]);
            mt = half_max(mt);
            const float mn = fmaxf(m, mt), alpha = __builtin_amdgcn_exp2f(m - mn);
            m = mn;
            float ps = 0.f;
#pragma unroll
            for (int i = 0; i < 16; ++i) { p[i] = __builtin_amdgcn_exp2f(p[i] - mn); ps += p[i]; }
            l = l * alpha + ps;
#pragma unroll
            for (int i = 0; i < 16; ++i) { o0[i] *= alpha; o1[i] *= alpha; }
            bf16x8 pb[2];
#pragma unroll
            for (int s2 = 0; s2 < 2; ++s2) { v4u t; t.x = cvtpk(p[8 * s2 + 0], p[8 * s2 + 1]); t.y = cvtpk(p[8 * s2 + 2], p[8 * s2 + 3]); t.z = cvtpk(p[8 * s2 + 4], p[8 * s2 + 5]); t.w = cvtpk(p[8 * s2 + 6], p[8 * s2 + 7]); pb[s2] = __builtin_bit_cast(bf16x8, t); }
#pragma unroll
            for (int s2 = 0; s2 < 2; ++s2) {
#pragma unroll
                for (int db = 0; db < 2; ++db) {
                    const LAS unsigned char* vp = vbp + kbi * 4096 + s2 * 2048 + (db ? voff1 : voff0);
                    const v4i16_t lo = __builtin_amdgcn_ds_read_tr16_b64_v4i16((LAS v4i16_t*)vp);
                    const v4i16_t hi = __builtin_amdgcn_ds_read_tr16_b64_v4i16((LAS v4i16_t*)(vp + 1024));
                    const bf16x8 vf = {lo[0], lo[1], lo[2], lo[3], hi[0], hi[1], hi[2], hi[3]};
                    if (db == 0) o0 = __builtin_amdgcn_mfma_f32_32x32x16_bf16(vf, pb[s2], o0, 0, 0, 0);
                    else o1 = __builtin_amdgcn_mfma_f32_32x32x16_bf16(vf, pb[s2], o1, 0, 0, 0);
                }
            }
        }
    }
    const float lt = half_sum(l), inv = 1.0f / lt;
#pragma unroll
    for (int g4 = 0; g4 < 4; ++g4) {
        v2u a, b;
        a.x = cvtpk(o0[4 * g4 + 0] * inv, o0[4 * g4 + 1] * inv); a.y = cvtpk(o0[4 * g4 + 2] * inv, o0[4 * g4 + 3] * inv);
        b.x = cvtpk(o1[4 * g4 + 0] * inv, o1[4 * g4 + 1] * inv); b.y = cvtpk(o1[4 * g4 + 2] * inv, o1[4 * g4 + 3] * inv);
        if (d.o8) { unsigned char* o8p = (unsigned char*)d.Op; const float sc = inv * Y8_SCALE;
            *(GAS unsigned*)(o8p + 8 * g4 + 4 * h) = pk4_fp8(o0[4 * g4 + 0] * sc, o0[4 * g4 + 1] * sc, o0[4 * g4 + 2] * sc, o0[4 * g4 + 3] * sc);
            *(GAS unsigned*)(o8p + 32 + 8 * g4 + 4 * h) = pk4_fp8(o1[4 * g4 + 0] * sc, o1[4 * g4 + 1] * sc, o1[4 * g4 + 2] * sc, o1[4 * g4 + 3] * sc); }
        else {
        *(GAS v2u*)(d.Op + 8 * g4 + 4 * h) = a;
        *(GAS v2u*)(d.Op + 32 + 8 * g4 + 4 * h) = b; }
    }
    if (d.Lp) { if (h == 0) *d.Lp = m + __builtin_amdgcn_logf(lt); }
}
__device__ __forceinline__ void attn_compute(const AUnit& d, const LAS unsigned char* KL, const LAS unsigned char* VL, int lane, const bf16x8 (&qf)[4]) {
    const int c = lane & 31, h = (lane >> 5) & 1;
    int koff[4];
    { const int kswz = (c >> 1) & 7;
#pragma unroll
      for (int s4 = 0; s4 < 4; ++s4) koff[s4] = c * 128 + (((2 * s4 + h) ^ kswz) << 4); }
    const int vrow = 4 * h + ((lane & 15) >> 2), vsw = (lane >> 3) & 1;
    const int voff0 = vrow * 128 + ((32 * ((lane >> 4) & 1) + 8 * (lane & 3)) ^ (vsw << 6)), voff1 = voff0 ^ 64;
    const float NEG = -INFINITY;
    float m = d.m0;
    f32x16 o0, o1, L;
#pragma unroll
    for (int i = 0; i < 16; ++i) { o0[i] = 0.f; o1[i] = 0.f; L[i] = 0.f; }
    v4u onesu = {0x3F803F80u, 0x3F803F80u, 0x3F803F80u, 0x3F803F80u}; asm volatile("" : "+v"(onesu));
    const bf16x8 ones = __builtin_bit_cast(bf16x8, onesu);
    const LAS unsigned char* kbp = KL + d.kb0 * 4096; const LAS unsigned char* vbp = VL + d.kb0 * 4096;
    const int clo = c + d.lo;
#pragma unroll
    for (int kbi = 0; kbi < 5; ++kbi) {
        {
            constexpr bool first_dummy = false; (void)first_dummy;
            const bool first = (kbi == 0);
            const float cinit = first ? 0.f : -m;
            f32x16 p;
#pragma unroll
            for (int i = 0; i < 16; ++i) p[i] = cinit;
#pragma unroll
            for (int s4 = 0; s4 < 4; ++s4) { const bf16x8 kf = *(const LAS bf16x8*)(kbp + kbi * 4096 + koff[s4]); p = __builtin_amdgcn_mfma_f32_32x32x16_bf16(kf, qf[s4], p, 0, 0, 0); }
            if (kbi == 0) {
#pragma unroll
                for (int i = 0; i < 16; ++i) { const int x = (i & 3) + 8 * (i >> 2) + 4 * h; p[i] = x < clo ? NEG : p[i]; }
            }
            if (kbi == 4) {
#pragma unroll
                for (int i = 0; i < 16; ++i) { const int x = (i & 3) + 8 * (i >> 2) + 4 * h; p[i] = x > c ? NEG : p[i]; }
            }
            float t0 = max3f(p[0], p[4], p[8]), t1 = max3f(p[1], p[5], p[9]), t2 = max3f(p[2], p[6], p[10]), t3 = max3f(p[3], p[7], p[11]);
            t0 = max3f(t0, p[12], p[13]); t1 = max3f(t1, p[14], p[15]);
            const float mt = half_max(max3f(max3f(t0, t1, t2), t3, t3));
            if (first) {
                const float mn = fmaxf(m, mt), l0 = d.m0 > -1e29f ? __builtin_amdgcn_exp2f(m - mn) : 0.f;
                m = mn;
#pragma unroll
                for (int i = 0; i < 16; ++i) { p[i] -= mn; L[i] = l0; }
            } else if (__any(mt > 8.0f)) {
                const float dl = fmaxf(mt, 0.f), al = __builtin_amdgcn_exp2f(-dl);
                m += dl;
#pragma unroll
                for (int i = 0; i < 16; ++i) { o0[i] *= al; o1[i] *= al; L[i] *= al; p[i] -= dl; }
            }
#pragma unroll
            for (int i = 0; i < 16; ++i) p[i] = __builtin_amdgcn_exp2f(p[i]);
            bf16x8 pb[2];
#pragma unroll
            for (int s2 = 0; s2 < 2; ++s2) { v4u t; t.x = cvtpk(p[8 * s2 + 0], p[8 * s2 + 1]); t.y = cvtpk(p[8 * s2 + 2], p[8 * s2 + 3]); t.z = cvtpk(p[8 * s2 + 4], p[8 * s2 + 5]); t.w = cvtpk(p[8 * s2 + 6], p[8 * s2 + 7]); pb[s2] = __builtin_bit_cast(bf16x8, t); }
#pragma unroll
            for (int s2 = 0; s2 < 2; ++s2) {
                L = __builtin_amdgcn_mfma_f32_32x32x16_bf16(ones, pb[s2], L, 0, 0, 0);
#pragma unroll
                for (int db = 0; db < 2; ++db) {
                    const LAS unsigned char* vp = vbp + kbi * 4096 + s2 * 2048 + (db ? voff1 : voff0);
                    const v4i16_t lo = __builtin_amdgcn_ds_read_tr16_b64_v4i16((LAS v4i16_t*)vp);
                    const v4i16_t hi = __builtin_amdgcn_ds_read_tr16_b64_v4i16((LAS v4i16_t*)(vp + 1024));
                    const bf16x8 vf = {lo[0], lo[1], lo[2], lo[3], hi[0], hi[1], hi[2], hi[3]};
                    if (db == 0) o0 = __builtin_amdgcn_mfma_f32_32x32x16_bf16(vf, pb[s2], o0, 0, 0, 0);
                    else o1 = __builtin_amdgcn_mfma_f32_32x32x16_bf16(vf, pb[s2], o1, 0, 0, 0);
                }
            }
        }
    }
    const float lt = L[0], inv = 1.0f / lt;
#pragma unroll
    for (int g4 = 0; g4 < 4; ++g4) {
        v2u a, b;
        a.x = cvtpk(o0[4 * g4 + 0] * inv, o0[4 * g4 + 1] * inv); a.y = cvtpk(o0[4 * g4 + 2] * inv, o0[4 * g4 + 3] * inv);
        b.x = cvtpk(o1[4 * g4 + 0] * inv, o1[4 * g4 + 1] * inv); b.y = cvtpk(o1[4 * g4 + 2] * inv, o1[4 * g4 + 3] * inv);
        if (d.o8) { unsigned char* o8p = (unsigned char*)d.Op; const float sc = inv * Y8_SCALE;
            *(GAS unsigned*)(o8p + 8 * g4 + 4 * h) = pk4_fp8(o0[4 * g4 + 0] * sc, o0[4 * g4 + 1] * sc, o0[4 * g4 + 2] * sc, o0[4 * g4 + 3] * sc);
            *(GAS unsigned*)(o8p + 32 + 8 * g4 + 4 * h) = pk4_fp8(o1[4 * g4 + 0] * sc, o1[4 * g4 + 1] * sc, o1[4 * g4 + 2] * sc, o1[4 * g4 + 3] * sc); }
        else {
        *(GAS v2u*)(d.Op + 8 * g4 + 4 * h) = a;
        *(GAS v2u*)(d.Op + 32 + 8 * g4 + 4 * h) = b; }
    }
    if (d.Lp) { if (h == 0) *d.Lp = m + __builtin_amdgcn_logf(lt); }
}
__device__ __forceinline__ void p2_attn(Frame& F, int ch) {
    int tid_ = threadIdx.x; asm volatile("" : "+v"(tid_));
    const int tid = tid_, lane = tid & 63;
    LAS unsigned char* KL = F.lds; LAS unsigned char* VL = F.lds + ATT_VOFF;
    constexpr int NUA = (TC / SEQ) * 3 * 8 * 16, NUB = (TC / SEQ) * 2 * 128, NU = NUA + NUB;
    int u = F.vcu;
    if (u >= NU) return;
    AUnit cur, nxt;
    v4u kreg[6], vreg[6]; bf16x8 qn[4];
    attn_decode(F, ch, u, NUA, lane, cur);
    attn_load(cur, tid, lane, kreg, vreg, qn);
    for (;;) {
        attn_write(cur, KL, VL, tid, kreg, vreg);
        bf16x8 qf[4];
#pragma unroll
        for (int s4 = 0; s4 < 4; ++s4) qf[s4] = qn[s4];
        __syncthreads();
        const int un = u + F.G; const bool has_next = un < NU;
        if (has_next) { attn_decode(F, ch, un, NUA, lane, nxt); attn_load(nxt, tid, lane, kreg, vreg, qn); }
        if (cur.kk_lo == 0) attn_compute(cur, KL, VL, lane, qf); else attn_compute_edge(cur, KL, VL, lane, qf);
        __syncthreads();
        if (!has_next) break;
        cur = nxt; u = un;
    }
}
__device__ __forceinline__ void p2_combine(Frame& F, int ch, int cu, int ncu) {
    int tid_ = threadIdx.x; asm volatile("" : "+v"(tid_)); const int lane_ = tid_ & 63;
    unsigned char* ws = F.ws;
    const bf16* OG = (const bf16*)((const unsigned char*)F.out + DO_OG); const float* LSE = (const float*)((const unsigned char*)F.out + DO_LSE);
    bf16* Y = (bf16*)(ws + WS_Y) + (size_t)ch * TC * Y_W; unsigned char* Y8 = ws + WS_Y + (size_t)ch * TC * Y_W;
    const int lane = lane_, hd = lane >> 3;
    const int gw = cu * NWAVES + F.wave, NGW = ncu * NWAVES;
    for (int row0 = gw; row0 < TC; row0 += 4 * NGW) {
        float lg[4][3]; v4u og[4][3];
#pragma unroll
        for (int r = 0; r < 4; ++r) { const int row = row0 + r * NGW < TC ? row0 + r * NGW : row0;
#pragma unroll
            for (int g = 0; g < 3; ++g) { lg[r][g] = LSE[((size_t)g * TC + row) * 8 + hd]; og[r][g] = *(const GAS v4u*)(OG + ((size_t)g * TC + row) * 512 + lane * 8); } }
#pragma unroll
        for (int r = 0; r < 4; ++r) { const int row = row0 + r * NGW; if (row >= TC) continue;
            const float mx = fmaxf(fmaxf(lg[r][0], lg[r][1]), lg[r][2]);
            float e[3]; e[0] = __builtin_amdgcn_exp2f(lg[r][0] - mx); e[1] = __builtin_amdgcn_exp2f(lg[r][1] - mx); e[2] = __builtin_amdgcn_exp2f(lg[r][2] - mx);
            const float inv = 1.0f / (e[0] + e[1] + e[2]);
            float acc[8];
#pragma unroll
            for (int i = 0; i < 8; ++i) acc[i] = 0.f;
#pragma unroll
            for (int g = 0; g < 3; ++g) { const float wg = e[g] * inv; const v4u o_ = og[r][g];
                acc[0] += wg * bflo(o_.x); acc[1] += wg * bfhi(o_.x); acc[2] += wg * bflo(o_.y); acc[3] += wg * bfhi(o_.y);
                acc[4] += wg * bflo(o_.z); acc[5] += wg * bfhi(o_.z); acc[6] += wg * bflo(o_.w); acc[7] += wg * bfhi(o_.w); }
            v4u o; o.x = cvtpk(acc[0], acc[1]); o.y = cvtpk(acc[2], acc[3]); o.z = cvtpk(acc[4], acc[5]); o.w = cvtpk(acc[6], acc[7]);
            if (P34_FP8) { v2u o8; o8.x = pk4_fp8(acc[0] * Y8_SCALE, acc[1] * Y8_SCALE, acc[2] * Y8_SCALE, acc[3] * Y8_SCALE); o8.y = pk4_fp8(acc[4] * Y8_SCALE, acc[5] * Y8_SCALE, acc[6] * Y8_SCALE, acc[7] * Y8_SCALE); *(GAS v2u*)(Y8 + (size_t)row * Y_W + lane * 8) = o8; }
            else *(GAS v4u*)(Y + (size_t)row * Y_W + lane * 8) = o; }
    }
}


struct EpiMerge {
    static constexpr bool PERM = true; static constexpr int HOOK_T = P34_FP8 ? 4 : 8;
    const bf16* Gt; bf16* MG;
    __device__ __forceinline__ void hook(f32x4 (&acc)[2][2][4][2], const pg9::Unit& u, int wr, int wc, int fr, int fq) const {
        asm volatile("" : "+v"(fr), "+v"(fq));
        const bf16* gr = Gt + (size_t)(u.pm * 256 + wr * 64 + fr) * G_W + u.pn * 256 + wc * 32 + 8 * fq;
        v4u rv[8][2];
#pragma unroll
        for (int rg = 0; rg < 8; ++rg)
#pragma unroll
            for (int bj = 0; bj < 2; ++bj) rv[rg][bj] = *(const GAS v4u*)(gr + (size_t)((rg >> 2) * 128 + (rg & 3) * 16) * G_W + bj * 128);
#pragma unroll
        for (int rg = 0; rg < 8; ++rg)
#pragma unroll
            for (int bj = 0; bj < 2; ++bj) { const v4u a = rv[rg][bj];
                const f32x4 r0 = {bflo(a.x), bfhi(a.x), bflo(a.y), bfhi(a.y)}, r1 = {bflo(a.z), bfhi(a.z), bflo(a.w), bfhi(a.w)};
                acc[rg >> 2][bj][rg & 3][0] = acc[rg >> 2][bj][rg & 3][0] * r0; acc[rg >> 2][bj][rg & 3][1] = acc[rg >> 2][bj][rg & 3][1] * r1; }
    }
    __device__ __forceinline__ void operator()(const f32x4 (&acc)[2][2][4][2], const pg9::Unit& u, int wr, int wc, int fr, int fq) const {
        asm volatile("" : "+v"(fr), "+v"(fq));
        const bf16* gr = Gt + (size_t)(u.pm * 256 + wr * 64 + fr) * G_W + 1024 + u.pn * 256 + wc * 32 + 8 * fq;
        bf16* mr = MG + (size_t)(u.pm * 256 + wr * 64 + fr) * D + u.pn * 256 + wc * 32 + 8 * fq;
        v4u gb[8][2];
#pragma unroll
        for (int rg = 0; rg < 8; ++rg)
#pragma unroll
            for (int bj = 0; bj < 2; ++bj) gb[rg][bj] = *(const GAS v4u*)(gr + (size_t)((rg >> 2) * 128 + (rg & 3) * 16) * G_W + bj * 128);
#pragma unroll
        for (int rg = 0; rg < 8; ++rg)
#pragma unroll
            for (int bj = 0; bj < 2; ++bj) { const v4u b = gb[rg][bj];
                const f32x4 v0 = acc[rg >> 2][bj][rg & 3][0], v1 = acc[rg >> 2][bj][rg & 3][1];
                if (P34_FP8) { constexpr float f = MG8_SCALE / (W34_SCALE * Y8_SCALE); unsigned char* m8 = (unsigned char*)MG + (size_t)(u.pm * 256 + wr * 64 + fr) * D + u.pn * 256 + wc * 32 + 8 * fq;
                    v2u w8; w8.x = pk4_fp8(v0[0] * bflo(b.x) * f, v0[1] * bfhi(b.x) * f, v0[2] * bflo(b.y) * f, v0[3] * bfhi(b.y) * f); w8.y = pk4_fp8(v1[0] * bflo(b.z) * f, v1[1] * bfhi(b.z) * f, v1[2] * bflo(b.w) * f, v1[3] * bfhi(b.w) * f);
                    *(GAS v2u*)(m8 + (size_t)((rg >> 2) * 128 + (rg & 3) * 16) * D + bj * 128) = w8; }
                else {
                v4u w; w.x = cvtpk(v0[0] * bflo(b.x), v0[1] * bfhi(b.x)); w.y = cvtpk(v0[2] * bflo(b.y), v0[3] * bfhi(b.y));
                w.z = cvtpk(v1[0] * bflo(b.z), v1[1] * bfhi(b.z)); w.w = cvtpk(v1[2] * bflo(b.w), v1[3] * bfhi(b.w));
                *(GAS v4u*)(mr + (size_t)((rg >> 2) * 128 + (rg & 3) * 16) * D + bj * 128) = w; } }
    }
};
__device__ __forceinline__ void p3_merge(Frame& F) {
    unsigned char* ws = F.ws;
    pg9::DenseOrder S; S.init(T, D, F.G, (int)blockIdx.x);
    EpiMerge E{(const bf16*)(ws + WS_G), (bf16*)(ws + WS_MG)};
    constexpr int ES = P34_FP8 ? 1 : 2;
    pg9::DenseA ao{(unsigned)(Y_W * ES)}; pg9::DenseB bb{(const char*)(ws + WS_WAB), (size_t)256 * Y_W * ES};
    pg9::gemm_phase<ES>(F.lds, (const char*)(ws + WS_Y), Y_W, S, E, ao, bb);
}
struct EpiOut {
    static constexpr bool PERM = true; static constexpr int HOOK_T = -1;
    bf16* DELTA;
    __device__ __forceinline__ void hook(f32x4 (&)[2][2][4][2], const pg9::Unit&, int, int, int, int) const {}
    __device__ __forceinline__ void operator()(const f32x4 (&acc)[2][2][4][2], const pg9::Unit& u, int wr, int wc, int fr, int fq) const {
        asm volatile("" : "+v"(fr), "+v"(fq));
        bf16* orow = DELTA + (size_t)(u.pm * 256 + wr * 64 + fr) * D + u.pn * 256 + wc * 32 + 8 * fq;
#pragma unroll
        for (int ai = 0; ai < 2; ++ai)
#pragma unroll
            for (int m = 0; m < 4; ++m)
#pragma unroll
                for (int bj = 0; bj < 2; ++bj) { constexpr float f = P34_FP8 ? 1.0f / (W34_SCALE * MG8_SCALE) : 1.0f; const f32x4 o0 = acc[ai][bj][m][0] * f, o1 = acc[ai][bj][m][1] * f;
                    v4u w; w.x = cvtpk(o0[0], o0[1]); w.y = cvtpk(o0[2], o0[3]); w.z = cvtpk(o1[0], o1[1]); w.w = cvtpk(o1[2], o1[3]); *(GAS v4u*)(orow + (size_t)(ai * 128 + m * 16) * D + bj * 128) = w; }
    }
};
__device__ __forceinline__ void p4_outproj(Frame& F) {
    unsigned char* ws = F.ws;
    pg9::DenseOrder S; S.init(T, D, F.G, (int)blockIdx.x);
    EpiOut E{(bf16*)((unsigned char*)F.out + DO_DELTA)};
    constexpr int ES = P34_FP8 ? 1 : 2;
    pg9::DenseA ao{(unsigned)(D * ES)}; pg9::DenseB bb{(const char*)(ws + WS_WO), (size_t)256 * D * ES};
    pg9::gemm_phase<ES>(F.lds, (const char*)(ws + WS_MG), D, S, E, ao, bb);
}

__device__ __forceinline__ void p5_route(Frame& F) {
    int tid_ = threadIdx.x; asm volatile("" : "+v"(tid_)); const int lane = tid_ & 63;
    unsigned char* ws = F.ws;
    const float* X = F.in[I_X]; const bf16* DELTA = (const bf16*)((const unsigned char*)F.out + DO_DELTA);
    bf16* X1B = (bf16*)(ws + WS_X1B); unsigned char* X1F8 = ws + WS_X1F8;
    unsigned* cnt = (unsigned*)(ws + WS_CTL) + CW_CNT;
    int* tokof = (int*)(ws + WS_TOKOF); float2* wtof = (float2*)(ws + WS_WTOF); int4* tpos = (int4*)(ws + WS_TPOS);
    const v4u* WRF = (const v4u*)(ws + WS_WRF);
    LAS v4u* wl = (LAS v4u*)F.lds;
    LAS float* sl = (LAS float*)(F.lds + 98304 + F.wave * 4096);
    const int i = lane & 15, q = lane >> 4;
    LAS unsigned* hist = (LAS unsigned*)(F.lds + LDS_MISC + 2048);
    for (int wt = F.vcu; wt < T / 128; wt += F.G) {
        const int tile = wt * NWAVES + F.wave;
        if (tid_ < 32) hist[tid_] = 0u;
        const size_t roff = (size_t)(tile * 16 + i) * D + 8 * q;
        const float* xr = X + roff; const bf16* dr = DELTA + roff;
        f32x4 a0 = {0.f, 0.f, 0.f, 0.f}, a1 = a0, a2 = a0; float ss = 0.f;
        f32x4 va[8][2]; v4u vd[8];
#pragma unroll
        for (int j = 0; j < 8; ++j) { va[j][0] = *(const GAS f32x4*)(xr + 32 * j); va[j][1] = *(const GAS f32x4*)(xr + 32 * j + 4); vd[j] = *(const GAS v4u*)(dr + 32 * j); }
#pragma unroll 1
        for (int half = 0; half < 2; ++half) {
            __syncthreads();
            { v4u t[12];
#pragma unroll
              for (int k = 0; k < 12; ++k) t[k] = WRF[half * 6144 + k * 512 + tid_];
#pragma unroll
              for (int k = 0; k < 12; ++k) wl[k * 512 + tid_] = t[k]; }
            __syncthreads();
#pragma unroll 1
            for (int sb = 0; sb < 2; ++sb) {
#pragma unroll
                for (int j = 0; j < 8; ++j) {
                    const int ksl = sb * 8 + j, ks = half * 16 + ksl;
                    const v4u dd = vd[j];
                    const f32x4 v0 = va[j][0] + (f32x4){bflo(dd.x), bfhi(dd.x), bflo(dd.y), bfhi(dd.y)}, v1 = va[j][1] + (f32x4){bflo(dd.z), bfhi(dd.z), bflo(dd.w), bfhi(dd.w)};
                    if (ks + 8 < 32) { va[j][0] = *(const GAS f32x4*)(xr + 32 * (ks + 8)); va[j][1] = *(const GAS f32x4*)(xr + 32 * (ks + 8) + 4); vd[j] = *(const GAS v4u*)(dr + 32 * (ks + 8)); }
                    ss += ((v0[0] * v0[0] + v0[1] * v0[1]) + (v0[2] * v0[2] + v0[3] * v0[3])) + ((v1[0] * v1[0] + v1[1] * v1[1]) + (v1[2] * v1[2] + v1[3] * v1[3]));
                    v4u hu; hu.x = cvtpk(v0[0], v0[1]); hu.y = cvtpk(v0[2], v0[3]); hu.z = cvtpk(v1[0], v1[1]); hu.w = cvtpk(v1[2], v1[3]);
                    v4u lu; lu.x = cvtpk(v0[0] - bflo(hu.x), v0[1] - bfhi(hu.x)); lu.y = cvtpk(v0[2] - bflo(hu.y), v0[3] - bfhi(hu.y)); lu.z = cvtpk(v1[0] - bflo(hu.z), v1[1] - bfhi(hu.z)); lu.w = cvtpk(v1[2] - bflo(hu.w), v1[3] - bfhi(hu.w));
                    *(GAS v4u*)(X1B + roff + 32 * ks) = hu;
                    if (P6_FP8) { v2u w8; w8.x = pk4_fp8(v0[0], v0[1], v0[2], v0[3]); w8.y = pk4_fp8(v1[0], v1[1], v1[2], v1[3]); *(GAS v2u*)(X1F8 + roff + 32 * ks) = w8; }
                    const bf16x8 ah = __builtin_bit_cast(bf16x8, hu), al = __builtin_bit_cast(bf16x8, lu);
#pragma unroll
                    for (int nb = 0; nb < 3; ++nb) {
                        const bf16x8 bh = __builtin_bit_cast(bf16x8, wl[((ksl * 3 + nb) * 2 + 0) * 64 + lane]), bl = __builtin_bit_cast(bf16x8, wl[((ksl * 3 + nb) * 2 + 1) * 64 + lane]);
                        f32x4 acc = nb == 0 ? a0 : (nb == 1 ? a1 : a2);
                        acc = __builtin_amdgcn_mfma_f32_16x16x32_bf16(ah, bh, acc, 0, 0, 0); acc = __builtin_amdgcn_mfma_f32_16x16x32_bf16(ah, bl, acc, 0, 0, 0); acc = __builtin_amdgcn_mfma_f32_16x16x32_bf16(al, bh, acc, 0, 0, 0);
                        if (nb == 0) a0 = acc; else if (nb == 1) a1 = acc; else a2 = acc;
                    }
                }
            }
        }
        ss += __shfl_xor(ss, 16); ss += __shfl_xor(ss, 32);
#pragma unroll
        for (int r = 0; r < 4; ++r) { sl[(4 * q + r) * 48 + i] = a0[r]; sl[(4 * q + r) * 48 + 16 + i] = a1[r]; sl[(4 * q + r) * 48 + 32 + i] = a2[r]; }
        LDS_WAIT(); asm volatile("" ::: "memory");
        int e0 = 0, e1 = 0, lp0 = 0, lp1 = 0; float w1 = 0.f, w2 = 0.f, rstd = 0.f;
        __syncthreads();
        if (lane < 16) {
            rstd = 1.0f / sqrtf(ss * (1.f / D) + RMS_EPS);
            float lg[36];
#pragma unroll
            for (int o = 0; o < 36; ++o) lg[o] = sl[lane * 48 + o] * rstd + (o < 4 ? F.in[I_BRG][o] : F.in[I_BRE][o - 4]);
            int gsel = 0; float gmax = lg[0];
#pragma unroll
            for (int k = 1; k < 4; ++k) if (lg[k] > gmax) { gmax = lg[k]; gsel = k; }
            float gden = 0.f;
#pragma unroll
            for (int k = 0; k < 4; ++k) gden += __expf(lg[k] - gmax);
            const float pg = 1.0f / gden;
            float le[8];
#pragma unroll
            for (int j = 0; j < 8; ++j) { le[j] = lg[4 + j];
#pragma unroll
                for (int gi = 1; gi < 4; ++gi) le[j] = (gsel == gi) ? lg[4 + gi * 8 + j] : le[j]; }
            int i1 = 0; float m1 = le[0];
#pragma unroll
            for (int j = 1; j < 8; ++j) if (le[j] > m1) { m1 = le[j]; i1 = j; }
            int i2 = -1; float m2 = -INFINITY;
#pragma unroll
            for (int j = 0; j < 8; ++j) if (j != i1 && le[j] > m2) { m2 = le[j]; i2 = j; }
            const float e2 = __expf(m2 - m1);
            w1 = pg / (1.0f + e2); w2 = pg * e2 / (1.0f + e2);
            e0 = gsel * 8 + i1; e1 = gsel * 8 + i2;
            lp0 = (int)__hip_atomic_fetch_add(&hist[e0], 1u, __ATOMIC_RELAXED, __HIP_MEMORY_SCOPE_WORKGROUP);
            lp1 = (int)__hip_atomic_fetch_add(&hist[e1], 1u, __ATOMIC_RELAXED, __HIP_MEMORY_SCOPE_WORKGROUP);
        }
        __syncthreads();
        if (tid_ < 32) { const unsigned n = hist[tid_]; hist[32 + tid_] = n ? atomicAdd(&cnt[64 * tid_], n) : 0u; }
        __syncthreads();
        if (lane < 16) {
            const int row = tile * 16 + lane;
            const int p0 = (int)hist[32 + e0] + lp0, p1 = (int)hist[32 + e1] + lp1;
            tokof[(size_t)e0 * T + p0] = row; wtof[(size_t)e0 * T + p0] = make_float2(w1, rstd);
            tokof[(size_t)e1 * T + p1] = row; wtof[(size_t)e1 * T + p1] = make_float2(w2, rstd);
            tpos[row] = make_int4(e0, p0, e1, p1);
        }
        __syncthreads();
    }
}

__device__ __forceinline__ void expert_tiles(Frame& F, LAS int* tb, LAS int* cn) {
    int tid_ = threadIdx.x; asm volatile("" : "+v"(tid_)); const int lane_ = tid_ & 63;
    if (tid_ == 0) {
        const unsigned* cnt = (const unsigned*)(F.ws + WS_CTL) + CW_CNT;
        int acc = 0;
        for (int e = 0; e < NE; ++e) { const int c = (int)__hip_atomic_load(cnt + 64 * e, __ATOMIC_RELAXED, __HIP_MEMORY_SCOPE_AGENT); cn[e] = c; tb[e] = acc; acc += (c + 255) >> 8; }
        tb[NE] = acc;
    }
    __syncthreads();
}

struct MoeOrder { const LAS int* tb; int ncol, G, c;
    __device__ bool next(int i, pg9::Unit& u) const {
        const int L = i * G + c; if (L >= tb[NE] * ncol) return false;
        const int rt = L / ncol; int e = 0;
        for (int k = 1; k < NE; ++k) if (tb[k] <= rt) e = k;
        u.pm = rt; u.pn = L % ncol; u.e = e; return true; } };
struct GatherA { static constexpr bool GATHER = true; unsigned rowbytes; const int* tokof; const LAS int* tb; const LAS int* cn;
    __device__ __forceinline__ unsigned operator()(const pg9::Unit& u, int row) const {
        const int p = (u.pm - tb[u.e]) * 256 + row; const int tok = tokof[(size_t)u.e * T + (p < cn[u.e] ? p : 0)]; return (unsigned)tok * rowbytes; } };
struct ExpertB { const char* W; size_t ebytes, tilebytes; __device__ __forceinline__ const char* operator()(const pg9::Unit& u) const { return W + (size_t)u.e * ebytes + (size_t)u.pn * tilebytes; } };
struct EpiGateUp {
    static constexpr bool PERM = true; static constexpr int HOOK_T = -1;
    const float2* wtof; bf16* HACT; const LAS int* tb; const LAS int* cn; float ascale;
    __device__ __forceinline__ void hook(f32x4 (&)[2][2][4][2], const pg9::Unit&, int, int, int, int) const {}
    __device__ __forceinline__ void operator()(const f32x4 (&acc)[2][2][4][2], const pg9::Unit& u, int wr, int wc, int fr, int fq) const {
        asm volatile("" : "+v"(fr), "+v"(fq));
        const int r0 = wr * 64 + fr, p0 = (u.pm - tb[u.e]) * 256, ce = cn[u.e];
        const float2* wp = wtof + (size_t)u.e * T;
#pragma unroll
        for (int ai = 0; ai < 2; ++ai) {
            float2 wv[4];
#pragma unroll
            for (int m = 0; m < 4; ++m) { const int p = p0 + r0 + ai * 128 + m * 16; wv[m] = p < ce ? wp[p] : make_float2(0.f, 0.f); }
#pragma unroll
            for (int m = 0; m < 4; ++m) { const int r = r0 + ai * 128 + m * 16;
                const float w = wv[m].x, rs = wv[m].y * ascale;
                bf16* orow = HACT + (size_t)(u.pm * 256 + r) * DE + u.pn * 128 + wc * 16 + 4 * fq; unsigned char* orow8 = (unsigned char*)HACT + (size_t)(u.pm * 256 + r) * DE + u.pn * 128 + wc * 16 + 4 * fq;
#pragma unroll
                for (int bj = 0; bj < 2; ++bj) { const f32x4 g = acc[ai][bj][m][0], uu = acc[ai][bj][m][1]; f32x4 hv;
#pragma unroll
                    for (int e = 0; e < 4; ++e) { const float gg = g[e] * rs; hv[e] = gg / (1.0f + __expf(-gg)) * (uu[e] * rs) * w; }
                    if (P6_FP8) *(GAS unsigned*)(orow8 + bj * 64) = pk4_fp8(hv[0] * H8_SCALE, hv[1] * H8_SCALE, hv[2] * H8_SCALE, hv[3] * H8_SCALE);
                    else { v2u o; o.x = cvtpk(hv[0], hv[1]); o.y = cvtpk(hv[2], hv[3]); *(GAS v2u*)(orow + bj * 64) = o; } } }
        }
    }
};
__device__ __forceinline__ void p6a_gateup(Frame& F) {
    unsigned char* ws = F.ws;
    LAS int* tb = (LAS int*)(F.lds + LDS_MISC + 1024); LAS int* cn = tb + 64;
    expert_tiles(F, tb, cn);
    MoeOrder S{tb, 2, F.G, F.vcu};
    constexpr int ES = P6_FP8 ? 1 : 2;
    GatherA ao{(unsigned)(D * ES), (const int*)(ws + WS_TOKOF), tb, cn}; ExpertB bb{(const char*)(ws + WS_WGU), (size_t)512 * D * ES, (size_t)256 * D * ES};
    EpiGateUp E{(const float2*)(ws + WS_WTOF), (bf16*)(ws + WS_HACT), tb, cn, P6_FP8 ? 1.0f / WG8_SCALE : 1.0f};
    pg9::gemm_phase<ES>(F.lds, (const char*)(ws + (P6_FP8 ? WS_X1F8 : WS_X1B)), D, S, E, ao, bb);
}
struct EpiDown {
    static constexpr bool PERM = true; static constexpr int HOOK_T = -1;
    bf16* YS; float ascale;
    __device__ __forceinline__ void hook(f32x4 (&)[2][2][4][2], const pg9::Unit&, int, int, int, int) const {}
    __device__ __forceinline__ void operator()(const f32x4 (&acc)[2][2][4][2], const pg9::Unit& u, int wr, int wc, int fr, int fq) const {
        asm volatile("" : "+v"(fr), "+v"(fq));
#pragma unroll
        for (int ai = 0; ai < 2; ++ai)
#pragma unroll
            for (int m = 0; m < 4; ++m) { bf16* orow = YS + (size_t)(u.pm * 256 + wr * 64 + fr + ai * 128 + m * 16) * D + u.pn * 256 + wc * 32 + 8 * fq;
#pragma unroll
                for (int bj = 0; bj < 2; ++bj) { const f32x4 v0 = acc[ai][bj][m][0] * ascale, v1 = acc[ai][bj][m][1] * ascale;
                    if (YS_FP8) { unsigned char* o8 = (unsigned char*)YS + (size_t)(u.pm * 256 + wr * 64 + fr + ai * 128 + m * 16) * D + u.pn * 256 + wc * 32 + 8 * fq + bj * 128;
                        v2u w8; w8.x = pk4_fp8(v0[0] * YS8_SCALE, v0[1] * YS8_SCALE, v0[2] * YS8_SCALE, v0[3] * YS8_SCALE); w8.y = pk4_fp8(v1[0] * YS8_SCALE, v1[1] * YS8_SCALE, v1[2] * YS8_SCALE, v1[3] * YS8_SCALE); *(GAS v2u*)o8 = w8; }
                    else { v4u w; w.x = cvtpk(v0[0], v0[1]); w.y = cvtpk(v0[2], v0[3]); w.z = cvtpk(v1[0], v1[1]); w.w = cvtpk(v1[2], v1[3]); *(GAS v4u*)(orow + bj * 128) = w; } } }
    }
};
__device__ __forceinline__ void p6b_down(Frame& F) {
    unsigned char* ws = F.ws;
    LAS int* tb = (LAS int*)(F.lds + LDS_MISC + 1024); LAS int* cn = tb + 64;
    expert_tiles(F, tb, cn);
    MoeOrder S{tb, 4, F.G, F.vcu};
    constexpr int ES = P6_FP8 ? 1 : 2;
    pg9::DenseA ao{(unsigned)(DE * ES)}; ExpertB bb{(const char*)(ws + WS_WD), (size_t)D * DE * ES, (size_t)256 * DE * ES};
    EpiDown E{(bf16*)(ws + WS_YS), P6_FP8 ? 1.0f / (WD8_SCALE * H8_SCALE) : 1.0f};
    pg9::gemm_phase<ES>(F.lds, (const char*)(ws + WS_HACT), DE, S, E, ao, bb);
}
__device__ __forceinline__ void p7_final(Frame& F) {
    int tid_ = threadIdx.x; asm volatile("" : "+v"(tid_)); const int lane_ = tid_ & 63;
    unsigned char* ws = F.ws;
    LAS int* tb = (LAS int*)(F.lds + LDS_MISC + 1024); LAS int* cn = tb + 64;
    expert_tiles(F, tb, cn);
    const bf16* YS = (const bf16*)(ws + WS_YS); const int4* tpos = (const int4*)(ws + WS_TPOS);
    float* X1 = F.out; const bf16* X1B = (const bf16*)(ws + WS_X1B);
    const int lane = lane_;
    const int gw = F.vcu * NWAVES + F.wave, NGW = F.G * NWAVES;
    const GAS f32x4* gr = (const GAS f32x4*)F.in[I_GFIN] + lane;
    for (int row = gw; row < T; row += NGW) {
        const int4 tp = tpos[row];
        const size_t s0 = (size_t)tb[tp.x] * 256 + tp.y, s1 = (size_t)tb[tp.z] * 256 + tp.w;
        GAS f32x4* xr = (GAS f32x4*)(X1 + (size_t)row * D) + lane; const GAS v2u* xb = (const GAS v2u*)(X1B + (size_t)row * D) + lane;
        const GAS v2u* y0 = (const GAS v2u*)(YS + s0 * D) + lane; const GAS v2u* y1 = (const GAS v2u*)(YS + s1 * D) + lane;
        const GAS unsigned* z0 = (const GAS unsigned*)((const unsigned char*)YS + s0 * D) + lane; const GAS unsigned* z1 = (const GAS unsigned*)((const unsigned char*)YS + s1 * D) + lane;
        f32x4 v[4]; float s = 0.f;
#pragma unroll
        for (int j = 0; j < 4; ++j) { const v2u xx = xb[64 * j]; v[j] = (f32x4){bflo(xx.x), bfhi(xx.x), bflo(xx.y), bfhi(xx.y)};
            if (YS_FP8) { const int a = (int)z0[64 * j], b = (int)z1[64 * j]; typedef float f2_ __attribute__((ext_vector_type(2)));
                const f2_ a0 = __builtin_amdgcn_cvt_pk_f32_fp8(a, false), a1 = __builtin_amdgcn_cvt_pk_f32_fp8(a, true), b0 = __builtin_amdgcn_cvt_pk_f32_fp8(b, false), b1 = __builtin_amdgcn_cvt_pk_f32_fp8(b, true);
                constexpr float f = 1.0f / YS8_SCALE; v[j].x += (a0[0] + b0[0]) * f; v[j].y += (a0[1] + b0[1]) * f; v[j].z += (a1[0] + b1[0]) * f; v[j].w += (a1[1] + b1[1]) * f; }
            else { const v2u a = y0[64 * j], b = y1[64 * j];
            v[j].x += bflo(a.x) + bflo(b.x); v[j].y += bfhi(a.x) + bfhi(b.x); v[j].z += bflo(a.y) + bflo(b.y); v[j].w += bfhi(a.y) + bfhi(b.y); }
            s += (v[j].x * v[j].x + v[j].y * v[j].y) + (v[j].z * v[j].z + v[j].w * v[j].w); }
        const float rstd = 1.0f / sqrtf(wave_sum(s) * (1.f / D) + RMS_EPS);
#pragma unroll
        for (int j = 0; j < 4; ++j) { const f32x4 gg = gr[64 * j]; f32x4 o; o.x = v[j].x * rstd * gg.x; o.y = v[j].y * rstd * gg.y; o.z = v[j].z * rstd * gg.z; o.w = v[j].w * rstd * gg.w; xr[64 * j] = o; }
    }
}

constexpr int NPHASE = 2 * NCH + 8;
__global__ void __launch_bounds__(NTHR, 2) fwd_kernel(KArgs args) {
    extern __shared__ __attribute__((aligned(16))) unsigned char lds_raw[];
    Frame F;
    F.lds = (LAS unsigned char*)lds_raw;
    F.tid = threadIdx.x; F.lane = F.tid & 63; F.wave = __builtin_amdgcn_readfirstlane(F.tid >> 6);
    F.G = gridDim.x; { const int bx = blockIdx.x; F.vcu = (F.G % 8 == 0) ? (bx % 8) * (F.G / 8) + bx / 8 : bx; }
#pragma unroll
    for (int i = 0; i < 17; ++i) F.in[i] = args.in[i];
    F.out = args.out; F.ws = args.ws;
    volatile LAS unsigned* MISC = (volatile LAS unsigned*)(F.lds + LDS_MISC);
    if (F.tid < 64) MISC[F.tid] = 0u;
    __syncthreads();
    XcdBarrier bar = xcd_barrier_post((unsigned*)(F.ws + WS_CTL) + CW_BAR + args.li * XCD_BAR_WORDS, MISC + 8);
#define IN(k) (args.ph_lo <= (k) && (k) < args.ph_hi)
#ifdef PROBE_MASK
    unsigned long long pr_acc = 0, pr_t0 = 0; const bool pr_me = (blockIdx.x == 0 && threadIdx.x == 0);
#define PR_BEGIN(k) do { if (pr_me && ((PROBE_MASK >> (k)) & 1ull)) pr_t0 = __builtin_amdgcn_s_memrealtime(); } while (0)
#define PR_END(k) do { if (pr_me && ((PROBE_MASK >> (k)) & 1ull)) pr_acc += __builtin_amdgcn_s_memrealtime() - pr_t0; } while (0)
#else
#define PR_BEGIN(k) do {} while (0)
#define PR_END(k) do {} while (0)
#endif
#define SEAM(k) do { if (IN(k) && IN((k) + 1)) xcd_barrier(bar); PR_END(k); } while (0)
    PR_BEGIN(0); if (IN(0)) p0_prologue(F);
    SEAM(0);
#pragma unroll 1
    for (int ch = 0; ch < NCH; ++ch) {
        PR_BEGIN(1 + 2 * ch);
        if (IN(1 + 2 * ch)) {
            constexpr int NWG1 = (TC / 256) * (NIN / 256);
            const int nfull = NWG1 % F.G, bx = (int)blockIdx.x;
            if (ch > 0 && nfull == 0) p2_combine(F, ch - 1, F.vcu, F.G);
            p1_inproj(F, ch);
            if (ch > 0 && nfull != 0 && bx >= nfull) p2_combine(F, ch - 1, bx - nfull, F.G - nfull);
        }
        SEAM(1 + 2 * ch);
        PR_BEGIN(2 + 2 * ch); if (IN(2 + 2 * ch)) p2_attn(F, ch);
        SEAM(2 + 2 * ch);
    }
    PR_BEGIN(2 * NCH + 1); if (IN(2 * NCH + 1)) p2_combine(F, NCH - 1, F.vcu, F.G);
    SEAM(2 * NCH + 1);
    PR_BEGIN(2 * NCH + 2); if (IN(2 * NCH + 2)) p3_merge(F);
    SEAM(2 * NCH + 2);
    PR_BEGIN(2 * NCH + 3); if (IN(2 * NCH + 3)) p4_outproj(F);
    SEAM(2 * NCH + 3);
    PR_BEGIN(2 * NCH + 4); if (IN(2 * NCH + 4)) p5_route(F);
    SEAM(2 * NCH + 4);
    PR_BEGIN(2 * NCH + 5); if (IN(2 * NCH + 5)) p6a_gateup(F);
    SEAM(2 * NCH + 5);
    PR_BEGIN(2 * NCH + 6); if (IN(2 * NCH + 6)) p6b_down(F);
    SEAM(2 * NCH + 6);
    PR_BEGIN(2 * NCH + 7); if (IN(2 * NCH + 7)) p7_final(F);
    PR_END(2 * NCH + 7);
#ifdef PROBE_MASK
    if (pr_me) { const unsigned long long t1 = __builtin_amdgcn_s_memrealtime(); while (__builtin_amdgcn_s_memrealtime() - t1 < pr_acc) __builtin_amdgcn_s_sleep(4); }
#endif
#undef IN
#undef SEAM
}

#ifndef N_LAUNCHES
#define N_LAUNCHES 1
#endif
extern "C" void kernel_launch(void* const* d_in, const int* in_sizes, int n_in, void* d_out, int out_size, void* d_ws, size_t ws_size, hipStream_t stream) {
    static int grid = 0;
    if (grid == 0) {
        if (n_in != 17 || in_sizes[0] != T * D || out_size != T * D || ws_size < WS_END) { fprintf(stderr, "kernel_launch: unexpected shapes / workspace (%d inputs, ws %zu)\n", n_in, ws_size); grid = -1; return; }
        int dev = 0, cus = 0;
        if (hipGetDevice(&dev) != hipSuccess || hipDeviceGetAttribute(&cus, hipDeviceAttributeMultiprocessorCount, dev) != hipSuccess) { grid = -1; return; }
        if (hipFuncSetAttribute((const void*)fwd_kernel, hipFuncAttributeMaxDynamicSharedMemorySize, LDS_BYTES) != hipSuccess) { fprintf(stderr, "kernel_launch: hipFuncSetAttribute failed\n"); grid = -1; return; }
        int per_cu = 0;
        if (hipOccupancyMaxActiveBlocksPerMultiprocessor(&per_cu, (const void*)fwd_kernel, NTHR, LDS_BYTES) != hipSuccess || per_cu < 1) fprintf(stderr, "kernel_launch: occupancy query says %d\n", per_cu);
        (void)hipGetLastError();
        grid = cus;
    }
    if (grid < 0) return;
    (void)hipMemsetAsync((char*)d_ws + WS_CTL, 0, N_LAUNCHES == 1 ? (size_t)(CW_BAR + XCD_BAR_WORDS) * 4 : CTL_BYTES, stream);
    KArgs a{};
    for (int i = 0; i < 17; ++i) a.in[i] = (const float*)d_in[i];
    a.out = (float*)d_out; a.ws = (unsigned char*)d_ws;
    for (int li = 0; li < N_LAUNCHES; ++li) {
        a.ph_lo = (int)((long)NPHASE * li / N_LAUNCHES); a.ph_hi = (int)((long)NPHASE * (li + 1) / N_LAUNCHES); a.li = li;
        hipLaunchKernelGGL(fwd_kernel, dim3(grid), dim3(NTHR), LDS_BYTES, stream, a);
    }
}
```

```cpp
#include <hip/hip_runtime.h>
#include <cstdint>
#include <cstdio>

#define GAS __attribute__((address_space(1)))
#define LAS __attribute__((address_space(3)))
typedef unsigned short bf16;
typedef short bf16x8 __attribute__((ext_vector_type(8)));
typedef float f32x4 __attribute__((ext_vector_type(4)));
typedef unsigned v4u __attribute__((ext_vector_type(4)));
typedef unsigned v2u __attribute__((ext_vector_type(2)));
typedef GAS unsigned gu32;

constexpr int T = 32768, D = 1024, SEQ = 4096, NIN = 7936;
constexpr int A_W = 4608, B_W = 1280, G_W = 2048, Y_W = 1536;
constexpr int NE = 32, DE = 256;
constexpr int NCH = 4, TC = T / NCH;
constexpr float QSCALE = 0.125f * 1.4426950408889634f;
constexpr float LOG2E = 1.4426950408889634f;
constexpr float RMS_EPS = 1e-6f;
#ifndef P1_FP8
#define P1_FP8 1
#endif
constexpr float W8_SCALE = P1_FP8 ? 64.0f : 0.0f, W8_INV = P1_FP8 ? 1.0f / 64.0f : 1.0f;
#ifndef P6_FP8
#define P6_FP8 1
#endif
#ifndef P34_FP8
#define P34_FP8 1
#endif
constexpr float Y8_SCALE = 16.0f, W34_SCALE = 64.0f, MG8_SCALE = 32.0f;
#ifndef YS_FP8
#define YS_FP8 1
#endif
constexpr float YS8_SCALE = 16.0f;
constexpr float WG8_SCALE = P6_FP8 ? 64.0f : 0.0f, WD8_SCALE = P6_FP8 ? 32.0f : 0.0f, H8_SCALE = 32.0f;
constexpr int NWAVES = 8, NTHR = 512;

constexpr size_t MiB = 1u << 20;
constexpr size_t WS_CTL = 0, CTL_BYTES = 1 * MiB;
constexpr size_t WS_INVF = 1 * MiB;
constexpr size_t WS_WRF = 2 * MiB;
constexpr size_t WS_TOKOF = 3 * MiB;
constexpr size_t WS_WTOF = 7 * MiB;
constexpr size_t WS_TPOS = 15 * MiB;
constexpr size_t WS_WIN = 16 * MiB;
constexpr size_t WS_WAB = 32 * MiB;
constexpr size_t WS_WO = 35 * MiB;
constexpr size_t WS_WGU = 37 * MiB;
constexpr size_t WS_WD = 69 * MiB;
constexpr size_t WS_G = 86 * MiB;
constexpr size_t WS_Y = 214 * MiB;
constexpr size_t WS_ZA = 310 * MiB;
constexpr size_t WS_ZB = 454 * MiB;
constexpr size_t WS_END = 494 * MiB;
constexpr size_t WS_MG = WS_ZA;
constexpr size_t WS_X1B = WS_ZA + 64 * MiB;
constexpr size_t WS_X1F8 = WS_Y + 64 * MiB;
constexpr size_t WS_HACT = WS_G;
constexpr size_t WS_YS = WS_G + 36 * MiB;
constexpr size_t DO_DELTA = 0;
constexpr size_t DO_HN = 0;
constexpr size_t DO_OG = 64 * MiB;
constexpr size_t DO_LSE = 112 * MiB;
constexpr int MAXSLOT = 2 * T + NE * 256;
static_assert(WS_ZA + (size_t)TC * A_W * 2 <= WS_ZB && WS_ZB + (size_t)TC * B_W * 2 <= WS_END && WS_Y + (size_t)T * Y_W * 2 <= WS_ZA && WS_G + (size_t)T * G_W * 2 <= WS_Y, "ws map");
static_assert(WS_MG + (size_t)T * D * 2 <= WS_END && WS_HACT + (size_t)MAXSLOT * DE * 2 <= WS_YS && WS_YS + (size_t)MAXSLOT * D * 2 <= WS_ZA && WS_X1B >= WS_MG + (size_t)T * D * 2 && WS_X1B + (size_t)T * D * 2 <= WS_ZB, "ws map");
static_assert(DO_OG + (size_t)3 * TC * 512 * 2 <= DO_LSE && DO_LSE + (size_t)3 * TC * 8 * 4 <= (size_t)T * D * 4 && DO_HN + (size_t)T * D * 2 <= DO_OG, "d_out scratch map");
constexpr int CW_CNT = 1024;
constexpr int CW_BAR = 4096;
constexpr int LDS_BYTES = 147456;
constexpr int LDS_MISC = 131072;

__device__ __forceinline__ unsigned f2bf(float f) { unsigned u = __builtin_bit_cast(unsigned, f); return (u + 0x7fffu + ((u >> 16) & 1u)) >> 16; }
__device__ __forceinline__ unsigned pk4_fp8(float a, float b, float c, float d) {
    a = __builtin_amdgcn_fmed3f(a, -448.f, 448.f); b = __builtin_amdgcn_fmed3f(b, -448.f, 448.f); c = __builtin_amdgcn_fmed3f(c, -448.f, 448.f); d = __builtin_amdgcn_fmed3f(d, -448.f, 448.f);
    int w = 0; w = __builtin_amdgcn_cvt_pk_fp8_f32(a, b, w, false); w = __builtin_amdgcn_cvt_pk_fp8_f32(c, d, w, true); return (unsigned)w; }
__device__ __forceinline__ unsigned pk2(float lo, float hi) { return f2bf(lo) | (f2bf(hi) << 16); }
__device__ __forceinline__ float bf2f(unsigned b) { return __builtin_bit_cast(float, b << 16); }
__device__ __forceinline__ float bflo(unsigned u) { return __builtin_bit_cast(float, u << 16); }
__device__ __forceinline__ float bfhi(unsigned u) { return __builtin_bit_cast(float, u & 0xffff0000u); }
__device__ __forceinline__ float wave_sum(float v) {
#pragma unroll
    for (int o = 1; o < 64; o <<= 1) v += __shfl_xor(v, o);
    return v;
}
__device__ __forceinline__ float wave_max(float v) {
#pragma unroll
    for (int o = 1; o < 64; o <<= 1) v = fmaxf(v, __shfl_xor(v, o));
    return v;
}
typedef float f32x2_t __attribute__((ext_vector_type(2)));
typedef __bf16 bf16x2_t __attribute__((ext_vector_type(2)));
__device__ __forceinline__ unsigned cvtpk(float lo, float hi) { f32x2_t v = {lo, hi}; bf16x2_t b = __builtin_convertvector(v, bf16x2_t); return __builtin_bit_cast(unsigned, b); }
#ifndef WT_STORES
#define WT_STORES 0
#endif
__device__ __forceinline__ __amdgpu_buffer_rsrc_t wt_rsrc(unsigned char* base) { return __builtin_amdgcn_make_buffer_rsrc(base, 0, 0x7ffffffc, 0x00020000); }
__device__ __forceinline__ void st16(__amdgpu_buffer_rsrc_t r, unsigned char* base, void* p, v4u v) { if (WT_STORES) __builtin_amdgcn_raw_buffer_store_b128(v, r, (unsigned)((unsigned char*)p - base), 0, 16); else *(GAS v4u*)p = v; }
__device__ __forceinline__ void st8(__amdgpu_buffer_rsrc_t r, unsigned char* base, void* p, v2u v) { if (WT_STORES) __builtin_amdgcn_raw_buffer_store_b64(v, r, (unsigned)((unsigned char*)p - base), 0, 16); else *(GAS v2u*)p = v; }
#define LDS_WAIT() asm volatile("s_waitcnt lgkmcnt(0)" ::: "memory")
#define VM_WAIT() asm volatile("s_waitcnt vmcnt(0)" ::: "memory")

#define XB_TMO      128
#define XB_XCNT(j)  (256  + 64 * (j))
#define XB_XSUB(j)  (1280 + 64 * (j))
#define XB_XGEN(j)  (2304 + 64 * (j))
#define XB_TOP      3328
#define XB_TOPGEN   3392
#define XCD_BAR_WORDS 3456
#define XB_SPIN_CAP (1u << 18)
__device__ __forceinline__ unsigned xb_ld(unsigned* p)              { return __hip_atomic_load(p, __ATOMIC_RELAXED, __HIP_MEMORY_SCOPE_AGENT); }
__device__ __forceinline__ unsigned xb_add(unsigned* p, unsigned v) { return __hip_atomic_fetch_add(p, v, __ATOMIC_RELAXED, __HIP_MEMORY_SCOPE_AGENT); }
__device__ __forceinline__ unsigned xb_xcc_id() { return (unsigned)__builtin_amdgcn_s_getreg((3 << 11) | 20) & 0xFu; }
#define XB_SPIN(cond, bar) do { unsigned _sp = 0; while (cond) { __builtin_amdgcn_s_sleep(1); \
    if ((++_sp & 255u) == 0u) { if (xb_ld(&(bar)[XB_TMO])) break; if (_sp > XB_SPIN_CAP) { atomicAdd(&(bar)[XB_TMO], 1u); break; } } } } while (0)
struct XcdBarrier { unsigned* bar; unsigned x; volatile LAS unsigned* st; };
__device__ __forceinline__ XcdBarrier xcd_barrier_post(unsigned* bar, volatile LAS unsigned* st) {
    XcdBarrier b; b.bar = bar; b.x = xb_xcc_id(); b.st = st;
    if (threadIdx.x == 0) (void)xb_add(&bar[XB_XCNT(b.x)], 1u);
    return b;
}
__device__ __forceinline__ void xcd_barrier_complete(unsigned* bar, unsigned x, unsigned& nloc, unsigned& nx) {
    const unsigned G = gridDim.x * gridDim.y * gridDim.z;
    unsigned sum, cnt, mine, sp = 0u;
    for (;;) {
        sum = 0u; cnt = 0u; mine = 0u;
#pragma unroll
        for (unsigned j = 0; j < 16; ++j) { const unsigned c = xb_ld(&bar[XB_XCNT(j)]); sum += c; cnt += (c > 0u) ? 1u : 0u; mine = (j == x) ? c : mine; }
        if (sum == G) break;
        __builtin_amdgcn_s_sleep(1);
        if ((++sp & 255u) == 0u) { if (xb_ld(&bar[XB_TMO])) break; if (sp > XB_SPIN_CAP) { atomicAdd(&bar[XB_TMO], 1u); break; } }
    }
    nloc = mine > 0u ? mine : 1u; nx = cnt > 0u ? cnt : 1u;
}
__device__ __forceinline__ void xcd_barrier(const XcdBarrier& b) {
    asm volatile("s_waitcnt vmcnt(0)" ::: "memory");
    __syncthreads();
    if (threadIdx.x == 0) {
        unsigned* bar = b.bar;
        __builtin_amdgcn_s_waitcnt(0);
        unsigned nloc = b.st[0], nx = b.st[1];
        if (nloc == 0u) { xcd_barrier_complete(bar, b.x, nloc, nx); b.st[0] = nloc; b.st[1] = nx; }
        const unsigned old = xb_add(&bar[XB_XSUB(b.x)], 1u);
        const unsigned gen = old / nloc;
        if (old + 1u == (gen + 1u) * nloc) {
            __builtin_amdgcn_fence(__ATOMIC_RELEASE, "agent");
            asm volatile("s_waitcnt vmcnt(0)" ::: "memory");
            const unsigned og = xb_add(&bar[XB_TOP], 1u);
            const unsigned tg = og / nx;
            if (og + 1u == (tg + 1u) * nx) xb_add(&bar[XB_TOPGEN], 1u);
            else XB_SPIN(xb_ld(&bar[XB_TOPGEN]) == tg, bar);
            __builtin_amdgcn_fence(__ATOMIC_ACQUIRE, "agent");
            xb_add(&bar[XB_XGEN(b.x)], 1u);
            asm volatile("s_waitcnt vmcnt(0)" ::: "memory");
        } else {
            XB_SPIN(xb_ld(&bar[XB_XGEN(b.x)]) == gen, bar);
            __builtin_amdgcn_fence(__ATOMIC_ACQUIRE, "agent");
            asm volatile("s_waitcnt vmcnt(0)" ::: "memory");
        }
    }
    __syncthreads();
}

struct KArgs { const float* in[17]; float* out; unsigned char* ws; int ph_lo, ph_hi, li, pad; };
struct Frame {
    LAS unsigned char* lds;
    int tid, lane, wave, vcu, G;
    const float* in[17]; float* out; unsigned char* ws;
};
enum { I_X = 0, I_WIN, I_BIN, I_SINK, I_WPA, I_WPB, I_WOUT, I_GMIX, I_GFFN, I_WRG, I_BRG, I_WRE, I_BRE, I_WEG, I_WEU, I_WED, I_GFIN };

struct TrDesc { const float* W; int N; bf16* WT; int ldo, rowbase, koff, k0, n0; bool perm; const float* kscale; float f8scale; };
__device__ __forceinline__ void tr_load(const TrDesc& d, int lane, f32x4 (&tv)[8], float (&ks)[8]) {
    const float* src = d.W + (size_t)(d.k0 + (lane >> 3)) * d.N + d.n0 + 4 * (lane & 7);
#pragma unroll
    for (int i = 0; i < 8; ++i) tv[i] = *(const GAS f32x4*)(src + (size_t)(8 * i) * d.N);
#pragma unroll
    for (int i = 0; i < 8; ++i) ks[i] = d.kscale ? d.kscale[d.k0 + 8 * i + (lane >> 3)] : 1.0f;
}
__device__ __forceinline__ void tr_finish(const TrDesc& d, LAS float* scr, int lane, const f32x4 (&tv)[8], const float (&ks)[8]) {
#pragma unroll
    for (int i = 0; i < 8; ++i) { const int kk = 8 * i + (lane >> 3); LAS float* w = scr + kk * 33 + 4 * (lane & 7);
        w[0] = tv[i][0] * ks[i]; w[1] = tv[i][1] * ks[i]; w[2] = tv[i][2] * ks[i]; w[3] = tv[i][3] * ks[i]; }
    LDS_WAIT(); asm volatile("" ::: "memory");
    const int c = lane & 7;
#pragma unroll
    for (int j = 0; j < 4; ++j) { const int n = (lane >> 3) + 8 * j; const LAS float* s = scr + (8 * c) * 33 + n;
        const int rr = d.perm ? 8 * (n >> 2) + (n & 3) : n;
        if (d.f8scale != 0.f) { const float f = d.f8scale; v2u o8; o8.x = pk4_fp8(s[0 * 33] * f, s[1 * 33] * f, s[2 * 33] * f, s[3 * 33] * f); o8.y = pk4_fp8(s[4 * 33] * f, s[5 * 33] * f, s[6 * 33] * f, s[7 * 33] * f);
            *(GAS v2u*)((unsigned char*)d.WT + (size_t)(d.rowbase + rr) * d.ldo + d.koff + d.k0 + 8 * c) = o8; }
        else { v4u o; o.x = pk2(s[0 * 33], s[1 * 33]); o.y = pk2(s[2 * 33], s[3 * 33]); o.z = pk2(s[4 * 33], s[5 * 33]); o.w = pk2(s[6 * 33], s[7 * 33]);
            *(GAS v4u*)(d.WT + (size_t)(d.rowbase + rr) * d.ldo + d.koff + d.k0 + 8 * c) = o; } }
    LDS_WAIT(); asm volatile("" ::: "memory");
}
__device__ __forceinline__ void rms_row_to_bf16(const float* xrow, const float* g, bf16* orow, int lane) {
    const GAS f32x4* xr = (const GAS f32x4*)xrow + lane; const GAS f32x4* gr = (const GAS f32x4*)g + lane;
    f32x4 v[4]; float s = 0.f;
#pragma unroll
    for (int j = 0; j < 4; ++j) { v[j] = xr[64 * j]; s += (v[j].x * v[j].x + v[j].y * v[j].y) + (v[j].z * v[j].z + v[j].w * v[j].w); }
    const float rstd = 1.0f / sqrtf(wave_sum(s) * (1.f / D) + RMS_EPS);
    GAS v2u* o8 = (GAS v2u*)orow + lane;
#pragma unroll
    for (int j = 0; j < 4; ++j) { const f32x4 gg = gr[64 * j]; v2u w; w.x = pk2(v[j].x * rstd * gg.x, v[j].y * rstd * gg.y); w.y = pk2(v[j].z * rstd * gg.z, v[j].w * rstd * gg.w); o8[64 * j] = w; }
}
__device__ __forceinline__ void p0_prologue(Frame& F) {
    int tid_ = threadIdx.x; asm volatile("" : "+v"(tid_)); const int lane_ = tid_ & 63;
    LAS float* scr = (LAS float*)(F.lds + F.wave * 16384);
    const int gw = F.vcu * NWAVES + F.wave, NGW = F.G * NWAVES;
    unsigned char* ws = F.ws;
    constexpr int I_IN = 16 * 248, I_PA = 8 * 32, I_PB = 16 * 32, I_WO = 16 * 32, I_EG = 32 * 16 * 8, I_ED = 32 * 4 * 32;
    constexpr int NITEMS = I_IN + I_PA + I_PB + I_WO + 2 * I_EG + I_ED;
    auto decode = [&](int it, TrDesc& d) {
        int r = it; d.perm = false; d.kscale = nullptr; d.f8scale = 0.f; d.koff = 0;
        if (r < I_IN) { const int kb = r / 248, nb = r % 248, n0 = 32 * nb; const bool qk = (n0 < 3072) || (n0 >= A_W && n0 < A_W + 1152);
            const bool gt_ = n0 >= A_W + B_W; const int gc = n0 - (A_W + B_W);
            d.W = F.in[I_WIN]; d.N = NIN; d.WT = (bf16*)(ws + WS_WIN); d.ldo = 1024; d.rowbase = qk ? (n0 & ~63) + ((n0 >> 5) & 1) * 4 : (gt_ ? A_W + B_W + 2 * (gc % 1024) + 4 * (gc / 1024) : n0); d.k0 = 64 * kb; d.n0 = n0; d.perm = qk || gt_; d.f8scale = W8_SCALE; return; } r -= I_IN;
        if (r < I_PA) { const int kb = r / 32, nb = r % 32; d.W = F.in[I_WPA]; d.N = 1024; d.WT = (bf16*)(ws + WS_WAB); d.ldo = 1536; d.rowbase = 32 * nb; d.k0 = 64 * kb; d.n0 = 32 * nb; if (P34_FP8) d.f8scale = W34_SCALE; return; } r -= I_PA;
        if (r < I_PB) { const int kb = r / 32, nb = r % 32; d.W = F.in[I_WPB]; d.N = 1024; d.WT = (bf16*)(ws + WS_WAB); d.ldo = 1536; d.rowbase = 32 * nb; d.koff = 512; d.k0 = 64 * kb; d.n0 = 32 * nb; if (P34_FP8) d.f8scale = W34_SCALE; return; } r -= I_PB;
        if (r < I_WO) { const int kb = r / 32, nb = r % 32; d.W = F.in[I_WOUT]; d.N = 1024; d.WT = (bf16*)(ws + WS_WO); d.ldo = 1024; d.rowbase = 32 * nb; d.k0 = 64 * kb; d.n0 = 32 * nb; if (P34_FP8) d.f8scale = W34_SCALE; return; } r -= I_WO;
        if (r < 2 * I_EG) { const int up = r >= I_EG; if (up) r -= I_EG; const int e = r / 128, q = r % 128, kb = q / 8, nb = q % 8;
            d.W = F.in[up ? I_WEU : I_WEG] + (size_t)e * 1024 * 256; d.N = 256; d.WT = (bf16*)(ws + WS_WGU) + (size_t)e * 512 * 1024; d.ldo = 1024; d.rowbase = 64 * nb + (up ? 4 : 0); d.k0 = 64 * kb; d.n0 = 32 * nb; d.perm = true; d.kscale = F.in[I_GFFN]; d.f8scale = WG8_SCALE; if (P6_FP8) d.WT = (bf16*)((unsigned char*)(ws + WS_WGU) + (size_t)e * 512 * 1024); return; } r -= 2 * I_EG;
        { const int e = r / 128, q = r % 128, kb = q / 32, nb = q % 32;
            d.W = F.in[I_WED] + (size_t)e * 256 * 1024; d.N = 1024; d.WT = (bf16*)(ws + WS_WD) + (size_t)e * 1024 * 256; d.ldo = 256; d.rowbase = 32 * nb; d.k0 = 64 * kb; d.n0 = 32 * nb; d.f8scale = WD8_SCALE; if (P6_FP8) d.WT = (bf16*)((unsigned char*)(ws + WS_WD) + (size_t)e * 1024 * 256); }
    };
    {
        int it = gw; TrDesc dc, dn; f32x4 tc[8], tn[8]; float kc[8], kn[8];
        bool hc = it < NITEMS; if (hc) { decode(it, dc); tr_load(dc, lane_, tc, kc); }
        while (hc) {
            it += NGW; const bool hn = it < NITEMS;
            if (hn) { decode(it, dn); tr_load(dn, lane_, tn, kn); }
            tr_finish(dc, scr, lane_, tc, kc);
            hc = hn; dc = dn;
#pragma unroll
            for (int i = 0; i < 8; ++i) { tc[i] = tn[i]; kc[i] = kn[i]; }
        }
    }
    for (int m = gw; m < T; m += 4 * NGW) {
        const GAS f32x4* gr = (const GAS f32x4*)F.in[I_GMIX] + lane_;
        f32x4 v[4][4]; float ss[4];
#pragma unroll
        for (int r = 0; r < 4; ++r) { const int mr = (m + r * NGW < T) ? m + r * NGW : m; const GAS f32x4* xr = (const GAS f32x4*)(F.in[I_X] + (size_t)mr * D) + lane_;
#pragma unroll
            for (int j = 0; j < 4; ++j) v[r][j] = xr[64 * j]; }
#pragma unroll
        for (int r = 0; r < 4; ++r) { float a = 0.f;
#pragma unroll
            for (int j = 0; j < 4; ++j) a += (v[r][j].x * v[r][j].x + v[r][j].y * v[r][j].y) + (v[r][j].z * v[r][j].z + v[r][j].w * v[r][j].w);
            ss[r] = 1.0f / sqrtf(wave_sum(a) * (1.f / D) + RMS_EPS); }
#pragma unroll
        for (int r = 0; r < 4; ++r) { if (m + r * NGW >= T) continue; GAS unsigned* o4 = (GAS unsigned*)((unsigned char*)F.out + DO_HN + (size_t)(m + r * NGW) * D) + lane_;
#pragma unroll
            for (int j = 0; j < 4; ++j) { const f32x4 gg = gr[64 * j];
                if (P1_FP8) o4[64 * j] = pk4_fp8(v[r][j].x * ss[r] * gg.x, v[r][j].y * ss[r] * gg.y, v[r][j].z * ss[r] * gg.z, v[r][j].w * ss[r] * gg.w);
                else { v2u w; w.x = cvtpk(v[r][j].x * ss[r] * gg.x, v[r][j].y * ss[r] * gg.y); w.y = cvtpk(v[r][j].z * ss[r] * gg.z, v[r][j].w * ss[r] * gg.w); ((GAS v2u*)((unsigned char*)F.out + DO_HN + (size_t)(m + r * NGW) * D * 2) + lane_)[64 * j] = w; } } }
    }
    const int gt = F.vcu * NTHR + tid_, NGT = F.G * NTHR;
    if (gt < 32) ((float*)(ws + WS_INVF))[gt] = (float)exp2(-(double)gt * (13.287712379549449 / 32.0));
    for (int i = gt; i < 32 * 3 * 64; i += NGT) {
        const int ln = i & 63, nb = (i >> 6) % 3, ks = i / 192;
        const int n = 16 * nb + (ln & 15);
        float hi[8], lo[8];
#pragma unroll
        for (int e = 0; e < 8; ++e) { const int k = 32 * ks + 8 * (ln >> 4) + e; float v = 0.f;
            if (n < 4) v = F.in[I_WRG][k * 4 + n]; else if (n < 36) v = F.in[I_WRE][k * 32 + (n - 4)];
            v *= F.in[I_GFFN][k]; hi[e] = bf2f(f2bf(v)); lo[e] = v - hi[e]; }
        v4u h, l; h.x = pk2(hi[0], hi[1]); h.y = pk2(hi[2], hi[3]); h.z = pk2(hi[4], hi[5]); h.w = pk2(hi[6], hi[7]);
        l.x = pk2(lo[0], lo[1]); l.y = pk2(lo[2], lo[3]); l.z = pk2(lo[4], lo[5]); l.w = pk2(lo[6], lo[7]);
        ((v4u*)(ws + WS_WRF))[((ks * 3 + nb) * 2 + 0) * 64 + ln] = h; ((v4u*)(ws + WS_WRF))[((ks * 3 + nb) * 2 + 1) * 64 + ln] = l;
    }
}

namespace pg8 {
#define PG8_LAS __attribute__((address_space(3)))
typedef unsigned short bf16_t;
typedef short bf16x8 __attribute__((ext_vector_type(8)));
typedef float f32x4 __attribute__((ext_vector_type(4)));
typedef unsigned u32x4 __attribute__((ext_vector_type(4)));
constexpr int BM = 256, BK = 64, HALF = 128, HTB = HALF * BK * 2  , STAGE_BYTES = 8 * HTB, NXCD = 8, WGM = 8;

__host__ __device__ __forceinline__ int lds_byte(int r, int c) { const int st = (r >> 4) * 2 + (c >> 5), rr = r & 15, cc = c & 31, ob = rr * 64 + cc * 2; return st * 1024 + (ob ^ (((ob >> 9) & 1) << 5)); }
__host__ __device__ __forceinline__ void stage_rc(int b, int& R, int& C) { const int st = b / 1024, sb = b % 1024, swz = sb ^ (((sb >> 9) & 1) << 5); R = (st >> 1) * 16 + swz / 64; C = (st & 1) * 32 + (swz % 64) / 2; }
__host__ __device__ __forceinline__ int perm32(int rho) { const int n = rho >> 4, i = rho & 15; return 8 * (i >> 2) + 4 * n + (i & 3); }

struct Unit { int pm, pn; };
struct Gemm { const bf16_t* A; const bf16_t* Bt; int M, N, K; };

struct StaticOrder {
    int nM, nN, nwg, G, c;
    __host__ __device__ void init(int M, int N, int G_, int c_) { nM = M / BM; nN = N / BM; nwg = nM * nN; G = G_; c = c_; }
    __host__ __device__ bool next(int i, Unit& u) const {
        const long L = (long)i * G + c; if (L >= nwg) return false;
        int wgid = (int)L; { const int q = nwg / NXCD, r = nwg % NXCD, xcd = wgid % NXCD, off = wgid / NXCD; wgid = (xcd < r ? xcd * (q + 1) : r * (q + 1) + (xcd - r) * q) + off; }
        const int nig = WGM * nN, gid = wgid / nig, fm = gid * WGM, gsz = (nM - fm) < WGM ? (nM - fm) : WGM;
        u.pm = fm + ((wgid % nig) % gsz); u.pn = (wgid % nig) / gsz; return true;
    }
    __device__ __forceinline__ void a_ready(const Unit&) const {}
    __device__ __forceinline__ void done(const Unit&) const {}
};
}


namespace pg9 {
using pg8::BM; using pg8::BK; using pg8::HALF; using pg8::HTB; using pg8::lds_byte; using pg8::stage_rc; using pg8::perm32;
struct Unit { int pm, pn, e; };
typedef int v8i_t __attribute__((ext_vector_type(8)));
typedef int v4i_t __attribute__((ext_vector_type(4)));
template <int ESZ, class Epi, class Sched, class AOff, class BBase>
__device__ __forceinline__ void gemm_phase(LAS unsigned char* lds, const char* Abase, int K, const Sched& S, const Epi& E, const AOff& aoffn, const BBase& bbase) {
    int tid_ = threadIdx.x; asm volatile("" : "+v"(tid_));
    const int tid = tid_, wid = __builtin_amdgcn_readfirstlane(tid >> 6), lane = tid & 63, wr = wid >> 2, wc = wid & 3, fr = lane & 15, fq = lane >> 4;
    const int nt = K * ESZ / (BK * 2);
    int Rr[2], Cc[2]; unsigned voffB[2];
#pragma unroll
    for (int i = 0; i < 2; ++i) { int R, C; stage_rc(tid * 16 + i * 8192, R, C); const int Rb = Epi::PERM ? ((R & ~31) + perm32(R & 31)) : R; Rr[i] = R; Cc[i] = C; voffB[i] = (unsigned)(Rb * K * ESZ + C * 2); }
    const size_t kstep = (size_t)(BK * 2);
    const size_t hstep = (size_t)HALF * K * ESZ;
    const unsigned ldsw = (unsigned)wid * 1024u;
    const int aoff = lds_byte(wr * 64 + fr, fq * 8), boff = lds_byte(wc * 32 + fr, fq * 8);
#define PG9_SA(b, h) (((b) * 2 + (h)) * HTB)
#define PG9_SB(b, h) ((4 + (b) * 2 + (h)) * HTB)
#define PG9_STAGE(bufoff, gbase, voff) do { _Pragma("unroll") for (int _i = 0; _i < 2; ++_i) \
        __builtin_amdgcn_global_load_lds((const unsigned*)((const char*)(gbase) + (voff)[_i]), (LAS unsigned*)(lds + (bufoff) + ldsw + _i * 8192), 16, 0, 0); } while (0)
#define PG9_LDA(dst, b, h) do { _Pragma("unroll") for (int m = 0; m < 4; ++m) { dst[m].lo = *(const LAS v4i_t*)(lds + PG9_SA(b, h) + aoff + m * 2048); dst[m].hi = *(const LAS v4i_t*)(lds + PG9_SA(b, h) + aoff + m * 2048 + 1024); } } while (0)
#define PG9_LDB(dst, b, h) do { _Pragma("unroll") for (int n = 0; n < 2; ++n) { dst[n].lo = *(const LAS v4i_t*)(lds + PG9_SB(b, h) + boff + n * 2048); dst[n].hi = *(const LAS v4i_t*)(lds + PG9_SB(b, h) + boff + n * 2048 + 1024); } } while (0)
#define PG9_HALF(v, o) __builtin_bit_cast(bf16x8, __builtin_shufflevector((v), (v), (o), (o) + 1, (o) + 2, (o) + 3))
#define PG9_MMA(ai, bj, At, Bt) do { __builtin_amdgcn_s_setprio(1); _Pragma("unroll") for (int m = 0; m < 4; ++m) _Pragma("unroll") for (int n = 0; n < 2; ++n) { \
        if (ESZ == 2) { acc[ai][bj][m][n] = __builtin_amdgcn_mfma_f32_16x16x32_bf16(PG9_HALF(Bt[n], 0), PG9_HALF(At[m], 0), acc[ai][bj][m][n], 0, 0, 0); \
                        acc[ai][bj][m][n] = __builtin_amdgcn_mfma_f32_16x16x32_bf16(PG9_HALF(Bt[n], 4), PG9_HALF(At[m], 4), acc[ai][bj][m][n], 0, 0, 0); } \
        else { asm volatile("v_mfma_scale_f32_16x16x128_f8f6f4 %0, %1, %2, %0, %3, %3 op_sel_hi:[0,0,0]" : "+v"(acc[ai][bj][m][n]) : "v"(Bt[n]), "v"(At[m]), "v"(one8)); } } \
        __builtin_amdgcn_s_setprio(0); } while (0)
#define PG9_WAIT_V(n) asm volatile("s_waitcnt vmcnt(" #n ")" ::: "memory")
#define PG9_WAIT_L(n) asm volatile("s_waitcnt lgkmcnt(" #n ")" ::: "memory")
#define PG9_BAR __builtin_amdgcn_s_barrier()
#define PG9_SCHED __builtin_amdgcn_sched_barrier(0)
#define PG9_VA(dst, u) do { _Pragma("unroll") for (int _h = 0; _h < 2; ++_h) _Pragma("unroll") for (int _i = 0; _i < 2; ++_i) dst[_h][_i] = aoffn((u), _h * HALF + Rr[_i]) + (unsigned)(Cc[_i] * 2); } while (0)
    constexpr bool GATHER = AOff::GATHER;
    const size_t hstepA = (size_t)HALF * aoffn.rowbytes;
    unsigned voffA[2];
#pragma unroll
    for (int i = 0; i < 2; ++i) voffA[i] = (unsigned)Rr[i] * aoffn.rowbytes + (unsigned)(Cc[i] * 2);
#define PG9_STAGE_A(bufoff, h, koff, nx) do { if (GATHER) { PG9_STAGE(bufoff, Abase + (koff), ((nx) ? nvA[h] : cvA[h])); } else { PG9_STAGE(bufoff, ((nx) ? nAu : cAu) + (h) * hstepA + (koff), voffA); } } while (0)
    Unit cur, nxt; int ui = 0;
    if (!S.next(0, cur)) return;
    f32x4 acc[2][2][4][2];
#pragma unroll
    for (int a = 0; a < 2; ++a)
#pragma unroll
        for (int b = 0; b < 2; ++b)
#pragma unroll
            for (int m = 0; m < 4; ++m)
#pragma unroll
                for (int n = 0; n < 2; ++n) acc[a][b][m][n] = (f32x4){0.f, 0.f, 0.f, 0.f};
    int one8 = 0x7f7f7f7f; asm volatile("" : "+v"(one8));
    v8i_t At[4], B0[2], B1[2];
    unsigned cvA[2][2], nvA[2][2];
    if (GATHER) { PG9_VA(cvA, cur); }
    const char* cAu = GATHER ? Abase : Abase + (size_t)aoffn(cur, 0); const char* nAu = cAu;
    const char* cB = bbase(cur);
    PG9_STAGE(PG9_SB(0, 0), cB, voffB); PG9_STAGE(PG9_SB(0, 1), cB + hstep, voffB); PG9_STAGE_A(PG9_SA(0, 0), 0, 0, false); PG9_STAGE_A(PG9_SA(0, 1), 1, 0, false);
    if (wr == 1) PG9_BAR;
    PG9_WAIT_V(2); PG9_BAR;
    PG9_STAGE(PG9_SB(1, 0), cB + kstep, voffB); PG9_STAGE_A(PG9_SA(1, 0), 0, kstep, false); PG9_STAGE(PG9_SB(1, 1), cB + hstep + kstep, voffB);
    PG9_WAIT_V(6); PG9_BAR;
    for (;;) {
        const bool has_next = S.next(ui + 1, nxt);
        if (GATHER) {
            if (has_next) { PG9_VA(nvA, nxt); } else {
#pragma unroll
                for (int _h = 0; _h < 2; ++_h)
#pragma unroll
                    for (int _i = 0; _i < 2; ++_i) nvA[_h][_i] = cvA[_h][_i]; }
        } else nAu = has_next ? Abase + (size_t)aoffn(nxt, 0) : cAu;
        const char* nB = has_next ? bbase(nxt) : cB;
#pragma unroll 1
        for (int t = 0; t < nt; t += 2) {
            const bool last = (t == nt - 2);
            if (Epi::HOOK_T >= 0) { if (t == Epi::HOOK_T) E.hook(acc, cur, wr, wc, fr, fq); }
            const size_t k1 = (size_t)(t + 1) * kstep, k2 = last ? 0 : (size_t)(t + 2) * kstep, k3 = k2 + kstep;
            const char* b2 = last ? nB : cB + (size_t)(t + 2) * kstep; const char* b3 = b2 + kstep;
            PG9_LDB(B0, 0, 0); PG9_LDB(B1, 0, 1); PG9_SCHED; PG9_LDA(At, 0, 0); PG9_STAGE_A(PG9_SA(1, 1), 1, k1, false);
            PG9_WAIT_V(8); PG9_WAIT_L(0); PG9_BAR; PG9_MMA(0, 0, At, B0); PG9_MMA(0, 1, At, B1); PG9_BAR; PG9_SCHED;
            PG9_LDA(At, 0, 1); PG9_STAGE(PG9_SB(0, 0), b2, voffB); PG9_STAGE(PG9_SB(0, 1), b2 + hstep, voffB); PG9_STAGE_A(PG9_SA(0, 0), 0, k2, last);
            PG9_WAIT_V(8); PG9_WAIT_L(0); PG9_BAR; PG9_MMA(1, 0, At, B0); PG9_MMA(1, 1, At, B1); PG9_BAR; PG9_SCHED;
            PG9_LDB(B0, 1, 0); PG9_LDB(B1, 1, 1); PG9_SCHED; PG9_LDA(At, 1, 0); PG9_STAGE_A(PG9_SA(0, 1), 1, k2, last);
            PG9_WAIT_V(8); PG9_WAIT_L(0); PG9_BAR; PG9_MMA(0, 0, At, B0); PG9_MMA(0, 1, At, B1); PG9_BAR; PG9_SCHED;
            PG9_LDA(At, 1, 1); PG9_STAGE(PG9_SB(1, 0), b3, voffB); PG9_STAGE(PG9_SB(1, 1), b3 + hstep, voffB); PG9_STAGE_A(PG9_SA(1, 0), 0, k3, last);
            PG9_WAIT_V(8); PG9_WAIT_L(0); PG9_BAR; PG9_MMA(1, 0, At, B0); PG9_MMA(1, 1, At, B1); PG9_BAR; PG9_SCHED;
        }
        if (wr == 0) PG9_BAR;
        if (ESZ == 1) asm volatile("s_nop 15\n\ts_nop 15" ::: "memory");
        E(acc, cur, wr, wc, fr, fq);
        if (!has_next) break;
#pragma unroll
        for (int a = 0; a < 2; ++a)
#pragma unroll
            for (int b = 0; b < 2; ++b)
#pragma unroll
                for (int m = 0; m < 4; ++m)
#pragma unroll
                    for (int n = 0; n < 2; ++n) acc[a][b][m][n] = (f32x4){0.f, 0.f, 0.f, 0.f};
        cur = nxt; cB = nB; cAu = nAu; ++ui;
        if (GATHER) {
#pragma unroll
            for (int _h = 0; _h < 2; ++_h)
#pragma unroll
                for (int _i = 0; _i < 2; ++_i) cvA[_h][_i] = nvA[_h][_i]; }
        if (wr == 1) PG9_BAR;
    }
    PG9_WAIT_V(0);
    PG9_BAR;
#undef PG9_SA
#undef PG9_SB
#undef PG9_STAGE
#undef PG9_LDA
#undef PG9_LDB
#undef PG9_MMA
#undef PG9_HALF
#undef PG9_WAIT_V
#undef PG9_WAIT_L
#undef PG9_BAR
#undef PG9_SCHED
#undef PG9_VA
#undef PG9_STAGE_A
}
struct DenseOrder { pg8::StaticOrder so;
    __device__ void init(int M, int N, int G, int c) { so.init(M, N, G, c); }
    __device__ bool next(int i, Unit& u) const { pg8::Unit v; if (!so.next(i, v)) return false; u.pm = v.pm; u.pn = v.pn; u.e = 0; return true; } };
struct DenseA { static constexpr bool GATHER = false; unsigned rowbytes; __device__ __forceinline__ unsigned operator()(const Unit& u, int row) const { return (unsigned)(u.pm * 256 + row) * rowbytes; } };
struct DenseB { const char* Bt; size_t tilebytes; __device__ __forceinline__ const char* operator()(const Unit& u) const { return Bt + (size_t)u.pn * tilebytes; } };
}

struct EpiInproj {
    static constexpr bool PERM = true; static constexpr int HOOK_T = -1;
    bf16* ZA; bf16* ZB; bf16* Gt; const float* bias; const float* invf; unsigned char* wsb;
    __device__ __forceinline__ void hook(f32x4 (&)[2][2][4][2], const pg9::Unit&, int, int, int, int) const {}
    __device__ __forceinline__ void operator()(const f32x4 (&acc)[2][2][4][2], const pg9::Unit& u, int wr, int wc, int fr, int fq) const {
        asm volatile("" : "+v"(fr), "+v"(fq));
        const int row0 = u.pm * 256 + wr * 64 + fr;
        const int q = 4 * (wc & 1) + fq;
        const int fr2 = (fr >> 2) + 4 * fq, fq2 = fr & 3, paddr = 4 * (16 * (fr & 3) + 4 * fq + (fr >> 2));
        const int row0s = u.pm * 256 + wr * 64 + fr2;
        int kind[2]; bf16* dst[2]; int ldd[2]; f32x4 b0[2], b1[2];
#pragma unroll
        for (int bj = 0; bj < 2; ++bj) {
            const int colpos = u.pn * 256 + bj * 128 + wc * 32 + 8 * fq, colposs = u.pn * 256 + bj * 128 + wc * 32 + 8 * fq2, hb = u.pn * 256 + bj * 128 + (wc >> 1) * 64;
            if (hb < A_W) { kind[bj] = hb / 1536; dst[bj] = ZA + colposs; ldd[bj] = A_W; }
            else if (hb < A_W + B_W) { const int cb = hb - A_W; kind[bj] = cb < 1024 ? 0 : (cb < 1152 ? 1 : 2); dst[bj] = ZB + (colposs - A_W); ldd[bj] = B_W; }
            else { kind[bj] = 3; dst[bj] = Gt + ((colposs - A_W - B_W) >> 1); ldd[bj] = G_W; }
            b0[bj] = *(const f32x4*)(bias + (kind[bj] < 2 ? hb + 4 * q : (kind[bj] == 3 ? A_W + B_W + ((colpos - A_W - B_W) >> 1) : colpos)));
            b1[bj] = *(const f32x4*)(bias + (kind[bj] < 2 ? hb + 32 + 4 * q : (kind[bj] == 3 ? A_W + B_W + 1024 + ((colpos - A_W - B_W) >> 1) : colpos + 4)));
        }
        const bool need_rope = kind[0] < 2 || kind[1] < 2;
        const f32x4 fv = *(const f32x4*)(invf + 4 * q);
#pragma unroll
        for (int ai = 0; ai < 2; ++ai) {
            f32x4 rc[4], rs[4];
#pragma unroll
            for (int m = 0; m < 4; ++m) { rc[m] = (f32x4){1.f, 1.f, 1.f, 1.f}; rs[m] = (f32x4){0.f, 0.f, 0.f, 0.f}; }
            if (need_rope) {
#pragma unroll
                for (int m = 0; m < 4; ++m) { const float posf = (float)((row0 + ai * 128 + m * 16) & (SEQ - 1));
#pragma unroll
                    for (int e = 0; e < 4; ++e) { const float ang = posf * fv[e]; const float pr = ang * 0.15915494f; const float er = __builtin_fmaf(ang, 0.15915494f, -pr) + ang * 6.4206382e-9f;
                        const float fr = __builtin_amdgcn_fractf(pr) + er; rc[m][e] = __builtin_amdgcn_cosf(fr); rs[m][e] = __builtin_amdgcn_sinf(fr); } }
            }
#pragma unroll
            for (int bj = 0; bj < 2; ++bj) {
                bf16* p = dst[bj] + (unsigned)(row0s + ai * 128) * (unsigned)ldd[bj]; const unsigned step = 16u * (unsigned)ldd[bj];
                switch (kind[bj]) {
                    case 0: store4<0>(acc[ai][bj], b0[bj], b1[bj], rc, rs, p, step, paddr); break;
                    case 1: store4<1>(acc[ai][bj], b0[bj], b1[bj], rc, rs, p, step, paddr); break;
                    case 2: store4<2>(acc[ai][bj], b0[bj], b1[bj], rc, rs, p, step, paddr); break;
                    default: store4<3>(acc[ai][bj], b0[bj], b1[bj], rc, rs, p, step, paddr); break;
                }
            }
        }
    }
    template <int KIND> static __device__ __forceinline__ void store4(const f32x4 (&a)[4][2], const f32x4 b0, const f32x4 b1, const f32x4 (&rc)[4], const f32x4 (&rs)[4], bf16* p, const unsigned step, const int paddr) {
#pragma unroll
        for (int m = 0; m < 4; ++m) {
            f32x4 v0 = a[m][0] * W8_INV + b0, v1 = a[m][1] * W8_INV + b1;
            if (KIND < 2) {
                const f32x4 cc = rc[m], ss = rs[m];
                const f32x4 t0 = v0 * cc - v1 * ss, t1 = v1 * cc + v0 * ss;
                v0 = t0; v1 = t1;
                if (KIND == 0) { v0 = v0 * QSCALE; v1 = v1 * QSCALE; }
            }
            if (KIND == 3) {
#pragma unroll
                for (int e = 0; e < 4; ++e) { const float d0 = 1.0f + __expf(-v0[e]), d1 = 1.0f + __expf(-v1[e]); v0[e] = d1 * __builtin_amdgcn_rcpf(d0); v1[e] = __builtin_amdgcn_rcpf(d1); }
                v2u w0, w1; w0.x = cvtpk(v0[0], v0[1]); w0.y = cvtpk(v0[2], v0[3]); w1.x = cvtpk(v1[0], v1[1]); w1.y = cvtpk(v1[2], v1[3]);
                w0.x = (unsigned)__builtin_amdgcn_ds_bpermute(paddr, (int)w0.x); w0.y = (unsigned)__builtin_amdgcn_ds_bpermute(paddr, (int)w0.y); w1.x = (unsigned)__builtin_amdgcn_ds_bpermute(paddr, (int)w1.x); w1.y = (unsigned)__builtin_amdgcn_ds_bpermute(paddr, (int)w1.y);
                *(GAS v2u*)p = w0; *(GAS v2u*)(p + 1024) = w1;
            } else {
                v4u w; w.x = cvtpk(v0[0], v0[1]); w.y = cvtpk(v0[2], v0[3]); w.z = cvtpk(v1[0], v1[1]); w.w = cvtpk(v1[2], v1[3]);
                w.x = (unsigned)__builtin_amdgcn_ds_bpermute(paddr, (int)w.x); w.y = (unsigned)__builtin_amdgcn_ds_bpermute(paddr, (int)w.y); w.z = (unsigned)__builtin_amdgcn_ds_bpermute(paddr, (int)w.z); w.w = (unsigned)__builtin_amdgcn_ds_bpermute(paddr, (int)w.w);
                *(GAS v4u*)p = w;
            }
            p += step;
        }
    }
};
__device__ __forceinline__ void p1_inproj(Frame& F, int ch) {
    unsigned char* ws = F.ws;
    pg9::DenseOrder S; S.init(TC, NIN, F.G, (int)blockIdx.x);
    EpiInproj E{(bf16*)(ws + WS_ZA), (bf16*)(ws + WS_ZB), (bf16*)(ws + WS_G) + (size_t)ch * TC * G_W, F.in[I_BIN], (const float*)(ws + WS_INVF), ws};
    constexpr int ES = P1_FP8 ? 1 : 2;
    pg9::DenseA ao{(unsigned)(D * ES)}; pg9::DenseB bb{(const char*)(ws + WS_WIN), (size_t)256 * D * ES};
    pg9::gemm_phase<ES>(F.lds, (const char*)F.out + DO_HN + (size_t)ch * TC * D * ES, D, S, E, ao, bb);
}

typedef float f32x16 __attribute__((ext_vector_type(16)));
typedef short v4i16_t __attribute__((ext_vector_type(4)));
__device__ __forceinline__ float half_max(float v) { auto rr = __builtin_amdgcn_permlane32_swap(__float_as_uint(v), __float_as_uint(v), false, false); return fmaxf(__uint_as_float(rr[0]), __uint_as_float(rr[1])); }
__device__ __forceinline__ float half_sum(float v) { auto rr = __builtin_amdgcn_permlane32_swap(__float_as_uint(v), __float_as_uint(v), false, false); return __uint_as_float(rr[0]) + __uint_as_float(rr[1]); }
__device__ __forceinline__ float max3f(float a, float b, float c) { float r; asm("v_max3_f32 %0, %1, %2, %3" : "=v"(r) : "v"(a), "v"(b), "v"(c)); return r; }
constexpr int ATT_VOFF = 49152;

struct AUnit { const bf16 *Kw, *Vw, *Qp; size_t pitch; int kk_lo, nkeys, kb0, kstart, lo; float m0, l0; bf16* Op; float* Lp; int o8; };
__device__ __forceinline__ void attn_decode(Frame& F, int ch, int u, int NUA, int lane, AUnit& d) {
    unsigned char* ws = F.ws;
    const int w = F.wave, c = lane & 31, h = (lane >> 5) & 1;
    if (u < NUA) {
        const bf16* ZA = (const bf16*)(ws + WS_ZA);
        const int rt = u & 15, hh = (u >> 4) & 7, gb = u >> 7, g = gb % 3, bl = gb / 3;
        const int dsh = 2 * g, dd = 1 << dsh, tsh = 4 - dsh;
        const int r = rt >> tsh, tile = rt & ((1 << tsh) - 1), i0 = tile * 256;
        const int rowb = bl * SEQ + r, col = g * 512 + hh * 64;
        d.pitch = (size_t)dd * A_W;
        d.Kw = ZA + ((long)rowb + (long)dd * (i0 - 128)) * A_W + 1536 + col; d.Vw = d.Kw + 1536;
        const long qrow = (long)rowb + (long)dd * (i0 + 32 * w + c);
        d.Qp = ZA + qrow * A_W + col;
        d.kk_lo = (i0 == 0) ? 128 : 0; d.nkeys = 384; d.kb0 = w; d.kstart = (i0 == 0) ? (w < 4 ? 4 - w : 0) : 0; d.lo = 0;
        d.m0 = -1e30f; d.l0 = 0.f;
        d.Op = (bf16*)((unsigned char*)F.out + DO_OG) + ((size_t)g * TC + qrow) * 512 + hh * 64;
        d.Lp = (float*)((unsigned char*)F.out + DO_LSE) + ((size_t)g * TC + qrow) * 8 + hh;
        d.o8 = 0;
    } else {
        const int u2 = u - NUA;
        const bf16* ZB = (const bf16*)(ws + WS_ZB);
        const int blk = u2 & 127, kvh = (u2 >> 7) & 1, bl = u2 >> 8;
        const int t0 = blk * 32, rowb = bl * SEQ;
        d.pitch = B_W;
        d.Kw = ZB + ((long)rowb + t0 - 128) * B_W + 1024 + kvh * 64; d.Vw = d.Kw + 128;
        const int qh = kvh * 8 + w;
        const long qrow = (long)rowb + t0 + c;
        d.Qp = ZB + qrow * B_W + qh * 64;
        d.kk_lo = t0 < 128 ? 128 - t0 : 0; d.nkeys = 160; d.kb0 = 0; d.kstart = d.kk_lo >> 5; d.lo = 1;
        d.m0 = F.in[I_SINK][qh] * LOG2E; d.l0 = h == 0 ? 1.f : 0.f;
        d.o8 = P34_FP8;
        d.Op = P34_FP8 ? (bf16*)(ws + WS_Y + ((size_t)ch * TC + qrow) * Y_W + 512 + qh * 64) : (bf16*)(ws + WS_Y) + ((size_t)ch * TC + qrow) * Y_W + 512 + qh * 64;
        d.Lp = nullptr;
    }
}
__device__ __forceinline__ void attn_load(const AUnit& d, int tid, int lane, v4u (&kreg)[6], v4u (&vreg)[6], bf16x8 (&qf)[4]) {
    const int skey = tid >> 3, sch = tid & 7, h = (lane >> 5) & 1;
#pragma unroll
    for (int s4 = 0; s4 < 4; ++s4) qf[s4] = *(const GAS bf16x8*)(d.Qp + 16 * s4 + 8 * h);
#pragma unroll
    for (int p = 0; p < 6; ++p) { const int kk = 64 * p + skey;
        if (kk >= d.kk_lo && kk < d.nkeys) { kreg[p] = *(const GAS v4u*)(d.Kw + (size_t)kk * d.pitch + 8 * sch); vreg[p] = *(const GAS v4u*)(d.Vw + (size_t)kk * d.pitch + 8 * sch); } }
}
__device__ __forceinline__ void attn_write(const AUnit& d, LAS unsigned char* KL, LAS unsigned char* VL, int tid, const v4u (&kreg)[6], const v4u (&vreg)[6]) {
    const int skey = tid >> 3, sch = tid & 7;
#pragma unroll
    for (int p = 0; p < 6; ++p) { const int kk = 64 * p + skey;
        if (kk >= d.kk_lo && kk < d.nkeys) {
            *(LAS v4u*)(KL + kk * 128 + ((sch ^ ((kk >> 1) & 7)) << 4)) = kreg[p];
            *(LAS v4u*)(VL + kk * 128 + ((sch * 16) ^ (((kk >> 1) & 1) << 6))) = vreg[p]; } }
}
__device__ __forceinline__ void attn_compute_edge(const AUnit& d, const LAS unsigned char* KL, const LAS unsigned char* VL, int lane, const bf16x8 (&qf)[4]) {
    const int c = lane & 31, h = (lane >> 5) & 1;
    int koff[4];
    { const int kswz = (c >> 1) & 7;
#pragma unroll
      for (int s4 = 0; s4 < 4; ++s4) koff[s4] = c * 128 + (((2 * s4 + h) ^ kswz) << 4); }
    const int vrow = 4 * h + ((lane & 15) >> 2), vsw = (lane >> 3) & 1;
    const int voff0 = vrow * 128 + ((32 * ((lane >> 4) & 1) + 8 * (lane & 3)) ^ (vsw << 6)), voff1 = voff0 ^ 64;
    const float NEG = -INFINITY;
    float m = d.m0, l = d.l0;
    f32x16 o0, o1;
#pragma unroll
    for (int i = 0; i < 16; ++i) { o0[i] = 0.f; o1[i] = 0.f; }
    const LAS unsigned char* kbp = KL + d.kb0 * 4096; const LAS unsigned char* vbp = VL + d.kb0 * 4096;
    const int clo = c + d.lo;
#pragma unroll
    for (int kbi = 0; kbi < 5; ++kbi) {
        if (kbi >= d.kstart) {
            f32x16 p;
#pragma unroll
            for (int i = 0; i < 16; ++i) p[i] = 0.f;
#pragma unroll
            for (int s4 = 0; s4 < 4; ++s4) { const bf16x8 kf = *(const LAS bf16x8*)(kbp + kbi * 4096 + koff[s4]); p = __builtin_amdgcn_mfma_f32_32x32x16_bf16(kf, qf[s4], p, 0, 0, 0); }
            if (kbi == 0) {
#pragma unroll
                for (int i = 0; i < 16; ++i) { const int x = (i & 3) + 8 * (i >> 2) + 4 * h; if (x < clo) p[i] = NEG; }
            }
            if (kbi == 4) {
#pragma unroll
                for (int i = 0; i < 16; ++i) { const int x = (i & 3) + 8 * (i >> 2) + 4 * h; if (x > c) p[i] = NEG; }
            }
            float mt = p[0];
#pragma unroll
            for (int i = 1; i < 16; ++i) mt = fmaxf(mt, p[i]);
            mt = half_max(mt);
            const float mn = fmaxf(m, mt), alpha = __builtin_amdgcn_exp2f(m - mn);
            m = mn;
            float ps = 0.f;
#pragma unroll
            for (int i = 0; i < 16; ++i) { p[i] = __builtin_amdgcn_exp2f(p[i] - mn); ps += p[i]; }
            l = l * alpha + ps;
#pragma unroll
            for (int i = 0; i < 16; ++i) { o0[i] *= alpha; o1[i] *= alpha; }
            bf16x8 pb[2];
#pragma unroll
            for (int s2 = 0; s2 < 2; ++s2) { v4u t; t.x = cvtpk(p[8 * s2 + 0], p[8 * s2 + 1]); t.y = cvtpk(p[8 * s2 + 2], p[8 * s2 + 3]); t.z = cvtpk(p[8 * s2 + 4], p[8 * s2 + 5]); t.w = cvtpk(p[8 * s2 + 6], p[8 * s2 + 7]); pb[s2] = __builtin_bit_cast(bf16x8, t); }
#pragma unroll
            for (int s2 = 0; s2 < 2; ++s2) {
#pragma unroll
                for (int db = 0; db < 2; ++db) {
                    const LAS unsigned char* vp = vbp + kbi * 4096 + s2 * 2048 + (db ? voff1 : voff0);
                    const v4i16_t lo = __builtin_amdgcn_ds_read_tr16_b64_v4i16((LAS v4i16_t*)vp);
                    const v4i16_t hi = __builtin_amdgcn_ds_read_tr16_b64_v4i16((LAS v4i16_t*)(vp + 1024));
                    const bf16x8 vf = {lo[0], lo[1], lo[2], lo[3], hi[0], hi[1], hi[2], hi[3]};
                    if (db == 0) o0 = __builtin_amdgcn_mfma_f32_32x32x16_bf16(vf, pb[s2], o0, 0, 0, 0);
                    else o1 = __builtin_amdgcn_mfma_f32_32x32x16_bf16(vf, pb[s2], o1, 0, 0, 0);
                }
            }
        }
    }
    const float lt = half_sum(l), inv = 1.0f / lt;
#pragma unroll
    for (int g4 = 0; g4 < 4; ++g4) {
        v2u a, b;
        a.x = cvtpk(o0[4 * g4 + 0] * inv, o0[4 * g4 + 1] * inv); a.y = cvtpk(o0[4 * g4 + 2] * inv, o0[4 * g4 + 3] * inv);
        b.x = cvtpk(o1[4 * g4 + 0] * inv, o1[4 * g4 + 1] * inv); b.y = cvtpk(o1[4 * g4 + 2] * inv, o1[4 * g4 + 3] * inv);
        if (d.o8) { unsigned char* o8p = (unsigned char*)d.Op; const float sc = inv * Y8_SCALE;
            *(GAS unsigned*)(o8p + 8 * g4 + 4 * h) = pk4_fp8(o0[4 * g4 + 0] * sc, o0[4 * g4 + 1] * sc, o0[4 * g4 + 2] * sc, o0[4 * g4 + 3] * sc);
            *(GAS unsigned*)(o8p + 32 + 8 * g4 + 4 * h) = pk4_fp8(o1[4 * g4 + 0] * sc, o1[4 * g4 + 1] * sc, o1[4 * g4 + 2] * sc, o1[4 * g4 + 3] * sc); }
        else {
        *(GAS v2u*)(d.Op + 8 * g4 + 4 * h) = a;
        *(GAS v2u*)(d.Op + 32 + 8 * g4 + 4 * h) = b; }
    }
    if (d.Lp) { if (h == 0) *d.Lp = m + __builtin_amdgcn_logf(lt); }
}
__device__ __forceinline__ void attn_compute(const AUnit& d, const LAS unsigned char* KL, const LAS unsigned char* VL, int lane, const bf16x8 (&qf)[4]) {
    const int c = lane & 31, h = (lane >> 5) & 1;
    int koff[4];
    { const int kswz = (c >> 1) & 7;
#pragma unroll
      for (int s4 = 0; s4 < 4; ++s4) koff[s4] = c * 128 + (((2 * s4 + h) ^ kswz) << 4); }
    const int vrow = 4 * h + ((lane & 15) >> 2), vsw = (lane >> 3) & 1;
    const int voff0 = vrow * 128 + ((32 * ((lane >> 4) & 1) + 8 * (lane & 3)) ^ (vsw << 6)), voff1 = voff0 ^ 64;
    const float NEG = -INFINITY;
    float m = d.m0;
    f32x16 o0, o1, L;
#pragma unroll
    for (int i = 0; i < 16; ++i) { o0[i] = 0.f; o1[i] = 0.f; L[i] = 0.f; }
    v4u onesu = {0x3F803F80u, 0x3F803F80u, 0x3F803F80u, 0x3F803F80u}; asm volatile("" : "+v"(onesu));
    const bf16x8 ones = __builtin_bit_cast(bf16x8, onesu);
    const LAS unsigned char* kbp = KL + d.kb0 * 4096; const LAS unsigned char* vbp = VL + d.kb0 * 4096;
    const int clo = c + d.lo;
#pragma unroll
    for (int kbi = 0; kbi < 5; ++kbi) {
        {
            constexpr bool first_dummy = false; (void)first_dummy;
            const bool first = (kbi == 0);
            const float cinit = first ? 0.f : -m;
            f32x16 p;
#pragma unroll
            for (int i = 0; i < 16; ++i) p[i] = cinit;
#pragma unroll
            for (int s4 = 0; s4 < 4; ++s4) { const bf16x8 kf = *(const LAS bf16x8*)(kbp + kbi * 4096 + koff[s4]); p = __builtin_amdgcn_mfma_f32_32x32x16_bf16(kf, qf[s4], p, 0, 0, 0); }
            if (kbi == 0) {
#pragma unroll
                for (int i = 0; i < 16; ++i) { const int x = (i & 3) + 8 * (i >> 2) + 4 * h; p[i] = x < clo ? NEG : p[i]; }
            }
            if (kbi == 4) {
#pragma unroll
                for (int i = 0; i < 16; ++i) { const int x = (i & 3) + 8 * (i >> 2) + 4 * h; p[i] = x > c ? NEG : p[i]; }
            }
            float t0 = max3f(p[0], p[4], p[8]), t1 = max3f(p[1], p[5], p[9]), t2 = max3f(p[2], p[6], p[10]), t3 = max3f(p[3], p[7], p[11]);
            t0 = max3f(t0, p[12], p[13]); t1 = max3f(t1, p[14], p[15]);
            const float mt = half_max(max3f(max3f(t0, t1, t2), t3, t3));
            if (first) {
                const float mn = fmaxf(m, mt), l0 = d.m0 > -1e29f ? __builtin_amdgcn_exp2f(m - mn) : 0.f;
                m = mn;
#pragma unroll
                for (int i = 0; i < 16; ++i) { p[i] -= mn; L[i] = l0; }
            } else if (__any(mt > 8.0f)) {
                const float dl = fmaxf(mt, 0.f), al = __builtin_amdgcn_exp2f(-dl);
                m += dl;
#pragma unroll
                for (int i = 0; i < 16; ++i) { o0[i] *= al; o1[i] *= al; L[i] *= al; p[i] -= dl; }
            }
#pragma unroll
            for (int i = 0; i < 16; ++i) p[i] = __builtin_amdgcn_exp2f(p[i]);
            bf16x8 pb[2];
#pragma unroll
            for (int s2 = 0; s2 < 2; ++s2) { v4u t; t.x = cvtpk(p[8 * s2 + 0], p[8 * s2 + 1]); t.y = cvtpk(p[8 * s2 + 2], p[8 * s2 + 3]); t.z = cvtpk(p[8 * s2 + 4], p[8 * s2 + 5]); t.w = cvtpk(p[8 * s2 + 6], p[8 * s2 + 7]); pb[s2] = __builtin_bit_cast(bf16x8, t); }
#pragma unroll
            for (int s2 = 0; s2 < 2; ++s2) {
                L = __builtin_amdgcn_mfma_f32_32x32x16_bf16(ones, pb[s2], L, 0, 0, 0);
#pragma unroll
                for (int db = 0; db < 2; ++db) {
                    const LAS unsigned char* vp = vbp + kbi * 4096 + s2 * 2048 + (db ? voff1 : voff0);
                    const v4i16_t lo = __builtin_amdgcn_ds_read_tr16_b64_v4i16((LAS v4i16_t*)vp);
                    const v4i16_t hi = __builtin_amdgcn_ds_read_tr16_b64_v4i16((LAS v4i16_t*)(vp + 1024));
                    const bf16x8 vf = {lo[0], lo[1], lo[2], lo[3], hi[0], hi[1], hi[2], hi[3]};
                    if (db == 0) o0 = __builtin_amdgcn_mfma_f32_32x32x16_bf16(vf, pb[s2], o0, 0, 0, 0);
                    else o1 = __builtin_amdgcn_mfma_f32_32x32x16_bf16(vf, pb[s2], o1, 0, 0, 0);
                }
            }
        }
    }
    const float lt = L[0], inv = 1.0f / lt;
#pragma unroll
    for (int g4 = 0; g4 < 4; ++g4) {
        v2u a, b;
        a.x = cvtpk(o0[4 * g4 + 0] * inv, o0[4 * g4 + 1] * inv); a.y = cvtpk(o0[4 * g4 + 2] * inv, o0[4 * g4 + 3] * inv);
        b.x = cvtpk(o1[4 * g4 + 0] * inv, o1[4 * g4 + 1] * inv); b.y = cvtpk(o1[4 * g4 + 2] * inv, o1[4 * g4 + 3] * inv);
        if (d.o8) { unsigned char* o8p = (unsigned char*)d.Op; const float sc = inv * Y8_SCALE;
            *(GAS unsigned*)(o8p + 8 * g4 + 4 * h) = pk4_fp8(o0[4 * g4 + 0] * sc, o0[4 * g4 + 1] * sc, o0[4 * g4 + 2] * sc, o0[4 * g4 + 3] * sc);
            *(GAS unsigned*)(o8p + 32 + 8 * g4 + 4 * h) = pk4_fp8(o1[4 * g4 + 0] * sc, o1[4 * g4 + 1] * sc, o1[4 * g4 + 2] * sc, o1[4 * g4 + 3] * sc); }
        else {
        *(GAS v2u*)(d.Op + 8 * g4 + 4 * h) = a;
        *(GAS v2u*)(d.Op + 32 + 8 * g4 + 4 * h) = b; }
    }
    if (d.Lp) { if (h == 0) *d.Lp = m + __builtin_amdgcn_logf(lt); }
}
__device__ __forceinline__ void p2_attn(Frame& F, int ch) {
    int tid_ = threadIdx.x; asm volatile("" : "+v"(tid_));
    const int tid = tid_, lane = tid & 63;
    LAS unsigned char* KL = F.lds; LAS unsigned char* VL = F.lds + ATT_VOFF;
    constexpr int NUA = (TC / SEQ) * 3 * 8 * 16, NUB = (TC / SEQ) * 2 * 128, NU = NUA + NUB;
    int u = F.vcu;
    if (u >= NU) return;
    AUnit cur, nxt;
    v4u kreg[6], vreg[6]; bf16x8 qn[4];
    attn_decode(F, ch, u, NUA, lane, cur);
    attn_load(cur, tid, lane, kreg, vreg, qn);
    for (;;) {
        attn_write(cur, KL, VL, tid, kreg, vreg);
        bf16x8 qf[4];
#pragma unroll
        for (int s4 = 0; s4 < 4; ++s4) qf[s4] = qn[s4];
        __syncthreads();
        const int un = u + F.G; const bool has_next = un < NU;
        if (has_next) { attn_decode(F, ch, un, NUA, lane, nxt); attn_load(nxt, tid, lane, kreg, vreg, qn); }
        if (cur.kk_lo == 0) attn_compute(cur, KL, VL, lane, qf); else attn_compute_edge(cur, KL, VL, lane, qf);
        __syncthreads();
        if (!has_next) break;
        cur = nxt; u = un;
    }
}
__device__ __forceinline__ void p2_combine(Frame& F, int ch, int cu, int ncu) {
    int tid_ = threadIdx.x; asm volatile("" : "+v"(tid_)); const int lane_ = tid_ & 63;
    unsigned char* ws = F.ws;
    const bf16* OG = (const bf16*)((const unsigned char*)F.out + DO_OG); const float* LSE = (const float*)((const unsigned char*)F.out + DO_LSE);
    bf16* Y = (bf16*)(ws + WS_Y) + (size_t)ch * TC * Y_W; unsigned char* Y8 = ws + WS_Y + (size_t)ch * TC * Y_W;
    const int lane = lane_, hd = lane >> 3;
    const int gw = cu * NWAVES + F.wave, NGW = ncu * NWAVES;
    for (int row0 = gw; row0 < TC; row0 += 4 * NGW) {
        float lg[4][3]; v4u og[4][3];
#pragma unroll
        for (int r = 0; r < 4; ++r) { const int row = row0 + r * NGW < TC ? row0 + r * NGW : row0;
#pragma unroll
            for (int g = 0; g < 3; ++g) { lg[r][g] = LSE[((size_t)g * TC + row) * 8 + hd]; og[r][g] = *(const GAS v4u*)(OG + ((size_t)g * TC + row) * 512 + lane * 8); } }
#pragma unroll
        for (int r = 0; r < 4; ++r) { const int row = row0 + r * NGW; if (row >= TC) continue;
            const float mx = fmaxf(fmaxf(lg[r][0], lg[r][1]), lg[r][2]);
            float e[3]; e[0] = __builtin_amdgcn_exp2f(lg[r][0] - mx); e[1] = __builtin_amdgcn_exp2f(lg[r][1] - mx); e[2] = __builtin_amdgcn_exp2f(lg[r][2] - mx);
            const float inv = 1.0f / (e[0] + e[1] + e[2]);
            float acc[8];
#pragma unroll
            for (int i = 0; i < 8; ++i) acc[i] = 0.f;
#pragma unroll
            for (int g = 0; g < 3; ++g) { const float wg = e[g] * inv; const v4u o_ = og[r][g];
                acc[0] += wg * bflo(o_.x); acc[1] += wg * bfhi(o_.x); acc[2] += wg * bflo(o_.y); acc[3] += wg * bfhi(o_.y);
                acc[4] += wg * bflo(o_.z); acc[5] += wg * bfhi(o_.z); acc[6] += wg * bflo(o_.w); acc[7] += wg * bfhi(o_.w); }
            v4u o; o.x = cvtpk(acc[0], acc[1]); o.y = cvtpk(acc[2], acc[3]); o.z = cvtpk(acc[4], acc[5]); o.w = cvtpk(acc[6], acc[7]);
            if (P34_FP8) { v2u o8; o8.x = pk4_fp8(acc[0] * Y8_SCALE, acc[1] * Y8_SCALE, acc[2] * Y8_SCALE, acc[3] * Y8_SCALE); o8.y = pk4_fp8(acc[4] * Y8_SCALE, acc[5] * Y8_SCALE, acc[6] * Y8_SCALE, acc[7] * Y8_SCALE); *(GAS v2u*)(Y8 + (size_t)row * Y_W + lane * 8) = o8; }
            else *(GAS v4u*)(Y + (size_t)row * Y_W + lane * 8) = o; }
    }
}


struct EpiMerge {
    static constexpr bool PERM = true; static constexpr int HOOK_T = P34_FP8 ? 4 : 8;
    const bf16* Gt; bf16* MG;
    __device__ __forceinline__ void hook(f32x4 (&acc)[2][2][4][2], const pg9::Unit& u, int wr, int wc, int fr, int fq) const {
        asm volatile("" : "+v"(fr), "+v"(fq));
        const bf16* gr = Gt + (size_t)(u.pm * 256 + wr * 64 + fr) * G_W + u.pn * 256 + wc * 32 + 8 * fq;
        v4u rv[8][2];
#pragma unroll
        for (int rg = 0; rg < 8; ++rg)
#pragma unroll
            for (int bj = 0; bj < 2; ++bj) rv[rg][bj] = *(const GAS v4u*)(gr + (size_t)((rg >> 2) * 128 + (rg & 3) * 16) * G_W + bj * 128);
#pragma unroll
        for (int rg = 0; rg < 8; ++rg)
#pragma unroll
            for (int bj = 0; bj < 2; ++bj) { const v4u a = rv[rg][bj];
                const f32x4 r0 = {bflo(a.x), bfhi(a.x), bflo(a.y), bfhi(a.y)}, r1 = {bflo(a.z), bfhi(a.z), bflo(a.w), bfhi(a.w)};
                acc[rg >> 2][bj][rg & 3][0] = acc[rg >> 2][bj][rg & 3][0] * r0; acc[rg >> 2][bj][rg & 3][1] = acc[rg >> 2][bj][rg & 3][1] * r1; }
    }
    __device__ __forceinline__ void operator()(const f32x4 (&acc)[2][2][4][2], const pg9::Unit& u, int wr, int wc, int fr, int fq) const {
        asm volatile("" : "+v"(fr), "+v"(fq));
        const bf16* gr = Gt + (size_t)(u.pm * 256 + wr * 64 + fr) * G_W + 1024 + u.pn * 256 + wc * 32 + 8 * fq;
        bf16* mr = MG + (size_t)(u.pm * 256 + wr * 64 + fr) * D + u.pn * 256 + wc * 32 + 8 * fq;
        v4u gb[8][2];
#pragma unroll
        for (int rg = 0; rg < 8; ++rg)
#pragma unroll
            for (int bj = 0; bj < 2; ++bj) gb[rg][bj] = *(const GAS v4u*)(gr + (size_t)((rg >> 2) * 128 + (rg & 3) * 16) * G_W + bj * 128);
#pragma unroll
        for (int rg = 0; rg < 8; ++rg)
#pragma unroll
            for (int bj = 0; bj < 2; ++bj) { const v4u b = gb[rg][bj];
                const f32x4 v0 = acc[rg >> 2][bj][rg & 3][0], v1 = acc[rg >> 2][bj][rg & 3][1];
                if (P34_FP8) { constexpr float f = MG8_SCALE / (W34_SCALE * Y8_SCALE); unsigned char* m8 = (unsigned char*)MG + (size_t)(u.pm * 256 + wr * 64 + fr) * D + u.pn * 256 + wc * 32 + 8 * fq;
                    v2u w8; w8.x = pk4_fp8(v0[0] * bflo(b.x) * f, v0[1] * bfhi(b.x) * f, v0[2] * bflo(b.y) * f, v0[3] * bfhi(b.y) * f); w8.y = pk4_fp8(v1[0] * bflo(b.z) * f, v1[1] * bfhi(b.z) * f, v1[2] * bflo(b.w) * f, v1[3] * bfhi(b.w) * f);
                    *(GAS v2u*)(m8 + (size_t)((rg >> 2) * 128 + (rg & 3) * 16) * D + bj * 128) = w8; }
                else {
                v4u w; w.x = cvtpk(v0[0] * bflo(b.x), v0[1] * bfhi(b.x)); w.y = cvtpk(v0[2] * bflo(b.y), v0[3] * bfhi(b.y));
                w.z = cvtpk(v1[0] * bflo(b.z), v1[1] * bfhi(b.z)); w.w = cvtpk(v1[2] * bflo(b.w), v1[3] * bfhi(b.w));
                *(GAS v4u*)(mr + (size_t)((rg >> 2) * 128 + (rg & 3) * 16) * D + bj * 128) = w; } }
    }
};
__device__ __forceinline__ void p3_merge(Frame& F) {
    unsigned char* ws = F.ws;
    pg9::DenseOrder S; S.init(T, D, F.G, (int)blockIdx.x);
    EpiMerge E{(const bf16*)(ws + WS_G), (bf16*)(ws + WS_MG)};
    constexpr int ES = P34_FP8 ? 1 : 2;
    pg9::DenseA ao{(unsigned)(Y_W * ES)}; pg9::DenseB bb{(const char*)(ws + WS_WAB), (size_t)256 * Y_W * ES};
    pg9::gemm_phase<ES>(F.lds, (const char*)(ws + WS_Y), Y_W, S, E, ao, bb);
}
struct EpiOut {
    static constexpr bool PERM = true; static constexpr int HOOK_T = -1;
    bf16* DELTA;
    __device__ __forceinline__ void hook(f32x4 (&)[2][2][4][2], const pg9::Unit&, int, int, int, int) const {}
    __device__ __forceinline__ void operator()(const f32x4 (&acc)[2][2][4][2], const pg9::Unit& u, int wr, int wc, int fr, int fq) const {
        asm volatile("" : "+v"(fr), "+v"(fq));
        bf16* orow = DELTA + (size_t)(u.pm * 256 + wr * 64 + fr) * D + u.pn * 256 + wc * 32 + 8 * fq;
#pragma unroll
        for (int ai = 0; ai < 2; ++ai)
#pragma unroll
            for (int m = 0; m < 4; ++m)
#pragma unroll
                for (int bj = 0; bj < 2; ++bj) { constexpr float f = P34_FP8 ? 1.0f / (W34_SCALE * MG8_SCALE) : 1.0f; const f32x4 o0 = acc[ai][bj][m][0] * f, o1 = acc[ai][bj][m][1] * f;
                    v4u w; w.x = cvtpk(o0[0], o0[1]); w.y = cvtpk(o0[2], o0[3]); w.z = cvtpk(o1[0], o1[1]); w.w = cvtpk(o1[2], o1[3]); *(GAS v4u*)(orow + (size_t)(ai * 128 + m * 16) * D + bj * 128) = w; }
    }
};
__device__ __forceinline__ void p4_outproj(Frame& F) {
    unsigned char* ws = F.ws;
    pg9::DenseOrder S; S.init(T, D, F.G, (int)blockIdx.x);
    EpiOut E{(bf16*)((unsigned char*)F.out + DO_DELTA)};
    constexpr int ES = P34_FP8 ? 1 : 2;
    pg9::DenseA ao{(unsigned)(D * ES)}; pg9::DenseB bb{(const char*)(ws + WS_WO), (size_t)256 * D * ES};
    pg9::gemm_phase<ES>(F.lds, (const char*)(ws + WS_MG), D, S, E, ao, bb);
}

__device__ __forceinline__ void p5_route(Frame& F) {
    int tid_ = threadIdx.x; asm volatile("" : "+v"(tid_)); const int lane = tid_ & 63;
    unsigned char* ws = F.ws;
    const float* X = F.in[I_X]; const bf16* DELTA = (const bf16*)((const unsigned char*)F.out + DO_DELTA);
    bf16* X1B = (bf16*)(ws + WS_X1B); unsigned char* X1F8 = ws + WS_X1F8;
    unsigned* cnt = (unsigned*)(ws + WS_CTL) + CW_CNT;
    int* tokof = (int*)(ws + WS_TOKOF); float2* wtof = (float2*)(ws + WS_WTOF); int4* tpos = (int4*)(ws + WS_TPOS);
    const v4u* WRF = (const v4u*)(ws + WS_WRF);
    LAS v4u* wl = (LAS v4u*)F.lds;
    LAS float* sl = (LAS float*)(F.lds + 98304 + F.wave * 4096);
    const int i = lane & 15, q = lane >> 4;
    LAS unsigned* hist = (LAS unsigned*)(F.lds + LDS_MISC + 2048);
    for (int wt = F.vcu; wt < T / 128; wt += F.G) {
        const int tile = wt * NWAVES + F.wave;
        if (tid_ < 32) hist[tid_] = 0u;
        const size_t roff = (size_t)(tile * 16 + i) * D + 8 * q;
        const float* xr = X + roff; const bf16* dr = DELTA + roff;
        f32x4 a0 = {0.f, 0.f, 0.f, 0.f}, a1 = a0, a2 = a0; float ss = 0.f;
        f32x4 va[8][2]; v4u vd[8];
#pragma unroll
        for (int j = 0; j < 8; ++j) { va[j][0] = *(const GAS f32x4*)(xr + 32 * j); va[j][1] = *(const GAS f32x4*)(xr + 32 * j + 4); vd[j] = *(const GAS v4u*)(dr + 32 * j); }
#pragma unroll 1
        for (int half = 0; half < 2; ++half) {
            __syncthreads();
            { v4u t[12];
#pragma unroll
              for (int k = 0; k < 12; ++k) t[k] = WRF[half * 6144 + k * 512 + tid_];
#pragma unroll
              for (int k = 0; k < 12; ++k) wl[k * 512 + tid_] = t[k]; }
            __syncthreads();
#pragma unroll 1
            for (int sb = 0; sb < 2; ++sb) {
#pragma unroll
                for (int j = 0; j < 8; ++j) {
                    const int ksl = sb * 8 + j, ks = half * 16 + ksl;
                    const v4u dd = vd[j];
                    const f32x4 v0 = va[j][0] + (f32x4){bflo(dd.x), bfhi(dd.x), bflo(dd.y), bfhi(dd.y)}, v1 = va[j][1] + (f32x4){bflo(dd.z), bfhi(dd.z), bflo(dd.w), bfhi(dd.w)};
                    if (ks + 8 < 32) { va[j][0] = *(const GAS f32x4*)(xr + 32 * (ks + 8)); va[j][1] = *(const GAS f32x4*)(xr + 32 * (ks + 8) + 4); vd[j] = *(const GAS v4u*)(dr + 32 * (ks + 8)); }
                    ss += ((v0[0] * v0[0] + v0[1] * v0[1]) + (v0[2] * v0[2] + v0[3] * v0[3])) + ((v1[0] * v1[0] + v1[1] * v1[1]) + (v1[2] * v1[2] + v1[3] * v1[3]));
                    v4u hu; hu.x = cvtpk(v0[0], v0[1]); hu.y = cvtpk(v0[2], v0[3]); hu.z = cvtpk(v1[0], v1[1]); hu.w = cvtpk(v1[2], v1[3]);
                    v4u lu; lu.x = cvtpk(v0[0] - bflo(hu.x), v0[1] - bfhi(hu.x)); lu.y = cvtpk(v0[2] - bflo(hu.y), v0[3] - bfhi(hu.y)); lu.z = cvtpk(v1[0] - bflo(hu.z), v1[1] - bfhi(hu.z)); lu.w = cvtpk(v1[2] - bflo(hu.w), v1[3] - bfhi(hu.w));
                    *(GAS v4u*)(X1B + roff + 32 * ks) = hu;
                    if (P6_FP8) { v2u w8; w8.x = pk4_fp8(v0[0], v0[1], v0[2], v0[3]); w8.y = pk4_fp8(v1[0], v1[1], v1[2], v1[3]); *(GAS v2u*)(X1F8 + roff + 32 * ks) = w8; }
                    const bf16x8 ah = __builtin_bit_cast(bf16x8, hu), al = __builtin_bit_cast(bf16x8, lu);
#pragma unroll
                    for (int nb = 0; nb < 3; ++nb) {
                        const bf16x8 bh = __builtin_bit_cast(bf16x8, wl[((ksl * 3 + nb) * 2 + 0) * 64 + lane]), bl = __builtin_bit_cast(bf16x8, wl[((ksl * 3 + nb) * 2 + 1) * 64 + lane]);
                        f32x4 acc = nb == 0 ? a0 : (nb == 1 ? a1 : a2);
                        acc = __builtin_amdgcn_mfma_f32_16x16x32_bf16(ah, bh, acc, 0, 0, 0); acc = __builtin_amdgcn_mfma_f32_16x16x32_bf16(ah, bl, acc, 0, 0, 0); acc = __builtin_amdgcn_mfma_f32_16x16x32_bf16(al, bh, acc, 0, 0, 0);
                        if (nb == 0) a0 = acc; else if (nb == 1) a1 = acc; else a2 = acc;
                    }
                }
            }
        }
        ss += __shfl_xor(ss, 16); ss += __shfl_xor(ss, 32);
#pragma unroll
        for (int r = 0; r < 4; ++r) { sl[(4 * q + r) * 48 + i] = a0[r]; sl[(4 * q + r) * 48 + 16 + i] = a1[r]; sl[(4 * q + r) * 48 + 32 + i] = a2[r]; }
        LDS_WAIT(); asm volatile("" ::: "memory");
        int e0 = 0, e1 = 0, lp0 = 0, lp1 = 0; float w1 = 0.f, w2 = 0.f, rstd = 0.f;
        __syncthreads();
        if (lane < 16) {
            rstd = 1.0f / sqrtf(ss * (1.f / D) + RMS_EPS);
            float lg[36];
#pragma unroll
            for (int o = 0; o < 36; ++o) lg[o] = sl[lane * 48 + o] * rstd + (o < 4 ? F.in[I_BRG][o] : F.in[I_BRE][o - 4]);
            int gsel = 0; float gmax = lg[0];
#pragma unroll
            for (int k = 1; k < 4; ++k) if (lg[k] > gmax) { gmax = lg[k]; gsel = k; }
            float gden = 0.f;
#pragma unroll
            for (int k = 0; k < 4; ++k) gden += __expf(lg[k] - gmax);
            const float pg = 1.0f / gden;
            float le[8];
#pragma unroll
            for (int j = 0; j < 8; ++j) { le[j] = lg[4 + j];
#pragma unroll
                for (int gi = 1; gi < 4; ++gi) le[j] = (gsel == gi) ? lg[4 + gi * 8 + j] : le[j]; }
            int i1 = 0; float m1 = le[0];
#pragma unroll
            for (int j = 1; j < 8; ++j) if (le[j] > m1) { m1 = le[j]; i1 = j; }
            int i2 = -1; float m2 = -INFINITY;
#pragma unroll
            for (int j = 0; j < 8; ++j) if (j != i1 && le[j] > m2) { m2 = le[j]; i2 = j; }
            const float e2 = __expf(m2 - m1);
            w1 = pg / (1.0f + e2); w2 = pg * e2 / (1.0f + e2);
            e0 = gsel * 8 + i1; e1 = gsel * 8 + i2;
            lp0 = (int)__hip_atomic_fetch_add(&hist[e0], 1u, __ATOMIC_RELAXED, __HIP_MEMORY_SCOPE_WORKGROUP);
            lp1 = (int)__hip_atomic_fetch_add(&hist[e1], 1u, __ATOMIC_RELAXED, __HIP_MEMORY_SCOPE_WORKGROUP);
        }
        __syncthreads();
        if (tid_ < 32) { const unsigned n = hist[tid_]; hist[32 + tid_] = n ? atomicAdd(&cnt[64 * tid_], n) : 0u; }
        __syncthreads();
        if (lane < 16) {
            const int row = tile * 16 + lane;
            const int p0 = (int)hist[32 + e0] + lp0, p1 = (int)hist[32 + e1] + lp1;
            tokof[(size_t)e0 * T + p0] = row; wtof[(size_t)e0 * T + p0] = make_float2(w1, rstd);
            tokof[(size_t)e1 * T + p1] = row; wtof[(size_t)e1 * T + p1] = make_float2(w2, rstd);
            tpos[row] = make_int4(e0, p0, e1, p1);
        }
        __syncthreads();
    }
}

__device__ __forceinline__ void expert_tiles(Frame& F, LAS int* tb, LAS int* cn) {
    int tid_ = threadIdx.x; asm volatile("" : "+v"(tid_)); const int lane_ = tid_ & 63;
    if (tid_ == 0) {
        const unsigned* cnt = (const unsigned*)(F.ws + WS_CTL) + CW_CNT;
        int acc = 0;
        for (int e = 0; e < NE; ++e) { const int c = (int)__hip_atomic_load(cnt + 64 * e, __ATOMIC_RELAXED, __HIP_MEMORY_SCOPE_AGENT); cn[e] = c; tb[e] = acc; acc += (c + 255) >> 8; }
        tb[NE] = acc;
    }
    __syncthreads();
}

struct MoeOrder { const LAS int* tb; int ncol, G, c;
    __device__ bool next(int i, pg9::Unit& u) const {
        const int L = i * G + c; if (L >= tb[NE] * ncol) return false;
        const int rt = L / ncol; int e = 0;
        for (int k = 1; k < NE; ++k) if (tb[k] <= rt) e = k;
        u.pm = rt; u.pn = L % ncol; u.e = e; return true; } };
struct GatherA { static constexpr bool GATHER = true; unsigned rowbytes; const int* tokof; const LAS int* tb; const LAS int* cn;
    __device__ __forceinline__ unsigned operator()(const pg9::Unit& u, int row) const {
        const int p = (u.pm - tb[u.e]) * 256 + row; const int tok = tokof[(size_t)u.e * T + (p < cn[u.e] ? p : 0)]; return (unsigned)tok * rowbytes; } };
struct ExpertB { const char* W; size_t ebytes, tilebytes; __device__ __forceinline__ const char* operator()(const pg9::Unit& u) const { return W + (size_t)u.e * ebytes + (size_t)u.pn * tilebytes; } };
struct EpiGateUp {
    static constexpr bool PERM = true; static constexpr int HOOK_T = -1;
    const float2* wtof; bf16* HACT; const LAS int* tb; const LAS int* cn; float ascale;
    __device__ __forceinline__ void hook(f32x4 (&)[2][2][4][2], const pg9::Unit&, int, int, int, int) const {}
    __device__ __forceinline__ void operator()(const f32x4 (&acc)[2][2][4][2], const pg9::Unit& u, int wr, int wc, int fr, int fq) const {
        asm volatile("" : "+v"(fr), "+v"(fq));
        const int r0 = wr * 64 + fr, p0 = (u.pm - tb[u.e]) * 256, ce = cn[u.e];
        const float2* wp = wtof + (size_t)u.e * T;
#pragma unroll
        for (int ai = 0; ai < 2; ++ai) {
            float2 wv[4];
#pragma unroll
            for (int m = 0; m < 4; ++m) { const int p = p0 + r0 + ai * 128 + m * 16; wv[m] = p < ce ? wp[p] : make_float2(0.f, 0.f); }
#pragma unroll
            for (int m = 0; m < 4; ++m) { const int r = r0 + ai * 128 + m * 16;
                const float w = wv[m].x, rs = wv[m].y * ascale;
                bf16* orow = HACT + (size_t)(u.pm * 256 + r) * DE + u.pn * 128 + wc * 16 + 4 * fq; unsigned char* orow8 = (unsigned char*)HACT + (size_t)(u.pm * 256 + r) * DE + u.pn * 128 + wc * 16 + 4 * fq;
#pragma unroll
                for (int bj = 0; bj < 2; ++bj) { const f32x4 g = acc[ai][bj][m][0], uu = acc[ai][bj][m][1]; f32x4 hv;
#pragma unroll
                    for (int e = 0; e < 4; ++e) { const float gg = g[e] * rs; hv[e] = gg / (1.0f + __expf(-gg)) * (uu[e] * rs) * w; }
                    if (P6_FP8) *(GAS unsigned*)(orow8 + bj * 64) = pk4_fp8(hv[0] * H8_SCALE, hv[1] * H8_SCALE, hv[2] * H8_SCALE, hv[3] * H8_SCALE);
                    else { v2u o; o.x = cvtpk(hv[0], hv[1]); o.y = cvtpk(hv[2], hv[3]); *(GAS v2u*)(orow + bj * 64) = o; } } }
        }
    }
};
__device__ __forceinline__ void p6a_gateup(Frame& F) {
    unsigned char* ws = F.ws;
    LAS int* tb = (LAS int*)(F.lds + LDS_MISC + 1024); LAS int* cn = tb + 64;
    expert_tiles(F, tb, cn);
    MoeOrder S{tb, 2, F.G, F.vcu};
    constexpr int ES = P6_FP8 ? 1 : 2;
    GatherA ao{(unsigned)(D * ES), (const int*)(ws + WS_TOKOF), tb, cn}; ExpertB bb{(const char*)(ws + WS_WGU), (size_t)512 * D * ES, (size_t)256 * D * ES};
    EpiGateUp E{(const float2*)(ws + WS_WTOF), (bf16*)(ws + WS_HACT), tb, cn, P6_FP8 ? 1.0f / WG8_SCALE : 1.0f};
    pg9::gemm_phase<ES>(F.lds, (const char*)(ws + (P6_FP8 ? WS_X1F8 : WS_X1B)), D, S, E, ao, bb);
}
struct EpiDown {
    static constexpr bool PERM = true; static constexpr int HOOK_T = -1;
    bf16* YS; float ascale;
    __device__ __forceinline__ void hook(f32x4 (&)[2][2][4][2], const pg9::Unit&, int, int, int, int) const {}
    __device__ __forceinline__ void operator()(const f32x4 (&acc)[2][2][4][2], const pg9::Unit& u, int wr, int wc, int fr, int fq) const {
        asm volatile("" : "+v"(fr), "+v"(fq));
#pragma unroll
        for (int ai = 0; ai < 2; ++ai)
#pragma unroll
            for (int m = 0; m < 4; ++m) { bf16* orow = YS + (size_t)(u.pm * 256 + wr * 64 + fr + ai * 128 + m * 16) * D + u.pn * 256 + wc * 32 + 8 * fq;
#pragma unroll
                for (int bj = 0; bj < 2; ++bj) { const f32x4 v0 = acc[ai][bj][m][0] * ascale, v1 = acc[ai][bj][m][1] * ascale;
                    if (YS_FP8) { unsigned char* o8 = (unsigned char*)YS + (size_t)(u.pm * 256 + wr * 64 + fr + ai * 128 + m * 16) * D + u.pn * 256 + wc * 32 + 8 * fq + bj * 128;
                        v2u w8; w8.x = pk4_fp8(v0[0] * YS8_SCALE, v0[1] * YS8_SCALE, v0[2] * YS8_SCALE, v0[3] * YS8_SCALE); w8.y = pk4_fp8(v1[0] * YS8_SCALE, v1[1] * YS8_SCALE, v1[2] * YS8_SCALE, v1[3] * YS8_SCALE); *(GAS v2u*)o8 = w8; }
                    else { v4u w; w.x = cvtpk(v0[0], v0[1]); w.y = cvtpk(v0[2], v0[3]); w.z = cvtpk(v1[0], v1[1]); w.w = cvtpk(v1[2], v1[3]); *(GAS v4u*)(orow + bj * 128) = w; } } }
    }
};
__device__ __forceinline__ void p6b_down(Frame& F) {
    unsigned char* ws = F.ws;
    LAS int* tb = (LAS int*)(F.lds + LDS_MISC + 1024); LAS int* cn = tb + 64;
    expert_tiles(F, tb, cn);
    MoeOrder S{tb, 4, F.G, F.vcu};
    constexpr int ES = P6_FP8 ? 1 : 2;
    pg9::DenseA ao{(unsigned)(DE * ES)}; ExpertB bb{(const char*)(ws + WS_WD), (size_t)D * DE * ES, (size_t)256 * DE * ES};
    EpiDown E{(bf16*)(ws + WS_YS), P6_FP8 ? 1.0f / (WD8_SCALE * H8_SCALE) : 1.0f};
    pg9::gemm_phase<ES>(F.lds, (const char*)(ws + WS_HACT), DE, S, E, ao, bb);
}
__device__ __forceinline__ void p7_final(Frame& F) {
    int tid_ = threadIdx.x; asm volatile("" : "+v"(tid_)); const int lane_ = tid_ & 63;
    unsigned char* ws = F.ws;
    LAS int* tb = (LAS int*)(F.lds + LDS_MISC + 1024); LAS int* cn = tb + 64;
    expert_tiles(F, tb, cn);
    const bf16* YS = (const bf16*)(ws + WS_YS); const int4* tpos = (const int4*)(ws + WS_TPOS);
    float* X1 = F.out; const bf16* X1B = (const bf16*)(ws + WS_X1B);
    const int lane = lane_;
    const int gw = F.vcu * NWAVES + F.wave, NGW = F.G * NWAVES;
    const GAS f32x4* gr = (const GAS f32x4*)F.in[I_GFIN] + lane;
    for (int row = gw; row < T; row += NGW) {
        const int4 tp = tpos[row];
        const size_t s0 = (size_t)tb[tp.x] * 256 + tp.y, s1 = (size_t)tb[tp.z] * 256 + tp.w;
        GAS f32x4* xr = (GAS f32x4*)(X1 + (size_t)row * D) + lane; const GAS v2u* xb = (const GAS v2u*)(X1B + (size_t)row * D) + lane;
        const GAS v2u* y0 = (const GAS v2u*)(YS + s0 * D) + lane; const GAS v2u* y1 = (const GAS v2u*)(YS + s1 * D) + lane;
        const GAS unsigned* z0 = (const GAS unsigned*)((const unsigned char*)YS + s0 * D) + lane; const GAS unsigned* z1 = (const GAS unsigned*)((const unsigned char*)YS + s1 * D) + lane;
        f32x4 v[4]; float s = 0.f;
#pragma unroll
        for (int j = 0; j < 4; ++j) { const v2u xx = xb[64 * j]; v[j] = (f32x4){bflo(xx.x), bfhi(xx.x), bflo(xx.y), bfhi(xx.y)};
            if (YS_FP8) { const int a = (int)z0[64 * j], b = (int)z1[64 * j]; typedef float f2_ __attribute__((ext_vector_type(2)));
                const f2_ a0 = __builtin_amdgcn_cvt_pk_f32_fp8(a, false), a1 = __builtin_amdgcn_cvt_pk_f32_fp8(a, true), b0 = __builtin_amdgcn_cvt_pk_f32_fp8(b, false), b1 = __builtin_amdgcn_cvt_pk_f32_fp8(b, true);
                constexpr float f = 1.0f / YS8_SCALE; v[j].x += (a0[0] + b0[0]) * f; v[j].y += (a0[1] + b0[1]) * f; v[j].z += (a1[0] + b1[0]) * f; v[j].w += (a1[1] + b1[1]) * f; }
            else { const v2u a = y0[64 * j], b = y1[64 * j];
            v[j].x += bflo(a.x) + bflo(b.x); v[j].y += bfhi(a.x) + bfhi(b.x); v[j].z += bflo(a.y) + bflo(b.y); v[j].w += bfhi(a.y) + bfhi(b.y); }
            s += (v[j].x * v[j].x + v[j].y * v[j].y) + (v[j].z * v[j].z + v[j].w * v[j].w); }
        const float rstd = 1.0f / sqrtf(wave_sum(s) * (1.f / D) + RMS_EPS);
#pragma unroll
        for (int j = 0; j < 4; ++j) { const f32x4 gg = gr[64 * j]; f32x4 o; o.x = v[j].x * rstd * gg.x; o.y = v[j].y * rstd * gg.y; o.z = v[j].z * rstd * gg.z; o.w = v[j].w * rstd * gg.w; xr[64 * j] = o; }
    }
}

constexpr int NPHASE = 2 * NCH + 8;
__global__ void __launch_bounds__(NTHR, 2) fwd_kernel(KArgs args) {
    extern __shared__ __attribute__((aligned(16))) unsigned char lds_raw[];
    Frame F;
    F.lds = (LAS unsigned char*)lds_raw;
    F.tid = threadIdx.x; F.lane = F.tid & 63; F.wave = __builtin_amdgcn_readfirstlane(F.tid >> 6);
    F.G = gridDim.x; { const int bx = blockIdx.x; F.vcu = (F.G % 8 == 0) ? (bx % 8) * (F.G / 8) + bx / 8 : bx; }
#pragma unroll
    for (int i = 0; i < 17; ++i) F.in[i] = args.in[i];
    F.out = args.out; F.ws = args.ws;
    volatile LAS unsigned* MISC = (volatile LAS unsigned*)(F.lds + LDS_MISC);
    if (F.tid < 64) MISC[F.tid] = 0u;
    __syncthreads();
    XcdBarrier bar = xcd_barrier_post((unsigned*)(F.ws + WS_CTL) + CW_BAR + args.li * XCD_BAR_WORDS, MISC + 8);
#define IN(k) (args.ph_lo <= (k) && (k) < args.ph_hi)
#ifdef PROBE_MASK
    unsigned long long pr_acc = 0, pr_t0 = 0; const bool pr_me = (blockIdx.x == 0 && threadIdx.x == 0);
#define PR_BEGIN(k) do { if (pr_me && ((PROBE_MASK >> (k)) & 1ull)) pr_t0 = __builtin_amdgcn_s_memrealtime(); } while (0)
#define PR_END(k) do { if (pr_me && ((PROBE_MASK >> (k)) & 1ull)) pr_acc += __builtin_amdgcn_s_memrealtime() - pr_t0; } while (0)
#else
#define PR_BEGIN(k) do {} while (0)
#define PR_END(k) do {} while (0)
#endif
#define SEAM(k) do { if (IN(k) && IN((k) + 1)) xcd_barrier(bar); PR_END(k); } while (0)
    PR_BEGIN(0); if (IN(0)) p0_prologue(F);
    SEAM(0);
#pragma unroll 1
    for (int ch = 0; ch < NCH; ++ch) {
        PR_BEGIN(1 + 2 * ch);
        if (IN(1 + 2 * ch)) {
            constexpr int NWG1 = (TC / 256) * (NIN / 256);
            const int nfull = NWG1 % F.G, bx = (int)blockIdx.x;
            if (ch > 0 && nfull == 0) p2_combine(F, ch - 1, F.vcu, F.G);
            p1_inproj(F, ch);
            if (ch > 0 && nfull != 0 && bx >= nfull) p2_combine(F, ch - 1, bx - nfull, F.G - nfull);
        }
        SEAM(1 + 2 * ch);
        PR_BEGIN(2 + 2 * ch); if (IN(2 + 2 * ch)) p2_attn(F, ch);
        SEAM(2 + 2 * ch);
    }
    PR_BEGIN(2 * NCH + 1); if (IN(2 * NCH + 1)) p2_combine(F, NCH - 1, F.vcu, F.G);
    SEAM(2 * NCH + 1);
    PR_BEGIN(2 * NCH + 2); if (IN(2 * NCH + 2)) p3_merge(F);
    SEAM(2 * NCH + 2);
    PR_BEGIN(2 * NCH + 3); if (IN(2 * NCH + 3)) p4_outproj(F);
    SEAM(2 * NCH + 3);
    PR_BEGIN(2 * NCH + 4); if (IN(2 * NCH + 4)) p5_route(F);
    SEAM(2 * NCH + 4);
    PR_BEGIN(2 * NCH + 5); if (IN(2 * NCH + 5)) p6a_gateup(F);
    SEAM(2 * NCH + 5);
    PR_BEGIN(2 * NCH + 6); if (IN(2 * NCH + 6)) p6b_down(F);
    SEAM(2 * NCH + 6);
    PR_BEGIN(2 * NCH + 7); if (IN(2 * NCH + 7)) p7_final(F);
    PR_END(2 * NCH + 7);
#ifdef PROBE_MASK
    if (pr_me) { const unsigned long long t1 = __builtin_amdgcn_s_memrealtime(); while (__builtin_amdgcn_s_memrealtime() - t1 < pr_acc) __builtin_amdgcn_s_sleep(4); }
#endif
#undef IN
#undef SEAM
}

#ifndef N_LAUNCHES
#define N_LAUNCHES 1
#endif
extern "C" void kernel_launch(void* const* d_in, const int* in_sizes, int n_in, void* d_out, int out_size, void* d_ws, size_t ws_size, hipStream_t stream) {
    static int grid = 0;
    if (grid == 0) {
        if (n_in != 17 || in_sizes[0] != T * D || out_size != T * D || ws_size < WS_END) { fprintf(stderr, "kernel_launch: unexpected shapes / workspace (%d inputs, ws %zu)\n", n_in, ws_size); grid = -1; return; }
        int dev = 0, cus = 0;
        if (hipGetDevice(&dev) != hipSuccess || hipDeviceGetAttribute(&cus, hipDeviceAttributeMultiprocessorCount, dev) != hipSuccess) { grid = -1; return; }
        if (hipFuncSetAttribute((const void*)fwd_kernel, hipFuncAttributeMaxDynamicSharedMemorySize, LDS_BYTES) != hipSuccess) { fprintf(stderr, "kernel_launch: hipFuncSetAttribute failed\n"); grid = -1; return; }
        int per_cu = 0;
        if (hipOccupancyMaxActiveBlocksPerMultiprocessor(&per_cu, (const void*)fwd_kernel, NTHR, LDS_BYTES) != hipSuccess || per_cu < 1) fprintf(stderr, "kernel_launch: occupancy query says %d\n", per_cu);
        (void)hipGetLastError();
        grid = cus;
    }
    if (grid < 0) return;
    (void)hipMemsetAsync((char*)d_ws + WS_CTL, 0, N_LAUNCHES == 1 ? (size_t)(CW_BAR + XCD_BAR_WORDS) * 4 : CTL_BYTES, stream);
    KArgs a{};
    for (int i = 0; i < 17; ++i) a.in[i] = (const float*)d_in[i];
    a.out = (float*)d_out; a.ws = (unsigned char*)d_ws;
    for (int li = 0; li < N_LAUNCHES; ++li) {
        a.ph_lo = (int)((long)NPHASE * li / N_LAUNCHES); a.ph_hi = (int)((long)NPHASE * (li + 1) / N_LAUNCHES); a.li = li;
        hipLaunchKernelGGL(fwd_kernel, dim3(grid), dim3(NTHR), LDS_BYTES, stream, a);
    }
}
```

```cpp
#include <hip/hip_runtime.h>
#include <cstdint>
#include <cstdio>

#define GAS __attribute__((address_space(1)))
#define LAS __attribute__((address_space(3)))
typedef unsigned short bf16;
typedef short bf16x8 __attribute__((ext_vector_type(8)));
typedef float f32x4 __attribute__((ext_vector_type(4)));
typedef unsigned v4u __attribute__((ext_vector_type(4)));
typedef unsigned v2u __attribute__((ext_vector_type(2)));
typedef GAS unsigned gu32;

constexpr int T = 32768, D = 1024, SEQ = 4096, NIN = 7936;
constexpr int A_W = 4608, B_W = 1280, G_W = 2048, Y_W = 1536;
constexpr int NE = 32, DE = 256;
constexpr int NCH = 4, TC = T / NCH;
constexpr float QSCALE = 0.125f * 1.4426950408889634f;
constexpr float LOG2E = 1.4426950408889634f;
constexpr float RMS_EPS = 1e-6f;
#ifndef P1_FP8
#define P1_FP8 1
#endif
constexpr float W8_SCALE = P1_FP8 ? 64.0f : 0.0f, W8_INV = P1_FP8 ? 1.0f / 64.0f : 1.0f;
#ifndef P6_FP8
#define P6_FP8 1
#endif
#ifndef P34_FP8
#define P34_FP8 1
#endif
constexpr float Y8_SCALE = 16.0f, W34_SCALE = 64.0f, MG8_SCALE = 32.0f;
#ifndef YS_FP8
#define YS_FP8 1
#endif
constexpr float YS8_SCALE = 16.0f;
constexpr float WG8_SCALE = P6_FP8 ? 64.0f : 0.0f, WD8_SCALE = P6_FP8 ? 32.0f : 0.0f, H8_SCALE = 32.0f;
constexpr int NWAVES = 8, NTHR = 512;

constexpr size_t MiB = 1u << 20;
constexpr size_t WS_CTL = 0, CTL_BYTES = 1 * MiB;
constexpr size_t WS_INVF = 1 * MiB;
constexpr size_t WS_WRF = 2 * MiB;
constexpr size_t WS_TOKOF = 3 * MiB;
constexpr size_t WS_WTOF = 7 * MiB;
constexpr size_t WS_TPOS = 15 * MiB;
constexpr size_t WS_WIN = 16 * MiB;
constexpr size_t WS_WAB = 32 * MiB;
constexpr size_t WS_WO = 35 * MiB;
constexpr size_t WS_WGU = 37 * MiB;
constexpr size_t WS_WD = 69 * MiB;
constexpr size_t WS_G = 86 * MiB;
constexpr size_t WS_Y = 214 * MiB;
constexpr size_t WS_ZA = 310 * MiB;
constexpr size_t WS_ZB = 454 * MiB;
constexpr size_t WS_END = 494 * MiB;
constexpr size_t WS_MG = WS_ZA;
constexpr size_t WS_X1B = WS_ZA + 64 * MiB;
constexpr size_t WS_X1F8 = WS_Y + 64 * MiB;
constexpr size_t WS_HACT = WS_G;
constexpr size_t WS_YS = WS_G + 36 * MiB;
constexpr size_t DO_DELTA = 0;
constexpr size_t DO_HN = 0;
constexpr size_t DO_OG = 64 * MiB;
constexpr size_t DO_LSE = 112 * MiB;
constexpr int MAXSLOT = 2 * T + NE * 256;
static_assert(WS_ZA + (size_t)TC * A_W * 2 <= WS_ZB && WS_ZB + (size_t)TC * B_W * 2 <= WS_END && WS_Y + (size_t)T * Y_W * 2 <= WS_ZA && WS_G + (size_t)T * G_W * 2 <= WS_Y, "ws map");
static_assert(WS_MG + (size_t)T * D * 2 <= WS_END && WS_HACT + (size_t)MAXSLOT * DE * 2 <= WS_YS && WS_YS + (size_t)MAXSLOT * D * 2 <= WS_ZA && WS_X1B >= WS_MG + (size_t)T * D * 2 && WS_X1B + (size_t)T * D * 2 <= WS_ZB, "ws map");
static_assert(DO_OG + (size_t)3 * TC * 512 * 2 <= DO_LSE && DO_LSE + (size_t)3 * TC * 8 * 4 <= (size_t)T * D * 4 && DO_HN + (size_t)T * D * 2 <= DO_OG, "d_out scratch map");
constexpr int CW_CNT = 1024;
constexpr int CW_BAR = 4096;
constexpr int LDS_BYTES = 147456;
constexpr int LDS_MISC = 131072;

__device__ __forceinline__ unsigned f2bf(float f) { unsigned u = __builtin_bit_cast(unsigned, f); return (u + 0x7fffu + ((u >> 16) & 1u)) >> 16; }
__device__ __forceinline__ unsigned pk4_fp8(float a, float b, float c, float d) {
    a = __builtin_amdgcn_fmed3f(a, -448.f, 448.f); b = __builtin_amdgcn_fmed3f(b, -448.f, 448.f); c = __builtin_amdgcn_fmed3f(c, -448.f, 448.f); d = __builtin_amdgcn_fmed3f(d, -448.f, 448.f);
    int w = 0; w = __builtin_amdgcn_cvt_pk_fp8_f32(a, b, w, false); w = __builtin_amdgcn_cvt_pk_fp8_f32(c, d, w, true); return (unsigned)w; }
__device__ __forceinline__ unsigned pk2(float lo, float hi) { return f2bf(lo) | (f2bf(hi) << 16); }
__device__ __forceinline__ float bf2f(unsigned b) { return __builtin_bit_cast(float, b << 16); }
__device__ __forceinline__ float bflo(unsigned u) { return __builtin_bit_cast(float, u << 16); }
__device__ __forceinline__ float bfhi(unsigned u) { return __builtin_bit_cast(float, u & 0xffff0000u); }
__device__ __forceinline__ float wave_sum(float v) {
#pragma unroll
    for (int o = 1; o < 64; o <<= 1) v += __shfl_xor(v, o);
    return v;
}
__device__ __forceinline__ float wave_max(float v) {
#pragma unroll
    for (int o = 1; o < 64; o <<= 1) v = fmaxf(v, __shfl_xor(v, o));
    return v;
}
typedef float f32x2_t __attribute__((ext_vector_type(2)));
typedef __bf16 bf16x2_t __attribute__((ext_vector_type(2)));
__device__ __forceinline__ unsigned cvtpk(float lo, float hi) { f32x2_t v = {lo, hi}; bf16x2_t b = __builtin_convertvector(v, bf16x2_t); return __builtin_bit_cast(unsigned, b); }
#ifndef WT_STORES
#define WT_STORES 0
#endif
__device__ __forceinline__ __amdgpu_buffer_rsrc_t wt_rsrc(unsigned char* base) { return __builtin_amdgcn_make_buffer_rsrc(base, 0, 0x7ffffffc, 0x00020000); }
__device__ __forceinline__ void st16(__amdgpu_buffer_rsrc_t r, unsigned char* base, void* p, v4u v) { if (WT_STORES) __builtin_amdgcn_raw_buffer_store_b128(v, r, (unsigned)((unsigned char*)p - base), 0, 16); else *(GAS v4u*)p = v; }
__device__ __forceinline__ void st8(__amdgpu_buffer_rsrc_t r, unsigned char* base, void* p, v2u v) { if (WT_STORES) __builtin_amdgcn_raw_buffer_store_b64(v, r, (unsigned)((unsigned char*)p - base), 0, 16); else *(GAS v2u*)p = v; }
#define LDS_WAIT() asm volatile("s_waitcnt lgkmcnt(0)" ::: "memory")
#define VM_WAIT() asm volatile("s_waitcnt vmcnt(0)" ::: "memory")

#define XB_TMO      128
#define XB_XCNT(j)  (256  + 64 * (j))
#define XB_XSUB(j)  (1280 + 64 * (j))
#define XB_XGEN(j)  (2304 + 64 * (j))
#define XB_TOP      3328
#define XB_TOPGEN   3392
#define XCD_BAR_WORDS 3456
#define XB_SPIN_CAP (1u << 18)
__device__ __forceinline__ unsigned xb_ld(unsigned* p)              { return __hip_atomic_load(p, __ATOMIC_RELAXED, __HIP_MEMORY_SCOPE_AGENT); }
__device__ __forceinline__ unsigned xb_add(unsigned* p, unsigned v) { return __hip_atomic_fetch_add(p, v, __ATOMIC_RELAXED, __HIP_MEMORY_SCOPE_AGENT); }
__device__ __forceinline__ unsigned xb_xcc_id() { return (unsigned)__builtin_amdgcn_s_getreg((3 << 11) | 20) & 0xFu; }
#define XB_SPIN(cond, bar) do { unsigned _sp = 0; while (cond) { __builtin_amdgcn_s_sleep(1); \
    if ((++_sp & 255u) == 0u) { if (xb_ld(&(bar)[XB_TMO])) break; if (_sp > XB_SPIN_CAP) { atomicAdd(&(bar)[XB_TMO], 1u); break; } } } } while (0)
struct XcdBarrier { unsigned* bar; unsigned x; volatile LAS unsigned* st; };
__device__ __forceinline__ XcdBarrier xcd_barrier_post(unsigned* bar, volatile LAS unsigned* st) {
    XcdBarrier b; b.bar = bar; b.x = xb_xcc_id(); b.st = st;
    if (threadIdx.x == 0) (void)xb_add(&bar[XB_XCNT(b.x)], 1u);
    return b;
}
__device__ __forceinline__ void xcd_barrier_complete(unsigned* bar, unsigned x, unsigned& nloc, unsigned& nx) {
    const unsigned G = gridDim.x * gridDim.y * gridDim.z;
    unsigned sum, cnt, mine, sp = 0u;
    for (;;) {
        sum = 0u; cnt = 0u; mine = 0u;
#pragma unroll
        for (unsigned j = 0; j < 16; ++j) { const unsigned c = xb_ld(&bar[XB_XCNT(j)]); sum += c; cnt += (c > 0u) ? 1u : 0u; mine = (j == x) ? c : mine; }
        if (sum == G) break;
        __builtin_amdgcn_s_sleep(1);
        if ((++sp & 255u) == 0u) { if (xb_ld(&bar[XB_TMO])) break; if (sp > XB_SPIN_CAP) { atomicAdd(&bar[XB_TMO], 1u); break; } }
    }
    nloc = mine > 0u ? mine : 1u; nx = cnt > 0u ? cnt : 1u;
}
__device__ __forceinline__ void xcd_barrier(const XcdBarrier& b) {
    asm volatile("s_waitcnt vmcnt(0)" ::: "memory");
    __syncthreads();
    if (threadIdx.x == 0) {
        unsigned* bar = b.bar;
        __builtin_amdgcn_s_waitcnt(0);
        unsigned nloc = b.st[0], nx = b.st[1];
        if (nloc == 0u) { xcd_barrier_complete(bar, b.x, nloc, nx); b.st[0] = nloc; b.st[1] = nx; }
        const unsigned old = xb_add(&bar[XB_XSUB(b.x)], 1u);
        const unsigned gen = old / nloc;
        if (old + 1u == (gen + 1u) * nloc) {
            __builtin_amdgcn_fence(__ATOMIC_RELEASE, "agent");
            asm volatile("s_waitcnt vmcnt(0)" ::: "memory");
            const unsigned og = xb_add(&bar[XB_TOP], 1u);
            const unsigned tg = og / nx;
            if (og + 1u == (tg + 1u) * nx) xb_add(&bar[XB_TOPGEN], 1u);
            else XB_SPIN(xb_ld(&bar[XB_TOPGEN]) == tg, bar);
            __builtin_amdgcn_fence(__ATOMIC_ACQUIRE, "agent");
            xb_add(&bar[XB_XGEN(b.x)], 1u);
            asm volatile("s_waitcnt vmcnt(0)" ::: "memory");
        } else {
            XB_SPIN(xb_ld(&bar[XB_XGEN(b.x)]) == gen, bar);
            __builtin_amdgcn_fence(__ATOMIC_ACQUIRE, "agent");
            asm volatile("s_waitcnt vmcnt(0)" ::: "memory");
        }
    }
    __syncthreads();
}

struct KArgs { const float* in[17]; float* out; unsigned char* ws; int ph_lo, ph_hi, li, pad; };
struct Frame {
    LAS unsigned char* lds;
    int tid, lane, wave, vcu, G;
    const float* in[17]; float* out; unsigned char* ws;
};
enum { I_X = 0, I_WIN, I_BIN, I_SINK, I_WPA, I_WPB, I_WOUT, I_GMIX, I_GFFN, I_WRG, I_BRG, I_WRE, I_BRE, I_WEG, I_WEU, I_WED, I_GFIN };

struct TrDesc { const float* W; int N; bf16* WT; int ldo, rowbase, koff, k0, n0; bool perm; const float* kscale; float f8scale; };
__device__ __forceinline__ void tr_load(const TrDesc& d, int lane, f32x4 (&tv)[8], float (&ks)[8]) {
    const float* src = d.W + (size_t)(d.k0 + (lane >> 3)) * d.N + d.n0 + 4 * (lane & 7);
#pragma unroll
    for (int i = 0; i < 8; ++i) tv[i] = *(const GAS f32x4*)(src + (size_t)(8 * i) * d.N);
#pragma unroll
    for (int i = 0; i < 8; ++i) ks[i] = d.kscale ? d.kscale[d.k0 + 8 * i + (lane >> 3)] : 1.0f;
}
__device__ __forceinline__ void tr_finish(const TrDesc& d, LAS float* scr, int lane, const f32x4 (&tv)[8], const float (&ks)[8]) {
#pragma unroll
    for (int i = 0; i < 8; ++i) { const int kk = 8 * i + (lane >> 3); LAS float* w = scr + kk * 33 + 4 * (lane & 7);
        w[0] = tv[i][0] * ks[i]; w[1] = tv[i][1] * ks[i]; w[2] = tv[i][2] * ks[i]; w[3] = tv[i][3] * ks[i]; }
    LDS_WAIT(); asm volatile("" ::: "memory");
    const int c = lane & 7;
#pragma unroll
    for (int j = 0; j < 4; ++j) { const int n = (lane >> 3) + 8 * j; const LAS float* s = scr + (8 * c) * 33 + n;
        const int rr = d.perm ? 8 * (n >> 2) + (n & 3) : n;
        if (d.f8scale != 0.f) { const float f = d.f8scale; v2u o8; o8.x = pk4_fp8(s[0 * 33] * f, s[1 * 33] * f, s[2 * 33] * f, s[3 * 33] * f); o8.y = pk4_fp8(s[4 * 33] * f, s[5 * 33] * f, s[6 * 33] * f, s[7 * 33] * f);
            *(GAS v2u*)((unsigned char*)d.WT + (size_t)(d.rowbase + rr) * d.ldo + d.koff + d.k0 + 8 * c) = o8; }
        else { v4u o; o.x = pk2(s[0 * 33], s[1 * 33]); o.y = pk2(s[2 * 33], s[3 * 33]); o.z = pk2(s[4 * 33], s[5 * 33]); o.w = pk2(s[6 * 33], s[7 * 33]);
            *(GAS v4u*)(d.WT + (size_t)(d.rowbase + rr) * d.ldo + d.koff + d.k0 + 8 * c) = o; } }
    LDS_WAIT(); asm volatile("" ::: "memory");
}
__device__ __forceinline__ void rms_row_to_bf16(const float* xrow, const float* g, bf16* orow, int lane) {
    const GAS f32x4* xr = (const GAS f32x4*)xrow + lane; const GAS f32x4* gr = (const GAS f32x4*)g + lane;
    f32x4 v[4]; float s = 0.f;
#pragma unroll
    for (int j = 0; j < 4; ++j) { v[j] = xr[64 * j]; s += (v[j].x * v[j].x + v[j].y * v[j].y) + (v[j].z * v[j].z + v[j].w * v[j].w); }
    const float rstd = 1.0f / sqrtf(wave_sum(s) * (1.f / D) + RMS_EPS);
    GAS v2u* o8 = (GAS v2u*)orow + lane;
#pragma unroll
    for (int j = 0; j < 4; ++j) { const f32x4 gg = gr[64 * j]; v2u w; w.x = pk2(v[j].x * rstd * gg.x, v[j].y * rstd * gg.y); w.y = pk2(v[j].z * rstd * gg.z, v[j].w * rstd * gg.w); o8[64 * j] = w; }
}
__device__ __forceinline__ void p0_prologue(Frame& F) {
    int tid_ = threadIdx.x; asm volatile("" : "+v"(tid_)); const int lane_ = tid_ & 63;
    LAS float* scr = (LAS float*)(F.lds + F.wave * 16384);
    const int gw = F.vcu * NWAVES + F.wave, NGW = F.G * NWAVES;
    unsigned char* ws = F.ws;
    constexpr int I_IN = 16 * 248, I_PA = 8 * 32, I_PB = 16 * 32, I_WO = 16 * 32, I_EG = 32 * 16 * 8, I_ED = 32 * 4 * 32;
    constexpr int NITEMS = I_IN + I_PA + I_PB + I_WO + 2 * I_EG + I_ED;
    auto decode = [&](int it, TrDesc& d) {
        int r = it; d.perm = false; d.kscale = nullptr; d.f8scale = 0.f; d.koff = 0;
        if (r < I_IN) { const int kb = r / 248, nb = r % 248, n0 = 32 * nb; const bool qk = (n0 < 3072) || (n0 >= A_W && n0 < A_W + 1152);
            const bool gt_ = n0 >= A_W + B_W; const int gc = n0 - (A_W + B_W);
            d.W = F.in[I_WIN]; d.N = NIN; d.WT = (bf16*)(ws + WS_WIN); d.ldo = 1024; d.rowbase = qk ? (n0 & ~63) + ((n0 >> 5) & 1) * 4 : (gt_ ? A_W + B_W + 2 * (gc % 1024) + 4 * (gc / 1024) : n0); d.k0 = 64 * kb; d.n0 = n0; d.perm = qk || gt_; d.f8scale = W8_SCALE; return; } r -= I_IN;
        if (r < I_PA) { const int kb = r / 32, nb = r % 32; d.W = F.in[I_WPA]; d.N = 1024; d.WT = (bf16*)(ws + WS_WAB); d.ldo = 1536; d.rowbase = 32 * nb; d.k0 = 64 * kb; d.n0 = 32 * nb; if (P34_FP8) d.f8scale = W34_SCALE; return; } r -= I_PA;
        if (r < I_PB) { const int kb = r / 32, nb = r % 32; d.W = F.in[I_WPB]; d.N = 1024; d.WT = (bf16*)(ws + WS_WAB); d.ldo = 1536; d.rowbase = 32 * nb; d.koff = 512; d.k0 = 64 * kb; d.n0 = 32 * nb; if (P34_FP8) d.f8scale = W34_SCALE; return; } r -= I_PB;
        if (r < I_WO) { const int kb = r / 32, nb = r % 32; d.W = F.in[I_WOUT]; d.N = 1024; d.WT = (bf16*)(ws + WS_WO); d.ldo = 1024; d.rowbase = 32 * nb; d.k0 = 64 * kb; d.n0 = 32 * nb; if (P34_FP8) d.f8scale = W34_SCALE; return; } r -= I_WO;
        if (r < 2 * I_EG) { const int up = r >= I_EG; if (up) r -= I_EG; const int e = r / 128, q = r % 128, kb = q / 8, nb = q % 8;
            d.W = F.in[up ? I_WEU : I_WEG] + (size_t)e * 1024 * 256; d.N = 256; d.WT = (bf16*)(ws + WS_WGU) + (size_t)e * 512 * 1024; d.ldo = 1024; d.rowbase = 64 * nb + (up ? 4 : 0); d.k0 = 64 * kb; d.n0 = 32 * nb; d.perm = true; d.kscale = F.in[I_GFFN]; d.f8scale = WG8_SCALE; if (P6_FP8) d.WT = (bf16*)((unsigned char*)(ws + WS_WGU) + (size_t)e * 512 * 1024); return; } r -= 2 * I_EG;
        { const int e = r / 128, q = r % 128, kb = q / 32, nb = q % 32;
            d.W = F.in[I_WED] + (size_t)e * 256 * 1024; d.N = 1024; d.WT = (bf16*)(ws + WS_WD) + (size_t)e * 1024 * 256; d.ldo = 256; d.rowbase = 32 * nb; d.k0 = 64 * kb; d.n0 = 32 * nb; d.f8scale = WD8_SCALE; if (P6_FP8) d.WT = (bf16*)((unsigned char*)(ws + WS_WD) + (size_t)e * 1024 * 256); }
    };
    {
        int it = gw; TrDesc dc, dn; f32x4 tc[8], tn[8]; float kc[8], kn[8];
        bool hc = it < NITEMS; if (hc) { decode(it, dc); tr_load(dc, lane_, tc, kc); }
        while (hc) {
            it += NGW; const bool hn = it < NITEMS;
            if (hn) { decode(it, dn); tr_load(dn, lane_, tn, kn); }
            tr_finish(dc, scr, lane_, tc, kc);
            hc = hn; dc = dn;
#pragma unroll
            for (int i = 0; i < 8; ++i) { tc[i] = tn[i]; kc[i] = kn[i]; }
        }
    }
    for (int m = gw; m < T; m += 4 * NGW) {
        const GAS f32x4* gr = (const GAS f32x4*)F.in[I_GMIX] + lane_;
        f32x4 v[4][4]; float ss[4];
#pragma unroll
        for (int r = 0; r < 4; ++r) { const int mr = (m + r * NGW < T) ? m + r * NGW : m; const GAS f32x4* xr = (const GAS f32x4*)(F.in[I_X] + (size_t)mr * D) + lane_;
#pragma unroll
            for (int j = 0; j < 4; ++j) v[r][j] = xr[64 * j]; }
#pragma unroll
        for (int r = 0; r < 4; ++r) { float a = 0.f;
#pragma unroll
            for (int j = 0; j < 4; ++j) a += (v[r][j].x * v[r][j].x + v[r][j].y * v[r][j].y) + (v[r][j].z * v[r][j].z + v[r][j].w * v[r][j].w);
            ss[r] = 1.0f / sqrtf(wave_sum(a) * (1.f / D) + RMS_EPS); }
#pragma unroll
        for (int r = 0; r < 4; ++r) { if (m + r * NGW >= T) continue; GAS unsigned* o4 = (GAS unsigned*)((unsigned char*)F.out + DO_HN + (size_t)(m + r * NGW) * D) + lane_;
#pragma unroll
            for (int j = 0; j < 4; ++j) { const f32x4 gg = gr[64 * j];
                if (P1_FP8) o4[64 * j] = pk4_fp8(v[r][j].x * ss[r] * gg.x, v[r][j].y * ss[r] * gg.y, v[r][j].z * ss[r] * gg.z, v[r][j].w * ss[r] * gg.w);
                else { v2u w; w.x = cvtpk(v[r][j].x * ss[r] * gg.x, v[r][j].y * ss[r] * gg.y); w.y = cvtpk(v[r][j].z * ss[r] * gg.z, v[r][j].w * ss[r] * gg.w); ((GAS v2u*)((unsigned char*)F.out + DO_HN + (size_t)(m + r * NGW) * D * 2) + lane_)[64 * j] = w; } } }
    }
    const int gt = F.vcu * NTHR + tid_, NGT = F.G * NTHR;
    if (gt < 32) ((float*)(ws + WS_INVF))[gt] = (float)exp2(-(double)gt * (13.287712379549449 / 32.0));
    for (int i = gt; i < 32 * 3 * 64; i += NGT) {
        const int ln = i & 63, nb = (i >> 6) % 3, ks = i / 192;
        const int n = 16 * nb + (ln & 15);
        float hi[8], lo[8];
#pragma unroll
        for (int e = 0; e < 8; ++e) { const int k = 32 * ks + 8 * (ln >> 4) + e; float v = 0.f;
            if (n < 4) v = F.in[I_WRG][k * 4 + n]; else if (n < 36) v = F.in[I_WRE][k * 32 + (n - 4)];
            v *= F.in[I_GFFN][k]; hi[e] = bf2f(f2bf(v)); lo[e] = v - hi[e]; }
        v4u h, l; h.x = pk2(hi[0], hi[1]); h.y = pk2(hi[2], hi[3]); h.z = pk2(hi[4], hi[5]); h.w = pk2(hi[6], hi[7]);
        l.x = pk2(lo[0], lo[1]); l.y = pk2(lo[2], lo[3]); l.z = pk2(lo[4], lo[5]); l.w = pk2(lo[6], lo[7]);
        ((v4u*)(ws + WS_WRF))[((ks * 3 + nb) * 2 + 0) * 64 + ln] = h; ((v4u*)(ws + WS_WRF))[((ks * 3 + nb) * 2 + 1) * 64 + ln] = l;
    }
}

namespace pg8 {
#define PG8_LAS __attribute__((address_space(3)))
typedef unsigned short bf16_t;
typedef short bf16x8 __attribute__((ext_vector_type(8)));
typedef float f32x4 __attribute__((ext_vector_type(4)));
typedef unsigned u32x4 __attribute__((ext_vector_type(4)));
constexpr int BM = 256, BK = 64, HALF = 128, HTB = HALF * BK * 2  , STAGE_BYTES = 8 * HTB, NXCD = 8, WGM = 8;

__host__ __device__ __forceinline__ int lds_byte(int r, int c) { const int st = (r >> 4) * 2 + (c >> 5), rr = r & 15, cc = c & 31, ob = rr * 64 + cc * 2; return st * 1024 + (ob ^ (((ob >> 9) & 1) << 5)); }
__host__ __device__ __forceinline__ void stage_rc(int b, int& R, int& C) { const int st = b / 1024, sb = b % 1024, swz = sb ^ (((sb >> 9) & 1) << 5); R = (st >> 1) * 16 + swz / 64; C = (st & 1) * 32 + (swz % 64) / 2; }
__host__ __device__ __forceinline__ int perm32(int rho) { const int n = rho >> 4, i = rho & 15; return 8 * (i >> 2) + 4 * n + (i & 3); }

struct Unit { int pm, pn; };
struct Gemm { const bf16_t* A; const bf16_t* Bt; int M, N, K; };

struct StaticOrder {
    int nM, nN, nwg, G, c;
    __host__ __device__ void init(int M, int N, int G_, int c_) { nM = M / BM; nN = N / BM; nwg = nM * nN; G = G_; c = c_; }
    __host__ __device__ bool next(int i, Unit& u) const {
        const long L = (long)i * G + c; if (L >= nwg) return false;
        int wgid = (int)L; { const int q = nwg / NXCD, r = nwg % NXCD, xcd = wgid % NXCD, off = wgid / NXCD; wgid = (xcd < r ? xcd * (q + 1) : r * (q + 1) + (xcd - r) * q) + off; }
        const int nig = WGM * nN, gid = wgid / nig, fm = gid * WGM, gsz = (nM - fm) < WGM ? (nM - fm) : WGM;
        u.pm = fm + ((wgid % nig) % gsz); u.pn = (wgid % nig) / gsz; return true;
    }
    __device__ __forceinline__ void a_ready(const Unit&) const {}
    __device__ __forceinline__ void done(const Unit&) const {}
};
}


namespace pg9 {
using pg8::BM; using pg8::BK; using pg8::HALF; using pg8::HTB; using pg8::lds_byte; using pg8::stage_rc; using pg8::perm32;
struct Unit { int pm, pn, e; };
typedef int v8i_t __attribute__((ext_vector_type(8)));
typedef int v4i_t __attribute__((ext_vector_type(4)));
template <int ESZ, class Epi, class Sched, class AOff, class BBase>
__device__ __forceinline__ void gemm_phase(LAS unsigned char* lds, const char* Abase, int K, const Sched& S, const Epi& E, const AOff& aoffn, const BBase& bbase) {
    int tid_ = threadIdx.x; asm volatile("" : "+v"(tid_));
    const int tid = tid_, wid = __builtin_amdgcn_readfirstlane(tid >> 6), lane = tid & 63, wr = wid >> 2, wc = wid & 3, fr = lane & 15, fq = lane >> 4;
    const int nt = K * ESZ / (BK * 2);
    int Rr[2], Cc[2]; unsigned voffB[2];
#pragma unroll
    for (int i = 0; i < 2; ++i) { int R, C; stage_rc(tid * 16 + i * 8192, R, C); const int Rb = Epi::PERM ? ((R & ~31) + perm32(R & 31)) : R; Rr[i] = R; Cc[i] = C; voffB[i] = (unsigned)(Rb * K * ESZ + C * 2); }
    const size_t kstep = (size_t)(BK * 2);
    const size_t hstep = (size_t)HALF * K * ESZ;
    const unsigned ldsw = (unsigned)wid * 1024u;
    const int aoff = lds_byte(wr * 64 + fr, fq * 8), boff = lds_byte(wc * 32 + fr, fq * 8);
#define PG9_SA(b, h) (((b) * 2 + (h)) * HTB)
#define PG9_SB(b, h) ((4 + (b) * 2 + (h)) * HTB)
#define PG9_STAGE(bufoff, gbase, voff) do { _Pragma("unroll") for (int _i = 0; _i < 2; ++_i) \
        __builtin_amdgcn_global_load_lds((const unsigned*)((const char*)(gbase) + (voff)[_i]), (LAS unsigned*)(lds + (bufoff) + ldsw + _i * 8192), 16, 0, 0); } while (0)
#define PG9_LDA(dst, b, h) do { _Pragma("unroll") for (int m = 0; m < 4; ++m) { dst[m].lo = *(const LAS v4i_t*)(lds + PG9_SA(b, h) + aoff + m * 2048); dst[m].hi = *(const LAS v4i_t*)(lds + PG9_SA(b, h) + aoff + m * 2048 + 1024); } } while (0)
#define PG9_LDB(dst, b, h) do { _Pragma("unroll") for (int n = 0; n < 2; ++n) { dst[n].lo = *(const LAS v4i_t*)(lds + PG9_SB(b, h) + boff + n * 2048); dst[n].hi = *(const LAS v4i_t*)(lds + PG9_SB(b, h) + boff + n * 2048 + 1024); } } while (0)
#define PG9_HALF(v, o) __builtin_bit_cast(bf16x8, __builtin_shufflevector((v), (v), (o), (o) + 1, (o) + 2, (o) + 3))
#define PG9_MMA(ai, bj, At, Bt) do { __builtin_amdgcn_s_setprio(1); _Pragma("unroll") for (int m = 0; m < 4; ++m) _Pragma("unroll") for (int n = 0; n < 2; ++n) { \
        if (ESZ == 2) { acc[ai][bj][m][n] = __builtin_amdgcn_mfma_f32_16x16x32_bf16(PG9_HALF(Bt[n], 0), PG9_HALF(At[m], 0), acc[ai][bj][m][n], 0, 0, 0); \
                        acc[ai][bj][m][n] = __builtin_amdgcn_mfma_f32_16x16x32_bf16(PG9_HALF(Bt[n], 4), PG9_HALF(At[m], 4), acc[ai][bj][m][n], 0, 0, 0); } \
        else { asm volatile("v_mfma_scale_f32_16x16x128_f8f6f4 %0, %1, %2, %0, %3, %3 op_sel_hi:[0,0,0]" : "+v"(acc[ai][bj][m][n]) : "v"(Bt[n]), "v"(At[m]), "v"(one8)); } } \
        __builtin_amdgcn_s_setprio(0); } while (0)
#define PG9_WAIT_V(n) asm volatile("s_waitcnt vmcnt(" #n ")" ::: "memory")
#define PG9_WAIT_L(n) asm volatile("s_waitcnt lgkmcnt(" #n ")" ::: "memory")
#define PG9_BAR __builtin_amdgcn_s_barrier()
#define PG9_SCHED __builtin_amdgcn_sched_barrier(0)
#define PG9_VA(dst, u) do { _Pragma("unroll") for (int _h = 0; _h < 2; ++_h) _Pragma("unroll") for (int _i = 0; _i < 2; ++_i) dst[_h][_i] = aoffn((u), _h * HALF + Rr[_i]) + (unsigned)(Cc[_i] * 2); } while (0)
    constexpr bool GATHER = AOff::GATHER;
    const size_t hstepA = (size_t)HALF * aoffn.rowbytes;
    unsigned voffA[2];
#pragma unroll
    for (int i = 0; i < 2; ++i) voffA[i] = (unsigned)Rr[i] * aoffn.rowbytes + (unsigned)(Cc[i] * 2);
#define PG9_STAGE_A(bufoff, h, koff, nx) do { if (GATHER) { PG9_STAGE(bufoff, Abase + (koff), ((nx) ? nvA[h] : cvA[h])); } else { PG9_STAGE(bufoff, ((nx) ? nAu : cAu) + (h) * hstepA + (koff), voffA); } } while (0)
    Unit cur, nxt; int ui = 0;
    if (!S.next(0, cur)) return;
    f32x4 acc[2][2][4][2];
#pragma unroll
    for (int a = 0; a < 2; ++a)
#pragma unroll
        for (int b = 0; b < 2; ++b)
#pragma unroll
            for (int m = 0; m < 4; ++m)
#pragma unroll
                for (int n = 0; n < 2; ++n) acc[a][b][m][n] = (f32x4){0.f, 0.f, 0.f, 0.f};
    int one8 = 0x7f7f7f7f; asm volatile("" : "+v"(one8));
    v8i_t At[4], B0[2], B1[2];
    unsigned cvA[2][2], nvA[2][2];
    if (GATHER) { PG9_VA(cvA, cur); }
    const char* cAu = GATHER ? Abase : Abase + (size_t)aoffn(cur, 0); const char* nAu = cAu;
    const char* cB = bbase(cur);
    PG9_STAGE(PG9_SB(0, 0), cB, voffB); PG9_STAGE(PG9_SB(0, 1), cB + hstep, voffB); PG9_STAGE_A(PG9_SA(0, 0), 0, 0, false); PG9_STAGE_A(PG9_SA(0, 1), 1, 0, false);
    if (wr == 1) PG9_BAR;
    PG9_WAIT_V(2); PG9_BAR;
    PG9_STAGE(PG9_SB(1, 0), cB + kstep, voffB); PG9_STAGE_A(PG9_SA(1, 0), 0, kstep, false); PG9_STAGE(PG9_SB(1, 1), cB + hstep + kstep, voffB);
    PG9_WAIT_V(6); PG9_BAR;
    for (;;) {
        const bool has_next = S.next(ui + 1, nxt);
        if (GATHER) {
            if (has_next) { PG9_VA(nvA, nxt); } else {
#pragma unroll
                for (int _h = 0; _h < 2; ++_h)
#pragma unroll
                    for (int _i = 0; _i < 2; ++_i) nvA[_h][_i] = cvA[_h][_i]; }
        } else nAu = has_next ? Abase + (size_t)aoffn(nxt, 0) : cAu;
        const char* nB = has_next ? bbase(nxt) : cB;
#pragma unroll 1
        for (int t = 0; t < nt; t += 2) {
            const bool last = (t == nt - 2);
            if (Epi::HOOK_T >= 0) { if (t == Epi::HOOK_T) E.hook(acc, cur, wr, wc, fr, fq); }
            const size_t k1 = (size_t)(t + 1) * kstep, k2 = last ? 0 : (size_t)(t + 2) * kstep, k3 = k2 + kstep;
            const char* b2 = last ? nB : cB + (size_t)(t + 2) * kstep; const char* b3 = b2 + kstep;
            PG9_LDB(B0, 0, 0); PG9_LDB(B1, 0, 1); PG9_SCHED; PG9_LDA(At, 0, 0); PG9_STAGE_A(PG9_SA(1, 1), 1, k1, false);
            PG9_WAIT_V(8); PG9_WAIT_L(0); PG9_BAR; PG9_MMA(0, 0, At, B0); PG9_MMA(0, 1, At, B1); PG9_BAR; PG9_SCHED;
            PG9_LDA(At, 0, 1); PG9_STAGE(PG9_SB(0, 0), b2, voffB); PG9_STAGE(PG9_SB(0, 1), b2 + hstep, voffB); PG9_STAGE_A(PG9_SA(0, 0), 0, k2, last);
            PG9_WAIT_V(8); PG9_WAIT_L(0); PG9_BAR; PG9_MMA(1, 0, At, B0); PG9_MMA(1, 1, At, B1); PG9_BAR; PG9_SCHED;
            PG9_LDB(B0, 1, 0); PG9_LDB(B1, 1, 1); PG9_SCHED; PG9_LDA(At, 1, 0); PG9_STAGE_A(PG9_SA(0, 1), 1, k2, last);
            PG9_WAIT_V(8); PG9_WAIT_L(0); PG9_BAR; PG9_MMA(0, 0, At, B0); PG9_MMA(0, 1, At, B1); PG9_BAR; PG9_SCHED;
            PG9_LDA(At, 1, 1); PG9_STAGE(PG9_SB(1, 0), b3, voffB); PG9_STAGE(PG9_SB(1, 1), b3 + hstep, voffB); PG9_STAGE_A(PG9_SA(1, 0), 0, k3, last);
            PG9_WAIT_V(8); PG9_WAIT_L(0); PG9_BAR; PG9_MMA(1, 0, At, B0); PG9_MMA(1, 1, At, B1); PG9_BAR; PG9_SCHED;
        }
        if (wr == 0) PG9_BAR;
        if (ESZ == 1) asm volatile("s_nop 15\n\ts_nop 15" ::: "memory");
        E(acc, cur, wr, wc, fr, fq);
        if (!has_next) break;
#pragma unroll
        for (int a = 0; a < 2; ++a)
#pragma unroll
            for (int b = 0; b < 2; ++b)
#pragma unroll
                for (int m = 0; m < 4; ++m)
#pragma unroll
                    for (int n = 0; n < 2; ++n) acc[a][b][m][n] = (f32x4){0.f, 0.f, 0.f, 0.f};
        cur = nxt; cB = nB; cAu = nAu; ++ui;
        if (GATHER) {
#pragma unroll
            for (int _h = 0; _h < 2; ++_h)
#pragma unroll
                for (int _i = 0; _i < 2; ++_i) cvA[_h][_i] = nvA[_h][_i]; }
        if (wr == 1) PG9_BAR;
    }
    PG9_WAIT_V(0);
    PG9_BAR;
#undef PG9_SA
#undef PG9_SB
#undef PG9_STAGE
#undef PG9_LDA
#undef PG9_LDB
#undef PG9_MMA
#undef PG9_HALF
#undef PG9_WAIT_V
#undef PG9_WAIT_L
#undef PG9_BAR
#undef PG9_SCHED
#undef PG9_VA
#undef PG9_STAGE_A
}
struct DenseOrder { pg8::StaticOrder so;
    __device__ void init(int M, int N, int G, int c) { so.init(M, N, G, c); }
    __device__ bool next(int i, Unit& u) const { pg8::Unit v; if (!so.next(i, v)) return false; u.pm = v.pm; u.pn = v.pn; u.e = 0; return true; } };
struct DenseA { static constexpr bool GATHER = false; unsigned rowbytes; __device__ __forceinline__ unsigned operator()(const Unit& u, int row) const { return (unsigned)(u.pm * 256 + row) * rowbytes; } };
struct DenseB { const char* Bt; size_t tilebytes; __device__ __forceinline__ const char* operator()(const Unit& u) const { return Bt + (size_t)u.pn * tilebytes; } };
}

struct EpiInproj {
    static constexpr bool PERM = true; static constexpr int HOOK_T = -1;
    bf16* ZA; bf16* ZB; bf16* Gt; const float* bias; const float* invf; unsigned char* wsb;
    __device__ __forceinline__ void hook(f32x4 (&)[2][2][4][2], const pg9::Unit&, int, int, int, int) const {}
    __device__ __forceinline__ void operator()(const f32x4 (&acc)[2][2][4][2], const pg9::Unit& u, int wr, int wc, int fr, int fq) const {
        asm volatile("" : "+v"(fr), "+v"(fq));
        const int row0 = u.pm * 256 + wr * 64 + fr;
        const int q = 4 * (wc & 1) + fq;
        const int fr2 = (fr >> 2) + 4 * fq, fq2 = fr & 3, paddr = 4 * (16 * (fr & 3) + 4 * fq + (fr >> 2));
        const int row0s = u.pm * 256 + wr * 64 + fr2;
        int kind[2]; bf16* dst[2]; int ldd[2]; f32x4 b0[2], b1[2];
#pragma unroll
        for (int bj = 0; bj < 2; ++bj) {
            const int colpos = u.pn * 256 + bj * 128 + wc * 32 + 8 * fq, colposs = u.pn * 256 + bj * 128 + wc * 32 + 8 * fq2, hb = u.pn * 256 + bj * 128 + (wc >> 1) * 64;
            if (hb < A_W) { kind[bj] = hb / 1536; dst[bj] = ZA + colposs; ldd[bj] = A_W; }
            else if (hb < A_W + B_W) { const int cb = hb - A_W; kind[bj] = cb < 1024 ? 0 : (cb < 1152 ? 1 : 2); dst[bj] = ZB + (colposs - A_W); ldd[bj] = B_W; }
            else { kind[bj] = 3; const int c0 = (colpos - A_W - B_W) >> 1;
                dst[bj] = Gt + ((size_t)((u.pm * 256 + wr * 64) >> 4) * 256 + (c0 >> 3)) * 128 + fr * 8 + (c0 & 7); ldd[bj] = 0; }
            b0[bj] = *(const f32x4*)(bias + (kind[bj] < 2 ? hb + 4 * q : (kind[bj] == 3 ? A_W + B_W + ((colpos - A_W - B_W) >> 1) : colpos)));
            b1[bj] = *(const f32x4*)(bias + (kind[bj] < 2 ? hb + 32 + 4 * q : (kind[bj] == 3 ? A_W + B_W + 1024 + ((colpos - A_W - B_W) >> 1) : colpos + 4)));
        }
        const bool need_rope = kind[0] < 2 || kind[1] < 2;
        const f32x4 fv = *(const f32x4*)(invf + 4 * q);
#pragma unroll
        for (int ai = 0; ai < 2; ++ai) {
            f32x4 rc[4], rs[4];
#pragma unroll
            for (int m = 0; m < 4; ++m) { rc[m] = (f32x4){1.f, 1.f, 1.f, 1.f}; rs[m] = (f32x4){0.f, 0.f, 0.f, 0.f}; }
            if (need_rope) {
#pragma unroll
                for (int m = 0; m < 4; ++m) { const float posf = (float)((row0 + ai * 128 + m * 16) & (SEQ - 1));
#pragma unroll
                    for (int e = 0; e < 4; ++e) { const float ang = posf * fv[e]; const float pr = ang * 0.15915494f; const float er = __builtin_fmaf(ang, 0.15915494f, -pr) + ang * 6.4206382e-9f;
                        const float fr = __builtin_amdgcn_fractf(pr) + er; rc[m][e] = __builtin_amdgcn_cosf(fr); rs[m][e] = __builtin_amdgcn_sinf(fr); } }
            }
#pragma unroll
            for (int bj = 0; bj < 2; ++bj) {
                bf16* p = dst[bj] + (unsigned)(row0s + ai * 128) * (unsigned)ldd[bj]; const unsigned step = 16u * (unsigned)ldd[bj];
                if (kind[bj] == 3) p = dst[bj] + (size_t)(ai * 8) * 32768;
                switch (kind[bj]) {
                    case 0: store4<0>(acc[ai][bj], b0[bj], b1[bj], rc, rs, p, step, paddr); break;
                    case 1: store4<1>(acc[ai][bj], b0[bj], b1[bj], rc, rs, p, step, paddr); break;
                    case 2: store4<2>(acc[ai][bj], b0[bj], b1[bj], rc, rs, p, step, paddr); break;
                    default: store4<3>(acc[ai][bj], b0[bj], b1[bj], rc, rs, p, step, paddr); break;
                }
            }
        }
    }
    template <int KIND> static __device__ __forceinline__ void store4(const f32x4 (&a)[4][2], const f32x4 b0, const f32x4 b1, const f32x4 (&rc)[4], const f32x4 (&rs)[4], bf16* p, const unsigned step, const int paddr) {
#pragma unroll
        for (int m = 0; m < 4; ++m) {
            f32x4 v0 = a[m][0] * W8_INV + b0, v1 = a[m][1] * W8_INV + b1;
            if (KIND < 2) {
                const f32x4 cc = rc[m], ss = rs[m];
                const f32x4 t0 = v0 * cc - v1 * ss, t1 = v1 * cc + v0 * ss;
                v0 = t0; v1 = t1;
                if (KIND == 0) { v0 = v0 * QSCALE; v1 = v1 * QSCALE; }
            }
            if (KIND == 3) {
#pragma unroll
                for (int e = 0; e < 4; ++e) { const float d0 = 1.0f + __expf(-v0[e]), d1 = 1.0f + __expf(-v1[e]); v0[e] = d1 * __builtin_amdgcn_rcpf(d0); v1[e] = __builtin_amdgcn_rcpf(d1); }
                v2u w0, w1; w0.x = cvtpk(v0[0], v0[1]); w0.y = cvtpk(v0[2], v0[3]); w1.x = cvtpk(v1[0], v1[1]); w1.y = cvtpk(v1[2], v1[3]);
                *(GAS v2u*)p = w0; *(GAS v2u*)(p + 128 * 128) = w1; p += 32768;
            } else {
                v4u w; w.x = cvtpk(v0[0], v0[1]); w.y = cvtpk(v0[2], v0[3]); w.z = cvtpk(v1[0], v1[1]); w.w = cvtpk(v1[2], v1[3]);
                w.x = (unsigned)__builtin_amdgcn_ds_bpermute(paddr, (int)w.x); w.y = (unsigned)__builtin_amdgcn_ds_bpermute(paddr, (int)w.y); w.z = (unsigned)__builtin_amdgcn_ds_bpermute(paddr, (int)w.z); w.w = (unsigned)__builtin_amdgcn_ds_bpermute(paddr, (int)w.w);
                *(GAS v4u*)p = w; p += step;
            }
        }
    }
};
__device__ __forceinline__ void p1_inproj(Frame& F, int ch) {
    unsigned char* ws = F.ws;
    pg9::DenseOrder S; S.init(TC, NIN, F.G, (int)blockIdx.x);
    EpiInproj E{(bf16*)(ws + WS_ZA), (bf16*)(ws + WS_ZB), (bf16*)(ws + WS_G) + (size_t)ch * TC * G_W, F.in[I_BIN], (const float*)(ws + WS_INVF), ws};
    constexpr int ES = P1_FP8 ? 1 : 2;
    pg9::DenseA ao{(unsigned)(D * ES)}; pg9::DenseB bb{(const char*)(ws + WS_WIN), (size_t)256 * D * ES};
    pg9::gemm_phase<ES>(F.lds, (const char*)F.out + DO_HN + (size_t)ch * TC * D * ES, D, S, E, ao, bb);
}

typedef float f32x16 __attribute__((ext_vector_type(16)));
typedef short v4i16_t __attribute__((ext_vector_type(4)));
__device__ __forceinline__ float half_max(float v) { auto rr = __builtin_amdgcn_permlane32_swap(__float_as_uint(v), __float_as_uint(v), false, false); return fmaxf(__uint_as_float(rr[0]), __uint_as_float(rr[1])); }
__device__ __forceinline__ float half_sum(float v) { auto rr = __builtin_amdgcn_permlane32_swap(__float_as_uint(v), __float_as_uint(v), false, false); return __uint_as_float(rr[0]) + __uint_as_float(rr[1]); }
__device__ __forceinline__ float max3f(float a, float b, float c) { float r; asm("v_max3_f32 %0, %1, %2, %3" : "=v"(r) : "v"(a), "v"(b), "v"(c)); return r; }
constexpr int ATT_VOFF = 49152;

struct AUnit { const bf16 *Kw, *Vw, *Qp; size_t pitch; int kk_lo, nkeys, kb0, kstart, lo; float m0, l0; bf16* Op; float* Lp; int o8; };
__device__ __forceinline__ void attn_decode(Frame& F, int ch, int u, int NUA, int lane, AUnit& d) {
    unsigned char* ws = F.ws;
    const int w = F.wave, c = lane & 31, h = (lane >> 5) & 1;
    if (u < NUA) {
        const bf16* ZA = (const bf16*)(ws + WS_ZA);
        const int rt = u & 15, hh = (u >> 4) & 7, gb = u >> 7, g = gb % 3, bl = gb / 3;
        const int dsh = 2 * g, dd = 1 << dsh, tsh = 4 - dsh;
        const int r = rt >> tsh, tile = rt & ((1 << tsh) - 1), i0 = tile * 256;
        const int rowb = bl * SEQ + r, col = g * 512 + hh * 64;
        d.pitch = (size_t)dd * A_W;
        d.Kw = ZA + ((long)rowb + (long)dd * (i0 - 128)) * A_W + 1536 + col; d.Vw = d.Kw + 1536;
        const long qrow = (long)rowb + (long)dd * (i0 + 32 * w + c);
        d.Qp = ZA + qrow * A_W + col;
        d.kk_lo = (i0 == 0) ? 128 : 0; d.nkeys = 384; d.kb0 = w; d.kstart = (i0 == 0) ? (w < 4 ? 4 - w : 0) : 0; d.lo = 0;
        d.m0 = -1e30f; d.l0 = 0.f;
        d.Op = (bf16*)((unsigned char*)F.out + DO_OG) + ((size_t)g * TC + qrow) * 512 + hh * 64;
        d.Lp = (float*)((unsigned char*)F.out + DO_LSE) + ((size_t)g * TC + qrow) * 8 + hh;
        d.o8 = 0;
    } else {
        const int u2 = u - NUA;
        const bf16* ZB = (const bf16*)(ws + WS_ZB);
        const int blk = u2 & 127, kvh = (u2 >> 7) & 1, bl = u2 >> 8;
        const int t0 = blk * 32, rowb = bl * SEQ;
        d.pitch = B_W;
        d.Kw = ZB + ((long)rowb + t0 - 128) * B_W + 1024 + kvh * 64; d.Vw = d.Kw + 128;
        const int qh = kvh * 8 + w;
        const long qrow = (long)rowb + t0 + c;
        d.Qp = ZB + qrow * B_W + qh * 64;
        d.kk_lo = t0 < 128 ? 128 - t0 : 0; d.nkeys = 160; d.kb0 = 0; d.kstart = d.kk_lo >> 5; d.lo = 1;
        d.m0 = F.in[I_SINK][qh] * LOG2E; d.l0 = h == 0 ? 1.f : 0.f;
        d.o8 = P34_FP8;
        d.Op = P34_FP8 ? (bf16*)(ws + WS_Y + ((size_t)ch * TC + qrow) * Y_W + 512 + qh * 64) : (bf16*)(ws + WS_Y) + ((size_t)ch * TC + qrow) * Y_W + 512 + qh * 64;
        d.Lp = nullptr;
    }
}
__device__ __forceinline__ void attn_load(const AUnit& d, int tid, int lane, v4u (&kreg)[6], v4u (&vreg)[6], bf16x8 (&qf)[4]) {
    const int skey = tid >> 3, sch = tid & 7, h = (lane >> 5) & 1;
#pragma unroll
    for (int s4 = 0; s4 < 4; ++s4) qf[s4] = *(const GAS bf16x8*)(d.Qp + 16 * s4 + 8 * h);
#pragma unroll
    for (int p = 0; p < 6; ++p) { const int kk = 64 * p + skey;
        if (kk >= d.kk_lo && kk < d.nkeys) { kreg[p] = *(const GAS v4u*)(d.Kw + (size_t)kk * d.pitch + 8 * sch); vreg[p] = *(const GAS v4u*)(d.Vw + (size_t)kk * d.pitch + 8 * sch); } }
}
__device__ __forceinline__ void attn_write(const AUnit& d, LAS unsigned char* KL, LAS unsigned char* VL, int tid, const v4u (&kreg)[6], const v4u (&vreg)[6]) {
    const int skey = tid >> 3, sch = tid & 7;
#pragma unroll
    for (int p = 0; p < 6; ++p) { const int kk = 64 * p + skey;
        if (kk >= d.kk_lo && kk < d.nkeys) {
            *(LAS v4u*)(KL + kk * 128 + ((sch ^ ((kk >> 1) & 7)) << 4)) = kreg[p];
            *(LAS v4u*)(VL + kk * 128 + ((sch * 16) ^ (((kk >> 1) & 1) << 6))) = vreg[p]; } }
}
__device__ __forceinline__ void attn_compute_edge(const AUnit& d, const LAS unsigned char* KL, const LAS unsigned char* VL, int lane, const bf16x8 (&qf)[4]) {
    const int c = lane & 31, h = (lane >> 5) & 1;
    int koff[4];
    { const int kswz = (c >> 1) & 7;
#pragma unroll
      for (int s4 = 0; s4 < 4; ++s4) koff[s4] = c * 128 + (((2 * s4 + h) ^ kswz) << 4); }
    const int vrow = 4 * h + ((lane & 15) >> 2), vsw = (lane >> 3) & 1;
    const int voff0 = vrow * 128 + ((32 * ((lane >> 4) & 1) + 8 * (lane & 3)) ^ (vsw << 6)), voff1 = voff0 ^ 64;
    const float NEG = -INFINITY;
    float m = d.m0, l = d.l0;
    f32x16 o0, o1;
#pragma unroll
    for (int i = 0; i < 16; ++i) { o0[i] = 0.f; o1[i] = 0.f; }
    const LAS unsigned char* kbp = KL + d.kb0 * 4096; const LAS unsigned char* vbp = VL + d.kb0 * 4096;
    const int clo = c + d.lo;
#pragma unroll
    for (int kbi = 0; kbi < 5; ++kbi) {
        if (kbi >= d.kstart) {
            f32x16 p;
#pragma unroll
            for (int i = 0; i < 16; ++i) p[i] = 0.f;
#pragma unroll
            for (int s4 = 0; s4 < 4; ++s4) { const bf16x8 kf = *(const LAS bf16x8*)(kbp + kbi * 4096 + koff[s4]); p = __builtin_amdgcn_mfma_f32_32x32x16_bf16(kf, qf[s4], p, 0, 0, 0); }
            if (kbi == 0) {
#pragma unroll
                for (int i = 0; i < 16; ++i) { const int x = (i & 3) + 8 * (i >> 2) + 4 * h; if (x < clo) p[i] = NEG; }
            }
            if (kbi == 4) {
#pragma unroll
                for (int i = 0; i < 16; ++i) { const int x = (i & 3) + 8 * (i >> 2) + 4 * h; if (x > c) p[i] = NEG; }
            }
            float mt = p[0];
#pragma unroll
            for (int i = 1; i < 16; ++i) mt = fmaxf(mt, p[i]);
            mt = half_max(mt);
            const float mn = fmaxf(m, mt), alpha = __builtin_amdgcn_exp2f(m - mn);
            m = mn;
            float ps = 0.f;
#pragma unroll
            for (int i = 0; i < 16; ++i) { p[i] = __builtin_amdgcn_exp2f(p[i] - mn); ps += p[i]; }
            l = l * alpha + ps;
#pragma unroll
            for (int i = 0; i < 16; ++i) { o0[i] *= alpha; o1[i] *= alpha; }
            bf16x8 pb[2];
#pragma unroll
            for (int s2 = 0; s2 < 2; ++s2) { v4u t; t.x = cvtpk(p[8 * s2 + 0], p[8 * s2 + 1]); t.y = cvtpk(p[8 * s2 + 2], p[8 * s2 + 3]); t.z = cvtpk(p[8 * s2 + 4], p[8 * s2 + 5]); t.w = cvtpk(p[8 * s2 + 6], p[8 * s2 + 7]); pb[s2] = __builtin_bit_cast(bf16x8, t); }
#pragma unroll
            for (int s2 = 0; s2 < 2; ++s2) {
#pragma unroll
                for (int db = 0; db < 2; ++db) {
                    const LAS unsigned char* vp = vbp + kbi * 4096 + s2 * 2048 + (db ? voff1 : voff0);
                    const v4i16_t lo = __builtin_amdgcn_ds_read_tr16_b64_v4i16((LAS v4i16_t*)vp);
                    const v4i16_t hi = __builtin_amdgcn_ds_read_tr16_b64_v4i16((LAS v4i16_t*)(vp + 1024));
                    const bf16x8 vf = {lo[0], lo[1], lo[2], lo[3], hi[0], hi[1], hi[2], hi[3]};
                    if (db == 0) o0 = __builtin_amdgcn_mfma_f32_32x32x16_bf16(vf, pb[s2], o0, 0, 0, 0);
                    else o1 = __builtin_amdgcn_mfma_f32_32x32x16_bf16(vf, pb[s2], o1, 0, 0, 0);
                }
            }
        }
    }
    const float lt = half_sum(l), inv = 1.0f / lt;
#pragma unroll
    for (int g4 = 0; g4 < 4; ++g4) {
        v2u a, b;
        a.x = cvtpk(o0[4 * g4 + 0] * inv, o0[4 * g4 + 1] * inv); a.y = cvtpk(o0[4 * g4 + 2] * inv, o0[4 * g4 + 3] * inv);
        b.x = cvtpk(o1[4 * g4 + 0] * inv, o1[4 * g4 + 1] * inv); b.y = cvtpk(o1[4 * g4 + 2] * inv, o1[4 * g4 + 3] * inv);
        if (d.o8) { unsigned char* o8p = (unsigned char*)d.Op; const float sc = inv * Y8_SCALE;
            *(GAS unsigned*)(o8p + 8 * g4 + 4 * h) = pk4_fp8(o0[4 * g4 + 0] * sc, o0[4 * g4 + 1] * sc, o0[4 * g4 + 2] * sc, o0[4 * g4 + 3] * sc);
            *(GAS unsigned*)(o8p + 32 + 8 * g4 + 4 * h) = pk4_fp8(o1[4 * g4 + 0] * sc, o1[4 * g4 + 1] * sc, o1[4 * g4 + 2] * sc, o1[4 * g4 + 3] * sc); }
        else {
        *(GAS v2u*)(d.Op + 8 * g4 + 4 * h) = a;
        *(GAS v2u*)(d.Op + 32 + 8 * g4 + 4 * h) = b; }
    }
    if (d.Lp) { if (h == 0) *d.Lp = m + __builtin_amdgcn_logf(lt); }
}
__device__ __forceinline__ void attn_compute(const AUnit& d, const LAS unsigned char* KL, const LAS unsigned char* VL, int lane, const bf16x8 (&qf)[4]) {
    const int c = lane & 31, h = (lane >> 5) & 1;
    int koff[4];
    { const int kswz = (c >> 1) & 7;
#pragma unroll
      for (int s4 = 0; s4 < 4; ++s4) koff[s4] = c * 128 + (((2 * s4 + h) ^ kswz) << 4); }
    const int vrow = 4 * h + ((lane & 15) >> 2), vsw = (lane >> 3) & 1;
    const int voff0 = vrow * 128 + ((32 * ((lane >> 4) & 1) + 8 * (lane & 3)) ^ (vsw << 6)), voff1 = voff0 ^ 64;
    const float NEG = -INFINITY;
    float m = d.m0;
    f32x16 o0, o1, L;
#pragma unroll
    for (int i = 0; i < 16; ++i) { o0[i] = 0.f; o1[i] = 0.f; L[i] = 0.f; }
    v4u onesu = {0x3F803F80u, 0x3F803F80u, 0x3F803F80u, 0x3F803F80u}; asm volatile("" : "+v"(onesu));
    const bf16x8 ones = __builtin_bit_cast(bf16x8, onesu);
    const LAS unsigned char* kbp = KL + d.kb0 * 4096; const LAS unsigned char* vbp = VL + d.kb0 * 4096;
    const int clo = c + d.lo;
#pragma unroll
    for (int kbi = 0; kbi < 5; ++kbi) {
        {
            constexpr bool first_dummy = false; (void)first_dummy;
            const bool first = (kbi == 0);
            const float cinit = first ? 0.f : -m;
            f32x16 p;
#pragma unroll
            for (int i = 0; i < 16; ++i) p[i] = cinit;
#pragma unroll
            for (int s4 = 0; s4 < 4; ++s4) { const bf16x8 kf = *(const LAS bf16x8*)(kbp + kbi * 4096 + koff[s4]); p = __builtin_amdgcn_mfma_f32_32x32x16_bf16(kf, qf[s4], p, 0, 0, 0); }
            if (kbi == 0) {
#pragma unroll
                for (int i = 0; i < 16; ++i) { const int x = (i & 3) + 8 * (i >> 2) + 4 * h; p[i] = x < clo ? NEG : p[i]; }
            }
            if (kbi == 4) {
#pragma unroll
                for (int i = 0; i < 16; ++i) { const int x = (i & 3) + 8 * (i >> 2) + 4 * h; p[i] = x > c ? NEG : p[i]; }
            }
            float t0 = max3f(p[0], p[4], p[8]), t1 = max3f(p[1], p[5], p[9]), t2 = max3f(p[2], p[6], p[10]), t3 = max3f(p[3], p[7], p[11]);
            t0 = max3f(t0, p[12], p[13]); t1 = max3f(t1, p[14], p[15]);
            const float mt = half_max(max3f(max3f(t0, t1, t2), t3, t3));
            if (first) {
                const float mn = fmaxf(m, mt), l0 = d.m0 > -1e29f ? __builtin_amdgcn_exp2f(m - mn) : 0.f;
                m = mn;
#pragma unroll
                for (int i = 0; i < 16; ++i) { p[i] -= mn; L[i] = l0; }
            } else if (__any(mt > 8.0f)) {
                const float dl = fmaxf(mt, 0.f), al = __builtin_amdgcn_exp2f(-dl);
                m += dl;
#pragma unroll
                for (int i = 0; i < 16; ++i) { o0[i] *= al; o1[i] *= al; L[i] *= al; p[i] -= dl; }
            }
#pragma unroll
            for (int i = 0; i < 16; ++i) p[i] = __builtin_amdgcn_exp2f(p[i]);
            bf16x8 pb[2];
#pragma unroll
            for (int s2 = 0; s2 < 2; ++s2) { v4u t; t.x = cvtpk(p[8 * s2 + 0], p[8 * s2 + 1]); t.y = cvtpk(p[8 * s2 + 2], p[8 * s2 + 3]); t.z = cvtpk(p[8 * s2 + 4], p[8 * s2 + 5]); t.w = cvtpk(p[8 * s2 + 6], p[8 * s2 + 7]); pb[s2] = __builtin_bit_cast(bf16x8, t); }
#pragma unroll
            for (int s2 = 0; s2 < 2; ++s2) {
                L = __builtin_amdgcn_mfma_f32_32x32x16_bf16(ones, pb[s2], L, 0, 0, 0);
#pragma unroll
                for (int db = 0; db < 2; ++db) {
                    const LAS unsigned char* vp = vbp + kbi * 4096 + s2 * 2048 + (db ? voff1 : voff0);
                    const v4i16_t lo = __builtin_amdgcn_ds_read_tr16_b64_v4i16((LAS v4i16_t*)vp);
                    const v4i16_t hi = __builtin_amdgcn_ds_read_tr16_b64_v4i16((LAS v4i16_t*)(vp + 1024));
                    const bf16x8 vf = {lo[0], lo[1], lo[2], lo[3], hi[0], hi[1], hi[2], hi[3]};
                    if (db == 0) o0 = __builtin_amdgcn_mfma_f32_32x32x16_bf16(vf, pb[s2], o0, 0, 0, 0);
                    else o1 = __builtin_amdgcn_mfma_f32_32x32x16_bf16(vf, pb[s2], o1, 0, 0, 0);
                }
            }
        }
    }
    const float lt = L[0], inv = 1.0f / lt;
#pragma unroll
    for (int g4 = 0; g4 < 4; ++g4) {
        v2u a, b;
        a.x = cvtpk(o0[4 * g4 + 0] * inv, o0[4 * g4 + 1] * inv); a.y = cvtpk(o0[4 * g4 + 2] * inv, o0[4 * g4 + 3] * inv);
        b.x = cvtpk(o1[4 * g4 + 0] * inv, o1[4 * g4 + 1] * inv); b.y = cvtpk(o1[4 * g4 + 2] * inv, o1[4 * g4 + 3] * inv);
        if (d.o8) { unsigned char* o8p = (unsigned char*)d.Op; const float sc = inv * Y8_SCALE;
            *(GAS unsigned*)(o8p + 8 * g4 + 4 * h) = pk4_fp8(o0[4 * g4 + 0] * sc, o0[4 * g4 + 1] * sc, o0[4 * g4 + 2] * sc, o0[4 * g4 + 3] * sc);
            *(GAS unsigned*)(o8p + 32 + 8 * g4 + 4 * h) = pk4_fp8(o1[4 * g4 + 0] * sc, o1[4 * g4 + 1] * sc, o1[4 * g4 + 2] * sc, o1[4 * g4 + 3] * sc); }
        else {
        *(GAS v2u*)(d.Op + 8 * g4 + 4 * h) = a;
        *(GAS v2u*)(d.Op + 32 + 8 * g4 + 4 * h) = b; }
    }
    if (d.Lp) { if (h == 0) *d.Lp = m + __builtin_amdgcn_logf(lt); }
}
__device__ __forceinline__ void p2_attn(Frame& F, int ch) {
    int tid_ = threadIdx.x; asm volatile("" : "+v"(tid_));
    const int tid = tid_, lane = tid & 63;
    LAS unsigned char* KL = F.lds; LAS unsigned char* VL = F.lds + ATT_VOFF;
    constexpr int NUA = (TC / SEQ) * 3 * 8 * 16, NUB = (TC / SEQ) * 2 * 128, NU = NUA + NUB;
    int u = F.vcu;
    if (u >= NU) return;
    AUnit cur, nxt;
    v4u kreg[6], vreg[6]; bf16x8 qn[4];
    attn_decode(F, ch, u, NUA, lane, cur);
    attn_load(cur, tid, lane, kreg, vreg, qn);
    for (;;) {
        attn_write(cur, KL, VL, tid, kreg, vreg);
        bf16x8 qf[4];
#pragma unroll
        for (int s4 = 0; s4 < 4; ++s4) qf[s4] = qn[s4];
        __syncthreads();
        const int un = u + F.G; const bool has_next = un < NU;
        if (has_next) { attn_decode(F, ch, un, NUA, lane, nxt); attn_load(nxt, tid, lane, kreg, vreg, qn); }
        if (cur.kk_lo == 0) attn_compute(cur, KL, VL, lane, qf); else attn_compute_edge(cur, KL, VL, lane, qf);
        __syncthreads();
        if (!has_next) break;
        cur = nxt; u = un;
    }
}
__device__ __forceinline__ void p2_combine(Frame& F, int ch, int cu, int ncu) {
    int tid_ = threadIdx.x; asm volatile("" : "+v"(tid_)); const int lane_ = tid_ & 63;
    unsigned char* ws = F.ws;
    const bf16* OG = (const bf16*)((const unsigned char*)F.out + DO_OG); const float* LSE = (const float*)((const unsigned char*)F.out + DO_LSE);
    bf16* Y = (bf16*)(ws + WS_Y) + (size_t)ch * TC * Y_W; unsigned char* Y8 = ws + WS_Y + (size_t)ch * TC * Y_W;
    const int lane = lane_, hd = lane >> 3;
    const int gw = cu * NWAVES + F.wave, NGW = ncu * NWAVES;
    for (int row0 = gw; row0 < TC; row0 += 4 * NGW) {
        float lg[4][3]; v4u og[4][3];
#pragma unroll
        for (int r = 0; r < 4; ++r) { const int row = row0 + r * NGW < TC ? row0 + r * NGW : row0;
#pragma unroll
            for (int g = 0; g < 3; ++g) { lg[r][g] = LSE[((size_t)g * TC + row) * 8 + hd]; og[r][g] = *(const GAS v4u*)(OG + ((size_t)g * TC + row) * 512 + lane * 8); } }
#pragma unroll
        for (int r = 0; r < 4; ++r) { const int row = row0 + r * NGW; if (row >= TC) continue;
            const float mx = fmaxf(fmaxf(lg[r][0], lg[r][1]), lg[r][2]);
            float e[3]; e[0] = __builtin_amdgcn_exp2f(lg[r][0] - mx); e[1] = __builtin_amdgcn_exp2f(lg[r][1] - mx); e[2] = __builtin_amdgcn_exp2f(lg[r][2] - mx);
            const float inv = 1.0f / (e[0] + e[1] + e[2]);
            float acc[8];
#pragma unroll
            for (int i = 0; i < 8; ++i) acc[i] = 0.f;
#pragma unroll
            for (int g = 0; g < 3; ++g) { const float wg = e[g] * inv; const v4u o_ = og[r][g];
                acc[0] += wg * bflo(o_.x); acc[1] += wg * bfhi(o_.x); acc[2] += wg * bflo(o_.y); acc[3] += wg * bfhi(o_.y);
                acc[4] += wg * bflo(o_.z); acc[5] += wg * bfhi(o_.z); acc[6] += wg * bflo(o_.w); acc[7] += wg * bfhi(o_.w); }
            v4u o; o.x = cvtpk(acc[0], acc[1]); o.y = cvtpk(acc[2], acc[3]); o.z = cvtpk(acc[4], acc[5]); o.w = cvtpk(acc[6], acc[7]);
            if (P34_FP8) { v2u o8; o8.x = pk4_fp8(acc[0] * Y8_SCALE, acc[1] * Y8_SCALE, acc[2] * Y8_SCALE, acc[3] * Y8_SCALE); o8.y = pk4_fp8(acc[4] * Y8_SCALE, acc[5] * Y8_SCALE, acc[6] * Y8_SCALE, acc[7] * Y8_SCALE); *(GAS v2u*)(Y8 + (size_t)row * Y_W + lane * 8) = o8; }
            else *(GAS v4u*)(Y + (size_t)row * Y_W + lane * 8) = o; }
    }
}


struct EpiMerge {
    static constexpr bool PERM = true; static constexpr int HOOK_T = P34_FP8 ? 4 : 8;
    const bf16* Gt; bf16* MG;
    __device__ __forceinline__ void hook(f32x4 (&acc)[2][2][4][2], const pg9::Unit& u, int wr, int wc, int fr, int fq) const {
        asm volatile("" : "+v"(fr), "+v"(fq));
        const bf16* gr = Gt + ((size_t)((u.pm * 256 + wr * 64) >> 4) * 256 + u.pn * 32 + wc * 4 + fq) * 128 + fr * 8;
        v4u rv[8][2];
#pragma unroll
        for (int rg = 0; rg < 8; ++rg)
#pragma unroll
            for (int bj = 0; bj < 2; ++bj) rv[rg][bj] = *(const GAS v4u*)(gr + (size_t)((rg >> 2) * 8 + (rg & 3)) * 32768 + bj * 16 * 128);
#pragma unroll
        for (int rg = 0; rg < 8; ++rg)
#pragma unroll
            for (int bj = 0; bj < 2; ++bj) { const v4u a = rv[rg][bj];
                const f32x4 r0 = {bflo(a.x), bfhi(a.x), bflo(a.y), bfhi(a.y)}, r1 = {bflo(a.z), bfhi(a.z), bflo(a.w), bfhi(a.w)};
                acc[rg >> 2][bj][rg & 3][0] = acc[rg >> 2][bj][rg & 3][0] * r0; acc[rg >> 2][bj][rg & 3][1] = acc[rg >> 2][bj][rg & 3][1] * r1; }
    }
    __device__ __forceinline__ void operator()(const f32x4 (&acc)[2][2][4][2], const pg9::Unit& u, int wr, int wc, int fr, int fq) const {
        asm volatile("" : "+v"(fr), "+v"(fq));
        const bf16* gr = Gt + ((size_t)((u.pm * 256 + wr * 64) >> 4) * 256 + 128 + u.pn * 32 + wc * 4 + fq) * 128 + fr * 8;
        const int fr2 = (fr >> 2) + 4 * fq, fq2 = fr & 3, paddr = 4 * (16 * (fr & 3) + 4 * fq + (fr >> 2));
        bf16* mr = MG + (size_t)(u.pm * 256 + wr * 64 + fr2) * D + u.pn * 256 + wc * 32 + 8 * fq2;
        v4u gb[8][2];
#pragma unroll
        for (int rg = 0; rg < 8; ++rg)
#pragma unroll
            for (int bj = 0; bj < 2; ++bj) gb[rg][bj] = *(const GAS v4u*)(gr + (size_t)((rg >> 2) * 8 + (rg & 3)) * 32768 + bj * 16 * 128);
#pragma unroll
        for (int rg = 0; rg < 8; ++rg)
#pragma unroll
            for (int bj = 0; bj < 2; ++bj) { const v4u b = gb[rg][bj];
                const f32x4 v0 = acc[rg >> 2][bj][rg & 3][0], v1 = acc[rg >> 2][bj][rg & 3][1];
                if (P34_FP8) { constexpr float f = MG8_SCALE / (W34_SCALE * Y8_SCALE); unsigned char* m8 = (unsigned char*)MG + (size_t)(u.pm * 256 + wr * 64 + fr2) * D + u.pn * 256 + wc * 32 + 8 * fq2;
                    v2u w8; w8.x = pk4_fp8(v0[0] * bflo(b.x) * f, v0[1] * bfhi(b.x) * f, v0[2] * bflo(b.y) * f, v0[3] * bfhi(b.y) * f); w8.y = pk4_fp8(v1[0] * bflo(b.z) * f, v1[1] * bfhi(b.z) * f, v1[2] * bflo(b.w) * f, v1[3] * bfhi(b.w) * f);
                    w8.x = (unsigned)__builtin_amdgcn_ds_bpermute(paddr, (int)w8.x); w8.y = (unsigned)__builtin_amdgcn_ds_bpermute(paddr, (int)w8.y);
                    *(GAS v2u*)(m8 + (size_t)((rg >> 2) * 128 + (rg & 3) * 16) * D + bj * 128) = w8; }
                else {
                v4u w; w.x = cvtpk(v0[0] * bflo(b.x), v0[1] * bfhi(b.x)); w.y = cvtpk(v0[2] * bflo(b.y), v0[3] * bfhi(b.y));
                w.z = cvtpk(v1[0] * bflo(b.z), v1[1] * bfhi(b.z)); w.w = cvtpk(v1[2] * bflo(b.w), v1[3] * bfhi(b.w));
                w.x = (unsigned)__builtin_amdgcn_ds_bpermute(paddr, (int)w.x); w.y = (unsigned)__builtin_amdgcn_ds_bpermute(paddr, (int)w.y); w.z = (unsigned)__builtin_amdgcn_ds_bpermute(paddr, (int)w.z); w.w = (unsigned)__builtin_amdgcn_ds_bpermute(paddr, (int)w.w);
                *(GAS v4u*)(mr + (size_t)((rg >> 2) * 128 + (rg & 3) * 16) * D + bj * 128) = w; } }
    }
};
__device__ __forceinline__ void p3_merge(Frame& F) {
    unsigned char* ws = F.ws;
    pg9::DenseOrder S; S.init(T, D, F.G, (int)blockIdx.x);
    EpiMerge E{(const bf16*)(ws + WS_G), (bf16*)(ws + WS_MG)};
    constexpr int ES = P34_FP8 ? 1 : 2;
    pg9::DenseA ao{(unsigned)(Y_W * ES)}; pg9::DenseB bb{(const char*)(ws + WS_WAB), (size_t)256 * Y_W * ES};
    pg9::gemm_phase<ES>(F.lds, (const char*)(ws + WS_Y), Y_W, S, E, ao, bb);
}
struct EpiOut {
    static constexpr bool PERM = true; static constexpr int HOOK_T = -1;
    bf16* DELTA;
    __device__ __forceinline__ void hook(f32x4 (&)[2][2][4][2], const pg9::Unit&, int, int, int, int) const {}
    __device__ __forceinline__ void operator()(const f32x4 (&acc)[2][2][4][2], const pg9::Unit& u, int wr, int wc, int fr, int fq) const {
        asm volatile("" : "+v"(fr), "+v"(fq));
        const int fr2 = (fr >> 2) + 4 * fq, fq2 = fr & 3, paddr = 4 * (16 * (fr & 3) + 4 * fq + (fr >> 2));
        bf16* orow = DELTA + (size_t)(u.pm * 256 + wr * 64 + fr2) * D + u.pn * 256 + wc * 32 + 8 * fq2;
#pragma unroll
        for (int ai = 0; ai < 2; ++ai)
#pragma unroll
            for (int m = 0; m < 4; ++m)
#pragma unroll
                for (int bj = 0; bj < 2; ++bj) { constexpr float f = P34_FP8 ? 1.0f / (W34_SCALE * MG8_SCALE) : 1.0f; const f32x4 o0 = acc[ai][bj][m][0] * f, o1 = acc[ai][bj][m][1] * f;
                    v4u w; w.x = cvtpk(o0[0], o0[1]); w.y = cvtpk(o0[2], o0[3]); w.z = cvtpk(o1[0], o1[1]); w.w = cvtpk(o1[2], o1[3]);
                    w.x = (unsigned)__builtin_amdgcn_ds_bpermute(paddr, (int)w.x); w.y = (unsigned)__builtin_amdgcn_ds_bpermute(paddr, (int)w.y); w.z = (unsigned)__builtin_amdgcn_ds_bpermute(paddr, (int)w.z); w.w = (unsigned)__builtin_amdgcn_ds_bpermute(paddr, (int)w.w);
                    *(GAS v4u*)(orow + (size_t)(ai * 128 + m * 16) * D + bj * 128) = w; }
    }
};
__device__ __forceinline__ void p4_outproj(Frame& F) {
    unsigned char* ws = F.ws;
    pg9::DenseOrder S; S.init(T, D, F.G, (int)blockIdx.x);
    EpiOut E{(bf16*)((unsigned char*)F.out + DO_DELTA)};
    constexpr int ES = P34_FP8 ? 1 : 2;
    pg9::DenseA ao{(unsigned)(D * ES)}; pg9::DenseB bb{(const char*)(ws + WS_WO), (size_t)256 * D * ES};
    pg9::gemm_phase<ES>(F.lds, (const char*)(ws + WS_MG), D, S, E, ao, bb);
}

__device__ __forceinline__ void p5_route(Frame& F) {
    int tid_ = threadIdx.x; asm volatile("" : "+v"(tid_)); const int lane = tid_ & 63;
    unsigned char* ws = F.ws;
    const float* X = F.in[I_X]; const bf16* DELTA = (const bf16*)((const unsigned char*)F.out + DO_DELTA);
    bf16* X1B = (bf16*)(ws + WS_X1B); unsigned char* X1F8 = ws + WS_X1F8;
    unsigned* cnt = (unsigned*)(ws + WS_CTL) + CW_CNT;
    int* tokof = (int*)(ws + WS_TOKOF); float2* wtof = (float2*)(ws + WS_WTOF); int4* tpos = (int4*)(ws + WS_TPOS);
    const v4u* WRF = (const v4u*)(ws + WS_WRF);
    LAS v4u* wl = (LAS v4u*)F.lds;
    LAS float* sl = (LAS float*)(F.lds + 98304 + F.wave * 4096);
    const int i = lane & 15, q = lane >> 4;
    LAS unsigned* hist = (LAS unsigned*)(F.lds + LDS_MISC + 2048);
    for (int wt = F.vcu; wt < T / 128; wt += F.G) {
        const int tile = wt * NWAVES + F.wave;
        if (tid_ < 32) hist[tid_] = 0u;
        const size_t roff = (size_t)(tile * 16 + i) * D + 8 * q;
        const float* xr = X + roff; const bf16* dr = DELTA + roff;
        f32x4 a0 = {0.f, 0.f, 0.f, 0.f}, a1 = a0, a2 = a0; float ss = 0.f;
        f32x4 va[8][2]; v4u vd[8];
#pragma unroll
        for (int j = 0; j < 8; ++j) { va[j][0] = *(const GAS f32x4*)(xr + 32 * j); va[j][1] = *(const GAS f32x4*)(xr + 32 * j + 4); vd[j] = *(const GAS v4u*)(dr + 32 * j); }
#pragma unroll 1
        for (int half = 0; half < 2; ++half) {
            __syncthreads();
            { v4u t[12];
#pragma unroll
              for (int k = 0; k < 12; ++k) t[k] = WRF[half * 6144 + k * 512 + tid_];
#pragma unroll
              for (int k = 0; k < 12; ++k) wl[k * 512 + tid_] = t[k]; }
            __syncthreads();
#pragma unroll 1
            for (int sb = 0; sb < 2; ++sb) {
#pragma unroll
                for (int j = 0; j < 8; ++j) {
                    const int ksl = sb * 8 + j, ks = half * 16 + ksl;
                    const v4u dd = vd[j];
                    const f32x4 v0 = va[j][0] + (f32x4){bflo(dd.x), bfhi(dd.x), bflo(dd.y), bfhi(dd.y)}, v1 = va[j][1] + (f32x4){bflo(dd.z), bfhi(dd.z), bflo(dd.w), bfhi(dd.w)};
                    if (ks + 8 < 32) { va[j][0] = *(const GAS f32x4*)(xr + 32 * (ks + 8)); va[j][1] = *(const GAS f32x4*)(xr + 32 * (ks + 8) + 4); vd[j] = *(const GAS v4u*)(dr + 32 * (ks + 8)); }
                    ss += ((v0[0] * v0[0] + v0[1] * v0[1]) + (v0[2] * v0[2] + v0[3] * v0[3])) + ((v1[0] * v1[0] + v1[1] * v1[1]) + (v1[2] * v1[2] + v1[3] * v1[3]));
                    v4u hu; hu.x = cvtpk(v0[0], v0[1]); hu.y = cvtpk(v0[2], v0[3]); hu.z = cvtpk(v1[0], v1[1]); hu.w = cvtpk(v1[2], v1[3]);
                    v4u lu; lu.x = cvtpk(v0[0] - bflo(hu.x), v0[1] - bfhi(hu.x)); lu.y = cvtpk(v0[2] - bflo(hu.y), v0[3] - bfhi(hu.y)); lu.z = cvtpk(v1[0] - bflo(hu.z), v1[1] - bfhi(hu.z)); lu.w = cvtpk(v1[2] - bflo(hu.w), v1[3] - bfhi(hu.w));
                    *(GAS v4u*)(X1B + roff + 32 * ks) = hu;
                    if (P6_FP8) { v2u w8; w8.x = pk4_fp8(v0[0], v0[1], v0[2], v0[3]); w8.y = pk4_fp8(v1[0], v1[1], v1[2], v1[3]); *(GAS v2u*)(X1F8 + roff + 32 * ks) = w8; }
                    const bf16x8 ah = __builtin_bit_cast(bf16x8, hu), al = __builtin_bit_cast(bf16x8, lu);
#pragma unroll
                    for (int nb = 0; nb < 3; ++nb) {
                        const bf16x8 bh = __builtin_bit_cast(bf16x8, wl[((ksl * 3 + nb) * 2 + 0) * 64 + lane]), bl = __builtin_bit_cast(bf16x8, wl[((ksl * 3 + nb) * 2 + 1) * 64 + lane]);
                        f32x4 acc = nb == 0 ? a0 : (nb == 1 ? a1 : a2);
                        acc = __builtin_amdgcn_mfma_f32_16x16x32_bf16(ah, bh, acc, 0, 0, 0); acc = __builtin_amdgcn_mfma_f32_16x16x32_bf16(ah, bl, acc, 0, 0, 0); acc = __builtin_amdgcn_mfma_f32_16x16x32_bf16(al, bh, acc, 0, 0, 0);
                        if (nb == 0) a0 = acc; else if (nb == 1) a1 = acc; else a2 = acc;
                    }
                }
            }
        }
        ss += __shfl_xor(ss, 16); ss += __shfl_xor(ss, 32);
#pragma unroll
        for (int r = 0; r < 4; ++r) { sl[(4 * q + r) * 48 + i] = a0[r]; sl[(4 * q + r) * 48 + 16 + i] = a1[r]; sl[(4 * q + r) * 48 + 32 + i] = a2[r]; }
        LDS_WAIT(); asm volatile("" ::: "memory");
        int e0 = 0, e1 = 0, lp0 = 0, lp1 = 0; float w1 = 0.f, w2 = 0.f, rstd = 0.f;
        __syncthreads();
        if (lane < 16) {
            rstd = 1.0f / sqrtf(ss * (1.f / D) + RMS_EPS);
            float lg[36];
#pragma unroll
            for (int o = 0; o < 36; ++o) lg[o] = sl[lane * 48 + o] * rstd + (o < 4 ? F.in[I_BRG][o] : F.in[I_BRE][o - 4]);
            int gsel = 0; float gmax = lg[0];
#pragma unroll
            for (int k = 1; k < 4; ++k) if (lg[k] > gmax) { gmax = lg[k]; gsel = k; }
            float gden = 0.f;
#pragma unroll
            for (int k = 0; k < 4; ++k) gden += __expf(lg[k] - gmax);
            const float pg = 1.0f / gden;
            float le[8];
#pragma unroll
            for (int j = 0; j < 8; ++j) { le[j] = lg[4 + j];
#pragma unroll
                for (int gi = 1; gi < 4; ++gi) le[j] = (gsel == gi) ? lg[4 + gi * 8 + j] : le[j]; }
            int i1 = 0; float m1 = le[0];
#pragma unroll
            for (int j = 1; j < 8; ++j) if (le[j] > m1) { m1 = le[j]; i1 = j; }
            int i2 = -1; float m2 = -INFINITY;
#pragma unroll
            for (int j = 0; j < 8; ++j) if (j != i1 && le[j] > m2) { m2 = le[j]; i2 = j; }
            const float e2 = __expf(m2 - m1);
            w1 = pg / (1.0f + e2); w2 = pg * e2 / (1.0f + e2);
            e0 = gsel * 8 + i1; e1 = gsel * 8 + i2;
            lp0 = (int)__hip_atomic_fetch_add(&hist[e0], 1u, __ATOMIC_RELAXED, __HIP_MEMORY_SCOPE_WORKGROUP);
            lp1 = (int)__hip_atomic_fetch_add(&hist[e1], 1u, __ATOMIC_RELAXED, __HIP_MEMORY_SCOPE_WORKGROUP);
        }
        __syncthreads();
        if (tid_ < 32) { const unsigned n = hist[tid_]; hist[32 + tid_] = n ? atomicAdd(&cnt[64 * tid_], n) : 0u; }
        __syncthreads();
        if (lane < 16) {
            const int row = tile * 16 + lane;
            const int p0 = (int)hist[32 + e0] + lp0, p1 = (int)hist[32 + e1] + lp1;
            tokof[(size_t)e0 * T + p0] = row; wtof[(size_t)e0 * T + p0] = make_float2(w1, rstd);
            tokof[(size_t)e1 * T + p1] = row; wtof[(size_t)e1 * T + p1] = make_float2(w2, rstd);
            tpos[row] = make_int4(e0, p0, e1, p1);
        }
        __syncthreads();
    }
}

__device__ __forceinline__ void expert_tiles(Frame& F, LAS int* tb, LAS int* cn) {
    int tid_ = threadIdx.x; asm volatile("" : "+v"(tid_)); const int lane_ = tid_ & 63;
    if (tid_ == 0) {
        const unsigned* cnt = (const unsigned*)(F.ws + WS_CTL) + CW_CNT;
        int acc = 0;
        for (int e = 0; e < NE; ++e) { const int c = (int)__hip_atomic_load(cnt + 64 * e, __ATOMIC_RELAXED, __HIP_MEMORY_SCOPE_AGENT); cn[e] = c; tb[e] = acc; acc += (c + 255) >> 8; }
        tb[NE] = acc;
    }
    __syncthreads();
}

struct MoeOrder { const LAS int* tb; int ncol, G, c;
    __device__ bool next(int i, pg9::Unit& u) const {
        const int L = i * G + c; if (L >= tb[NE] * ncol) return false;
        const int rt = L / ncol; int e = 0;
        for (int k = 1; k < NE; ++k) if (tb[k] <= rt) e = k;
        u.pm = rt; u.pn = L % ncol; u.e = e; return true; } };
struct GatherA { static constexpr bool GATHER = true; unsigned rowbytes; const int* tokof; const LAS int* tb; const LAS int* cn;
    __device__ __forceinline__ unsigned operator()(const pg9::Unit& u, int row) const {
        const int p = (u.pm - tb[u.e]) * 256 + row; const int tok = tokof[(size_t)u.e * T + (p < cn[u.e] ? p : 0)]; return (unsigned)tok * rowbytes; } };
struct ExpertB { const char* W; size_t ebytes, tilebytes; __device__ __forceinline__ const char* operator()(const pg9::Unit& u) const { return W + (size_t)u.e * ebytes + (size_t)u.pn * tilebytes; } };
struct EpiGateUp {
    static constexpr bool PERM = true; static constexpr int HOOK_T = -1;
    const float2* wtof; bf16* HACT; const LAS int* tb; const LAS int* cn; float ascale;
    __device__ __forceinline__ void hook(f32x4 (&)[2][2][4][2], const pg9::Unit&, int, int, int, int) const {}
    __device__ __forceinline__ void operator()(const f32x4 (&acc)[2][2][4][2], const pg9::Unit& u, int wr, int wc, int fr, int fq) const {
        asm volatile("" : "+v"(fr), "+v"(fq));
        const int r0 = wr * 64 + fr, p0 = (u.pm - tb[u.e]) * 256, ce = cn[u.e];
        const int fr2 = (fr >> 2) + 4 * fq, fq2 = fr & 3, paddr = 4 * (16 * (fr & 3) + 4 * fq + (fr >> 2)), r0s = wr * 64 + fr2;
        const float2* wp = wtof + (size_t)u.e * T;
#pragma unroll
        for (int ai = 0; ai < 2; ++ai) {
            float2 wv[4];
#pragma unroll
            for (int m = 0; m < 4; ++m) { const int p = p0 + r0 + ai * 128 + m * 16; wv[m] = p < ce ? wp[p] : make_float2(0.f, 0.f); }
#pragma unroll
            for (int m = 0; m < 4; ++m) { const int r = r0s + ai * 128 + m * 16;
                const float w = wv[m].x, rs = wv[m].y * ascale;
                bf16* orow = HACT + (size_t)(u.pm * 256 + r) * DE + u.pn * 128 + wc * 16 + 4 * fq2; unsigned char* orow8 = (unsigned char*)HACT + (size_t)(u.pm * 256 + r) * DE + u.pn * 128 + wc * 16 + 4 * fq2;
#pragma unroll
                for (int bj = 0; bj < 2; ++bj) { const f32x4 g = acc[ai][bj][m][0], uu = acc[ai][bj][m][1]; f32x4 hv;
#pragma unroll
                    for (int e = 0; e < 4; ++e) { const float gg = g[e] * rs; hv[e] = gg / (1.0f + __expf(-gg)) * (uu[e] * rs) * w; }
                    if (P6_FP8) *(GAS unsigned*)(orow8 + bj * 64) = (unsigned)__builtin_amdgcn_ds_bpermute(paddr, (int)pk4_fp8(hv[0] * H8_SCALE, hv[1] * H8_SCALE, hv[2] * H8_SCALE, hv[3] * H8_SCALE));
                    else { v2u o; o.x = (unsigned)__builtin_amdgcn_ds_bpermute(paddr, (int)cvtpk(hv[0], hv[1])); o.y = (unsigned)__builtin_amdgcn_ds_bpermute(paddr, (int)cvtpk(hv[2], hv[3])); *(GAS v2u*)(orow + bj * 64) = o; } } }
        }
    }
};
__device__ __forceinline__ void p6a_gateup(Frame& F) {
    unsigned char* ws = F.ws;
    LAS int* tb = (LAS int*)(F.lds + LDS_MISC + 1024); LAS int* cn = tb + 64;
    expert_tiles(F, tb, cn);
    MoeOrder S{tb, 2, F.G, F.vcu};
    constexpr int ES = P6_FP8 ? 1 : 2;
    GatherA ao{(unsigned)(D * ES), (const int*)(ws + WS_TOKOF), tb, cn}; ExpertB bb{(const char*)(ws + WS_WGU), (size_t)512 * D * ES, (size_t)256 * D * ES};
    EpiGateUp E{(const float2*)(ws + WS_WTOF), (bf16*)(ws + WS_HACT), tb, cn, P6_FP8 ? 1.0f / WG8_SCALE : 1.0f};
    pg9::gemm_phase<ES>(F.lds, (const char*)(ws + (P6_FP8 ? WS_X1F8 : WS_X1B)), D, S, E, ao, bb);
}
struct EpiDown {
    static constexpr bool PERM = true; static constexpr int HOOK_T = -1;
    bf16* YS; float ascale;
    __device__ __forceinline__ void hook(f32x4 (&)[2][2][4][2], const pg9::Unit&, int, int, int, int) const {}
    __device__ __forceinline__ void operator()(const f32x4 (&acc)[2][2][4][2], const pg9::Unit& u, int wr, int wc, int fr, int fq) const {
        asm volatile("" : "+v"(fr), "+v"(fq));
        const int fr2 = (fr >> 2) + 4 * fq, fq2 = fr & 3, paddr = 4 * (16 * (fr & 3) + 4 * fq + (fr >> 2));
#pragma unroll
        for (int ai = 0; ai < 2; ++ai)
#pragma unroll
            for (int m = 0; m < 4; ++m) { bf16* orow = YS + (size_t)(u.pm * 256 + wr * 64 + fr2 + ai * 128 + m * 16) * D + u.pn * 256 + wc * 32 + 8 * fq2;
#pragma unroll
                for (int bj = 0; bj < 2; ++bj) { const f32x4 v0 = acc[ai][bj][m][0] * ascale, v1 = acc[ai][bj][m][1] * ascale;
                    if (YS_FP8) { unsigned char* o8 = (unsigned char*)YS + (size_t)(u.pm * 256 + wr * 64 + fr2 + ai * 128 + m * 16) * D + u.pn * 256 + wc * 32 + 8 * fq2 + bj * 128;
                        v2u w8; w8.x = pk4_fp8(v0[0] * YS8_SCALE, v0[1] * YS8_SCALE, v0[2] * YS8_SCALE, v0[3] * YS8_SCALE); w8.y = pk4_fp8(v1[0] * YS8_SCALE, v1[1] * YS8_SCALE, v1[2] * YS8_SCALE, v1[3] * YS8_SCALE);
                        w8.x = (unsigned)__builtin_amdgcn_ds_bpermute(paddr, (int)w8.x); w8.y = (unsigned)__builtin_amdgcn_ds_bpermute(paddr, (int)w8.y); *(GAS v2u*)o8 = w8; }
                    else { v4u w; w.x = cvtpk(v0[0], v0[1]); w.y = cvtpk(v0[2], v0[3]); w.z = cvtpk(v1[0], v1[1]); w.w = cvtpk(v1[2], v1[3]);
                        w.x = (unsigned)__builtin_amdgcn_ds_bpermute(paddr, (int)w.x); w.y = (unsigned)__builtin_amdgcn_ds_bpermute(paddr, (int)w.y); w.z = (unsigned)__builtin_amdgcn_ds_bpermute(paddr, (int)w.z); w.w = (unsigned)__builtin_amdgcn_ds_bpermute(paddr, (int)w.w); *(GAS v4u*)(orow + bj * 128) = w; } } }
    }
};
__device__ __forceinline__ void p6b_down(Frame& F) {
    unsigned char* ws = F.ws;
    LAS int* tb = (LAS int*)(F.lds + LDS_MISC + 1024); LAS int* cn = tb + 64;
    expert_tiles(F, tb, cn);
    MoeOrder S{tb, 4, F.G, F.vcu};
    constexpr int ES = P6_FP8 ? 1 : 2;
    pg9::DenseA ao{(unsigned)(DE * ES)}; ExpertB bb{(const char*)(ws + WS_WD), (size_t)D * DE * ES, (size_t)256 * DE * ES};
    EpiDown E{(bf16*)(ws + WS_YS), P6_FP8 ? 1.0f / (WD8_SCALE * H8_SCALE) : 1.0f};
    pg9::gemm_phase<ES>(F.lds, (const char*)(ws + WS_HACT), DE, S, E, ao, bb);
}
__device__ __forceinline__ void p7_final(Frame& F) {
    int tid_ = threadIdx.x; asm volatile("" : "+v"(tid_)); const int lane_ = tid_ & 63;
    unsigned char* ws = F.ws;
    LAS int* tb = (LAS int*)(F.lds + LDS_MISC + 1024); LAS int* cn = tb + 64;
    expert_tiles(F, tb, cn);
    const bf16* YS = (const bf16*)(ws + WS_YS); const int4* tpos = (const int4*)(ws + WS_TPOS);
    float* X1 = F.out; const bf16* X1B = (const bf16*)(ws + WS_X1B);
    const int lane = lane_;
    const int gw = F.vcu * NWAVES + F.wave, NGW = F.G * NWAVES;
    const GAS f32x4* gr = (const GAS f32x4*)F.in[I_GFIN] + lane;
    for (int row = gw; row < T; row += NGW) {
        const int4 tp = tpos[row];
        const size_t s0 = (size_t)tb[tp.x] * 256 + tp.y, s1 = (size_t)tb[tp.z] * 256 + tp.w;
        GAS f32x4* xr = (GAS f32x4*)(X1 + (size_t)row * D) + lane; const GAS v2u* xb = (const GAS v2u*)(X1B + (size_t)row * D) + lane;
        const GAS v2u* y0 = (const GAS v2u*)(YS + s0 * D) + lane; const GAS v2u* y1 = (const GAS v2u*)(YS + s1 * D) + lane;
        const GAS unsigned* z0 = (const GAS unsigned*)((const unsigned char*)YS + s0 * D) + lane; const GAS unsigned* z1 = (const GAS unsigned*)((const unsigned char*)YS + s1 * D) + lane;
        f32x4 v[4]; float s = 0.f;
#pragma unroll
        for (int j = 0; j < 4; ++j) { const v2u xx = xb[64 * j]; v[j] = (f32x4){bflo(xx.x), bfhi(xx.x), bflo(xx.y), bfhi(xx.y)};
            if (YS_FP8) { const int a = (int)z0[64 * j], b = (int)z1[64 * j]; typedef float f2_ __attribute__((ext_vector_type(2)));
                const f2_ a0 = __builtin_amdgcn_cvt_pk_f32_fp8(a, false), a1 = __builtin_amdgcn_cvt_pk_f32_fp8(a, true), b0 = __builtin_amdgcn_cvt_pk_f32_fp8(b, false), b1 = __builtin_amdgcn_cvt_pk_f32_fp8(b, true);
                constexpr float f = 1.0f / YS8_SCALE; v[j].x += (a0[0] + b0[0]) * f; v[j].y += (a0[1] + b0[1]) * f; v[j].z += (a1[0] + b1[0]) * f; v[j].w += (a1[1] + b1[1]) * f; }
            else { const v2u a = y0[64 * j], b = y1[64 * j];
            v[j].x += bflo(a.x) + bflo(b.x); v[j].y += bfhi(a.x) + bfhi(b.x); v[j].z += bflo(a.y) + bflo(b.y); v[j].w += bfhi(a.y) + bfhi(b.y); }
            s += (v[j].x * v[j].x + v[j].y * v[j].y) + (v[j].z * v[j].z + v[j].w * v[j].w); }
        const float rstd = 1.0f / sqrtf(wave_sum(s) * (1.f / D) + RMS_EPS);
#pragma unroll
        for (int j = 0; j < 4; ++j) { const f32x4 gg = gr[64 * j]; f32x4 o; o.x = v[j].x * rstd * gg.x; o.y = v[j].y * rstd * gg.y; o.z = v[j].z * rstd * gg.z; o.w = v[j].w * rstd * gg.w; xr[64 * j] = o; }
    }
}

constexpr int NPHASE = 2 * NCH + 8;
__global__ void __launch_bounds__(NTHR, 2) fwd_kernel(KArgs args) {
    extern __shared__ __attribute__((aligned(16))) unsigned char lds_raw[];
    Frame F;
    F.lds = (LAS unsigned char*)lds_raw;
    F.tid = threadIdx.x; F.lane = F.tid & 63; F.wave = __builtin_amdgcn_readfirstlane(F.tid >> 6);
    F.G = gridDim.x; { const int bx = blockIdx.x; F.vcu = (F.G % 8 == 0) ? (bx % 8) * (F.G / 8) + bx / 8 : bx; }
#pragma unroll
    for (int i = 0; i < 17; ++i) F.in[i] = args.in[i];
    F.out = args.out; F.ws = args.ws;
    volatile LAS unsigned* MISC = (volatile LAS unsigned*)(F.lds + LDS_MISC);
    if (F.tid < 64) MISC[F.tid] = 0u;
    __syncthreads();
    XcdBarrier bar = xcd_barrier_post((unsigned*)(F.ws + WS_CTL) + CW_BAR + args.li * XCD_BAR_WORDS, MISC + 8);
#define IN(k) (args.ph_lo <= (k) && (k) < args.ph_hi)
#ifdef PROBE_MASK
    unsigned long long pr_acc = 0, pr_t0 = 0; const bool pr_me = (blockIdx.x == 0 && threadIdx.x == 0);
#define PR_BEGIN(k) do { if (pr_me && ((PROBE_MASK >> (k)) & 1ull)) pr_t0 = __builtin_amdgcn_s_memrealtime(); } while (0)
#define PR_END(k) do { if (pr_me && ((PROBE_MASK >> (k)) & 1ull)) pr_acc += __builtin_amdgcn_s_memrealtime() - pr_t0; } while (0)
#else
#define PR_BEGIN(k) do {} while (0)
#define PR_END(k) do {} while (0)
#endif
#define SEAM(k) do { if (IN(k) && IN((k) + 1)) xcd_barrier(bar); PR_END(k); } while (0)
    PR_BEGIN(0); if (IN(0)) p0_prologue(F);
    SEAM(0);
#pragma unroll 1
    for (int ch = 0; ch < NCH; ++ch) {
        PR_BEGIN(1 + 2 * ch);
        if (IN(1 + 2 * ch)) {
            constexpr int NWG1 = (TC / 256) * (NIN / 256);
            const int nfull = NWG1 % F.G, bx = (int)blockIdx.x;
            if (ch > 0 && nfull == 0) p2_combine(F, ch - 1, F.vcu, F.G);
            p1_inproj(F, ch);
            if (ch > 0 && nfull != 0 && bx >= nfull) p2_combine(F, ch - 1, bx - nfull, F.G - nfull);
        }
        SEAM(1 + 2 * ch);
        PR_BEGIN(2 + 2 * ch); if (IN(2 + 2 * ch)) p2_attn(F, ch);
        SEAM(2 + 2 * ch);
    }
    PR_BEGIN(2 * NCH + 1); if (IN(2 * NCH + 1)) p2_combine(F, NCH - 1, F.vcu, F.G);
    SEAM(2 * NCH + 1);
    PR_BEGIN(2 * NCH + 2); if (IN(2 * NCH + 2)) p3_merge(F);
    SEAM(2 * NCH + 2);
    PR_BEGIN(2 * NCH + 3); if (IN(2 * NCH + 3)) p4_outproj(F);
    SEAM(2 * NCH + 3);
    PR_BEGIN(2 * NCH + 4); if (IN(2 * NCH + 4)) p5_route(F);
    SEAM(2 * NCH + 4);
    PR_BEGIN(2 * NCH + 5); if (IN(2 * NCH + 5)) p6a_gateup(F);
    SEAM(2 * NCH + 5);
    PR_BEGIN(2 * NCH + 6); if (IN(2 * NCH + 6)) p6b_down(F);
    SEAM(2 * NCH + 6);
    PR_BEGIN(2 * NCH + 7); if (IN(2 * NCH + 7)) p7_final(F);
    PR_END(2 * NCH + 7);
#ifdef PROBE_MASK
    if (pr_me) { const unsigned long long t1 = __builtin_amdgcn_s_memrealtime(); while (__builtin_amdgcn_s_memrealtime() - t1 < pr_acc) __builtin_amdgcn_s_sleep(4); }
#endif
#undef IN
#undef SEAM
}

#ifndef N_LAUNCHES
#define N_LAUNCHES 1
#endif
extern "C" void kernel_launch(void* const* d_in, const int* in_sizes, int n_in, void* d_out, int out_size, void* d_ws, size_t ws_size, hipStream_t stream) {
    static int grid = 0;
    if (grid == 0) {
        if (n_in != 17 || in_sizes[0] != T * D || out_size != T * D || ws_size < WS_END) { fprintf(stderr, "kernel_launch: unexpected shapes / workspace (%d inputs, ws %zu)\n", n_in, ws_size); grid = -1; return; }
        int dev = 0, cus = 0;
        if (hipGetDevice(&dev) != hipSuccess || hipDeviceGetAttribute(&cus, hipDeviceAttributeMultiprocessorCount, dev) != hipSuccess) { grid = -1; return; }
        if (hipFuncSetAttribute((const void*)fwd_kernel, hipFuncAttributeMaxDynamicSharedMemorySize, LDS_BYTES) != hipSuccess) { fprintf(stderr, "kernel_launch: hipFuncSetAttribute failed\n"); grid = -1; return; }
        int per_cu = 0;
        if (hipOccupancyMaxActiveBlocksPerMultiprocessor(&per_cu, (const void*)fwd_kernel, NTHR, LDS_BYTES) != hipSuccess || per_cu < 1) fprintf(stderr, "kernel_launch: occupancy query says %d\n", per_cu);
        (void)hipGetLastError();
        grid = cus;
    }
    if (grid < 0) return;
    (void)hipMemsetAsync((char*)d_ws + WS_CTL, 0, N_LAUNCHES == 1 ? (size_t)(CW_BAR + XCD_BAR_WORDS) * 4 : CTL_BYTES, stream);
    KArgs a{};
    for (int i = 0; i < 17; ++i) a.in[i] = (const float*)d_in[i];
    a.out = (float*)d_out; a.ws = (unsigned char*)d_ws;
    for (int li = 0; li < N_LAUNCHES; ++li) {
        a.ph_lo = (int)((long)NPHASE * li / N_LAUNCHES); a.ph_hi = (int)((long)NPHASE * (li + 1) / N_LAUNCHES); a.li = li;
        hipLaunchKernelGGL(fwd_kernel, dim3(grid), dim3(NTHR), LDS_BYTES, stream, a);
    }
}
```

```cpp
#include <hip/hip_runtime.h>
#include <cstdint>
#include <cstdio>

#define GAS __attribute__((address_space(1)))
#define LAS __attribute__((address_space(3)))
typedef unsigned short bf16;
typedef short bf16x8 __attribute__((ext_vector_type(8)));
typedef float f32x4 __attribute__((ext_vector_type(4)));
typedef unsigned v4u __attribute__((ext_vector_type(4)));
typedef unsigned v2u __attribute__((ext_vector_type(2)));
typedef GAS unsigned gu32;

constexpr int T = 32768, D = 1024, SEQ = 4096, NIN = 7936;
constexpr int A_W = 4608, B_W = 1280, G_W = 2048, Y_W = 1536;
constexpr int NE = 32, DE = 256;
constexpr int NCH = 4, TC = T / NCH;
constexpr float QSCALE = 0.125f * 1.4426950408889634f;
constexpr float LOG2E = 1.4426950408889634f;
constexpr float RMS_EPS = 1e-6f;
#ifndef P1_FP8
#define P1_FP8 1
#endif
constexpr float W8_SCALE = P1_FP8 ? 64.0f : 0.0f, W8_INV = P1_FP8 ? 1.0f / 64.0f : 1.0f;
#ifndef P6_FP8
#define P6_FP8 1
#endif
#ifndef P34_FP8
#define P34_FP8 1
#endif
constexpr float Y8_SCALE = 16.0f, W34_SCALE = 64.0f, MG8_SCALE = 32.0f;
#ifndef YS_FP8
#define YS_FP8 1
#endif
constexpr float YS8_SCALE = 16.0f;
constexpr float WG8_SCALE = P6_FP8 ? 64.0f : 0.0f, WD8_SCALE = P6_FP8 ? 32.0f : 0.0f, H8_SCALE = 32.0f;
constexpr int NWAVES = 8, NTHR = 512;

constexpr size_t MiB = 1u << 20;
constexpr size_t WS_CTL = 0, CTL_BYTES = 1 * MiB;
constexpr size_t WS_BIASP = ((size_t)1 << 20) + 4096;
constexpr size_t WS_INVF = 1 * MiB;
constexpr size_t WS_WRF = 2 * MiB;
constexpr size_t WS_TOKOF = 3 * MiB;
constexpr size_t WS_WTOF = 7 * MiB;
constexpr size_t WS_TPOS = 15 * MiB;
constexpr size_t WS_WIN = 16 * MiB;
constexpr size_t WS_WAB = 32 * MiB;
constexpr size_t WS_WO = 35 * MiB;
constexpr size_t WS_WGU = 37 * MiB;
constexpr size_t WS_WD = 69 * MiB;
constexpr size_t WS_G = 86 * MiB;
constexpr size_t WS_Y = 214 * MiB;
constexpr size_t WS_ZA = 310 * MiB;
constexpr size_t WS_ZB = 454 * MiB;
constexpr size_t WS_END = 494 * MiB;
constexpr size_t WS_MG = WS_ZA;
constexpr size_t WS_X1B = WS_ZA + 64 * MiB;
constexpr size_t WS_X1F8 = WS_Y + 64 * MiB;
constexpr size_t WS_HACT = WS_G;
constexpr size_t WS_YS = WS_G + 36 * MiB;
constexpr size_t DO_DELTA = 0;
constexpr size_t DO_HN = 0;
constexpr size_t DO_OG = 64 * MiB;
constexpr size_t DO_LSE = 112 * MiB;
constexpr int MAXSLOT = 2 * T + NE * 256;
static_assert(WS_ZA + (size_t)TC * A_W * 2 <= WS_ZB && WS_ZB + (size_t)TC * B_W * 2 <= WS_END && WS_Y + (size_t)T * Y_W * 2 <= WS_ZA && WS_G + (size_t)T * G_W * 2 <= WS_Y, "ws map");
static_assert(WS_MG + (size_t)T * D * 2 <= WS_END && WS_HACT + (size_t)MAXSLOT * DE * 2 <= WS_YS && WS_YS + (size_t)MAXSLOT * D * 2 <= WS_ZA && WS_X1B >= WS_MG + (size_t)T * D * 2 && WS_X1B + (size_t)T * D * 2 <= WS_ZB, "ws map");
static_assert(DO_OG + (size_t)3 * TC * 512 * 2 <= DO_LSE && DO_LSE + (size_t)3 * TC * 8 * 4 <= (size_t)T * D * 4 && DO_HN + (size_t)T * D * 2 <= DO_OG, "d_out scratch map");
constexpr int CW_CNT = 1024;
constexpr int CW_BAR = 4096;
constexpr int LDS_BYTES = 147456;
constexpr int LDS_MISC = 131072;

__device__ __forceinline__ unsigned f2bf(float f) { unsigned u = __builtin_bit_cast(unsigned, f); return (u + 0x7fffu + ((u >> 16) & 1u)) >> 16; }
__device__ __forceinline__ unsigned pk4_fp8(float a, float b, float c, float d) {
    a = __builtin_amdgcn_fmed3f(a, -448.f, 448.f); b = __builtin_amdgcn_fmed3f(b, -448.f, 448.f); c = __builtin_amdgcn_fmed3f(c, -448.f, 448.f); d = __builtin_amdgcn_fmed3f(d, -448.f, 448.f);
    int w = 0; w = __builtin_amdgcn_cvt_pk_fp8_f32(a, b, w, false); w = __builtin_amdgcn_cvt_pk_fp8_f32(c, d, w, true); return (unsigned)w; }
__device__ __forceinline__ unsigned pk2(float lo, float hi) { return f2bf(lo) | (f2bf(hi) << 16); }
__device__ __forceinline__ float bf2f(unsigned b) { return __builtin_bit_cast(float, b << 16); }
__device__ __forceinline__ float bflo(unsigned u) { return __builtin_bit_cast(float, u << 16); }
__device__ __forceinline__ float bfhi(unsigned u) { return __builtin_bit_cast(float, u & 0xffff0000u); }
__device__ __forceinline__ float wave_sum(float v) {
#pragma unroll
    for (int o = 1; o < 64; o <<= 1) v += __shfl_xor(v, o);
    return v;
}
__device__ __forceinline__ float wave_max(float v) {
#pragma unroll
    for (int o = 1; o < 64; o <<= 1) v = fmaxf(v, __shfl_xor(v, o));
    return v;
}
typedef float f32x2_t __attribute__((ext_vector_type(2)));
typedef __bf16 bf16x2_t __attribute__((ext_vector_type(2)));
__device__ __forceinline__ unsigned cvtpk(float lo, float hi) { f32x2_t v = {lo, hi}; bf16x2_t b = __builtin_convertvector(v, bf16x2_t); return __builtin_bit_cast(unsigned, b); }
#ifndef WT_STORES
#define WT_STORES 0
#endif
__device__ __forceinline__ __amdgpu_buffer_rsrc_t wt_rsrc(unsigned char* base) { return __builtin_amdgcn_make_buffer_rsrc(base, 0, 0x7ffffffc, 0x00020000); }
__device__ __forceinline__ void st16(__amdgpu_buffer_rsrc_t r, unsigned char* base, void* p, v4u v) { if (WT_STORES) __builtin_amdgcn_raw_buffer_store_b128(v, r, (unsigned)((unsigned char*)p - base), 0, 16); else *(GAS v4u*)p = v; }
__device__ __forceinline__ void st8(__amdgpu_buffer_rsrc_t r, unsigned char* base, void* p, v2u v) { if (WT_STORES) __builtin_amdgcn_raw_buffer_store_b64(v, r, (unsigned)((unsigned char*)p - base), 0, 16); else *(GAS v2u*)p = v; }
#define LDS_WAIT() asm volatile("s_waitcnt lgkmcnt(0)" ::: "memory")
#define VM_WAIT() asm volatile("s_waitcnt vmcnt(0)" ::: "memory")

#define XB_TMO      128
#define XB_XCNT(j)  (256  + 64 * (j))
#define XB_XSUB(j)  (1280 + 64 * (j))
#define XB_XGEN(j)  (2304 + 64 * (j))
#define XB_TOP      3328
#define XB_TOPGEN   3392
#define XCD_BAR_WORDS 3456
#define XB_SPIN_CAP (1u << 18)
__device__ __forceinline__ unsigned xb_ld(unsigned* p)              { return __hip_atomic_load(p, __ATOMIC_RELAXED, __HIP_MEMORY_SCOPE_AGENT); }
__device__ __forceinline__ unsigned xb_add(unsigned* p, unsigned v) { return __hip_atomic_fetch_add(p, v, __ATOMIC_RELAXED, __HIP_MEMORY_SCOPE_AGENT); }
__device__ __forceinline__ unsigned xb_xcc_id() { return (unsigned)__builtin_amdgcn_s_getreg((3 << 11) | 20) & 0xFu; }
#define XB_SPIN(cond, bar) do { unsigned _sp = 0; while (cond) { __builtin_amdgcn_s_sleep(1); \
    if ((++_sp & 255u) == 0u) { if (xb_ld(&(bar)[XB_TMO])) break; if (_sp > XB_SPIN_CAP) { atomicAdd(&(bar)[XB_TMO], 1u); break; } } } } while (0)
struct XcdBarrier { unsigned* bar; unsigned x; volatile LAS unsigned* st; };
__device__ __forceinline__ XcdBarrier xcd_barrier_post(unsigned* bar, volatile LAS unsigned* st) {
    XcdBarrier b; b.bar = bar; b.x = xb_xcc_id(); b.st = st;
    if (threadIdx.x == 0) (void)xb_add(&bar[XB_XCNT(b.x)], 1u);
    return b;
}
__device__ __forceinline__ void xcd_barrier_complete(unsigned* bar, unsigned x, unsigned& nloc, unsigned& nx) {
    const unsigned G = gridDim.x * gridDim.y * gridDim.z;
    unsigned sum, cnt, mine, sp = 0u;
    for (;;) {
        sum = 0u; cnt = 0u; mine = 0u;
#pragma unroll
        for (unsigned j = 0; j < 16; ++j) { const unsigned c = xb_ld(&bar[XB_XCNT(j)]); sum += c; cnt += (c > 0u) ? 1u : 0u; mine = (j == x) ? c : mine; }
        if (sum == G) break;
        __builtin_amdgcn_s_sleep(1);
        if ((++sp & 255u) == 0u) { if (xb_ld(&bar[XB_TMO])) break; if (sp > XB_SPIN_CAP) { atomicAdd(&bar[XB_TMO], 1u); break; } }
    }
    nloc = mine > 0u ? mine : 1u; nx = cnt > 0u ? cnt : 1u;
}
__device__ __forceinline__ void xcd_barrier(const XcdBarrier& b) {
    asm volatile("s_waitcnt vmcnt(0)" ::: "memory");
    __syncthreads();
    if (threadIdx.x == 0) {
        unsigned* bar = b.bar;
        __builtin_amdgcn_s_waitcnt(0);
        unsigned nloc = b.st[0], nx = b.st[1];
        if (nloc == 0u) { xcd_barrier_complete(bar, b.x, nloc, nx); b.st[0] = nloc; b.st[1] = nx; }
        const unsigned old = xb_add(&bar[XB_XSUB(b.x)], 1u);
        const unsigned gen = old / nloc;
        if (old + 1u == (gen + 1u) * nloc) {
            __builtin_amdgcn_fence(__ATOMIC_RELEASE, "agent");
            asm volatile("s_waitcnt vmcnt(0)" ::: "memory");
            const unsigned og = xb_add(&bar[XB_TOP], 1u);
            const unsigned tg = og / nx;
            if (og + 1u == (tg + 1u) * nx) xb_add(&bar[XB_TOPGEN], 1u);
            else XB_SPIN(xb_ld(&bar[XB_TOPGEN]) == tg, bar);
            __builtin_amdgcn_fence(__ATOMIC_ACQUIRE, "agent");
            xb_add(&bar[XB_XGEN(b.x)], 1u);
            asm volatile("s_waitcnt vmcnt(0)" ::: "memory");
        } else {
            XB_SPIN(xb_ld(&bar[XB_XGEN(b.x)]) == gen, bar);
            __builtin_amdgcn_fence(__ATOMIC_ACQUIRE, "agent");
            asm volatile("s_waitcnt vmcnt(0)" ::: "memory");
        }
    }
    __syncthreads();
}

struct KArgs { const float* in[17]; float* out; unsigned char* ws; int ph_lo, ph_hi, li, pad; };
struct Frame {
    LAS unsigned char* lds;
    int tid, lane, wave, vcu, G;
    const float* in[17]; float* out; unsigned char* ws;
};
enum { I_X = 0, I_WIN, I_BIN, I_SINK, I_WPA, I_WPB, I_WOUT, I_GMIX, I_GFFN, I_WRG, I_BRG, I_WRE, I_BRE, I_WEG, I_WEU, I_WED, I_GFIN };

struct TrDesc { const float* W; int N; bf16* WT; int ldo, rowbase, koff, k0, n0; bool perm; const float* kscale; float f8scale; };
__device__ __forceinline__ void tr_load(const TrDesc& d, int lane, f32x4 (&tv)[8], float (&ks)[8]) {
    const float* src = d.W + (size_t)(d.k0 + (lane >> 3)) * d.N + d.n0 + 4 * (lane & 7);
#pragma unroll
    for (int i = 0; i < 8; ++i) tv[i] = *(const GAS f32x4*)(src + (size_t)(8 * i) * d.N);
#pragma unroll
    for (int i = 0; i < 8; ++i) ks[i] = d.kscale ? d.kscale[d.k0 + 8 * i + (lane >> 3)] : 1.0f;
}
__device__ __forceinline__ void tr_finish(const TrDesc& d, LAS float* scr, int lane, const f32x4 (&tv)[8], const float (&ks)[8]) {
#pragma unroll
    for (int i = 0; i < 8; ++i) { const int kk = 8 * i + (lane >> 3); LAS float* w = scr + kk * 33 + 4 * (lane & 7);
        w[0] = tv[i][0] * ks[i]; w[1] = tv[i][1] * ks[i]; w[2] = tv[i][2] * ks[i]; w[3] = tv[i][3] * ks[i]; }
    LDS_WAIT(); asm volatile("" ::: "memory");
    const int c = lane & 7;
#pragma unroll
    for (int j = 0; j < 4; ++j) { const int n = (lane >> 3) + 8 * j; const LAS float* s = scr + (8 * c) * 33 + n;
        const int rr = d.perm ? 8 * (n >> 2) + (n & 3) : n;
        if (d.f8scale != 0.f) { const float f = d.f8scale; v2u o8; o8.x = pk4_fp8(s[0 * 33] * f, s[1 * 33] * f, s[2 * 33] * f, s[3 * 33] * f); o8.y = pk4_fp8(s[4 * 33] * f, s[5 * 33] * f, s[6 * 33] * f, s[7 * 33] * f);
            *(GAS v2u*)((unsigned char*)d.WT + (size_t)(d.rowbase + rr) * d.ldo + d.koff + d.k0 + 8 * c) = o8; }
        else { v4u o; o.x = pk2(s[0 * 33], s[1 * 33]); o.y = pk2(s[2 * 33], s[3 * 33]); o.z = pk2(s[4 * 33], s[5 * 33]); o.w = pk2(s[6 * 33], s[7 * 33]);
            *(GAS v4u*)(d.WT + (size_t)(d.rowbase + rr) * d.ldo + d.koff + d.k0 + 8 * c) = o; } }
    LDS_WAIT(); asm volatile("" ::: "memory");
}
__device__ __forceinline__ void rms_row_to_bf16(const float* xrow, const float* g, bf16* orow, int lane) {
    const GAS f32x4* xr = (const GAS f32x4*)xrow + lane; const GAS f32x4* gr = (const GAS f32x4*)g + lane;
    f32x4 v[4]; float s = 0.f;
#pragma unroll
    for (int j = 0; j < 4; ++j) { v[j] = xr[64 * j]; s += (v[j].x * v[j].x + v[j].y * v[j].y) + (v[j].z * v[j].z + v[j].w * v[j].w); }
    const float rstd = 1.0f / sqrtf(wave_sum(s) * (1.f / D) + RMS_EPS);
    GAS v2u* o8 = (GAS v2u*)orow + lane;
#pragma unroll
    for (int j = 0; j < 4; ++j) { const f32x4 gg = gr[64 * j]; v2u w; w.x = pk2(v[j].x * rstd * gg.x, v[j].y * rstd * gg.y); w.y = pk2(v[j].z * rstd * gg.z, v[j].w * rstd * gg.w); o8[64 * j] = w; }
}
__device__ __forceinline__ void p0_prologue(Frame& F) {
    int tid_ = threadIdx.x; asm volatile("" : "+v"(tid_)); const int lane_ = tid_ & 63;
    LAS float* scr = (LAS float*)(F.lds + F.wave * 16384);
    const int gw = F.vcu * NWAVES + F.wave, NGW = F.G * NWAVES;
    unsigned char* ws = F.ws;
    constexpr int I_IN = 16 * 248, I_PA = 8 * 32, I_PB = 16 * 32, I_WO = 16 * 32, I_EG = 32 * 16 * 8, I_ED = 32 * 4 * 32;
    constexpr int NITEMS = I_IN + I_PA + I_PB + I_WO + 2 * I_EG + I_ED;
    auto decode = [&](int it, TrDesc& d) {
        int r = it; d.perm = false; d.kscale = nullptr; d.f8scale = 0.f; d.koff = 0;
        if (r < I_IN) { const int kb = r / 248, nb = r % 248, n0 = 32 * nb; const bool qk = (n0 < 3072) || (n0 >= A_W && n0 < A_W + 1152);
            const bool gt_ = n0 >= A_W + B_W; const int gc = n0 - (A_W + B_W);
            d.W = F.in[I_WIN]; d.N = NIN; d.WT = (bf16*)(ws + WS_WIN); d.ldo = 1024; d.rowbase = qk ? (n0 & ~63) + ((n0 >> 5) & 1) * 4 : (gt_ ? A_W + B_W + 2 * (gc % 1024) + 4 * (gc / 1024) : n0); d.k0 = 64 * kb; d.n0 = n0; d.perm = qk || gt_; d.f8scale = W8_SCALE; return; } r -= I_IN;
        if (r < I_PA) { const int kb = r / 32, nb = r % 32; d.W = F.in[I_WPA]; d.N = 1024; d.WT = (bf16*)(ws + WS_WAB); d.ldo = 1536; d.rowbase = 32 * nb; d.k0 = 64 * kb; d.n0 = 32 * nb; if (P34_FP8) d.f8scale = W34_SCALE; return; } r -= I_PA;
        if (r < I_PB) { const int kb = r / 32, nb = r % 32; d.W = F.in[I_WPB]; d.N = 1024; d.WT = (bf16*)(ws + WS_WAB); d.ldo = 1536; d.rowbase = 32 * nb; d.koff = 512; d.k0 = 64 * kb; d.n0 = 32 * nb; if (P34_FP8) d.f8scale = W34_SCALE; return; } r -= I_PB;
        if (r < I_WO) { const int kb = r / 32, nb = r % 32; d.W = F.in[I_WOUT]; d.N = 1024; d.WT = (bf16*)(ws + WS_WO); d.ldo = 1024; d.rowbase = 32 * nb; d.k0 = 64 * kb; d.n0 = 32 * nb; if (P34_FP8) d.f8scale = W34_SCALE; return; } r -= I_WO;
        if (r < 2 * I_EG) { const int up = r >= I_EG; if (up) r -= I_EG; const int e = r / 128, q = r % 128, kb = q / 8, nb = q % 8;
            d.W = F.in[up ? I_WEU : I_WEG] + (size_t)e * 1024 * 256; d.N = 256; d.WT = (bf16*)(ws + WS_WGU) + (size_t)e * 512 * 1024; d.ldo = 1024; d.rowbase = 64 * nb + (up ? 4 : 0); d.k0 = 64 * kb; d.n0 = 32 * nb; d.perm = true; d.kscale = F.in[I_GFFN]; d.f8scale = WG8_SCALE; if (P6_FP8) d.WT = (bf16*)((unsigned char*)(ws + WS_WGU) + (size_t)e * 512 * 1024); return; } r -= 2 * I_EG;
        { const int e = r / 128, q = r % 128, kb = q / 32, nb = q % 32;
            d.W = F.in[I_WED] + (size_t)e * 256 * 1024; d.N = 1024; d.WT = (bf16*)(ws + WS_WD) + (size_t)e * 1024 * 256; d.ldo = 256; d.rowbase = 32 * nb; d.k0 = 64 * kb; d.n0 = 32 * nb; d.f8scale = WD8_SCALE; if (P6_FP8) d.WT = (bf16*)((unsigned char*)(ws + WS_WD) + (size_t)e * 1024 * 256); }
    };
    {
        int it = gw; TrDesc dc, dn; f32x4 tc[8], tn[8]; float kc[8], kn[8];
        bool hc = it < NITEMS; if (hc) { decode(it, dc); tr_load(dc, lane_, tc, kc); }
        while (hc) {
            it += NGW; const bool hn = it < NITEMS;
            if (hn) { decode(it, dn); tr_load(dn, lane_, tn, kn); }
            tr_finish(dc, scr, lane_, tc, kc);
            hc = hn; dc = dn;
#pragma unroll
            for (int i = 0; i < 8; ++i) { tc[i] = tn[i]; kc[i] = kn[i]; }
        }
    }
    for (int m = gw; m < T; m += 4 * NGW) {
        const GAS f32x4* gr = (const GAS f32x4*)F.in[I_GMIX] + lane_;
        f32x4 v[4][4]; float ss[4];
#pragma unroll
        for (int r = 0; r < 4; ++r) { const int mr = (m + r * NGW < T) ? m + r * NGW : m; const GAS f32x4* xr = (const GAS f32x4*)(F.in[I_X] + (size_t)mr * D) + lane_;
#pragma unroll
            for (int j = 0; j < 4; ++j) v[r][j] = xr[64 * j]; }
#pragma unroll
        for (int r = 0; r < 4; ++r) { float a = 0.f;
#pragma unroll
            for (int j = 0; j < 4; ++j) a += (v[r][j].x * v[r][j].x + v[r][j].y * v[r][j].y) + (v[r][j].z * v[r][j].z + v[r][j].w * v[r][j].w);
            ss[r] = 1.0f / sqrtf(wave_sum(a) * (1.f / D) + RMS_EPS); }
#pragma unroll
        for (int r = 0; r < 4; ++r) { if (m + r * NGW >= T) continue; GAS unsigned* o4 = (GAS unsigned*)((unsigned char*)F.out + DO_HN + (size_t)(m + r * NGW) * D) + lane_;
#pragma unroll
            for (int j = 0; j < 4; ++j) { const f32x4 gg = gr[64 * j];
                if (P1_FP8) o4[64 * j] = pk4_fp8(v[r][j].x * ss[r] * gg.x, v[r][j].y * ss[r] * gg.y, v[r][j].z * ss[r] * gg.z, v[r][j].w * ss[r] * gg.w);
                else { v2u w; w.x = cvtpk(v[r][j].x * ss[r] * gg.x, v[r][j].y * ss[r] * gg.y); w.y = cvtpk(v[r][j].z * ss[r] * gg.z, v[r][j].w * ss[r] * gg.w); ((GAS v2u*)((unsigned char*)F.out + DO_HN + (size_t)(m + r * NGW) * D * 2) + lane_)[64 * j] = w; } } }
    }
    const int gt = F.vcu * NTHR + tid_, NGT = F.G * NTHR;
    if (gt < 32) ((float*)(ws + WS_INVF))[gt] = (float)exp2(-(double)gt * (13.287712379549449 / 32.0));
    for (int c = gt; c < NIN; c += NGT) {
        int s = c; const int e = c & 7;
        if (c < 3072 || (c >= A_W && c < A_W + 1152)) s = (c & ~63) + 4 * ((c & 63) >> 3) + (e < 4 ? e : 28 + e);
        else if (c >= A_W + B_W) s = A_W + B_W + 4 * ((c - A_W - B_W) >> 3) + (e < 4 ? e : 1020 + e);
        ((float*)(ws + WS_BIASP))[c] = F.in[I_BIN][s];
    }
    for (int i = gt; i < 32 * 3 * 64; i += NGT) {
        const int ln = i & 63, nb = (i >> 6) % 3, ks = i / 192;
        const int n = 16 * nb + (ln & 15);
        float hi[8], lo[8];
#pragma unroll
        for (int e = 0; e < 8; ++e) { const int k = 32 * ks + 8 * (ln >> 4) + e; float v = 0.f;
            if (n < 4) v = F.in[I_WRG][k * 4 + n]; else if (n < 36) v = F.in[I_WRE][k * 32 + (n - 4)];
            v *= F.in[I_GFFN][k]; hi[e] = bf2f(f2bf(v)); lo[e] = v - hi[e]; }
        v4u h, l; h.x = pk2(hi[0], hi[1]); h.y = pk2(hi[2], hi[3]); h.z = pk2(hi[4], hi[5]); h.w = pk2(hi[6], hi[7]);
        l.x = pk2(lo[0], lo[1]); l.y = pk2(lo[2], lo[3]); l.z = pk2(lo[4], lo[5]); l.w = pk2(lo[6], lo[7]);
        ((v4u*)(ws + WS_WRF))[((ks * 3 + nb) * 2 + 0) * 64 + ln] = h; ((v4u*)(ws + WS_WRF))[((ks * 3 + nb) * 2 + 1) * 64 + ln] = l;
    }
}

namespace pg8 {
#define PG8_LAS __attribute__((address_space(3)))
typedef unsigned short bf16_t;
typedef short bf16x8 __attribute__((ext_vector_type(8)));
typedef float f32x4 __attribute__((ext_vector_type(4)));
typedef unsigned u32x4 __attribute__((ext_vector_type(4)));
constexpr int BM = 256, BK = 64, HALF = 128, HTB = HALF * BK * 2  , STAGE_BYTES = 8 * HTB, NXCD = 8, WGM = 8;

__host__ __device__ __forceinline__ int lds_byte(int r, int c) { const int st = (r >> 4) * 2 + (c >> 5), rr = r & 15, cc = c & 31, ob = rr * 64 + cc * 2; return st * 1024 + (ob ^ (((ob >> 9) & 1) << 5)); }
__host__ __device__ __forceinline__ void stage_rc(int b, int& R, int& C) { const int st = b / 1024, sb = b % 1024, swz = sb ^ (((sb >> 9) & 1) << 5); R = (st >> 1) * 16 + swz / 64; C = (st & 1) * 32 + (swz % 64) / 2; }
__host__ __device__ __forceinline__ int perm32(int rho) { const int n = rho >> 4, i = rho & 15; return 8 * (i >> 2) + 4 * n + (i & 3); }

struct Unit { int pm, pn; };
struct Gemm { const bf16_t* A; const bf16_t* Bt; int M, N, K; };

struct StaticOrder {
    int nM, nN, nwg, G, c;
    __host__ __device__ void init(int M, int N, int G_, int c_) { nM = M / BM; nN = N / BM; nwg = nM * nN; G = G_; c = c_; }
    __host__ __device__ bool next(int i, Unit& u) const {
        const long L = (long)i * G + c; if (L >= nwg) return false;
        int wgid = (int)L; { const int q = nwg / NXCD, r = nwg % NXCD, xcd = wgid % NXCD, off = wgid / NXCD; wgid = (xcd < r ? xcd * (q + 1) : r * (q + 1) + (xcd - r) * q) + off; }
        const int nig = WGM * nN, gid = wgid / nig, fm = gid * WGM, gsz = (nM - fm) < WGM ? (nM - fm) : WGM;
        u.pm = fm + ((wgid % nig) % gsz); u.pn = (wgid % nig) / gsz; return true;
    }
    __device__ __forceinline__ void a_ready(const Unit&) const {}
    __device__ __forceinline__ void done(const Unit&) const {}
};
}


namespace pg9 {
using pg8::BM; using pg8::BK; using pg8::HALF; using pg8::HTB; using pg8::lds_byte; using pg8::stage_rc; using pg8::perm32;
struct Unit { int pm, pn, e; };
typedef int v8i_t __attribute__((ext_vector_type(8)));
typedef int v4i_t __attribute__((ext_vector_type(4)));
template <int ESZ, class Epi, class Sched, class AOff, class BBase>
__device__ __forceinline__ void gemm_phase(LAS unsigned char* lds, const char* Abase, int K, const Sched& S, const Epi& E, const AOff& aoffn, const BBase& bbase) {
    int tid_ = threadIdx.x; asm volatile("" : "+v"(tid_));
    const int tid = tid_, wid = __builtin_amdgcn_readfirstlane(tid >> 6), lane = tid & 63, wr = wid >> 2, wc = wid & 3, fr = lane & 15, fq = lane >> 4;
    const int nt = K * ESZ / (BK * 2);
    int Rr[2], Cc[2]; unsigned voffB[2];
#pragma unroll
    for (int i = 0; i < 2; ++i) { int R, C; stage_rc(tid * 16 + i * 8192, R, C); const int Rb = Epi::PERM ? ((R & ~31) + perm32(R & 31)) : R; Rr[i] = R; Cc[i] = C; voffB[i] = (unsigned)(Rb * K * ESZ + C * 2); }
    const size_t kstep = (size_t)(BK * 2);
    const size_t hstep = (size_t)HALF * K * ESZ;
    const unsigned ldsw = (unsigned)wid * 1024u;
    const int aoff = lds_byte(wr * 64 + fr, fq * 8), boff = lds_byte(wc * 32 + fr, fq * 8);
#define PG9_SA(b, h) (((b) * 2 + (h)) * HTB)
#define PG9_SB(b, h) ((4 + (b) * 2 + (h)) * HTB)
#define PG9_STAGE(bufoff, gbase, voff) do { _Pragma("unroll") for (int _i = 0; _i < 2; ++_i) \
        __builtin_amdgcn_global_load_lds((const unsigned*)((const char*)(gbase) + (voff)[_i]), (LAS unsigned*)(lds + (bufoff) + ldsw + _i * 8192), 16, 0, 0); } while (0)
#define PG9_LDA(dst, b, h) do { _Pragma("unroll") for (int m = 0; m < 4; ++m) { dst[m].lo = *(const LAS v4i_t*)(lds + PG9_SA(b, h) + aoff + m * 2048); dst[m].hi = *(const LAS v4i_t*)(lds + PG9_SA(b, h) + aoff + m * 2048 + 1024); } } while (0)
#define PG9_LDB(dst, b, h) do { _Pragma("unroll") for (int n = 0; n < 2; ++n) { dst[n].lo = *(const LAS v4i_t*)(lds + PG9_SB(b, h) + boff + n * 2048); dst[n].hi = *(const LAS v4i_t*)(lds + PG9_SB(b, h) + boff + n * 2048 + 1024); } } while (0)
#define PG9_HALF(v, o) __builtin_bit_cast(bf16x8, __builtin_shufflevector((v), (v), (o), (o) + 1, (o) + 2, (o) + 3))
#define PG9_MMA(ai, bj, At, Bt) do { __builtin_amdgcn_s_setprio(1); _Pragma("unroll") for (int m = 0; m < 4; ++m) _Pragma("unroll") for (int n = 0; n < 2; ++n) { \
        if (ESZ == 2) { acc[ai][bj][m][n] = __builtin_amdgcn_mfma_f32_16x16x32_bf16(PG9_HALF(Bt[n], 0), PG9_HALF(At[m], 0), acc[ai][bj][m][n], 0, 0, 0); \
                        acc[ai][bj][m][n] = __builtin_amdgcn_mfma_f32_16x16x32_bf16(PG9_HALF(Bt[n], 4), PG9_HALF(At[m], 4), acc[ai][bj][m][n], 0, 0, 0); } \
        else { asm volatile("v_mfma_scale_f32_16x16x128_f8f6f4 %0, %1, %2, %0, %3, %3 op_sel_hi:[0,0,0]" : "+v"(acc[ai][bj][m][n]) : "v"(Bt[n]), "v"(At[m]), "v"(one8)); } } \
        __builtin_amdgcn_s_setprio(0); } while (0)
#define PG9_WAIT_V(n) asm volatile("s_waitcnt vmcnt(" #n ")" ::: "memory")
#define PG9_WAIT_L(n) asm volatile("s_waitcnt lgkmcnt(" #n ")" ::: "memory")
#define PG9_BAR __builtin_amdgcn_s_barrier()
#define PG9_SCHED __builtin_amdgcn_sched_barrier(0)
#define PG9_VA(dst, u) do { _Pragma("unroll") for (int _h = 0; _h < 2; ++_h) _Pragma("unroll") for (int _i = 0; _i < 2; ++_i) dst[_h][_i] = aoffn((u), _h * HALF + Rr[_i]) + (unsigned)(Cc[_i] * 2); } while (0)
    constexpr bool GATHER = AOff::GATHER;
    const size_t hstepA = (size_t)HALF * aoffn.rowbytes;
    unsigned voffA[2];
#pragma unroll
    for (int i = 0; i < 2; ++i) voffA[i] = (unsigned)Rr[i] * aoffn.rowbytes + (unsigned)(Cc[i] * 2);
#define PG9_STAGE_A(bufoff, h, koff, nx) do { if (GATHER) { PG9_STAGE(bufoff, Abase + (koff), ((nx) ? nvA[h] : cvA[h])); } else { PG9_STAGE(bufoff, ((nx) ? nAu : cAu) + (h) * hstepA + (koff), voffA); } } while (0)
    Unit cur, nxt; int ui = 0;
    if (!S.next(0, cur)) return;
    f32x4 acc[2][2][4][2];
#pragma unroll
    for (int a = 0; a < 2; ++a)
#pragma unroll
        for (int b = 0; b < 2; ++b)
#pragma unroll
            for (int m = 0; m < 4; ++m)
#pragma unroll
                for (int n = 0; n < 2; ++n) acc[a][b][m][n] = (f32x4){0.f, 0.f, 0.f, 0.f};
    int one8 = 0x7f7f7f7f; asm volatile("" : "+v"(one8));
    v8i_t At[4], B0[2], B1[2];
    unsigned cvA[2][2], nvA[2][2];
    if (GATHER) { PG9_VA(cvA, cur); }
    const char* cAu = GATHER ? Abase : Abase + (size_t)aoffn(cur, 0); const char* nAu = cAu;
    const char* cB = bbase(cur);
    E.prefetch(lds, cur, 0, wid, lane);
    PG9_STAGE(PG9_SB(0, 0), cB, voffB); PG9_STAGE(PG9_SB(0, 1), cB + hstep, voffB); PG9_STAGE_A(PG9_SA(0, 0), 0, 0, false); PG9_STAGE_A(PG9_SA(0, 1), 1, 0, false);
    if (wr == 1) PG9_BAR;
    PG9_WAIT_V(2); PG9_BAR;
    PG9_STAGE(PG9_SB(1, 0), cB + kstep, voffB); PG9_STAGE_A(PG9_SA(1, 0), 0, kstep, false); PG9_STAGE(PG9_SB(1, 1), cB + hstep + kstep, voffB);
    PG9_WAIT_V(6); PG9_BAR;
    for (;;) {
        const bool has_next = S.next(ui + 1, nxt);
        if (GATHER) {
            if (has_next) { PG9_VA(nvA, nxt); } else {
#pragma unroll
                for (int _h = 0; _h < 2; ++_h)
#pragma unroll
                    for (int _i = 0; _i < 2; ++_i) nvA[_h][_i] = cvA[_h][_i]; }
        } else nAu = has_next ? Abase + (size_t)aoffn(nxt, 0) : cAu;
        const char* nB = has_next ? bbase(nxt) : cB;
#pragma unroll 1
        for (int t = 0; t < nt; t += 2) {
            const bool last = (t == nt - 2);
            if (Epi::HOOK_T >= 0) { if (t == Epi::HOOK_T) E.hook(acc, cur, wr, wc, fr, fq); }
            const size_t k1 = (size_t)(t + 1) * kstep, k2 = last ? 0 : (size_t)(t + 2) * kstep, k3 = k2 + kstep;
            const char* b2 = last ? nB : cB + (size_t)(t + 2) * kstep; const char* b3 = b2 + kstep;
            PG9_LDB(B0, 0, 0); PG9_LDB(B1, 0, 1); PG9_SCHED; PG9_LDA(At, 0, 0); PG9_STAGE_A(PG9_SA(1, 1), 1, k1, false);
            PG9_WAIT_V(8); PG9_WAIT_L(0); PG9_BAR; PG9_MMA(0, 0, At, B0); PG9_MMA(0, 1, At, B1); PG9_BAR; PG9_SCHED;
            PG9_LDA(At, 0, 1); PG9_STAGE(PG9_SB(0, 0), b2, voffB); PG9_STAGE(PG9_SB(0, 1), b2 + hstep, voffB); PG9_STAGE_A(PG9_SA(0, 0), 0, k2, last);
            PG9_WAIT_V(8); PG9_WAIT_L(0); PG9_BAR; PG9_MMA(1, 0, At, B0); PG9_MMA(1, 1, At, B1); PG9_BAR; PG9_SCHED;
            PG9_LDB(B0, 1, 0); PG9_LDB(B1, 1, 1); PG9_SCHED; PG9_LDA(At, 1, 0); PG9_STAGE_A(PG9_SA(0, 1), 1, k2, last);
            PG9_WAIT_V(8); PG9_WAIT_L(0); PG9_BAR; PG9_MMA(0, 0, At, B0); PG9_MMA(0, 1, At, B1); PG9_BAR; PG9_SCHED;
            PG9_LDA(At, 1, 1); PG9_STAGE(PG9_SB(1, 0), b3, voffB); PG9_STAGE(PG9_SB(1, 1), b3 + hstep, voffB); PG9_STAGE_A(PG9_SA(1, 0), 0, k3, last);
            PG9_WAIT_V(8); PG9_WAIT_L(0); PG9_BAR; PG9_MMA(1, 0, At, B0); PG9_MMA(1, 1, At, B1); PG9_BAR; PG9_SCHED;
        }
        if (wr == 0) PG9_BAR;
        if (ESZ == 1) asm volatile("s_nop 15\n\ts_nop 15" ::: "memory");
        E(acc, cur, ui, wr, wc, fr, fq);
        if (!has_next) break;
#pragma unroll
        for (int a = 0; a < 2; ++a)
#pragma unroll
            for (int b = 0; b < 2; ++b)
#pragma unroll
                for (int m = 0; m < 4; ++m)
#pragma unroll
                    for (int n = 0; n < 2; ++n) acc[a][b][m][n] = (f32x4){0.f, 0.f, 0.f, 0.f};
        cur = nxt; cB = nB; cAu = nAu; ++ui;
        E.prefetch(lds, cur, ui, wid, lane);
        if (GATHER) {
#pragma unroll
            for (int _h = 0; _h < 2; ++_h)
#pragma unroll
                for (int _i = 0; _i < 2; ++_i) cvA[_h][_i] = nvA[_h][_i]; }
        if (wr == 1) PG9_BAR;
    }
    PG9_WAIT_V(0);
    PG9_BAR;
#undef PG9_SA
#undef PG9_SB
#undef PG9_STAGE
#undef PG9_LDA
#undef PG9_LDB
#undef PG9_MMA
#undef PG9_HALF
#undef PG9_WAIT_V
#undef PG9_WAIT_L
#undef PG9_BAR
#undef PG9_SCHED
#undef PG9_VA
#undef PG9_STAGE_A
}
struct DenseOrder { pg8::StaticOrder so;
    __device__ void init(int M, int N, int G, int c) { so.init(M, N, G, c); }
    __device__ bool next(int i, Unit& u) const { pg8::Unit v; if (!so.next(i, v)) return false; u.pm = v.pm; u.pn = v.pn; u.e = 0; return true; } };
struct DenseA { static constexpr bool GATHER = false; unsigned rowbytes; __device__ __forceinline__ unsigned operator()(const Unit& u, int row) const { return (unsigned)(u.pm * 256 + row) * rowbytes; } };
struct DenseB { const char* Bt; size_t tilebytes; __device__ __forceinline__ const char* operator()(const Unit& u) const { return Bt + (size_t)u.pn * tilebytes; } };
}

struct EpiInproj {
    static constexpr bool PERM = true; static constexpr int HOOK_T = -1;
    bf16* ZA; bf16* ZB; bf16* Gt; const float* biasP; LAS unsigned char* ldsb;
    __device__ __forceinline__ void hook(f32x4 (&)[2][2][4][2], const pg9::Unit&, int, int, int, int) const {}
    __device__ __forceinline__ void prefetch(LAS unsigned char* lds, const pg9::Unit& u, int ui, int wid, int lane) const {
        if (wid == 0) __builtin_amdgcn_global_load_lds((const unsigned*)(biasP + u.pn * 256 + lane * 4), (LAS unsigned*)(lds + LDS_MISC + 4096 + (ui & 1) * 1024), 16, 0, 0);
    }
    __device__ __forceinline__ void operator()(const f32x4 (&acc)[2][2][4][2], const pg9::Unit& u, int ui, int wr, int wc, int fr, int fq) const {
        asm volatile("" : "+v"(fr), "+v"(fq));
        const int row0 = u.pm * 256 + wr * 64 + fr;
        const int q = 4 * (wc & 1) + fq;
        const int fr2 = (fr >> 2) + 4 * fq, fq2 = fr & 3, paddr = 4 * (16 * (fr & 3) + 4 * fq + (fr >> 2));
        const int row0s = u.pm * 256 + wr * 64 + fr2;
        int kind[2]; bf16* dst[2]; int ldd[2]; f32x4 b0[2], b1[2];
#pragma unroll
        for (int bj = 0; bj < 2; ++bj) {
            const int colpos = u.pn * 256 + bj * 128 + wc * 32 + 8 * fq, colposs = u.pn * 256 + bj * 128 + wc * 32 + 8 * fq2, hb = u.pn * 256 + bj * 128 + (wc >> 1) * 64;
            if (hb < A_W) { kind[bj] = hb / 1536; dst[bj] = ZA + colposs; ldd[bj] = A_W; }
            else if (hb < A_W + B_W) { const int cb = hb - A_W; kind[bj] = cb < 1024 ? 0 : (cb < 1152 ? 1 : 2); dst[bj] = ZB + (colposs - A_W); ldd[bj] = B_W; }
            else { kind[bj] = 3; const int c0 = (colpos - A_W - B_W) >> 1;
                dst[bj] = Gt + ((size_t)((u.pm * 256 + wr * 64) >> 4) * 256 + (c0 >> 3)) * 128 + fr * 8 + (c0 & 7); ldd[bj] = 0; }
            const LAS float* bs = (const LAS float*)(ldsb + LDS_MISC + 4096 + (ui & 1) * 1024) + bj * 128 + wc * 32 + 8 * fq;
            b0[bj] = *(const LAS f32x4*)bs; b1[bj] = *(const LAS f32x4*)(bs + 4);
        }
        const bool need_rope = kind[0] < 2 || kind[1] < 2;
        const f32x4 fv = *(const LAS f32x4*)(ldsb + LDS_MISC + 6144 + 16 * q);
#pragma unroll
        for (int ai = 0; ai < 2; ++ai) {
            f32x4 rc[4], rs[4];
#pragma unroll
            for (int m = 0; m < 4; ++m) { rc[m] = (f32x4){1.f, 1.f, 1.f, 1.f}; rs[m] = (f32x4){0.f, 0.f, 0.f, 0.f}; }
            if (need_rope) {
#pragma unroll
                for (int m = 0; m < 4; ++m) { const float posf = (float)((row0 + ai * 128 + m * 16) & (SEQ - 1));
#pragma unroll
                    for (int e = 0; e < 4; ++e) { const float ang = posf * fv[e]; const float pr = ang * 0.15915494f; const float er = __builtin_fmaf(ang, 0.15915494f, -pr) + ang * 6.4206382e-9f;
                        const float fr = __builtin_amdgcn_fractf(pr) + er; rc[m][e] = __builtin_amdgcn_cosf(fr); rs[m][e] = __builtin_amdgcn_sinf(fr); } }
            }
#pragma unroll
            for (int bj = 0; bj < 2; ++bj) {
                bf16* p = dst[bj] + (unsigned)(row0s + ai * 128) * (unsigned)ldd[bj]; const unsigned step = 16u * (unsigned)ldd[bj];
                if (kind[bj] == 3) p = dst[bj] + (size_t)(ai * 8) * 32768;
                switch (kind[bj]) {
                    case 0: store4<0>(acc[ai][bj], b0[bj], b1[bj], rc, rs, p, step, paddr); break;
                    case 1: store4<1>(acc[ai][bj], b0[bj], b1[bj], rc, rs, p, step, paddr); break;
                    case 2: store4<2>(acc[ai][bj], b0[bj], b1[bj], rc, rs, p, step, paddr); break;
                    default: store4<3>(acc[ai][bj], b0[bj], b1[bj], rc, rs, p, step, paddr); break;
                }
            }
        }
    }
    template <int KIND> static __device__ __forceinline__ void store4(const f32x4 (&a)[4][2], const f32x4 b0, const f32x4 b1, const f32x4 (&rc)[4], const f32x4 (&rs)[4], bf16* p, const unsigned step, const int paddr) {
#pragma unroll
        for (int m = 0; m < 4; ++m) {
            f32x4 v0 = a[m][0] * W8_INV + b0, v1 = a[m][1] * W8_INV + b1;
            if (KIND < 2) {
                const f32x4 cc = rc[m], ss = rs[m];
                const f32x4 t0 = v0 * cc - v1 * ss, t1 = v1 * cc + v0 * ss;
                v0 = t0; v1 = t1;
                if (KIND == 0) { v0 = v0 * QSCALE; v1 = v1 * QSCALE; }
            }
            if (KIND == 3) {
#pragma unroll
                for (int e = 0; e < 4; ++e) { const float d0 = 1.0f + __expf(-v0[e]), d1 = 1.0f + __expf(-v1[e]); v0[e] = d1 * __builtin_amdgcn_rcpf(d0); v1[e] = __builtin_amdgcn_rcpf(d1); }
                v2u w0, w1; w0.x = cvtpk(v0[0], v0[1]); w0.y = cvtpk(v0[2], v0[3]); w1.x = cvtpk(v1[0], v1[1]); w1.y = cvtpk(v1[2], v1[3]);
                *(GAS v2u*)p = w0; *(GAS v2u*)(p + 128 * 128) = w1; p += 32768;
            } else {
                v4u w; w.x = cvtpk(v0[0], v0[1]); w.y = cvtpk(v0[2], v0[3]); w.z = cvtpk(v1[0], v1[1]); w.w = cvtpk(v1[2], v1[3]);
                w.x = (unsigned)__builtin_amdgcn_ds_bpermute(paddr, (int)w.x); w.y = (unsigned)__builtin_amdgcn_ds_bpermute(paddr, (int)w.y); w.z = (unsigned)__builtin_amdgcn_ds_bpermute(paddr, (int)w.z); w.w = (unsigned)__builtin_amdgcn_ds_bpermute(paddr, (int)w.w);
                *(GAS v4u*)p = w; p += step;
            }
        }
    }
};
__device__ __forceinline__ void p1_inproj(Frame& F, int ch) {
    unsigned char* ws = F.ws;
    pg9::DenseOrder S; S.init(TC, NIN, F.G, (int)blockIdx.x);
    EpiInproj E{(bf16*)(ws + WS_ZA), (bf16*)(ws + WS_ZB), (bf16*)(ws + WS_G) + (size_t)ch * TC * G_W, (const float*)(ws + WS_BIASP), F.lds};
    if (F.tid < 32) ((LAS float*)(F.lds + LDS_MISC + 6144))[F.tid] = ((const float*)(ws + WS_INVF))[F.tid];
    constexpr int ES = P1_FP8 ? 1 : 2;
    pg9::DenseA ao{(unsigned)(D * ES)}; pg9::DenseB bb{(const char*)(ws + WS_WIN), (size_t)256 * D * ES};
    pg9::gemm_phase<ES>(F.lds, (const char*)F.out + DO_HN + (size_t)ch * TC * D * ES, D, S, E, ao, bb);
}

typedef float f32x16 __attribute__((ext_vector_type(16)));
typedef short v4i16_t __attribute__((ext_vector_type(4)));
__device__ __forceinline__ float half_max(float v) { auto rr = __builtin_amdgcn_permlane32_swap(__float_as_uint(v), __float_as_uint(v), false, false); return fmaxf(__uint_as_float(rr[0]), __uint_as_float(rr[1])); }
__device__ __forceinline__ float half_sum(float v) { auto rr = __builtin_amdgcn_permlane32_swap(__float_as_uint(v), __float_as_uint(v), false, false); return __uint_as_float(rr[0]) + __uint_as_float(rr[1]); }
__device__ __forceinline__ float max3f(float a, float b, float c) { float r; asm("v_max3_f32 %0, %1, %2, %3" : "=v"(r) : "v"(a), "v"(b), "v"(c)); return r; }
constexpr int ATT_VOFF = 49152;

struct AUnit { const bf16 *Kw, *Vw, *Qp; size_t pitch; int kk_lo, nkeys, kb0, kstart, lo; float m0, l0; bf16* Op; float* Lp; int o8; };
__device__ __forceinline__ void attn_decode(Frame& F, int ch, int u, int NUA, int lane, AUnit& d) {
    unsigned char* ws = F.ws;
    const int w = F.wave, c = lane & 31, h = (lane >> 5) & 1;
    if (u < NUA) {
        const bf16* ZA = (const bf16*)(ws + WS_ZA);
        const int rt = u & 15, hh = (u >> 4) & 7, gb = u >> 7, g = gb % 3, bl = gb / 3;
        const int dsh = 2 * g, dd = 1 << dsh, tsh = 4 - dsh;
        const int r = rt >> tsh, tile = rt & ((1 << tsh) - 1), i0 = tile * 256;
        const int rowb = bl * SEQ + r, col = g * 512 + hh * 64;
        d.pitch = (size_t)dd * A_W;
        d.Kw = ZA + ((long)rowb + (long)dd * (i0 - 128)) * A_W + 1536 + col; d.Vw = d.Kw + 1536;
        const long qrow = (long)rowb + (long)dd * (i0 + 32 * w + c);
        d.Qp = ZA + qrow * A_W + col;
        d.kk_lo = (i0 == 0) ? 128 : 0; d.nkeys = 384; d.kb0 = w; d.kstart = (i0 == 0) ? (w < 4 ? 4 - w : 0) : 0; d.lo = 0;
        d.m0 = -1e30f; d.l0 = 0.f;
        d.Op = (bf16*)((unsigned char*)F.out + DO_OG) + ((size_t)g * TC + qrow) * 512 + hh * 64;
        d.Lp = (float*)((unsigned char*)F.out + DO_LSE) + ((size_t)g * TC + qrow) * 8 + hh;
        d.o8 = 0;
    } else {
        const int u2 = u - NUA;
        const bf16* ZB = (const bf16*)(ws + WS_ZB);
        const int blk = u2 & 127, kvh = (u2 >> 7) & 1, bl = u2 >> 8;
        const int t0 = blk * 32, rowb = bl * SEQ;
        d.pitch = B_W;
        d.Kw = ZB + ((long)rowb + t0 - 128) * B_W + 1024 + kvh * 64; d.Vw = d.Kw + 128;
        const int qh = kvh * 8 + w;
        const long qrow = (long)rowb + t0 + c;
        d.Qp = ZB + qrow * B_W + qh * 64;
        d.kk_lo = t0 < 128 ? 128 - t0 : 0; d.nkeys = 160; d.kb0 = 0; d.kstart = d.kk_lo >> 5; d.lo = 1;
        d.m0 = F.in[I_SINK][qh] * LOG2E; d.l0 = h == 0 ? 1.f : 0.f;
        d.o8 = P34_FP8;
        d.Op = P34_FP8 ? (bf16*)(ws + WS_Y + ((size_t)ch * TC + qrow) * Y_W + 512 + qh * 64) : (bf16*)(ws + WS_Y) + ((size_t)ch * TC + qrow) * Y_W + 512 + qh * 64;
        d.Lp = nullptr;
    }
}
__device__ __forceinline__ void attn_load(const AUnit& d, int tid, int lane, v4u (&kreg)[6], v4u (&vreg)[6], bf16x8 (&qf)[4]) {
    const int skey = tid >> 3, sch = tid & 7, h = (lane >> 5) & 1;
#pragma unroll
    for (int s4 = 0; s4 < 4; ++s4) qf[s4] = *(const GAS bf16x8*)(d.Qp + 16 * s4 + 8 * h);
#pragma unroll
    for (int p = 0; p < 6; ++p) { const int kk = 64 * p + skey;
        if (kk >= d.kk_lo && kk < d.nkeys) { kreg[p] = *(const GAS v4u*)(d.Kw + (size_t)kk * d.pitch + 8 * sch); vreg[p] = *(const GAS v4u*)(d.Vw + (size_t)kk * d.pitch + 8 * sch); } }
}
__device__ __forceinline__ void attn_write(const AUnit& d, LAS unsigned char* KL, LAS unsigned char* VL, int tid, const v4u (&kreg)[6], const v4u (&vreg)[6]) {
    const int skey = tid >> 3, sch = tid & 7;
#pragma unroll
    for (int p = 0; p < 6; ++p) { const int kk = 64 * p + skey;
        if (kk >= d.kk_lo && kk < d.nkeys) {
            *(LAS v4u*)(KL + kk * 128 + ((sch ^ ((kk >> 1) & 7)) << 4)) = kreg[p];
            *(LAS v4u*)(VL + kk * 128 + ((sch * 16) ^ (((kk >> 1) & 1) << 6))) = vreg[p]; } }
}
__device__ __forceinline__ void attn_compute_edge(const AUnit& d, const LAS unsigned char* KL, const LAS unsigned char* VL, int lane, const bf16x8 (&qf)[4]) {
    const int c = lane & 31, h = (lane >> 5) & 1;
    int koff[4];
    { const int kswz = (c >> 1) & 7;
#pragma unroll
      for (int s4 = 0; s4 < 4; ++s4) koff[s4] = c * 128 + (((2 * s4 + h) ^ kswz) << 4); }
    const int vrow = 4 * h + ((lane & 15) >> 2), vsw = (lane >> 3) & 1;
    const int voff0 = vrow * 128 + ((32 * ((lane >> 4) & 1) + 8 * (lane & 3)) ^ (vsw << 6)), voff1 = voff0 ^ 64;
    const float NEG = -INFINITY;
    float m = d.m0, l = d.l0;
    f32x16 o0, o1;
#pragma unroll
    for (int i = 0; i < 16; ++i) { o0[i] = 0.f; o1[i] = 0.f; }
    const LAS unsigned char* kbp = KL + d.kb0 * 4096; const LAS unsigned char* vbp = VL + d.kb0 * 4096;
    const int clo = c + d.lo;
#pragma unroll
    for (int kbi = 0; kbi < 5; ++kbi) {
        if (kbi >= d.kstart) {
            f32x16 p;
#pragma unroll
            for (int i = 0; i < 16; ++i) p[i] = 0.f;
#pragma unroll
            for (int s4 = 0; s4 < 4; ++s4) { const bf16x8 kf = *(const LAS bf16x8*)(kbp + kbi * 4096 + koff[s4]); p = __builtin_amdgcn_mfma_f32_32x32x16_bf16(kf, qf[s4], p, 0, 0, 0); }
            if (kbi == 0) {
#pragma unroll
                for (int i = 0; i < 16; ++i) { const int x = (i & 3) + 8 * (i >> 2) + 4 * h; if (x < clo) p[i] = NEG; }
            }
            if (kbi == 4) {
#pragma unroll
                for (int i = 0; i < 16; ++i) { const int x = (i & 3) + 8 * (i >> 2) + 4 * h; if (x > c) p[i] = NEG; }
            }
            float mt = p[0];
#pragma unroll
            for (int i = 1; i < 16; ++i) mt = fmaxf(mt, p[i]);
            mt = half_max(mt);
            const float mn = fmaxf(m, mt), alpha = __builtin_amdgcn_exp2f(m - mn);
            m = mn;
            float ps = 0.f;
#pragma unroll
            for (int i = 0; i < 16; ++i) { p[i] = __builtin_amdgcn_exp2f(p[i] - mn); ps += p[i]; }
            l = l * alpha + ps;
#pragma unroll
            for (int i = 0; i < 16; ++i) { o0[i] *= alpha; o1[i] *= alpha; }
            bf16x8 pb[2];
#pragma unroll
            for (int s2 = 0; s2 < 2; ++s2) { v4u t; t.x = cvtpk(p[8 * s2 + 0], p[8 * s2 + 1]); t.y = cvtpk(p[8 * s2 + 2], p[8 * s2 + 3]); t.z = cvtpk(p[8 * s2 + 4], p[8 * s2 + 5]); t.w = cvtpk(p[8 * s2 + 6], p[8 * s2 + 7]); pb[s2] = __builtin_bit_cast(bf16x8, t); }
#pragma unroll
            for (int s2 = 0; s2 < 2; ++s2) {
#pragma unroll
                for (int db = 0; db < 2; ++db) {
                    const LAS unsigned char* vp = vbp + kbi * 4096 + s2 * 2048 + (db ? voff1 : voff0);
                    const v4i16_t lo = __builtin_amdgcn_ds_read_tr16_b64_v4i16((LAS v4i16_t*)vp);
                    const v4i16_t hi = __builtin_amdgcn_ds_read_tr16_b64_v4i16((LAS v4i16_t*)(vp + 1024));
                    const bf16x8 vf = {lo[0], lo[1], lo[2], lo[3], hi[0], hi[1], hi[2], hi[3]};
                    if (db == 0) o0 = __builtin_amdgcn_mfma_f32_32x32x16_bf16(vf, pb[s2], o0, 0, 0, 0);
                    else o1 = __builtin_amdgcn_mfma_f32_32x32x16_bf16(vf, pb[s2], o1, 0, 0, 0);
                }
            }
        }
    }
    const float lt = half_sum(l), inv = 1.0f / lt;
#pragma unroll
    for (int g4 = 0; g4 < 4; ++g4) {
        v2u a, b;
        a.x = cvtpk(o0[4 * g4 + 0] * inv, o0[4 * g4 + 1] * inv); a.y = cvtpk(o0[4 * g4 + 2] * inv, o0[4 * g4 + 3] * inv);
        b.x = cvtpk(o1[4 * g4 + 0] * inv, o1[4 * g4 + 1] * inv); b.y = cvtpk(o1[4 * g4 + 2] * inv, o1[4 * g4 + 3] * inv);
        if (d.o8) { unsigned char* o8p = (unsigned char*)d.Op; const float sc = inv * Y8_SCALE;
            *(GAS unsigned*)(o8p + 8 * g4 + 4 * h) = pk4_fp8(o0[4 * g4 + 0] * sc, o0[4 * g4 + 1] * sc, o0[4 * g4 + 2] * sc, o0[4 * g4 + 3] * sc);
            *(GAS unsigned*)(o8p + 32 + 8 * g4 + 4 * h) = pk4_fp8(o1[4 * g4 + 0] * sc, o1[4 * g4 + 1] * sc, o1[4 * g4 + 2] * sc, o1[4 * g4 + 3] * sc); }
        else {
        *(GAS v2u*)(d.Op + 8 * g4 + 4 * h) = a;
        *(GAS v2u*)(d.Op + 32 + 8 * g4 + 4 * h) = b; }
    }
    if (d.Lp) { if (h == 0) *d.Lp = m + __builtin_amdgcn_logf(lt); }
}
__device__ __forceinline__ void attn_compute(const AUnit& d, const LAS unsigned char* KL, const LAS unsigned char* VL, int lane, const bf16x8 (&qf)[4]) {
    const int c = lane & 31, h = (lane >> 5) & 1;
    int koff[4];
    { const int kswz = (c >> 1) & 7;
#pragma unroll
      for (int s4 = 0; s4 < 4; ++s4) koff[s4] = c * 128 + (((2 * s4 + h) ^ kswz) << 4); }
    const int vrow = 4 * h + ((lane & 15) >> 2), vsw = (lane >> 3) & 1;
    const int voff0 = vrow * 128 + ((32 * ((lane >> 4) & 1) + 8 * (lane & 3)) ^ (vsw << 6)), voff1 = voff0 ^ 64;
    const float NEG = -INFINITY;
    float m = d.m0;
    f32x16 o0, o1, L;
#pragma unroll
    for (int i = 0; i < 16; ++i) { o0[i] = 0.f; o1[i] = 0.f; L[i] = 0.f; }
    v4u onesu = {0x3F803F80u, 0x3F803F80u, 0x3F803F80u, 0x3F803F80u}; asm volatile("" : "+v"(onesu));
    const bf16x8 ones = __builtin_bit_cast(bf16x8, onesu);
    const LAS unsigned char* kbp = KL + d.kb0 * 4096; const LAS unsigned char* vbp = VL + d.kb0 * 4096;
    const int clo = c + d.lo;
#pragma unroll
    for (int kbi = 0; kbi < 5; ++kbi) {
        {
            constexpr bool first_dummy = false; (void)first_dummy;
            const bool first = (kbi == 0);
            const float cinit = first ? 0.f : -m;
            f32x16 p;
#pragma unroll
            for (int i = 0; i < 16; ++i) p[i] = cinit;
#pragma unroll
            for (int s4 = 0; s4 < 4; ++s4) { const bf16x8 kf = *(const LAS bf16x8*)(kbp + kbi * 4096 + koff[s4]); p = __builtin_amdgcn_mfma_f32_32x32x16_bf16(kf, qf[s4], p, 0, 0, 0); }
            if (kbi == 0) {
#pragma unroll
                for (int i = 0; i < 16; ++i) { const int x = (i & 3) + 8 * (i >> 2) + 4 * h; p[i] = x < clo ? NEG : p[i]; }
            }
            if (kbi == 4) {
#pragma unroll
                for (int i = 0; i < 16; ++i) { const int x = (i & 3) + 8 * (i >> 2) + 4 * h; p[i] = x > c ? NEG : p[i]; }
            }
            float t0 = max3f(p[0], p[4], p[8]), t1 = max3f(p[1], p[5], p[9]), t2 = max3f(p[2], p[6], p[10]), t3 = max3f(p[3], p[7], p[11]);
            t0 = max3f(t0, p[12], p[13]); t1 = max3f(t1, p[14], p[15]);
            const float mt = half_max(max3f(max3f(t0, t1, t2), t3, t3));
            if (first) {
                const float mn = fmaxf(m, mt), l0 = d.m0 > -1e29f ? __builtin_amdgcn_exp2f(m - mn) : 0.f;
                m = mn;
#pragma unroll
                for (int i = 0; i < 16; ++i) { p[i] -= mn; L[i] = l0; }
            } else if (__any(mt > 8.0f)) {
                const float dl = fmaxf(mt, 0.f), al = __builtin_amdgcn_exp2f(-dl);
                m += dl;
#pragma unroll
                for (int i = 0; i < 16; ++i) { o0[i] *= al; o1[i] *= al; L[i] *= al; p[i] -= dl; }
            }
#pragma unroll
            for (int i = 0; i < 16; ++i) p[i] = __builtin_amdgcn_exp2f(p[i]);
            bf16x8 pb[2];
#pragma unroll
            for (int s2 = 0; s2 < 2; ++s2) { v4u t; t.x = cvtpk(p[8 * s2 + 0], p[8 * s2 + 1]); t.y = cvtpk(p[8 * s2 + 2], p[8 * s2 + 3]); t.z = cvtpk(p[8 * s2 + 4], p[8 * s2 + 5]); t.w = cvtpk(p[8 * s2 + 6], p[8 * s2 + 7]); pb[s2] = __builtin_bit_cast(bf16x8, t); }
#pragma unroll
            for (int s2 = 0; s2 < 2; ++s2) {
                L = __builtin_amdgcn_mfma_f32_32x32x16_bf16(ones, pb[s2], L, 0, 0, 0);
#pragma unroll
                for (int db = 0; db < 2; ++db) {
                    const LAS unsigned char* vp = vbp + kbi * 4096 + s2 * 2048 + (db ? voff1 : voff0);
                    const v4i16_t lo = __builtin_amdgcn_ds_read_tr16_b64_v4i16((LAS v4i16_t*)vp);
                    const v4i16_t hi = __builtin_amdgcn_ds_read_tr16_b64_v4i16((LAS v4i16_t*)(vp + 1024));
                    const bf16x8 vf = {lo[0], lo[1], lo[2], lo[3], hi[0], hi[1], hi[2], hi[3]};
                    if (db == 0) o0 = __builtin_amdgcn_mfma_f32_32x32x16_bf16(vf, pb[s2], o0, 0, 0, 0);
                    else o1 = __builtin_amdgcn_mfma_f32_32x32x16_bf16(vf, pb[s2], o1, 0, 0, 0);
                }
            }
        }
    }
    const float lt = L[0], inv = 1.0f / lt;
#pragma unroll
    for (int g4 = 0; g4 < 4; ++g4) {
        v2u a, b;
        a.x = cvtpk(o0[4 * g4 + 0] * inv, o0[4 * g4 + 1] * inv); a.y = cvtpk(o0[4 * g4 + 2] * inv, o0[4 * g4 + 3] * inv);
        b.x = cvtpk(o1[4 * g4 + 0] * inv, o1[4 * g4 + 1] * inv); b.y = cvtpk(o1[4 * g4 + 2] * inv, o1[4 * g4 + 3] * inv);
        if (d.o8) { unsigned char* o8p = (unsigned char*)d.Op; const float sc = inv * Y8_SCALE;
            *(GAS unsigned*)(o8p + 8 * g4 + 4 * h) = pk4_fp8(o0[4 * g4 + 0] * sc, o0[4 * g4 + 1] * sc, o0[4 * g4 + 2] * sc, o0[4 * g4 + 3] * sc);
            *(GAS unsigned*)(o8p + 32 + 8 * g4 + 4 * h) = pk4_fp8(o1[4 * g4 + 0] * sc, o1[4 * g4 + 1] * sc, o1[4 * g4 + 2] * sc, o1[4 * g4 + 3] * sc); }
        else {
        *(GAS v2u*)(d.Op + 8 * g4 + 4 * h) = a;
        *(GAS v2u*)(d.Op + 32 + 8 * g4 + 4 * h) = b; }
    }
    if (d.Lp) { if (h == 0) *d.Lp = m + __builtin_amdgcn_logf(lt); }
}
__device__ __forceinline__ void p2_attn(Frame& F, int ch) {
    int tid_ = threadIdx.x; asm volatile("" : "+v"(tid_));
    const int tid = tid_, lane = tid & 63;
    LAS unsigned char* KL = F.lds; LAS unsigned char* VL = F.lds + ATT_VOFF;
    constexpr int NUA = (TC / SEQ) * 3 * 8 * 16, NUB = (TC / SEQ) * 2 * 128, NU = NUA + NUB;
    int u = F.vcu;
    if (u >= NU) return;
    AUnit cur, nxt;
    v4u kreg[6], vreg[6]; bf16x8 qn[4];
    attn_decode(F, ch, u, NUA, lane, cur);
    attn_load(cur, tid, lane, kreg, vreg, qn);
    for (;;) {
        attn_write(cur, KL, VL, tid, kreg, vreg);
        bf16x8 qf[4];
#pragma unroll
        for (int s4 = 0; s4 < 4; ++s4) qf[s4] = qn[s4];
        __syncthreads();
        const int un = u + F.G; const bool has_next = un < NU;
        if (has_next) { attn_decode(F, ch, un, NUA, lane, nxt); attn_load(nxt, tid, lane, kreg, vreg, qn); }
        if (cur.kk_lo == 0) attn_compute(cur, KL, VL, lane, qf); else attn_compute_edge(cur, KL, VL, lane, qf);
        __syncthreads();
        if (!has_next) break;
        cur = nxt; u = un;
    }
}
__device__ __forceinline__ void p2_combine(Frame& F, int ch, int cu, int ncu) {
    int tid_ = threadIdx.x; asm volatile("" : "+v"(tid_)); const int lane_ = tid_ & 63;
    unsigned char* ws = F.ws;
    const bf16* OG = (const bf16*)((const unsigned char*)F.out + DO_OG); const float* LSE = (const float*)((const unsigned char*)F.out + DO_LSE);
    bf16* Y = (bf16*)(ws + WS_Y) + (size_t)ch * TC * Y_W; unsigned char* Y8 = ws + WS_Y + (size_t)ch * TC * Y_W;
    const int lane = lane_, hd = lane >> 3;
    const int gw = cu * NWAVES + F.wave, NGW = ncu * NWAVES;
    for (int row0 = gw; row0 < TC; row0 += 4 * NGW) {
        float lg[4][3]; v4u og[4][3];
#pragma unroll
        for (int r = 0; r < 4; ++r) { const int row = row0 + r * NGW < TC ? row0 + r * NGW : row0;
#pragma unroll
            for (int g = 0; g < 3; ++g) { lg[r][g] = LSE[((size_t)g * TC + row) * 8 + hd]; og[r][g] = *(const GAS v4u*)(OG + ((size_t)g * TC + row) * 512 + lane * 8); } }
#pragma unroll
        for (int r = 0; r < 4; ++r) { const int row = row0 + r * NGW; if (row >= TC) continue;
            const float mx = fmaxf(fmaxf(lg[r][0], lg[r][1]), lg[r][2]);
            float e[3]; e[0] = __builtin_amdgcn_exp2f(lg[r][0] - mx); e[1] = __builtin_amdgcn_exp2f(lg[r][1] - mx); e[2] = __builtin_amdgcn_exp2f(lg[r][2] - mx);
            const float inv = 1.0f / (e[0] + e[1] + e[2]);
            float acc[8];
#pragma unroll
            for (int i = 0; i < 8; ++i) acc[i] = 0.f;
#pragma unroll
            for (int g = 0; g < 3; ++g) { const float wg = e[g] * inv; const v4u o_ = og[r][g];
                acc[0] += wg * bflo(o_.x); acc[1] += wg * bfhi(o_.x); acc[2] += wg * bflo(o_.y); acc[3] += wg * bfhi(o_.y);
                acc[4] += wg * bflo(o_.z); acc[5] += wg * bfhi(o_.z); acc[6] += wg * bflo(o_.w); acc[7] += wg * bfhi(o_.w); }
            v4u o; o.x = cvtpk(acc[0], acc[1]); o.y = cvtpk(acc[2], acc[3]); o.z = cvtpk(acc[4], acc[5]); o.w = cvtpk(acc[6], acc[7]);
            if (P34_FP8) { v2u o8; o8.x = pk4_fp8(acc[0] * Y8_SCALE, acc[1] * Y8_SCALE, acc[2] * Y8_SCALE, acc[3] * Y8_SCALE); o8.y = pk4_fp8(acc[4] * Y8_SCALE, acc[5] * Y8_SCALE, acc[6] * Y8_SCALE, acc[7] * Y8_SCALE); *(GAS v2u*)(Y8 + (size_t)row * Y_W + lane * 8) = o8; }
            else *(GAS v4u*)(Y + (size_t)row * Y_W + lane * 8) = o; }
    }
}


struct EpiMerge {
    static constexpr bool PERM = true; static constexpr int HOOK_T = P34_FP8 ? 4 : 8;
    const bf16* Gt; bf16* MG;
    __device__ __forceinline__ void prefetch(LAS unsigned char*, const pg9::Unit&, int, int, int) const {}
    __device__ __forceinline__ void hook(f32x4 (&acc)[2][2][4][2], const pg9::Unit& u, int wr, int wc, int fr, int fq) const {
        asm volatile("" : "+v"(fr), "+v"(fq));
        const bf16* gr = Gt + ((size_t)((u.pm * 256 + wr * 64) >> 4) * 256 + u.pn * 32 + wc * 4 + fq) * 128 + fr * 8;
        v4u rv[8][2];
#pragma unroll
        for (int rg = 0; rg < 8; ++rg)
#pragma unroll
            for (int bj = 0; bj < 2; ++bj) rv[rg][bj] = *(const GAS v4u*)(gr + (size_t)((rg >> 2) * 8 + (rg & 3)) * 32768 + bj * 16 * 128);
#pragma unroll
        for (int rg = 0; rg < 8; ++rg)
#pragma unroll
            for (int bj = 0; bj < 2; ++bj) { const v4u a = rv[rg][bj];
                const f32x4 r0 = {bflo(a.x), bfhi(a.x), bflo(a.y), bfhi(a.y)}, r1 = {bflo(a.z), bfhi(a.z), bflo(a.w), bfhi(a.w)};
                acc[rg >> 2][bj][rg & 3][0] = acc[rg >> 2][bj][rg & 3][0] * r0; acc[rg >> 2][bj][rg & 3][1] = acc[rg >> 2][bj][rg & 3][1] * r1; }
    }
    __device__ __forceinline__ void operator()(const f32x4 (&acc)[2][2][4][2], const pg9::Unit& u, int ui, int wr, int wc, int fr, int fq) const {
        asm volatile("" : "+v"(fr), "+v"(fq));
        const bf16* gr = Gt + ((size_t)((u.pm * 256 + wr * 64) >> 4) * 256 + 128 + u.pn * 32 + wc * 4 + fq) * 128 + fr * 8;
        const int fr2 = (fr >> 2) + 4 * fq, fq2 = fr & 3, paddr = 4 * (16 * (fr & 3) + 4 * fq + (fr >> 2));
        bf16* mr = MG + (size_t)(u.pm * 256 + wr * 64 + fr2) * D + u.pn * 256 + wc * 32 + 8 * fq2;
        v4u gb[8][2];
#pragma unroll
        for (int rg = 0; rg < 8; ++rg)
#pragma unroll
            for (int bj = 0; bj < 2; ++bj) gb[rg][bj] = *(const GAS v4u*)(gr + (size_t)((rg >> 2) * 8 + (rg & 3)) * 32768 + bj * 16 * 128);
#pragma unroll
        for (int rg = 0; rg < 8; ++rg)
#pragma unroll
            for (int bj = 0; bj < 2; ++bj) { const v4u b = gb[rg][bj];
                const f32x4 v0 = acc[rg >> 2][bj][rg & 3][0], v1 = acc[rg >> 2][bj][rg & 3][1];
                if (P34_FP8) { constexpr float f = MG8_SCALE / (W34_SCALE * Y8_SCALE); unsigned char* m8 = (unsigned char*)MG + (size_t)(u.pm * 256 + wr * 64 + fr2) * D + u.pn * 256 + wc * 32 + 8 * fq2;
                    v2u w8; w8.x = pk4_fp8(v0[0] * bflo(b.x) * f, v0[1] * bfhi(b.x) * f, v0[2] * bflo(b.y) * f, v0[3] * bfhi(b.y) * f); w8.y = pk4_fp8(v1[0] * bflo(b.z) * f, v1[1] * bfhi(b.z) * f, v1[2] * bflo(b.w) * f, v1[3] * bfhi(b.w) * f);
                    w8.x = (unsigned)__builtin_amdgcn_ds_bpermute(paddr, (int)w8.x); w8.y = (unsigned)__builtin_amdgcn_ds_bpermute(paddr, (int)w8.y);
                    *(GAS v2u*)(m8 + (size_t)((rg >> 2) * 128 + (rg & 3) * 16) * D + bj * 128) = w8; }
                else {
                v4u w; w.x = cvtpk(v0[0] * bflo(b.x), v0[1] * bfhi(b.x)); w.y = cvtpk(v0[2] * bflo(b.y), v0[3] * bfhi(b.y));
                w.z = cvtpk(v1[0] * bflo(b.z), v1[1] * bfhi(b.z)); w.w = cvtpk(v1[2] * bflo(b.w), v1[3] * bfhi(b.w));
                w.x = (unsigned)__builtin_amdgcn_ds_bpermute(paddr, (int)w.x); w.y = (unsigned)__builtin_amdgcn_ds_bpermute(paddr, (int)w.y); w.z = (unsigned)__builtin_amdgcn_ds_bpermute(paddr, (int)w.z); w.w = (unsigned)__builtin_amdgcn_ds_bpermute(paddr, (int)w.w);
                *(GAS v4u*)(mr + (size_t)((rg >> 2) * 128 + (rg & 3) * 16) * D + bj * 128) = w; } }
    }
};
__device__ __forceinline__ void p3_merge(Frame& F) {
    unsigned char* ws = F.ws;
    pg9::DenseOrder S; S.init(T, D, F.G, (int)blockIdx.x);
    EpiMerge E{(const bf16*)(ws + WS_G), (bf16*)(ws + WS_MG)};
    constexpr int ES = P34_FP8 ? 1 : 2;
    pg9::DenseA ao{(unsigned)(Y_W * ES)}; pg9::DenseB bb{(const char*)(ws + WS_WAB), (size_t)256 * Y_W * ES};
    pg9::gemm_phase<ES>(F.lds, (const char*)(ws + WS_Y), Y_W, S, E, ao, bb);
}
struct EpiOut {
    static constexpr bool PERM = true; static constexpr int HOOK_T = -1;
    bf16* DELTA;
    __device__ __forceinline__ void hook(f32x4 (&)[2][2][4][2], const pg9::Unit&, int, int, int, int) const {}
    __device__ __forceinline__ void prefetch(LAS unsigned char*, const pg9::Unit&, int, int, int) const {}
    __device__ __forceinline__ void operator()(const f32x4 (&acc)[2][2][4][2], const pg9::Unit& u, int ui, int wr, int wc, int fr, int fq) const {
        asm volatile("" : "+v"(fr), "+v"(fq));
        const int fr2 = (fr >> 2) + 4 * fq, fq2 = fr & 3, paddr = 4 * (16 * (fr & 3) + 4 * fq + (fr >> 2));
        bf16* orow = DELTA + (size_t)(u.pm * 256 + wr * 64 + fr2) * D + u.pn * 256 + wc * 32 + 8 * fq2;
#pragma unroll
        for (int ai = 0; ai < 2; ++ai)
#pragma unroll
            for (int m = 0; m < 4; ++m)
#pragma unroll
                for (int bj = 0; bj < 2; ++bj) { constexpr float f = P34_FP8 ? 1.0f / (W34_SCALE * MG8_SCALE) : 1.0f; const f32x4 o0 = acc[ai][bj][m][0] * f, o1 = acc[ai][bj][m][1] * f;
                    v4u w; w.x = cvtpk(o0[0], o0[1]); w.y = cvtpk(o0[2], o0[3]); w.z = cvtpk(o1[0], o1[1]); w.w = cvtpk(o1[2], o1[3]);
                    w.x = (unsigned)__builtin_amdgcn_ds_bpermute(paddr, (int)w.x); w.y = (unsigned)__builtin_amdgcn_ds_bpermute(paddr, (int)w.y); w.z = (unsigned)__builtin_amdgcn_ds_bpermute(paddr, (int)w.z); w.w = (unsigned)__builtin_amdgcn_ds_bpermute(paddr, (int)w.w);
                    *(GAS v4u*)(orow + (size_t)(ai * 128 + m * 16) * D + bj * 128) = w; }
    }
};
__device__ __forceinline__ void p4_outproj(Frame& F) {
    unsigned char* ws = F.ws;
    pg9::DenseOrder S; S.init(T, D, F.G, (int)blockIdx.x);
    EpiOut E{(bf16*)((unsigned char*)F.out + DO_DELTA)};
    constexpr int ES = P34_FP8 ? 1 : 2;
    pg9::DenseA ao{(unsigned)(D * ES)}; pg9::DenseB bb{(const char*)(ws + WS_WO), (size_t)256 * D * ES};
    pg9::gemm_phase<ES>(F.lds, (const char*)(ws + WS_MG), D, S, E, ao, bb);
}

__device__ __forceinline__ void p5_route(Frame& F) {
    int tid_ = threadIdx.x; asm volatile("" : "+v"(tid_)); const int lane = tid_ & 63;
    unsigned char* ws = F.ws;
    const float* X = F.in[I_X]; const bf16* DELTA = (const bf16*)((const unsigned char*)F.out + DO_DELTA);
    bf16* X1B = (bf16*)(ws + WS_X1B); unsigned char* X1F8 = ws + WS_X1F8;
    unsigned* cnt = (unsigned*)(ws + WS_CTL) + CW_CNT;
    int* tokof = (int*)(ws + WS_TOKOF); float2* wtof = (float2*)(ws + WS_WTOF); int4* tpos = (int4*)(ws + WS_TPOS);
    const v4u* WRF = (const v4u*)(ws + WS_WRF);
    LAS v4u* wl = (LAS v4u*)F.lds;
    LAS float* sl = (LAS float*)(F.lds + 98304 + F.wave * 4096);
    const int i = lane & 15, q = lane >> 4;
    LAS unsigned* hist = (LAS unsigned*)(F.lds + LDS_MISC + 2048);
    for (int wt = F.vcu; wt < T / 128; wt += F.G) {
        const int tile = wt * NWAVES + F.wave;
        if (tid_ < 32) hist[tid_] = 0u;
        const size_t roff = (size_t)(tile * 16 + i) * D + 8 * q;
        const float* xr = X + roff; const bf16* dr = DELTA + roff;
        f32x4 a0 = {0.f, 0.f, 0.f, 0.f}, a1 = a0, a2 = a0; float ss = 0.f;
        f32x4 va[8][2]; v4u vd[8];
#pragma unroll
        for (int j = 0; j < 8; ++j) { va[j][0] = *(const GAS f32x4*)(xr + 32 * j); va[j][1] = *(const GAS f32x4*)(xr + 32 * j + 4); vd[j] = *(const GAS v4u*)(dr + 32 * j); }
#pragma unroll 1
        for (int half = 0; half < 2; ++half) {
            __syncthreads();
            { v4u t[12];
#pragma unroll
              for (int k = 0; k < 12; ++k) t[k] = WRF[half * 6144 + k * 512 + tid_];
#pragma unroll
              for (int k = 0; k < 12; ++k) wl[k * 512 + tid_] = t[k]; }
            __syncthreads();
#pragma unroll 1
            for (int sb = 0; sb < 2; ++sb) {
#pragma unroll
                for (int j = 0; j < 8; ++j) {
                    const int ksl = sb * 8 + j, ks = half * 16 + ksl;
                    const v4u dd = vd[j];
                    const f32x4 v0 = va[j][0] + (f32x4){bflo(dd.x), bfhi(dd.x), bflo(dd.y), bfhi(dd.y)}, v1 = va[j][1] + (f32x4){bflo(dd.z), bfhi(dd.z), bflo(dd.w), bfhi(dd.w)};
                    if (ks + 8 < 32) { va[j][0] = *(const GAS f32x4*)(xr + 32 * (ks + 8)); va[j][1] = *(const GAS f32x4*)(xr + 32 * (ks + 8) + 4); vd[j] = *(const GAS v4u*)(dr + 32 * (ks + 8)); }
                    ss += ((v0[0] * v0[0] + v0[1] * v0[1]) + (v0[2] * v0[2] + v0[3] * v0[3])) + ((v1[0] * v1[0] + v1[1] * v1[1]) + (v1[2] * v1[2] + v1[3] * v1[3]));
                    v4u hu; hu.x = cvtpk(v0[0], v0[1]); hu.y = cvtpk(v0[2], v0[3]); hu.z = cvtpk(v1[0], v1[1]); hu.w = cvtpk(v1[2], v1[3]);
                    v4u lu; lu.x = cvtpk(v0[0] - bflo(hu.x), v0[1] - bfhi(hu.x)); lu.y = cvtpk(v0[2] - bflo(hu.y), v0[3] - bfhi(hu.y)); lu.z = cvtpk(v1[0] - bflo(hu.z), v1[1] - bfhi(hu.z)); lu.w = cvtpk(v1[2] - bflo(hu.w), v1[3] - bfhi(hu.w));
                    *(GAS v4u*)(X1B + roff + 32 * ks) = hu;
                    if (P6_FP8) { v2u w8; w8.x = pk4_fp8(v0[0], v0[1], v0[2], v0[3]); w8.y = pk4_fp8(v1[0], v1[1], v1[2], v1[3]); *(GAS v2u*)(X1F8 + roff + 32 * ks) = w8; }
                    const bf16x8 ah = __builtin_bit_cast(bf16x8, hu), al = __builtin_bit_cast(bf16x8, lu);
#pragma unroll
                    for (int nb = 0; nb < 3; ++nb) {
                        const bf16x8 bh = __builtin_bit_cast(bf16x8, wl[((ksl * 3 + nb) * 2 + 0) * 64 + lane]), bl = __builtin_bit_cast(bf16x8, wl[((ksl * 3 + nb) * 2 + 1) * 64 + lane]);
                        f32x4 acc = nb == 0 ? a0 : (nb == 1 ? a1 : a2);
                        acc = __builtin_amdgcn_mfma_f32_16x16x32_bf16(ah, bh, acc, 0, 0, 0); acc = __builtin_amdgcn_mfma_f32_16x16x32_bf16(ah, bl, acc, 0, 0, 0); acc = __builtin_amdgcn_mfma_f32_16x16x32_bf16(al, bh, acc, 0, 0, 0);
                        if (nb == 0) a0 = acc; else if (nb == 1) a1 = acc; else a2 = acc;
                    }
                }
            }
        }
        ss += __shfl_xor(ss, 16); ss += __shfl_xor(ss, 32);
#pragma unroll
        for (int r = 0; r < 4; ++r) { sl[(4 * q + r) * 48 + i] = a0[r]; sl[(4 * q + r) * 48 + 16 + i] = a1[r]; sl[(4 * q + r) * 48 + 32 + i] = a2[r]; }
        LDS_WAIT(); asm volatile("" ::: "memory");
        int e0 = 0, e1 = 0, lp0 = 0, lp1 = 0; float w1 = 0.f, w2 = 0.f, rstd = 0.f;
        __syncthreads();
        if (lane < 16) {
            rstd = 1.0f / sqrtf(ss * (1.f / D) + RMS_EPS);
            float lg[36];
#pragma unroll
            for (int o = 0; o < 36; ++o) lg[o] = sl[lane * 48 + o] * rstd + (o < 4 ? F.in[I_BRG][o] : F.in[I_BRE][o - 4]);
            int gsel = 0; float gmax = lg[0];
#pragma unroll
            for (int k = 1; k < 4; ++k) if (lg[k] > gmax) { gmax = lg[k]; gsel = k; }
            float gden = 0.f;
#pragma unroll
            for (int k = 0; k < 4; ++k) gden += __expf(lg[k] - gmax);
            const float pg = 1.0f / gden;
            float le[8];
#pragma unroll
            for (int j = 0; j < 8; ++j) { le[j] = lg[4 + j];
#pragma unroll
                for (int gi = 1; gi < 4; ++gi) le[j] = (gsel == gi) ? lg[4 + gi * 8 + j] : le[j]; }
            int i1 = 0; float m1 = le[0];
#pragma unroll
            for (int j = 1; j < 8; ++j) if (le[j] > m1) { m1 = le[j]; i1 = j; }
            int i2 = -1; float m2 = -INFINITY;
#pragma unroll
            for (int j = 0; j < 8; ++j) if (j != i1 && le[j] > m2) { m2 = le[j]; i2 = j; }
            const float e2 = __expf(m2 - m1);
            w1 = pg / (1.0f + e2); w2 = pg * e2 / (1.0f + e2);
            e0 = gsel * 8 + i1; e1 = gsel * 8 + i2;
            lp0 = (int)__hip_atomic_fetch_add(&hist[e0], 1u, __ATOMIC_RELAXED, __HIP_MEMORY_SCOPE_WORKGROUP);
            lp1 = (int)__hip_atomic_fetch_add(&hist[e1], 1u, __ATOMIC_RELAXED, __HIP_MEMORY_SCOPE_WORKGROUP);
        }
        __syncthreads();
        if (tid_ < 32) { const unsigned n = hist[tid_]; hist[32 + tid_] = n ? atomicAdd(&cnt[64 * tid_], n) : 0u; }
        __syncthreads();
        if (lane < 16) {
            const int row = tile * 16 + lane;
            const int p0 = (int)hist[32 + e0] + lp0, p1 = (int)hist[32 + e1] + lp1;
            tokof[(size_t)e0 * T + p0] = row; wtof[(size_t)e0 * T + p0] = make_float2(w1, rstd);
            tokof[(size_t)e1 * T + p1] = row; wtof[(size_t)e1 * T + p1] = make_float2(w2, rstd);
            tpos[row] = make_int4(e0, p0, e1, p1);
        }
        __syncthreads();
    }
}

__device__ __forceinline__ void expert_tiles(Frame& F, LAS int* tb, LAS int* cn) {
    int tid_ = threadIdx.x; asm volatile("" : "+v"(tid_)); const int lane_ = tid_ & 63;
    if (tid_ == 0) {
        const unsigned* cnt = (const unsigned*)(F.ws + WS_CTL) + CW_CNT;
        int acc = 0;
        for (int e = 0; e < NE; ++e) { const int c = (int)__hip_atomic_load(cnt + 64 * e, __ATOMIC_RELAXED, __HIP_MEMORY_SCOPE_AGENT); cn[e] = c; tb[e] = acc; acc += (c + 255) >> 8; }
        tb[NE] = acc;
    }
    __syncthreads();
}

struct MoeOrder { const LAS int* tb; int ncol, G, c;
    __device__ bool next(int i, pg9::Unit& u) const {
        const int L = i * G + c; if (L >= tb[NE] * ncol) return false;
        const int rt = L / ncol; int e = 0;
        for (int k = 1; k < NE; ++k) if (tb[k] <= rt) e = k;
        u.pm = rt; u.pn = L % ncol; u.e = e; return true; } };
struct GatherA { static constexpr bool GATHER = true; unsigned rowbytes; const int* tokof; const LAS int* tb; const LAS int* cn;
    __device__ __forceinline__ unsigned operator()(const pg9::Unit& u, int row) const {
        const int p = (u.pm - tb[u.e]) * 256 + row; const int tok = tokof[(size_t)u.e * T + (p < cn[u.e] ? p : 0)]; return (unsigned)tok * rowbytes; } };
struct ExpertB { const char* W; size_t ebytes, tilebytes; __device__ __forceinline__ const char* operator()(const pg9::Unit& u) const { return W + (size_t)u.e * ebytes + (size_t)u.pn * tilebytes; } };
struct EpiGateUp {
    static constexpr bool PERM = true; static constexpr int HOOK_T = -1;
    const float2* wtof; bf16* HACT; const LAS int* tb; const LAS int* cn; float ascale;
    __device__ __forceinline__ void hook(f32x4 (&)[2][2][4][2], const pg9::Unit&, int, int, int, int) const {}
    __device__ __forceinline__ void prefetch(LAS unsigned char*, const pg9::Unit&, int, int, int) const {}
    __device__ __forceinline__ void operator()(const f32x4 (&acc)[2][2][4][2], const pg9::Unit& u, int ui, int wr, int wc, int fr, int fq) const {
        asm volatile("" : "+v"(fr), "+v"(fq));
        const int r0 = wr * 64 + fr, p0 = (u.pm - tb[u.e]) * 256, ce = cn[u.e];
        const int fr2 = (fr >> 2) + 4 * fq, fq2 = fr & 3, paddr = 4 * (16 * (fr & 3) + 4 * fq + (fr >> 2)), r0s = wr * 64 + fr2;
        const float2* wp = wtof + (size_t)u.e * T;
#pragma unroll
        for (int ai = 0; ai < 2; ++ai) {
            float2 wv[4];
#pragma unroll
            for (int m = 0; m < 4; ++m) { const int p = p0 + r0 + ai * 128 + m * 16; wv[m] = p < ce ? wp[p] : make_float2(0.f, 0.f); }
#pragma unroll
            for (int m = 0; m < 4; ++m) { const int r = r0s + ai * 128 + m * 16;
                const float w = wv[m].x, rs = wv[m].y * ascale;
                bf16* orow = HACT + (size_t)(u.pm * 256 + r) * DE + u.pn * 128 + wc * 16 + 4 * fq2; unsigned char* orow8 = (unsigned char*)HACT + (size_t)(u.pm * 256 + r) * DE + u.pn * 128 + wc * 16 + 4 * fq2;
#pragma unroll
                for (int bj = 0; bj < 2; ++bj) { const f32x4 g = acc[ai][bj][m][0], uu = acc[ai][bj][m][1]; f32x4 hv;
#pragma unroll
                    for (int e = 0; e < 4; ++e) { const float gg = g[e] * rs; hv[e] = gg / (1.0f + __expf(-gg)) * (uu[e] * rs) * w; }
                    if (P6_FP8) *(GAS unsigned*)(orow8 + bj * 64) = (unsigned)__builtin_amdgcn_ds_bpermute(paddr, (int)pk4_fp8(hv[0] * H8_SCALE, hv[1] * H8_SCALE, hv[2] * H8_SCALE, hv[3] * H8_SCALE));
                    else { v2u o; o.x = (unsigned)__builtin_amdgcn_ds_bpermute(paddr, (int)cvtpk(hv[0], hv[1])); o.y = (unsigned)__builtin_amdgcn_ds_bpermute(paddr, (int)cvtpk(hv[2], hv[3])); *(GAS v2u*)(orow + bj * 64) = o; } } }
        }
    }
};
__device__ __forceinline__ void p6a_gateup(Frame& F) {
    unsigned char* ws = F.ws;
    LAS int* tb = (LAS int*)(F.lds + LDS_MISC + 1024); LAS int* cn = tb + 64;
    expert_tiles(F, tb, cn);
    MoeOrder S{tb, 2, F.G, F.vcu};
    constexpr int ES = P6_FP8 ? 1 : 2;
    GatherA ao{(unsigned)(D * ES), (const int*)(ws + WS_TOKOF), tb, cn}; ExpertB bb{(const char*)(ws + WS_WGU), (size_t)512 * D * ES, (size_t)256 * D * ES};
    EpiGateUp E{(const float2*)(ws + WS_WTOF), (bf16*)(ws + WS_HACT), tb, cn, P6_FP8 ? 1.0f / WG8_SCALE : 1.0f};
    pg9::gemm_phase<ES>(F.lds, (const char*)(ws + (P6_FP8 ? WS_X1F8 : WS_X1B)), D, S, E, ao, bb);
}
struct EpiDown {
    static constexpr bool PERM = true; static constexpr int HOOK_T = -1;
    bf16* YS; float ascale;
    __device__ __forceinline__ void hook(f32x4 (&)[2][2][4][2], const pg9::Unit&, int, int, int, int) const {}
    __device__ __forceinline__ void prefetch(LAS unsigned char*, const pg9::Unit&, int, int, int) const {}
    __device__ __forceinline__ void operator()(const f32x4 (&acc)[2][2][4][2], const pg9::Unit& u, int ui, int wr, int wc, int fr, int fq) const {
        asm volatile("" : "+v"(fr), "+v"(fq));
        const int fr2 = (fr >> 2) + 4 * fq, fq2 = fr & 3, paddr = 4 * (16 * (fr & 3) + 4 * fq + (fr >> 2));
#pragma unroll
        for (int ai = 0; ai < 2; ++ai)
#pragma unroll
            for (int m = 0; m < 4; ++m) { bf16* orow = YS + (size_t)(u.pm * 256 + wr * 64 + fr2 + ai * 128 + m * 16) * D + u.pn * 256 + wc * 32 + 8 * fq2;
#pragma unroll
                for (int bj = 0; bj < 2; ++bj) { const f32x4 v0 = acc[ai][bj][m][0] * ascale, v1 = acc[ai][bj][m][1] * ascale;
                    if (YS_FP8) { unsigned char* o8 = (unsigned char*)YS + (size_t)(u.pm * 256 + wr * 64 + fr2 + ai * 128 + m * 16) * D + u.pn * 256 + wc * 32 + 8 * fq2 + bj * 128;
                        v2u w8; w8.x = pk4_fp8(v0[0] * YS8_SCALE, v0[1] * YS8_SCALE, v0[2] * YS8_SCALE, v0[3] * YS8_SCALE); w8.y = pk4_fp8(v1[0] * YS8_SCALE, v1[1] * YS8_SCALE, v1[2] * YS8_SCALE, v1[3] * YS8_SCALE);
                        w8.x = (unsigned)__builtin_amdgcn_ds_bpermute(paddr, (int)w8.x); w8.y = (unsigned)__builtin_amdgcn_ds_bpermute(paddr, (int)w8.y); *(GAS v2u*)o8 = w8; }
                    else { v4u w; w.x = cvtpk(v0[0], v0[1]); w.y = cvtpk(v0[2], v0[3]); w.z = cvtpk(v1[0], v1[1]); w.w = cvtpk(v1[2], v1[3]);
                        w.x = (unsigned)__builtin_amdgcn_ds_bpermute(paddr, (int)w.x); w.y = (unsigned)__builtin_amdgcn_ds_bpermute(paddr, (int)w.y); w.z = (unsigned)__builtin_amdgcn_ds_bpermute(paddr, (int)w.z); w.w = (unsigned)__builtin_amdgcn_ds_bpermute(paddr, (int)w.w); *(GAS v4u*)(orow + bj * 128) = w; } } }
    }
};
__device__ __forceinline__ void p6b_down(Frame& F) {
    unsigned char* ws = F.ws;
    LAS int* tb = (LAS int*)(F.lds + LDS_MISC + 1024); LAS int* cn = tb + 64;
    expert_tiles(F, tb, cn);
    MoeOrder S{tb, 4, F.G, F.vcu};
    constexpr int ES = P6_FP8 ? 1 : 2;
    pg9::DenseA ao{(unsigned)(DE * ES)}; ExpertB bb{(const char*)(ws + WS_WD), (size_t)D * DE * ES, (size_t)256 * DE * ES};
    EpiDown E{(bf16*)(ws + WS_YS), P6_FP8 ? 1.0f / (WD8_SCALE * H8_SCALE) : 1.0f};
    pg9::gemm_phase<ES>(F.lds, (const char*)(ws + WS_HACT), DE, S, E, ao, bb);
}
__device__ __forceinline__ void p7_final(Frame& F) {
    int tid_ = threadIdx.x; asm volatile("" : "+v"(tid_)); const int lane_ = tid_ & 63;
    unsigned char* ws = F.ws;
    LAS int* tb = (LAS int*)(F.lds + LDS_MISC + 1024); LAS int* cn = tb + 64;
    expert_tiles(F, tb, cn);
    const bf16* YS = (const bf16*)(ws + WS_YS); const int4* tpos = (const int4*)(ws + WS_TPOS);
    float* X1 = F.out; const bf16* X1B = (const bf16*)(ws + WS_X1B);
    const int lane = lane_;
    const int gw = F.vcu * NWAVES + F.wave, NGW = F.G * NWAVES;
    const GAS f32x4* gr = (const GAS f32x4*)F.in[I_GFIN] + lane;
    for (int row = gw; row < T; row += NGW) {
        const int4 tp = tpos[row];
        const size_t s0 = (size_t)tb[tp.x] * 256 + tp.y, s1 = (size_t)tb[tp.z] * 256 + tp.w;
        GAS f32x4* xr = (GAS f32x4*)(X1 + (size_t)row * D) + lane; const GAS v2u* xb = (const GAS v2u*)(X1B + (size_t)row * D) + lane;
        const GAS v2u* y0 = (const GAS v2u*)(YS + s0 * D) + lane; const GAS v2u* y1 = (const GAS v2u*)(YS + s1 * D) + lane;
        const GAS unsigned* z0 = (const GAS unsigned*)((const unsigned char*)YS + s0 * D) + lane; const GAS unsigned* z1 = (const GAS unsigned*)((const unsigned char*)YS + s1 * D) + lane;
        f32x4 v[4]; float s = 0.f;
#pragma unroll
        for (int j = 0; j < 4; ++j) { const v2u xx = xb[64 * j]; v[j] = (f32x4){bflo(xx.x), bfhi(xx.x), bflo(xx.y), bfhi(xx.y)};
            if (YS_FP8) { const int a = (int)z0[64 * j], b = (int)z1[64 * j]; typedef float f2_ __attribute__((ext_vector_type(2)));
                const f2_ a0 = __builtin_amdgcn_cvt_pk_f32_fp8(a, false), a1 = __builtin_amdgcn_cvt_pk_f32_fp8(a, true), b0 = __builtin_amdgcn_cvt_pk_f32_fp8(b, false), b1 = __builtin_amdgcn_cvt_pk_f32_fp8(b, true);
                constexpr float f = 1.0f / YS8_SCALE; v[j].x += (a0[0] + b0[0]) * f; v[j].y += (a0[1] + b0[1]) * f; v[j].z += (a1[0] + b1[0]) * f; v[j].w += (a1[1] + b1[1]) * f; }
            else { const v2u a = y0[64 * j], b = y1[64 * j];
            v[j].x += bflo(a.x) + bflo(b.x); v[j].y += bfhi(a.x) + bfhi(b.x); v[j].z += bflo(a.y) + bflo(b.y); v[j].w += bfhi(a.y) + bfhi(b.y); }
            s += (v[j].x * v[j].x + v[j].y * v[j].y) + (v[j].z * v[j].z + v[j].w * v[j].w); }
        const float rstd = 1.0f / sqrtf(wave_sum(s) * (1.f / D) + RMS_EPS);
#pragma unroll
        for (int j = 0; j < 4; ++j) { const f32x4 gg = gr[64 * j]; f32x4 o; o.x = v[j].x * rstd * gg.x; o.y = v[j].y * rstd * gg.y; o.z = v[j].z * rstd * gg.z; o.w = v[j].w * rstd * gg.w; xr[64 * j] = o; }
    }
}

constexpr int NPHASE = 2 * NCH + 8;
__global__ void __launch_bounds__(NTHR, 2) fwd_kernel(KArgs args) {
    extern __shared__ __attribute__((aligned(16))) unsigned char lds_raw[];
    Frame F;
    F.lds = (LAS unsigned char*)lds_raw;
    F.tid = threadIdx.x; F.lane = F.tid & 63; F.wave = __builtin_amdgcn_readfirstlane(F.tid >> 6);
    F.G = gridDim.x; { const int bx = blockIdx.x; F.vcu = (F.G % 8 == 0) ? (bx % 8) * (F.G / 8) + bx / 8 : bx; }
#pragma unroll
    for (int i = 0; i < 17; ++i) F.in[i] = args.in[i];
    F.out = args.out; F.ws = args.ws;
    volatile LAS unsigned* MISC = (volatile LAS unsigned*)(F.lds + LDS_MISC);
    if (F.tid < 64) MISC[F.tid] = 0u;
    __syncthreads();
    XcdBarrier bar = xcd_barrier_post((unsigned*)(F.ws + WS_CTL) + CW_BAR + args.li * XCD_BAR_WORDS, MISC + 8);
#define IN(k) (args.ph_lo <= (k) && (k) < args.ph_hi)
#ifdef PROBE_MASK
    unsigned long long pr_acc = 0, pr_t0 = 0; const bool pr_me = (blockIdx.x == 0 && threadIdx.x == 0);
#define PR_BEGIN(k) do { if (pr_me && ((PROBE_MASK >> (k)) & 1ull)) pr_t0 = __builtin_amdgcn_s_memrealtime(); } while (0)
#define PR_END(k) do { if (pr_me && ((PROBE_MASK >> (k)) & 1ull)) pr_acc += __builtin_amdgcn_s_memrealtime() - pr_t0; } while (0)
#else
#define PR_BEGIN(k) do {} while (0)
#define PR_END(k) do {} while (0)
#endif
#define SEAM(k) do { if (IN(k) && IN((k) + 1)) xcd_barrier(bar); PR_END(k); } while (0)
    PR_BEGIN(0); if (IN(0)) p0_prologue(F);
    SEAM(0);
#pragma unroll 1
    for (int ch = 0; ch < NCH; ++ch) {
        PR_BEGIN(1 + 2 * ch);
        if (IN(1 + 2 * ch)) {
            constexpr int NWG1 = (TC / 256) * (NIN / 256);
            const int nfull = NWG1 % F.G, bx = (int)blockIdx.x;
            if (ch > 0 && nfull == 0) p2_combine(F, ch - 1, F.vcu, F.G);
            p1_inproj(F, ch);
            if (ch > 0 && nfull != 0 && bx >= nfull) p2_combine(F, ch - 1, bx - nfull, F.G - nfull);
        }
        SEAM(1 + 2 * ch);
        PR_BEGIN(2 + 2 * ch); if (IN(2 + 2 * ch)) p2_attn(F, ch);
        SEAM(2 + 2 * ch);
    }
    PR_BEGIN(2 * NCH + 1); if (IN(2 * NCH + 1)) p2_combine(F, NCH - 1, F.vcu, F.G);
    SEAM(2 * NCH + 1);
    PR_BEGIN(2 * NCH + 2); if (IN(2 * NCH + 2)) p3_merge(F);
    SEAM(2 * NCH + 2);
    PR_BEGIN(2 * NCH + 3); if (IN(2 * NCH + 3)) p4_outproj(F);
    SEAM(2 * NCH + 3);
    PR_BEGIN(2 * NCH + 4); if (IN(2 * NCH + 4)) p5_route(F);
    SEAM(2 * NCH + 4);
    PR_BEGIN(2 * NCH + 5); if (IN(2 * NCH + 5)) p6a_gateup(F);
    SEAM(2 * NCH + 5);
    PR_BEGIN(2 * NCH + 6); if (IN(2 * NCH + 6)) p6b_down(F);
    SEAM(2 * NCH + 6);
    PR_BEGIN(2 * NCH + 7); if (IN(2 * NCH + 7)) p7_final(F);
    PR_END(2 * NCH + 7);
#ifdef PROBE_MASK
    if (pr_me) { const unsigned long long t1 = __builtin_amdgcn_s_memrealtime(); while (__builtin_amdgcn_s_memrealtime() - t1 < pr_acc) __builtin_amdgcn_s_sleep(4); }
#endif
#undef IN
#undef SEAM
}

#ifndef N_LAUNCHES
#define N_LAUNCHES 1
#endif
extern "C" void kernel_launch(void* const* d_in, const int* in_sizes, int n_in, void* d_out, int out_size, void* d_ws, size_t ws_size, hipStream_t stream) {
    static int grid = 0;
    if (grid == 0) {
        if (n_in != 17 || in_sizes[0] != T * D || out_size != T * D || ws_size < WS_END) { fprintf(stderr, "kernel_launch: unexpected shapes / workspace (%d inputs, ws %zu)\n", n_in, ws_size); grid = -1; return; }
        int dev = 0, cus = 0;
        if (hipGetDevice(&dev) != hipSuccess || hipDeviceGetAttribute(&cus, hipDeviceAttributeMultiprocessorCount, dev) != hipSuccess) { grid = -1; return; }
        if (hipFuncSetAttribute((const void*)fwd_kernel, hipFuncAttributeMaxDynamicSharedMemorySize, LDS_BYTES) != hipSuccess) { fprintf(stderr, "kernel_launch: hipFuncSetAttribute failed\n"); grid = -1; return; }
        int per_cu = 0;
        if (hipOccupancyMaxActiveBlocksPerMultiprocessor(&per_cu, (const void*)fwd_kernel, NTHR, LDS_BYTES) != hipSuccess || per_cu < 1) fprintf(stderr, "kernel_launch: occupancy query says %d\n", per_cu);
        (void)hipGetLastError();
        grid = cus;
    }
    if (grid < 0) return;
    (void)hipMemsetAsync((char*)d_ws + WS_CTL, 0, N_LAUNCHES == 1 ? (size_t)(CW_BAR + XCD_BAR_WORDS) * 4 : CTL_BYTES, stream);
    KArgs a{};
    for (int i = 0; i < 17; ++i) a.in[i] = (const float*)d_in[i];
    a.out = (float*)d_out; a.ws = (unsigned char*)d_ws;
    for (int li = 0; li < N_LAUNCHES; ++li) {
        a.ph_lo = (int)((long)NPHASE * li / N_LAUNCHES); a.ph_hi = (int)((long)NPHASE * (li + 1) / N_LAUNCHES); a.li = li;
        hipLaunchKernelGGL(fwd_kernel, dim3(grid), dim3(NTHR), LDS_BYTES, stream, a);
    }
}
```

```cpp
#include <hip/hip_runtime.h>
#include <cstdint>
#include <cstdio>

#define GAS __attribute__((address_space(1)))
#define LAS __attribute__((address_space(3)))
typedef unsigned short bf16;
typedef short bf16x8 __attribute__((ext_vector_type(8)));
typedef float f32x4 __attribute__((ext_vector_type(4)));
typedef unsigned v4u __attribute__((ext_vector_type(4)));
typedef unsigned v2u __attribute__((ext_vector_type(2)));
typedef GAS unsigned gu32;

constexpr int T = 32768, D = 1024, SEQ = 4096, NIN = 7936;
constexpr int A_W = 4608, B_W = 1280, G_W = 2048, Y_W = 1536;
constexpr int NE = 32, DE = 256;
constexpr int NCH = 4, TC = T / NCH;
constexpr float QSCALE = 0.125f * 1.4426950408889634f;
constexpr float LOG2E = 1.4426950408889634f;
constexpr float RMS_EPS = 1e-6f;
#ifndef P1_FP8
#define P1_FP8 1
#endif
constexpr float W8_SCALE = P1_FP8 ? 64.0f : 0.0f, W8_INV = P1_FP8 ? 1.0f / 64.0f : 1.0f;
#ifndef P6_FP8
#define P6_FP8 1
#endif
#ifndef P34_FP8
#define P34_FP8 1
#endif
constexpr float Y8_SCALE = 16.0f, W34_SCALE = 64.0f, MG8_SCALE = 32.0f;
#ifndef YS_FP8
#define YS_FP8 1
#endif
constexpr float YS8_SCALE = 16.0f;
constexpr float WG8_SCALE = P6_FP8 ? 64.0f : 0.0f, WD8_SCALE = P6_FP8 ? 32.0f : 0.0f, H8_SCALE = 32.0f;
constexpr int NWAVES = 8, NTHR = 512;

constexpr size_t MiB = 1u << 20;
constexpr size_t WS_CTL = 0, CTL_BYTES = 1 * MiB;
constexpr size_t WS_BIASP = ((size_t)1 << 20) + 4096;
constexpr size_t WS_INVF = 1 * MiB;
constexpr size_t WS_WRF = 2 * MiB;
constexpr size_t WS_TOKOF = 3 * MiB;
constexpr size_t WS_WTOF = 7 * MiB;
constexpr size_t WS_TPOS = 15 * MiB;
constexpr size_t WS_WIN = 16 * MiB;
constexpr size_t WS_WAB = 32 * MiB;
constexpr size_t WS_WO = 35 * MiB;
constexpr size_t WS_WGU = 37 * MiB;
constexpr size_t WS_WD = 69 * MiB;
constexpr size_t WS_G = 86 * MiB;
constexpr size_t WS_Y = 214 * MiB;
constexpr size_t WS_ZA = 310 * MiB;
constexpr size_t WS_ZB = 454 * MiB;
constexpr size_t WS_END = 494 * MiB;
constexpr size_t WS_MG = WS_ZA;
constexpr size_t WS_X1B = WS_ZA + 64 * MiB;
constexpr size_t WS_X1F8 = WS_Y + 64 * MiB;
constexpr size_t WS_HACT = WS_G;
constexpr size_t WS_YS = WS_G + 36 * MiB;
constexpr size_t DO_DELTA = 0;
constexpr size_t DO_HN = 0;
constexpr size_t DO_OG = 64 * MiB;
constexpr size_t DO_LSE = 112 * MiB;
constexpr int MAXSLOT = 2 * T + NE * 256;
static_assert(WS_ZA + (size_t)TC * A_W * 2 <= WS_ZB && WS_ZB + (size_t)TC * B_W * 2 <= WS_END && WS_Y + (size_t)T * Y_W * 2 <= WS_ZA && WS_G + (size_t)T * G_W * 2 <= WS_Y, "ws map");
static_assert(WS_MG + (size_t)T * D * 2 <= WS_END && WS_HACT + (size_t)MAXSLOT * DE * 2 <= WS_YS && WS_YS + (size_t)MAXSLOT * D * 2 <= WS_ZA && WS_X1B >= WS_MG + (size_t)T * D * 2 && WS_X1B + (size_t)T * D * 2 <= WS_ZB, "ws map");
static_assert(DO_OG + (size_t)3 * TC * 512 * 2 <= DO_LSE && DO_LSE + (size_t)3 * TC * 8 * 4 <= (size_t)T * D * 4 && DO_HN + (size_t)T * D * 2 <= DO_OG, "d_out scratch map");
constexpr int CW_CNT = 1024;
constexpr int CW_BAR = 4096;
constexpr int LDS_BYTES = 147456;
constexpr int LDS_MISC = 131072;

__device__ __forceinline__ unsigned f2bf(float f) { unsigned u = __builtin_bit_cast(unsigned, f); return (u + 0x7fffu + ((u >> 16) & 1u)) >> 16; }
__device__ __forceinline__ unsigned pk4_fp8(float a, float b, float c, float d) {
    a = __builtin_amdgcn_fmed3f(a, -448.f, 448.f); b = __builtin_amdgcn_fmed3f(b, -448.f, 448.f); c = __builtin_amdgcn_fmed3f(c, -448.f, 448.f); d = __builtin_amdgcn_fmed3f(d, -448.f, 448.f);
    int w = 0; w = __builtin_amdgcn_cvt_pk_fp8_f32(a, b, w, false); w = __builtin_amdgcn_cvt_pk_fp8_f32(c, d, w, true); return (unsigned)w; }
__device__ __forceinline__ unsigned pk2(float lo, float hi) { return f2bf(lo) | (f2bf(hi) << 16); }
__device__ __forceinline__ float bf2f(unsigned b) { return __builtin_bit_cast(float, b << 16); }
__device__ __forceinline__ float bflo(unsigned u) { return __builtin_bit_cast(float, u << 16); }
__device__ __forceinline__ float bfhi(unsigned u) { return __builtin_bit_cast(float, u & 0xffff0000u); }
__device__ __forceinline__ float wave_sum(float v) {
#pragma unroll
    for (int o = 1; o < 64; o <<= 1) v += __shfl_xor(v, o);
    return v;
}
__device__ __forceinline__ float wave_max(float v) {
#pragma unroll
    for (int o = 1; o < 64; o <<= 1) v = fmaxf(v, __shfl_xor(v, o));
    return v;
}
typedef float f32x2_t __attribute__((ext_vector_type(2)));
typedef __bf16 bf16x2_t __attribute__((ext_vector_type(2)));
__device__ __forceinline__ unsigned cvtpk(float lo, float hi) { f32x2_t v = {lo, hi}; bf16x2_t b = __builtin_convertvector(v, bf16x2_t); return __builtin_bit_cast(unsigned, b); }
#ifndef WT_STORES
#define WT_STORES 0
#endif
__device__ __forceinline__ __amdgpu_buffer_rsrc_t wt_rsrc(unsigned char* base) { return __builtin_amdgcn_make_buffer_rsrc(base, 0, 0x7ffffffc, 0x00020000); }
__device__ __forceinline__ void st16(__amdgpu_buffer_rsrc_t r, unsigned char* base, void* p, v4u v) { if (WT_STORES) __builtin_amdgcn_raw_buffer_store_b128(v, r, (unsigned)((unsigned char*)p - base), 0, 16); else *(GAS v4u*)p = v; }
__device__ __forceinline__ void st8(__amdgpu_buffer_rsrc_t r, unsigned char* base, void* p, v2u v) { if (WT_STORES) __builtin_amdgcn_raw_buffer_store_b64(v, r, (unsigned)((unsigned char*)p - base), 0, 16); else *(GAS v2u*)p = v; }
#define LDS_WAIT() asm volatile("s_waitcnt lgkmcnt(0)" ::: "memory")
#define VM_WAIT() asm volatile("s_waitcnt vmcnt(0)" ::: "memory")

#define XB_TMO      128
#define XB_XCNT(j)  (256  + 64 * (j))
#define XB_XSUB(j)  (1280 + 64 * (j))
#define XB_XGEN(j)  (2304 + 64 * (j))
#define XB_TOP      3328
#define XB_TOPGEN   3392
#define XCD_BAR_WORDS 3456
#define XB_SPIN_CAP (1u << 18)
__device__ __forceinline__ unsigned xb_ld(unsigned* p)              { return __hip_atomic_load(p, __ATOMIC_RELAXED, __HIP_MEMORY_SCOPE_AGENT); }
__device__ __forceinline__ unsigned xb_add(unsigned* p, unsigned v) { return __hip_atomic_fetch_add(p, v, __ATOMIC_RELAXED, __HIP_MEMORY_SCOPE_AGENT); }
__device__ __forceinline__ unsigned xb_xcc_id() { return (unsigned)__builtin_amdgcn_s_getreg((3 << 11) | 20) & 0xFu; }
#define XB_SPIN(cond, bar) do { unsigned _sp = 0; while (cond) { __builtin_amdgcn_s_sleep(1); \
    if ((++_sp & 255u) == 0u) { if (xb_ld(&(bar)[XB_TMO])) break; if (_sp > XB_SPIN_CAP) { atomicAdd(&(bar)[XB_TMO], 1u); break; } } } } while (0)
struct XcdBarrier { unsigned* bar; unsigned x; volatile LAS unsigned* st; };
__device__ __forceinline__ XcdBarrier xcd_barrier_post(unsigned* bar, volatile LAS unsigned* st) {
    XcdBarrier b; b.bar = bar; b.x = xb_xcc_id(); b.st = st;
    if (threadIdx.x == 0) (void)xb_add(&bar[XB_XCNT(b.x)], 1u);
    return b;
}
__device__ __forceinline__ void xcd_barrier_complete(unsigned* bar, unsigned x, unsigned& nloc, unsigned& nx) {
    const unsigned G = gridDim.x * gridDim.y * gridDim.z;
    unsigned sum, cnt, mine, sp = 0u;
    for (;;) {
        sum = 0u; cnt = 0u; mine = 0u;
#pragma unroll
        for (unsigned j = 0; j < 16; ++j) { const unsigned c = xb_ld(&bar[XB_XCNT(j)]); sum += c; cnt += (c > 0u) ? 1u : 0u; mine = (j == x) ? c : mine; }
        if (sum == G) break;
        __builtin_amdgcn_s_sleep(1);
        if ((++sp & 255u) == 0u) { if (xb_ld(&bar[XB_TMO])) break; if (sp > XB_SPIN_CAP) { atomicAdd(&bar[XB_TMO], 1u); break; } }
    }
    nloc = mine > 0u ? mine : 1u; nx = cnt > 0u ? cnt : 1u;
}
__device__ __forceinline__ void xcd_barrier(const XcdBarrier& b) {
    asm volatile("s_waitcnt vmcnt(0)" ::: "memory");
    __syncthreads();
    if (threadIdx.x == 0) {
        unsigned* bar = b.bar;
        __builtin_amdgcn_s_waitcnt(0);
        unsigned nloc = b.st[0], nx = b.st[1];
        if (nloc == 0u) { xcd_barrier_complete(bar, b.x, nloc, nx); b.st[0] = nloc; b.st[1] = nx; }
        const unsigned old = xb_add(&bar[XB_XSUB(b.x)], 1u);
        const unsigned gen = old / nloc;
        if (old + 1u == (gen + 1u) * nloc) {
            __builtin_amdgcn_fence(__ATOMIC_RELEASE, "agent");
            asm volatile("s_waitcnt vmcnt(0)" ::: "memory");
            const unsigned og = xb_add(&bar[XB_TOP], 1u);
            const unsigned tg = og / nx;
            if (og + 1u == (tg + 1u) * nx) xb_add(&bar[XB_TOPGEN], 1u);
            else XB_SPIN(xb_ld(&bar[XB_TOPGEN]) == tg, bar);
            __builtin_amdgcn_fence(__ATOMIC_ACQUIRE, "agent");
            xb_add(&bar[XB_XGEN(b.x)], 1u);
            asm volatile("s_waitcnt vmcnt(0)" ::: "memory");
        } else {
            XB_SPIN(xb_ld(&bar[XB_XGEN(b.x)]) == gen, bar);
            __builtin_amdgcn_fence(__ATOMIC_ACQUIRE, "agent");
            asm volatile("s_waitcnt vmcnt(0)" ::: "memory");
        }
    }
    __syncthreads();
}

struct KArgs { const float* in[17]; float* out; unsigned char* ws; int ph_lo, ph_hi, li, pad; };
struct Frame {
    LAS unsigned char* lds;
    int tid, lane, wave, vcu, G;
    const float* in[17]; float* out; unsigned char* ws;
};
enum { I_X = 0, I_WIN, I_BIN, I_SINK, I_WPA, I_WPB, I_WOUT, I_GMIX, I_GFFN, I_WRG, I_BRG, I_WRE, I_BRE, I_WEG, I_WEU, I_WED, I_GFIN };

struct TrDesc { const float* W; int N; bf16* WT; int ldo, rowbase, koff, k0, n0; bool perm; const float* kscale; float f8scale; };
__device__ __forceinline__ void tr_load(const TrDesc& d, int lane, f32x4 (&tv)[8], float (&ks)[8]) {
    const float* src = d.W + (size_t)(d.k0 + (lane >> 3)) * d.N + d.n0 + 4 * (lane & 7);
#pragma unroll
    for (int i = 0; i < 8; ++i) tv[i] = *(const GAS f32x4*)(src + (size_t)(8 * i) * d.N);
#pragma unroll
    for (int i = 0; i < 8; ++i) ks[i] = d.kscale ? d.kscale[d.k0 + 8 * i + (lane >> 3)] : 1.0f;
}
__device__ __forceinline__ void tr_finish(const TrDesc& d, LAS float* scr, int lane, const f32x4 (&tv)[8], const float (&ks)[8]) {
#pragma unroll
    for (int i = 0; i < 8; ++i) { const int kk = 8 * i + (lane >> 3); LAS float* w = scr + kk * 33 + 4 * (lane & 7);
        w[0] = tv[i][0] * ks[i]; w[1] = tv[i][1] * ks[i]; w[2] = tv[i][2] * ks[i]; w[3] = tv[i][3] * ks[i]; }
    LDS_WAIT(); asm volatile("" ::: "memory");
    const int c = lane & 7;
#pragma unroll
    for (int j = 0; j < 4; ++j) { const int n = (lane >> 3) + 8 * j; const LAS float* s = scr + (8 * c) * 33 + n;
        const int rr = d.perm ? 8 * (n >> 2) + (n & 3) : n;
        if (d.f8scale != 0.f) { const float f = d.f8scale; v2u o8; o8.x = pk4_fp8(s[0 * 33] * f, s[1 * 33] * f, s[2 * 33] * f, s[3 * 33] * f); o8.y = pk4_fp8(s[4 * 33] * f, s[5 * 33] * f, s[6 * 33] * f, s[7 * 33] * f);
            *(GAS v2u*)((unsigned char*)d.WT + (size_t)(d.rowbase + rr) * d.ldo + d.koff + d.k0 + 8 * c) = o8; }
        else { v4u o; o.x = pk2(s[0 * 33], s[1 * 33]); o.y = pk2(s[2 * 33], s[3 * 33]); o.z = pk2(s[4 * 33], s[5 * 33]); o.w = pk2(s[6 * 33], s[7 * 33]);
            *(GAS v4u*)(d.WT + (size_t)(d.rowbase + rr) * d.ldo + d.koff + d.k0 + 8 * c) = o; } }
    LDS_WAIT(); asm volatile("" ::: "memory");
}
__device__ __forceinline__ void rms_row_to_bf16(const float* xrow, const float* g, bf16* orow, int lane) {
    const GAS f32x4* xr = (const GAS f32x4*)xrow + lane; const GAS f32x4* gr = (const GAS f32x4*)g + lane;
    f32x4 v[4]; float s = 0.f;
#pragma unroll
    for (int j = 0; j < 4; ++j) { v[j] = xr[64 * j]; s += (v[j].x * v[j].x + v[j].y * v[j].y) + (v[j].z * v[j].z + v[j].w * v[j].w); }
    const float rstd = 1.0f / sqrtf(wave_sum(s) * (1.f / D) + RMS_EPS);
    GAS v2u* o8 = (GAS v2u*)orow + lane;
#pragma unroll
    for (int j = 0; j < 4; ++j) { const f32x4 gg = gr[64 * j]; v2u w; w.x = pk2(v[j].x * rstd * gg.x, v[j].y * rstd * gg.y); w.y = pk2(v[j].z * rstd * gg.z, v[j].w * rstd * gg.w); o8[64 * j] = w; }
}
__device__ __forceinline__ void p0_prologue(Frame& F) {
    int tid_ = threadIdx.x; asm volatile("" : "+v"(tid_)); const int lane_ = tid_ & 63;
    LAS float* scr = (LAS float*)(F.lds + F.wave * 16384);
    const int gw = F.vcu * NWAVES + F.wave, NGW = F.G * NWAVES;
    unsigned char* ws = F.ws;
    constexpr int I_IN = 16 * 248, I_PA = 8 * 32, I_PB = 16 * 32, I_WO = 16 * 32, I_EG = 32 * 16 * 8, I_ED = 32 * 4 * 32;
    constexpr int NITEMS = I_IN + I_PA + I_PB + I_WO + 2 * I_EG + I_ED;
    auto decode = [&](int it, TrDesc& d) {
        int r = it; d.perm = false; d.kscale = nullptr; d.f8scale = 0.f; d.koff = 0;
        if (r < I_IN) { const int kb = r / 248, nb = r % 248, n0 = 32 * nb; const bool qk = (n0 < 3072) || (n0 >= A_W && n0 < A_W + 1152);
            const bool gt_ = n0 >= A_W + B_W; const int gc = n0 - (A_W + B_W);
            d.W = F.in[I_WIN]; d.N = NIN; d.WT = (bf16*)(ws + WS_WIN); d.ldo = 1024; d.rowbase = qk ? (n0 & ~63) + ((n0 >> 5) & 1) * 4 : (gt_ ? A_W + B_W + 2 * (gc % 1024) + 4 * (gc / 1024) : n0); d.k0 = 64 * kb; d.n0 = n0; d.perm = qk || gt_; d.f8scale = W8_SCALE; return; } r -= I_IN;
        if (r < I_PA) { const int kb = r / 32, nb = r % 32; d.W = F.in[I_WPA]; d.N = 1024; d.WT = (bf16*)(ws + WS_WAB); d.ldo = 1536; d.rowbase = 32 * nb; d.k0 = 64 * kb; d.n0 = 32 * nb; if (P34_FP8) d.f8scale = W34_SCALE; return; } r -= I_PA;
        if (r < I_PB) { const int kb = r / 32, nb = r % 32; d.W = F.in[I_WPB]; d.N = 1024; d.WT = (bf16*)(ws + WS_WAB); d.ldo = 1536; d.rowbase = 32 * nb; d.koff = 512; d.k0 = 64 * kb; d.n0 = 32 * nb; if (P34_FP8) d.f8scale = W34_SCALE; return; } r -= I_PB;
        if (r < I_WO) { const int kb = r / 32, nb = r % 32; d.W = F.in[I_WOUT]; d.N = 1024; d.WT = (bf16*)(ws + WS_WO); d.ldo = 1024; d.rowbase = 32 * nb; d.k0 = 64 * kb; d.n0 = 32 * nb; if (P34_FP8) d.f8scale = W34_SCALE; return; } r -= I_WO;
        if (r < 2 * I_EG) { const int up = r >= I_EG; if (up) r -= I_EG; const int e = r / 128, q = r % 128, kb = q / 8, nb = q % 8;
            d.W = F.in[up ? I_WEU : I_WEG] + (size_t)e * 1024 * 256; d.N = 256; d.WT = (bf16*)(ws + WS_WGU) + (size_t)e * 512 * 1024; d.ldo = 1024; d.rowbase = 64 * nb + (up ? 4 : 0); d.k0 = 64 * kb; d.n0 = 32 * nb; d.perm = true; d.kscale = F.in[I_GFFN]; d.f8scale = WG8_SCALE; if (P6_FP8) d.WT = (bf16*)((unsigned char*)(ws + WS_WGU) + (size_t)e * 512 * 1024); return; } r -= 2 * I_EG;
        { const int e = r / 128, q = r % 128, kb = q / 32, nb = q % 32;
            d.W = F.in[I_WED] + (size_t)e * 256 * 1024; d.N = 1024; d.WT = (bf16*)(ws + WS_WD) + (size_t)e * 1024 * 256; d.ldo = 256; d.rowbase = 32 * nb; d.k0 = 64 * kb; d.n0 = 32 * nb; d.f8scale = WD8_SCALE; if (P6_FP8) d.WT = (bf16*)((unsigned char*)(ws + WS_WD) + (size_t)e * 1024 * 256); }
    };
    {
        int it = gw; TrDesc dc, dn; f32x4 tc[8], tn[8]; float kc[8], kn[8];
        bool hc = it < NITEMS; if (hc) { decode(it, dc); tr_load(dc, lane_, tc, kc); }
        while (hc) {
            it += NGW; const bool hn = it < NITEMS;
            if (hn) { decode(it, dn); tr_load(dn, lane_, tn, kn); }
            tr_finish(dc, scr, lane_, tc, kc);
            hc = hn; dc = dn;
#pragma unroll
            for (int i = 0; i < 8; ++i) { tc[i] = tn[i]; kc[i] = kn[i]; }
        }
    }
    for (int m = gw; m < T; m += 4 * NGW) {
        const GAS f32x4* gr = (const GAS f32x4*)F.in[I_GMIX] + lane_;
        f32x4 v[4][4]; float ss[4];
#pragma unroll
        for (int r = 0; r < 4; ++r) { const int mr = (m + r * NGW < T) ? m + r * NGW : m; const GAS f32x4* xr = (const GAS f32x4*)(F.in[I_X] + (size_t)mr * D) + lane_;
#pragma unroll
            for (int j = 0; j < 4; ++j) v[r][j] = xr[64 * j]; }
#pragma unroll
        for (int r = 0; r < 4; ++r) { float a = 0.f;
#pragma unroll
            for (int j = 0; j < 4; ++j) a += (v[r][j].x * v[r][j].x + v[r][j].y * v[r][j].y) + (v[r][j].z * v[r][j].z + v[r][j].w * v[r][j].w);
            ss[r] = 1.0f / sqrtf(wave_sum(a) * (1.f / D) + RMS_EPS); }
#pragma unroll
        for (int r = 0; r < 4; ++r) { if (m + r * NGW >= T) continue; GAS unsigned* o4 = (GAS unsigned*)((unsigned char*)F.out + DO_HN + (size_t)(m + r * NGW) * D) + lane_;
#pragma unroll
            for (int j = 0; j < 4; ++j) { const f32x4 gg = gr[64 * j];
                if (P1_FP8) o4[64 * j] = pk4_fp8(v[r][j].x * ss[r] * gg.x, v[r][j].y * ss[r] * gg.y, v[r][j].z * ss[r] * gg.z, v[r][j].w * ss[r] * gg.w);
                else { v2u w; w.x = cvtpk(v[r][j].x * ss[r] * gg.x, v[r][j].y * ss[r] * gg.y); w.y = cvtpk(v[r][j].z * ss[r] * gg.z, v[r][j].w * ss[r] * gg.w); ((GAS v2u*)((unsigned char*)F.out + DO_HN + (size_t)(m + r * NGW) * D * 2) + lane_)[64 * j] = w; } } }
    }
    const int gt = F.vcu * NTHR + tid_, NGT = F.G * NTHR;
    if (gt < 32) {
        float* tbl = (float*)(ws + WS_INVF); const float f = (float)exp2(-(double)gt * (13.287712379549449 / 32.0)); tbl[gt] = f;
#pragma unroll
        for (int s = 0; s < 2; ++s) { const float ang = (s ? 128.f : 16.f) * f, pr = ang * 0.15915494f, er = __builtin_fmaf(ang, 0.15915494f, -pr) + ang * 6.4206382e-9f, fr = __builtin_amdgcn_fractf(pr) + er;
            tbl[32 + 64 * s + gt] = __builtin_amdgcn_cosf(fr); tbl[64 + 64 * s + gt] = __builtin_amdgcn_sinf(fr); }
    }
    for (int c = gt; c < NIN; c += NGT) {
        int s = c; const int e = c & 7;
        if (c < 3072 || (c >= A_W && c < A_W + 1152)) s = (c & ~63) + 4 * ((c & 63) >> 3) + (e < 4 ? e : 28 + e);
        else if (c >= A_W + B_W) s = A_W + B_W + 4 * ((c - A_W - B_W) >> 3) + (e < 4 ? e : 1020 + e);
        ((float*)(ws + WS_BIASP))[c] = F.in[I_BIN][s];
    }
    for (int i = gt; i < 32 * 3 * 64; i += NGT) {
        const int ln = i & 63, nb = (i >> 6) % 3, ks = i / 192;
        const int n = 16 * nb + (ln & 15);
        float hi[8], lo[8];
#pragma unroll
        for (int e = 0; e < 8; ++e) { const int k = 32 * ks + 8 * (ln >> 4) + e; float v = 0.f;
            if (n < 4) v = F.in[I_WRG][k * 4 + n]; else if (n < 36) v = F.in[I_WRE][k * 32 + (n - 4)];
            v *= F.in[I_GFFN][k]; hi[e] = bf2f(f2bf(v)); lo[e] = v - hi[e]; }
        v4u h, l; h.x = pk2(hi[0], hi[1]); h.y = pk2(hi[2], hi[3]); h.z = pk2(hi[4], hi[5]); h.w = pk2(hi[6], hi[7]);
        l.x = pk2(lo[0], lo[1]); l.y = pk2(lo[2], lo[3]); l.z = pk2(lo[4], lo[5]); l.w = pk2(lo[6], lo[7]);
        ((v4u*)(ws + WS_WRF))[((ks * 3 + nb) * 2 + 0) * 64 + ln] = h; ((v4u*)(ws + WS_WRF))[((ks * 3 + nb) * 2 + 1) * 64 + ln] = l;
    }
}

namespace pg8 {
#define PG8_LAS __attribute__((address_space(3)))
typedef unsigned short bf16_t;
typedef short bf16x8 __attribute__((ext_vector_type(8)));
typedef float f32x4 __attribute__((ext_vector_type(4)));
typedef unsigned u32x4 __attribute__((ext_vector_type(4)));
constexpr int BM = 256, BK = 64, HALF = 128, HTB = HALF * BK * 2  , STAGE_BYTES = 8 * HTB, NXCD = 8, WGM = 8;

__host__ __device__ __forceinline__ int lds_byte(int r, int c) { const int st = (r >> 4) * 2 + (c >> 5), rr = r & 15, cc = c & 31, ob = rr * 64 + cc * 2; return st * 1024 + (ob ^ (((ob >> 9) & 1) << 5)); }
__host__ __device__ __forceinline__ void stage_rc(int b, int& R, int& C) { const int st = b / 1024, sb = b % 1024, swz = sb ^ (((sb >> 9) & 1) << 5); R = (st >> 1) * 16 + swz / 64; C = (st & 1) * 32 + (swz % 64) / 2; }
__host__ __device__ __forceinline__ int perm32(int rho) { const int n = rho >> 4, i = rho & 15; return 8 * (i >> 2) + 4 * n + (i & 3); }

struct Unit { int pm, pn; };
struct Gemm { const bf16_t* A; const bf16_t* Bt; int M, N, K; };

struct StaticOrder {
    int nM, nN, nwg, G, c;
    __host__ __device__ void init(int M, int N, int G_, int c_) { nM = M / BM; nN = N / BM; nwg = nM * nN; G = G_; c = c_; }
    __host__ __device__ bool next(int i, Unit& u) const {
        const long L = (long)i * G + c; if (L >= nwg) return false;
        int wgid = (int)L; { const int q = nwg / NXCD, r = nwg % NXCD, xcd = wgid % NXCD, off = wgid / NXCD; wgid = (xcd < r ? xcd * (q + 1) : r * (q + 1) + (xcd - r) * q) + off; }
        const int nig = WGM * nN, gid = wgid / nig, fm = gid * WGM, gsz = (nM - fm) < WGM ? (nM - fm) : WGM;
        u.pm = fm + ((wgid % nig) % gsz); u.pn = (wgid % nig) / gsz; return true;
    }
    __device__ __forceinline__ void a_ready(const Unit&) const {}
    __device__ __forceinline__ void done(const Unit&) const {}
};
}


namespace pg9 {
using pg8::BM; using pg8::BK; using pg8::HALF; using pg8::HTB; using pg8::lds_byte; using pg8::stage_rc; using pg8::perm32;
struct Unit { int pm, pn, e; };
typedef int v8i_t __attribute__((ext_vector_type(8)));
typedef int v4i_t __attribute__((ext_vector_type(4)));
template <int ESZ, class Epi, class Sched, class AOff, class BBase>
__device__ __forceinline__ void gemm_phase(LAS unsigned char* lds, const char* Abase, int K, const Sched& S, const Epi& E, const AOff& aoffn, const BBase& bbase) {
    int tid_ = threadIdx.x; asm volatile("" : "+v"(tid_));
    const int tid = tid_, wid = __builtin_amdgcn_readfirstlane(tid >> 6), lane = tid & 63, wr = wid >> 2, wc = wid & 3, fr = lane & 15, fq = lane >> 4;
    const int nt = K * ESZ / (BK * 2);
    int Rr[2], Cc[2]; unsigned voffB[2];
#pragma unroll
    for (int i = 0; i < 2; ++i) { int R, C; stage_rc(tid * 16 + i * 8192, R, C); const int Rb = Epi::PERM ? ((R & ~31) + perm32(R & 31)) : R; Rr[i] = R; Cc[i] = C; voffB[i] = (unsigned)(Rb * K * ESZ + C * 2); }
    const size_t kstep = (size_t)(BK * 2);
    const size_t hstep = (size_t)HALF * K * ESZ;
    const unsigned ldsw = (unsigned)wid * 1024u;
    const int aoff = lds_byte(wr * 64 + fr, fq * 8), boff = lds_byte(wc * 32 + fr, fq * 8);
#define PG9_SA(b, h) (((b) * 2 + (h)) * HTB)
#define PG9_SB(b, h) ((4 + (b) * 2 + (h)) * HTB)
#define PG9_STAGE(bufoff, gbase, voff) do { _Pragma("unroll") for (int _i = 0; _i < 2; ++_i) \
        __builtin_amdgcn_global_load_lds((const unsigned*)((const char*)(gbase) + (voff)[_i]), (LAS unsigned*)(lds + (bufoff) + ldsw + _i * 8192), 16, 0, 0); } while (0)
#define PG9_LDA(dst, b, h) do { _Pragma("unroll") for (int m = 0; m < 4; ++m) { dst[m].lo = *(const LAS v4i_t*)(lds + PG9_SA(b, h) + aoff + m * 2048); dst[m].hi = *(const LAS v4i_t*)(lds + PG9_SA(b, h) + aoff + m * 2048 + 1024); } } while (0)
#define PG9_LDB(dst, b, h) do { _Pragma("unroll") for (int n = 0; n < 2; ++n) { dst[n].lo = *(const LAS v4i_t*)(lds + PG9_SB(b, h) + boff + n * 2048); dst[n].hi = *(const LAS v4i_t*)(lds + PG9_SB(b, h) + boff + n * 2048 + 1024); } } while (0)
#define PG9_HALF(v, o) __builtin_bit_cast(bf16x8, __builtin_shufflevector((v), (v), (o), (o) + 1, (o) + 2, (o) + 3))
#define PG9_MMA(ai, bj, At, Bt) do { __builtin_amdgcn_s_setprio(1); _Pragma("unroll") for (int m = 0; m < 4; ++m) _Pragma("unroll") for (int n = 0; n < 2; ++n) { \
        if (ESZ == 2) { acc[ai][bj][m][n] = __builtin_amdgcn_mfma_f32_16x16x32_bf16(PG9_HALF(Bt[n], 0), PG9_HALF(At[m], 0), acc[ai][bj][m][n], 0, 0, 0); \
                        acc[ai][bj][m][n] = __builtin_amdgcn_mfma_f32_16x16x32_bf16(PG9_HALF(Bt[n], 4), PG9_HALF(At[m], 4), acc[ai][bj][m][n], 0, 0, 0); } \
        else { asm volatile("v_mfma_scale_f32_16x16x128_f8f6f4 %0, %1, %2, %0, %3, %3 op_sel_hi:[0,0,0]" : "+v"(acc[ai][bj][m][n]) : "v"(Bt[n]), "v"(At[m]), "v"(one8)); } } \
        __builtin_amdgcn_s_setprio(0); } while (0)
#define PG9_WAIT_V(n) asm volatile("s_waitcnt vmcnt(" #n ")" ::: "memory")
#define PG9_WAIT_L(n) asm volatile("s_waitcnt lgkmcnt(" #n ")" ::: "memory")
#define PG9_BAR __builtin_amdgcn_s_barrier()
#define PG9_SCHED __builtin_amdgcn_sched_barrier(0)
#define PG9_VA(dst, u) do { _Pragma("unroll") for (int _h = 0; _h < 2; ++_h) _Pragma("unroll") for (int _i = 0; _i < 2; ++_i) dst[_h][_i] = aoffn((u), _h * HALF + Rr[_i]) + (unsigned)(Cc[_i] * 2); } while (0)
    constexpr bool GATHER = AOff::GATHER;
    const size_t hstepA = (size_t)HALF * aoffn.rowbytes;
    unsigned voffA[2];
#pragma unroll
    for (int i = 0; i < 2; ++i) voffA[i] = (unsigned)Rr[i] * aoffn.rowbytes + (unsigned)(Cc[i] * 2);
#define PG9_STAGE_A(bufoff, h, koff, nx) do { if (GATHER) { PG9_STAGE(bufoff, Abase + (koff), ((nx) ? nvA[h] : cvA[h])); } else { PG9_STAGE(bufoff, ((nx) ? nAu : cAu) + (h) * hstepA + (koff), voffA); } } while (0)
    Unit cur, nxt; int ui = 0;
    if (!S.next(0, cur)) return;
    f32x4 acc[2][2][4][2];
#pragma unroll
    for (int a = 0; a < 2; ++a)
#pragma unroll
        for (int b = 0; b < 2; ++b)
#pragma unroll
            for (int m = 0; m < 4; ++m)
#pragma unroll
                for (int n = 0; n < 2; ++n) acc[a][b][m][n] = (f32x4){0.f, 0.f, 0.f, 0.f};
    int one8 = 0x7f7f7f7f; asm volatile("" : "+v"(one8));
    v8i_t At[4], B0[2], B1[2];
    unsigned cvA[2][2], nvA[2][2];
    if (GATHER) { PG9_VA(cvA, cur); }
    const char* cAu = GATHER ? Abase : Abase + (size_t)aoffn(cur, 0); const char* nAu = cAu;
    const char* cB = bbase(cur);
    E.prefetch(lds, cur, 0, wid, lane);
    PG9_STAGE(PG9_SB(0, 0), cB, voffB); PG9_STAGE(PG9_SB(0, 1), cB + hstep, voffB); PG9_STAGE_A(PG9_SA(0, 0), 0, 0, false); PG9_STAGE_A(PG9_SA(0, 1), 1, 0, false);
    if (wr == 1) PG9_BAR;
    PG9_WAIT_V(2); PG9_BAR;
    PG9_STAGE(PG9_SB(1, 0), cB + kstep, voffB); PG9_STAGE_A(PG9_SA(1, 0), 0, kstep, false); PG9_STAGE(PG9_SB(1, 1), cB + hstep + kstep, voffB);
    PG9_WAIT_V(6); PG9_BAR;
    for (;;) {
        const bool has_next = S.next(ui + 1, nxt);
        if (GATHER) {
            if (has_next) { PG9_VA(nvA, nxt); } else {
#pragma unroll
                for (int _h = 0; _h < 2; ++_h)
#pragma unroll
                    for (int _i = 0; _i < 2; ++_i) nvA[_h][_i] = cvA[_h][_i]; }
        } else nAu = has_next ? Abase + (size_t)aoffn(nxt, 0) : cAu;
        const char* nB = has_next ? bbase(nxt) : cB;
#pragma unroll 1
        for (int t = 0; t < nt; t += 2) {
            const bool last = (t == nt - 2);
            if (Epi::HOOK_T >= 0) { if (t == Epi::HOOK_T) E.hook(acc, cur, wr, wc, fr, fq); }
            const size_t k1 = (size_t)(t + 1) * kstep, k2 = last ? 0 : (size_t)(t + 2) * kstep, k3 = k2 + kstep;
            const char* b2 = last ? nB : cB + (size_t)(t + 2) * kstep; const char* b3 = b2 + kstep;
            PG9_LDB(B0, 0, 0); PG9_LDB(B1, 0, 1); PG9_SCHED; PG9_LDA(At, 0, 0); PG9_STAGE_A(PG9_SA(1, 1), 1, k1, false);
            PG9_WAIT_V(8); PG9_WAIT_L(0); PG9_BAR; PG9_MMA(0, 0, At, B0); PG9_MMA(0, 1, At, B1); PG9_BAR; PG9_SCHED;
            PG9_LDA(At, 0, 1); PG9_STAGE(PG9_SB(0, 0), b2, voffB); PG9_STAGE(PG9_SB(0, 1), b2 + hstep, voffB); PG9_STAGE_A(PG9_SA(0, 0), 0, k2, last);
            PG9_WAIT_V(8); PG9_WAIT_L(0); PG9_BAR; PG9_MMA(1, 0, At, B0); PG9_MMA(1, 1, At, B1); PG9_BAR; PG9_SCHED;
            PG9_LDB(B0, 1, 0); PG9_LDB(B1, 1, 1); PG9_SCHED; PG9_LDA(At, 1, 0); PG9_STAGE_A(PG9_SA(0, 1), 1, k2, last);
            PG9_WAIT_V(8); PG9_WAIT_L(0); PG9_BAR; PG9_MMA(0, 0, At, B0); PG9_MMA(0, 1, At, B1); PG9_BAR; PG9_SCHED;
            PG9_LDA(At, 1, 1); PG9_STAGE(PG9_SB(1, 0), b3, voffB); PG9_STAGE(PG9_SB(1, 1), b3 + hstep, voffB); PG9_STAGE_A(PG9_SA(1, 0), 0, k3, last);
            PG9_WAIT_V(8); PG9_WAIT_L(0); PG9_BAR; PG9_MMA(1, 0, At, B0); PG9_MMA(1, 1, At, B1); PG9_BAR; PG9_SCHED;
        }
        if (wr == 0) PG9_BAR;
        if (ESZ == 1) asm volatile("s_nop 15\n\ts_nop 15" ::: "memory");
        E(acc, cur, ui, wr, wc, fr, fq);
        if (!has_next) break;
#pragma unroll
        for (int a = 0; a < 2; ++a)
#pragma unroll
            for (int b = 0; b < 2; ++b)
#pragma unroll
                for (int m = 0; m < 4; ++m)
#pragma unroll
                    for (int n = 0; n < 2; ++n) acc[a][b][m][n] = (f32x4){0.f, 0.f, 0.f, 0.f};
        cur = nxt; cB = nB; cAu = nAu; ++ui;
        E.prefetch(lds, cur, ui, wid, lane);
        if (GATHER) {
#pragma unroll
            for (int _h = 0; _h < 2; ++_h)
#pragma unroll
                for (int _i = 0; _i < 2; ++_i) cvA[_h][_i] = nvA[_h][_i]; }
        if (wr == 1) PG9_BAR;
    }
    PG9_WAIT_V(0);
    PG9_BAR;
#undef PG9_SA
#undef PG9_SB
#undef PG9_STAGE
#undef PG9_LDA
#undef PG9_LDB
#undef PG9_MMA
#undef PG9_HALF
#undef PG9_WAIT_V
#undef PG9_WAIT_L
#undef PG9_BAR
#undef PG9_SCHED
#undef PG9_VA
#undef PG9_STAGE_A
}
struct DenseOrder { pg8::StaticOrder so;
    __device__ void init(int M, int N, int G, int c) { so.init(M, N, G, c); }
    __device__ bool next(int i, Unit& u) const { pg8::Unit v; if (!so.next(i, v)) return false; u.pm = v.pm; u.pn = v.pn; u.e = 0; return true; } };
struct DenseA { static constexpr bool GATHER = false; unsigned rowbytes; __device__ __forceinline__ unsigned operator()(const Unit& u, int row) const { return (unsigned)(u.pm * 256 + row) * rowbytes; } };
struct DenseB { const char* Bt; size_t tilebytes; __device__ __forceinline__ const char* operator()(const Unit& u) const { return Bt + (size_t)u.pn * tilebytes; } };
}

struct EpiInproj {
    static constexpr bool PERM = true; static constexpr int HOOK_T = -1;
    bf16* ZA; bf16* ZB; bf16* Gt; const float* biasP; LAS unsigned char* ldsb;
    __device__ __forceinline__ void hook(f32x4 (&)[2][2][4][2], const pg9::Unit&, int, int, int, int) const {}
    __device__ __forceinline__ void prefetch(LAS unsigned char* lds, const pg9::Unit& u, int ui, int wid, int lane) const {
        if (wid == 0) __builtin_amdgcn_global_load_lds((const unsigned*)(biasP + u.pn * 256 + lane * 4), (LAS unsigned*)(lds + LDS_MISC + 4096 + (ui & 1) * 1024), 16, 0, 0);
    }
    __device__ __forceinline__ void operator()(const f32x4 (&acc)[2][2][4][2], const pg9::Unit& u, int ui, int wr, int wc, int fr, int fq) const {
        asm volatile("" : "+v"(fr), "+v"(fq));
        const int row0 = u.pm * 256 + wr * 64 + fr;
        const int q = 4 * (wc & 1) + fq;
        const int fr2 = (fr >> 2) + 4 * fq, fq2 = fr & 3, paddr = 4 * (16 * (fr & 3) + 4 * fq + (fr >> 2));
        const int row0s = u.pm * 256 + wr * 64 + fr2;
        int kind[2]; bf16* dst[2]; int ldd[2]; f32x4 b0[2], b1[2];
#pragma unroll
        for (int bj = 0; bj < 2; ++bj) {
            const int colpos = u.pn * 256 + bj * 128 + wc * 32 + 8 * fq, colposs = u.pn * 256 + bj * 128 + wc * 32 + 8 * fq2, hb = u.pn * 256 + bj * 128 + (wc >> 1) * 64;
            if (hb < A_W) { kind[bj] = hb / 1536; dst[bj] = ZA + colposs; ldd[bj] = A_W; }
            else if (hb < A_W + B_W) { const int cb = hb - A_W; kind[bj] = cb < 1024 ? 0 : (cb < 1152 ? 1 : 2); dst[bj] = ZB + (colposs - A_W); ldd[bj] = B_W; }
            else { kind[bj] = 3; const int c0 = (colpos - A_W - B_W) >> 1;
                dst[bj] = Gt + ((size_t)((u.pm * 256 + wr * 64) >> 4) * 256 + (c0 >> 3)) * 128 + fr * 8 + (c0 & 7); ldd[bj] = 0; }
            const LAS float* bs = (const LAS float*)(ldsb + LDS_MISC + 4096 + (ui & 1) * 1024) + bj * 128 + wc * 32 + 8 * fq;
            b0[bj] = *(const LAS f32x4*)bs; b1[bj] = *(const LAS f32x4*)(bs + 4);
        }
        const bool need_rope = kind[0] < 2 || kind[1] < 2;
        const LAS float* rt = (const LAS float*)(ldsb + LDS_MISC + 6144) + 4 * q;
        const f32x4 fv = *(const LAS f32x4*)rt, c16 = *(const LAS f32x4*)(rt + 32), s16 = *(const LAS f32x4*)(rt + 64), c128 = *(const LAS f32x4*)(rt + 96), s128 = *(const LAS f32x4*)(rt + 128);
        f32x4 cb = {1.f, 1.f, 1.f, 1.f}, sb = {0.f, 0.f, 0.f, 0.f};
        if (need_rope) { const float posf = (float)(row0 & (SEQ - 1));
#pragma unroll
            for (int e = 0; e < 4; ++e) { const float ang = posf * fv[e]; const float pr = ang * 0.15915494f; const float er = __builtin_fmaf(ang, 0.15915494f, -pr) + ang * 6.4206382e-9f;
                const float fr_ = __builtin_amdgcn_fractf(pr) + er; cb[e] = __builtin_amdgcn_cosf(fr_); sb[e] = __builtin_amdgcn_sinf(fr_); } }
#pragma unroll
        for (int ai = 0; ai < 2; ++ai) {
            f32x4 rc[4], rs[4];
            rc[0] = cb; rs[0] = sb;
#pragma unroll
            for (int m = 1; m < 4; ++m) { rc[m] = rc[m - 1] * c16 - rs[m - 1] * s16; rs[m] = rs[m - 1] * c16 + rc[m - 1] * s16; }
            if (ai == 0) { const f32x4 cn = cb * c128 - sb * s128, sn = sb * c128 + cb * s128; cb = cn; sb = sn; }
#pragma unroll
            for (int bj = 0; bj < 2; ++bj) {
                bf16* p = dst[bj] + (unsigned)(row0s + ai * 128) * (unsigned)ldd[bj]; const unsigned step = 16u * (unsigned)ldd[bj];
                if (kind[bj] == 3) p = dst[bj] + (size_t)(ai * 8) * 32768;
                switch (kind[bj]) {
                    case 0: store4<0>(acc[ai][bj], b0[bj], b1[bj], rc, rs, p, step, paddr); break;
                    case 1: store4<1>(acc[ai][bj], b0[bj], b1[bj], rc, rs, p, step, paddr); break;
                    case 2: store4<2>(acc[ai][bj], b0[bj], b1[bj], rc, rs, p, step, paddr); break;
                    default: store4<3>(acc[ai][bj], b0[bj], b1[bj], rc, rs, p, step, paddr); break;
                }
            }
        }
    }
    template <int KIND> static __device__ __forceinline__ void store4(const f32x4 (&a)[4][2], const f32x4 b0, const f32x4 b1, const f32x4 (&rc)[4], const f32x4 (&rs)[4], bf16* p, const unsigned step, const int paddr) {
#pragma unroll
        for (int m = 0; m < 4; ++m) {
            f32x4 v0 = a[m][0] * W8_INV + b0, v1 = a[m][1] * W8_INV + b1;
            if (KIND < 2) {
                const f32x4 cc = rc[m], ss = rs[m];
                const f32x4 t0 = v0 * cc - v1 * ss, t1 = v1 * cc + v0 * ss;
                v0 = t0; v1 = t1;
                if (KIND == 0) { v0 = v0 * QSCALE; v1 = v1 * QSCALE; }
            }
            if (KIND == 3) {
#pragma unroll
                for (int e = 0; e < 4; ++e) { const float d0 = 1.0f + __expf(-v0[e]), d1 = 1.0f + __expf(-v1[e]); v0[e] = d1 * __builtin_amdgcn_rcpf(d0); v1[e] = __builtin_amdgcn_rcpf(d1); }
                v2u w0, w1; w0.x = cvtpk(v0[0], v0[1]); w0.y = cvtpk(v0[2], v0[3]); w1.x = cvtpk(v1[0], v1[1]); w1.y = cvtpk(v1[2], v1[3]);
                *(GAS v2u*)p = w0; *(GAS v2u*)(p + 128 * 128) = w1; p += 32768;
            } else {
                v4u w; w.x = cvtpk(v0[0], v0[1]); w.y = cvtpk(v0[2], v0[3]); w.z = cvtpk(v1[0], v1[1]); w.w = cvtpk(v1[2], v1[3]);
                w.x = (unsigned)__builtin_amdgcn_ds_bpermute(paddr, (int)w.x); w.y = (unsigned)__builtin_amdgcn_ds_bpermute(paddr, (int)w.y); w.z = (unsigned)__builtin_amdgcn_ds_bpermute(paddr, (int)w.z); w.w = (unsigned)__builtin_amdgcn_ds_bpermute(paddr, (int)w.w);
                *(GAS v4u*)p = w; p += step;
            }
        }
    }
};
__device__ __forceinline__ void p1_inproj(Frame& F, int ch) {
    unsigned char* ws = F.ws;
    pg9::DenseOrder S; S.init(TC, NIN, F.G, (int)blockIdx.x);
    EpiInproj E{(bf16*)(ws + WS_ZA), (bf16*)(ws + WS_ZB), (bf16*)(ws + WS_G) + (size_t)ch * TC * G_W, (const float*)(ws + WS_BIASP), F.lds};
    if (F.tid < 160) ((LAS float*)(F.lds + LDS_MISC + 6144))[F.tid] = ((const float*)(ws + WS_INVF))[F.tid];
    constexpr int ES = P1_FP8 ? 1 : 2;
    pg9::DenseA ao{(unsigned)(D * ES)}; pg9::DenseB bb{(const char*)(ws + WS_WIN), (size_t)256 * D * ES};
    pg9::gemm_phase<ES>(F.lds, (const char*)F.out + DO_HN + (size_t)ch * TC * D * ES, D, S, E, ao, bb);
}

typedef float f32x16 __attribute__((ext_vector_type(16)));
typedef short v4i16_t __attribute__((ext_vector_type(4)));
__device__ __forceinline__ float half_max(float v) { auto rr = __builtin_amdgcn_permlane32_swap(__float_as_uint(v), __float_as_uint(v), false, false); return fmaxf(__uint_as_float(rr[0]), __uint_as_float(rr[1])); }
__device__ __forceinline__ float half_sum(float v) { auto rr = __builtin_amdgcn_permlane32_swap(__float_as_uint(v), __float_as_uint(v), false, false); return __uint_as_float(rr[0]) + __uint_as_float(rr[1]); }
__device__ __forceinline__ float max3f(float a, float b, float c) { float r; asm("v_max3_f32 %0, %1, %2, %3" : "=v"(r) : "v"(a), "v"(b), "v"(c)); return r; }
constexpr int ATT_VOFF = 49152;

struct AUnit { const bf16 *Kw, *Vw, *Qp; size_t pitch; int kk_lo, nkeys, kb0, kstart, lo; float m0, l0; bf16* Op; float* Lp; int o8; };
__device__ __forceinline__ void attn_decode(Frame& F, int ch, int u, int NUA, int lane, AUnit& d) {
    unsigned char* ws = F.ws;
    const int w = F.wave, c = lane & 31, h = (lane >> 5) & 1;
    if (u < NUA) {
        const bf16* ZA = (const bf16*)(ws + WS_ZA);
        const int rt = u & 15, hh = (u >> 4) & 7, gb = u >> 7, g = gb % 3, bl = gb / 3;
        const int dsh = 2 * g, dd = 1 << dsh, tsh = 4 - dsh;
        const int r = rt >> tsh, tile = rt & ((1 << tsh) - 1), i0 = tile * 256;
        const int rowb = bl * SEQ + r, col = g * 512 + hh * 64;
        d.pitch = (size_t)dd * A_W;
        d.Kw = ZA + ((long)rowb + (long)dd * (i0 - 128)) * A_W + 1536 + col; d.Vw = d.Kw + 1536;
        const long qrow = (long)rowb + (long)dd * (i0 + 32 * w + c);
        d.Qp = ZA + qrow * A_W + col;
        d.kk_lo = (i0 == 0) ? 128 : 0; d.nkeys = 384; d.kb0 = w; d.kstart = (i0 == 0) ? (w < 4 ? 4 - w : 0) : 0; d.lo = 0;
        d.m0 = -1e30f; d.l0 = 0.f;
        d.Op = (bf16*)((unsigned char*)F.out + DO_OG) + ((size_t)g * TC + qrow) * 512 + hh * 64;
        d.Lp = (float*)((unsigned char*)F.out + DO_LSE) + ((size_t)g * TC + qrow) * 8 + hh;
        d.o8 = 0;
    } else {
        const int u2 = u - NUA;
        const bf16* ZB = (const bf16*)(ws + WS_ZB);
        const int blk = u2 & 127, kvh = (u2 >> 7) & 1, bl = u2 >> 8;
        const int t0 = blk * 32, rowb = bl * SEQ;
        d.pitch = B_W;
        d.Kw = ZB + ((long)rowb + t0 - 128) * B_W + 1024 + kvh * 64; d.Vw = d.Kw + 128;
        const int qh = kvh * 8 + w;
        const long qrow = (long)rowb + t0 + c;
        d.Qp = ZB + qrow * B_W + qh * 64;
        d.kk_lo = t0 < 128 ? 128 - t0 : 0; d.nkeys = 160; d.kb0 = 0; d.kstart = d.kk_lo >> 5; d.lo = 1;
        d.m0 = F.in[I_SINK][qh] * LOG2E; d.l0 = h == 0 ? 1.f : 0.f;
        d.o8 = P34_FP8;
        d.Op = P34_FP8 ? (bf16*)(ws + WS_Y + ((size_t)ch * TC + qrow) * Y_W + 512 + qh * 64) : (bf16*)(ws + WS_Y) + ((size_t)ch * TC + qrow) * Y_W + 512 + qh * 64;
        d.Lp = nullptr;
    }
}
__device__ __forceinline__ void attn_load(const AUnit& d, int tid, int lane, v4u (&kreg)[6], v4u (&vreg)[6], bf16x8 (&qf)[4]) {
    const int skey = tid >> 3, sch = tid & 7, h = (lane >> 5) & 1;
#pragma unroll
    for (int s4 = 0; s4 < 4; ++s4) qf[s4] = *(const GAS bf16x8*)(d.Qp + 16 * s4 + 8 * h);
#pragma unroll
    for (int p = 0; p < 6; ++p) { const int kk = 64 * p + skey;
        if (kk >= d.kk_lo && kk < d.nkeys) { kreg[p] = *(const GAS v4u*)(d.Kw + (size_t)kk * d.pitch + 8 * sch); vreg[p] = *(const GAS v4u*)(d.Vw + (size_t)kk * d.pitch + 8 * sch); } }
}
__device__ __forceinline__ void attn_write(const AUnit& d, LAS unsigned char* KL, LAS unsigned char* VL, int tid, const v4u (&kreg)[6], const v4u (&vreg)[6]) {
    const int skey = tid >> 3, sch = tid & 7;
#pragma unroll
    for (int p = 0; p < 6; ++p) { const int kk = 64 * p + skey;
        if (kk >= d.kk_lo && kk < d.nkeys) {
            *(LAS v4u*)(KL + kk * 128 + ((sch ^ ((kk >> 1) & 7)) << 4)) = kreg[p];
            *(LAS v4u*)(VL + kk * 128 + ((sch * 16) ^ (((kk >> 1) & 1) << 6))) = vreg[p]; } }
}
__device__ __forceinline__ void attn_compute_edge(const AUnit& d, const LAS unsigned char* KL, const LAS unsigned char* VL, int lane, const bf16x8 (&qf)[4]) {
    const int c = lane & 31, h = (lane >> 5) & 1;
    int koff[4];
    { const int kswz = (c >> 1) & 7;
#pragma unroll
      for (int s4 = 0; s4 < 4; ++s4) koff[s4] = c * 128 + (((2 * s4 + h) ^ kswz) << 4); }
    const int vrow = 4 * h + ((lane & 15) >> 2), vsw = (lane >> 3) & 1;
    const int voff0 = vrow * 128 + ((32 * ((lane >> 4) & 1) + 8 * (lane & 3)) ^ (vsw << 6)), voff1 = voff0 ^ 64;
    const float NEG = -INFINITY;
    float m = d.m0, l = d.l0;
    f32x16 o0, o1;
#pragma unroll
    for (int i = 0; i < 16; ++i) { o0[i] = 0.f; o1[i] = 0.f; }
    const LAS unsigned char* kbp = KL + d.kb0 * 4096; const LAS unsigned char* vbp = VL + d.kb0 * 4096;
    const int clo = c + d.lo;
#pragma unroll
    for (int kbi = 0; kbi < 5; ++kbi) {
        if (kbi >= d.kstart) {
            f32x16 p;
#pragma unroll
            for (int i = 0; i < 16; ++i) p[i] = 0.f;
#pragma unroll
            for (int s4 = 0; s4 < 4; ++s4) { const bf16x8 kf = *(const LAS bf16x8*)(kbp + kbi * 4096 + koff[s4]); p = __builtin_amdgcn_mfma_f32_32x32x16_bf16(kf, qf[s4], p, 0, 0, 0); }
            if (kbi == 0) {
#pragma unroll
                for (int i = 0; i < 16; ++i) { const int x = (i & 3) + 8 * (i >> 2) + 4 * h; if (x < clo) p[i] = NEG; }
            }
            if (kbi == 4) {
#pragma unroll
                for (int i = 0; i < 16; ++i) { const int x = (i & 3) + 8 * (i >> 2) + 4 * h; if (x > c) p[i] = NEG; }
            }
            float mt = p[0];
#pragma unroll
            for (int i = 1; i < 16; ++i) mt = fmaxf(mt, p[i]);
            mt = half_max(mt);
            const float mn = fmaxf(m, mt), alpha = __builtin_amdgcn_exp2f(m - mn);
            m = mn;
            float ps = 0.f;
#pragma unroll
            for (int i = 0; i < 16; ++i) { p[i] = __builtin_amdgcn_exp2f(p[i] - mn); ps += p[i]; }
            l = l * alpha + ps;
#pragma unroll
            for (int i = 0; i < 16; ++i) { o0[i] *= alpha; o1[i] *= alpha; }
            bf16x8 pb[2];
#pragma unroll
            for (int s2 = 0; s2 < 2; ++s2) { v4u t; t.x = cvtpk(p[8 * s2 + 0], p[8 * s2 + 1]); t.y = cvtpk(p[8 * s2 + 2], p[8 * s2 + 3]); t.z = cvtpk(p[8 * s2 + 4], p[8 * s2 + 5]); t.w = cvtpk(p[8 * s2 + 6], p[8 * s2 + 7]); pb[s2] = __builtin_bit_cast(bf16x8, t); }
#pragma unroll
            for (int s2 = 0; s2 < 2; ++s2) {
#pragma unroll
                for (int db = 0; db < 2; ++db) {
                    const LAS unsigned char* vp = vbp + kbi * 4096 + s2 * 2048 + (db ? voff1 : voff0);
                    const v4i16_t lo = __builtin_amdgcn_ds_read_tr16_b64_v4i16((LAS v4i16_t*)vp);
                    const v4i16_t hi = __builtin_amdgcn_ds_read_tr16_b64_v4i16((LAS v4i16_t*)(vp + 1024));
                    const bf16x8 vf = {lo[0], lo[1], lo[2], lo[3], hi[0], hi[1], hi[2], hi[3]};
                    if (db == 0) o0 = __builtin_amdgcn_mfma_f32_32x32x16_bf16(vf, pb[s2], o0, 0, 0, 0);
                    else o1 = __builtin_amdgcn_mfma_f32_32x32x16_bf16(vf, pb[s2], o1, 0, 0, 0);
                }
            }
        }
    }
    const float lt = half_sum(l), inv = 1.0f / lt;
#pragma unroll
    for (int g4 = 0; g4 < 4; ++g4) {
        v2u a, b;
        a.x = cvtpk(o0[4 * g4 + 0] * inv, o0[4 * g4 + 1] * inv); a.y = cvtpk(o0[4 * g4 + 2] * inv, o0[4 * g4 + 3] * inv);
        b.x = cvtpk(o1[4 * g4 + 0] * inv, o1[4 * g4 + 1] * inv); b.y = cvtpk(o1[4 * g4 + 2] * inv, o1[4 * g4 + 3] * inv);
        if (d.o8) { unsigned char* o8p = (unsigned char*)d.Op; const float sc = inv * Y8_SCALE;
            *(GAS unsigned*)(o8p + 8 * g4 + 4 * h) = pk4_fp8(o0[4 * g4 + 0] * sc, o0[4 * g4 + 1] * sc, o0[4 * g4 + 2] * sc, o0[4 * g4 + 3] * sc);
            *(GAS unsigned*)(o8p + 32 + 8 * g4 + 4 * h) = pk4_fp8(o1[4 * g4 + 0] * sc, o1[4 * g4 + 1] * sc, o1[4 * g4 + 2] * sc, o1[4 * g4 + 3] * sc); }
        else {
        *(GAS v2u*)(d.Op + 8 * g4 + 4 * h) = a;
        *(GAS v2u*)(d.Op + 32 + 8 * g4 + 4 * h) = b; }
    }
    if (d.Lp) { if (h == 0) *d.Lp = m + __builtin_amdgcn_logf(lt); }
}
__device__ __forceinline__ void attn_compute(const AUnit& d, const LAS unsigned char* KL, const LAS unsigned char* VL, int lane, const bf16x8 (&qf)[4]) {
    const int c = lane & 31, h = (lane >> 5) & 1;
    int koff[4];
    { const int kswz = (c >> 1) & 7;
#pragma unroll
      for (int s4 = 0; s4 < 4; ++s4) koff[s4] = c * 128 + (((2 * s4 + h) ^ kswz) << 4); }
    const int vrow = 4 * h + ((lane & 15) >> 2), vsw = (lane >> 3) & 1;
    const int voff0 = vrow * 128 + ((32 * ((lane >> 4) & 1) + 8 * (lane & 3)) ^ (vsw << 6)), voff1 = voff0 ^ 64;
    const float NEG = -INFINITY;
    float m = d.m0;
    f32x16 o0, o1, L;
#pragma unroll
    for (int i = 0; i < 16; ++i) { o0[i] = 0.f; o1[i] = 0.f; L[i] = 0.f; }
    v4u onesu = {0x3F803F80u, 0x3F803F80u, 0x3F803F80u, 0x3F803F80u}; asm volatile("" : "+v"(onesu));
    const bf16x8 ones = __builtin_bit_cast(bf16x8, onesu);
    const LAS unsigned char* kbp = KL + d.kb0 * 4096; const LAS unsigned char* vbp = VL + d.kb0 * 4096;
    const int clo = c + d.lo;
#pragma unroll
    for (int kbi = 0; kbi < 5; ++kbi) {
        {
            constexpr bool first_dummy = false; (void)first_dummy;
            const bool first = (kbi == 0);
            const float cinit = first ? 0.f : -m;
            f32x16 p;
#pragma unroll
            for (int i = 0; i < 16; ++i) p[i] = cinit;
#pragma unroll
            for (int s4 = 0; s4 < 4; ++s4) { const bf16x8 kf = *(const LAS bf16x8*)(kbp + kbi * 4096 + koff[s4]); p = __builtin_amdgcn_mfma_f32_32x32x16_bf16(kf, qf[s4], p, 0, 0, 0); }
            if (kbi == 0) {
#pragma unroll
                for (int i = 0; i < 16; ++i) { const int x = (i & 3) + 8 * (i >> 2) + 4 * h; p[i] = x < clo ? NEG : p[i]; }
            }
            if (kbi == 4) {
#pragma unroll
                for (int i = 0; i < 16; ++i) { const int x = (i & 3) + 8 * (i >> 2) + 4 * h; p[i] = x > c ? NEG : p[i]; }
            }
            float t0 = max3f(p[0], p[4], p[8]), t1 = max3f(p[1], p[5], p[9]), t2 = max3f(p[2], p[6], p[10]), t3 = max3f(p[3], p[7], p[11]);
            t0 = max3f(t0, p[12], p[13]); t1 = max3f(t1, p[14], p[15]);
            const float mt = half_max(max3f(max3f(t0, t1, t2), t3, t3));
            if (first) {
                const float mn = fmaxf(m, mt), l0 = d.m0 > -1e29f ? __builtin_amdgcn_exp2f(m - mn) : 0.f;
                m = mn;
#pragma unroll
                for (int i = 0; i < 16; ++i) { p[i] -= mn; L[i] = l0; }
            } else if (__any(mt > 8.0f)) {
                const float dl = fmaxf(mt, 0.f), al = __builtin_amdgcn_exp2f(-dl);
                m += dl;
#pragma unroll
                for (int i = 0; i < 16; ++i) { o0[i] *= al; o1[i] *= al; L[i] *= al; p[i] -= dl; }
            }
#pragma unroll
            for (int i = 0; i < 16; ++i) p[i] = __builtin_amdgcn_exp2f(p[i]);
            bf16x8 pb[2];
#pragma unroll
            for (int s2 = 0; s2 < 2; ++s2) { v4u t; t.x = cvtpk(p[8 * s2 + 0], p[8 * s2 + 1]); t.y = cvtpk(p[8 * s2 + 2], p[8 * s2 + 3]); t.z = cvtpk(p[8 * s2 + 4], p[8 * s2 + 5]); t.w = cvtpk(p[8 * s2 + 6], p[8 * s2 + 7]); pb[s2] = __builtin_bit_cast(bf16x8, t); }
#pragma unroll
            for (int s2 = 0; s2 < 2; ++s2) {
                L = __builtin_amdgcn_mfma_f32_32x32x16_bf16(ones, pb[s2], L, 0, 0, 0);
#pragma unroll
                for (int db = 0; db < 2; ++db) {
                    const LAS unsigned char* vp = vbp + kbi * 4096 + s2 * 2048 + (db ? voff1 : voff0);
                    const v4i16_t lo = __builtin_amdgcn_ds_read_tr16_b64_v4i16((LAS v4i16_t*)vp);
                    const v4i16_t hi = __builtin_amdgcn_ds_read_tr16_b64_v4i16((LAS v4i16_t*)(vp + 1024));
                    const bf16x8 vf = {lo[0], lo[1], lo[2], lo[3], hi[0], hi[1], hi[2], hi[3]};
                    if (db == 0) o0 = __builtin_amdgcn_mfma_f32_32x32x16_bf16(vf, pb[s2], o0, 0, 0, 0);
                    else o1 = __builtin_amdgcn_mfma_f32_32x32x16_bf16(vf, pb[s2], o1, 0, 0, 0);
                }
            }
        }
    }
    const float lt = L[0], inv = 1.0f / lt;
#pragma unroll
    for (int g4 = 0; g4 < 4; ++g4) {
        v2u a, b;
        a.x = cvtpk(o0[4 * g4 + 0] * inv, o0[4 * g4 + 1] * inv); a.y = cvtpk(o0[4 * g4 + 2] * inv, o0[4 * g4 + 3] * inv);
        b.x = cvtpk(o1[4 * g4 + 0] * inv, o1[4 * g4 + 1] * inv); b.y = cvtpk(o1[4 * g4 + 2] * inv, o1[4 * g4 + 3] * inv);
        if (d.o8) { unsigned char* o8p = (unsigned char*)d.Op; const float sc = inv * Y8_SCALE;
            *(GAS unsigned*)(o8p + 8 * g4 + 4 * h) = pk4_fp8(o0[4 * g4 + 0] * sc, o0[4 * g4 + 1] * sc, o0[4 * g4 + 2] * sc, o0[4 * g4 + 3] * sc);
            *(GAS unsigned*)(o8p + 32 + 8 * g4 + 4 * h) = pk4_fp8(o1[4 * g4 + 0] * sc, o1[4 * g4 + 1] * sc, o1[4 * g4 + 2] * sc, o1[4 * g4 + 3] * sc); }
        else {
        *(GAS v2u*)(d.Op + 8 * g4 + 4 * h) = a;
        *(GAS v2u*)(d.Op + 32 + 8 * g4 + 4 * h) = b; }
    }
    if (d.Lp) { if (h == 0) *d.Lp = m + __builtin_amdgcn_logf(lt); }
}
__device__ __forceinline__ void p2_attn(Frame& F, int ch) {
    int tid_ = threadIdx.x; asm volatile("" : "+v"(tid_));
    const int tid = tid_, lane = tid & 63;
    LAS unsigned char* KL = F.lds; LAS unsigned char* VL = F.lds + ATT_VOFF;
    constexpr int NUA = (TC / SEQ) * 3 * 8 * 16, NUB = (TC / SEQ) * 2 * 128, NU = NUA + NUB;
    int u = F.vcu;
    if (u >= NU) return;
    AUnit cur, nxt;
    v4u kreg[6], vreg[6]; bf16x8 qn[4];
    attn_decode(F, ch, u, NUA, lane, cur);
    attn_load(cur, tid, lane, kreg, vreg, qn);
    for (;;) {
        attn_write(cur, KL, VL, tid, kreg, vreg);
        bf16x8 qf[4];
#pragma unroll
        for (int s4 = 0; s4 < 4; ++s4) qf[s4] = qn[s4];
        __syncthreads();
        const int un = u + F.G; const bool has_next = un < NU;
        if (has_next) { attn_decode(F, ch, un, NUA, lane, nxt); attn_load(nxt, tid, lane, kreg, vreg, qn); }
        if (cur.kk_lo == 0) attn_compute(cur, KL, VL, lane, qf); else attn_compute_edge(cur, KL, VL, lane, qf);
        __syncthreads();
        if (!has_next) break;
        cur = nxt; u = un;
    }
}
__device__ __forceinline__ void p2_combine(Frame& F, int ch, int cu, int ncu) {
    int tid_ = threadIdx.x; asm volatile("" : "+v"(tid_)); const int lane_ = tid_ & 63;
    unsigned char* ws = F.ws;
    const bf16* OG = (const bf16*)((const unsigned char*)F.out + DO_OG); const float* LSE = (const float*)((const unsigned char*)F.out + DO_LSE);
    bf16* Y = (bf16*)(ws + WS_Y) + (size_t)ch * TC * Y_W; unsigned char* Y8 = ws + WS_Y + (size_t)ch * TC * Y_W;
    const int lane = lane_, hd = lane >> 3;
    const int gw = cu * NWAVES + F.wave, NGW = ncu * NWAVES;
    for (int row0 = gw; row0 < TC; row0 += 4 * NGW) {
        float lg[4][3]; v4u og[4][3];
#pragma unroll
        for (int r = 0; r < 4; ++r) { const int row = row0 + r * NGW < TC ? row0 + r * NGW : row0;
#pragma unroll
            for (int g = 0; g < 3; ++g) { lg[r][g] = LSE[((size_t)g * TC + row) * 8 + hd]; og[r][g] = *(const GAS v4u*)(OG + ((size_t)g * TC + row) * 512 + lane * 8); } }
#pragma unroll
        for (int r = 0; r < 4; ++r) { const int row = row0 + r * NGW; if (row >= TC) continue;
            const float mx = fmaxf(fmaxf(lg[r][0], lg[r][1]), lg[r][2]);
            float e[3]; e[0] = __builtin_amdgcn_exp2f(lg[r][0] - mx); e[1] = __builtin_amdgcn_exp2f(lg[r][1] - mx); e[2] = __builtin_amdgcn_exp2f(lg[r][2] - mx);
            const float inv = 1.0f / (e[0] + e[1] + e[2]);
            float acc[8];
#pragma unroll
            for (int i = 0; i < 8; ++i) acc[i] = 0.f;
#pragma unroll
            for (int g = 0; g < 3; ++g) { const float wg = e[g] * inv; const v4u o_ = og[r][g];
                acc[0] += wg * bflo(o_.x); acc[1] += wg * bfhi(o_.x); acc[2] += wg * bflo(o_.y); acc[3] += wg * bfhi(o_.y);
                acc[4] += wg * bflo(o_.z); acc[5] += wg * bfhi(o_.z); acc[6] += wg * bflo(o_.w); acc[7] += wg * bfhi(o_.w); }
            v4u o; o.x = cvtpk(acc[0], acc[1]); o.y = cvtpk(acc[2], acc[3]); o.z = cvtpk(acc[4], acc[5]); o.w = cvtpk(acc[6], acc[7]);
            if (P34_FP8) { v2u o8; o8.x = pk4_fp8(acc[0] * Y8_SCALE, acc[1] * Y8_SCALE, acc[2] * Y8_SCALE, acc[3] * Y8_SCALE); o8.y = pk4_fp8(acc[4] * Y8_SCALE, acc[5] * Y8_SCALE, acc[6] * Y8_SCALE, acc[7] * Y8_SCALE); *(GAS v2u*)(Y8 + (size_t)row * Y_W + lane * 8) = o8; }
            else *(GAS v4u*)(Y + (size_t)row * Y_W + lane * 8) = o; }
    }
}


struct EpiMerge {
    static constexpr bool PERM = true; static constexpr int HOOK_T = P34_FP8 ? 4 : 8;
    const bf16* Gt; bf16* MG;
    __device__ __forceinline__ void prefetch(LAS unsigned char*, const pg9::Unit&, int, int, int) const {}
    __device__ __forceinline__ void hook(f32x4 (&acc)[2][2][4][2], const pg9::Unit& u, int wr, int wc, int fr, int fq) const {
        asm volatile("" : "+v"(fr), "+v"(fq));
        const bf16* gr = Gt + ((size_t)((u.pm * 256 + wr * 64) >> 4) * 256 + u.pn * 32 + wc * 4 + fq) * 128 + fr * 8;
        v4u rv[8][2];
#pragma unroll
        for (int rg = 0; rg < 8; ++rg)
#pragma unroll
            for (int bj = 0; bj < 2; ++bj) rv[rg][bj] = *(const GAS v4u*)(gr + (size_t)((rg >> 2) * 8 + (rg & 3)) * 32768 + bj * 16 * 128);
#pragma unroll
        for (int rg = 0; rg < 8; ++rg)
#pragma unroll
            for (int bj = 0; bj < 2; ++bj) { const v4u a = rv[rg][bj];
                const f32x4 r0 = {bflo(a.x), bfhi(a.x), bflo(a.y), bfhi(a.y)}, r1 = {bflo(a.z), bfhi(a.z), bflo(a.w), bfhi(a.w)};
                acc[rg >> 2][bj][rg & 3][0] = acc[rg >> 2][bj][rg & 3][0] * r0; acc[rg >> 2][bj][rg & 3][1] = acc[rg >> 2][bj][rg & 3][1] * r1; }
    }
    __device__ __forceinline__ void operator()(const f32x4 (&acc)[2][2][4][2], const pg9::Unit& u, int ui, int wr, int wc, int fr, int fq) const {
        asm volatile("" : "+v"(fr), "+v"(fq));
        const bf16* gr = Gt + ((size_t)((u.pm * 256 + wr * 64) >> 4) * 256 + 128 + u.pn * 32 + wc * 4 + fq) * 128 + fr * 8;
        const int fr2 = (fr >> 2) + 4 * fq, fq2 = fr & 3, paddr = 4 * (16 * (fr & 3) + 4 * fq + (fr >> 2));
        bf16* mr = MG + (size_t)(u.pm * 256 + wr * 64 + fr2) * D + u.pn * 256 + wc * 32 + 8 * fq2;
        v4u gb[8][2];
#pragma unroll
        for (int rg = 0; rg < 8; ++rg)
#pragma unroll
            for (int bj = 0; bj < 2; ++bj) gb[rg][bj] = *(const GAS v4u*)(gr + (size_t)((rg >> 2) * 8 + (rg & 3)) * 32768 + bj * 16 * 128);
#pragma unroll
        for (int rg = 0; rg < 8; ++rg)
#pragma unroll
            for (int bj = 0; bj < 2; ++bj) { const v4u b = gb[rg][bj];
                const f32x4 v0 = acc[rg >> 2][bj][rg & 3][0], v1 = acc[rg >> 2][bj][rg & 3][1];
                if (P34_FP8) { constexpr float f = MG8_SCALE / (W34_SCALE * Y8_SCALE); unsigned char* m8 = (unsigned char*)MG + (size_t)(u.pm * 256 + wr * 64 + fr2) * D + u.pn * 256 + wc * 32 + 8 * fq2;
                    v2u w8; w8.x = pk4_fp8(v0[0] * bflo(b.x) * f, v0[1] * bfhi(b.x) * f, v0[2] * bflo(b.y) * f, v0[3] * bfhi(b.y) * f); w8.y = pk4_fp8(v1[0] * bflo(b.z) * f, v1[1] * bfhi(b.z) * f, v1[2] * bflo(b.w) * f, v1[3] * bfhi(b.w) * f);
                    w8.x = (unsigned)__builtin_amdgcn_ds_bpermute(paddr, (int)w8.x); w8.y = (unsigned)__builtin_amdgcn_ds_bpermute(paddr, (int)w8.y);
                    *(GAS v2u*)(m8 + (size_t)((rg >> 2) * 128 + (rg & 3) * 16) * D + bj * 128) = w8; }
                else {
                v4u w; w.x = cvtpk(v0[0] * bflo(b.x), v0[1] * bfhi(b.x)); w.y = cvtpk(v0[2] * bflo(b.y), v0[3] * bfhi(b.y));
                w.z = cvtpk(v1[0] * bflo(b.z), v1[1] * bfhi(b.z)); w.w = cvtpk(v1[2] * bflo(b.w), v1[3] * bfhi(b.w));
                w.x = (unsigned)__builtin_amdgcn_ds_bpermute(paddr, (int)w.x); w.y = (unsigned)__builtin_amdgcn_ds_bpermute(paddr, (int)w.y); w.z = (unsigned)__builtin_amdgcn_ds_bpermute(paddr, (int)w.z); w.w = (unsigned)__builtin_amdgcn_ds_bpermute(paddr, (int)w.w);
                *(GAS v4u*)(mr + (size_t)((rg >> 2) * 128 + (rg & 3) * 16) * D + bj * 128) = w; } }
    }
};
__device__ __forceinline__ void p3_merge(Frame& F) {
    unsigned char* ws = F.ws;
    pg9::DenseOrder S; S.init(T, D, F.G, (int)blockIdx.x);
    EpiMerge E{(const bf16*)(ws + WS_G), (bf16*)(ws + WS_MG)};
    constexpr int ES = P34_FP8 ? 1 : 2;
    pg9::DenseA ao{(unsigned)(Y_W * ES)}; pg9::DenseB bb{(const char*)(ws + WS_WAB), (size_t)256 * Y_W * ES};
    pg9::gemm_phase<ES>(F.lds, (const char*)(ws + WS_Y), Y_W, S, E, ao, bb);
}
struct EpiOut {
    static constexpr bool PERM = true; static constexpr int HOOK_T = -1;
    bf16* DELTA;
    __device__ __forceinline__ void hook(f32x4 (&)[2][2][4][2], const pg9::Unit&, int, int, int, int) const {}
    __device__ __forceinline__ void prefetch(LAS unsigned char*, const pg9::Unit&, int, int, int) const {}
    __device__ __forceinline__ void operator()(const f32x4 (&acc)[2][2][4][2], const pg9::Unit& u, int ui, int wr, int wc, int fr, int fq) const {
        asm volatile("" : "+v"(fr), "+v"(fq));
        const int fr2 = (fr >> 2) + 4 * fq, fq2 = fr & 3, paddr = 4 * (16 * (fr & 3) + 4 * fq + (fr >> 2));
        bf16* orow = DELTA + (size_t)(u.pm * 256 + wr * 64 + fr2) * D + u.pn * 256 + wc * 32 + 8 * fq2;
#pragma unroll
        for (int ai = 0; ai < 2; ++ai)
#pragma unroll
            for (int m = 0; m < 4; ++m)
#pragma unroll
                for (int bj = 0; bj < 2; ++bj) { constexpr float f = P34_FP8 ? 1.0f / (W34_SCALE * MG8_SCALE) : 1.0f; const f32x4 o0 = acc[ai][bj][m][0] * f, o1 = acc[ai][bj][m][1] * f;
                    v4u w; w.x = cvtpk(o0[0], o0[1]); w.y = cvtpk(o0[2], o0[3]); w.z = cvtpk(o1[0], o1[1]); w.w = cvtpk(o1[2], o1[3]);
                    w.x = (unsigned)__builtin_amdgcn_ds_bpermute(paddr, (int)w.x); w.y = (unsigned)__builtin_amdgcn_ds_bpermute(paddr, (int)w.y); w.z = (unsigned)__builtin_amdgcn_ds_bpermute(paddr, (int)w.z); w.w = (unsigned)__builtin_amdgcn_ds_bpermute(paddr, (int)w.w);
                    *(GAS v4u*)(orow + (size_t)(ai * 128 + m * 16) * D + bj * 128) = w; }
    }
};
__device__ __forceinline__ void p4_outproj(Frame& F) {
    unsigned char* ws = F.ws;
    pg9::DenseOrder S; S.init(T, D, F.G, (int)blockIdx.x);
    EpiOut E{(bf16*)((unsigned char*)F.out + DO_DELTA)};
    constexpr int ES = P34_FP8 ? 1 : 2;
    pg9::DenseA ao{(unsigned)(D * ES)}; pg9::DenseB bb{(const char*)(ws + WS_WO), (size_t)256 * D * ES};
    pg9::gemm_phase<ES>(F.lds, (const char*)(ws + WS_MG), D, S, E, ao, bb);
}

__device__ __forceinline__ void p5_route(Frame& F) {
    int tid_ = threadIdx.x; asm volatile("" : "+v"(tid_)); const int lane = tid_ & 63;
    unsigned char* ws = F.ws;
    const float* X = F.in[I_X]; const bf16* DELTA = (const bf16*)((const unsigned char*)F.out + DO_DELTA);
    bf16* X1B = (bf16*)(ws + WS_X1B); unsigned char* X1F8 = ws + WS_X1F8;
    unsigned* cnt = (unsigned*)(ws + WS_CTL) + CW_CNT;
    int* tokof = (int*)(ws + WS_TOKOF); float2* wtof = (float2*)(ws + WS_WTOF); int4* tpos = (int4*)(ws + WS_TPOS);
    const v4u* WRF = (const v4u*)(ws + WS_WRF);
    LAS v4u* wl = (LAS v4u*)F.lds;
    LAS float* sl = (LAS float*)(F.lds + 98304 + F.wave * 4096);
    const int i = lane & 15, q = lane >> 4;
    LAS unsigned* hist = (LAS unsigned*)(F.lds + LDS_MISC + 2048);
    for (int wt = F.vcu; wt < T / 128; wt += F.G) {
        const int tile = wt * NWAVES + F.wave;
        if (tid_ < 32) hist[tid_] = 0u;
        const size_t roff = (size_t)(tile * 16 + i) * D + 8 * q;
        const float* xr = X + roff; const bf16* dr = DELTA + roff;
        f32x4 a0 = {0.f, 0.f, 0.f, 0.f}, a1 = a0, a2 = a0; float ss = 0.f;
        f32x4 va[8][2]; v4u vd[8];
#pragma unroll
        for (int j = 0; j < 8; ++j) { va[j][0] = *(const GAS f32x4*)(xr + 32 * j); va[j][1] = *(const GAS f32x4*)(xr + 32 * j + 4); vd[j] = *(const GAS v4u*)(dr + 32 * j); }
#pragma unroll 1
        for (int half = 0; half < 2; ++half) {
            __syncthreads();
            { v4u t[12];
#pragma unroll
              for (int k = 0; k < 12; ++k) t[k] = WRF[half * 6144 + k * 512 + tid_];
#pragma unroll
              for (int k = 0; k < 12; ++k) wl[k * 512 + tid_] = t[k]; }
            __syncthreads();
#pragma unroll 1
            for (int sb = 0; sb < 2; ++sb) {
#pragma unroll
                for (int j = 0; j < 8; ++j) {
                    const int ksl = sb * 8 + j, ks = half * 16 + ksl;
                    const v4u dd = vd[j];
                    const f32x4 v0 = va[j][0] + (f32x4){bflo(dd.x), bfhi(dd.x), bflo(dd.y), bfhi(dd.y)}, v1 = va[j][1] + (f32x4){bflo(dd.z), bfhi(dd.z), bflo(dd.w), bfhi(dd.w)};
                    if (ks + 8 < 32) { va[j][0] = *(const GAS f32x4*)(xr + 32 * (ks + 8)); va[j][1] = *(const GAS f32x4*)(xr + 32 * (ks + 8) + 4); vd[j] = *(const GAS v4u*)(dr + 32 * (ks + 8)); }
                    ss += ((v0[0] * v0[0] + v0[1] * v0[1]) + (v0[2] * v0[2] + v0[3] * v0[3])) + ((v1[0] * v1[0] + v1[1] * v1[1]) + (v1[2] * v1[2] + v1[3] * v1[3]));
                    v4u hu; hu.x = cvtpk(v0[0], v0[1]); hu.y = cvtpk(v0[2], v0[3]); hu.z = cvtpk(v1[0], v1[1]); hu.w = cvtpk(v1[2], v1[3]);
                    v4u lu; lu.x = cvtpk(v0[0] - bflo(hu.x), v0[1] - bfhi(hu.x)); lu.y = cvtpk(v0[2] - bflo(hu.y), v0[3] - bfhi(hu.y)); lu.z = cvtpk(v1[0] - bflo(hu.z), v1[1] - bfhi(hu.z)); lu.w = cvtpk(v1[2] - bflo(hu.w), v1[3] - bfhi(hu.w));
                    *(GAS v4u*)(X1B + roff + 32 * ks) = hu;
                    if (P6_FP8) { v2u w8; w8.x = pk4_fp8(v0[0], v0[1], v0[2], v0[3]); w8.y = pk4_fp8(v1[0], v1[1], v1[2], v1[3]); *(GAS v2u*)(X1F8 + roff + 32 * ks) = w8; }
                    const bf16x8 ah = __builtin_bit_cast(bf16x8, hu), al = __builtin_bit_cast(bf16x8, lu);
#pragma unroll
                    for (int nb = 0; nb < 3; ++nb) {
                        const bf16x8 bh = __builtin_bit_cast(bf16x8, wl[((ksl * 3 + nb) * 2 + 0) * 64 + lane]), bl = __builtin_bit_cast(bf16x8, wl[((ksl * 3 + nb) * 2 + 1) * 64 + lane]);
                        f32x4 acc = nb == 0 ? a0 : (nb == 1 ? a1 : a2);
                        acc = __builtin_amdgcn_mfma_f32_16x16x32_bf16(ah, bh, acc, 0, 0, 0); acc = __builtin_amdgcn_mfma_f32_16x16x32_bf16(ah, bl, acc, 0, 0, 0); acc = __builtin_amdgcn_mfma_f32_16x16x32_bf16(al, bh, acc, 0, 0, 0);
                        if (nb == 0) a0 = acc; else if (nb == 1) a1 = acc; else a2 = acc;
                    }
                }
            }
        }
        ss += __shfl_xor(ss, 16); ss += __shfl_xor(ss, 32);
#pragma unroll
        for (int r = 0; r < 4; ++r) { sl[(4 * q + r) * 48 + i] = a0[r]; sl[(4 * q + r) * 48 + 16 + i] = a1[r]; sl[(4 * q + r) * 48 + 32 + i] = a2[r]; }
        LDS_WAIT(); asm volatile("" ::: "memory");
        int e0 = 0, e1 = 0, lp0 = 0, lp1 = 0; float w1 = 0.f, w2 = 0.f, rstd = 0.f;
        __syncthreads();
        if (lane < 16) {
            rstd = 1.0f / sqrtf(ss * (1.f / D) + RMS_EPS);
            float lg[36];
#pragma unroll
            for (int o = 0; o < 36; ++o) lg[o] = sl[lane * 48 + o] * rstd + (o < 4 ? F.in[I_BRG][o] : F.in[I_BRE][o - 4]);
            int gsel = 0; float gmax = lg[0];
#pragma unroll
            for (int k = 1; k < 4; ++k) if (lg[k] > gmax) { gmax = lg[k]; gsel = k; }
            float gden = 0.f;
#pragma unroll
            for (int k = 0; k < 4; ++k) gden += __expf(lg[k] - gmax);
            const float pg = 1.0f / gden;
            float le[8];
#pragma unroll
            for (int j = 0; j < 8; ++j) { le[j] = lg[4 + j];
#pragma unroll
                for (int gi = 1; gi < 4; ++gi) le[j] = (gsel == gi) ? lg[4 + gi * 8 + j] : le[j]; }
            int i1 = 0; float m1 = le[0];
#pragma unroll
            for (int j = 1; j < 8; ++j) if (le[j] > m1) { m1 = le[j]; i1 = j; }
            int i2 = -1; float m2 = -INFINITY;
#pragma unroll
            for (int j = 0; j < 8; ++j) if (j != i1 && le[j] > m2) { m2 = le[j]; i2 = j; }
            const float e2 = __expf(m2 - m1);
            w1 = pg / (1.0f + e2); w2 = pg * e2 / (1.0f + e2);
            e0 = gsel * 8 + i1; e1 = gsel * 8 + i2;
            lp0 = (int)__hip_atomic_fetch_add(&hist[e0], 1u, __ATOMIC_RELAXED, __HIP_MEMORY_SCOPE_WORKGROUP);
            lp1 = (int)__hip_atomic_fetch_add(&hist[e1], 1u, __ATOMIC_RELAXED, __HIP_MEMORY_SCOPE_WORKGROUP);
        }
        __syncthreads();
        if (tid_ < 32) { const unsigned n = hist[tid_]; hist[32 + tid_] = n ? atomicAdd(&cnt[64 * tid_], n) : 0u; }
        __syncthreads();
        if (lane < 16) {
            const int row = tile * 16 + lane;
            const int p0 = (int)hist[32 + e0] + lp0, p1 = (int)hist[32 + e1] + lp1;
            tokof[(size_t)e0 * T + p0] = row; wtof[(size_t)e0 * T + p0] = make_float2(w1, rstd);
            tokof[(size_t)e1 * T + p1] = row; wtof[(size_t)e1 * T + p1] = make_float2(w2, rstd);
            tpos[row] = make_int4(e0, p0, e1, p1);
        }
        __syncthreads();
    }
}

__device__ __forceinline__ void expert_tiles(Frame& F, LAS int* tb, LAS int* cn) {
    int tid_ = threadIdx.x; asm volatile("" : "+v"(tid_)); const int lane_ = tid_ & 63;
    if (tid_ == 0) {
        const unsigned* cnt = (const unsigned*)(F.ws + WS_CTL) + CW_CNT;
        int acc = 0;
        for (int e = 0; e < NE; ++e) { const int c = (int)__hip_atomic_load(cnt + 64 * e, __ATOMIC_RELAXED, __HIP_MEMORY_SCOPE_AGENT); cn[e] = c; tb[e] = acc; acc += (c + 255) >> 8; }
        tb[NE] = acc;
    }
    __syncthreads();
}

struct MoeOrder { const LAS int* tb; int ncol, G, c;
    __device__ bool next(int i, pg9::Unit& u) const {
        const int L = i * G + c; if (L >= tb[NE] * ncol) return false;
        const int rt = L / ncol; int e = 0;
        for (int k = 1; k < NE; ++k) if (tb[k] <= rt) e = k;
        u.pm = rt; u.pn = L % ncol; u.e = e; return true; } };
struct GatherA { static constexpr bool GATHER = true; unsigned rowbytes; const int* tokof; const LAS int* tb; const LAS int* cn;
    __device__ __forceinline__ unsigned operator()(const pg9::Unit& u, int row) const {
        const int p = (u.pm - tb[u.e]) * 256 + row; const int tok = tokof[(size_t)u.e * T + (p < cn[u.e] ? p : 0)]; return (unsigned)tok * rowbytes; } };
struct ExpertB { const char* W; size_t ebytes, tilebytes; __device__ __forceinline__ const char* operator()(const pg9::Unit& u) const { return W + (size_t)u.e * ebytes + (size_t)u.pn * tilebytes; } };
struct EpiGateUp {
    static constexpr bool PERM = true; static constexpr int HOOK_T = -1;
    const float2* wtof; bf16* HACT; const LAS int* tb; const LAS int* cn; float ascale;
    __device__ __forceinline__ void hook(f32x4 (&)[2][2][4][2], const pg9::Unit&, int, int, int, int) const {}
    __device__ __forceinline__ void prefetch(LAS unsigned char*, const pg9::Unit&, int, int, int) const {}
    __device__ __forceinline__ void operator()(const f32x4 (&acc)[2][2][4][2], const pg9::Unit& u, int ui, int wr, int wc, int fr, int fq) const {
        asm volatile("" : "+v"(fr), "+v"(fq));
        const int r0 = wr * 64 + fr, p0 = (u.pm - tb[u.e]) * 256, ce = cn[u.e];
        const int fr2 = (fr >> 2) + 4 * fq, fq2 = fr & 3, paddr = 4 * (16 * (fr & 3) + 4 * fq + (fr >> 2)), r0s = wr * 64 + fr2;
        const float2* wp = wtof + (size_t)u.e * T;
#pragma unroll
        for (int ai = 0; ai < 2; ++ai) {
            float2 wv[4];
#pragma unroll
            for (int m = 0; m < 4; ++m) { const int p = p0 + r0 + ai * 128 + m * 16; wv[m] = p < ce ? wp[p] : make_float2(0.f, 0.f); }
#pragma unroll
            for (int m = 0; m < 4; ++m) { const int r = r0s + ai * 128 + m * 16;
                const float w = wv[m].x, rs = wv[m].y * ascale;
                bf16* orow = HACT + (size_t)(u.pm * 256 + r) * DE + u.pn * 128 + wc * 16 + 4 * fq2; unsigned char* orow8 = (unsigned char*)HACT + (size_t)(u.pm * 256 + r) * DE + u.pn * 128 + wc * 16 + 4 * fq2;
#pragma unroll
                for (int bj = 0; bj < 2; ++bj) { const f32x4 g = acc[ai][bj][m][0], uu = acc[ai][bj][m][1]; f32x4 hv;
#pragma unroll
                    for (int e = 0; e < 4; ++e) { const float gg = g[e] * rs; hv[e] = gg / (1.0f + __expf(-gg)) * (uu[e] * rs) * w; }
                    if (P6_FP8) *(GAS unsigned*)(orow8 + bj * 64) = (unsigned)__builtin_amdgcn_ds_bpermute(paddr, (int)pk4_fp8(hv[0] * H8_SCALE, hv[1] * H8_SCALE, hv[2] * H8_SCALE, hv[3] * H8_SCALE));
                    else { v2u o; o.x = (unsigned)__builtin_amdgcn_ds_bpermute(paddr, (int)cvtpk(hv[0], hv[1])); o.y = (unsigned)__builtin_amdgcn_ds_bpermute(paddr, (int)cvtpk(hv[2], hv[3])); *(GAS v2u*)(orow + bj * 64) = o; } } }
        }
    }
};
__device__ __forceinline__ void p6a_gateup(Frame& F) {
    unsigned char* ws = F.ws;
    LAS int* tb = (LAS int*)(F.lds + LDS_MISC + 1024); LAS int* cn = tb + 64;
    expert_tiles(F, tb, cn);
    MoeOrder S{tb, 2, F.G, F.vcu};
    constexpr int ES = P6_FP8 ? 1 : 2;
    GatherA ao{(unsigned)(D * ES), (const int*)(ws + WS_TOKOF), tb, cn}; ExpertB bb{(const char*)(ws + WS_WGU), (size_t)512 * D * ES, (size_t)256 * D * ES};
    EpiGateUp E{(const float2*)(ws + WS_WTOF), (bf16*)(ws + WS_HACT), tb, cn, P6_FP8 ? 1.0f / WG8_SCALE : 1.0f};
    pg9::gemm_phase<ES>(F.lds, (const char*)(ws + (P6_FP8 ? WS_X1F8 : WS_X1B)), D, S, E, ao, bb);
}
struct EpiDown {
    static constexpr bool PERM = true; static constexpr int HOOK_T = -1;
    bf16* YS; float ascale;
    __device__ __forceinline__ void hook(f32x4 (&)[2][2][4][2], const pg9::Unit&, int, int, int, int) const {}
    __device__ __forceinline__ void prefetch(LAS unsigned char*, const pg9::Unit&, int, int, int) const {}
    __device__ __forceinline__ void operator()(const f32x4 (&acc)[2][2][4][2], const pg9::Unit& u, int ui, int wr, int wc, int fr, int fq) const {
        asm volatile("" : "+v"(fr), "+v"(fq));
        const int fr2 = (fr >> 2) + 4 * fq, fq2 = fr & 3, paddr = 4 * (16 * (fr & 3) + 4 * fq + (fr >> 2));
#pragma unroll
        for (int ai = 0; ai < 2; ++ai)
#pragma unroll
            for (int m = 0; m < 4; ++m) { bf16* orow = YS + (size_t)(u.pm * 256 + wr * 64 + fr2 + ai * 128 + m * 16) * D + u.pn * 256 + wc * 32 + 8 * fq2;
#pragma unroll
                for (int bj = 0; bj < 2; ++bj) { const f32x4 v0 = acc[ai][bj][m][0] * ascale, v1 = acc[ai][bj][m][1] * ascale;
                    if (YS_FP8) { unsigned char* o8 = (unsigned char*)YS + (size_t)(u.pm * 256 + wr * 64 + fr2 + ai * 128 + m * 16) * D + u.pn * 256 + wc * 32 + 8 * fq2 + bj * 128;
                        v2u w8; w8.x = pk4_fp8(v0[0] * YS8_SCALE, v0[1] * YS8_SCALE, v0[2] * YS8_SCALE, v0[3] * YS8_SCALE); w8.y = pk4_fp8(v1[0] * YS8_SCALE, v1[1] * YS8_SCALE, v1[2] * YS8_SCALE, v1[3] * YS8_SCALE);
                        w8.x = (unsigned)__builtin_amdgcn_ds_bpermute(paddr, (int)w8.x); w8.y = (unsigned)__builtin_amdgcn_ds_bpermute(paddr, (int)w8.y); *(GAS v2u*)o8 = w8; }
                    else { v4u w; w.x = cvtpk(v0[0], v0[1]); w.y = cvtpk(v0[2], v0[3]); w.z = cvtpk(v1[0], v1[1]); w.w = cvtpk(v1[2], v1[3]);
                        w.x = (unsigned)__builtin_amdgcn_ds_bpermute(paddr, (int)w.x); w.y = (unsigned)__builtin_amdgcn_ds_bpermute(paddr, (int)w.y); w.z = (unsigned)__builtin_amdgcn_ds_bpermute(paddr, (int)w.z); w.w = (unsigned)__builtin_amdgcn_ds_bpermute(paddr, (int)w.w); *(GAS v4u*)(orow + bj * 128) = w; } } }
    }
};
__device__ __forceinline__ void p6b_down(Frame& F) {
    unsigned char* ws = F.ws;
    LAS int* tb = (LAS int*)(F.lds + LDS_MISC + 1024); LAS int* cn = tb + 64;
    expert_tiles(F, tb, cn);
    MoeOrder S{tb, 4, F.G, F.vcu};
    constexpr int ES = P6_FP8 ? 1 : 2;
    pg9::DenseA ao{(unsigned)(DE * ES)}; ExpertB bb{(const char*)(ws + WS_WD), (size_t)D * DE * ES, (size_t)256 * DE * ES};
    EpiDown E{(bf16*)(ws + WS_YS), P6_FP8 ? 1.0f / (WD8_SCALE * H8_SCALE) : 1.0f};
    pg9::gemm_phase<ES>(F.lds, (const char*)(ws + WS_HACT), DE, S, E, ao, bb);
}
__device__ __forceinline__ void p7_final(Frame& F) {
    int tid_ = threadIdx.x; asm volatile("" : "+v"(tid_)); const int lane_ = tid_ & 63;
    unsigned char* ws = F.ws;
    LAS int* tb = (LAS int*)(F.lds + LDS_MISC + 1024); LAS int* cn = tb + 64;
    expert_tiles(F, tb, cn);
    const bf16* YS = (const bf16*)(ws + WS_YS); const int4* tpos = (const int4*)(ws + WS_TPOS);
    float* X1 = F.out; const bf16* X1B = (const bf16*)(ws + WS_X1B);
    const int lane = lane_;
    const int gw = F.vcu * NWAVES + F.wave, NGW = F.G * NWAVES;
    const GAS f32x4* gr = (const GAS f32x4*)F.in[I_GFIN] + lane;
    for (int row = gw; row < T; row += NGW) {
        const int4 tp = tpos[row];
        const size_t s0 = (size_t)tb[tp.x] * 256 + tp.y, s1 = (size_t)tb[tp.z] * 256 + tp.w;
        GAS f32x4* xr = (GAS f32x4*)(X1 + (size_t)row * D) + lane; const GAS v2u* xb = (const GAS v2u*)(X1B + (size_t)row * D) + lane;
        const GAS v2u* y0 = (const GAS v2u*)(YS + s0 * D) + lane; const GAS v2u* y1 = (const GAS v2u*)(YS + s1 * D) + lane;
        const GAS unsigned* z0 = (const GAS unsigned*)((const unsigned char*)YS + s0 * D) + lane; const GAS unsigned* z1 = (const GAS unsigned*)((const unsigned char*)YS + s1 * D) + lane;
        f32x4 v[4]; float s = 0.f;
#pragma unroll
        for (int j = 0; j < 4; ++j) { const v2u xx = xb[64 * j]; v[j] = (f32x4){bflo(xx.x), bfhi(xx.x), bflo(xx.y), bfhi(xx.y)};
            if (YS_FP8) { const int a = (int)z0[64 * j], b = (int)z1[64 * j]; typedef float f2_ __attribute__((ext_vector_type(2)));
                const f2_ a0 = __builtin_amdgcn_cvt_pk_f32_fp8(a, false), a1 = __builtin_amdgcn_cvt_pk_f32_fp8(a, true), b0 = __builtin_amdgcn_cvt_pk_f32_fp8(b, false), b1 = __builtin_amdgcn_cvt_pk_f32_fp8(b, true);
                constexpr float f = 1.0f / YS8_SCALE; v[j].x += (a0[0] + b0[0]) * f; v[j].y += (a0[1] + b0[1]) * f; v[j].z += (a1[0] + b1[0]) * f; v[j].w += (a1[1] + b1[1]) * f; }
            else { const v2u a = y0[64 * j], b = y1[64 * j];
            v[j].x += bflo(a.x) + bflo(b.x); v[j].y += bfhi(a.x) + bfhi(b.x); v[j].z += bflo(a.y) + bflo(b.y); v[j].w += bfhi(a.y) + bfhi(b.y); }
            s += (v[j].x * v[j].x + v[j].y * v[j].y) + (v[j].z * v[j].z + v[j].w * v[j].w); }
        const float rstd = 1.0f / sqrtf(wave_sum(s) * (1.f / D) + RMS_EPS);
#pragma unroll
        for (int j = 0; j < 4; ++j) { const f32x4 gg = gr[64 * j]; f32x4 o; o.x = v[j].x * rstd * gg.x; o.y = v[j].y * rstd * gg.y; o.z = v[j].z * rstd * gg.z; o.w = v[j].w * rstd * gg.w; xr[64 * j] = o; }
    }
}

constexpr int NPHASE = 2 * NCH + 8;
__global__ void __launch_bounds__(NTHR, 2) fwd_kernel(KArgs args) {
    extern __shared__ __attribute__((aligned(16))) unsigned char lds_raw[];
    Frame F;
    F.lds = (LAS unsigned char*)lds_raw;
    F.tid = threadIdx.x; F.lane = F.tid & 63; F.wave = __builtin_amdgcn_readfirstlane(F.tid >> 6);
    F.G = gridDim.x; { const int bx = blockIdx.x; F.vcu = (F.G % 8 == 0) ? (bx % 8) * (F.G / 8) + bx / 8 : bx; }
#pragma unroll
    for (int i = 0; i < 17; ++i) F.in[i] = args.in[i];
    F.out = args.out; F.ws = args.ws;
    volatile LAS unsigned* MISC = (volatile LAS unsigned*)(F.lds + LDS_MISC);
    if (F.tid < 64) MISC[F.tid] = 0u;
    __syncthreads();
    XcdBarrier bar = xcd_barrier_post((unsigned*)(F.ws + WS_CTL) + CW_BAR + args.li * XCD_BAR_WORDS, MISC + 8);
#define IN(k) (args.ph_lo <= (k) && (k) < args.ph_hi)
#ifdef PROBE_MASK
    unsigned long long pr_acc = 0, pr_t0 = 0; const bool pr_me = (blockIdx.x == 0 && threadIdx.x == 0);
#define PR_BEGIN(k) do { if (pr_me && ((PROBE_MASK >> (k)) & 1ull)) pr_t0 = __builtin_amdgcn_s_memrealtime(); } while (0)
#define PR_END(k) do { if (pr_me && ((PROBE_MASK >> (k)) & 1ull)) pr_acc += __builtin_amdgcn_s_memrealtime() - pr_t0; } while (0)
#else
#define PR_BEGIN(k) do {} while (0)
#define PR_END(k) do {} while (0)
#endif
#define SEAM(k) do { if (IN(k) && IN((k) + 1)) xcd_barrier(bar); PR_END(k); } while (0)
    PR_BEGIN(0); if (IN(0)) p0_prologue(F);
    SEAM(0);
#pragma unroll 1
    for (int ch = 0; ch < NCH; ++ch) {
        PR_BEGIN(1 + 2 * ch);
        if (IN(1 + 2 * ch)) {
            constexpr int NWG1 = (TC / 256) * (NIN / 256);
            const int nfull = NWG1 % F.G, bx = (int)blockIdx.x;
            if (ch > 0 && nfull == 0) p2_combine(F, ch - 1, F.vcu, F.G);
            p1_inproj(F, ch);
            if (ch > 0 && nfull != 0 && bx >= nfull) p2_combine(F, ch - 1, bx - nfull, F.G - nfull);
        }
        SEAM(1 + 2 * ch);
        PR_BEGIN(2 + 2 * ch); if (IN(2 + 2 * ch)) p2_attn(F, ch);
        SEAM(2 + 2 * ch);
    }
    PR_BEGIN(2 * NCH + 1); if (IN(2 * NCH + 1)) p2_combine(F, NCH - 1, F.vcu, F.G);
    SEAM(2 * NCH + 1);
    PR_BEGIN(2 * NCH + 2); if (IN(2 * NCH + 2)) p3_merge(F);
    SEAM(2 * NCH + 2);
    PR_BEGIN(2 * NCH + 3); if (IN(2 * NCH + 3)) p4_outproj(F);
    SEAM(2 * NCH + 3);
    PR_BEGIN(2 * NCH + 4); if (IN(2 * NCH + 4)) p5_route(F);
    SEAM(2 * NCH + 4);
    PR_BEGIN(2 * NCH + 5); if (IN(2 * NCH + 5)) p6a_gateup(F);
    SEAM(2 * NCH + 5);
    PR_BEGIN(2 * NCH + 6); if (IN(2 * NCH + 6)) p6b_down(F);
    SEAM(2 * NCH + 6);
    PR_BEGIN(2 * NCH + 7); if (IN(2 * NCH + 7)) p7_final(F);
    PR_END(2 * NCH + 7);
#ifdef PROBE_MASK
    if (pr_me) { const unsigned long long t1 = __builtin_amdgcn_s_memrealtime(); while (__builtin_amdgcn_s_memrealtime() - t1 < pr_acc) __builtin_amdgcn_s_sleep(4); }
#endif
#undef IN
#undef SEAM
}

#ifndef N_LAUNCHES
#define N_LAUNCHES 1
#endif
extern "C" void kernel_launch(void* const* d_in, const int* in_sizes, int n_in, void* d_out, int out_size, void* d_ws, size_t ws_size, hipStream_t stream) {
    static int grid = 0;
    if (grid == 0) {
        if (n_in != 17 || in_sizes[0] != T * D || out_size != T * D || ws_size < WS_END) { fprintf(stderr, "kernel_launch: unexpected shapes / workspace (%d inputs, ws %zu)\n", n_in, ws_size); grid = -1; return; }
        int dev = 0, cus = 0;
        if (hipGetDevice(&dev) != hipSuccess || hipDeviceGetAttribute(&cus, hipDeviceAttributeMultiprocessorCount, dev) != hipSuccess) { grid = -1; return; }
        if (hipFuncSetAttribute((const void*)fwd_kernel, hipFuncAttributeMaxDynamicSharedMemorySize, LDS_BYTES) != hipSuccess) { fprintf(stderr, "kernel_launch: hipFuncSetAttribute failed\n"); grid = -1; return; }
        int per_cu = 0;
        if (hipOccupancyMaxActiveBlocksPerMultiprocessor(&per_cu, (const void*)fwd_kernel, NTHR, LDS_BYTES) != hipSuccess || per_cu < 1) fprintf(stderr, "kernel_launch: occupancy query says %d\n", per_cu);
        (void)hipGetLastError();
        grid = cus;
    }
    if (grid < 0) return;
    (void)hipMemsetAsync((char*)d_ws + WS_CTL, 0, N_LAUNCHES == 1 ? (size_t)(CW_BAR + XCD_BAR_WORDS) * 4 : CTL_BYTES, stream);
    KArgs a{};
    for (int i = 0; i < 17; ++i) a.in[i] = (const float*)d_in[i];
    a.out = (float*)d_out; a.ws = (unsigned char*)d_ws;
    for (int li = 0; li < N_LAUNCHES; ++li) {
        a.ph_lo = (int)((long)NPHASE * li / N_LAUNCHES); a.ph_hi = (int)((long)NPHASE * (li + 1) / N_LAUNCHES); a.li = li;
        hipLaunchKernelGGL(fwd_kernel, dim3(grid), dim3(NTHR), LDS_BYTES, stream, a);
    }
}
```

```cpp
#include <hip/hip_runtime.h>
#include <cstdint>
#include <cstdio>

#define GAS __attribute__((address_space(1)))
#define LAS __attribute__((address_space(3)))
typedef unsigned short bf16;
typedef short bf16x8 __attribute__((ext_vector_type(8)));
typedef float f32x4 __attribute__((ext_vector_type(4)));
typedef unsigned v4u __attribute__((ext_vector_type(4)));
typedef unsigned v2u __attribute__((ext_vector_type(2)));
typedef GAS unsigned gu32;

constexpr int T = 32768, D = 1024, SEQ = 4096, NIN = 7936;
constexpr int A_W = 4608, B_W = 1280, G_W = 2048, Y_W = 1536;
constexpr int NE = 32, DE = 256;
constexpr int NCH = 4, TC = T / NCH;
constexpr float QSCALE = 0.125f * 1.4426950408889634f;
constexpr float LOG2E = 1.4426950408889634f;
constexpr float RMS_EPS = 1e-6f;
#ifndef P1_FP8
#define P1_FP8 1
#endif
constexpr float W8_SCALE = P1_FP8 ? 64.0f : 0.0f, W8_INV = P1_FP8 ? 1.0f / 64.0f : 1.0f;
#ifndef P6_FP8
#define P6_FP8 1
#endif
#ifndef P34_FP8
#define P34_FP8 1
#endif
constexpr float Y8_SCALE = 16.0f, W34_SCALE = 64.0f, MG8_SCALE = 32.0f;
#ifndef YS_FP8
#define YS_FP8 1
#endif
constexpr float YS8_SCALE = 16.0f;
constexpr float WG8_SCALE = P6_FP8 ? 64.0f : 0.0f, WD8_SCALE = P6_FP8 ? 32.0f : 0.0f, H8_SCALE = 32.0f;
constexpr int NWAVES = 8, NTHR = 512;

constexpr size_t MiB = 1u << 20;
constexpr size_t WS_CTL = 0, CTL_BYTES = 1 * MiB;
constexpr size_t WS_BIASP = ((size_t)1 << 20) + 4096;
constexpr size_t WS_INVF = 1 * MiB;
constexpr size_t WS_WRF = 2 * MiB;
constexpr size_t WS_TOKOF = 3 * MiB;
constexpr size_t WS_WTOF = 7 * MiB;
constexpr size_t WS_TPOS = 15 * MiB;
constexpr size_t WS_WIN = 16 * MiB;
constexpr size_t WS_WAB = 32 * MiB;
constexpr size_t WS_WO = 35 * MiB;
constexpr size_t WS_WGU = 37 * MiB;
constexpr size_t WS_WD = 69 * MiB;
constexpr size_t WS_G = 86 * MiB;
constexpr size_t WS_Y = 214 * MiB;
constexpr size_t WS_ZA = 310 * MiB;
constexpr size_t WS_ZB = 454 * MiB;
constexpr size_t WS_END = 494 * MiB;
constexpr size_t WS_MG = WS_ZA;
constexpr size_t WS_X1B = WS_ZA + 64 * MiB;
constexpr size_t WS_X1F8 = WS_Y + 64 * MiB;
constexpr size_t WS_HACT = WS_G;
constexpr size_t WS_YS = WS_G + 36 * MiB;
constexpr size_t DO_DELTA = 0;
constexpr size_t DO_HN = 0;
constexpr size_t DO_OG = 64 * MiB;
constexpr size_t DO_LSE = 112 * MiB;
constexpr int MAXSLOT = 2 * T + NE * 256;
static_assert(WS_ZA + (size_t)TC * A_W * 2 <= WS_ZB && WS_ZB + (size_t)TC * B_W * 2 <= WS_END && WS_Y + (size_t)T * Y_W * 2 <= WS_ZA && WS_G + (size_t)T * G_W * 2 <= WS_Y, "ws map");
static_assert(WS_MG + (size_t)T * D * 2 <= WS_END && WS_HACT + (size_t)MAXSLOT * DE * 2 <= WS_YS && WS_YS + (size_t)MAXSLOT * D * 2 <= WS_ZA && WS_X1B >= WS_MG + (size_t)T * D * 2 && WS_X1B + (size_t)T * D * 2 <= WS_ZB, "ws map");
static_assert(DO_OG + (size_t)3 * TC * 512 * 2 <= DO_LSE && DO_LSE + (size_t)3 * TC * 8 * 4 <= (size_t)T * D * 4 && DO_HN + (size_t)T * D * 2 <= DO_OG, "d_out scratch map");
constexpr int CW_CNT = 1024;
constexpr int CW_BAR = 4096;
constexpr int LDS_BYTES = 147456;
constexpr int LDS_MISC = 131072;

__device__ __forceinline__ unsigned f2bf(float f) { unsigned u = __builtin_bit_cast(unsigned, f); return (u + 0x7fffu + ((u >> 16) & 1u)) >> 16; }
__device__ __forceinline__ unsigned pk4_fp8(float a, float b, float c, float d) {
    a = __builtin_amdgcn_fmed3f(a, -448.f, 448.f); b = __builtin_amdgcn_fmed3f(b, -448.f, 448.f); c = __builtin_amdgcn_fmed3f(c, -448.f, 448.f); d = __builtin_amdgcn_fmed3f(d, -448.f, 448.f);
    int w = 0; w = __builtin_amdgcn_cvt_pk_fp8_f32(a, b, w, false); w = __builtin_amdgcn_cvt_pk_fp8_f32(c, d, w, true); return (unsigned)w; }
__device__ __forceinline__ unsigned pk2(float lo, float hi) { return f2bf(lo) | (f2bf(hi) << 16); }
__device__ __forceinline__ float bf2f(unsigned b) { return __builtin_bit_cast(float, b << 16); }
__device__ __forceinline__ float bflo(unsigned u) { return __builtin_bit_cast(float, u << 16); }
__device__ __forceinline__ float bfhi(unsigned u) { return __builtin_bit_cast(float, u & 0xffff0000u); }
__device__ __forceinline__ float wave_sum(float v) {
#pragma unroll
    for (int o = 1; o < 64; o <<= 1) v += __shfl_xor(v, o);
    return v;
}
__device__ __forceinline__ float wave_max(float v) {
#pragma unroll
    for (int o = 1; o < 64; o <<= 1) v = fmaxf(v, __shfl_xor(v, o));
    return v;
}
typedef float f32x2_t __attribute__((ext_vector_type(2)));
typedef __bf16 bf16x2_t __attribute__((ext_vector_type(2)));
__device__ __forceinline__ unsigned cvtpk(float lo, float hi) { f32x2_t v = {lo, hi}; bf16x2_t b = __builtin_convertvector(v, bf16x2_t); return __builtin_bit_cast(unsigned, b); }
#ifndef WT_STORES
#define WT_STORES 0
#endif
__device__ __forceinline__ __amdgpu_buffer_rsrc_t wt_rsrc(unsigned char* base) { return __builtin_amdgcn_make_buffer_rsrc(base, 0, 0x7ffffffc, 0x00020000); }
__device__ __forceinline__ void st16(__amdgpu_buffer_rsrc_t r, unsigned char* base, void* p, v4u v) { if (WT_STORES) __builtin_amdgcn_raw_buffer_store_b128(v, r, (unsigned)((unsigned char*)p - base), 0, 16); else *(GAS v4u*)p = v; }
__device__ __forceinline__ void st8(__amdgpu_buffer_rsrc_t r, unsigned char* base, void* p, v2u v) { if (WT_STORES) __builtin_amdgcn_raw_buffer_store_b64(v, r, (unsigned)((unsigned char*)p - base), 0, 16); else *(GAS v2u*)p = v; }
#define LDS_WAIT() asm volatile("s_waitcnt lgkmcnt(0)" ::: "memory")
#define VM_WAIT() asm volatile("s_waitcnt vmcnt(0)" ::: "memory")

#define XB_TMO      128
#define XB_XCNT(j)  (256  + 64 * (j))
#define XB_XSUB(j)  (1280 + 64 * (j))
#define XB_XGEN(j)  (2304 + 64 * (j))
#define XB_TOP      3328
#define XB_TOPGEN   3392
#define XCD_BAR_WORDS 3456
#define XB_SPIN_CAP (1u << 18)
__device__ __forceinline__ unsigned xb_ld(unsigned* p)              { return __hip_atomic_load(p, __ATOMIC_RELAXED, __HIP_MEMORY_SCOPE_AGENT); }
__device__ __forceinline__ unsigned xb_add(unsigned* p, unsigned v) { return __hip_atomic_fetch_add(p, v, __ATOMIC_RELAXED, __HIP_MEMORY_SCOPE_AGENT); }
__device__ __forceinline__ unsigned xb_xcc_id() { return (unsigned)__builtin_amdgcn_s_getreg((3 << 11) | 20) & 0xFu; }
#define XB_SPIN(cond, bar) do { unsigned _sp = 0; while (cond) { __builtin_amdgcn_s_sleep(1); \
    if ((++_sp & 255u) == 0u) { if (xb_ld(&(bar)[XB_TMO])) break; if (_sp > XB_SPIN_CAP) { atomicAdd(&(bar)[XB_TMO], 1u); break; } } } } while (0)
struct XcdBarrier { unsigned* bar; unsigned x; volatile LAS unsigned* st; };
__device__ __forceinline__ XcdBarrier xcd_barrier_post(unsigned* bar, volatile LAS unsigned* st) {
    XcdBarrier b; b.bar = bar; b.x = xb_xcc_id(); b.st = st;
    if (threadIdx.x == 0) (void)xb_add(&bar[XB_XCNT(b.x)], 1u);
    return b;
}
__device__ __forceinline__ void xcd_barrier_complete(unsigned* bar, unsigned x, unsigned& nloc, unsigned& nx) {
    const unsigned G = gridDim.x * gridDim.y * gridDim.z;
    unsigned sum, cnt, mine, sp = 0u;
    for (;;) {
        sum = 0u; cnt = 0u; mine = 0u;
#pragma unroll
        for (unsigned j = 0; j < 16; ++j) { const unsigned c = xb_ld(&bar[XB_XCNT(j)]); sum += c; cnt += (c > 0u) ? 1u : 0u; mine = (j == x) ? c : mine; }
        if (sum == G) break;
        __builtin_amdgcn_s_sleep(1);
        if ((++sp & 255u) == 0u) { if (xb_ld(&bar[XB_TMO])) break; if (sp > XB_SPIN_CAP) { atomicAdd(&bar[XB_TMO], 1u); break; } }
    }
    nloc = mine > 0u ? mine : 1u; nx = cnt > 0u ? cnt : 1u;
}
__device__ __forceinline__ void xcd_barrier(const XcdBarrier& b) {
    asm volatile("s_waitcnt vmcnt(0)" ::: "memory");
    __syncthreads();
    int t_ = threadIdx.x; asm volatile("" : "+v"(t_));
    if (t_ == 0) {
        unsigned* bar = b.bar;
        __builtin_amdgcn_s_waitcnt(0);
        unsigned nloc = b.st[0], nx = b.st[1];
        if (nloc == 0u) { xcd_barrier_complete(bar, b.x, nloc, nx); b.st[0] = nloc; b.st[1] = nx; }
        const unsigned old = xb_add(&bar[XB_XSUB(b.x)], 1u);
        const unsigned gen = old / nloc;
        if (old + 1u == (gen + 1u) * nloc) {
            __builtin_amdgcn_fence(__ATOMIC_RELEASE, "agent");
            asm volatile("s_waitcnt vmcnt(0)" ::: "memory");
            const unsigned og = xb_add(&bar[XB_TOP], 1u);
            const unsigned tg = og / nx;
            if (og + 1u == (tg + 1u) * nx) xb_add(&bar[XB_TOPGEN], 1u);
            else XB_SPIN(xb_ld(&bar[XB_TOPGEN]) == tg, bar);
            __builtin_amdgcn_fence(__ATOMIC_ACQUIRE, "agent");
            xb_add(&bar[XB_XGEN(b.x)], 1u);
            asm volatile("s_waitcnt vmcnt(0)" ::: "memory");
        } else {
            XB_SPIN(xb_ld(&bar[XB_XGEN(b.x)]) == gen, bar);
            __builtin_amdgcn_fence(__ATOMIC_ACQUIRE, "agent");
            asm volatile("s_waitcnt vmcnt(0)" ::: "memory");
        }
    }
    __syncthreads();
}

struct KArgs { const float* in[17]; float* out; unsigned char* ws; int ph_lo, ph_hi, li, pad; };
struct Frame {
    LAS unsigned char* lds;
    int tid, lane, wave, vcu, G;
    const float* in[17]; float* out; unsigned char* ws;
};
enum { I_X = 0, I_WIN, I_BIN, I_SINK, I_WPA, I_WPB, I_WOUT, I_GMIX, I_GFFN, I_WRG, I_BRG, I_WRE, I_BRE, I_WEG, I_WEU, I_WED, I_GFIN };

struct TrDesc { const float* W; int N; bf16* WT; int ldo, rowbase, koff, k0, n0; bool perm; const float* kscale; float f8scale; };
__device__ __forceinline__ void tr_load(const TrDesc& d, int lane, f32x4 (&tv)[8], float (&ks)[8]) {
    const float* src = d.W + (size_t)(d.k0 + (lane >> 3)) * d.N + d.n0 + 4 * (lane & 7);
#pragma unroll
    for (int i = 0; i < 8; ++i) tv[i] = *(const GAS f32x4*)(src + (size_t)(8 * i) * d.N);
#pragma unroll
    for (int i = 0; i < 8; ++i) ks[i] = d.kscale ? d.kscale[d.k0 + 8 * i + (lane >> 3)] : 1.0f;
}
__device__ __forceinline__ void tr_finish(const TrDesc& d, LAS float* scr, int lane, const f32x4 (&tv)[8], const float (&ks)[8]) {
#pragma unroll
    for (int i = 0; i < 8; ++i) { const int kk = 8 * i + (lane >> 3); LAS float* w = scr + kk * 33 + 4 * (lane & 7);
        w[0] = tv[i][0] * ks[i]; w[1] = tv[i][1] * ks[i]; w[2] = tv[i][2] * ks[i]; w[3] = tv[i][3] * ks[i]; }
    LDS_WAIT(); asm volatile("" ::: "memory");
    const int c = lane & 7;
#pragma unroll
    for (int j = 0; j < 4; ++j) { const int n = (lane >> 3) + 8 * j; const LAS float* s = scr + (8 * c) * 33 + n;
        const int rr = d.perm ? 8 * (n >> 2) + (n & 3) : n;
        if (d.f8scale != 0.f) { const float f = d.f8scale; v2u o8; o8.x = pk4_fp8(s[0 * 33] * f, s[1 * 33] * f, s[2 * 33] * f, s[3 * 33] * f); o8.y = pk4_fp8(s[4 * 33] * f, s[5 * 33] * f, s[6 * 33] * f, s[7 * 33] * f);
            *(GAS v2u*)((unsigned char*)d.WT + (size_t)(d.rowbase + rr) * d.ldo + d.koff + d.k0 + 8 * c) = o8; }
        else { v4u o; o.x = pk2(s[0 * 33], s[1 * 33]); o.y = pk2(s[2 * 33], s[3 * 33]); o.z = pk2(s[4 * 33], s[5 * 33]); o.w = pk2(s[6 * 33], s[7 * 33]);
            *(GAS v4u*)(d.WT + (size_t)(d.rowbase + rr) * d.ldo + d.koff + d.k0 + 8 * c) = o; } }
    LDS_WAIT(); asm volatile("" ::: "memory");
}
__device__ __forceinline__ void rms_row_to_bf16(const float* xrow, const float* g, bf16* orow, int lane) {
    const GAS f32x4* xr = (const GAS f32x4*)xrow + lane; const GAS f32x4* gr = (const GAS f32x4*)g + lane;
    f32x4 v[4]; float s = 0.f;
#pragma unroll
    for (int j = 0; j < 4; ++j) { v[j] = xr[64 * j]; s += (v[j].x * v[j].x + v[j].y * v[j].y) + (v[j].z * v[j].z + v[j].w * v[j].w); }
    const float rstd = 1.0f / sqrtf(wave_sum(s) * (1.f / D) + RMS_EPS);
    GAS v2u* o8 = (GAS v2u*)orow + lane;
#pragma unroll
    for (int j = 0; j < 4; ++j) { const f32x4 gg = gr[64 * j]; v2u w; w.x = pk2(v[j].x * rstd * gg.x, v[j].y * rstd * gg.y); w.y = pk2(v[j].z * rstd * gg.z, v[j].w * rstd * gg.w); o8[64 * j] = w; }
}
__device__ __forceinline__ void p0_prologue(Frame& F) {
    int tid_ = threadIdx.x; asm volatile("" : "+v"(tid_)); const int lane_ = tid_ & 63;
    LAS float* scr = (LAS float*)(F.lds + F.wave * 16384);
    const int gw = F.vcu * NWAVES + F.wave, NGW = F.G * NWAVES;
    unsigned char* ws = F.ws;
    constexpr int I_IN = 16 * 248, I_PA = 8 * 32, I_PB = 16 * 32, I_WO = 16 * 32, I_EG = 32 * 16 * 8, I_ED = 32 * 4 * 32;
    constexpr int NITEMS = I_IN + I_PA + I_PB + I_WO + 2 * I_EG + I_ED;
    auto decode = [&](int it, TrDesc& d) {
        int r = it; d.perm = false; d.kscale = nullptr; d.f8scale = 0.f; d.koff = 0;
        if (r < I_IN) { const int kb = r / 248, nb = r % 248, n0 = 32 * nb; const bool qk = (n0 < 3072) || (n0 >= A_W && n0 < A_W + 1152);
            const bool gt_ = n0 >= A_W + B_W; const int gc = n0 - (A_W + B_W);
            d.W = F.in[I_WIN]; d.N = NIN; d.WT = (bf16*)(ws + WS_WIN); d.ldo = 1024; d.rowbase = qk ? (n0 & ~63) + ((n0 >> 5) & 1) * 4 : (gt_ ? A_W + B_W + 2 * (gc % 1024) + 4 * (gc / 1024) : n0); d.k0 = 64 * kb; d.n0 = n0; d.perm = qk || gt_; d.f8scale = W8_SCALE; return; } r -= I_IN;
        if (r < I_PA) { const int kb = r / 32, nb = r % 32; d.W = F.in[I_WPA]; d.N = 1024; d.WT = (bf16*)(ws + WS_WAB); d.ldo = 1536; d.rowbase = 32 * nb; d.k0 = 64 * kb; d.n0 = 32 * nb; if (P34_FP8) d.f8scale = W34_SCALE; return; } r -= I_PA;
        if (r < I_PB) { const int kb = r / 32, nb = r % 32; d.W = F.in[I_WPB]; d.N = 1024; d.WT = (bf16*)(ws + WS_WAB); d.ldo = 1536; d.rowbase = 32 * nb; d.koff = 512; d.k0 = 64 * kb; d.n0 = 32 * nb; if (P34_FP8) d.f8scale = W34_SCALE; return; } r -= I_PB;
        if (r < I_WO) { const int kb = r / 32, nb = r % 32; d.W = F.in[I_WOUT]; d.N = 1024; d.WT = (bf16*)(ws + WS_WO); d.ldo = 1024; d.rowbase = 32 * nb; d.k0 = 64 * kb; d.n0 = 32 * nb; if (P34_FP8) d.f8scale = W34_SCALE; return; } r -= I_WO;
        if (r < 2 * I_EG) { const int up = r >= I_EG; if (up) r -= I_EG; const int e = r / 128, q = r % 128, kb = q / 8, nb = q % 8;
            d.W = F.in[up ? I_WEU : I_WEG] + (size_t)e * 1024 * 256; d.N = 256; d.WT = (bf16*)(ws + WS_WGU) + (size_t)e * 512 * 1024; d.ldo = 1024; d.rowbase = 64 * nb + (up ? 4 : 0); d.k0 = 64 * kb; d.n0 = 32 * nb; d.perm = true; d.kscale = F.in[I_GFFN]; d.f8scale = WG8_SCALE; if (P6_FP8) d.WT = (bf16*)((unsigned char*)(ws + WS_WGU) + (size_t)e * 512 * 1024); return; } r -= 2 * I_EG;
        { const int e = r / 128, q = r % 128, kb = q / 32, nb = q % 32;
            d.W = F.in[I_WED] + (size_t)e * 256 * 1024; d.N = 1024; d.WT = (bf16*)(ws + WS_WD) + (size_t)e * 1024 * 256; d.ldo = 256; d.rowbase = 32 * nb; d.k0 = 64 * kb; d.n0 = 32 * nb; d.f8scale = WD8_SCALE; if (P6_FP8) d.WT = (bf16*)((unsigned char*)(ws + WS_WD) + (size_t)e * 1024 * 256); }
    };
    {
        int it = gw; TrDesc dc, dn; f32x4 tc[8], tn[8]; float kc[8], kn[8];
        bool hc = it < NITEMS; if (hc) { decode(it, dc); tr_load(dc, lane_, tc, kc); }
        while (hc) {
            it += NGW; const bool hn = it < NITEMS;
            if (hn) { decode(it, dn); tr_load(dn, lane_, tn, kn); }
            tr_finish(dc, scr, lane_, tc, kc);
            hc = hn; dc = dn;
#pragma unroll
            for (int i = 0; i < 8; ++i) { tc[i] = tn[i]; kc[i] = kn[i]; }
        }
    }
    for (int m = gw; m < T; m += 4 * NGW) {
        const GAS f32x4* gr = (const GAS f32x4*)F.in[I_GMIX] + lane_;
        f32x4 v[4][4]; float ss[4];
#pragma unroll
        for (int r = 0; r < 4; ++r) { const int mr = (m + r * NGW < T) ? m + r * NGW : m; const GAS f32x4* xr = (const GAS f32x4*)(F.in[I_X] + (size_t)mr * D) + lane_;
#pragma unroll
            for (int j = 0; j < 4; ++j) v[r][j] = xr[64 * j]; }
#pragma unroll
        for (int r = 0; r < 4; ++r) { float a = 0.f;
#pragma unroll
            for (int j = 0; j < 4; ++j) a += (v[r][j].x * v[r][j].x + v[r][j].y * v[r][j].y) + (v[r][j].z * v[r][j].z + v[r][j].w * v[r][j].w);
            ss[r] = 1.0f / sqrtf(wave_sum(a) * (1.f / D) + RMS_EPS); }
#pragma unroll
        for (int r = 0; r < 4; ++r) { if (m + r * NGW >= T) continue; GAS unsigned* o4 = (GAS unsigned*)((unsigned char*)F.out + DO_HN + (size_t)(m + r * NGW) * D) + lane_;
#pragma unroll
            for (int j = 0; j < 4; ++j) { const f32x4 gg = gr[64 * j];
                if (P1_FP8) o4[64 * j] = pk4_fp8(v[r][j].x * ss[r] * gg.x, v[r][j].y * ss[r] * gg.y, v[r][j].z * ss[r] * gg.z, v[r][j].w * ss[r] * gg.w);
                else { v2u w; w.x = cvtpk(v[r][j].x * ss[r] * gg.x, v[r][j].y * ss[r] * gg.y); w.y = cvtpk(v[r][j].z * ss[r] * gg.z, v[r][j].w * ss[r] * gg.w); ((GAS v2u*)((unsigned char*)F.out + DO_HN + (size_t)(m + r * NGW) * D * 2) + lane_)[64 * j] = w; } } }
    }
    const int gt = F.vcu * NTHR + tid_, NGT = F.G * NTHR;
    if (gt < 32) ((float*)(ws + WS_INVF))[gt] = (float)exp2(-(double)gt * (13.287712379549449 / 32.0));
    for (int c = gt; c < NIN; c += NGT) {
        int s = c; const int e = c & 7;
        if (c < 3072 || (c >= A_W && c < A_W + 1152)) s = (c & ~63) + 4 * ((c & 63) >> 3) + (e < 4 ? e : 28 + e);
        else if (c >= A_W + B_W) s = A_W + B_W + 4 * ((c - A_W - B_W) >> 3) + (e < 4 ? e : 1020 + e);
        ((float*)(ws + WS_BIASP))[c] = F.in[I_BIN][s];
    }
    for (int i = gt; i < 32 * 3 * 64; i += NGT) {
        const int ln = i & 63, nb = (i >> 6) % 3, ks = i / 192;
        const int n = 16 * nb + (ln & 15);
        float hi[8], lo[8];
#pragma unroll
        for (int e = 0; e < 8; ++e) { const int k = 32 * ks + 8 * (ln >> 4) + e; float v = 0.f;
            if (n < 4) v = F.in[I_WRG][k * 4 + n]; else if (n < 36) v = F.in[I_WRE][k * 32 + (n - 4)];
            v *= F.in[I_GFFN][k]; hi[e] = bf2f(f2bf(v)); lo[e] = v - hi[e]; }
        v4u h, l; h.x = pk2(hi[0], hi[1]); h.y = pk2(hi[2], hi[3]); h.z = pk2(hi[4], hi[5]); h.w = pk2(hi[6], hi[7]);
        l.x = pk2(lo[0], lo[1]); l.y = pk2(lo[2], lo[3]); l.z = pk2(lo[4], lo[5]); l.w = pk2(lo[6], lo[7]);
        ((v4u*)(ws + WS_WRF))[((ks * 3 + nb) * 2 + 0) * 64 + ln] = h; ((v4u*)(ws + WS_WRF))[((ks * 3 + nb) * 2 + 1) * 64 + ln] = l;
    }
}

namespace pg8 {
#define PG8_LAS __attribute__((address_space(3)))
typedef unsigned short bf16_t;
typedef short bf16x8 __attribute__((ext_vector_type(8)));
typedef float f32x4 __attribute__((ext_vector_type(4)));
typedef unsigned u32x4 __attribute__((ext_vector_type(4)));
constexpr int BM = 256, BK = 64, HALF = 128, HTB = HALF * BK * 2  , STAGE_BYTES = 8 * HTB, NXCD = 8, WGM = 8;

__host__ __device__ __forceinline__ int lds_byte(int r, int c) { const int st = (r >> 4) * 2 + (c >> 5), rr = r & 15, cc = c & 31, ob = rr * 64 + cc * 2; return st * 1024 + (ob ^ (((ob >> 9) & 1) << 5)); }
__host__ __device__ __forceinline__ void stage_rc(int b, int& R, int& C) { const int st = b / 1024, sb = b % 1024, swz = sb ^ (((sb >> 9) & 1) << 5); R = (st >> 1) * 16 + swz / 64; C = (st & 1) * 32 + (swz % 64) / 2; }
__host__ __device__ __forceinline__ int perm32(int rho) { const int n = rho >> 4, i = rho & 15; return 8 * (i >> 2) + 4 * n + (i & 3); }

struct Unit { int pm, pn; };
struct Gemm { const bf16_t* A; const bf16_t* Bt; int M, N, K; };

struct StaticOrder {
    int nM, nN, nwg, G, c;
    __host__ __device__ void init(int M, int N, int G_, int c_) { nM = M / BM; nN = N / BM; nwg = nM * nN; G = G_; c = c_; }
    __host__ __device__ bool next(int i, Unit& u) const {
        const long L = (long)i * G + c; if (L >= nwg) return false;
        int wgid = (int)L; { const int q = nwg / NXCD, r = nwg % NXCD, xcd = wgid % NXCD, off = wgid / NXCD; wgid = (xcd < r ? xcd * (q + 1) : r * (q + 1) + (xcd - r) * q) + off; }
        const int nig = WGM * nN, gid = wgid / nig, fm = gid * WGM, gsz = (nM - fm) < WGM ? (nM - fm) : WGM;
        u.pm = fm + ((wgid % nig) % gsz); u.pn = (wgid % nig) / gsz; return true;
    }
    __device__ __forceinline__ void a_ready(const Unit&) const {}
    __device__ __forceinline__ void done(const Unit&) const {}
};
}


namespace pg9 {
using pg8::BM; using pg8::BK; using pg8::HALF; using pg8::HTB; using pg8::lds_byte; using pg8::stage_rc; using pg8::perm32;
struct Unit { int pm, pn, e; };
typedef int v8i_t __attribute__((ext_vector_type(8)));
typedef int v4i_t __attribute__((ext_vector_type(4)));
template <int ESZ, class Epi, class Sched, class AOff, class BBase>
__device__ __forceinline__ void gemm_phase(LAS unsigned char* lds, const char* Abase, int K, const Sched& S, const Epi& E, const AOff& aoffn, const BBase& bbase) {
    int tid_ = threadIdx.x; asm volatile("" : "+v"(tid_));
    const int tid = tid_, wid = __builtin_amdgcn_readfirstlane(tid >> 6), lane = tid & 63, wr = wid >> 2, wc = wid & 3, fr = lane & 15, fq = lane >> 4;
    const int nt = K * ESZ / (BK * 2);
    int Rr[2], Cc[2]; unsigned voffB[2];
#pragma unroll
    for (int i = 0; i < 2; ++i) { int R, C; stage_rc(tid * 16 + i * 8192, R, C); const int Rb = Epi::PERM ? ((R & ~31) + perm32(R & 31)) : R; Rr[i] = R; Cc[i] = C; voffB[i] = (unsigned)(Rb * K * ESZ + C * 2); }
    const size_t kstep = (size_t)(BK * 2);
    const size_t hstep = (size_t)HALF * K * ESZ;
    const unsigned ldsw = (unsigned)wid * 1024u;
    const int aoff = lds_byte(wr * 64 + fr, fq * 8), boff = lds_byte(wc * 32 + fr, fq * 8);
#define PG9_SA(b, h) (((b) * 2 + (h)) * HTB)
#define PG9_SB(b, h) ((4 + (b) * 2 + (h)) * HTB)
#define PG9_STAGE(bufoff, gbase, voff) do { _Pragma("unroll") for (int _i = 0; _i < 2; ++_i) \
        __builtin_amdgcn_global_load_lds((const unsigned*)((const char*)(gbase) + (voff)[_i]), (LAS unsigned*)(lds + (bufoff) + ldsw + _i * 8192), 16, 0, 0); } while (0)
#define PG9_LDA(dst, b, h) do { _Pragma("unroll") for (int m = 0; m < 4; ++m) { dst[m].lo = *(const LAS v4i_t*)(lds + PG9_SA(b, h) + aoff + m * 2048); dst[m].hi = *(const LAS v4i_t*)(lds + PG9_SA(b, h) + aoff + m * 2048 + 1024); } } while (0)
#define PG9_LDB(dst, b, h) do { _Pragma("unroll") for (int n = 0; n < 2; ++n) { dst[n].lo = *(const LAS v4i_t*)(lds + PG9_SB(b, h) + boff + n * 2048); dst[n].hi = *(const LAS v4i_t*)(lds + PG9_SB(b, h) + boff + n * 2048 + 1024); } } while (0)
#define PG9_HALF(v, o) __builtin_bit_cast(bf16x8, __builtin_shufflevector((v), (v), (o), (o) + 1, (o) + 2, (o) + 3))
#define PG9_MMA(ai, bj, At, Bt) do { __builtin_amdgcn_s_setprio(1); _Pragma("unroll") for (int m = 0; m < 4; ++m) _Pragma("unroll") for (int n = 0; n < 2; ++n) { \
        if (ESZ == 2) { acc[ai][bj][m][n] = __builtin_amdgcn_mfma_f32_16x16x32_bf16(PG9_HALF(Bt[n], 0), PG9_HALF(At[m], 0), acc[ai][bj][m][n], 0, 0, 0); \
                        acc[ai][bj][m][n] = __builtin_amdgcn_mfma_f32_16x16x32_bf16(PG9_HALF(Bt[n], 4), PG9_HALF(At[m], 4), acc[ai][bj][m][n], 0, 0, 0); } \
        else { asm volatile("v_mfma_scale_f32_16x16x128_f8f6f4 %0, %1, %2, %0, %3, %3 op_sel_hi:[0,0,0]" : "+v"(acc[ai][bj][m][n]) : "v"(Bt[n]), "v"(At[m]), "v"(one8)); } } \
        __builtin_amdgcn_s_setprio(0); } while (0)
#define PG9_WAIT_V(n) asm volatile("s_waitcnt vmcnt(" #n ")" ::: "memory")
#define PG9_WAIT_L(n) asm volatile("s_waitcnt lgkmcnt(" #n ")" ::: "memory")
#define PG9_BAR __builtin_amdgcn_s_barrier()
#define PG9_SCHED __builtin_amdgcn_sched_barrier(0)
#define PG9_VA(dst, u) do { _Pragma("unroll") for (int _h = 0; _h < 2; ++_h) _Pragma("unroll") for (int _i = 0; _i < 2; ++_i) dst[_h][_i] = aoffn((u), _h * HALF + Rr[_i]) + (unsigned)(Cc[_i] * 2); } while (0)
    constexpr bool GATHER = AOff::GATHER;
    const size_t hstepA = (size_t)HALF * aoffn.rowbytes;
    unsigned voffA[2];
#pragma unroll
    for (int i = 0; i < 2; ++i) voffA[i] = (unsigned)Rr[i] * aoffn.rowbytes + (unsigned)(Cc[i] * 2);
#define PG9_STAGE_A(bufoff, h, koff, nx) do { if (GATHER) { PG9_STAGE(bufoff, Abase + (koff), ((nx) ? nvA[h] : cvA[h])); } else { PG9_STAGE(bufoff, ((nx) ? nAu : cAu) + (h) * hstepA + (koff), voffA); } } while (0)
    Unit cur, nxt; int ui = 0;
    if (!S.next(0, cur)) return;
    f32x4 acc[2][2][4][2];
#pragma unroll
    for (int a = 0; a < 2; ++a)
#pragma unroll
        for (int b = 0; b < 2; ++b)
#pragma unroll
            for (int m = 0; m < 4; ++m)
#pragma unroll
                for (int n = 0; n < 2; ++n) acc[a][b][m][n] = (f32x4){0.f, 0.f, 0.f, 0.f};
    int one8 = 0x7f7f7f7f; asm volatile("" : "+v"(one8));
    v8i_t At[4], B0[2], B1[2];
    unsigned cvA[2][2], nvA[2][2];
    if (GATHER) { PG9_VA(cvA, cur); }
    const char* cAu = GATHER ? Abase : Abase + (size_t)aoffn(cur, 0); const char* nAu = cAu;
    const char* cB = bbase(cur);
    E.prefetch(lds, cur, 0, wid, lane);
    PG9_STAGE(PG9_SB(0, 0), cB, voffB); PG9_STAGE(PG9_SB(0, 1), cB + hstep, voffB); PG9_STAGE_A(PG9_SA(0, 0), 0, 0, false); PG9_STAGE_A(PG9_SA(0, 1), 1, 0, false);
    if (wr == 1) PG9_BAR;
    PG9_WAIT_V(2); PG9_BAR;
    PG9_STAGE(PG9_SB(1, 0), cB + kstep, voffB); PG9_STAGE_A(PG9_SA(1, 0), 0, kstep, false); PG9_STAGE(PG9_SB(1, 1), cB + hstep + kstep, voffB);
    PG9_WAIT_V(6); PG9_BAR;
    for (;;) {
        const bool has_next = S.next(ui + 1, nxt);
        if (GATHER) {
            if (has_next) { PG9_VA(nvA, nxt); } else {
#pragma unroll
                for (int _h = 0; _h < 2; ++_h)
#pragma unroll
                    for (int _i = 0; _i < 2; ++_i) nvA[_h][_i] = cvA[_h][_i]; }
        } else nAu = has_next ? Abase + (size_t)aoffn(nxt, 0) : cAu;
        const char* nB = has_next ? bbase(nxt) : cB;
#pragma unroll 1
        for (int t = 0; t < nt; t += 2) {
            const bool last = (t == nt - 2);
            if (Epi::HOOK_T >= 0) { if (t == Epi::HOOK_T) E.hook(acc, cur, wr, wc, fr, fq); }
            const size_t k1 = (size_t)(t + 1) * kstep, k2 = last ? 0 : (size_t)(t + 2) * kstep, k3 = k2 + kstep;
            const char* b2 = last ? nB : cB + (size_t)(t + 2) * kstep; const char* b3 = b2 + kstep;
            PG9_LDB(B0, 0, 0); PG9_LDB(B1, 0, 1); PG9_SCHED; PG9_LDA(At, 0, 0); PG9_STAGE_A(PG9_SA(1, 1), 1, k1, false);
            PG9_WAIT_V(8); PG9_WAIT_L(0); PG9_BAR; PG9_MMA(0, 0, At, B0); PG9_MMA(0, 1, At, B1); PG9_BAR; PG9_SCHED;
            PG9_LDA(At, 0, 1); PG9_STAGE(PG9_SB(0, 0), b2, voffB); PG9_STAGE(PG9_SB(0, 1), b2 + hstep, voffB); PG9_STAGE_A(PG9_SA(0, 0), 0, k2, last);
            PG9_WAIT_V(8); PG9_WAIT_L(0); PG9_BAR; PG9_MMA(1, 0, At, B0); PG9_MMA(1, 1, At, B1); PG9_BAR; PG9_SCHED;
            PG9_LDB(B0, 1, 0); PG9_LDB(B1, 1, 1); PG9_SCHED; PG9_LDA(At, 1, 0); PG9_STAGE_A(PG9_SA(0, 1), 1, k2, last);
            PG9_WAIT_V(8); PG9_WAIT_L(0); PG9_BAR; PG9_MMA(0, 0, At, B0); PG9_MMA(0, 1, At, B1); PG9_BAR; PG9_SCHED;
            PG9_LDA(At, 1, 1); PG9_STAGE(PG9_SB(1, 0), b3, voffB); PG9_STAGE(PG9_SB(1, 1), b3 + hstep, voffB); PG9_STAGE_A(PG9_SA(1, 0), 0, k3, last);
            PG9_WAIT_V(8); PG9_WAIT_L(0); PG9_BAR; PG9_MMA(1, 0, At, B0); PG9_MMA(1, 1, At, B1); PG9_BAR; PG9_SCHED;
        }
        if (wr == 0) PG9_BAR;
        if (ESZ == 1) asm volatile("s_nop 15\n\ts_nop 15" ::: "memory");
        E(acc, cur, ui, wr, wc, fr, fq);
        if (!has_next) break;
#pragma unroll
        for (int a = 0; a < 2; ++a)
#pragma unroll
            for (int b = 0; b < 2; ++b)
#pragma unroll
                for (int m = 0; m < 4; ++m)
#pragma unroll
                    for (int n = 0; n < 2; ++n) acc[a][b][m][n] = (f32x4){0.f, 0.f, 0.f, 0.f};
        cur = nxt; cB = nB; cAu = nAu; ++ui;
        E.prefetch(lds, cur, ui, wid, lane);
        if (GATHER) {
#pragma unroll
            for (int _h = 0; _h < 2; ++_h)
#pragma unroll
                for (int _i = 0; _i < 2; ++_i) cvA[_h][_i] = nvA[_h][_i]; }
        if (wr == 1) PG9_BAR;
    }
    PG9_WAIT_V(0);
    PG9_BAR;
#undef PG9_SA
#undef PG9_SB
#undef PG9_STAGE
#undef PG9_LDA
#undef PG9_LDB
#undef PG9_MMA
#undef PG9_HALF
#undef PG9_WAIT_V
#undef PG9_WAIT_L
#undef PG9_BAR
#undef PG9_SCHED
#undef PG9_VA
#undef PG9_STAGE_A
}
struct DenseOrder { pg8::StaticOrder so;
    __device__ void init(int M, int N, int G, int c) { so.init(M, N, G, c); }
    __device__ bool next(int i, Unit& u) const { pg8::Unit v; if (!so.next(i, v)) return false; u.pm = v.pm; u.pn = v.pn; u.e = 0; return true; } };
struct DenseA { static constexpr bool GATHER = false; unsigned rowbytes; __device__ __forceinline__ unsigned operator()(const Unit& u, int row) const { return (unsigned)(u.pm * 256 + row) * rowbytes; } };
struct DenseB { const char* Bt; size_t tilebytes; __device__ __forceinline__ const char* operator()(const Unit& u) const { return Bt + (size_t)u.pn * tilebytes; } };
}

struct EpiInproj {
    static constexpr bool PERM = true; static constexpr int HOOK_T = -1;
    bf16* ZA; bf16* ZB; bf16* Gt; const float* biasP; LAS unsigned char* ldsb;
    __device__ __forceinline__ void hook(f32x4 (&)[2][2][4][2], const pg9::Unit&, int, int, int, int) const {}
    __device__ __forceinline__ void prefetch(LAS unsigned char* lds, const pg9::Unit& u, int ui, int wid, int lane) const {
        if (wid == 0) __builtin_amdgcn_global_load_lds((const unsigned*)(biasP + u.pn * 256 + lane * 4), (LAS unsigned*)(lds + LDS_MISC + 4096 + (ui & 1) * 1024), 16, 0, 0);
    }
    __device__ __forceinline__ void operator()(const f32x4 (&acc)[2][2][4][2], const pg9::Unit& u, int ui, int wr, int wc, int fr, int fq) const {
        asm volatile("" : "+v"(fr), "+v"(fq));
        const int row0 = u.pm * 256 + wr * 64 + fr;
        const int q = 4 * (wc & 1) + fq;
        const int fr2 = (fr >> 2) + 4 * fq, fq2 = fr & 3, paddr = 4 * (16 * (fr & 3) + 4 * fq + (fr >> 2));
        const int row0s = u.pm * 256 + wr * 64 + fr2;
        int kind[2]; bf16* dst[2]; int ldd[2]; f32x4 b0[2], b1[2];
#pragma unroll
        for (int bj = 0; bj < 2; ++bj) {
            const int colpos = u.pn * 256 + bj * 128 + wc * 32 + 8 * fq, colposs = u.pn * 256 + bj * 128 + wc * 32 + 8 * fq2, hb = u.pn * 256 + bj * 128 + (wc >> 1) * 64;
            if (hb < A_W) { const int hbi = hb >> 6; kind[bj] = hb / 1536; dst[bj] = ZA + (size_t)hbi * (TC * 64) + (colposs - hb); ldd[bj] = 2 * ((hbi % 24) >> 3); }
            else if (hb < A_W + B_W) { const int cb = hb - A_W; kind[bj] = cb < 1024 ? 0 : (cb < 1152 ? 1 : 2); dst[bj] = ZB + (size_t)(cb >> 6) * (TC * 64) + (colposs - hb); ldd[bj] = 0; }
            else { kind[bj] = 3; const int c0 = (colpos - A_W - B_W) >> 1;
                dst[bj] = Gt + ((size_t)((u.pm * 256 + wr * 64) >> 4) * 256 + (c0 >> 3)) * 128 + fr * 8 + (c0 & 7); ldd[bj] = 0; }
            const LAS float* bs = (const LAS float*)(ldsb + LDS_MISC + 4096 + (ui & 1) * 1024) + bj * 128 + wc * 32 + 8 * fq;
            b0[bj] = *(const LAS f32x4*)bs; b1[bj] = *(const LAS f32x4*)(bs + 4);
        }
        const bool need_rope = kind[0] < 2 || kind[1] < 2;
        const f32x4 fv = *(const LAS f32x4*)(ldsb + LDS_MISC + 6144 + 16 * q);
#pragma unroll
        for (int ai = 0; ai < 2; ++ai) {
            f32x4 rc[4], rs[4];
#pragma unroll
            for (int m = 0; m < 4; ++m) { rc[m] = (f32x4){1.f, 1.f, 1.f, 1.f}; rs[m] = (f32x4){0.f, 0.f, 0.f, 0.f}; }
            if (need_rope) {
#pragma unroll
                for (int m = 0; m < 4; ++m) { const float posf = (float)((row0 + ai * 128 + m * 16) & (SEQ - 1));
#pragma unroll
                    for (int e = 0; e < 4; ++e) { const float ang = posf * fv[e]; const float pr = ang * 0.15915494f; const float er = __builtin_fmaf(ang, 0.15915494f, -pr) + ang * 6.4206382e-9f;
                        const float fr = __builtin_amdgcn_fractf(pr) + er; rc[m][e] = __builtin_amdgcn_cosf(fr); rs[m][e] = __builtin_amdgcn_sinf(fr); } }
            }
#pragma unroll
            for (int bj = 0; bj < 2; ++bj) {
                const int sh = ldd[bj], posr = row0s & (SEQ - 1), ridx = (row0s & ~(SEQ - 1)) + ((posr & ((1 << sh) - 1)) << (12 - sh)) + (posr >> sh);
                bf16* p = dst[bj] + (size_t)(ridx + ai * (128 >> sh)) * 64; const unsigned step = (unsigned)((16 >> sh) * 64);
                if (kind[bj] == 3) p = dst[bj] + (size_t)(ai * 8) * 32768;
                switch (kind[bj]) {
                    case 0: store4<0>(acc[ai][bj], b0[bj], b1[bj], rc, rs, p, step, paddr); break;
                    case 1: store4<1>(acc[ai][bj], b0[bj], b1[bj], rc, rs, p, step, paddr); break;
                    case 2: store4<2>(acc[ai][bj], b0[bj], b1[bj], rc, rs, p, step, paddr); break;
                    default: store4<3>(acc[ai][bj], b0[bj], b1[bj], rc, rs, p, step, paddr); break;
                }
            }
        }
    }
    template <int KIND> static __device__ __forceinline__ void store4(const f32x4 (&a)[4][2], const f32x4 b0, const f32x4 b1, const f32x4 (&rc)[4], const f32x4 (&rs)[4], bf16* p, const unsigned step, const int paddr) {
#pragma unroll
        for (int m = 0; m < 4; ++m) {
            f32x4 v0 = a[m][0] * W8_INV + b0, v1 = a[m][1] * W8_INV + b1;
            if (KIND < 2) {
                const f32x4 cc = rc[m], ss = rs[m];
                const f32x4 t0 = v0 * cc - v1 * ss, t1 = v1 * cc + v0 * ss;
                v0 = t0; v1 = t1;
                if (KIND == 0) { v0 = v0 * QSCALE; v1 = v1 * QSCALE; }
            }
            if (KIND == 3) {
#pragma unroll
                for (int e = 0; e < 4; ++e) { const float d0 = 1.0f + __expf(-v0[e]), d1 = 1.0f + __expf(-v1[e]); v0[e] = d1 * __builtin_amdgcn_rcpf(d0); v1[e] = __builtin_amdgcn_rcpf(d1); }
                v2u w0, w1; w0.x = cvtpk(v0[0], v0[1]); w0.y = cvtpk(v0[2], v0[3]); w1.x = cvtpk(v1[0], v1[1]); w1.y = cvtpk(v1[2], v1[3]);
                *(GAS v2u*)p = w0; *(GAS v2u*)(p + 128 * 128) = w1; p += 32768;
            } else {
                v4u w; w.x = cvtpk(v0[0], v0[1]); w.y = cvtpk(v0[2], v0[3]); w.z = cvtpk(v1[0], v1[1]); w.w = cvtpk(v1[2], v1[3]);
                w.x = (unsigned)__builtin_amdgcn_ds_bpermute(paddr, (int)w.x); w.y = (unsigned)__builtin_amdgcn_ds_bpermute(paddr, (int)w.y); w.z = (unsigned)__builtin_amdgcn_ds_bpermute(paddr, (int)w.z); w.w = (unsigned)__builtin_amdgcn_ds_bpermute(paddr, (int)w.w);
                *(GAS v4u*)p = w; p += step;
            }
        }
    }
};
__device__ __forceinline__ void p1_inproj(Frame& F, int ch) {
    unsigned char* ws = F.ws;
    pg9::DenseOrder S; S.init(TC, NIN, F.G, (int)blockIdx.x);
    EpiInproj E{(bf16*)(ws + WS_ZA), (bf16*)(ws + WS_ZB), (bf16*)(ws + WS_G) + (size_t)ch * TC * G_W, (const float*)(ws + WS_BIASP), F.lds};
    { int t_ = threadIdx.x; asm volatile("" : "+v"(t_)); if (t_ < 32) ((LAS float*)(F.lds + LDS_MISC + 6144))[t_] = ((const float*)(ws + WS_INVF))[t_]; }
    constexpr int ES = P1_FP8 ? 1 : 2;
    pg9::DenseA ao{(unsigned)(D * ES)}; pg9::DenseB bb{(const char*)(ws + WS_WIN), (size_t)256 * D * ES};
    pg9::gemm_phase<ES>(F.lds, (const char*)F.out + DO_HN + (size_t)ch * TC * D * ES, D, S, E, ao, bb);
}

typedef float f32x16 __attribute__((ext_vector_type(16)));
typedef short v4i16_t __attribute__((ext_vector_type(4)));
__device__ __forceinline__ float half_max(float v) { auto rr = __builtin_amdgcn_permlane32_swap(__float_as_uint(v), __float_as_uint(v), false, false); return fmaxf(__uint_as_float(rr[0]), __uint_as_float(rr[1])); }
__device__ __forceinline__ float half_sum(float v) { auto rr = __builtin_amdgcn_permlane32_swap(__float_as_uint(v), __float_as_uint(v), false, false); return __uint_as_float(rr[0]) + __uint_as_float(rr[1]); }
__device__ __forceinline__ float max3f(float a, float b, float c) { float r; asm("v_max3_f32 %0, %1, %2, %3" : "=v"(r) : "v"(a), "v"(b), "v"(c)); return r; }
constexpr int ATT_VOFF = 49152;

struct AUnit { const bf16 *Kw, *Vw, *Qp; size_t pitch; int kk_lo, nkeys, kb0, kstart, lo; float m0; bf16* Op; float* Lp; int o8; };
__device__ __forceinline__ void attn_decode(Frame& F, int ch, int u, int NUA, int lane, AUnit& d) {
    unsigned char* ws = F.ws;
    const int w = F.wave, c = lane & 31, h = (lane >> 5) & 1;
    if (u < NUA) {
        const bf16* ZA = (const bf16*)(ws + WS_ZA);
        const int rt = u & 15, hh = (u >> 4) & 7, gb = u >> 7, g = gb % 3, bl = gb / 3;
        const int dsh = 2 * g, dd = 1 << dsh, tsh = 4 - dsh;
        const int r = rt >> tsh, tile = rt & ((1 << tsh) - 1), i0 = tile * 256;
        const int rowb = bl * SEQ + r;
        d.pitch = 64;
        const int sl = g * 8 + hh; const long rb = (long)bl * SEQ + ((long)r << (12 - dsh));
        d.Kw = ZA + ((long)(24 + sl) * TC + rb + (i0 - 128)) * 64; d.Vw = ZA + ((long)(48 + sl) * TC + rb + (i0 - 128)) * 64;
        const long qrow = (long)rowb + (long)dd * (i0 + 32 * w + c);
        d.Qp = ZA + ((long)sl * TC + rb + i0 + 32 * w + c) * 64;
        d.kk_lo = (i0 == 0) ? 128 : 0; d.nkeys = 384; d.kb0 = w; d.kstart = (i0 == 0) ? (w < 4 ? 4 - w : 0) : 0; d.lo = 0;
        d.m0 = -1e30f;
        d.Op = (bf16*)((unsigned char*)F.out + DO_OG) + ((size_t)g * TC + qrow) * 512 + hh * 64;
        d.Lp = (float*)((unsigned char*)F.out + DO_LSE) + ((size_t)g * TC + qrow) * 8 + hh;
        d.o8 = 0;
    } else {
        const int u2 = u - NUA;
        const bf16* ZB = (const bf16*)(ws + WS_ZB);
        const int blk = u2 & 127, kvh = (u2 >> 7) & 1, bl = u2 >> 8;
        const int t0 = blk * 32, rowb = bl * SEQ;
        d.pitch = 64;
        d.Kw = ZB + ((long)(16 + kvh) * TC + rowb + t0 - 128) * 64; d.Vw = ZB + ((long)(18 + kvh) * TC + rowb + t0 - 128) * 64;
        const int qh = kvh * 8 + w;
        const long qrow = (long)rowb + t0 + c;
        d.Qp = ZB + ((long)qh * TC + qrow) * 64;
        d.kk_lo = t0 < 128 ? 128 - t0 : 0; d.nkeys = 160; d.kb0 = 0; d.kstart = d.kk_lo >> 5; d.lo = 1;
        d.m0 = F.in[I_SINK][qh] * LOG2E;
        d.o8 = P34_FP8;
        d.Op = P34_FP8 ? (bf16*)(ws + WS_Y + ((size_t)ch * TC + qrow) * Y_W + 512 + qh * 64) : (bf16*)(ws + WS_Y) + ((size_t)ch * TC + qrow) * Y_W + 512 + qh * 64;
        d.Lp = nullptr;
    }
}
__device__ __forceinline__ void attn_load(const AUnit& d, int tid, int lane, v4u (&kreg)[6], v4u (&vreg)[6], bf16x8 (&qf)[4]) {
    const int skey = tid >> 3, sch = tid & 7, h = (lane >> 5) & 1;
#pragma unroll
    for (int s4 = 0; s4 < 4; ++s4) qf[s4] = *(const GAS bf16x8*)(d.Qp + 16 * s4 + 8 * h);
#pragma unroll
    for (int p = 0; p < 6; ++p) { const int kk = 64 * p + skey;
        if (kk >= d.kk_lo && kk < d.nkeys) { kreg[p] = *(const GAS v4u*)(d.Kw + (size_t)kk * d.pitch + 8 * sch); vreg[p] = *(const GAS v4u*)(d.Vw + (size_t)kk * d.pitch + 8 * sch); } }
}
__device__ __forceinline__ void attn_write(const AUnit& d, LAS unsigned char* KL, LAS unsigned char* VL, int tid, const v4u (&kreg)[6], const v4u (&vreg)[6]) {
    const int skey = tid >> 3, sch = tid & 7;
#pragma unroll
    for (int p = 0; p < 6; ++p) { const int kk = 64 * p + skey;
        if (kk >= d.kk_lo && kk < d.nkeys) {
            *(LAS v4u*)(KL + kk * 128 + ((sch ^ ((kk >> 1) & 7)) << 4)) = kreg[p];
            *(LAS v4u*)(VL + kk * 128 + ((sch * 16) ^ (((kk >> 1) & 1) << 6))) = vreg[p]; } }
}
__device__ __forceinline__ void attn_compute_edge(const AUnit& d, const LAS unsigned char* KL, const LAS unsigned char* VL, int lane, const bf16x8 (&qf)[4]) {
    const int c = lane & 31, h = (lane >> 5) & 1;
    int koff[4];
    { const int kswz = (c >> 1) & 7;
#pragma unroll
      for (int s4 = 0; s4 < 4; ++s4) koff[s4] = c * 128 + (((2 * s4 + h) ^ kswz) << 4); }
    const int vrow = 4 * h + ((lane & 15) >> 2), vsw = (lane >> 3) & 1;
    const int voff0 = vrow * 128 + ((32 * ((lane >> 4) & 1) + 8 * (lane & 3)) ^ (vsw << 6)), voff1 = voff0 ^ 64;
    const float NEG = -INFINITY;
    float m = d.m0, l = (d.lo && h == 0) ? 1.f : 0.f;
    f32x16 o0, o1;
#pragma unroll
    for (int i = 0; i < 16; ++i) { o0[i] = 0.f; o1[i] = 0.f; }
    const LAS unsigned char* kbp = KL + d.kb0 * 4096; const LAS unsigned char* vbp = VL + d.kb0 * 4096;
    const int clo = c + d.lo;
#pragma unroll
    for (int kbi = 0; kbi < 5; ++kbi) {
        if (kbi >= d.kstart) {
            f32x16 p;
#pragma unroll
            for (int i = 0; i < 16; ++i) p[i] = 0.f;
#pragma unroll
            for (int s4 = 0; s4 < 4; ++s4) { const bf16x8 kf = *(const LAS bf16x8*)(kbp + kbi * 4096 + koff[s4]); p = __builtin_amdgcn_mfma_f32_32x32x16_bf16(kf, qf[s4], p, 0, 0, 0); }
            if (kbi == 0) {
#pragma unroll
                for (int i = 0; i < 16; ++i) { const int x = (i & 3) + 8 * (i >> 2) + 4 * h; if (x < clo) p[i] = NEG; }
            }
            if (kbi == 4) {
#pragma unroll
                for (int i = 0; i < 16; ++i) { const int x = (i & 3) + 8 * (i >> 2) + 4 * h; if (x > c) p[i] = NEG; }
            }
            float mt = p[0];
#pragma unroll
            for (int i = 1; i < 16; ++i) mt = fmaxf(mt, p[i]);
            mt = half_max(mt);
            const float mn = fmaxf(m, mt), alpha = __builtin_amdgcn_exp2f(m - mn);
            m = mn;
            float ps = 0.f;
#pragma unroll
            for (int i = 0; i < 16; ++i) { p[i] = __builtin_amdgcn_exp2f(p[i] - mn); ps += p[i]; }
            l = l * alpha + ps;
#pragma unroll
            for (int i = 0; i < 16; ++i) { o0[i] *= alpha; o1[i] *= alpha; }
            bf16x8 pb[2];
#pragma unroll
            for (int s2 = 0; s2 < 2; ++s2) { v4u t; t.x = cvtpk(p[8 * s2 + 0], p[8 * s2 + 1]); t.y = cvtpk(p[8 * s2 + 2], p[8 * s2 + 3]); t.z = cvtpk(p[8 * s2 + 4], p[8 * s2 + 5]); t.w = cvtpk(p[8 * s2 + 6], p[8 * s2 + 7]); pb[s2] = __builtin_bit_cast(bf16x8, t); }
#pragma unroll
            for (int s2 = 0; s2 < 2; ++s2) {
#pragma unroll
                for (int db = 0; db < 2; ++db) {
                    const LAS unsigned char* vp = vbp + kbi * 4096 + s2 * 2048 + (db ? voff1 : voff0);
                    const v4i16_t lo = __builtin_amdgcn_ds_read_tr16_b64_v4i16((LAS v4i16_t*)vp);
                    const v4i16_t hi = __builtin_amdgcn_ds_read_tr16_b64_v4i16((LAS v4i16_t*)(vp + 1024));
                    const bf16x8 vf = {lo[0], lo[1], lo[2], lo[3], hi[0], hi[1], hi[2], hi[3]};
                    if (db == 0) o0 = __builtin_amdgcn_mfma_f32_32x32x16_bf16(vf, pb[s2], o0, 0, 0, 0);
                    else o1 = __builtin_amdgcn_mfma_f32_32x32x16_bf16(vf, pb[s2], o1, 0, 0, 0);
                }
            }
        }
    }
    const float lt = half_sum(l), inv = 1.0f / lt;
#pragma unroll
    for (int g4 = 0; g4 < 4; ++g4) {
        v2u a, b;
        a.x = cvtpk(o0[4 * g4 + 0] * inv, o0[4 * g4 + 1] * inv); a.y = cvtpk(o0[4 * g4 + 2] * inv, o0[4 * g4 + 3] * inv);
        b.x = cvtpk(o1[4 * g4 + 0] * inv, o1[4 * g4 + 1] * inv); b.y = cvtpk(o1[4 * g4 + 2] * inv, o1[4 * g4 + 3] * inv);
        if (d.o8) { unsigned char* o8p = (unsigned char*)d.Op; const float sc = inv * Y8_SCALE;
            *(GAS unsigned*)(o8p + 8 * g4 + 4 * h) = pk4_fp8(o0[4 * g4 + 0] * sc, o0[4 * g4 + 1] * sc, o0[4 * g4 + 2] * sc, o0[4 * g4 + 3] * sc);
            *(GAS unsigned*)(o8p + 32 + 8 * g4 + 4 * h) = pk4_fp8(o1[4 * g4 + 0] * sc, o1[4 * g4 + 1] * sc, o1[4 * g4 + 2] * sc, o1[4 * g4 + 3] * sc); }
        else {
        *(GAS v2u*)(d.Op + 8 * g4 + 4 * h) = a;
        *(GAS v2u*)(d.Op + 32 + 8 * g4 + 4 * h) = b; }
    }
    if (d.Lp) { if (h == 0) *d.Lp = m + __builtin_amdgcn_logf(lt); }
}
__device__ __forceinline__ void attn_compute(const AUnit& d, const LAS unsigned char* KL, const LAS unsigned char* VL, int lane, const bf16x8 (&qf)[4]) {
    const int c = lane & 31, h = (lane >> 5) & 1;
    int koff[4];
    { const int kswz = (c >> 1) & 7;
#pragma unroll
      for (int s4 = 0; s4 < 4; ++s4) koff[s4] = c * 128 + (((2 * s4 + h) ^ kswz) << 4); }
    const int vrow = 4 * h + ((lane & 15) >> 2), vsw = (lane >> 3) & 1;
    const int voff0 = vrow * 128 + ((32 * ((lane >> 4) & 1) + 8 * (lane & 3)) ^ (vsw << 6)), voff1 = voff0 ^ 64;
    const float NEG = -INFINITY;
    float m = d.m0;
    f32x16 o0, o1, L;
#pragma unroll
    for (int i = 0; i < 16; ++i) { o0[i] = 0.f; o1[i] = 0.f; L[i] = 0.f; }
    v4u onesu = {0x3F803F80u, 0x3F803F80u, 0x3F803F80u, 0x3F803F80u}; asm volatile("" : "+v"(onesu));
    const bf16x8 ones = __builtin_bit_cast(bf16x8, onesu);
    const LAS unsigned char* kbp = KL + d.kb0 * 4096; const LAS unsigned char* vbp = VL + d.kb0 * 4096;
    const int clo = c + d.lo;
#pragma unroll
    for (int kbi = 0; kbi < 5; ++kbi) {
        {
            constexpr bool first_dummy = false; (void)first_dummy;
            const bool first = (kbi == 0);
            const float cinit = first ? 0.f : -m;
            f32x16 p;
#pragma unroll
            for (int i = 0; i < 16; ++i) p[i] = cinit;
#pragma unroll
            for (int s4 = 0; s4 < 4; ++s4) { const bf16x8 kf = *(const LAS bf16x8*)(kbp + kbi * 4096 + koff[s4]); p = __builtin_amdgcn_mfma_f32_32x32x16_bf16(kf, qf[s4], p, 0, 0, 0); }
            if (kbi == 0) {
#pragma unroll
                for (int i = 0; i < 16; ++i) { const int x = (i & 3) + 8 * (i >> 2) + 4 * h; p[i] = x < clo ? NEG : p[i]; }
            }
            if (kbi == 4) {
#pragma unroll
                for (int i = 0; i < 16; ++i) { const int x = (i & 3) + 8 * (i >> 2) + 4 * h; p[i] = x > c ? NEG : p[i]; }
            }
            float t0 = max3f(p[0], p[4], p[8]), t1 = max3f(p[1], p[5], p[9]), t2 = max3f(p[2], p[6], p[10]), t3 = max3f(p[3], p[7], p[11]);
            t0 = max3f(t0, p[12], p[13]); t1 = max3f(t1, p[14], p[15]);
            const float mt = half_max(max3f(max3f(t0, t1, t2), t3, t3));
            if (first) {
                const float mn = fmaxf(m, mt), l0 = d.m0 > -1e29f ? __builtin_amdgcn_exp2f(m - mn) : 0.f;
                m = mn;
#pragma unroll
                for (int i = 0; i < 16; ++i) { p[i] -= mn; L[i] = l0; }
            } else if (__any(mt > 8.0f)) {
                const float dl = fmaxf(mt, 0.f), al = __builtin_amdgcn_exp2f(-dl);
                m += dl;
#pragma unroll
                for (int i = 0; i < 16; ++i) { o0[i] *= al; o1[i] *= al; L[i] *= al; p[i] -= dl; }
            }
#pragma unroll
            for (int i = 0; i < 16; ++i) p[i] = __builtin_amdgcn_exp2f(p[i]);
            bf16x8 pb[2];
#pragma unroll
            for (int s2 = 0; s2 < 2; ++s2) { v4u t; t.x = cvtpk(p[8 * s2 + 0], p[8 * s2 + 1]); t.y = cvtpk(p[8 * s2 + 2], p[8 * s2 + 3]); t.z = cvtpk(p[8 * s2 + 4], p[8 * s2 + 5]); t.w = cvtpk(p[8 * s2 + 6], p[8 * s2 + 7]); pb[s2] = __builtin_bit_cast(bf16x8, t); }
#pragma unroll
            for (int s2 = 0; s2 < 2; ++s2) {
                L = __builtin_amdgcn_mfma_f32_32x32x16_bf16(ones, pb[s2], L, 0, 0, 0);
#pragma unroll
                for (int db = 0; db < 2; ++db) {
                    const LAS unsigned char* vp = vbp + kbi * 4096 + s2 * 2048 + (db ? voff1 : voff0);
                    const v4i16_t lo = __builtin_amdgcn_ds_read_tr16_b64_v4i16((LAS v4i16_t*)vp);
                    const v4i16_t hi = __builtin_amdgcn_ds_read_tr16_b64_v4i16((LAS v4i16_t*)(vp + 1024));
                    const bf16x8 vf = {lo[0], lo[1], lo[2], lo[3], hi[0], hi[1], hi[2], hi[3]};
                    if (db == 0) o0 = __builtin_amdgcn_mfma_f32_32x32x16_bf16(vf, pb[s2], o0, 0, 0, 0);
                    else o1 = __builtin_amdgcn_mfma_f32_32x32x16_bf16(vf, pb[s2], o1, 0, 0, 0);
                }
            }
        }
    }
    const float lt = L[0], inv = 1.0f / lt;
#pragma unroll
    for (int g4 = 0; g4 < 4; ++g4) {
        v2u a, b;
        a.x = cvtpk(o0[4 * g4 + 0] * inv, o0[4 * g4 + 1] * inv); a.y = cvtpk(o0[4 * g4 + 2] * inv, o0[4 * g4 + 3] * inv);
        b.x = cvtpk(o1[4 * g4 + 0] * inv, o1[4 * g4 + 1] * inv); b.y = cvtpk(o1[4 * g4 + 2] * inv, o1[4 * g4 + 3] * inv);
        if (d.o8) { unsigned char* o8p = (unsigned char*)d.Op; const float sc = inv * Y8_SCALE;
            *(GAS unsigned*)(o8p + 8 * g4 + 4 * h) = pk4_fp8(o0[4 * g4 + 0] * sc, o0[4 * g4 + 1] * sc, o0[4 * g4 + 2] * sc, o0[4 * g4 + 3] * sc);
            *(GAS unsigned*)(o8p + 32 + 8 * g4 + 4 * h) = pk4_fp8(o1[4 * g4 + 0] * sc, o1[4 * g4 + 1] * sc, o1[4 * g4 + 2] * sc, o1[4 * g4 + 3] * sc); }
        else {
        *(GAS v2u*)(d.Op + 8 * g4 + 4 * h) = a;
        *(GAS v2u*)(d.Op + 32 + 8 * g4 + 4 * h) = b; }
    }
    if (d.Lp) { if (h == 0) *d.Lp = m + __builtin_amdgcn_logf(lt); }
}
__device__ __forceinline__ void p2_attn(Frame& F, int ch) {
    int tid_ = threadIdx.x; asm volatile("" : "+v"(tid_));
    const int tid = tid_, lane = tid & 63;
    LAS unsigned char* KL = F.lds; LAS unsigned char* VL = F.lds + ATT_VOFF;
    constexpr int NUA = (TC / SEQ) * 3 * 8 * 16, NUB = (TC / SEQ) * 2 * 128, NU = NUA + NUB;
    int u = F.vcu; asm volatile("" : "+s"(u));
    if (u >= NU) return;
    AUnit cur, nxt;
    v4u kreg[6], vreg[6]; bf16x8 qn[4];
    attn_decode(F, ch, u, NUA, lane, cur);
    attn_load(cur, tid, lane, kreg, vreg, qn);
    for (;;) {
        attn_write(cur, KL, VL, tid, kreg, vreg);
        bf16x8 qf[4];
#pragma unroll
        for (int s4 = 0; s4 < 4; ++s4) qf[s4] = qn[s4];
        __syncthreads();
        const int un = u + F.G; const bool has_next = un < NU;
        if (has_next) { attn_decode(F, ch, un, NUA, lane, nxt); attn_load(nxt, tid, lane, kreg, vreg, qn); }
        if (cur.kk_lo == 0) attn_compute(cur, KL, VL, lane, qf); else attn_compute_edge(cur, KL, VL, lane, qf);
        __syncthreads();
        if (!has_next) break;
        cur = nxt; u = un;
    }
}
__device__ __forceinline__ void p2_combine(Frame& F, int ch, int cu, int ncu) {
    int tid_ = threadIdx.x; asm volatile("" : "+v"(tid_)); const int lane_ = tid_ & 63;
    unsigned char* ws = F.ws;
    const bf16* OG = (const bf16*)((const unsigned char*)F.out + DO_OG); const float* LSE = (const float*)((const unsigned char*)F.out + DO_LSE);
    bf16* Y = (bf16*)(ws + WS_Y) + (size_t)ch * TC * Y_W; unsigned char* Y8 = ws + WS_Y + (size_t)ch * TC * Y_W;
    const int lane = lane_, hd = lane >> 3;
    int gw_ = cu * NWAVES + F.wave; asm volatile("" : "+s"(gw_));
    const int gw = gw_, NGW = ncu * NWAVES;
    for (int row0 = gw; row0 < TC; row0 += 4 * NGW) {
        float lg[4][3]; v4u og[4][3];
#pragma unroll
        for (int r = 0; r < 4; ++r) { const int row = row0 + r * NGW < TC ? row0 + r * NGW : row0;
#pragma unroll
            for (int g = 0; g < 3; ++g) { lg[r][g] = LSE[((size_t)g * TC + row) * 8 + hd]; og[r][g] = *(const GAS v4u*)(OG + ((size_t)g * TC + row) * 512 + lane * 8); } }
#pragma unroll
        for (int r = 0; r < 4; ++r) { const int row = row0 + r * NGW; if (row >= TC) continue;
            const float mx = fmaxf(fmaxf(lg[r][0], lg[r][1]), lg[r][2]);
            float e[3]; e[0] = __builtin_amdgcn_exp2f(lg[r][0] - mx); e[1] = __builtin_amdgcn_exp2f(lg[r][1] - mx); e[2] = __builtin_amdgcn_exp2f(lg[r][2] - mx);
            const float inv = 1.0f / (e[0] + e[1] + e[2]);
            float acc[8];
#pragma unroll
            for (int i = 0; i < 8; ++i) acc[i] = 0.f;
#pragma unroll
            for (int g = 0; g < 3; ++g) { const float wg = e[g] * inv; const v4u o_ = og[r][g];
                acc[0] += wg * bflo(o_.x); acc[1] += wg * bfhi(o_.x); acc[2] += wg * bflo(o_.y); acc[3] += wg * bfhi(o_.y);
                acc[4] += wg * bflo(o_.z); acc[5] += wg * bfhi(o_.z); acc[6] += wg * bflo(o_.w); acc[7] += wg * bfhi(o_.w); }
            v4u o; o.x = cvtpk(acc[0], acc[1]); o.y = cvtpk(acc[2], acc[3]); o.z = cvtpk(acc[4], acc[5]); o.w = cvtpk(acc[6], acc[7]);
            if (P34_FP8) { v2u o8; o8.x = pk4_fp8(acc[0] * Y8_SCALE, acc[1] * Y8_SCALE, acc[2] * Y8_SCALE, acc[3] * Y8_SCALE); o8.y = pk4_fp8(acc[4] * Y8_SCALE, acc[5] * Y8_SCALE, acc[6] * Y8_SCALE, acc[7] * Y8_SCALE); *(GAS v2u*)(Y8 + (size_t)row * Y_W + lane * 8) = o8; }
            else *(GAS v4u*)(Y + (size_t)row * Y_W + lane * 8) = o; }
    }
}


struct EpiMerge {
    static constexpr bool PERM = true; static constexpr int HOOK_T = P34_FP8 ? 4 : 8;
    const bf16* Gt; bf16* MG;
    __device__ __forceinline__ void prefetch(LAS unsigned char*, const pg9::Unit&, int, int, int) const {}
    __device__ __forceinline__ void hook(f32x4 (&acc)[2][2][4][2], const pg9::Unit& u, int wr, int wc, int fr, int fq) const {
        asm volatile("" : "+v"(fr), "+v"(fq));
        const bf16* gr = Gt + ((size_t)((u.pm * 256 + wr * 64) >> 4) * 256 + u.pn * 32 + wc * 4 + fq) * 128 + fr * 8;
        v4u rv[8][2];
#pragma unroll
        for (int rg = 0; rg < 8; ++rg)
#pragma unroll
            for (int bj = 0; bj < 2; ++bj) rv[rg][bj] = *(const GAS v4u*)(gr + (size_t)((rg >> 2) * 8 + (rg & 3)) * 32768 + bj * 16 * 128);
#pragma unroll
        for (int rg = 0; rg < 8; ++rg)
#pragma unroll
            for (int bj = 0; bj < 2; ++bj) { const v4u a = rv[rg][bj];
                const f32x4 r0 = {bflo(a.x), bfhi(a.x), bflo(a.y), bfhi(a.y)}, r1 = {bflo(a.z), bfhi(a.z), bflo(a.w), bfhi(a.w)};
                acc[rg >> 2][bj][rg & 3][0] = acc[rg >> 2][bj][rg & 3][0] * r0; acc[rg >> 2][bj][rg & 3][1] = acc[rg >> 2][bj][rg & 3][1] * r1; }
    }
    __device__ __forceinline__ void operator()(const f32x4 (&acc)[2][2][4][2], const pg9::Unit& u, int ui, int wr, int wc, int fr, int fq) const {
        asm volatile("" : "+v"(fr), "+v"(fq));
        const bf16* gr = Gt + ((size_t)((u.pm * 256 + wr * 64) >> 4) * 256 + 128 + u.pn * 32 + wc * 4 + fq) * 128 + fr * 8;
        const int fr2 = (fr >> 2) + 4 * fq, fq2 = fr & 3, paddr = 4 * (16 * (fr & 3) + 4 * fq + (fr >> 2));
        bf16* mr = MG + (size_t)(u.pm * 256 + wr * 64 + fr2) * D + u.pn * 256 + wc * 32 + 8 * fq2;
        v4u gb[8][2];
#pragma unroll
        for (int rg = 0; rg < 8; ++rg)
#pragma unroll
            for (int bj = 0; bj < 2; ++bj) gb[rg][bj] = *(const GAS v4u*)(gr + (size_t)((rg >> 2) * 8 + (rg & 3)) * 32768 + bj * 16 * 128);
#pragma unroll
        for (int rg = 0; rg < 8; ++rg)
#pragma unroll
            for (int bj = 0; bj < 2; ++bj) { const v4u b = gb[rg][bj];
                const f32x4 v0 = acc[rg >> 2][bj][rg & 3][0], v1 = acc[rg >> 2][bj][rg & 3][1];
                if (P34_FP8) { constexpr float f = MG8_SCALE / (W34_SCALE * Y8_SCALE); unsigned char* m8 = (unsigned char*)MG + (size_t)(u.pm * 256 + wr * 64 + fr2) * D + u.pn * 256 + wc * 32 + 8 * fq2;
                    v2u w8; w8.x = pk4_fp8(v0[0] * bflo(b.x) * f, v0[1] * bfhi(b.x) * f, v0[2] * bflo(b.y) * f, v0[3] * bfhi(b.y) * f); w8.y = pk4_fp8(v1[0] * bflo(b.z) * f, v1[1] * bfhi(b.z) * f, v1[2] * bflo(b.w) * f, v1[3] * bfhi(b.w) * f);
                    w8.x = (unsigned)__builtin_amdgcn_ds_bpermute(paddr, (int)w8.x); w8.y = (unsigned)__builtin_amdgcn_ds_bpermute(paddr, (int)w8.y);
                    *(GAS v2u*)(m8 + (size_t)((rg >> 2) * 128 + (rg & 3) * 16) * D + bj * 128) = w8; }
                else {
                v4u w; w.x = cvtpk(v0[0] * bflo(b.x), v0[1] * bfhi(b.x)); w.y = cvtpk(v0[2] * bflo(b.y), v0[3] * bfhi(b.y));
                w.z = cvtpk(v1[0] * bflo(b.z), v1[1] * bfhi(b.z)); w.w = cvtpk(v1[2] * bflo(b.w), v1[3] * bfhi(b.w));
                w.x = (unsigned)__builtin_amdgcn_ds_bpermute(paddr, (int)w.x); w.y = (unsigned)__builtin_amdgcn_ds_bpermute(paddr, (int)w.y); w.z = (unsigned)__builtin_amdgcn_ds_bpermute(paddr, (int)w.z); w.w = (unsigned)__builtin_amdgcn_ds_bpermute(paddr, (int)w.w);
                *(GAS v4u*)(mr + (size_t)((rg >> 2) * 128 + (rg & 3) * 16) * D + bj * 128) = w; } }
    }
};
__device__ __forceinline__ void p3_merge(Frame& F) {
    unsigned char* ws = F.ws;
    pg9::DenseOrder S; S.init(T, D, F.G, (int)blockIdx.x);
    EpiMerge E{(const bf16*)(ws + WS_G), (bf16*)(ws + WS_MG)};
    constexpr int ES = P34_FP8 ? 1 : 2;
    pg9::DenseA ao{(unsigned)(Y_W * ES)}; pg9::DenseB bb{(const char*)(ws + WS_WAB), (size_t)256 * Y_W * ES};
    pg9::gemm_phase<ES>(F.lds, (const char*)(ws + WS_Y), Y_W, S, E, ao, bb);
}
struct EpiOut {
    static constexpr bool PERM = true; static constexpr int HOOK_T = -1;
    bf16* DELTA;
    __device__ __forceinline__ void hook(f32x4 (&)[2][2][4][2], const pg9::Unit&, int, int, int, int) const {}
    __device__ __forceinline__ void prefetch(LAS unsigned char*, const pg9::Unit&, int, int, int) const {}
    __device__ __forceinline__ void operator()(const f32x4 (&acc)[2][2][4][2], const pg9::Unit& u, int ui, int wr, int wc, int fr, int fq) const {
        asm volatile("" : "+v"(fr), "+v"(fq));
        const int fr2 = (fr >> 2) + 4 * fq, fq2 = fr & 3, paddr = 4 * (16 * (fr & 3) + 4 * fq + (fr >> 2));
        bf16* orow = DELTA + (size_t)(u.pm * 256 + wr * 64 + fr2) * D + u.pn * 256 + wc * 32 + 8 * fq2;
#pragma unroll
        for (int ai = 0; ai < 2; ++ai)
#pragma unroll
            for (int m = 0; m < 4; ++m)
#pragma unroll
                for (int bj = 0; bj < 2; ++bj) { constexpr float f = P34_FP8 ? 1.0f / (W34_SCALE * MG8_SCALE) : 1.0f; const f32x4 o0 = acc[ai][bj][m][0] * f, o1 = acc[ai][bj][m][1] * f;
                    v4u w; w.x = cvtpk(o0[0], o0[1]); w.y = cvtpk(o0[2], o0[3]); w.z = cvtpk(o1[0], o1[1]); w.w = cvtpk(o1[2], o1[3]);
                    w.x = (unsigned)__builtin_amdgcn_ds_bpermute(paddr, (int)w.x); w.y = (unsigned)__builtin_amdgcn_ds_bpermute(paddr, (int)w.y); w.z = (unsigned)__builtin_amdgcn_ds_bpermute(paddr, (int)w.z); w.w = (unsigned)__builtin_amdgcn_ds_bpermute(paddr, (int)w.w);
                    *(GAS v4u*)(orow + (size_t)(ai * 128 + m * 16) * D + bj * 128) = w; }
    }
};
__device__ __forceinline__ void p4_outproj(Frame& F) {
    unsigned char* ws = F.ws;
    pg9::DenseOrder S; S.init(T, D, F.G, (int)blockIdx.x);
    EpiOut E{(bf16*)((unsigned char*)F.out + DO_DELTA)};
    constexpr int ES = P34_FP8 ? 1 : 2;
    pg9::DenseA ao{(unsigned)(D * ES)}; pg9::DenseB bb{(const char*)(ws + WS_WO), (size_t)256 * D * ES};
    pg9::gemm_phase<ES>(F.lds, (const char*)(ws + WS_MG), D, S, E, ao, bb);
}

__device__ __forceinline__ void p5_route(Frame& F) {
    int tid_ = threadIdx.x; asm volatile("" : "+v"(tid_)); const int lane = tid_ & 63;
    unsigned char* ws = F.ws;
    const float* X = F.in[I_X]; const bf16* DELTA = (const bf16*)((const unsigned char*)F.out + DO_DELTA);
    bf16* X1B = (bf16*)(ws + WS_X1B); unsigned char* X1F8 = ws + WS_X1F8;
    unsigned* cnt = (unsigned*)(ws + WS_CTL) + CW_CNT;
    int* tokof = (int*)(ws + WS_TOKOF); float2* wtof = (float2*)(ws + WS_WTOF); int4* tpos = (int4*)(ws + WS_TPOS);
    const v4u* WRF = (const v4u*)(ws + WS_WRF);
    LAS v4u* wl = (LAS v4u*)F.lds;
    LAS float* sl = (LAS float*)(F.lds + 98304 + F.wave * 4096);
    const int i = lane & 15, q = lane >> 4;
    LAS unsigned* hist = (LAS unsigned*)(F.lds + LDS_MISC + 2048);
    for (int wt = F.vcu; wt < T / 128; wt += F.G) {
        const int tile = wt * NWAVES + F.wave;
        if (tid_ < 32) hist[tid_] = 0u;
        const size_t roff = (size_t)(tile * 16 + i) * D + 8 * q;
        const float* xr = X + roff; const bf16* dr = DELTA + roff;
        f32x4 a0 = {0.f, 0.f, 0.f, 0.f}, a1 = a0, a2 = a0; float ss = 0.f;
        f32x4 va[8][2]; v4u vd[8];
#pragma unroll
        for (int j = 0; j < 8; ++j) { va[j][0] = *(const GAS f32x4*)(xr + 32 * j); va[j][1] = *(const GAS f32x4*)(xr + 32 * j + 4); vd[j] = *(const GAS v4u*)(dr + 32 * j); }
#pragma unroll 1
        for (int half = 0; half < 2; ++half) {
            __syncthreads();
            { v4u t[12];
#pragma unroll
              for (int k = 0; k < 12; ++k) t[k] = WRF[half * 6144 + k * 512 + tid_];
#pragma unroll
              for (int k = 0; k < 12; ++k) wl[k * 512 + tid_] = t[k]; }
            __syncthreads();
#pragma unroll 1
            for (int sb = 0; sb < 2; ++sb) {
#pragma unroll
                for (int j = 0; j < 8; ++j) {
                    const int ksl = sb * 8 + j, ks = half * 16 + ksl;
                    const v4u dd = vd[j];
                    const f32x4 v0 = va[j][0] + (f32x4){bflo(dd.x), bfhi(dd.x), bflo(dd.y), bfhi(dd.y)}, v1 = va[j][1] + (f32x4){bflo(dd.z), bfhi(dd.z), bflo(dd.w), bfhi(dd.w)};
                    if (ks + 8 < 32) { va[j][0] = *(const GAS f32x4*)(xr + 32 * (ks + 8)); va[j][1] = *(const GAS f32x4*)(xr + 32 * (ks + 8) + 4); vd[j] = *(const GAS v4u*)(dr + 32 * (ks + 8)); }
                    ss += ((v0[0] * v0[0] + v0[1] * v0[1]) + (v0[2] * v0[2] + v0[3] * v0[3])) + ((v1[0] * v1[0] + v1[1] * v1[1]) + (v1[2] * v1[2] + v1[3] * v1[3]));
                    v4u hu; hu.x = cvtpk(v0[0], v0[1]); hu.y = cvtpk(v0[2], v0[3]); hu.z = cvtpk(v1[0], v1[1]); hu.w = cvtpk(v1[2], v1[3]);
                    v4u lu; lu.x = cvtpk(v0[0] - bflo(hu.x), v0[1] - bfhi(hu.x)); lu.y = cvtpk(v0[2] - bflo(hu.y), v0[3] - bfhi(hu.y)); lu.z = cvtpk(v1[0] - bflo(hu.z), v1[1] - bfhi(hu.z)); lu.w = cvtpk(v1[2] - bflo(hu.w), v1[3] - bfhi(hu.w));
                    *(GAS v4u*)(X1B + roff + 32 * ks) = hu;
                    if (P6_FP8) { v2u w8; w8.x = pk4_fp8(v0[0], v0[1], v0[2], v0[3]); w8.y = pk4_fp8(v1[0], v1[1], v1[2], v1[3]); *(GAS v2u*)(X1F8 + roff + 32 * ks) = w8; }
                    const bf16x8 ah = __builtin_bit_cast(bf16x8, hu), al = __builtin_bit_cast(bf16x8, lu);
#pragma unroll
                    for (int nb = 0; nb < 3; ++nb) {
                        const bf16x8 bh = __builtin_bit_cast(bf16x8, wl[((ksl * 3 + nb) * 2 + 0) * 64 + lane]), bl = __builtin_bit_cast(bf16x8, wl[((ksl * 3 + nb) * 2 + 1) * 64 + lane]);
                        f32x4 acc = nb == 0 ? a0 : (nb == 1 ? a1 : a2);
                        acc = __builtin_amdgcn_mfma_f32_16x16x32_bf16(ah, bh, acc, 0, 0, 0); acc = __builtin_amdgcn_mfma_f32_16x16x32_bf16(ah, bl, acc, 0, 0, 0); acc = __builtin_amdgcn_mfma_f32_16x16x32_bf16(al, bh, acc, 0, 0, 0);
                        if (nb == 0) a0 = acc; else if (nb == 1) a1 = acc; else a2 = acc;
                    }
                }
            }
        }
        ss += __shfl_xor(ss, 16); ss += __shfl_xor(ss, 32);
#pragma unroll
        for (int r = 0; r < 4; ++r) { sl[(4 * q + r) * 48 + i] = a0[r]; sl[(4 * q + r) * 48 + 16 + i] = a1[r]; sl[(4 * q + r) * 48 + 32 + i] = a2[r]; }
        LDS_WAIT(); asm volatile("" ::: "memory");
        int e0 = 0, e1 = 0, lp0 = 0, lp1 = 0; float w1 = 0.f, w2 = 0.f, rstd = 0.f;
        __syncthreads();
        if (lane < 16) {
            rstd = 1.0f / sqrtf(ss * (1.f / D) + RMS_EPS);
            float lg[36];
#pragma unroll
            for (int o = 0; o < 36; ++o) lg[o] = sl[lane * 48 + o] * rstd + (o < 4 ? F.in[I_BRG][o] : F.in[I_BRE][o - 4]);
            int gsel = 0; float gmax = lg[0];
#pragma unroll
            for (int k = 1; k < 4; ++k) if (lg[k] > gmax) { gmax = lg[k]; gsel = k; }
            float gden = 0.f;
#pragma unroll
            for (int k = 0; k < 4; ++k) gden += __expf(lg[k] - gmax);
            const float pg = 1.0f / gden;
            float le[8];
#pragma unroll
            for (int j = 0; j < 8; ++j) { le[j] = lg[4 + j];
#pragma unroll
                for (int gi = 1; gi < 4; ++gi) le[j] = (gsel == gi) ? lg[4 + gi * 8 + j] : le[j]; }
            int i1 = 0; float m1 = le[0];
#pragma unroll
            for (int j = 1; j < 8; ++j) if (le[j] > m1) { m1 = le[j]; i1 = j; }
            int i2 = -1; float m2 = -INFINITY;
#pragma unroll
            for (int j = 0; j < 8; ++j) if (j != i1 && le[j] > m2) { m2 = le[j]; i2 = j; }
            const float e2 = __expf(m2 - m1);
            w1 = pg / (1.0f + e2); w2 = pg * e2 / (1.0f + e2);
            e0 = gsel * 8 + i1; e1 = gsel * 8 + i2;
            lp0 = (int)__hip_atomic_fetch_add(&hist[e0], 1u, __ATOMIC_RELAXED, __HIP_MEMORY_SCOPE_WORKGROUP);
            lp1 = (int)__hip_atomic_fetch_add(&hist[e1], 1u, __ATOMIC_RELAXED, __HIP_MEMORY_SCOPE_WORKGROUP);
        }
        __syncthreads();
        if (tid_ < 32) { const unsigned n = hist[tid_]; hist[32 + tid_] = n ? atomicAdd(&cnt[64 * tid_], n) : 0u; }
        __syncthreads();
        if (lane < 16) {
            const int row = tile * 16 + lane;
            const int p0 = (int)hist[32 + e0] + lp0, p1 = (int)hist[32 + e1] + lp1;
            tokof[(size_t)e0 * T + p0] = row; wtof[(size_t)e0 * T + p0] = make_float2(w1, rstd);
            tokof[(size_t)e1 * T + p1] = row; wtof[(size_t)e1 * T + p1] = make_float2(w2, rstd);
            tpos[row] = make_int4(e0, p0, e1, p1);
        }
        __syncthreads();
    }
}

__device__ __forceinline__ void expert_tiles(Frame& F, LAS int* tb, LAS int* cn) {
    int tid_ = threadIdx.x; asm volatile("" : "+v"(tid_)); const int lane_ = tid_ & 63;
    if (tid_ == 0) {
        const unsigned* cnt = (const unsigned*)(F.ws + WS_CTL) + CW_CNT;
        int acc = 0;
        for (int e = 0; e < NE; ++e) { const int c = (int)__hip_atomic_load(cnt + 64 * e, __ATOMIC_RELAXED, __HIP_MEMORY_SCOPE_AGENT); cn[e] = c; tb[e] = acc; acc += (c + 255) >> 8; }
        tb[NE] = acc;
    }
    __syncthreads();
}

struct MoeOrder { const LAS int* tb; int ncol, G, c;
    __device__ bool next(int i, pg9::Unit& u) const {
        const int L = i * G + c; if (L >= tb[NE] * ncol) return false;
        const int rt = L / ncol; int e = 0;
        for (int k = 1; k < NE; ++k) if (tb[k] <= rt) e = k;
        u.pm = rt; u.pn = L % ncol; u.e = e; return true; } };
struct GatherA { static constexpr bool GATHER = true; unsigned rowbytes; const int* tokof; const LAS int* tb; const LAS int* cn;
    __device__ __forceinline__ unsigned operator()(const pg9::Unit& u, int row) const {
        const int p = (u.pm - tb[u.e]) * 256 + row; const int tok = tokof[(size_t)u.e * T + (p < cn[u.e] ? p : 0)]; return (unsigned)tok * rowbytes; } };
struct ExpertB { const char* W; size_t ebytes, tilebytes; __device__ __forceinline__ const char* operator()(const pg9::Unit& u) const { return W + (size_t)u.e * ebytes + (size_t)u.pn * tilebytes; } };
struct EpiGateUp {
    static constexpr bool PERM = true; static constexpr int HOOK_T = -1;
    const float2* wtof; bf16* HACT; const LAS int* tb; const LAS int* cn; float ascale;
    __device__ __forceinline__ void hook(f32x4 (&)[2][2][4][2], const pg9::Unit&, int, int, int, int) const {}
    __device__ __forceinline__ void prefetch(LAS unsigned char*, const pg9::Unit&, int, int, int) const {}
    __device__ __forceinline__ void operator()(const f32x4 (&acc)[2][2][4][2], const pg9::Unit& u, int ui, int wr, int wc, int fr, int fq) const {
        asm volatile("" : "+v"(fr), "+v"(fq));
        const int r0 = wr * 64 + fr, p0 = (u.pm - tb[u.e]) * 256, ce = cn[u.e];
        const int fr2 = (fr >> 2) + 4 * fq, fq2 = fr & 3, paddr = 4 * (16 * (fr & 3) + 4 * fq + (fr >> 2)), r0s = wr * 64 + fr2;
        const float2* wp = wtof + (size_t)u.e * T;
#pragma unroll
        for (int ai = 0; ai < 2; ++ai) {
            float2 wv[4];
#pragma unroll
            for (int m = 0; m < 4; ++m) { const int p = p0 + r0 + ai * 128 + m * 16; wv[m] = p < ce ? wp[p] : make_float2(0.f, 0.f); }
#pragma unroll
            for (int m = 0; m < 4; ++m) { const int r = r0s + ai * 128 + m * 16;
                const float w = wv[m].x, rs = wv[m].y * ascale;
                bf16* orow = HACT + (size_t)(u.pm * 256 + r) * DE + u.pn * 128 + wc * 16 + 4 * fq2; unsigned char* orow8 = (unsigned char*)HACT + (size_t)(u.pm * 256 + r) * DE + u.pn * 128 + wc * 16 + 4 * fq2;
#pragma unroll
                for (int bj = 0; bj < 2; ++bj) { const f32x4 g = acc[ai][bj][m][0], uu = acc[ai][bj][m][1]; f32x4 hv;
#pragma unroll
                    for (int e = 0; e < 4; ++e) { const float gg = g[e] * rs; hv[e] = gg / (1.0f + __expf(-gg)) * (uu[e] * rs) * w; }
                    if (P6_FP8) *(GAS unsigned*)(orow8 + bj * 64) = (unsigned)__builtin_amdgcn_ds_bpermute(paddr, (int)pk4_fp8(hv[0] * H8_SCALE, hv[1] * H8_SCALE, hv[2] * H8_SCALE, hv[3] * H8_SCALE));
                    else { v2u o; o.x = (unsigned)__builtin_amdgcn_ds_bpermute(paddr, (int)cvtpk(hv[0], hv[1])); o.y = (unsigned)__builtin_amdgcn_ds_bpermute(paddr, (int)cvtpk(hv[2], hv[3])); *(GAS v2u*)(orow + bj * 64) = o; } } }
        }
    }
};
__device__ __forceinline__ void p6a_gateup(Frame& F) {
    unsigned char* ws = F.ws;
    LAS int* tb = (LAS int*)(F.lds + LDS_MISC + 1024); LAS int* cn = tb + 64;
    expert_tiles(F, tb, cn);
    MoeOrder S{tb, 2, F.G, F.vcu};
    constexpr int ES = P6_FP8 ? 1 : 2;
    GatherA ao{(unsigned)(D * ES), (const int*)(ws + WS_TOKOF), tb, cn}; ExpertB bb{(const char*)(ws + WS_WGU), (size_t)512 * D * ES, (size_t)256 * D * ES};
    EpiGateUp E{(const float2*)(ws + WS_WTOF), (bf16*)(ws + WS_HACT), tb, cn, P6_FP8 ? 1.0f / WG8_SCALE : 1.0f};
    pg9::gemm_phase<ES>(F.lds, (const char*)(ws + (P6_FP8 ? WS_X1F8 : WS_X1B)), D, S, E, ao, bb);
}
struct EpiDown {
    static constexpr bool PERM = true; static constexpr int HOOK_T = -1;
    bf16* YS; float ascale;
    __device__ __forceinline__ void hook(f32x4 (&)[2][2][4][2], const pg9::Unit&, int, int, int, int) const {}
    __device__ __forceinline__ void prefetch(LAS unsigned char*, const pg9::Unit&, int, int, int) const {}
    __device__ __forceinline__ void operator()(const f32x4 (&acc)[2][2][4][2], const pg9::Unit& u, int ui, int wr, int wc, int fr, int fq) const {
        asm volatile("" : "+v"(fr), "+v"(fq));
        const int fr2 = (fr >> 2) + 4 * fq, fq2 = fr & 3, paddr = 4 * (16 * (fr & 3) + 4 * fq + (fr >> 2));
#pragma unroll
        for (int ai = 0; ai < 2; ++ai)
#pragma unroll
            for (int m = 0; m < 4; ++m) { bf16* orow = YS + (size_t)(u.pm * 256 + wr * 64 + fr2 + ai * 128 + m * 16) * D + u.pn * 256 + wc * 32 + 8 * fq2;
#pragma unroll
                for (int bj = 0; bj < 2; ++bj) { const f32x4 v0 = acc[ai][bj][m][0] * ascale, v1 = acc[ai][bj][m][1] * ascale;
                    if (YS_FP8) { unsigned char* o8 = (unsigned char*)YS + (size_t)(u.pm * 256 + wr * 64 + fr2 + ai * 128 + m * 16) * D + u.pn * 256 + wc * 32 + 8 * fq2 + bj * 128;
                        v2u w8; w8.x = pk4_fp8(v0[0] * YS8_SCALE, v0[1] * YS8_SCALE, v0[2] * YS8_SCALE, v0[3] * YS8_SCALE); w8.y = pk4_fp8(v1[0] * YS8_SCALE, v1[1] * YS8_SCALE, v1[2] * YS8_SCALE, v1[3] * YS8_SCALE);
                        w8.x = (unsigned)__builtin_amdgcn_ds_bpermute(paddr, (int)w8.x); w8.y = (unsigned)__builtin_amdgcn_ds_bpermute(paddr, (int)w8.y); *(GAS v2u*)o8 = w8; }
                    else { v4u w; w.x = cvtpk(v0[0], v0[1]); w.y = cvtpk(v0[2], v0[3]); w.z = cvtpk(v1[0], v1[1]); w.w = cvtpk(v1[2], v1[3]);
                        w.x = (unsigned)__builtin_amdgcn_ds_bpermute(paddr, (int)w.x); w.y = (unsigned)__builtin_amdgcn_ds_bpermute(paddr, (int)w.y); w.z = (unsigned)__builtin_amdgcn_ds_bpermute(paddr, (int)w.z); w.w = (unsigned)__builtin_amdgcn_ds_bpermute(paddr, (int)w.w); *(GAS v4u*)(orow + bj * 128) = w; } } }
    }
};
__device__ __forceinline__ void p6b_down(Frame& F) {
    unsigned char* ws = F.ws;
    LAS int* tb = (LAS int*)(F.lds + LDS_MISC + 1024); LAS int* cn = tb + 64;
    expert_tiles(F, tb, cn);
    MoeOrder S{tb, 4, F.G, F.vcu};
    constexpr int ES = P6_FP8 ? 1 : 2;
    pg9::DenseA ao{(unsigned)(DE * ES)}; ExpertB bb{(const char*)(ws + WS_WD), (size_t)D * DE * ES, (size_t)256 * DE * ES};
    EpiDown E{(bf16*)(ws + WS_YS), P6_FP8 ? 1.0f / (WD8_SCALE * H8_SCALE) : 1.0f};
    pg9::gemm_phase<ES>(F.lds, (const char*)(ws + WS_HACT), DE, S, E, ao, bb);
}
__device__ __forceinline__ void p7_final(Frame& F) {
    int tid_ = threadIdx.x; asm volatile("" : "+v"(tid_)); const int lane_ = tid_ & 63;
    unsigned char* ws = F.ws;
    LAS int* tb = (LAS int*)(F.lds + LDS_MISC + 1024); LAS int* cn = tb + 64;
    expert_tiles(F, tb, cn);
    const bf16* YS = (const bf16*)(ws + WS_YS); const int4* tpos = (const int4*)(ws + WS_TPOS);
    float* X1 = F.out; const bf16* X1B = (const bf16*)(ws + WS_X1B);
    const int lane = lane_;
    const int gw = F.vcu * NWAVES + F.wave, NGW = F.G * NWAVES;
    const GAS f32x4* gr = (const GAS f32x4*)F.in[I_GFIN] + lane;
    for (int row = gw; row < T; row += NGW) {
        const int4 tp = tpos[row];
        const size_t s0 = (size_t)tb[tp.x] * 256 + tp.y, s1 = (size_t)tb[tp.z] * 256 + tp.w;
        GAS f32x4* xr = (GAS f32x4*)(X1 + (size_t)row * D) + lane; const GAS v2u* xb = (const GAS v2u*)(X1B + (size_t)row * D) + lane;
        const GAS v2u* y0 = (const GAS v2u*)(YS + s0 * D) + lane; const GAS v2u* y1 = (const GAS v2u*)(YS + s1 * D) + lane;
        const GAS unsigned* z0 = (const GAS unsigned*)((const unsigned char*)YS + s0 * D) + lane; const GAS unsigned* z1 = (const GAS unsigned*)((const unsigned char*)YS + s1 * D) + lane;
        f32x4 v[4]; float s = 0.f;
#pragma unroll
        for (int j = 0; j < 4; ++j) { const v2u xx = xb[64 * j]; v[j] = (f32x4){bflo(xx.x), bfhi(xx.x), bflo(xx.y), bfhi(xx.y)};
            if (YS_FP8) { const int a = (int)z0[64 * j], b = (int)z1[64 * j]; typedef float f2_ __attribute__((ext_vector_type(2)));
                const f2_ a0 = __builtin_amdgcn_cvt_pk_f32_fp8(a, false), a1 = __builtin_amdgcn_cvt_pk_f32_fp8(a, true), b0 = __builtin_amdgcn_cvt_pk_f32_fp8(b, false), b1 = __builtin_amdgcn_cvt_pk_f32_fp8(b, true);
                constexpr float f = 1.0f / YS8_SCALE; v[j].x += (a0[0] + b0[0]) * f; v[j].y += (a0[1] + b0[1]) * f; v[j].z += (a1[0] + b1[0]) * f; v[j].w += (a1[1] + b1[1]) * f; }
            else { const v2u a = y0[64 * j], b = y1[64 * j];
            v[j].x += bflo(a.x) + bflo(b.x); v[j].y += bfhi(a.x) + bfhi(b.x); v[j].z += bflo(a.y) + bflo(b.y); v[j].w += bfhi(a.y) + bfhi(b.y); }
            s += (v[j].x * v[j].x + v[j].y * v[j].y) + (v[j].z * v[j].z + v[j].w * v[j].w); }
        const float rstd = 1.0f / sqrtf(wave_sum(s) * (1.f / D) + RMS_EPS);
#pragma unroll
        for (int j = 0; j < 4; ++j) { const f32x4 gg = gr[64 * j]; f32x4 o; o.x = v[j].x * rstd * gg.x; o.y = v[j].y * rstd * gg.y; o.z = v[j].z * rstd * gg.z; o.w = v[j].w * rstd * gg.w; xr[64 * j] = o; }
    }
}

constexpr int NPHASE = 2 * NCH + 8;
__global__ void __launch_bounds__(NTHR, 2) fwd_kernel(KArgs args) {
    extern __shared__ __attribute__((aligned(16))) unsigned char lds_raw[];
    Frame F;
    F.lds = (LAS unsigned char*)lds_raw;
    F.tid = threadIdx.x; F.lane = F.tid & 63; F.wave = __builtin_amdgcn_readfirstlane(F.tid >> 6);
    F.G = gridDim.x; { const int bx = blockIdx.x; F.vcu = (F.G % 8 == 0) ? (bx % 8) * (F.G / 8) + bx / 8 : bx; }
#pragma unroll
    for (int i = 0; i < 17; ++i) F.in[i] = args.in[i];
    F.out = args.out; F.ws = args.ws;
    volatile LAS unsigned* MISC = (volatile LAS unsigned*)(F.lds + LDS_MISC);
    if (F.tid < 64) MISC[F.tid] = 0u;
    __syncthreads();
    XcdBarrier bar = xcd_barrier_post((unsigned*)(F.ws + WS_CTL) + CW_BAR + args.li * XCD_BAR_WORDS, MISC + 8);
#define IN(k) (args.ph_lo <= (k) && (k) < args.ph_hi)
#ifdef PROBE_MASK
    unsigned long long pr_acc = 0, pr_t0 = 0; const bool pr_me = (blockIdx.x == 0 && threadIdx.x == 0);
#define PR_BEGIN(k) do { if (pr_me && ((PROBE_MASK >> (k)) & 1ull)) pr_t0 = __builtin_amdgcn_s_memrealtime(); } while (0)
#define PR_END(k) do { if (pr_me && ((PROBE_MASK >> (k)) & 1ull)) pr_acc += __builtin_amdgcn_s_memrealtime() - pr_t0; } while (0)
#else
#define PR_BEGIN(k) do {} while (0)
#define PR_END(k) do {} while (0)
#endif
#define SEAM(k) do { if (IN(k) && IN((k) + 1)) xcd_barrier(bar); PR_END(k); } while (0)
    PR_BEGIN(0); if (IN(0)) p0_prologue(F);
    SEAM(0);
#pragma unroll 1
    for (int ch = 0; ch < NCH; ++ch) {
        PR_BEGIN(1 + 2 * ch);
        if (IN(1 + 2 * ch)) {
            constexpr int NWG1 = (TC / 256) * (NIN / 256);
            const int nfull = NWG1 % F.G, bx = (int)blockIdx.x;
            if (ch > 0 && nfull == 0) p2_combine(F, ch - 1, F.vcu, F.G);
            p1_inproj(F, ch);
            if (ch > 0 && nfull != 0 && bx >= nfull) p2_combine(F, ch - 1, bx - nfull, F.G - nfull);
        }
        SEAM(1 + 2 * ch);
        PR_BEGIN(2 + 2 * ch); if (IN(2 + 2 * ch)) p2_attn(F, ch);
        SEAM(2 + 2 * ch);
    }
    PR_BEGIN(2 * NCH + 1); if (IN(2 * NCH + 1)) p2_combine(F, NCH - 1, F.vcu, F.G);
    SEAM(2 * NCH + 1);
    PR_BEGIN(2 * NCH + 2); if (IN(2 * NCH + 2)) p3_merge(F);
    SEAM(2 * NCH + 2);
    PR_BEGIN(2 * NCH + 3); if (IN(2 * NCH + 3)) p4_outproj(F);
    SEAM(2 * NCH + 3);
    PR_BEGIN(2 * NCH + 4); if (IN(2 * NCH + 4)) p5_route(F);
    SEAM(2 * NCH + 4);
    PR_BEGIN(2 * NCH + 5); if (IN(2 * NCH + 5)) p6a_gateup(F);
    SEAM(2 * NCH + 5);
    PR_BEGIN(2 * NCH + 6); if (IN(2 * NCH + 6)) p6b_down(F);
    SEAM(2 * NCH + 6);
    PR_BEGIN(2 * NCH + 7); if (IN(2 * NCH + 7)) p7_final(F);
    PR_END(2 * NCH + 7);
#ifdef PROBE_MASK
    if (pr_me) { const unsigned long long t1 = __builtin_amdgcn_s_memrealtime(); while (__builtin_amdgcn_s_memrealtime() - t1 < pr_acc) __builtin_amdgcn_s_sleep(4); }
#endif
#undef IN
#undef SEAM
}

#ifndef N_LAUNCHES
#define N_LAUNCHES 1
#endif
extern "C" void kernel_launch(void* const* d_in, const int* in_sizes, int n_in, void* d_out, int out_size, void* d_ws, size_t ws_size, hipStream_t stream) {
    static int grid = 0;
    if (grid == 0) {
        if (n_in != 17 || in_sizes[0] != T * D || out_size != T * D || ws_size < WS_END) { fprintf(stderr, "kernel_launch: unexpected shapes / workspace (%d inputs, ws %zu)\n", n_in, ws_size); grid = -1; return; }
        int dev = 0, cus = 0;
        if (hipGetDevice(&dev) != hipSuccess || hipDeviceGetAttribute(&cus, hipDeviceAttributeMultiprocessorCount, dev) != hipSuccess) { grid = -1; return; }
        if (hipFuncSetAttribute((const void*)fwd_kernel, hipFuncAttributeMaxDynamicSharedMemorySize, LDS_BYTES) != hipSuccess) { fprintf(stderr, "kernel_launch: hipFuncSetAttribute failed\n"); grid = -1; return; }
        int per_cu = 0;
        if (hipOccupancyMaxActiveBlocksPerMultiprocessor(&per_cu, (const void*)fwd_kernel, NTHR, LDS_BYTES) != hipSuccess || per_cu < 1) fprintf(stderr, "kernel_launch: occupancy query says %d\n", per_cu);
        (void)hipGetLastError();
        grid = cus;
    }
    if (grid < 0) return;
    (void)hipMemsetAsync((char*)d_ws + WS_CTL, 0, N_LAUNCHES == 1 ? (size_t)(CW_BAR + XCD_BAR_WORDS) * 4 : CTL_BYTES, stream);
    KArgs a{};
    for (int i = 0; i < 17; ++i) a.in[i] = (const float*)d_in[i];
    a.out = (float*)d_out; a.ws = (unsigned char*)d_ws;
    for (int li = 0; li < N_LAUNCHES; ++li) {
        a.ph_lo = (int)((long)NPHASE * li / N_LAUNCHES); a.ph_hi = (int)((long)NPHASE * (li + 1) / N_LAUNCHES); a.li = li;
        hipLaunchKernelGGL(fwd_kernel, dim3(grid), dim3(NTHR), LDS_BYTES, stream, a);
    }
}
```

```cpp
#include <hip/hip_runtime.h>
#include <cstdint>
#include <cstdio>

#define GAS __attribute__((address_space(1)))
#define LAS __attribute__((address_space(3)))
typedef unsigned short bf16;
typedef short bf16x8 __attribute__((ext_vector_type(8)));
typedef float f32x4 __attribute__((ext_vector_type(4)));
typedef unsigned v4u __attribute__((ext_vector_type(4)));
typedef unsigned v2u __attribute__((ext_vector_type(2)));
typedef GAS unsigned gu32;

constexpr int T = 32768, D = 1024, SEQ = 4096, NIN = 7936;
constexpr int A_W = 4608, B_W = 1280, G_W = 2048, Y_W = 1536;
constexpr int NE = 32, DE = 256;
constexpr int NCH = 4, TC = T / NCH;
constexpr float QSCALE = 0.125f * 1.4426950408889634f;
constexpr float LOG2E = 1.4426950408889634f;
constexpr float RMS_EPS = 1e-6f;
#ifndef P1_FP8
#define P1_FP8 1
#endif
constexpr float W8_SCALE = P1_FP8 ? 64.0f : 0.0f, W8_INV = P1_FP8 ? 1.0f / 64.0f : 1.0f;
#ifndef P6_FP8
#define P6_FP8 1
#endif
#ifndef P34_FP8
#define P34_FP8 1
#endif
constexpr float Y8_SCALE = 16.0f, W34_SCALE = 64.0f, MG8_SCALE = 32.0f;
#ifndef YS_FP8
#define YS_FP8 1
#endif
constexpr float YS8_SCALE = 16.0f;
constexpr float WG8_SCALE = P6_FP8 ? 64.0f : 0.0f, WD8_SCALE = P6_FP8 ? 32.0f : 0.0f, H8_SCALE = 32.0f;
constexpr int NWAVES = 8, NTHR = 512;

constexpr size_t MiB = 1u << 20;
constexpr size_t WS_CTL = 0, CTL_BYTES = 1 * MiB;
constexpr size_t WS_BIASP = ((size_t)1 << 20) + 4096;
constexpr size_t WS_INVF = 1 * MiB;
constexpr size_t WS_WRF = 2 * MiB;
constexpr size_t WS_TOKOF = 3 * MiB;
constexpr size_t WS_WTOF = 7 * MiB;
constexpr size_t WS_TPOS = 15 * MiB;
constexpr size_t WS_WIN = 16 * MiB;
constexpr size_t WS_WAB = 32 * MiB;
constexpr size_t WS_WO = 35 * MiB;
constexpr size_t WS_WGU = 37 * MiB;
constexpr size_t WS_WD = 69 * MiB;
constexpr size_t WS_G = 86 * MiB;
constexpr size_t WS_Y = 214 * MiB;
constexpr size_t WS_ZA = 310 * MiB;
constexpr size_t WS_ZB = 454 * MiB;
constexpr size_t WS_END = 494 * MiB;
constexpr size_t WS_MG = WS_ZA;
constexpr size_t WS_X1B = WS_ZA + 64 * MiB;
constexpr size_t WS_X1F8 = WS_Y + 64 * MiB;
constexpr size_t WS_HACT = WS_G;
constexpr size_t WS_YS = WS_G + 36 * MiB;
constexpr size_t DO_DELTA = 0;
constexpr size_t DO_HN = 0;
constexpr size_t DO_OG = 64 * MiB;
constexpr size_t DO_LSE = 112 * MiB;
constexpr int MAXSLOT = 2 * T + NE * 256;
static_assert(WS_ZA + (size_t)TC * A_W * 2 <= WS_ZB && WS_ZB + (size_t)TC * B_W * 2 <= WS_END && WS_Y + (size_t)T * Y_W * 2 <= WS_ZA && WS_G + (size_t)T * G_W * 2 <= WS_Y, "ws map");
static_assert(WS_MG + (size_t)T * D * 2 <= WS_END && WS_HACT + (size_t)MAXSLOT * DE * 2 <= WS_YS && WS_YS + (size_t)MAXSLOT * D * 2 <= WS_ZA && WS_X1B >= WS_MG + (size_t)T * D * 2 && WS_X1B + (size_t)T * D * 2 <= WS_ZB, "ws map");
static_assert(DO_OG + (size_t)3 * TC * 512 * 2 <= DO_LSE && DO_LSE + (size_t)3 * TC * 8 * 4 <= (size_t)T * D * 4 && DO_HN + (size_t)T * D * 2 <= DO_OG, "d_out scratch map");
constexpr int CW_CNT = 1024;
constexpr int CW_BAR = 4096;
constexpr int LDS_BYTES = 147456;
constexpr int LDS_MISC = 131072;

__device__ __forceinline__ unsigned f2bf(float f) { unsigned u = __builtin_bit_cast(unsigned, f); return (u + 0x7fffu + ((u >> 16) & 1u)) >> 16; }
__device__ __forceinline__ unsigned pk4_fp8(float a, float b, float c, float d) {
    a = __builtin_amdgcn_fmed3f(a, -448.f, 448.f); b = __builtin_amdgcn_fmed3f(b, -448.f, 448.f); c = __builtin_amdgcn_fmed3f(c, -448.f, 448.f); d = __builtin_amdgcn_fmed3f(d, -448.f, 448.f);
    int w = 0; w = __builtin_amdgcn_cvt_pk_fp8_f32(a, b, w, false); w = __builtin_amdgcn_cvt_pk_fp8_f32(c, d, w, true); return (unsigned)w; }
__device__ __forceinline__ unsigned pk2(float lo, float hi) { return f2bf(lo) | (f2bf(hi) << 16); }
__device__ __forceinline__ float bf2f(unsigned b) { return __builtin_bit_cast(float, b << 16); }
__device__ __forceinline__ float bflo(unsigned u) { return __builtin_bit_cast(float, u << 16); }
__device__ __forceinline__ float bfhi(unsigned u) { return __builtin_bit_cast(float, u & 0xffff0000u); }
__device__ __forceinline__ float wave_sum(float v) {
#pragma unroll
    for (int o = 1; o < 64; o <<= 1) v += __shfl_xor(v, o);
    return v;
}
__device__ __forceinline__ float wave_max(float v) {
#pragma unroll
    for (int o = 1; o < 64; o <<= 1) v = fmaxf(v, __shfl_xor(v, o));
    return v;
}
typedef float f32x2_t __attribute__((ext_vector_type(2)));
typedef __bf16 bf16x2_t __attribute__((ext_vector_type(2)));
__device__ __forceinline__ unsigned cvtpk(float lo, float hi) { f32x2_t v = {lo, hi}; bf16x2_t b = __builtin_convertvector(v, bf16x2_t); return __builtin_bit_cast(unsigned, b); }
#ifndef WT_STORES
#define WT_STORES 0
#endif
__device__ __forceinline__ __amdgpu_buffer_rsrc_t wt_rsrc(unsigned char* base) { return __builtin_amdgcn_make_buffer_rsrc(base, 0, 0x7ffffffc, 0x00020000); }
__device__ __forceinline__ void st16(__amdgpu_buffer_rsrc_t r, unsigned char* base, void* p, v4u v) { if (WT_STORES) __builtin_amdgcn_raw_buffer_store_b128(v, r, (unsigned)((unsigned char*)p - base), 0, 16); else *(GAS v4u*)p = v; }
__device__ __forceinline__ void st8(__amdgpu_buffer_rsrc_t r, unsigned char* base, void* p, v2u v) { if (WT_STORES) __builtin_amdgcn_raw_buffer_store_b64(v, r, (unsigned)((unsigned char*)p - base), 0, 16); else *(GAS v2u*)p = v; }
#define LDS_WAIT() asm volatile("s_waitcnt lgkmcnt(0)" ::: "memory")
#define VM_WAIT() asm volatile("s_waitcnt vmcnt(0)" ::: "memory")

#define XB_TMO      128
#define XB_XCNT(j)  (256  + 64 * (j))
#define XB_XSUB(j)  (1280 + 64 * (j))
#define XB_XGEN(j)  (2304 + 64 * (j))
#define XB_TOP      3328
#define XB_TOPGEN   3392
#define XCD_BAR_WORDS 3456
#define XB_SPIN_CAP (1u << 18)
__device__ __forceinline__ unsigned xb_ld(unsigned* p)              { return __hip_atomic_load(p, __ATOMIC_RELAXED, __HIP_MEMORY_SCOPE_AGENT); }
__device__ __forceinline__ unsigned xb_add(unsigned* p, unsigned v) { return __hip_atomic_fetch_add(p, v, __ATOMIC_RELAXED, __HIP_MEMORY_SCOPE_AGENT); }
__device__ __forceinline__ unsigned xb_xcc_id() { return (unsigned)__builtin_amdgcn_s_getreg((3 << 11) | 20) & 0xFu; }
#define XB_SPIN(cond, bar) do { unsigned _sp = 0; while (cond) { __builtin_amdgcn_s_sleep(1); \
    if ((++_sp & 255u) == 0u) { if (xb_ld(&(bar)[XB_TMO])) break; if (_sp > XB_SPIN_CAP) { atomicAdd(&(bar)[XB_TMO], 1u); break; } } } } while (0)
struct XcdBarrier { unsigned* bar; unsigned x; volatile LAS unsigned* st; };
__device__ __forceinline__ XcdBarrier xcd_barrier_post(unsigned* bar, volatile LAS unsigned* st) {
    XcdBarrier b; b.bar = bar; b.x = xb_xcc_id(); b.st = st;
    if (threadIdx.x == 0) (void)xb_add(&bar[XB_XCNT(b.x)], 1u);
    return b;
}
__device__ __forceinline__ void xcd_barrier_complete(unsigned* bar, unsigned x, unsigned& nloc, unsigned& nx) {
    const unsigned G = gridDim.x * gridDim.y * gridDim.z;
    unsigned sum, cnt, mine, sp = 0u;
    for (;;) {
        sum = 0u; cnt = 0u; mine = 0u;
#pragma unroll
        for (unsigned j = 0; j < 16; ++j) { const unsigned c = xb_ld(&bar[XB_XCNT(j)]); sum += c; cnt += (c > 0u) ? 1u : 0u; mine = (j == x) ? c : mine; }
        if (sum == G) break;
        __builtin_amdgcn_s_sleep(1);
        if ((++sp & 255u) == 0u) { if (xb_ld(&bar[XB_TMO])) break; if (sp > XB_SPIN_CAP) { atomicAdd(&bar[XB_TMO], 1u); break; } }
    }
    nloc = mine > 0u ? mine : 1u; nx = cnt > 0u ? cnt : 1u;
}
__device__ __forceinline__ void xcd_barrier(const XcdBarrier& b) {
    asm volatile("s_waitcnt vmcnt(0)" ::: "memory");
    __syncthreads();
    int t_ = threadIdx.x; asm volatile("" : "+v"(t_));
    if (t_ == 0) {
        unsigned* bar = b.bar;
        __builtin_amdgcn_s_waitcnt(0);
        unsigned nloc = b.st[0], nx = b.st[1];
        if (nloc == 0u) { xcd_barrier_complete(bar, b.x, nloc, nx); b.st[0] = nloc; b.st[1] = nx; }
        const unsigned old = xb_add(&bar[XB_XSUB(b.x)], 1u);
        const unsigned gen = old / nloc;
        if (old + 1u == (gen + 1u) * nloc) {
            __builtin_amdgcn_fence(__ATOMIC_RELEASE, "agent");
            asm volatile("s_waitcnt vmcnt(0)" ::: "memory");
            const unsigned og = xb_add(&bar[XB_TOP], 1u);
            const unsigned tg = og / nx;
            if (og + 1u == (tg + 1u) * nx) xb_add(&bar[XB_TOPGEN], 1u);
            else XB_SPIN(xb_ld(&bar[XB_TOPGEN]) == tg, bar);
            __builtin_amdgcn_fence(__ATOMIC_ACQUIRE, "agent");
            xb_add(&bar[XB_XGEN(b.x)], 1u);
            asm volatile("s_waitcnt vmcnt(0)" ::: "memory");
        } else {
            XB_SPIN(xb_ld(&bar[XB_XGEN(b.x)]) == gen, bar);
            __builtin_amdgcn_fence(__ATOMIC_ACQUIRE, "agent");
            asm volatile("s_waitcnt vmcnt(0)" ::: "memory");
        }
    }
    __syncthreads();
}

struct KArgs { const float* in[17]; float* out; unsigned char* ws; int ph_lo, ph_hi, li, pad; };
struct Frame {
    LAS unsigned char* lds;
    int tid, lane, wave, vcu, G;
    const float* in[17]; float* out; unsigned char* ws;
};
enum { I_X = 0, I_WIN, I_BIN, I_SINK, I_WPA, I_WPB, I_WOUT, I_GMIX, I_GFFN, I_WRG, I_BRG, I_WRE, I_BRE, I_WEG, I_WEU, I_WED, I_GFIN };

struct TrDesc { const float* W; int N; bf16* WT; int ldo, rowbase, koff, k0, n0; bool perm; const float* kscale; float f8scale; };
__device__ __forceinline__ void tr_load(const TrDesc& d, int lane, f32x4 (&tv)[8], float (&ks)[8]) {
    const float* src = d.W + (size_t)(d.k0 + (lane >> 3)) * d.N + d.n0 + 4 * (lane & 7);
#pragma unroll
    for (int i = 0; i < 8; ++i) tv[i] = *(const GAS f32x4*)(src + (size_t)(8 * i) * d.N);
#pragma unroll
    for (int i = 0; i < 8; ++i) ks[i] = d.kscale ? d.kscale[d.k0 + 8 * i + (lane >> 3)] : 1.0f;
}
__device__ __forceinline__ void tr_finish(const TrDesc& d, LAS float* scr, int lane, const f32x4 (&tv)[8], const float (&ks)[8]) {
#pragma unroll
    for (int i = 0; i < 8; ++i) { const int kk = 8 * i + (lane >> 3); LAS float* w = scr + kk * 33 + 4 * (lane & 7);
        w[0] = tv[i][0] * ks[i]; w[1] = tv[i][1] * ks[i]; w[2] = tv[i][2] * ks[i]; w[3] = tv[i][3] * ks[i]; }
    LDS_WAIT(); asm volatile("" ::: "memory");
    const int c = lane & 7;
#pragma unroll
    for (int j = 0; j < 4; ++j) { const int n = (lane >> 3) + 8 * j; const LAS float* s = scr + (8 * c) * 33 + n;
        const int rr = d.perm ? 8 * (n >> 2) + (n & 3) : n;
        if (d.f8scale != 0.f) { const float f = d.f8scale; v2u o8; o8.x = pk4_fp8(s[0 * 33] * f, s[1 * 33] * f, s[2 * 33] * f, s[3 * 33] * f); o8.y = pk4_fp8(s[4 * 33] * f, s[5 * 33] * f, s[6 * 33] * f, s[7 * 33] * f);
            *(GAS v2u*)((unsigned char*)d.WT + (size_t)(d.rowbase + rr) * d.ldo + d.koff + d.k0 + 8 * c) = o8; }
        else { v4u o; o.x = pk2(s[0 * 33], s[1 * 33]); o.y = pk2(s[2 * 33], s[3 * 33]); o.z = pk2(s[4 * 33], s[5 * 33]); o.w = pk2(s[6 * 33], s[7 * 33]);
            *(GAS v4u*)(d.WT + (size_t)(d.rowbase + rr) * d.ldo + d.koff + d.k0 + 8 * c) = o; } }
    LDS_WAIT(); asm volatile("" ::: "memory");
}
__device__ __forceinline__ void rms_row_to_bf16(const float* xrow, const float* g, bf16* orow, int lane) {
    const GAS f32x4* xr = (const GAS f32x4*)xrow + lane; const GAS f32x4* gr = (const GAS f32x4*)g + lane;
    f32x4 v[4]; float s = 0.f;
#pragma unroll
    for (int j = 0; j < 4; ++j) { v[j] = xr[64 * j]; s += (v[j].x * v[j].x + v[j].y * v[j].y) + (v[j].z * v[j].z + v[j].w * v[j].w); }
    const float rstd = 1.0f / sqrtf(wave_sum(s) * (1.f / D) + RMS_EPS);
    GAS v2u* o8 = (GAS v2u*)orow + lane;
#pragma unroll
    for (int j = 0; j < 4; ++j) { const f32x4 gg = gr[64 * j]; v2u w; w.x = pk2(v[j].x * rstd * gg.x, v[j].y * rstd * gg.y); w.y = pk2(v[j].z * rstd * gg.z, v[j].w * rstd * gg.w); o8[64 * j] = w; }
}
__device__ __forceinline__ void p0_prologue(Frame& F) {
    int tid_ = threadIdx.x; asm volatile("" : "+v"(tid_)); const int lane_ = tid_ & 63;
    LAS float* scr = (LAS float*)(F.lds + F.wave * 16384);
    const int gw = F.vcu * NWAVES + F.wave, NGW = F.G * NWAVES;
    unsigned char* ws = F.ws;
    constexpr int I_IN = 16 * 248, I_PA = 8 * 32, I_PB = 16 * 32, I_WO = 16 * 32, I_EG = 32 * 16 * 8, I_ED = 32 * 4 * 32;
    constexpr int NITEMS = I_IN + I_PA + I_PB + I_WO + 2 * I_EG + I_ED;
    auto decode = [&](int it, TrDesc& d) {
        int r = it; d.perm = false; d.kscale = nullptr; d.f8scale = 0.f; d.koff = 0;
        if (r < I_IN) { const int kb = r / 248, nb = r % 248, n0 = 32 * nb; const bool qk = (n0 < 3072) || (n0 >= A_W && n0 < A_W + 1152);
            const bool gt_ = n0 >= A_W + B_W; const int gc = n0 - (A_W + B_W);
            d.W = F.in[I_WIN]; d.N = NIN; d.WT = (bf16*)(ws + WS_WIN); d.ldo = 1024; d.rowbase = qk ? (n0 & ~63) + ((n0 >> 5) & 1) * 4 : (gt_ ? A_W + B_W + 2 * (gc % 1024) + 4 * (gc / 1024) : n0); d.k0 = 64 * kb; d.n0 = n0; d.perm = qk || gt_; d.f8scale = W8_SCALE; return; } r -= I_IN;
        if (r < I_PA) { const int kb = r / 32, nb = r % 32; d.W = F.in[I_WPA]; d.N = 1024; d.WT = (bf16*)(ws + WS_WAB); d.ldo = 1536; d.rowbase = 32 * nb; d.k0 = 64 * kb; d.n0 = 32 * nb; if (P34_FP8) d.f8scale = W34_SCALE; return; } r -= I_PA;
        if (r < I_PB) { const int kb = r / 32, nb = r % 32; d.W = F.in[I_WPB]; d.N = 1024; d.WT = (bf16*)(ws + WS_WAB); d.ldo = 1536; d.rowbase = 32 * nb; d.koff = 512; d.k0 = 64 * kb; d.n0 = 32 * nb; if (P34_FP8) d.f8scale = W34_SCALE; return; } r -= I_PB;
        if (r < I_WO) { const int kb = r / 32, nb = r % 32; d.W = F.in[I_WOUT]; d.N = 1024; d.WT = (bf16*)(ws + WS_WO); d.ldo = 1024; d.rowbase = 32 * nb; d.k0 = 64 * kb; d.n0 = 32 * nb; if (P34_FP8) d.f8scale = W34_SCALE; return; } r -= I_WO;
        if (r < 2 * I_EG) { const int up = r >= I_EG; if (up) r -= I_EG; const int e = r / 128, q = r % 128, kb = q / 8, nb = q % 8;
            d.W = F.in[up ? I_WEU : I_WEG] + (size_t)e * 1024 * 256; d.N = 256; d.WT = (bf16*)(ws + WS_WGU) + (size_t)e * 512 * 1024; d.ldo = 1024; d.rowbase = 64 * nb + (up ? 4 : 0); d.k0 = 64 * kb; d.n0 = 32 * nb; d.perm = true; d.kscale = F.in[I_GFFN]; d.f8scale = WG8_SCALE; if (P6_FP8) d.WT = (bf16*)((unsigned char*)(ws + WS_WGU) + (size_t)e * 512 * 1024); return; } r -= 2 * I_EG;
        { const int e = r / 128, q = r % 128, kb = q / 32, nb = q % 32;
            d.W = F.in[I_WED] + (size_t)e * 256 * 1024; d.N = 1024; d.WT = (bf16*)(ws + WS_WD) + (size_t)e * 1024 * 256; d.ldo = 256; d.rowbase = 32 * nb; d.k0 = 64 * kb; d.n0 = 32 * nb; d.f8scale = WD8_SCALE; if (P6_FP8) d.WT = (bf16*)((unsigned char*)(ws + WS_WD) + (size_t)e * 1024 * 256); }
    };
    {
        int it = gw; TrDesc dc, dn; f32x4 tc[8], tn[8]; float kc[8], kn[8];
        bool hc = it < NITEMS; if (hc) { decode(it, dc); tr_load(dc, lane_, tc, kc); }
        while (hc) {
            it += NGW; const bool hn = it < NITEMS;
            if (hn) { decode(it, dn); tr_load(dn, lane_, tn, kn); }
            tr_finish(dc, scr, lane_, tc, kc);
            hc = hn; dc = dn;
#pragma unroll
            for (int i = 0; i < 8; ++i) { tc[i] = tn[i]; kc[i] = kn[i]; }
        }
    }
    for (int m = gw; m < T; m += 4 * NGW) {
        const GAS f32x4* gr = (const GAS f32x4*)F.in[I_GMIX] + lane_;
        f32x4 v[4][4]; float ss[4];
#pragma unroll
        for (int r = 0; r < 4; ++r) { const int mr = (m + r * NGW < T) ? m + r * NGW : m; const GAS f32x4* xr = (const GAS f32x4*)(F.in[I_X] + (size_t)mr * D) + lane_;
#pragma unroll
            for (int j = 0; j < 4; ++j) v[r][j] = xr[64 * j]; }
#pragma unroll
        for (int r = 0; r < 4; ++r) { float a = 0.f;
#pragma unroll
            for (int j = 0; j < 4; ++j) a += (v[r][j].x * v[r][j].x + v[r][j].y * v[r][j].y) + (v[r][j].z * v[r][j].z + v[r][j].w * v[r][j].w);
            ss[r] = 1.0f / sqrtf(wave_sum(a) * (1.f / D) + RMS_EPS); }
#pragma unroll
        for (int r = 0; r < 4; ++r) { if (m + r * NGW >= T) continue; GAS unsigned* o4 = (GAS unsigned*)((unsigned char*)F.out + DO_HN + (size_t)(m + r * NGW) * D) + lane_;
#pragma unroll
            for (int j = 0; j < 4; ++j) { const f32x4 gg = gr[64 * j];
                if (P1_FP8) o4[64 * j] = pk4_fp8(v[r][j].x * ss[r] * gg.x, v[r][j].y * ss[r] * gg.y, v[r][j].z * ss[r] * gg.z, v[r][j].w * ss[r] * gg.w);
                else { v2u w; w.x = cvtpk(v[r][j].x * ss[r] * gg.x, v[r][j].y * ss[r] * gg.y); w.y = cvtpk(v[r][j].z * ss[r] * gg.z, v[r][j].w * ss[r] * gg.w); ((GAS v2u*)((unsigned char*)F.out + DO_HN + (size_t)(m + r * NGW) * D * 2) + lane_)[64 * j] = w; } } }
    }
    const int gt = F.vcu * NTHR + tid_, NGT = F.G * NTHR;
    if (gt < 32) ((float*)(ws + WS_INVF))[gt] = (float)exp2(-(double)gt * (13.287712379549449 / 32.0));
    for (int c = gt; c < NIN; c += NGT) {
        int s = c; const int e = c & 7;
        if (c < 3072 || (c >= A_W && c < A_W + 1152)) s = (c & ~63) + 4 * ((c & 63) >> 3) + (e < 4 ? e : 28 + e);
        else if (c >= A_W + B_W) s = A_W + B_W + 4 * ((c - A_W - B_W) >> 3) + (e < 4 ? e : 1020 + e);
        ((float*)(ws + WS_BIASP))[c] = F.in[I_BIN][s];
    }
    for (int i = gt; i < 32 * 3 * 64; i += NGT) {
        const int ln = i & 63, nb = (i >> 6) % 3, ks = i / 192;
        const int n = 16 * nb + (ln & 15);
        float hi[8], lo[8];
#pragma unroll
        for (int e = 0; e < 8; ++e) { const int k = 32 * ks + 8 * (ln >> 4) + e; float v = 0.f;
            if (n < 4) v = F.in[I_WRG][k * 4 + n]; else if (n < 36) v = F.in[I_WRE][k * 32 + (n - 4)];
            v *= F.in[I_GFFN][k]; hi[e] = bf2f(f2bf(v)); lo[e] = v - hi[e]; }
        v4u h, l; h.x = pk2(hi[0], hi[1]); h.y = pk2(hi[2], hi[3]); h.z = pk2(hi[4], hi[5]); h.w = pk2(hi[6], hi[7]);
        l.x = pk2(lo[0], lo[1]); l.y = pk2(lo[2], lo[3]); l.z = pk2(lo[4], lo[5]); l.w = pk2(lo[6], lo[7]);
        ((v4u*)(ws + WS_WRF))[((ks * 3 + nb) * 2 + 0) * 64 + ln] = h; ((v4u*)(ws + WS_WRF))[((ks * 3 + nb) * 2 + 1) * 64 + ln] = l;
    }
}

namespace pg8 {
#define PG8_LAS __attribute__((address_space(3)))
typedef unsigned short bf16_t;
typedef short bf16x8 __attribute__((ext_vector_type(8)));
typedef float f32x4 __attribute__((ext_vector_type(4)));
typedef unsigned u32x4 __attribute__((ext_vector_type(4)));
constexpr int BM = 256, BK = 64, HALF = 128, HTB = HALF * BK * 2  , STAGE_BYTES = 8 * HTB, NXCD = 8, WGM = 8;

__host__ __device__ __forceinline__ int lds_byte(int r, int c) { const int st = (r >> 4) * 2 + (c >> 5), rr = r & 15, cc = c & 31, ob = rr * 64 + cc * 2; return st * 1024 + (ob ^ (((ob >> 9) & 1) << 5)); }
__host__ __device__ __forceinline__ void stage_rc(int b, int& R, int& C) { const int st = b / 1024, sb = b % 1024, swz = sb ^ (((sb >> 9) & 1) << 5); R = (st >> 1) * 16 + swz / 64; C = (st & 1) * 32 + (swz % 64) / 2; }
__host__ __device__ __forceinline__ int perm32(int rho) { const int n = rho >> 4, i = rho & 15; return 8 * (i >> 2) + 4 * n + (i & 3); }

struct Unit { int pm, pn; };
struct Gemm { const bf16_t* A; const bf16_t* Bt; int M, N, K; };

struct StaticOrder {
    int nM, nN, nwg, G, c;
    __host__ __device__ void init(int M, int N, int G_, int c_) { nM = M / BM; nN = N / BM; nwg = nM * nN; G = G_; c = c_; }
    __host__ __device__ bool next(int i, Unit& u) const {
        const long L = (long)i * G + c; if (L >= nwg) return false;
        int wgid = (int)L; { const int q = nwg / NXCD, r = nwg % NXCD, xcd = wgid % NXCD, off = wgid / NXCD; wgid = (xcd < r ? xcd * (q + 1) : r * (q + 1) + (xcd - r) * q) + off; }
        const int nig = WGM * nN, gid = wgid / nig, fm = gid * WGM, gsz = (nM - fm) < WGM ? (nM - fm) : WGM;
        u.pm = fm + ((wgid % nig) % gsz); u.pn = (wgid % nig) / gsz; return true;
    }
    __device__ __forceinline__ void a_ready(const Unit&) const {}
    __device__ __forceinline__ void done(const Unit&) const {}
};
}


namespace pg9 {
using pg8::BM; using pg8::BK; using pg8::HALF; using pg8::HTB; using pg8::lds_byte; using pg8::stage_rc; using pg8::perm32;
struct Unit { int pm, pn, e; };
typedef int v8i_t __attribute__((ext_vector_type(8)));
typedef int v4i_t __attribute__((ext_vector_type(4)));
template <int ESZ, class Epi, class Sched, class AOff, class BBase>
__device__ __forceinline__ void gemm_phase(LAS unsigned char* lds, const char* Abase, int K, const Sched& S, const Epi& E, const AOff& aoffn, const BBase& bbase) {
    int tid_ = threadIdx.x; asm volatile("" : "+v"(tid_));
    const int tid = tid_, wid = __builtin_amdgcn_readfirstlane(tid >> 6), lane = tid & 63, wr = wid >> 2, wc = wid & 3, fr = lane & 15, fq = lane >> 4;
    const int nt = K * ESZ / (BK * 2);
    int Rr[2], Cc[2]; unsigned voffB[2];
#pragma unroll
    for (int i = 0; i < 2; ++i) { int R, C; stage_rc(tid * 16 + i * 8192, R, C); const int Rb = Epi::PERM ? ((R & ~31) + perm32(R & 31)) : R; Rr[i] = R; Cc[i] = C; voffB[i] = (unsigned)(Rb * K * ESZ + C * 2); }
    const size_t kstep = (size_t)(BK * 2);
    const size_t hstep = (size_t)HALF * K * ESZ;
    const unsigned ldsw = (unsigned)wid * 1024u;
    const int aoff = lds_byte(wr * 64 + fr, fq * 8), boff = lds_byte(wc * 32 + fr, fq * 8);
#define PG9_SA(b, h) (((b) * 2 + (h)) * HTB)
#define PG9_SB(b, h) ((4 + (b) * 2 + (h)) * HTB)
#define PG9_STAGE(bufoff, gbase, voff) do { _Pragma("unroll") for (int _i = 0; _i < 2; ++_i) \
        __builtin_amdgcn_global_load_lds((const unsigned*)((const char*)(gbase) + (voff)[_i]), (LAS unsigned*)(lds + (bufoff) + ldsw + _i * 8192), 16, 0, 0); } while (0)
#define PG9_LDA(dst, b, h) do { _Pragma("unroll") for (int m = 0; m < 4; ++m) { dst[m].lo = *(const LAS v4i_t*)(lds + PG9_SA(b, h) + aoff + m * 2048); dst[m].hi = *(const LAS v4i_t*)(lds + PG9_SA(b, h) + aoff + m * 2048 + 1024); } } while (0)
#define PG9_LDB(dst, b, h) do { _Pragma("unroll") for (int n = 0; n < 2; ++n) { dst[n].lo = *(const LAS v4i_t*)(lds + PG9_SB(b, h) + boff + n * 2048); dst[n].hi = *(const LAS v4i_t*)(lds + PG9_SB(b, h) + boff + n * 2048 + 1024); } } while (0)
#define PG9_HALF(v, o) __builtin_bit_cast(bf16x8, __builtin_shufflevector((v), (v), (o), (o) + 1, (o) + 2, (o) + 3))
#define PG9_MMA(ai, bj, At, Bt) do { __builtin_amdgcn_s_setprio(1); _Pragma("unroll") for (int m = 0; m < 4; ++m) _Pragma("unroll") for (int n = 0; n < 2; ++n) { \
        if (ESZ == 2) { acc[ai][bj][m][n] = __builtin_amdgcn_mfma_f32_16x16x32_bf16(PG9_HALF(Bt[n], 0), PG9_HALF(At[m], 0), acc[ai][bj][m][n], 0, 0, 0); \
                        acc[ai][bj][m][n] = __builtin_amdgcn_mfma_f32_16x16x32_bf16(PG9_HALF(Bt[n], 4), PG9_HALF(At[m], 4), acc[ai][bj][m][n], 0, 0, 0); } \
        else { asm volatile("v_mfma_scale_f32_16x16x128_f8f6f4 %0, %1, %2, %0, %3, %3 op_sel_hi:[0,0,0]" : "+v"(acc[ai][bj][m][n]) : "v"(Bt[n]), "v"(At[m]), "v"(one8)); } } \
        __builtin_amdgcn_s_setprio(0); } while (0)
#define PG9_WAIT_V(n) asm volatile("s_waitcnt vmcnt(" #n ")" ::: "memory")
#define PG9_WAIT_L(n) asm volatile("s_waitcnt lgkmcnt(" #n ")" ::: "memory")
#define PG9_BAR __builtin_amdgcn_s_barrier()
#define PG9_SCHED __builtin_amdgcn_sched_barrier(0)
#define PG9_VA(dst, u) do { _Pragma("unroll") for (int _h = 0; _h < 2; ++_h) _Pragma("unroll") for (int _i = 0; _i < 2; ++_i) dst[_h][_i] = aoffn((u), _h * HALF + Rr[_i]) + (unsigned)(Cc[_i] * 2); } while (0)
    constexpr bool GATHER = AOff::GATHER;
    const size_t hstepA = (size_t)HALF * aoffn.rowbytes;
    unsigned voffA[2];
#pragma unroll
    for (int i = 0; i < 2; ++i) voffA[i] = (unsigned)Rr[i] * aoffn.rowbytes + (unsigned)(Cc[i] * 2);
#define PG9_STAGE_A(bufoff, h, koff, nx) do { if (GATHER) { PG9_STAGE(bufoff, Abase + (koff), ((nx) ? nvA[h] : cvA[h])); } else { PG9_STAGE(bufoff, ((nx) ? nAu : cAu) + (h) * hstepA + (koff), voffA); } } while (0)
    Unit cur, nxt; int ui = 0;
    if (!S.next(0, cur)) return;
    f32x4 acc[2][2][4][2];
#pragma unroll
    for (int a = 0; a < 2; ++a)
#pragma unroll
        for (int b = 0; b < 2; ++b)
#pragma unroll
            for (int m = 0; m < 4; ++m)
#pragma unroll
                for (int n = 0; n < 2; ++n) acc[a][b][m][n] = (f32x4){0.f, 0.f, 0.f, 0.f};
    int one8 = 0x7f7f7f7f; asm volatile("" : "+v"(one8));
    v8i_t At[4], B0[2], B1[2];
    unsigned cvA[2][2], nvA[2][2];
    if (GATHER) { PG9_VA(cvA, cur); }
    const char* cAu = GATHER ? Abase : Abase + (size_t)aoffn(cur, 0); const char* nAu = cAu;
    const char* cB = bbase(cur);
    E.prefetch(lds, cur, 0, wid, lane);
    PG9_STAGE(PG9_SB(0, 0), cB, voffB); PG9_STAGE(PG9_SB(0, 1), cB + hstep, voffB); PG9_STAGE_A(PG9_SA(0, 0), 0, 0, false); PG9_STAGE_A(PG9_SA(0, 1), 1, 0, false);
    if (wr == 1) PG9_BAR;
    PG9_WAIT_V(2); PG9_BAR;
    PG9_STAGE(PG9_SB(1, 0), cB + kstep, voffB); PG9_STAGE_A(PG9_SA(1, 0), 0, kstep, false); PG9_STAGE(PG9_SB(1, 1), cB + hstep + kstep, voffB);
    PG9_WAIT_V(6); PG9_BAR;
    for (;;) {
        const bool has_next = S.next(ui + 1, nxt);
        if (GATHER) {
            if (has_next) { PG9_VA(nvA, nxt); } else {
#pragma unroll
                for (int _h = 0; _h < 2; ++_h)
#pragma unroll
                    for (int _i = 0; _i < 2; ++_i) nvA[_h][_i] = cvA[_h][_i]; }
        } else nAu = has_next ? Abase + (size_t)aoffn(nxt, 0) : cAu;
        const char* nB = has_next ? bbase(nxt) : cB;
#pragma unroll 1
        for (int t = 0; t < nt; t += 2) {
            const bool last = (t == nt - 2);
            if (Epi::HOOK_T >= 0) { if (t == Epi::HOOK_T) E.hook(acc, cur, wr, wc, fr, fq); }
            const size_t k1 = (size_t)(t + 1) * kstep, k2 = last ? 0 : (size_t)(t + 2) * kstep, k3 = k2 + kstep;
            const char* b2 = last ? nB : cB + (size_t)(t + 2) * kstep; const char* b3 = b2 + kstep;
            PG9_LDB(B0, 0, 0); PG9_LDB(B1, 0, 1); PG9_SCHED; PG9_LDA(At, 0, 0); PG9_STAGE_A(PG9_SA(1, 1), 1, k1, false);
            PG9_WAIT_V(8); PG9_WAIT_L(0); PG9_BAR; PG9_MMA(0, 0, At, B0); PG9_MMA(0, 1, At, B1); PG9_BAR; PG9_SCHED;
            PG9_LDA(At, 0, 1); PG9_STAGE(PG9_SB(0, 0), b2, voffB); PG9_STAGE(PG9_SB(0, 1), b2 + hstep, voffB); PG9_STAGE_A(PG9_SA(0, 0), 0, k2, last);
            PG9_WAIT_V(8); PG9_WAIT_L(0); PG9_BAR; PG9_MMA(1, 0, At, B0); PG9_MMA(1, 1, At, B1); PG9_BAR; PG9_SCHED;
            PG9_LDB(B0, 1, 0); PG9_LDB(B1, 1, 1); PG9_SCHED; PG9_LDA(At, 1, 0); PG9_STAGE_A(PG9_SA(0, 1), 1, k2, last);
            PG9_WAIT_V(8); PG9_WAIT_L(0); PG9_BAR; PG9_MMA(0, 0, At, B0); PG9_MMA(0, 1, At, B1); PG9_BAR; PG9_SCHED;
            PG9_LDA(At, 1, 1); PG9_STAGE(PG9_SB(1, 0), b3, voffB); PG9_STAGE(PG9_SB(1, 1), b3 + hstep, voffB); PG9_STAGE_A(PG9_SA(1, 0), 0, k3, last);
            PG9_WAIT_V(8); PG9_WAIT_L(0); PG9_BAR; PG9_MMA(1, 0, At, B0); PG9_MMA(1, 1, At, B1); PG9_BAR; PG9_SCHED;
        }
        if (wr == 0) PG9_BAR;
        if (ESZ == 1) asm volatile("s_nop 15\n\ts_nop 15" ::: "memory");
        E(acc, cur, ui, wr, wc, fr, fq);
        if (!has_next) break;
#pragma unroll
        for (int a = 0; a < 2; ++a)
#pragma unroll
            for (int b = 0; b < 2; ++b)
#pragma unroll
                for (int m = 0; m < 4; ++m)
#pragma unroll
                    for (int n = 0; n < 2; ++n) acc[a][b][m][n] = (f32x4){0.f, 0.f, 0.f, 0.f};
        cur = nxt; cB = nB; cAu = nAu; ++ui;
        E.prefetch(lds, cur, ui, wid, lane);
        if (GATHER) {
#pragma unroll
            for (int _h = 0; _h < 2; ++_h)
#pragma unroll
                for (int _i = 0; _i < 2; ++_i) cvA[_h][_i] = nvA[_h][_i]; }
        if (wr == 1) PG9_BAR;
    }
    PG9_WAIT_V(0);
    PG9_BAR;
#undef PG9_SA
#undef PG9_SB
#undef PG9_STAGE
#undef PG9_LDA
#undef PG9_LDB
#undef PG9_MMA
#undef PG9_HALF
#undef PG9_WAIT_V
#undef PG9_WAIT_L
#undef PG9_BAR
#undef PG9_SCHED
#undef PG9_VA
#undef PG9_STAGE_A
}
struct DenseOrder { pg8::StaticOrder so;
    __device__ void init(int M, int N, int G, int c) { so.init(M, N, G, c); }
    __device__ bool next(int i, Unit& u) const { pg8::Unit v; if (!so.next(i, v)) return false; u.pm = v.pm; u.pn = v.pn; u.e = 0; return true; } };
struct DenseA { static constexpr bool GATHER = false; unsigned rowbytes; __device__ __forceinline__ unsigned operator()(const Unit& u, int row) const { return (unsigned)(u.pm * 256 + row) * rowbytes; } };
struct DenseB { const char* Bt; size_t tilebytes; __device__ __forceinline__ const char* operator()(const Unit& u) const { return Bt + (size_t)u.pn * tilebytes; } };
}

struct EpiInproj {
    static constexpr bool PERM = true; static constexpr int HOOK_T = -1;
    bf16* ZA; bf16* ZB; bf16* Gt; const float* biasP; LAS unsigned char* ldsb;
    __device__ __forceinline__ void hook(f32x4 (&)[2][2][4][2], const pg9::Unit&, int, int, int, int) const {}
    __device__ __forceinline__ void prefetch(LAS unsigned char* lds, const pg9::Unit& u, int ui, int wid, int lane) const {
        if (wid == 0) __builtin_amdgcn_global_load_lds((const unsigned*)(biasP + u.pn * 256 + lane * 4), (LAS unsigned*)(lds + LDS_MISC + 4096 + (ui & 1) * 1024), 16, 0, 0);
    }
    __device__ __forceinline__ void operator()(const f32x4 (&acc)[2][2][4][2], const pg9::Unit& u, int ui, int wr, int wc, int fr, int fq) const {
        asm volatile("" : "+v"(fr), "+v"(fq));
        const int row0 = u.pm * 256 + wr * 64 + fr;
        const int q = 4 * (wc & 1) + fq;
        const int fr2 = (fr >> 2) + 4 * fq, fq2 = fr & 3, paddr = 4 * (16 * (fr & 3) + 4 * fq + (fr >> 2));
        const int row0s = u.pm * 256 + wr * 64 + fr2;
        int kind[2]; bf16* dst[2]; int ldd[2]; f32x4 b0[2], b1[2];
#pragma unroll
        for (int bj = 0; bj < 2; ++bj) {
            const int colpos = u.pn * 256 + bj * 128 + wc * 32 + 8 * fq, colposs = u.pn * 256 + bj * 128 + wc * 32 + 8 * fq2, hb = u.pn * 256 + bj * 128 + (wc >> 1) * 64;
            if (hb < A_W) { const int hbi = hb >> 6; kind[bj] = hb / 1536; dst[bj] = ZA + (size_t)hbi * (TC * 64) + (colposs - hb); ldd[bj] = 2 * ((hbi % 24) >> 3); }
            else if (hb < A_W + B_W) { const int cb = hb - A_W; kind[bj] = cb < 1024 ? 0 : (cb < 1152 ? 1 : 2); dst[bj] = ZB + (size_t)(cb >> 6) * (TC * 64) + (colposs - hb); ldd[bj] = 0; }
            else { kind[bj] = 3; const int c0 = (colpos - A_W - B_W) >> 1;
                dst[bj] = Gt + ((size_t)((u.pm * 256 + wr * 64) >> 4) * 256 + (c0 >> 3)) * 128 + fr * 8 + (c0 & 7); ldd[bj] = 0; }
            const LAS float* bs = (const LAS float*)(ldsb + LDS_MISC + 4096 + (ui & 1) * 1024) + bj * 128 + wc * 32 + 8 * fq;
            b0[bj] = *(const LAS f32x4*)bs; b1[bj] = *(const LAS f32x4*)(bs + 4);
        }
        const bool need_rope = kind[0] < 2 || kind[1] < 2;
        const f32x4 fv = *(const LAS f32x4*)(ldsb + LDS_MISC + 6144 + 16 * q);
#pragma unroll
        for (int ai = 0; ai < 2; ++ai) {
            f32x4 rc[4], rs[4];
#pragma unroll
            for (int m = 0; m < 4; ++m) { rc[m] = (f32x4){1.f, 1.f, 1.f, 1.f}; rs[m] = (f32x4){0.f, 0.f, 0.f, 0.f}; }
            if (need_rope) {
#pragma unroll
                for (int m = 0; m < 4; ++m) { const float posf = (float)((row0 + ai * 128 + m * 16) & (SEQ - 1));
#pragma unroll
                    for (int e = 0; e < 4; ++e) { const float ang = posf * fv[e]; const float pr = ang * 0.15915494f; const float er = __builtin_fmaf(ang, 0.15915494f, -pr) + ang * 6.4206382e-9f;
                        const float fr = __builtin_amdgcn_fractf(pr) + er; rc[m][e] = __builtin_amdgcn_cosf(fr); rs[m][e] = __builtin_amdgcn_sinf(fr); } }
            }
#pragma unroll
            for (int bj = 0; bj < 2; ++bj) {
                const int sh = ldd[bj], posr = row0s & (SEQ - 1), ridx = (row0s & ~(SEQ - 1)) + ((posr & ((1 << sh) - 1)) << (12 - sh)) + (posr >> sh);
                bf16* p = dst[bj] + (size_t)(ridx + ai * (128 >> sh)) * 64; const unsigned step = (unsigned)((16 >> sh) * 64);
                if (kind[bj] == 3) p = dst[bj] + (size_t)(ai * 8) * 32768;
                switch (kind[bj]) {
                    case 0: store4<0>(acc[ai][bj], b0[bj], b1[bj], rc, rs, p, step, paddr); break;
                    case 1: store4<1>(acc[ai][bj], b0[bj], b1[bj], rc, rs, p, step, paddr); break;
                    case 2: store4<2>(acc[ai][bj], b0[bj], b1[bj], rc, rs, p, step, paddr); break;
                    default: store4<3>(acc[ai][bj], b0[bj], b1[bj], rc, rs, p, step, paddr); break;
                }
            }
        }
    }
    template <int KIND> static __device__ __forceinline__ void store4(const f32x4 (&a)[4][2], const f32x4 b0, const f32x4 b1, const f32x4 (&rc)[4], const f32x4 (&rs)[4], bf16* p, const unsigned step, const int paddr) {
#pragma unroll
        for (int m = 0; m < 4; ++m) {
            f32x4 v0 = a[m][0] * W8_INV + b0, v1 = a[m][1] * W8_INV + b1;
            if (KIND < 2) {
                const f32x4 cc = rc[m], ss = rs[m];
                const f32x4 t0 = v0 * cc - v1 * ss, t1 = v1 * cc + v0 * ss;
                v0 = t0; v1 = t1;
                if (KIND == 0) { v0 = v0 * QSCALE; v1 = v1 * QSCALE; }
            }
            if (KIND == 3) {
#pragma unroll
                for (int e = 0; e < 4; ++e) { const float d0 = 1.0f + __expf(-v0[e]), d1 = 1.0f + __expf(-v1[e]); v0[e] = d1 * __builtin_amdgcn_rcpf(d0); v1[e] = __builtin_amdgcn_rcpf(d1); }
                v2u w0, w1; w0.x = cvtpk(v0[0], v0[1]); w0.y = cvtpk(v0[2], v0[3]); w1.x = cvtpk(v1[0], v1[1]); w1.y = cvtpk(v1[2], v1[3]);
                *(GAS v2u*)p = w0; *(GAS v2u*)(p + 128 * 128) = w1; p += 32768;
            } else {
                v4u w; w.x = cvtpk(v0[0], v0[1]); w.y = cvtpk(v0[2], v0[3]); w.z = cvtpk(v1[0], v1[1]); w.w = cvtpk(v1[2], v1[3]);
                w.x = (unsigned)__builtin_amdgcn_ds_bpermute(paddr, (int)w.x); w.y = (unsigned)__builtin_amdgcn_ds_bpermute(paddr, (int)w.y); w.z = (unsigned)__builtin_amdgcn_ds_bpermute(paddr, (int)w.z); w.w = (unsigned)__builtin_amdgcn_ds_bpermute(paddr, (int)w.w);
                *(GAS v4u*)p = w; p += step;
            }
        }
    }
};
__device__ __forceinline__ void p1_inproj(Frame& F, int ch) {
    unsigned char* ws = F.ws;
    pg9::DenseOrder S; S.init(TC, NIN, F.G, (int)blockIdx.x);
    EpiInproj E{(bf16*)(ws + WS_ZA), (bf16*)(ws + WS_ZB), (bf16*)(ws + WS_G) + (size_t)ch * TC * G_W, (const float*)(ws + WS_BIASP), F.lds};
    { int t_ = threadIdx.x; asm volatile("" : "+v"(t_)); if (t_ < 32) ((LAS float*)(F.lds + LDS_MISC + 6144))[t_] = ((const float*)(ws + WS_INVF))[t_]; }
    constexpr int ES = P1_FP8 ? 1 : 2;
    pg9::DenseA ao{(unsigned)(D * ES)}; pg9::DenseB bb{(const char*)(ws + WS_WIN), (size_t)256 * D * ES};
    pg9::gemm_phase<ES>(F.lds, (const char*)F.out + DO_HN + (size_t)ch * TC * D * ES, D, S, E, ao, bb);
}

typedef float f32x16 __attribute__((ext_vector_type(16)));
typedef short v4i16_t __attribute__((ext_vector_type(4)));
__device__ __forceinline__ float half_max(float v) { auto rr = __builtin_amdgcn_permlane32_swap(__float_as_uint(v), __float_as_uint(v), false, false); return fmaxf(__uint_as_float(rr[0]), __uint_as_float(rr[1])); }
__device__ __forceinline__ float half_sum(float v) { auto rr = __builtin_amdgcn_permlane32_swap(__float_as_uint(v), __float_as_uint(v), false, false); return __uint_as_float(rr[0]) + __uint_as_float(rr[1]); }
__device__ __forceinline__ float max3f(float a, float b, float c) { float r; asm("v_max3_f32 %0, %1, %2, %3" : "=v"(r) : "v"(a), "v"(b), "v"(c)); return r; }
constexpr int ATT_VOFF = 49152;

struct AUnit { const bf16 *Kw, *Vw, *Qp; size_t pitch; int kk_lo, nkeys, kb0, kstart, lo; float m0; bf16* Op; long ostr; float* Lp; int o8; };
__device__ __forceinline__ void attn_decode(Frame& F, int ch, int u, int NUA, int lane, AUnit& d) {
    unsigned char* ws = F.ws;
    const int w = F.wave, c = lane & 31, h = (lane >> 5) & 1;
    if (u < NUA) {
        const bf16* ZA = (const bf16*)(ws + WS_ZA);
        const int rt = u & 15, hh = (u >> 4) & 7, gb = u >> 7, g = gb % 3, bl = gb / 3;
        const int dsh = 2 * g, dd = 1 << dsh, tsh = 4 - dsh;
        const int r = rt >> tsh, tile = rt & ((1 << tsh) - 1), i0 = tile * 256;
        const int rowb = bl * SEQ + r;
        d.pitch = 64;
        const int sl = g * 8 + hh; const long rb = (long)bl * SEQ + ((long)r << (12 - dsh));
        d.Kw = ZA + ((long)(24 + sl) * TC + rb + (i0 - 128)) * 64; d.Vw = ZA + ((long)(48 + sl) * TC + rb + (i0 - 128)) * 64;
        const long qrow = (long)rowb + (long)dd * (i0 + 32 * w + c);
        d.Qp = ZA + ((long)sl * TC + rb + i0 + 32 * w + c) * 64;
        d.kk_lo = (i0 == 0) ? 128 : 0; d.nkeys = 384; d.kb0 = w; d.kstart = (i0 == 0) ? (w < 4 ? 4 - w : 0) : 0; d.lo = 0;
        d.m0 = -1e30f;
        d.Op = (bf16*)((unsigned char*)F.out + DO_OG) + ((size_t)g * TC + (qrow - (long)dd * c)) * 512 + hh * 64; d.ostr = (long)dd * 1024;
        d.Lp = (float*)((unsigned char*)F.out + DO_LSE) + ((size_t)g * TC + qrow) * 8 + hh;
        d.o8 = 0;
    } else {
        const int u2 = u - NUA;
        const bf16* ZB = (const bf16*)(ws + WS_ZB);
        const int blk = u2 & 127, kvh = (u2 >> 7) & 1, bl = u2 >> 8;
        const int t0 = blk * 32, rowb = bl * SEQ;
        d.pitch = 64;
        d.Kw = ZB + ((long)(16 + kvh) * TC + rowb + t0 - 128) * 64; d.Vw = ZB + ((long)(18 + kvh) * TC + rowb + t0 - 128) * 64;
        const int qh = kvh * 8 + w;
        const long qrow = (long)rowb + t0 + c;
        d.Qp = ZB + ((long)qh * TC + qrow) * 64;
        d.kk_lo = t0 < 128 ? 128 - t0 : 0; d.nkeys = 160; d.kb0 = 0; d.kstart = d.kk_lo >> 5; d.lo = 1;
        d.m0 = F.in[I_SINK][qh] * LOG2E;
        d.o8 = P34_FP8;
        d.Op = P34_FP8 ? (bf16*)(ws + WS_Y + ((size_t)ch * TC + (qrow - c)) * Y_W + 512 + qh * 64) : (bf16*)(ws + WS_Y) + ((size_t)ch * TC + (qrow - c)) * Y_W + 512 + qh * 64; d.ostr = P34_FP8 ? Y_W : 2 * Y_W;
        d.Lp = nullptr;
    }
}
__device__ __forceinline__ void attn_load(const AUnit& d, int tid, int lane, v4u (&kreg)[6], v4u (&vreg)[6], bf16x8 (&qf)[4]) {
    const int skey = tid >> 3, sch = tid & 7, h = (lane >> 5) & 1;
#pragma unroll
    for (int s4 = 0; s4 < 4; ++s4) qf[s4] = *(const GAS bf16x8*)(d.Qp + 16 * s4 + 8 * h);
#pragma unroll
    for (int p = 0; p < 6; ++p) { const int kk = 64 * p + skey;
        if (kk >= d.kk_lo && kk < d.nkeys) { kreg[p] = *(const GAS v4u*)(d.Kw + (size_t)kk * d.pitch + 8 * sch); vreg[p] = *(const GAS v4u*)(d.Vw + (size_t)kk * d.pitch + 8 * sch); } }
}
__device__ __forceinline__ void attn_write(const AUnit& d, LAS unsigned char* KL, LAS unsigned char* VL, int tid, const v4u (&kreg)[6], const v4u (&vreg)[6]) {
    const int skey = tid >> 3, sch = tid & 7;
#pragma unroll
    for (int p = 0; p < 6; ++p) { const int kk = 64 * p + skey;
        if (kk >= d.kk_lo && kk < d.nkeys) {
            *(LAS v4u*)(KL + kk * 128 + ((sch ^ ((kk >> 1) & 7)) << 4)) = kreg[p];
            *(LAS v4u*)(VL + kk * 128 + ((sch * 16) ^ (((kk >> 1) & 1) << 6))) = vreg[p]; } }
}
__device__ __forceinline__ void attn_out(const AUnit& d, LAS unsigned char* OL, int lane, const f32x16& o0, const f32x16& o1, float inv) {
    asm volatile("" : "+v"(lane));
    const int c = lane & 31, h = (lane >> 5) & 1;
    if (d.o8) {
        const float sc = inv * Y8_SCALE;
#pragma unroll
        for (int g4 = 0; g4 < 4; ++g4) {
            const int bo0 = 8 * g4 + 4 * h, bo1 = 32 + bo0;
            *(LAS unsigned*)(OL + c * 64 + (((bo0 >> 4) ^ (c & 3)) << 4) + (bo0 & 15)) = pk4_fp8(o0[4 * g4 + 0] * sc, o0[4 * g4 + 1] * sc, o0[4 * g4 + 2] * sc, o0[4 * g4 + 3] * sc);
            *(LAS unsigned*)(OL + c * 64 + (((bo1 >> 4) ^ (c & 3)) << 4) + (bo1 & 15)) = pk4_fp8(o1[4 * g4 + 0] * sc, o1[4 * g4 + 1] * sc, o1[4 * g4 + 2] * sc, o1[4 * g4 + 3] * sc);
        }
        unsigned char* ob = (unsigned char*)d.Op;
#pragma unroll
        for (int j = 0; j < 2; ++j) { const int q = (lane >> 2) + 16 * j, k = lane & 3;
            const v4u v = *(const LAS v4u*)(OL + q * 64 + ((k ^ (q & 3)) << 4)); *(GAS v4u*)(ob + (long)q * d.ostr + k * 16) = v; }
    } else {
#pragma unroll
        for (int g4 = 0; g4 < 4; ++g4) {
            v2u a, b;
            a.x = cvtpk(o0[4 * g4 + 0] * inv, o0[4 * g4 + 1] * inv); a.y = cvtpk(o0[4 * g4 + 2] * inv, o0[4 * g4 + 3] * inv);
            b.x = cvtpk(o1[4 * g4 + 0] * inv, o1[4 * g4 + 1] * inv); b.y = cvtpk(o1[4 * g4 + 2] * inv, o1[4 * g4 + 3] * inv);
            const int bo0 = 16 * g4 + 8 * h, bo1 = 64 + bo0;
            *(LAS v2u*)(OL + c * 128 + (((bo0 >> 4) ^ (c & 7)) << 4) + (bo0 & 15)) = a;
            *(LAS v2u*)(OL + c * 128 + (((bo1 >> 4) ^ (c & 7)) << 4) + (bo1 & 15)) = b;
        }
        unsigned char* ob = (unsigned char*)d.Op;
#pragma unroll
        for (int j = 0; j < 4; ++j) { const int q = (lane >> 3) + 8 * j, k = lane & 7;
            const v4u v = *(const LAS v4u*)(OL + q * 128 + ((k ^ (q & 7)) << 4)); *(GAS v4u*)(ob + (long)q * d.ostr + k * 16) = v; }
    }
}
__device__ __forceinline__ void attn_compute_edge(const AUnit& d, const LAS unsigned char* KL, const LAS unsigned char* VL, LAS unsigned char* OL, int lane, const bf16x8 (&qf)[4]) {
    const int c = lane & 31, h = (lane >> 5) & 1;
    int koff[4];
    { const int kswz = (c >> 1) & 7;
#pragma unroll
      for (int s4 = 0; s4 < 4; ++s4) koff[s4] = c * 128 + (((2 * s4 + h) ^ kswz) << 4); }
    const int vrow = 4 * h + ((lane & 15) >> 2), vsw = (lane >> 3) & 1;
    const int voff0 = vrow * 128 + ((32 * ((lane >> 4) & 1) + 8 * (lane & 3)) ^ (vsw << 6)), voff1 = voff0 ^ 64;
    const float NEG = -INFINITY;
    float m = d.m0, l = (d.lo && h == 0) ? 1.f : 0.f;
    f32x16 o0, o1;
#pragma unroll
    for (int i = 0; i < 16; ++i) { o0[i] = 0.f; o1[i] = 0.f; }
    const LAS unsigned char* kbp = KL + d.kb0 * 4096; const LAS unsigned char* vbp = VL + d.kb0 * 4096;
    const int clo = c + d.lo;
#pragma unroll
    for (int kbi = 0; kbi < 5; ++kbi) {
        if (kbi >= d.kstart) {
            f32x16 p;
#pragma unroll
            for (int i = 0; i < 16; ++i) p[i] = 0.f;
#pragma unroll
            for (int s4 = 0; s4 < 4; ++s4) { const bf16x8 kf = *(const LAS bf16x8*)(kbp + kbi * 4096 + koff[s4]); p = __builtin_amdgcn_mfma_f32_32x32x16_bf16(kf, qf[s4], p, 0, 0, 0); }
            if (kbi == 0) {
#pragma unroll
                for (int i = 0; i < 16; ++i) { const int x = (i & 3) + 8 * (i >> 2) + 4 * h; if (x < clo) p[i] = NEG; }
            }
            if (kbi == 4) {
#pragma unroll
                for (int i = 0; i < 16; ++i) { const int x = (i & 3) + 8 * (i >> 2) + 4 * h; if (x > c) p[i] = NEG; }
            }
            float mt = p[0];
#pragma unroll
            for (int i = 1; i < 16; ++i) mt = fmaxf(mt, p[i]);
            mt = half_max(mt);
            const float mn = fmaxf(m, mt), alpha = __builtin_amdgcn_exp2f(m - mn);
            m = mn;
            float ps = 0.f;
#pragma unroll
            for (int i = 0; i < 16; ++i) { p[i] = __builtin_amdgcn_exp2f(p[i] - mn); ps += p[i]; }
            l = l * alpha + ps;
#pragma unroll
            for (int i = 0; i < 16; ++i) { o0[i] *= alpha; o1[i] *= alpha; }
            bf16x8 pb[2];
#pragma unroll
            for (int s2 = 0; s2 < 2; ++s2) { v4u t; t.x = cvtpk(p[8 * s2 + 0], p[8 * s2 + 1]); t.y = cvtpk(p[8 * s2 + 2], p[8 * s2 + 3]); t.z = cvtpk(p[8 * s2 + 4], p[8 * s2 + 5]); t.w = cvtpk(p[8 * s2 + 6], p[8 * s2 + 7]); pb[s2] = __builtin_bit_cast(bf16x8, t); }
#pragma unroll
            for (int s2 = 0; s2 < 2; ++s2) {
#pragma unroll
                for (int db = 0; db < 2; ++db) {
                    const LAS unsigned char* vp = vbp + kbi * 4096 + s2 * 2048 + (db ? voff1 : voff0);
                    const v4i16_t lo = __builtin_amdgcn_ds_read_tr16_b64_v4i16((LAS v4i16_t*)vp);
                    const v4i16_t hi = __builtin_amdgcn_ds_read_tr16_b64_v4i16((LAS v4i16_t*)(vp + 1024));
                    const bf16x8 vf = {lo[0], lo[1], lo[2], lo[3], hi[0], hi[1], hi[2], hi[3]};
                    if (db == 0) o0 = __builtin_amdgcn_mfma_f32_32x32x16_bf16(vf, pb[s2], o0, 0, 0, 0);
                    else o1 = __builtin_amdgcn_mfma_f32_32x32x16_bf16(vf, pb[s2], o1, 0, 0, 0);
                }
            }
        }
    }
    const float lt = half_sum(l), inv = 1.0f / lt;
    attn_out(d, OL, lane, o0, o1, inv);
    if (d.Lp) { if (h == 0) *d.Lp = m + __builtin_amdgcn_logf(lt); }
}
__device__ __forceinline__ void attn_compute(const AUnit& d, const LAS unsigned char* KL, const LAS unsigned char* VL, LAS unsigned char* OL, int lane, const bf16x8 (&qf)[4]) {
    const int c = lane & 31, h = (lane >> 5) & 1;
    int koff[4];
    { const int kswz = (c >> 1) & 7;
#pragma unroll
      for (int s4 = 0; s4 < 4; ++s4) koff[s4] = c * 128 + (((2 * s4 + h) ^ kswz) << 4); }
    const int vrow = 4 * h + ((lane & 15) >> 2), vsw = (lane >> 3) & 1;
    const int voff0 = vrow * 128 + ((32 * ((lane >> 4) & 1) + 8 * (lane & 3)) ^ (vsw << 6)), voff1 = voff0 ^ 64;
    const float NEG = -INFINITY;
    float m = d.m0;
    f32x16 o0, o1, L;
#pragma unroll
    for (int i = 0; i < 16; ++i) { o0[i] = 0.f; o1[i] = 0.f; L[i] = 0.f; }
    v4u onesu = {0x3F803F80u, 0x3F803F80u, 0x3F803F80u, 0x3F803F80u}; asm volatile("" : "+v"(onesu));
    const bf16x8 ones = __builtin_bit_cast(bf16x8, onesu);
    const LAS unsigned char* kbp = KL + d.kb0 * 4096; const LAS unsigned char* vbp = VL + d.kb0 * 4096;
    const int clo = c + d.lo;
#pragma unroll
    for (int kbi = 0; kbi < 5; ++kbi) {
        {
            constexpr bool first_dummy = false; (void)first_dummy;
            const bool first = (kbi == 0);
            const float cinit = first ? 0.f : -m;
            f32x16 p;
#pragma unroll
            for (int i = 0; i < 16; ++i) p[i] = cinit;
#pragma unroll
            for (int s4 = 0; s4 < 4; ++s4) { const bf16x8 kf = *(const LAS bf16x8*)(kbp + kbi * 4096 + koff[s4]); p = __builtin_amdgcn_mfma_f32_32x32x16_bf16(kf, qf[s4], p, 0, 0, 0); }
            if (kbi == 0) {
#pragma unroll
                for (int i = 0; i < 16; ++i) { const int x = (i & 3) + 8 * (i >> 2) + 4 * h; p[i] = x < clo ? NEG : p[i]; }
            }
            if (kbi == 4) {
#pragma unroll
                for (int i = 0; i < 16; ++i) { const int x = (i & 3) + 8 * (i >> 2) + 4 * h; p[i] = x > c ? NEG : p[i]; }
            }
            float t0 = max3f(p[0], p[4], p[8]), t1 = max3f(p[1], p[5], p[9]), t2 = max3f(p[2], p[6], p[10]), t3 = max3f(p[3], p[7], p[11]);
            t0 = max3f(t0, p[12], p[13]); t1 = max3f(t1, p[14], p[15]);
            const float mt = half_max(max3f(max3f(t0, t1, t2), t3, t3));
            if (first) {
                const float mn = fmaxf(m, mt), l0 = d.m0 > -1e29f ? __builtin_amdgcn_exp2f(m - mn) : 0.f;
                m = mn;
#pragma unroll
                for (int i = 0; i < 16; ++i) { p[i] -= mn; L[i] = l0; }
            } else if (__any(mt > 8.0f)) {
                const float dl = fmaxf(mt, 0.f), al = __builtin_amdgcn_exp2f(-dl);
                m += dl;
#pragma unroll
                for (int i = 0; i < 16; ++i) { o0[i] *= al; o1[i] *= al; L[i] *= al; p[i] -= dl; }
            }
#pragma unroll
            for (int i = 0; i < 16; ++i) p[i] = __builtin_amdgcn_exp2f(p[i]);
            bf16x8 pb[2];
#pragma unroll
            for (int s2 = 0; s2 < 2; ++s2) { v4u t; t.x = cvtpk(p[8 * s2 + 0], p[8 * s2 + 1]); t.y = cvtpk(p[8 * s2 + 2], p[8 * s2 + 3]); t.z = cvtpk(p[8 * s2 + 4], p[8 * s2 + 5]); t.w = cvtpk(p[8 * s2 + 6], p[8 * s2 + 7]); pb[s2] = __builtin_bit_cast(bf16x8, t); }
#pragma unroll
            for (int s2 = 0; s2 < 2; ++s2) {
                L = __builtin_amdgcn_mfma_f32_32x32x16_bf16(ones, pb[s2], L, 0, 0, 0);
#pragma unroll
                for (int db = 0; db < 2; ++db) {
                    const LAS unsigned char* vp = vbp + kbi * 4096 + s2 * 2048 + (db ? voff1 : voff0);
                    const v4i16_t lo = __builtin_amdgcn_ds_read_tr16_b64_v4i16((LAS v4i16_t*)vp);
                    const v4i16_t hi = __builtin_amdgcn_ds_read_tr16_b64_v4i16((LAS v4i16_t*)(vp + 1024));
                    const bf16x8 vf = {lo[0], lo[1], lo[2], lo[3], hi[0], hi[1], hi[2], hi[3]};
                    if (db == 0) o0 = __builtin_amdgcn_mfma_f32_32x32x16_bf16(vf, pb[s2], o0, 0, 0, 0);
                    else o1 = __builtin_amdgcn_mfma_f32_32x32x16_bf16(vf, pb[s2], o1, 0, 0, 0);
                }
            }
        }
    }
    const float lt = L[0], inv = 1.0f / lt;
    attn_out(d, OL, lane, o0, o1, inv);
    if (d.Lp) { if (h == 0) *d.Lp = m + __builtin_amdgcn_logf(lt); }
}
__device__ __forceinline__ void p2_attn(Frame& F, int ch) {
    int tid_ = threadIdx.x; asm volatile("" : "+v"(tid_));
    const int tid = tid_, lane = tid & 63;
    LAS unsigned char* KL = F.lds; LAS unsigned char* VL = F.lds + ATT_VOFF; LAS unsigned char* OL = F.lds + 2 * ATT_VOFF + F.wave * 4096;
    constexpr int NUA = (TC / SEQ) * 3 * 8 * 16, NUB = (TC / SEQ) * 2 * 128, NU = NUA + NUB;
    int u = F.vcu; asm volatile("" : "+s"(u));
    if (u >= NU) return;
    AUnit cur, nxt;
    v4u kreg[6], vreg[6]; bf16x8 qn[4];
    attn_decode(F, ch, u, NUA, lane, cur);
    attn_load(cur, tid, lane, kreg, vreg, qn);
    for (;;) {
        attn_write(cur, KL, VL, tid, kreg, vreg);
        bf16x8 qf[4];
#pragma unroll
        for (int s4 = 0; s4 < 4; ++s4) qf[s4] = qn[s4];
        __syncthreads();
        const int un = u + F.G; const bool has_next = un < NU;
        if (has_next) { attn_decode(F, ch, un, NUA, lane, nxt); attn_load(nxt, tid, lane, kreg, vreg, qn); }
        if (cur.kk_lo == 0) attn_compute(cur, KL, VL, OL, lane, qf); else attn_compute_edge(cur, KL, VL, OL, lane, qf);
        __syncthreads();
        if (!has_next) break;
        cur = nxt; u = un;
    }
}
__device__ __forceinline__ void p2_combine(Frame& F, int ch, int cu, int ncu) {
    int tid_ = threadIdx.x; asm volatile("" : "+v"(tid_)); const int lane_ = tid_ & 63;
    unsigned char* ws = F.ws;
    const bf16* OG = (const bf16*)((const unsigned char*)F.out + DO_OG); const float* LSE = (const float*)((const unsigned char*)F.out + DO_LSE);
    bf16* Y = (bf16*)(ws + WS_Y) + (size_t)ch * TC * Y_W; unsigned char* Y8 = ws + WS_Y + (size_t)ch * TC * Y_W;
    const int lane = lane_, hd = lane >> 3;
    int gw_ = cu * NWAVES + F.wave; asm volatile("" : "+s"(gw_));
    const int gw = gw_, NGW = ncu * NWAVES;
    for (int row0 = gw; row0 < TC; row0 += 4 * NGW) {
        float lg[4][3]; v4u og[4][3];
#pragma unroll
        for (int r = 0; r < 4; ++r) { const int row = row0 + r * NGW < TC ? row0 + r * NGW : row0;
#pragma unroll
            for (int g = 0; g < 3; ++g) { lg[r][g] = LSE[((size_t)g * TC + row) * 8 + hd]; og[r][g] = *(const GAS v4u*)(OG + ((size_t)g * TC + row) * 512 + lane * 8); } }
#pragma unroll
        for (int r = 0; r < 4; ++r) { const int row = row0 + r * NGW; if (row >= TC) continue;
            const float mx = fmaxf(fmaxf(lg[r][0], lg[r][1]), lg[r][2]);
            float e[3]; e[0] = __builtin_amdgcn_exp2f(lg[r][0] - mx); e[1] = __builtin_amdgcn_exp2f(lg[r][1] - mx); e[2] = __builtin_amdgcn_exp2f(lg[r][2] - mx);
            const float inv = 1.0f / (e[0] + e[1] + e[2]);
            float acc[8];
#pragma unroll
            for (int i = 0; i < 8; ++i) acc[i] = 0.f;
#pragma unroll
            for (int g = 0; g < 3; ++g) { const float wg = e[g] * inv; const v4u o_ = og[r][g];
                acc[0] += wg * bflo(o_.x); acc[1] += wg * bfhi(o_.x); acc[2] += wg * bflo(o_.y); acc[3] += wg * bfhi(o_.y);
                acc[4] += wg * bflo(o_.z); acc[5] += wg * bfhi(o_.z); acc[6] += wg * bflo(o_.w); acc[7] += wg * bfhi(o_.w); }
            v4u o; o.x = cvtpk(acc[0], acc[1]); o.y = cvtpk(acc[2], acc[3]); o.z = cvtpk(acc[4], acc[5]); o.w = cvtpk(acc[6], acc[7]);
            if (P34_FP8) { v2u o8; o8.x = pk4_fp8(acc[0] * Y8_SCALE, acc[1] * Y8_SCALE, acc[2] * Y8_SCALE, acc[3] * Y8_SCALE); o8.y = pk4_fp8(acc[4] * Y8_SCALE, acc[5] * Y8_SCALE, acc[6] * Y8_SCALE, acc[7] * Y8_SCALE); *(GAS v2u*)(Y8 + (size_t)row * Y_W + lane * 8) = o8; }
            else *(GAS v4u*)(Y + (size_t)row * Y_W + lane * 8) = o; }
    }
}


struct EpiMerge {
    static constexpr bool PERM = true; static constexpr int HOOK_T = P34_FP8 ? 4 : 8;
    const bf16* Gt; bf16* MG;
    __device__ __forceinline__ void prefetch(LAS unsigned char*, const pg9::Unit&, int, int, int) const {}
    __device__ __forceinline__ void hook(f32x4 (&acc)[2][2][4][2], const pg9::Unit& u, int wr, int wc, int fr, int fq) const {
        asm volatile("" : "+v"(fr), "+v"(fq));
        const bf16* gr = Gt + ((size_t)((u.pm * 256 + wr * 64) >> 4) * 256 + u.pn * 32 + wc * 4 + fq) * 128 + fr * 8;
        v4u rv[8][2];
#pragma unroll
        for (int rg = 0; rg < 8; ++rg)
#pragma unroll
            for (int bj = 0; bj < 2; ++bj) rv[rg][bj] = *(const GAS v4u*)(gr + (size_t)((rg >> 2) * 8 + (rg & 3)) * 32768 + bj * 16 * 128);
#pragma unroll
        for (int rg = 0; rg < 8; ++rg)
#pragma unroll
            for (int bj = 0; bj < 2; ++bj) { const v4u a = rv[rg][bj];
                const f32x4 r0 = {bflo(a.x), bfhi(a.x), bflo(a.y), bfhi(a.y)}, r1 = {bflo(a.z), bfhi(a.z), bflo(a.w), bfhi(a.w)};
                acc[rg >> 2][bj][rg & 3][0] = acc[rg >> 2][bj][rg & 3][0] * r0; acc[rg >> 2][bj][rg & 3][1] = acc[rg >> 2][bj][rg & 3][1] * r1; }
    }
    __device__ __forceinline__ void operator()(const f32x4 (&acc)[2][2][4][2], const pg9::Unit& u, int ui, int wr, int wc, int fr, int fq) const {
        asm volatile("" : "+v"(fr), "+v"(fq));
        const bf16* gr = Gt + ((size_t)((u.pm * 256 + wr * 64) >> 4) * 256 + 128 + u.pn * 32 + wc * 4 + fq) * 128 + fr * 8;
        const int fr2 = (fr >> 2) + 4 * fq, fq2 = fr & 3, paddr = 4 * (16 * (fr & 3) + 4 * fq + (fr >> 2));
        bf16* mr = MG + (size_t)(u.pm * 256 + wr * 64 + fr2) * D + u.pn * 256 + wc * 32 + 8 * fq2;
        v4u gb[8][2];
#pragma unroll
        for (int rg = 0; rg < 8; ++rg)
#pragma unroll
            for (int bj = 0; bj < 2; ++bj) gb[rg][bj] = *(const GAS v4u*)(gr + (size_t)((rg >> 2) * 8 + (rg & 3)) * 32768 + bj * 16 * 128);
#pragma unroll
        for (int rg = 0; rg < 8; ++rg)
#pragma unroll
            for (int bj = 0; bj < 2; ++bj) { const v4u b = gb[rg][bj];
                const f32x4 v0 = acc[rg >> 2][bj][rg & 3][0], v1 = acc[rg >> 2][bj][rg & 3][1];
                if (P34_FP8) { constexpr float f = MG8_SCALE / (W34_SCALE * Y8_SCALE); unsigned char* m8 = (unsigned char*)MG + (size_t)(u.pm * 256 + wr * 64 + fr2) * D + u.pn * 256 + wc * 32 + 8 * fq2;
                    v2u w8; w8.x = pk4_fp8(v0[0] * bflo(b.x) * f, v0[1] * bfhi(b.x) * f, v0[2] * bflo(b.y) * f, v0[3] * bfhi(b.y) * f); w8.y = pk4_fp8(v1[0] * bflo(b.z) * f, v1[1] * bfhi(b.z) * f, v1[2] * bflo(b.w) * f, v1[3] * bfhi(b.w) * f);
                    w8.x = (unsigned)__builtin_amdgcn_ds_bpermute(paddr, (int)w8.x); w8.y = (unsigned)__builtin_amdgcn_ds_bpermute(paddr, (int)w8.y);
                    *(GAS v2u*)(m8 + (size_t)((rg >> 2) * 128 + (rg & 3) * 16) * D + bj * 128) = w8; }
                else {
                v4u w; w.x = cvtpk(v0[0] * bflo(b.x), v0[1] * bfhi(b.x)); w.y = cvtpk(v0[2] * bflo(b.y), v0[3] * bfhi(b.y));
                w.z = cvtpk(v1[0] * bflo(b.z), v1[1] * bfhi(b.z)); w.w = cvtpk(v1[2] * bflo(b.w), v1[3] * bfhi(b.w));
                w.x = (unsigned)__builtin_amdgcn_ds_bpermute(paddr, (int)w.x); w.y = (unsigned)__builtin_amdgcn_ds_bpermute(paddr, (int)w.y); w.z = (unsigned)__builtin_amdgcn_ds_bpermute(paddr, (int)w.z); w.w = (unsigned)__builtin_amdgcn_ds_bpermute(paddr, (int)w.w);
                *(GAS v4u*)(mr + (size_t)((rg >> 2) * 128 + (rg & 3) * 16) * D + bj * 128) = w; } }
    }
};
__device__ __forceinline__ void p3_merge(Frame& F) {
    unsigned char* ws = F.ws;
    pg9::DenseOrder S; S.init(T, D, F.G, (int)blockIdx.x);
    EpiMerge E{(const bf16*)(ws + WS_G), (bf16*)(ws + WS_MG)};
    constexpr int ES = P34_FP8 ? 1 : 2;
    pg9::DenseA ao{(unsigned)(Y_W * ES)}; pg9::DenseB bb{(const char*)(ws + WS_WAB), (size_t)256 * Y_W * ES};
    pg9::gemm_phase<ES>(F.lds, (const char*)(ws + WS_Y), Y_W, S, E, ao, bb);
}
struct EpiOut {
    static constexpr bool PERM = true; static constexpr int HOOK_T = -1;
    bf16* DELTA;
    __device__ __forceinline__ void hook(f32x4 (&)[2][2][4][2], const pg9::Unit&, int, int, int, int) const {}
    __device__ __forceinline__ void prefetch(LAS unsigned char*, const pg9::Unit&, int, int, int) const {}
    __device__ __forceinline__ void operator()(const f32x4 (&acc)[2][2][4][2], const pg9::Unit& u, int ui, int wr, int wc, int fr, int fq) const {
        asm volatile("" : "+v"(fr), "+v"(fq));
        const int fr2 = (fr >> 2) + 4 * fq, fq2 = fr & 3, paddr = 4 * (16 * (fr & 3) + 4 * fq + (fr >> 2));
        bf16* orow = DELTA + (size_t)(u.pm * 256 + wr * 64 + fr2) * D + u.pn * 256 + wc * 32 + 8 * fq2;
#pragma unroll
        for (int ai = 0; ai < 2; ++ai)
#pragma unroll
            for (int m = 0; m < 4; ++m)
#pragma unroll
                for (int bj = 0; bj < 2; ++bj) { constexpr float f = P34_FP8 ? 1.0f / (W34_SCALE * MG8_SCALE) : 1.0f; const f32x4 o0 = acc[ai][bj][m][0] * f, o1 = acc[ai][bj][m][1] * f;
                    v4u w; w.x = cvtpk(o0[0], o0[1]); w.y = cvtpk(o0[2], o0[3]); w.z = cvtpk(o1[0], o1[1]); w.w = cvtpk(o1[2], o1[3]);
                    w.x = (unsigned)__builtin_amdgcn_ds_bpermute(paddr, (int)w.x); w.y = (unsigned)__builtin_amdgcn_ds_bpermute(paddr, (int)w.y); w.z = (unsigned)__builtin_amdgcn_ds_bpermute(paddr, (int)w.z); w.w = (unsigned)__builtin_amdgcn_ds_bpermute(paddr, (int)w.w);
                    *(GAS v4u*)(orow + (size_t)(ai * 128 + m * 16) * D + bj * 128) = w; }
    }
};
__device__ __forceinline__ void p4_outproj(Frame& F) {
    unsigned char* ws = F.ws;
    pg9::DenseOrder S; S.init(T, D, F.G, (int)blockIdx.x);
    EpiOut E{(bf16*)((unsigned char*)F.out + DO_DELTA)};
    constexpr int ES = P34_FP8 ? 1 : 2;
    pg9::DenseA ao{(unsigned)(D * ES)}; pg9::DenseB bb{(const char*)(ws + WS_WO), (size_t)256 * D * ES};
    pg9::gemm_phase<ES>(F.lds, (const char*)(ws + WS_MG), D, S, E, ao, bb);
}

__device__ __forceinline__ void p5_route(Frame& F) {
    int tid_ = threadIdx.x; asm volatile("" : "+v"(tid_)); const int lane = tid_ & 63;
    unsigned char* ws = F.ws;
    const float* X = F.in[I_X]; const bf16* DELTA = (const bf16*)((const unsigned char*)F.out + DO_DELTA);
    bf16* X1B = (bf16*)(ws + WS_X1B); unsigned char* X1F8 = ws + WS_X1F8;
    unsigned* cnt = (unsigned*)(ws + WS_CTL) + CW_CNT;
    int* tokof = (int*)(ws + WS_TOKOF); float2* wtof = (float2*)(ws + WS_WTOF); int4* tpos = (int4*)(ws + WS_TPOS);
    const v4u* WRF = (const v4u*)(ws + WS_WRF);
    LAS v4u* wl = (LAS v4u*)F.lds;
    LAS float* sl = (LAS float*)(F.lds + 98304 + F.wave * 4096);
    const int i = lane & 15, q = lane >> 4;
    LAS unsigned* hist = (LAS unsigned*)(F.lds + LDS_MISC + 2048);
    for (int wt = F.vcu; wt < T / 128; wt += F.G) {
        const int tile = wt * NWAVES + F.wave;
        if (tid_ < 32) hist[tid_] = 0u;
        const size_t roff = (size_t)(tile * 16 + i) * D + 8 * q;
        const float* xr = X + roff; const bf16* dr = DELTA + roff;
        f32x4 a0 = {0.f, 0.f, 0.f, 0.f}, a1 = a0, a2 = a0; float ss = 0.f;
        f32x4 va[8][2]; v4u vd[8];
#pragma unroll
        for (int j = 0; j < 8; ++j) { va[j][0] = *(const GAS f32x4*)(xr + 32 * j); va[j][1] = *(const GAS f32x4*)(xr + 32 * j + 4); vd[j] = *(const GAS v4u*)(dr + 32 * j); }
#pragma unroll 1
        for (int half = 0; half < 2; ++half) {
            __syncthreads();
            { v4u t[12];
#pragma unroll
              for (int k = 0; k < 12; ++k) t[k] = WRF[half * 6144 + k * 512 + tid_];
#pragma unroll
              for (int k = 0; k < 12; ++k) wl[k * 512 + tid_] = t[k]; }
            __syncthreads();
#pragma unroll 1
            for (int sb = 0; sb < 2; ++sb) {
#pragma unroll
                for (int j = 0; j < 8; ++j) {
                    const int ksl = sb * 8 + j, ks = half * 16 + ksl;
                    const v4u dd = vd[j];
                    const f32x4 v0 = va[j][0] + (f32x4){bflo(dd.x), bfhi(dd.x), bflo(dd.y), bfhi(dd.y)}, v1 = va[j][1] + (f32x4){bflo(dd.z), bfhi(dd.z), bflo(dd.w), bfhi(dd.w)};
                    if (ks + 8 < 32) { va[j][0] = *(const GAS f32x4*)(xr + 32 * (ks + 8)); va[j][1] = *(const GAS f32x4*)(xr + 32 * (ks + 8) + 4); vd[j] = *(const GAS v4u*)(dr + 32 * (ks + 8)); }
                    ss += ((v0[0] * v0[0] + v0[1] * v0[1]) + (v0[2] * v0[2] + v0[3] * v0[3])) + ((v1[0] * v1[0] + v1[1] * v1[1]) + (v1[2] * v1[2] + v1[3] * v1[3]));
                    v4u hu; hu.x = cvtpk(v0[0], v0[1]); hu.y = cvtpk(v0[2], v0[3]); hu.z = cvtpk(v1[0], v1[1]); hu.w = cvtpk(v1[2], v1[3]);
                    v4u lu; lu.x = cvtpk(v0[0] - bflo(hu.x), v0[1] - bfhi(hu.x)); lu.y = cvtpk(v0[2] - bflo(hu.y), v0[3] - bfhi(hu.y)); lu.z = cvtpk(v1[0] - bflo(hu.z), v1[1] - bfhi(hu.z)); lu.w = cvtpk(v1[2] - bflo(hu.w), v1[3] - bfhi(hu.w));
                    *(GAS v4u*)(X1B + roff + 32 * ks) = hu;
                    if (P6_FP8) { v2u w8; w8.x = pk4_fp8(v0[0], v0[1], v0[2], v0[3]); w8.y = pk4_fp8(v1[0], v1[1], v1[2], v1[3]); *(GAS v2u*)(X1F8 + roff + 32 * ks) = w8; }
                    const bf16x8 ah = __builtin_bit_cast(bf16x8, hu), al = __builtin_bit_cast(bf16x8, lu);
#pragma unroll
                    for (int nb = 0; nb < 3; ++nb) {
                        const bf16x8 bh = __builtin_bit_cast(bf16x8, wl[((ksl * 3 + nb) * 2 + 0) * 64 + lane]), bl = __builtin_bit_cast(bf16x8, wl[((ksl * 3 + nb) * 2 + 1) * 64 + lane]);
                        f32x4 acc = nb == 0 ? a0 : (nb == 1 ? a1 : a2);
                        acc = __builtin_amdgcn_mfma_f32_16x16x32_bf16(ah, bh, acc, 0, 0, 0); acc = __builtin_amdgcn_mfma_f32_16x16x32_bf16(ah, bl, acc, 0, 0, 0); acc = __builtin_amdgcn_mfma_f32_16x16x32_bf16(al, bh, acc, 0, 0, 0);
                        if (nb == 0) a0 = acc; else if (nb == 1) a1 = acc; else a2 = acc;
                    }
                }
            }
        }
        ss += __shfl_xor(ss, 16); ss += __shfl_xor(ss, 32);
#pragma unroll
        for (int r = 0; r < 4; ++r) { sl[(4 * q + r) * 48 + i] = a0[r]; sl[(4 * q + r) * 48 + 16 + i] = a1[r]; sl[(4 * q + r) * 48 + 32 + i] = a2[r]; }
        LDS_WAIT(); asm volatile("" ::: "memory");
        int e0 = 0, e1 = 0, lp0 = 0, lp1 = 0; float w1 = 0.f, w2 = 0.f, rstd = 0.f;
        __syncthreads();
        if (lane < 16) {
            rstd = 1.0f / sqrtf(ss * (1.f / D) + RMS_EPS);
            float lg[36];
#pragma unroll
            for (int o = 0; o < 36; ++o) lg[o] = sl[lane * 48 + o] * rstd + (o < 4 ? F.in[I_BRG][o] : F.in[I_BRE][o - 4]);
            int gsel = 0; float gmax = lg[0];
#pragma unroll
            for (int k = 1; k < 4; ++k) if (lg[k] > gmax) { gmax = lg[k]; gsel = k; }
            float gden = 0.f;
#pragma unroll
            for (int k = 0; k < 4; ++k) gden += __expf(lg[k] - gmax);
            const float pg = 1.0f / gden;
            float le[8];
#pragma unroll
            for (int j = 0; j < 8; ++j) { le[j] = lg[4 + j];
#pragma unroll
                for (int gi = 1; gi < 4; ++gi) le[j] = (gsel == gi) ? lg[4 + gi * 8 + j] : le[j]; }
            int i1 = 0; float m1 = le[0];
#pragma unroll
            for (int j = 1; j < 8; ++j) if (le[j] > m1) { m1 = le[j]; i1 = j; }
            int i2 = -1; float m2 = -INFINITY;
#pragma unroll
            for (int j = 0; j < 8; ++j) if (j != i1 && le[j] > m2) { m2 = le[j]; i2 = j; }
            const float e2 = __expf(m2 - m1);
            w1 = pg / (1.0f + e2); w2 = pg * e2 / (1.0f + e2);
            e0 = gsel * 8 + i1; e1 = gsel * 8 + i2;
            lp0 = (int)__hip_atomic_fetch_add(&hist[e0], 1u, __ATOMIC_RELAXED, __HIP_MEMORY_SCOPE_WORKGROUP);
            lp1 = (int)__hip_atomic_fetch_add(&hist[e1], 1u, __ATOMIC_RELAXED, __HIP_MEMORY_SCOPE_WORKGROUP);
        }
        __syncthreads();
        if (tid_ < 32) { const unsigned n = hist[tid_]; hist[32 + tid_] = n ? atomicAdd(&cnt[64 * tid_], n) : 0u; }
        __syncthreads();
        if (lane < 16) {
            const int row = tile * 16 + lane;
            const int p0 = (int)hist[32 + e0] + lp0, p1 = (int)hist[32 + e1] + lp1;
            tokof[(size_t)e0 * T + p0] = row; wtof[(size_t)e0 * T + p0] = make_float2(w1, rstd);
            tokof[(size_t)e1 * T + p1] = row; wtof[(size_t)e1 * T + p1] = make_float2(w2, rstd);
            tpos[row] = make_int4(e0, p0, e1, p1);
        }
        __syncthreads();
    }
}

__device__ __forceinline__ void expert_tiles(Frame& F, LAS int* tb, LAS int* cn) {
    int tid_ = threadIdx.x; asm volatile("" : "+v"(tid_)); const int lane_ = tid_ & 63;
    if (tid_ == 0) {
        const unsigned* cnt = (const unsigned*)(F.ws + WS_CTL) + CW_CNT;
        int acc = 0;
        for (int e = 0; e < NE; ++e) { const int c = (int)__hip_atomic_load(cnt + 64 * e, __ATOMIC_RELAXED, __HIP_MEMORY_SCOPE_AGENT); cn[e] = c; tb[e] = acc; acc += (c + 255) >> 8; }
        tb[NE] = acc;
    }
    __syncthreads();
}

struct MoeOrder { const LAS int* tb; int ncol, G, c;
    __device__ bool next(int i, pg9::Unit& u) const {
        const int L = i * G + c; if (L >= tb[NE] * ncol) return false;
        const int rt = L / ncol; int e = 0;
        for (int k = 1; k < NE; ++k) if (tb[k] <= rt) e = k;
        u.pm = rt; u.pn = L % ncol; u.e = e; return true; } };
struct GatherA { static constexpr bool GATHER = true; unsigned rowbytes; const int* tokof; const LAS int* tb; const LAS int* cn;
    __device__ __forceinline__ unsigned operator()(const pg9::Unit& u, int row) const {
        const int p = (u.pm - tb[u.e]) * 256 + row; const int tok = tokof[(size_t)u.e * T + (p < cn[u.e] ? p : 0)]; return (unsigned)tok * rowbytes; } };
struct ExpertB { const char* W; size_t ebytes, tilebytes; __device__ __forceinline__ const char* operator()(const pg9::Unit& u) const { return W + (size_t)u.e * ebytes + (size_t)u.pn * tilebytes; } };
struct EpiGateUp {
    static constexpr bool PERM = true; static constexpr int HOOK_T = -1;
    const float2* wtof; bf16* HACT; const LAS int* tb; const LAS int* cn; float ascale;
    __device__ __forceinline__ void hook(f32x4 (&)[2][2][4][2], const pg9::Unit&, int, int, int, int) const {}
    __device__ __forceinline__ void prefetch(LAS unsigned char*, const pg9::Unit&, int, int, int) const {}
    __device__ __forceinline__ void operator()(const f32x4 (&acc)[2][2][4][2], const pg9::Unit& u, int ui, int wr, int wc, int fr, int fq) const {
        asm volatile("" : "+v"(fr), "+v"(fq));
        const int r0 = wr * 64 + fr, p0 = (u.pm - tb[u.e]) * 256, ce = cn[u.e];
        const int fr2 = (fr >> 2) + 4 * fq, fq2 = fr & 3, paddr = 4 * (16 * (fr & 3) + 4 * fq + (fr >> 2)), r0s = wr * 64 + fr2;
        const float2* wp = wtof + (size_t)u.e * T;
#pragma unroll
        for (int ai = 0; ai < 2; ++ai) {
            float2 wv[4];
#pragma unroll
            for (int m = 0; m < 4; ++m) { const int p = p0 + r0 + ai * 128 + m * 16; wv[m] = p < ce ? wp[p] : make_float2(0.f, 0.f); }
#pragma unroll
            for (int m = 0; m < 4; ++m) { const int r = r0s + ai * 128 + m * 16;
                const float w = wv[m].x, rs = wv[m].y * ascale;
                bf16* orow = HACT + (size_t)(u.pm * 256 + r) * DE + u.pn * 128 + wc * 16 + 4 * fq2; unsigned char* orow8 = (unsigned char*)HACT + (size_t)(u.pm * 256 + r) * DE + u.pn * 128 + wc * 16 + 4 * fq2;
#pragma unroll
                for (int bj = 0; bj < 2; ++bj) { const f32x4 g = acc[ai][bj][m][0], uu = acc[ai][bj][m][1]; f32x4 hv;
#pragma unroll
                    for (int e = 0; e < 4; ++e) { const float gg = g[e] * rs; hv[e] = gg / (1.0f + __expf(-gg)) * (uu[e] * rs) * w; }
                    if (P6_FP8) *(GAS unsigned*)(orow8 + bj * 64) = (unsigned)__builtin_amdgcn_ds_bpermute(paddr, (int)pk4_fp8(hv[0] * H8_SCALE, hv[1] * H8_SCALE, hv[2] * H8_SCALE, hv[3] * H8_SCALE));
                    else { v2u o; o.x = (unsigned)__builtin_amdgcn_ds_bpermute(paddr, (int)cvtpk(hv[0], hv[1])); o.y = (unsigned)__builtin_amdgcn_ds_bpermute(paddr, (int)cvtpk(hv[2], hv[3])); *(GAS v2u*)(orow + bj * 64) = o; } } }
        }
    }
};
__device__ __forceinline__ void p6a_gateup(Frame& F) {
    unsigned char* ws = F.ws;
    LAS int* tb = (LAS int*)(F.lds + LDS_MISC + 1024); LAS int* cn = tb + 64;
    expert_tiles(F, tb, cn);
    MoeOrder S{tb, 2, F.G, F.vcu};
    constexpr int ES = P6_FP8 ? 1 : 2;
    GatherA ao{(unsigned)(D * ES), (const int*)(ws + WS_TOKOF), tb, cn}; ExpertB bb{(const char*)(ws + WS_WGU), (size_t)512 * D * ES, (size_t)256 * D * ES};
    EpiGateUp E{(const float2*)(ws + WS_WTOF), (bf16*)(ws + WS_HACT), tb, cn, P6_FP8 ? 1.0f / WG8_SCALE : 1.0f};
    pg9::gemm_phase<ES>(F.lds, (const char*)(ws + (P6_FP8 ? WS_X1F8 : WS_X1B)), D, S, E, ao, bb);
}
struct EpiDown {
    static constexpr bool PERM = true; static constexpr int HOOK_T = -1;
    bf16* YS; float ascale;
    __device__ __forceinline__ void hook(f32x4 (&)[2][2][4][2], const pg9::Unit&, int, int, int, int) const {}
    __device__ __forceinline__ void prefetch(LAS unsigned char*, const pg9::Unit&, int, int, int) const {}
    __device__ __forceinline__ void operator()(const f32x4 (&acc)[2][2][4][2], const pg9::Unit& u, int ui, int wr, int wc, int fr, int fq) const {
        asm volatile("" : "+v"(fr), "+v"(fq));
        const int fr2 = (fr >> 2) + 4 * fq, fq2 = fr & 3, paddr = 4 * (16 * (fr & 3) + 4 * fq + (fr >> 2));
#pragma unroll
        for (int ai = 0; ai < 2; ++ai)
#pragma unroll
            for (int m = 0; m < 4; ++m) { bf16* orow = YS + (size_t)(u.pm * 256 + wr * 64 + fr2 + ai * 128 + m * 16) * D + u.pn * 256 + wc * 32 + 8 * fq2;
#pragma unroll
                for (int bj = 0; bj < 2; ++bj) { const f32x4 v0 = acc[ai][bj][m][0] * ascale, v1 = acc[ai][bj][m][1] * ascale;
                    if (YS_FP8) { unsigned char* o8 = (unsigned char*)YS + (size_t)(u.pm * 256 + wr * 64 + fr2 + ai * 128 + m * 16) * D + u.pn * 256 + wc * 32 + 8 * fq2 + bj * 128;
                        v2u w8; w8.x = pk4_fp8(v0[0] * YS8_SCALE, v0[1] * YS8_SCALE, v0[2] * YS8_SCALE, v0[3] * YS8_SCALE); w8.y = pk4_fp8(v1[0] * YS8_SCALE, v1[1] * YS8_SCALE, v1[2] * YS8_SCALE, v1[3] * YS8_SCALE);
                        w8.x = (unsigned)__builtin_amdgcn_ds_bpermute(paddr, (int)w8.x); w8.y = (unsigned)__builtin_amdgcn_ds_bpermute(paddr, (int)w8.y); *(GAS v2u*)o8 = w8; }
                    else { v4u w; w.x = cvtpk(v0[0], v0[1]); w.y = cvtpk(v0[2], v0[3]); w.z = cvtpk(v1[0], v1[1]); w.w = cvtpk(v1[2], v1[3]);
                        w.x = (unsigned)__builtin_amdgcn_ds_bpermute(paddr, (int)w.x); w.y = (unsigned)__builtin_amdgcn_ds_bpermute(paddr, (int)w.y); w.z = (unsigned)__builtin_amdgcn_ds_bpermute(paddr, (int)w.z); w.w = (unsigned)__builtin_amdgcn_ds_bpermute(paddr, (int)w.w); *(GAS v4u*)(orow + bj * 128) = w; } } }
    }
};
__device__ __forceinline__ void p6b_down(Frame& F) {
    unsigned char* ws = F.ws;
    LAS int* tb = (LAS int*)(F.lds + LDS_MISC + 1024); LAS int* cn = tb + 64;
    expert_tiles(F, tb, cn);
    MoeOrder S{tb, 4, F.G, F.vcu};
    constexpr int ES = P6_FP8 ? 1 : 2;
    pg9::DenseA ao{(unsigned)(DE * ES)}; ExpertB bb{(const char*)(ws + WS_WD), (size_t)D * DE * ES, (size_t)256 * DE * ES};
    EpiDown E{(bf16*)(ws + WS_YS), P6_FP8 ? 1.0f / (WD8_SCALE * H8_SCALE) : 1.0f};
    pg9::gemm_phase<ES>(F.lds, (const char*)(ws + WS_HACT), DE, S, E, ao, bb);
}
__device__ __forceinline__ void p7_final(Frame& F) {
    int tid_ = threadIdx.x; asm volatile("" : "+v"(tid_)); const int lane_ = tid_ & 63;
    unsigned char* ws = F.ws;
    LAS int* tb = (LAS int*)(F.lds + LDS_MISC + 1024); LAS int* cn = tb + 64;
    expert_tiles(F, tb, cn);
    const bf16* YS = (const bf16*)(ws + WS_YS); const int4* tpos = (const int4*)(ws + WS_TPOS);
    float* X1 = F.out; const bf16* X1B = (const bf16*)(ws + WS_X1B);
    const int lane = lane_;
    const int gw = F.vcu * NWAVES + F.wave, NGW = F.G * NWAVES;
    const GAS f32x4* gr = (const GAS f32x4*)F.in[I_GFIN] + lane;
    for (int row = gw; row < T; row += NGW) {
        const int4 tp = tpos[row];
        const size_t s0 = (size_t)tb[tp.x] * 256 + tp.y, s1 = (size_t)tb[tp.z] * 256 + tp.w;
        GAS f32x4* xr = (GAS f32x4*)(X1 + (size_t)row * D) + lane; const GAS v2u* xb = (const GAS v2u*)(X1B + (size_t)row * D) + lane;
        const GAS v2u* y0 = (const GAS v2u*)(YS + s0 * D) + lane; const GAS v2u* y1 = (const GAS v2u*)(YS + s1 * D) + lane;
        const GAS unsigned* z0 = (const GAS unsigned*)((const unsigned char*)YS + s0 * D) + lane; const GAS unsigned* z1 = (const GAS unsigned*)((const unsigned char*)YS + s1 * D) + lane;
        f32x4 v[4]; float s = 0.f;
#pragma unroll
        for (int j = 0; j < 4; ++j) { const v2u xx = xb[64 * j]; v[j] = (f32x4){bflo(xx.x), bfhi(xx.x), bflo(xx.y), bfhi(xx.y)};
            if (YS_FP8) { const int a = (int)z0[64 * j], b = (int)z1[64 * j]; typedef float f2_ __attribute__((ext_vector_type(2)));
                const f2_ a0 = __builtin_amdgcn_cvt_pk_f32_fp8(a, false), a1 = __builtin_amdgcn_cvt_pk_f32_fp8(a, true), b0 = __builtin_amdgcn_cvt_pk_f32_fp8(b, false), b1 = __builtin_amdgcn_cvt_pk_f32_fp8(b, true);
                constexpr float f = 1.0f / YS8_SCALE; v[j].x += (a0[0] + b0[0]) * f; v[j].y += (a0[1] + b0[1]) * f; v[j].z += (a1[0] + b1[0]) * f; v[j].w += (a1[1] + b1[1]) * f; }
            else { const v2u a = y0[64 * j], b = y1[64 * j];
            v[j].x += bflo(a.x) + bflo(b.x); v[j].y += bfhi(a.x) + bfhi(b.x); v[j].z += bflo(a.y) + bflo(b.y); v[j].w += bfhi(a.y) + bfhi(b.y); }
            s += (v[j].x * v[j].x + v[j].y * v[j].y) + (v[j].z * v[j].z + v[j].w * v[j].w); }
        const float rstd = 1.0f / sqrtf(wave_sum(s) * (1.f / D) + RMS_EPS);
#pragma unroll
        for (int j = 0; j < 4; ++j) { const f32x4 gg = gr[64 * j]; f32x4 o; o.x = v[j].x * rstd * gg.x; o.y = v[j].y * rstd * gg.y; o.z = v[j].z * rstd * gg.z; o.w = v[j].w * rstd * gg.w; xr[64 * j] = o; }
    }
}

constexpr int NPHASE = 2 * NCH + 8;
__global__ void __launch_bounds__(NTHR, 2) fwd_kernel(KArgs args) {
    extern __shared__ __attribute__((aligned(16))) unsigned char lds_raw[];
    Frame F;
    F.lds = (LAS unsigned char*)lds_raw;
    F.tid = threadIdx.x; F.lane = F.tid & 63; F.wave = __builtin_amdgcn_readfirstlane(F.tid >> 6);
    F.G = gridDim.x; { const int bx = blockIdx.x; F.vcu = (F.G % 8 == 0) ? (bx % 8) * (F.G / 8) + bx / 8 : bx; }
#pragma unroll
    for (int i = 0; i < 17; ++i) F.in[i] = args.in[i];
    F.out = args.out; F.ws = args.ws;
    volatile LAS unsigned* MISC = (volatile LAS unsigned*)(F.lds + LDS_MISC);
    if (F.tid < 64) MISC[F.tid] = 0u;
    __syncthreads();
    XcdBarrier bar = xcd_barrier_post((unsigned*)(F.ws + WS_CTL) + CW_BAR + args.li * XCD_BAR_WORDS, MISC + 8);
#define IN(k) (args.ph_lo <= (k) && (k) < args.ph_hi)
#ifdef PROBE_MASK
    unsigned long long pr_acc = 0, pr_t0 = 0; const bool pr_me = (blockIdx.x == 0 && threadIdx.x == 0);
#define PR_BEGIN(k) do { if (pr_me && ((PROBE_MASK >> (k)) & 1ull)) pr_t0 = __builtin_amdgcn_s_memrealtime(); } while (0)
#define PR_END(k) do { if (pr_me && ((PROBE_MASK >> (k)) & 1ull)) pr_acc += __builtin_amdgcn_s_memrealtime() - pr_t0; } while (0)
#else
#define PR_BEGIN(k) do {} while (0)
#define PR_END(k) do {} while (0)
#endif
#define SEAM(k) do { if (IN(k) && IN((k) + 1)) xcd_barrier(bar); PR_END(k); } while (0)
    PR_BEGIN(0); if (IN(0)) p0_prologue(F);
    SEAM(0);
#pragma unroll 1
    for (int ch = 0; ch < NCH; ++ch) {
        PR_BEGIN(1 + 2 * ch);
        if (IN(1 + 2 * ch)) {
            constexpr int NWG1 = (TC / 256) * (NIN / 256);
            const int nfull = NWG1 % F.G, bx = (int)blockIdx.x;
            if (ch > 0 && nfull == 0) p2_combine(F, ch - 1, F.vcu, F.G);
            p1_inproj(F, ch);
            if (ch > 0 && nfull != 0 && bx >= nfull) p2_combine(F, ch - 1, bx - nfull, F.G - nfull);
        }
        SEAM(1 + 2 * ch);
        PR_BEGIN(2 + 2 * ch); if (IN(2 + 2 * ch)) p2_attn(F, ch);
        SEAM(2 + 2 * ch);
    }
    PR_BEGIN(2 * NCH + 1); if (IN(2 * NCH + 1)) p2_combine(F, NCH - 1, F.vcu, F.G);
    SEAM(2 * NCH + 1);
    PR_BEGIN(2 * NCH + 2); if (IN(2 * NCH + 2)) p3_merge(F);
    SEAM(2 * NCH + 2);
    PR_BEGIN(2 * NCH + 3); if (IN(2 * NCH + 3)) p4_outproj(F);
    SEAM(2 * NCH + 3);
    PR_BEGIN(2 * NCH + 4); if (IN(2 * NCH + 4)) p5_route(F);
    SEAM(2 * NCH + 4);
    PR_BEGIN(2 * NCH + 5); if (IN(2 * NCH + 5)) p6a_gateup(F);
    SEAM(2 * NCH + 5);
    PR_BEGIN(2 * NCH + 6); if (IN(2 * NCH + 6)) p6b_down(F);
    SEAM(2 * NCH + 6);
    PR_BEGIN(2 * NCH + 7); if (IN(2 * NCH + 7)) p7_final(F);
    PR_END(2 * NCH + 7);
#ifdef PROBE_MASK
    if (pr_me) { const unsigned long long t1 = __builtin_amdgcn_s_memrealtime(); while (__builtin_amdgcn_s_memrealtime() - t1 < pr_acc) __builtin_amdgcn_s_sleep(4); }
#endif
#undef IN
#undef SEAM
}

#ifndef N_LAUNCHES
#define N_LAUNCHES 1
#endif
extern "C" void kernel_launch(void* const* d_in, const int* in_sizes, int n_in, void* d_out, int out_size, void* d_ws, size_t ws_size, hipStream_t stream) {
    static int grid = 0;
    if (grid == 0) {
        if (n_in != 17 || in_sizes[0] != T * D || out_size != T * D || ws_size < WS_END) { fprintf(stderr, "kernel_launch: unexpected shapes / workspace (%d inputs, ws %zu)\n", n_in, ws_size); grid = -1; return; }
        int dev = 0, cus = 0;
        if (hipGetDevice(&dev) != hipSuccess || hipDeviceGetAttribute(&cus, hipDeviceAttributeMultiprocessorCount, dev) != hipSuccess) { grid = -1; return; }
        if (hipFuncSetAttribute((const void*)fwd_kernel, hipFuncAttributeMaxDynamicSharedMemorySize, LDS_BYTES) != hipSuccess) { fprintf(stderr, "kernel_launch: hipFuncSetAttribute failed\n"); grid = -1; return; }
        int per_cu = 0;
        if (hipOccupancyMaxActiveBlocksPerMultiprocessor(&per_cu, (const void*)fwd_kernel, NTHR, LDS_BYTES) != hipSuccess || per_cu < 1) fprintf(stderr, "kernel_launch: occupancy query says %d\n", per_cu);
        (void)hipGetLastError();
        grid = cus;
    }
    if (grid < 0) return;
    (void)hipMemsetAsync((char*)d_ws + WS_CTL, 0, N_LAUNCHES == 1 ? (size_t)(CW_BAR + XCD_BAR_WORDS) * 4 : CTL_BYTES, stream);
    KArgs a{};
    for (int i = 0; i < 17; ++i) a.in[i] = (const float*)d_in[i];
    a.out = (float*)d_out; a.ws = (unsigned char*)d_ws;
    for (int li = 0; li < N_LAUNCHES; ++li) {
        a.ph_lo = (int)((long)NPHASE * li / N_LAUNCHES); a.ph_hi = (int)((long)NPHASE * (li + 1) / N_LAUNCHES); a.li = li;
        hipLaunchKernelGGL(fwd_kernel, dim3(grid), dim3(NTHR), LDS_BYTES, stream, a);
    }
}
```

```cpp
#include <hip/hip_runtime.h>
#include <cstdint>
#include <cstdio>

#define GAS __attribute__((address_space(1)))
#define LAS __attribute__((address_space(3)))
typedef unsigned short bf16;
typedef short bf16x8 __attribute__((ext_vector_type(8)));
typedef float f32x4 __attribute__((ext_vector_type(4)));
typedef unsigned v4u __attribute__((ext_vector_type(4)));
typedef unsigned v2u __attribute__((ext_vector_type(2)));
typedef GAS unsigned gu32;

constexpr int T = 32768, D = 1024, SEQ = 4096, NIN = 7936;
constexpr int A_W = 4608, B_W = 1280, G_W = 2048, Y_W = 1536;
constexpr int NE = 32, DE = 256;
constexpr int NCH = 4, TC = T / NCH;
constexpr float QSCALE = 0.125f * 1.4426950408889634f;
constexpr float LOG2E = 1.4426950408889634f;
constexpr float RMS_EPS = 1e-6f;
#ifndef P1_FP8
#define P1_FP8 1
#endif
constexpr float W8_SCALE = P1_FP8 ? 64.0f : 0.0f, W8_INV = P1_FP8 ? 1.0f / 64.0f : 1.0f;
#ifndef P6_FP8
#define P6_FP8 1
#endif
#ifndef P34_FP8
#define P34_FP8 1
#endif
constexpr float Y8_SCALE = 16.0f, W34_SCALE = 64.0f, MG8_SCALE = 32.0f;
#ifndef YS_FP8
#define YS_FP8 1
#endif
constexpr float YS8_SCALE = 16.0f;
constexpr float WG8_SCALE = P6_FP8 ? 64.0f : 0.0f, WD8_SCALE = P6_FP8 ? 32.0f : 0.0f, H8_SCALE = 32.0f;
constexpr int NWAVES = 8, NTHR = 512;

constexpr size_t MiB = 1u << 20;
constexpr size_t WS_CTL = 0, CTL_BYTES = 1 * MiB;
constexpr size_t WS_BIASP = ((size_t)1 << 20) + 4096;
constexpr size_t WS_INVF = 1 * MiB;
constexpr size_t WS_WRF = 2 * MiB;
constexpr size_t WS_TOKOF = 3 * MiB;
constexpr size_t WS_WTOF = 7 * MiB;
constexpr size_t WS_TPOS = 15 * MiB;
constexpr size_t WS_WIN = 16 * MiB;
constexpr size_t WS_WAB = 32 * MiB;
constexpr size_t WS_WO = 35 * MiB;
constexpr size_t WS_WGU = 37 * MiB;
constexpr size_t WS_WD = 69 * MiB;
constexpr size_t WS_G = 86 * MiB;
constexpr size_t WS_Y = 214 * MiB;
constexpr size_t WS_ZA = 310 * MiB;
constexpr size_t WS_ZB = 454 * MiB;
constexpr size_t WS_END = 494 * MiB;
constexpr size_t WS_MG = WS_ZA;
constexpr size_t WS_X1B = WS_ZA + 64 * MiB;
constexpr size_t WS_X1F8 = WS_Y + 64 * MiB;
constexpr size_t WS_HACT = WS_G;
constexpr size_t WS_YS = WS_G + 36 * MiB;
constexpr size_t DO_DELTA = 0;
constexpr size_t DO_HN = 0;
constexpr size_t DO_OG = 64 * MiB;
constexpr size_t DO_LSE = 112 * MiB;
constexpr int MAXSLOT = 2 * T + NE * 256;
static_assert(WS_ZA + (size_t)TC * A_W * 2 <= WS_ZB && WS_ZB + (size_t)TC * B_W * 2 <= WS_END && WS_Y + (size_t)T * Y_W * 2 <= WS_ZA && WS_G + (size_t)T * G_W * 2 <= WS_Y, "ws map");
static_assert(WS_MG + (size_t)T * D * 2 <= WS_END && WS_HACT + (size_t)MAXSLOT * DE * 2 <= WS_YS && WS_YS + (size_t)MAXSLOT * D * 2 <= WS_ZA && WS_X1B >= WS_MG + (size_t)T * D * 2 && WS_X1B + (size_t)T * D * 2 <= WS_ZB, "ws map");
static_assert(DO_OG + (size_t)3 * TC * 512 * 2 <= DO_LSE && DO_LSE + (size_t)3 * TC * 8 * 4 <= (size_t)T * D * 4 && DO_HN + (size_t)T * D * 2 <= DO_OG, "d_out scratch map");
constexpr int CW_CNT = 1024;
constexpr int CW_BAR = 4096;
constexpr int LDS_BYTES = 147456;
constexpr int LDS_MISC = 131072;

__device__ __forceinline__ unsigned f2bf(float f) { unsigned u = __builtin_bit_cast(unsigned, f); return (u + 0x7fffu + ((u >> 16) & 1u)) >> 16; }
__device__ __forceinline__ unsigned pk4_fp8(float a, float b, float c, float d) {
    a = __builtin_amdgcn_fmed3f(a, -448.f, 448.f); b = __builtin_amdgcn_fmed3f(b, -448.f, 448.f); c = __builtin_amdgcn_fmed3f(c, -448.f, 448.f); d = __builtin_amdgcn_fmed3f(d, -448.f, 448.f);
    int w = 0; w = __builtin_amdgcn_cvt_pk_fp8_f32(a, b, w, false); w = __builtin_amdgcn_cvt_pk_fp8_f32(c, d, w, true); return (unsigned)w; }
__device__ __forceinline__ unsigned pk2(float lo, float hi) { return f2bf(lo) | (f2bf(hi) << 16); }
__device__ __forceinline__ float bf2f(unsigned b) { return __builtin_bit_cast(float, b << 16); }
__device__ __forceinline__ float bflo(unsigned u) { return __builtin_bit_cast(float, u << 16); }
__device__ __forceinline__ float bfhi(unsigned u) { return __builtin_bit_cast(float, u & 0xffff0000u); }
__device__ __forceinline__ float wave_sum(float v) {
#pragma unroll
    for (int o = 1; o < 64; o <<= 1) v += __shfl_xor(v, o);
    return v;
}
__device__ __forceinline__ float wave_max(float v) {
#pragma unroll
    for (int o = 1; o < 64; o <<= 1) v = fmaxf(v, __shfl_xor(v, o));
    return v;
}
typedef float f32x2_t __attribute__((ext_vector_type(2)));
typedef __bf16 bf16x2_t __attribute__((ext_vector_type(2)));
__device__ __forceinline__ unsigned cvtpk(float lo, float hi) { f32x2_t v = {lo, hi}; bf16x2_t b = __builtin_convertvector(v, bf16x2_t); return __builtin_bit_cast(unsigned, b); }
#ifndef WT_STORES
#define WT_STORES 0
#endif
__device__ __forceinline__ __amdgpu_buffer_rsrc_t wt_rsrc(unsigned char* base) { return __builtin_amdgcn_make_buffer_rsrc(base, 0, 0x7ffffffc, 0x00020000); }
__device__ __forceinline__ void st16(__amdgpu_buffer_rsrc_t r, unsigned char* base, void* p, v4u v) { if (WT_STORES) __builtin_amdgcn_raw_buffer_store_b128(v, r, (unsigned)((unsigned char*)p - base), 0, 16); else *(GAS v4u*)p = v; }
__device__ __forceinline__ void st8(__amdgpu_buffer_rsrc_t r, unsigned char* base, void* p, v2u v) { if (WT_STORES) __builtin_amdgcn_raw_buffer_store_b64(v, r, (unsigned)((unsigned char*)p - base), 0, 16); else *(GAS v2u*)p = v; }
#define LDS_WAIT() asm volatile("s_waitcnt lgkmcnt(0)" ::: "memory")
#define VM_WAIT() asm volatile("s_waitcnt vmcnt(0)" ::: "memory")

#define XB_TMO      128
#define XB_XCNT(j)  (256  + 64 * (j))
#define XB_XSUB(j)  (1280 + 64 * (j))
#define XB_XGEN(j)  (2304 + 64 * (j))
#define XB_TOP      3328
#define XB_TOPGEN   3392
#define XCD_BAR_WORDS 3456
#define XB_SPIN_CAP (1u << 18)
__device__ __forceinline__ unsigned xb_ld(unsigned* p)              { return __hip_atomic_load(p, __ATOMIC_RELAXED, __HIP_MEMORY_SCOPE_AGENT); }
__device__ __forceinline__ unsigned xb_add(unsigned* p, unsigned v) { return __hip_atomic_fetch_add(p, v, __ATOMIC_RELAXED, __HIP_MEMORY_SCOPE_AGENT); }
__device__ __forceinline__ unsigned xb_xcc_id() { return (unsigned)__builtin_amdgcn_s_getreg((3 << 11) | 20) & 0xFu; }
#define XB_SPIN(cond, bar) do { unsigned _sp = 0; while (cond) { __builtin_amdgcn_s_sleep(1); \
    if ((++_sp & 255u) == 0u) { if (xb_ld(&(bar)[XB_TMO])) break; if (_sp > XB_SPIN_CAP) { atomicAdd(&(bar)[XB_TMO], 1u); break; } } } } while (0)
struct XcdBarrier { unsigned* bar; unsigned x; volatile LAS unsigned* st; };
__device__ __forceinline__ XcdBarrier xcd_barrier_post(unsigned* bar, volatile LAS unsigned* st) {
    XcdBarrier b; b.bar = bar; b.x = xb_xcc_id(); b.st = st;
    if (threadIdx.x == 0) (void)xb_add(&bar[XB_XCNT(b.x)], 1u);
    return b;
}
__device__ __forceinline__ void xcd_barrier_complete(unsigned* bar, unsigned x, unsigned& nloc, unsigned& nx) {
    const unsigned G = gridDim.x * gridDim.y * gridDim.z;
    unsigned sum, cnt, mine, sp = 0u;
    for (;;) {
        sum = 0u; cnt = 0u; mine = 0u;
#pragma unroll
        for (unsigned j = 0; j < 16; ++j) { const unsigned c = xb_ld(&bar[XB_XCNT(j)]); sum += c; cnt += (c > 0u) ? 1u : 0u; mine = (j == x) ? c : mine; }
        if (sum == G) break;
        __builtin_amdgcn_s_sleep(1);
        if ((++sp & 255u) == 0u) { if (xb_ld(&bar[XB_TMO])) break; if (sp > XB_SPIN_CAP) { atomicAdd(&bar[XB_TMO], 1u); break; } }
    }
    nloc = mine > 0u ? mine : 1u; nx = cnt > 0u ? cnt : 1u;
}
__device__ __forceinline__ void xcd_barrier(const XcdBarrier& b) {
    asm volatile("s_waitcnt vmcnt(0)" ::: "memory");
    __syncthreads();
    int t_ = threadIdx.x; asm volatile("" : "+v"(t_));
    if (t_ == 0) {
        unsigned* bar = b.bar;
        __builtin_amdgcn_s_waitcnt(0);
        unsigned nloc = b.st[0], nx = b.st[1];
        if (nloc == 0u) { xcd_barrier_complete(bar, b.x, nloc, nx); b.st[0] = nloc; b.st[1] = nx; }
        const unsigned old = xb_add(&bar[XB_XSUB(b.x)], 1u);
        const unsigned gen = old / nloc;
        if (old + 1u == (gen + 1u) * nloc) {
            __builtin_amdgcn_fence(__ATOMIC_RELEASE, "agent");
            asm volatile("s_waitcnt vmcnt(0)" ::: "memory");
            const unsigned og = xb_add(&bar[XB_TOP], 1u);
            const unsigned tg = og / nx;
            if (og + 1u == (tg + 1u) * nx) xb_add(&bar[XB_TOPGEN], 1u);
            else XB_SPIN(xb_ld(&bar[XB_TOPGEN]) == tg, bar);
            __builtin_amdgcn_fence(__ATOMIC_ACQUIRE, "agent");
            xb_add(&bar[XB_XGEN(b.x)], 1u);
            asm volatile("s_waitcnt vmcnt(0)" ::: "memory");
        } else {
            XB_SPIN(xb_ld(&bar[XB_XGEN(b.x)]) == gen, bar);
            __builtin_amdgcn_fence(__ATOMIC_ACQUIRE, "agent");
            asm volatile("s_waitcnt vmcnt(0)" ::: "memory");
        }
    }
    __syncthreads();
}

struct KArgs { const float* in[17]; float* out; unsigned char* ws; int ph_lo, ph_hi, li, pad; };
struct Frame {
    LAS unsigned char* lds;
    int tid, lane, wave, vcu, G;
    const float* in[17]; float* out; unsigned char* ws;
};
enum { I_X = 0, I_WIN, I_BIN, I_SINK, I_WPA, I_WPB, I_WOUT, I_GMIX, I_GFFN, I_WRG, I_BRG, I_WRE, I_BRE, I_WEG, I_WEU, I_WED, I_GFIN };

struct TrDesc { const float* W; int N; bf16* WT; int ldo, rowbase, koff, k0, n0; bool perm; const float* kscale; float f8scale; };
__device__ __forceinline__ void tr_load(const TrDesc& d, int lane, f32x4 (&tv)[8], float (&ks)[8]) {
    const float* src = d.W + (size_t)(d.k0 + (lane >> 3)) * d.N + d.n0 + 4 * (lane & 7);
#pragma unroll
    for (int i = 0; i < 8; ++i) tv[i] = *(const GAS f32x4*)(src + (size_t)(8 * i) * d.N);
#pragma unroll
    for (int i = 0; i < 8; ++i) ks[i] = d.kscale ? d.kscale[d.k0 + 8 * i + (lane >> 3)] : 1.0f;
}
__device__ __forceinline__ void tr_finish(const TrDesc& d, LAS float* scr, int lane, const f32x4 (&tv)[8], const float (&ks)[8]) {
#pragma unroll
    for (int i = 0; i < 8; ++i) { const int kk = 8 * i + (lane >> 3); LAS float* w = scr + kk * 33 + 4 * (lane & 7);
        w[0] = tv[i][0] * ks[i]; w[1] = tv[i][1] * ks[i]; w[2] = tv[i][2] * ks[i]; w[3] = tv[i][3] * ks[i]; }
    LDS_WAIT(); asm volatile("" ::: "memory");
    const int c = lane & 7;
#pragma unroll
    for (int j = 0; j < 4; ++j) { const int n = (lane >> 3) + 8 * j; const LAS float* s = scr + (8 * c) * 33 + n;
        const int rr = d.perm ? 8 * (n >> 2) + (n & 3) : n;
        if (d.f8scale != 0.f) { const float f = d.f8scale; v2u o8; o8.x = pk4_fp8(s[0 * 33] * f, s[1 * 33] * f, s[2 * 33] * f, s[3 * 33] * f); o8.y = pk4_fp8(s[4 * 33] * f, s[5 * 33] * f, s[6 * 33] * f, s[7 * 33] * f);
            *(GAS v2u*)((unsigned char*)d.WT + (size_t)(d.rowbase + rr) * d.ldo + d.koff + d.k0 + 8 * c) = o8; }
        else { v4u o; o.x = pk2(s[0 * 33], s[1 * 33]); o.y = pk2(s[2 * 33], s[3 * 33]); o.z = pk2(s[4 * 33], s[5 * 33]); o.w = pk2(s[6 * 33], s[7 * 33]);
            *(GAS v4u*)(d.WT + (size_t)(d.rowbase + rr) * d.ldo + d.koff + d.k0 + 8 * c) = o; } }
    LDS_WAIT(); asm volatile("" ::: "memory");
}
__device__ __forceinline__ void rms_row_to_bf16(const float* xrow, const float* g, bf16* orow, int lane) {
    const GAS f32x4* xr = (const GAS f32x4*)xrow + lane; const GAS f32x4* gr = (const GAS f32x4*)g + lane;
    f32x4 v[4]; float s = 0.f;
#pragma unroll
    for (int j = 0; j < 4; ++j) { v[j] = xr[64 * j]; s += (v[j].x * v[j].x + v[j].y * v[j].y) + (v[j].z * v[j].z + v[j].w * v[j].w); }
    const float rstd = 1.0f / sqrtf(wave_sum(s) * (1.f / D) + RMS_EPS);
    GAS v2u* o8 = (GAS v2u*)orow + lane;
#pragma unroll
    for (int j = 0; j < 4; ++j) { const f32x4 gg = gr[64 * j]; v2u w; w.x = pk2(v[j].x * rstd * gg.x, v[j].y * rstd * gg.y); w.y = pk2(v[j].z * rstd * gg.z, v[j].w * rstd * gg.w); o8[64 * j] = w; }
}
__device__ __forceinline__ void p0_prologue(Frame& F) {
    int tid_ = threadIdx.x; asm volatile("" : "+v"(tid_)); const int lane_ = tid_ & 63;
    LAS float* scr = (LAS float*)(F.lds + F.wave * 16384);
    const int gw = F.vcu * NWAVES + F.wave, NGW = F.G * NWAVES;
    unsigned char* ws = F.ws;
    constexpr int I_IN = 16 * 248, I_PA = 8 * 32, I_PB = 16 * 32, I_WO = 16 * 32, I_EG = 32 * 16 * 8, I_ED = 32 * 4 * 32;
    constexpr int NITEMS = I_IN + I_PA + I_PB + I_WO + 2 * I_EG + I_ED;
    auto decode = [&](int it, TrDesc& d) {
        int r = it; d.perm = false; d.kscale = nullptr; d.f8scale = 0.f; d.koff = 0;
        if (r < I_IN) { const int kb = r / 248, nb = r % 248, n0 = 32 * nb; const bool qk = (n0 < 3072) || (n0 >= A_W && n0 < A_W + 1152);
            const bool gt_ = n0 >= A_W + B_W; const int gc = n0 - (A_W + B_W);
            d.W = F.in[I_WIN]; d.N = NIN; d.WT = (bf16*)(ws + WS_WIN); d.ldo = 1024; d.rowbase = qk ? (n0 & ~63) + ((n0 >> 5) & 1) * 4 : (gt_ ? A_W + B_W + 2 * (gc % 1024) + 4 * (gc / 1024) : n0); d.k0 = 64 * kb; d.n0 = n0; d.perm = qk || gt_; d.f8scale = W8_SCALE; return; } r -= I_IN;
        if (r < I_PA) { const int kb = r / 32, nb = r % 32; d.W = F.in[I_WPA]; d.N = 1024; d.WT = (bf16*)(ws + WS_WAB); d.ldo = 1536; d.rowbase = 32 * nb; d.k0 = 64 * kb; d.n0 = 32 * nb; if (P34_FP8) d.f8scale = W34_SCALE; return; } r -= I_PA;
        if (r < I_PB) { const int kb = r / 32, nb = r % 32; d.W = F.in[I_WPB]; d.N = 1024; d.WT = (bf16*)(ws + WS_WAB); d.ldo = 1536; d.rowbase = 32 * nb; d.koff = 512; d.k0 = 64 * kb; d.n0 = 32 * nb; if (P34_FP8) d.f8scale = W34_SCALE; return; } r -= I_PB;
        if (r < I_WO) { const int kb = r / 32, nb = r % 32; d.W = F.in[I_WOUT]; d.N = 1024; d.WT = (bf16*)(ws + WS_WO); d.ldo = 1024; d.rowbase = 32 * nb; d.k0 = 64 * kb; d.n0 = 32 * nb; if (P34_FP8) d.f8scale = W34_SCALE; return; } r -= I_WO;
        if (r < 2 * I_EG) { const int up = r >= I_EG; if (up) r -= I_EG; const int e = r / 128, q = r % 128, kb = q / 8, nb = q % 8;
            d.W = F.in[up ? I_WEU : I_WEG] + (size_t)e * 1024 * 256; d.N = 256; d.WT = (bf16*)(ws + WS_WGU) + (size_t)e * 512 * 1024; d.ldo = 1024; d.rowbase = 64 * nb + (up ? 4 : 0); d.k0 = 64 * kb; d.n0 = 32 * nb; d.perm = true; d.kscale = F.in[I_GFFN]; d.f8scale = WG8_SCALE; if (P6_FP8) d.WT = (bf16*)((unsigned char*)(ws + WS_WGU) + (size_t)e * 512 * 1024); return; } r -= 2 * I_EG;
        { const int e = r / 128, q = r % 128, kb = q / 32, nb = q % 32;
            d.W = F.in[I_WED] + (size_t)e * 256 * 1024; d.N = 1024; d.WT = (bf16*)(ws + WS_WD) + (size_t)e * 1024 * 256; d.ldo = 256; d.rowbase = 32 * nb; d.k0 = 64 * kb; d.n0 = 32 * nb; d.f8scale = WD8_SCALE; if (P6_FP8) d.WT = (bf16*)((unsigned char*)(ws + WS_WD) + (size_t)e * 1024 * 256); }
    };
    {
        int it = gw; TrDesc dc, dn; f32x4 tc[8], tn[8]; float kc[8], kn[8];
        bool hc = it < NITEMS; if (hc) { decode(it, dc); tr_load(dc, lane_, tc, kc); }
        while (hc) {
            it += NGW; const bool hn = it < NITEMS;
            if (hn) { decode(it, dn); tr_load(dn, lane_, tn, kn); }
            tr_finish(dc, scr, lane_, tc, kc);
            hc = hn; dc = dn;
#pragma unroll
            for (int i = 0; i < 8; ++i) { tc[i] = tn[i]; kc[i] = kn[i]; }
        }
    }
    for (int m = gw; m < T; m += 4 * NGW) {
        const GAS f32x4* gr = (const GAS f32x4*)F.in[I_GMIX] + lane_;
        f32x4 v[4][4]; float ss[4];
#pragma unroll
        for (int r = 0; r < 4; ++r) { const int mr = (m + r * NGW < T) ? m + r * NGW : m; const GAS f32x4* xr = (const GAS f32x4*)(F.in[I_X] + (size_t)mr * D) + lane_;
#pragma unroll
            for (int j = 0; j < 4; ++j) v[r][j] = xr[64 * j]; }
#pragma unroll
        for (int r = 0; r < 4; ++r) { float a = 0.f;
#pragma unroll
            for (int j = 0; j < 4; ++j) a += (v[r][j].x * v[r][j].x + v[r][j].y * v[r][j].y) + (v[r][j].z * v[r][j].z + v[r][j].w * v[r][j].w);
            ss[r] = 1.0f / sqrtf(wave_sum(a) * (1.f / D) + RMS_EPS); }
#pragma unroll
        for (int r = 0; r < 4; ++r) { if (m + r * NGW >= T) continue; GAS unsigned* o4 = (GAS unsigned*)((unsigned char*)F.out + DO_HN + (size_t)(m + r * NGW) * D) + lane_;
#pragma unroll
            for (int j = 0; j < 4; ++j) { const f32x4 gg = gr[64 * j];
                if (P1_FP8) o4[64 * j] = pk4_fp8(v[r][j].x * ss[r] * gg.x, v[r][j].y * ss[r] * gg.y, v[r][j].z * ss[r] * gg.z, v[r][j].w * ss[r] * gg.w);
                else { v2u w; w.x = cvtpk(v[r][j].x * ss[r] * gg.x, v[r][j].y * ss[r] * gg.y); w.y = cvtpk(v[r][j].z * ss[r] * gg.z, v[r][j].w * ss[r] * gg.w); ((GAS v2u*)((unsigned char*)F.out + DO_HN + (size_t)(m + r * NGW) * D * 2) + lane_)[64 * j] = w; } } }
    }
    const int gt = F.vcu * NTHR + tid_, NGT = F.G * NTHR;
    if (gt < 32) ((float*)(ws + WS_INVF))[gt] = (float)exp2(-(double)gt * (13.287712379549449 / 32.0));
    for (int c = gt; c < NIN; c += NGT) {
        int s = c; const int e = c & 7;
        if (c < 3072 || (c >= A_W && c < A_W + 1152)) s = (c & ~63) + 4 * ((c & 63) >> 3) + (e < 4 ? e : 28 + e);
        else if (c >= A_W + B_W) s = A_W + B_W + 4 * ((c - A_W - B_W) >> 3) + (e < 4 ? e : 1020 + e);
        ((float*)(ws + WS_BIASP))[c] = F.in[I_BIN][s];
    }
    for (int i = gt; i < 32 * 3 * 64; i += NGT) {
        const int ln = i & 63, nb = (i >> 6) % 3, ks = i / 192;
        const int n = 16 * nb + (ln & 15);
        float hi[8], lo[8];
#pragma unroll
        for (int e = 0; e < 8; ++e) { const int k = 32 * ks + 8 * (ln >> 4) + e; float v = 0.f;
            if (n < 4) v = F.in[I_WRG][k * 4 + n]; else if (n < 36) v = F.in[I_WRE][k * 32 + (n - 4)];
            v *= F.in[I_GFFN][k]; hi[e] = bf2f(f2bf(v)); lo[e] = v - hi[e]; }
        v4u h, l; h.x = pk2(hi[0], hi[1]); h.y = pk2(hi[2], hi[3]); h.z = pk2(hi[4], hi[5]); h.w = pk2(hi[6], hi[7]);
        l.x = pk2(lo[0], lo[1]); l.y = pk2(lo[2], lo[3]); l.z = pk2(lo[4], lo[5]); l.w = pk2(lo[6], lo[7]);
        ((v4u*)(ws + WS_WRF))[((ks * 3 + nb) * 2 + 0) * 64 + ln] = h; ((v4u*)(ws + WS_WRF))[((ks * 3 + nb) * 2 + 1) * 64 + ln] = l;
    }
}

namespace pg8 {
#define PG8_LAS __attribute__((address_space(3)))
typedef unsigned short bf16_t;
typedef short bf16x8 __attribute__((ext_vector_type(8)));
typedef float f32x4 __attribute__((ext_vector_type(4)));
typedef unsigned u32x4 __attribute__((ext_vector_type(4)));
constexpr int BM = 256, BK = 64, HALF = 128, HTB = HALF * BK * 2  , STAGE_BYTES = 8 * HTB, NXCD = 8, WGM = 8;

__host__ __device__ __forceinline__ int lds_byte(int r, int c) { const int st = (r >> 4) * 2 + (c >> 5), rr = r & 15, cc = c & 31, ob = rr * 64 + cc * 2; return st * 1024 + (ob ^ (((ob >> 9) & 1) << 5)); }
__host__ __device__ __forceinline__ void stage_rc(int b, int& R, int& C) { const int st = b / 1024, sb = b % 1024, swz = sb ^ (((sb >> 9) & 1) << 5); R = (st >> 1) * 16 + swz / 64; C = (st & 1) * 32 + (swz % 64) / 2; }
__host__ __device__ __forceinline__ int perm32(int rho) { const int n = rho >> 4, i = rho & 15; return 8 * (i >> 2) + 4 * n + (i & 3); }

struct Unit { int pm, pn; };
struct Gemm { const bf16_t* A; const bf16_t* Bt; int M, N, K; };

struct StaticOrder {
    int nM, nN, nwg, G, c;
    __host__ __device__ void init(int M, int N, int G_, int c_) { nM = M / BM; nN = N / BM; nwg = nM * nN; G = G_; c = c_; }
    __host__ __device__ bool next(int i, Unit& u) const {
        const long L = (long)i * G + c; if (L >= nwg) return false;
        int wgid = (int)L; { const int q = nwg / NXCD, r = nwg % NXCD, xcd = wgid % NXCD, off = wgid / NXCD; wgid = (xcd < r ? xcd * (q + 1) : r * (q + 1) + (xcd - r) * q) + off; }
        const int nig = WGM * nN, gid = wgid / nig, fm = gid * WGM, gsz = (nM - fm) < WGM ? (nM - fm) : WGM;
        u.pm = fm + ((wgid % nig) % gsz); u.pn = (wgid % nig) / gsz; return true;
    }
    __device__ __forceinline__ void a_ready(const Unit&) const {}
    __device__ __forceinline__ void done(const Unit&) const {}
};
}


namespace pg9 {
using pg8::BM; using pg8::BK; using pg8::HALF; using pg8::HTB; using pg8::lds_byte; using pg8::stage_rc; using pg8::perm32;
struct Unit { int pm, pn, e; };
typedef int v8i_t __attribute__((ext_vector_type(8)));
typedef int v4i_t __attribute__((ext_vector_type(4)));
template <int ESZ, class Epi, class Sched, class AOff, class BBase>
__device__ __forceinline__ void gemm_phase(LAS unsigned char* lds, const char* Abase, int K, const Sched& S, const Epi& E, const AOff& aoffn, const BBase& bbase) {
    int tid_ = threadIdx.x; asm volatile("" : "+v"(tid_));
    const int tid = tid_, wid = __builtin_amdgcn_readfirstlane(tid >> 6), lane = tid & 63, wr = wid >> 2, wc = wid & 3, fr = lane & 15, fq = lane >> 4;
    const int nt = K * ESZ / (BK * 2);
    int Rr[2], Cc[2]; unsigned voffB[2];
#pragma unroll
    for (int i = 0; i < 2; ++i) { int R, C; stage_rc(tid * 16 + i * 8192, R, C); const int Rb = Epi::PERM ? ((R & ~31) + perm32(R & 31)) : R; Rr[i] = R; Cc[i] = C; voffB[i] = (unsigned)(Rb * K * ESZ + C * 2); }
    const size_t kstep = (size_t)(BK * 2);
    const size_t hstep = (size_t)HALF * K * ESZ;
    const unsigned ldsw = (unsigned)wid * 1024u;
    const int aoff = lds_byte(wr * 64 + fr, fq * 8), boff = lds_byte(wc * 32 + fr, fq * 8);
#define PG9_SA(b, h) (((b) * 2 + (h)) * HTB)
#define PG9_SB(b, h) ((4 + (b) * 2 + (h)) * HTB)
#define PG9_STAGE(bufoff, gbase, voff) do { _Pragma("unroll") for (int _i = 0; _i < 2; ++_i) \
        __builtin_amdgcn_global_load_lds((const unsigned*)((const char*)(gbase) + (voff)[_i]), (LAS unsigned*)(lds + (bufoff) + ldsw + _i * 8192), 16, 0, 0); } while (0)
#define PG9_LDA(dst, b, h) do { _Pragma("unroll") for (int m = 0; m < 4; ++m) { dst[m].lo = *(const LAS v4i_t*)(lds + PG9_SA(b, h) + aoff + m * 2048); dst[m].hi = *(const LAS v4i_t*)(lds + PG9_SA(b, h) + aoff + m * 2048 + 1024); } } while (0)
#define PG9_LDB(dst, b, h) do { _Pragma("unroll") for (int n = 0; n < 2; ++n) { dst[n].lo = *(const LAS v4i_t*)(lds + PG9_SB(b, h) + boff + n * 2048); dst[n].hi = *(const LAS v4i_t*)(lds + PG9_SB(b, h) + boff + n * 2048 + 1024); } } while (0)
#define PG9_HALF(v, o) __builtin_bit_cast(bf16x8, __builtin_shufflevector((v), (v), (o), (o) + 1, (o) + 2, (o) + 3))
#define PG9_MMA(ai, bj, At, Bt) do { __builtin_amdgcn_s_setprio(1); _Pragma("unroll") for (int m = 0; m < 4; ++m) _Pragma("unroll") for (int n = 0; n < 2; ++n) { \
        if (ESZ == 2) { acc[ai][bj][m][n] = __builtin_amdgcn_mfma_f32_16x16x32_bf16(PG9_HALF(Bt[n], 0), PG9_HALF(At[m], 0), acc[ai][bj][m][n], 0, 0, 0); \
                        acc[ai][bj][m][n] = __builtin_amdgcn_mfma_f32_16x16x32_bf16(PG9_HALF(Bt[n], 4), PG9_HALF(At[m], 4), acc[ai][bj][m][n], 0, 0, 0); } \
        else { asm volatile("v_mfma_scale_f32_16x16x128_f8f6f4 %0, %1, %2, %0, %3, %3 op_sel_hi:[0,0,0]" : "+v"(acc[ai][bj][m][n]) : "v"(Bt[n]), "v"(At[m]), "v"(one8)); } } \
        __builtin_amdgcn_s_setprio(0); } while (0)
#define PG9_WAIT_V(n) asm volatile("s_waitcnt vmcnt(" #n ")" ::: "memory")
#define PG9_WAIT_L(n) asm volatile("s_waitcnt lgkmcnt(" #n ")" ::: "memory")
#define PG9_BAR __builtin_amdgcn_s_barrier()
#define PG9_SCHED __builtin_amdgcn_sched_barrier(0)
#define PG9_VA(dst, u) do { _Pragma("unroll") for (int _h = 0; _h < 2; ++_h) _Pragma("unroll") for (int _i = 0; _i < 2; ++_i) dst[_h][_i] = aoffn((u), _h * HALF + Rr[_i]) + (unsigned)(Cc[_i] * 2); } while (0)
    constexpr bool GATHER = AOff::GATHER;
    const size_t hstepA = (size_t)HALF * aoffn.rowbytes;
    unsigned voffA[2];
#pragma unroll
    for (int i = 0; i < 2; ++i) voffA[i] = (unsigned)Rr[i] * aoffn.rowbytes + (unsigned)(Cc[i] * 2);
#define PG9_STAGE_A(bufoff, h, koff, nx) do { if (GATHER) { PG9_STAGE(bufoff, Abase + (koff), ((nx) ? nvA[h] : cvA[h])); } else { PG9_STAGE(bufoff, ((nx) ? nAu : cAu) + (h) * hstepA + (koff), voffA); } } while (0)
    Unit cur, nxt; int ui = 0;
    if (!S.next(0, cur)) return;
    f32x4 acc[2][2][4][2];
#pragma unroll
    for (int a = 0; a < 2; ++a)
#pragma unroll
        for (int b = 0; b < 2; ++b)
#pragma unroll
            for (int m = 0; m < 4; ++m)
#pragma unroll
                for (int n = 0; n < 2; ++n) acc[a][b][m][n] = (f32x4){0.f, 0.f, 0.f, 0.f};
    int one8 = 0x7f7f7f7f; asm volatile("" : "+v"(one8));
    v8i_t At[4], B0[2], B1[2];
    unsigned cvA[2][2], nvA[2][2];
    if (GATHER) { PG9_VA(cvA, cur); }
    const char* cAu = GATHER ? Abase : Abase + (size_t)aoffn(cur, 0); const char* nAu = cAu;
    const char* cB = bbase(cur);
    E.prefetch(lds, cur, 0, wid, lane);
    PG9_STAGE(PG9_SB(0, 0), cB, voffB); PG9_STAGE(PG9_SB(0, 1), cB + hstep, voffB); PG9_STAGE_A(PG9_SA(0, 0), 0, 0, false); PG9_STAGE_A(PG9_SA(0, 1), 1, 0, false);
    if (wr == 1) PG9_BAR;
    PG9_WAIT_V(2); PG9_BAR;
    PG9_STAGE(PG9_SB(1, 0), cB + kstep, voffB); PG9_STAGE_A(PG9_SA(1, 0), 0, kstep, false); PG9_STAGE(PG9_SB(1, 1), cB + hstep + kstep, voffB);
    PG9_WAIT_V(6); PG9_BAR;
    for (;;) {
        const bool has_next = S.next(ui + 1, nxt);
        if (GATHER) {
            if (has_next) { PG9_VA(nvA, nxt); } else {
#pragma unroll
                for (int _h = 0; _h < 2; ++_h)
#pragma unroll
                    for (int _i = 0; _i < 2; ++_i) nvA[_h][_i] = cvA[_h][_i]; }
        } else nAu = has_next ? Abase + (size_t)aoffn(nxt, 0) : cAu;
        const char* nB = has_next ? bbase(nxt) : cB;
#pragma unroll 1
        for (int t = 0; t < nt; t += 2) {
            const bool last = (t == nt - 2);
            if (Epi::HOOK_T >= 0) { if (t == Epi::HOOK_T) E.hook(acc, cur, wr, wc, fr, fq); }
            const size_t k1 = (size_t)(t + 1) * kstep, k2 = last ? 0 : (size_t)(t + 2) * kstep, k3 = k2 + kstep;
            const char* b2 = last ? nB : cB + (size_t)(t + 2) * kstep; const char* b3 = b2 + kstep;
            PG9_LDB(B0, 0, 0); PG9_LDB(B1, 0, 1); PG9_SCHED; PG9_LDA(At, 0, 0); PG9_STAGE_A(PG9_SA(1, 1), 1, k1, false);
            PG9_WAIT_V(8); PG9_WAIT_L(0); PG9_BAR; PG9_MMA(0, 0, At, B0); PG9_MMA(0, 1, At, B1); PG9_BAR; PG9_SCHED;
            PG9_LDA(At, 0, 1); PG9_STAGE(PG9_SB(0, 0), b2, voffB); PG9_STAGE(PG9_SB(0, 1), b2 + hstep, voffB); PG9_STAGE_A(PG9_SA(0, 0), 0, k2, last);
            PG9_WAIT_V(8); PG9_WAIT_L(0); PG9_BAR; PG9_MMA(1, 0, At, B0); PG9_MMA(1, 1, At, B1); PG9_BAR; PG9_SCHED;
            PG9_LDB(B0, 1, 0); PG9_LDB(B1, 1, 1); PG9_SCHED; PG9_LDA(At, 1, 0); PG9_STAGE_A(PG9_SA(0, 1), 1, k2, last);
            PG9_WAIT_V(8); PG9_WAIT_L(0); PG9_BAR; PG9_MMA(0, 0, At, B0); PG9_MMA(0, 1, At, B1); PG9_BAR; PG9_SCHED;
            PG9_LDA(At, 1, 1); PG9_STAGE(PG9_SB(1, 0), b3, voffB); PG9_STAGE(PG9_SB(1, 1), b3 + hstep, voffB); PG9_STAGE_A(PG9_SA(1, 0), 0, k3, last);
            PG9_WAIT_V(8); PG9_WAIT_L(0); PG9_BAR; PG9_MMA(1, 0, At, B0); PG9_MMA(1, 1, At, B1); PG9_BAR; PG9_SCHED;
        }
        if (wr == 0) PG9_BAR;
        if (ESZ == 1) asm volatile("s_nop 15\n\ts_nop 15" ::: "memory");
        E(acc, cur, ui, wr, wc, fr, fq);
        if (!has_next) break;
#pragma unroll
        for (int a = 0; a < 2; ++a)
#pragma unroll
            for (int b = 0; b < 2; ++b)
#pragma unroll
                for (int m = 0; m < 4; ++m)
#pragma unroll
                    for (int n = 0; n < 2; ++n) acc[a][b][m][n] = (f32x4){0.f, 0.f, 0.f, 0.f};
        cur = nxt; cB = nB; cAu = nAu; ++ui;
        E.prefetch(lds, cur, ui, wid, lane);
        if (GATHER) {
#pragma unroll
            for (int _h = 0; _h < 2; ++_h)
#pragma unroll
                for (int _i = 0; _i < 2; ++_i) cvA[_h][_i] = nvA[_h][_i]; }
        if (wr == 1) PG9_BAR;
    }
    PG9_WAIT_V(0);
    PG9_BAR;
#undef PG9_SA
#undef PG9_SB
#undef PG9_STAGE
#undef PG9_LDA
#undef PG9_LDB
#undef PG9_MMA
#undef PG9_HALF
#undef PG9_WAIT_V
#undef PG9_WAIT_L
#undef PG9_BAR
#undef PG9_SCHED
#undef PG9_VA
#undef PG9_STAGE_A
}
struct DenseOrder { pg8::StaticOrder so;
    __device__ void init(int M, int N, int G, int c) { so.init(M, N, G, c); }
    __device__ bool next(int i, Unit& u) const { pg8::Unit v; if (!so.next(i, v)) return false; u.pm = v.pm; u.pn = v.pn; u.e = 0; return true; } };
struct DenseA { static constexpr bool GATHER = false; unsigned rowbytes; __device__ __forceinline__ unsigned operator()(const Unit& u, int row) const { return (unsigned)(u.pm * 256 + row) * rowbytes; } };
struct DenseB { const char* Bt; size_t tilebytes; __device__ __forceinline__ const char* operator()(const Unit& u) const { return Bt + (size_t)u.pn * tilebytes; } };
}

struct EpiInproj {
    static constexpr bool PERM = true; static constexpr int HOOK_T = -1;
    bf16* ZA; bf16* ZB; bf16* Gt; const float* biasP; LAS unsigned char* ldsb;
    __device__ __forceinline__ void hook(f32x4 (&)[2][2][4][2], const pg9::Unit&, int, int, int, int) const {}
    __device__ __forceinline__ void prefetch(LAS unsigned char* lds, const pg9::Unit& u, int ui, int wid, int lane) const {
        if (wid == 0) __builtin_amdgcn_global_load_lds((const unsigned*)(biasP + u.pn * 256 + lane * 4), (LAS unsigned*)(lds + LDS_MISC + 4096 + (ui & 1) * 1024), 16, 0, 0);
    }
    __device__ __forceinline__ void operator()(const f32x4 (&acc)[2][2][4][2], const pg9::Unit& u, int ui, int wr, int wc, int fr, int fq) const {
        asm volatile("" : "+v"(fr), "+v"(fq));
        const int row0 = u.pm * 256 + wr * 64 + fr;
        const int q = 4 * (wc & 1) + fq;
        const int fr2 = (fr >> 2) + 4 * fq, fq2 = fr & 3, paddr = 4 * (16 * (fr & 3) + 4 * fq + (fr >> 2));
        const int row0s = u.pm * 256 + wr * 64 + fr2;
        int kind[2]; bf16* dst[2]; int ldd[2]; f32x4 b0[2], b1[2];
#pragma unroll
        for (int bj = 0; bj < 2; ++bj) {
            const int colpos = u.pn * 256 + bj * 128 + wc * 32 + 8 * fq, colposs = u.pn * 256 + bj * 128 + wc * 32 + 8 * fq2, hb = u.pn * 256 + bj * 128 + (wc >> 1) * 64;
            if (hb < A_W) { const int hbi = hb >> 6; kind[bj] = hb / 1536; dst[bj] = ZA + (size_t)hbi * (TC * 64) + (colposs - hb); ldd[bj] = 2 * ((hbi % 24) >> 3); }
            else if (hb < A_W + B_W) { const int cb = hb - A_W; kind[bj] = cb < 1024 ? 0 : (cb < 1152 ? 1 : 2); dst[bj] = ZB + (size_t)(cb >> 6) * (TC * 64) + (colposs - hb); ldd[bj] = 0; }
            else { kind[bj] = 3; const int c0 = (colpos - A_W - B_W) >> 1;
                dst[bj] = Gt + ((size_t)((u.pm * 256 + wr * 64) >> 4) * 256 + (c0 >> 3)) * 128 + fr * 8 + (c0 & 7); ldd[bj] = 0; }
            const LAS float* bs = (const LAS float*)(ldsb + LDS_MISC + 4096 + (ui & 1) * 1024) + bj * 128 + wc * 32 + 8 * fq;
            b0[bj] = *(const LAS f32x4*)bs; b1[bj] = *(const LAS f32x4*)(bs + 4);
        }
        const bool need_rope = kind[0] < 2 || kind[1] < 2;
        const f32x4 fv = *(const LAS f32x4*)(ldsb + LDS_MISC + 6144 + 16 * q);
#pragma unroll
        for (int ai = 0; ai < 2; ++ai) {
            f32x4 rc[4], rs[4];
#pragma unroll
            for (int m = 0; m < 4; ++m) { rc[m] = (f32x4){1.f, 1.f, 1.f, 1.f}; rs[m] = (f32x4){0.f, 0.f, 0.f, 0.f}; }
            if (need_rope) {
#pragma unroll
                for (int m = 0; m < 4; ++m) { const float posf = (float)((row0 + ai * 128 + m * 16) & (SEQ - 1));
#pragma unroll
                    for (int e = 0; e < 4; ++e) { const float ang = posf * fv[e]; const float pr = ang * 0.15915494f; const float er = __builtin_fmaf(ang, 0.15915494f, -pr) + ang * 6.4206382e-9f;
                        const float fr = __builtin_amdgcn_fractf(pr) + er; rc[m][e] = __builtin_amdgcn_cosf(fr); rs[m][e] = __builtin_amdgcn_sinf(fr); } }
            }
#pragma unroll
            for (int bj = 0; bj < 2; ++bj) {
                const int sh = ldd[bj], posr = row0s & (SEQ - 1), ridx = (row0s & ~(SEQ - 1)) + ((posr & ((1 << sh) - 1)) << (12 - sh)) + (posr >> sh);
                bf16* p = dst[bj] + (size_t)(ridx + ai * (128 >> sh)) * 64; const unsigned step = (unsigned)((16 >> sh) * 64);
                if (kind[bj] == 3) p = dst[bj] + (size_t)(ai * 8) * 32768;
                switch (kind[bj]) {
                    case 0: store4<0>(acc[ai][bj], b0[bj], b1[bj], rc, rs, p, step, paddr); break;
                    case 1: store4<1>(acc[ai][bj], b0[bj], b1[bj], rc, rs, p, step, paddr); break;
                    case 2: store4<2>(acc[ai][bj], b0[bj], b1[bj], rc, rs, p, step, paddr); break;
                    default: store4<3>(acc[ai][bj], b0[bj], b1[bj], rc, rs, p, step, paddr); break;
                }
            }
        }
    }
    template <int KIND> static __device__ __forceinline__ void store4(const f32x4 (&a)[4][2], const f32x4 b0, const f32x4 b1, const f32x4 (&rc)[4], const f32x4 (&rs)[4], bf16* p, const unsigned step, const int paddr) {
#pragma unroll
        for (int m = 0; m < 4; ++m) {
            f32x4 v0 = a[m][0] * W8_INV + b0, v1 = a[m][1] * W8_INV + b1;
            if (KIND < 2) {
                const f32x4 cc = rc[m], ss = rs[m];
                const f32x4 t0 = v0 * cc - v1 * ss, t1 = v1 * cc + v0 * ss;
                v0 = t0; v1 = t1;
                if (KIND == 0) { v0 = v0 * QSCALE; v1 = v1 * QSCALE; }
            }
            if (KIND == 3) {
#pragma unroll
                for (int e = 0; e < 4; ++e) { const float d0 = 1.0f + __expf(-v0[e]), d1 = 1.0f + __expf(-v1[e]); v0[e] = d1 * __builtin_amdgcn_rcpf(d0); v1[e] = __builtin_amdgcn_rcpf(d1); }
                v2u w0, w1; w0.x = cvtpk(v0[0], v0[1]); w0.y = cvtpk(v0[2], v0[3]); w1.x = cvtpk(v1[0], v1[1]); w1.y = cvtpk(v1[2], v1[3]);
                *(GAS v2u*)p = w0; *(GAS v2u*)(p + 128 * 128) = w1; p += 32768;
            } else {
                v4u w; w.x = cvtpk(v0[0], v0[1]); w.y = cvtpk(v0[2], v0[3]); w.z = cvtpk(v1[0], v1[1]); w.w = cvtpk(v1[2], v1[3]);
                w.x = (unsigned)__builtin_amdgcn_ds_bpermute(paddr, (int)w.x); w.y = (unsigned)__builtin_amdgcn_ds_bpermute(paddr, (int)w.y); w.z = (unsigned)__builtin_amdgcn_ds_bpermute(paddr, (int)w.z); w.w = (unsigned)__builtin_amdgcn_ds_bpermute(paddr, (int)w.w);
                *(GAS v4u*)p = w; p += step;
            }
        }
    }
};
__device__ __forceinline__ void p1_inproj(Frame& F, int ch) {
    unsigned char* ws = F.ws;
    pg9::DenseOrder S; S.init(TC, NIN, F.G, (int)blockIdx.x);
    EpiInproj E{(bf16*)(ws + WS_ZA), (bf16*)(ws + WS_ZB), (bf16*)(ws + WS_G) + (size_t)ch * TC * G_W, (const float*)(ws + WS_BIASP), F.lds};
    { int t_ = threadIdx.x; asm volatile("" : "+v"(t_)); if (t_ < 32) ((LAS float*)(F.lds + LDS_MISC + 6144))[t_] = ((const float*)(ws + WS_INVF))[t_]; }
    constexpr int ES = P1_FP8 ? 1 : 2;
    pg9::DenseA ao{(unsigned)(D * ES)}; pg9::DenseB bb{(const char*)(ws + WS_WIN), (size_t)256 * D * ES};
    pg9::gemm_phase<ES>(F.lds, (const char*)F.out + DO_HN + (size_t)ch * TC * D * ES, D, S, E, ao, bb);
}

typedef float f32x16 __attribute__((ext_vector_type(16)));
typedef short v4i16_t __attribute__((ext_vector_type(4)));
__device__ __forceinline__ float half_max(float v) { auto rr = __builtin_amdgcn_permlane32_swap(__float_as_uint(v), __float_as_uint(v), false, false); return fmaxf(__uint_as_float(rr[0]), __uint_as_float(rr[1])); }
__device__ __forceinline__ float half_sum(float v) { auto rr = __builtin_amdgcn_permlane32_swap(__float_as_uint(v), __float_as_uint(v), false, false); return __uint_as_float(rr[0]) + __uint_as_float(rr[1]); }
__device__ __forceinline__ float max3f(float a, float b, float c) { float r; asm("v_max3_f32 %0, %1, %2, %3" : "=v"(r) : "v"(a), "v"(b), "v"(c)); return r; }
constexpr int ATT_VOFF = 49152;

struct AUnit { const bf16 *Kw, *Vw, *Qp; size_t pitch; int kk_lo, nkeys, kb0, kstart, lo; float m0; bf16* Op; long ostr; float* Lp; int o8; };
__device__ __forceinline__ void attn_decode(Frame& F, int ch, int u, int NUA, int lane, AUnit& d) {
    unsigned char* ws = F.ws;
    const int w = F.wave, c = lane & 31, h = (lane >> 5) & 1;
    if (u < NUA) {
        const bf16* ZA = (const bf16*)(ws + WS_ZA);
        const int rt = u & 15, hh = (u >> 4) & 7, gb = u >> 7, g = gb % 3, bl = gb / 3;
        const int dsh = 2 * g, dd = 1 << dsh, tsh = 4 - dsh;
        const int r = rt >> tsh, tile = rt & ((1 << tsh) - 1), i0 = tile * 256;
        const int rowb = bl * SEQ + r;
        d.pitch = 64;
        const int sl = g * 8 + hh; const long rb = (long)bl * SEQ + ((long)r << (12 - dsh));
        d.Kw = ZA + ((long)(24 + sl) * TC + rb + (i0 - 128)) * 64; d.Vw = ZA + ((long)(48 + sl) * TC + rb + (i0 - 128)) * 64;
        const long qrow = (long)rowb + (long)dd * (i0 + 32 * w + c);
        d.Qp = ZA + ((long)sl * TC + rb + i0 + 32 * w + c) * 64;
        d.kk_lo = (i0 == 0) ? 128 : 0; d.nkeys = 384; d.kb0 = w; d.kstart = (i0 == 0) ? (w < 4 ? 4 - w : 0) : 0; d.lo = 0;
        d.m0 = -1e30f;
        d.Op = (bf16*)((unsigned char*)F.out + DO_OG) + ((size_t)g * TC + (qrow - (long)dd * c)) * 512 + hh * 64; d.ostr = (long)dd * 1024;
        d.Lp = (float*)((unsigned char*)F.out + DO_LSE) + ((size_t)g * TC + qrow) * 8 + hh;
        d.o8 = 0;
    } else {
        const int u2 = u - NUA;
        const bf16* ZB = (const bf16*)(ws + WS_ZB);
        const int blk = u2 & 127, kvh = (u2 >> 7) & 1, bl = u2 >> 8;
        const int t0 = blk * 32, rowb = bl * SEQ;
        d.pitch = 64;
        d.Kw = ZB + ((long)(16 + kvh) * TC + rowb + t0 - 128) * 64; d.Vw = ZB + ((long)(18 + kvh) * TC + rowb + t0 - 128) * 64;
        const int qh = kvh * 8 + w;
        const long qrow = (long)rowb + t0 + c;
        d.Qp = ZB + ((long)qh * TC + qrow) * 64;
        d.kk_lo = t0 < 128 ? 128 - t0 : 0; d.nkeys = 160; d.kb0 = 0; d.kstart = d.kk_lo >> 5; d.lo = 1;
        d.m0 = F.in[I_SINK][qh] * LOG2E;
        d.o8 = P34_FP8;
        d.Op = P34_FP8 ? (bf16*)(ws + WS_Y + ((size_t)ch * TC + (qrow - c)) * Y_W + 512 + qh * 64) : (bf16*)(ws + WS_Y) + ((size_t)ch * TC + (qrow - c)) * Y_W + 512 + qh * 64; d.ostr = P34_FP8 ? Y_W : 2 * Y_W;
        d.Lp = nullptr;
    }
}
__device__ __forceinline__ void attn_load(const AUnit& d, int tid, int lane, v4u (&kreg)[6], v4u (&vreg)[6], bf16x8 (&qf)[4]) {
    const int skey = tid >> 3, sch = tid & 7, h = (lane >> 5) & 1;
#pragma unroll
    for (int s4 = 0; s4 < 4; ++s4) qf[s4] = *(const GAS bf16x8*)(d.Qp + 16 * s4 + 8 * h);
#pragma unroll
    for (int p = 0; p < 6; ++p) { const int kk = 64 * p + skey;
        if (kk >= d.kk_lo && kk < d.nkeys) { kreg[p] = *(const GAS v4u*)(d.Kw + (size_t)kk * d.pitch + 8 * sch); vreg[p] = *(const GAS v4u*)(d.Vw + (size_t)kk * d.pitch + 8 * sch); } }
}
__device__ __forceinline__ void attn_write(const AUnit& d, LAS unsigned char* KL, LAS unsigned char* VL, int tid, const v4u (&kreg)[6], const v4u (&vreg)[6]) {
    const int skey = tid >> 3, sch = tid & 7;
#pragma unroll
    for (int p = 0; p < 6; ++p) { const int kk = 64 * p + skey;
        if (kk >= d.kk_lo && kk < d.nkeys) {
            *(LAS v4u*)(KL + kk * 128 + ((sch ^ ((kk >> 1) & 7)) << 4)) = kreg[p];
            *(LAS v4u*)(VL + kk * 128 + ((sch * 16) ^ (((kk >> 1) & 1) << 6))) = vreg[p]; } }
}
__device__ __forceinline__ void attn_out(const AUnit& d, LAS unsigned char* OL, int lane, const f32x16& o0, const f32x16& o1, float inv) {
    asm volatile("" : "+v"(lane));
    const int c = lane & 31, h = (lane >> 5) & 1;
    if (d.o8) {
        const float sc = inv * Y8_SCALE;
#pragma unroll
        for (int g4 = 0; g4 < 4; ++g4) {
            const int bo0 = 8 * g4 + 4 * h, bo1 = 32 + bo0;
            *(LAS unsigned*)(OL + c * 64 + (((bo0 >> 4) ^ (c & 3)) << 4) + (bo0 & 15)) = pk4_fp8(o0[4 * g4 + 0] * sc, o0[4 * g4 + 1] * sc, o0[4 * g4 + 2] * sc, o0[4 * g4 + 3] * sc);
            *(LAS unsigned*)(OL + c * 64 + (((bo1 >> 4) ^ (c & 3)) << 4) + (bo1 & 15)) = pk4_fp8(o1[4 * g4 + 0] * sc, o1[4 * g4 + 1] * sc, o1[4 * g4 + 2] * sc, o1[4 * g4 + 3] * sc);
        }
        unsigned char* ob = (unsigned char*)d.Op;
#pragma unroll
        for (int j = 0; j < 2; ++j) { const int q = (lane >> 2) + 16 * j, k = lane & 3;
            const v4u v = *(const LAS v4u*)(OL + q * 64 + ((k ^ (q & 3)) << 4)); *(GAS v4u*)(ob + (long)q * d.ostr + k * 16) = v; }
    } else {
#pragma unroll
        for (int g4 = 0; g4 < 4; ++g4) {
            v2u a, b;
            a.x = cvtpk(o0[4 * g4 + 0] * inv, o0[4 * g4 + 1] * inv); a.y = cvtpk(o0[4 * g4 + 2] * inv, o0[4 * g4 + 3] * inv);
            b.x = cvtpk(o1[4 * g4 + 0] * inv, o1[4 * g4 + 1] * inv); b.y = cvtpk(o1[4 * g4 + 2] * inv, o1[4 * g4 + 3] * inv);
            const int bo0 = 16 * g4 + 8 * h, bo1 = 64 + bo0;
            *(LAS v2u*)(OL + c * 128 + (((bo0 >> 4) ^ (c & 7)) << 4) + (bo0 & 15)) = a;
            *(LAS v2u*)(OL + c * 128 + (((bo1 >> 4) ^ (c & 7)) << 4) + (bo1 & 15)) = b;
        }
        unsigned char* ob = (unsigned char*)d.Op;
#pragma unroll
        for (int j = 0; j < 4; ++j) { const int q = (lane >> 3) + 8 * j, k = lane & 7;
            const v4u v = *(const LAS v4u*)(OL + q * 128 + ((k ^ (q & 7)) << 4)); *(GAS v4u*)(ob + (long)q * d.ostr + k * 16) = v; }
    }
}
__device__ __forceinline__ void attn_compute_edge(const AUnit& d, const LAS unsigned char* KL, const LAS unsigned char* VL, LAS unsigned char* OL, int lane, const bf16x8 (&qf)[4]) {
    const int c = lane & 31, h = (lane >> 5) & 1;
    int koff[4];
    { const int kswz = (c >> 1) & 7;
#pragma unroll
      for (int s4 = 0; s4 < 4; ++s4) koff[s4] = c * 128 + (((2 * s4 + h) ^ kswz) << 4); }
    const int vrow = 4 * h + ((lane & 15) >> 2), vsw = (lane >> 3) & 1;
    const int voff0 = vrow * 128 + ((32 * ((lane >> 4) & 1) + 8 * (lane & 3)) ^ (vsw << 6)), voff1 = voff0 ^ 64;
    const float NEG = -INFINITY;
    float m = d.m0, l = (d.lo && h == 0) ? 1.f : 0.f;
    f32x16 o0, o1;
#pragma unroll
    for (int i = 0; i < 16; ++i) { o0[i] = 0.f; o1[i] = 0.f; }
    const LAS unsigned char* kbp = KL + d.kb0 * 4096; const LAS unsigned char* vbp = VL + d.kb0 * 4096;
    const int clo = c + d.lo;
#pragma unroll
    for (int kbi = 0; kbi < 5; ++kbi) {
        if (kbi >= d.kstart) {
            f32x16 p;
#pragma unroll
            for (int i = 0; i < 16; ++i) p[i] = 0.f;
#pragma unroll
            for (int s4 = 0; s4 < 4; ++s4) { const bf16x8 kf = *(const LAS bf16x8*)(kbp + kbi * 4096 + koff[s4]); p = __builtin_amdgcn_mfma_f32_32x32x16_bf16(kf, qf[s4], p, 0, 0, 0); }
            if (kbi == 0) {
#pragma unroll
                for (int i = 0; i < 16; ++i) { const int x = (i & 3) + 8 * (i >> 2) + 4 * h; if (x < clo) p[i] = NEG; }
            }
            if (kbi == 4) {
#pragma unroll
                for (int i = 0; i < 16; ++i) { const int x = (i & 3) + 8 * (i >> 2) + 4 * h; if (x > c) p[i] = NEG; }
            }
            float mt = p[0];
#pragma unroll
            for (int i = 1; i < 16; ++i) mt = fmaxf(mt, p[i]);
            mt = half_max(mt);
            const float mn = fmaxf(m, mt), alpha = __builtin_amdgcn_exp2f(m - mn);
            m = mn;
            float ps = 0.f;
#pragma unroll
            for (int i = 0; i < 16; ++i) { p[i] = __builtin_amdgcn_exp2f(p[i] - mn); ps += p[i]; }
            l = l * alpha + ps;
#pragma unroll
            for (int i = 0; i < 16; ++i) { o0[i] *= alpha; o1[i] *= alpha; }
            bf16x8 pb[2];
#pragma unroll
            for (int s2 = 0; s2 < 2; ++s2) { v4u t; t.x = cvtpk(p[8 * s2 + 0], p[8 * s2 + 1]); t.y = cvtpk(p[8 * s2 + 2], p[8 * s2 + 3]); t.z = cvtpk(p[8 * s2 + 4], p[8 * s2 + 5]); t.w = cvtpk(p[8 * s2 + 6], p[8 * s2 + 7]); pb[s2] = __builtin_bit_cast(bf16x8, t); }
#pragma unroll
            for (int s2 = 0; s2 < 2; ++s2) {
#pragma unroll
                for (int db = 0; db < 2; ++db) {
                    const LAS unsigned char* vp = vbp + kbi * 4096 + s2 * 2048 + (db ? voff1 : voff0);
                    const v4i16_t lo = __builtin_amdgcn_ds_read_tr16_b64_v4i16((LAS v4i16_t*)vp);
                    const v4i16_t hi = __builtin_amdgcn_ds_read_tr16_b64_v4i16((LAS v4i16_t*)(vp + 1024));
                    const bf16x8 vf = {lo[0], lo[1], lo[2], lo[3], hi[0], hi[1], hi[2], hi[3]};
                    if (db == 0) o0 = __builtin_amdgcn_mfma_f32_32x32x16_bf16(vf, pb[s2], o0, 0, 0, 0);
                    else o1 = __builtin_amdgcn_mfma_f32_32x32x16_bf16(vf, pb[s2], o1, 0, 0, 0);
                }
            }
        }
    }
    const float lt = half_sum(l), inv = 1.0f / lt;
    attn_out(d, OL, lane, o0, o1, inv);
    if (d.Lp) { if (h == 0) *d.Lp = m + __builtin_amdgcn_logf(lt); }
}
__device__ __forceinline__ void attn_compute(const AUnit& d, const LAS unsigned char* KL, const LAS unsigned char* VL, LAS unsigned char* OL, int lane, const bf16x8 (&qf)[4]) {
    const int c = lane & 31, h = (lane >> 5) & 1;
    int koff[4];
    { const int kswz = (c >> 1) & 7;
#pragma unroll
      for (int s4 = 0; s4 < 4; ++s4) koff[s4] = c * 128 + (((2 * s4 + h) ^ kswz) << 4); }
    const int vrow = 4 * h + ((lane & 15) >> 2), vsw = (lane >> 3) & 1;
    const int voff0 = vrow * 128 + ((32 * ((lane >> 4) & 1) + 8 * (lane & 3)) ^ (vsw << 6)), voff1 = voff0 ^ 64;
    const float NEG = -INFINITY;
    float m = d.m0;
    f32x16 o0, o1, L;
#pragma unroll
    for (int i = 0; i < 16; ++i) { o0[i] = 0.f; o1[i] = 0.f; L[i] = 0.f; }
    v4u onesu = {0x3F803F80u, 0x3F803F80u, 0x3F803F80u, 0x3F803F80u}; asm volatile("" : "+v"(onesu));
    const bf16x8 ones = __builtin_bit_cast(bf16x8, onesu);
    const LAS unsigned char* kbp = KL + d.kb0 * 4096; const LAS unsigned char* vbp = VL + d.kb0 * 4096;
    const int clo = c + d.lo;
#pragma unroll
    for (int kbi = 0; kbi < 5; ++kbi) {
        {
            constexpr bool first_dummy = false; (void)first_dummy;
            const bool first = (kbi == 0);
            const float cinit = first ? 0.f : -m;
            f32x16 p;
#pragma unroll
            for (int i = 0; i < 16; ++i) p[i] = cinit;
#pragma unroll
            for (int s4 = 0; s4 < 4; ++s4) { const bf16x8 kf = *(const LAS bf16x8*)(kbp + kbi * 4096 + koff[s4]); p = __builtin_amdgcn_mfma_f32_32x32x16_bf16(kf, qf[s4], p, 0, 0, 0); }
            if (kbi == 0) {
#pragma unroll
                for (int i = 0; i < 16; ++i) { const int x = (i & 3) + 8 * (i >> 2) + 4 * h; p[i] = x < clo ? NEG : p[i]; }
            }
            if (kbi == 4) {
#pragma unroll
                for (int i = 0; i < 16; ++i) { const int x = (i & 3) + 8 * (i >> 2) + 4 * h; p[i] = x > c ? NEG : p[i]; }
            }
            float t0 = max3f(p[0], p[4], p[8]), t1 = max3f(p[1], p[5], p[9]), t2 = max3f(p[2], p[6], p[10]), t3 = max3f(p[3], p[7], p[11]);
            t0 = max3f(t0, p[12], p[13]); t1 = max3f(t1, p[14], p[15]);
            const float mt = half_max(max3f(max3f(t0, t1, t2), t3, t3));
            if (first) {
                const float mn = fmaxf(m, mt), l0 = d.m0 > -1e29f ? __builtin_amdgcn_exp2f(m - mn) : 0.f;
                m = mn;
#pragma unroll
                for (int i = 0; i < 16; ++i) { p[i] -= mn; L[i] = l0; }
            } else if (__any(mt > 8.0f)) {
                const float dl = fmaxf(mt, 0.f), al = __builtin_amdgcn_exp2f(-dl);
                m += dl;
#pragma unroll
                for (int i = 0; i < 16; ++i) { o0[i] *= al; o1[i] *= al; L[i] *= al; p[i] -= dl; }
            }
#pragma unroll
            for (int i = 0; i < 16; ++i) p[i] = __builtin_amdgcn_exp2f(p[i]);
            bf16x8 pb[2];
#pragma unroll
            for (int s2 = 0; s2 < 2; ++s2) { v4u t; t.x = cvtpk(p[8 * s2 + 0], p[8 * s2 + 1]); t.y = cvtpk(p[8 * s2 + 2], p[8 * s2 + 3]); t.z = cvtpk(p[8 * s2 + 4], p[8 * s2 + 5]); t.w = cvtpk(p[8 * s2 + 6], p[8 * s2 + 7]); pb[s2] = __builtin_bit_cast(bf16x8, t); }
#pragma unroll
            for (int s2 = 0; s2 < 2; ++s2) {
                L = __builtin_amdgcn_mfma_f32_32x32x16_bf16(ones, pb[s2], L, 0, 0, 0);
#pragma unroll
                for (int db = 0; db < 2; ++db) {
                    const LAS unsigned char* vp = vbp + kbi * 4096 + s2 * 2048 + (db ? voff1 : voff0);
                    const v4i16_t lo = __builtin_amdgcn_ds_read_tr16_b64_v4i16((LAS v4i16_t*)vp);
                    const v4i16_t hi = __builtin_amdgcn_ds_read_tr16_b64_v4i16((LAS v4i16_t*)(vp + 1024));
                    const bf16x8 vf = {lo[0], lo[1], lo[2], lo[3], hi[0], hi[1], hi[2], hi[3]};
                    if (db == 0) o0 = __builtin_amdgcn_mfma_f32_32x32x16_bf16(vf, pb[s2], o0, 0, 0, 0);
                    else o1 = __builtin_amdgcn_mfma_f32_32x32x16_bf16(vf, pb[s2], o1, 0, 0, 0);
                }
            }
        }
    }
    const float lt = L[0], inv = 1.0f / lt;
    attn_out(d, OL, lane, o0, o1, inv);
    if (d.Lp) { if (h == 0) *d.Lp = m + __builtin_amdgcn_logf(lt); }
}
__device__ __forceinline__ void p2_attn(Frame& F, int ch) {
    int tid_ = threadIdx.x; asm volatile("" : "+v"(tid_));
    const int tid = tid_, lane = tid & 63;
    LAS unsigned char* KL = F.lds; LAS unsigned char* VL = F.lds + ATT_VOFF; LAS unsigned char* OL = F.lds + 2 * ATT_VOFF + F.wave * 4096;
    constexpr int NUA = (TC / SEQ) * 3 * 8 * 16, NUB = (TC / SEQ) * 2 * 128, NU = NUA + NUB;
    int u = F.vcu; asm volatile("" : "+s"(u));
    if (u >= NU) return;
    AUnit cur, nxt;
    v4u kreg[6], vreg[6]; bf16x8 qn[4];
    attn_decode(F, ch, u, NUA, lane, cur);
    attn_load(cur, tid, lane, kreg, vreg, qn);
    for (;;) {
        attn_write(cur, KL, VL, tid, kreg, vreg);
        bf16x8 qf[4];
#pragma unroll
        for (int s4 = 0; s4 < 4; ++s4) qf[s4] = qn[s4];
        __syncthreads();
        const int un = u + F.G; const bool has_next = un < NU;
        if (has_next) { attn_decode(F, ch, un, NUA, lane, nxt); attn_load(nxt, tid, lane, kreg, vreg, qn); }
        if (cur.kk_lo == 0) attn_compute(cur, KL, VL, OL, lane, qf); else attn_compute_edge(cur, KL, VL, OL, lane, qf);
        __syncthreads();
        if (!has_next) break;
        cur = nxt; u = un;
    }
}
__device__ __forceinline__ void p2_combine(Frame& F, int ch, int cu, int ncu) {
    int tid_ = threadIdx.x; asm volatile("" : "+v"(tid_)); const int lane_ = tid_ & 63;
    unsigned char* ws = F.ws;
    const bf16* OG = (const bf16*)((const unsigned char*)F.out + DO_OG); const float* LSE = (const float*)((const unsigned char*)F.out + DO_LSE);
    bf16* Y = (bf16*)(ws + WS_Y) + (size_t)ch * TC * Y_W; unsigned char* Y8 = ws + WS_Y + (size_t)ch * TC * Y_W;
    const int lane = lane_, hd = lane >> 3;
    int gw_ = cu * NWAVES + F.wave; asm volatile("" : "+s"(gw_));
    const int gw = gw_, NGW = ncu * NWAVES;
    for (int row0 = gw; row0 < TC; row0 += 4 * NGW) {
        float lg[4][3]; v4u og[4][3];
#pragma unroll
        for (int r = 0; r < 4; ++r) { const int row = row0 + r * NGW < TC ? row0 + r * NGW : row0;
#pragma unroll
            for (int g = 0; g < 3; ++g) { lg[r][g] = LSE[((size_t)g * TC + row) * 8 + hd]; og[r][g] = *(const GAS v4u*)(OG + ((size_t)g * TC + row) * 512 + lane * 8); } }
#pragma unroll
        for (int r = 0; r < 4; ++r) { const int row = row0 + r * NGW; if (row >= TC) continue;
            const float mx = fmaxf(fmaxf(lg[r][0], lg[r][1]), lg[r][2]);
            float e[3]; e[0] = __builtin_amdgcn_exp2f(lg[r][0] - mx); e[1] = __builtin_amdgcn_exp2f(lg[r][1] - mx); e[2] = __builtin_amdgcn_exp2f(lg[r][2] - mx);
            const float inv = 1.0f / (e[0] + e[1] + e[2]);
            float acc[8];
#pragma unroll
            for (int i = 0; i < 8; ++i) acc[i] = 0.f;
#pragma unroll
            for (int g = 0; g < 3; ++g) { const float wg = e[g] * inv; const v4u o_ = og[r][g];
                acc[0] += wg * bflo(o_.x); acc[1] += wg * bfhi(o_.x); acc[2] += wg * bflo(o_.y); acc[3] += wg * bfhi(o_.y);
                acc[4] += wg * bflo(o_.z); acc[5] += wg * bfhi(o_.z); acc[6] += wg * bflo(o_.w); acc[7] += wg * bfhi(o_.w); }
            v4u o; o.x = cvtpk(acc[0], acc[1]); o.y = cvtpk(acc[2], acc[3]); o.z = cvtpk(acc[4], acc[5]); o.w = cvtpk(acc[6], acc[7]);
            if (P34_FP8) { v2u o8; o8.x = pk4_fp8(acc[0] * Y8_SCALE, acc[1] * Y8_SCALE, acc[2] * Y8_SCALE, acc[3] * Y8_SCALE); o8.y = pk4_fp8(acc[4] * Y8_SCALE, acc[5] * Y8_SCALE, acc[6] * Y8_SCALE, acc[7] * Y8_SCALE); *(GAS v2u*)(Y8 + (size_t)row * Y_W + lane * 8) = o8; }
            else *(GAS v4u*)(Y + (size_t)row * Y_W + lane * 8) = o; }
    }
}


struct EpiMerge {
    static constexpr bool PERM = true; static constexpr int HOOK_T = P34_FP8 ? 4 : 8;
    const bf16* Gt; bf16* MG;
    __device__ __forceinline__ void prefetch(LAS unsigned char*, const pg9::Unit&, int, int, int) const {}
    __device__ __forceinline__ void hook(f32x4 (&acc)[2][2][4][2], const pg9::Unit& u, int wr, int wc, int fr, int fq) const {
        asm volatile("" : "+v"(fr), "+v"(fq));
        const bf16* gr = Gt + ((size_t)((u.pm * 256 + wr * 64) >> 4) * 256 + u.pn * 32 + wc * 4 + fq) * 128 + fr * 8;
        v4u rv[8][2];
#pragma unroll
        for (int rg = 0; rg < 8; ++rg)
#pragma unroll
            for (int bj = 0; bj < 2; ++bj) rv[rg][bj] = *(const GAS v4u*)(gr + (size_t)((rg >> 2) * 8 + (rg & 3)) * 32768 + bj * 16 * 128);
#pragma unroll
        for (int rg = 0; rg < 8; ++rg)
#pragma unroll
            for (int bj = 0; bj < 2; ++bj) { const v4u a = rv[rg][bj];
                const f32x4 r0 = {bflo(a.x), bfhi(a.x), bflo(a.y), bfhi(a.y)}, r1 = {bflo(a.z), bfhi(a.z), bflo(a.w), bfhi(a.w)};
                acc[rg >> 2][bj][rg & 3][0] = acc[rg >> 2][bj][rg & 3][0] * r0; acc[rg >> 2][bj][rg & 3][1] = acc[rg >> 2][bj][rg & 3][1] * r1; }
    }
    __device__ __forceinline__ void operator()(const f32x4 (&acc)[2][2][4][2], const pg9::Unit& u, int ui, int wr, int wc, int fr, int fq) const {
        asm volatile("" : "+v"(fr), "+v"(fq));
        const bf16* gr = Gt + ((size_t)((u.pm * 256 + wr * 64) >> 4) * 256 + 128 + u.pn * 32 + wc * 4 + fq) * 128 + fr * 8;
        const int fr2 = (fr >> 2) + 4 * fq, fq2 = fr & 3, paddr = 4 * (16 * (fr & 3) + 4 * fq + (fr >> 2));
        bf16* mr = MG + (size_t)(u.pm * 256 + wr * 64 + fr2) * D + u.pn * 256 + wc * 32 + 8 * fq2;
        v4u gb[8][2];
#pragma unroll
        for (int rg = 0; rg < 8; ++rg)
#pragma unroll
            for (int bj = 0; bj < 2; ++bj) gb[rg][bj] = *(const GAS v4u*)(gr + (size_t)((rg >> 2) * 8 + (rg & 3)) * 32768 + bj * 16 * 128);
#pragma unroll
        for (int rg = 0; rg < 8; ++rg)
#pragma unroll
            for (int bj = 0; bj < 2; ++bj) { const v4u b = gb[rg][bj];
                const f32x4 v0 = acc[rg >> 2][bj][rg & 3][0], v1 = acc[rg >> 2][bj][rg & 3][1];
                if (P34_FP8) { constexpr float f = MG8_SCALE / (W34_SCALE * Y8_SCALE); unsigned char* m8 = (unsigned char*)MG + (size_t)(u.pm * 256 + wr * 64 + fr2) * D + u.pn * 256 + wc * 32 + 8 * fq2;
                    v2u w8; w8.x = pk4_fp8(v0[0] * bflo(b.x) * f, v0[1] * bfhi(b.x) * f, v0[2] * bflo(b.y) * f, v0[3] * bfhi(b.y) * f); w8.y = pk4_fp8(v1[0] * bflo(b.z) * f, v1[1] * bfhi(b.z) * f, v1[2] * bflo(b.w) * f, v1[3] * bfhi(b.w) * f);
                    w8.x = (unsigned)__builtin_amdgcn_ds_bpermute(paddr, (int)w8.x); w8.y = (unsigned)__builtin_amdgcn_ds_bpermute(paddr, (int)w8.y);
                    *(GAS v2u*)(m8 + (size_t)((rg >> 2) * 128 + (rg & 3) * 16) * D + bj * 128) = w8; }
                else {
                v4u w; w.x = cvtpk(v0[0] * bflo(b.x), v0[1] * bfhi(b.x)); w.y = cvtpk(v0[2] * bflo(b.y), v0[3] * bfhi(b.y));
                w.z = cvtpk(v1[0] * bflo(b.z), v1[1] * bfhi(b.z)); w.w = cvtpk(v1[2] * bflo(b.w), v1[3] * bfhi(b.w));
                w.x = (unsigned)__builtin_amdgcn_ds_bpermute(paddr, (int)w.x); w.y = (unsigned)__builtin_amdgcn_ds_bpermute(paddr, (int)w.y); w.z = (unsigned)__builtin_amdgcn_ds_bpermute(paddr, (int)w.z); w.w = (unsigned)__builtin_amdgcn_ds_bpermute(paddr, (int)w.w);
                *(GAS v4u*)(mr + (size_t)((rg >> 2) * 128 + (rg & 3) * 16) * D + bj * 128) = w; } }
    }
};
__device__ __forceinline__ void p3_merge(Frame& F) {
    unsigned char* ws = F.ws;
    pg9::DenseOrder S; S.init(T, D, F.G, (int)blockIdx.x);
    EpiMerge E{(const bf16*)(ws + WS_G), (bf16*)(ws + WS_MG)};
    constexpr int ES = P34_FP8 ? 1 : 2;
    pg9::DenseA ao{(unsigned)(Y_W * ES)}; pg9::DenseB bb{(const char*)(ws + WS_WAB), (size_t)256 * Y_W * ES};
    pg9::gemm_phase<ES>(F.lds, (const char*)(ws + WS_Y), Y_W, S, E, ao, bb);
}
struct EpiOut {
    static constexpr bool PERM = true; static constexpr int HOOK_T = -1;
    bf16* DELTA;
    __device__ __forceinline__ void hook(f32x4 (&)[2][2][4][2], const pg9::Unit&, int, int, int, int) const {}
    __device__ __forceinline__ void prefetch(LAS unsigned char*, const pg9::Unit&, int, int, int) const {}
    __device__ __forceinline__ void operator()(const f32x4 (&acc)[2][2][4][2], const pg9::Unit& u, int ui, int wr, int wc, int fr, int fq) const {
        asm volatile("" : "+v"(fr), "+v"(fq));
        const int fr2 = (fr >> 2) + 4 * fq, fq2 = fr & 3, paddr = 4 * (16 * (fr & 3) + 4 * fq + (fr >> 2));
        bf16* orow = DELTA + (size_t)(u.pm * 256 + wr * 64 + fr2) * D + u.pn * 256 + wc * 32 + 8 * fq2;
#pragma unroll
        for (int ai = 0; ai < 2; ++ai)
#pragma unroll
            for (int m = 0; m < 4; ++m)
#pragma unroll
                for (int bj = 0; bj < 2; ++bj) { constexpr float f = P34_FP8 ? 1.0f / (W34_SCALE * MG8_SCALE) : 1.0f; const f32x4 o0 = acc[ai][bj][m][0] * f, o1 = acc[ai][bj][m][1] * f;
                    v4u w; w.x = cvtpk(o0[0], o0[1]); w.y = cvtpk(o0[2], o0[3]); w.z = cvtpk(o1[0], o1[1]); w.w = cvtpk(o1[2], o1[3]);
                    w.x = (unsigned)__builtin_amdgcn_ds_bpermute(paddr, (int)w.x); w.y = (unsigned)__builtin_amdgcn_ds_bpermute(paddr, (int)w.y); w.z = (unsigned)__builtin_amdgcn_ds_bpermute(paddr, (int)w.z); w.w = (unsigned)__builtin_amdgcn_ds_bpermute(paddr, (int)w.w);
                    *(GAS v4u*)(orow + (size_t)(ai * 128 + m * 16) * D + bj * 128) = w; }
    }
};
__device__ __forceinline__ void p4_outproj(Frame& F) {
    unsigned char* ws = F.ws;
    pg9::DenseOrder S; S.init(T, D, F.G, (int)blockIdx.x);
    EpiOut E{(bf16*)((unsigned char*)F.out + DO_DELTA)};
    constexpr int ES = P34_FP8 ? 1 : 2;
    pg9::DenseA ao{(unsigned)(D * ES)}; pg9::DenseB bb{(const char*)(ws + WS_WO), (size_t)256 * D * ES};
    pg9::gemm_phase<ES>(F.lds, (const char*)(ws + WS_MG), D, S, E, ao, bb);
}

__device__ __forceinline__ void p5_route(Frame& F) {
    int tid_ = threadIdx.x; asm volatile("" : "+v"(tid_)); const int lane = tid_ & 63;
    unsigned char* ws = F.ws;
    const float* X = F.in[I_X]; const bf16* DELTA = (const bf16*)((const unsigned char*)F.out + DO_DELTA);
    bf16* X1B = (bf16*)(ws + WS_X1B); unsigned char* X1F8 = ws + WS_X1F8;
    unsigned* cnt = (unsigned*)(ws + WS_CTL) + CW_CNT;
    int* tokof = (int*)(ws + WS_TOKOF); float2* wtof = (float2*)(ws + WS_WTOF); int4* tpos = (int4*)(ws + WS_TPOS);
    const v4u* WRF = (const v4u*)(ws + WS_WRF);
    LAS v4u* wl = (LAS v4u*)F.lds;
    LAS float* sl = (LAS float*)(F.lds + 98304 + F.wave * 4096);
    const int i = lane & 15, q = lane >> 4;
    LAS unsigned* hist = (LAS unsigned*)(F.lds + LDS_MISC + 2048);
    for (int wt = F.vcu; wt < T / 128; wt += F.G) {
        const int tile = wt * NWAVES + F.wave;
        if (tid_ < 32) hist[tid_] = 0u;
        const size_t roff = (size_t)(tile * 16 + i) * D + 8 * q;
        const float* xr = X + roff; const bf16* dr = DELTA + roff;
        f32x4 a0 = {0.f, 0.f, 0.f, 0.f}, a1 = a0, a2 = a0; float ss = 0.f;
        f32x4 va[8][2]; v4u vd[8];
#pragma unroll
        for (int j = 0; j < 8; ++j) { va[j][0] = *(const GAS f32x4*)(xr + 32 * j); va[j][1] = *(const GAS f32x4*)(xr + 32 * j + 4); vd[j] = *(const GAS v4u*)(dr + 32 * j); }
#pragma unroll 1
        for (int half = 0; half < 2; ++half) {
            __syncthreads();
            { v4u t[12];
#pragma unroll
              for (int k = 0; k < 12; ++k) t[k] = WRF[half * 6144 + k * 512 + tid_];
#pragma unroll
              for (int k = 0; k < 12; ++k) wl[k * 512 + tid_] = t[k]; }
            __syncthreads();
#pragma unroll 1
            for (int sb = 0; sb < 2; ++sb) {
#pragma unroll
                for (int j = 0; j < 8; ++j) {
                    const int ksl = sb * 8 + j, ks = half * 16 + ksl;
                    const v4u dd = vd[j];
                    const f32x4 v0 = va[j][0] + (f32x4){bflo(dd.x), bfhi(dd.x), bflo(dd.y), bfhi(dd.y)}, v1 = va[j][1] + (f32x4){bflo(dd.z), bfhi(dd.z), bflo(dd.w), bfhi(dd.w)};
                    if (ks + 8 < 32) { va[j][0] = *(const GAS f32x4*)(xr + 32 * (ks + 8)); va[j][1] = *(const GAS f32x4*)(xr + 32 * (ks + 8) + 4); vd[j] = *(const GAS v4u*)(dr + 32 * (ks + 8)); }
                    ss += ((v0[0] * v0[0] + v0[1] * v0[1]) + (v0[2] * v0[2] + v0[3] * v0[3])) + ((v1[0] * v1[0] + v1[1] * v1[1]) + (v1[2] * v1[2] + v1[3] * v1[3]));
                    v4u hu; hu.x = cvtpk(v0[0], v0[1]); hu.y = cvtpk(v0[2], v0[3]); hu.z = cvtpk(v1[0], v1[1]); hu.w = cvtpk(v1[2], v1[3]);
                    v4u lu; lu.x = cvtpk(v0[0] - bflo(hu.x), v0[1] - bfhi(hu.x)); lu.y = cvtpk(v0[2] - bflo(hu.y), v0[3] - bfhi(hu.y)); lu.z = cvtpk(v1[0] - bflo(hu.z), v1[1] - bfhi(hu.z)); lu.w = cvtpk(v1[2] - bflo(hu.w), v1[3] - bfhi(hu.w));
                    *(GAS v4u*)(X1B + roff + 32 * ks) = hu;
                    if (P6_FP8) { v2u w8; w8.x = pk4_fp8(v0[0], v0[1], v0[2], v0[3]); w8.y = pk4_fp8(v1[0], v1[1], v1[2], v1[3]); *(GAS v2u*)(X1F8 + roff + 32 * ks) = w8; }
                    const bf16x8 ah = __builtin_bit_cast(bf16x8, hu), al = __builtin_bit_cast(bf16x8, lu);
#pragma unroll
                    for (int nb = 0; nb < 3; ++nb) {
                        const bf16x8 bh = __builtin_bit_cast(bf16x8, wl[((ksl * 3 + nb) * 2 + 0) * 64 + lane]), bl = __builtin_bit_cast(bf16x8, wl[((ksl * 3 + nb) * 2 + 1) * 64 + lane]);
                        f32x4 acc = nb == 0 ? a0 : (nb == 1 ? a1 : a2);
                        acc = __builtin_amdgcn_mfma_f32_16x16x32_bf16(ah, bh, acc, 0, 0, 0); acc = __builtin_amdgcn_mfma_f32_16x16x32_bf16(ah, bl, acc, 0, 0, 0); acc = __builtin_amdgcn_mfma_f32_16x16x32_bf16(al, bh, acc, 0, 0, 0);
                        if (nb == 0) a0 = acc; else if (nb == 1) a1 = acc; else a2 = acc;
                    }
                }
            }
        }
        ss += __shfl_xor(ss, 16); ss += __shfl_xor(ss, 32);
#pragma unroll
        for (int r = 0; r < 4; ++r) { sl[(4 * q + r) * 48 + i] = a0[r]; sl[(4 * q + r) * 48 + 16 + i] = a1[r]; sl[(4 * q + r) * 48 + 32 + i] = a2[r]; }
        LDS_WAIT(); asm volatile("" ::: "memory");
        int e0 = 0, e1 = 0, lp0 = 0, lp1 = 0; float w1 = 0.f, w2 = 0.f, rstd = 0.f;
        __syncthreads();
        if (lane < 16) {
            rstd = 1.0f / sqrtf(ss * (1.f / D) + RMS_EPS);
            float lg[36];
#pragma unroll
            for (int o = 0; o < 36; ++o) lg[o] = sl[lane * 48 + o] * rstd + (o < 4 ? F.in[I_BRG][o] : F.in[I_BRE][o - 4]);
            int gsel = 0; float gmax = lg[0];
#pragma unroll
            for (int k = 1; k < 4; ++k) if (lg[k] > gmax) { gmax = lg[k]; gsel = k; }
            float gden = 0.f;
#pragma unroll
            for (int k = 0; k < 4; ++k) gden += __expf(lg[k] - gmax);
            const float pg = 1.0f / gden;
            float le[8];
#pragma unroll
            for (int j = 0; j < 8; ++j) { le[j] = lg[4 + j];
#pragma unroll
                for (int gi = 1; gi < 4; ++gi) le[j] = (gsel == gi) ? lg[4 + gi * 8 + j] : le[j]; }
            int i1 = 0; float m1 = le[0];
#pragma unroll
            for (int j = 1; j < 8; ++j) if (le[j] > m1) { m1 = le[j]; i1 = j; }
            int i2 = -1; float m2 = -INFINITY;
#pragma unroll
            for (int j = 0; j < 8; ++j) if (j != i1 && le[j] > m2) { m2 = le[j]; i2 = j; }
            const float e2 = __expf(m2 - m1);
            w1 = pg / (1.0f + e2); w2 = pg * e2 / (1.0f + e2);
            e0 = gsel * 8 + i1; e1 = gsel * 8 + i2;
            lp0 = (int)__hip_atomic_fetch_add(&hist[e0], 1u, __ATOMIC_RELAXED, __HIP_MEMORY_SCOPE_WORKGROUP);
            lp1 = (int)__hip_atomic_fetch_add(&hist[e1], 1u, __ATOMIC_RELAXED, __HIP_MEMORY_SCOPE_WORKGROUP);
        }
        __syncthreads();
        if (tid_ < 32) { const unsigned n = hist[tid_]; hist[32 + tid_] = n ? atomicAdd(&cnt[64 * tid_], n) : 0u; }
        __syncthreads();
        if (lane < 16) {
            const int row = tile * 16 + lane;
            const int p0 = (int)hist[32 + e0] + lp0, p1 = (int)hist[32 + e1] + lp1;
            tokof[(size_t)e0 * T + p0] = row; wtof[(size_t)e0 * T + p0] = make_float2(w1, rstd);
            tokof[(size_t)e1 * T + p1] = row; wtof[(size_t)e1 * T + p1] = make_float2(w2, rstd);
            tpos[row] = make_int4(e0, p0, e1, p1);
        }
        __syncthreads();
    }
}

__device__ __forceinline__ void expert_tiles(Frame& F, LAS int* tb, LAS int* cn) {
    int tid_ = threadIdx.x; asm volatile("" : "+v"(tid_)); const int lane_ = tid_ & 63;
    if (tid_ == 0) {
        const unsigned* cnt = (const unsigned*)(F.ws + WS_CTL) + CW_CNT;
        int acc = 0;
        for (int e = 0; e < NE; ++e) { const int c = (int)__hip_atomic_load(cnt + 64 * e, __ATOMIC_RELAXED, __HIP_MEMORY_SCOPE_AGENT); cn[e] = c; tb[e] = acc; acc += (c + 255) >> 8; }
        tb[NE] = acc;
    }
    __syncthreads();
}

struct MoeOrder { const LAS int* tb; int ncol, G, c;
    __device__ bool next(int i, pg9::Unit& u) const {
        const int L = i * G + c; if (L >= tb[NE] * ncol) return false;
        const int rt = L / ncol; int e = 0;
        for (int k = 1; k < NE; ++k) if (tb[k] <= rt) e = k;
        u.pm = rt; u.pn = L % ncol; u.e = e; return true; } };
struct GatherA { static constexpr bool GATHER = true; unsigned rowbytes; const int* tokof; const LAS int* tb; const LAS int* cn;
    __device__ __forceinline__ unsigned operator()(const pg9::Unit& u, int row) const {
        const int p = (u.pm - tb[u.e]) * 256 + row; const int tok = tokof[(size_t)u.e * T + (p < cn[u.e] ? p : 0)]; return (unsigned)tok * rowbytes; } };
struct ExpertB { const char* W; size_t ebytes, tilebytes; __device__ __forceinline__ const char* operator()(const pg9::Unit& u) const { return W + (size_t)u.e * ebytes + (size_t)u.pn * tilebytes; } };
struct EpiGateUp {
    static constexpr bool PERM = true; static constexpr int HOOK_T = -1;
    const float2* wtof; bf16* HACT; const LAS int* tb; const LAS int* cn; float ascale;
    __device__ __forceinline__ void hook(f32x4 (&)[2][2][4][2], const pg9::Unit&, int, int, int, int) const {}
    __device__ __forceinline__ void prefetch(LAS unsigned char*, const pg9::Unit&, int, int, int) const {}
    __device__ __forceinline__ void operator()(const f32x4 (&acc)[2][2][4][2], const pg9::Unit& u, int ui, int wr, int wc, int fr, int fq) const {
        asm volatile("" : "+v"(fr), "+v"(fq));
        const int r0 = wr * 64 + fr, p0 = (u.pm - tb[u.e]) * 256, ce = cn[u.e];
        const int fr2 = (fr >> 2) + 4 * fq, fq2 = fr & 3, paddr = 4 * (16 * (fr & 3) + 4 * fq + (fr >> 2)), r0s = wr * 64 + fr2;
        const float2* wp = wtof + (size_t)u.e * T;
#pragma unroll
        for (int ai = 0; ai < 2; ++ai) {
            float2 wv[4];
#pragma unroll
            for (int m = 0; m < 4; ++m) { const int p = p0 + r0 + ai * 128 + m * 16; wv[m] = p < ce ? wp[p] : make_float2(0.f, 0.f); }
#pragma unroll
            for (int m = 0; m < 4; ++m) { const int r = r0s + ai * 128 + m * 16;
                const float w = wv[m].x, rs = wv[m].y * ascale;
                bf16* orow = HACT + (size_t)(u.pm * 256 + r) * DE + u.pn * 128 + wc * 16 + 4 * fq2; unsigned char* orow8 = (unsigned char*)HACT + (size_t)(u.pm * 256 + r) * DE + u.pn * 128 + wc * 16 + 4 * fq2;
#pragma unroll
                for (int bj = 0; bj < 2; ++bj) { const f32x4 g = acc[ai][bj][m][0], uu = acc[ai][bj][m][1]; f32x4 hv;
#pragma unroll
                    for (int e = 0; e < 4; ++e) { const float gg = g[e] * rs; hv[e] = gg / (1.0f + __expf(-gg)) * (uu[e] * rs) * w; }
                    if (P6_FP8) *(GAS unsigned*)(orow8 + bj * 64) = (unsigned)__builtin_amdgcn_ds_bpermute(paddr, (int)pk4_fp8(hv[0] * H8_SCALE, hv[1] * H8_SCALE, hv[2] * H8_SCALE, hv[3] * H8_SCALE));
                    else { v2u o; o.x = (unsigned)__builtin_amdgcn_ds_bpermute(paddr, (int)cvtpk(hv[0], hv[1])); o.y = (unsigned)__builtin_amdgcn_ds_bpermute(paddr, (int)cvtpk(hv[2], hv[3])); *(GAS v2u*)(orow + bj * 64) = o; } } }
        }
    }
};
__device__ __forceinline__ void p6a_gateup(Frame& F) {
    unsigned char* ws = F.ws;
    LAS int* tb = (LAS int*)(F.lds + LDS_MISC + 1024); LAS int* cn = tb + 64;
    expert_tiles(F, tb, cn);
    MoeOrder S{tb, 2, F.G, F.vcu};
    constexpr int ES = P6_FP8 ? 1 : 2;
    GatherA ao{(unsigned)(D * ES), (const int*)(ws + WS_TOKOF), tb, cn}; ExpertB bb{(const char*)(ws + WS_WGU), (size_t)512 * D * ES, (size_t)256 * D * ES};
    EpiGateUp E{(const float2*)(ws + WS_WTOF), (bf16*)(ws + WS_HACT), tb, cn, P6_FP8 ? 1.0f / WG8_SCALE : 1.0f};
    pg9::gemm_phase<ES>(F.lds, (const char*)(ws + (P6_FP8 ? WS_X1F8 : WS_X1B)), D, S, E, ao, bb);
}
struct EpiDown {
    static constexpr bool PERM = true; static constexpr int HOOK_T = -1;
    bf16* YS; float ascale;
    __device__ __forceinline__ void hook(f32x4 (&)[2][2][4][2], const pg9::Unit&, int, int, int, int) const {}
    __device__ __forceinline__ void prefetch(LAS unsigned char*, const pg9::Unit&, int, int, int) const {}
    __device__ __forceinline__ void operator()(const f32x4 (&acc)[2][2][4][2], const pg9::Unit& u, int ui, int wr, int wc, int fr, int fq) const {
        asm volatile("" : "+v"(fr), "+v"(fq));
        const int fr2 = (fr >> 2) + 4 * fq, fq2 = fr & 3, paddr = 4 * (16 * (fr & 3) + 4 * fq + (fr >> 2));
#pragma unroll
        for (int ai = 0; ai < 2; ++ai)
#pragma unroll
            for (int m = 0; m < 4; ++m) { bf16* orow = YS + (size_t)(u.pm * 256 + wr * 64 + fr2 + ai * 128 + m * 16) * D + u.pn * 256 + wc * 32 + 8 * fq2;
#pragma unroll
                for (int bj = 0; bj < 2; ++bj) { const f32x4 v0 = acc[ai][bj][m][0] * ascale, v1 = acc[ai][bj][m][1] * ascale;
                    if (YS_FP8) { unsigned char* o8 = (unsigned char*)YS + (size_t)(u.pm * 256 + wr * 64 + fr2 + ai * 128 + m * 16) * D + u.pn * 256 + wc * 32 + 8 * fq2 + bj * 128;
                        v2u w8; w8.x = pk4_fp8(v0[0] * YS8_SCALE, v0[1] * YS8_SCALE, v0[2] * YS8_SCALE, v0[3] * YS8_SCALE); w8.y = pk4_fp8(v1[0] * YS8_SCALE, v1[1] * YS8_SCALE, v1[2] * YS8_SCALE, v1[3] * YS8_SCALE);
                        w8.x = (unsigned)__builtin_amdgcn_ds_bpermute(paddr, (int)w8.x); w8.y = (unsigned)__builtin_amdgcn_ds_bpermute(paddr, (int)w8.y); *(GAS v2u*)o8 = w8; }
                    else { v4u w; w.x = cvtpk(v0[0], v0[1]); w.y = cvtpk(v0[2], v0[3]); w.z = cvtpk(v1[0], v1[1]); w.w = cvtpk(v1[2], v1[3]);
                        w.x = (unsigned)__builtin_amdgcn_ds_bpermute(paddr, (int)w.x); w.y = (unsigned)__builtin_amdgcn_ds_bpermute(paddr, (int)w.y); w.z = (unsigned)__builtin_amdgcn_ds_bpermute(paddr, (int)w.z); w.w = (unsigned)__builtin_amdgcn_ds_bpermute(paddr, (int)w.w); *(GAS v4u*)(orow + bj * 128) = w; } } }
    }
};
__device__ __forceinline__ void p6b_down(Frame& F) {
    unsigned char* ws = F.ws;
    LAS int* tb = (LAS int*)(F.lds + LDS_MISC + 1024); LAS int* cn = tb + 64;
    expert_tiles(F, tb, cn);
    MoeOrder S{tb, 4, F.G, F.vcu};
    constexpr int ES = P6_FP8 ? 1 : 2;
    pg9::DenseA ao{(unsigned)(DE * ES)}; ExpertB bb{(const char*)(ws + WS_WD), (size_t)D * DE * ES, (size_t)256 * DE * ES};
    EpiDown E{(bf16*)(ws + WS_YS), P6_FP8 ? 1.0f / (WD8_SCALE * H8_SCALE) : 1.0f};
    pg9::gemm_phase<ES>(F.lds, (const char*)(ws + WS_HACT), DE, S, E, ao, bb);
}
__device__ __forceinline__ void p7_final(Frame& F) {
    int tid_ = threadIdx.x; asm volatile("" : "+v"(tid_)); const int lane_ = tid_ & 63;
    unsigned char* ws = F.ws;
    LAS int* tb = (LAS int*)(F.lds + LDS_MISC + 1024); LAS int* cn = tb + 64;
    expert_tiles(F, tb, cn);
    const bf16* YS = (const bf16*)(ws + WS_YS); const int4* tpos = (const int4*)(ws + WS_TPOS);
    float* X1 = F.out; const bf16* X1B = (const bf16*)(ws + WS_X1B);
    const int lane = lane_;
    const int gw = F.vcu * NWAVES + F.wave, NGW = F.G * NWAVES;
    f32x4 gg[4];
#pragma unroll
    for (int j = 0; j < 4; ++j) gg[j] = ((const GAS f32x4*)F.in[I_GFIN] + lane)[64 * j];
    for (int row0 = gw; row0 < T; row0 += 4 * NGW) {
        int4 tp[4];
#pragma unroll
        for (int r = 0; r < 4; ++r) { const int row = row0 + r * NGW < T ? row0 + r * NGW : row0; tp[r] = tpos[row]; }
        v2u xx[4][4]; v2u ya[4][4], yb[4][4]; unsigned za[4][4], zb[4][4];
#pragma unroll
        for (int r = 0; r < 4; ++r) { const int row = row0 + r * NGW < T ? row0 + r * NGW : row0;
            const size_t s0 = (size_t)tb[tp[r].x] * 256 + tp[r].y, s1 = (size_t)tb[tp[r].z] * 256 + tp[r].w;
            const GAS v2u* xb = (const GAS v2u*)(X1B + (size_t)row * D) + lane;
            const GAS v2u* y0 = (const GAS v2u*)(YS + s0 * D) + lane; const GAS v2u* y1 = (const GAS v2u*)(YS + s1 * D) + lane;
            const GAS unsigned* z0 = (const GAS unsigned*)((const unsigned char*)YS + s0 * D) + lane; const GAS unsigned* z1 = (const GAS unsigned*)((const unsigned char*)YS + s1 * D) + lane;
#pragma unroll
            for (int j = 0; j < 4; ++j) { xx[r][j] = xb[64 * j];
                if (YS_FP8) { za[r][j] = z0[64 * j]; zb[r][j] = z1[64 * j]; } else { ya[r][j] = y0[64 * j]; yb[r][j] = y1[64 * j]; } } }
#pragma unroll
        for (int r = 0; r < 4; ++r) { const int row = row0 + r * NGW; if (row >= T) continue;
            GAS f32x4* xr = (GAS f32x4*)(X1 + (size_t)row * D) + lane;
            f32x4 v[4]; float s = 0.f;
#pragma unroll
            for (int j = 0; j < 4; ++j) { const v2u x_ = xx[r][j]; v[j] = (f32x4){bflo(x_.x), bfhi(x_.x), bflo(x_.y), bfhi(x_.y)};
                if (YS_FP8) { const int a = (int)za[r][j], b = (int)zb[r][j]; typedef float f2_ __attribute__((ext_vector_type(2)));
                    const f2_ a0 = __builtin_amdgcn_cvt_pk_f32_fp8(a, false), a1 = __builtin_amdgcn_cvt_pk_f32_fp8(a, true), b0 = __builtin_amdgcn_cvt_pk_f32_fp8(b, false), b1 = __builtin_amdgcn_cvt_pk_f32_fp8(b, true);
                    constexpr float f = 1.0f / YS8_SCALE; v[j].x += (a0[0] + b0[0]) * f; v[j].y += (a0[1] + b0[1]) * f; v[j].z += (a1[0] + b1[0]) * f; v[j].w += (a1[1] + b1[1]) * f; }
                else { const v2u a = ya[r][j], b = yb[r][j];
                v[j].x += bflo(a.x) + bflo(b.x); v[j].y += bfhi(a.x) + bfhi(b.x); v[j].z += bflo(a.y) + bflo(b.y); v[j].w += bfhi(a.y) + bfhi(b.y); }
                s += (v[j].x * v[j].x + v[j].y * v[j].y) + (v[j].z * v[j].z + v[j].w * v[j].w); }
            const float rstd = 1.0f / sqrtf(wave_sum(s) * (1.f / D) + RMS_EPS);
#pragma unroll
            for (int j = 0; j < 4; ++j) { f32x4 o; o.x = v[j].x * rstd * gg[j].x; o.y = v[j].y * rstd * gg[j].y; o.z = v[j].z * rstd * gg[j].z; o.w = v[j].w * rstd * gg[j].w; xr[64 * j] = o; } }
    }
}

constexpr int NPHASE = 2 * NCH + 8;
__global__ void __launch_bounds__(NTHR, 2) fwd_kernel(KArgs args) {
    extern __shared__ __attribute__((aligned(16))) unsigned char lds_raw[];
    Frame F;
    F.lds = (LAS unsigned char*)lds_raw;
    F.tid = threadIdx.x; F.lane = F.tid & 63; F.wave = __builtin_amdgcn_readfirstlane(F.tid >> 6);
    F.G = gridDim.x; { const int bx = blockIdx.x; F.vcu = (F.G % 8 == 0) ? (bx % 8) * (F.G / 8) + bx / 8 : bx; }
#pragma unroll
    for (int i = 0; i < 17; ++i) F.in[i] = args.in[i];
    F.out = args.out; F.ws = args.ws;
    volatile LAS unsigned* MISC = (volatile LAS unsigned*)(F.lds + LDS_MISC);
    if (F.tid < 64) MISC[F.tid] = 0u;
    __syncthreads();
    XcdBarrier bar = xcd_barrier_post((unsigned*)(F.ws + WS_CTL) + CW_BAR + args.li * XCD_BAR_WORDS, MISC + 8);
#define IN(k) (args.ph_lo <= (k) && (k) < args.ph_hi)
#ifdef PROBE_MASK
    unsigned long long pr_acc = 0, pr_t0 = 0; const bool pr_me = (blockIdx.x == 0 && threadIdx.x == 0);
#define PR_BEGIN(k) do { if (pr_me && ((PROBE_MASK >> (k)) & 1ull)) pr_t0 = __builtin_amdgcn_s_memrealtime(); } while (0)
#define PR_END(k) do { if (pr_me && ((PROBE_MASK >> (k)) & 1ull)) pr_acc += __builtin_amdgcn_s_memrealtime() - pr_t0; } while (0)
#else
#define PR_BEGIN(k) do {} while (0)
#define PR_END(k) do {} while (0)
#endif
#define SEAM(k) do { if (IN(k) && IN((k) + 1)) xcd_barrier(bar); PR_END(k); } while (0)
    PR_BEGIN(0); if (IN(0)) p0_prologue(F);
    SEAM(0);
#pragma unroll 1
    for (int ch = 0; ch < NCH; ++ch) {
        PR_BEGIN(1 + 2 * ch);
        if (IN(1 + 2 * ch)) {
            constexpr int NWG1 = (TC / 256) * (NIN / 256);
            const int nfull = NWG1 % F.G, bx = (int)blockIdx.x;
            if (ch > 0 && nfull == 0) p2_combine(F, ch - 1, F.vcu, F.G);
            p1_inproj(F, ch);
            if (ch > 0 && nfull != 0 && bx >= nfull) p2_combine(F, ch - 1, bx - nfull, F.G - nfull);
        }
        SEAM(1 + 2 * ch);
        PR_BEGIN(2 + 2 * ch); if (IN(2 + 2 * ch)) p2_attn(F, ch);
        SEAM(2 + 2 * ch);
    }
    PR_BEGIN(2 * NCH + 1); if (IN(2 * NCH + 1)) p2_combine(F, NCH - 1, F.vcu, F.G);
    SEAM(2 * NCH + 1);
    PR_BEGIN(2 * NCH + 2); if (IN(2 * NCH + 2)) p3_merge(F);
    SEAM(2 * NCH + 2);
    PR_BEGIN(2 * NCH + 3); if (IN(2 * NCH + 3)) p4_outproj(F);
    SEAM(2 * NCH + 3);
    PR_BEGIN(2 * NCH + 4); if (IN(2 * NCH + 4)) p5_route(F);
    SEAM(2 * NCH + 4);
    PR_BEGIN(2 * NCH + 5); if (IN(2 * NCH + 5)) p6a_gateup(F);
    SEAM(2 * NCH + 5);
    PR_BEGIN(2 * NCH + 6); if (IN(2 * NCH + 6)) p6b_down(F);
    SEAM(2 * NCH + 6);
    PR_BEGIN(2 * NCH + 7); if (IN(2 * NCH + 7)) p7_final(F);
    PR_END(2 * NCH + 7);
#ifdef PROBE_MASK
    if (pr_me) { const unsigned long long t1 = __builtin_amdgcn_s_memrealtime(); while (__builtin_amdgcn_s_memrealtime() - t1 < pr_acc) __builtin_amdgcn_s_sleep(4); }
#endif
#undef IN
#undef SEAM
}

#ifndef N_LAUNCHES
#define N_LAUNCHES 1
#endif
extern "C" void kernel_launch(void* const* d_in, const int* in_sizes, int n_in, void* d_out, int out_size, void* d_ws, size_t ws_size, hipStream_t stream) {
    static int grid = 0;
    if (grid == 0) {
        if (n_in != 17 || in_sizes[0] != T * D || out_size != T * D || ws_size < WS_END) { fprintf(stderr, "kernel_launch: unexpected shapes / workspace (%d inputs, ws %zu)\n", n_in, ws_size); grid = -1; return; }
        int dev = 0, cus = 0;
        if (hipGetDevice(&dev) != hipSuccess || hipDeviceGetAttribute(&cus, hipDeviceAttributeMultiprocessorCount, dev) != hipSuccess) { grid = -1; return; }
        if (hipFuncSetAttribute((const void*)fwd_kernel, hipFuncAttributeMaxDynamicSharedMemorySize, LDS_BYTES) != hipSuccess) { fprintf(stderr, "kernel_launch: hipFuncSetAttribute failed\n"); grid = -1; return; }
        int per_cu = 0;
        if (hipOccupancyMaxActiveBlocksPerMultiprocessor(&per_cu, (const void*)fwd_kernel, NTHR, LDS_BYTES) != hipSuccess || per_cu < 1) fprintf(stderr, "kernel_launch: occupancy query says %d\n", per_cu);
        (void)hipGetLastError();
        grid = cus;
    }
    if (grid < 0) return;
    (void)hipMemsetAsync((char*)d_ws + WS_CTL, 0, N_LAUNCHES == 1 ? (size_t)(CW_BAR + XCD_BAR_WORDS) * 4 : CTL_BYTES, stream);
    KArgs a{};
    for (int i = 0; i < 17; ++i) a.in[i] = (const float*)d_in[i];
    a.out = (float*)d_out; a.ws = (unsigned char*)d_ws;
    for (int li = 0; li < N_LAUNCHES; ++li) {
        a.ph_lo = (int)((long)NPHASE * li / N_LAUNCHES); a.ph_hi = (int)((long)NPHASE * (li + 1) / N_LAUNCHES); a.li = li;
        hipLaunchKernelGGL(fwd_kernel, dim3(grid), dim3(NTHR), LDS_BYTES, stream, a);
    }
}
```

```cpp
#include <hip/hip_runtime.h>
#include <cstdint>
#include <cstdio>

#define GAS __attribute__((address_space(1)))
#define LAS __attribute__((address_space(3)))
typedef unsigned short bf16;
typedef short bf16x8 __attribute__((ext_vector_type(8)));
typedef float f32x4 __attribute__((ext_vector_type(4)));
typedef unsigned v4u __attribute__((ext_vector_type(4)));
typedef unsigned v2u __attribute__((ext_vector_type(2)));
typedef GAS unsigned gu32;

constexpr int T = 32768, D = 1024, SEQ = 4096, NIN = 7936;
constexpr int A_W = 4608, B_W = 1280, G_W = 2048, Y_W = 1536;
constexpr int NE = 32, DE = 256;
constexpr int NCH = 4, TC = T / NCH;
constexpr float QSCALE = 0.125f * 1.4426950408889634f;
constexpr float LOG2E = 1.4426950408889634f;
constexpr float RMS_EPS = 1e-6f;
#ifndef P1_FP8
#define P1_FP8 1
#endif
constexpr float W8_SCALE = P1_FP8 ? 64.0f : 0.0f, W8_INV = P1_FP8 ? 1.0f / 64.0f : 1.0f;
#ifndef P6_FP8
#define P6_FP8 1
#endif
#ifndef P34_FP8
#define P34_FP8 1
#endif
constexpr float Y8_SCALE = 16.0f, W34_SCALE = 64.0f, MG8_SCALE = 32.0f;
#ifndef YS_FP8
#define YS_FP8 1
#endif
constexpr float YS8_SCALE = 16.0f;
constexpr float WG8_SCALE = P6_FP8 ? 64.0f : 0.0f, WD8_SCALE = P6_FP8 ? 32.0f : 0.0f, H8_SCALE = 32.0f;
constexpr int NWAVES = 8, NTHR = 512;

constexpr size_t MiB = 1u << 20;
constexpr size_t WS_CTL = 0, CTL_BYTES = 1 * MiB;
constexpr size_t WS_BIASP = ((size_t)1 << 20) + 4096;
constexpr size_t WS_INVF = 1 * MiB;
constexpr size_t WS_WRF = 2 * MiB;
constexpr size_t WS_TOKOF = 3 * MiB;
constexpr size_t WS_WTOF = 7 * MiB;
constexpr size_t WS_TPOS = 15 * MiB;
constexpr size_t WS_WIN = 16 * MiB;
constexpr size_t WS_WAB = 32 * MiB;
constexpr size_t WS_WO = 35 * MiB;
constexpr size_t WS_WGU = 37 * MiB;
constexpr size_t WS_WD = 69 * MiB;
constexpr size_t WS_G = 86 * MiB;
constexpr size_t WS_Y = 214 * MiB;
constexpr size_t WS_ZA = 310 * MiB;
constexpr size_t WS_ZB = 454 * MiB;
constexpr size_t WS_END = 494 * MiB;
constexpr size_t WS_MG = WS_ZA;
constexpr size_t WS_X1B = WS_ZA + 64 * MiB;
constexpr size_t WS_X1F8 = WS_Y + 64 * MiB;
constexpr size_t WS_HACT = WS_G;
constexpr size_t WS_YS = WS_G + 36 * MiB;
constexpr size_t DO_DELTA = 0;
constexpr size_t DO_HN = 0;
constexpr size_t DO_OG = 64 * MiB;
constexpr size_t DO_LSE = 112 * MiB;
constexpr int MAXSLOT = 2 * T + NE * 256;
static_assert(WS_ZA + (size_t)TC * A_W * 2 <= WS_ZB && WS_ZB + (size_t)TC * B_W * 2 <= WS_END && WS_Y + (size_t)T * Y_W * 2 <= WS_ZA && WS_G + (size_t)T * G_W * 2 <= WS_Y, "ws map");
static_assert(WS_MG + (size_t)T * D * 2 <= WS_END && WS_HACT + (size_t)MAXSLOT * DE * 2 <= WS_YS && WS_YS + (size_t)MAXSLOT * D * 2 <= WS_ZA && WS_X1B >= WS_MG + (size_t)T * D * 2 && WS_X1B + (size_t)T * D * 2 <= WS_ZB, "ws map");
static_assert(DO_OG + (size_t)3 * TC * 512 * 2 <= DO_LSE && DO_LSE + (size_t)3 * TC * 8 * 4 <= (size_t)T * D * 4 && DO_HN + (size_t)T * D * 2 <= DO_OG, "d_out scratch map");
constexpr int CW_CNT = 1024;
constexpr int CW_BAR = 4096;
constexpr int LDS_BYTES = 147456;
constexpr int LDS_MISC = 131072;

__device__ __forceinline__ unsigned f2bf(float f) { unsigned u = __builtin_bit_cast(unsigned, f); return (u + 0x7fffu + ((u >> 16) & 1u)) >> 16; }
__device__ __forceinline__ unsigned pk4_fp8(float a, float b, float c, float d) {
    a = __builtin_amdgcn_fmed3f(a, -448.f, 448.f); b = __builtin_amdgcn_fmed3f(b, -448.f, 448.f); c = __builtin_amdgcn_fmed3f(c, -448.f, 448.f); d = __builtin_amdgcn_fmed3f(d, -448.f, 448.f);
    int w = 0; w = __builtin_amdgcn_cvt_pk_fp8_f32(a, b, w, false); w = __builtin_amdgcn_cvt_pk_fp8_f32(c, d, w, true); return (unsigned)w; }
__device__ __forceinline__ unsigned pk2(float lo, float hi) { return f2bf(lo) | (f2bf(hi) << 16); }
__device__ __forceinline__ float bf2f(unsigned b) { return __builtin_bit_cast(float, b << 16); }
__device__ __forceinline__ float bflo(unsigned u) { return __builtin_bit_cast(float, u << 16); }
__device__ __forceinline__ float bfhi(unsigned u) { return __builtin_bit_cast(float, u & 0xffff0000u); }
__device__ __forceinline__ float wave_sum(float v) {
#pragma unroll
    for (int o = 1; o < 64; o <<= 1) v += __shfl_xor(v, o);
    return v;
}
__device__ __forceinline__ float wave_max(float v) {
#pragma unroll
    for (int o = 1; o < 64; o <<= 1) v = fmaxf(v, __shfl_xor(v, o));
    return v;
}
typedef float f32x2_t __attribute__((ext_vector_type(2)));
typedef __bf16 bf16x2_t __attribute__((ext_vector_type(2)));
__device__ __forceinline__ unsigned cvtpk(float lo, float hi) { f32x2_t v = {lo, hi}; bf16x2_t b = __builtin_convertvector(v, bf16x2_t); return __builtin_bit_cast(unsigned, b); }
#ifndef WT_STORES
#define WT_STORES 0
#endif
__device__ __forceinline__ __amdgpu_buffer_rsrc_t wt_rsrc(unsigned char* base) { return __builtin_amdgcn_make_buffer_rsrc(base, 0, 0x7ffffffc, 0x00020000); }
__device__ __forceinline__ void st16(__amdgpu_buffer_rsrc_t r, unsigned char* base, void* p, v4u v) { if (WT_STORES) __builtin_amdgcn_raw_buffer_store_b128(v, r, (unsigned)((unsigned char*)p - base), 0, 16); else *(GAS v4u*)p = v; }
__device__ __forceinline__ void st8(__amdgpu_buffer_rsrc_t r, unsigned char* base, void* p, v2u v) { if (WT_STORES) __builtin_amdgcn_raw_buffer_store_b64(v, r, (unsigned)((unsigned char*)p - base), 0, 16); else *(GAS v2u*)p = v; }
#define LDS_WAIT() asm volatile("s_waitcnt lgkmcnt(0)" ::: "memory")
#define VM_WAIT() asm volatile("s_waitcnt vmcnt(0)" ::: "memory")

#define XB_TMO      128
#define XB_XCNT(j)  (256  + 64 * (j))
#define XB_XSUB(j)  (1280 + 64 * (j))
#define XB_XGEN(j)  (2304 + 64 * (j))
#define XB_TOP      3328
#define XB_TOPGEN   3392
#define XCD_BAR_WORDS 3456
#define XB_SPIN_CAP (1u << 18)
__device__ __forceinline__ unsigned xb_ld(unsigned* p)              { return __hip_atomic_load(p, __ATOMIC_RELAXED, __HIP_MEMORY_SCOPE_AGENT); }
__device__ __forceinline__ unsigned xb_add(unsigned* p, unsigned v) { return __hip_atomic_fetch_add(p, v, __ATOMIC_RELAXED, __HIP_MEMORY_SCOPE_AGENT); }
__device__ __forceinline__ unsigned xb_xcc_id() { return (unsigned)__builtin_amdgcn_s_getreg((3 << 11) | 20) & 0xFu; }
#define XB_SPIN(cond, bar) do { unsigned _sp = 0; while (cond) { __builtin_amdgcn_s_sleep(1); \
    if ((++_sp & 255u) == 0u) { if (xb_ld(&(bar)[XB_TMO])) break; if (_sp > XB_SPIN_CAP) { atomicAdd(&(bar)[XB_TMO], 1u); break; } } } } while (0)
struct XcdBarrier { unsigned* bar; unsigned x; volatile LAS unsigned* st; };
__device__ __forceinline__ XcdBarrier xcd_barrier_post(unsigned* bar, volatile LAS unsigned* st) {
    XcdBarrier b; b.bar = bar; b.x = xb_xcc_id(); b.st = st;
    if (threadIdx.x == 0) (void)xb_add(&bar[XB_XCNT(b.x)], 1u);
    return b;
}
__device__ __forceinline__ void xcd_barrier_complete(unsigned* bar, unsigned x, unsigned& nloc, unsigned& nx) {
    const unsigned G = gridDim.x * gridDim.y * gridDim.z;
    unsigned sum, cnt, mine, sp = 0u;
    for (;;) {
        sum = 0u; cnt = 0u; mine = 0u;
#pragma unroll
        for (unsigned j = 0; j < 16; ++j) { const unsigned c = xb_ld(&bar[XB_XCNT(j)]); sum += c; cnt += (c > 0u) ? 1u : 0u; mine = (j == x) ? c : mine; }
        if (sum == G) break;
        __builtin_amdgcn_s_sleep(1);
        if ((++sp & 255u) == 0u) { if (xb_ld(&bar[XB_TMO])) break; if (sp > XB_SPIN_CAP) { atomicAdd(&bar[XB_TMO], 1u); break; } }
    }
    nloc = mine > 0u ? mine : 1u; nx = cnt > 0u ? cnt : 1u;
}
__device__ __forceinline__ void xcd_barrier(const XcdBarrier& b) {
    asm volatile("s_waitcnt vmcnt(0)" ::: "memory");
    __syncthreads();
    int t_ = threadIdx.x; asm volatile("" : "+v"(t_));
    if (t_ == 0) {
        unsigned* bar = b.bar;
        __builtin_amdgcn_s_waitcnt(0);
        unsigned nloc = b.st[0], nx = b.st[1];
        if (nloc == 0u) { xcd_barrier_complete(bar, b.x, nloc, nx); b.st[0] = nloc; b.st[1] = nx; }
        const unsigned old = xb_add(&bar[XB_XSUB(b.x)], 1u);
        const unsigned gen = old / nloc;
        if (old + 1u == (gen + 1u) * nloc) {
            __builtin_amdgcn_fence(__ATOMIC_RELEASE, "agent");
            asm volatile("s_waitcnt vmcnt(0)" ::: "memory");
            const unsigned og = xb_add(&bar[XB_TOP], 1u);
            const unsigned tg = og / nx;
            if (og + 1u == (tg + 1u) * nx) xb_add(&bar[XB_TOPGEN], 1u);
            else XB_SPIN(xb_ld(&bar[XB_TOPGEN]) == tg, bar);
            __builtin_amdgcn_fence(__ATOMIC_ACQUIRE, "agent");
            xb_add(&bar[XB_XGEN(b.x)], 1u);
            asm volatile("s_waitcnt vmcnt(0)" ::: "memory");
        } else {
            XB_SPIN(xb_ld(&bar[XB_XGEN(b.x)]) == gen, bar);
            __builtin_amdgcn_fence(__ATOMIC_ACQUIRE, "agent");
            asm volatile("s_waitcnt vmcnt(0)" ::: "memory");
        }
    }
    __syncthreads();
}

struct KArgs { const float* in[17]; float* out; unsigned char* ws; int ph_lo, ph_hi, li, pad; };
struct Frame {
    LAS unsigned char* lds;
    int tid, lane, wave, vcu, G;
    const float* in[17]; float* out; unsigned char* ws;
};
enum { I_X = 0, I_WIN, I_BIN, I_SINK, I_WPA, I_WPB, I_WOUT, I_GMIX, I_GFFN, I_WRG, I_BRG, I_WRE, I_BRE, I_WEG, I_WEU, I_WED, I_GFIN };

struct TrDesc { const float* W; int N; bf16* WT; int ldo, rowbase, koff, k0, n0; bool perm; const float* kscale; float f8scale; };
__device__ __forceinline__ void tr_load(const TrDesc& d, int lane, f32x4 (&tv)[8], float (&ks)[8]) {
    const float* src = d.W + (size_t)(d.k0 + (lane >> 3)) * d.N + d.n0 + 4 * (lane & 7);
#pragma unroll
    for (int i = 0; i < 8; ++i) tv[i] = *(const GAS f32x4*)(src + (size_t)(8 * i) * d.N);
#pragma unroll
    for (int i = 0; i < 8; ++i) ks[i] = d.kscale ? d.kscale[d.k0 + 8 * i + (lane >> 3)] : 1.0f;
}
__device__ __forceinline__ void tr_finish(const TrDesc& d, LAS float* scr, int lane, const f32x4 (&tv)[8], const float (&ks)[8]) {
#pragma unroll
    for (int i = 0; i < 8; ++i) { const int kk = 8 * i + (lane >> 3); LAS float* w = scr + kk * 33 + 4 * (lane & 7);
        w[0] = tv[i][0] * ks[i]; w[1] = tv[i][1] * ks[i]; w[2] = tv[i][2] * ks[i]; w[3] = tv[i][3] * ks[i]; }
    LDS_WAIT(); asm volatile("" ::: "memory");
    const int c = lane & 7;
#pragma unroll
    for (int j = 0; j < 4; ++j) { const int n = (lane >> 3) + 8 * j; const LAS float* s = scr + (8 * c) * 33 + n;
        const int rr = d.perm ? 8 * (n >> 2) + (n & 3) : n;
        if (d.f8scale != 0.f) { const float f = d.f8scale; v2u o8; o8.x = pk4_fp8(s[0 * 33] * f, s[1 * 33] * f, s[2 * 33] * f, s[3 * 33] * f); o8.y = pk4_fp8(s[4 * 33] * f, s[5 * 33] * f, s[6 * 33] * f, s[7 * 33] * f);
            *(GAS v2u*)((unsigned char*)d.WT + (size_t)(d.rowbase + rr) * d.ldo + d.koff + d.k0 + 8 * c) = o8; }
        else { v4u o; o.x = pk2(s[0 * 33], s[1 * 33]); o.y = pk2(s[2 * 33], s[3 * 33]); o.z = pk2(s[4 * 33], s[5 * 33]); o.w = pk2(s[6 * 33], s[7 * 33]);
            *(GAS v4u*)(d.WT + (size_t)(d.rowbase + rr) * d.ldo + d.koff + d.k0 + 8 * c) = o; } }
    LDS_WAIT(); asm volatile("" ::: "memory");
}
__device__ __forceinline__ void rms_row_to_bf16(const float* xrow, const float* g, bf16* orow, int lane) {
    const GAS f32x4* xr = (const GAS f32x4*)xrow + lane; const GAS f32x4* gr = (const GAS f32x4*)g + lane;
    f32x4 v[4]; float s = 0.f;
#pragma unroll
    for (int j = 0; j < 4; ++j) { v[j] = xr[64 * j]; s += (v[j].x * v[j].x + v[j].y * v[j].y) + (v[j].z * v[j].z + v[j].w * v[j].w); }
    const float rstd = 1.0f / sqrtf(wave_sum(s) * (1.f / D) + RMS_EPS);
    GAS v2u* o8 = (GAS v2u*)orow + lane;
#pragma unroll
    for (int j = 0; j < 4; ++j) { const f32x4 gg = gr[64 * j]; v2u w; w.x = pk2(v[j].x * rstd * gg.x, v[j].y * rstd * gg.y); w.y = pk2(v[j].z * rstd * gg.z, v[j].w * rstd * gg.w); o8[64 * j] = w; }
}
__device__ __forceinline__ void p0_prologue(Frame& F) {
    int tid_ = threadIdx.x; asm volatile("" : "+v"(tid_)); const int lane_ = tid_ & 63;
    LAS float* scr = (LAS float*)(F.lds + F.wave * 16384);
    const int gw = F.vcu * NWAVES + F.wave, NGW = F.G * NWAVES;
    unsigned char* ws = F.ws;
    constexpr int I_IN = 16 * 248, I_PA = 8 * 32, I_PB = 16 * 32, I_WO = 16 * 32, I_EG = 32 * 16 * 8, I_ED = 32 * 4 * 32;
    constexpr int NITEMS = I_IN + I_PA + I_PB + I_WO + 2 * I_EG + I_ED;
    auto decode = [&](int it, TrDesc& d) {
        int r = it; d.perm = false; d.kscale = nullptr; d.f8scale = 0.f; d.koff = 0;
        if (r < I_IN) { const int kb = r / 248, nb = r % 248, n0 = 32 * nb; const bool qk = (n0 < 3072) || (n0 >= A_W && n0 < A_W + 1152);
            const bool gt_ = n0 >= A_W + B_W; const int gc = n0 - (A_W + B_W);
            d.W = F.in[I_WIN]; d.N = NIN; d.WT = (bf16*)(ws + WS_WIN); d.ldo = 1024; d.rowbase = qk ? (n0 & ~63) + ((n0 >> 5) & 1) * 4 : (gt_ ? A_W + B_W + 2 * (gc % 1024) + 4 * (gc / 1024) : n0); d.k0 = 64 * kb; d.n0 = n0; d.perm = qk || gt_; d.f8scale = W8_SCALE; return; } r -= I_IN;
        if (r < I_PA) { const int kb = r / 32, nb = r % 32; d.W = F.in[I_WPA]; d.N = 1024; d.WT = (bf16*)(ws + WS_WAB); d.ldo = 1536; d.rowbase = 32 * nb; d.k0 = 64 * kb; d.n0 = 32 * nb; if (P34_FP8) d.f8scale = W34_SCALE; return; } r -= I_PA;
        if (r < I_PB) { const int kb = r / 32, nb = r % 32; d.W = F.in[I_WPB]; d.N = 1024; d.WT = (bf16*)(ws + WS_WAB); d.ldo = 1536; d.rowbase = 32 * nb; d.koff = 512; d.k0 = 64 * kb; d.n0 = 32 * nb; if (P34_FP8) d.f8scale = W34_SCALE; return; } r -= I_PB;
        if (r < I_WO) { const int kb = r / 32, nb = r % 32; d.W = F.in[I_WOUT]; d.N = 1024; d.WT = (bf16*)(ws + WS_WO); d.ldo = 1024; d.rowbase = 32 * nb; d.k0 = 64 * kb; d.n0 = 32 * nb; if (P34_FP8) d.f8scale = W34_SCALE; return; } r -= I_WO;
        if (r < 2 * I_EG) { const int up = r >= I_EG; if (up) r -= I_EG; const int e = r / 128, q = r % 128, kb = q / 8, nb = q % 8;
            d.W = F.in[up ? I_WEU : I_WEG] + (size_t)e * 1024 * 256; d.N = 256; d.WT = (bf16*)(ws + WS_WGU) + (size_t)e * 512 * 1024; d.ldo = 1024; d.rowbase = 64 * nb + (up ? 4 : 0); d.k0 = 64 * kb; d.n0 = 32 * nb; d.perm = true; d.kscale = F.in[I_GFFN]; d.f8scale = WG8_SCALE; if (P6_FP8) d.WT = (bf16*)((unsigned char*)(ws + WS_WGU) + (size_t)e * 512 * 1024); return; } r -= 2 * I_EG;
        { const int e = r / 128, q = r % 128, kb = q / 32, nb = q % 32;
            d.W = F.in[I_WED] + (size_t)e * 256 * 1024; d.N = 1024; d.WT = (bf16*)(ws + WS_WD) + (size_t)e * 1024 * 256; d.ldo = 256; d.rowbase = 32 * nb; d.k0 = 64 * kb; d.n0 = 32 * nb; d.f8scale = WD8_SCALE; if (P6_FP8) d.WT = (bf16*)((unsigned char*)(ws + WS_WD) + (size_t)e * 1024 * 256); }
    };
    {
        int it = gw; TrDesc dc, dn; f32x4 tc[8], tn[8]; float kc[8], kn[8];
        bool hc = it < NITEMS; if (hc) { decode(it, dc); tr_load(dc, lane_, tc, kc); }
        while (hc) {
            it += NGW; const bool hn = it < NITEMS;
            if (hn) { decode(it, dn); tr_load(dn, lane_, tn, kn); }
            tr_finish(dc, scr, lane_, tc, kc);
            hc = hn; dc = dn;
#pragma unroll
            for (int i = 0; i < 8; ++i) { tc[i] = tn[i]; kc[i] = kn[i]; }
        }
    }
    for (int m = gw; m < T; m += 4 * NGW) {
        const GAS f32x4* gr = (const GAS f32x4*)F.in[I_GMIX] + lane_;
        f32x4 v[4][4]; float ss[4];
#pragma unroll
        for (int r = 0; r < 4; ++r) { const int mr = (m + r * NGW < T) ? m + r * NGW : m; const GAS f32x4* xr = (const GAS f32x4*)(F.in[I_X] + (size_t)mr * D) + lane_;
#pragma unroll
            for (int j = 0; j < 4; ++j) v[r][j] = xr[64 * j]; }
#pragma unroll
        for (int r = 0; r < 4; ++r) { float a = 0.f;
#pragma unroll
            for (int j = 0; j < 4; ++j) a += (v[r][j].x * v[r][j].x + v[r][j].y * v[r][j].y) + (v[r][j].z * v[r][j].z + v[r][j].w * v[r][j].w);
            ss[r] = 1.0f / sqrtf(wave_sum(a) * (1.f / D) + RMS_EPS); }
#pragma unroll
        for (int r = 0; r < 4; ++r) { if (m + r * NGW >= T) continue; GAS unsigned* o4 = (GAS unsigned*)((unsigned char*)F.out + DO_HN + (size_t)(m + r * NGW) * D) + lane_;
#pragma unroll
            for (int j = 0; j < 4; ++j) { const f32x4 gg = gr[64 * j];
                if (P1_FP8) o4[64 * j] = pk4_fp8(v[r][j].x * ss[r] * gg.x, v[r][j].y * ss[r] * gg.y, v[r][j].z * ss[r] * gg.z, v[r][j].w * ss[r] * gg.w);
                else { v2u w; w.x = cvtpk(v[r][j].x * ss[r] * gg.x, v[r][j].y * ss[r] * gg.y); w.y = cvtpk(v[r][j].z * ss[r] * gg.z, v[r][j].w * ss[r] * gg.w); ((GAS v2u*)((unsigned char*)F.out + DO_HN + (size_t)(m + r * NGW) * D * 2) + lane_)[64 * j] = w; } } }
    }
    const int gt = F.vcu * NTHR + tid_, NGT = F.G * NTHR;
    if (gt < 32) ((float*)(ws + WS_INVF))[gt] = (float)exp2(-(double)gt * (13.287712379549449 / 32.0));
    for (int c = gt; c < NIN; c += NGT) {
        int s = c; const int e = c & 7;
        if (c < 3072 || (c >= A_W && c < A_W + 1152)) s = (c & ~63) + 4 * ((c & 63) >> 3) + (e < 4 ? e : 28 + e);
        else if (c >= A_W + B_W) s = A_W + B_W + 4 * ((c - A_W - B_W) >> 3) + (e < 4 ? e : 1020 + e);
        ((float*)(ws + WS_BIASP))[c] = F.in[I_BIN][s];
    }
    for (int i = gt; i < 32 * 3 * 64; i += NGT) {
        const int ln = i & 63, nb = (i >> 6) % 3, ks = i / 192;
        const int n = 16 * nb + (ln & 15);
        float hi[8], lo[8];
#pragma unroll
        for (int e = 0; e < 8; ++e) { const int k = 32 * ks + 8 * (ln >> 4) + e; float v = 0.f;
            if (n < 4) v = F.in[I_WRG][k * 4 + n]; else if (n < 36) v = F.in[I_WRE][k * 32 + (n - 4)];
            v *= F.in[I_GFFN][k]; hi[e] = bf2f(f2bf(v)); lo[e] = v - hi[e]; }
        v4u h, l; h.x = pk2(hi[0], hi[1]); h.y = pk2(hi[2], hi[3]); h.z = pk2(hi[4], hi[5]); h.w = pk2(hi[6], hi[7]);
        l.x = pk2(lo[0], lo[1]); l.y = pk2(lo[2], lo[3]); l.z = pk2(lo[4], lo[5]); l.w = pk2(lo[6], lo[7]);
        ((v4u*)(ws + WS_WRF))[((ks * 3 + nb) * 2 + 0) * 64 + ln] = h; ((v4u*)(ws + WS_WRF))[((ks * 3 + nb) * 2 + 1) * 64 + ln] = l;
    }
}

namespace pg8 {
#define PG8_LAS __attribute__((address_space(3)))
typedef unsigned short bf16_t;
typedef short bf16x8 __attribute__((ext_vector_type(8)));
typedef float f32x4 __attribute__((ext_vector_type(4)));
typedef unsigned u32x4 __attribute__((ext_vector_type(4)));
constexpr int BM = 256, BK = 64, HALF = 128, HTB = HALF * BK * 2  , STAGE_BYTES = 8 * HTB, NXCD = 8, WGM = 8;

__host__ __device__ __forceinline__ int lds_byte(int r, int c) { const int st = (r >> 4) * 2 + (c >> 5), rr = r & 15, cc = c & 31, ob = rr * 64 + cc * 2; return st * 1024 + (ob ^ (((ob >> 9) & 1) << 5)); }
__host__ __device__ __forceinline__ void stage_rc(int b, int& R, int& C) { const int st = b / 1024, sb = b % 1024, swz = sb ^ (((sb >> 9) & 1) << 5); R = (st >> 1) * 16 + swz / 64; C = (st & 1) * 32 + (swz % 64) / 2; }
__host__ __device__ __forceinline__ int perm32(int rho) { const int n = rho >> 4, i = rho & 15; return 8 * (i >> 2) + 4 * n + (i & 3); }

struct Unit { int pm, pn; };
struct Gemm { const bf16_t* A; const bf16_t* Bt; int M, N, K; };

struct StaticOrder {
    int nM, nN, nwg, G, c;
    __host__ __device__ void init(int M, int N, int G_, int c_) { nM = M / BM; nN = N / BM; nwg = nM * nN; G = G_; c = c_; }
    __host__ __device__ bool next(int i, Unit& u) const {
        const long L = (long)i * G + c; if (L >= nwg) return false;
        int wgid = (int)L; { const int q = nwg / NXCD, r = nwg % NXCD, xcd = wgid % NXCD, off = wgid / NXCD; wgid = (xcd < r ? xcd * (q + 1) : r * (q + 1) + (xcd - r) * q) + off; }
        const int nig = WGM * nN, gid = wgid / nig, fm = gid * WGM, gsz = (nM - fm) < WGM ? (nM - fm) : WGM;
        u.pm = fm + ((wgid % nig) % gsz); u.pn = (wgid % nig) / gsz; return true;
    }
    __device__ __forceinline__ void a_ready(const Unit&) const {}
    __device__ __forceinline__ void done(const Unit&) const {}
};
}


namespace pg9 {
using pg8::BM; using pg8::BK; using pg8::HALF; using pg8::HTB; using pg8::lds_byte; using pg8::stage_rc; using pg8::perm32;
struct Unit { int pm, pn, e; };
typedef int v8i_t __attribute__((ext_vector_type(8)));
typedef int v4i_t __attribute__((ext_vector_type(4)));
template <int ESZ, class Epi, class Sched, class AOff, class BBase>
__device__ __forceinline__ void gemm_phase(LAS unsigned char* lds, const char* Abase, int K, const Sched& S, const Epi& E, const AOff& aoffn, const BBase& bbase) {
    int tid_ = threadIdx.x; asm volatile("" : "+v"(tid_));
    const int tid = tid_, wid = __builtin_amdgcn_readfirstlane(tid >> 6), lane = tid & 63, wr = wid >> 2, wc = wid & 3, fr = lane & 15, fq = lane >> 4;
    const int nt = K * ESZ / (BK * 2);
    int Rr[2], Cc[2]; unsigned voffB[2];
#pragma unroll
    for (int i = 0; i < 2; ++i) { int R, C; stage_rc(tid * 16 + i * 8192, R, C); const int Rb = Epi::PERM ? ((R & ~31) + perm32(R & 31)) : R; Rr[i] = R; Cc[i] = C; voffB[i] = (unsigned)(Rb * K * ESZ + C * 2); }
    const size_t kstep = (size_t)(BK * 2);
    const size_t hstep = (size_t)HALF * K * ESZ;
    const unsigned ldsw = (unsigned)wid * 1024u;
    const int aoff = lds_byte(wr * 64 + fr, fq * 8), boff = lds_byte(wc * 32 + fr, fq * 8);
#define PG9_SA(b, h) (((b) * 2 + (h)) * HTB)
#define PG9_SB(b, h) ((4 + (b) * 2 + (h)) * HTB)
#define PG9_STAGE(bufoff, gbase, voff) do { _Pragma("unroll") for (int _i = 0; _i < 2; ++_i) \
        __builtin_amdgcn_global_load_lds((const unsigned*)((const char*)(gbase) + (voff)[_i]), (LAS unsigned*)(lds + (bufoff) + ldsw + _i * 8192), 16, 0, 0); } while (0)
#define PG9_LDA(dst, b, h) do { _Pragma("unroll") for (int m = 0; m < 4; ++m) { dst[m].lo = *(const LAS v4i_t*)(lds + PG9_SA(b, h) + aoff + m * 2048); dst[m].hi = *(const LAS v4i_t*)(lds + PG9_SA(b, h) + aoff + m * 2048 + 1024); } } while (0)
#define PG9_LDB(dst, b, h) do { _Pragma("unroll") for (int n = 0; n < 2; ++n) { dst[n].lo = *(const LAS v4i_t*)(lds + PG9_SB(b, h) + boff + n * 2048); dst[n].hi = *(const LAS v4i_t*)(lds + PG9_SB(b, h) + boff + n * 2048 + 1024); } } while (0)
#define PG9_HALF(v, o) __builtin_bit_cast(bf16x8, __builtin_shufflevector((v), (v), (o), (o) + 1, (o) + 2, (o) + 3))
#define PG9_MMA(ai, bj, At, Bt) do { __builtin_amdgcn_s_setprio(1); _Pragma("unroll") for (int m = 0; m < 4; ++m) _Pragma("unroll") for (int n = 0; n < 2; ++n) { \
        if (ESZ == 2) { acc[ai][bj][m][n] = __builtin_amdgcn_mfma_f32_16x16x32_bf16(PG9_HALF(Bt[n], 0), PG9_HALF(At[m], 0), acc[ai][bj][m][n], 0, 0, 0); \
                        acc[ai][bj][m][n] = __builtin_amdgcn_mfma_f32_16x16x32_bf16(PG9_HALF(Bt[n], 4), PG9_HALF(At[m], 4), acc[ai][bj][m][n], 0, 0, 0); } \
        else { asm volatile("v_mfma_scale_f32_16x16x128_f8f6f4 %0, %1, %2, %0, %3, %3 op_sel_hi:[0,0,0]" : "+v"(acc[ai][bj][m][n]) : "v"(Bt[n]), "v"(At[m]), "v"(one8)); } } \
        __builtin_amdgcn_s_setprio(0); } while (0)
#define PG9_WAIT_V(n) asm volatile("s_waitcnt vmcnt(" #n ")" ::: "memory")
#define PG9_WAIT_L(n) asm volatile("s_waitcnt lgkmcnt(" #n ")" ::: "memory")
#define PG9_BAR __builtin_amdgcn_s_barrier()
#define PG9_SCHED __builtin_amdgcn_sched_barrier(0)
#define PG9_VA(dst, u) do { _Pragma("unroll") for (int _h = 0; _h < 2; ++_h) _Pragma("unroll") for (int _i = 0; _i < 2; ++_i) dst[_h][_i] = aoffn((u), _h * HALF + Rr[_i]) + (unsigned)(Cc[_i] * 2); } while (0)
    constexpr bool GATHER = AOff::GATHER;
    const size_t hstepA = (size_t)HALF * aoffn.rowbytes;
    unsigned voffA[2];
#pragma unroll
    for (int i = 0; i < 2; ++i) voffA[i] = (unsigned)Rr[i] * aoffn.rowbytes + (unsigned)(Cc[i] * 2);
#define PG9_STAGE_A(bufoff, h, koff, nx) do { if (GATHER) { PG9_STAGE(bufoff, Abase + (koff), ((nx) ? nvA[h] : cvA[h])); } else { PG9_STAGE(bufoff, ((nx) ? nAu : cAu) + (h) * hstepA + (koff), voffA); } } while (0)
    Unit cur, nxt; int ui = 0;
    if (!S.next(0, cur)) return;
    f32x4 acc[2][2][4][2];
#pragma unroll
    for (int a = 0; a < 2; ++a)
#pragma unroll
        for (int b = 0; b < 2; ++b)
#pragma unroll
            for (int m = 0; m < 4; ++m)
#pragma unroll
                for (int n = 0; n < 2; ++n) acc[a][b][m][n] = (f32x4){0.f, 0.f, 0.f, 0.f};
    int one8 = 0x7f7f7f7f; asm volatile("" : "+v"(one8));
    v8i_t At[4], B0[2], B1[2];
    unsigned cvA[2][2], nvA[2][2];
    if (GATHER) { PG9_VA(cvA, cur); }
    const char* cAu = GATHER ? Abase : Abase + (size_t)aoffn(cur, 0); const char* nAu = cAu;
    const char* cB = bbase(cur);
    E.prefetch(lds, cur, 0, wid, lane);
    PG9_STAGE(PG9_SB(0, 0), cB, voffB); PG9_STAGE(PG9_SB(0, 1), cB + hstep, voffB); PG9_STAGE_A(PG9_SA(0, 0), 0, 0, false); PG9_STAGE_A(PG9_SA(0, 1), 1, 0, false);
    if (wr == 1) PG9_BAR;
    PG9_WAIT_V(2); PG9_BAR;
    PG9_STAGE(PG9_SB(1, 0), cB + kstep, voffB); PG9_STAGE_A(PG9_SA(1, 0), 0, kstep, false); PG9_STAGE(PG9_SB(1, 1), cB + hstep + kstep, voffB);
    PG9_WAIT_V(6); PG9_BAR;
    for (;;) {
        const bool has_next = S.next(ui + 1, nxt);
        if (GATHER) {
            if (has_next) { PG9_VA(nvA, nxt); } else {
#pragma unroll
                for (int _h = 0; _h < 2; ++_h)
#pragma unroll
                    for (int _i = 0; _i < 2; ++_i) nvA[_h][_i] = cvA[_h][_i]; }
        } else nAu = has_next ? Abase + (size_t)aoffn(nxt, 0) : cAu;
        const char* nB = has_next ? bbase(nxt) : cB;
#pragma unroll 1
        for (int t = 0; t < nt; t += 2) {
            const bool last = (t == nt - 2);
            if (Epi::HOOK_T >= 0) { if (t == Epi::HOOK_T) E.hook(acc, cur, wr, wc, fr, fq); }
            const size_t k1 = (size_t)(t + 1) * kstep, k2 = last ? 0 : (size_t)(t + 2) * kstep, k3 = k2 + kstep;
            const char* b2 = last ? nB : cB + (size_t)(t + 2) * kstep; const char* b3 = b2 + kstep;
            PG9_LDB(B0, 0, 0); PG9_LDB(B1, 0, 1); PG9_SCHED; PG9_LDA(At, 0, 0); PG9_STAGE_A(PG9_SA(1, 1), 1, k1, false);
            PG9_WAIT_V(8); PG9_WAIT_L(0); PG9_BAR; PG9_MMA(0, 0, At, B0); PG9_MMA(0, 1, At, B1); PG9_BAR; PG9_SCHED;
            PG9_LDA(At, 0, 1); PG9_STAGE(PG9_SB(0, 0), b2, voffB); PG9_STAGE(PG9_SB(0, 1), b2 + hstep, voffB); PG9_STAGE_A(PG9_SA(0, 0), 0, k2, last);
            PG9_WAIT_V(8); PG9_WAIT_L(0); PG9_BAR; PG9_MMA(1, 0, At, B0); PG9_MMA(1, 1, At, B1); PG9_BAR; PG9_SCHED;
            PG9_LDB(B0, 1, 0); PG9_LDB(B1, 1, 1); PG9_SCHED; PG9_LDA(At, 1, 0); PG9_STAGE_A(PG9_SA(0, 1), 1, k2, last);
            PG9_WAIT_V(8); PG9_WAIT_L(0); PG9_BAR; PG9_MMA(0, 0, At, B0); PG9_MMA(0, 1, At, B1); PG9_BAR; PG9_SCHED;
            PG9_LDA(At, 1, 1); PG9_STAGE(PG9_SB(1, 0), b3, voffB); PG9_STAGE(PG9_SB(1, 1), b3 + hstep, voffB); PG9_STAGE_A(PG9_SA(1, 0), 0, k3, last);
            PG9_WAIT_V(8); PG9_WAIT_L(0); PG9_BAR; PG9_MMA(1, 0, At, B0); PG9_MMA(1, 1, At, B1); PG9_BAR; PG9_SCHED;
        }
        if (wr == 0) PG9_BAR;
        if (ESZ == 1) asm volatile("s_nop 15\n\ts_nop 15" ::: "memory");
        E(acc, cur, ui, wr, wc, fr, fq);
        if (!has_next) break;
#pragma unroll
        for (int a = 0; a < 2; ++a)
#pragma unroll
            for (int b = 0; b < 2; ++b)
#pragma unroll
                for (int m = 0; m < 4; ++m)
#pragma unroll
                    for (int n = 0; n < 2; ++n) acc[a][b][m][n] = (f32x4){0.f, 0.f, 0.f, 0.f};
        cur = nxt; cB = nB; cAu = nAu; ++ui;
        E.prefetch(lds, cur, ui, wid, lane);
        if (GATHER) {
#pragma unroll
            for (int _h = 0; _h < 2; ++_h)
#pragma unroll
                for (int _i = 0; _i < 2; ++_i) cvA[_h][_i] = nvA[_h][_i]; }
        if (wr == 1) PG9_BAR;
    }
    PG9_WAIT_V(0);
    PG9_BAR;
#undef PG9_SA
#undef PG9_SB
#undef PG9_STAGE
#undef PG9_LDA
#undef PG9_LDB
#undef PG9_MMA
#undef PG9_HALF
#undef PG9_WAIT_V
#undef PG9_WAIT_L
#undef PG9_BAR
#undef PG9_SCHED
#undef PG9_VA
#undef PG9_STAGE_A
}
struct DenseOrder { pg8::StaticOrder so;
    __device__ void init(int M, int N, int G, int c) { so.init(M, N, G, c); }
    __device__ bool next(int i, Unit& u) const { pg8::Unit v; if (!so.next(i, v)) return false; u.pm = v.pm; u.pn = v.pn; u.e = 0; return true; } };
struct DenseA { static constexpr bool GATHER = false; unsigned rowbytes; __device__ __forceinline__ unsigned operator()(const Unit& u, int row) const { return (unsigned)(u.pm * 256 + row) * rowbytes; } };
struct DenseB { const char* Bt; size_t tilebytes; __device__ __forceinline__ const char* operator()(const Unit& u) const { return Bt + (size_t)u.pn * tilebytes; } };
}

struct EpiInproj {
    static constexpr bool PERM = true; static constexpr int HOOK_T = -1;
    bf16* ZA; bf16* ZB; bf16* Gt; const float* biasP; LAS unsigned char* ldsb;
    __device__ __forceinline__ void hook(f32x4 (&)[2][2][4][2], const pg9::Unit&, int, int, int, int) const {}
    __device__ __forceinline__ void prefetch(LAS unsigned char* lds, const pg9::Unit& u, int ui, int wid, int lane) const {
        if (wid == 0) __builtin_amdgcn_global_load_lds((const unsigned*)(biasP + u.pn * 256 + lane * 4), (LAS unsigned*)(lds + LDS_MISC + 4096 + (ui & 1) * 1024), 16, 0, 0);
    }
    __device__ __forceinline__ void operator()(const f32x4 (&acc)[2][2][4][2], const pg9::Unit& u, int ui, int wr, int wc, int fr, int fq) const {
        asm volatile("" : "+v"(fr), "+v"(fq));
        const int row0 = u.pm * 256 + wr * 64 + fr;
        const int q = 4 * (wc & 1) + fq;
        const int fr2 = (fr >> 2) + 4 * fq, fq2 = fr & 3, paddr = 4 * (16 * (fr & 3) + 4 * fq + (fr >> 2));
        const int row0s = u.pm * 256 + wr * 64 + fr2;
        int kind[2]; bf16* dst[2]; int ldd[2]; f32x4 b0[2], b1[2];
#pragma unroll
        for (int bj = 0; bj < 2; ++bj) {
            const int colpos = u.pn * 256 + bj * 128 + wc * 32 + 8 * fq, colposs = u.pn * 256 + bj * 128 + wc * 32 + 8 * fq2, hb = u.pn * 256 + bj * 128 + (wc >> 1) * 64;
            if (hb < A_W) { const int hbi = hb >> 6; kind[bj] = hb / 1536; dst[bj] = ZA + (size_t)hbi * (TC * 64) + (colposs - hb); ldd[bj] = 2 * ((hbi % 24) >> 3); }
            else if (hb < A_W + B_W) { const int cb = hb - A_W; kind[bj] = cb < 1024 ? 0 : (cb < 1152 ? 1 : 2); dst[bj] = ZB + (size_t)(cb >> 6) * (TC * 64) + (colposs - hb); ldd[bj] = 0; }
            else { kind[bj] = 3; const int c0 = (colpos - A_W - B_W) >> 1;
                dst[bj] = Gt + ((size_t)((u.pm * 256 + wr * 64) >> 4) * 256 + (c0 >> 3)) * 128 + fr * 8 + (c0 & 7); ldd[bj] = 0; }
            const LAS float* bs = (const LAS float*)(ldsb + LDS_MISC + 4096 + (ui & 1) * 1024) + bj * 128 + wc * 32 + 8 * fq;
            b0[bj] = *(const LAS f32x4*)bs; b1[bj] = *(const LAS f32x4*)(bs + 4);
        }
        const bool need_rope = kind[0] < 2 || kind[1] < 2;
        const f32x4 fv = *(const LAS f32x4*)(ldsb + LDS_MISC + 6144 + 16 * q);
#pragma unroll
        for (int ai = 0; ai < 2; ++ai) {
            f32x4 rc[4], rs[4];
#pragma unroll
            for (int m = 0; m < 4; ++m) { rc[m] = (f32x4){1.f, 1.f, 1.f, 1.f}; rs[m] = (f32x4){0.f, 0.f, 0.f, 0.f}; }
            if (need_rope) {
#pragma unroll
                for (int m = 0; m < 4; ++m) { const float posf = (float)((row0 + ai * 128 + m * 16) & (SEQ - 1));
#pragma unroll
                    for (int e = 0; e < 4; ++e) { const float ang = posf * fv[e]; const float pr = ang * 0.15915494f; const float er = __builtin_fmaf(ang, 0.15915494f, -pr) + ang * 6.4206382e-9f;
                        const float fr = __builtin_amdgcn_fractf(pr) + er; rc[m][e] = __builtin_amdgcn_cosf(fr); rs[m][e] = __builtin_amdgcn_sinf(fr); } }
            }
#pragma unroll
            for (int bj = 0; bj < 2; ++bj) {
                const int sh = ldd[bj], posr = row0s & (SEQ - 1), ridx = (row0s & ~(SEQ - 1)) + ((posr & ((1 << sh) - 1)) << (12 - sh)) + (posr >> sh);
                bf16* p = dst[bj] + (size_t)(ridx + ai * (128 >> sh)) * 64; const unsigned step = (unsigned)((16 >> sh) * 64);
                if (kind[bj] == 3) p = dst[bj] + (size_t)(ai * 8) * 32768;
                switch (kind[bj]) {
                    case 0: store4<0>(acc[ai][bj], b0[bj], b1[bj], rc, rs, p, step, paddr); break;
                    case 1: store4<1>(acc[ai][bj], b0[bj], b1[bj], rc, rs, p, step, paddr); break;
                    case 2: store4<2>(acc[ai][bj], b0[bj], b1[bj], rc, rs, p, step, paddr); break;
                    default: store4<3>(acc[ai][bj], b0[bj], b1[bj], rc, rs, p, step, paddr); break;
                }
            }
        }
    }
    template <int KIND> static __device__ __forceinline__ void store4(const f32x4 (&a)[4][2], const f32x4 b0, const f32x4 b1, const f32x4 (&rc)[4], const f32x4 (&rs)[4], bf16* p, const unsigned step, const int paddr) {
#pragma unroll
        for (int m = 0; m < 4; ++m) {
            f32x4 v0 = a[m][0] * W8_INV + b0, v1 = a[m][1] * W8_INV + b1;
            if (KIND < 2) {
                const f32x4 cc = rc[m], ss = rs[m];
                const f32x4 t0 = v0 * cc - v1 * ss, t1 = v1 * cc + v0 * ss;
                v0 = t0; v1 = t1;
                if (KIND == 0) { v0 = v0 * QSCALE; v1 = v1 * QSCALE; }
            }
            if (KIND == 3) {
#pragma unroll
                for (int e = 0; e < 4; ++e) { const float d0 = 1.0f + __expf(-v0[e]), d1 = 1.0f + __expf(-v1[e]); v0[e] = d1 * __builtin_amdgcn_rcpf(d0); v1[e] = __builtin_amdgcn_rcpf(d1); }
                v2u w0, w1; w0.x = cvtpk(v0[0], v0[1]); w0.y = cvtpk(v0[2], v0[3]); w1.x = cvtpk(v1[0], v1[1]); w1.y = cvtpk(v1[2], v1[3]);
                *(GAS v2u*)p = w0; *(GAS v2u*)(p + 128 * 128) = w1; p += 32768;
            } else {
                v4u w; w.x = cvtpk(v0[0], v0[1]); w.y = cvtpk(v0[2], v0[3]); w.z = cvtpk(v1[0], v1[1]); w.w = cvtpk(v1[2], v1[3]);
                w.x = (unsigned)__builtin_amdgcn_ds_bpermute(paddr, (int)w.x); w.y = (unsigned)__builtin_amdgcn_ds_bpermute(paddr, (int)w.y); w.z = (unsigned)__builtin_amdgcn_ds_bpermute(paddr, (int)w.z); w.w = (unsigned)__builtin_amdgcn_ds_bpermute(paddr, (int)w.w);
                *(GAS v4u*)p = w; p += step;
            }
        }
    }
};
__device__ __forceinline__ void p1_inproj(Frame& F, int ch) {
    unsigned char* ws = F.ws;
    pg9::DenseOrder S; S.init(TC, NIN, F.G, (int)blockIdx.x);
    EpiInproj E{(bf16*)(ws + WS_ZA), (bf16*)(ws + WS_ZB), (bf16*)(ws + WS_G) + (size_t)ch * TC * G_W, (const float*)(ws + WS_BIASP), F.lds};
    { int t_ = threadIdx.x; asm volatile("" : "+v"(t_)); if (t_ < 32) ((LAS float*)(F.lds + LDS_MISC + 6144))[t_] = ((const float*)(ws + WS_INVF))[t_]; }
    constexpr int ES = P1_FP8 ? 1 : 2;
    pg9::DenseA ao{(unsigned)(D * ES)}; pg9::DenseB bb{(const char*)(ws + WS_WIN), (size_t)256 * D * ES};
    pg9::gemm_phase<ES>(F.lds, (const char*)F.out + DO_HN + (size_t)ch * TC * D * ES, D, S, E, ao, bb);
}

typedef float f32x16 __attribute__((ext_vector_type(16)));
typedef short v4i16_t __attribute__((ext_vector_type(4)));
__device__ __forceinline__ float half_max(float v) { auto rr = __builtin_amdgcn_permlane32_swap(__float_as_uint(v), __float_as_uint(v), false, false); return fmaxf(__uint_as_float(rr[0]), __uint_as_float(rr[1])); }
__device__ __forceinline__ float half_sum(float v) { auto rr = __builtin_amdgcn_permlane32_swap(__float_as_uint(v), __float_as_uint(v), false, false); return __uint_as_float(rr[0]) + __uint_as_float(rr[1]); }
__device__ __forceinline__ float max3f(float a, float b, float c) { float r; asm("v_max3_f32 %0, %1, %2, %3" : "=v"(r) : "v"(a), "v"(b), "v"(c)); return r; }
constexpr int ATT_VOFF = 49152;

struct AUnit { const bf16 *Kw, *Vw, *Qp; size_t pitch; int kk_lo, nkeys, kb0, kstart, lo; float m0; bf16* Op; long ostr; float* Lp; int o8; };
__device__ __forceinline__ void attn_decode(Frame& F, int ch, int u, int NUA, int lane, AUnit& d) {
    unsigned char* ws = F.ws;
    const int w = F.wave, c = lane & 31, h = (lane >> 5) & 1;
    if (u < NUA) {
        const bf16* ZA = (const bf16*)(ws + WS_ZA);
        const int rt = u & 15, hh = (u >> 4) & 7, gb = u >> 7, g = gb % 3, bl = gb / 3;
        const int dsh = 2 * g, dd = 1 << dsh, tsh = 4 - dsh;
        const int r = rt >> tsh, tile = rt & ((1 << tsh) - 1), i0 = tile * 256;
        const int rowb = bl * SEQ + r;
        d.pitch = 64;
        const int sl = g * 8 + hh; const long rb = (long)bl * SEQ + ((long)r << (12 - dsh));
        d.Kw = ZA + ((long)(24 + sl) * TC + rb + (i0 - 128)) * 64; d.Vw = ZA + ((long)(48 + sl) * TC + rb + (i0 - 128)) * 64;
        const long qrow = (long)rowb + (long)dd * (i0 + 32 * w + c);
        d.Qp = ZA + ((long)sl * TC + rb + i0 + 32 * w + c) * 64;
        d.kk_lo = (i0 == 0) ? 128 : 0; d.nkeys = 384; d.kb0 = w; d.kstart = (i0 == 0) ? (w < 4 ? 4 - w : 0) : 0; d.lo = 0;
        d.m0 = -1e30f;
        d.Op = (bf16*)((unsigned char*)F.out + DO_OG) + ((size_t)g * TC + (qrow - (long)dd * c)) * 512 + hh * 64; d.ostr = (long)dd * 1024;
        d.Lp = (float*)((unsigned char*)F.out + DO_LSE) + ((size_t)g * TC + qrow) * 8 + hh;
        d.o8 = 0;
    } else {
        const int u2 = u - NUA;
        const bf16* ZB = (const bf16*)(ws + WS_ZB);
        const int blk = u2 & 127, kvh = (u2 >> 7) & 1, bl = u2 >> 8;
        const int t0 = blk * 32, rowb = bl * SEQ;
        d.pitch = 64;
        d.Kw = ZB + ((long)(16 + kvh) * TC + rowb + t0 - 128) * 64; d.Vw = ZB + ((long)(18 + kvh) * TC + rowb + t0 - 128) * 64;
        const int qh = kvh * 8 + w;
        const long qrow = (long)rowb + t0 + c;
        d.Qp = ZB + ((long)qh * TC + qrow) * 64;
        d.kk_lo = t0 < 128 ? 128 - t0 : 0; d.nkeys = 160; d.kb0 = 0; d.kstart = d.kk_lo >> 5; d.lo = 1;
        d.m0 = F.in[I_SINK][qh] * LOG2E;
        d.o8 = P34_FP8;
        d.Op = P34_FP8 ? (bf16*)(ws + WS_Y + ((size_t)ch * TC + (qrow - c)) * Y_W + 512 + qh * 64) : (bf16*)(ws + WS_Y) + ((size_t)ch * TC + (qrow - c)) * Y_W + 512 + qh * 64; d.ostr = P34_FP8 ? Y_W : 2 * Y_W;
        d.Lp = nullptr;
    }
}
__device__ __forceinline__ void attn_load(const AUnit& d, int tid, int lane, v4u (&kreg)[6], v4u (&vreg)[6], bf16x8 (&qf)[4]) {
    const int skey = tid >> 3, sch = tid & 7, h = (lane >> 5) & 1;
#pragma unroll
    for (int s4 = 0; s4 < 4; ++s4) qf[s4] = *(const GAS bf16x8*)(d.Qp + 16 * s4 + 8 * h);
#pragma unroll
    for (int p = 0; p < 6; ++p) { const int kk = 64 * p + skey;
        if (kk >= d.kk_lo && kk < d.nkeys) { kreg[p] = *(const GAS v4u*)(d.Kw + (size_t)kk * d.pitch + 8 * sch); vreg[p] = *(const GAS v4u*)(d.Vw + (size_t)kk * d.pitch + 8 * sch); } }
}
__device__ __forceinline__ void attn_write(const AUnit& d, LAS unsigned char* KL, LAS unsigned char* VL, int tid, const v4u (&kreg)[6], const v4u (&vreg)[6]) {
    const int skey = tid >> 3, sch = tid & 7;
#pragma unroll
    for (int p = 0; p < 6; ++p) { const int kk = 64 * p + skey;
        if (kk >= d.kk_lo && kk < d.nkeys) {
            *(LAS v4u*)(KL + kk * 128 + ((sch ^ ((kk >> 1) & 7)) << 4)) = kreg[p];
            *(LAS v4u*)(VL + kk * 128 + ((sch * 16) ^ (((kk >> 1) & 1) << 6))) = vreg[p]; } }
}
__device__ __forceinline__ void attn_out(const AUnit& d, LAS unsigned char* OL, int lane, const f32x16& o0, const f32x16& o1, float inv) {
    asm volatile("" : "+v"(lane));
    const int c = lane & 31, h = (lane >> 5) & 1;
    if (d.o8) {
        const float sc = inv * Y8_SCALE;
#pragma unroll
        for (int g4 = 0; g4 < 4; ++g4) {
            const int bo0 = 8 * g4 + 4 * h, bo1 = 32 + bo0;
            *(LAS unsigned*)(OL + c * 64 + (((bo0 >> 4) ^ (c & 3)) << 4) + (bo0 & 15)) = pk4_fp8(o0[4 * g4 + 0] * sc, o0[4 * g4 + 1] * sc, o0[4 * g4 + 2] * sc, o0[4 * g4 + 3] * sc);
            *(LAS unsigned*)(OL + c * 64 + (((bo1 >> 4) ^ (c & 3)) << 4) + (bo1 & 15)) = pk4_fp8(o1[4 * g4 + 0] * sc, o1[4 * g4 + 1] * sc, o1[4 * g4 + 2] * sc, o1[4 * g4 + 3] * sc);
        }
        unsigned char* ob = (unsigned char*)d.Op;
#pragma unroll
        for (int j = 0; j < 2; ++j) { const int q = (lane >> 2) + 16 * j, k = lane & 3;
            const v4u v = *(const LAS v4u*)(OL + q * 64 + ((k ^ (q & 3)) << 4)); *(GAS v4u*)(ob + (long)q * d.ostr + k * 16) = v; }
    } else {
#pragma unroll
        for (int g4 = 0; g4 < 4; ++g4) {
            v2u a, b;
            a.x = cvtpk(o0[4 * g4 + 0] * inv, o0[4 * g4 + 1] * inv); a.y = cvtpk(o0[4 * g4 + 2] * inv, o0[4 * g4 + 3] * inv);
            b.x = cvtpk(o1[4 * g4 + 0] * inv, o1[4 * g4 + 1] * inv); b.y = cvtpk(o1[4 * g4 + 2] * inv, o1[4 * g4 + 3] * inv);
            const int bo0 = 16 * g4 + 8 * h, bo1 = 64 + bo0;
            *(LAS v2u*)(OL + c * 128 + (((bo0 >> 4) ^ (c & 7)) << 4) + (bo0 & 15)) = a;
            *(LAS v2u*)(OL + c * 128 + (((bo1 >> 4) ^ (c & 7)) << 4) + (bo1 & 15)) = b;
        }
        unsigned char* ob = (unsigned char*)d.Op;
#pragma unroll
        for (int j = 0; j < 4; ++j) { const int q = (lane >> 3) + 8 * j, k = lane & 7;
            const v4u v = *(const LAS v4u*)(OL + q * 128 + ((k ^ (q & 7)) << 4)); *(GAS v4u*)(ob + (long)q * d.ostr + k * 16) = v; }
    }
}
__device__ __forceinline__ void attn_compute_edge(const AUnit& d, const LAS unsigned char* KL, const LAS unsigned char* VL, LAS unsigned char* OL, int lane, const bf16x8 (&qf)[4]) {
    const int c = lane & 31, h = (lane >> 5) & 1;
    int koff[4];
    { const int kswz = (c >> 1) & 7;
#pragma unroll
      for (int s4 = 0; s4 < 4; ++s4) koff[s4] = c * 128 + (((2 * s4 + h) ^ kswz) << 4); }
    const int vrow = 4 * h + ((lane & 15) >> 2), vsw = (lane >> 3) & 1;
    const int voff0 = vrow * 128 + ((32 * ((lane >> 4) & 1) + 8 * (lane & 3)) ^ (vsw << 6)), voff1 = voff0 ^ 64;
    const float NEG = -INFINITY;
    float m = d.m0, l = (d.lo && h == 0) ? 1.f : 0.f;
    f32x16 o0, o1;
#pragma unroll
    for (int i = 0; i < 16; ++i) { o0[i] = 0.f; o1[i] = 0.f; }
    const LAS unsigned char* kbp = KL + d.kb0 * 4096; const LAS unsigned char* vbp = VL + d.kb0 * 4096;
    const int clo = c + d.lo;
#pragma unroll
    for (int kbi = 0; kbi < 5; ++kbi) {
        if (kbi >= d.kstart) {
            f32x16 p;
#pragma unroll
            for (int i = 0; i < 16; ++i) p[i] = 0.f;
#pragma unroll
            for (int s4 = 0; s4 < 4; ++s4) { const bf16x8 kf = *(const LAS bf16x8*)(kbp + kbi * 4096 + koff[s4]); p = __builtin_amdgcn_mfma_f32_32x32x16_bf16(kf, qf[s4], p, 0, 0, 0); }
            if (kbi == 0) {
#pragma unroll
                for (int i = 0; i < 16; ++i) { const int x = (i & 3) + 8 * (i >> 2) + 4 * h; if (x < clo) p[i] = NEG; }
            }
            if (kbi == 4) {
#pragma unroll
                for (int i = 0; i < 16; ++i) { const int x = (i & 3) + 8 * (i >> 2) + 4 * h; if (x > c) p[i] = NEG; }
            }
            float mt = p[0];
#pragma unroll
            for (int i = 1; i < 16; ++i) mt = fmaxf(mt, p[i]);
            mt = half_max(mt);
            const float mn = fmaxf(m, mt), alpha = __builtin_amdgcn_exp2f(m - mn);
            m = mn;
            float ps = 0.f;
#pragma unroll
            for (int i = 0; i < 16; ++i) { p[i] = __builtin_amdgcn_exp2f(p[i] - mn); ps += p[i]; }
            l = l * alpha + ps;
#pragma unroll
            for (int i = 0; i < 16; ++i) { o0[i] *= alpha; o1[i] *= alpha; }
            bf16x8 pb[2];
#pragma unroll
            for (int s2 = 0; s2 < 2; ++s2) { v4u t; t.x = cvtpk(p[8 * s2 + 0], p[8 * s2 + 1]); t.y = cvtpk(p[8 * s2 + 2], p[8 * s2 + 3]); t.z = cvtpk(p[8 * s2 + 4], p[8 * s2 + 5]); t.w = cvtpk(p[8 * s2 + 6], p[8 * s2 + 7]); pb[s2] = __builtin_bit_cast(bf16x8, t); }
#pragma unroll
            for (int s2 = 0; s2 < 2; ++s2) {
#pragma unroll
                for (int db = 0; db < 2; ++db) {
                    const LAS unsigned char* vp = vbp + kbi * 4096 + s2 * 2048 + (db ? voff1 : voff0);
                    const v4i16_t lo = __builtin_amdgcn_ds_read_tr16_b64_v4i16((LAS v4i16_t*)vp);
                    const v4i16_t hi = __builtin_amdgcn_ds_read_tr16_b64_v4i16((LAS v4i16_t*)(vp + 1024));
                    const bf16x8 vf = {lo[0], lo[1], lo[2], lo[3], hi[0], hi[1], hi[2], hi[3]};
                    if (db == 0) o0 = __builtin_amdgcn_mfma_f32_32x32x16_bf16(vf, pb[s2], o0, 0, 0, 0);
                    else o1 = __builtin_amdgcn_mfma_f32_32x32x16_bf16(vf, pb[s2], o1, 0, 0, 0);
                }
            }
        }
    }
    const float lt = half_sum(l), inv = 1.0f / lt;
    attn_out(d, OL, lane, o0, o1, inv);
    if (d.Lp) { if (h == 0) *d.Lp = m + __builtin_amdgcn_logf(lt); }
}
__device__ __forceinline__ void attn_compute(const AUnit& d, const LAS unsigned char* KL, const LAS unsigned char* VL, LAS unsigned char* OL, int lane, const bf16x8 (&qf)[4]) {
    const int c = lane & 31, h = (lane >> 5) & 1;
    int koff[4];
    { const int kswz = (c >> 1) & 7;
#pragma unroll
      for (int s4 = 0; s4 < 4; ++s4) koff[s4] = c * 128 + (((2 * s4 + h) ^ kswz) << 4); }
    const int vrow = 4 * h + ((lane & 15) >> 2), vsw = (lane >> 3) & 1;
    const int voff0 = vrow * 128 + ((32 * ((lane >> 4) & 1) + 8 * (lane & 3)) ^ (vsw << 6)), voff1 = voff0 ^ 64;
    const float NEG = -INFINITY;
    float m = d.m0;
    f32x16 o0, o1, L;
#pragma unroll
    for (int i = 0; i < 16; ++i) { o0[i] = 0.f; o1[i] = 0.f; L[i] = 0.f; }
    v4u onesu = {0x3F803F80u, 0x3F803F80u, 0x3F803F80u, 0x3F803F80u}; asm volatile("" : "+v"(onesu));
    const bf16x8 ones = __builtin_bit_cast(bf16x8, onesu);
    const LAS unsigned char* kbp = KL + d.kb0 * 4096; const LAS unsigned char* vbp = VL + d.kb0 * 4096;
    const int clo = c + d.lo;
#pragma unroll
    for (int kbi = 0; kbi < 5; ++kbi) {
        {
            constexpr bool first_dummy = false; (void)first_dummy;
            const bool first = (kbi == 0);
            const float cinit = first ? 0.f : -m;
            f32x16 p;
#pragma unroll
            for (int i = 0; i < 16; ++i) p[i] = cinit;
#pragma unroll
            for (int s4 = 0; s4 < 4; ++s4) { const bf16x8 kf = *(const LAS bf16x8*)(kbp + kbi * 4096 + koff[s4]); p = __builtin_amdgcn_mfma_f32_32x32x16_bf16(kf, qf[s4], p, 0, 0, 0); }
            if (kbi == 0) {
#pragma unroll
                for (int i = 0; i < 16; ++i) { const int x = (i & 3) + 8 * (i >> 2) + 4 * h; p[i] = x < clo ? NEG : p[i]; }
            }
            if (kbi == 4) {
#pragma unroll
                for (int i = 0; i < 16; ++i) { const int x = (i & 3) + 8 * (i >> 2) + 4 * h; p[i] = x > c ? NEG : p[i]; }
            }
            float t0 = max3f(p[0], p[4], p[8]), t1 = max3f(p[1], p[5], p[9]), t2 = max3f(p[2], p[6], p[10]), t3 = max3f(p[3], p[7], p[11]);
            t0 = max3f(t0, p[12], p[13]); t1 = max3f(t1, p[14], p[15]);
            const float mt = half_max(max3f(max3f(t0, t1, t2), t3, t3));
            if (first) {
                const float mn = fmaxf(m, mt), l0 = d.m0 > -1e29f ? __builtin_amdgcn_exp2f(m - mn) : 0.f;
                m = mn;
#pragma unroll
                for (int i = 0; i < 16; ++i) { p[i] -= mn; L[i] = l0; }
            } else if (__any(mt > 8.0f)) {
                const float dl = fmaxf(mt, 0.f), al = __builtin_amdgcn_exp2f(-dl);
                m += dl;
#pragma unroll
                for (int i = 0; i < 16; ++i) { o0[i] *= al; o1[i] *= al; L[i] *= al; p[i] -= dl; }
            }
#pragma unroll
            for (int i = 0; i < 16; ++i) p[i] = __builtin_amdgcn_exp2f(p[i]);
            bf16x8 pb[2];
#pragma unroll
            for (int s2 = 0; s2 < 2; ++s2) { v4u t; t.x = cvtpk(p[8 * s2 + 0], p[8 * s2 + 1]); t.y = cvtpk(p[8 * s2 + 2], p[8 * s2 + 3]); t.z = cvtpk(p[8 * s2 + 4], p[8 * s2 + 5]); t.w = cvtpk(p[8 * s2 + 6], p[8 * s2 + 7]); pb[s2] = __builtin_bit_cast(bf16x8, t); }
#pragma unroll
            for (int s2 = 0; s2 < 2; ++s2) {
                L = __builtin_amdgcn_mfma_f32_32x32x16_bf16(ones, pb[s2], L, 0, 0, 0);
#pragma unroll
                for (int db = 0; db < 2; ++db) {
                    const LAS unsigned char* vp = vbp + kbi * 4096 + s2 * 2048 + (db ? voff1 : voff0);
                    const v4i16_t lo = __builtin_amdgcn_ds_read_tr16_b64_v4i16((LAS v4i16_t*)vp);
                    const v4i16_t hi = __builtin_amdgcn_ds_read_tr16_b64_v4i16((LAS v4i16_t*)(vp + 1024));
                    const bf16x8 vf = {lo[0], lo[1], lo[2], lo[3], hi[0], hi[1], hi[2], hi[3]};
                    if (db == 0) o0 = __builtin_amdgcn_mfma_f32_32x32x16_bf16(vf, pb[s2], o0, 0, 0, 0);
                    else o1 = __builtin_amdgcn_mfma_f32_32x32x16_bf16(vf, pb[s2], o1, 0, 0, 0);
                }
            }
        }
    }
    const float lt = L[0], inv = 1.0f / lt;
    attn_out(d, OL, lane, o0, o1, inv);
    if (d.Lp) { if (h == 0) *d.Lp = m + __builtin_amdgcn_logf(lt); }
}
__device__ __forceinline__ void p2_attn(Frame& F, int ch) {
    int tid_ = threadIdx.x; asm volatile("" : "+v"(tid_));
    const int tid = tid_, lane = tid & 63;
    LAS unsigned char* KL = F.lds; LAS unsigned char* VL = F.lds + ATT_VOFF; LAS unsigned char* OL = F.lds + 2 * ATT_VOFF + F.wave * 4096;
    constexpr int NUA = (TC / SEQ) * 3 * 8 * 16, NUB = (TC / SEQ) * 2 * 128, NU = NUA + NUB;
    int u = F.vcu; asm volatile("" : "+s"(u));
    if (u >= NU) return;
    AUnit cur, nxt;
    v4u kreg[6], vreg[6]; bf16x8 qn[4];
    attn_decode(F, ch, u, NUA, lane, cur);
    attn_load(cur, tid, lane, kreg, vreg, qn);
    for (;;) {
        attn_write(cur, KL, VL, tid, kreg, vreg);
        bf16x8 qf[4];
#pragma unroll
        for (int s4 = 0; s4 < 4; ++s4) qf[s4] = qn[s4];
        __syncthreads();
        const int un = u + F.G; const bool has_next = un < NU;
        if (has_next) { attn_decode(F, ch, un, NUA, lane, nxt); attn_load(nxt, tid, lane, kreg, vreg, qn); }
        if (cur.kk_lo == 0) attn_compute(cur, KL, VL, OL, lane, qf); else attn_compute_edge(cur, KL, VL, OL, lane, qf);
        __syncthreads();
        if (!has_next) break;
        cur = nxt; u = un;
    }
}
__device__ __forceinline__ void p2_combine(Frame& F, int ch, int cu, int ncu) {
    int tid_ = threadIdx.x; asm volatile("" : "+v"(tid_)); const int lane_ = tid_ & 63;
    unsigned char* ws = F.ws;
    const bf16* OG = (const bf16*)((const unsigned char*)F.out + DO_OG); const float* LSE = (const float*)((const unsigned char*)F.out + DO_LSE);
    bf16* Y = (bf16*)(ws + WS_Y) + (size_t)ch * TC * Y_W; unsigned char* Y8 = ws + WS_Y + (size_t)ch * TC * Y_W;
    const int lane = lane_, hd = lane >> 3;
    int gw_ = cu * NWAVES + F.wave; asm volatile("" : "+s"(gw_));
    const int gw = gw_, NGW = ncu * NWAVES;
    for (int row0 = gw; row0 < TC; row0 += 4 * NGW) {
        float lg[4][3]; v4u og[4][3];
#pragma unroll
        for (int r = 0; r < 4; ++r) { const int row = row0 + r * NGW < TC ? row0 + r * NGW : row0;
#pragma unroll
            for (int g = 0; g < 3; ++g) { lg[r][g] = LSE[((size_t)g * TC + row) * 8 + hd]; og[r][g] = *(const GAS v4u*)(OG + ((size_t)g * TC + row) * 512 + lane * 8); } }
#pragma unroll
        for (int r = 0; r < 4; ++r) { const int row = row0 + r * NGW; if (row >= TC) continue;
            const float mx = fmaxf(fmaxf(lg[r][0], lg[r][1]), lg[r][2]);
            float e[3]; e[0] = __builtin_amdgcn_exp2f(lg[r][0] - mx); e[1] = __builtin_amdgcn_exp2f(lg[r][1] - mx); e[2] = __builtin_amdgcn_exp2f(lg[r][2] - mx);
            const float inv = 1.0f / (e[0] + e[1] + e[2]);
            float acc[8];
#pragma unroll
            for (int i = 0; i < 8; ++i) acc[i] = 0.f;
#pragma unroll
            for (int g = 0; g < 3; ++g) { const float wg = e[g] * inv; const v4u o_ = og[r][g];
                acc[0] += wg * bflo(o_.x); acc[1] += wg * bfhi(o_.x); acc[2] += wg * bflo(o_.y); acc[3] += wg * bfhi(o_.y);
                acc[4] += wg * bflo(o_.z); acc[5] += wg * bfhi(o_.z); acc[6] += wg * bflo(o_.w); acc[7] += wg * bfhi(o_.w); }
            v4u o; o.x = cvtpk(acc[0], acc[1]); o.y = cvtpk(acc[2], acc[3]); o.z = cvtpk(acc[4], acc[5]); o.w = cvtpk(acc[6], acc[7]);
            if (P34_FP8) { v2u o8; o8.x = pk4_fp8(acc[0] * Y8_SCALE, acc[1] * Y8_SCALE, acc[2] * Y8_SCALE, acc[3] * Y8_SCALE); o8.y = pk4_fp8(acc[4] * Y8_SCALE, acc[5] * Y8_SCALE, acc[6] * Y8_SCALE, acc[7] * Y8_SCALE); *(GAS v2u*)(Y8 + (size_t)row * Y_W + lane * 8) = o8; }
            else *(GAS v4u*)(Y + (size_t)row * Y_W + lane * 8) = o; }
    }
}


struct EpiMerge {
    static constexpr bool PERM = true; static constexpr int HOOK_T = P34_FP8 ? 4 : 8;
    const bf16* Gt; bf16* MG;
    __device__ __forceinline__ void prefetch(LAS unsigned char*, const pg9::Unit&, int, int, int) const {}
    __device__ __forceinline__ void hook(f32x4 (&acc)[2][2][4][2], const pg9::Unit& u, int wr, int wc, int fr, int fq) const {
        asm volatile("" : "+v"(fr), "+v"(fq));
        const bf16* gr = Gt + ((size_t)((u.pm * 256 + wr * 64) >> 4) * 256 + u.pn * 32 + wc * 4 + fq) * 128 + fr * 8;
        v4u rv[8][2];
#pragma unroll
        for (int rg = 0; rg < 8; ++rg)
#pragma unroll
            for (int bj = 0; bj < 2; ++bj) rv[rg][bj] = *(const GAS v4u*)(gr + (size_t)((rg >> 2) * 8 + (rg & 3)) * 32768 + bj * 16 * 128);
#pragma unroll
        for (int rg = 0; rg < 8; ++rg)
#pragma unroll
            for (int bj = 0; bj < 2; ++bj) { const v4u a = rv[rg][bj];
                const f32x4 r0 = {bflo(a.x), bfhi(a.x), bflo(a.y), bfhi(a.y)}, r1 = {bflo(a.z), bfhi(a.z), bflo(a.w), bfhi(a.w)};
                acc[rg >> 2][bj][rg & 3][0] = acc[rg >> 2][bj][rg & 3][0] * r0; acc[rg >> 2][bj][rg & 3][1] = acc[rg >> 2][bj][rg & 3][1] * r1; }
    }
    __device__ __forceinline__ void operator()(const f32x4 (&acc)[2][2][4][2], const pg9::Unit& u, int ui, int wr, int wc, int fr, int fq) const {
        asm volatile("" : "+v"(fr), "+v"(fq));
        const bf16* gr = Gt + ((size_t)((u.pm * 256 + wr * 64) >> 4) * 256 + 128 + u.pn * 32 + wc * 4 + fq) * 128 + fr * 8;
        const int fr2 = (fr >> 2) + 4 * fq, fq2 = fr & 3, paddr = 4 * (16 * (fr & 3) + 4 * fq + (fr >> 2));
        bf16* mr = MG + (size_t)(u.pm * 256 + wr * 64 + fr2) * D + u.pn * 256 + wc * 32 + 8 * fq2;
        v4u gb[8][2];
#pragma unroll
        for (int rg = 0; rg < 8; ++rg)
#pragma unroll
            for (int bj = 0; bj < 2; ++bj) gb[rg][bj] = *(const GAS v4u*)(gr + (size_t)((rg >> 2) * 8 + (rg & 3)) * 32768 + bj * 16 * 128);
#pragma unroll
        for (int rg = 0; rg < 8; ++rg)
#pragma unroll
            for (int bj = 0; bj < 2; ++bj) { const v4u b = gb[rg][bj];
                const f32x4 v0 = acc[rg >> 2][bj][rg & 3][0], v1 = acc[rg >> 2][bj][rg & 3][1];
                if (P34_FP8) { constexpr float f = MG8_SCALE / (W34_SCALE * Y8_SCALE); unsigned char* m8 = (unsigned char*)MG + (size_t)(u.pm * 256 + wr * 64 + fr2) * D + u.pn * 256 + wc * 32 + 8 * fq2;
                    v2u w8; w8.x = pk4_fp8(v0[0] * bflo(b.x) * f, v0[1] * bfhi(b.x) * f, v0[2] * bflo(b.y) * f, v0[3] * bfhi(b.y) * f); w8.y = pk4_fp8(v1[0] * bflo(b.z) * f, v1[1] * bfhi(b.z) * f, v1[2] * bflo(b.w) * f, v1[3] * bfhi(b.w) * f);
                    w8.x = (unsigned)__builtin_amdgcn_ds_bpermute(paddr, (int)w8.x); w8.y = (unsigned)__builtin_amdgcn_ds_bpermute(paddr, (int)w8.y);
                    *(GAS v2u*)(m8 + (size_t)((rg >> 2) * 128 + (rg & 3) * 16) * D + bj * 128) = w8; }
                else {
                v4u w; w.x = cvtpk(v0[0] * bflo(b.x), v0[1] * bfhi(b.x)); w.y = cvtpk(v0[2] * bflo(b.y), v0[3] * bfhi(b.y));
                w.z = cvtpk(v1[0] * bflo(b.z), v1[1] * bfhi(b.z)); w.w = cvtpk(v1[2] * bflo(b.w), v1[3] * bfhi(b.w));
                w.x = (unsigned)__builtin_amdgcn_ds_bpermute(paddr, (int)w.x); w.y = (unsigned)__builtin_amdgcn_ds_bpermute(paddr, (int)w.y); w.z = (unsigned)__builtin_amdgcn_ds_bpermute(paddr, (int)w.z); w.w = (unsigned)__builtin_amdgcn_ds_bpermute(paddr, (int)w.w);
                *(GAS v4u*)(mr + (size_t)((rg >> 2) * 128 + (rg & 3) * 16) * D + bj * 128) = w; } }
    }
};
__device__ __forceinline__ void p3_merge(Frame& F) {
    unsigned char* ws = F.ws;
    pg9::DenseOrder S; S.init(T, D, F.G, (int)blockIdx.x);
    EpiMerge E{(const bf16*)(ws + WS_G), (bf16*)(ws + WS_MG)};
    constexpr int ES = P34_FP8 ? 1 : 2;
    pg9::DenseA ao{(unsigned)(Y_W * ES)}; pg9::DenseB bb{(const char*)(ws + WS_WAB), (size_t)256 * Y_W * ES};
    pg9::gemm_phase<ES>(F.lds, (const char*)(ws + WS_Y), Y_W, S, E, ao, bb);
}
struct EpiOut {
    static constexpr bool PERM = true; static constexpr int HOOK_T = -1;
    bf16* DELTA;
    __device__ __forceinline__ void hook(f32x4 (&)[2][2][4][2], const pg9::Unit&, int, int, int, int) const {}
    __device__ __forceinline__ void prefetch(LAS unsigned char*, const pg9::Unit&, int, int, int) const {}
    __device__ __forceinline__ void operator()(const f32x4 (&acc)[2][2][4][2], const pg9::Unit& u, int ui, int wr, int wc, int fr, int fq) const {
        asm volatile("" : "+v"(fr), "+v"(fq));
        const int fr2 = (fr >> 2) + 4 * fq, fq2 = fr & 3, paddr = 4 * (16 * (fr & 3) + 4 * fq + (fr >> 2));
        bf16* orow = DELTA + (size_t)(u.pm * 256 + wr * 64 + fr2) * D + u.pn * 256 + wc * 32 + 8 * fq2;
#pragma unroll
        for (int ai = 0; ai < 2; ++ai)
#pragma unroll
            for (int m = 0; m < 4; ++m)
#pragma unroll
                for (int bj = 0; bj < 2; ++bj) { constexpr float f = P34_FP8 ? 1.0f / (W34_SCALE * MG8_SCALE) : 1.0f; const f32x4 o0 = acc[ai][bj][m][0] * f, o1 = acc[ai][bj][m][1] * f;
                    v4u w; w.x = cvtpk(o0[0], o0[1]); w.y = cvtpk(o0[2], o0[3]); w.z = cvtpk(o1[0], o1[1]); w.w = cvtpk(o1[2], o1[3]);
                    w.x = (unsigned)__builtin_amdgcn_ds_bpermute(paddr, (int)w.x); w.y = (unsigned)__builtin_amdgcn_ds_bpermute(paddr, (int)w.y); w.z = (unsigned)__builtin_amdgcn_ds_bpermute(paddr, (int)w.z); w.w = (unsigned)__builtin_amdgcn_ds_bpermute(paddr, (int)w.w);
                    *(GAS v4u*)(orow + (size_t)(ai * 128 + m * 16) * D + bj * 128) = w; }
    }
};
__device__ __forceinline__ void p4_outproj(Frame& F) {
    unsigned char* ws = F.ws;
    pg9::DenseOrder S; S.init(T, D, F.G, (int)blockIdx.x);
    EpiOut E{(bf16*)((unsigned char*)F.out + DO_DELTA)};
    constexpr int ES = P34_FP8 ? 1 : 2;
    pg9::DenseA ao{(unsigned)(D * ES)}; pg9::DenseB bb{(const char*)(ws + WS_WO), (size_t)256 * D * ES};
    pg9::gemm_phase<ES>(F.lds, (const char*)(ws + WS_MG), D, S, E, ao, bb);
}

__device__ __forceinline__ void p5_route(Frame& F) {
    int tid_ = threadIdx.x; asm volatile("" : "+v"(tid_)); const int lane = tid_ & 63;
    unsigned char* ws = F.ws;
    const float* X = F.in[I_X]; const bf16* DELTA = (const bf16*)((const unsigned char*)F.out + DO_DELTA);
    bf16* X1B = (bf16*)(ws + WS_X1B); unsigned char* X1F8 = ws + WS_X1F8;
    unsigned* cnt = (unsigned*)(ws + WS_CTL) + CW_CNT;
    int* tokof = (int*)(ws + WS_TOKOF); float2* wtof = (float2*)(ws + WS_WTOF); int4* tpos = (int4*)(ws + WS_TPOS);
    const v4u* WRF = (const v4u*)(ws + WS_WRF);
    LAS v4u* wl = (LAS v4u*)F.lds;
    LAS float* sl = (LAS float*)(F.lds + 98304 + F.wave * 4096);
    const int i = lane & 15, q = lane >> 4;
    LAS unsigned* hist = (LAS unsigned*)(F.lds + LDS_MISC + 2048);
    for (int wt = F.vcu; wt < T / 128; wt += F.G) {
        const int tile = wt * NWAVES + F.wave;
        if (tid_ < 32) hist[tid_] = 0u;
        const size_t roff = (size_t)(tile * 16 + i) * D + 8 * q;
        const float* xr = X + roff; const bf16* dr = DELTA + roff;
        f32x4 a0 = {0.f, 0.f, 0.f, 0.f}, a1 = a0, a2 = a0; float ss = 0.f;
        f32x4 va[8][2]; v4u vd[8];
#pragma unroll
        for (int j = 0; j < 8; ++j) { va[j][0] = *(const GAS f32x4*)(xr + 32 * j); va[j][1] = *(const GAS f32x4*)(xr + 32 * j + 4); vd[j] = *(const GAS v4u*)(dr + 32 * j); }
#pragma unroll 1
        for (int half = 0; half < 2; ++half) {
            __syncthreads();
            { v4u t[12];
#pragma unroll
              for (int k = 0; k < 12; ++k) t[k] = WRF[half * 6144 + k * 512 + tid_];
#pragma unroll
              for (int k = 0; k < 12; ++k) wl[k * 512 + tid_] = t[k]; }
            __syncthreads();
#pragma unroll 1
            for (int sb = 0; sb < 2; ++sb) {
#pragma unroll
                for (int j = 0; j < 8; ++j) {
                    const int ksl = sb * 8 + j, ks = half * 16 + ksl;
                    const v4u dd = vd[j];
                    const f32x4 v0 = va[j][0] + (f32x4){bflo(dd.x), bfhi(dd.x), bflo(dd.y), bfhi(dd.y)}, v1 = va[j][1] + (f32x4){bflo(dd.z), bfhi(dd.z), bflo(dd.w), bfhi(dd.w)};
                    if (ks + 8 < 32) { va[j][0] = *(const GAS f32x4*)(xr + 32 * (ks + 8)); va[j][1] = *(const GAS f32x4*)(xr + 32 * (ks + 8) + 4); vd[j] = *(const GAS v4u*)(dr + 32 * (ks + 8)); }
                    ss += ((v0[0] * v0[0] + v0[1] * v0[1]) + (v0[2] * v0[2] + v0[3] * v0[3])) + ((v1[0] * v1[0] + v1[1] * v1[1]) + (v1[2] * v1[2] + v1[3] * v1[3]));
                    v4u hu; hu.x = cvtpk(v0[0], v0[1]); hu.y = cvtpk(v0[2], v0[3]); hu.z = cvtpk(v1[0], v1[1]); hu.w = cvtpk(v1[2], v1[3]);
                    v4u lu; lu.x = cvtpk(v0[0] - bflo(hu.x), v0[1] - bfhi(hu.x)); lu.y = cvtpk(v0[2] - bflo(hu.y), v0[3] - bfhi(hu.y)); lu.z = cvtpk(v1[0] - bflo(hu.z), v1[1] - bfhi(hu.z)); lu.w = cvtpk(v1[2] - bflo(hu.w), v1[3] - bfhi(hu.w));
                    *(GAS v4u*)(X1B + roff + 32 * ks) = hu;
                    if (P6_FP8) { v2u w8; w8.x = pk4_fp8(v0[0], v0[1], v0[2], v0[3]); w8.y = pk4_fp8(v1[0], v1[1], v1[2], v1[3]); *(GAS v2u*)(X1F8 + roff + 32 * ks) = w8; }
                    const bf16x8 ah = __builtin_bit_cast(bf16x8, hu), al = __builtin_bit_cast(bf16x8, lu);
#pragma unroll
                    for (int nb = 0; nb < 3; ++nb) {
                        const bf16x8 bh = __builtin_bit_cast(bf16x8, wl[((ksl * 3 + nb) * 2 + 0) * 64 + lane]), bl = __builtin_bit_cast(bf16x8, wl[((ksl * 3 + nb) * 2 + 1) * 64 + lane]);
                        f32x4 acc = nb == 0 ? a0 : (nb == 1 ? a1 : a2);
                        acc = __builtin_amdgcn_mfma_f32_16x16x32_bf16(ah, bh, acc, 0, 0, 0); acc = __builtin_amdgcn_mfma_f32_16x16x32_bf16(ah, bl, acc, 0, 0, 0); acc = __builtin_amdgcn_mfma_f32_16x16x32_bf16(al, bh, acc, 0, 0, 0);
                        if (nb == 0) a0 = acc; else if (nb == 1) a1 = acc; else a2 = acc;
                    }
                }
            }
        }
        ss += __shfl_xor(ss, 16); ss += __shfl_xor(ss, 32);
#pragma unroll
        for (int r = 0; r < 4; ++r) { sl[(4 * q + r) * 48 + i] = a0[r]; sl[(4 * q + r) * 48 + 16 + i] = a1[r]; sl[(4 * q + r) * 48 + 32 + i] = a2[r]; }
        LDS_WAIT(); asm volatile("" ::: "memory");
        int e0 = 0, e1 = 0, lp0 = 0, lp1 = 0; float w1 = 0.f, w2 = 0.f, rstd = 0.f;
        __syncthreads();
        if (lane < 16) {
            rstd = 1.0f / sqrtf(ss * (1.f / D) + RMS_EPS);
            float lg[36];
#pragma unroll
            for (int o = 0; o < 36; ++o) lg[o] = sl[lane * 48 + o] * rstd + (o < 4 ? F.in[I_BRG][o] : F.in[I_BRE][o - 4]);
            int gsel = 0; float gmax = lg[0];
#pragma unroll
            for (int k = 1; k < 4; ++k) if (lg[k] > gmax) { gmax = lg[k]; gsel = k; }
            float gden = 0.f;
#pragma unroll
            for (int k = 0; k < 4; ++k) gden += __expf(lg[k] - gmax);
            const float pg = 1.0f / gden;
            float le[8];
#pragma unroll
            for (int j = 0; j < 8; ++j) { le[j] = lg[4 + j];
#pragma unroll
                for (int gi = 1; gi < 4; ++gi) le[j] = (gsel == gi) ? lg[4 + gi * 8 + j] : le[j]; }
            int i1 = 0; float m1 = le[0];
#pragma unroll
            for (int j = 1; j < 8; ++j) if (le[j] > m1) { m1 = le[j]; i1 = j; }
            int i2 = -1; float m2 = -INFINITY;
#pragma unroll
            for (int j = 0; j < 8; ++j) if (j != i1 && le[j] > m2) { m2 = le[j]; i2 = j; }
            const float e2 = __expf(m2 - m1);
            w1 = pg / (1.0f + e2); w2 = pg * e2 / (1.0f + e2);
            e0 = gsel * 8 + i1; e1 = gsel * 8 + i2;
            lp0 = (int)__hip_atomic_fetch_add(&hist[e0], 1u, __ATOMIC_RELAXED, __HIP_MEMORY_SCOPE_WORKGROUP);
            lp1 = (int)__hip_atomic_fetch_add(&hist[e1], 1u, __ATOMIC_RELAXED, __HIP_MEMORY_SCOPE_WORKGROUP);
        }
        __syncthreads();
        if (tid_ < 32) { const unsigned n = hist[tid_]; hist[32 + tid_] = n ? atomicAdd(&cnt[64 * tid_], n) : 0u; }
        __syncthreads();
        if (lane < 16) {
            const int row = tile * 16 + lane;
            const int p0 = (int)hist[32 + e0] + lp0, p1 = (int)hist[32 + e1] + lp1;
            tokof[(size_t)e0 * T + p0] = row; wtof[(size_t)e0 * T + p0] = make_float2(w1, rstd);
            tokof[(size_t)e1 * T + p1] = row; wtof[(size_t)e1 * T + p1] = make_float2(w2, rstd);
            tpos[row] = make_int4(e0, p0, e1, p1);
        }
        __syncthreads();
    }
}

__device__ __forceinline__ void expert_tiles(Frame& F, LAS int* tb, LAS int* cn) {
    int tid_ = threadIdx.x; asm volatile("" : "+v"(tid_)); const int lane_ = tid_ & 63;
    if (tid_ == 0) {
        const unsigned* cnt = (const unsigned*)(F.ws + WS_CTL) + CW_CNT;
        int acc = 0;
        for (int e = 0; e < NE; ++e) { const int c = (int)__hip_atomic_load(cnt + 64 * e, __ATOMIC_RELAXED, __HIP_MEMORY_SCOPE_AGENT); cn[e] = c; tb[e] = acc; acc += (c + 255) >> 8; }
        tb[NE] = acc;
    }
    __syncthreads();
}

struct MoeOrder { const LAS int* tb; int ncol, G, c;
    __device__ bool next(int i, pg9::Unit& u) const {
        const int L = i * G + c; if (L >= tb[NE] * ncol) return false;
        const int rt = L / ncol; int e = 0;
        for (int k = 1; k < NE; ++k) if (tb[k] <= rt) e = k;
        u.pm = rt; u.pn = L % ncol; u.e = e; return true; } };
struct GatherA { static constexpr bool GATHER = true; unsigned rowbytes; const int* tokof; const LAS int* tb; const LAS int* cn;
    __device__ __forceinline__ unsigned operator()(const pg9::Unit& u, int row) const {
        const int p = (u.pm - tb[u.e]) * 256 + row; const int tok = tokof[(size_t)u.e * T + (p < cn[u.e] ? p : 0)]; return (unsigned)tok * rowbytes; } };
struct ExpertB { const char* W; size_t ebytes, tilebytes; __device__ __forceinline__ const char* operator()(const pg9::Unit& u) const { return W + (size_t)u.e * ebytes + (size_t)u.pn * tilebytes; } };
struct EpiGateUp {
    static constexpr bool PERM = true; static constexpr int HOOK_T = -1;
    const float2* wtof; bf16* HACT; const LAS int* tb; const LAS int* cn; float ascale;
    __device__ __forceinline__ void hook(f32x4 (&)[2][2][4][2], const pg9::Unit&, int, int, int, int) const {}
    __device__ __forceinline__ void prefetch(LAS unsigned char*, const pg9::Unit&, int, int, int) const {}
    __device__ __forceinline__ void operator()(const f32x4 (&acc)[2][2][4][2], const pg9::Unit& u, int ui, int wr, int wc, int fr, int fq) const {
        asm volatile("" : "+v"(fr), "+v"(fq));
        const int r0 = wr * 64 + fr, p0 = (u.pm - tb[u.e]) * 256, ce = cn[u.e];
        const int fr2 = (fr >> 2) + 4 * fq, fq2 = fr & 3, paddr = 4 * (16 * (fr & 3) + 4 * fq + (fr >> 2)), r0s = wr * 64 + fr2;
        const float2* wp = wtof + (size_t)u.e * T;
#pragma unroll
        for (int ai = 0; ai < 2; ++ai) {
            float2 wv[4];
#pragma unroll
            for (int m = 0; m < 4; ++m) { const int p = p0 + r0 + ai * 128 + m * 16; wv[m] = p < ce ? wp[p] : make_float2(0.f, 0.f); }
#pragma unroll
            for (int m = 0; m < 4; ++m) { const int r = r0s + ai * 128 + m * 16;
                const float w = wv[m].x, rs = wv[m].y * ascale;
                bf16* orow = HACT + (size_t)(u.pm * 256 + r) * DE + u.pn * 128 + wc * 16 + 4 * fq2; unsigned char* orow8 = (unsigned char*)HACT + (size_t)(u.pm * 256 + r) * DE + u.pn * 128 + wc * 16 + 4 * fq2;
#pragma unroll
                for (int bj = 0; bj < 2; ++bj) { const f32x4 g = acc[ai][bj][m][0], uu = acc[ai][bj][m][1]; f32x4 hv;
#pragma unroll
                    for (int e = 0; e < 4; ++e) { const float gg = g[e] * rs; hv[e] = gg / (1.0f + __expf(-gg)) * (uu[e] * rs) * w; }
                    if (P6_FP8) *(GAS unsigned*)(orow8 + bj * 64) = (unsigned)__builtin_amdgcn_ds_bpermute(paddr, (int)pk4_fp8(hv[0] * H8_SCALE, hv[1] * H8_SCALE, hv[2] * H8_SCALE, hv[3] * H8_SCALE));
                    else { v2u o; o.x = (unsigned)__builtin_amdgcn_ds_bpermute(paddr, (int)cvtpk(hv[0], hv[1])); o.y = (unsigned)__builtin_amdgcn_ds_bpermute(paddr, (int)cvtpk(hv[2], hv[3])); *(GAS v2u*)(orow + bj * 64) = o; } } }
        }
    }
};
__device__ __forceinline__ void p6a_gateup(Frame& F) {
    unsigned char* ws = F.ws;
    LAS int* tb = (LAS int*)(F.lds + LDS_MISC + 1024); LAS int* cn = tb + 64;
    expert_tiles(F, tb, cn);
    MoeOrder S{tb, 2, F.G, F.vcu};
    constexpr int ES = P6_FP8 ? 1 : 2;
    GatherA ao{(unsigned)(D * ES), (const int*)(ws + WS_TOKOF), tb, cn}; ExpertB bb{(const char*)(ws + WS_WGU), (size_t)512 * D * ES, (size_t)256 * D * ES};
    EpiGateUp E{(const float2*)(ws + WS_WTOF), (bf16*)(ws + WS_HACT), tb, cn, P6_FP8 ? 1.0f / WG8_SCALE : 1.0f};
    pg9::gemm_phase<ES>(F.lds, (const char*)(ws + (P6_FP8 ? WS_X1F8 : WS_X1B)), D, S, E, ao, bb);
}
struct EpiDown {
    static constexpr bool PERM = true; static constexpr int HOOK_T = -1;
    bf16* YS; float ascale;
    __device__ __forceinline__ void hook(f32x4 (&)[2][2][4][2], const pg9::Unit&, int, int, int, int) const {}
    __device__ __forceinline__ void prefetch(LAS unsigned char*, const pg9::Unit&, int, int, int) const {}
    __device__ __forceinline__ void operator()(const f32x4 (&acc)[2][2][4][2], const pg9::Unit& u, int ui, int wr, int wc, int fr, int fq) const {
        asm volatile("" : "+v"(fr), "+v"(fq));
        const int fr2 = (fr >> 2) + 4 * fq, fq2 = fr & 3, paddr = 4 * (16 * (fr & 3) + 4 * fq + (fr >> 2));
#pragma unroll
        for (int ai = 0; ai < 2; ++ai)
#pragma unroll
            for (int m = 0; m < 4; ++m) { bf16* orow = YS + (size_t)(u.pm * 256 + wr * 64 + fr2 + ai * 128 + m * 16) * D + u.pn * 256 + wc * 32 + 8 * fq2;
#pragma unroll
                for (int bj = 0; bj < 2; ++bj) { const f32x4 v0 = acc[ai][bj][m][0] * ascale, v1 = acc[ai][bj][m][1] * ascale;
                    if (YS_FP8) { unsigned char* o8 = (unsigned char*)YS + (size_t)(u.pm * 256 + wr * 64 + fr2 + ai * 128 + m * 16) * D + u.pn * 256 + wc * 32 + 8 * fq2 + bj * 128;
                        v2u w8; w8.x = pk4_fp8(v0[0] * YS8_SCALE, v0[1] * YS8_SCALE, v0[2] * YS8_SCALE, v0[3] * YS8_SCALE); w8.y = pk4_fp8(v1[0] * YS8_SCALE, v1[1] * YS8_SCALE, v1[2] * YS8_SCALE, v1[3] * YS8_SCALE);
                        w8.x = (unsigned)__builtin_amdgcn_ds_bpermute(paddr, (int)w8.x); w8.y = (unsigned)__builtin_amdgcn_ds_bpermute(paddr, (int)w8.y); *(GAS v2u*)o8 = w8; }
                    else { v4u w; w.x = cvtpk(v0[0], v0[1]); w.y = cvtpk(v0[2], v0[3]); w.z = cvtpk(v1[0], v1[1]); w.w = cvtpk(v1[2], v1[3]);
                        w.x = (unsigned)__builtin_amdgcn_ds_bpermute(paddr, (int)w.x); w.y = (unsigned)__builtin_amdgcn_ds_bpermute(paddr, (int)w.y); w.z = (unsigned)__builtin_amdgcn_ds_bpermute(paddr, (int)w.z); w.w = (unsigned)__builtin_amdgcn_ds_bpermute(paddr, (int)w.w); *(GAS v4u*)(orow + bj * 128) = w; } } }
    }
};
__device__ __forceinline__ void p6b_down(Frame& F) {
    unsigned char* ws = F.ws;
    LAS int* tb = (LAS int*)(F.lds + LDS_MISC + 1024); LAS int* cn = tb + 64;
    MoeOrder S{tb, 4, F.G, F.vcu};
    constexpr int ES = P6_FP8 ? 1 : 2;
    pg9::DenseA ao{(unsigned)(DE * ES)}; ExpertB bb{(const char*)(ws + WS_WD), (size_t)D * DE * ES, (size_t)256 * DE * ES};
    EpiDown E{(bf16*)(ws + WS_YS), P6_FP8 ? 1.0f / (WD8_SCALE * H8_SCALE) : 1.0f};
    pg9::gemm_phase<ES>(F.lds, (const char*)(ws + WS_HACT), DE, S, E, ao, bb);
}
__device__ __forceinline__ void p7_final(Frame& F) {
    int tid_ = threadIdx.x; asm volatile("" : "+v"(tid_)); const int lane_ = tid_ & 63;
    unsigned char* ws = F.ws;
    LAS int* tb = (LAS int*)(F.lds + LDS_MISC + 1024); LAS int* cn = tb + 64;
    const bf16* YS = (const bf16*)(ws + WS_YS); const int4* tpos = (const int4*)(ws + WS_TPOS);
    float* X1 = F.out; const bf16* X1B = (const bf16*)(ws + WS_X1B);
    const int lane = lane_;
    const int gw = F.vcu * NWAVES + F.wave, NGW = F.G * NWAVES;
    f32x4 gg[4];
#pragma unroll
    for (int j = 0; j < 4; ++j) gg[j] = ((const GAS f32x4*)F.in[I_GFIN] + lane)[64 * j];
    for (int row0 = gw; row0 < T; row0 += 4 * NGW) {
        int4 tp[4];
#pragma unroll
        for (int r = 0; r < 4; ++r) { const int row = row0 + r * NGW < T ? row0 + r * NGW : row0; tp[r] = tpos[row]; }
        v2u xx[4][4]; v2u ya[4][4], yb[4][4]; unsigned za[4][4], zb[4][4];
#pragma unroll
        for (int r = 0; r < 4; ++r) { const int row = row0 + r * NGW < T ? row0 + r * NGW : row0;
            const size_t s0 = (size_t)tb[tp[r].x] * 256 + tp[r].y, s1 = (size_t)tb[tp[r].z] * 256 + tp[r].w;
            const GAS v2u* xb = (const GAS v2u*)(X1B + (size_t)row * D) + lane;
            const GAS v2u* y0 = (const GAS v2u*)(YS + s0 * D) + lane; const GAS v2u* y1 = (const GAS v2u*)(YS + s1 * D) + lane;
            const GAS unsigned* z0 = (const GAS unsigned*)((const unsigned char*)YS + s0 * D) + lane; const GAS unsigned* z1 = (const GAS unsigned*)((const unsigned char*)YS + s1 * D) + lane;
#pragma unroll
            for (int j = 0; j < 4; ++j) { xx[r][j] = xb[64 * j];
                if (YS_FP8) { za[r][j] = z0[64 * j]; zb[r][j] = z1[64 * j]; } else { ya[r][j] = y0[64 * j]; yb[r][j] = y1[64 * j]; } } }
#pragma unroll
        for (int r = 0; r < 4; ++r) { const int row = row0 + r * NGW; if (row >= T) continue;
            GAS f32x4* xr = (GAS f32x4*)(X1 + (size_t)row * D) + lane;
            f32x4 v[4]; float s = 0.f;
#pragma unroll
            for (int j = 0; j < 4; ++j) { const v2u x_ = xx[r][j]; v[j] = (f32x4){bflo(x_.x), bfhi(x_.x), bflo(x_.y), bfhi(x_.y)};
                if (YS_FP8) { const int a = (int)za[r][j], b = (int)zb[r][j]; typedef float f2_ __attribute__((ext_vector_type(2)));
                    const f2_ a0 = __builtin_amdgcn_cvt_pk_f32_fp8(a, false), a1 = __builtin_amdgcn_cvt_pk_f32_fp8(a, true), b0 = __builtin_amdgcn_cvt_pk_f32_fp8(b, false), b1 = __builtin_amdgcn_cvt_pk_f32_fp8(b, true);
                    constexpr float f = 1.0f / YS8_SCALE; v[j].x += (a0[0] + b0[0]) * f; v[j].y += (a0[1] + b0[1]) * f; v[j].z += (a1[0] + b1[0]) * f; v[j].w += (a1[1] + b1[1]) * f; }
                else { const v2u a = ya[r][j], b = yb[r][j];
                v[j].x += bflo(a.x) + bflo(b.x); v[j].y += bfhi(a.x) + bfhi(b.x); v[j].z += bflo(a.y) + bflo(b.y); v[j].w += bfhi(a.y) + bfhi(b.y); }
                s += (v[j].x * v[j].x + v[j].y * v[j].y) + (v[j].z * v[j].z + v[j].w * v[j].w); }
            const float rstd = 1.0f / sqrtf(wave_sum(s) * (1.f / D) + RMS_EPS);
#pragma unroll
            for (int j = 0; j < 4; ++j) { f32x4 o; o.x = v[j].x * rstd * gg[j].x; o.y = v[j].y * rstd * gg[j].y; o.z = v[j].z * rstd * gg[j].z; o.w = v[j].w * rstd * gg[j].w; xr[64 * j] = o; } }
    }
}

constexpr int NPHASE = 2 * NCH + 8;
__global__ void __launch_bounds__(NTHR, 2) fwd_kernel(KArgs args) {
    extern __shared__ __attribute__((aligned(16))) unsigned char lds_raw[];
    Frame F;
    F.lds = (LAS unsigned char*)lds_raw;
    F.tid = threadIdx.x; F.lane = F.tid & 63; F.wave = __builtin_amdgcn_readfirstlane(F.tid >> 6);
    F.G = gridDim.x; { const int bx = blockIdx.x; F.vcu = (F.G % 8 == 0) ? (bx % 8) * (F.G / 8) + bx / 8 : bx; }
#pragma unroll
    for (int i = 0; i < 17; ++i) F.in[i] = args.in[i];
    F.out = args.out; F.ws = args.ws;
    volatile LAS unsigned* MISC = (volatile LAS unsigned*)(F.lds + LDS_MISC);
    if (F.tid < 64) MISC[F.tid] = 0u;
    __syncthreads();
    XcdBarrier bar = xcd_barrier_post((unsigned*)(F.ws + WS_CTL) + CW_BAR + args.li * XCD_BAR_WORDS, MISC + 8);
#define IN(k) (args.ph_lo <= (k) && (k) < args.ph_hi)
#ifdef PROBE_MASK
    unsigned long long pr_acc = 0, pr_t0 = 0; const bool pr_me = (blockIdx.x == 0 && threadIdx.x == 0);
#define PR_BEGIN(k) do { if (pr_me && ((PROBE_MASK >> (k)) & 1ull)) pr_t0 = __builtin_amdgcn_s_memrealtime(); } while (0)
#define PR_END(k) do { if (pr_me && ((PROBE_MASK >> (k)) & 1ull)) pr_acc += __builtin_amdgcn_s_memrealtime() - pr_t0; } while (0)
#else
#define PR_BEGIN(k) do {} while (0)
#define PR_END(k) do {} while (0)
#endif
#define SEAM(k) do { if (IN(k) && IN((k) + 1)) xcd_barrier(bar); PR_END(k); } while (0)
    PR_BEGIN(0); if (IN(0)) p0_prologue(F);
    SEAM(0);
#pragma unroll 1
    for (int ch = 0; ch < NCH; ++ch) {
        PR_BEGIN(1 + 2 * ch);
        if (IN(1 + 2 * ch)) {
            constexpr int NWG1 = (TC / 256) * (NIN / 256);
            const int nfull = NWG1 % F.G, bx = (int)blockIdx.x;
            if (ch > 0 && nfull == 0) p2_combine(F, ch - 1, F.vcu, F.G);
            p1_inproj(F, ch);
            if (ch > 0 && nfull != 0 && bx >= nfull) p2_combine(F, ch - 1, bx - nfull, F.G - nfull);
        }
        SEAM(1 + 2 * ch);
        PR_BEGIN(2 + 2 * ch); if (IN(2 + 2 * ch)) p2_attn(F, ch);
        SEAM(2 + 2 * ch);
    }
    PR_BEGIN(2 * NCH + 1); if (IN(2 * NCH + 1)) p2_combine(F, NCH - 1, F.vcu, F.G);
    SEAM(2 * NCH + 1);
    PR_BEGIN(2 * NCH + 2); if (IN(2 * NCH + 2)) p3_merge(F);
    SEAM(2 * NCH + 2);
    PR_BEGIN(2 * NCH + 3); if (IN(2 * NCH + 3)) p4_outproj(F);
    SEAM(2 * NCH + 3);
    PR_BEGIN(2 * NCH + 4); if (IN(2 * NCH + 4)) p5_route(F);
    SEAM(2 * NCH + 4);
    PR_BEGIN(2 * NCH + 5); if (IN(2 * NCH + 5)) p6a_gateup(F);
    SEAM(2 * NCH + 5);
    PR_BEGIN(2 * NCH + 6); if (IN(2 * NCH + 6)) p6b_down(F);
    SEAM(2 * NCH + 6);
    PR_BEGIN(2 * NCH + 7); if (IN(2 * NCH + 7)) p7_final(F);
    PR_END(2 * NCH + 7);
#ifdef PROBE_MASK
    if (pr_me) { const unsigned long long t1 = __builtin_amdgcn_s_memrealtime(); while (__builtin_amdgcn_s_memrealtime() - t1 < pr_acc) __builtin_amdgcn_s_sleep(4); }
#endif
#undef IN
#undef SEAM
}

#ifndef N_LAUNCHES
#define N_LAUNCHES 1
#endif
extern "C" void kernel_launch(void* const* d_in, const int* in_sizes, int n_in, void* d_out, int out_size, void* d_ws, size_t ws_size, hipStream_t stream) {
    static int grid = 0;
    if (grid == 0) {
        if (n_in != 17 || in_sizes[0] != T * D || out_size != T * D || ws_size < WS_END) { fprintf(stderr, "kernel_launch: unexpected shapes / workspace (%d inputs, ws %zu)\n", n_in, ws_size); grid = -1; return; }
        int dev = 0, cus = 0;
        if (hipGetDevice(&dev) != hipSuccess || hipDeviceGetAttribute(&cus, hipDeviceAttributeMultiprocessorCount, dev) != hipSuccess) { grid = -1; return; }
        if (hipFuncSetAttribute((const void*)fwd_kernel, hipFuncAttributeMaxDynamicSharedMemorySize, LDS_BYTES) != hipSuccess) { fprintf(stderr, "kernel_launch: hipFuncSetAttribute failed\n"); grid = -1; return; }
        int per_cu = 0;
        if (hipOccupancyMaxActiveBlocksPerMultiprocessor(&per_cu, (const void*)fwd_kernel, NTHR, LDS_BYTES) != hipSuccess || per_cu < 1) fprintf(stderr, "kernel_launch: occupancy query says %d\n", per_cu);
        (void)hipGetLastError();
        grid = cus;
    }
    if (grid < 0) return;
    (void)hipMemsetAsync((char*)d_ws + WS_CTL, 0, N_LAUNCHES == 1 ? (size_t)(CW_BAR + XCD_BAR_WORDS) * 4 : CTL_BYTES, stream);
    KArgs a{};
    for (int i = 0; i < 17; ++i) a.in[i] = (const float*)d_in[i];
    a.out = (float*)d_out; a.ws = (unsigned char*)d_ws;
    for (int li = 0; li < N_LAUNCHES; ++li) {
        a.ph_lo = (int)((long)NPHASE * li / N_LAUNCHES); a.ph_hi = (int)((long)NPHASE * (li + 1) / N_LAUNCHES); a.li = li;
        hipLaunchKernelGGL(fwd_kernel, dim3(grid), dim3(NTHR), LDS_BYTES, stream, a);
    }
}
```

```cpp
#include <hip/hip_runtime.h>
#include <cstdint>
#include <cstdio>

#define GAS __attribute__((address_space(1)))
#define LAS __attribute__((address_space(3)))
typedef unsigned short bf16;
typedef short bf16x8 __attribute__((ext_vector_type(8)));
typedef float f32x4 __attribute__((ext_vector_type(4)));
typedef unsigned v4u __attribute__((ext_vector_type(4)));
typedef unsigned v2u __attribute__((ext_vector_type(2)));
typedef GAS unsigned gu32;

constexpr int T = 32768, D = 1024, SEQ = 4096, NIN = 7936;
constexpr int A_W = 4608, B_W = 1280, G_W = 2048, Y_W = 1536;
constexpr int NE = 32, DE = 256;
constexpr int NCH = 4, TC = T / NCH;
constexpr float QSCALE = 0.125f * 1.4426950408889634f;
constexpr float LOG2E = 1.4426950408889634f;
constexpr float RMS_EPS = 1e-6f;
#ifndef P1_FP8
#define P1_FP8 1
#endif
constexpr float W8_SCALE = P1_FP8 ? 64.0f : 0.0f, W8_INV = P1_FP8 ? 1.0f / 64.0f : 1.0f;
#ifndef P6_FP8
#define P6_FP8 1
#endif
#ifndef P34_FP8
#define P34_FP8 1
#endif
constexpr float Y8_SCALE = 16.0f, W34_SCALE = 64.0f, MG8_SCALE = 32.0f;
#ifndef YS_FP8
#define YS_FP8 1
#endif
constexpr float YS8_SCALE = 16.0f;
constexpr float WG8_SCALE = P6_FP8 ? 64.0f : 0.0f, WD8_SCALE = P6_FP8 ? 32.0f : 0.0f, H8_SCALE = 32.0f;
constexpr int NWAVES = 8, NTHR = 512;

constexpr size_t MiB = 1u << 20;
constexpr size_t WS_CTL = 0, CTL_BYTES = 1 * MiB;
constexpr size_t WS_BIASP = ((size_t)1 << 20) + 4096;
constexpr size_t WS_INVF = 1 * MiB;
constexpr size_t WS_WRF = 2 * MiB;
constexpr size_t WS_TOKOF = 3 * MiB;
constexpr size_t WS_WTOF = 7 * MiB;
constexpr size_t WS_TPOS = 15 * MiB;
constexpr size_t WS_WIN = 16 * MiB;
constexpr size_t WS_WAB = 32 * MiB;
constexpr size_t WS_WO = 35 * MiB;
constexpr size_t WS_WGU = 37 * MiB;
constexpr size_t WS_WD = 69 * MiB;
constexpr size_t WS_G = 86 * MiB;
constexpr size_t WS_Y = 214 * MiB;
constexpr size_t WS_ZA = 310 * MiB;
constexpr size_t WS_ZB = 454 * MiB;
constexpr size_t WS_END = 494 * MiB;
constexpr size_t WS_MG = WS_ZA;
constexpr size_t WS_X1B = WS_ZA + 64 * MiB;
constexpr size_t WS_X1F8 = WS_Y + 64 * MiB;
constexpr size_t WS_HACT = WS_G;
constexpr size_t WS_YS = WS_G + 36 * MiB;
constexpr size_t DO_DELTA = 0;
constexpr size_t DO_HN = 0;
constexpr size_t DO_OG = 64 * MiB;
constexpr size_t DO_LSE = 112 * MiB;
constexpr int MAXSLOT = 2 * T + NE * 256;
static_assert(WS_ZA + (size_t)TC * A_W * 2 <= WS_ZB && WS_ZB + (size_t)TC * B_W * 2 <= WS_END && WS_Y + (size_t)T * Y_W * 2 <= WS_ZA && WS_G + (size_t)T * G_W * 2 <= WS_Y, "ws map");
static_assert(WS_MG + (size_t)T * D * 2 <= WS_END && WS_HACT + (size_t)MAXSLOT * DE * 2 <= WS_YS && WS_YS + (size_t)MAXSLOT * D * 2 <= WS_ZA && WS_X1B >= WS_MG + (size_t)T * D * 2 && WS_X1B + (size_t)T * D * 2 <= WS_ZB, "ws map");
static_assert(DO_OG + (size_t)3 * TC * 512 * 2 <= DO_LSE && DO_LSE + (size_t)3 * TC * 8 * 4 <= (size_t)T * D * 4 && DO_HN + (size_t)T * D * 2 <= DO_OG, "d_out scratch map");
constexpr int CW_CNT = 1024;
constexpr int CW_BAR = 4096;
constexpr int LDS_BYTES = 147456;
constexpr int LDS_MISC = 131072;

__device__ __forceinline__ unsigned f2bf(float f) { unsigned u = __builtin_bit_cast(unsigned, f); return (u + 0x7fffu + ((u >> 16) & 1u)) >> 16; }
__device__ __forceinline__ unsigned pk4_fp8(float a, float b, float c, float d) {
    a = __builtin_amdgcn_fmed3f(a, -448.f, 448.f); b = __builtin_amdgcn_fmed3f(b, -448.f, 448.f); c = __builtin_amdgcn_fmed3f(c, -448.f, 448.f); d = __builtin_amdgcn_fmed3f(d, -448.f, 448.f);
    int w = 0; w = __builtin_amdgcn_cvt_pk_fp8_f32(a, b, w, false); w = __builtin_amdgcn_cvt_pk_fp8_f32(c, d, w, true); return (unsigned)w; }
__device__ __forceinline__ unsigned pk2(float lo, float hi) { return f2bf(lo) | (f2bf(hi) << 16); }
__device__ __forceinline__ float bf2f(unsigned b) { return __builtin_bit_cast(float, b << 16); }
__device__ __forceinline__ float bflo(unsigned u) { return __builtin_bit_cast(float, u << 16); }
__device__ __forceinline__ float bfhi(unsigned u) { return __builtin_bit_cast(float, u & 0xffff0000u); }
__device__ __forceinline__ float wave_sum(float v) {
#pragma unroll
    for (int o = 1; o < 64; o <<= 1) v += __shfl_xor(v, o);
    return v;
}
__device__ __forceinline__ float wave_max(float v) {
#pragma unroll
    for (int o = 1; o < 64; o <<= 1) v = fmaxf(v, __shfl_xor(v, o));
    return v;
}
typedef float f32x2_t __attribute__((ext_vector_type(2)));
typedef __bf16 bf16x2_t __attribute__((ext_vector_type(2)));
__device__ __forceinline__ unsigned cvtpk(float lo, float hi) { f32x2_t v = {lo, hi}; bf16x2_t b = __builtin_convertvector(v, bf16x2_t); return __builtin_bit_cast(unsigned, b); }
#ifndef WT_STORES
#define WT_STORES 0
#endif
__device__ __forceinline__ __amdgpu_buffer_rsrc_t wt_rsrc(unsigned char* base) { return __builtin_amdgcn_make_buffer_rsrc(base, 0, 0x7ffffffc, 0x00020000); }
__device__ __forceinline__ void st16(__amdgpu_buffer_rsrc_t r, unsigned char* base, void* p, v4u v) { if (WT_STORES) __builtin_amdgcn_raw_buffer_store_b128(v, r, (unsigned)((unsigned char*)p - base), 0, 16); else *(GAS v4u*)p = v; }
__device__ __forceinline__ void st8(__amdgpu_buffer_rsrc_t r, unsigned char* base, void* p, v2u v) { if (WT_STORES) __builtin_amdgcn_raw_buffer_store_b64(v, r, (unsigned)((unsigned char*)p - base), 0, 16); else *(GAS v2u*)p = v; }
#define LDS_WAIT() asm volatile("s_waitcnt lgkmcnt(0)" ::: "memory")
#define VM_WAIT() asm volatile("s_waitcnt vmcnt(0)" ::: "memory")

#define XB_TMO      128
#define XB_XCNT(j)  (256  + 64 * (j))
#define XB_XSUB(j)  (1280 + 64 * (j))
#define XB_XGEN(j)  (2304 + 64 * (j))
#define XB_TOP      3328
#define XB_TOPGEN   3392
#define XCD_BAR_WORDS 3456
#define XB_SPIN_CAP (1u << 18)
__device__ __forceinline__ unsigned xb_ld(unsigned* p)              { return __hip_atomic_load(p, __ATOMIC_RELAXED, __HIP_MEMORY_SCOPE_AGENT); }
__device__ __forceinline__ unsigned xb_add(unsigned* p, unsigned v) { return __hip_atomic_fetch_add(p, v, __ATOMIC_RELAXED, __HIP_MEMORY_SCOPE_AGENT); }
__device__ __forceinline__ unsigned xb_xcc_id() { return (unsigned)__builtin_amdgcn_s_getreg((3 << 11) | 20) & 0xFu; }
#define XB_SPIN(cond, bar) do { unsigned _sp = 0; while (cond) { __builtin_amdgcn_s_sleep(1); \
    if ((++_sp & 255u) == 0u) { if (xb_ld(&(bar)[XB_TMO])) break; if (_sp > XB_SPIN_CAP) { atomicAdd(&(bar)[XB_TMO], 1u); break; } } } } while (0)
struct XcdBarrier { unsigned* bar; unsigned x; volatile LAS unsigned* st; };
__device__ __forceinline__ XcdBarrier xcd_barrier_post(unsigned* bar, volatile LAS unsigned* st) {
    XcdBarrier b; b.bar = bar; b.x = xb_xcc_id(); b.st = st;
    if (threadIdx.x == 0) (void)xb_add(&bar[XB_XCNT(b.x)], 1u);
    return b;
}
__device__ __forceinline__ void xcd_barrier_complete(unsigned* bar, unsigned x, unsigned& nloc, unsigned& nx) {
    const unsigned G = gridDim.x * gridDim.y * gridDim.z;
    unsigned sum, cnt, mine, sp = 0u;
    for (;;) {
        sum = 0u; cnt = 0u; mine = 0u;
#pragma unroll
        for (unsigned j = 0; j < 16; ++j) { const unsigned c = xb_ld(&bar[XB_XCNT(j)]); sum += c; cnt += (c > 0u) ? 1u : 0u; mine = (j == x) ? c : mine; }
        if (sum == G) break;
        __builtin_amdgcn_s_sleep(1);
        if ((++sp & 255u) == 0u) { if (xb_ld(&bar[XB_TMO])) break; if (sp > XB_SPIN_CAP) { atomicAdd(&bar[XB_TMO], 1u); break; } }
    }
    nloc = mine > 0u ? mine : 1u; nx = cnt > 0u ? cnt : 1u;
}
__device__ __forceinline__ void xcd_barrier(const XcdBarrier& b) {
    asm volatile("s_waitcnt vmcnt(0)" ::: "memory");
    __syncthreads();
    int t_ = threadIdx.x; asm volatile("" : "+v"(t_));
    if (t_ == 0) {
        unsigned* bar = b.bar;
        __builtin_amdgcn_s_waitcnt(0);
        unsigned nloc = b.st[0], nx = b.st[1];
        if (nloc == 0u) { xcd_barrier_complete(bar, b.x, nloc, nx); b.st[0] = nloc; b.st[1] = nx; }
        const unsigned old = xb_add(&bar[XB_XSUB(b.x)], 1u);
        const unsigned gen = old / nloc;
        if (old + 1u == (gen + 1u) * nloc) {
            __builtin_amdgcn_fence(__ATOMIC_RELEASE, "agent");
            asm volatile("s_waitcnt vmcnt(0)" ::: "memory");
            const unsigned og = xb_add(&bar[XB_TOP], 1u);
            const unsigned tg = og / nx;
            if (og + 1u == (tg + 1u) * nx) xb_add(&bar[XB_TOPGEN], 1u);
            else XB_SPIN(xb_ld(&bar[XB_TOPGEN]) == tg, bar);
            __builtin_amdgcn_fence(__ATOMIC_ACQUIRE, "agent");
            xb_add(&bar[XB_XGEN(b.x)], 1u);
            asm volatile("s_waitcnt vmcnt(0)" ::: "memory");
        } else {
            XB_SPIN(xb_ld(&bar[XB_XGEN(b.x)]) == gen, bar);
            __builtin_amdgcn_fence(__ATOMIC_ACQUIRE, "agent");
            asm volatile("s_waitcnt vmcnt(0)" ::: "memory");
        }
    }
    __syncthreads();
}

struct KArgs { const float* in[17]; float* out; unsigned char* ws; int ph_lo, ph_hi, li, pad; };
struct Frame {
    LAS unsigned char* lds;
    int tid, lane, wave, vcu, G;
    const float* in[17]; float* out; unsigned char* ws;
};
enum { I_X = 0, I_WIN, I_BIN, I_SINK, I_WPA, I_WPB, I_WOUT, I_GMIX, I_GFFN, I_WRG, I_BRG, I_WRE, I_BRE, I_WEG, I_WEU, I_WED, I_GFIN };

struct TrDesc { const float* W; int N; bf16* WT; int ldo, rowbase, koff, k0, n0; bool perm; const float* kscale; float f8scale; };
__device__ __forceinline__ void tr_load(const TrDesc& d, int lane, f32x4 (&tv)[8], float (&ks)[8]) {
    const float* src = d.W + (size_t)(d.k0 + (lane >> 3)) * d.N + d.n0 + 4 * (lane & 7);
#pragma unroll
    for (int i = 0; i < 8; ++i) tv[i] = *(const GAS f32x4*)(src + (size_t)(8 * i) * d.N);
#pragma unroll
    for (int i = 0; i < 8; ++i) ks[i] = d.kscale ? d.kscale[d.k0 + 8 * i + (lane >> 3)] : 1.0f;
}
__device__ __forceinline__ void tr_finish(const TrDesc& d, LAS float* scr, int lane, const f32x4 (&tv)[8], const float (&ks)[8]) {
#pragma unroll
    for (int i = 0; i < 8; ++i) { const int kk = 8 * i + (lane >> 3); LAS float* w = scr + kk * 33 + 4 * (lane & 7);
        w[0] = tv[i][0] * ks[i]; w[1] = tv[i][1] * ks[i]; w[2] = tv[i][2] * ks[i]; w[3] = tv[i][3] * ks[i]; }
    LDS_WAIT(); asm volatile("" ::: "memory");
    const int c = lane & 7;
#pragma unroll
    for (int j = 0; j < 4; ++j) { const int n = (lane >> 3) + 8 * j; const LAS float* s = scr + (8 * c) * 33 + n;
        const int rr = d.perm ? 8 * (n >> 2) + (n & 3) : n;
        if (d.f8scale != 0.f) { const float f = d.f8scale; v2u o8; o8.x = pk4_fp8(s[0 * 33] * f, s[1 * 33] * f, s[2 * 33] * f, s[3 * 33] * f); o8.y = pk4_fp8(s[4 * 33] * f, s[5 * 33] * f, s[6 * 33] * f, s[7 * 33] * f);
            *(GAS v2u*)((unsigned char*)d.WT + (size_t)(d.rowbase + rr) * d.ldo + d.koff + d.k0 + 8 * c) = o8; }
        else { v4u o; o.x = pk2(s[0 * 33], s[1 * 33]); o.y = pk2(s[2 * 33], s[3 * 33]); o.z = pk2(s[4 * 33], s[5 * 33]); o.w = pk2(s[6 * 33], s[7 * 33]);
            *(GAS v4u*)(d.WT + (size_t)(d.rowbase + rr) * d.ldo + d.koff + d.k0 + 8 * c) = o; } }
    LDS_WAIT(); asm volatile("" ::: "memory");
}
__device__ __forceinline__ void rms_row_to_bf16(const float* xrow, const float* g, bf16* orow, int lane) {
    const GAS f32x4* xr = (const GAS f32x4*)xrow + lane; const GAS f32x4* gr = (const GAS f32x4*)g + lane;
    f32x4 v[4]; float s = 0.f;
#pragma unroll
    for (int j = 0; j < 4; ++j) { v[j] = xr[64 * j]; s += (v[j].x * v[j].x + v[j].y * v[j].y) + (v[j].z * v[j].z + v[j].w * v[j].w); }
    const float rstd = 1.0f / sqrtf(wave_sum(s) * (1.f / D) + RMS_EPS);
    GAS v2u* o8 = (GAS v2u*)orow + lane;
#pragma unroll
    for (int j = 0; j < 4; ++j) { const f32x4 gg = gr[64 * j]; v2u w; w.x = pk2(v[j].x * rstd * gg.x, v[j].y * rstd * gg.y); w.y = pk2(v[j].z * rstd * gg.z, v[j].w * rstd * gg.w); o8[64 * j] = w; }
}
__device__ __forceinline__ void p0_prologue(Frame& F) {
    int tid_ = threadIdx.x; asm volatile("" : "+v"(tid_)); const int lane_ = tid_ & 63;
    LAS float* scr = (LAS float*)(F.lds + F.wave * 16384);
    const int gw = F.vcu * NWAVES + F.wave, NGW = F.G * NWAVES;
    unsigned char* ws = F.ws;
    constexpr int I_IN = 16 * 248, I_PA = 8 * 32, I_PB = 16 * 32, I_WO = 16 * 32, I_EG = 32 * 16 * 8, I_ED = 32 * 4 * 32;
    constexpr int NITEMS = I_IN + I_PA + I_PB + I_WO + 2 * I_EG + I_ED;
    auto decode = [&](int it, TrDesc& d) {
        int r = it; d.perm = false; d.kscale = nullptr; d.f8scale = 0.f; d.koff = 0;
        if (r < I_IN) { const int kb = r / 248, nb = r % 248, n0 = 32 * nb; const bool qk = (n0 < 3072) || (n0 >= A_W && n0 < A_W + 1152);
            const bool gt_ = n0 >= A_W + B_W; const int gc = n0 - (A_W + B_W);
            d.W = F.in[I_WIN]; d.N = NIN; d.WT = (bf16*)(ws + WS_WIN); d.ldo = 1024; d.rowbase = qk ? (n0 & ~63) + ((n0 >> 5) & 1) * 4 : (gt_ ? A_W + B_W + 2 * (gc % 1024) + 4 * (gc / 1024) : n0); d.k0 = 64 * kb; d.n0 = n0; d.perm = qk || gt_; d.f8scale = W8_SCALE; return; } r -= I_IN;
        if (r < I_PA) { const int kb = r / 32, nb = r % 32; d.W = F.in[I_WPA]; d.N = 1024; d.WT = (bf16*)(ws + WS_WAB); d.ldo = 1536; d.rowbase = 32 * nb; d.k0 = 64 * kb; d.n0 = 32 * nb; if (P34_FP8) d.f8scale = W34_SCALE; return; } r -= I_PA;
        if (r < I_PB) { const int kb = r / 32, nb = r % 32; d.W = F.in[I_WPB]; d.N = 1024; d.WT = (bf16*)(ws + WS_WAB); d.ldo = 1536; d.rowbase = 32 * nb; d.koff = 512; d.k0 = 64 * kb; d.n0 = 32 * nb; if (P34_FP8) d.f8scale = W34_SCALE; return; } r -= I_PB;
        if (r < I_WO) { const int kb = r / 32, nb = r % 32; d.W = F.in[I_WOUT]; d.N = 1024; d.WT = (bf16*)(ws + WS_WO); d.ldo = 1024; d.rowbase = 32 * nb; d.k0 = 64 * kb; d.n0 = 32 * nb; if (P34_FP8) d.f8scale = W34_SCALE; return; } r -= I_WO;
        if (r < 2 * I_EG) { const int up = r >= I_EG; if (up) r -= I_EG; const int e = r / 128, q = r % 128, kb = q / 8, nb = q % 8;
            d.W = F.in[up ? I_WEU : I_WEG] + (size_t)e * 1024 * 256; d.N = 256; d.WT = (bf16*)(ws + WS_WGU) + (size_t)e * 512 * 1024; d.ldo = 1024; d.rowbase = 64 * nb + (up ? 4 : 0); d.k0 = 64 * kb; d.n0 = 32 * nb; d.perm = true; d.kscale = F.in[I_GFFN]; d.f8scale = WG8_SCALE; if (P6_FP8) d.WT = (bf16*)((unsigned char*)(ws + WS_WGU) + (size_t)e * 512 * 1024); return; } r -= 2 * I_EG;
        { const int e = r / 128, q = r % 128, kb = q / 32, nb = q % 32;
            d.W = F.in[I_WED] + (size_t)e * 256 * 1024; d.N = 1024; d.WT = (bf16*)(ws + WS_WD) + (size_t)e * 1024 * 256; d.ldo = 256; d.rowbase = 32 * nb; d.k0 = 64 * kb; d.n0 = 32 * nb; d.f8scale = WD8_SCALE; if (P6_FP8) d.WT = (bf16*)((unsigned char*)(ws + WS_WD) + (size_t)e * 1024 * 256); }
    };
    {
        int it = gw; TrDesc dc, dn; f32x4 tc[8], tn[8]; float kc[8], kn[8];
        bool hc = it < NITEMS; if (hc) { decode(it, dc); tr_load(dc, lane_, tc, kc); }
        while (hc) {
            it += NGW; const bool hn = it < NITEMS;
            if (hn) { decode(it, dn); tr_load(dn, lane_, tn, kn); }
            tr_finish(dc, scr, lane_, tc, kc);
            hc = hn; dc = dn;
#pragma unroll
            for (int i = 0; i < 8; ++i) { tc[i] = tn[i]; kc[i] = kn[i]; }
        }
    }
    for (int m = gw; m < T; m += 4 * NGW) {
        const GAS f32x4* gr = (const GAS f32x4*)F.in[I_GMIX] + lane_;
        f32x4 v[4][4]; float ss[4];
#pragma unroll
        for (int r = 0; r < 4; ++r) { const int mr = (m + r * NGW < T) ? m + r * NGW : m; const GAS f32x4* xr = (const GAS f32x4*)(F.in[I_X] + (size_t)mr * D) + lane_;
#pragma unroll
            for (int j = 0; j < 4; ++j) v[r][j] = xr[64 * j]; }
#pragma unroll
        for (int r = 0; r < 4; ++r) { float a = 0.f;
#pragma unroll
            for (int j = 0; j < 4; ++j) a += (v[r][j].x * v[r][j].x + v[r][j].y * v[r][j].y) + (v[r][j].z * v[r][j].z + v[r][j].w * v[r][j].w);
            ss[r] = 1.0f / sqrtf(wave_sum(a) * (1.f / D) + RMS_EPS); }
#pragma unroll
        for (int r = 0; r < 4; ++r) { if (m + r * NGW >= T) continue; GAS unsigned* o4 = (GAS unsigned*)((unsigned char*)F.out + DO_HN + (size_t)(m + r * NGW) * D) + lane_;
#pragma unroll
            for (int j = 0; j < 4; ++j) { const f32x4 gg = gr[64 * j];
                if (P1_FP8) o4[64 * j] = pk4_fp8(v[r][j].x * ss[r] * gg.x, v[r][j].y * ss[r] * gg.y, v[r][j].z * ss[r] * gg.z, v[r][j].w * ss[r] * gg.w);
                else { v2u w; w.x = cvtpk(v[r][j].x * ss[r] * gg.x, v[r][j].y * ss[r] * gg.y); w.y = cvtpk(v[r][j].z * ss[r] * gg.z, v[r][j].w * ss[r] * gg.w); ((GAS v2u*)((unsigned char*)F.out + DO_HN + (size_t)(m + r * NGW) * D * 2) + lane_)[64 * j] = w; } } }
    }
    const int gt = F.vcu * NTHR + tid_, NGT = F.G * NTHR;
    if (gt < 32) ((float*)(ws + WS_INVF))[gt] = (float)exp2(-(double)gt * (13.287712379549449 / 32.0));
    for (int c = gt; c < NIN; c += NGT) {
        int s = c; const int e = c & 7;
        if (c < 3072 || (c >= A_W && c < A_W + 1152)) s = (c & ~63) + 4 * ((c & 63) >> 3) + (e < 4 ? e : 28 + e);
        else if (c >= A_W + B_W) s = A_W + B_W + 4 * ((c - A_W - B_W) >> 3) + (e < 4 ? e : 1020 + e);
        ((float*)(ws + WS_BIASP))[c] = F.in[I_BIN][s];
    }
    for (int i = gt; i < 32 * 3 * 64; i += NGT) {
        const int ln = i & 63, nb = (i >> 6) % 3, ks = i / 192;
        const int n = 16 * nb + (ln & 15);
        float hi[8], lo[8];
#pragma unroll
        for (int e = 0; e < 8; ++e) { const int k = 32 * ks + 8 * (ln >> 4) + e; float v = 0.f;
            if (n < 4) v = F.in[I_WRG][k * 4 + n]; else if (n < 36) v = F.in[I_WRE][k * 32 + (n - 4)];
            v *= F.in[I_GFFN][k]; hi[e] = bf2f(f2bf(v)); lo[e] = v - hi[e]; }
        v4u h, l; h.x = pk2(hi[0], hi[1]); h.y = pk2(hi[2], hi[3]); h.z = pk2(hi[4], hi[5]); h.w = pk2(hi[6], hi[7]);
        l.x = pk2(lo[0], lo[1]); l.y = pk2(lo[2], lo[3]); l.z = pk2(lo[4], lo[5]); l.w = pk2(lo[6], lo[7]);
        ((v4u*)(ws + WS_WRF))[((ks * 3 + nb) * 2 + 0) * 64 + ln] = h; ((v4u*)(ws + WS_WRF))[((ks * 3 + nb) * 2 + 1) * 64 + ln] = l;
    }
}

namespace pg8 {
#define PG8_LAS __attribute__((address_space(3)))
typedef unsigned short bf16_t;
typedef short bf16x8 __attribute__((ext_vector_type(8)));
typedef float f32x4 __attribute__((ext_vector_type(4)));
typedef unsigned u32x4 __attribute__((ext_vector_type(4)));
constexpr int BM = 256, BK = 64, HALF = 128, HTB = HALF * BK * 2  , STAGE_BYTES = 8 * HTB, NXCD = 8, WGM = 8;

__host__ __device__ __forceinline__ int lds_byte(int r, int c) { const int st = (r >> 4) * 2 + (c >> 5), rr = r & 15, cc = c & 31, ob = rr * 64 + cc * 2; return st * 1024 + (ob ^ (((ob >> 9) & 1) << 5)); }
__host__ __device__ __forceinline__ void stage_rc(int b, int& R, int& C) { const int st = b / 1024, sb = b % 1024, swz = sb ^ (((sb >> 9) & 1) << 5); R = (st >> 1) * 16 + swz / 64; C = (st & 1) * 32 + (swz % 64) / 2; }
__host__ __device__ __forceinline__ int perm32(int rho) { const int n = rho >> 4, i = rho & 15; return 8 * (i >> 2) + 4 * n + (i & 3); }

struct Unit { int pm, pn; };
struct Gemm { const bf16_t* A; const bf16_t* Bt; int M, N, K; };

struct StaticOrder {
    int nM, nN, nwg, G, c;
    __host__ __device__ void init(int M, int N, int G_, int c_) { nM = M / BM; nN = N / BM; nwg = nM * nN; G = G_; c = c_; }
    __host__ __device__ bool next(int i, Unit& u) const {
        const long L = (long)i * G + c; if (L >= nwg) return false;
        int wgid = (int)L; { const int q = nwg / NXCD, r = nwg % NXCD, xcd = wgid % NXCD, off = wgid / NXCD; wgid = (xcd < r ? xcd * (q + 1) : r * (q + 1) + (xcd - r) * q) + off; }
        const int nig = WGM * nN, gid = wgid / nig, fm = gid * WGM, gsz = (nM - fm) < WGM ? (nM - fm) : WGM;
        u.pm = fm + ((wgid % nig) % gsz); u.pn = (wgid % nig) / gsz; return true;
    }
    __device__ __forceinline__ void a_ready(const Unit&) const {}
    __device__ __forceinline__ void done(const Unit&) const {}
};
}


namespace pg9 {
using pg8::BM; using pg8::BK; using pg8::HALF; using pg8::HTB; using pg8::lds_byte; using pg8::stage_rc; using pg8::perm32;
struct Unit { int pm, pn, e; };
typedef int v8i_t __attribute__((ext_vector_type(8)));
typedef int v4i_t __attribute__((ext_vector_type(4)));
template <int ESZ, class Epi, class Sched, class AOff, class BBase>
__device__ __forceinline__ void gemm_phase(LAS unsigned char* lds, const char* Abase, int K, const Sched& S, const Epi& E, const AOff& aoffn, const BBase& bbase) {
    int tid_ = threadIdx.x; asm volatile("" : "+v"(tid_));
    const int tid = tid_, wid = __builtin_amdgcn_readfirstlane(tid >> 6), lane = tid & 63, wr = wid >> 2, wc = wid & 3, fr = lane & 15, fq = lane >> 4;
    const int nt = K * ESZ / (BK * 2);
    int Rr[2], Cc[2]; unsigned voffB[2];
#pragma unroll
    for (int i = 0; i < 2; ++i) { int R, C; stage_rc(tid * 16 + i * 8192, R, C); const int Rb = Epi::PERM ? ((R & ~31) + perm32(R & 31)) : R; Rr[i] = R; Cc[i] = C; voffB[i] = (unsigned)(Rb * K * ESZ + C * 2); }
    const size_t kstep = (size_t)(BK * 2);
    const size_t hstep = (size_t)HALF * K * ESZ;
    const unsigned ldsw = (unsigned)wid * 1024u;
    const int aoff = lds_byte(wr * 64 + fr, fq * 8), boff = lds_byte(wc * 32 + fr, fq * 8);
#define PG9_SA(b, h) (((b) * 2 + (h)) * HTB)
#define PG9_SB(b, h) ((4 + (b) * 2 + (h)) * HTB)
#define PG9_STAGE(bufoff, gbase, voff) do { _Pragma("unroll") for (int _i = 0; _i < 2; ++_i) \
        __builtin_amdgcn_global_load_lds((const unsigned*)((const char*)(gbase) + (voff)[_i]), (LAS unsigned*)(lds + (bufoff) + ldsw + _i * 8192), 16, 0, 0); } while (0)
#define PG9_LDA(dst, b, h) do { _Pragma("unroll") for (int m = 0; m < 4; ++m) { dst[m].lo = *(const LAS v4i_t*)(lds + PG9_SA(b, h) + aoff + m * 2048); dst[m].hi = *(const LAS v4i_t*)(lds + PG9_SA(b, h) + aoff + m * 2048 + 1024); } } while (0)
#define PG9_LDB(dst, b, h) do { _Pragma("unroll") for (int n = 0; n < 2; ++n) { dst[n].lo = *(const LAS v4i_t*)(lds + PG9_SB(b, h) + boff + n * 2048); dst[n].hi = *(const LAS v4i_t*)(lds + PG9_SB(b, h) + boff + n * 2048 + 1024); } } while (0)
#define PG9_HALF(v, o) __builtin_bit_cast(bf16x8, __builtin_shufflevector((v), (v), (o), (o) + 1, (o) + 2, (o) + 3))
#define PG9_MMA(ai, bj, At, Bt) do { __builtin_amdgcn_s_setprio(1); _Pragma("unroll") for (int m = 0; m < 4; ++m) _Pragma("unroll") for (int n = 0; n < 2; ++n) { \
        if (ESZ == 2) { acc[ai][bj][m][n] = __builtin_amdgcn_mfma_f32_16x16x32_bf16(PG9_HALF(Bt[n], 0), PG9_HALF(At[m], 0), acc[ai][bj][m][n], 0, 0, 0); \
                        acc[ai][bj][m][n] = __builtin_amdgcn_mfma_f32_16x16x32_bf16(PG9_HALF(Bt[n], 4), PG9_HALF(At[m], 4), acc[ai][bj][m][n], 0, 0, 0); } \
        else { asm volatile("v_mfma_scale_f32_16x16x128_f8f6f4 %0, %1, %2, %0, %3, %3 op_sel_hi:[0,0,0]" : "+v"(acc[ai][bj][m][n]) : "v"(Bt[n]), "v"(At[m]), "v"(one8)); } } \
        __builtin_amdgcn_s_setprio(0); } while (0)
#define PG9_WAIT_V(n) asm volatile("s_waitcnt vmcnt(" #n ")" ::: "memory")
#define PG9_WAIT_L(n) asm volatile("s_waitcnt lgkmcnt(" #n ")" ::: "memory")
#define PG9_BAR __builtin_amdgcn_s_barrier()
#define PG9_SCHED __builtin_amdgcn_sched_barrier(0)
#define PG9_VA(dst, u) do { _Pragma("unroll") for (int _h = 0; _h < 2; ++_h) _Pragma("unroll") for (int _i = 0; _i < 2; ++_i) dst[_h][_i] = aoffn((u), _h * HALF + Rr[_i]) + (unsigned)(Cc[_i] * 2); } while (0)
    constexpr bool GATHER = AOff::GATHER;
    const size_t hstepA = (size_t)HALF * aoffn.rowbytes;
    unsigned voffA[2];
#pragma unroll
    for (int i = 0; i < 2; ++i) voffA[i] = (unsigned)Rr[i] * aoffn.rowbytes + (unsigned)(Cc[i] * 2);
#define PG9_STAGE_A(bufoff, h, koff, nx) do { if (GATHER) { PG9_STAGE(bufoff, Abase + (koff), ((nx) ? nvA[h] : cvA[h])); } else { PG9_STAGE(bufoff, ((nx) ? nAu : cAu) + (h) * hstepA + (koff), voffA); } } while (0)
    Unit cur, nxt; int ui = 0;
    if (!S.next(0, cur)) return;
    f32x4 acc[2][2][4][2];
#pragma unroll
    for (int a = 0; a < 2; ++a)
#pragma unroll
        for (int b = 0; b < 2; ++b)
#pragma unroll
            for (int m = 0; m < 4; ++m)
#pragma unroll
                for (int n = 0; n < 2; ++n) acc[a][b][m][n] = (f32x4){0.f, 0.f, 0.f, 0.f};
    int one8 = 0x7f7f7f7f; asm volatile("" : "+v"(one8));
    v8i_t At[4], B0[2], B1[2];
    unsigned cvA[2][2], nvA[2][2];
    if (GATHER) { PG9_VA(cvA, cur); }
    const char* cAu = GATHER ? Abase : Abase + (size_t)aoffn(cur, 0); const char* nAu = cAu;
    const char* cB = bbase(cur);
    E.prefetch(lds, cur, 0, wid, lane);
    PG9_STAGE(PG9_SB(0, 0), cB, voffB); PG9_STAGE(PG9_SB(0, 1), cB + hstep, voffB); PG9_STAGE_A(PG9_SA(0, 0), 0, 0, false); PG9_STAGE_A(PG9_SA(0, 1), 1, 0, false);
    if (wr == 1) PG9_BAR;
    PG9_WAIT_V(2); PG9_BAR;
    PG9_STAGE(PG9_SB(1, 0), cB + kstep, voffB); PG9_STAGE_A(PG9_SA(1, 0), 0, kstep, false); PG9_STAGE(PG9_SB(1, 1), cB + hstep + kstep, voffB);
    PG9_WAIT_V(6); PG9_BAR;
    for (;;) {
        const bool has_next = S.next(ui + 1, nxt);
        if (GATHER) {
            if (has_next) { PG9_VA(nvA, nxt); } else {
#pragma unroll
                for (int _h = 0; _h < 2; ++_h)
#pragma unroll
                    for (int _i = 0; _i < 2; ++_i) nvA[_h][_i] = cvA[_h][_i]; }
        } else nAu = has_next ? Abase + (size_t)aoffn(nxt, 0) : cAu;
        const char* nB = has_next ? bbase(nxt) : cB;
#pragma unroll 1
        for (int t = 0; t < nt; t += 2) {
            const bool last = (t == nt - 2);
            if (Epi::HOOK_T >= 0) { if (t == Epi::HOOK_T) E.hook(acc, cur, wr, wc, fr, fq); }
            const size_t k1 = (size_t)(t + 1) * kstep, k2 = last ? 0 : (size_t)(t + 2) * kstep, k3 = k2 + kstep;
            const char* b2 = last ? nB : cB + (size_t)(t + 2) * kstep; const char* b3 = b2 + kstep;
            PG9_LDB(B0, 0, 0); PG9_LDB(B1, 0, 1); PG9_SCHED; PG9_LDA(At, 0, 0); PG9_STAGE_A(PG9_SA(1, 1), 1, k1, false);
            PG9_WAIT_V(8); PG9_WAIT_L(0); PG9_BAR; PG9_MMA(0, 0, At, B0); PG9_MMA(0, 1, At, B1); PG9_BAR; PG9_SCHED;
            PG9_LDA(At, 0, 1); PG9_STAGE(PG9_SB(0, 0), b2, voffB); PG9_STAGE(PG9_SB(0, 1), b2 + hstep, voffB); PG9_STAGE_A(PG9_SA(0, 0), 0, k2, last);
            PG9_WAIT_V(8); PG9_WAIT_L(0); PG9_BAR; PG9_MMA(1, 0, At, B0); PG9_MMA(1, 1, At, B1); PG9_BAR; PG9_SCHED;
            PG9_LDB(B0, 1, 0); PG9_LDB(B1, 1, 1); PG9_SCHED; PG9_LDA(At, 1, 0); PG9_STAGE_A(PG9_SA(0, 1), 1, k2, last);
            PG9_WAIT_V(8); PG9_WAIT_L(0); PG9_BAR; PG9_MMA(0, 0, At, B0); PG9_MMA(0, 1, At, B1); PG9_BAR; PG9_SCHED;
            PG9_LDA(At, 1, 1); PG9_STAGE(PG9_SB(1, 0), b3, voffB); PG9_STAGE(PG9_SB(1, 1), b3 + hstep, voffB); PG9_STAGE_A(PG9_SA(1, 0), 0, k3, last);
            PG9_WAIT_V(8); PG9_WAIT_L(0); PG9_BAR; PG9_MMA(1, 0, At, B0); PG9_MMA(1, 1, At, B1); PG9_BAR; PG9_SCHED;
        }
        if (wr == 0) PG9_BAR;
        if (ESZ == 1) asm volatile("s_nop 15\n\ts_nop 15" ::: "memory");
        E(acc, cur, ui, wr, wc, fr, fq);
        if (!has_next) break;
#pragma unroll
        for (int a = 0; a < 2; ++a)
#pragma unroll
            for (int b = 0; b < 2; ++b)
#pragma unroll
                for (int m = 0; m < 4; ++m)
#pragma unroll
                    for (int n = 0; n < 2; ++n) acc[a][b][m][n] = (f32x4){0.f, 0.f, 0.f, 0.f};
        cur = nxt; cB = nB; cAu = nAu; ++ui;
        E.prefetch(lds, cur, ui, wid, lane);
        if (GATHER) {
#pragma unroll
            for (int _h = 0; _h < 2; ++_h)
#pragma unroll
                for (int _i = 0; _i < 2; ++_i) cvA[_h][_i] = nvA[_h][_i]; }
        if (wr == 1) PG9_BAR;
    }
    PG9_WAIT_V(0);
    PG9_BAR;
#undef PG9_SA
#undef PG9_SB
#undef PG9_STAGE
#undef PG9_LDA
#undef PG9_LDB
#undef PG9_MMA
#undef PG9_HALF
#undef PG9_WAIT_V
#undef PG9_WAIT_L
#undef PG9_BAR
#undef PG9_SCHED
#undef PG9_VA
#undef PG9_STAGE_A
}
struct DenseOrder { pg8::StaticOrder so;
    __device__ void init(int M, int N, int G, int c) { so.init(M, N, G, c); }
    __device__ bool next(int i, Unit& u) const { pg8::Unit v; if (!so.next(i, v)) return false; u.pm = v.pm; u.pn = v.pn; u.e = 0; return true; } };
struct DenseA { static constexpr bool GATHER = false; unsigned rowbytes; __device__ __forceinline__ unsigned operator()(const Unit& u, int row) const { return (unsigned)(u.pm * 256 + row) * rowbytes; } };
struct DenseB { const char* Bt; size_t tilebytes; __device__ __forceinline__ const char* operator()(const Unit& u) const { return Bt + (size_t)u.pn * tilebytes; } };
}

struct EpiInproj {
    static constexpr bool PERM = true; static constexpr int HOOK_T = -1;
    bf16* ZA; bf16* ZB; bf16* Gt; const float* biasP; LAS unsigned char* ldsb;
    __device__ __forceinline__ void hook(f32x4 (&)[2][2][4][2], const pg9::Unit&, int, int, int, int) const {}
    __device__ __forceinline__ void prefetch(LAS unsigned char* lds, const pg9::Unit& u, int ui, int wid, int lane) const {
        if (wid == 0) __builtin_amdgcn_global_load_lds((const unsigned*)(biasP + u.pn * 256 + lane * 4), (LAS unsigned*)(lds + LDS_MISC + 4096 + (ui & 1) * 1024), 16, 0, 0);
    }
    __device__ __forceinline__ void operator()(const f32x4 (&acc)[2][2][4][2], const pg9::Unit& u, int ui, int wr, int wc, int fr, int fq) const {
        asm volatile("" : "+v"(fr), "+v"(fq));
        const int row0 = u.pm * 256 + wr * 64 + fr;
        const int q = 4 * (wc & 1) + fq;
        const int fr2 = (fr >> 2) + 4 * fq, fq2 = fr & 3, paddr = 4 * (16 * (fr & 3) + 4 * fq + (fr >> 2));
        const int row0s = u.pm * 256 + wr * 64 + fr2;
        int kind[2]; bf16* dst[2]; int ldd[2]; f32x4 b0[2], b1[2];
#pragma unroll
        for (int bj = 0; bj < 2; ++bj) {
            const int colpos = u.pn * 256 + bj * 128 + wc * 32 + 8 * fq, colposs = u.pn * 256 + bj * 128 + wc * 32 + 8 * fq2, hb = u.pn * 256 + bj * 128 + (wc >> 1) * 64;
            if (hb < A_W) { const int hbi = hb >> 6; kind[bj] = hb / 1536; dst[bj] = ZA + (size_t)hbi * (TC * 64) + (colposs - hb); ldd[bj] = 2 * ((hbi % 24) >> 3); }
            else if (hb < A_W + B_W) { const int cb = hb - A_W; kind[bj] = cb < 1024 ? 0 : (cb < 1152 ? 1 : 2); dst[bj] = ZB + (size_t)(cb >> 6) * (TC * 64) + (colposs - hb); ldd[bj] = 0; }
            else { kind[bj] = 3; const int c0 = (colpos - A_W - B_W) >> 1;
                dst[bj] = Gt + ((size_t)((u.pm * 256 + wr * 64) >> 4) * 256 + (c0 >> 3)) * 128 + fr * 8 + (c0 & 7); ldd[bj] = 0; }
            const LAS float* bs = (const LAS float*)(ldsb + LDS_MISC + 4096 + (ui & 1) * 1024) + bj * 128 + wc * 32 + 8 * fq;
            b0[bj] = *(const LAS f32x4*)bs; b1[bj] = *(const LAS f32x4*)(bs + 4);
        }
        const bool need_rope = kind[0] < 2 || kind[1] < 2;
        const f32x4 fv = *(const LAS f32x4*)(ldsb + LDS_MISC + 6144 + 16 * q);
#pragma unroll
        for (int ai = 0; ai < 2; ++ai) {
            f32x4 rc[4], rs[4];
#pragma unroll
            for (int m = 0; m < 4; ++m) { rc[m] = (f32x4){1.f, 1.f, 1.f, 1.f}; rs[m] = (f32x4){0.f, 0.f, 0.f, 0.f}; }
            if (need_rope) {
#pragma unroll
                for (int m = 0; m < 4; ++m) { const float posf = (float)((row0 + ai * 128 + m * 16) & (SEQ - 1));
#pragma unroll
                    for (int e = 0; e < 4; ++e) { const float ang = posf * fv[e]; const float pr = ang * 0.15915494f; const float er = __builtin_fmaf(ang, 0.15915494f, -pr) + ang * 6.4206382e-9f;
                        const float fr = __builtin_amdgcn_fractf(pr) + er; rc[m][e] = __builtin_amdgcn_cosf(fr); rs[m][e] = __builtin_amdgcn_sinf(fr); } }
            }
#pragma unroll
            for (int bj = 0; bj < 2; ++bj) {
                const int sh = ldd[bj], posr = row0s & (SEQ - 1), ridx = (row0s & ~(SEQ - 1)) + ((posr & ((1 << sh) - 1)) << (12 - sh)) + (posr >> sh);
                bf16* p = dst[bj] + (size_t)(ridx + ai * (128 >> sh)) * 64; const unsigned step = (unsigned)((16 >> sh) * 64);
                if (kind[bj] == 3) p = dst[bj] + (size_t)(ai * 8) * 32768;
                switch (kind[bj]) {
                    case 0: store4<0>(acc[ai][bj], b0[bj], b1[bj], rc, rs, p, step, paddr); break;
                    case 1: store4<1>(acc[ai][bj], b0[bj], b1[bj], rc, rs, p, step, paddr); break;
                    case 2: store4<2>(acc[ai][bj], b0[bj], b1[bj], rc, rs, p, step, paddr); break;
                    default: store4<3>(acc[ai][bj], b0[bj], b1[bj], rc, rs, p, step, paddr); break;
                }
            }
        }
    }
    template <int KIND> static __device__ __forceinline__ void store4(const f32x4 (&a)[4][2], const f32x4 b0, const f32x4 b1, const f32x4 (&rc)[4], const f32x4 (&rs)[4], bf16* p, const unsigned step, const int paddr) {
#pragma unroll
        for (int m = 0; m < 4; ++m) {
            f32x4 v0 = a[m][0] * W8_INV + b0, v1 = a[m][1] * W8_INV + b1;
            if (KIND < 2) {
                const f32x4 cc = rc[m], ss = rs[m];
                const f32x4 t0 = v0 * cc - v1 * ss, t1 = v1 * cc + v0 * ss;
                v0 = t0; v1 = t1;
                if (KIND == 0) { v0 = v0 * QSCALE; v1 = v1 * QSCALE; }
            }
            if (KIND == 3) {
#pragma unroll
                for (int e = 0; e < 4; ++e) { const float d0 = 1.0f + __expf(-v0[e]), d1 = 1.0f + __expf(-v1[e]); v0[e] = d1 * __builtin_amdgcn_rcpf(d0); v1[e] = __builtin_amdgcn_rcpf(d1); }
                v2u w0, w1; w0.x = cvtpk(v0[0], v0[1]); w0.y = cvtpk(v0[2], v0[3]); w1.x = cvtpk(v1[0], v1[1]); w1.y = cvtpk(v1[2], v1[3]);
                *(GAS v2u*)p = w0; *(GAS v2u*)(p + 128 * 128) = w1; p += 32768;
            } else {
                v4u w; w.x = cvtpk(v0[0], v0[1]); w.y = cvtpk(v0[2], v0[3]); w.z = cvtpk(v1[0], v1[1]); w.w = cvtpk(v1[2], v1[3]);
                w.x = (unsigned)__builtin_amdgcn_ds_bpermute(paddr, (int)w.x); w.y = (unsigned)__builtin_amdgcn_ds_bpermute(paddr, (int)w.y); w.z = (unsigned)__builtin_amdgcn_ds_bpermute(paddr, (int)w.z); w.w = (unsigned)__builtin_amdgcn_ds_bpermute(paddr, (int)w.w);
                *(GAS v4u*)p = w; p += step;
            }
        }
    }
};
__device__ __forceinline__ void p1_inproj(Frame& F, int ch) {
    unsigned char* ws = F.ws;
    pg9::DenseOrder S; S.init(TC, NIN, F.G, (int)blockIdx.x);
    EpiInproj E{(bf16*)(ws + WS_ZA), (bf16*)(ws + WS_ZB), (bf16*)(ws + WS_G) + (size_t)ch * TC * G_W, (const float*)(ws + WS_BIASP), F.lds};
    { int t_ = threadIdx.x; asm volatile("" : "+v"(t_)); if (t_ < 32) ((LAS float*)(F.lds + LDS_MISC + 6144))[t_] = ((const float*)(ws + WS_INVF))[t_]; }
    constexpr int ES = P1_FP8 ? 1 : 2;
    pg9::DenseA ao{(unsigned)(D * ES)}; pg9::DenseB bb{(const char*)(ws + WS_WIN), (size_t)256 * D * ES};
    pg9::gemm_phase<ES>(F.lds, (const char*)F.out + DO_HN + (size_t)ch * TC * D * ES, D, S, E, ao, bb);
}

typedef float f32x16 __attribute__((ext_vector_type(16)));
typedef short v4i16_t __attribute__((ext_vector_type(4)));
__device__ __forceinline__ float half_max(float v) { auto rr = __builtin_amdgcn_permlane32_swap(__float_as_uint(v), __float_as_uint(v), false, false); return fmaxf(__uint_as_float(rr[0]), __uint_as_float(rr[1])); }
__device__ __forceinline__ float half_sum(float v) { auto rr = __builtin_amdgcn_permlane32_swap(__float_as_uint(v), __float_as_uint(v), false, false); return __uint_as_float(rr[0]) + __uint_as_float(rr[1]); }
__device__ __forceinline__ float max3f(float a, float b, float c) { float r; asm("v_max3_f32 %0, %1, %2, %3" : "=v"(r) : "v"(a), "v"(b), "v"(c)); return r; }
constexpr int ATT_VOFF = 49152;

struct AUnit { const bf16 *Kw, *Vw, *Qp; size_t pitch; int kk_lo, nkeys, kb0, kstart, lo; float m0; bf16* Op; long ostr; float* Lp; int o8; };
__device__ __forceinline__ void attn_decode(Frame& F, int ch, int u, int NUA, int lane, AUnit& d) {
    unsigned char* ws = F.ws;
    const int w = F.wave, c = lane & 31, h = (lane >> 5) & 1;
    if (u < NUA) {
        const bf16* ZA = (const bf16*)(ws + WS_ZA);
        const int rt = u & 15, hh = (u >> 4) & 7, gb = u >> 7, g = gb % 3, bl = gb / 3;
        const int dsh = 2 * g, dd = 1 << dsh, tsh = 4 - dsh;
        const int r = rt >> tsh, tile = rt & ((1 << tsh) - 1), i0 = tile * 256;
        const int rowb = bl * SEQ + r;
        d.pitch = 64;
        const int sl = g * 8 + hh; const long rb = (long)bl * SEQ + ((long)r << (12 - dsh));
        d.Kw = ZA + ((long)(24 + sl) * TC + rb + (i0 - 128)) * 64; d.Vw = ZA + ((long)(48 + sl) * TC + rb + (i0 - 128)) * 64;
        const long qrow = (long)rowb + (long)dd * (i0 + 32 * w + c);
        d.Qp = ZA + ((long)sl * TC + rb + i0 + 32 * w + c) * 64;
        d.kk_lo = (i0 == 0) ? 128 : 0; d.nkeys = 384; d.kb0 = w; d.kstart = (i0 == 0) ? (w < 4 ? 4 - w : 0) : 0; d.lo = 0;
        d.m0 = -1e30f;
        d.Op = (bf16*)((unsigned char*)F.out + DO_OG) + ((size_t)g * TC + (qrow - (long)dd * c)) * 512 + hh * 64; d.ostr = (long)dd * 1024;
        d.Lp = (float*)((unsigned char*)F.out + DO_LSE) + ((size_t)g * TC + qrow) * 8 + hh;
        d.o8 = 0;
    } else {
        const int u2 = u - NUA;
        const bf16* ZB = (const bf16*)(ws + WS_ZB);
        const int blk = u2 & 127, kvh = (u2 >> 7) & 1, bl = u2 >> 8;
        const int t0 = blk * 32, rowb = bl * SEQ;
        d.pitch = 64;
        d.Kw = ZB + ((long)(16 + kvh) * TC + rowb + t0 - 128) * 64; d.Vw = ZB + ((long)(18 + kvh) * TC + rowb + t0 - 128) * 64;
        const int qh = kvh * 8 + w;
        const long qrow = (long)rowb + t0 + c;
        d.Qp = ZB + ((long)qh * TC + qrow) * 64;
        d.kk_lo = t0 < 128 ? 128 - t0 : 0; d.nkeys = 160; d.kb0 = 0; d.kstart = d.kk_lo >> 5; d.lo = 1;
        d.m0 = F.in[I_SINK][qh] * LOG2E;
        d.o8 = P34_FP8;
        d.Op = P34_FP8 ? (bf16*)(ws + WS_Y + ((size_t)ch * TC + (qrow - c)) * Y_W + 512 + qh * 64) : (bf16*)(ws + WS_Y) + ((size_t)ch * TC + (qrow - c)) * Y_W + 512 + qh * 64; d.ostr = P34_FP8 ? Y_W : 2 * Y_W;
        d.Lp = nullptr;
    }
}
__device__ __forceinline__ void attn_load(const AUnit& d, int tid, int lane, v4u (&kreg)[6], v4u (&vreg)[6], bf16x8 (&qf)[4]) {
    const int skey = tid >> 3, sch = tid & 7, h = (lane >> 5) & 1;
#pragma unroll
    for (int s4 = 0; s4 < 4; ++s4) qf[s4] = *(const GAS bf16x8*)(d.Qp + 16 * s4 + 8 * h);
#pragma unroll
    for (int p = 0; p < 6; ++p) { const int kk = 64 * p + skey;
        if (kk >= d.kk_lo && kk < d.nkeys) { kreg[p] = *(const GAS v4u*)(d.Kw + (size_t)kk * d.pitch + 8 * sch); vreg[p] = *(const GAS v4u*)(d.Vw + (size_t)kk * d.pitch + 8 * sch); } }
}
__device__ __forceinline__ void attn_write(const AUnit& d, LAS unsigned char* KL, LAS unsigned char* VL, int tid, const v4u (&kreg)[6], const v4u (&vreg)[6]) {
    const int skey = tid >> 3, sch = tid & 7;
#pragma unroll
    for (int p = 0; p < 6; ++p) { const int kk = 64 * p + skey;
        if (kk >= d.kk_lo && kk < d.nkeys) {
            *(LAS v4u*)(KL + kk * 128 + ((sch ^ ((kk >> 1) & 7)) << 4)) = kreg[p];
            *(LAS v4u*)(VL + kk * 128 + ((sch * 16) ^ (((kk >> 1) & 1) << 6))) = vreg[p]; } }
}
__device__ __forceinline__ void attn_out(const AUnit& d, LAS unsigned char* OL, int lane, const f32x16& o0, const f32x16& o1, float inv) {
    asm volatile("" : "+v"(lane));
    const int c = lane & 31, h = (lane >> 5) & 1;
    if (d.o8) {
        const float sc = inv * Y8_SCALE;
#pragma unroll
        for (int g4 = 0; g4 < 4; ++g4) {
            const int bo0 = 8 * g4 + 4 * h, bo1 = 32 + bo0;
            *(LAS unsigned*)(OL + c * 64 + (((bo0 >> 4) ^ (c & 3)) << 4) + (bo0 & 15)) = pk4_fp8(o0[4 * g4 + 0] * sc, o0[4 * g4 + 1] * sc, o0[4 * g4 + 2] * sc, o0[4 * g4 + 3] * sc);
            *(LAS unsigned*)(OL + c * 64 + (((bo1 >> 4) ^ (c & 3)) << 4) + (bo1 & 15)) = pk4_fp8(o1[4 * g4 + 0] * sc, o1[4 * g4 + 1] * sc, o1[4 * g4 + 2] * sc, o1[4 * g4 + 3] * sc);
        }
        unsigned char* ob = (unsigned char*)d.Op;
#pragma unroll
        for (int j = 0; j < 2; ++j) { const int q = (lane >> 2) + 16 * j, k = lane & 3;
            const v4u v = *(const LAS v4u*)(OL + q * 64 + ((k ^ (q & 3)) << 4)); *(GAS v4u*)(ob + (long)q * d.ostr + k * 16) = v; }
    } else {
#pragma unroll
        for (int g4 = 0; g4 < 4; ++g4) {
            v2u a, b;
            a.x = cvtpk(o0[4 * g4 + 0] * inv, o0[4 * g4 + 1] * inv); a.y = cvtpk(o0[4 * g4 + 2] * inv, o0[4 * g4 + 3] * inv);
            b.x = cvtpk(o1[4 * g4 + 0] * inv, o1[4 * g4 + 1] * inv); b.y = cvtpk(o1[4 * g4 + 2] * inv, o1[4 * g4 + 3] * inv);
            const int bo0 = 16 * g4 + 8 * h, bo1 = 64 + bo0;
            *(LAS v2u*)(OL + c * 128 + (((bo0 >> 4) ^ (c & 7)) << 4) + (bo0 & 15)) = a;
            *(LAS v2u*)(OL + c * 128 + (((bo1 >> 4) ^ (c & 7)) << 4) + (bo1 & 15)) = b;
        }
        unsigned char* ob = (unsigned char*)d.Op;
#pragma unroll
        for (int j = 0; j < 4; ++j) { const int q = (lane >> 3) + 8 * j, k = lane & 7;
            const v4u v = *(const LAS v4u*)(OL + q * 128 + ((k ^ (q & 7)) << 4)); *(GAS v4u*)(ob + (long)q * d.ostr + k * 16) = v; }
    }
}
__device__ __forceinline__ void attn_compute_edge(const AUnit& d, const LAS unsigned char* KL, const LAS unsigned char* VL, LAS unsigned char* OL, int lane, const bf16x8 (&qf)[4]) {
    const int c = lane & 31, h = (lane >> 5) & 1;
    int koff[4];
    { const int kswz = (c >> 1) & 7;
#pragma unroll
      for (int s4 = 0; s4 < 4; ++s4) koff[s4] = c * 128 + (((2 * s4 + h) ^ kswz) << 4); }
    const int vrow = 4 * h + ((lane & 15) >> 2), vsw = (lane >> 3) & 1;
    const int voff0 = vrow * 128 + ((32 * ((lane >> 4) & 1) + 8 * (lane & 3)) ^ (vsw << 6)), voff1 = voff0 ^ 64;
    const float NEG = -INFINITY;
    float m = d.m0, l = (d.lo && h == 0) ? 1.f : 0.f;
    f32x16 o0, o1;
#pragma unroll
    for (int i = 0; i < 16; ++i) { o0[i] = 0.f; o1[i] = 0.f; }
    const LAS unsigned char* kbp = KL + d.kb0 * 4096; const LAS unsigned char* vbp = VL + d.kb0 * 4096;
    const int clo = c + d.lo;
#pragma unroll
    for (int kbi = 0; kbi < 5; ++kbi) {
        if (kbi >= d.kstart) {
            f32x16 p;
#pragma unroll
            for (int i = 0; i < 16; ++i) p[i] = 0.f;
#pragma unroll
            for (int s4 = 0; s4 < 4; ++s4) { const bf16x8 kf = *(const LAS bf16x8*)(kbp + kbi * 4096 + koff[s4]); p = __builtin_amdgcn_mfma_f32_32x32x16_bf16(kf, qf[s4], p, 0, 0, 0); }
            if (kbi == 0) {
#pragma unroll
                for (int i = 0; i < 16; ++i) { const int x = (i & 3) + 8 * (i >> 2) + 4 * h; if (x < clo) p[i] = NEG; }
            }
            if (kbi == 4) {
#pragma unroll
                for (int i = 0; i < 16; ++i) { const int x = (i & 3) + 8 * (i >> 2) + 4 * h; if (x > c) p[i] = NEG; }
            }
            float mt = p[0];
#pragma unroll
            for (int i = 1; i < 16; ++i) mt = fmaxf(mt, p[i]);
            mt = half_max(mt);
            const float mn = fmaxf(m, mt), alpha = __builtin_amdgcn_exp2f(m - mn);
            m = mn;
            float ps = 0.f;
#pragma unroll
            for (int i = 0; i < 16; ++i) { p[i] = __builtin_amdgcn_exp2f(p[i] - mn); ps += p[i]; }
            l = l * alpha + ps;
#pragma unroll
            for (int i = 0; i < 16; ++i) { o0[i] *= alpha; o1[i] *= alpha; }
            bf16x8 pb[2];
#pragma unroll
            for (int s2 = 0; s2 < 2; ++s2) { v4u t; t.x = cvtpk(p[8 * s2 + 0], p[8 * s2 + 1]); t.y = cvtpk(p[8 * s2 + 2], p[8 * s2 + 3]); t.z = cvtpk(p[8 * s2 + 4], p[8 * s2 + 5]); t.w = cvtpk(p[8 * s2 + 6], p[8 * s2 + 7]); pb[s2] = __builtin_bit_cast(bf16x8, t); }
#pragma unroll
            for (int s2 = 0; s2 < 2; ++s2) {
#pragma unroll
                for (int db = 0; db < 2; ++db) {
                    const LAS unsigned char* vp = vbp + kbi * 4096 + s2 * 2048 + (db ? voff1 : voff0);
                    const v4i16_t lo = __builtin_amdgcn_ds_read_tr16_b64_v4i16((LAS v4i16_t*)vp);
                    const v4i16_t hi = __builtin_amdgcn_ds_read_tr16_b64_v4i16((LAS v4i16_t*)(vp + 1024));
                    const bf16x8 vf = {lo[0], lo[1], lo[2], lo[3], hi[0], hi[1], hi[2], hi[3]};
                    if (db == 0) o0 = __builtin_amdgcn_mfma_f32_32x32x16_bf16(vf, pb[s2], o0, 0, 0, 0);
                    else o1 = __builtin_amdgcn_mfma_f32_32x32x16_bf16(vf, pb[s2], o1, 0, 0, 0);
                }
            }
        }
    }
    const float lt = half_sum(l), inv = 1.0f / lt;
    attn_out(d, OL, lane, o0, o1, inv);
    if (d.Lp) { if (h == 0) *d.Lp = m + __builtin_amdgcn_logf(lt); }
}
__device__ __forceinline__ void attn_compute(const AUnit& d, const LAS unsigned char* KL, const LAS unsigned char* VL, LAS unsigned char* OL, int lane, const bf16x8 (&qf)[4]) {
    const int c = lane & 31, h = (lane >> 5) & 1;
    int koff[4];
    { const int kswz = (c >> 1) & 7;
#pragma unroll
      for (int s4 = 0; s4 < 4; ++s4) koff[s4] = c * 128 + (((2 * s4 + h) ^ kswz) << 4); }
    const int vrow = 4 * h + ((lane & 15) >> 2), vsw = (lane >> 3) & 1;
    const int voff0 = vrow * 128 + ((32 * ((lane >> 4) & 1) + 8 * (lane & 3)) ^ (vsw << 6)), voff1 = voff0 ^ 64;
    const float NEG = -INFINITY;
    float m = d.m0;
    f32x16 o0, o1, L;
#pragma unroll
    for (int i = 0; i < 16; ++i) { o0[i] = 0.f; o1[i] = 0.f; L[i] = 0.f; }
    v4u onesu = {0x3F803F80u, 0x3F803F80u, 0x3F803F80u, 0x3F803F80u}; asm volatile("" : "+v"(onesu));
    const bf16x8 ones = __builtin_bit_cast(bf16x8, onesu);
    const LAS unsigned char* kbp = KL + d.kb0 * 4096; const LAS unsigned char* vbp = VL + d.kb0 * 4096;
    const int clo = c + d.lo;
#pragma unroll
    for (int kbi = 0; kbi < 5; ++kbi) {
        {
            constexpr bool first_dummy = false; (void)first_dummy;
            const bool first = (kbi == 0);
            const float cinit = first ? 0.f : -m;
            f32x16 p;
#pragma unroll
            for (int i = 0; i < 16; ++i) p[i] = cinit;
#pragma unroll
            for (int s4 = 0; s4 < 4; ++s4) { const bf16x8 kf = *(const LAS bf16x8*)(kbp + kbi * 4096 + koff[s4]); p = __builtin_amdgcn_mfma_f32_32x32x16_bf16(kf, qf[s4], p, 0, 0, 0); }
            if (kbi == 0) {
#pragma unroll
                for (int i = 0; i < 16; ++i) { const int x = (i & 3) + 8 * (i >> 2) + 4 * h; p[i] = x < clo ? NEG : p[i]; }
            }
            if (kbi == 4) {
#pragma unroll
                for (int i = 0; i < 16; ++i) { const int x = (i & 3) + 8 * (i >> 2) + 4 * h; p[i] = x > c ? NEG : p[i]; }
            }
            float t0 = max3f(p[0], p[4], p[8]), t1 = max3f(p[1], p[5], p[9]), t2 = max3f(p[2], p[6], p[10]), t3 = max3f(p[3], p[7], p[11]);
            t0 = max3f(t0, p[12], p[13]); t1 = max3f(t1, p[14], p[15]);
            const float mt = half_max(max3f(max3f(t0, t1, t2), t3, t3));
            if (first) {
                const float mn = fmaxf(m, mt), l0 = d.m0 > -1e29f ? __builtin_amdgcn_exp2f(m - mn) : 0.f;
                m = mn;
#pragma unroll
                for (int i = 0; i < 16; ++i) { p[i] -= mn; L[i] = l0; }
            } else if (__any(mt > 8.0f)) {
                const float dl = fmaxf(mt, 0.f), al = __builtin_amdgcn_exp2f(-dl);
                m += dl;
#pragma unroll
                for (int i = 0; i < 16; ++i) { o0[i] *= al; o1[i] *= al; L[i] *= al; p[i] -= dl; }
            }
#pragma unroll
            for (int i = 0; i < 16; ++i) p[i] = __builtin_amdgcn_exp2f(p[i]);
            bf16x8 pb[2];
#pragma unroll
            for (int s2 = 0; s2 < 2; ++s2) { v4u t; t.x = cvtpk(p[8 * s2 + 0], p[8 * s2 + 1]); t.y = cvtpk(p[8 * s2 + 2], p[8 * s2 + 3]); t.z = cvtpk(p[8 * s2 + 4], p[8 * s2 + 5]); t.w = cvtpk(p[8 * s2 + 6], p[8 * s2 + 7]); pb[s2] = __builtin_bit_cast(bf16x8, t); }
#pragma unroll
            for (int s2 = 0; s2 < 2; ++s2) {
                L = __builtin_amdgcn_mfma_f32_32x32x16_bf16(ones, pb[s2], L, 0, 0, 0);
#pragma unroll
                for (int db = 0; db < 2; ++db) {
                    const LAS unsigned char* vp = vbp + kbi * 4096 + s2 * 2048 + (db ? voff1 : voff0);
                    const v4i16_t lo = __builtin_amdgcn_ds_read_tr16_b64_v4i16((LAS v4i16_t*)vp);
                    const v4i16_t hi = __builtin_amdgcn_ds_read_tr16_b64_v4i16((LAS v4i16_t*)(vp + 1024));
                    const bf16x8 vf = {lo[0], lo[1], lo[2], lo[3], hi[0], hi[1], hi[2], hi[3]};
                    if (db == 0) o0 = __builtin_amdgcn_mfma_f32_32x32x16_bf16(vf, pb[s2], o0, 0, 0, 0);
                    else o1 = __builtin_amdgcn_mfma_f32_32x32x16_bf16(vf, pb[s2], o1, 0, 0, 0);
                }
            }
        }
    }
    const float lt = L[0], inv = 1.0f / lt;
    attn_out(d, OL, lane, o0, o1, inv);
    if (d.Lp) { if (h == 0) *d.Lp = m + __builtin_amdgcn_logf(lt); }
}
__device__ __forceinline__ void p2_attn(Frame& F, int ch) {
    int tid_ = threadIdx.x; asm volatile("" : "+v"(tid_));
    const int tid = tid_, lane = tid & 63;
    LAS unsigned char* KL = F.lds; LAS unsigned char* VL = F.lds + ATT_VOFF; LAS unsigned char* OL = F.lds + 2 * ATT_VOFF + F.wave * 4096;
    constexpr int NUA = (TC / SEQ) * 3 * 8 * 16, NUB = (TC / SEQ) * 2 * 128, NU = NUA + NUB;
    int u = F.vcu; asm volatile("" : "+s"(u));
    if (u >= NU) return;
    AUnit cur, nxt;
    v4u kreg[6], vreg[6]; bf16x8 qn[4];
    attn_decode(F, ch, u, NUA, lane, cur);
    attn_load(cur, tid, lane, kreg, vreg, qn);
    for (;;) {
        attn_write(cur, KL, VL, tid, kreg, vreg);
        bf16x8 qf[4];
#pragma unroll
        for (int s4 = 0; s4 < 4; ++s4) qf[s4] = qn[s4];
        __syncthreads();
        const int un = u + F.G; const bool has_next = un < NU;
        if (has_next) { attn_decode(F, ch, un, NUA, lane, nxt); attn_load(nxt, tid, lane, kreg, vreg, qn); }
        if (cur.kk_lo == 0) attn_compute(cur, KL, VL, OL, lane, qf); else attn_compute_edge(cur, KL, VL, OL, lane, qf);
        __syncthreads();
        if (!has_next) break;
        cur = nxt; u = un;
    }
}
__device__ __forceinline__ void p2_combine(Frame& F, int ch, int cu, int ncu) {
    int tid_ = threadIdx.x; asm volatile("" : "+v"(tid_)); const int lane_ = tid_ & 63;
    unsigned char* ws = F.ws;
    const bf16* OG = (const bf16*)((const unsigned char*)F.out + DO_OG); const float* LSE = (const float*)((const unsigned char*)F.out + DO_LSE);
    bf16* Y = (bf16*)(ws + WS_Y) + (size_t)ch * TC * Y_W; unsigned char* Y8 = ws + WS_Y + (size_t)ch * TC * Y_W;
    const int lane = lane_, hd = lane >> 3;
    int gw_ = cu * NWAVES + F.wave; asm volatile("" : "+s"(gw_));
    const int gw = gw_, NGW = ncu * NWAVES;
    for (int row0 = gw; row0 < TC; row0 += 4 * NGW) {
        float lg[4][3]; v4u og[4][3];
#pragma unroll
        for (int r = 0; r < 4; ++r) { const int row = row0 + r * NGW < TC ? row0 + r * NGW : row0;
#pragma unroll
            for (int g = 0; g < 3; ++g) { lg[r][g] = LSE[((size_t)g * TC + row) * 8 + hd]; og[r][g] = *(const GAS v4u*)(OG + ((size_t)g * TC + row) * 512 + lane * 8); } }
#pragma unroll
        for (int r = 0; r < 4; ++r) { const int row = row0 + r * NGW; if (row >= TC) continue;
            const float mx = fmaxf(fmaxf(lg[r][0], lg[r][1]), lg[r][2]);
            float e[3]; e[0] = __builtin_amdgcn_exp2f(lg[r][0] - mx); e[1] = __builtin_amdgcn_exp2f(lg[r][1] - mx); e[2] = __builtin_amdgcn_exp2f(lg[r][2] - mx);
            const float inv = 1.0f / (e[0] + e[1] + e[2]);
            float acc[8];
#pragma unroll
            for (int i = 0; i < 8; ++i) acc[i] = 0.f;
#pragma unroll
            for (int g = 0; g < 3; ++g) { const float wg = e[g] * inv; const v4u o_ = og[r][g];
                acc[0] += wg * bflo(o_.x); acc[1] += wg * bfhi(o_.x); acc[2] += wg * bflo(o_.y); acc[3] += wg * bfhi(o_.y);
                acc[4] += wg * bflo(o_.z); acc[5] += wg * bfhi(o_.z); acc[6] += wg * bflo(o_.w); acc[7] += wg * bfhi(o_.w); }
            v4u o; o.x = cvtpk(acc[0], acc[1]); o.y = cvtpk(acc[2], acc[3]); o.z = cvtpk(acc[4], acc[5]); o.w = cvtpk(acc[6], acc[7]);
            if (P34_FP8) { v2u o8; o8.x = pk4_fp8(acc[0] * Y8_SCALE, acc[1] * Y8_SCALE, acc[2] * Y8_SCALE, acc[3] * Y8_SCALE); o8.y = pk4_fp8(acc[4] * Y8_SCALE, acc[5] * Y8_SCALE, acc[6] * Y8_SCALE, acc[7] * Y8_SCALE); *(GAS v2u*)(Y8 + (size_t)row * Y_W + lane * 8) = o8; }
            else *(GAS v4u*)(Y + (size_t)row * Y_W + lane * 8) = o; }
    }
}


struct EpiMerge {
    static constexpr bool PERM = true; static constexpr int HOOK_T = P34_FP8 ? 4 : 8;
    const bf16* Gt; bf16* MG;
    __device__ __forceinline__ void prefetch(LAS unsigned char*, const pg9::Unit&, int, int, int) const {}
    __device__ __forceinline__ void hook(f32x4 (&acc)[2][2][4][2], const pg9::Unit& u, int wr, int wc, int fr, int fq) const {
        asm volatile("" : "+v"(fr), "+v"(fq));
        const bf16* gr = Gt + ((size_t)((u.pm * 256 + wr * 64) >> 4) * 256 + u.pn * 32 + wc * 4 + fq) * 128 + fr * 8;
        v4u rv[8][2];
#pragma unroll
        for (int rg = 0; rg < 8; ++rg)
#pragma unroll
            for (int bj = 0; bj < 2; ++bj) rv[rg][bj] = *(const GAS v4u*)(gr + (size_t)((rg >> 2) * 8 + (rg & 3)) * 32768 + bj * 16 * 128);
#pragma unroll
        for (int rg = 0; rg < 8; ++rg)
#pragma unroll
            for (int bj = 0; bj < 2; ++bj) { const v4u a = rv[rg][bj];
                const f32x4 r0 = {bflo(a.x), bfhi(a.x), bflo(a.y), bfhi(a.y)}, r1 = {bflo(a.z), bfhi(a.z), bflo(a.w), bfhi(a.w)};
                acc[rg >> 2][bj][rg & 3][0] = acc[rg >> 2][bj][rg & 3][0] * r0; acc[rg >> 2][bj][rg & 3][1] = acc[rg >> 2][bj][rg & 3][1] * r1; }
    }
    __device__ __forceinline__ void operator()(const f32x4 (&acc)[2][2][4][2], const pg9::Unit& u, int ui, int wr, int wc, int fr, int fq) const {
        asm volatile("" : "+v"(fr), "+v"(fq));
        const bf16* gr = Gt + ((size_t)((u.pm * 256 + wr * 64) >> 4) * 256 + 128 + u.pn * 32 + wc * 4 + fq) * 128 + fr * 8;
        const int fr2 = (fr >> 2) + 4 * fq, fq2 = fr & 3, paddr = 4 * (16 * (fr & 3) + 4 * fq + (fr >> 2));
        bf16* mr = MG + (size_t)(u.pm * 256 + wr * 64 + fr2) * D + u.pn * 256 + wc * 32 + 8 * fq2;
        v4u gb[8][2];
#pragma unroll
        for (int rg = 0; rg < 8; ++rg)
#pragma unroll
            for (int bj = 0; bj < 2; ++bj) gb[rg][bj] = *(const GAS v4u*)(gr + (size_t)((rg >> 2) * 8 + (rg & 3)) * 32768 + bj * 16 * 128);
#pragma unroll
        for (int rg = 0; rg < 8; ++rg)
#pragma unroll
            for (int bj = 0; bj < 2; ++bj) { const v4u b = gb[rg][bj];
                const f32x4 v0 = acc[rg >> 2][bj][rg & 3][0], v1 = acc[rg >> 2][bj][rg & 3][1];
                if (P34_FP8) { constexpr float f = MG8_SCALE / (W34_SCALE * Y8_SCALE); unsigned char* m8 = (unsigned char*)MG + (size_t)(u.pm * 256 + wr * 64 + fr2) * D + u.pn * 256 + wc * 32 + 8 * fq2;
                    v2u w8; w8.x = pk4_fp8(v0[0] * bflo(b.x) * f, v0[1] * bfhi(b.x) * f, v0[2] * bflo(b.y) * f, v0[3] * bfhi(b.y) * f); w8.y = pk4_fp8(v1[0] * bflo(b.z) * f, v1[1] * bfhi(b.z) * f, v1[2] * bflo(b.w) * f, v1[3] * bfhi(b.w) * f);
                    w8.x = (unsigned)__builtin_amdgcn_ds_bpermute(paddr, (int)w8.x); w8.y = (unsigned)__builtin_amdgcn_ds_bpermute(paddr, (int)w8.y);
                    *(GAS v2u*)(m8 + (size_t)((rg >> 2) * 128 + (rg & 3) * 16) * D + bj * 128) = w8; }
                else {
                v4u w; w.x = cvtpk(v0[0] * bflo(b.x), v0[1] * bfhi(b.x)); w.y = cvtpk(v0[2] * bflo(b.y), v0[3] * bfhi(b.y));
                w.z = cvtpk(v1[0] * bflo(b.z), v1[1] * bfhi(b.z)); w.w = cvtpk(v1[2] * bflo(b.w), v1[3] * bfhi(b.w));
                w.x = (unsigned)__builtin_amdgcn_ds_bpermute(paddr, (int)w.x); w.y = (unsigned)__builtin_amdgcn_ds_bpermute(paddr, (int)w.y); w.z = (unsigned)__builtin_amdgcn_ds_bpermute(paddr, (int)w.z); w.w = (unsigned)__builtin_amdgcn_ds_bpermute(paddr, (int)w.w);
                *(GAS v4u*)(mr + (size_t)((rg >> 2) * 128 + (rg & 3) * 16) * D + bj * 128) = w; } }
    }
};
__device__ __forceinline__ void p3_merge(Frame& F) {
    unsigned char* ws = F.ws;
    pg9::DenseOrder S; S.init(T, D, F.G, (int)blockIdx.x);
    EpiMerge E{(const bf16*)(ws + WS_G), (bf16*)(ws + WS_MG)};
    constexpr int ES = P34_FP8 ? 1 : 2;
    pg9::DenseA ao{(unsigned)(Y_W * ES)}; pg9::DenseB bb{(const char*)(ws + WS_WAB), (size_t)256 * Y_W * ES};
    pg9::gemm_phase<ES>(F.lds, (const char*)(ws + WS_Y), Y_W, S, E, ao, bb);
}
struct EpiOut {
    static constexpr bool PERM = true; static constexpr int HOOK_T = -1;
    bf16* DELTA;
    __device__ __forceinline__ void hook(f32x4 (&)[2][2][4][2], const pg9::Unit&, int, int, int, int) const {}
    __device__ __forceinline__ void prefetch(LAS unsigned char*, const pg9::Unit&, int, int, int) const {}
    __device__ __forceinline__ void operator()(const f32x4 (&acc)[2][2][4][2], const pg9::Unit& u, int ui, int wr, int wc, int fr, int fq) const {
        asm volatile("" : "+v"(fr), "+v"(fq));
        const int fr2 = (fr >> 2) + 4 * fq, fq2 = fr & 3, paddr = 4 * (16 * (fr & 3) + 4 * fq + (fr >> 2));
        bf16* orow = DELTA + (size_t)(u.pm * 256 + wr * 64 + fr2) * D + u.pn * 256 + wc * 32 + 8 * fq2;
#pragma unroll
        for (int ai = 0; ai < 2; ++ai)
#pragma unroll
            for (int m = 0; m < 4; ++m)
#pragma unroll
                for (int bj = 0; bj < 2; ++bj) { constexpr float f = P34_FP8 ? 1.0f / (W34_SCALE * MG8_SCALE) : 1.0f; const f32x4 o0 = acc[ai][bj][m][0] * f, o1 = acc[ai][bj][m][1] * f;
                    v4u w; w.x = cvtpk(o0[0], o0[1]); w.y = cvtpk(o0[2], o0[3]); w.z = cvtpk(o1[0], o1[1]); w.w = cvtpk(o1[2], o1[3]);
                    w.x = (unsigned)__builtin_amdgcn_ds_bpermute(paddr, (int)w.x); w.y = (unsigned)__builtin_amdgcn_ds_bpermute(paddr, (int)w.y); w.z = (unsigned)__builtin_amdgcn_ds_bpermute(paddr, (int)w.z); w.w = (unsigned)__builtin_amdgcn_ds_bpermute(paddr, (int)w.w);
                    *(GAS v4u*)(orow + (size_t)(ai * 128 + m * 16) * D + bj * 128) = w; }
    }
};
__device__ __forceinline__ void p4_outproj(Frame& F) {
    unsigned char* ws = F.ws;
    pg9::DenseOrder S; S.init(T, D, F.G, (int)blockIdx.x);
    EpiOut E{(bf16*)((unsigned char*)F.out + DO_DELTA)};
    constexpr int ES = P34_FP8 ? 1 : 2;
    pg9::DenseA ao{(unsigned)(D * ES)}; pg9::DenseB bb{(const char*)(ws + WS_WO), (size_t)256 * D * ES};
    pg9::gemm_phase<ES>(F.lds, (const char*)(ws + WS_MG), D, S, E, ao, bb);
}

__device__ __forceinline__ void p5_route(Frame& F) {
    int tid_ = threadIdx.x; asm volatile("" : "+v"(tid_)); const int lane = tid_ & 63;
    unsigned char* ws = F.ws;
    const float* X = F.in[I_X]; const bf16* DELTA = (const bf16*)((const unsigned char*)F.out + DO_DELTA);
    bf16* X1B = (bf16*)(ws + WS_X1B); unsigned char* X1F8 = ws + WS_X1F8;
    unsigned* cnt = (unsigned*)(ws + WS_CTL) + CW_CNT;
    int* tokof = (int*)(ws + WS_TOKOF); float2* wtof = (float2*)(ws + WS_WTOF); int4* tpos = (int4*)(ws + WS_TPOS);
    const v4u* WRF = (const v4u*)(ws + WS_WRF);
    LAS v4u* wl = (LAS v4u*)F.lds;
    LAS float* sl = (LAS float*)(F.lds + 98304 + F.wave * 4096);
    const int i = lane & 15, q = lane >> 4;
    LAS unsigned* hist = (LAS unsigned*)(F.lds + LDS_MISC + 2048);
    for (int wt = F.vcu; wt < T / 128; wt += F.G) {
        const int tile = wt * NWAVES + F.wave;
        if (tid_ < 32) hist[tid_] = 0u;
        const size_t roff = (size_t)(tile * 16 + i) * D + 8 * q;
        const float* xr = X + roff; const bf16* dr = DELTA + roff;
        f32x4 a0 = {0.f, 0.f, 0.f, 0.f}, a1 = a0, a2 = a0; float ss = 0.f;
        f32x4 va[8][2]; v4u vd[8];
#pragma unroll
        for (int j = 0; j < 8; ++j) { va[j][0] = *(const GAS f32x4*)(xr + 32 * j); va[j][1] = *(const GAS f32x4*)(xr + 32 * j + 4); vd[j] = *(const GAS v4u*)(dr + 32 * j); }
#pragma unroll 1
        for (int half = 0; half < 2; ++half) {
            __syncthreads();
            { v4u t[12];
#pragma unroll
              for (int k = 0; k < 12; ++k) t[k] = WRF[half * 6144 + k * 512 + tid_];
#pragma unroll
              for (int k = 0; k < 12; ++k) wl[k * 512 + tid_] = t[k]; }
            __syncthreads();
#pragma unroll 1
            for (int sb = 0; sb < 2; ++sb) {
#pragma unroll
                for (int j = 0; j < 8; ++j) {
                    const int ksl = sb * 8 + j, ks = half * 16 + ksl;
                    const v4u dd = vd[j];
                    const f32x4 v0 = va[j][0] + (f32x4){bflo(dd.x), bfhi(dd.x), bflo(dd.y), bfhi(dd.y)}, v1 = va[j][1] + (f32x4){bflo(dd.z), bfhi(dd.z), bflo(dd.w), bfhi(dd.w)};
                    if (ks + 8 < 32) { va[j][0] = *(const GAS f32x4*)(xr + 32 * (ks + 8)); va[j][1] = *(const GAS f32x4*)(xr + 32 * (ks + 8) + 4); vd[j] = *(const GAS v4u*)(dr + 32 * (ks + 8)); }
                    ss += ((v0[0] * v0[0] + v0[1] * v0[1]) + (v0[2] * v0[2] + v0[3] * v0[3])) + ((v1[0] * v1[0] + v1[1] * v1[1]) + (v1[2] * v1[2] + v1[3] * v1[3]));
                    v4u hu; hu.x = cvtpk(v0[0], v0[1]); hu.y = cvtpk(v0[2], v0[3]); hu.z = cvtpk(v1[0], v1[1]); hu.w = cvtpk(v1[2], v1[3]);
                    v4u lu; lu.x = cvtpk(v0[0] - bflo(hu.x), v0[1] - bfhi(hu.x)); lu.y = cvtpk(v0[2] - bflo(hu.y), v0[3] - bfhi(hu.y)); lu.z = cvtpk(v1[0] - bflo(hu.z), v1[1] - bfhi(hu.z)); lu.w = cvtpk(v1[2] - bflo(hu.w), v1[3] - bfhi(hu.w));
                    *(GAS v4u*)(X1B + roff + 32 * ks) = hu;
                    if (P6_FP8) { v2u w8; w8.x = pk4_fp8(v0[0], v0[1], v0[2], v0[3]); w8.y = pk4_fp8(v1[0], v1[1], v1[2], v1[3]); *(GAS v2u*)(X1F8 + roff + 32 * ks) = w8; }
                    const bf16x8 ah = __builtin_bit_cast(bf16x8, hu), al = __builtin_bit_cast(bf16x8, lu);
#pragma unroll
                    for (int nb = 0; nb < 3; ++nb) {
                        const bf16x8 bh = __builtin_bit_cast(bf16x8, wl[((ksl * 3 + nb) * 2 + 0) * 64 + lane]), bl = __builtin_bit_cast(bf16x8, wl[((ksl * 3 + nb) * 2 + 1) * 64 + lane]);
                        f32x4 acc = nb == 0 ? a0 : (nb == 1 ? a1 : a2);
                        acc = __builtin_amdgcn_mfma_f32_16x16x32_bf16(ah, bh, acc, 0, 0, 0); acc = __builtin_amdgcn_mfma_f32_16x16x32_bf16(ah, bl, acc, 0, 0, 0); acc = __builtin_amdgcn_mfma_f32_16x16x32_bf16(al, bh, acc, 0, 0, 0);
                        if (nb == 0) a0 = acc; else if (nb == 1) a1 = acc; else a2 = acc;
                    }
                }
            }
        }
        ss += __shfl_xor(ss, 16); ss += __shfl_xor(ss, 32);
#pragma unroll
        for (int r = 0; r < 4; ++r) { sl[(4 * q + r) * 48 + i] = a0[r]; sl[(4 * q + r) * 48 + 16 + i] = a1[r]; sl[(4 * q + r) * 48 + 32 + i] = a2[r]; }
        LDS_WAIT(); asm volatile("" ::: "memory");
        int e0 = 0, e1 = 0, lp0 = 0, lp1 = 0; float w1 = 0.f, w2 = 0.f, rstd = 0.f;
        __syncthreads();
        if (lane < 16) {
            rstd = 1.0f / sqrtf(ss * (1.f / D) + RMS_EPS);
            float lg[36];
#pragma unroll
            for (int o = 0; o < 36; ++o) lg[o] = sl[lane * 48 + o] * rstd + (o < 4 ? F.in[I_BRG][o] : F.in[I_BRE][o - 4]);
            int gsel = 0; float gmax = lg[0];
#pragma unroll
            for (int k = 1; k < 4; ++k) if (lg[k] > gmax) { gmax = lg[k]; gsel = k; }
            float gden = 0.f;
#pragma unroll
            for (int k = 0; k < 4; ++k) gden += __expf(lg[k] - gmax);
            const float pg = 1.0f / gden;
            float le[8];
#pragma unroll
            for (int j = 0; j < 8; ++j) { le[j] = lg[4 + j];
#pragma unroll
                for (int gi = 1; gi < 4; ++gi) le[j] = (gsel == gi) ? lg[4 + gi * 8 + j] : le[j]; }
            int i1 = 0; float m1 = le[0];
#pragma unroll
            for (int j = 1; j < 8; ++j) if (le[j] > m1) { m1 = le[j]; i1 = j; }
            int i2 = -1; float m2 = -INFINITY;
#pragma unroll
            for (int j = 0; j < 8; ++j) if (j != i1 && le[j] > m2) { m2 = le[j]; i2 = j; }
            const float e2 = __expf(m2 - m1);
            w1 = pg / (1.0f + e2); w2 = pg * e2 / (1.0f + e2);
            e0 = gsel * 8 + i1; e1 = gsel * 8 + i2;
            lp0 = (int)__hip_atomic_fetch_add(&hist[e0], 1u, __ATOMIC_RELAXED, __HIP_MEMORY_SCOPE_WORKGROUP);
            lp1 = (int)__hip_atomic_fetch_add(&hist[e1], 1u, __ATOMIC_RELAXED, __HIP_MEMORY_SCOPE_WORKGROUP);
        }
        __syncthreads();
        if (tid_ < 32) { const unsigned n = hist[tid_]; hist[32 + tid_] = n ? atomicAdd(&cnt[64 * tid_], n) : 0u; }
        __syncthreads();
        if (lane < 16) {
            const int row = tile * 16 + lane;
            const int p0 = (int)hist[32 + e0] + lp0, p1 = (int)hist[32 + e1] + lp1;
            tokof[(size_t)e0 * T + p0] = row; wtof[(size_t)e0 * T + p0] = make_float2(w1, rstd);
            tokof[(size_t)e1 * T + p1] = row; wtof[(size_t)e1 * T + p1] = make_float2(w2, rstd);
            tpos[row] = make_int4(e0, p0, e1, p1);
        }
        __syncthreads();
    }
}

__device__ __forceinline__ void expert_tiles(Frame& F, LAS int* tb, LAS int* cn) {
    int tid_ = threadIdx.x; asm volatile("" : "+v"(tid_)); const int lane_ = tid_ & 63;
    if (tid_ < 64) {
        const unsigned* cnt = (const unsigned*)(F.ws + WS_CTL) + CW_CNT;
        const int e = lane_ & (NE - 1);
        const int c = (int)__hip_atomic_load(cnt + 64 * e, __ATOMIC_RELAXED, __HIP_MEMORY_SCOPE_AGENT);
        const int tiles = (c + 255) >> 8;
        int pre = tiles;
#pragma unroll
        for (int d = 1; d < NE; d <<= 1) { const int t = __shfl_up(pre, d); if (e >= d) pre += t; }
        if (lane_ < NE) { cn[e] = c; tb[e] = pre - tiles; if (e == NE - 1) tb[NE] = pre; }
    }
    __syncthreads();
}

struct MoeOrder { const LAS int* tb; int ncol, G, c;
    __device__ bool next(int i, pg9::Unit& u) const {
        const int L = i * G + c; if (L >= tb[NE] * ncol) return false;
        const int rt = L / ncol; int e = 0;
        for (int k = 1; k < NE; ++k) if (tb[k] <= rt) e = k;
        u.pm = rt; u.pn = L % ncol; u.e = e; return true; } };
struct GatherA { static constexpr bool GATHER = true; unsigned rowbytes; const int* tokof; const LAS int* tb; const LAS int* cn;
    __device__ __forceinline__ unsigned operator()(const pg9::Unit& u, int row) const {
        const int p = (u.pm - tb[u.e]) * 256 + row; const int tok = tokof[(size_t)u.e * T + (p < cn[u.e] ? p : 0)]; return (unsigned)tok * rowbytes; } };
struct ExpertB { const char* W; size_t ebytes, tilebytes; __device__ __forceinline__ const char* operator()(const pg9::Unit& u) const { return W + (size_t)u.e * ebytes + (size_t)u.pn * tilebytes; } };
struct EpiGateUp {
    static constexpr bool PERM = true; static constexpr int HOOK_T = -1;
    const float2* wtof; bf16* HACT; const LAS int* tb; const LAS int* cn; float ascale;
    __device__ __forceinline__ void hook(f32x4 (&)[2][2][4][2], const pg9::Unit&, int, int, int, int) const {}
    __device__ __forceinline__ void prefetch(LAS unsigned char*, const pg9::Unit&, int, int, int) const {}
    __device__ __forceinline__ void operator()(const f32x4 (&acc)[2][2][4][2], const pg9::Unit& u, int ui, int wr, int wc, int fr, int fq) const {
        asm volatile("" : "+v"(fr), "+v"(fq));
        const int r0 = wr * 64 + fr, p0 = (u.pm - tb[u.e]) * 256, ce = cn[u.e];
        const int fr2 = (fr >> 2) + 4 * fq, fq2 = fr & 3, paddr = 4 * (16 * (fr & 3) + 4 * fq + (fr >> 2)), r0s = wr * 64 + fr2;
        const float2* wp = wtof + (size_t)u.e * T;
#pragma unroll
        for (int ai = 0; ai < 2; ++ai) {
            float2 wv[4];
#pragma unroll
            for (int m = 0; m < 4; ++m) { const int p = p0 + r0 + ai * 128 + m * 16; wv[m] = p < ce ? wp[p] : make_float2(0.f, 0.f); }
#pragma unroll
            for (int m = 0; m < 4; ++m) { const int r = r0s + ai * 128 + m * 16;
                const float w = wv[m].x, rs = wv[m].y * ascale;
                bf16* orow = HACT + (size_t)(u.pm * 256 + r) * DE + u.pn * 128 + wc * 16 + 4 * fq2; unsigned char* orow8 = (unsigned char*)HACT + (size_t)(u.pm * 256 + r) * DE + u.pn * 128 + wc * 16 + 4 * fq2;
#pragma unroll
                for (int bj = 0; bj < 2; ++bj) { const f32x4 g = acc[ai][bj][m][0], uu = acc[ai][bj][m][1]; f32x4 hv;
#pragma unroll
                    for (int e = 0; e < 4; ++e) { const float gg = g[e] * rs; hv[e] = gg / (1.0f + __expf(-gg)) * (uu[e] * rs) * w; }
                    if (P6_FP8) *(GAS unsigned*)(orow8 + bj * 64) = (unsigned)__builtin_amdgcn_ds_bpermute(paddr, (int)pk4_fp8(hv[0] * H8_SCALE, hv[1] * H8_SCALE, hv[2] * H8_SCALE, hv[3] * H8_SCALE));
                    else { v2u o; o.x = (unsigned)__builtin_amdgcn_ds_bpermute(paddr, (int)cvtpk(hv[0], hv[1])); o.y = (unsigned)__builtin_amdgcn_ds_bpermute(paddr, (int)cvtpk(hv[2], hv[3])); *(GAS v2u*)(orow + bj * 64) = o; } } }
        }
    }
};
__device__ __forceinline__ void p6a_gateup(Frame& F) {
    unsigned char* ws = F.ws;
    LAS int* tb = (LAS int*)(F.lds + LDS_MISC + 1024); LAS int* cn = tb + 64;
    expert_tiles(F, tb, cn);
    MoeOrder S{tb, 2, F.G, F.vcu};
    constexpr int ES = P6_FP8 ? 1 : 2;
    GatherA ao{(unsigned)(D * ES), (const int*)(ws + WS_TOKOF), tb, cn}; ExpertB bb{(const char*)(ws + WS_WGU), (size_t)512 * D * ES, (size_t)256 * D * ES};
    EpiGateUp E{(const float2*)(ws + WS_WTOF), (bf16*)(ws + WS_HACT), tb, cn, P6_FP8 ? 1.0f / WG8_SCALE : 1.0f};
    pg9::gemm_phase<ES>(F.lds, (const char*)(ws + (P6_FP8 ? WS_X1F8 : WS_X1B)), D, S, E, ao, bb);
}
struct EpiDown {
    static constexpr bool PERM = true; static constexpr int HOOK_T = -1;
    bf16* YS; float ascale;
    __device__ __forceinline__ void hook(f32x4 (&)[2][2][4][2], const pg9::Unit&, int, int, int, int) const {}
    __device__ __forceinline__ void prefetch(LAS unsigned char*, const pg9::Unit&, int, int, int) const {}
    __device__ __forceinline__ void operator()(const f32x4 (&acc)[2][2][4][2], const pg9::Unit& u, int ui, int wr, int wc, int fr, int fq) const {
        asm volatile("" : "+v"(fr), "+v"(fq));
        const int fr2 = (fr >> 2) + 4 * fq, fq2 = fr & 3, paddr = 4 * (16 * (fr & 3) + 4 * fq + (fr >> 2));
#pragma unroll
        for (int ai = 0; ai < 2; ++ai)
#pragma unroll
            for (int m = 0; m < 4; ++m) { bf16* orow = YS + (size_t)(u.pm * 256 + wr * 64 + fr2 + ai * 128 + m * 16) * D + u.pn * 256 + wc * 32 + 8 * fq2;
#pragma unroll
                for (int bj = 0; bj < 2; ++bj) { const f32x4 v0 = acc[ai][bj][m][0] * ascale, v1 = acc[ai][bj][m][1] * ascale;
                    if (YS_FP8) { unsigned char* o8 = (unsigned char*)YS + (size_t)(u.pm * 256 + wr * 64 + fr2 + ai * 128 + m * 16) * D + u.pn * 256 + wc * 32 + 8 * fq2 + bj * 128;
                        v2u w8; w8.x = pk4_fp8(v0[0] * YS8_SCALE, v0[1] * YS8_SCALE, v0[2] * YS8_SCALE, v0[3] * YS8_SCALE); w8.y = pk4_fp8(v1[0] * YS8_SCALE, v1[1] * YS8_SCALE, v1[2] * YS8_SCALE, v1[3] * YS8_SCALE);
                        w8.x = (unsigned)__builtin_amdgcn_ds_bpermute(paddr, (int)w8.x); w8.y = (unsigned)__builtin_amdgcn_ds_bpermute(paddr, (int)w8.y); *(GAS v2u*)o8 = w8; }
                    else { v4u w; w.x = cvtpk(v0[0], v0[1]); w.y = cvtpk(v0[2], v0[3]); w.z = cvtpk(v1[0], v1[1]); w.w = cvtpk(v1[2], v1[3]);
                        w.x = (unsigned)__builtin_amdgcn_ds_bpermute(paddr, (int)w.x); w.y = (unsigned)__builtin_amdgcn_ds_bpermute(paddr, (int)w.y); w.z = (unsigned)__builtin_amdgcn_ds_bpermute(paddr, (int)w.z); w.w = (unsigned)__builtin_amdgcn_ds_bpermute(paddr, (int)w.w); *(GAS v4u*)(orow + bj * 128) = w; } } }
    }
};
__device__ __forceinline__ void p6b_down(Frame& F) {
    unsigned char* ws = F.ws;
    LAS int* tb = (LAS int*)(F.lds + LDS_MISC + 1024); LAS int* cn = tb + 64;
    MoeOrder S{tb, 4, F.G, F.vcu};
    constexpr int ES = P6_FP8 ? 1 : 2;
    pg9::DenseA ao{(unsigned)(DE * ES)}; ExpertB bb{(const char*)(ws + WS_WD), (size_t)D * DE * ES, (size_t)256 * DE * ES};
    EpiDown E{(bf16*)(ws + WS_YS), P6_FP8 ? 1.0f / (WD8_SCALE * H8_SCALE) : 1.0f};
    pg9::gemm_phase<ES>(F.lds, (const char*)(ws + WS_HACT), DE, S, E, ao, bb);
}
__device__ __forceinline__ void p7_final(Frame& F) {
    int tid_ = threadIdx.x; asm volatile("" : "+v"(tid_)); const int lane_ = tid_ & 63;
    unsigned char* ws = F.ws;
    LAS int* tb = (LAS int*)(F.lds + LDS_MISC + 1024); LAS int* cn = tb + 64;
    const bf16* YS = (const bf16*)(ws + WS_YS); const int4* tpos = (const int4*)(ws + WS_TPOS);
    float* X1 = F.out; const bf16* X1B = (const bf16*)(ws + WS_X1B);
    const int lane = lane_;
    const int gw = F.vcu * NWAVES + F.wave, NGW = F.G * NWAVES;
    f32x4 gg[4];
#pragma unroll
    for (int j = 0; j < 4; ++j) gg[j] = ((const GAS f32x4*)F.in[I_GFIN] + lane)[64 * j];
    for (int row0 = gw; row0 < T; row0 += 4 * NGW) {
        int4 tp[4];
#pragma unroll
        for (int r = 0; r < 4; ++r) { const int row = row0 + r * NGW < T ? row0 + r * NGW : row0; tp[r] = tpos[row]; }
        v2u xx[4][4]; v2u ya[4][4], yb[4][4]; unsigned za[4][4], zb[4][4];
#pragma unroll
        for (int r = 0; r < 4; ++r) { const int row = row0 + r * NGW < T ? row0 + r * NGW : row0;
            const size_t s0 = (size_t)tb[tp[r].x] * 256 + tp[r].y, s1 = (size_t)tb[tp[r].z] * 256 + tp[r].w;
            const GAS v2u* xb = (const GAS v2u*)(X1B + (size_t)row * D) + lane;
            const GAS v2u* y0 = (const GAS v2u*)(YS + s0 * D) + lane; const GAS v2u* y1 = (const GAS v2u*)(YS + s1 * D) + lane;
            const GAS unsigned* z0 = (const GAS unsigned*)((const unsigned char*)YS + s0 * D) + lane; const GAS unsigned* z1 = (const GAS unsigned*)((const unsigned char*)YS + s1 * D) + lane;
#pragma unroll
            for (int j = 0; j < 4; ++j) { xx[r][j] = xb[64 * j];
                if (YS_FP8) { za[r][j] = z0[64 * j]; zb[r][j] = z1[64 * j]; } else { ya[r][j] = y0[64 * j]; yb[r][j] = y1[64 * j]; } } }
#pragma unroll
        for (int r = 0; r < 4; ++r) { const int row = row0 + r * NGW; if (row >= T) continue;
            GAS f32x4* xr = (GAS f32x4*)(X1 + (size_t)row * D) + lane;
            f32x4 v[4]; float s = 0.f;
#pragma unroll
            for (int j = 0; j < 4; ++j) { const v2u x_ = xx[r][j]; v[j] = (f32x4){bflo(x_.x), bfhi(x_.x), bflo(x_.y), bfhi(x_.y)};
                if (YS_FP8) { const int a = (int)za[r][j], b = (int)zb[r][j]; typedef float f2_ __attribute__((ext_vector_type(2)));
                    const f2_ a0 = __builtin_amdgcn_cvt_pk_f32_fp8(a, false), a1 = __builtin_amdgcn_cvt_pk_f32_fp8(a, true), b0 = __builtin_amdgcn_cvt_pk_f32_fp8(b, false), b1 = __builtin_amdgcn_cvt_pk_f32_fp8(b, true);
                    constexpr float f = 1.0f / YS8_SCALE; v[j].x += (a0[0] + b0[0]) * f; v[j].y += (a0[1] + b0[1]) * f; v[j].z += (a1[0] + b1[0]) * f; v[j].w += (a1[1] + b1[1]) * f; }
                else { const v2u a = ya[r][j], b = yb[r][j];
                v[j].x += bflo(a.x) + bflo(b.x); v[j].y += bfhi(a.x) + bfhi(b.x); v[j].z += bflo(a.y) + bflo(b.y); v[j].w += bfhi(a.y) + bfhi(b.y); }
                s += (v[j].x * v[j].x + v[j].y * v[j].y) + (v[j].z * v[j].z + v[j].w * v[j].w); }
            const float rstd = 1.0f / sqrtf(wave_sum(s) * (1.f / D) + RMS_EPS);
#pragma unroll
            for (int j = 0; j < 4; ++j) { f32x4 o; o.x = v[j].x * rstd * gg[j].x; o.y = v[j].y * rstd * gg[j].y; o.z = v[j].z * rstd * gg[j].z; o.w = v[j].w * rstd * gg[j].w; xr[64 * j] = o; } }
    }
}

constexpr int NPHASE = 2 * NCH + 8;
__global__ void __launch_bounds__(NTHR, 2) fwd_kernel(KArgs args) {
    extern __shared__ __attribute__((aligned(16))) unsigned char lds_raw[];
    Frame F;
    F.lds = (LAS unsigned char*)lds_raw;
    F.tid = threadIdx.x; F.lane = F.tid & 63; F.wave = __builtin_amdgcn_readfirstlane(F.tid >> 6);
    F.G = gridDim.x; { const int bx = blockIdx.x; F.vcu = (F.G % 8 == 0) ? (bx % 8) * (F.G / 8) + bx / 8 : bx; }
#pragma unroll
    for (int i = 0; i < 17; ++i) F.in[i] = args.in[i];
    F.out = args.out; F.ws = args.ws;
    volatile LAS unsigned* MISC = (volatile LAS unsigned*)(F.lds + LDS_MISC);
    if (F.tid < 64) MISC[F.tid] = 0u;
    __syncthreads();
    XcdBarrier bar = xcd_barrier_post((unsigned*)(F.ws + WS_CTL) + CW_BAR + args.li * XCD_BAR_WORDS, MISC + 8);
#define IN(k) (args.ph_lo <= (k) && (k) < args.ph_hi)
#ifdef PROBE_MASK
    unsigned long long pr_acc = 0, pr_t0 = 0; const bool pr_me = (blockIdx.x == 0 && threadIdx.x == 0);
#define PR_BEGIN(k) do { if (pr_me && ((PROBE_MASK >> (k)) & 1ull)) pr_t0 = __builtin_amdgcn_s_memrealtime(); } while (0)
#define PR_END(k) do { if (pr_me && ((PROBE_MASK >> (k)) & 1ull)) pr_acc += __builtin_amdgcn_s_memrealtime() - pr_t0; } while (0)
#else
#define PR_BEGIN(k) do {} while (0)
#define PR_END(k) do {} while (0)
#endif
#define SEAM(k) do { if (IN(k) && IN((k) + 1)) xcd_barrier(bar); PR_END(k); } while (0)
    PR_BEGIN(0); if (IN(0)) p0_prologue(F);
    SEAM(0);
#pragma unroll 1
    for (int ch = 0; ch < NCH; ++ch) {
        PR_BEGIN(1 + 2 * ch);
        if (IN(1 + 2 * ch)) {
            constexpr int NWG1 = (TC / 256) * (NIN / 256);
            const int nfull = NWG1 % F.G, bx = (int)blockIdx.x;
            if (ch > 0 && nfull == 0) p2_combine(F, ch - 1, F.vcu, F.G);
            p1_inproj(F, ch);
            if (ch > 0 && nfull != 0 && bx >= nfull) p2_combine(F, ch - 1, bx - nfull, F.G - nfull);
        }
        SEAM(1 + 2 * ch);
        PR_BEGIN(2 + 2 * ch); if (IN(2 + 2 * ch)) p2_attn(F, ch);
        SEAM(2 + 2 * ch);
    }
    PR_BEGIN(2 * NCH + 1); if (IN(2 * NCH + 1)) p2_combine(F, NCH - 1, F.vcu, F.G);
    SEAM(2 * NCH + 1);
    PR_BEGIN(2 * NCH + 2); if (IN(2 * NCH + 2)) p3_merge(F);
    SEAM(2 * NCH + 2);
    PR_BEGIN(2 * NCH + 3); if (IN(2 * NCH + 3)) p4_outproj(F);
    SEAM(2 * NCH + 3);
    PR_BEGIN(2 * NCH + 4); if (IN(2 * NCH + 4)) p5_route(F);
    SEAM(2 * NCH + 4);
    PR_BEGIN(2 * NCH + 5); if (IN(2 * NCH + 5)) p6a_gateup(F);
    SEAM(2 * NCH + 5);
    PR_BEGIN(2 * NCH + 6); if (IN(2 * NCH + 6)) p6b_down(F);
    SEAM(2 * NCH + 6);
    PR_BEGIN(2 * NCH + 7); if (IN(2 * NCH + 7)) p7_final(F);
    PR_END(2 * NCH + 7);
#ifdef PROBE_MASK
    if (pr_me) { const unsigned long long t1 = __builtin_amdgcn_s_memrealtime(); while (__builtin_amdgcn_s_memrealtime() - t1 < pr_acc) __builtin_amdgcn_s_sleep(4); }
#endif
#undef IN
#undef SEAM
}

#ifndef N_LAUNCHES
#define N_LAUNCHES 1
#endif
extern "C" void kernel_launch(void* const* d_in, const int* in_sizes, int n_in, void* d_out, int out_size, void* d_ws, size_t ws_size, hipStream_t stream) {
    static int grid = 0;
    if (grid == 0) {
        if (n_in != 17 || in_sizes[0] != T * D || out_size != T * D || ws_size < WS_END) { fprintf(stderr, "kernel_launch: unexpected shapes / workspace (%d inputs, ws %zu)\n", n_in, ws_size); grid = -1; return; }
        int dev = 0, cus = 0;
        if (hipGetDevice(&dev) != hipSuccess || hipDeviceGetAttribute(&cus, hipDeviceAttributeMultiprocessorCount, dev) != hipSuccess) { grid = -1; return; }
        if (hipFuncSetAttribute((const void*)fwd_kernel, hipFuncAttributeMaxDynamicSharedMemorySize, LDS_BYTES) != hipSuccess) { fprintf(stderr, "kernel_launch: hipFuncSetAttribute failed\n"); grid = -1; return; }
        int per_cu = 0;
        if (hipOccupancyMaxActiveBlocksPerMultiprocessor(&per_cu, (const void*)fwd_kernel, NTHR, LDS_BYTES) != hipSuccess || per_cu < 1) fprintf(stderr, "kernel_launch: occupancy query says %d\n", per_cu);
        (void)hipGetLastError();
        grid = cus;
    }
    if (grid < 0) return;
    (void)hipMemsetAsync((char*)d_ws + WS_CTL, 0, N_LAUNCHES == 1 ? (size_t)(CW_BAR + XCD_BAR_WORDS) * 4 : CTL_BYTES, stream);
    KArgs a{};
    for (int i = 0; i < 17; ++i) a.in[i] = (const float*)d_in[i];
    a.out = (float*)d_out; a.ws = (unsigned char*)d_ws;
    for (int li = 0; li < N_LAUNCHES; ++li) {
        a.ph_lo = (int)((long)NPHASE * li / N_LAUNCHES); a.ph_hi = (int)((long)NPHASE * (li + 1) / N_LAUNCHES); a.li = li;
        hipLaunchKernelGGL(fwd_kernel, dim3(grid), dim3(NTHR), LDS_BYTES, stream, a);
    }
}
```

```cpp
#include <hip/hip_runtime.h>
#include <cstdint>
#include <cstdio>

#define GAS __attribute__((address_space(1)))
#define LAS __attribute__((address_space(3)))
typedef unsigned short bf16;
typedef short bf16x8 __attribute__((ext_vector_type(8)));
typedef float f32x4 __attribute__((ext_vector_type(4)));
typedef unsigned v4u __attribute__((ext_vector_type(4)));
typedef unsigned v2u __attribute__((ext_vector_type(2)));
typedef GAS unsigned gu32;

constexpr int T = 32768, D = 1024, SEQ = 4096, NIN = 7936;
constexpr int A_W = 4608, B_W = 1280, G_W = 2048, Y_W = 1536;
constexpr int NE = 32, DE = 256;
constexpr int NCH = 4, TC = T / NCH;
constexpr float QSCALE = 0.125f * 1.4426950408889634f;
constexpr float LOG2E = 1.4426950408889634f;
constexpr float RMS_EPS = 1e-6f;
#ifndef P1_FP8
#define P1_FP8 1
#endif
constexpr float W8_SCALE = P1_FP8 ? 64.0f : 0.0f, W8_INV = P1_FP8 ? 1.0f / 64.0f : 1.0f;
#ifndef P6_FP8
#define P6_FP8 1
#endif
#ifndef P34_FP8
#define P34_FP8 1
#endif
constexpr float Y8_SCALE = 16.0f, W34_SCALE = 64.0f, MG8_SCALE = 32.0f;
#ifndef YS_FP8
#define YS_FP8 1
#endif
constexpr float YS8_SCALE = 16.0f;
constexpr float WG8_SCALE = P6_FP8 ? 64.0f : 0.0f, WD8_SCALE = P6_FP8 ? 32.0f : 0.0f, H8_SCALE = 32.0f;
constexpr int NWAVES = 8, NTHR = 512;

constexpr size_t MiB = 1u << 20;
constexpr size_t WS_CTL = 0, CTL_BYTES = 1 * MiB;
constexpr size_t WS_BIASP = ((size_t)1 << 20) + 4096;
constexpr size_t WS_INVF = 1 * MiB;
constexpr size_t WS_WRF = 2 * MiB;
constexpr size_t WS_TOKOF = 3 * MiB;
constexpr size_t WS_WTOF = 7 * MiB;
constexpr size_t WS_TPOS = 15 * MiB;
constexpr size_t WS_WIN = 16 * MiB;
constexpr size_t WS_WAB = 32 * MiB;
constexpr size_t WS_WO = 35 * MiB;
constexpr size_t WS_WGU = 37 * MiB;
constexpr size_t WS_WD = 69 * MiB;
constexpr size_t WS_G = 86 * MiB;
constexpr size_t WS_Y = 214 * MiB;
constexpr size_t WS_ZA = 310 * MiB;
constexpr size_t WS_ZB = 454 * MiB;
constexpr size_t WS_END = 494 * MiB;
constexpr size_t WS_MG = WS_ZA;
constexpr size_t WS_X1B = WS_ZA + 64 * MiB;
constexpr size_t WS_X1F8 = WS_Y + 64 * MiB;
constexpr size_t WS_HACT = WS_G;
constexpr size_t WS_YS = WS_G + 36 * MiB;
constexpr size_t DO_DELTA = 0;
constexpr size_t DO_HN = 0;
constexpr size_t DO_OG = 64 * MiB;
constexpr size_t DO_LSE = 112 * MiB;
constexpr int MAXSLOT = 2 * T + NE * 256;
static_assert(WS_ZA + (size_t)TC * A_W * 2 <= WS_ZB && WS_ZB + (size_t)TC * B_W * 2 <= WS_END && WS_Y + (size_t)T * Y_W * 2 <= WS_ZA && WS_G + (size_t)T * G_W * 2 <= WS_Y, "ws map");
static_assert(WS_MG + (size_t)T * D * 2 <= WS_END && WS_HACT + (size_t)MAXSLOT * DE * 2 <= WS_YS && WS_YS + (size_t)MAXSLOT * D * 2 <= WS_ZA && WS_X1B >= WS_MG + (size_t)T * D * 2 && WS_X1B + (size_t)T * D * 2 <= WS_ZB, "ws map");
static_assert(DO_OG + (size_t)3 * TC * 512 * 2 <= DO_LSE && DO_LSE + (size_t)3 * TC * 8 * 4 <= (size_t)T * D * 4 && DO_HN + (size_t)T * D * 2 <= DO_OG, "d_out scratch map");
constexpr int CW_CNT = 1024;
constexpr int CW_BAR = 4096;
constexpr int LDS_BYTES = 147456;
constexpr int LDS_MISC = 131072;

__device__ __forceinline__ unsigned f2bf(float f) { unsigned u = __builtin_bit_cast(unsigned, f); return (u + 0x7fffu + ((u >> 16) & 1u)) >> 16; }
__device__ __forceinline__ unsigned pk4_fp8(float a, float b, float c, float d) {
    a = __builtin_amdgcn_fmed3f(a, -448.f, 448.f); b = __builtin_amdgcn_fmed3f(b, -448.f, 448.f); c = __builtin_amdgcn_fmed3f(c, -448.f, 448.f); d = __builtin_amdgcn_fmed3f(d, -448.f, 448.f);
    int w = 0; w = __builtin_amdgcn_cvt_pk_fp8_f32(a, b, w, false); w = __builtin_amdgcn_cvt_pk_fp8_f32(c, d, w, true); return (unsigned)w; }
__device__ __forceinline__ unsigned pk2(float lo, float hi) { return f2bf(lo) | (f2bf(hi) << 16); }
__device__ __forceinline__ float bf2f(unsigned b) { return __builtin_bit_cast(float, b << 16); }
__device__ __forceinline__ float bflo(unsigned u) { return __builtin_bit_cast(float, u << 16); }
__device__ __forceinline__ float bfhi(unsigned u) { return __builtin_bit_cast(float, u & 0xffff0000u); }
__device__ __forceinline__ float wave_sum(float v) {
#pragma unroll
    for (int o = 1; o < 64; o <<= 1) v += __shfl_xor(v, o);
    return v;
}
__device__ __forceinline__ float wave_max(float v) {
#pragma unroll
    for (int o = 1; o < 64; o <<= 1) v = fmaxf(v, __shfl_xor(v, o));
    return v;
}
typedef float f32x2_t __attribute__((ext_vector_type(2)));
typedef __bf16 bf16x2_t __attribute__((ext_vector_type(2)));
__device__ __forceinline__ unsigned cvtpk(float lo, float hi) { f32x2_t v = {lo, hi}; bf16x2_t b = __builtin_convertvector(v, bf16x2_t); return __builtin_bit_cast(unsigned, b); }
#ifndef WT_STORES
#define WT_STORES 0
#endif
__device__ __forceinline__ __amdgpu_buffer_rsrc_t wt_rsrc(unsigned char* base) { return __builtin_amdgcn_make_buffer_rsrc(base, 0, 0x7ffffffc, 0x00020000); }
__device__ __forceinline__ void st16(__amdgpu_buffer_rsrc_t r, unsigned char* base, void* p, v4u v) { if (WT_STORES) __builtin_amdgcn_raw_buffer_store_b128(v, r, (unsigned)((unsigned char*)p - base), 0, 16); else *(GAS v4u*)p = v; }
__device__ __forceinline__ void st8(__amdgpu_buffer_rsrc_t r, unsigned char* base, void* p, v2u v) { if (WT_STORES) __builtin_amdgcn_raw_buffer_store_b64(v, r, (unsigned)((unsigned char*)p - base), 0, 16); else *(GAS v2u*)p = v; }
#define LDS_WAIT() asm volatile("s_waitcnt lgkmcnt(0)" ::: "memory")
#define VM_WAIT() asm volatile("s_waitcnt vmcnt(0)" ::: "memory")

#define XB_TMO      128
#define XB_XCNT(j)  (256  + 64 * (j))
#define XB_XSUB(j)  (1280 + 64 * (j))
#define XB_XGEN(j)  (2304 + 64 * (j))
#define XB_TOP      3328
#define XB_TOPGEN   3392
#define XCD_BAR_WORDS 3456
#define XB_SPIN_CAP (1u << 18)
__device__ __forceinline__ unsigned xb_ld(unsigned* p)              { return __hip_atomic_load(p, __ATOMIC_RELAXED, __HIP_MEMORY_SCOPE_AGENT); }
__device__ __forceinline__ unsigned xb_add(unsigned* p, unsigned v) { return __hip_atomic_fetch_add(p, v, __ATOMIC_RELAXED, __HIP_MEMORY_SCOPE_AGENT); }
__device__ __forceinline__ unsigned xb_xcc_id() { return (unsigned)__builtin_amdgcn_s_getreg((3 << 11) | 20) & 0xFu; }
#define XB_SPIN(cond, bar) do { unsigned _sp = 0; while (cond) { __builtin_amdgcn_s_sleep(1); \
    if ((++_sp & 255u) == 0u) { if (xb_ld(&(bar)[XB_TMO])) break; if (_sp > XB_SPIN_CAP) { atomicAdd(&(bar)[XB_TMO], 1u); break; } } } } while (0)
struct XcdBarrier { unsigned* bar; unsigned x; volatile LAS unsigned* st; };
__device__ __forceinline__ XcdBarrier xcd_barrier_post(unsigned* bar, volatile LAS unsigned* st) {
    XcdBarrier b; b.bar = bar; b.x = xb_xcc_id(); b.st = st;
    if (threadIdx.x == 0) (void)xb_add(&bar[XB_XCNT(b.x)], 1u);
    return b;
}
__device__ __forceinline__ void xcd_barrier_complete(unsigned* bar, unsigned x, unsigned& nloc, unsigned& nx) {
    const unsigned G = gridDim.x * gridDim.y * gridDim.z;
    unsigned sum, cnt, mine, sp = 0u;
    for (;;) {
        sum = 0u; cnt = 0u; mine = 0u;
#pragma unroll
        for (unsigned j = 0; j < 16; ++j) { const unsigned c = xb_ld(&bar[XB_XCNT(j)]); sum += c; cnt += (c > 0u) ? 1u : 0u; mine = (j == x) ? c : mine; }
        if (sum == G) break;
        __builtin_amdgcn_s_sleep(1);
        if ((++sp & 255u) == 0u) { if (xb_ld(&bar[XB_TMO])) break; if (sp > XB_SPIN_CAP) { atomicAdd(&bar[XB_TMO], 1u); break; } }
    }
    nloc = mine > 0u ? mine : 1u; nx = cnt > 0u ? cnt : 1u;
}
__device__ __forceinline__ void xcd_barrier(const XcdBarrier& b) {
    asm volatile("s_waitcnt vmcnt(0)" ::: "memory");
    __syncthreads();
    int t_ = threadIdx.x; asm volatile("" : "+v"(t_));
    if (t_ == 0) {
        unsigned* bar = b.bar;
        __builtin_amdgcn_s_waitcnt(0);
        unsigned nloc = b.st[0], nx = b.st[1];
        if (nloc == 0u) { xcd_barrier_complete(bar, b.x, nloc, nx); b.st[0] = nloc; b.st[1] = nx; }
        const unsigned old = xb_add(&bar[XB_XSUB(b.x)], 1u);
        const unsigned gen = old / nloc;
        if (old + 1u == (gen + 1u) * nloc) {
            __builtin_amdgcn_fence(__ATOMIC_RELEASE, "agent");
            asm volatile("s_waitcnt vmcnt(0)" ::: "memory");
            const unsigned og = xb_add(&bar[XB_TOP], 1u);
            const unsigned tg = og / nx;
            if (og + 1u == (tg + 1u) * nx) xb_add(&bar[XB_TOPGEN], 1u);
            else XB_SPIN(xb_ld(&bar[XB_TOPGEN]) == tg, bar);
            __builtin_amdgcn_fence(__ATOMIC_ACQUIRE, "agent");
            xb_add(&bar[XB_XGEN(b.x)], 1u);
            asm volatile("s_waitcnt vmcnt(0)" ::: "memory");
        } else {
            XB_SPIN(xb_ld(&bar[XB_XGEN(b.x)]) == gen, bar);
            __builtin_amdgcn_fence(__ATOMIC_ACQUIRE, "agent");
            asm volatile("s_waitcnt vmcnt(0)" ::: "memory");
        }
    }
    __syncthreads();
}

struct KArgs { const float* in[17]; float* out; unsigned char* ws; int ph_lo, ph_hi, li, pad; };
struct Frame {
    LAS unsigned char* lds;
    int tid, lane, wave, vcu, G;
    const float* in[17]; float* out; unsigned char* ws;
};
enum { I_X = 0, I_WIN, I_BIN, I_SINK, I_WPA, I_WPB, I_WOUT, I_GMIX, I_GFFN, I_WRG, I_BRG, I_WRE, I_BRE, I_WEG, I_WEU, I_WED, I_GFIN };

struct TrDesc { const float* W; int N; bf16* WT; int ldo, rowbase, koff, k0, n0; bool perm; const float* kscale; float f8scale; };
__device__ __forceinline__ void tr_load(const TrDesc& d, int lane, f32x4 (&tv)[8], float (&ks)[8]) {
    const float* src = d.W + (size_t)(d.k0 + (lane >> 3)) * d.N + d.n0 + 4 * (lane & 7);
#pragma unroll
    for (int i = 0; i < 8; ++i) tv[i] = *(const GAS f32x4*)(src + (size_t)(8 * i) * d.N);
#pragma unroll
    for (int i = 0; i < 8; ++i) ks[i] = d.kscale ? d.kscale[d.k0 + 8 * i + (lane >> 3)] : 1.0f;
}
__device__ __forceinline__ void tr_finish(const TrDesc& d, LAS float* scr, int lane, const f32x4 (&tv)[8], const float (&ks)[8]) {
#pragma unroll
    for (int i = 0; i < 8; ++i) { const int kk = 8 * i + (lane >> 3); LAS float* w = scr + kk * 33 + 4 * (lane & 7);
        w[0] = tv[i][0] * ks[i]; w[1] = tv[i][1] * ks[i]; w[2] = tv[i][2] * ks[i]; w[3] = tv[i][3] * ks[i]; }
    LDS_WAIT(); asm volatile("" ::: "memory");
    const int c = lane & 7;
#pragma unroll
    for (int j = 0; j < 4; ++j) { const int n = (lane >> 3) + 8 * j; const LAS float* s = scr + (8 * c) * 33 + n;
        const int rr = d.perm ? 8 * (n >> 2) + (n & 3) : n;
        if (d.f8scale != 0.f) { const float f = d.f8scale; v2u o8; o8.x = pk4_fp8(s[0 * 33] * f, s[1 * 33] * f, s[2 * 33] * f, s[3 * 33] * f); o8.y = pk4_fp8(s[4 * 33] * f, s[5 * 33] * f, s[6 * 33] * f, s[7 * 33] * f);
            *(GAS v2u*)((unsigned char*)d.WT + (size_t)(d.rowbase + rr) * d.ldo + d.koff + d.k0 + 8 * c) = o8; }
        else { v4u o; o.x = pk2(s[0 * 33], s[1 * 33]); o.y = pk2(s[2 * 33], s[3 * 33]); o.z = pk2(s[4 * 33], s[5 * 33]); o.w = pk2(s[6 * 33], s[7 * 33]);
            *(GAS v4u*)(d.WT + (size_t)(d.rowbase + rr) * d.ldo + d.koff + d.k0 + 8 * c) = o; } }
    LDS_WAIT(); asm volatile("" ::: "memory");
}
__device__ __forceinline__ void rms_row_to_bf16(const float* xrow, const float* g, bf16* orow, int lane) {
    const GAS f32x4* xr = (const GAS f32x4*)xrow + lane; const GAS f32x4* gr = (const GAS f32x4*)g + lane;
    f32x4 v[4]; float s = 0.f;
#pragma unroll
    for (int j = 0; j < 4; ++j) { v[j] = xr[64 * j]; s += (v[j].x * v[j].x + v[j].y * v[j].y) + (v[j].z * v[j].z + v[j].w * v[j].w); }
    const float rstd = 1.0f / sqrtf(wave_sum(s) * (1.f / D) + RMS_EPS);
    GAS v2u* o8 = (GAS v2u*)orow + lane;
#pragma unroll
    for (int j = 0; j < 4; ++j) { const f32x4 gg = gr[64 * j]; v2u w; w.x = pk2(v[j].x * rstd * gg.x, v[j].y * rstd * gg.y); w.y = pk2(v[j].z * rstd * gg.z, v[j].w * rstd * gg.w); o8[64 * j] = w; }
}
__device__ __forceinline__ void p0_prologue(Frame& F) {
    int tid_ = threadIdx.x; asm volatile("" : "+v"(tid_)); const int lane_ = tid_ & 63;
    LAS float* scr = (LAS float*)(F.lds + F.wave * 16384);
    const int gw = F.vcu * NWAVES + F.wave, NGW = F.G * NWAVES;
    unsigned char* ws = F.ws;
    constexpr int I_IN = 16 * 248, I_PA = 8 * 32, I_PB = 16 * 32, I_WO = 16 * 32, I_EG = 32 * 16 * 8, I_ED = 32 * 4 * 32;
    constexpr int NITEMS = I_IN + I_PA + I_PB + I_WO + 2 * I_EG + I_ED;
    auto decode = [&](int it, TrDesc& d) {
        int r = it; d.perm = false; d.kscale = nullptr; d.f8scale = 0.f; d.koff = 0;
        if (r < I_IN) { const int kb = r / 248, nb = r % 248, n0 = 32 * nb; const bool qk = (n0 < 3072) || (n0 >= A_W && n0 < A_W + 1152);
            const bool gt_ = n0 >= A_W + B_W; const int gc = n0 - (A_W + B_W);
            d.W = F.in[I_WIN]; d.N = NIN; d.WT = (bf16*)(ws + WS_WIN); d.ldo = 1024; d.rowbase = qk ? (n0 & ~63) + ((n0 >> 5) & 1) * 4 : (gt_ ? A_W + B_W + 2 * (gc % 1024) + 4 * (gc / 1024) : n0); d.k0 = 64 * kb; d.n0 = n0; d.perm = qk || gt_; d.f8scale = W8_SCALE; return; } r -= I_IN;
        if (r < I_PA) { const int kb = r / 32, nb = r % 32; d.W = F.in[I_WPA]; d.N = 1024; d.WT = (bf16*)(ws + WS_WAB); d.ldo = 1536; d.rowbase = 32 * nb; d.k0 = 64 * kb; d.n0 = 32 * nb; if (P34_FP8) d.f8scale = W34_SCALE; return; } r -= I_PA;
        if (r < I_PB) { const int kb = r / 32, nb = r % 32; d.W = F.in[I_WPB]; d.N = 1024; d.WT = (bf16*)(ws + WS_WAB); d.ldo = 1536; d.rowbase = 32 * nb; d.koff = 512; d.k0 = 64 * kb; d.n0 = 32 * nb; if (P34_FP8) d.f8scale = W34_SCALE; return; } r -= I_PB;
        if (r < I_WO) { const int kb = r / 32, nb = r % 32; d.W = F.in[I_WOUT]; d.N = 1024; d.WT = (bf16*)(ws + WS_WO); d.ldo = 1024; d.rowbase = 32 * nb; d.k0 = 64 * kb; d.n0 = 32 * nb; if (P34_FP8) d.f8scale = W34_SCALE; return; } r -= I_WO;
        if (r < 2 * I_EG) { const int up = r >= I_EG; if (up) r -= I_EG; const int e = r / 128, q = r % 128, kb = q / 8, nb = q % 8;
            d.W = F.in[up ? I_WEU : I_WEG] + (size_t)e * 1024 * 256; d.N = 256; d.WT = (bf16*)(ws + WS_WGU) + (size_t)e * 512 * 1024; d.ldo = 1024; d.rowbase = 64 * nb + (up ? 4 : 0); d.k0 = 64 * kb; d.n0 = 32 * nb; d.perm = true; d.kscale = F.in[I_GFFN]; d.f8scale = WG8_SCALE; if (P6_FP8) d.WT = (bf16*)((unsigned char*)(ws + WS_WGU) + (size_t)e * 512 * 1024); return; } r -= 2 * I_EG;
        { const int e = r / 128, q = r % 128, kb = q / 32, nb = q % 32;
            d.W = F.in[I_WED] + (size_t)e * 256 * 1024; d.N = 1024; d.WT = (bf16*)(ws + WS_WD) + (size_t)e * 1024 * 256; d.ldo = 256; d.rowbase = 32 * nb; d.k0 = 64 * kb; d.n0 = 32 * nb; d.f8scale = WD8_SCALE; if (P6_FP8) d.WT = (bf16*)((unsigned char*)(ws + WS_WD) + (size_t)e * 1024 * 256); }
    };
    {
        int it = gw; TrDesc dc, dn; f32x4 tc[8], tn[8]; float kc[8], kn[8];
        bool hc = it < NITEMS; if (hc) { decode(it, dc); tr_load(dc, lane_, tc, kc); }
        while (hc) {
            it += NGW; const bool hn = it < NITEMS;
            if (hn) { decode(it, dn); tr_load(dn, lane_, tn, kn); }
            tr_finish(dc, scr, lane_, tc, kc);
            hc = hn; dc = dn;
#pragma unroll
            for (int i = 0; i < 8; ++i) { tc[i] = tn[i]; kc[i] = kn[i]; }
        }
    }
    f32x4 gmx[4];
#pragma unroll
    for (int j = 0; j < 4; ++j) gmx[j] = ((const GAS f32x4*)F.in[I_GMIX] + lane_)[64 * j];
    for (int m = gw; m < T; m += 4 * NGW) {
        f32x4 v[4][4]; float ss[4];
#pragma unroll
        for (int r = 0; r < 4; ++r) { const int mr = (m + r * NGW < T) ? m + r * NGW : m; const GAS f32x4* xr = (const GAS f32x4*)(F.in[I_X] + (size_t)mr * D) + lane_;
#pragma unroll
            for (int j = 0; j < 4; ++j) v[r][j] = xr[64 * j]; }
#pragma unroll
        for (int r = 0; r < 4; ++r) { float a = 0.f;
#pragma unroll
            for (int j = 0; j < 4; ++j) a += (v[r][j].x * v[r][j].x + v[r][j].y * v[r][j].y) + (v[r][j].z * v[r][j].z + v[r][j].w * v[r][j].w);
            ss[r] = 1.0f / sqrtf(wave_sum(a) * (1.f / D) + RMS_EPS); }
#pragma unroll
        for (int r = 0; r < 4; ++r) { if (m + r * NGW >= T) continue; GAS unsigned* o4 = (GAS unsigned*)((unsigned char*)F.out + DO_HN + (size_t)(m + r * NGW) * D) + lane_;
#pragma unroll
            for (int j = 0; j < 4; ++j) { const f32x4 gg = gmx[j];
                if (P1_FP8) o4[64 * j] = pk4_fp8(v[r][j].x * ss[r] * gg.x, v[r][j].y * ss[r] * gg.y, v[r][j].z * ss[r] * gg.z, v[r][j].w * ss[r] * gg.w);
                else { v2u w; w.x = cvtpk(v[r][j].x * ss[r] * gg.x, v[r][j].y * ss[r] * gg.y); w.y = cvtpk(v[r][j].z * ss[r] * gg.z, v[r][j].w * ss[r] * gg.w); ((GAS v2u*)((unsigned char*)F.out + DO_HN + (size_t)(m + r * NGW) * D * 2) + lane_)[64 * j] = w; } } }
    }
    const int gt = F.vcu * NTHR + tid_, NGT = F.G * NTHR;
    if (gt < 32) ((float*)(ws + WS_INVF))[gt] = (float)exp2(-(double)gt * (13.287712379549449 / 32.0));
    for (int c = gt; c < NIN; c += NGT) {
        int s = c; const int e = c & 7;
        if (c < 3072 || (c >= A_W && c < A_W + 1152)) s = (c & ~63) + 4 * ((c & 63) >> 3) + (e < 4 ? e : 28 + e);
        else if (c >= A_W + B_W) s = A_W + B_W + 4 * ((c - A_W - B_W) >> 3) + (e < 4 ? e : 1020 + e);
        ((float*)(ws + WS_BIASP))[c] = F.in[I_BIN][s];
    }
    for (int i = gt; i < 32 * 3 * 64; i += NGT) {
        const int ln = i & 63, nb = (i >> 6) % 3, ks = i / 192;
        const int n = 16 * nb + (ln & 15);
        float hi[8], lo[8];
#pragma unroll
        for (int e = 0; e < 8; ++e) { const int k = 32 * ks + 8 * (ln >> 4) + e; float v = 0.f;
            if (n < 4) v = F.in[I_WRG][k * 4 + n]; else if (n < 36) v = F.in[I_WRE][k * 32 + (n - 4)];
            v *= F.in[I_GFFN][k]; hi[e] = bf2f(f2bf(v)); lo[e] = v - hi[e]; }
        v4u h, l; h.x = pk2(hi[0], hi[1]); h.y = pk2(hi[2], hi[3]); h.z = pk2(hi[4], hi[5]); h.w = pk2(hi[6], hi[7]);
        l.x = pk2(lo[0], lo[1]); l.y = pk2(lo[2], lo[3]); l.z = pk2(lo[4], lo[5]); l.w = pk2(lo[6], lo[7]);
        ((v4u*)(ws + WS_WRF))[((ks * 3 + nb) * 2 + 0) * 64 + ln] = h; ((v4u*)(ws + WS_WRF))[((ks * 3 + nb) * 2 + 1) * 64 + ln] = l;
    }
}

namespace pg8 {
#define PG8_LAS __attribute__((address_space(3)))
typedef unsigned short bf16_t;
typedef short bf16x8 __attribute__((ext_vector_type(8)));
typedef float f32x4 __attribute__((ext_vector_type(4)));
typedef unsigned u32x4 __attribute__((ext_vector_type(4)));
constexpr int BM = 256, BK = 64, HALF = 128, HTB = HALF * BK * 2  , STAGE_BYTES = 8 * HTB, NXCD = 8, WGM = 8;

__host__ __device__ __forceinline__ int lds_byte(int r, int c) { const int st = (r >> 4) * 2 + (c >> 5), rr = r & 15, cc = c & 31, ob = rr * 64 + cc * 2; return st * 1024 + (ob ^ (((ob >> 9) & 1) << 5)); }
__host__ __device__ __forceinline__ void stage_rc(int b, int& R, int& C) { const int st = b / 1024, sb = b % 1024, swz = sb ^ (((sb >> 9) & 1) << 5); R = (st >> 1) * 16 + swz / 64; C = (st & 1) * 32 + (swz % 64) / 2; }
__host__ __device__ __forceinline__ int perm32(int rho) { const int n = rho >> 4, i = rho & 15; return 8 * (i >> 2) + 4 * n + (i & 3); }

struct Unit { int pm, pn; };
struct Gemm { const bf16_t* A; const bf16_t* Bt; int M, N, K; };

struct StaticOrder {
    int nM, nN, nwg, G, c;
    __host__ __device__ void init(int M, int N, int G_, int c_) { nM = M / BM; nN = N / BM; nwg = nM * nN; G = G_; c = c_; }
    __host__ __device__ bool next(int i, Unit& u) const {
        const long L = (long)i * G + c; if (L >= nwg) return false;
        int wgid = (int)L; { const int q = nwg / NXCD, r = nwg % NXCD, xcd = wgid % NXCD, off = wgid / NXCD; wgid = (xcd < r ? xcd * (q + 1) : r * (q + 1) + (xcd - r) * q) + off; }
        const int nig = WGM * nN, gid = wgid / nig, fm = gid * WGM, gsz = (nM - fm) < WGM ? (nM - fm) : WGM;
        u.pm = fm + ((wgid % nig) % gsz); u.pn = (wgid % nig) / gsz; return true;
    }
    __device__ __forceinline__ void a_ready(const Unit&) const {}
    __device__ __forceinline__ void done(const Unit&) const {}
};
}


namespace pg9 {
using pg8::BM; using pg8::BK; using pg8::HALF; using pg8::HTB; using pg8::lds_byte; using pg8::stage_rc; using pg8::perm32;
struct Unit { int pm, pn, e; };
typedef int v8i_t __attribute__((ext_vector_type(8)));
typedef int v4i_t __attribute__((ext_vector_type(4)));
template <int ESZ, class Epi, class Sched, class AOff, class BBase>
__device__ __forceinline__ void gemm_phase(LAS unsigned char* lds, const char* Abase, int K, const Sched& S, const Epi& E, const AOff& aoffn, const BBase& bbase) {
    int tid_ = threadIdx.x; asm volatile("" : "+v"(tid_));
    const int tid = tid_, wid = __builtin_amdgcn_readfirstlane(tid >> 6), lane = tid & 63, wr = wid >> 2, wc = wid & 3, fr = lane & 15, fq = lane >> 4;
    const int nt = K * ESZ / (BK * 2);
    int Rr[2], Cc[2]; unsigned voffB[2];
#pragma unroll
    for (int i = 0; i < 2; ++i) { int R, C; stage_rc(tid * 16 + i * 8192, R, C); const int Rb = Epi::PERM ? ((R & ~31) + perm32(R & 31)) : R; Rr[i] = R; Cc[i] = C; voffB[i] = (unsigned)(Rb * K * ESZ + C * 2); }
    const size_t kstep = (size_t)(BK * 2);
    const size_t hstep = (size_t)HALF * K * ESZ;
    const unsigned ldsw = (unsigned)wid * 1024u;
    const int aoff = lds_byte(wr * 64 + fr, fq * 8), boff = lds_byte(wc * 32 + fr, fq * 8);
#define PG9_SA(b, h) (((b) * 2 + (h)) * HTB)
#define PG9_SB(b, h) ((4 + (b) * 2 + (h)) * HTB)
#define PG9_STAGE(bufoff, gbase, voff) do { _Pragma("unroll") for (int _i = 0; _i < 2; ++_i) \
        __builtin_amdgcn_global_load_lds((const unsigned*)((const char*)(gbase) + (voff)[_i]), (LAS unsigned*)(lds + (bufoff) + ldsw + _i * 8192), 16, 0, 0); } while (0)
#define PG9_LDA(dst, b, h) do { _Pragma("unroll") for (int m = 0; m < 4; ++m) { dst[m].lo = *(const LAS v4i_t*)(lds + PG9_SA(b, h) + aoff + m * 2048); dst[m].hi = *(const LAS v4i_t*)(lds + PG9_SA(b, h) + aoff + m * 2048 + 1024); } } while (0)
#define PG9_LDB(dst, b, h) do { _Pragma("unroll") for (int n = 0; n < 2; ++n) { dst[n].lo = *(const LAS v4i_t*)(lds + PG9_SB(b, h) + boff + n * 2048); dst[n].hi = *(const LAS v4i_t*)(lds + PG9_SB(b, h) + boff + n * 2048 + 1024); } } while (0)
#define PG9_HALF(v, o) __builtin_bit_cast(bf16x8, __builtin_shufflevector((v), (v), (o), (o) + 1, (o) + 2, (o) + 3))
#define PG9_MMA(ai, bj, At, Bt) do { __builtin_amdgcn_s_setprio(1); _Pragma("unroll") for (int m = 0; m < 4; ++m) _Pragma("unroll") for (int n = 0; n < 2; ++n) { \
        if (ESZ == 2) { acc[ai][bj][m][n] = __builtin_amdgcn_mfma_f32_16x16x32_bf16(PG9_HALF(Bt[n], 0), PG9_HALF(At[m], 0), acc[ai][bj][m][n], 0, 0, 0); \
                        acc[ai][bj][m][n] = __builtin_amdgcn_mfma_f32_16x16x32_bf16(PG9_HALF(Bt[n], 4), PG9_HALF(At[m], 4), acc[ai][bj][m][n], 0, 0, 0); } \
        else { asm volatile("v_mfma_scale_f32_16x16x128_f8f6f4 %0, %1, %2, %0, %3, %3 op_sel_hi:[0,0,0]" : "+v"(acc[ai][bj][m][n]) : "v"(Bt[n]), "v"(At[m]), "v"(one8)); } } \
        __builtin_amdgcn_s_setprio(0); } while (0)
#define PG9_WAIT_V(n) asm volatile("s_waitcnt vmcnt(" #n ")" ::: "memory")
#define PG9_WAIT_L(n) asm volatile("s_waitcnt lgkmcnt(" #n ")" ::: "memory")
#define PG9_BAR __builtin_amdgcn_s_barrier()
#define PG9_SCHED __builtin_amdgcn_sched_barrier(0)
#define PG9_VA(dst, u) do { _Pragma("unroll") for (int _h = 0; _h < 2; ++_h) _Pragma("unroll") for (int _i = 0; _i < 2; ++_i) dst[_h][_i] = aoffn((u), _h * HALF + Rr[_i]) + (unsigned)(Cc[_i] * 2); } while (0)
    constexpr bool GATHER = AOff::GATHER;
    const size_t hstepA = (size_t)HALF * aoffn.rowbytes;
    unsigned voffA[2];
#pragma unroll
    for (int i = 0; i < 2; ++i) voffA[i] = (unsigned)Rr[i] * aoffn.rowbytes + (unsigned)(Cc[i] * 2);
#define PG9_STAGE_A(bufoff, h, koff, nx) do { if (GATHER) { PG9_STAGE(bufoff, Abase + (koff), ((nx) ? nvA[h] : cvA[h])); } else { PG9_STAGE(bufoff, ((nx) ? nAu : cAu) + (h) * hstepA + (koff), voffA); } } while (0)
    Unit cur, nxt; int ui = 0;
    if (!S.next(0, cur)) return;
    f32x4 acc[2][2][4][2];
#pragma unroll
    for (int a = 0; a < 2; ++a)
#pragma unroll
        for (int b = 0; b < 2; ++b)
#pragma unroll
            for (int m = 0; m < 4; ++m)
#pragma unroll
                for (int n = 0; n < 2; ++n) acc[a][b][m][n] = (f32x4){0.f, 0.f, 0.f, 0.f};
    int one8 = 0x7f7f7f7f; asm volatile("" : "+v"(one8));
    v8i_t At[4], B0[2], B1[2];
    unsigned cvA[2][2], nvA[2][2];
    if (GATHER) { PG9_VA(cvA, cur); }
    const char* cAu = GATHER ? Abase : Abase + (size_t)aoffn(cur, 0); const char* nAu = cAu;
    const char* cB = bbase(cur);
    E.prefetch(lds, cur, 0, wid, lane);
    PG9_STAGE(PG9_SB(0, 0), cB, voffB); PG9_STAGE(PG9_SB(0, 1), cB + hstep, voffB); PG9_STAGE_A(PG9_SA(0, 0), 0, 0, false); PG9_STAGE_A(PG9_SA(0, 1), 1, 0, false);
    if (wr == 1) PG9_BAR;
    PG9_WAIT_V(2); PG9_BAR;
    PG9_STAGE(PG9_SB(1, 0), cB + kstep, voffB); PG9_STAGE_A(PG9_SA(1, 0), 0, kstep, false); PG9_STAGE(PG9_SB(1, 1), cB + hstep + kstep, voffB);
    PG9_WAIT_V(6); PG9_BAR;
    for (;;) {
        const bool has_next = S.next(ui + 1, nxt);
        if (GATHER) {
            if (has_next) { unsigned o4[4]; aoffn.rows4(nxt, Rr[0], Rr[1], HALF + Rr[0], HALF + Rr[1], o4);
                nvA[0][0] = o4[0] + (unsigned)(Cc[0] * 2); nvA[0][1] = o4[1] + (unsigned)(Cc[1] * 2); nvA[1][0] = o4[2] + (unsigned)(Cc[0] * 2); nvA[1][1] = o4[3] + (unsigned)(Cc[1] * 2);
            } else {
#pragma unroll
                for (int _h = 0; _h < 2; ++_h)
#pragma unroll
                    for (int _i = 0; _i < 2; ++_i) nvA[_h][_i] = cvA[_h][_i]; }
        } else nAu = has_next ? Abase + (size_t)aoffn(nxt, 0) : cAu;
        const char* nB = has_next ? bbase(nxt) : cB;
#pragma unroll 1
        for (int t = 0; t < nt; t += 2) {
            const bool last = (t == nt - 2);
            if (Epi::HOOK_T >= 0) { if (t == Epi::HOOK_T) E.hook(acc, cur, wr, wc, fr, fq); }
            const size_t k1 = (size_t)(t + 1) * kstep, k2 = last ? 0 : (size_t)(t + 2) * kstep, k3 = k2 + kstep;
            const char* b2 = last ? nB : cB + (size_t)(t + 2) * kstep; const char* b3 = b2 + kstep;
            PG9_LDB(B0, 0, 0); PG9_LDB(B1, 0, 1); PG9_SCHED; PG9_LDA(At, 0, 0); PG9_STAGE_A(PG9_SA(1, 1), 1, k1, false);
            PG9_WAIT_V(8); PG9_WAIT_L(0); PG9_BAR; PG9_MMA(0, 0, At, B0); PG9_MMA(0, 1, At, B1); PG9_BAR; PG9_SCHED;
            PG9_LDA(At, 0, 1); PG9_STAGE(PG9_SB(0, 0), b2, voffB); PG9_STAGE(PG9_SB(0, 1), b2 + hstep, voffB); PG9_STAGE_A(PG9_SA(0, 0), 0, k2, last);
            PG9_WAIT_V(8); PG9_WAIT_L(0); PG9_BAR; PG9_MMA(1, 0, At, B0); PG9_MMA(1, 1, At, B1); PG9_BAR; PG9_SCHED;
            PG9_LDB(B0, 1, 0); PG9_LDB(B1, 1, 1); PG9_SCHED; PG9_LDA(At, 1, 0); PG9_STAGE_A(PG9_SA(0, 1), 1, k2, last);
            PG9_WAIT_V(8); PG9_WAIT_L(0); PG9_BAR; PG9_MMA(0, 0, At, B0); PG9_MMA(0, 1, At, B1); PG9_BAR; PG9_SCHED;
            PG9_LDA(At, 1, 1); PG9_STAGE(PG9_SB(1, 0), b3, voffB); PG9_STAGE(PG9_SB(1, 1), b3 + hstep, voffB); PG9_STAGE_A(PG9_SA(1, 0), 0, k3, last);
            PG9_WAIT_V(8); PG9_WAIT_L(0); PG9_BAR; PG9_MMA(1, 0, At, B0); PG9_MMA(1, 1, At, B1); PG9_BAR; PG9_SCHED;
        }
        if (wr == 0) PG9_BAR;
        if (ESZ == 1) asm volatile("s_nop 15\n\ts_nop 15" ::: "memory");
        E(acc, cur, ui, wr, wc, fr, fq);
        if (!has_next) break;
#pragma unroll
        for (int a = 0; a < 2; ++a)
#pragma unroll
            for (int b = 0; b < 2; ++b)
#pragma unroll
                for (int m = 0; m < 4; ++m)
#pragma unroll
                    for (int n = 0; n < 2; ++n) acc[a][b][m][n] = (f32x4){0.f, 0.f, 0.f, 0.f};
        cur = nxt; cB = nB; cAu = nAu; ++ui;
        E.prefetch(lds, cur, ui, wid, lane);
        if (GATHER) {
#pragma unroll
            for (int _h = 0; _h < 2; ++_h)
#pragma unroll
                for (int _i = 0; _i < 2; ++_i) cvA[_h][_i] = nvA[_h][_i]; }
        if (wr == 1) PG9_BAR;
    }
    PG9_WAIT_V(0);
    PG9_BAR;
#undef PG9_SA
#undef PG9_SB
#undef PG9_STAGE
#undef PG9_LDA
#undef PG9_LDB
#undef PG9_MMA
#undef PG9_HALF
#undef PG9_WAIT_V
#undef PG9_WAIT_L
#undef PG9_BAR
#undef PG9_SCHED
#undef PG9_VA
#undef PG9_STAGE_A
}
struct DenseOrder { pg8::StaticOrder so;
    __device__ void init(int M, int N, int G, int c) { so.init(M, N, G, c); }
    __device__ bool next(int i, Unit& u) const { pg8::Unit v; if (!so.next(i, v)) return false; u.pm = v.pm; u.pn = v.pn; u.e = 0; return true; } };
struct DenseA { static constexpr bool GATHER = false; unsigned rowbytes; __device__ __forceinline__ unsigned operator()(const Unit& u, int row) const { return (unsigned)(u.pm * 256 + row) * rowbytes; }
    __device__ __forceinline__ void rows4(const Unit&, int, int, int, int, unsigned (&)[4]) const {} };
struct DenseB { const char* Bt; size_t tilebytes; __device__ __forceinline__ const char* operator()(const Unit& u) const { return Bt + (size_t)u.pn * tilebytes; } };
}

struct EpiInproj {
    static constexpr bool PERM = true; static constexpr int HOOK_T = -1;
    bf16* ZA; bf16* ZB; bf16* Gt; const float* biasP; LAS unsigned char* ldsb;
    __device__ __forceinline__ void hook(f32x4 (&)[2][2][4][2], const pg9::Unit&, int, int, int, int) const {}
    __device__ __forceinline__ void prefetch(LAS unsigned char* lds, const pg9::Unit& u, int ui, int wid, int lane) const {
        if (wid == 0) __builtin_amdgcn_global_load_lds((const unsigned*)(biasP + u.pn * 256 + lane * 4), (LAS unsigned*)(lds + LDS_MISC + 4096 + (ui & 1) * 1024), 16, 0, 0);
    }
    __device__ __forceinline__ void operator()(const f32x4 (&acc)[2][2][4][2], const pg9::Unit& u, int ui, int wr, int wc, int fr, int fq) const {
        asm volatile("" : "+v"(fr), "+v"(fq));
        const int row0 = u.pm * 256 + wr * 64 + fr;
        const int q = 4 * (wc & 1) + fq;
        const int fr2 = (fr >> 2) + 4 * fq, fq2 = fr & 3, paddr = 4 * (16 * (fr & 3) + 4 * fq + (fr >> 2));
        const int row0s = u.pm * 256 + wr * 64 + fr2;
        int kind[2]; bf16* dst[2]; int ldd[2]; f32x4 b0[2], b1[2];
#pragma unroll
        for (int bj = 0; bj < 2; ++bj) {
            const int colpos = u.pn * 256 + bj * 128 + wc * 32 + 8 * fq, colposs = u.pn * 256 + bj * 128 + wc * 32 + 8 * fq2, hb = u.pn * 256 + bj * 128 + (wc >> 1) * 64;
            if (hb < A_W) { const int hbi = hb >> 6; kind[bj] = hb / 1536; dst[bj] = ZA + (size_t)hbi * (TC * 64) + (colposs - hb); ldd[bj] = 2 * ((hbi % 24) >> 3); }
            else if (hb < A_W + B_W) { const int cb = hb - A_W; kind[bj] = cb < 1024 ? 0 : (cb < 1152 ? 1 : 2); dst[bj] = ZB + (size_t)(cb >> 6) * (TC * 64) + (colposs - hb); ldd[bj] = 0; }
            else { kind[bj] = 3; const int c0 = (colpos - A_W - B_W) >> 1;
                dst[bj] = Gt + ((size_t)((u.pm * 256 + wr * 64) >> 4) * 256 + (c0 >> 3)) * 128 + fr * 8 + (c0 & 7); ldd[bj] = 0; }
            const LAS float* bs = (const LAS float*)(ldsb + LDS_MISC + 4096 + (ui & 1) * 1024) + bj * 128 + wc * 32 + 8 * fq;
            b0[bj] = *(const LAS f32x4*)bs; b1[bj] = *(const LAS f32x4*)(bs + 4);
        }
        const bool need_rope = kind[0] < 2 || kind[1] < 2;
        const f32x4 fv = *(const LAS f32x4*)(ldsb + LDS_MISC + 6144 + 16 * q);
#pragma unroll
        for (int ai = 0; ai < 2; ++ai) {
            f32x4 rc[4], rs[4];
#pragma unroll
            for (int m = 0; m < 4; ++m) { rc[m] = (f32x4){1.f, 1.f, 1.f, 1.f}; rs[m] = (f32x4){0.f, 0.f, 0.f, 0.f}; }
            if (need_rope) {
#pragma unroll
                for (int m = 0; m < 4; ++m) { const float posf = (float)((row0 + ai * 128 + m * 16) & (SEQ - 1));
#pragma unroll
                    for (int e = 0; e < 4; ++e) { const float ang = posf * fv[e]; const float pr = ang * 0.15915494f; const float er = __builtin_fmaf(ang, 0.15915494f, -pr) + ang * 6.4206382e-9f;
                        const float fr = __builtin_amdgcn_fractf(pr) + er; rc[m][e] = __builtin_amdgcn_cosf(fr); rs[m][e] = __builtin_amdgcn_sinf(fr); } }
            }
#pragma unroll
            for (int bj = 0; bj < 2; ++bj) {
                const int sh = ldd[bj], posr = row0s & (SEQ - 1), ridx = (row0s & ~(SEQ - 1)) + ((posr & ((1 << sh) - 1)) << (12 - sh)) + (posr >> sh);
                bf16* p = dst[bj] + (size_t)(ridx + ai * (128 >> sh)) * 64; const unsigned step = (unsigned)((16 >> sh) * 64);
                if (kind[bj] == 3) p = dst[bj] + (size_t)(ai * 8) * 32768;
                switch (kind[bj]) {
                    case 0: store4<0>(acc[ai][bj], b0[bj], b1[bj], rc, rs, p, step, paddr); break;
                    case 1: store4<1>(acc[ai][bj], b0[bj], b1[bj], rc, rs, p, step, paddr); break;
                    case 2: store4<2>(acc[ai][bj], b0[bj], b1[bj], rc, rs, p, step, paddr); break;
                    default: store4<3>(acc[ai][bj], b0[bj], b1[bj], rc, rs, p, step, paddr); break;
                }
            }
        }
    }
    template <int KIND> static __device__ __forceinline__ void store4(const f32x4 (&a)[4][2], const f32x4 b0, const f32x4 b1, const f32x4 (&rc)[4], const f32x4 (&rs)[4], bf16* p, const unsigned step, const int paddr) {
#pragma unroll
        for (int m = 0; m < 4; ++m) {
            f32x4 v0 = a[m][0] * W8_INV + b0, v1 = a[m][1] * W8_INV + b1;
            if (KIND < 2) {
                const f32x4 cc = rc[m], ss = rs[m];
                const f32x4 t0 = v0 * cc - v1 * ss, t1 = v1 * cc + v0 * ss;
                v0 = t0; v1 = t1;
                if (KIND == 0) { v0 = v0 * QSCALE; v1 = v1 * QSCALE; }
            }
            if (KIND == 3) {
#pragma unroll
                for (int e = 0; e < 4; ++e) { const float d0 = 1.0f + __expf(-v0[e]), d1 = 1.0f + __expf(-v1[e]); v0[e] = d1 * __builtin_amdgcn_rcpf(d0); v1[e] = __builtin_amdgcn_rcpf(d1); }
                v2u w0, w1; w0.x = cvtpk(v0[0], v0[1]); w0.y = cvtpk(v0[2], v0[3]); w1.x = cvtpk(v1[0], v1[1]); w1.y = cvtpk(v1[2], v1[3]);
                *(GAS v2u*)p = w0; *(GAS v2u*)(p + 128 * 128) = w1; p += 32768;
            } else {
                v4u w; w.x = cvtpk(v0[0], v0[1]); w.y = cvtpk(v0[2], v0[3]); w.z = cvtpk(v1[0], v1[1]); w.w = cvtpk(v1[2], v1[3]);
                w.x = (unsigned)__builtin_amdgcn_ds_bpermute(paddr, (int)w.x); w.y = (unsigned)__builtin_amdgcn_ds_bpermute(paddr, (int)w.y); w.z = (unsigned)__builtin_amdgcn_ds_bpermute(paddr, (int)w.z); w.w = (unsigned)__builtin_amdgcn_ds_bpermute(paddr, (int)w.w);
                *(GAS v4u*)p = w; p += step;
            }
        }
    }
};
__device__ __forceinline__ void p1_inproj(Frame& F, int ch) {
    unsigned char* ws = F.ws;
    pg9::DenseOrder S; S.init(TC, NIN, F.G, (int)blockIdx.x);
    EpiInproj E{(bf16*)(ws + WS_ZA), (bf16*)(ws + WS_ZB), (bf16*)(ws + WS_G) + (size_t)ch * TC * G_W, (const float*)(ws + WS_BIASP), F.lds};
    { int t_ = threadIdx.x; asm volatile("" : "+v"(t_)); if (t_ < 32) ((LAS float*)(F.lds + LDS_MISC + 6144))[t_] = ((const float*)(ws + WS_INVF))[t_]; }
    constexpr int ES = P1_FP8 ? 1 : 2;
    pg9::DenseA ao{(unsigned)(D * ES)}; pg9::DenseB bb{(const char*)(ws + WS_WIN), (size_t)256 * D * ES};
    pg9::gemm_phase<ES>(F.lds, (const char*)F.out + DO_HN + (size_t)ch * TC * D * ES, D, S, E, ao, bb);
}

typedef float f32x16 __attribute__((ext_vector_type(16)));
typedef short v4i16_t __attribute__((ext_vector_type(4)));
__device__ __forceinline__ float half_max(float v) { auto rr = __builtin_amdgcn_permlane32_swap(__float_as_uint(v), __float_as_uint(v), false, false); return fmaxf(__uint_as_float(rr[0]), __uint_as_float(rr[1])); }
__device__ __forceinline__ float half_sum(float v) { auto rr = __builtin_amdgcn_permlane32_swap(__float_as_uint(v), __float_as_uint(v), false, false); return __uint_as_float(rr[0]) + __uint_as_float(rr[1]); }
__device__ __forceinline__ float max3f(float a, float b, float c) { float r; asm("v_max3_f32 %0, %1, %2, %3" : "=v"(r) : "v"(a), "v"(b), "v"(c)); return r; }
constexpr int ATT_VOFF = 49152;

struct AUnit { const bf16 *Kw, *Vw, *Qp; size_t pitch; int kk_lo, nkeys, kb0, kstart, lo; float m0; bf16* Op; long ostr; float* Lp; int o8; };
__device__ __forceinline__ void attn_decode(Frame& F, int ch, int u, int NUA, int lane, AUnit& d) {
    unsigned char* ws = F.ws;
    const int w = F.wave, c = lane & 31, h = (lane >> 5) & 1;
    if (u < NUA) {
        const bf16* ZA = (const bf16*)(ws + WS_ZA);
        const int rt = u & 15, hh = (u >> 4) & 7, gb = u >> 7, g = gb % 3, bl = gb / 3;
        const int dsh = 2 * g, dd = 1 << dsh, tsh = 4 - dsh;
        const int r = rt >> tsh, tile = rt & ((1 << tsh) - 1), i0 = tile * 256;
        const int rowb = bl * SEQ + r;
        d.pitch = 64;
        const int sl = g * 8 + hh; const long rb = (long)bl * SEQ + ((long)r << (12 - dsh));
        d.Kw = ZA + ((long)(24 + sl) * TC + rb + (i0 - 128)) * 64; d.Vw = ZA + ((long)(48 + sl) * TC + rb + (i0 - 128)) * 64;
        const long qrow = (long)rowb + (long)dd * (i0 + 32 * w + c);
        d.Qp = ZA + ((long)sl * TC + rb + i0 + 32 * w + c) * 64;
        d.kk_lo = (i0 == 0) ? 128 : 0; d.nkeys = 384; d.kb0 = w; d.kstart = (i0 == 0) ? (w < 4 ? 4 - w : 0) : 0; d.lo = 0;
        d.m0 = -1e30f;
        d.Op = (bf16*)((unsigned char*)F.out + DO_OG) + ((size_t)g * TC + (qrow - (long)dd * c)) * 512 + hh * 64; d.ostr = (long)dd * 1024;
        d.Lp = (float*)((unsigned char*)F.out + DO_LSE) + ((size_t)g * TC + qrow) * 8 + hh;
        d.o8 = 0;
    } else {
        const int u2 = u - NUA;
        const bf16* ZB = (const bf16*)(ws + WS_ZB);
        const int blk = u2 & 127, kvh = (u2 >> 7) & 1, bl = u2 >> 8;
        const int t0 = blk * 32, rowb = bl * SEQ;
        d.pitch = 64;
        d.Kw = ZB + ((long)(16 + kvh) * TC + rowb + t0 - 128) * 64; d.Vw = ZB + ((long)(18 + kvh) * TC + rowb + t0 - 128) * 64;
        const int qh = kvh * 8 + w;
        const long qrow = (long)rowb + t0 + c;
        d.Qp = ZB + ((long)qh * TC + qrow) * 64;
        d.kk_lo = t0 < 128 ? 128 - t0 : 0; d.nkeys = 160; d.kb0 = 0; d.kstart = d.kk_lo >> 5; d.lo = 1;
        d.m0 = F.in[I_SINK][qh] * LOG2E;
        d.o8 = P34_FP8;
        d.Op = P34_FP8 ? (bf16*)(ws + WS_Y + ((size_t)ch * TC + (qrow - c)) * Y_W + 512 + qh * 64) : (bf16*)(ws + WS_Y) + ((size_t)ch * TC + (qrow - c)) * Y_W + 512 + qh * 64; d.ostr = P34_FP8 ? Y_W : 2 * Y_W;
        d.Lp = nullptr;
    }
}
__device__ __forceinline__ void attn_load(const AUnit& d, int tid, int lane, v4u (&kreg)[6], v4u (&vreg)[6], bf16x8 (&qf)[4]) {
    const int skey = tid >> 3, sch = tid & 7, h = (lane >> 5) & 1;
#pragma unroll
    for (int s4 = 0; s4 < 4; ++s4) qf[s4] = *(const GAS bf16x8*)(d.Qp + 16 * s4 + 8 * h);
#pragma unroll
    for (int p = 0; p < 6; ++p) { const int kk = 64 * p + skey;
        if (kk >= d.kk_lo && kk < d.nkeys) { kreg[p] = *(const GAS v4u*)(d.Kw + (size_t)kk * d.pitch + 8 * sch); vreg[p] = *(const GAS v4u*)(d.Vw + (size_t)kk * d.pitch + 8 * sch); } }
}
__device__ __forceinline__ void attn_write(const AUnit& d, LAS unsigned char* KL, LAS unsigned char* VL, int tid, const v4u (&kreg)[6], const v4u (&vreg)[6]) {
    const int skey = tid >> 3, sch = tid & 7;
#pragma unroll
    for (int p = 0; p < 6; ++p) { const int kk = 64 * p + skey;
        if (kk >= d.kk_lo && kk < d.nkeys) {
            *(LAS v4u*)(KL + kk * 128 + ((sch ^ ((kk >> 1) & 7)) << 4)) = kreg[p];
            *(LAS v4u*)(VL + kk * 128 + ((sch * 16) ^ (((kk >> 1) & 1) << 6))) = vreg[p]; } }
}
__device__ __forceinline__ void attn_out(const AUnit& d, LAS unsigned char* OL, int lane, const f32x16& o0, const f32x16& o1, float inv) {
    asm volatile("" : "+v"(lane));
    const int c = lane & 31, h = (lane >> 5) & 1;
    if (d.o8) {
        const float sc = inv * Y8_SCALE;
#pragma unroll
        for (int g4 = 0; g4 < 4; ++g4) {
            const int bo0 = 8 * g4 + 4 * h, bo1 = 32 + bo0;
            *(LAS unsigned*)(OL + c * 64 + (((bo0 >> 4) ^ (c & 3)) << 4) + (bo0 & 15)) = pk4_fp8(o0[4 * g4 + 0] * sc, o0[4 * g4 + 1] * sc, o0[4 * g4 + 2] * sc, o0[4 * g4 + 3] * sc);
            *(LAS unsigned*)(OL + c * 64 + (((bo1 >> 4) ^ (c & 3)) << 4) + (bo1 & 15)) = pk4_fp8(o1[4 * g4 + 0] * sc, o1[4 * g4 + 1] * sc, o1[4 * g4 + 2] * sc, o1[4 * g4 + 3] * sc);
        }
        unsigned char* ob = (unsigned char*)d.Op;
#pragma unroll
        for (int j = 0; j < 2; ++j) { const int q = (lane >> 2) + 16 * j, k = lane & 3;
            const v4u v = *(const LAS v4u*)(OL + q * 64 + ((k ^ (q & 3)) << 4)); *(GAS v4u*)(ob + (long)q * d.ostr + k * 16) = v; }
    } else {
#pragma unroll
        for (int g4 = 0; g4 < 4; ++g4) {
            v2u a, b;
            a.x = cvtpk(o0[4 * g4 + 0] * inv, o0[4 * g4 + 1] * inv); a.y = cvtpk(o0[4 * g4 + 2] * inv, o0[4 * g4 + 3] * inv);
            b.x = cvtpk(o1[4 * g4 + 0] * inv, o1[4 * g4 + 1] * inv); b.y = cvtpk(o1[4 * g4 + 2] * inv, o1[4 * g4 + 3] * inv);
            const int bo0 = 16 * g4 + 8 * h, bo1 = 64 + bo0;
            *(LAS v2u*)(OL + c * 128 + (((bo0 >> 4) ^ (c & 7)) << 4) + (bo0 & 15)) = a;
            *(LAS v2u*)(OL + c * 128 + (((bo1 >> 4) ^ (c & 7)) << 4) + (bo1 & 15)) = b;
        }
        unsigned char* ob = (unsigned char*)d.Op;
#pragma unroll
        for (int j = 0; j < 4; ++j) { const int q = (lane >> 3) + 8 * j, k = lane & 7;
            const v4u v = *(const LAS v4u*)(OL + q * 128 + ((k ^ (q & 7)) << 4)); *(GAS v4u*)(ob + (long)q * d.ostr + k * 16) = v; }
    }
}
__device__ __forceinline__ void attn_compute_edge(const AUnit& d, const LAS unsigned char* KL, const LAS unsigned char* VL, LAS unsigned char* OL, int lane, const bf16x8 (&qf)[4]) {
    const int c = lane & 31, h = (lane >> 5) & 1;
    int koff[4];
    { const int kswz = (c >> 1) & 7;
#pragma unroll
      for (int s4 = 0; s4 < 4; ++s4) koff[s4] = c * 128 + (((2 * s4 + h) ^ kswz) << 4); }
    const int vrow = 4 * h + ((lane & 15) >> 2), vsw = (lane >> 3) & 1;
    const int voff0 = vrow * 128 + ((32 * ((lane >> 4) & 1) + 8 * (lane & 3)) ^ (vsw << 6)), voff1 = voff0 ^ 64;
    const float NEG = -INFINITY;
    float m = d.m0, l = (d.lo && h == 0) ? 1.f : 0.f;
    f32x16 o0, o1;
#pragma unroll
    for (int i = 0; i < 16; ++i) { o0[i] = 0.f; o1[i] = 0.f; }
    const LAS unsigned char* kbp = KL + d.kb0 * 4096; const LAS unsigned char* vbp = VL + d.kb0 * 4096;
    const int clo = c + d.lo;
#pragma unroll
    for (int kbi = 0; kbi < 5; ++kbi) {
        if (kbi >= d.kstart) {
            f32x16 p;
#pragma unroll
            for (int i = 0; i < 16; ++i) p[i] = 0.f;
#pragma unroll
            for (int s4 = 0; s4 < 4; ++s4) { const bf16x8 kf = *(const LAS bf16x8*)(kbp + kbi * 4096 + koff[s4]); p = __builtin_amdgcn_mfma_f32_32x32x16_bf16(kf, qf[s4], p, 0, 0, 0); }
            if (kbi == 0) {
#pragma unroll
                for (int i = 0; i < 16; ++i) { const int x = (i & 3) + 8 * (i >> 2) + 4 * h; if (x < clo) p[i] = NEG; }
            }
            if (kbi == 4) {
#pragma unroll
                for (int i = 0; i < 16; ++i) { const int x = (i & 3) + 8 * (i >> 2) + 4 * h; if (x > c) p[i] = NEG; }
            }
            float mt = p[0];
#pragma unroll
            for (int i = 1; i < 16; ++i) mt = fmaxf(mt, p[i]);
            mt = half_max(mt);
            const float mn = fmaxf(m, mt), alpha = __builtin_amdgcn_exp2f(m - mn);
            m = mn;
            float ps = 0.f;
#pragma unroll
            for (int i = 0; i < 16; ++i) { p[i] = __builtin_amdgcn_exp2f(p[i] - mn); ps += p[i]; }
            l = l * alpha + ps;
#pragma unroll
            for (int i = 0; i < 16; ++i) { o0[i] *= alpha; o1[i] *= alpha; }
            bf16x8 pb[2];
#pragma unroll
            for (int s2 = 0; s2 < 2; ++s2) { v4u t; t.x = cvtpk(p[8 * s2 + 0], p[8 * s2 + 1]); t.y = cvtpk(p[8 * s2 + 2], p[8 * s2 + 3]); t.z = cvtpk(p[8 * s2 + 4], p[8 * s2 + 5]); t.w = cvtpk(p[8 * s2 + 6], p[8 * s2 + 7]); pb[s2] = __builtin_bit_cast(bf16x8, t); }
#pragma unroll
            for (int s2 = 0; s2 < 2; ++s2) {
#pragma unroll
                for (int db = 0; db < 2; ++db) {
                    const LAS unsigned char* vp = vbp + kbi * 4096 + s2 * 2048 + (db ? voff1 : voff0);
                    const v4i16_t lo = __builtin_amdgcn_ds_read_tr16_b64_v4i16((LAS v4i16_t*)vp);
                    const v4i16_t hi = __builtin_amdgcn_ds_read_tr16_b64_v4i16((LAS v4i16_t*)(vp + 1024));
                    const bf16x8 vf = {lo[0], lo[1], lo[2], lo[3], hi[0], hi[1], hi[2], hi[3]};
                    if (db == 0) o0 = __builtin_amdgcn_mfma_f32_32x32x16_bf16(vf, pb[s2], o0, 0, 0, 0);
                    else o1 = __builtin_amdgcn_mfma_f32_32x32x16_bf16(vf, pb[s2], o1, 0, 0, 0);
                }
            }
        }
    }
    const float lt = half_sum(l), inv = 1.0f / lt;
    attn_out(d, OL, lane, o0, o1, inv);
    if (d.Lp) { if (h == 0) *d.Lp = m + __builtin_amdgcn_logf(lt); }
}
__device__ __forceinline__ void attn_compute(const AUnit& d, const LAS unsigned char* KL, const LAS unsigned char* VL, LAS unsigned char* OL, int lane, const bf16x8 (&qf)[4]) {
    const int c = lane & 31, h = (lane >> 5) & 1;
    int koff[4];
    { const int kswz = (c >> 1) & 7;
#pragma unroll
      for (int s4 = 0; s4 < 4; ++s4) koff[s4] = c * 128 + (((2 * s4 + h) ^ kswz) << 4); }
    const int vrow = 4 * h + ((lane & 15) >> 2), vsw = (lane >> 3) & 1;
    const int voff0 = vrow * 128 + ((32 * ((lane >> 4) & 1) + 8 * (lane & 3)) ^ (vsw << 6)), voff1 = voff0 ^ 64;
    const float NEG = -INFINITY;
    float m = d.m0;
    f32x16 o0, o1, L;
#pragma unroll
    for (int i = 0; i < 16; ++i) { o0[i] = 0.f; o1[i] = 0.f; L[i] = 0.f; }
    v4u onesu = {0x3F803F80u, 0x3F803F80u, 0x3F803F80u, 0x3F803F80u}; asm volatile("" : "+v"(onesu));
    const bf16x8 ones = __builtin_bit_cast(bf16x8, onesu);
    const LAS unsigned char* kbp = KL + d.kb0 * 4096; const LAS unsigned char* vbp = VL + d.kb0 * 4096;
    const int clo = c + d.lo;
#pragma unroll
    for (int kbi = 0; kbi < 5; ++kbi) {
        {
            constexpr bool first_dummy = false; (void)first_dummy;
            const bool first = (kbi == 0);
            const float cinit = first ? 0.f : -m;
            f32x16 p;
#pragma unroll
            for (int i = 0; i < 16; ++i) p[i] = cinit;
#pragma unroll
            for (int s4 = 0; s4 < 4; ++s4) { const bf16x8 kf = *(const LAS bf16x8*)(kbp + kbi * 4096 + koff[s4]); p = __builtin_amdgcn_mfma_f32_32x32x16_bf16(kf, qf[s4], p, 0, 0, 0); }
            if (kbi == 0) {
#pragma unroll
                for (int i = 0; i < 16; ++i) { const int x = (i & 3) + 8 * (i >> 2) + 4 * h; p[i] = x < clo ? NEG : p[i]; }
            }
            if (kbi == 4) {
#pragma unroll
                for (int i = 0; i < 16; ++i) { const int x = (i & 3) + 8 * (i >> 2) + 4 * h; p[i] = x > c ? NEG : p[i]; }
            }
            float t0 = max3f(p[0], p[4], p[8]), t1 = max3f(p[1], p[5], p[9]), t2 = max3f(p[2], p[6], p[10]), t3 = max3f(p[3], p[7], p[11]);
            t0 = max3f(t0, p[12], p[13]); t1 = max3f(t1, p[14], p[15]);
            const float mt = half_max(max3f(max3f(t0, t1, t2), t3, t3));
            if (first) {
                const float mn = fmaxf(m, mt), l0 = d.m0 > -1e29f ? __builtin_amdgcn_exp2f(m - mn) : 0.f;
                m = mn;
#pragma unroll
                for (int i = 0; i < 16; ++i) { p[i] -= mn; L[i] = l0; }
            } else if (__any(mt > 8.0f)) {
                const float dl = fmaxf(mt, 0.f), al = __builtin_amdgcn_exp2f(-dl);
                m += dl;
#pragma unroll
                for (int i = 0; i < 16; ++i) { o0[i] *= al; o1[i] *= al; L[i] *= al; p[i] -= dl; }
            }
#pragma unroll
            for (int i = 0; i < 16; ++i) p[i] = __builtin_amdgcn_exp2f(p[i]);
            bf16x8 pb[2];
#pragma unroll
            for (int s2 = 0; s2 < 2; ++s2) { v4u t; t.x = cvtpk(p[8 * s2 + 0], p[8 * s2 + 1]); t.y = cvtpk(p[8 * s2 + 2], p[8 * s2 + 3]); t.z = cvtpk(p[8 * s2 + 4], p[8 * s2 + 5]); t.w = cvtpk(p[8 * s2 + 6], p[8 * s2 + 7]); pb[s2] = __builtin_bit_cast(bf16x8, t); }
#pragma unroll
            for (int s2 = 0; s2 < 2; ++s2) {
                L = __builtin_amdgcn_mfma_f32_32x32x16_bf16(ones, pb[s2], L, 0, 0, 0);
#pragma unroll
                for (int db = 0; db < 2; ++db) {
                    const LAS unsigned char* vp = vbp + kbi * 4096 + s2 * 2048 + (db ? voff1 : voff0);
                    const v4i16_t lo = __builtin_amdgcn_ds_read_tr16_b64_v4i16((LAS v4i16_t*)vp);
                    const v4i16_t hi = __builtin_amdgcn_ds_read_tr16_b64_v4i16((LAS v4i16_t*)(vp + 1024));
                    const bf16x8 vf = {lo[0], lo[1], lo[2], lo[3], hi[0], hi[1], hi[2], hi[3]};
                    if (db == 0) o0 = __builtin_amdgcn_mfma_f32_32x32x16_bf16(vf, pb[s2], o0, 0, 0, 0);
                    else o1 = __builtin_amdgcn_mfma_f32_32x32x16_bf16(vf, pb[s2], o1, 0, 0, 0);
                }
            }
        }
    }
    const float lt = L[0], inv = 1.0f / lt;
    attn_out(d, OL, lane, o0, o1, inv);
    if (d.Lp) { if (h == 0) *d.Lp = m + __builtin_amdgcn_logf(lt); }
}
__device__ __forceinline__ void p2_attn(Frame& F, int ch) {
    int tid_ = threadIdx.x; asm volatile("" : "+v"(tid_));
    const int tid = tid_, lane = tid & 63;
    LAS unsigned char* KL = F.lds; LAS unsigned char* VL = F.lds + ATT_VOFF; LAS unsigned char* OL = F.lds + 2 * ATT_VOFF + F.wave * 4096;
    constexpr int NUA = (TC / SEQ) * 3 * 8 * 16, NUB = (TC / SEQ) * 2 * 128, NU = NUA + NUB;
    int u = F.vcu; asm volatile("" : "+s"(u));
    if (u >= NU) return;
    AUnit cur, nxt;
    v4u kreg[6], vreg[6]; bf16x8 qn[4];
    attn_decode(F, ch, u, NUA, lane, cur);
    attn_load(cur, tid, lane, kreg, vreg, qn);
    for (;;) {
        attn_write(cur, KL, VL, tid, kreg, vreg);
        bf16x8 qf[4];
#pragma unroll
        for (int s4 = 0; s4 < 4; ++s4) qf[s4] = qn[s4];
        __syncthreads();
        const int un = u + F.G; const bool has_next = un < NU;
        if (has_next) { attn_decode(F, ch, un, NUA, lane, nxt); attn_load(nxt, tid, lane, kreg, vreg, qn); }
        if (cur.kk_lo == 0) attn_compute(cur, KL, VL, OL, lane, qf); else attn_compute_edge(cur, KL, VL, OL, lane, qf);
        __syncthreads();
        if (!has_next) break;
        cur = nxt; u = un;
    }
}
__device__ __forceinline__ void p2_combine(Frame& F, int ch, int cu, int ncu) {
    int tid_ = threadIdx.x; asm volatile("" : "+v"(tid_)); const int lane_ = tid_ & 63;
    unsigned char* ws = F.ws;
    const bf16* OG = (const bf16*)((const unsigned char*)F.out + DO_OG); const float* LSE = (const float*)((const unsigned char*)F.out + DO_LSE);
    bf16* Y = (bf16*)(ws + WS_Y) + (size_t)ch * TC * Y_W; unsigned char* Y8 = ws + WS_Y + (size_t)ch * TC * Y_W;
    const int lane = lane_, hd = lane >> 3;
    int gw_ = cu * NWAVES + F.wave; asm volatile("" : "+s"(gw_));
    const int gw = gw_, NGW = ncu * NWAVES;
    for (int row0 = gw; row0 < TC; row0 += 4 * NGW) {
        float lg[4][3]; v4u og[4][3];
#pragma unroll
        for (int r = 0; r < 4; ++r) { const int row = row0 + r * NGW < TC ? row0 + r * NGW : row0;
#pragma unroll
            for (int g = 0; g < 3; ++g) { lg[r][g] = LSE[((size_t)g * TC + row) * 8 + hd]; og[r][g] = *(const GAS v4u*)(OG + ((size_t)g * TC + row) * 512 + lane * 8); } }
#pragma unroll
        for (int r = 0; r < 4; ++r) { const int row = row0 + r * NGW; if (row >= TC) continue;
            const float mx = fmaxf(fmaxf(lg[r][0], lg[r][1]), lg[r][2]);
            float e[3]; e[0] = __builtin_amdgcn_exp2f(lg[r][0] - mx); e[1] = __builtin_amdgcn_exp2f(lg[r][1] - mx); e[2] = __builtin_amdgcn_exp2f(lg[r][2] - mx);
            const float inv = 1.0f / (e[0] + e[1] + e[2]);
            float acc[8];
#pragma unroll
            for (int i = 0; i < 8; ++i) acc[i] = 0.f;
#pragma unroll
            for (int g = 0; g < 3; ++g) { const float wg = e[g] * inv; const v4u o_ = og[r][g];
                acc[0] += wg * bflo(o_.x); acc[1] += wg * bfhi(o_.x); acc[2] += wg * bflo(o_.y); acc[3] += wg * bfhi(o_.y);
                acc[4] += wg * bflo(o_.z); acc[5] += wg * bfhi(o_.z); acc[6] += wg * bflo(o_.w); acc[7] += wg * bfhi(o_.w); }
            v4u o; o.x = cvtpk(acc[0], acc[1]); o.y = cvtpk(acc[2], acc[3]); o.z = cvtpk(acc[4], acc[5]); o.w = cvtpk(acc[6], acc[7]);
            if (P34_FP8) { v2u o8; o8.x = pk4_fp8(acc[0] * Y8_SCALE, acc[1] * Y8_SCALE, acc[2] * Y8_SCALE, acc[3] * Y8_SCALE); o8.y = pk4_fp8(acc[4] * Y8_SCALE, acc[5] * Y8_SCALE, acc[6] * Y8_SCALE, acc[7] * Y8_SCALE); *(GAS v2u*)(Y8 + (size_t)row * Y_W + lane * 8) = o8; }
            else *(GAS v4u*)(Y + (size_t)row * Y_W + lane * 8) = o; }
    }
}


struct EpiMerge {
    static constexpr bool PERM = true; static constexpr int HOOK_T = P34_FP8 ? 4 : 8;
    const bf16* Gt; bf16* MG;
    __device__ __forceinline__ void prefetch(LAS unsigned char*, const pg9::Unit&, int, int, int) const {}
    __device__ __forceinline__ void hook(f32x4 (&acc)[2][2][4][2], const pg9::Unit& u, int wr, int wc, int fr, int fq) const {
        asm volatile("" : "+v"(fr), "+v"(fq));
        const bf16* gr = Gt + ((size_t)((u.pm * 256 + wr * 64) >> 4) * 256 + u.pn * 32 + wc * 4 + fq) * 128 + fr * 8;
        v4u rv[8][2];
#pragma unroll
        for (int rg = 0; rg < 8; ++rg)
#pragma unroll
            for (int bj = 0; bj < 2; ++bj) rv[rg][bj] = *(const GAS v4u*)(gr + (size_t)((rg >> 2) * 8 + (rg & 3)) * 32768 + bj * 16 * 128);
#pragma unroll
        for (int rg = 0; rg < 8; ++rg)
#pragma unroll
            for (int bj = 0; bj < 2; ++bj) { const v4u a = rv[rg][bj];
                const f32x4 r0 = {bflo(a.x), bfhi(a.x), bflo(a.y), bfhi(a.y)}, r1 = {bflo(a.z), bfhi(a.z), bflo(a.w), bfhi(a.w)};
                acc[rg >> 2][bj][rg & 3][0] = acc[rg >> 2][bj][rg & 3][0] * r0; acc[rg >> 2][bj][rg & 3][1] = acc[rg >> 2][bj][rg & 3][1] * r1; }
    }
    __device__ __forceinline__ void operator()(const f32x4 (&acc)[2][2][4][2], const pg9::Unit& u, int ui, int wr, int wc, int fr, int fq) const {
        asm volatile("" : "+v"(fr), "+v"(fq));
        const bf16* gr = Gt + ((size_t)((u.pm * 256 + wr * 64) >> 4) * 256 + 128 + u.pn * 32 + wc * 4 + fq) * 128 + fr * 8;
        const int fr2 = (fr >> 2) + 4 * fq, fq2 = fr & 3, paddr = 4 * (16 * (fr & 3) + 4 * fq + (fr >> 2));
        bf16* mr = MG + (size_t)(u.pm * 256 + wr * 64 + fr2) * D + u.pn * 256 + wc * 32 + 8 * fq2;
        v4u gb[8][2];
#pragma unroll
        for (int rg = 0; rg < 8; ++rg)
#pragma unroll
            for (int bj = 0; bj < 2; ++bj) gb[rg][bj] = *(const GAS v4u*)(gr + (size_t)((rg >> 2) * 8 + (rg & 3)) * 32768 + bj * 16 * 128);
#pragma unroll
        for (int rg = 0; rg < 8; ++rg)
#pragma unroll
            for (int bj = 0; bj < 2; ++bj) { const v4u b = gb[rg][bj];
                const f32x4 v0 = acc[rg >> 2][bj][rg & 3][0], v1 = acc[rg >> 2][bj][rg & 3][1];
                if (P34_FP8) { constexpr float f = MG8_SCALE / (W34_SCALE * Y8_SCALE); unsigned char* m8 = (unsigned char*)MG + (size_t)(u.pm * 256 + wr * 64 + fr2) * D + u.pn * 256 + wc * 32 + 8 * fq2;
                    v2u w8; w8.x = pk4_fp8(v0[0] * bflo(b.x) * f, v0[1] * bfhi(b.x) * f, v0[2] * bflo(b.y) * f, v0[3] * bfhi(b.y) * f); w8.y = pk4_fp8(v1[0] * bflo(b.z) * f, v1[1] * bfhi(b.z) * f, v1[2] * bflo(b.w) * f, v1[3] * bfhi(b.w) * f);
                    w8.x = (unsigned)__builtin_amdgcn_ds_bpermute(paddr, (int)w8.x); w8.y = (unsigned)__builtin_amdgcn_ds_bpermute(paddr, (int)w8.y);
                    *(GAS v2u*)(m8 + (size_t)((rg >> 2) * 128 + (rg & 3) * 16) * D + bj * 128) = w8; }
                else {
                v4u w; w.x = cvtpk(v0[0] * bflo(b.x), v0[1] * bfhi(b.x)); w.y = cvtpk(v0[2] * bflo(b.y), v0[3] * bfhi(b.y));
                w.z = cvtpk(v1[0] * bflo(b.z), v1[1] * bfhi(b.z)); w.w = cvtpk(v1[2] * bflo(b.w), v1[3] * bfhi(b.w));
                w.x = (unsigned)__builtin_amdgcn_ds_bpermute(paddr, (int)w.x); w.y = (unsigned)__builtin_amdgcn_ds_bpermute(paddr, (int)w.y); w.z = (unsigned)__builtin_amdgcn_ds_bpermute(paddr, (int)w.z); w.w = (unsigned)__builtin_amdgcn_ds_bpermute(paddr, (int)w.w);
                *(GAS v4u*)(mr + (size_t)((rg >> 2) * 128 + (rg & 3) * 16) * D + bj * 128) = w; } }
    }
};
__device__ __forceinline__ void p3_merge(Frame& F) {
    unsigned char* ws = F.ws;
    pg9::DenseOrder S; S.init(T, D, F.G, (int)blockIdx.x);
    EpiMerge E{(const bf16*)(ws + WS_G), (bf16*)(ws + WS_MG)};
    constexpr int ES = P34_FP8 ? 1 : 2;
    pg9::DenseA ao{(unsigned)(Y_W * ES)}; pg9::DenseB bb{(const char*)(ws + WS_WAB), (size_t)256 * Y_W * ES};
    pg9::gemm_phase<ES>(F.lds, (const char*)(ws + WS_Y), Y_W, S, E, ao, bb);
}
struct EpiOut {
    static constexpr bool PERM = true; static constexpr int HOOK_T = -1;
    bf16* DELTA;
    __device__ __forceinline__ void hook(f32x4 (&)[2][2][4][2], const pg9::Unit&, int, int, int, int) const {}
    __device__ __forceinline__ void prefetch(LAS unsigned char*, const pg9::Unit&, int, int, int) const {}
    __device__ __forceinline__ void operator()(const f32x4 (&acc)[2][2][4][2], const pg9::Unit& u, int ui, int wr, int wc, int fr, int fq) const {
        asm volatile("" : "+v"(fr), "+v"(fq));
        const int fr2 = (fr >> 2) + 4 * fq, fq2 = fr & 3, paddr = 4 * (16 * (fr & 3) + 4 * fq + (fr >> 2));
        bf16* orow = DELTA + (size_t)(u.pm * 256 + wr * 64 + fr2) * D + u.pn * 256 + wc * 32 + 8 * fq2;
#pragma unroll
        for (int ai = 0; ai < 2; ++ai)
#pragma unroll
            for (int m = 0; m < 4; ++m)
#pragma unroll
                for (int bj = 0; bj < 2; ++bj) { constexpr float f = P34_FP8 ? 1.0f / (W34_SCALE * MG8_SCALE) : 1.0f; const f32x4 o0 = acc[ai][bj][m][0] * f, o1 = acc[ai][bj][m][1] * f;
                    v4u w; w.x = cvtpk(o0[0], o0[1]); w.y = cvtpk(o0[2], o0[3]); w.z = cvtpk(o1[0], o1[1]); w.w = cvtpk(o1[2], o1[3]);
                    w.x = (unsigned)__builtin_amdgcn_ds_bpermute(paddr, (int)w.x); w.y = (unsigned)__builtin_amdgcn_ds_bpermute(paddr, (int)w.y); w.z = (unsigned)__builtin_amdgcn_ds_bpermute(paddr, (int)w.z); w.w = (unsigned)__builtin_amdgcn_ds_bpermute(paddr, (int)w.w);
                    *(GAS v4u*)(orow + (size_t)(ai * 128 + m * 16) * D + bj * 128) = w; }
    }
};
__device__ __forceinline__ void p4_outproj(Frame& F) {
    unsigned char* ws = F.ws;
    pg9::DenseOrder S; S.init(T, D, F.G, (int)blockIdx.x);
    EpiOut E{(bf16*)((unsigned char*)F.out + DO_DELTA)};
    constexpr int ES = P34_FP8 ? 1 : 2;
    pg9::DenseA ao{(unsigned)(D * ES)}; pg9::DenseB bb{(const char*)(ws + WS_WO), (size_t)256 * D * ES};
    pg9::gemm_phase<ES>(F.lds, (const char*)(ws + WS_MG), D, S, E, ao, bb);
}

__device__ __forceinline__ void p5_route(Frame& F) {
    int tid_ = threadIdx.x; asm volatile("" : "+v"(tid_)); const int lane = tid_ & 63;
    unsigned char* ws = F.ws;
    const float* X = F.in[I_X]; const bf16* DELTA = (const bf16*)((const unsigned char*)F.out + DO_DELTA);
    bf16* X1B = (bf16*)(ws + WS_X1B); unsigned char* X1F8 = ws + WS_X1F8;
    unsigned* cnt = (unsigned*)(ws + WS_CTL) + CW_CNT;
    int* tokof = (int*)(ws + WS_TOKOF); float2* wtof = (float2*)(ws + WS_WTOF); int4* tpos = (int4*)(ws + WS_TPOS);
    const v4u* WRF = (const v4u*)(ws + WS_WRF);
    LAS v4u* wl = (LAS v4u*)F.lds;
    LAS float* sl = (LAS float*)(F.lds + 98304 + F.wave * 4096);
    const int i = lane & 15, q = lane >> 4;
    LAS unsigned* hist = (LAS unsigned*)(F.lds + LDS_MISC + 2048);
    for (int wt = F.vcu; wt < T / 128; wt += F.G) {
        const int tile = wt * NWAVES + F.wave;
        if (tid_ < 32) hist[tid_] = 0u;
        const size_t roff = (size_t)(tile * 16 + i) * D + 8 * q;
        const float* xr = X + roff; const bf16* dr = DELTA + roff;
        f32x4 a0 = {0.f, 0.f, 0.f, 0.f}, a1 = a0, a2 = a0; float ss = 0.f;
        f32x4 va[8][2]; v4u vd[8];
#pragma unroll
        for (int j = 0; j < 8; ++j) { va[j][0] = *(const GAS f32x4*)(xr + 32 * j); va[j][1] = *(const GAS f32x4*)(xr + 32 * j + 4); vd[j] = *(const GAS v4u*)(dr + 32 * j); }
#pragma unroll 1
        for (int half = 0; half < 2; ++half) {
            __syncthreads();
            { v4u t[12];
#pragma unroll
              for (int k = 0; k < 12; ++k) t[k] = WRF[half * 6144 + k * 512 + tid_];
#pragma unroll
              for (int k = 0; k < 12; ++k) wl[k * 512 + tid_] = t[k]; }
            __syncthreads();
#pragma unroll 1
            for (int sb = 0; sb < 2; ++sb) {
#pragma unroll
                for (int j = 0; j < 8; ++j) {
                    const int ksl = sb * 8 + j, ks = half * 16 + ksl;
                    const v4u dd = vd[j];
                    const f32x4 v0 = va[j][0] + (f32x4){bflo(dd.x), bfhi(dd.x), bflo(dd.y), bfhi(dd.y)}, v1 = va[j][1] + (f32x4){bflo(dd.z), bfhi(dd.z), bflo(dd.w), bfhi(dd.w)};
                    if (ks + 8 < 32) { va[j][0] = *(const GAS f32x4*)(xr + 32 * (ks + 8)); va[j][1] = *(const GAS f32x4*)(xr + 32 * (ks + 8) + 4); vd[j] = *(const GAS v4u*)(dr + 32 * (ks + 8)); }
                    ss += ((v0[0] * v0[0] + v0[1] * v0[1]) + (v0[2] * v0[2] + v0[3] * v0[3])) + ((v1[0] * v1[0] + v1[1] * v1[1]) + (v1[2] * v1[2] + v1[3] * v1[3]));
                    v4u hu; hu.x = cvtpk(v0[0], v0[1]); hu.y = cvtpk(v0[2], v0[3]); hu.z = cvtpk(v1[0], v1[1]); hu.w = cvtpk(v1[2], v1[3]);
                    v4u lu; lu.x = cvtpk(v0[0] - bflo(hu.x), v0[1] - bfhi(hu.x)); lu.y = cvtpk(v0[2] - bflo(hu.y), v0[3] - bfhi(hu.y)); lu.z = cvtpk(v1[0] - bflo(hu.z), v1[1] - bfhi(hu.z)); lu.w = cvtpk(v1[2] - bflo(hu.w), v1[3] - bfhi(hu.w));
                    *(GAS v4u*)(X1B + roff + 32 * ks) = hu;
                    if (P6_FP8) { v2u w8; w8.x = pk4_fp8(v0[0], v0[1], v0[2], v0[3]); w8.y = pk4_fp8(v1[0], v1[1], v1[2], v1[3]); *(GAS v2u*)(X1F8 + roff + 32 * ks) = w8; }
                    const bf16x8 ah = __builtin_bit_cast(bf16x8, hu), al = __builtin_bit_cast(bf16x8, lu);
#pragma unroll
                    for (int nb = 0; nb < 3; ++nb) {
                        const bf16x8 bh = __builtin_bit_cast(bf16x8, wl[((ksl * 3 + nb) * 2 + 0) * 64 + lane]), bl = __builtin_bit_cast(bf16x8, wl[((ksl * 3 + nb) * 2 + 1) * 64 + lane]);
                        f32x4 acc = nb == 0 ? a0 : (nb == 1 ? a1 : a2);
                        acc = __builtin_amdgcn_mfma_f32_16x16x32_bf16(ah, bh, acc, 0, 0, 0); acc = __builtin_amdgcn_mfma_f32_16x16x32_bf16(ah, bl, acc, 0, 0, 0); acc = __builtin_amdgcn_mfma_f32_16x16x32_bf16(al, bh, acc, 0, 0, 0);
                        if (nb == 0) a0 = acc; else if (nb == 1) a1 = acc; else a2 = acc;
                    }
                }
            }
        }
        ss += __shfl_xor(ss, 16); ss += __shfl_xor(ss, 32);
#pragma unroll
        for (int r = 0; r < 4; ++r) { sl[(4 * q + r) * 48 + i] = a0[r]; sl[(4 * q + r) * 48 + 16 + i] = a1[r]; sl[(4 * q + r) * 48 + 32 + i] = a2[r]; }
        LDS_WAIT(); asm volatile("" ::: "memory");
        int e0 = 0, e1 = 0, lp0 = 0, lp1 = 0; float w1 = 0.f, w2 = 0.f, rstd = 0.f;
        __syncthreads();
        if (lane < 16) {
            rstd = 1.0f / sqrtf(ss * (1.f / D) + RMS_EPS);
            float lg[36];
#pragma unroll
            for (int o = 0; o < 36; ++o) lg[o] = sl[lane * 48 + o] * rstd + (o < 4 ? F.in[I_BRG][o] : F.in[I_BRE][o - 4]);
            int gsel = 0; float gmax = lg[0];
#pragma unroll
            for (int k = 1; k < 4; ++k) if (lg[k] > gmax) { gmax = lg[k]; gsel = k; }
            float gden = 0.f;
#pragma unroll
            for (int k = 0; k < 4; ++k) gden += __expf(lg[k] - gmax);
            const float pg = 1.0f / gden;
            float le[8];
#pragma unroll
            for (int j = 0; j < 8; ++j) { le[j] = lg[4 + j];
#pragma unroll
                for (int gi = 1; gi < 4; ++gi) le[j] = (gsel == gi) ? lg[4 + gi * 8 + j] : le[j]; }
            int i1 = 0; float m1 = le[0];
#pragma unroll
            for (int j = 1; j < 8; ++j) if (le[j] > m1) { m1 = le[j]; i1 = j; }
            int i2 = -1; float m2 = -INFINITY;
#pragma unroll
            for (int j = 0; j < 8; ++j) if (j != i1 && le[j] > m2) { m2 = le[j]; i2 = j; }
            const float e2 = __expf(m2 - m1);
            w1 = pg / (1.0f + e2); w2 = pg * e2 / (1.0f + e2);
            e0 = gsel * 8 + i1; e1 = gsel * 8 + i2;
            lp0 = (int)__hip_atomic_fetch_add(&hist[e0], 1u, __ATOMIC_RELAXED, __HIP_MEMORY_SCOPE_WORKGROUP);
            lp1 = (int)__hip_atomic_fetch_add(&hist[e1], 1u, __ATOMIC_RELAXED, __HIP_MEMORY_SCOPE_WORKGROUP);
        }
        __syncthreads();
        if (tid_ < 32) { const unsigned n = hist[tid_]; hist[32 + tid_] = n ? atomicAdd(&cnt[64 * tid_], n) : 0u; }
        __syncthreads();
        if (lane < 16) {
            const int row = tile * 16 + lane;
            const int p0 = (int)hist[32 + e0] + lp0, p1 = (int)hist[32 + e1] + lp1;
            tokof[(size_t)e0 * T + p0] = row; wtof[(size_t)e0 * T + p0] = make_float2(w1, rstd);
            tokof[(size_t)e1 * T + p1] = row; wtof[(size_t)e1 * T + p1] = make_float2(w2, rstd);
            tpos[row] = make_int4(e0, p0, e1, p1);
        }
        __syncthreads();
    }
}

__device__ __forceinline__ void expert_tiles(Frame& F, LAS int* tb, LAS int* cn) {
    int tid_ = threadIdx.x; asm volatile("" : "+v"(tid_)); const int lane_ = tid_ & 63;
    if (tid_ < 64) {
        const unsigned* cnt = (const unsigned*)(F.ws + WS_CTL) + CW_CNT;
        const int e = lane_ & (NE - 1);
        const int c = (int)__hip_atomic_load(cnt + 64 * e, __ATOMIC_RELAXED, __HIP_MEMORY_SCOPE_AGENT);
        const int tiles = (c + 255) >> 8;
        int pre = tiles;
#pragma unroll
        for (int d = 1; d < NE; d <<= 1) { const int t = __shfl_up(pre, d); if (e >= d) pre += t; }
        if (lane_ < NE) { cn[e] = c; tb[e] = pre - tiles; if (e == NE - 1) tb[NE] = pre; }
    }
    __syncthreads();
}

struct MoeOrder { const LAS int* tb; int ncol, G, c;
    __device__ bool next(int i, pg9::Unit& u) const {
        const int L = i * G + c; if (L >= tb[NE] * ncol) return false;
        const int rt = L / ncol; int e = 0;
        for (int k = 1; k < NE; ++k) if (tb[k] <= rt) e = k;
        u.pm = rt; u.pn = L % ncol; u.e = e; return true; } };
struct GatherA { static constexpr bool GATHER = true; unsigned rowbytes; const int* tokof; const LAS int* tb; const LAS int* cn;
    __device__ __forceinline__ unsigned operator()(const pg9::Unit& u, int row) const {
        const int p = (u.pm - tb[u.e]) * 256 + row; const int tok = tokof[(size_t)u.e * T + (p < cn[u.e] ? p : 0)]; return (unsigned)tok * rowbytes; }
    __device__ __forceinline__ void rows4(const pg9::Unit& u, int r0, int r1, int r2, int r3, unsigned (&o)[4]) const {
        const int base = (u.pm - tb[u.e]) * 256, ce = cn[u.e]; const int* tp = tokof + (size_t)u.e * T;
        const int* a0 = tp + (base + r0 < ce ? base + r0 : 0); const int* a1 = tp + (base + r1 < ce ? base + r1 : 0); const int* a2 = tp + (base + r2 < ce ? base + r2 : 0); const int* a3 = tp + (base + r3 < ce ? base + r3 : 0);
        int t0, t1, t2, t3;
        asm volatile("global_load_dword %0, %4, off\n\tglobal_load_dword %1, %5, off\n\tglobal_load_dword %2, %6, off\n\tglobal_load_dword %3, %7, off\n\ts_waitcnt vmcnt(0)"
                     : "=&v"(t0), "=&v"(t1), "=&v"(t2), "=&v"(t3) : "v"(a0), "v"(a1), "v"(a2), "v"(a3) : "memory");
        o[0] = (unsigned)t0 * rowbytes; o[1] = (unsigned)t1 * rowbytes; o[2] = (unsigned)t2 * rowbytes; o[3] = (unsigned)t3 * rowbytes; } };
struct ExpertB { const char* W; size_t ebytes, tilebytes; __device__ __forceinline__ const char* operator()(const pg9::Unit& u) const { return W + (size_t)u.e * ebytes + (size_t)u.pn * tilebytes; } };
struct EpiGateUp {
    static constexpr bool PERM = true; static constexpr int HOOK_T = -1;
    const float2* wtof; bf16* HACT; const LAS int* tb; const LAS int* cn; float ascale;
    __device__ __forceinline__ void hook(f32x4 (&)[2][2][4][2], const pg9::Unit&, int, int, int, int) const {}
    __device__ __forceinline__ void prefetch(LAS unsigned char*, const pg9::Unit&, int, int, int) const {}
    __device__ __forceinline__ void operator()(const f32x4 (&acc)[2][2][4][2], const pg9::Unit& u, int ui, int wr, int wc, int fr, int fq) const {
        asm volatile("" : "+v"(fr), "+v"(fq));
        const int r0 = wr * 64 + fr, p0 = (u.pm - tb[u.e]) * 256, ce = cn[u.e];
        const int fr2 = (fr >> 2) + 4 * fq, fq2 = fr & 3, paddr = 4 * (16 * (fr & 3) + 4 * fq + (fr >> 2)), r0s = wr * 64 + fr2;
        const float2* wp = wtof + (size_t)u.e * T;
#pragma unroll
        for (int ai = 0; ai < 2; ++ai) {
            float2 wv[4];
#pragma unroll
            for (int m = 0; m < 4; ++m) { const int p = p0 + r0 + ai * 128 + m * 16; wv[m] = p < ce ? wp[p] : make_float2(0.f, 0.f); }
#pragma unroll
            for (int m = 0; m < 4; ++m) { const int r = r0s + ai * 128 + m * 16;
                const float w = wv[m].x, rs = wv[m].y * ascale;
                bf16* orow = HACT + (size_t)(u.pm * 256 + r) * DE + u.pn * 128 + wc * 16 + 4 * fq2; unsigned char* orow8 = (unsigned char*)HACT + (size_t)(u.pm * 256 + r) * DE + u.pn * 128 + wc * 16 + 4 * fq2;
#pragma unroll
                for (int bj = 0; bj < 2; ++bj) { const f32x4 g = acc[ai][bj][m][0], uu = acc[ai][bj][m][1]; f32x4 hv;
#pragma unroll
                    for (int e = 0; e < 4; ++e) { const float gg = g[e] * rs; hv[e] = gg / (1.0f + __expf(-gg)) * (uu[e] * rs) * w; }
                    if (P6_FP8) *(GAS unsigned*)(orow8 + bj * 64) = (unsigned)__builtin_amdgcn_ds_bpermute(paddr, (int)pk4_fp8(hv[0] * H8_SCALE, hv[1] * H8_SCALE, hv[2] * H8_SCALE, hv[3] * H8_SCALE));
                    else { v2u o; o.x = (unsigned)__builtin_amdgcn_ds_bpermute(paddr, (int)cvtpk(hv[0], hv[1])); o.y = (unsigned)__builtin_amdgcn_ds_bpermute(paddr, (int)cvtpk(hv[2], hv[3])); *(GAS v2u*)(orow + bj * 64) = o; } } }
        }
    }
};
__device__ __forceinline__ void p6a_gateup(Frame& F) {
    unsigned char* ws = F.ws;
    LAS int* tb = (LAS int*)(F.lds + LDS_MISC + 1024); LAS int* cn = tb + 64;
    expert_tiles(F, tb, cn);
    MoeOrder S{tb, 2, F.G, F.vcu};
    constexpr int ES = P6_FP8 ? 1 : 2;
    GatherA ao{(unsigned)(D * ES), (const int*)(ws + WS_TOKOF), tb, cn}; ExpertB bb{(const char*)(ws + WS_WGU), (size_t)512 * D * ES, (size_t)256 * D * ES};
    EpiGateUp E{(const float2*)(ws + WS_WTOF), (bf16*)(ws + WS_HACT), tb, cn, P6_FP8 ? 1.0f / WG8_SCALE : 1.0f};
    pg9::gemm_phase<ES>(F.lds, (const char*)(ws + (P6_FP8 ? WS_X1F8 : WS_X1B)), D, S, E, ao, bb);
}
struct EpiDown {
    static constexpr bool PERM = true; static constexpr int HOOK_T = -1;
    bf16* YS; float ascale;
    __device__ __forceinline__ void hook(f32x4 (&)[2][2][4][2], const pg9::Unit&, int, int, int, int) const {}
    __device__ __forceinline__ void prefetch(LAS unsigned char*, const pg9::Unit&, int, int, int) const {}
    __device__ __forceinline__ void operator()(const f32x4 (&acc)[2][2][4][2], const pg9::Unit& u, int ui, int wr, int wc, int fr, int fq) const {
        asm volatile("" : "+v"(fr), "+v"(fq));
        const int fr2 = (fr >> 2) + 4 * fq, fq2 = fr & 3, paddr = 4 * (16 * (fr & 3) + 4 * fq + (fr >> 2));
#pragma unroll
        for (int ai = 0; ai < 2; ++ai)
#pragma unroll
            for (int m = 0; m < 4; ++m) { bf16* orow = YS + (size_t)(u.pm * 256 + wr * 64 + fr2 + ai * 128 + m * 16) * D + u.pn * 256 + wc * 32 + 8 * fq2;
#pragma unroll
                for (int bj = 0; bj < 2; ++bj) { const f32x4 v0 = acc[ai][bj][m][0] * ascale, v1 = acc[ai][bj][m][1] * ascale;
                    if (YS_FP8) { unsigned char* o8 = (unsigned char*)YS + (size_t)(u.pm * 256 + wr * 64 + fr2 + ai * 128 + m * 16) * D + u.pn * 256 + wc * 32 + 8 * fq2 + bj * 128;
                        v2u w8; w8.x = pk4_fp8(v0[0] * YS8_SCALE, v0[1] * YS8_SCALE, v0[2] * YS8_SCALE, v0[3] * YS8_SCALE); w8.y = pk4_fp8(v1[0] * YS8_SCALE, v1[1] * YS8_SCALE, v1[2] * YS8_SCALE, v1[3] * YS8_SCALE);
                        w8.x = (unsigned)__builtin_amdgcn_ds_bpermute(paddr, (int)w8.x); w8.y = (unsigned)__builtin_amdgcn_ds_bpermute(paddr, (int)w8.y); *(GAS v2u*)o8 = w8; }
                    else { v4u w; w.x = cvtpk(v0[0], v0[1]); w.y = cvtpk(v0[2], v0[3]); w.z = cvtpk(v1[0], v1[1]); w.w = cvtpk(v1[2], v1[3]);
                        w.x = (unsigned)__builtin_amdgcn_ds_bpermute(paddr, (int)w.x); w.y = (unsigned)__builtin_amdgcn_ds_bpermute(paddr, (int)w.y); w.z = (unsigned)__builtin_amdgcn_ds_bpermute(paddr, (int)w.z); w.w = (unsigned)__builtin_amdgcn_ds_bpermute(paddr, (int)w.w); *(GAS v4u*)(orow + bj * 128) = w; } } }
    }
};
__device__ __forceinline__ void p6b_down(Frame& F) {
    unsigned char* ws = F.ws;
    LAS int* tb = (LAS int*)(F.lds + LDS_MISC + 1024); LAS int* cn = tb + 64;
    MoeOrder S{tb, 4, F.G, F.vcu};
    constexpr int ES = P6_FP8 ? 1 : 2;
    pg9::DenseA ao{(unsigned)(DE * ES)}; ExpertB bb{(const char*)(ws + WS_WD), (size_t)D * DE * ES, (size_t)256 * DE * ES};
    EpiDown E{(bf16*)(ws + WS_YS), P6_FP8 ? 1.0f / (WD8_SCALE * H8_SCALE) : 1.0f};
    pg9::gemm_phase<ES>(F.lds, (const char*)(ws + WS_HACT), DE, S, E, ao, bb);
}
__device__ __forceinline__ void p7_final(Frame& F) {
    int tid_ = threadIdx.x; asm volatile("" : "+v"(tid_)); const int lane_ = tid_ & 63;
    unsigned char* ws = F.ws;
    LAS int* tb = (LAS int*)(F.lds + LDS_MISC + 1024); LAS int* cn = tb + 64;
    const bf16* YS = (const bf16*)(ws + WS_YS); const int4* tpos = (const int4*)(ws + WS_TPOS);
    float* X1 = F.out; const bf16* X1B = (const bf16*)(ws + WS_X1B);
    const int lane = lane_;
    const int gw = F.vcu * NWAVES + F.wave, NGW = F.G * NWAVES;
    f32x4 gg[4];
#pragma unroll
    for (int j = 0; j < 4; ++j) gg[j] = ((const GAS f32x4*)F.in[I_GFIN] + lane)[64 * j];
    for (int row0 = gw; row0 < T; row0 += 4 * NGW) {
        int4 tp[4];
#pragma unroll
        for (int r = 0; r < 4; ++r) { const int row = row0 + r * NGW < T ? row0 + r * NGW : row0; tp[r] = tpos[row]; }
        v2u xx[4][4]; v2u ya[4][4], yb[4][4]; unsigned za[4][4], zb[4][4];
#pragma unroll
        for (int r = 0; r < 4; ++r) { const int row = row0 + r * NGW < T ? row0 + r * NGW : row0;
            const size_t s0 = (size_t)tb[tp[r].x] * 256 + tp[r].y, s1 = (size_t)tb[tp[r].z] * 256 + tp[r].w;
            const GAS v2u* xb = (const GAS v2u*)(X1B + (size_t)row * D) + lane;
            const GAS v2u* y0 = (const GAS v2u*)(YS + s0 * D) + lane; const GAS v2u* y1 = (const GAS v2u*)(YS + s1 * D) + lane;
            const GAS unsigned* z0 = (const GAS unsigned*)((const unsigned char*)YS + s0 * D) + lane; const GAS unsigned* z1 = (const GAS unsigned*)((const unsigned char*)YS + s1 * D) + lane;
#pragma unroll
            for (int j = 0; j < 4; ++j) { xx[r][j] = xb[64 * j];
                if (YS_FP8) { za[r][j] = z0[64 * j]; zb[r][j] = z1[64 * j]; } else { ya[r][j] = y0[64 * j]; yb[r][j] = y1[64 * j]; } } }
#pragma unroll
        for (int r = 0; r < 4; ++r) { const int row = row0 + r * NGW; if (row >= T) continue;
            GAS f32x4* xr = (GAS f32x4*)(X1 + (size_t)row * D) + lane;
            f32x4 v[4]; float s = 0.f;
#pragma unroll
            for (int j = 0; j < 4; ++j) { const v2u x_ = xx[r][j]; v[j] = (f32x4){bflo(x_.x), bfhi(x_.x), bflo(x_.y), bfhi(x_.y)};
                if (YS_FP8) { const int a = (int)za[r][j], b = (int)zb[r][j]; typedef float f2_ __attribute__((ext_vector_type(2)));
                    const f2_ a0 = __builtin_amdgcn_cvt_pk_f32_fp8(a, false), a1 = __builtin_amdgcn_cvt_pk_f32_fp8(a, true), b0 = __builtin_amdgcn_cvt_pk_f32_fp8(b, false), b1 = __builtin_amdgcn_cvt_pk_f32_fp8(b, true);
                    constexpr float f = 1.0f / YS8_SCALE; v[j].x += (a0[0] + b0[0]) * f; v[j].y += (a0[1] + b0[1]) * f; v[j].z += (a1[0] + b1[0]) * f; v[j].w += (a1[1] + b1[1]) * f; }
                else { const v2u a = ya[r][j], b = yb[r][j];
                v[j].x += bflo(a.x) + bflo(b.x); v[j].y += bfhi(a.x) + bfhi(b.x); v[j].z += bflo(a.y) + bflo(b.y); v[j].w += bfhi(a.y) + bfhi(b.y); }
                s += (v[j].x * v[j].x + v[j].y * v[j].y) + (v[j].z * v[j].z + v[j].w * v[j].w); }
            const float rstd = 1.0f / sqrtf(wave_sum(s) * (1.f / D) + RMS_EPS);
#pragma unroll
            for (int j = 0; j < 4; ++j) { f32x4 o; o.x = v[j].x * rstd * gg[j].x; o.y = v[j].y * rstd * gg[j].y; o.z = v[j].z * rstd * gg[j].z; o.w = v[j].w * rstd * gg[j].w; xr[64 * j] = o; } }
    }
}

constexpr int NPHASE = 2 * NCH + 8;
__global__ void __launch_bounds__(NTHR, 2) fwd_kernel(KArgs args) {
    extern __shared__ __attribute__((aligned(16))) unsigned char lds_raw[];
    Frame F;
    F.lds = (LAS unsigned char*)lds_raw;
    F.tid = threadIdx.x; F.lane = F.tid & 63; F.wave = __builtin_amdgcn_readfirstlane(F.tid >> 6);
    F.G = gridDim.x; { const int bx = blockIdx.x; F.vcu = (F.G % 8 == 0) ? (bx % 8) * (F.G / 8) + bx / 8 : bx; }
#pragma unroll
    for (int i = 0; i < 17; ++i) F.in[i] = args.in[i];
    F.out = args.out; F.ws = args.ws;
    volatile LAS unsigned* MISC = (volatile LAS unsigned*)(F.lds + LDS_MISC);
    if (F.tid < 64) MISC[F.tid] = 0u;
    __syncthreads();
    XcdBarrier bar = xcd_barrier_post((unsigned*)(F.ws + WS_CTL) + CW_BAR + args.li * XCD_BAR_WORDS, MISC + 8);
#define IN(k) (args.ph_lo <= (k) && (k) < args.ph_hi)
#ifdef PROBE_MASK
    unsigned long long pr_acc = 0, pr_t0 = 0; const bool pr_me = (blockIdx.x == 0 && threadIdx.x == 0);
#define PR_BEGIN(k) do { if (pr_me && ((PROBE_MASK >> (k)) & 1ull)) pr_t0 = __builtin_amdgcn_s_memrealtime(); } while (0)
#define PR_END(k) do { if (pr_me && ((PROBE_MASK >> (k)) & 1ull)) pr_acc += __builtin_amdgcn_s_memrealtime() - pr_t0; } while (0)
#else
#define PR_BEGIN(k) do {} while (0)
#define PR_END(k) do {} while (0)
#endif
#define SEAM(k) do { if (IN(k) && IN((k) + 1)) xcd_barrier(bar); PR_END(k); } while (0)
    PR_BEGIN(0); if (IN(0)) p0_prologue(F);
    SEAM(0);
#pragma unroll 1
    for (int ch = 0; ch < NCH; ++ch) {
        PR_BEGIN(1 + 2 * ch);
        if (IN(1 + 2 * ch)) {
            constexpr int NWG1 = (TC / 256) * (NIN / 256);
            const int nfull = NWG1 % F.G, bx = (int)blockIdx.x;
            if (ch > 0 && nfull == 0) p2_combine(F, ch - 1, F.vcu, F.G);
            p1_inproj(F, ch);
            if (ch > 0 && nfull != 0 && bx >= nfull) p2_combine(F, ch - 1, bx - nfull, F.G - nfull);
        }
        SEAM(1 + 2 * ch);
        PR_BEGIN(2 + 2 * ch); if (IN(2 + 2 * ch)) p2_attn(F, ch);
        SEAM(2 + 2 * ch);
    }
    PR_BEGIN(2 * NCH + 1); if (IN(2 * NCH + 1)) p2_combine(F, NCH - 1, F.vcu, F.G);
    SEAM(2 * NCH + 1);
    PR_BEGIN(2 * NCH + 2); if (IN(2 * NCH + 2)) p3_merge(F);
    SEAM(2 * NCH + 2);
    PR_BEGIN(2 * NCH + 3); if (IN(2 * NCH + 3)) p4_outproj(F);
    SEAM(2 * NCH + 3);
    PR_BEGIN(2 * NCH + 4); if (IN(2 * NCH + 4)) p5_route(F);
    SEAM(2 * NCH + 4);
    PR_BEGIN(2 * NCH + 5); if (IN(2 * NCH + 5)) p6a_gateup(F);
    SEAM(2 * NCH + 5);
    PR_BEGIN(2 * NCH + 6); if (IN(2 * NCH + 6)) p6b_down(F);
    SEAM(2 * NCH + 6);
    PR_BEGIN(2 * NCH + 7); if (IN(2 * NCH + 7)) p7_final(F);
    PR_END(2 * NCH + 7);
#ifdef PROBE_MASK
    if (pr_me) { const unsigned long long t1 = __builtin_amdgcn_s_memrealtime(); while (__builtin_amdgcn_s_memrealtime() - t1 < pr_acc) __builtin_amdgcn_s_sleep(4); }
#endif
#undef IN
#undef SEAM
}

#ifndef N_LAUNCHES
#define N_LAUNCHES 1
#endif
extern "C" void kernel_launch(void* const* d_in, const int* in_sizes, int n_in, void* d_out, int out_size, void* d_ws, size_t ws_size, hipStream_t stream) {
    static int grid = 0;
    if (grid == 0) {
        if (n_in != 17 || in_sizes[0] != T * D || out_size != T * D || ws_size < WS_END) { fprintf(stderr, "kernel_launch: unexpected shapes / workspace (%d inputs, ws %zu)\n", n_in, ws_size); grid = -1; return; }
        int dev = 0, cus = 0;
        if (hipGetDevice(&dev) != hipSuccess || hipDeviceGetAttribute(&cus, hipDeviceAttributeMultiprocessorCount, dev) != hipSuccess) { grid = -1; return; }
        if (hipFuncSetAttribute((const void*)fwd_kernel, hipFuncAttributeMaxDynamicSharedMemorySize, LDS_BYTES) != hipSuccess) { fprintf(stderr, "kernel_launch: hipFuncSetAttribute failed\n"); grid = -1; return; }
        int per_cu = 0;
        if (hipOccupancyMaxActiveBlocksPerMultiprocessor(&per_cu, (const void*)fwd_kernel, NTHR, LDS_BYTES) != hipSuccess || per_cu < 1) fprintf(stderr, "kernel_launch: occupancy query says %d\n", per_cu);
        (void)hipGetLastError();
        grid = cus;
    }
    if (grid < 0) return;
    (void)hipMemsetAsync((char*)d_ws + WS_CTL, 0, N_LAUNCHES == 1 ? (size_t)(CW_BAR + XCD_BAR_WORDS) * 4 : CTL_BYTES, stream);
    KArgs a{};
    for (int i = 0; i < 17; ++i) a.in[i] = (const float*)d_in[i];
    a.out = (float*)d_out; a.ws = (unsigned char*)d_ws;
    for (int li = 0; li < N_LAUNCHES; ++li) {
        a.ph_lo = (int)((long)NPHASE * li / N_LAUNCHES); a.ph_hi = (int)((long)NPHASE * (li + 1) / N_LAUNCHES); a.li = li;
        hipLaunchKernelGGL(fwd_kernel, dim3(grid), dim3(NTHR), LDS_BYTES, stream, a);
    }
}
```

```cpp
#include <hip/hip_runtime.h>
#include <cstdint>
#include <cstdio>

#define GAS __attribute__((address_space(1)))
#define LAS __attribute__((address_space(3)))
typedef unsigned short bf16;
typedef short bf16x8 __attribute__((ext_vector_type(8)));
typedef float f32x4 __attribute__((ext_vector_type(4)));
typedef unsigned v4u __attribute__((ext_vector_type(4)));
typedef unsigned v2u __attribute__((ext_vector_type(2)));
typedef GAS unsigned gu32;

constexpr int T = 32768, D = 1024, SEQ = 4096, NIN = 7936;
constexpr int A_W = 4608, B_W = 1280, G_W = 2048, Y_W = 1536;
constexpr int NE = 32, DE = 256;
constexpr int NCH = 4, TC = T / NCH;
constexpr float QSCALE = 0.125f * 1.4426950408889634f;
constexpr float LOG2E = 1.4426950408889634f;
constexpr float RMS_EPS = 1e-6f;
#ifndef P1_FP8
#define P1_FP8 1
#endif
constexpr float W8_SCALE = P1_FP8 ? 64.0f : 0.0f, W8_INV = P1_FP8 ? 1.0f / 64.0f : 1.0f;
#ifndef P6_FP8
#define P6_FP8 1
#endif
#ifndef P34_FP8
#define P34_FP8 1
#endif
constexpr float Y8_SCALE = 16.0f, W34_SCALE = 64.0f, MG8_SCALE = 32.0f;
#ifndef YS_FP8
#define YS_FP8 1
#endif
constexpr float YS8_SCALE = 16.0f;
constexpr float WG8_SCALE = P6_FP8 ? 64.0f : 0.0f, WD8_SCALE = P6_FP8 ? 32.0f : 0.0f, H8_SCALE = 32.0f;
constexpr int NWAVES = 8, NTHR = 512;

constexpr size_t MiB = 1u << 20;
constexpr size_t WS_CTL = 0, CTL_BYTES = 1 * MiB;
constexpr size_t WS_BIASP = ((size_t)1 << 20) + 4096;
constexpr size_t WS_INVF = 1 * MiB;
constexpr size_t WS_WRF = 2 * MiB;
constexpr size_t WS_TOKOF = 3 * MiB;
constexpr size_t WS_WTOF = 7 * MiB;
constexpr size_t WS_TPOS = 15 * MiB;
constexpr size_t WS_WIN = 16 * MiB;
constexpr size_t WS_WAB = 32 * MiB;
constexpr size_t WS_WO = 35 * MiB;
constexpr size_t WS_WGU = 37 * MiB;
constexpr size_t WS_WD = 69 * MiB;
constexpr size_t WS_G = 86 * MiB;
constexpr size_t WS_Y = 214 * MiB;
constexpr size_t WS_ZA = 310 * MiB;
constexpr size_t WS_ZB = 454 * MiB;
constexpr size_t WS_END = 494 * MiB;
constexpr size_t WS_MG = WS_ZA;
constexpr size_t WS_X1B = WS_ZA + 64 * MiB;
constexpr size_t WS_X1F8 = WS_Y + 64 * MiB;
constexpr size_t WS_HACT = WS_G;
constexpr size_t WS_YS = WS_G + 36 * MiB;
constexpr size_t DO_DELTA = 0;
constexpr size_t DO_HN = 0;
constexpr size_t DO_OG = 64 * MiB;
constexpr size_t DO_LSE = 112 * MiB;
constexpr int MAXSLOT = 2 * T + NE * 256;
static_assert(WS_ZA + (size_t)TC * A_W * 2 <= WS_ZB && WS_ZB + (size_t)TC * B_W * 2 <= WS_END && WS_Y + (size_t)T * Y_W * 2 <= WS_ZA && WS_G + (size_t)T * G_W * 2 <= WS_Y, "ws map");
static_assert(WS_MG + (size_t)T * D * 2 <= WS_END && WS_HACT + (size_t)MAXSLOT * DE * 2 <= WS_YS && WS_YS + (size_t)MAXSLOT * D * 2 <= WS_ZA && WS_X1B >= WS_MG + (size_t)T * D * 2 && WS_X1B + (size_t)T * D * 2 <= WS_ZB, "ws map");
static_assert(DO_OG + (size_t)3 * TC * 512 * 2 <= DO_LSE && DO_LSE + (size_t)3 * TC * 8 * 4 <= (size_t)T * D * 4 && DO_HN + (size_t)T * D * 2 <= DO_OG, "d_out scratch map");
constexpr int CW_CNT = 1024;
constexpr int CW_BAR = 4096;
constexpr int LDS_BYTES = 147456;
constexpr int LDS_MISC = 131072;

__device__ __forceinline__ unsigned f2bf(float f) { unsigned u = __builtin_bit_cast(unsigned, f); return (u + 0x7fffu + ((u >> 16) & 1u)) >> 16; }
__device__ __forceinline__ unsigned pk4_fp8(float a, float b, float c, float d) {
    a = __builtin_amdgcn_fmed3f(a, -448.f, 448.f); b = __builtin_amdgcn_fmed3f(b, -448.f, 448.f); c = __builtin_amdgcn_fmed3f(c, -448.f, 448.f); d = __builtin_amdgcn_fmed3f(d, -448.f, 448.f);
    int w = 0; w = __builtin_amdgcn_cvt_pk_fp8_f32(a, b, w, false); w = __builtin_amdgcn_cvt_pk_fp8_f32(c, d, w, true); return (unsigned)w; }
__device__ __forceinline__ unsigned pk2(float lo, float hi) { return f2bf(lo) | (f2bf(hi) << 16); }
__device__ __forceinline__ float bf2f(unsigned b) { return __builtin_bit_cast(float, b << 16); }
__device__ __forceinline__ float bflo(unsigned u) { return __builtin_bit_cast(float, u << 16); }
__device__ __forceinline__ float bfhi(unsigned u) { return __builtin_bit_cast(float, u & 0xffff0000u); }
__device__ __forceinline__ float wave_sum(float v) {
#pragma unroll
    for (int o = 1; o < 64; o <<= 1) v += __shfl_xor(v, o);
    return v;
}
__device__ __forceinline__ float wave_max(float v) {
#pragma unroll
    for (int o = 1; o < 64; o <<= 1) v = fmaxf(v, __shfl_xor(v, o));
    return v;
}
typedef float f32x2_t __attribute__((ext_vector_type(2)));
typedef __bf16 bf16x2_t __attribute__((ext_vector_type(2)));
__device__ __forceinline__ unsigned cvtpk(float lo, float hi) { f32x2_t v = {lo, hi}; bf16x2_t b = __builtin_convertvector(v, bf16x2_t); return __builtin_bit_cast(unsigned, b); }
#ifndef WT_STORES
#define WT_STORES 1
#endif
__device__ __forceinline__ __amdgpu_buffer_rsrc_t wt_rsrc(unsigned char* base) { return __builtin_amdgcn_make_buffer_rsrc(base, 0, 0x7ffffffc, 0x00020000); }
__device__ __forceinline__ void st16(__amdgpu_buffer_rsrc_t r, unsigned char* base, void* p, v4u v) { if (WT_STORES) __builtin_amdgcn_raw_buffer_store_b128(v, r, (unsigned)((unsigned char*)p - base), 0, 16); else *(GAS v4u*)p = v; }
__device__ __forceinline__ void st8(__amdgpu_buffer_rsrc_t r, unsigned char* base, void* p, v2u v) { if (WT_STORES) __builtin_amdgcn_raw_buffer_store_b64(v, r, (unsigned)((unsigned char*)p - base), 0, 16); else *(GAS v2u*)p = v; }
#define LDS_WAIT() asm volatile("s_waitcnt lgkmcnt(0)" ::: "memory")
#define VM_WAIT() asm volatile("s_waitcnt vmcnt(0)" ::: "memory")

#define XB_TMO      128
#define XB_XCNT(j)  (256  + 64 * (j))
#define XB_XSUB(j)  (1280 + 64 * (j))
#define XB_XGEN(j)  (2304 + 64 * (j))
#define XB_TOP      3328
#define XB_TOPGEN   3392
#define XCD_BAR_WORDS 3456
#define XB_SPIN_CAP (1u << 18)
__device__ __forceinline__ unsigned xb_ld(unsigned* p)              { return __hip_atomic_load(p, __ATOMIC_RELAXED, __HIP_MEMORY_SCOPE_AGENT); }
__device__ __forceinline__ unsigned xb_add(unsigned* p, unsigned v) { return __hip_atomic_fetch_add(p, v, __ATOMIC_RELAXED, __HIP_MEMORY_SCOPE_AGENT); }
__device__ __forceinline__ unsigned xb_xcc_id() { return (unsigned)__builtin_amdgcn_s_getreg((3 << 11) | 20) & 0xFu; }
#define XB_SPIN(cond, bar) do { unsigned _sp = 0; while (cond) { __builtin_amdgcn_s_sleep(1); \
    if ((++_sp & 255u) == 0u) { if (xb_ld(&(bar)[XB_TMO])) break; if (_sp > XB_SPIN_CAP) { atomicAdd(&(bar)[XB_TMO], 1u); break; } } } } while (0)
struct XcdBarrier { unsigned* bar; unsigned x; volatile LAS unsigned* st; };
__device__ __forceinline__ XcdBarrier xcd_barrier_post(unsigned* bar, volatile LAS unsigned* st) {
    XcdBarrier b; b.bar = bar; b.x = xb_xcc_id(); b.st = st;
    if (threadIdx.x == 0) (void)xb_add(&bar[XB_XCNT(b.x)], 1u);
    return b;
}
__device__ __forceinline__ void xcd_barrier_complete(unsigned* bar, unsigned x, unsigned& nloc, unsigned& nx) {
    const unsigned G = gridDim.x * gridDim.y * gridDim.z;
    unsigned sum, cnt, mine, sp = 0u;
    for (;;) {
        sum = 0u; cnt = 0u; mine = 0u;
#pragma unroll
        for (unsigned j = 0; j < 16; ++j) { const unsigned c = xb_ld(&bar[XB_XCNT(j)]); sum += c; cnt += (c > 0u) ? 1u : 0u; mine = (j == x) ? c : mine; }
        if (sum == G) break;
        __builtin_amdgcn_s_sleep(1);
        if ((++sp & 255u) == 0u) { if (xb_ld(&bar[XB_TMO])) break; if (sp > XB_SPIN_CAP) { atomicAdd(&bar[XB_TMO], 1u); break; } }
    }
    nloc = mine > 0u ? mine : 1u; nx = cnt > 0u ? cnt : 1u;
}
__device__ __forceinline__ void xcd_barrier(const XcdBarrier& b, const bool wb = true) {
    asm volatile("s_waitcnt vmcnt(0)" ::: "memory");
    __syncthreads();
    int t_ = threadIdx.x; asm volatile("" : "+v"(t_));
    if (t_ == 0) {
        unsigned* bar = b.bar;
        __builtin_amdgcn_s_waitcnt(0);
        unsigned nloc = b.st[0], nx = b.st[1];
        if (nloc == 0u) { xcd_barrier_complete(bar, b.x, nloc, nx); b.st[0] = nloc; b.st[1] = nx; }
        const unsigned old = xb_add(&bar[XB_XSUB(b.x)], 1u);
        const unsigned gen = old / nloc;
        if (old + 1u == (gen + 1u) * nloc) {
            if (wb) __builtin_amdgcn_fence(__ATOMIC_RELEASE, "agent");
            asm volatile("s_waitcnt vmcnt(0)" ::: "memory");
            const unsigned og = xb_add(&bar[XB_TOP], 1u);
            const unsigned tg = og / nx;
            if (og + 1u == (tg + 1u) * nx) xb_add(&bar[XB_TOPGEN], 1u);
            else XB_SPIN(xb_ld(&bar[XB_TOPGEN]) == tg, bar);
            __builtin_amdgcn_fence(__ATOMIC_ACQUIRE, "agent");
            xb_add(&bar[XB_XGEN(b.x)], 1u);
            asm volatile("s_waitcnt vmcnt(0)" ::: "memory");
        } else {
            XB_SPIN(xb_ld(&bar[XB_XGEN(b.x)]) == gen, bar);
            __builtin_amdgcn_fence(__ATOMIC_ACQUIRE, "agent");
            asm volatile("s_waitcnt vmcnt(0)" ::: "memory");
        }
    }
    __syncthreads();
}

struct KArgs { const float* in[17]; float* out; unsigned char* ws; int ph_lo, ph_hi, li, pad; };
struct Frame {
    LAS unsigned char* lds;
    int tid, lane, wave, vcu, G;
    const float* in[17]; float* out; unsigned char* ws;
};
enum { I_X = 0, I_WIN, I_BIN, I_SINK, I_WPA, I_WPB, I_WOUT, I_GMIX, I_GFFN, I_WRG, I_BRG, I_WRE, I_BRE, I_WEG, I_WEU, I_WED, I_GFIN };

struct TrDesc { const float* W; int N; bf16* WT; int ldo, rowbase, koff, k0, n0; bool perm; const float* kscale; float f8scale; };
__device__ __forceinline__ void tr_load(const TrDesc& d, int lane, f32x4 (&tv)[8], float (&ks)[8]) {
    const float* src = d.W + (size_t)(d.k0 + (lane >> 3)) * d.N + d.n0 + 4 * (lane & 7);
#pragma unroll
    for (int i = 0; i < 8; ++i) tv[i] = *(const GAS f32x4*)(src + (size_t)(8 * i) * d.N);
#pragma unroll
    for (int i = 0; i < 8; ++i) ks[i] = d.kscale ? d.kscale[d.k0 + 8 * i + (lane >> 3)] : 1.0f;
}
__device__ __forceinline__ void tr_finish(const TrDesc& d, LAS float* scr, int lane, const f32x4 (&tv)[8], const float (&ks)[8]) {
#pragma unroll
    for (int i = 0; i < 8; ++i) { const int kk = 8 * i + (lane >> 3); LAS float* w = scr + kk * 33 + 4 * (lane & 7);
        w[0] = tv[i][0] * ks[i]; w[1] = tv[i][1] * ks[i]; w[2] = tv[i][2] * ks[i]; w[3] = tv[i][3] * ks[i]; }
    LDS_WAIT(); asm volatile("" ::: "memory");
    const int c = lane & 7;
#pragma unroll
    for (int j = 0; j < 4; ++j) { const int n = (lane >> 3) + 8 * j; const LAS float* s = scr + (8 * c) * 33 + n;
        const int rr = d.perm ? 8 * (n >> 2) + (n & 3) : n;
        if (d.f8scale != 0.f) { const float f = d.f8scale; v2u o8; o8.x = pk4_fp8(s[0 * 33] * f, s[1 * 33] * f, s[2 * 33] * f, s[3 * 33] * f); o8.y = pk4_fp8(s[4 * 33] * f, s[5 * 33] * f, s[6 * 33] * f, s[7 * 33] * f);
            *(GAS v2u*)((unsigned char*)d.WT + (size_t)(d.rowbase + rr) * d.ldo + d.koff + d.k0 + 8 * c) = o8; }
        else { v4u o; o.x = pk2(s[0 * 33], s[1 * 33]); o.y = pk2(s[2 * 33], s[3 * 33]); o.z = pk2(s[4 * 33], s[5 * 33]); o.w = pk2(s[6 * 33], s[7 * 33]);
            *(GAS v4u*)(d.WT + (size_t)(d.rowbase + rr) * d.ldo + d.koff + d.k0 + 8 * c) = o; } }
    LDS_WAIT(); asm volatile("" ::: "memory");
}
__device__ __forceinline__ void rms_row_to_bf16(const float* xrow, const float* g, bf16* orow, int lane) {
    const GAS f32x4* xr = (const GAS f32x4*)xrow + lane; const GAS f32x4* gr = (const GAS f32x4*)g + lane;
    f32x4 v[4]; float s = 0.f;
#pragma unroll
    for (int j = 0; j < 4; ++j) { v[j] = xr[64 * j]; s += (v[j].x * v[j].x + v[j].y * v[j].y) + (v[j].z * v[j].z + v[j].w * v[j].w); }
    const float rstd = 1.0f / sqrtf(wave_sum(s) * (1.f / D) + RMS_EPS);
    GAS v2u* o8 = (GAS v2u*)orow + lane;
#pragma unroll
    for (int j = 0; j < 4; ++j) { const f32x4 gg = gr[64 * j]; v2u w; w.x = pk2(v[j].x * rstd * gg.x, v[j].y * rstd * gg.y); w.y = pk2(v[j].z * rstd * gg.z, v[j].w * rstd * gg.w); o8[64 * j] = w; }
}
__device__ __forceinline__ void p0_prologue(Frame& F) {
    int tid_ = threadIdx.x; asm volatile("" : "+v"(tid_)); const int lane_ = tid_ & 63;
    LAS float* scr = (LAS float*)(F.lds + F.wave * 16384);
    const int gw = F.vcu * NWAVES + F.wave, NGW = F.G * NWAVES;
    unsigned char* ws = F.ws;
    constexpr int I_IN = 16 * 248, I_PA = 8 * 32, I_PB = 16 * 32, I_WO = 16 * 32, I_EG = 32 * 16 * 8, I_ED = 32 * 4 * 32;
    constexpr int NITEMS = I_IN + I_PA + I_PB + I_WO + 2 * I_EG + I_ED;
    auto decode = [&](int it, TrDesc& d) {
        int r = it; d.perm = false; d.kscale = nullptr; d.f8scale = 0.f; d.koff = 0;
        if (r < I_IN) { const int kb = r / 248, nb = r % 248, n0 = 32 * nb; const bool qk = (n0 < 3072) || (n0 >= A_W && n0 < A_W + 1152);
            const bool gt_ = n0 >= A_W + B_W; const int gc = n0 - (A_W + B_W);
            d.W = F.in[I_WIN]; d.N = NIN; d.WT = (bf16*)(ws + WS_WIN); d.ldo = 1024; d.rowbase = qk ? (n0 & ~63) + ((n0 >> 5) & 1) * 4 : (gt_ ? A_W + B_W + 2 * (gc % 1024) + 4 * (gc / 1024) : n0); d.k0 = 64 * kb; d.n0 = n0; d.perm = qk || gt_; d.f8scale = W8_SCALE; return; } r -= I_IN;
        if (r < I_PA) { const int kb = r / 32, nb = r % 32; d.W = F.in[I_WPA]; d.N = 1024; d.WT = (bf16*)(ws + WS_WAB); d.ldo = 1536; d.rowbase = 32 * nb; d.k0 = 64 * kb; d.n0 = 32 * nb; if (P34_FP8) d.f8scale = W34_SCALE; return; } r -= I_PA;
        if (r < I_PB) { const int kb = r / 32, nb = r % 32; d.W = F.in[I_WPB]; d.N = 1024; d.WT = (bf16*)(ws + WS_WAB); d.ldo = 1536; d.rowbase = 32 * nb; d.koff = 512; d.k0 = 64 * kb; d.n0 = 32 * nb; if (P34_FP8) d.f8scale = W34_SCALE; return; } r -= I_PB;
        if (r < I_WO) { const int kb = r / 32, nb = r % 32; d.W = F.in[I_WOUT]; d.N = 1024; d.WT = (bf16*)(ws + WS_WO); d.ldo = 1024; d.rowbase = 32 * nb; d.k0 = 64 * kb; d.n0 = 32 * nb; if (P34_FP8) d.f8scale = W34_SCALE; return; } r -= I_WO;
        if (r < 2 * I_EG) { const int up = r >= I_EG; if (up) r -= I_EG; const int e = r / 128, q = r % 128, kb = q / 8, nb = q % 8;
            d.W = F.in[up ? I_WEU : I_WEG] + (size_t)e * 1024 * 256; d.N = 256; d.WT = (bf16*)(ws + WS_WGU) + (size_t)e * 512 * 1024; d.ldo = 1024; d.rowbase = 64 * nb + (up ? 4 : 0); d.k0 = 64 * kb; d.n0 = 32 * nb; d.perm = true; d.kscale = F.in[I_GFFN]; d.f8scale = WG8_SCALE; if (P6_FP8) d.WT = (bf16*)((unsigned char*)(ws + WS_WGU) + (size_t)e * 512 * 1024); return; } r -= 2 * I_EG;
        { const int e = r / 128, q = r % 128, kb = q / 32, nb = q % 32;
            d.W = F.in[I_WED] + (size_t)e * 256 * 1024; d.N = 1024; d.WT = (bf16*)(ws + WS_WD) + (size_t)e * 1024 * 256; d.ldo = 256; d.rowbase = 32 * nb; d.k0 = 64 * kb; d.n0 = 32 * nb; d.f8scale = WD8_SCALE; if (P6_FP8) d.WT = (bf16*)((unsigned char*)(ws + WS_WD) + (size_t)e * 1024 * 256); }
    };
    {
        int it = gw; TrDesc dc, dn; f32x4 tc[8], tn[8]; float kc[8], kn[8];
        bool hc = it < NITEMS; if (hc) { decode(it, dc); tr_load(dc, lane_, tc, kc); }
        while (hc) {
            it += NGW; const bool hn = it < NITEMS;
            if (hn) { decode(it, dn); tr_load(dn, lane_, tn, kn); }
            tr_finish(dc, scr, lane_, tc, kc);
            hc = hn; dc = dn;
#pragma unroll
            for (int i = 0; i < 8; ++i) { tc[i] = tn[i]; kc[i] = kn[i]; }
        }
    }
    f32x4 gmx[4];
#pragma unroll
    for (int j = 0; j < 4; ++j) gmx[j] = ((const GAS f32x4*)F.in[I_GMIX] + lane_)[64 * j];
    const __amdgpu_buffer_rsrc_t wro_ = wt_rsrc((unsigned char*)F.out);
#define WTS32(ptr, val) __builtin_amdgcn_raw_buffer_store_b32((val), wro_, (unsigned)((unsigned char*)(ptr) - (unsigned char*)F.out), 0, 16)
    for (int m = gw; m < T; m += 4 * NGW) {
        f32x4 v[4][4]; float ss[4];
#pragma unroll
        for (int r = 0; r < 4; ++r) { const int mr = (m + r * NGW < T) ? m + r * NGW : m; const GAS f32x4* xr = (const GAS f32x4*)(F.in[I_X] + (size_t)mr * D) + lane_;
#pragma unroll
            for (int j = 0; j < 4; ++j) v[r][j] = xr[64 * j]; }
#pragma unroll
        for (int r = 0; r < 4; ++r) { float a = 0.f;
#pragma unroll
            for (int j = 0; j < 4; ++j) a += (v[r][j].x * v[r][j].x + v[r][j].y * v[r][j].y) + (v[r][j].z * v[r][j].z + v[r][j].w * v[r][j].w);
            ss[r] = 1.0f / sqrtf(wave_sum(a) * (1.f / D) + RMS_EPS); }
#pragma unroll
        for (int r = 0; r < 4; ++r) { if (m + r * NGW >= T) continue; GAS unsigned* o4 = (GAS unsigned*)((unsigned char*)F.out + DO_HN + (size_t)(m + r * NGW) * D) + lane_;
#pragma unroll
            for (int j = 0; j < 4; ++j) { const f32x4 gg = gmx[j];
                if (P1_FP8) WTS32(o4 + 64 * j, pk4_fp8(v[r][j].x * ss[r] * gg.x, v[r][j].y * ss[r] * gg.y, v[r][j].z * ss[r] * gg.z, v[r][j].w * ss[r] * gg.w));
                else { v2u w; w.x = cvtpk(v[r][j].x * ss[r] * gg.x, v[r][j].y * ss[r] * gg.y); w.y = cvtpk(v[r][j].z * ss[r] * gg.z, v[r][j].w * ss[r] * gg.w); ((GAS v2u*)((unsigned char*)F.out + DO_HN + (size_t)(m + r * NGW) * D * 2) + lane_)[64 * j] = w; } } }
    }
    const int gt = F.vcu * NTHR + tid_, NGT = F.G * NTHR;
    if (gt < 32) ((float*)(ws + WS_INVF))[gt] = (float)exp2(-(double)gt * (13.287712379549449 / 32.0));
    for (int c = gt; c < NIN; c += NGT) {
        int s = c; const int e = c & 7;
        if (c < 3072 || (c >= A_W && c < A_W + 1152)) s = (c & ~63) + 4 * ((c & 63) >> 3) + (e < 4 ? e : 28 + e);
        else if (c >= A_W + B_W) s = A_W + B_W + 4 * ((c - A_W - B_W) >> 3) + (e < 4 ? e : 1020 + e);
        ((float*)(ws + WS_BIASP))[c] = F.in[I_BIN][s];
    }
    for (int i = gt; i < 32 * 3 * 64; i += NGT) {
        const int ln = i & 63, nb = (i >> 6) % 3, ks = i / 192;
        const int n = 16 * nb + (ln & 15);
        float hi[8], lo[8];
#pragma unroll
        for (int e = 0; e < 8; ++e) { const int k = 32 * ks + 8 * (ln >> 4) + e; float v = 0.f;
            if (n < 4) v = F.in[I_WRG][k * 4 + n]; else if (n < 36) v = F.in[I_WRE][k * 32 + (n - 4)];
            v *= F.in[I_GFFN][k]; hi[e] = bf2f(f2bf(v)); lo[e] = v - hi[e]; }
        v4u h, l; h.x = pk2(hi[0], hi[1]); h.y = pk2(hi[2], hi[3]); h.z = pk2(hi[4], hi[5]); h.w = pk2(hi[6], hi[7]);
        l.x = pk2(lo[0], lo[1]); l.y = pk2(lo[2], lo[3]); l.z = pk2(lo[4], lo[5]); l.w = pk2(lo[6], lo[7]);
        ((v4u*)(ws + WS_WRF))[((ks * 3 + nb) * 2 + 0) * 64 + ln] = h; ((v4u*)(ws + WS_WRF))[((ks * 3 + nb) * 2 + 1) * 64 + ln] = l;
    }
}

namespace pg8 {
#define PG8_LAS __attribute__((address_space(3)))
typedef unsigned short bf16_t;
typedef short bf16x8 __attribute__((ext_vector_type(8)));
typedef float f32x4 __attribute__((ext_vector_type(4)));
typedef unsigned u32x4 __attribute__((ext_vector_type(4)));
constexpr int BM = 256, BK = 64, HALF = 128, HTB = HALF * BK * 2  , STAGE_BYTES = 8 * HTB, NXCD = 8, WGM = 8;

__host__ __device__ __forceinline__ int lds_byte(int r, int c) { const int st = (r >> 4) * 2 + (c >> 5), rr = r & 15, cc = c & 31, ob = rr * 64 + cc * 2; return st * 1024 + (ob ^ (((ob >> 9) & 1) << 5)); }
__host__ __device__ __forceinline__ void stage_rc(int b, int& R, int& C) { const int st = b / 1024, sb = b % 1024, swz = sb ^ (((sb >> 9) & 1) << 5); R = (st >> 1) * 16 + swz / 64; C = (st & 1) * 32 + (swz % 64) / 2; }
__host__ __device__ __forceinline__ int perm32(int rho) { const int n = rho >> 4, i = rho & 15; return 8 * (i >> 2) + 4 * n + (i & 3); }

struct Unit { int pm, pn; };
struct Gemm { const bf16_t* A; const bf16_t* Bt; int M, N, K; };

struct StaticOrder {
    int nM, nN, nwg, G, c;
    __host__ __device__ void init(int M, int N, int G_, int c_) { nM = M / BM; nN = N / BM; nwg = nM * nN; G = G_; c = c_; }
    __host__ __device__ bool next(int i, Unit& u) const {
        const long L = (long)i * G + c; if (L >= nwg) return false;
        int wgid = (int)L; { const int q = nwg / NXCD, r = nwg % NXCD, xcd = wgid % NXCD, off = wgid / NXCD; wgid = (xcd < r ? xcd * (q + 1) : r * (q + 1) + (xcd - r) * q) + off; }
        const int nig = WGM * nN, gid = wgid / nig, fm = gid * WGM, gsz = (nM - fm) < WGM ? (nM - fm) : WGM;
        u.pm = fm + ((wgid % nig) % gsz); u.pn = (wgid % nig) / gsz; return true;
    }
    __device__ __forceinline__ void a_ready(const Unit&) const {}
    __device__ __forceinline__ void done(const Unit&) const {}
};
}


namespace pg9 {
using pg8::BM; using pg8::BK; using pg8::HALF; using pg8::HTB; using pg8::lds_byte; using pg8::stage_rc; using pg8::perm32;
struct Unit { int pm, pn, e; };
typedef int v8i_t __attribute__((ext_vector_type(8)));
typedef int v4i_t __attribute__((ext_vector_type(4)));
template <int ESZ, class Epi, class Sched, class AOff, class BBase>
__device__ __forceinline__ void gemm_phase(LAS unsigned char* lds, const char* Abase, int K, const Sched& S, const Epi& E, const AOff& aoffn, const BBase& bbase) {
    int tid_ = threadIdx.x; asm volatile("" : "+v"(tid_));
    const int tid = tid_, wid = __builtin_amdgcn_readfirstlane(tid >> 6), lane = tid & 63, wr = wid >> 2, wc = wid & 3, fr = lane & 15, fq = lane >> 4;
    const int nt = K * ESZ / (BK * 2);
    int Rr[2], Cc[2]; unsigned voffB[2];
#pragma unroll
    for (int i = 0; i < 2; ++i) { int R, C; stage_rc(tid * 16 + i * 8192, R, C); const int Rb = Epi::PERM ? ((R & ~31) + perm32(R & 31)) : R; Rr[i] = R; Cc[i] = C; voffB[i] = (unsigned)(Rb * K * ESZ + C * 2); }
    const size_t kstep = (size_t)(BK * 2);
    const size_t hstep = (size_t)HALF * K * ESZ;
    const unsigned ldsw = (unsigned)wid * 1024u;
    const int aoff = lds_byte(wr * 64 + fr, fq * 8), boff = lds_byte(wc * 32 + fr, fq * 8);
#define PG9_SA(b, h) (((b) * 2 + (h)) * HTB)
#define PG9_SB(b, h) ((4 + (b) * 2 + (h)) * HTB)
#define PG9_STAGE(bufoff, gbase, voff) do { _Pragma("unroll") for (int _i = 0; _i < 2; ++_i) \
        __builtin_amdgcn_global_load_lds((const unsigned*)((const char*)(gbase) + (voff)[_i]), (LAS unsigned*)(lds + (bufoff) + ldsw + _i * 8192), 16, 0, 0); } while (0)
#define PG9_LDA(dst, b, h) do { _Pragma("unroll") for (int m = 0; m < 4; ++m) { dst[m].lo = *(const LAS v4i_t*)(lds + PG9_SA(b, h) + aoff + m * 2048); dst[m].hi = *(const LAS v4i_t*)(lds + PG9_SA(b, h) + aoff + m * 2048 + 1024); } } while (0)
#define PG9_LDB(dst, b, h) do { _Pragma("unroll") for (int n = 0; n < 2; ++n) { dst[n].lo = *(const LAS v4i_t*)(lds + PG9_SB(b, h) + boff + n * 2048); dst[n].hi = *(const LAS v4i_t*)(lds + PG9_SB(b, h) + boff + n * 2048 + 1024); } } while (0)
#define PG9_HALF(v, o) __builtin_bit_cast(bf16x8, __builtin_shufflevector((v), (v), (o), (o) + 1, (o) + 2, (o) + 3))
#define PG9_MMA(ai, bj, At, Bt) do { __builtin_amdgcn_s_setprio(1); _Pragma("unroll") for (int m = 0; m < 4; ++m) _Pragma("unroll") for (int n = 0; n < 2; ++n) { \
        if (ESZ == 2) { acc[ai][bj][m][n] = __builtin_amdgcn_mfma_f32_16x16x32_bf16(PG9_HALF(Bt[n], 0), PG9_HALF(At[m], 0), acc[ai][bj][m][n], 0, 0, 0); \
                        acc[ai][bj][m][n] = __builtin_amdgcn_mfma_f32_16x16x32_bf16(PG9_HALF(Bt[n], 4), PG9_HALF(At[m], 4), acc[ai][bj][m][n], 0, 0, 0); } \
        else { asm volatile("v_mfma_scale_f32_16x16x128_f8f6f4 %0, %1, %2, %0, %3, %3 op_sel_hi:[0,0,0]" : "+v"(acc[ai][bj][m][n]) : "v"(Bt[n]), "v"(At[m]), "v"(one8)); } } \
        __builtin_amdgcn_s_setprio(0); } while (0)
#define PG9_WAIT_V(n) asm volatile("s_waitcnt vmcnt(" #n ")" ::: "memory")
#define PG9_WAIT_L(n) asm volatile("s_waitcnt lgkmcnt(" #n ")" ::: "memory")
#define PG9_BAR __builtin_amdgcn_s_barrier()
#define PG9_SCHED __builtin_amdgcn_sched_barrier(0)
#define PG9_VA(dst, u) do { _Pragma("unroll") for (int _h = 0; _h < 2; ++_h) _Pragma("unroll") for (int _i = 0; _i < 2; ++_i) dst[_h][_i] = aoffn((u), _h * HALF + Rr[_i]) + (unsigned)(Cc[_i] * 2); } while (0)
    constexpr bool GATHER = AOff::GATHER;
    const size_t hstepA = (size_t)HALF * aoffn.rowbytes;
    unsigned voffA[2];
#pragma unroll
    for (int i = 0; i < 2; ++i) voffA[i] = (unsigned)Rr[i] * aoffn.rowbytes + (unsigned)(Cc[i] * 2);
#define PG9_STAGE_A(bufoff, h, koff, nx) do { if (GATHER) { PG9_STAGE(bufoff, Abase + (koff), ((nx) ? nvA[h] : cvA[h])); } else { PG9_STAGE(bufoff, ((nx) ? nAu : cAu) + (h) * hstepA + (koff), voffA); } } while (0)
    Unit cur, nxt; int ui = 0;
    if (!S.next(0, cur)) return;
    f32x4 acc[2][2][4][2];
#pragma unroll
    for (int a = 0; a < 2; ++a)
#pragma unroll
        for (int b = 0; b < 2; ++b)
#pragma unroll
            for (int m = 0; m < 4; ++m)
#pragma unroll
                for (int n = 0; n < 2; ++n) acc[a][b][m][n] = (f32x4){0.f, 0.f, 0.f, 0.f};
    int one8 = 0x7f7f7f7f; asm volatile("" : "+v"(one8));
    v8i_t At[4], B0[2], B1[2];
    unsigned cvA[2][2], nvA[2][2];
    if (GATHER) { PG9_VA(cvA, cur); }
    const char* cAu = GATHER ? Abase : Abase + (size_t)aoffn(cur, 0); const char* nAu = cAu;
    const char* cB = bbase(cur);
    E.prefetch(lds, cur, 0, wid, lane);
    PG9_STAGE(PG9_SB(0, 0), cB, voffB); PG9_STAGE(PG9_SB(0, 1), cB + hstep, voffB); PG9_STAGE_A(PG9_SA(0, 0), 0, 0, false); PG9_STAGE_A(PG9_SA(0, 1), 1, 0, false);
    if (wr == 1) PG9_BAR;
    PG9_WAIT_V(2); PG9_BAR;
    PG9_STAGE(PG9_SB(1, 0), cB + kstep, voffB); PG9_STAGE_A(PG9_SA(1, 0), 0, kstep, false); PG9_STAGE(PG9_SB(1, 1), cB + hstep + kstep, voffB);
    PG9_WAIT_V(6); PG9_BAR;
    for (;;) {
        const bool has_next = S.next(ui + 1, nxt);
        if (GATHER) {
            if (has_next) { unsigned o4[4]; aoffn.rows4(nxt, Rr[0], Rr[1], HALF + Rr[0], HALF + Rr[1], o4);
                nvA[0][0] = o4[0] + (unsigned)(Cc[0] * 2); nvA[0][1] = o4[1] + (unsigned)(Cc[1] * 2); nvA[1][0] = o4[2] + (unsigned)(Cc[0] * 2); nvA[1][1] = o4[3] + (unsigned)(Cc[1] * 2);
            } else {
#pragma unroll
                for (int _h = 0; _h < 2; ++_h)
#pragma unroll
                    for (int _i = 0; _i < 2; ++_i) nvA[_h][_i] = cvA[_h][_i]; }
        } else nAu = has_next ? Abase + (size_t)aoffn(nxt, 0) : cAu;
        const char* nB = has_next ? bbase(nxt) : cB;
#pragma unroll 1
        for (int t = 0; t < nt; t += 2) {
            const bool last = (t == nt - 2);
            if (Epi::HOOK_T >= 0) { if (t == Epi::HOOK_T) E.hook(acc, cur, wr, wc, fr, fq); }
            const size_t k1 = (size_t)(t + 1) * kstep, k2 = last ? 0 : (size_t)(t + 2) * kstep, k3 = k2 + kstep;
            const char* b2 = last ? nB : cB + (size_t)(t + 2) * kstep; const char* b3 = b2 + kstep;
            PG9_LDB(B0, 0, 0); PG9_LDB(B1, 0, 1); PG9_SCHED; PG9_LDA(At, 0, 0); PG9_STAGE_A(PG9_SA(1, 1), 1, k1, false);
            PG9_WAIT_V(8); PG9_WAIT_L(0); PG9_BAR; PG9_MMA(0, 0, At, B0); PG9_MMA(0, 1, At, B1); PG9_BAR; PG9_SCHED;
            PG9_LDA(At, 0, 1); PG9_STAGE(PG9_SB(0, 0), b2, voffB); PG9_STAGE(PG9_SB(0, 1), b2 + hstep, voffB); PG9_STAGE_A(PG9_SA(0, 0), 0, k2, last);
            PG9_WAIT_V(8); PG9_WAIT_L(0); PG9_BAR; PG9_MMA(1, 0, At, B0); PG9_MMA(1, 1, At, B1); PG9_BAR; PG9_SCHED;
            PG9_LDB(B0, 1, 0); PG9_LDB(B1, 1, 1); PG9_SCHED; PG9_LDA(At, 1, 0); PG9_STAGE_A(PG9_SA(0, 1), 1, k2, last);
            PG9_WAIT_V(8); PG9_WAIT_L(0); PG9_BAR; PG9_MMA(0, 0, At, B0); PG9_MMA(0, 1, At, B1); PG9_BAR; PG9_SCHED;
            PG9_LDA(At, 1, 1); PG9_STAGE(PG9_SB(1, 0), b3, voffB); PG9_STAGE(PG9_SB(1, 1), b3 + hstep, voffB); PG9_STAGE_A(PG9_SA(1, 0), 0, k3, last);
            PG9_WAIT_V(8); PG9_WAIT_L(0); PG9_BAR; PG9_MMA(1, 0, At, B0); PG9_MMA(1, 1, At, B1); PG9_BAR; PG9_SCHED;
        }
        if (wr == 0) PG9_BAR;
        if (ESZ == 1) asm volatile("s_nop 15\n\ts_nop 15" ::: "memory");
        E(acc, cur, ui, wr, wc, fr, fq);
        if (!has_next) break;
#pragma unroll
        for (int a = 0; a < 2; ++a)
#pragma unroll
            for (int b = 0; b < 2; ++b)
#pragma unroll
                for (int m = 0; m < 4; ++m)
#pragma unroll
                    for (int n = 0; n < 2; ++n) acc[a][b][m][n] = (f32x4){0.f, 0.f, 0.f, 0.f};
        cur = nxt; cB = nB; cAu = nAu; ++ui;
        E.prefetch(lds, cur, ui, wid, lane);
        if (GATHER) {
#pragma unroll
            for (int _h = 0; _h < 2; ++_h)
#pragma unroll
                for (int _i = 0; _i < 2; ++_i) cvA[_h][_i] = nvA[_h][_i]; }
        if (wr == 1) PG9_BAR;
    }
    PG9_WAIT_V(0);
    PG9_BAR;
#undef PG9_SA
#undef PG9_SB
#undef PG9_STAGE
#undef PG9_LDA
#undef PG9_LDB
#undef PG9_MMA
#undef PG9_HALF
#undef PG9_WAIT_V
#undef PG9_WAIT_L
#undef PG9_BAR
#undef PG9_SCHED
#undef PG9_VA
#undef PG9_STAGE_A
}
struct DenseOrder { pg8::StaticOrder so;
    __device__ void init(int M, int N, int G, int c) { so.init(M, N, G, c); }
    __device__ bool next(int i, Unit& u) const { pg8::Unit v; if (!so.next(i, v)) return false; u.pm = v.pm; u.pn = v.pn; u.e = 0; return true; } };
struct DenseA { static constexpr bool GATHER = false; unsigned rowbytes; __device__ __forceinline__ unsigned operator()(const Unit& u, int row) const { return (unsigned)(u.pm * 256 + row) * rowbytes; }
    __device__ __forceinline__ void rows4(const Unit&, int, int, int, int, unsigned (&)[4]) const {} };
struct DenseB { const char* Bt; size_t tilebytes; __device__ __forceinline__ const char* operator()(const Unit& u) const { return Bt + (size_t)u.pn * tilebytes; } };
}

struct EpiInproj {
    static constexpr bool PERM = true; static constexpr int HOOK_T = -1;
    bf16* ZA; bf16* ZB; bf16* Gt; const float* biasP; LAS unsigned char* ldsb; unsigned char* wsb;
    __device__ __forceinline__ void hook(f32x4 (&)[2][2][4][2], const pg9::Unit&, int, int, int, int) const {}
    __device__ __forceinline__ void prefetch(LAS unsigned char* lds, const pg9::Unit& u, int ui, int wid, int lane) const {
        if (wid == 0) __builtin_amdgcn_global_load_lds((const unsigned*)(biasP + u.pn * 256 + lane * 4), (LAS unsigned*)(lds + LDS_MISC + 4096 + (ui & 1) * 1024), 16, 0, 0);
    }
    __device__ __forceinline__ void operator()(const f32x4 (&acc)[2][2][4][2], const pg9::Unit& u, int ui, int wr, int wc, int fr, int fq) const {
        asm volatile("" : "+v"(fr), "+v"(fq));
        const int row0 = u.pm * 256 + wr * 64 + fr;
        const int q = 4 * (wc & 1) + fq;
        const int fr2 = (fr >> 2) + 4 * fq, fq2 = fr & 3, paddr = 4 * (16 * (fr & 3) + 4 * fq + (fr >> 2));
        const int row0s = u.pm * 256 + wr * 64 + fr2;
        int kind[2]; bf16* dst[2]; int ldd[2]; f32x4 b0[2], b1[2];
#pragma unroll
        for (int bj = 0; bj < 2; ++bj) {
            const int colpos = u.pn * 256 + bj * 128 + wc * 32 + 8 * fq, colposs = u.pn * 256 + bj * 128 + wc * 32 + 8 * fq2, hb = u.pn * 256 + bj * 128 + (wc >> 1) * 64;
            if (hb < A_W) { const int hbi = hb >> 6; kind[bj] = hb / 1536; dst[bj] = ZA + (size_t)hbi * (TC * 64) + (colposs - hb); ldd[bj] = 2 * ((hbi % 24) >> 3); }
            else if (hb < A_W + B_W) { const int cb = hb - A_W; kind[bj] = cb < 1024 ? 0 : (cb < 1152 ? 1 : 2); dst[bj] = ZB + (size_t)(cb >> 6) * (TC * 64) + (colposs - hb); ldd[bj] = 0; }
            else { kind[bj] = 3; const int c0 = (colpos - A_W - B_W) >> 1;
                dst[bj] = Gt + ((size_t)((u.pm * 256 + wr * 64) >> 4) * 256 + (c0 >> 3)) * 128 + fr * 8 + (c0 & 7); ldd[bj] = 0; }
            const LAS float* bs = (const LAS float*)(ldsb + LDS_MISC + 4096 + (ui & 1) * 1024) + bj * 128 + wc * 32 + 8 * fq;
            b0[bj] = *(const LAS f32x4*)bs; b1[bj] = *(const LAS f32x4*)(bs + 4);
        }
        const bool need_rope = kind[0] < 2 || kind[1] < 2;
        const f32x4 fv = *(const LAS f32x4*)(ldsb + LDS_MISC + 6144 + 16 * q);
#pragma unroll
        for (int ai = 0; ai < 2; ++ai) {
            f32x4 rc[4], rs[4];
#pragma unroll
            for (int m = 0; m < 4; ++m) { rc[m] = (f32x4){1.f, 1.f, 1.f, 1.f}; rs[m] = (f32x4){0.f, 0.f, 0.f, 0.f}; }
            if (need_rope) {
#pragma unroll
                for (int m = 0; m < 4; ++m) { const float posf = (float)((row0 + ai * 128 + m * 16) & (SEQ - 1));
#pragma unroll
                    for (int e = 0; e < 4; ++e) { const float ang = posf * fv[e]; const float pr = ang * 0.15915494f; const float er = __builtin_fmaf(ang, 0.15915494f, -pr) + ang * 6.4206382e-9f;
                        const float fr = __builtin_amdgcn_fractf(pr) + er; rc[m][e] = __builtin_amdgcn_cosf(fr); rs[m][e] = __builtin_amdgcn_sinf(fr); } }
            }
#pragma unroll
            for (int bj = 0; bj < 2; ++bj) {
                const int sh = ldd[bj], posr = row0s & (SEQ - 1), ridx = (row0s & ~(SEQ - 1)) + ((posr & ((1 << sh) - 1)) << (12 - sh)) + (posr >> sh);
                bf16* p = dst[bj] + (size_t)(ridx + ai * (128 >> sh)) * 64; const unsigned step = (unsigned)((16 >> sh) * 64);
                if (kind[bj] == 3) p = dst[bj] + (size_t)(ai * 8) * 32768;
                switch (kind[bj]) {
                    case 0: store4<0>(acc[ai][bj], b0[bj], b1[bj], rc, rs, p, step, paddr, wsb); break;
                    case 1: store4<1>(acc[ai][bj], b0[bj], b1[bj], rc, rs, p, step, paddr, wsb); break;
                    case 2: store4<2>(acc[ai][bj], b0[bj], b1[bj], rc, rs, p, step, paddr, wsb); break;
                    default: store4<3>(acc[ai][bj], b0[bj], b1[bj], rc, rs, p, step, paddr, wsb); break;
                }
            }
        }
    }
    template <int KIND> static __device__ __forceinline__ void store4(const f32x4 (&a)[4][2], const f32x4 b0, const f32x4 b1, const f32x4 (&rc)[4], const f32x4 (&rs)[4], bf16* p, const unsigned step, const int paddr, unsigned char* wsb) {
        const __amdgpu_buffer_rsrc_t wr_ = wt_rsrc(wsb);
#pragma unroll
        for (int m = 0; m < 4; ++m) {
            f32x4 v0 = a[m][0] * W8_INV + b0, v1 = a[m][1] * W8_INV + b1;
            if (KIND < 2) {
                const f32x4 cc = rc[m], ss = rs[m];
                const f32x4 t0 = v0 * cc - v1 * ss, t1 = v1 * cc + v0 * ss;
                v0 = t0; v1 = t1;
                if (KIND == 0) { v0 = v0 * QSCALE; v1 = v1 * QSCALE; }
            }
            if (KIND == 3) {
#pragma unroll
                for (int e = 0; e < 4; ++e) { const float d0 = 1.0f + __expf(-v0[e]), d1 = 1.0f + __expf(-v1[e]); v0[e] = d1 * __builtin_amdgcn_rcpf(d0); v1[e] = __builtin_amdgcn_rcpf(d1); }
                v2u w0, w1; w0.x = cvtpk(v0[0], v0[1]); w0.y = cvtpk(v0[2], v0[3]); w1.x = cvtpk(v1[0], v1[1]); w1.y = cvtpk(v1[2], v1[3]);
                st8(wr_, wsb, p, w0); st8(wr_, wsb, p + 128 * 128, w1); p += 32768;
            } else {
                v4u w; w.x = cvtpk(v0[0], v0[1]); w.y = cvtpk(v0[2], v0[3]); w.z = cvtpk(v1[0], v1[1]); w.w = cvtpk(v1[2], v1[3]);
                w.x = (unsigned)__builtin_amdgcn_ds_bpermute(paddr, (int)w.x); w.y = (unsigned)__builtin_amdgcn_ds_bpermute(paddr, (int)w.y); w.z = (unsigned)__builtin_amdgcn_ds_bpermute(paddr, (int)w.z); w.w = (unsigned)__builtin_amdgcn_ds_bpermute(paddr, (int)w.w);
                st16(wr_, wsb, p, w); p += step;
            }
        }
    }
};
__device__ __forceinline__ void p1_inproj(Frame& F, int ch) {
    unsigned char* ws = F.ws;
    pg9::DenseOrder S; S.init(TC, NIN, F.G, (int)blockIdx.x);
    EpiInproj E{(bf16*)(ws + WS_ZA), (bf16*)(ws + WS_ZB), (bf16*)(ws + WS_G) + (size_t)ch * TC * G_W, (const float*)(ws + WS_BIASP), F.lds, ws};
    if (ch == 0) { int t_ = threadIdx.x; asm volatile("" : "+v"(t_)); if (t_ < 32) ((LAS float*)(F.lds + LDS_MISC + 6144))[t_] = ((const float*)(ws + WS_INVF))[t_]; }
    constexpr int ES = P1_FP8 ? 1 : 2;
    pg9::DenseA ao{(unsigned)(D * ES)}; pg9::DenseB bb{(const char*)(ws + WS_WIN), (size_t)256 * D * ES};
    pg9::gemm_phase<ES>(F.lds, (const char*)F.out + DO_HN + (size_t)ch * TC * D * ES, D, S, E, ao, bb);
}

typedef float f32x16 __attribute__((ext_vector_type(16)));
typedef short v4i16_t __attribute__((ext_vector_type(4)));
__device__ __forceinline__ float half_max(float v) { auto rr = __builtin_amdgcn_permlane32_swap(__float_as_uint(v), __float_as_uint(v), false, false); return fmaxf(__uint_as_float(rr[0]), __uint_as_float(rr[1])); }
__device__ __forceinline__ float half_sum(float v) { auto rr = __builtin_amdgcn_permlane32_swap(__float_as_uint(v), __float_as_uint(v), false, false); return __uint_as_float(rr[0]) + __uint_as_float(rr[1]); }
__device__ __forceinline__ float max3f(float a, float b, float c) { float r; asm("v_max3_f32 %0, %1, %2, %3" : "=v"(r) : "v"(a), "v"(b), "v"(c)); return r; }
constexpr int ATT_VOFF = 49152;

struct AUnit { const bf16 *Kw, *Vw, *Qp; size_t pitch; int kk_lo, nkeys, kb0, kstart, lo; float m0; bf16* Op; long ostr; float* Lp; int o8; unsigned ooff; };
__device__ __forceinline__ void attn_decode(Frame& F, int ch, int u, int NUA, int lane, AUnit& d) {
    unsigned char* ws = F.ws;
    const int w = F.wave, c = lane & 31, h = (lane >> 5) & 1;
    constexpr int NUB_ = (TC / SEQ) * 2 * 128;
    if (u >= NUB_) { const int ua = u - NUB_;
        const bf16* ZA = (const bf16*)(ws + WS_ZA);
        const int rt = ua & 15, hh = (ua >> 4) & 7, gb = ua >> 7, g = gb % 3, bl = gb / 3;
        const int dsh = 2 * g, dd = 1 << dsh, tsh = 4 - dsh;
        const int r = rt >> tsh, tile = rt & ((1 << tsh) - 1), i0 = tile * 256;
        const int rowb = bl * SEQ + r;
        d.pitch = 64;
        const int sl = g * 8 + hh; const long rb = (long)bl * SEQ + ((long)r << (12 - dsh));
        d.Kw = ZA + ((long)(24 + sl) * TC + rb + (i0 - 128)) * 64; d.Vw = ZA + ((long)(48 + sl) * TC + rb + (i0 - 128)) * 64;
        const long qrow = (long)rowb + (long)dd * (i0 + 32 * w + c);
        d.Qp = ZA + ((long)sl * TC + rb + i0 + 32 * w + c) * 64;
        d.kk_lo = (i0 == 0) ? 128 : 0; d.nkeys = 384; d.kb0 = w; d.kstart = (i0 == 0) ? (w < 4 ? 4 - w : 0) : 0; d.lo = 0;
        d.m0 = -1e30f;
        d.Op = (bf16*)((unsigned char*)F.out + DO_OG) + ((size_t)g * TC + (qrow - (long)dd * c)) * 512 + hh * 64; d.ostr = (long)dd * 1024;
        d.ooff = (unsigned)(DO_OG + (((size_t)g * TC + (size_t)rowb + (size_t)dd * (i0 + 32 * w)) * 512 + hh * 64) * 2);
        d.Lp = (float*)((unsigned char*)F.out + DO_LSE) + ((size_t)g * TC + qrow) * 8 + hh;
        d.o8 = 0;
    } else {
        const int u2 = u;
        const bf16* ZB = (const bf16*)(ws + WS_ZB);
        const int blk = u2 & 127, kvh = (u2 >> 7) & 1, bl = u2 >> 8;
        const int t0 = blk * 32, rowb = bl * SEQ;
        d.pitch = 64;
        d.Kw = ZB + ((long)(16 + kvh) * TC + rowb + t0 - 128) * 64; d.Vw = ZB + ((long)(18 + kvh) * TC + rowb + t0 - 128) * 64;
        const int qh = kvh * 8 + w;
        const long qrow = (long)rowb + t0 + c;
        d.Qp = ZB + ((long)qh * TC + qrow) * 64;
        d.kk_lo = t0 < 128 ? 128 - t0 : 0; d.nkeys = 160; d.kb0 = 0; d.kstart = d.kk_lo >> 5; d.lo = 1;
        d.m0 = F.in[I_SINK][qh] * LOG2E;
        d.o8 = P34_FP8;
        d.Op = P34_FP8 ? (bf16*)(ws + WS_Y + ((size_t)ch * TC + (qrow - c)) * Y_W + 512 + qh * 64) : (bf16*)(ws + WS_Y) + ((size_t)ch * TC + (qrow - c)) * Y_W + 512 + qh * 64; d.ostr = P34_FP8 ? Y_W : 2 * Y_W;
        d.ooff = (unsigned)(WS_Y + ((size_t)ch * TC + (size_t)rowb + t0) * Y_W + 512 + qh * 64);
        d.Lp = nullptr;
    }
}
__device__ __forceinline__ void attn_load(const AUnit& d, int tid, int lane, v4u (&kreg)[6], v4u (&vreg)[6], bf16x8 (&qf)[4]) {
    const int skey = tid >> 3, sch = tid & 7, h = (lane >> 5) & 1;
#pragma unroll
    for (int s4 = 0; s4 < 4; ++s4) qf[s4] = *(const GAS bf16x8*)(d.Qp + 16 * s4 + 8 * h);
#pragma unroll
    for (int p = 0; p < 6; ++p) { const int kk = 64 * p + skey;
        if (kk >= d.kk_lo && kk < d.nkeys) { kreg[p] = ((const GAS v4u*)((const GAS unsigned char*)d.Kw + (size_t)p * 8192))[tid]; vreg[p] = ((const GAS v4u*)((const GAS unsigned char*)d.Vw + (size_t)p * 8192))[tid]; } }
}
__device__ __forceinline__ void attn_write(const AUnit& d, LAS unsigned char* KL, LAS unsigned char* VL, int tid, const v4u (&kreg)[6], const v4u (&vreg)[6]) {
    const int skey = tid >> 3, sch = tid & 7;
#pragma unroll
    for (int p = 0; p < 6; ++p) { const int kk = 64 * p + skey;
        if (kk >= d.kk_lo && kk < d.nkeys) {
            *(LAS v4u*)(KL + kk * 128 + ((sch ^ ((kk >> 1) & 7)) << 4)) = kreg[p];
            *(LAS v4u*)(VL + kk * 128 + ((sch * 16) ^ (((kk >> 1) & 1) << 6))) = vreg[p]; } }
}
__device__ __forceinline__ void attn_out(const AUnit& d, LAS unsigned char* OL, int lane, const f32x16& o0, const f32x16& o1, float inv, unsigned char* outb, unsigned char* wsb) {
    asm volatile("" : "+v"(lane));
    const int c = lane & 31, h = (lane >> 5) & 1;
    if (d.o8) {
        const float sc = inv * Y8_SCALE;
#pragma unroll
        for (int g4 = 0; g4 < 4; ++g4) {
            const int bo0 = 8 * g4 + 4 * h, bo1 = 32 + bo0;
            *(LAS unsigned*)(OL + c * 64 + (((bo0 >> 4) ^ (c & 3)) << 4) + (bo0 & 15)) = pk4_fp8(o0[4 * g4 + 0] * sc, o0[4 * g4 + 1] * sc, o0[4 * g4 + 2] * sc, o0[4 * g4 + 3] * sc);
            *(LAS unsigned*)(OL + c * 64 + (((bo1 >> 4) ^ (c & 3)) << 4) + (bo1 & 15)) = pk4_fp8(o1[4 * g4 + 0] * sc, o1[4 * g4 + 1] * sc, o1[4 * g4 + 2] * sc, o1[4 * g4 + 3] * sc);
        }
        unsigned char* ob = (unsigned char*)d.Op;
#pragma unroll
        for (int j = 0; j < 2; ++j) { const int q = (lane >> 2) + 16 * j, k = lane & 3;
            const v4u v = *(const LAS v4u*)(OL + q * 64 + ((k ^ (q & 3)) << 4));
            if (WT_STORES && P34_FP8) __builtin_amdgcn_raw_buffer_store_b128(v, wt_rsrc(wsb), (unsigned)(q * (int)d.ostr + k * 16), d.ooff, 16); else *(GAS v4u*)(ob + (long)q * d.ostr + k * 16) = v; }
    } else {
#pragma unroll
        for (int g4 = 0; g4 < 4; ++g4) {
            v2u a, b;
            a.x = cvtpk(o0[4 * g4 + 0] * inv, o0[4 * g4 + 1] * inv); a.y = cvtpk(o0[4 * g4 + 2] * inv, o0[4 * g4 + 3] * inv);
            b.x = cvtpk(o1[4 * g4 + 0] * inv, o1[4 * g4 + 1] * inv); b.y = cvtpk(o1[4 * g4 + 2] * inv, o1[4 * g4 + 3] * inv);
            const int bo0 = 16 * g4 + 8 * h, bo1 = 64 + bo0;
            *(LAS v2u*)(OL + c * 128 + (((bo0 >> 4) ^ (c & 7)) << 4) + (bo0 & 15)) = a;
            *(LAS v2u*)(OL + c * 128 + (((bo1 >> 4) ^ (c & 7)) << 4) + (bo1 & 15)) = b;
        }
        unsigned char* ob = (unsigned char*)d.Op;
#pragma unroll
        for (int j = 0; j < 4; ++j) { const int q = (lane >> 3) + 8 * j, k = lane & 7;
            const v4u v = *(const LAS v4u*)(OL + q * 128 + ((k ^ (q & 7)) << 4));
            if (WT_STORES) __builtin_amdgcn_raw_buffer_store_b128(v, wt_rsrc(outb), (unsigned)(q * (int)d.ostr + k * 16), d.ooff, 16); else *(GAS v4u*)(ob + (long)q * d.ostr + k * 16) = v; }
    }
}
__device__ __forceinline__ void attn_compute_edge(const AUnit& d, const LAS unsigned char* KL, const LAS unsigned char* VL, LAS unsigned char* OL, int lane, const bf16x8 (&qf)[4], unsigned char* outb, unsigned char* wsb) {
    const int c = lane & 31, h = (lane >> 5) & 1;
    int koff[4];
    { const int kswz = (c >> 1) & 7;
#pragma unroll
      for (int s4 = 0; s4 < 4; ++s4) koff[s4] = c * 128 + (((2 * s4 + h) ^ kswz) << 4); }
    const int vrow = 4 * h + ((lane & 15) >> 2), vsw = (lane >> 3) & 1;
    const int voff0 = vrow * 128 + ((32 * ((lane >> 4) & 1) + 8 * (lane & 3)) ^ (vsw << 6)), voff1 = voff0 ^ 64;
    const float NEG = -INFINITY;
    float m = d.m0, l = (d.lo && h == 0) ? 1.f : 0.f;
    f32x16 o0, o1;
#pragma unroll
    for (int i = 0; i < 16; ++i) { o0[i] = 0.f; o1[i] = 0.f; }
    const LAS unsigned char* kbp = KL + d.kb0 * 4096; const LAS unsigned char* vbp = VL + d.kb0 * 4096;
    const int clo = c + d.lo;
#pragma unroll
    for (int kbi = 0; kbi < 5; ++kbi) {
        if (kbi >= d.kstart) {
            f32x16 p;
#pragma unroll
            for (int i = 0; i < 16; ++i) p[i] = 0.f;
#pragma unroll
            for (int s4 = 0; s4 < 4; ++s4) { const bf16x8 kf = *(const LAS bf16x8*)(kbp + kbi * 4096 + koff[s4]); p = __builtin_amdgcn_mfma_f32_32x32x16_bf16(kf, qf[s4], p, 0, 0, 0); }
            if (kbi == 0) {
#pragma unroll
                for (int i = 0; i < 16; ++i) { const int x = (i & 3) + 8 * (i >> 2) + 4 * h; if (x < clo) p[i] = NEG; }
            }
            if (kbi == 4) {
#pragma unroll
                for (int i = 0; i < 16; ++i) { const int x = (i & 3) + 8 * (i >> 2) + 4 * h; if (x > c) p[i] = NEG; }
            }
            float mt = p[0];
#pragma unroll
            for (int i = 1; i < 16; ++i) mt = fmaxf(mt, p[i]);
            mt = half_max(mt);
            const float mn = fmaxf(m, mt), alpha = __builtin_amdgcn_exp2f(m - mn);
            m = mn;
            float ps = 0.f;
#pragma unroll
            for (int i = 0; i < 16; ++i) { p[i] = __builtin_amdgcn_exp2f(p[i] - mn); ps += p[i]; }
            l = l * alpha + ps;
#pragma unroll
            for (int i = 0; i < 16; ++i) { o0[i] *= alpha; o1[i] *= alpha; }
            bf16x8 pb[2];
#pragma unroll
            for (int s2 = 0; s2 < 2; ++s2) { v4u t; t.x = cvtpk(p[8 * s2 + 0], p[8 * s2 + 1]); t.y = cvtpk(p[8 * s2 + 2], p[8 * s2 + 3]); t.z = cvtpk(p[8 * s2 + 4], p[8 * s2 + 5]); t.w = cvtpk(p[8 * s2 + 6], p[8 * s2 + 7]); pb[s2] = __builtin_bit_cast(bf16x8, t); }
#pragma unroll
            for (int s2 = 0; s2 < 2; ++s2) {
#pragma unroll
                for (int db = 0; db < 2; ++db) {
                    const LAS unsigned char* vp = vbp + kbi * 4096 + s2 * 2048 + (db ? voff1 : voff0);
                    const v4i16_t lo = __builtin_amdgcn_ds_read_tr16_b64_v4i16((LAS v4i16_t*)vp);
                    const v4i16_t hi = __builtin_amdgcn_ds_read_tr16_b64_v4i16((LAS v4i16_t*)(vp + 1024));
                    const bf16x8 vf = {lo[0], lo[1], lo[2], lo[3], hi[0], hi[1], hi[2], hi[3]};
                    if (db == 0) o0 = __builtin_amdgcn_mfma_f32_32x32x16_bf16(vf, pb[s2], o0, 0, 0, 0);
                    else o1 = __builtin_amdgcn_mfma_f32_32x32x16_bf16(vf, pb[s2], o1, 0, 0, 0);
                }
            }
        }
    }
    const float lt = half_sum(l), inv = 1.0f / lt;
    attn_out(d, OL, lane, o0, o1, inv, outb, wsb);
    if (d.Lp) { if (h == 0) __hip_atomic_store((GAS unsigned*)d.Lp, __float_as_uint(m + __builtin_amdgcn_logf(lt)), __ATOMIC_RELAXED, __HIP_MEMORY_SCOPE_AGENT); }
}
__device__ __forceinline__ void attn_compute(const AUnit& d, const LAS unsigned char* KL, const LAS unsigned char* VL, LAS unsigned char* OL, int lane, const bf16x8 (&qf)[4], unsigned char* outb, unsigned char* wsb) {
    const int c = lane & 31, h = (lane >> 5) & 1;
    int koff[4];
    { const int kswz = (c >> 1) & 7;
#pragma unroll
      for (int s4 = 0; s4 < 4; ++s4) koff[s4] = c * 128 + (((2 * s4 + h) ^ kswz) << 4); }
    const int vrow = 4 * h + ((lane & 15) >> 2), vsw = (lane >> 3) & 1;
    const int voff0 = vrow * 128 + ((32 * ((lane >> 4) & 1) + 8 * (lane & 3)) ^ (vsw << 6)), voff1 = voff0 ^ 64;
    const float NEG = -INFINITY;
    float m = d.m0;
    f32x16 o0, o1, L;
#pragma unroll
    for (int i = 0; i < 16; ++i) { o0[i] = 0.f; o1[i] = 0.f; L[i] = 0.f; }
    v4u onesu = {0x3F803F80u, 0x3F803F80u, 0x3F803F80u, 0x3F803F80u}; asm volatile("" : "+v"(onesu));
    const bf16x8 ones = __builtin_bit_cast(bf16x8, onesu);
    const LAS unsigned char* kbp = KL + d.kb0 * 4096; const LAS unsigned char* vbp = VL + d.kb0 * 4096;
    const int clo = c + d.lo;
#pragma unroll
    for (int kbi = 0; kbi < 5; ++kbi) {
        {
            constexpr bool first_dummy = false; (void)first_dummy;
            const bool first = (kbi == 0);
            const float cinit = first ? 0.f : -m;
            f32x16 p;
#pragma unroll
            for (int i = 0; i < 16; ++i) p[i] = cinit;
#pragma unroll
            for (int s4 = 0; s4 < 4; ++s4) { const bf16x8 kf = *(const LAS bf16x8*)(kbp + kbi * 4096 + koff[s4]); p = __builtin_amdgcn_mfma_f32_32x32x16_bf16(kf, qf[s4], p, 0, 0, 0); }
            bf16x8 vfr[2][2];
#pragma unroll
            for (int s2 = 0; s2 < 1; ++s2)
#pragma unroll
                for (int db = 0; db < 2; ++db) {
                    const LAS unsigned char* vp = vbp + kbi * 4096 + s2 * 2048 + (db ? voff1 : voff0);
                    const v4i16_t lo = __builtin_amdgcn_ds_read_tr16_b64_v4i16((LAS v4i16_t*)vp);
                    const v4i16_t hi = __builtin_amdgcn_ds_read_tr16_b64_v4i16((LAS v4i16_t*)(vp + 1024));
                    vfr[s2][db] = (bf16x8){lo[0], lo[1], lo[2], lo[3], hi[0], hi[1], hi[2], hi[3]}; }
            if (kbi == 0) {
#pragma unroll
                for (int i = 0; i < 16; ++i) { const int x = (i & 3) + 8 * (i >> 2) + 4 * h; p[i] = x < clo ? NEG : p[i]; }
            }
            if (kbi == 4) {
#pragma unroll
                for (int i = 0; i < 16; ++i) { const int x = (i & 3) + 8 * (i >> 2) + 4 * h; p[i] = x > c ? NEG : p[i]; }
            }
            float t0 = max3f(p[0], p[4], p[8]), t1 = max3f(p[1], p[5], p[9]), t2 = max3f(p[2], p[6], p[10]), t3 = max3f(p[3], p[7], p[11]);
            t0 = max3f(t0, p[12], p[13]); t1 = max3f(t1, p[14], p[15]);
            const float mt = half_max(max3f(max3f(t0, t1, t2), t3, t3));
            if (first) {
                const float mn = fmaxf(m, mt), l0 = d.m0 > -1e29f ? __builtin_amdgcn_exp2f(m - mn) : 0.f;
                m = mn;
#pragma unroll
                for (int i = 0; i < 16; ++i) { p[i] -= mn; L[i] = l0; }
            } else if (__any(mt > 8.0f)) {
                const float dl = fmaxf(mt, 0.f), al = __builtin_amdgcn_exp2f(-dl);
                m += dl;
#pragma unroll
                for (int i = 0; i < 16; ++i) { o0[i] *= al; o1[i] *= al; L[i] *= al; p[i] -= dl; }
            }
#pragma unroll
            for (int i = 0; i < 16; ++i) p[i] = __builtin_amdgcn_exp2f(p[i]);
            bf16x8 pb[2];
#pragma unroll
            for (int s2 = 0; s2 < 2; ++s2) { v4u t; t.x = cvtpk(p[8 * s2 + 0], p[8 * s2 + 1]); t.y = cvtpk(p[8 * s2 + 2], p[8 * s2 + 3]); t.z = cvtpk(p[8 * s2 + 4], p[8 * s2 + 5]); t.w = cvtpk(p[8 * s2 + 6], p[8 * s2 + 7]); pb[s2] = __builtin_bit_cast(bf16x8, t); }
#pragma unroll
            for (int s2 = 0; s2 < 2; ++s2) {
                L = __builtin_amdgcn_mfma_f32_32x32x16_bf16(ones, pb[s2], L, 0, 0, 0);
#pragma unroll
                for (int db = 0; db < 2; ++db) {
                    bf16x8 vf;
                    if (s2 == 0) vf = vfr[0][db];
                    else { const LAS unsigned char* vp = vbp + kbi * 4096 + s2 * 2048 + (db ? voff1 : voff0);
                        const v4i16_t lo = __builtin_amdgcn_ds_read_tr16_b64_v4i16((LAS v4i16_t*)vp);
                        const v4i16_t hi = __builtin_amdgcn_ds_read_tr16_b64_v4i16((LAS v4i16_t*)(vp + 1024));
                        vf = (bf16x8){lo[0], lo[1], lo[2], lo[3], hi[0], hi[1], hi[2], hi[3]}; }
                    if (db == 0) o0 = __builtin_amdgcn_mfma_f32_32x32x16_bf16(vf, pb[s2], o0, 0, 0, 0);
                    else o1 = __builtin_amdgcn_mfma_f32_32x32x16_bf16(vf, pb[s2], o1, 0, 0, 0);
                }
            }
        }
    }
    const float lt = L[0], inv = 1.0f / lt;
    attn_out(d, OL, lane, o0, o1, inv, outb, wsb);
    if (d.Lp) { if (h == 0) __hip_atomic_store((GAS unsigned*)d.Lp, __float_as_uint(m + __builtin_amdgcn_logf(lt)), __ATOMIC_RELAXED, __HIP_MEMORY_SCOPE_AGENT); }
}
__device__ __forceinline__ void p2_attn(Frame& F, int ch) {
    int tid_ = threadIdx.x; asm volatile("" : "+v"(tid_));
    const int tid = tid_, lane = tid & 63;
    LAS unsigned char* KL = F.lds; LAS unsigned char* VL = F.lds + ATT_VOFF; LAS unsigned char* OL = F.lds + 2 * ATT_VOFF + F.wave * 4096;
    constexpr int NUA = (TC / SEQ) * 3 * 8 * 16, NUB = (TC / SEQ) * 2 * 128, NU = NUA + NUB;
    int u = F.vcu; asm volatile("" : "+s"(u));
    if (u >= NU) return;
    AUnit cur, nxt;
    v4u kreg[6], vreg[6]; bf16x8 qn[4];
    attn_decode(F, ch, u, NUA, lane, cur);
    attn_load(cur, tid, lane, kreg, vreg, qn);
    for (;;) {
        attn_write(cur, KL, VL, tid, kreg, vreg);
        bf16x8 qf[4];
#pragma unroll
        for (int s4 = 0; s4 < 4; ++s4) qf[s4] = qn[s4];
        __syncthreads();
        const int un = u + F.G; const bool has_next = un < NU;
        if (has_next) { attn_decode(F, ch, un, NUA, lane, nxt); attn_load(nxt, tid, lane, kreg, vreg, qn); }
        if (cur.kstart == 0) attn_compute(cur, KL, VL, OL, lane, qf, (unsigned char*)F.out, F.ws); else attn_compute_edge(cur, KL, VL, OL, lane, qf, (unsigned char*)F.out, F.ws);
        __syncthreads();
        if (!has_next) break;
        cur = nxt; u = un;
    }
}
__device__ __forceinline__ void p2_combine(Frame& F, int ch, int cu, int ncu) {
    int tid_ = threadIdx.x; asm volatile("" : "+v"(tid_)); const int lane_ = tid_ & 63;
    unsigned char* ws = F.ws;
    const bf16* OG = (const bf16*)((const unsigned char*)F.out + DO_OG); const float* LSE = (const float*)((const unsigned char*)F.out + DO_LSE);
    bf16* Y = (bf16*)(ws + WS_Y) + (size_t)ch * TC * Y_W; unsigned char* Y8 = ws + WS_Y + (size_t)ch * TC * Y_W;
    const int lane = lane_, hd = lane >> 3;
    int gw_ = cu * NWAVES + F.wave; asm volatile("" : "+s"(gw_));
    const int gw = gw_, NGW = ncu * NWAVES;
    for (int row0 = gw; row0 < TC; row0 += 4 * NGW) {
        float lg[4][3]; v4u og[4][3];
#pragma unroll
        for (int r = 0; r < 4; ++r) { const int row = row0 + r * NGW < TC ? row0 + r * NGW : row0;
#pragma unroll
            for (int g = 0; g < 3; ++g) { lg[r][g] = LSE[((size_t)g * TC + row) * 8 + hd]; og[r][g] = *(const GAS v4u*)(OG + ((size_t)g * TC + row) * 512 + lane * 8); } }
#pragma unroll
        for (int r = 0; r < 4; ++r) { const int row = row0 + r * NGW; if (row >= TC) continue;
            const float mx = fmaxf(fmaxf(lg[r][0], lg[r][1]), lg[r][2]);
            float e[3]; e[0] = __builtin_amdgcn_exp2f(lg[r][0] - mx); e[1] = __builtin_amdgcn_exp2f(lg[r][1] - mx); e[2] = __builtin_amdgcn_exp2f(lg[r][2] - mx);
            const float inv = 1.0f / (e[0] + e[1] + e[2]);
            float acc[8];
#pragma unroll
            for (int i = 0; i < 8; ++i) acc[i] = 0.f;
#pragma unroll
            for (int g = 0; g < 3; ++g) { const float wg = e[g] * inv; const v4u o_ = og[r][g];
                acc[0] += wg * bflo(o_.x); acc[1] += wg * bfhi(o_.x); acc[2] += wg * bflo(o_.y); acc[3] += wg * bfhi(o_.y);
                acc[4] += wg * bflo(o_.z); acc[5] += wg * bfhi(o_.z); acc[6] += wg * bflo(o_.w); acc[7] += wg * bfhi(o_.w); }
            v4u o; o.x = cvtpk(acc[0], acc[1]); o.y = cvtpk(acc[2], acc[3]); o.z = cvtpk(acc[4], acc[5]); o.w = cvtpk(acc[6], acc[7]);
            if (P34_FP8) { v2u o8; o8.x = pk4_fp8(acc[0] * Y8_SCALE, acc[1] * Y8_SCALE, acc[2] * Y8_SCALE, acc[3] * Y8_SCALE); o8.y = pk4_fp8(acc[4] * Y8_SCALE, acc[5] * Y8_SCALE, acc[6] * Y8_SCALE, acc[7] * Y8_SCALE); __hip_atomic_store((GAS unsigned long long*)(Y8 + (size_t)row * Y_W + lane * 8), ((unsigned long long)o8.y << 32) | o8.x, __ATOMIC_RELAXED, __HIP_MEMORY_SCOPE_AGENT); }
            else *(GAS v4u*)(Y + (size_t)row * Y_W + lane * 8) = o; }
    }
}


struct EpiMerge {
    static constexpr bool PERM = true; static constexpr int HOOK_T = P34_FP8 ? 4 : 8;
    const bf16* Gt; bf16* MG;
    __device__ __forceinline__ void prefetch(LAS unsigned char*, const pg9::Unit&, int, int, int) const {}
    __device__ __forceinline__ void hook(f32x4 (&acc)[2][2][4][2], const pg9::Unit& u, int wr, int wc, int fr, int fq) const {
        asm volatile("" : "+v"(fr), "+v"(fq));
        const bf16* gr = Gt + ((size_t)((u.pm * 256 + wr * 64) >> 4) * 256 + u.pn * 32 + wc * 4 + fq) * 128 + fr * 8;
        v4u rv[8][2];
#pragma unroll
        for (int rg = 0; rg < 8; ++rg)
#pragma unroll
            for (int bj = 0; bj < 2; ++bj) rv[rg][bj] = *(const GAS v4u*)(gr + (size_t)((rg >> 2) * 8 + (rg & 3)) * 32768 + bj * 16 * 128);
#pragma unroll
        for (int rg = 0; rg < 8; ++rg)
#pragma unroll
            for (int bj = 0; bj < 2; ++bj) { const v4u a = rv[rg][bj];
                const f32x4 r0 = {bflo(a.x), bfhi(a.x), bflo(a.y), bfhi(a.y)}, r1 = {bflo(a.z), bfhi(a.z), bflo(a.w), bfhi(a.w)};
                acc[rg >> 2][bj][rg & 3][0] = acc[rg >> 2][bj][rg & 3][0] * r0; acc[rg >> 2][bj][rg & 3][1] = acc[rg >> 2][bj][rg & 3][1] * r1; }
    }
    __device__ __forceinline__ void operator()(const f32x4 (&acc)[2][2][4][2], const pg9::Unit& u, int ui, int wr, int wc, int fr, int fq) const {
        asm volatile("" : "+v"(fr), "+v"(fq));
        const bf16* gr = Gt + ((size_t)((u.pm * 256 + wr * 64) >> 4) * 256 + 128 + u.pn * 32 + wc * 4 + fq) * 128 + fr * 8;
        const int fr2 = (fr >> 2) + 4 * fq, fq2 = fr & 3, paddr = 4 * (16 * (fr & 3) + 4 * fq + (fr >> 2));
        bf16* mr = MG + (size_t)(u.pm * 256 + wr * 64 + fr2) * D + u.pn * 256 + wc * 32 + 8 * fq2;
        v4u gb[8][2];
#pragma unroll
        for (int rg = 0; rg < 8; ++rg)
#pragma unroll
            for (int bj = 0; bj < 2; ++bj) gb[rg][bj] = *(const GAS v4u*)(gr + (size_t)((rg >> 2) * 8 + (rg & 3)) * 32768 + bj * 16 * 128);
#pragma unroll
        for (int rg = 0; rg < 8; ++rg)
#pragma unroll
            for (int bj = 0; bj < 2; ++bj) { const v4u b = gb[rg][bj];
                const f32x4 v0 = acc[rg >> 2][bj][rg & 3][0], v1 = acc[rg >> 2][bj][rg & 3][1];
                if (P34_FP8) { constexpr float f = MG8_SCALE / (W34_SCALE * Y8_SCALE); unsigned char* m8 = (unsigned char*)MG + (size_t)(u.pm * 256 + wr * 64 + fr2) * D + u.pn * 256 + wc * 32 + 8 * fq2;
                    v2u w8; w8.x = pk4_fp8(v0[0] * bflo(b.x) * f, v0[1] * bfhi(b.x) * f, v0[2] * bflo(b.y) * f, v0[3] * bfhi(b.y) * f); w8.y = pk4_fp8(v1[0] * bflo(b.z) * f, v1[1] * bfhi(b.z) * f, v1[2] * bflo(b.w) * f, v1[3] * bfhi(b.w) * f);
                    w8.x = (unsigned)__builtin_amdgcn_ds_bpermute(paddr, (int)w8.x); w8.y = (unsigned)__builtin_amdgcn_ds_bpermute(paddr, (int)w8.y);
                    *(GAS v2u*)(m8 + (size_t)((rg >> 2) * 128 + (rg & 3) * 16) * D + bj * 128) = w8; }
                else {
                v4u w; w.x = cvtpk(v0[0] * bflo(b.x), v0[1] * bfhi(b.x)); w.y = cvtpk(v0[2] * bflo(b.y), v0[3] * bfhi(b.y));
                w.z = cvtpk(v1[0] * bflo(b.z), v1[1] * bfhi(b.z)); w.w = cvtpk(v1[2] * bflo(b.w), v1[3] * bfhi(b.w));
                w.x = (unsigned)__builtin_amdgcn_ds_bpermute(paddr, (int)w.x); w.y = (unsigned)__builtin_amdgcn_ds_bpermute(paddr, (int)w.y); w.z = (unsigned)__builtin_amdgcn_ds_bpermute(paddr, (int)w.z); w.w = (unsigned)__builtin_amdgcn_ds_bpermute(paddr, (int)w.w);
                *(GAS v4u*)(mr + (size_t)((rg >> 2) * 128 + (rg & 3) * 16) * D + bj * 128) = w; } }
    }
};
__device__ __forceinline__ void p3_merge(Frame& F) {
    unsigned char* ws = F.ws;
    pg9::DenseOrder S; S.init(T, D, F.G, (int)blockIdx.x);
    EpiMerge E{(const bf16*)(ws + WS_G), (bf16*)(ws + WS_MG)};
    constexpr int ES = P34_FP8 ? 1 : 2;
    pg9::DenseA ao{(unsigned)(Y_W * ES)}; pg9::DenseB bb{(const char*)(ws + WS_WAB), (size_t)256 * Y_W * ES};
    pg9::gemm_phase<ES>(F.lds, (const char*)(ws + WS_Y), Y_W, S, E, ao, bb);
}
struct EpiOut {
    static constexpr bool PERM = true; static constexpr int HOOK_T = -1;
    bf16* DELTA;
    __device__ __forceinline__ void hook(f32x4 (&)[2][2][4][2], const pg9::Unit&, int, int, int, int) const {}
    __device__ __forceinline__ void prefetch(LAS unsigned char*, const pg9::Unit&, int, int, int) const {}
    __device__ __forceinline__ void operator()(const f32x4 (&acc)[2][2][4][2], const pg9::Unit& u, int ui, int wr, int wc, int fr, int fq) const {
        asm volatile("" : "+v"(fr), "+v"(fq));
        const int fr2 = (fr >> 2) + 4 * fq, fq2 = fr & 3, paddr = 4 * (16 * (fr & 3) + 4 * fq + (fr >> 2));
        bf16* orow = DELTA + (size_t)(u.pm * 256 + wr * 64 + fr2) * D + u.pn * 256 + wc * 32 + 8 * fq2;
#pragma unroll
        for (int ai = 0; ai < 2; ++ai)
#pragma unroll
            for (int m = 0; m < 4; ++m)
#pragma unroll
                for (int bj = 0; bj < 2; ++bj) { constexpr float f = P34_FP8 ? 1.0f / (W34_SCALE * MG8_SCALE) : 1.0f; const f32x4 o0 = acc[ai][bj][m][0] * f, o1 = acc[ai][bj][m][1] * f;
                    v4u w; w.x = cvtpk(o0[0], o0[1]); w.y = cvtpk(o0[2], o0[3]); w.z = cvtpk(o1[0], o1[1]); w.w = cvtpk(o1[2], o1[3]);
                    w.x = (unsigned)__builtin_amdgcn_ds_bpermute(paddr, (int)w.x); w.y = (unsigned)__builtin_amdgcn_ds_bpermute(paddr, (int)w.y); w.z = (unsigned)__builtin_amdgcn_ds_bpermute(paddr, (int)w.z); w.w = (unsigned)__builtin_amdgcn_ds_bpermute(paddr, (int)w.w);
                    *(GAS v4u*)(orow + (size_t)(ai * 128 + m * 16) * D + bj * 128) = w; }
    }
};
__device__ __forceinline__ void p4_outproj(Frame& F) {
    unsigned char* ws = F.ws;
    pg9::DenseOrder S; S.init(T, D, F.G, (int)blockIdx.x);
    EpiOut E{(bf16*)((unsigned char*)F.out + DO_DELTA)};
    constexpr int ES = P34_FP8 ? 1 : 2;
    pg9::DenseA ao{(unsigned)(D * ES)}; pg9::DenseB bb{(const char*)(ws + WS_WO), (size_t)256 * D * ES};
    pg9::gemm_phase<ES>(F.lds, (const char*)(ws + WS_MG), D, S, E, ao, bb);
}

__device__ __forceinline__ void p5_route(Frame& F) {
    int tid_ = threadIdx.x; asm volatile("" : "+v"(tid_)); const int lane = tid_ & 63;
    unsigned char* ws = F.ws;
    const float* X = F.in[I_X]; const bf16* DELTA = (const bf16*)((const unsigned char*)F.out + DO_DELTA);
    bf16* X1B = (bf16*)(ws + WS_X1B); unsigned char* X1F8 = ws + WS_X1F8;
    unsigned* cnt = (unsigned*)(ws + WS_CTL) + CW_CNT;
    int* tokof = (int*)(ws + WS_TOKOF); float2* wtof = (float2*)(ws + WS_WTOF); int4* tpos = (int4*)(ws + WS_TPOS);
    const v4u* WRF = (const v4u*)(ws + WS_WRF);
    LAS v4u* wl = (LAS v4u*)F.lds;
    LAS float* sl = (LAS float*)(F.lds + 98304 + F.wave * 4096);
    const int i = lane & 15, q = lane >> 4;
    LAS unsigned* hist = (LAS unsigned*)(F.lds + LDS_MISC + 2048);
    for (int wt = F.vcu; wt < T / 128; wt += F.G) {
        const int tile = wt * NWAVES + F.wave;
        if (tid_ < 32) hist[tid_] = 0u;
        const size_t roff = (size_t)(tile * 16 + i) * D + 8 * q;
        const float* xr = X + roff; const bf16* dr = DELTA + roff;
        f32x4 a0 = {0.f, 0.f, 0.f, 0.f}, a1 = a0, a2 = a0; float ss = 0.f;
        f32x4 va[8][2]; v4u vd[8];
#pragma unroll
        for (int j = 0; j < 8; ++j) { va[j][0] = *(const GAS f32x4*)(xr + 32 * j); va[j][1] = *(const GAS f32x4*)(xr + 32 * j + 4); vd[j] = *(const GAS v4u*)(dr + 32 * j); }
#pragma unroll 1
        for (int half = 0; half < 2; ++half) {
            __syncthreads();
            { v4u t[12];
#pragma unroll
              for (int k = 0; k < 12; ++k) t[k] = WRF[half * 6144 + k * 512 + tid_];
#pragma unroll
              for (int k = 0; k < 12; ++k) wl[k * 512 + tid_] = t[k]; }
            __syncthreads();
#pragma unroll 1
            for (int sb = 0; sb < 2; ++sb) {
#pragma unroll
                for (int j = 0; j < 8; ++j) {
                    const int ksl = sb * 8 + j, ks = half * 16 + ksl;
                    const v4u dd = vd[j];
                    const f32x4 v0 = va[j][0] + (f32x4){bflo(dd.x), bfhi(dd.x), bflo(dd.y), bfhi(dd.y)}, v1 = va[j][1] + (f32x4){bflo(dd.z), bfhi(dd.z), bflo(dd.w), bfhi(dd.w)};
                    if (ks + 8 < 32) { va[j][0] = *(const GAS f32x4*)(xr + 32 * (ks + 8)); va[j][1] = *(const GAS f32x4*)(xr + 32 * (ks + 8) + 4); vd[j] = *(const GAS v4u*)(dr + 32 * (ks + 8)); }
                    ss += ((v0[0] * v0[0] + v0[1] * v0[1]) + (v0[2] * v0[2] + v0[3] * v0[3])) + ((v1[0] * v1[0] + v1[1] * v1[1]) + (v1[2] * v1[2] + v1[3] * v1[3]));
                    v4u hu; hu.x = cvtpk(v0[0], v0[1]); hu.y = cvtpk(v0[2], v0[3]); hu.z = cvtpk(v1[0], v1[1]); hu.w = cvtpk(v1[2], v1[3]);
                    v4u lu; lu.x = cvtpk(v0[0] - bflo(hu.x), v0[1] - bfhi(hu.x)); lu.y = cvtpk(v0[2] - bflo(hu.y), v0[3] - bfhi(hu.y)); lu.z = cvtpk(v1[0] - bflo(hu.z), v1[1] - bfhi(hu.z)); lu.w = cvtpk(v1[2] - bflo(hu.w), v1[3] - bfhi(hu.w));
                    *(GAS v4u*)(X1B + roff + 32 * ks) = hu;
                    if (P6_FP8) { v2u w8; w8.x = pk4_fp8(v0[0], v0[1], v0[2], v0[3]); w8.y = pk4_fp8(v1[0], v1[1], v1[2], v1[3]); *(GAS v2u*)(X1F8 + roff + 32 * ks) = w8; }
                    const bf16x8 ah = __builtin_bit_cast(bf16x8, hu), al = __builtin_bit_cast(bf16x8, lu);
#pragma unroll
                    for (int nb = 0; nb < 3; ++nb) {
                        const bf16x8 bh = __builtin_bit_cast(bf16x8, wl[((ksl * 3 + nb) * 2 + 0) * 64 + lane]), bl = __builtin_bit_cast(bf16x8, wl[((ksl * 3 + nb) * 2 + 1) * 64 + lane]);
                        f32x4 acc = nb == 0 ? a0 : (nb == 1 ? a1 : a2);
                        acc = __builtin_amdgcn_mfma_f32_16x16x32_bf16(ah, bh, acc, 0, 0, 0); acc = __builtin_amdgcn_mfma_f32_16x16x32_bf16(ah, bl, acc, 0, 0, 0); acc = __builtin_amdgcn_mfma_f32_16x16x32_bf16(al, bh, acc, 0, 0, 0);
                        if (nb == 0) a0 = acc; else if (nb == 1) a1 = acc; else a2 = acc;
                    }
                }
            }
        }
        ss += __shfl_xor(ss, 16); ss += __shfl_xor(ss, 32);
#pragma unroll
        for (int r = 0; r < 4; ++r) { sl[(4 * q + r) * 48 + i] = a0[r]; sl[(4 * q + r) * 48 + 16 + i] = a1[r]; sl[(4 * q + r) * 48 + 32 + i] = a2[r]; }
        LDS_WAIT(); asm volatile("" ::: "memory");
        int e0 = 0, e1 = 0, lp0 = 0, lp1 = 0; float w1 = 0.f, w2 = 0.f, rstd = 0.f;
        __syncthreads();
        if (lane < 16) {
            rstd = 1.0f / sqrtf(ss * (1.f / D) + RMS_EPS);
            float lg[36];
#pragma unroll
            for (int o = 0; o < 36; ++o) lg[o] = sl[lane * 48 + o] * rstd + (o < 4 ? F.in[I_BRG][o] : F.in[I_BRE][o - 4]);
            int gsel = 0; float gmax = lg[0];
#pragma unroll
            for (int k = 1; k < 4; ++k) if (lg[k] > gmax) { gmax = lg[k]; gsel = k; }
            float gden = 0.f;
#pragma unroll
            for (int k = 0; k < 4; ++k) gden += __expf(lg[k] - gmax);
            const float pg = 1.0f / gden;
            float le[8];
#pragma unroll
            for (int j = 0; j < 8; ++j) { le[j] = lg[4 + j];
#pragma unroll
                for (int gi = 1; gi < 4; ++gi) le[j] = (gsel == gi) ? lg[4 + gi * 8 + j] : le[j]; }
            int i1 = 0; float m1 = le[0];
#pragma unroll
            for (int j = 1; j < 8; ++j) if (le[j] > m1) { m1 = le[j]; i1 = j; }
            int i2 = -1; float m2 = -INFINITY;
#pragma unroll
            for (int j = 0; j < 8; ++j) if (j != i1 && le[j] > m2) { m2 = le[j]; i2 = j; }
            const float e2 = __expf(m2 - m1);
            w1 = pg / (1.0f + e2); w2 = pg * e2 / (1.0f + e2);
            e0 = gsel * 8 + i1; e1 = gsel * 8 + i2;
            lp0 = (int)__hip_atomic_fetch_add(&hist[e0], 1u, __ATOMIC_RELAXED, __HIP_MEMORY_SCOPE_WORKGROUP);
            lp1 = (int)__hip_atomic_fetch_add(&hist[e1], 1u, __ATOMIC_RELAXED, __HIP_MEMORY_SCOPE_WORKGROUP);
        }
        __syncthreads();
        if (tid_ < 32) { const unsigned n = hist[tid_]; hist[32 + tid_] = n ? atomicAdd(&cnt[64 * tid_], n) : 0u; }
        __syncthreads();
        if (lane < 16) {
            const int row = tile * 16 + lane;
            const int p0 = (int)hist[32 + e0] + lp0, p1 = (int)hist[32 + e1] + lp1;
            tokof[(size_t)e0 * T + p0] = row; wtof[(size_t)e0 * T + p0] = make_float2(w1, rstd);
            tokof[(size_t)e1 * T + p1] = row; wtof[(size_t)e1 * T + p1] = make_float2(w2, rstd);
            tpos[row] = make_int4(e0, p0, e1, p1);
        }
        __syncthreads();
    }
}

__device__ __forceinline__ void expert_tiles(Frame& F, LAS int* tb, LAS int* cn) {
    int tid_ = threadIdx.x; asm volatile("" : "+v"(tid_)); const int lane_ = tid_ & 63;
    if (tid_ < 64) {
        const unsigned* cnt = (const unsigned*)(F.ws + WS_CTL) + CW_CNT;
        const int e = lane_ & (NE - 1);
        const int c = (int)__hip_atomic_load(cnt + 64 * e, __ATOMIC_RELAXED, __HIP_MEMORY_SCOPE_AGENT);
        const int tiles = (c + 255) >> 8;
        int pre = tiles;
#pragma unroll
        for (int d = 1; d < NE; d <<= 1) { const int t = __shfl_up(pre, d); if (e >= d) pre += t; }
        if (lane_ < NE) { cn[e] = c; tb[e] = pre - tiles; if (e == NE - 1) tb[NE] = pre; }
    }
    __syncthreads();
}

struct MoeOrder { const LAS int* tb; int ncol, G, c;
    __device__ bool next(int i, pg9::Unit& u) const {
        const int tot = tb[NE] * ncol;
        int L = i * G + c;
        if (G == 256 && (i + 1) * G > tot) L = i * G + ((c & 31) << 3) + (c >> 5);
        if (L >= tot) return false;
        const int rt = L / ncol; int e = 0;
        for (int k = 1; k < NE; ++k) if (tb[k] <= rt) e = k;
        u.pm = rt; u.pn = L % ncol; u.e = e; return true; } };
struct GatherA { static constexpr bool GATHER = true; unsigned rowbytes; const int* tokof; const LAS int* tb; const LAS int* cn;
    __device__ __forceinline__ unsigned operator()(const pg9::Unit& u, int row) const {
        const int p = (u.pm - tb[u.e]) * 256 + row; const int tok = tokof[(size_t)u.e * T + (p < cn[u.e] ? p : 0)]; return (unsigned)tok * rowbytes; }
    __device__ __forceinline__ void rows4(const pg9::Unit& u, int r0, int r1, int r2, int r3, unsigned (&o)[4]) const {
        const int base = (u.pm - tb[u.e]) * 256, ce = cn[u.e]; const int* tp = tokof + (size_t)u.e * T;
        const int* a0 = tp + (base + r0 < ce ? base + r0 : 0); const int* a1 = tp + (base + r1 < ce ? base + r1 : 0); const int* a2 = tp + (base + r2 < ce ? base + r2 : 0); const int* a3 = tp + (base + r3 < ce ? base + r3 : 0);
        int t0, t1, t2, t3;
        asm volatile("global_load_dword %0, %4, off\n\tglobal_load_dword %1, %5, off\n\tglobal_load_dword %2, %6, off\n\tglobal_load_dword %3, %7, off\n\ts_waitcnt vmcnt(0)"
                     : "=&v"(t0), "=&v"(t1), "=&v"(t2), "=&v"(t3) : "v"(a0), "v"(a1), "v"(a2), "v"(a3) : "memory");
        o[0] = (unsigned)t0 * rowbytes; o[1] = (unsigned)t1 * rowbytes; o[2] = (unsigned)t2 * rowbytes; o[3] = (unsigned)t3 * rowbytes; } };
struct ExpertB { const char* W; size_t ebytes, tilebytes; __device__ __forceinline__ const char* operator()(const pg9::Unit& u) const { return W + (size_t)u.e * ebytes + (size_t)u.pn * tilebytes; } };
struct EpiGateUp {
    static constexpr bool PERM = true; static constexpr int HOOK_T = -1;
    const float2* wtof; bf16* HACT; const LAS int* tb; const LAS int* cn; float ascale;
    __device__ __forceinline__ void hook(f32x4 (&)[2][2][4][2], const pg9::Unit&, int, int, int, int) const {}
    __device__ __forceinline__ void prefetch(LAS unsigned char*, const pg9::Unit&, int, int, int) const {}
    __device__ __forceinline__ void operator()(const f32x4 (&acc)[2][2][4][2], const pg9::Unit& u, int ui, int wr, int wc, int fr, int fq) const {
        asm volatile("" : "+v"(fr), "+v"(fq));
        const int r0 = wr * 64 + fr, p0 = (u.pm - tb[u.e]) * 256, ce = cn[u.e];
        const int fr2 = (fr >> 2) + 4 * fq, fq2 = fr & 3, paddr = 4 * (16 * (fr & 3) + 4 * fq + (fr >> 2)), r0s = wr * 64 + fr2;
        const float2* wp = wtof + (size_t)u.e * T;
#pragma unroll
        for (int ai = 0; ai < 2; ++ai) {
            float2 wv[4];
#pragma unroll
            for (int m = 0; m < 4; ++m) { const int p = p0 + r0 + ai * 128 + m * 16; const float2 t = wp[p < ce ? p : 0]; wv[m].x = p < ce ? t.x : 0.f; wv[m].y = p < ce ? t.y : 0.f; }
#pragma unroll
            for (int m = 0; m < 4; ++m) { const int r = r0s + ai * 128 + m * 16;
                const float w = wv[m].x, rs = wv[m].y * ascale;
                bf16* orow = HACT + (size_t)(u.pm * 256 + r) * DE + u.pn * 128 + wc * 16 + 4 * fq2; unsigned char* orow8 = (unsigned char*)HACT + (size_t)(u.pm * 256 + r) * DE + u.pn * 128 + wc * 16 + 4 * fq2;
#pragma unroll
                for (int bj = 0; bj < 2; ++bj) { const f32x4 g = acc[ai][bj][m][0], uu = acc[ai][bj][m][1]; f32x4 hv;
#pragma unroll
                    for (int e = 0; e < 4; ++e) { const float gg = g[e] * rs; hv[e] = gg / (1.0f + __expf(-gg)) * (uu[e] * rs) * w; }
                    if (P6_FP8) *(GAS unsigned*)(orow8 + bj * 64) = (unsigned)__builtin_amdgcn_ds_bpermute(paddr, (int)pk4_fp8(hv[0] * H8_SCALE, hv[1] * H8_SCALE, hv[2] * H8_SCALE, hv[3] * H8_SCALE));
                    else { v2u o; o.x = (unsigned)__builtin_amdgcn_ds_bpermute(paddr, (int)cvtpk(hv[0], hv[1])); o.y = (unsigned)__builtin_amdgcn_ds_bpermute(paddr, (int)cvtpk(hv[2], hv[3])); *(GAS v2u*)(orow + bj * 64) = o; } } }
        }
    }
};
__device__ __forceinline__ void p6a_gateup(Frame& F) {
    unsigned char* ws = F.ws;
    LAS int* tb = (LAS int*)(F.lds + LDS_MISC + 1024); LAS int* cn = tb + 64;
    expert_tiles(F, tb, cn);
    MoeOrder S{tb, 2, F.G, F.vcu};
    constexpr int ES = P6_FP8 ? 1 : 2;
    GatherA ao{(unsigned)(D * ES), (const int*)(ws + WS_TOKOF), tb, cn}; ExpertB bb{(const char*)(ws + WS_WGU), (size_t)512 * D * ES, (size_t)256 * D * ES};
    EpiGateUp E{(const float2*)(ws + WS_WTOF), (bf16*)(ws + WS_HACT), tb, cn, P6_FP8 ? 1.0f / WG8_SCALE : 1.0f};
    pg9::gemm_phase<ES>(F.lds, (const char*)(ws + (P6_FP8 ? WS_X1F8 : WS_X1B)), D, S, E, ao, bb);
}
struct EpiDown {
    static constexpr bool PERM = true; static constexpr int HOOK_T = -1;
    bf16* YS; float ascale;
    __device__ __forceinline__ void hook(f32x4 (&)[2][2][4][2], const pg9::Unit&, int, int, int, int) const {}
    __device__ __forceinline__ void prefetch(LAS unsigned char*, const pg9::Unit&, int, int, int) const {}
    __device__ __forceinline__ void operator()(const f32x4 (&acc)[2][2][4][2], const pg9::Unit& u, int ui, int wr, int wc, int fr, int fq) const {
        asm volatile("" : "+v"(fr), "+v"(fq));
        const int fr2 = (fr >> 2) + 4 * fq, fq2 = fr & 3, paddr = 4 * (16 * (fr & 3) + 4 * fq + (fr >> 2));
#pragma unroll
        for (int ai = 0; ai < 2; ++ai)
#pragma unroll
            for (int m = 0; m < 4; ++m) { bf16* orow = YS + (size_t)(u.pm * 256 + wr * 64 + fr2 + ai * 128 + m * 16) * D + u.pn * 256 + wc * 32 + 8 * fq2;
#pragma unroll
                for (int bj = 0; bj < 2; ++bj) { const f32x4 v0 = acc[ai][bj][m][0] * ascale, v1 = acc[ai][bj][m][1] * ascale;
                    if (YS_FP8) { unsigned char* o8 = (unsigned char*)YS + (size_t)(u.pm * 256 + wr * 64 + fr2 + ai * 128 + m * 16) * D + u.pn * 256 + wc * 32 + 8 * fq2 + bj * 128;
                        v2u w8; w8.x = pk4_fp8(v0[0] * YS8_SCALE, v0[1] * YS8_SCALE, v0[2] * YS8_SCALE, v0[3] * YS8_SCALE); w8.y = pk4_fp8(v1[0] * YS8_SCALE, v1[1] * YS8_SCALE, v1[2] * YS8_SCALE, v1[3] * YS8_SCALE);
                        w8.x = (unsigned)__builtin_amdgcn_ds_bpermute(paddr, (int)w8.x); w8.y = (unsigned)__builtin_amdgcn_ds_bpermute(paddr, (int)w8.y); *(GAS v2u*)o8 = w8; }
                    else { v4u w; w.x = cvtpk(v0[0], v0[1]); w.y = cvtpk(v0[2], v0[3]); w.z = cvtpk(v1[0], v1[1]); w.w = cvtpk(v1[2], v1[3]);
                        w.x = (unsigned)__builtin_amdgcn_ds_bpermute(paddr, (int)w.x); w.y = (unsigned)__builtin_amdgcn_ds_bpermute(paddr, (int)w.y); w.z = (unsigned)__builtin_amdgcn_ds_bpermute(paddr, (int)w.z); w.w = (unsigned)__builtin_amdgcn_ds_bpermute(paddr, (int)w.w); *(GAS v4u*)(orow + bj * 128) = w; } } }
    }
};
__device__ __forceinline__ void p6b_down(Frame& F) {
    unsigned char* ws = F.ws;
    LAS int* tb = (LAS int*)(F.lds + LDS_MISC + 1024); LAS int* cn = tb + 64;
    MoeOrder S{tb, 4, F.G, F.vcu};
    constexpr int ES = P6_FP8 ? 1 : 2;
    pg9::DenseA ao{(unsigned)(DE * ES)}; ExpertB bb{(const char*)(ws + WS_WD), (size_t)D * DE * ES, (size_t)256 * DE * ES};
    EpiDown E{(bf16*)(ws + WS_YS), P6_FP8 ? 1.0f / (WD8_SCALE * H8_SCALE) : 1.0f};
    pg9::gemm_phase<ES>(F.lds, (const char*)(ws + WS_HACT), DE, S, E, ao, bb);
}
__device__ __forceinline__ void p7_final(Frame& F) {
    int tid_ = threadIdx.x; asm volatile("" : "+v"(tid_)); const int lane_ = tid_ & 63;
    unsigned char* ws = F.ws;
    LAS int* tb = (LAS int*)(F.lds + LDS_MISC + 1024); LAS int* cn = tb + 64;
    const bf16* YS = (const bf16*)(ws + WS_YS); const int4* tpos = (const int4*)(ws + WS_TPOS);
    float* X1 = F.out; const bf16* X1B = (const bf16*)(ws + WS_X1B);
    const int lane = lane_;
    const int gw = F.vcu * NWAVES + F.wave, NGW = F.G * NWAVES;
    f32x4 gg[4];
#pragma unroll
    for (int j = 0; j < 4; ++j) gg[j] = ((const GAS f32x4*)F.in[I_GFIN] + lane)[64 * j];
    for (int row0 = gw; row0 < T; row0 += 4 * NGW) {
        int4 tp[4];
#pragma unroll
        for (int r = 0; r < 4; ++r) { const int row = row0 + r * NGW < T ? row0 + r * NGW : row0; tp[r] = tpos[row]; }
        v2u xx[4][4]; v2u ya[4][4], yb[4][4]; unsigned za[4][4], zb[4][4];
#pragma unroll
        for (int r = 0; r < 4; ++r) { const int row = row0 + r * NGW < T ? row0 + r * NGW : row0;
            const size_t s0 = (size_t)tb[tp[r].x] * 256 + tp[r].y, s1 = (size_t)tb[tp[r].z] * 256 + tp[r].w;
            const GAS v2u* xb = (const GAS v2u*)(X1B + (size_t)row * D) + lane;
            const GAS v2u* y0 = (const GAS v2u*)(YS + s0 * D) + lane; const GAS v2u* y1 = (const GAS v2u*)(YS + s1 * D) + lane;
            const GAS unsigned* z0 = (const GAS unsigned*)((const unsigned char*)YS + s0 * D) + lane; const GAS unsigned* z1 = (const GAS unsigned*)((const unsigned char*)YS + s1 * D) + lane;
#pragma unroll
            for (int j = 0; j < 4; ++j) { xx[r][j] = xb[64 * j];
                if (YS_FP8) { za[r][j] = z0[64 * j]; zb[r][j] = z1[64 * j]; } else { ya[r][j] = y0[64 * j]; yb[r][j] = y1[64 * j]; } } }
#pragma unroll
        for (int r = 0; r < 4; ++r) { const int row = row0 + r * NGW; if (row >= T) continue;
            GAS f32x4* xr = (GAS f32x4*)(X1 + (size_t)row * D) + lane;
            f32x4 v[4]; float s = 0.f;
#pragma unroll
            for (int j = 0; j < 4; ++j) { const v2u x_ = xx[r][j]; v[j] = (f32x4){bflo(x_.x), bfhi(x_.x), bflo(x_.y), bfhi(x_.y)};
                if (YS_FP8) { const int a = (int)za[r][j], b = (int)zb[r][j]; typedef float f2_ __attribute__((ext_vector_type(2)));
                    const f2_ a0 = __builtin_amdgcn_cvt_pk_f32_fp8(a, false), a1 = __builtin_amdgcn_cvt_pk_f32_fp8(a, true), b0 = __builtin_amdgcn_cvt_pk_f32_fp8(b, false), b1 = __builtin_amdgcn_cvt_pk_f32_fp8(b, true);
                    constexpr float f = 1.0f / YS8_SCALE; v[j].x += (a0[0] + b0[0]) * f; v[j].y += (a0[1] + b0[1]) * f; v[j].z += (a1[0] + b1[0]) * f; v[j].w += (a1[1] + b1[1]) * f; }
                else { const v2u a = ya[r][j], b = yb[r][j];
                v[j].x += bflo(a.x) + bflo(b.x); v[j].y += bfhi(a.x) + bfhi(b.x); v[j].z += bflo(a.y) + bflo(b.y); v[j].w += bfhi(a.y) + bfhi(b.y); }
                s += (v[j].x * v[j].x + v[j].y * v[j].y) + (v[j].z * v[j].z + v[j].w * v[j].w); }
            const float rstd = 1.0f / sqrtf(wave_sum(s) * (1.f / D) + RMS_EPS);
#pragma unroll
            for (int j = 0; j < 4; ++j) { f32x4 o; o.x = v[j].x * rstd * gg[j].x; o.y = v[j].y * rstd * gg[j].y; o.z = v[j].z * rstd * gg[j].z; o.w = v[j].w * rstd * gg[j].w; xr[64 * j] = o; } }
    }
}

constexpr int NPHASE = 2 * NCH + 8;
__global__ void __launch_bounds__(NTHR, 2) fwd_kernel(KArgs args) {
    extern __shared__ __attribute__((aligned(16))) unsigned char lds_raw[];
    Frame F;
    F.lds = (LAS unsigned char*)lds_raw;
    F.tid = threadIdx.x; F.lane = F.tid & 63; F.wave = __builtin_amdgcn_readfirstlane(F.tid >> 6);
    F.G = gridDim.x; { const int bx = blockIdx.x; F.vcu = (F.G % 8 == 0) ? (bx % 8) * (F.G / 8) + bx / 8 : bx; }
#pragma unroll
    for (int i = 0; i < 17; ++i) F.in[i] = args.in[i];
    F.out = args.out; F.ws = args.ws;
    volatile LAS unsigned* MISC = (volatile LAS unsigned*)(F.lds + LDS_MISC);
    if (F.tid < 64) MISC[F.tid] = 0u;
    __syncthreads();
    XcdBarrier bar = xcd_barrier_post((unsigned*)(F.ws + WS_CTL) + CW_BAR + args.li * XCD_BAR_WORDS, MISC + 8);
#define IN(k) (args.ph_lo <= (k) && (k) < args.ph_hi)
#ifdef PROBE_MASK
    unsigned long long pr_acc = 0, pr_t0 = 0; const bool pr_me = (blockIdx.x == 0 && threadIdx.x == 0);
#define PR_BEGIN(k) do { if (pr_me && ((PROBE_MASK >> (k)) & 1ull)) pr_t0 = __builtin_amdgcn_s_memrealtime(); } while (0)
#define PR_END(k) do { if (pr_me && ((PROBE_MASK >> (k)) & 1ull)) pr_acc += __builtin_amdgcn_s_memrealtime() - pr_t0; } while (0)
#else
#define PR_BEGIN(k) do {} while (0)
#define PR_END(k) do {} while (0)
#endif
#define SEAM(k) do { if (IN(k) && IN((k) + 1)) xcd_barrier(bar); PR_END(k); } while (0)
#define SEAM_WT(k) do { if (IN(k) && IN((k) + 1)) xcd_barrier(bar, false); PR_END(k); } while (0)
    PR_BEGIN(0); if (IN(0)) p0_prologue(F);
    SEAM(0);
#pragma unroll 1
    for (int ch = 0; ch < NCH; ++ch) {
        PR_BEGIN(1 + 2 * ch);
        if (IN(1 + 2 * ch)) {
            constexpr int NWG1 = (TC / 256) * (NIN / 256);
            const int nfull = NWG1 % F.G, bx = (int)blockIdx.x;
            if (ch > 0 && nfull == 0) p2_combine(F, ch - 1, F.vcu, F.G);
            p1_inproj(F, ch);
            if (ch > 0 && nfull != 0 && bx >= nfull) p2_combine(F, ch - 1, bx - nfull, F.G - nfull);
        }
        SEAM_WT(1 + 2 * ch);
        PR_BEGIN(2 + 2 * ch); if (IN(2 + 2 * ch)) p2_attn(F, ch);
        SEAM_WT(2 + 2 * ch);
    }
    PR_BEGIN(2 * NCH + 1); if (IN(2 * NCH + 1)) p2_combine(F, NCH - 1, F.vcu, F.G);
    SEAM_WT(2 * NCH + 1);
    PR_BEGIN(2 * NCH + 2); if (IN(2 * NCH + 2)) p3_merge(F);
    SEAM(2 * NCH + 2);
    PR_BEGIN(2 * NCH + 3); if (IN(2 * NCH + 3)) p4_outproj(F);
    SEAM(2 * NCH + 3);
    PR_BEGIN(2 * NCH + 4); if (IN(2 * NCH + 4)) p5_route(F);
    SEAM(2 * NCH + 4);
    PR_BEGIN(2 * NCH + 5); if (IN(2 * NCH + 5)) p6a_gateup(F);
    SEAM(2 * NCH + 5);
    PR_BEGIN(2 * NCH + 6); if (IN(2 * NCH + 6)) p6b_down(F);
    SEAM(2 * NCH + 6);
    PR_BEGIN(2 * NCH + 7); if (IN(2 * NCH + 7)) p7_final(F);
    PR_END(2 * NCH + 7);
#ifdef PROBE_MASK
    if (pr_me) { const unsigned long long t1 = __builtin_amdgcn_s_memrealtime(); while (__builtin_amdgcn_s_memrealtime() - t1 < pr_acc) __builtin_amdgcn_s_sleep(4); }
#endif
#undef IN
#undef SEAM
}

#ifndef N_LAUNCHES
#define N_LAUNCHES 1
#endif
extern "C" void kernel_launch(void* const* d_in, const int* in_sizes, int n_in, void* d_out, int out_size, void* d_ws, size_t ws_size, hipStream_t stream) {
    static int grid = 0;
    if (grid == 0) {
        if (n_in != 17 || in_sizes[0] != T * D || out_size != T * D || ws_size < WS_END) { fprintf(stderr, "kernel_launch: unexpected shapes / workspace (%d inputs, ws %zu)\n", n_in, ws_size); grid = -1; return; }
        int dev = 0, cus = 0;
        if (hipGetDevice(&dev) != hipSuccess || hipDeviceGetAttribute(&cus, hipDeviceAttributeMultiprocessorCount, dev) != hipSuccess) { grid = -1; return; }
        if (hipFuncSetAttribute((const void*)fwd_kernel, hipFuncAttributeMaxDynamicSharedMemorySize, LDS_BYTES) != hipSuccess) { fprintf(stderr, "kernel_launch: hipFuncSetAttribute failed\n"); grid = -1; return; }
        int per_cu = 0;
        if (hipOccupancyMaxActiveBlocksPerMultiprocessor(&per_cu, (const void*)fwd_kernel, NTHR, LDS_BYTES) != hipSuccess || per_cu < 1) fprintf(stderr, "kernel_launch: occupancy query says %d\n", per_cu);
        (void)hipGetLastError();
        grid = cus;
    }
    if (grid < 0) return;
    (void)hipMemsetAsync((char*)d_ws + WS_CTL, 0, N_LAUNCHES == 1 ? (size_t)(CW_BAR + XCD_BAR_WORDS) * 4 : CTL_BYTES, stream);
    KArgs a{};
    for (int i = 0; i < 17; ++i) a.in[i] = (const float*)d_in[i];
    a.out = (float*)d_out; a.ws = (unsigned char*)d_ws;
    for (int li = 0; li < N_LAUNCHES; ++li) {
        a.ph_lo = (int)((long)NPHASE * li / N_LAUNCHES); a.ph_hi = (int)((long)NPHASE * (li + 1) / N_LAUNCHES); a.li = li;
        hipLaunchKernelGGL(fwd_kernel, dim3(grid), dim3(NTHR), LDS_BYTES, stream, a);
    }
}
```
